# Optimizing an MI355X kernel written in HIP

```python
import jax, jax.numpy as jnp
from jax import lax
import numpy as np

D_MODEL = 1024
BATCH = 8
SEQ = 8192
DEPTH = 2

NSA_HEADS = 8
NSA_KV_HEADS = 2
NSA_GROUP = NSA_HEADS // NSA_KV_HEADS
NSA_HEAD_DIM = 64
NSA_Q_W = NSA_HEADS * NSA_HEAD_DIM
NSA_KV_W = NSA_KV_HEADS * NSA_HEAD_DIM
CMP_STRIDE = 16
CMP_LEN = 2 * CMP_STRIDE
CMP_HIDDEN = 128
SEL_BLOCK = 64
N_SEL = 8
WINDOW = 512
Q_BLOCK = 128
SEL_FORCE = 1e4
CONV_CH = 512
CONV_K = 31
RWKV_HEADS = 8
RWKV_HEAD_DIM = 64
RWKV_W = RWKV_HEADS * RWKV_HEAD_DIM
DECAY_LORA = 64
ICLR_LORA = 64
GATE_LORA = 160
VRES_LORA = 32
N_BRANCH = 3
DENSE_FF = 2816
N_EXPERTS = 8
TOP_K = 2
EXPERT_FF = 3584
MOE_BLOCK = 512
ROPE_THETA = 10000.0
RMS_EPS = 1e-6
LN_EPS = 1e-5
GN_EPS = 64e-5
NEG_INF = -1e30

NSA_IN = NSA_Q_W + 6 * NSA_KV_W + 3 * NSA_HEADS
CONV_IN = 2 * CONV_CH
GATE_IN = N_BRANCH * D_MODEL
RWKV_IN_FIRST = 3 * RWKV_W + DECAY_LORA + ICLR_LORA + GATE_LORA
RWKV_IN_REST = RWKV_IN_FIRST + VRES_LORA
OFF_CONV = NSA_IN
OFF_GATE = OFF_CONV + CONV_IN
OFF_RWKV = OFF_GATE + GATE_IN
N_IN_FIRST = OFF_RWKV + RWKV_IN_FIRST
N_IN_REST = OFF_RWKV + RWKV_IN_REST

kernel_name = 'hybrid_nsa_conformer_rwkv7_moe'


def rms_norm(x, g):
    xf = x.astype(jnp.float32)
    y = xf * lax.rsqrt(jnp.mean(xf * xf, axis=-1, keepdims=True) + RMS_EPS)
    return (y * g.astype(jnp.float32)).astype(x.dtype)


def rope(x, pos):
    half = x.shape[-1] // 2
    inv = ROPE_THETA ** (-jnp.arange(half, dtype=jnp.float32) / half)
    ang = pos.astype(jnp.float32)[:, None] * inv[None, :]
    cos, sin = jnp.cos(ang), jnp.sin(ang)
    x1 = x[..., :half].astype(jnp.float32)
    x2 = x[..., half:].astype(jnp.float32)
    return jnp.concatenate([x1 * cos - x2 * sin, x2 * cos + x1 * sin], axis=-1).astype(x.dtype)


def masked_softmax(s, mask):
    return jax.nn.softmax(jnp.where(mask, s, NEG_INF), axis=-1) * mask


def compress_blocks(t, pos_emb, w1, w2):
    B, G, S, DH = t.shape
    ch = t.reshape(B, G, S // CMP_STRIDE, CMP_STRIDE, DH)
    blocks = jnp.concatenate([ch[:, :, :-1], ch[:, :, 1:]], axis=3) + pos_emb
    flat = blocks.reshape(B, G, S // CMP_STRIDE - 1, CMP_LEN * DH)
    return jax.nn.gelu(flat @ w1) @ w2


def nsa_mixer(p, qk_g, cmp_pos, cmp_w1, cmp_w2):
    B, S, _ = p.shape
    G, HG, DH = NSA_KV_HEADS, NSA_GROUP, NSA_HEAD_DIM
    pos = jnp.arange(S)

    def heads(t, n):
        return t.reshape(B, S, n, DH).transpose(0, 2, 1, 3)

    q = heads(p[..., :NSA_Q_W], NSA_HEADS)
    kc, vc, ks, vs, kw, vw = [heads(p[..., NSA_Q_W + i * NSA_KV_W:NSA_Q_W + (i + 1) * NSA_KV_W], G)
                              for i in range(6)]
    g_off = NSA_Q_W + 6 * NSA_KV_W
    gates = jax.nn.sigmoid(p[..., g_off:g_off + 3 * NSA_HEADS].astype(jnp.float32))
    gates = gates.reshape(B, S, G, HG, 3).transpose(0, 2, 3, 1, 4)

    q = rope(rms_norm(q, qk_g[0]), pos).reshape(B, G, HG, S, DH)
    nc = S // CMP_STRIDE - 1
    ns = S // SEL_BLOCK
    c_start = jnp.arange(nc) * CMP_STRIDE
    cmp_end = c_start + CMP_LEN - 1
    k_cmp = rope(rms_norm(compress_blocks(kc, cmp_pos[0], cmp_w1[0], cmp_w2[0]), qk_g[1]), cmp_end)
    v_cmp = compress_blocks(vc, cmp_pos[1], cmp_w1[1], cmp_w2[1])
    ks = rope(rms_norm(ks, qk_g[2]), pos)
    kw = rope(rms_norm(kw, qk_g[3]), pos)
    ks_blk = ks.reshape(B, G, ns, SEL_BLOCK, DH)
    vs_blk = vs.reshape(B, G, ns, SEL_BLOCK, DH)
    pad = ((0, 0), (0, 0), (WINDOW, 0), (0, 0))
    kw_pad = jnp.pad(kw, pad)
    vw_pad = jnp.pad(vw, pad)

    s_start = jnp.arange(ns) * SEL_BLOCK
    overlap = ((c_start[:, None] < s_start[None, :] + SEL_BLOCK)
               & (c_start[:, None] + CMP_LEN > s_start[None, :])).astype(jnp.float32)
    n_sel = min(N_SEL, ns)
    scale = DH ** -0.5
    b_ix = jnp.arange(B)[:, None, None, None]
    g_ix = jnp.arange(G)[None, :, None, None]
    blk_ids = jnp.arange(ns)

    def query_block(qb):
        t0 = qb * Q_BLOCK
        t = t0 + jnp.arange(Q_BLOCK)
        q_b = lax.dynamic_slice_in_dim(q, t0, Q_BLOCK, axis=3)
        g_b = lax.dynamic_slice_in_dim(gates, t0, Q_BLOCK, axis=3)
        s_c = jnp.einsum('bghqd,bgcd->bghqc', q_b, k_cmp, preferred_element_type=jnp.float32) * scale
        p_c = masked_softmax(s_c, cmp_end[None, :] <= t[:, None])
        o_c = jnp.einsum('bghqc,bgcd->bghqd', p_c, v_cmp)
        imp = jnp.einsum('bghqc,cj->bgqj', p_c, overlap)
        cur = (t // SEL_BLOCK)[:, None]
        j = blk_ids[None, :]
        forced = (j == 0) | (j == cur) | (j == cur - 1)
        score = jnp.where(forced, SEL_FORCE, jnp.where(j <= cur, imp, -1.0))
        _, idx = lax.top_k(score, n_sel)
        k_sel = ks_blk[b_ix, g_ix, idx]
        v_sel = vs_blk[b_ix, g_ix, idx]
        s_s = jnp.einsum('bghqd,bgqnkd->bghqnk', q_b, k_sel, preferred_element_type=jnp.float32) * scale
        tok = idx[..., None] * SEL_BLOCK + jnp.arange(SEL_BLOCK)
        m_s = (tok <= t[None, None, :, None, None])[:, :, None]
        p_s = masked_softmax(s_s.reshape(B, G, HG, Q_BLOCK, n_sel * SEL_BLOCK),
                             m_s.reshape(B, G, 1, Q_BLOCK, n_sel * SEL_BLOCK))
        o_s = jnp.einsum('bghqm,bgqmd->bghqd', p_s, v_sel.reshape(B, G, Q_BLOCK, n_sel * SEL_BLOCK, DH))
        k_w = lax.dynamic_slice_in_dim(kw_pad, t0, WINDOW + Q_BLOCK, axis=2)
        v_w = lax.dynamic_slice_in_dim(vw_pad, t0, WINDOW + Q_BLOCK, axis=2)
        kpos = t0 - WINDOW + jnp.arange(WINDOW + Q_BLOCK)
        m_w = ((kpos[None, :] <= t[:, None]) & (kpos[None, :] > t[:, None] - WINDOW)
               & (kpos[None, :] >= 0))
        s_w = jnp.einsum('bghqd,bgkd->bghqk', q_b, k_w, preferred_element_type=jnp.float32) * scale
        p_w = masked_softmax(s_w, m_w)
        o_w = jnp.einsum('bghqk,bgkd->bghqd', p_w, v_w)
        out = g_b[..., 0:1] * o_c + g_b[..., 1:2] * o_s + g_b[..., 2:3] * o_w
        return out.astype(p.dtype)

    outs = lax.map(query_block, jnp.arange(S // Q_BLOCK))
    return outs.transpose(1, 0, 4, 2, 3, 5).reshape(B, S, NSA_Q_W)


def conformer_conv(p, conv_w, conv_vec, w_o):
    u = p[..., :CONV_CH] * jax.nn.sigmoid(p[..., CONV_CH:])
    u = lax.conv_general_dilated(u, conv_w[:, None, :].astype(u.dtype), (1,), [(CONV_K - 1, 0)],
                                 dimension_numbers=('NWC', 'WIO', 'NWC'),
                                 feature_group_count=CONV_CH)
    uf = u.astype(jnp.float32) + conv_vec[0]
    mu = jnp.mean(uf, axis=-1, keepdims=True)
    var = jnp.mean(jnp.square(uf - mu), axis=-1, keepdims=True)
    uf = (uf - mu) * lax.rsqrt(var + LN_EPS) * conv_vec[1] + conv_vec[2]
    uf = uf * jax.nn.sigmoid(uf)
    return uf.astype(p.dtype) @ w_o


def wkv7_scan(r, w, k, v, kk, a):
    B, S, H, N = r.shape

    def step(state, inp):
        r_t, w_t, k_t, v_t, kk_t, a_t = inp
        s_kk = jnp.einsum('bhvk,bhk->bhv', state, kk_t)
        state = (state * w_t[:, :, None, :]
                 - s_kk[..., None] * (kk_t * a_t)[:, :, None, :]
                 + v_t[..., None] * k_t[:, :, None, :])
        return state, jnp.einsum('bhvk,bhk->bhv', state, r_t)

    xs = tuple(jnp.swapaxes(z, 0, 1) for z in (r, w, k, v, kk, a))
    _, ys = lax.scan(step, jnp.zeros((B, H, N, N), jnp.float32), xs)
    return jnp.swapaxes(ys, 0, 1)


def rwkv7_mixer(p, mu, vec, w_up, a_up, g_up, w_o, v_first, vres_up, vres_b):
    B, S, _ = p.shape
    C, H, N = RWKV_W, RWKV_HEADS, RWKV_HEAD_DIM
    prev = jnp.concatenate([jnp.zeros_like(p[:, :1]), p[:, :-1]], axis=1)
    u = p + (prev - p) * mu
    r, k, v = u[..., :C], u[..., C:2 * C], u[..., 2 * C:3 * C]
    o = 3 * C
    wd = u[..., o:o + DECAY_LORA]; o += DECAY_LORA
    ad = u[..., o:o + ICLR_LORA]; o += ICLR_LORA
    gd = u[..., o:o + GATE_LORA]; o += GATE_LORA
    w_log = -jax.nn.softplus(-(vec[0] + jnp.tanh(wd) @ w_up).astype(jnp.float32)) - 0.5
    decay = jnp.exp(-jnp.exp(w_log))
    a = jax.nn.sigmoid((vec[1] + ad @ a_up).astype(jnp.float32))
    g = jax.nn.sigmoid(gd) @ g_up
    if v_first is not None:
        vd = u[..., o:o + VRES_LORA]
        v = v + (v_first - v) * jax.nn.sigmoid(vres_b + vd @ vres_up)
    hd = lambda z: z.reshape(B, S, H, N)
    kk = hd(k * vec[2]).astype(jnp.float32)
    kk = kk / jnp.maximum(jnp.sqrt(jnp.sum(kk * kk, axis=-1, keepdims=True)), 1e-12)
    k = k * (1.0 + (a - 1.0) * vec[3])
    rf, kf, vf = hd(r).astype(jnp.float32), hd(k).astype(jnp.float32), hd(v).astype(jnp.float32)
    y = wkv7_scan(rf, hd(decay), kf, vf, kk, hd(a))
    ym = jnp.mean(y, axis=-1, keepdims=True)
    yv = jnp.mean(jnp.square(y - ym), axis=-1, keepdims=True)
    y = ((y - ym) * lax.rsqrt(yv + GN_EPS)).reshape(B, S, C) * vec[5] + vec[6]
    r_k = vec[4].reshape(H, N).astype(jnp.float32)
    bonus = (jnp.sum(rf * kf * r_k, axis=-1, keepdims=True) * vf).reshape(B, S, C)
    y = (y + bonus) * g
    return y.astype(p.dtype) @ w_o, v


def swiglu(h, w_gu, w_down):
    gate, up = jnp.split(h @ w_gu, 2, axis=-1)
    return (jax.nn.silu(gate) * up) @ w_down


def moe_swiglu(h, router_w, router_b, w_gu, w_down):
    B, S, D = h.shape
    T = B * S
    ht = h.reshape(T, D)
    logits = (ht @ router_w).astype(jnp.float32) + router_b
    top_logit, top_e = lax.top_k(logits, TOP_K)
    top_w = jax.nn.softmax(top_logit, axis=-1)
    A = T * TOP_K
    flat_e = top_e.reshape(A)
    flat_tok = jnp.repeat(jnp.arange(T, dtype=jnp.int32), TOP_K)
    flat_w = top_w.reshape(A)
    order = jnp.argsort(flat_e)
    sorted_e = flat_e[order]
    counts = jnp.bincount(flat_e, length=N_EXPERTS)
    padded = (counts + MOE_BLOCK - 1) // MOE_BLOCK * MOE_BLOCK
    pad_end = jnp.cumsum(padded)
    pad_start = pad_end - padded
    start = jnp.cumsum(counts) - counts
    dest = pad_start[sorted_e] + jnp.arange(A) - start[sorted_e]
    n_blocks = -(-A // MOE_BLOCK) + N_EXPERTS
    rows = n_blocks * MOE_BLOCK
    row_tok = jnp.full((rows,), T, jnp.int32).at[dest].set(flat_tok[order])
    row_w = jnp.zeros((rows,), jnp.float32).at[dest].set(flat_w[order])
    block_e = jnp.minimum(jnp.searchsorted(pad_end, jnp.arange(n_blocks) * MOE_BLOCK, side='right'),
                          N_EXPERTS - 1)
    h_pad = jnp.concatenate([ht, jnp.zeros((1, D), ht.dtype)], axis=0)
    xs = h_pad[row_tok].reshape(n_blocks, MOE_BLOCK, D)

    def expert_block(args):
        xb, e = args
        gate, up = jnp.split(xb @ w_gu[e], 2, axis=-1)
        return (jax.nn.silu(gate) * up) @ w_down[e]

    ys = lax.map(expert_block, (xs, block_e)).reshape(rows, D)
    ys = ys * row_w[:, None].astype(ys.dtype)
    out = jax.ops.segment_sum(ys, row_tok, num_segments=T + 1)[:T]
    return out.reshape(B, S, D)


def setup_inputs(seed: int = 0) -> dict:
    key = jax.random.key(seed)
    keys = iter(jax.random.split(key, 48))
    L = DEPTH
    nd = (DEPTH + 1) // 2
    nm = DEPTH // 2
    f32 = jnp.float32

    def nrm(shape, scale):
        return jax.random.normal(next(keys), shape, f32) * scale

    def gain(shape):
        return 1.0 + nrm(shape, 0.02)

    def unif(shape, lo, hi):
        return jax.random.uniform(next(keys), shape, f32, minval=lo, maxval=hi)

    C = RWKV_W
    return {
        'x': nrm((BATCH, SEQ, D_MODEL), 1.0),
        'mix_norm_g': gain((L, D_MODEL)),
        'w_in_first': nrm((D_MODEL, N_IN_FIRST), D_MODEL ** -0.5),
        'w_in_rest': nrm((L - 1, D_MODEL, N_IN_REST), D_MODEL ** -0.5),
        'rwkv_mu_first': unif((RWKV_IN_FIRST,), 0.0, 1.0),
        'rwkv_mu_rest': unif((L - 1, RWKV_IN_REST), 0.0, 1.0),
        'nsa_qk_g': gain((L, 4, NSA_HEAD_DIM)),
        'nsa_cmp_pos': nrm((L, 2, CMP_LEN, NSA_HEAD_DIM), 0.1),
        'nsa_cmp_w1': nrm((L, 2, CMP_LEN * NSA_HEAD_DIM, CMP_HIDDEN), (CMP_LEN * NSA_HEAD_DIM) ** -0.5),
        'nsa_cmp_w2': nrm((L, 2, CMP_HIDDEN, NSA_HEAD_DIM), CMP_HIDDEN ** -0.5),
        'nsa_w_o': nrm((L, NSA_Q_W, D_MODEL), NSA_Q_W ** -0.5),
        'conv_w': nrm((L, CONV_K, CONV_CH), CONV_K ** -0.5),
        'conv_vec': jnp.stack([nrm((L, CONV_CH), 0.02), gain((L, CONV_CH)), nrm((L, CONV_CH), 0.02)], axis=1),
        'conv_w_o': nrm((L, CONV_CH, D_MODEL), CONV_CH ** -0.5),
        'rwkv_vec': jnp.stack([
            unif((L, C), -6.0, 1.0),
            nrm((L, C), 0.5),
            1.0 + nrm((L, C), 0.1),
            1.0 + nrm((L, C), 0.1),
            nrm((L, C), 0.1),
            gain((L, C)),
            nrm((L, C), 0.02),
        ], axis=1),
        'rwkv_w_up': nrm((L, DECAY_LORA, C), 0.1),
        'rwkv_a_up': nrm((L, ICLR_LORA, C), ICLR_LORA ** -0.5),
        'rwkv_g_up': nrm((L, GATE_LORA, C), GATE_LORA ** -0.5),
        'rwkv_vres_up': nrm((L - 1, VRES_LORA, C), VRES_LORA ** -0.5),
        'rwkv_vres_b': nrm((L - 1, C), 0.1),
        'rwkv_w_o': nrm((L, C, D_MODEL), C ** -0.5),
        'w_out': nrm((L, D_MODEL, D_MODEL), D_MODEL ** -0.5),
        'ffn_norm_g': gain((L, D_MODEL)),
        'dense_w_gu': nrm((nd, D_MODEL, 2 * DENSE_FF), D_MODEL ** -0.5),
        'dense_w_down': nrm((nd, DENSE_FF, D_MODEL), DENSE_FF ** -0.5),
        'router_w': nrm((nm, D_MODEL, N_EXPERTS), D_MODEL ** -0.5),
        'router_b': nrm((nm, N_EXPERTS), 0.01),
        'moe_w_gu': nrm((nm, N_EXPERTS, D_MODEL, 2 * EXPERT_FF), D_MODEL ** -0.5),
        'moe_w_down': nrm((nm, N_EXPERTS, EXPERT_FF, D_MODEL), EXPERT_FF ** -0.5),
    }


def reference(x, mix_norm_g, w_in_first, w_in_rest, rwkv_mu_first, rwkv_mu_rest, nsa_qk_g, nsa_cmp_pos,
              nsa_cmp_w1, nsa_cmp_w2, nsa_w_o, conv_w, conv_vec, conv_w_o, rwkv_vec, rwkv_w_up, rwkv_a_up,
              rwkv_g_up, rwkv_vres_up, rwkv_vres_b, rwkv_w_o, w_out, ffn_norm_g, dense_w_gu, dense_w_down,
              router_w, router_b, moe_w_gu, moe_w_down):
    B, S, D = x.shape
    v_first = None
    for layer in range(DEPTH):
        h = rms_norm(x, mix_norm_g[layer])
        if layer == 0:
            w_in, mu, vres_up, vres_b = w_in_first, rwkv_mu_first, None, None
        else:
            w_in, mu = w_in_rest[layer - 1], rwkv_mu_rest[layer - 1]
            vres_up, vres_b = rwkv_vres_up[layer - 1], rwkv_vres_b[layer - 1]
        proj = h @ w_in
        o_nsa = nsa_mixer(proj[..., :OFF_CONV], nsa_qk_g[layer], nsa_cmp_pos[layer], nsa_cmp_w1[layer],
                          nsa_cmp_w2[layer]) @ nsa_w_o[layer]
        o_conv = conformer_conv(proj[..., OFF_CONV:OFF_GATE], conv_w[layer], conv_vec[layer], conv_w_o[layer])
        o_rwkv, v_layer = rwkv7_mixer(proj[..., OFF_RWKV:], mu, rwkv_vec[layer], rwkv_w_up[layer],
                                      rwkv_a_up[layer], rwkv_g_up[layer], rwkv_w_o[layer], v_first,
                                      vres_up, vres_b)
        if layer == 0:
            v_first = v_layer
        gates = jax.nn.sigmoid(proj[..., OFF_GATE:OFF_RWKV].astype(jnp.float32)).reshape(B, S, N_BRANCH, D)
        mixed = gates[:, :, 0] * o_nsa + gates[:, :, 1] * o_conv + gates[:, :, 2] * o_rwkv
        x = x + mixed.astype(x.dtype) @ w_out[layer]
        h2 = rms_norm(x, ffn_norm_g[layer])
        if layer % 2 == 0:
            f = swiglu(h2, dense_w_gu[layer // 2], dense_w_down[layer // 2])
        else:
            f = moe_swiglu(h2, router_w[layer // 2], router_b[layer // 2], moe_w_gu[layer // 2],
                           moe_w_down[layer // 2])
        x = x + f.astype(x.dtype)
    return x
```

```cpp
#include <hip/hip_runtime.h>
#include <cstdio>
#include <cstdint>
#include <cmath>
#include <cstring>
#ifdef HOST_EMU
#define HD
#define DEV_INLINE inline
#else
#define HD __host__ __device__
#define DEV_INLINE __device__ __forceinline__
#endif

typedef unsigned short bf16;
struct alignas(16) U4 { unsigned x, y, z, w; };

#ifdef SMALL_CFG
constexpr int BATCH = 1, SEQ = 1024, DM = 128, DENSE_FF = 256, EXPERT_FF = 256;
#else
constexpr int BATCH = 8, SEQ = 8192, DM = 1024, DENSE_FF = 2816, EXPERT_FF = 3584;
#endif
constexpr int T = BATCH * SEQ;
constexpr int NHEAD = 8, NKV = 2, HG = 4, DH = 64;
constexpr int NC = SEQ / 16 - 1, NS = SEQ / 64, NSEL = 8, WINDOW = 512;
constexpr int CONV_CH = 512, CONV_K = 31, RC = 512;
constexpr int NEXP = 8;
constexpr int NSA_IN = 1304, OFF_CONV = 1304, OFF_GATE = 2328, OFF_RWKV = OFF_GATE + 3 * DM;
constexpr int N_IN_FIRST = OFF_RWKV + 1824, N_IN_REST = OFF_RWKV + 1856;
constexpr int NPROJ = 4352;
constexpr int LDQ = 512, LDKV = 768, LDRW = 2048, LBLK = 1536;
constexpr int MOE_ROWS = T + NEXP * 256;
constexpr float RMS_EPS = 1e-6f, LN_EPS = 1e-5f, GN_EPS = 64e-5f;

constexpr size_t al(size_t x) { return (x + 255) & ~(size_t)255; }
constexpr size_t WS_CTL = 0, CTL_BYTES = 1u << 20;
constexpr size_t SZ_WIN = (size_t)NPROJ * DM * 2, SZ_WG = (size_t)3 * DM * DM * 2, SZ_WO3 = (size_t)3 * DM * 512 * 2, SZ_WOUT = (size_t)DM * DM * 2;
constexpr size_t SZ_LAYERW = SZ_WIN + SZ_WG + SZ_WO3 + SZ_WOUT;
constexpr size_t WS_W = CTL_BYTES;
constexpr size_t OFF_WIN = 0, OFF_WG = SZ_WIN, OFF_WO3 = OFF_WG + SZ_WG, OFF_WOUT = OFF_WO3 + SZ_WO3;
constexpr size_t WS_DGU = WS_W + 2 * SZ_LAYERW, SZ_DGU = (size_t)2 * DENSE_FF * DM * 2;
constexpr size_t WS_DDN = WS_DGU + SZ_DGU, SZ_DDN = (size_t)DM * DENSE_FF * 2;
constexpr size_t WS_VF = al(WS_DDN + SZ_DDN), SZ_TC = (size_t)T * 512 * 2;
constexpr size_t WS_H = WS_VF + SZ_TC, SZ_H = (size_t)T * DM * 2;
constexpr size_t WS_AR = al(WS_H + SZ_H);
constexpr size_t AR_QB = WS_AR, AR_A = AR_QB + SZ_TC, AR_CO = AR_A + SZ_TC;
constexpr size_t AR_KV = AR_CO + SZ_TC, SZ_KV = (size_t)T * LDKV * 2;
constexpr size_t AR_RW = AR_KV + SZ_KV, SZ_RW = (size_t)T * LDRW * 2;
constexpr size_t AR_W = AR_RW + SZ_RW, AR_G = AR_W + SZ_TC, AR_UB = AR_G + SZ_TC;
constexpr size_t AR_NG = AR_UB + SZ_TC, SZ_NG = (size_t)T * 24 * 4;
constexpr size_t AR_HALO = al(AR_NG + SZ_NG), SZ_HALO = (size_t)(T / 256) * LDRW * 2;
constexpr size_t AR_KC = al(AR_HALO + SZ_HALO), SZ_CMP = (size_t)BATCH * NKV * (SEQ / 16) * 64 * 2;
constexpr size_t AR_VC = AR_KC + SZ_CMP;
constexpr size_t AR_HID = al(AR_VC + SZ_CMP), SZ_HID = (size_t)BATCH * NKV * (SEQ / 16) * 2 * 128 * 4;
constexpr size_t AR_SEL = al(AR_HID + SZ_HID), SZ_SEL = (size_t)T * NKV * 8 * 4;
constexpr size_t AR_INVN = al(AR_SEL + SZ_SEL), SZ_INVN = (size_t)T * 8 * 4;
constexpr size_t AR_END1 = al(AR_INVN + SZ_INVN);
constexpr size_t AR_OBUF = AR_KV, SZ_OBUF = (size_t)3 * T * DM * 2;
constexpr size_t AR_MIX = AR_OBUF + SZ_OBUF, SZ_MIX = (size_t)T * DM * 2;
constexpr size_t AR_END2 = AR_MIX + SZ_MIX;
constexpr size_t AR_ACT = WS_AR;
constexpr size_t AR_MGU = WS_AR, SZ_MGU = (size_t)NEXP * 2 * EXPERT_FF * DM * 2;
constexpr size_t AR_MDN = AR_MGU + SZ_MGU, SZ_MDN = (size_t)NEXP * DM * EXPERT_FF * 2;
constexpr size_t AR_XG = al(AR_MDN + SZ_MDN), SZ_XG = (size_t)MOE_ROWS * DM * 2;
constexpr size_t AR_MACT = al(AR_XG + SZ_XG), SZ_MACT = (size_t)MOE_ROWS * EXPERT_FF * 2;
constexpr size_t AR_RTOK = al(AR_MACT + SZ_MACT), SZ_RTOK = (size_t)2 * MOE_ROWS * 4;
constexpr size_t AR_RW8 = al(AR_RTOK + SZ_RTOK);
constexpr size_t AR_TROW = al(AR_RW8 + SZ_RTOK), SZ_TROW = (size_t)2 * T * 4;
constexpr size_t AR_RTE = al(AR_TROW + SZ_TROW);
constexpr size_t AR_RTW = al(AR_RTE + (size_t)T * 4);
constexpr size_t AR_END3 = al(AR_RTW + (size_t)T * 8);
constexpr size_t WS_END = (AR_END1 > AR_END2 ? (AR_END1 > AR_END3 ? AR_END1 : AR_END3) : (AR_END2 > AR_END3 ? AR_END2 : AR_END3));
constexpr int CW_CNT = 64, CW_FILL = 128;
constexpr int CW_BAR = 4096;

struct P {
    const float *x, *mix_norm_g, *w_in_first, *w_in_rest, *mu_first, *mu_rest, *qk_g, *cmp_pos, *cmp_w1, *cmp_w2, *nsa_w_o, *conv_w, *conv_vec, *conv_w_o,
        *rwkv_vec, *w_up, *a_up, *g_up, *vres_up, *vres_b, *rwkv_w_o, *w_out, *ffn_norm_g, *dense_gu, *dense_down, *router_w, *router_b, *moe_gu, *moe_down;
    float* out; unsigned char* ws;
};
HD inline void fill_params(P& p, const float* const* in, float* out, unsigned char* ws) {
    p.x = in[0]; p.mix_norm_g = in[1]; p.w_in_first = in[2]; p.w_in_rest = in[3]; p.mu_first = in[4]; p.mu_rest = in[5]; p.qk_g = in[6]; p.cmp_pos = in[7];
    p.cmp_w1 = in[8]; p.cmp_w2 = in[9]; p.nsa_w_o = in[10]; p.conv_w = in[11]; p.conv_vec = in[12]; p.conv_w_o = in[13]; p.rwkv_vec = in[14]; p.w_up = in[15];
    p.a_up = in[16]; p.g_up = in[17]; p.vres_up = in[18]; p.vres_b = in[19]; p.rwkv_w_o = in[20]; p.w_out = in[21]; p.ffn_norm_g = in[22]; p.dense_gu = in[23];
    p.dense_down = in[24]; p.router_w = in[25]; p.router_b = in[26]; p.moe_gu = in[27]; p.moe_down = in[28]; p.out = out; p.ws = ws;
}
#define WSP(type, off) ((type*)(p.ws + (off)))

#ifdef HOST_EMU
#define FENCE()
#else
#define FENCE() asm volatile("" ::: "memory")
#endif
HD inline float bf2f(bf16 v) { unsigned u = (unsigned)v << 16; float f; memcpy(&f, &u, 4); return f; }
HD inline bf16 f2bf(float f) { unsigned u; memcpy(&u, &f, 4); return (bf16)((u + 0x7fffu + ((u >> 16) & 1u)) >> 16); }
HD inline float blo(unsigned v) { unsigned u = v << 16; float f; memcpy(&f, &u, 4); return f; }
HD inline float bhi(unsigned v) { unsigned u = v & 0xffff0000u; float f; memcpy(&f, &u, 4); return f; }
HD inline float sigmoidf_(float x) { return 1.f / (1.f + expf(-x)); }
HD inline float dot64(const float* q, const bf16* kp) {
    const U4* k4 = (const U4*)kp; float s0 = 0.f, s1 = 0.f;
#pragma unroll
    for (int i = 0; i < 8; ++i) { const U4 v = k4[i];
        s0 += q[8 * i + 0] * blo(v.x) + q[8 * i + 2] * blo(v.y) + q[8 * i + 4] * blo(v.z) + q[8 * i + 6] * blo(v.w);
        s1 += q[8 * i + 1] * bhi(v.x) + q[8 * i + 3] * bhi(v.y) + q[8 * i + 5] * bhi(v.z) + q[8 * i + 7] * bhi(v.w); }
    return s0 + s1;
}
HD inline float dot64p(const U4* q, const bf16* kp) {
    const U4* k4 = (const U4*)kp; float s0 = 0.f, s1 = 0.f;
#pragma unroll
    for (int i = 0; i < 8; ++i) { const U4 v = k4[i], w = q[i];
        s0 += blo(w.x) * blo(v.x) + blo(w.y) * blo(v.y) + blo(w.z) * blo(v.z) + blo(w.w) * blo(v.w);
        s1 += bhi(w.x) * bhi(v.x) + bhi(w.y) * bhi(v.y) + bhi(w.z) * bhi(v.z) + bhi(w.w) * bhi(v.w); }
    return s0 + s1;
}
HD inline void ld64(const bf16* kp, float* q) {
    const U4* k4 = (const U4*)kp;
#pragma unroll
    for (int i = 0; i < 8; ++i) { const U4 v = k4[i]; q[8 * i] = blo(v.x); q[8 * i + 1] = bhi(v.x); q[8 * i + 2] = blo(v.y); q[8 * i + 3] = bhi(v.y);
        q[8 * i + 4] = blo(v.z); q[8 * i + 5] = bhi(v.z); q[8 * i + 6] = blo(v.w); q[8 * i + 7] = bhi(v.w); }
}
HD inline void axpy64(float* o, float w, const bf16* vp) {
    const U4* k4 = (const U4*)vp;
#pragma unroll
    for (int i = 0; i < 8; ++i) { const U4 v = k4[i]; o[8 * i] += w * blo(v.x); o[8 * i + 1] += w * bhi(v.x); o[8 * i + 2] += w * blo(v.y); o[8 * i + 3] += w * bhi(v.y);
        o[8 * i + 4] += w * blo(v.z); o[8 * i + 5] += w * bhi(v.z); o[8 * i + 6] += w * blo(v.w); o[8 * i + 7] += w * bhi(v.w); }
}
HD inline void axpy64s(float* o, float w, const bf16* vp) {
    const U4* k4 = (const U4*)vp;
#pragma unroll
    for (int i = 0; i < 8; ++i) { const U4 v = k4[i]; o[8 * i] = w * o[8 * i] + blo(v.x); o[8 * i + 1] = w * o[8 * i + 1] + bhi(v.x); o[8 * i + 2] = w * o[8 * i + 2] + blo(v.y); o[8 * i + 3] = w * o[8 * i + 3] + bhi(v.y);
        o[8 * i + 4] = w * o[8 * i + 4] + blo(v.z); o[8 * i + 5] = w * o[8 * i + 5] + bhi(v.z); o[8 * i + 6] = w * o[8 * i + 6] + blo(v.w); o[8 * i + 7] = w * o[8 * i + 7] + bhi(v.w); }
}
HD inline void st64(bf16* op, const float* o) {
    U4* o4 = (U4*)op;
#pragma unroll
    for (int i = 0; i < 8; ++i) { U4 v; v.x = (unsigned)f2bf(o[8 * i]) | ((unsigned)f2bf(o[8 * i + 1]) << 16); v.y = (unsigned)f2bf(o[8 * i + 2]) | ((unsigned)f2bf(o[8 * i + 3]) << 16);
        v.z = (unsigned)f2bf(o[8 * i + 4]) | ((unsigned)f2bf(o[8 * i + 5]) << 16); v.w = (unsigned)f2bf(o[8 * i + 6]) | ((unsigned)f2bf(o[8 * i + 7]) << 16); o4[i] = v; }
}

HD inline void rope_cs(int pos, int i, float& cs, float& sn) {
    double a = (double)pos * exp2(-(double)i * (13.287712379549449 / 32.0));
    a -= 6.283185307179586 * rint(a * 0.15915494309189535);
#ifdef HOST_EMU
    cs = cosf((float)a); sn = sinf((float)a);
#else
    cs = __cosf((float)a); sn = __sinf((float)a);
#endif
}
HD inline int win_dest(int j, int layer, int& which) {
    which = 0;
    if (j < 1280) return j;
    if (j < 1304) return 3840 + 320 + (j - 1280);
    if (j < 1816) { const int cc = j - 1304; return 1280 + 256 * (cc / 128) + cc % 128; }
    if (j < 2328) { const int cc = j - 1816; return 1280 + 256 * (cc / 128) + 128 + cc % 128; }
    if (j < OFF_RWKV) { which = 1; const int gg = j - OFF_GATE, br = gg / DM; return (br == 0 ? 0 : (br == 1 ? 2 * DM : DM)) + gg % DM; }
    const int rr = j - OFF_RWKV;
    if (rr < 1536) return 2304 + rr;
    if (rr < 1824) return 3840 + (rr - 1536);
    if (rr < 1856 && layer == 1) return 3840 + 288 + (rr - 1824);
    return -1;
}
HD inline int glu_dest(int j, int ff) { return j < ff ? 256 * (j / 128) + j % 128 : 256 * ((j - ff) / 128) + 128 + (j - ff) % 128; }

DEV_INLINE void ph_shift(const P& p, int layer, long gtid, long NT) {
    bf16* RW = WSP(bf16, AR_RW); const bf16* HALO = WSP(bf16, AR_HALO);
    const float* mu = layer == 0 ? p.mu_first : p.mu_rest;
    const long n = (long)(T / 256) * LDRW;
    for (long it = gtid; it < n; it += NT) {
        const int pm = (int)(it / LDRW), c = (int)(it % LDRW);
        int mi = -1, act = 0;
        if (c < LBLK) mi = c;
        else { const int w = c - LBLK; if (w < 288) { mi = 1536 + w; act = w < 64 ? 1 : (w >= 128 ? 2 : 0); } else if (w < 320 && layer == 1) mi = 1824 + (w - 288); }
        if (mi < 0) continue;
        const float m = mu[mi];
        float prev = ((pm * 256) % SEQ == 0) ? 0.f : bf2f(HALO[(size_t)(pm - 1) * LDRW + c]);
        bf16* col = RW + (size_t)pm * 256 * LDRW + c;
        for (int r = 0; r < 256; ++r) {
            const float pv = bf2f(col[(size_t)r * LDRW]);
            float u = pv + (prev - pv) * m; prev = pv;
            if (act == 1) u = tanhf(u); else if (act == 2) u = sigmoidf_(u);
            col[(size_t)r * LDRW] = f2bf(u);
        }
    }
}

DEV_INLINE void ph_nsa_prep(const P& p, int layer, long gtid, long NT) {
    bf16* QB = WSP(bf16, AR_QB); bf16* KV = WSP(bf16, AR_KV);
    const long n = (long)T * 12;
    for (long it = gtid; it < n; it += NT) {
        const int t = (int)(it / 12), s = (int)(it % 12), pos = t % SEQ;
        bf16* ptr; const float* g;
        if (s < 8) { ptr = QB + (size_t)t * LDQ + s * 64; g = p.qk_g + (layer * 4 + 0) * 64; }
        else if (s < 10) { ptr = KV + (size_t)t * LDKV + 256 + (s - 8) * 64; g = p.qk_g + (layer * 4 + 2) * 64; }
        else { ptr = KV + (size_t)t * LDKV + 512 + (s - 10) * 64; g = p.qk_g + (layer * 4 + 3) * 64; }
        float v[64]; ld64(ptr, v);
        float ss = 0.f;
#pragma unroll
        for (int i = 0; i < 64; ++i) ss += v[i] * v[i];
        const float rs = 1.f / sqrtf(ss * (1.f / 64.f) + RMS_EPS);
#pragma unroll
        for (int i = 0; i < 64; ++i) v[i] = v[i] * rs * g[i];
#pragma unroll
        for (int i = 0; i < 32; ++i) {
            float cs, sn; rope_cs(pos, i, cs, sn);
            const float x1 = v[i], x2 = v[i + 32]; v[i] = x1 * cs - x2 * sn; v[i + 32] = x2 * cs + x1 * sn;
        }
        st64(ptr, v);
    }
}

DEV_INLINE void ph_cmp1(const P& p, int layer, long gtid, long NT) {
    const bf16* KV = WSP(bf16, AR_KV); float* HID = WSP(float, AR_HID);
    const long n = (long)BATCH * NKV * NC * 2 * 128;
    for (long it = gtid; it < n; it += NT) {
        const int j = (int)(it % 128); long r = it / 128; const int which = (int)(r % 2); r /= 2; const int i = (int)(r % NC); const int bg = (int)(r / NC), b = bg / NKV, g = bg % NKV;
        const float* w1 = p.cmp_w1 + ((size_t)(layer * 2 + which) * 2048) * 128 + j;
        const float* pe = p.cmp_pos + (size_t)(layer * 2 + which) * 32 * 64;
        float acc = 0.f;
        for (int rr = 0; rr < 32; ++rr) {
            const bf16* src = KV + (size_t)(b * SEQ + 16 * i + rr) * LDKV + which * 128 + g * 64;
            for (int d = 0; d < 64; ++d) acc += (bf2f(src[d]) + pe[rr * 64 + d]) * w1[(size_t)(rr * 64 + d) * 128];
        }
        const float x = acc, gl = 0.5f * x * (1.f + tanhf(0.7978845608028654f * (x + 0.044715f * x * x * x)));
        HID[(((size_t)bg * (SEQ / 16) + i) * 2 + which) * 128 + j] = gl;
    }
}
DEV_INLINE void ph_cmp2(const P& p, int layer, long gtid, long NT) {
    const float* HID = WSP(float, AR_HID);
    const long n = (long)BATCH * NKV * NC * 2;
    for (long it = gtid; it < n; it += NT) {
        const int which = (int)(it % 2); long r = it / 2; const int i = (int)(r % NC); const int bg = (int)(r / NC);
        const float* h = HID + (((size_t)bg * (SEQ / 16) + i) * 2 + which) * 128;
        const float* w2 = p.cmp_w2 + (size_t)(layer * 2 + which) * 128 * 64;
        float o[64];
#pragma unroll
        for (int d = 0; d < 64; ++d) o[d] = 0.f;
        for (int j = 0; j < 128; ++j) { const float hv = h[j];
#pragma unroll
            for (int d = 0; d < 64; ++d) o[d] += hv * w2[j * 64 + d]; }
        if (which == 0) {
            const float* g = p.qk_g + (layer * 4 + 1) * 64; float ss = 0.f;
#pragma unroll
            for (int d = 0; d < 64; ++d) ss += o[d] * o[d];
            const float rs = 1.f / sqrtf(ss * (1.f / 64.f) + RMS_EPS);
#pragma unroll
            for (int d = 0; d < 64; ++d) o[d] = o[d] * rs * g[d];
            const int pos = 16 * i + 31;
#pragma unroll
            for (int d = 0; d < 32; ++d) { float cs, sn; rope_cs(pos, d, cs, sn);
                const float x1 = o[d], x2 = o[d + 32]; o[d] = x1 * cs - x2 * sn; o[d + 32] = x2 * cs + x1 * sn; }
        }
        st64(WSP(bf16, which == 0 ? AR_KC : AR_VC) + ((size_t)bg * (SEQ / 16) + i) * 64, o);
    }
}

DEV_INLINE void ph_conv(const P& p, int layer, long gtid, long NT) {
    const bf16* UB = WSP(bf16, AR_UB); bf16* CO = WSP(bf16, AR_CO);
    const float* cw = p.conv_w + (size_t)layer * CONV_K * CONV_CH; const float* cv = p.conv_vec + (size_t)layer * 3 * CONV_CH;
    for (long t = gtid; t < T; t += NT) {
        const int pos = (int)(t % SEQ); const int j0 = pos >= 30 ? 0 : 30 - pos;
        float s1 = 0.f, s2 = 0.f;
        for (int pass = 0; pass < 2; ++pass) {
            const float mean = s1 * (1.f / CONV_CH), var = s2 * (1.f / CONV_CH) - mean * mean, rstd = 1.f / sqrtf((var > 0.f ? var : 0.f) + LN_EPS);
            for (int c0 = 0; c0 < CONV_CH; c0 += 8) {
                float a[8];
#pragma unroll
                for (int k = 0; k < 8; ++k) a[k] = cv[c0 + k];
                for (int j = j0; j < CONV_K; ++j) {
                    const U4 v = *(const U4*)(UB + (size_t)(t - 30 + j) * CONV_CH + c0); const float* w = cw + j * CONV_CH + c0;
                    a[0] += blo(v.x) * w[0]; a[1] += bhi(v.x) * w[1]; a[2] += blo(v.y) * w[2]; a[3] += bhi(v.y) * w[3];
                    a[4] += blo(v.z) * w[4]; a[5] += bhi(v.z) * w[5]; a[6] += blo(v.w) * w[6]; a[7] += bhi(v.w) * w[7];
                }
                if (pass == 0) {
#pragma unroll
                    for (int k = 0; k < 8; ++k) { s1 += a[k]; s2 += a[k] * a[k]; }
                } else {
                    float o[8];
#pragma unroll
                    for (int k = 0; k < 8; ++k) { const float y = (a[k] - mean) * rstd * cv[CONV_CH + c0 + k] + cv[2 * CONV_CH + c0 + k]; o[k] = y * sigmoidf_(y); }
                    U4 ov; ov.x = (unsigned)f2bf(o[0]) | ((unsigned)f2bf(o[1]) << 16); ov.y = (unsigned)f2bf(o[2]) | ((unsigned)f2bf(o[3]) << 16);
                    ov.z = (unsigned)f2bf(o[4]) | ((unsigned)f2bf(o[5]) << 16); ov.w = (unsigned)f2bf(o[6]) | ((unsigned)f2bf(o[7]) << 16);
                    *(U4*)(CO + (size_t)t * CONV_CH + c0) = ov;
                }
            }
        }
    }
}

DEV_INLINE void ph_rwkv_b1(const P& p, int layer, long gtid, long NT) {
    bf16* RW = WSP(bf16, AR_RW); bf16* Wm = WSP(bf16, AR_W); bf16* Am = WSP(bf16, AR_A); bf16* Gm = WSP(bf16, AR_G); bf16* VF = WSP(bf16, WS_VF);
    float* INVN = WSP(float, AR_INVN); float* NG = WSP(float, AR_NG);
    const float* vec = p.rwkv_vec + (size_t)layer * 7 * RC;
    const float* wup = p.w_up + (size_t)layer * 64 * RC; const float* aup = p.a_up + (size_t)layer * 64 * RC; const float* gup = p.g_up + (size_t)layer * 160 * RC;
    const long n = (long)T * RC;
    for (long it = gtid; it < n; it += NT) {
        const int t = (int)(it / RC), c = (int)(it % RC);
        bf16* row = RW + (size_t)t * LDRW; const bf16* L = row + LBLK;
        float wl = vec[c], alin = vec[RC + c], g = 0.f;
        for (int j = 0; j < 64; ++j) { wl += bf2f(L[j]) * wup[j * RC + c]; alin += bf2f(L[64 + j]) * aup[j * RC + c]; }
        for (int j = 0; j < 160; ++j) g += bf2f(L[128 + j]) * gup[j * RC + c];
        const float nx = -wl, sp = (nx > 0.f ? nx : 0.f) + log1pf(expf(-fabsf(nx)));
        const float e = expf(-sp - 0.5f);
        Wm[it] = f2bf(-expm1f(-e));
        Am[it] = f2bf(sigmoidf_(alin));
        Gm[it] = f2bf(g);
        float v = bf2f(row[1024 + c]);
        if (layer == 0) VF[it] = row[1024 + c];
        else {
            float vl = p.vres_b[c]; const float* vu = p.vres_up;
            for (int j = 0; j < 32; ++j) vl += bf2f(L[288 + j]) * vu[j * RC + c];
            const float vf = bf2f(VF[it]); v = v + (vf - v) * sigmoidf_(vl); row[1024 + c] = f2bf(v);
        }
        if ((c & 63) == 0) { float ss = 0.f; for (int k = 0; k < 64; ++k) { const float kk = bf2f(row[512 + c + k]) * vec[2 * RC + c + k]; ss += kk * kk; }
            const float nrm = sqrtf(ss); INVN[(size_t)t * 8 + (c >> 6)] = 1.f / (nrm > 1e-12f ? nrm : 1e-12f); }
        if (c < 24) NG[(size_t)t * 24 + c] = sigmoidf_(bf2f(L[320 + c]));
    }
}
DEV_INLINE void ph_rwkv_b2(const P& p, int layer, long gtid, long NT) {
    bf16* RW = WSP(bf16, AR_RW); const bf16* Am = WSP(bf16, AR_A); const float* INVN = WSP(float, AR_INVN);
    const float* vec = p.rwkv_vec + (size_t)layer * 7 * RC;
    const long n = (long)T * RC;
    for (long it = gtid; it < n; it += NT) {
        const int t = (int)(it / RC), c = (int)(it % RC);
        bf16* row = RW + (size_t)t * LDRW;
        const float k = bf2f(row[512 + c]), a = bf2f(Am[it]);
        row[LBLK + c] = f2bf(k * vec[2 * RC + c] * INVN[(size_t)t * 8 + (c >> 6)]);
        row[512 + c] = f2bf(k * (1.f + (a - 1.f) * vec[3 * RC + c]));
    }
}
DEV_INLINE void ph_scan_naive(const P& p, long gtid, long NT) {
    const bf16* RW = WSP(bf16, AR_RW); const bf16* Wm = WSP(bf16, AR_W); const bf16* Am = WSP(bf16, AR_A); bf16* Y = WSP(bf16, AR_UB);
    const long n = (long)BATCH * 8 * 64;
    for (long it = gtid; it < n; it += NT) {
        const int vr = (int)(it % 64), h = (int)((it / 64) % 8), b = (int)(it / 512);
        float s[64];
#pragma unroll
        for (int k = 0; k < 64; ++k) s[k] = 0.f;
        for (int tt = 0; tt < SEQ; ++tt) {
            const size_t t = (size_t)b * SEQ + tt; const bf16* row = RW + t * LDRW;
            float skk = 0.f;
#pragma unroll
            for (int c8 = 0; c8 < 8; ++c8) { const U4 v = *(const U4*)(row + LBLK + h * 64 + c8 * 8);
                skk += s[c8 * 8] * blo(v.x) + s[c8 * 8 + 1] * bhi(v.x) + s[c8 * 8 + 2] * blo(v.y) + s[c8 * 8 + 3] * bhi(v.y) + s[c8 * 8 + 4] * blo(v.z) + s[c8 * 8 + 5] * bhi(v.z) + s[c8 * 8 + 6] * blo(v.w) + s[c8 * 8 + 7] * bhi(v.w); }
            const float vv = bf2f(row[1024 + h * 64 + vr]);
            float y = 0.f;
#pragma unroll
            for (int c8 = 0; c8 < 8; ++c8) {
                const U4 vk = *(const U4*)(row + LBLK + h * 64 + c8 * 8), va = *(const U4*)(Am + t * RC + h * 64 + c8 * 8), vw = *(const U4*)(Wm + t * RC + h * 64 + c8 * 8);
                const U4 vt = *(const U4*)(row + 512 + h * 64 + c8 * 8), vr4 = *(const U4*)(row + h * 64 + c8 * 8);
#define SCAN_EL(j, KK, AA, WW, KT, RR) { float& sj = s[c8 * 8 + j]; sj = sj - sj * (WW) - skk * ((KK) * (AA)) + vv * (KT); y += sj * (RR); }
                SCAN_EL(0, blo(vk.x), blo(va.x), blo(vw.x), blo(vt.x), blo(vr4.x)) SCAN_EL(1, bhi(vk.x), bhi(va.x), bhi(vw.x), bhi(vt.x), bhi(vr4.x))
                SCAN_EL(2, blo(vk.y), blo(va.y), blo(vw.y), blo(vt.y), blo(vr4.y)) SCAN_EL(3, bhi(vk.y), bhi(va.y), bhi(vw.y), bhi(vt.y), bhi(vr4.y))
                SCAN_EL(4, blo(vk.z), blo(va.z), blo(vw.z), blo(vt.z), blo(vr4.z)) SCAN_EL(5, bhi(vk.z), bhi(va.z), bhi(vw.z), bhi(vt.z), bhi(vr4.z))
                SCAN_EL(6, blo(vk.w), blo(va.w), blo(vw.w), blo(vt.w), blo(vr4.w)) SCAN_EL(7, bhi(vk.w), bhi(va.w), bhi(vw.w), bhi(vt.w), bhi(vr4.w))
#undef SCAN_EL
                FENCE();
            }
            Y[t * RC + h * 64 + vr] = f2bf(y);
        }
    }
}
DEV_INLINE void ph_rwkv_post(const P& p, int layer, long gtid, long NT) {
    const bf16* RW = WSP(bf16, AR_RW); const bf16* Y = WSP(bf16, AR_UB); const bf16* Gm = WSP(bf16, AR_G); bf16* YO = WSP(bf16, AR_A);
    const float* vec = p.rwkv_vec + (size_t)layer * 7 * RC;
    const long n = (long)T * RC;
    for (long it = gtid; it < n; it += NT) {
        const int t = (int)(it / RC), c = (int)(it % RC), h0 = c & ~63;
        const bf16* row = RW + (size_t)t * LDRW; const bf16* y = Y + (size_t)t * RC + h0;
        float m = 0.f; for (int k = 0; k < 64; ++k) m += bf2f(y[k]); m *= (1.f / 64.f);
        float vq = 0.f, bon = 0.f;
        for (int k = 0; k < 64; ++k) { const float d = bf2f(y[k]) - m; vq += d * d; bon += bf2f(row[h0 + k]) * bf2f(row[512 + h0 + k]) * vec[4 * RC + h0 + k]; }
        const float yn = (bf2f(y[c - h0]) - m) / sqrtf(vq * (1.f / 64.f) + GN_EPS) * vec[5 * RC + c] + vec[6 * RC + c];
        YO[it] = f2bf((yn + bon * bf2f(row[1024 + c])) * bf2f(Gm[it]));
    }
}

DEV_INLINE void nsa_select_one(const P& p, long item, float* imp) {
    const bf16* QB = WSP(bf16, AR_QB); const bf16* KC = WSP(bf16, AR_KC); int* SEL = WSP(int, AR_SEL);
    const int t = (int)(item % SEQ), bg = (int)(item / SEQ), b = bg / NKV, g = bg % NKV;
    for (int j = 0; j < NS; ++j) imp[j] = 0.f;
    int nv = t >= 31 ? (t - 31) / 16 + 1 : 0; if (nv > NC) nv = NC;
    const bf16* kc = KC + (size_t)bg * (SEQ / 16) * 64;
    for (int hh = 0; hh < HG && nv > 0; ++hh) {
        float q[64]; ld64(QB + (size_t)(b * SEQ + t) * LDQ + (g * HG + hh) * 64, q);
        float m = -1e30f;
        for (int c = 0; c < nv; ++c) { const float s = dot64(q, kc + (size_t)c * 64) * 0.125f; m = s > m ? s : m; }
        float l = 0.f;
        for (int c = 0; c < nv; ++c) l += expf(dot64(q, kc + (size_t)c * 64) * 0.125f - m);
        const float il = 1.f / l;
        for (int c = 0; c < nv; ++c) { const float pc = expf(dot64(q, kc + (size_t)c * 64) * 0.125f - m) * il;
            imp[c >> 2] += pc; if ((c & 3) == 3) imp[(c + 1) >> 2] += pc; }
    }
    const int cur = t / 64;
    for (int j = 0; j < NS; ++j) { const bool forced = (j == 0) || (j == cur) || (j == cur - 1); imp[j] = forced ? 1e4f : (j <= cur ? imp[j] : -1.f); }
    const int nsel = NSEL < NS ? NSEL : NS;
    for (int r = 0; r < nsel; ++r) { int bj = 0; float bv = imp[0]; for (int j = 1; j < NS; ++j) if (imp[j] > bv) { bv = imp[j]; bj = j; }
        SEL[(size_t)item * 8 + r] = bj; imp[bj] = -3e38f; }
}

DEV_INLINE void ph_nsa_attn_naive(const P& p, long gtid, long NT) {
    bf16* QB = WSP(bf16, AR_QB); const bf16* KV = WSP(bf16, AR_KV); const bf16* KC = WSP(bf16, AR_KC); const bf16* VC = WSP(bf16, AR_VC);
    const int* SEL = WSP(int, AR_SEL); const float* NG = WSP(float, AR_NG);
    const long n = (long)BATCH * NHEAD * SEQ;
    for (long it = gtid; it < n; it += NT) {
        const int t = (int)(it % SEQ), hd = (int)((it / SEQ) % NHEAD), b = (int)(it / ((long)SEQ * NHEAD)), g = hd / HG, hh = hd % HG, bg = b * NKV + g;
        const size_t tok = (size_t)b * SEQ + t;
        U4 q[8]; { const U4* qs = (const U4*)(QB + tok * LDQ + hd * 64);
#pragma unroll
            for (int i = 0; i < 8; ++i) q[i] = qs[i]; }
        const float* gt = NG + tok * 24 + g * 12 + hh * 3;
        for (int br = 0; br < 3; ++br) {
            float o[64];
#pragma unroll
            for (int d = 0; d < 64; ++d) o[d] = 0.f;
            float m = -1e30f, l = 0.f;
            if (br == 0) {
                int nv = t >= 31 ? (t - 31) / 16 + 1 : 0; if (nv > NC) nv = NC;
                for (int c = 0; c < nv; ++c) { const size_t r = ((size_t)bg * (SEQ / 16) + c) * 64;
                    const float s = dot64p(q, KC + r) * 0.125f; const float mn = s > m ? s : m, sc = expf(m - mn), pw = expf(s - mn);
#pragma unroll
                    for (int d = 0; d < 64; ++d) o[d] *= sc;
                    axpy64(o, pw, VC + r); l = l * sc + pw; m = mn; }
            } else if (br == 1) {
                const int* sel = SEL + ((size_t)bg * SEQ + t) * 8;
                for (int r8 = 0; r8 < 8; ++r8) { const int j = sel[r8];
                    for (int kk = 0; kk < 64; ++kk) { const int kt = j * 64 + kk; if (kt > t) break;
                        const size_t r = ((size_t)b * SEQ + kt) * LDKV + g * 64;
                        const float s = dot64p(q, KV + r + 256) * 0.125f; const float mn = s > m ? s : m, sc = expf(m - mn), pw = expf(s - mn);
#pragma unroll
                        for (int d = 0; d < 64; ++d) o[d] *= sc;
                        axpy64(o, pw, KV + r + 384); l = l * sc + pw; m = mn; } }
            } else {
                const int k0 = t - (WINDOW - 1) > 0 ? t - (WINDOW - 1) : 0;
                for (int kt = k0; kt <= t; ++kt) { const size_t r = ((size_t)b * SEQ + kt) * LDKV + g * 64;
                    const float s = dot64p(q, KV + r + 512) * 0.125f; const float mn = s > m ? s : m, sc = expf(m - mn), pw = expf(s - mn);
#pragma unroll
                    for (int d = 0; d < 64; ++d) o[d] *= sc;
                    axpy64(o, pw, KV + r + 640); l = l * sc + pw; m = mn; }
            }
            const float w = l > 0.f ? gt[br] / l : 0.f;
            FENCE();
            if (br == 0) {
#pragma unroll
                for (int d = 0; d < 64; ++d) o[d] *= w;
            } else axpy64s(o, w, QB + tok * LDQ + hd * 64);
            st64(QB + tok * LDQ + hd * 64, o);
            FENCE();
        }
    }
}
namespace pg8 {
#define PG8_LAS __attribute__((address_space(3)))
typedef unsigned short bf16_t;
typedef short bf16x8 __attribute__((ext_vector_type(8)));
typedef float f32x4 __attribute__((ext_vector_type(4)));
typedef unsigned u32x4 __attribute__((ext_vector_type(4)));
constexpr int BM = 256, BK = 64, HALF = 128, HTB = HALF * BK * 2  , STAGE_BYTES = 8 * HTB, NXCD = 8, WGM = 8;

__host__ __device__ __forceinline__ int lds_byte(int r, int c) { const int st = (r >> 4) * 2 + (c >> 5), rr = r & 15, cc = c & 31, ob = rr * 64 + cc * 2; return st * 1024 + (ob ^ (((ob >> 9) & 1) << 5)); }
__host__ __device__ __forceinline__ void stage_rc(int b, int& R, int& C) { const int st = b / 1024, sb = b % 1024, swz = sb ^ (((sb >> 9) & 1) << 5); R = (st >> 1) * 16 + swz / 64; C = (st & 1) * 32 + (swz % 64) / 2; }
__host__ __device__ __forceinline__ int perm32(int rho) { const int n = rho >> 4, i = rho & 15; return 8 * (i >> 2) + 4 * n + (i & 3); }

struct Unit { int pm, pn; };
struct Gemm { const bf16_t* A; const bf16_t* Bt; int M, N, K; };

struct StaticOrder {
    int nM, nN, nwg, G, c;
    __host__ __device__ void init(int M, int N, int G_, int c_) { nM = M / BM; nN = N / BM; nwg = nM * nN; G = G_; c = c_; }
    __host__ __device__ bool next(int i, Unit& u) const {
        const long L = (long)i * G + c; if (L >= nwg) return false;
        int wgid = (int)L; { const int q = nwg / NXCD, r = nwg % NXCD, xcd = wgid % NXCD, off = wgid / NXCD; wgid = (xcd < r ? xcd * (q + 1) : r * (q + 1) + (xcd - r) * q) + off; }
        const int nig = WGM * nN, gid = wgid / nig, fm = gid * WGM, gsz = (nM - fm) < WGM ? (nM - fm) : WGM;
        u.pm = fm + ((wgid % nig) % gsz); u.pn = (wgid % nig) / gsz; return true;
    }
    __device__ __forceinline__ void a_ready(const Unit&) const {}
    __device__ __forceinline__ void done(const Unit&) const {}
};

__device__ __forceinline__ unsigned cvt_pk_bf16(float lo, float hi) { unsigned r; asm volatile("v_cvt_pk_bf16_f32 %0, %1, %2" : "=v"(r) : "v"(lo), "v"(hi)); return r; }
typedef float f32x2 __attribute__((ext_vector_type(2)));
template <class Epi, class Sched, bool ALIGN_EPI = false, bool SP2 = false>
__device__ __forceinline__ void gemm_phase(PG8_LAS unsigned char* lds, const Gemm g, const Sched& S, const Epi& E) {
    int tid_ = threadIdx.x; asm volatile("" : "+v"(tid_));
    const int tid = tid_, wid = __builtin_amdgcn_readfirstlane(tid >> 6), lane = tid & 63, wr = wid >> 2, wc = wid & 3, fr = lane & 15, fq = lane >> 4;
    const int K = g.K, nt = K / BK;
    unsigned voffA[2], voffB[2];
#pragma unroll
    for (int i = 0; i < 2; ++i) { int R, C; stage_rc(tid * 16 + i * 8192, R, C); const int Rb = Epi::PERM ? ((R & ~31) + perm32(R & 31)) : R;
        voffA[i] = (unsigned)(R * K + C) * 2u; voffB[i] = (unsigned)(Rb * K + C) * 2u; }
    const size_t kstep = (size_t)(BK * 2);
    const size_t hstep = (size_t)HALF * K * 2;
    const size_t tstep = 2 * hstep;
    const unsigned ldsw = (unsigned)wid * 1024u;
    const int aoff = lds_byte(wr * 64 + fr, fq * 8), boff = lds_byte(wc * 32 + fr, fq * 8);
#define PG8_SA(b, h) (((b) * 2 + (h)) * HTB)
#define PG8_SB(b, h) ((4 + (b) * 2 + (h)) * HTB)
#define PG8_STAGE(bufoff, gbase, voff) do { _Pragma("unroll") for (int _i = 0; _i < 2; ++_i) \
        __builtin_amdgcn_global_load_lds((const unsigned*)((const char*)(gbase) + (voff)[_i]), (PG8_LAS unsigned*)(lds + (bufoff) + ldsw + _i * 8192), 16, 0, 0); } while (0)
#define PG8_LDA(dst, b, h) do { _Pragma("unroll") for (int m = 0; m < 4; ++m) _Pragma("unroll") for (int k = 0; k < 2; ++k) dst[m][k] = *(const PG8_LAS bf16x8*)(lds + PG8_SA(b, h) + aoff + m * 2048 + k * 1024); } while (0)
#define PG8_LDB(dst, b, h) do { _Pragma("unroll") for (int n = 0; n < 2; ++n) _Pragma("unroll") for (int k = 0; k < 2; ++k) dst[n][k] = *(const PG8_LAS bf16x8*)(lds + PG8_SB(b, h) + boff + n * 2048 + k * 1024); } while (0)
#define PG8_MMA(ai, bj, At, Bt) do { __builtin_amdgcn_s_setprio(1); _Pragma("unroll") for (int m = 0; m < 4; ++m) _Pragma("unroll") for (int n = 0; n < 2; ++n) _Pragma("unroll") for (int k = 0; k < 2; ++k) \
        acc[ai][bj][m][n] = __builtin_amdgcn_mfma_f32_16x16x32_bf16(Bt[n][k], At[m][k], acc[ai][bj][m][n], 0, 0, 0); __builtin_amdgcn_s_setprio(0); } while (0)
#define PG8_WAIT_V(n) asm volatile("s_waitcnt vmcnt(" #n ")" ::: "memory")
#define PG8_WAIT_L(n) asm volatile("s_waitcnt lgkmcnt(" #n ")" ::: "memory")
#define PG8_BAR __builtin_amdgcn_s_barrier()
#define PG8_SCHED __builtin_amdgcn_sched_barrier(0)
    Unit cur, nxt; int ui = 0;
    if (!S.next(0, cur)) return;
    f32x4 acc[2][2][4][2];
#pragma unroll
    for (int a = 0; a < 2; ++a)
#pragma unroll
        for (int b = 0; b < 2; ++b)
#pragma unroll
            for (int m = 0; m < 4; ++m)
#pragma unroll
                for (int n = 0; n < 2; ++n) acc[a][b][m][n] = (f32x4){0.f, 0.f, 0.f, 0.f};
    bf16x8 At[4][2], B0[2][2], B1[2][2];
    const char* cA = (const char*)g.A + (size_t)cur.pm * tstep; const char* cB = (const char*)g.Bt + (size_t)cur.pn * tstep;
    S.a_ready(cur);
    if constexpr (SP2) {
        PG8_STAGE(PG8_SB(0, 0), cB, voffB); PG8_STAGE(PG8_SB(0, 1), cB + hstep, voffB); PG8_STAGE(PG8_SA(0, 0), cA, voffA); PG8_STAGE(PG8_SA(0, 1), cA + hstep, voffA);
        if (wr == 1) PG8_BAR;
        PG8_WAIT_V(2); PG8_BAR;
        PG8_STAGE(PG8_SB(1, 0), cB + kstep, voffB); PG8_STAGE(PG8_SA(1, 0), cA + kstep, voffA); PG8_STAGE(PG8_SB(1, 1), cB + hstep + kstep, voffB);
        PG8_WAIT_V(6); PG8_BAR;
    } else {
        PG8_STAGE(PG8_SB(0, 0), cB, voffB); PG8_STAGE(PG8_SA(0, 0), cA, voffA); PG8_STAGE(PG8_SB(0, 1), cB + hstep, voffB); PG8_STAGE(PG8_SA(0, 1), cA + hstep, voffA);
        if (wr == 1) PG8_BAR;
        PG8_WAIT_V(4); PG8_BAR;
        PG8_STAGE(PG8_SB(1, 0), cB + kstep, voffB); PG8_STAGE(PG8_SA(1, 0), cA + kstep, voffA); PG8_STAGE(PG8_SB(1, 1), cB + hstep + kstep, voffB);
        PG8_WAIT_V(6); PG8_BAR;
    }
    for (;;) {
        const bool has_next = S.next(ui + 1, nxt);
        const char* nA = has_next ? (const char*)g.A + (size_t)nxt.pm * tstep : cA; const char* nB = has_next ? (const char*)g.Bt + (size_t)nxt.pn * tstep : cB;
        for (int t = 0; t < nt; t += 2) {
            const bool last = (t == nt - 2);
            const char* a1 = cA + (size_t)(t + 1) * kstep;
            const char* a2 = last ? nA : cA + (size_t)(t + 2) * kstep; const char* b2 = last ? nB : cB + (size_t)(t + 2) * kstep;
            const char* a3 = a2 + kstep; const char* b3 = b2 + kstep;
            if (last && has_next) S.a_ready(nxt);
            if constexpr (SP2) {
            PG8_LDB(B0, 0, 0); PG8_LDB(B1, 0, 1); PG8_SCHED; PG8_LDA(At, 0, 0); PG8_STAGE(PG8_SA(1, 1), a1 + hstep, voffA);
            PG8_WAIT_V(8); PG8_WAIT_L(0); PG8_BAR; PG8_MMA(0, 0, At, B0); PG8_MMA(0, 1, At, B1); PG8_BAR; PG8_SCHED;
            PG8_LDA(At, 0, 1); PG8_STAGE(PG8_SB(0, 0), b2, voffB); PG8_STAGE(PG8_SB(0, 1), b2 + hstep, voffB); PG8_STAGE(PG8_SA(0, 0), a2, voffA);
            PG8_WAIT_V(8); PG8_WAIT_L(0); PG8_BAR; PG8_MMA(1, 0, At, B0); PG8_MMA(1, 1, At, B1); PG8_BAR; PG8_SCHED;
            PG8_LDB(B0, 1, 0); PG8_LDB(B1, 1, 1); PG8_SCHED; PG8_LDA(At, 1, 0); PG8_STAGE(PG8_SA(0, 1), a2 + hstep, voffA);
            PG8_WAIT_V(8); PG8_WAIT_L(0); PG8_BAR; PG8_MMA(0, 0, At, B0); PG8_MMA(0, 1, At, B1); PG8_BAR; PG8_SCHED;
            PG8_LDA(At, 1, 1); PG8_STAGE(PG8_SB(1, 0), b3, voffB); PG8_STAGE(PG8_SB(1, 1), b3 + hstep, voffB); PG8_STAGE(PG8_SA(1, 0), a3, voffA);
            PG8_WAIT_V(8); PG8_WAIT_L(0); PG8_BAR; PG8_MMA(1, 0, At, B0); PG8_MMA(1, 1, At, B1); PG8_BAR; PG8_SCHED;
            } else {
            PG8_LDB(B0, 0, 0); PG8_SCHED; PG8_LDA(At, 0, 0); PG8_STAGE(PG8_SA(1, 1), a1 + hstep, voffA);
            PG8_WAIT_L(8); PG8_BAR; PG8_WAIT_L(0); PG8_MMA(0, 0, At, B0); PG8_BAR; PG8_SCHED;
            PG8_LDB(B1, 0, 1); PG8_STAGE(PG8_SB(0, 0), b2, voffB);
            PG8_BAR; PG8_WAIT_L(0); PG8_MMA(0, 1, At, B1); PG8_BAR;
            PG8_LDA(At, 0, 1); PG8_STAGE(PG8_SA(0, 0), a2, voffA);
            PG8_BAR; PG8_WAIT_L(0); PG8_MMA(1, 0, At, B0); PG8_BAR; PG8_SCHED;
            PG8_STAGE(PG8_SB(0, 1), b2 + hstep, voffB);
            PG8_WAIT_V(6); PG8_BAR; PG8_MMA(1, 1, At, B1); PG8_BAR;
            PG8_LDB(B0, 1, 0); PG8_SCHED; PG8_LDA(At, 1, 0); PG8_STAGE(PG8_SA(0, 1), a2 + hstep, voffA);
            PG8_WAIT_L(8); PG8_BAR; PG8_WAIT_L(0); PG8_MMA(0, 0, At, B0); PG8_BAR; PG8_SCHED;
            PG8_LDB(B1, 1, 1); PG8_STAGE(PG8_SB(1, 0), b3, voffB);
            PG8_BAR; PG8_WAIT_L(0); PG8_MMA(0, 1, At, B1); PG8_BAR;
            PG8_LDA(At, 1, 1); PG8_STAGE(PG8_SA(1, 0), a3, voffA);
            PG8_BAR; PG8_WAIT_L(0); PG8_MMA(1, 0, At, B0); PG8_BAR; PG8_SCHED;
            PG8_STAGE(PG8_SB(1, 1), b3 + hstep, voffB);
            PG8_WAIT_V(6); PG8_BAR; PG8_MMA(1, 1, At, B1); PG8_BAR;
            }
        }
        if constexpr (ALIGN_EPI) { if (wr == 0) PG8_BAR; }
        if constexpr (!Epi::AFTER_DRAIN) { E(acc, cur, wr, wc, fr, fq); S.done(cur); }
        if (!has_next) break;
#pragma unroll
        for (int a = 0; a < 2; ++a)
#pragma unroll
            for (int b = 0; b < 2; ++b)
#pragma unroll
                for (int m = 0; m < 4; ++m)
#pragma unroll
                    for (int n = 0; n < 2; ++n) acc[a][b][m][n] = (f32x4){0.f, 0.f, 0.f, 0.f};
        cur = nxt; cA = nA; cB = nB; ++ui;
        if constexpr (ALIGN_EPI) { if (wr == 1) PG8_BAR; }
    }
    PG8_WAIT_V(0);
    if constexpr (!ALIGN_EPI) { if (wr == 0) PG8_BAR; }
    PG8_BAR;
    if constexpr (Epi::AFTER_DRAIN) { E.fused(acc, cur, wr, wc, fr, fq, lds, wid, lane); S.done(cur); }
#undef PG8_SA
#undef PG8_SB
#undef PG8_STAGE
#undef PG8_LDA
#undef PG8_LDB
#undef PG8_MMA
#undef PG8_WAIT_V
#undef PG8_WAIT_L
#undef PG8_BAR
#undef PG8_SCHED
}
}

#define LAS __attribute__((address_space(3)))
#define XB_TMO      128
#define XB_XCNT(j)  (256  + 64 * (j))
#define XB_XSUB(j)  (1280 + 64 * (j))
#define XB_XGEN(j)  (2304 + 64 * (j))
#define XB_TOP      3328
#define XB_TOPGEN   3392
#define XCD_BAR_WORDS 3456
#define XB_SPIN_CAP (1u << 22)

__device__ __forceinline__ unsigned xb_ld(unsigned* p)              { return __hip_atomic_load(p, __ATOMIC_RELAXED, __HIP_MEMORY_SCOPE_AGENT); }
__device__ __forceinline__ unsigned xb_add(unsigned* p, unsigned v) { return __hip_atomic_fetch_add(p, v, __ATOMIC_RELAXED, __HIP_MEMORY_SCOPE_AGENT); }
__device__ __forceinline__ unsigned xb_xcc_id() { return (unsigned)__builtin_amdgcn_s_getreg((3 << 11) | 20) & 0xFu; }
#define XB_SPIN(cond, bar) do { unsigned _sp = 0; while (cond) { __builtin_amdgcn_s_sleep(1); \
    if ((++_sp & 255u) == 0u) { if (xb_ld(&(bar)[XB_TMO])) break; if (_sp > XB_SPIN_CAP) { atomicAdd(&(bar)[XB_TMO], 1u); break; } } } } while (0)

struct XcdBarrier {
    unsigned* bar; unsigned x;
    volatile LAS unsigned* st;
};

__device__ __forceinline__ XcdBarrier xcd_barrier_post(unsigned* bar, volatile LAS unsigned* st) {
    XcdBarrier b; b.bar = bar; b.x = xb_xcc_id(); b.st = st;
    if (threadIdx.x == 0) (void)xb_add(&bar[XB_XCNT(b.x)], 1u);
    return b;
}
__device__ __forceinline__ void xcd_barrier_complete(unsigned* bar, unsigned x, unsigned& nloc, unsigned& nx) {
    const unsigned G = gridDim.x * gridDim.y * gridDim.z;
    unsigned sum, cnt, mine, sp = 0u;
    for (;;) {
        sum = 0u; cnt = 0u; mine = 0u;
#pragma unroll
        for (unsigned j = 0; j < 16; ++j) { const unsigned c = xb_ld(&bar[XB_XCNT(j)]); sum += c; cnt += (c > 0u) ? 1u : 0u; mine = (j == x) ? c : mine; }
        if (sum == G) break;
        __builtin_amdgcn_s_sleep(1);
        if ((++sp & 255u) == 0u) { if (xb_ld(&bar[XB_TMO])) break; if (sp > XB_SPIN_CAP) { atomicAdd(&bar[XB_TMO], 1u); break; } }
    }
    nloc = mine > 0u ? mine : 1u; nx = cnt > 0u ? cnt : 1u;
}

__device__ __forceinline__ void xcd_barrier(const XcdBarrier& b) {
    asm volatile("s_waitcnt vmcnt(0)" ::: "memory");
    __syncthreads();
    if (threadIdx.x == 0) {
        unsigned* bar = b.bar;
        __builtin_amdgcn_s_waitcnt(0);
        unsigned nloc = b.st[0], nx = b.st[1];
        if (nloc == 0u) { xcd_barrier_complete(bar, b.x, nloc, nx); b.st[0] = nloc; b.st[1] = nx; }
        const unsigned old = xb_add(&bar[XB_XSUB(b.x)], 1u);
        const unsigned gen = old / nloc;
        if (old + 1u == (gen + 1u) * nloc) {
            __builtin_amdgcn_fence(__ATOMIC_RELEASE, "agent");
            asm volatile("s_waitcnt vmcnt(0)" ::: "memory");
            const unsigned og = xb_add(&bar[XB_TOP], 1u);
            const unsigned tg = og / nx;
            if (og + 1u == (tg + 1u) * nx) xb_add(&bar[XB_TOPGEN], 1u);
            else XB_SPIN(xb_ld(&bar[XB_TOPGEN]) == tg, bar);
            __builtin_amdgcn_fence(__ATOMIC_ACQUIRE, "agent");
            xb_add(&bar[XB_XGEN(b.x)], 1u);
            asm volatile("s_waitcnt vmcnt(0)" ::: "memory");
        } else {
            XB_SPIN(xb_ld(&bar[XB_XGEN(b.x)]) == gen, bar);
            __builtin_amdgcn_fence(__ATOMIC_ACQUIRE, "agent");
            asm volatile("s_waitcnt vmcnt(0)" ::: "memory");
        }
    }
    __syncthreads();
}
#define GAS __attribute__((address_space(1)))
typedef unsigned v4u __attribute__((ext_vector_type(4)));
typedef unsigned v2u __attribute__((ext_vector_type(2)));
typedef GAS unsigned gu32;
#define RLX_AGENT __ATOMIC_RELAXED, __HIP_MEMORY_SCOPE_AGENT
#define LDS_WAIT() asm volatile("s_waitcnt lgkmcnt(0)" ::: "memory")
#define VM_WAIT() asm volatile("s_waitcnt vmcnt(0)" ::: "memory")
using pg8::f32x4; using pg8::Unit; using pg8::Gemm; using pg8::BM; using pg8::HALF; using pg8::cvt_pk_bf16; using pg8::u32x4;

constexpr int NWAVES = 8, NTHREADS = 512;
constexpr int RING_BYTES = 131072, LDSCTL_OFF = RING_BYTES, MISC_OFF = LDSCTL_OFF + 320, LDS_BYTES = 147456;

__device__ __forceinline__ float wave_sum(float v, int lane) {
#pragma unroll
    for (int o = 1; o < 64; o <<= 1) v += __builtin_bit_cast(float, __builtin_amdgcn_ds_bpermute((lane ^ o) << 2, __builtin_bit_cast(int, v)));
    return v;
}
__device__ __forceinline__ float fsig(float x) { return __builtin_amdgcn_rcpf(1.f + __expf(-x)); }

__device__ __forceinline__ int rfl(int v) { return __builtin_amdgcn_readfirstlane(v); }
struct SOrder {
    pg8::StaticOrder s;
    __device__ void init(int M, int N, int G, int c) { s.init(M, N, G, c); }
    __device__ bool next(int i, Unit& u) const { Unit t; t.pm = 0; t.pn = 0; const bool ok = s.next(i, t); u.pm = rfl(t.pm); u.pn = rfl(t.pn); return ok; }
    __device__ __forceinline__ void a_ready(const Unit&) const {}
    __device__ __forceinline__ void done(const Unit&) const {}
};
struct StackOrder {
    int nM, nN, nb, G, c;
    __device__ bool next(int i, Unit& u) const { const long L = (long)i * G + c; if (L >= (long)nb * nM * nN) return false;
        const int br = (int)(L / (nM * nN)), rem = (int)(L % (nM * nN)); u.pm = rfl(br * nM + rem / nN); u.pn = rfl(br * nN + rem % nN); return true; }
    __device__ __forceinline__ void a_ready(const Unit&) const {}
    __device__ __forceinline__ void done(const Unit&) const {}
};
struct GateOrder {
    int nM, nN, G, c;
    __device__ bool next(int i, Unit& u) const { const int j = i / 3, br = i - 3 * j; const long L = (long)j * G + c; if (L >= (long)nM * nN) return false;
        u.pm = rfl((int)(L / nN)); u.pn = rfl(br * nN + (int)(L % nN)); return true; }
    __device__ __forceinline__ void a_ready(const Unit&) const {}
    __device__ __forceinline__ void done(const Unit&) const {}
};
struct MoeOrder {
    int nN, G, c, e0, e1, e2, e3, e4, e5, e6, e7;
    __device__ void init(const unsigned* cnt, int nN_, int G_, int c_) { nN = nN_; G = G_; c = c_;
        int s = 0; s += (cnt[0] + 255) >> 8; e0 = s; s += (cnt[1] + 255) >> 8; e1 = s; s += (cnt[2] + 255) >> 8; e2 = s; s += (cnt[3] + 255) >> 8; e3 = s;
        s += (cnt[4] + 255) >> 8; e4 = s; s += (cnt[5] + 255) >> 8; e5 = s; s += (cnt[6] + 255) >> 8; e6 = s; s += (cnt[7] + 255) >> 8; e7 = s; }
    __device__ bool next(int i, Unit& u) const { const long L = (long)i * G + c; if (L >= (long)e7 * nN) return false;
        const int pm = (int)(L / nN), pl = (int)(L % nN);
        const int e = (pm >= e0) + (pm >= e1) + (pm >= e2) + (pm >= e3) + (pm >= e4) + (pm >= e5) + (pm >= e6);
        u.pm = rfl(pm); u.pn = rfl(e * nN + pl); return true; }
    __device__ __forceinline__ void a_ready(const Unit&) const {}
    __device__ __forceinline__ void done(const Unit&) const {}
};

__device__ __forceinline__ u32x4 pack8(f32x4 v0, f32x4 v1) { u32x4 w; w.x = cvt_pk_bf16(v0[0], v0[1]); w.y = cvt_pk_bf16(v0[2], v0[3]); w.z = cvt_pk_bf16(v1[0], v1[1]); w.w = cvt_pk_bf16(v1[2], v1[3]); return w; }
__device__ __forceinline__ void unpack8(u32x4 w, f32x4& v0, f32x4& v1) {
    v0 = (f32x4){blo(w.x), bhi(w.x), blo(w.y), bhi(w.y)}; v1 = (f32x4){blo(w.z), bhi(w.z), blo(w.w), bhi(w.w)}; }

struct EpiProj {
    static constexpr bool PERM = true, AFTER_DRAIN = false;
    bf16 *QB, *KV, *UB, *RW, *HALO;
    __device__ __forceinline__ void operator()(const f32x4 (&acc)[2][2][4][2], const Unit& u, int wr, int wc, int fr, int fq) const {
        const int row0 = u.pm * BM + wr * 64 + fr, cl = wc * 32 + 8 * fq;
        if (u.pn >= 5 && u.pn < 9) {
#pragma unroll
            for (int ai = 0; ai < 2; ++ai)
#pragma unroll
                for (int m = 0; m < 4; ++m) { f32x4 a0 = acc[ai][0][m][0], a1 = acc[ai][0][m][1]; const f32x4 b0 = acc[ai][1][m][0], b1 = acc[ai][1][m][1];
#pragma unroll
                    for (int k = 0; k < 4; ++k) { a0[k] *= fsig(b0[k]); a1[k] *= fsig(b1[k]); }
                    *(u32x4*)(UB + (size_t)(row0 + ai * HALF + m * 16) * 512 + (u.pn - 5) * 128 + cl) = pack8(a0, a1); }
            return;
        }
        bf16* base; int ld, c0;
        if (u.pn < 2) { base = QB; ld = LDQ; c0 = u.pn * 256; } else if (u.pn < 5) { base = KV; ld = LDKV; c0 = (u.pn - 2) * 256; } else { base = RW; ld = LDRW; c0 = (u.pn - 9) * 256; }
#pragma unroll
        for (int ai = 0; ai < 2; ++ai)
#pragma unroll
            for (int m = 0; m < 4; ++m)
#pragma unroll
                for (int bj = 0; bj < 2; ++bj) { const u32x4 w = pack8(acc[ai][bj][m][0], acc[ai][bj][m][1]);
                    *(u32x4*)(base + (size_t)(row0 + ai * HALF + m * 16) * ld + c0 + bj * HALF + cl) = w;
                    if (u.pn >= 9 && ai == 1 && m == 3 && wr == 1 && fr == 15) *(u32x4*)(HALO + (size_t)u.pm * LDRW + c0 + bj * HALF + cl) = w; }
    }
};
struct EpiStore {
    static constexpr bool PERM = true, AFTER_DRAIN = false;
    bf16* O; int ld, ntn;
    __device__ __forceinline__ void operator()(const f32x4 (&acc)[2][2][4][2], const Unit& u, int wr, int wc, int fr, int fq) const {
        const int row0 = u.pm * BM + wr * 64 + fr, c0 = (u.pn % ntn) * 256 + wc * 32 + 8 * fq;
#pragma unroll
        for (int ai = 0; ai < 2; ++ai)
#pragma unroll
            for (int m = 0; m < 4; ++m)
#pragma unroll
                for (int bj = 0; bj < 2; ++bj) *(u32x4*)(O + (size_t)(row0 + ai * HALF + m * 16) * ld + c0 + bj * HALF) = pack8(acc[ai][bj][m][0], acc[ai][bj][m][1]);
    }
};
struct EpiGate {
    static constexpr bool PERM = true, AFTER_DRAIN = false;
    const bf16* OB; bf16* MIX; int ntn;
    __device__ __forceinline__ void operator()(const f32x4 (&acc)[2][2][4][2], const Unit& u, int wr, int wc, int fr, int fq) const {
        const int br = u.pn / ntn, row0 = u.pm * BM + wr * 64 + fr, c0 = (u.pn % ntn) * 256 + wc * 32 + 8 * fq;
        const bf16* ob = OB + (size_t)br * T * DM;
#pragma unroll
        for (int ai = 0; ai < 2; ++ai)
#pragma unroll
            for (int m = 0; m < 4; ++m)
#pragma unroll
                for (int bj = 0; bj < 2; ++bj) { const size_t off = (size_t)(row0 + ai * HALF + m * 16) * DM + c0 + bj * HALF;
                    f32x4 o0, o1; unpack8(*(const u32x4*)(ob + off), o0, o1);
                    f32x4 g0 = acc[ai][bj][m][0], g1 = acc[ai][bj][m][1];
#pragma unroll
                    for (int k = 0; k < 4; ++k) { g0[k] = fsig(g0[k]) * o0[k]; g1[k] = fsig(g1[k]) * o1[k]; }
                    if (br != 0) { f32x4 p0, p1; unpack8(*(const u32x4*)(MIX + off), p0, p1); g0 += p0; g1 += p1; }
                    *(u32x4*)(MIX + off) = pack8(g0, g1); }
    }
};
struct EpiResid {
    static constexpr bool PERM = true, AFTER_DRAIN = false;
    const float* base; float* out;
    __device__ __forceinline__ void operator()(const f32x4 (&acc)[2][2][4][2], const Unit& u, int wr, int wc, int fr, int fq) const {
        const int row0 = u.pm * BM + wr * 64 + fr, c0 = u.pn * 256 + wc * 32 + 8 * fq;
#pragma unroll
        for (int ai = 0; ai < 2; ++ai)
#pragma unroll
            for (int m = 0; m < 4; ++m)
#pragma unroll
                for (int bj = 0; bj < 2; ++bj) { const size_t off = (size_t)(row0 + ai * HALF + m * 16) * DM + c0 + bj * HALF;
                    const f32x4 x0 = *(const f32x4*)(base + off), x1 = *(const f32x4*)(base + off + 4);
                    *(f32x4*)(out + off) = x0 + acc[ai][bj][m][0]; *(f32x4*)(out + off + 4) = x1 + acc[ai][bj][m][1]; }
    }
};
struct EpiSwiglu {
    static constexpr bool PERM = true, AFTER_DRAIN = false;
    bf16* ACT; int ld, ntn;
    __device__ __forceinline__ void operator()(const f32x4 (&acc)[2][2][4][2], const Unit& u, int wr, int wc, int fr, int fq) const {
        const int row0 = u.pm * BM + wr * 64 + fr, c0 = (u.pn % ntn) * 128 + wc * 32 + 8 * fq;
#pragma unroll
        for (int ai = 0; ai < 2; ++ai)
#pragma unroll
            for (int m = 0; m < 4; ++m) { f32x4 g0 = acc[ai][0][m][0], g1 = acc[ai][0][m][1]; const f32x4 u0 = acc[ai][1][m][0], u1 = acc[ai][1][m][1];
#pragma unroll
                for (int k = 0; k < 4; ++k) { g0[k] = g0[k] * fsig(g0[k]) * u0[k]; g1[k] = g1[k] * fsig(g1[k]) * u1[k]; }
                *(u32x4*)(ACT + (size_t)(row0 + ai * HALF + m * 16) * ld + c0) = pack8(g0, g1); }
    }
};
struct EpiMoeDown {
    static constexpr bool PERM = true, AFTER_DRAIN = false;
    float* out; const int* rtok; const float* rw; int ntn;
    __device__ __forceinline__ void operator()(const f32x4 (&acc)[2][2][4][2], const Unit& u, int wr, int wc, int fr, int fq) const {
        const int row0 = u.pm * BM + wr * 64 + fr, c0 = (u.pn % ntn) * 256 + wc * 32 + 8 * fq;
#pragma unroll
        for (int ai = 0; ai < 2; ++ai)
#pragma unroll
            for (int m = 0; m < 4; ++m) { const int row = row0 + ai * HALF + m * 16; const int tok = rtok[row]; const float w = rw[row];
                if (tok >= 0) {
#pragma unroll
                    for (int bj = 0; bj < 2; ++bj) { float* o = out + (size_t)tok * DM + c0 + bj * HALF;
                        const f32x4 x0 = *(const f32x4*)o, x1 = *(const f32x4*)(o + 4);
                        *(f32x4*)o = x0 + acc[ai][bj][m][0] * w; *(f32x4*)(o + 4) = x1 + acc[ai][bj][m][1] * w; } } }
    }
};

struct MapPlain { bf16* base; int K; __device__ __forceinline__ bf16* operator()(int col) const { return base + (size_t)col * K; } };
struct MapGlu { bf16* base; int K, ff; __device__ __forceinline__ bf16* operator()(int col) const { return base + (size_t)glu_dest(col, ff) * K; } };
struct MapWin { unsigned char* wl; int layer; __device__ __forceinline__ bf16* operator()(int col) const { int which; const int r = win_dest(col, layer, which); const size_t off = (which ? OFF_WG : OFF_WIN) + (size_t)(r < 0 ? 0 : r) * DM * 2; return r < 0 ? nullptr : (bf16*)(wl + off); } };
template <class Map>
__device__ __forceinline__ void transpose_item(const float* W, int K, int N, const Map& mp, LAS float* scr, int item, int lane) {
    const int nblk = (N + 31) / 32, kb = item / nblk, nb = item % nblk, k0 = 64 * kb, n0 = 32 * nb;
    const int col = n0 + (lane & 31);
#pragma unroll 8
    for (int i = 0; i < 32; ++i) { const int kk = 2 * i + (lane >> 5); scr[kk * 33 + (lane & 31)] = col < N ? W[(size_t)(k0 + kk) * N + col] : 0.f; }
    LDS_WAIT(); asm volatile("" ::: "memory");
    const int c = lane & 7;
#pragma unroll
    for (int j = 0; j < 4; ++j) { const int n = (lane >> 3) + 8 * j; const LAS float* s = scr + (8 * c) * 33 + n;
        v4u o; o.x = (unsigned)f2bf(s[0]) | ((unsigned)f2bf(s[33]) << 16); o.y = (unsigned)f2bf(s[66]) | ((unsigned)f2bf(s[99]) << 16);
        o.z = (unsigned)f2bf(s[132]) | ((unsigned)f2bf(s[165]) << 16); o.w = (unsigned)f2bf(s[198]) | ((unsigned)f2bf(s[231]) << 16);
        if (n0 + n < N) { bf16* d = mp(n0 + n); if (d) *(v4u*)(d + k0 + 8 * c) = o; } }
    LDS_WAIT(); asm volatile("" ::: "memory");
}
template <class Map>
__device__ __forceinline__ bool conv_job(int& r, const float* W, int K, int N, const Map& mp, LAS float* scr, int lane) {
    const int items = (K / 64) * ((N + 31) / 32);
    if (r < items) { transpose_item(W, K, N, mp, scr, r, lane); return true; }
    r -= items; return false;
}

__device__ __forceinline__ void rms_row(const P& p, const float* xrow, const float* g, bf16* orow, int lane, bool route, int t) {
    const f32x4* xr = (const f32x4*)xrow + lane; const f32x4* gr = (const f32x4*)g + lane;
    f32x4 v[DM / 256]; float ss = 0.f;
#pragma unroll
    for (int j = 0; j < DM / 256; ++j) { v[j] = xr[64 * j]; ss += (v[j].x * v[j].x + v[j].y * v[j].y) + (v[j].z * v[j].z + v[j].w * v[j].w); }
    const float rs = 1.f / sqrtf(wave_sum(ss, lane) * (1.f / DM) + RMS_EPS);
    v2u* o8 = (v2u*)orow + lane;
#pragma unroll
    for (int j = 0; j < DM / 256; ++j) { const f32x4 gg = gr[64 * j]; v[j].x *= rs * gg.x; v[j].y *= rs * gg.y; v[j].z *= rs * gg.z; v[j].w *= rs * gg.w;
        v2u w; w.x = cvt_pk_bf16(v[j].x, v[j].y); w.y = cvt_pk_bf16(v[j].z, v[j].w); o8[64 * j] = w; }
    if (route) {
        float lg[NEXP];
#pragma unroll
        for (int e = 0; e < NEXP; ++e) lg[e] = 0.f;
#pragma unroll
        for (int j = 0; j < DM / 256; ++j) { const float* rw = p.router_w + (size_t)(4 * (lane + 64 * j)) * NEXP;
#pragma unroll
            for (int e = 0; e < NEXP; ++e) lg[e] += v[j].x * rw[e] + v[j].y * rw[NEXP + e] + v[j].z * rw[2 * NEXP + e] + v[j].w * rw[3 * NEXP + e]; }
#pragma unroll
        for (int e = 0; e < NEXP; ++e) lg[e] = wave_sum(lg[e], lane) + p.router_b[e];
        int e0 = 0; float l0 = lg[0];
#pragma unroll
        for (int e = 1; e < NEXP; ++e) if (lg[e] > l0) { l0 = lg[e]; e0 = e; }
        int e1 = -1; float l1 = -3e38f;
#pragma unroll
        for (int e = 0; e < NEXP; ++e) if (e != e0 && lg[e] > l1) { l1 = lg[e]; e1 = e; }
        if (lane == 0) { const float w0 = 1.f / (1.f + expf(l1 - l0));
            WSP(int, AR_RTE)[t] = e0 | (e1 << 8); float* rw = WSP(float, AR_RTW) + (size_t)t * 2; rw[0] = w0; rw[1] = 1.f - w0;
            unsigned* ctl = WSP(unsigned, WS_CTL); atomicAdd(ctl + CW_CNT + e0, 1u); atomicAdd(ctl + CW_CNT + 8 + e1, 1u); }
    }
}
__device__ __forceinline__ void copy_row_wave(const bf16* src, bf16* dst, int lane) {
#pragma unroll
    for (int j = 0; j < DM / 512; ++j) ((v4u*)dst)[lane + 64 * j] = ((const v4u*)src)[lane + 64 * j];
}
__device__ __forceinline__ int moe_seg_start(const unsigned* cnt, int e) { int s = 0;
#pragma unroll
    for (int k = 0; k < NEXP; ++k) s += (k < e) ? (int)((cnt[k] + 255u) & ~255u) : 0;
    return s; }

#ifndef PHMASK
#define PHMASK 0xFFFFFFFFu
#endif
#define PHM(k) (((PHMASK) >> (k)) & 1u)
constexpr int NPH = 16, NPHASES = 1 + 2 * NPH;
struct Args { const float* in[29]; float* out; unsigned char* ws; int ph_lo, ph_hi; };

typedef const Args __attribute__((address_space(4)))* CArgsP;
__device__ __forceinline__ void fill_params_k(P& p, CArgsP a) {
    p.x = a->in[0]; p.mix_norm_g = a->in[1]; p.w_in_first = a->in[2]; p.w_in_rest = a->in[3]; p.mu_first = a->in[4]; p.mu_rest = a->in[5]; p.qk_g = a->in[6]; p.cmp_pos = a->in[7];
    p.cmp_w1 = a->in[8]; p.cmp_w2 = a->in[9]; p.nsa_w_o = a->in[10]; p.conv_w = a->in[11]; p.conv_vec = a->in[12]; p.conv_w_o = a->in[13]; p.rwkv_vec = a->in[14]; p.w_up = a->in[15];
    p.a_up = a->in[16]; p.g_up = a->in[17]; p.vres_up = a->in[18]; p.vres_b = a->in[19]; p.rwkv_w_o = a->in[20]; p.w_out = a->in[21]; p.ffn_norm_g = a->in[22]; p.dense_gu = a->in[23];
    p.dense_down = a->in[24]; p.router_w = a->in[25]; p.router_b = a->in[26]; p.moe_gu = a->in[27]; p.moe_down = a->in[28]; p.out = a->out; p.ws = a->ws;
}
__global__ void __launch_bounds__(NTHREADS, 2) mk_fwd(Args args) {
    extern __shared__ __attribute__((aligned(16))) unsigned char lds_raw[];
    LAS unsigned char* lds = (LAS unsigned char*)lds_raw;
    const int tid = threadIdx.x, lane = tid & 63, wave = __builtin_amdgcn_readfirstlane(tid >> 6);
    const int G = gridDim.x, bid = blockIdx.x;
    unsigned* ctl = (unsigned*)(args.ws + WS_CTL);
    for (int u = tid; u < (LDS_BYTES - LDSCTL_OFF) / 4; u += NTHREADS) ((LAS unsigned*)(lds + LDSCTL_OFF))[u] = 0u;
    __syncthreads();
    const int lo = args.ph_lo, hi = args.ph_hi;
    XcdBarrier bar; bar.bar = ctl + CW_BAR; bar.x = 0; bar.st = nullptr;
    if (hi - lo > 1) bar = xcd_barrier_post(ctl + CW_BAR, (volatile LAS unsigned*)(lds + MISC_OFF) + 8);
#define IN(k) (lo <= (k) && (k) < hi)
#define MKP CArgsP ap_ = (CArgsP)__builtin_amdgcn_kernarg_segment_ptr(); asm volatile("" : "+s"(ap_)); P p; fill_params_k(p, ap_); int tid = threadIdx.x; asm volatile("" : "+v"(tid)); const int lane = tid & 63, wave = __builtin_amdgcn_readfirstlane(tid >> 6); int G = gridDim.x, bid = blockIdx.x; asm volatile("" : "+s"(G), "+s"(bid)); unsigned* ctl = WSP(unsigned, WS_CTL); const long gtid = (long)bid * NTHREADS + tid, NT = (long)G * NTHREADS; const int gw = bid * NWAVES + wave, NGW = G * NWAVES; LAS float* scrw = (LAS float*)(lds + wave * 16384); (void)gtid; (void)NT; (void)gw; (void)NGW; (void)scrw; (void)lane; (void)ctl
#define SEAM(k) do { if ((k) + 1 < hi) xcd_barrier(bar); } while (0)

    if (PHM(16) && IN(0)) { MKP;
        constexpr int IT_WIN0 = (DM / 64) * ((N_IN_FIRST + 31) / 32), IT_WIN1 = (DM / 64) * ((N_IN_REST + 31) / 32), IT_WO = (512 / 64) * (DM / 32), IT_WOUT = (DM / 64) * (DM / 32);
        constexpr int total = IT_WIN0 + IT_WIN1 + 6 * IT_WO + 2 * IT_WOUT + (DM / 64) * (2 * DENSE_FF / 32) + (DENSE_FF / 64) * (DM / 32);
        bf16* wl0 = WSP(bf16, WS_W); bf16* wl1 = WSP(bf16, WS_W + SZ_LAYERW);
#define WOFF(b, o) ((bf16*)((unsigned char*)(b) + (o)))
        for (int it = gw; it < total; it += NGW) {
            int r = it;
            if (conv_job(r, p.w_in_first, DM, N_IN_FIRST, MapWin{(unsigned char*)wl0, 0}, scrw, lane)) continue;
            if (conv_job(r, p.w_in_rest, DM, N_IN_REST, MapWin{(unsigned char*)wl1, 1}, scrw, lane)) continue;
            if (conv_job(r, p.nsa_w_o, 512, DM, MapPlain{WOFF(wl0, OFF_WO3), 512}, scrw, lane)) continue;
            if (conv_job(r, p.rwkv_w_o, 512, DM, MapPlain{WOFF(wl0, OFF_WO3) + (size_t)DM * 512, 512}, scrw, lane)) continue;
            if (conv_job(r, p.conv_w_o, 512, DM, MapPlain{WOFF(wl0, OFF_WO3) + (size_t)2 * DM * 512, 512}, scrw, lane)) continue;
            if (conv_job(r, p.nsa_w_o + (size_t)512 * DM, 512, DM, MapPlain{WOFF(wl1, OFF_WO3), 512}, scrw, lane)) continue;
            if (conv_job(r, p.rwkv_w_o + (size_t)512 * DM, 512, DM, MapPlain{WOFF(wl1, OFF_WO3) + (size_t)DM * 512, 512}, scrw, lane)) continue;
            if (conv_job(r, p.conv_w_o + (size_t)512 * DM, 512, DM, MapPlain{WOFF(wl1, OFF_WO3) + (size_t)2 * DM * 512, 512}, scrw, lane)) continue;
            if (conv_job(r, p.w_out, DM, DM, MapPlain{WOFF(wl0, OFF_WOUT), DM}, scrw, lane)) continue;
            if (conv_job(r, p.w_out + (size_t)DM * DM, DM, DM, MapPlain{WOFF(wl1, OFF_WOUT), DM}, scrw, lane)) continue;
            if (conv_job(r, p.dense_gu, DM, 2 * DENSE_FF, MapGlu{WSP(bf16, WS_DGU), DM, DENSE_FF}, scrw, lane)) continue;
            conv_job(r, p.dense_down, DENSE_FF, DM, MapPlain{WSP(bf16, WS_DDN), DENSE_FF}, scrw, lane);
        }
        SEAM(0);
    }

    for (int layer = 0; layer < 2; ++layer) {
        const int pb = 1 + layer * NPH;
        if (PHM(0) && IN(pb + 0)) { MKP;
            const float* xin = layer == 0 ? p.x : p.out;
            for (int m = gw; m < T; m += NGW) rms_row(p, xin + (size_t)m * DM, p.mix_norm_g + (size_t)layer * DM, WSP(bf16, WS_H) + (size_t)m * DM, lane, false, m);
            SEAM(pb + 0);
        }
        if (PHM(1) && IN(pb + 1)) { MKP;
            Gemm g{WSP(bf16, WS_H), (const bf16*)(p.ws + WS_W + (size_t)layer * SZ_LAYERW + OFF_WIN), T, NPROJ, DM}; SOrder S; S.init(T, NPROJ, G, bid);
            EpiProj E{WSP(bf16, AR_QB), WSP(bf16, AR_KV), WSP(bf16, AR_UB), WSP(bf16, AR_RW), WSP(bf16, AR_HALO)};
            pg8::gemm_phase<EpiProj, SOrder, true, true>(lds, g, S, E);
            SEAM(pb + 1);
        }
        if (PHM(2) && IN(pb + 2)) { MKP;
#ifndef D_SHIFT
 ph_shift(p, layer, gtid, NT);
#endif
#ifndef D_PREP
 ph_nsa_prep(p, layer, gtid, NT);
#endif
#ifndef D_CMP1
 ph_cmp1(p, layer, gtid, NT);
#endif
#ifndef D_CONV
 ph_conv(p, layer, gtid, NT);
#endif
 SEAM(pb + 2); }
        if (PHM(3) && IN(pb + 3)) { MKP;
#ifndef D_B1
 ph_rwkv_b1(p, layer, gtid, NT);
#endif
#ifndef D_CMP2
 ph_cmp2(p, layer, gtid, NT);
#endif
 SEAM(pb + 3); }
        if (PHM(4) && IN(pb + 4)) { MKP;
            ph_rwkv_b2(p, layer, gtid, NT);
            constexpr int NSELT = 224;
            if (tid < NSELT) { float* imp = (float*)(lds_raw + (size_t)tid * 516);

#ifndef D_SEL
 for (long it = (long)bid * NSELT + tid; it < (long)BATCH * NKV * SEQ; it += (long)G * NSELT) nsa_select_one(p, it, imp);
#endif
 }
            SEAM(pb + 4);
        }
        if (PHM(5) && IN(pb + 5)) { MKP;
#ifndef D_SCAN
 ph_scan_naive(p, gtid, NT);
#endif
#ifndef D_ATTN
 ph_nsa_attn_naive(p, gtid, NT);
#endif
 SEAM(pb + 5); }
        if (PHM(6) && IN(pb + 6)) { MKP; ph_rwkv_post(p, layer, gtid, NT); SEAM(pb + 6); }
        if (PHM(7) && IN(pb + 7)) { MKP;
            Gemm g{WSP(bf16, AR_QB), (const bf16*)(p.ws + WS_W + (size_t)layer * SZ_LAYERW + OFF_WO3), 3 * T, 3 * DM, 512}; StackOrder S{T / 256, DM / 256, 3, G, bid};
            EpiStore E{WSP(bf16, AR_OBUF), DM, DM / 256};
            pg8::gemm_phase<EpiStore, StackOrder, true, true>(lds, g, S, E);
            SEAM(pb + 7);
        }
        if (PHM(8) && IN(pb + 8)) { MKP;
            Gemm g{WSP(bf16, WS_H), (const bf16*)(p.ws + WS_W + (size_t)layer * SZ_LAYERW + OFF_WG), T, 3 * DM, DM}; GateOrder S{T / 256, DM / 256, G, bid};
            EpiGate E{WSP(bf16, AR_OBUF), WSP(bf16, AR_MIX), DM / 256};
            pg8::gemm_phase<EpiGate, GateOrder, true, true>(lds, g, S, E);
            SEAM(pb + 8);
        }
        if (PHM(9) && IN(pb + 9)) { MKP;
            Gemm g{WSP(bf16, AR_MIX), (const bf16*)(p.ws + WS_W + (size_t)layer * SZ_LAYERW + OFF_WOUT), T, DM, DM}; SOrder S; S.init(T, DM, G, bid);
            EpiResid E{layer == 0 ? p.x : p.out, p.out};
            pg8::gemm_phase<EpiResid, SOrder, true, true>(lds, g, S, E);
            SEAM(pb + 9);
        }
        if (PHM(10) && IN(pb + 10)) { MKP;
            for (int m = gw; m < T; m += NGW) rms_row(p, p.out + (size_t)m * DM, p.ffn_norm_g + (size_t)layer * DM, WSP(bf16, WS_H) + (size_t)m * DM, lane, layer == 1, m);
            if (layer == 1) { int* rt = WSP(int, AR_RTOK); for (long i = gtid; i < 2L * MOE_ROWS; i += NT) rt[i] = -1; }
            SEAM(pb + 10);
        }
        if (layer == 0) {
            if (PHM(11) && IN(pb + 11)) { MKP;
                Gemm g{WSP(bf16, WS_H), WSP(bf16, WS_DGU), T, 2 * DENSE_FF, DM}; SOrder S; S.init(T, 2 * DENSE_FF, G, bid);
                EpiSwiglu E{WSP(bf16, AR_ACT), DENSE_FF, 2 * DENSE_FF / 256};
                pg8::gemm_phase<EpiSwiglu, SOrder, true, true>(lds, g, S, E);
                SEAM(pb + 11);
            }
            if (PHM(12) && IN(pb + 12)) { MKP;
                Gemm g{WSP(bf16, AR_ACT), WSP(bf16, WS_DDN), T, DM, DENSE_FF}; SOrder S; S.init(T, DM, G, bid);
                EpiResid E{p.out, p.out};
                pg8::gemm_phase<EpiResid, SOrder, true, true>(lds, g, S, E);
                SEAM(pb + 12);
            }
        } else {
            if (PHM(11) && IN(pb + 11)) { MKP;
                const int ig = (DM / 64) * (2 * EXPERT_FF / 32), id = (EXPERT_FF / 64) * (DM / 32);
                for (int it = gw; it < NEXP * (ig + id); it += NGW) { const int e = it / (ig + id); int r = it % (ig + id);
                    if (conv_job(r, p.moe_gu + (size_t)e * DM * 2 * EXPERT_FF, DM, 2 * EXPERT_FF, MapGlu{WSP(bf16, AR_MGU) + (size_t)e * 2 * EXPERT_FF * DM, DM, EXPERT_FF}, scrw, lane)) continue;
                    conv_job(r, p.moe_down + (size_t)e * EXPERT_FF * DM, EXPERT_FF, DM, MapPlain{WSP(bf16, AR_MDN) + (size_t)e * DM * EXPERT_FF, EXPERT_FF}, scrw, lane); }
                int* rtok = WSP(int, AR_RTOK); float* rww = WSP(float, AR_RW8); int* trow = WSP(int, AR_TROW);
                for (int t = gw; t < T; t += NGW) {
                    int row0 = 0;
                    if (lane == 0) { const int ee = WSP(int, AR_RTE)[t], e0 = ee & 255, e1 = ee >> 8; const float* w = WSP(float, AR_RTW) + (size_t)t * 2;
                        row0 = moe_seg_start(ctl + CW_CNT, e0) + (int)atomicAdd(ctl + CW_FILL + e0, 1u);
                        const int row1 = moe_seg_start(ctl + CW_CNT + 8, e1) + (int)atomicAdd(ctl + CW_FILL + 8 + e1, 1u);
                        rtok[row0] = t; rww[row0] = w[0]; rtok[MOE_ROWS + row1] = t; rww[MOE_ROWS + row1] = w[1]; trow[T + t] = row1; }
                    row0 = __builtin_amdgcn_readfirstlane(row0);
                    copy_row_wave(WSP(bf16, WS_H) + (size_t)t * DM, WSP(bf16, AR_XG) + (size_t)row0 * DM, lane);
                }
                SEAM(pb + 11);
            }
#pragma unroll
            for (int pass = 0; pass < 2; ++pass) {
                if (PHM(12) && IN(pb + 12 + 2 * pass)) { MKP;
                    Gemm g{WSP(bf16, AR_XG), WSP(bf16, AR_MGU), MOE_ROWS, NEXP * 2 * EXPERT_FF, DM}; MoeOrder S; S.init(ctl + CW_CNT + 8 * pass, 2 * EXPERT_FF / 256, G, bid);
                    EpiSwiglu E{WSP(bf16, AR_MACT), EXPERT_FF, 2 * EXPERT_FF / 256};
                    pg8::gemm_phase<EpiSwiglu, MoeOrder, true, true>(lds, g, S, E);
                    SEAM(pb + 12 + 2 * pass);
                }
                if (PHM(13) && IN(pb + 13 + 2 * pass)) { MKP;
                    Gemm g{WSP(bf16, AR_MACT), WSP(bf16, AR_MDN), MOE_ROWS, NEXP * DM, EXPERT_FF}; MoeOrder S; S.init(ctl + CW_CNT + 8 * pass, DM / 256, G, bid);
                    EpiMoeDown E{p.out, WSP(int, AR_RTOK) + (size_t)pass * MOE_ROWS, WSP(float, AR_RW8) + (size_t)pass * MOE_ROWS, DM / 256};
                    pg8::gemm_phase<EpiMoeDown, MoeOrder, true, true>(lds, g, S, E);
                    if (pass == 0) { const int* trow = WSP(int, AR_TROW);
                        for (int t = gw; t < T; t += NGW) copy_row_wave(WSP(bf16, WS_H) + (size_t)t * DM, WSP(bf16, AR_XG) + (size_t)trow[T + t] * DM, lane); }
                    SEAM(pb + 13 + 2 * pass);
                }
            }
        }
    }
#undef IN
#undef SEAM
}

#ifndef MK_ONE_LAUNCH
#define MK_ONE_LAUNCH 1
#endif
extern "C" void kernel_launch(void* const* d_in, const int* in_sizes, int n_in, void* d_out, int out_size, void* d_ws, size_t ws_size, hipStream_t stream) {
    static int grid = 0;
    if (grid == 0) {
        if (n_in != 29 || in_sizes[0] != T * DM || out_size != T * DM || ws_size < WS_END) { fprintf(stderr, "kernel_launch: unexpected shapes / workspace (%d inputs, ws %zu, need %zu)\n", n_in, ws_size, (size_t)WS_END); grid = -1; return; }
        int dev = 0, cus = 0;
        if (hipGetDevice(&dev) != hipSuccess || hipDeviceGetAttribute(&cus, hipDeviceAttributeMultiprocessorCount, dev) != hipSuccess) { grid = -1; return; }
        if (hipFuncSetAttribute((const void*)mk_fwd, hipFuncAttributeMaxDynamicSharedMemorySize, LDS_BYTES) != hipSuccess) { fprintf(stderr, "kernel_launch: hipFuncSetAttribute failed\n"); grid = -1; return; }
        int per_cu = 0;
        if (hipOccupancyMaxActiveBlocksPerMultiprocessor(&per_cu, (const void*)mk_fwd, NTHREADS, LDS_BYTES) != hipSuccess || per_cu < 1) { fprintf(stderr, "kernel_launch: occupancy query says %d\n", per_cu); }
        (void)hipGetLastError();
        grid = cus;
    }
    if (grid < 0) return;
    if (hipMemsetAsync((char*)d_ws + WS_CTL, 0, CTL_BYTES, stream) != hipSuccess) return;
    Args a{};
    for (int i = 0; i < 29; ++i) a.in[i] = (const float*)d_in[i];
    a.out = (float*)d_out; a.ws = (unsigned char*)d_ws;
#if MK_ONE_LAUNCH
    a.ph_lo = 0; a.ph_hi = NPHASES;
    hipLaunchKernelGGL(mk_fwd, dim3(grid), dim3(NTHREADS), LDS_BYTES, stream, a);
#else
    for (int k = 0; k < NPHASES; ++k) {
        if (k >= 1 + 13 && k < 1 + NPH) continue;
        a.ph_lo = k; a.ph_hi = k + 1;
        hipLaunchKernelGGL(mk_fwd, dim3(grid), dim3(NTHREADS), LDS_BYTES, stream, a);
    }
#endif
}
```

```cpp
#include <hip/hip_runtime.h>
#include <cstdio>
#include <cstdint>
#include <cmath>
#include <cstring>
#ifdef HOST_EMU
#define HD
#define DEV_INLINE inline
#else
#define HD __host__ __device__
#define DEV_INLINE __device__ __forceinline__
#endif

typedef unsigned short bf16;
struct alignas(16) U4 { unsigned x, y, z, w; };

#ifdef SMALL_CFG
constexpr int BATCH = 1, SEQ = 1024, DM = 128, DENSE_FF = 256, EXPERT_FF = 256;
#else
constexpr int BATCH = 8, SEQ = 8192, DM = 1024, DENSE_FF = 2816, EXPERT_FF = 3584;
#endif
constexpr int T = BATCH * SEQ;
constexpr int NHEAD = 8, NKV = 2, HG = 4, DH = 64;
constexpr int NC = SEQ / 16 - 1, NS = SEQ / 64, NSEL = 8, WINDOW = 512;
constexpr int CONV_CH = 512, CONV_K = 31, RC = 512;
constexpr int NEXP = 8;
constexpr int NSA_IN = 1304, OFF_CONV = 1304, OFF_GATE = 2328, OFF_RWKV = OFF_GATE + 3 * DM;
constexpr int N_IN_FIRST = OFF_RWKV + 1824, N_IN_REST = OFF_RWKV + 1856;
constexpr int NPROJ = 4352;
constexpr int LDQ = 512, LDKV = 768, LDRW = 2048, LBLK = 1536;
constexpr int MOE_ROWS = T + NEXP * 256;
constexpr float RMS_EPS = 1e-6f, LN_EPS = 1e-5f, GN_EPS = 64e-5f;

constexpr size_t al(size_t x) { return (x + 255) & ~(size_t)255; }
constexpr size_t WS_CTL = 0, CTL_BYTES = 1u << 20;
constexpr size_t SZ_WIN = (size_t)NPROJ * DM * 2, SZ_WG = (size_t)3 * DM * DM * 2, SZ_WO3 = (size_t)3 * DM * 512 * 2, SZ_WOUT = (size_t)DM * DM * 2;
constexpr size_t SZ_LAYERW = SZ_WIN + SZ_WG + SZ_WO3 + SZ_WOUT;
constexpr size_t WS_W = CTL_BYTES;
constexpr size_t OFF_WIN = 0, OFF_WG = SZ_WIN, OFF_WO3 = OFF_WG + SZ_WG, OFF_WOUT = OFF_WO3 + SZ_WO3;
constexpr size_t WS_DGU = WS_W + 2 * SZ_LAYERW, SZ_DGU = (size_t)2 * DENSE_FF * DM * 2;
constexpr size_t WS_DDN = WS_DGU + SZ_DGU, SZ_DDN = (size_t)DM * DENSE_FF * 2;
constexpr size_t WS_VF = al(WS_DDN + SZ_DDN), SZ_TC = (size_t)T * 512 * 2;
constexpr size_t WS_H = WS_VF + SZ_TC, SZ_H = (size_t)T * DM * 2;
constexpr size_t WS_AR = al(WS_H + SZ_H);
constexpr size_t AR_QB = WS_AR, AR_A = AR_QB + SZ_TC, AR_CO = AR_A + SZ_TC;
constexpr size_t AR_KV = AR_CO + SZ_TC, SZ_KV = (size_t)T * LDKV * 2;
constexpr size_t AR_RW = AR_KV + SZ_KV, SZ_RW = (size_t)T * LDRW * 2;
constexpr size_t AR_W = AR_RW + SZ_RW, AR_G = AR_W + SZ_TC, AR_UB = AR_G + SZ_TC;
constexpr size_t AR_NG = AR_UB + SZ_TC, SZ_NG = (size_t)T * 24 * 4;
constexpr size_t AR_HALO = al(AR_NG + SZ_NG), SZ_HALO = (size_t)(T / 256) * LDRW * 2;
constexpr size_t AR_KC = al(AR_HALO + SZ_HALO), SZ_CMP = (size_t)BATCH * NKV * (SEQ / 16) * 64 * 2;
constexpr size_t AR_VC = AR_KC + SZ_CMP;
constexpr size_t AR_HID = al(AR_VC + SZ_CMP), SZ_HID = (size_t)BATCH * NKV * (SEQ / 16) * 2 * 128 * 4;
constexpr size_t AR_SEL = al(AR_HID + SZ_HID), SZ_SEL = (size_t)T * NKV * 8 * 4;
constexpr size_t AR_INVN = al(AR_SEL + SZ_SEL), SZ_INVN = (size_t)T * 8 * 4;
constexpr size_t AR_VCT = al(AR_INVN + SZ_INVN);
constexpr size_t AR_END1 = al(AR_VCT + SZ_CMP);
constexpr size_t WS_VST = WS_H, WS_VWT = WS_H + (size_t)T * 128 * 2;
constexpr size_t AR_OBUF = AR_KV, SZ_OBUF = (size_t)3 * T * DM * 2;
constexpr size_t AR_MIX = AR_OBUF + SZ_OBUF, SZ_MIX = (size_t)T * DM * 2;
constexpr size_t AR_END2 = AR_MIX + SZ_MIX;
constexpr size_t AR_ACT = WS_AR;
constexpr size_t AR_MGU = WS_AR, SZ_MGU = (size_t)NEXP * 2 * EXPERT_FF * DM * 2;
constexpr size_t AR_MDN = AR_MGU + SZ_MGU, SZ_MDN = (size_t)NEXP * DM * EXPERT_FF * 2;
constexpr size_t AR_XG = al(AR_MDN + SZ_MDN), SZ_XG = (size_t)MOE_ROWS * DM * 2;
constexpr size_t AR_MACT = al(AR_XG + SZ_XG), SZ_MACT = (size_t)MOE_ROWS * EXPERT_FF * 2;
constexpr size_t AR_RTOK = al(AR_MACT + SZ_MACT), SZ_RTOK = (size_t)2 * MOE_ROWS * 4;
constexpr size_t AR_RW8 = al(AR_RTOK + SZ_RTOK);
constexpr size_t AR_TROW = al(AR_RW8 + SZ_RTOK), SZ_TROW = (size_t)2 * T * 4;
constexpr size_t AR_RTE = al(AR_TROW + SZ_TROW);
constexpr size_t AR_RTW = al(AR_RTE + (size_t)T * 4);
constexpr size_t AR_END3 = al(AR_RTW + (size_t)T * 8);
constexpr size_t WS_END = (AR_END1 > AR_END2 ? (AR_END1 > AR_END3 ? AR_END1 : AR_END3) : (AR_END2 > AR_END3 ? AR_END2 : AR_END3));
constexpr int CW_CNT = 64, CW_FILL = 128;
constexpr int CW_ATT = 256;
constexpr int CW_BAR = 4096;

struct P {
    const float *x, *mix_norm_g, *w_in_first, *w_in_rest, *mu_first, *mu_rest, *qk_g, *cmp_pos, *cmp_w1, *cmp_w2, *nsa_w_o, *conv_w, *conv_vec, *conv_w_o,
        *rwkv_vec, *w_up, *a_up, *g_up, *vres_up, *vres_b, *rwkv_w_o, *w_out, *ffn_norm_g, *dense_gu, *dense_down, *router_w, *router_b, *moe_gu, *moe_down;
    float* out; unsigned char* ws;
};
HD inline void fill_params(P& p, const float* const* in, float* out, unsigned char* ws) {
    p.x = in[0]; p.mix_norm_g = in[1]; p.w_in_first = in[2]; p.w_in_rest = in[3]; p.mu_first = in[4]; p.mu_rest = in[5]; p.qk_g = in[6]; p.cmp_pos = in[7];
    p.cmp_w1 = in[8]; p.cmp_w2 = in[9]; p.nsa_w_o = in[10]; p.conv_w = in[11]; p.conv_vec = in[12]; p.conv_w_o = in[13]; p.rwkv_vec = in[14]; p.w_up = in[15];
    p.a_up = in[16]; p.g_up = in[17]; p.vres_up = in[18]; p.vres_b = in[19]; p.rwkv_w_o = in[20]; p.w_out = in[21]; p.ffn_norm_g = in[22]; p.dense_gu = in[23];
    p.dense_down = in[24]; p.router_w = in[25]; p.router_b = in[26]; p.moe_gu = in[27]; p.moe_down = in[28]; p.out = out; p.ws = ws;
}
#define WSP(type, off) ((type*)(p.ws + (off)))

#ifdef HOST_EMU
#define FENCE()
#else
#define FENCE() asm volatile("" ::: "memory")
#endif
HD inline float bf2f(bf16 v) { unsigned u = (unsigned)v << 16; float f; memcpy(&f, &u, 4); return f; }
HD inline bf16 f2bf(float f) { unsigned u; memcpy(&u, &f, 4); return (bf16)((u + 0x7fffu + ((u >> 16) & 1u)) >> 16); }
HD inline float blo(unsigned v) { unsigned u = v << 16; float f; memcpy(&f, &u, 4); return f; }
HD inline float bhi(unsigned v) { unsigned u = v & 0xffff0000u; float f; memcpy(&f, &u, 4); return f; }
HD inline float sigmoidf_(float x) { return 1.f / (1.f + expf(-x)); }
HD inline float dot64(const float* q, const bf16* kp) {
    const U4* k4 = (const U4*)kp; float s0 = 0.f, s1 = 0.f;
#pragma unroll
    for (int i = 0; i < 8; ++i) { const U4 v = k4[i];
        s0 += q[8 * i + 0] * blo(v.x) + q[8 * i + 2] * blo(v.y) + q[8 * i + 4] * blo(v.z) + q[8 * i + 6] * blo(v.w);
        s1 += q[8 * i + 1] * bhi(v.x) + q[8 * i + 3] * bhi(v.y) + q[8 * i + 5] * bhi(v.z) + q[8 * i + 7] * bhi(v.w); }
    return s0 + s1;
}
HD inline float dot64p(const U4* q, const bf16* kp) {
    const U4* k4 = (const U4*)kp; float s0 = 0.f, s1 = 0.f;
#pragma unroll
    for (int i = 0; i < 8; ++i) { const U4 v = k4[i], w = q[i];
        s0 += blo(w.x) * blo(v.x) + blo(w.y) * blo(v.y) + blo(w.z) * blo(v.z) + blo(w.w) * blo(v.w);
        s1 += bhi(w.x) * bhi(v.x) + bhi(w.y) * bhi(v.y) + bhi(w.z) * bhi(v.z) + bhi(w.w) * bhi(v.w); }
    return s0 + s1;
}
HD inline void ld64(const bf16* kp, float* q) {
    const U4* k4 = (const U4*)kp;
#pragma unroll
    for (int i = 0; i < 8; ++i) { const U4 v = k4[i]; q[8 * i] = blo(v.x); q[8 * i + 1] = bhi(v.x); q[8 * i + 2] = blo(v.y); q[8 * i + 3] = bhi(v.y);
        q[8 * i + 4] = blo(v.z); q[8 * i + 5] = bhi(v.z); q[8 * i + 6] = blo(v.w); q[8 * i + 7] = bhi(v.w); }
}
HD inline void axpy64(float* o, float w, const bf16* vp) {
    const U4* k4 = (const U4*)vp;
#pragma unroll
    for (int i = 0; i < 8; ++i) { const U4 v = k4[i]; o[8 * i] += w * blo(v.x); o[8 * i + 1] += w * bhi(v.x); o[8 * i + 2] += w * blo(v.y); o[8 * i + 3] += w * bhi(v.y);
        o[8 * i + 4] += w * blo(v.z); o[8 * i + 5] += w * bhi(v.z); o[8 * i + 6] += w * blo(v.w); o[8 * i + 7] += w * bhi(v.w); }
}
HD inline void axpy64s(float* o, float w, const bf16* vp) {
    const U4* k4 = (const U4*)vp;
#pragma unroll
    for (int i = 0; i < 8; ++i) { const U4 v = k4[i]; o[8 * i] = w * o[8 * i] + blo(v.x); o[8 * i + 1] = w * o[8 * i + 1] + bhi(v.x); o[8 * i + 2] = w * o[8 * i + 2] + blo(v.y); o[8 * i + 3] = w * o[8 * i + 3] + bhi(v.y);
        o[8 * i + 4] = w * o[8 * i + 4] + blo(v.z); o[8 * i + 5] = w * o[8 * i + 5] + bhi(v.z); o[8 * i + 6] = w * o[8 * i + 6] + blo(v.w); o[8 * i + 7] = w * o[8 * i + 7] + bhi(v.w); }
}
HD inline void st64(bf16* op, const float* o) {
    U4* o4 = (U4*)op;
#pragma unroll
    for (int i = 0; i < 8; ++i) { U4 v; v.x = (unsigned)f2bf(o[8 * i]) | ((unsigned)f2bf(o[8 * i + 1]) << 16); v.y = (unsigned)f2bf(o[8 * i + 2]) | ((unsigned)f2bf(o[8 * i + 3]) << 16);
        v.z = (unsigned)f2bf(o[8 * i + 4]) | ((unsigned)f2bf(o[8 * i + 5]) << 16); v.w = (unsigned)f2bf(o[8 * i + 6]) | ((unsigned)f2bf(o[8 * i + 7]) << 16); o4[i] = v; }
}

HD inline void rope_cs(int pos, int i, float& cs, float& sn) {
    double a = (double)pos * exp2(-(double)i * (13.287712379549449 / 32.0));
    a -= 6.283185307179586 * rint(a * 0.15915494309189535);
#ifdef HOST_EMU
    cs = cosf((float)a); sn = sinf((float)a);
#else
    cs = __cosf((float)a); sn = __sinf((float)a);
#endif
}
HD inline int win_dest(int j, int layer, int& which) {
    which = 0;
    if (j < 1280) return j;
    if (j < 1304) return 3840 + 320 + (j - 1280);
    if (j < 1816) { const int cc = j - 1304; return 1280 + 256 * (cc / 128) + cc % 128; }
    if (j < 2328) { const int cc = j - 1816; return 1280 + 256 * (cc / 128) + 128 + cc % 128; }
    if (j < OFF_RWKV) { which = 1; const int gg = j - OFF_GATE, br = gg / DM; return (br == 0 ? 0 : (br == 1 ? 2 * DM : DM)) + gg % DM; }
    const int rr = j - OFF_RWKV;
    if (rr < 1536) return 2304 + rr;
    if (rr < 1824) return 3840 + (rr - 1536);
    if (rr < 1856 && layer == 1) return 3840 + 288 + (rr - 1824);
    return -1;
}
HD inline int glu_dest(int j, int ff) { return j < ff ? 256 * (j / 128) + j % 128 : 256 * ((j - ff) / 128) + 128 + (j - ff) % 128; }

DEV_INLINE void ph_shift(const P& p, int layer, long gtid, long NT) {
    bf16* RW = WSP(bf16, AR_RW); const bf16* HALO = WSP(bf16, AR_HALO);
    const float* mu = layer == 0 ? p.mu_first : p.mu_rest;
    const long n = (long)(T / 256) * LDRW;
    for (long it = gtid; it < n; it += NT) {
        const int pm = (int)(it / LDRW), c = (int)(it % LDRW);
        int mi = -1, act = 0;
        if (c < LBLK) mi = c;
        else { const int w = c - LBLK; if (w < 288) { mi = 1536 + w; act = w < 64 ? 1 : (w >= 128 ? 2 : 0); } else if (w < 320 && layer == 1) mi = 1824 + (w - 288); }
        if (mi < 0) continue;
        const float m = mu[mi];
        float prev = ((pm * 256) % SEQ == 0) ? 0.f : bf2f(HALO[(size_t)(pm - 1) * LDRW + c]);
        bf16* col = RW + (size_t)pm * 256 * LDRW + c;
        for (int r = 0; r < 256; ++r) {
            const float pv = bf2f(col[(size_t)r * LDRW]);
            float u = pv + (prev - pv) * m; prev = pv;
            if (act == 1) u = tanhf(u); else if (act == 2) u = sigmoidf_(u);
            col[(size_t)r * LDRW] = f2bf(u);
        }
    }
}

DEV_INLINE void ph_nsa_prep(const P& p, int layer, long gtid, long NT) {
    bf16* QB = WSP(bf16, AR_QB); bf16* KV = WSP(bf16, AR_KV);
    const long n = (long)T * 12;
    for (long it = gtid; it < n; it += NT) {
        const int t = (int)(it / 12), s = (int)(it % 12), pos = t % SEQ;
        bf16* ptr; const float* g;
        if (s < 8) { ptr = QB + (size_t)t * LDQ + s * 64; g = p.qk_g + (layer * 4 + 0) * 64; }
        else if (s < 10) { ptr = KV + (size_t)t * LDKV + 256 + (s - 8) * 64; g = p.qk_g + (layer * 4 + 2) * 64; }
        else { ptr = KV + (size_t)t * LDKV + 512 + (s - 10) * 64; g = p.qk_g + (layer * 4 + 3) * 64; }
        float v[64]; ld64(ptr, v);
        float ss = 0.f;
#pragma unroll
        for (int i = 0; i < 64; ++i) ss += v[i] * v[i];
        const float rs = 1.f / sqrtf(ss * (1.f / 64.f) + RMS_EPS);
#pragma unroll
        for (int i = 0; i < 64; ++i) v[i] = v[i] * rs * g[i];
#pragma unroll
        for (int i = 0; i < 32; ++i) {
            float cs, sn; rope_cs(pos, i, cs, sn);
            const float x1 = v[i], x2 = v[i + 32]; v[i] = x1 * cs - x2 * sn; v[i + 32] = x2 * cs + x1 * sn;
        }
        st64(ptr, v);
    }
}

DEV_INLINE void ph_vtrans(const P& p, long gtid, long NT) {
    const bf16* KV = WSP(bf16, AR_KV); bf16* VsT = WSP(bf16, WS_VST); bf16* VwT = WSP(bf16, WS_VWT);
    const long n = (long)BATCH * NKV * (SEQ / 8) * 64;
    for (long it = gtid; it < n; it += NT) {
        const int d = (int)(it % 64); long r = it / 64; const int t8 = (int)(r % (SEQ / 8)); const int bg = (int)(r / (SEQ / 8)), b = bg / NKV, g = bg % NKV;
        const bf16* src = KV + (size_t)(b * SEQ + 8 * t8) * LDKV + g * 64 + d;
        U4 s, w; unsigned short sv[8], wv[8];
#pragma unroll
        for (int j = 0; j < 8; ++j) { sv[j] = src[(size_t)j * LDKV + 384]; wv[j] = src[(size_t)j * LDKV + 640]; }
        s.x = sv[0] | ((unsigned)sv[1] << 16); s.y = sv[2] | ((unsigned)sv[3] << 16); s.z = sv[4] | ((unsigned)sv[5] << 16); s.w = sv[6] | ((unsigned)sv[7] << 16);
        w.x = wv[0] | ((unsigned)wv[1] << 16); w.y = wv[2] | ((unsigned)wv[3] << 16); w.z = wv[4] | ((unsigned)wv[5] << 16); w.w = wv[6] | ((unsigned)wv[7] << 16);
        *(U4*)(VsT + ((size_t)bg * 64 + d) * SEQ + 8 * t8) = s; *(U4*)(VwT + ((size_t)bg * 64 + d) * SEQ + 8 * t8) = w;
    }
}
DEV_INLINE void ph_cmp1(const P& p, int layer, long gtid, long NT) {
    const bf16* KV = WSP(bf16, AR_KV); float* HID = WSP(float, AR_HID);
    const long n = (long)BATCH * NKV * NC * 2 * 128;
    for (long it = gtid; it < n; it += NT) {
        const int j = (int)(it % 128); long r = it / 128; const int which = (int)(r % 2); r /= 2; const int i = (int)(r % NC); const int bg = (int)(r / NC), b = bg / NKV, g = bg % NKV;
        const float* w1 = p.cmp_w1 + ((size_t)(layer * 2 + which) * 2048) * 128 + j;
        const float* pe = p.cmp_pos + (size_t)(layer * 2 + which) * 32 * 64;
        float acc = 0.f;
        for (int rr = 0; rr < 32; ++rr) {
            const bf16* src = KV + (size_t)(b * SEQ + 16 * i + rr) * LDKV + which * 128 + g * 64;
            for (int d = 0; d < 64; ++d) acc += (bf2f(src[d]) + pe[rr * 64 + d]) * w1[(size_t)(rr * 64 + d) * 128];
        }
        const float x = acc, gl = 0.5f * x * (1.f + tanhf(0.7978845608028654f * (x + 0.044715f * x * x * x)));
        HID[(((size_t)bg * (SEQ / 16) + i) * 2 + which) * 128 + j] = gl;
    }
}
DEV_INLINE void ph_cmp2(const P& p, int layer, long gtid, long NT) {
    const float* HID = WSP(float, AR_HID);
    const long n = (long)BATCH * NKV * NC * 2;
    for (long it = gtid; it < n; it += NT) {
        const int which = (int)(it % 2); long r = it / 2; const int i = (int)(r % NC); const int bg = (int)(r / NC);
        const float* h = HID + (((size_t)bg * (SEQ / 16) + i) * 2 + which) * 128;
        const float* w2 = p.cmp_w2 + (size_t)(layer * 2 + which) * 128 * 64;
        float o[64];
#pragma unroll
        for (int d = 0; d < 64; ++d) o[d] = 0.f;
        for (int j = 0; j < 128; ++j) { const float hv = h[j];
#pragma unroll
            for (int d = 0; d < 64; ++d) o[d] += hv * w2[j * 64 + d]; }
        if (which == 0) {
            const float* g = p.qk_g + (layer * 4 + 1) * 64; float ss = 0.f;
#pragma unroll
            for (int d = 0; d < 64; ++d) ss += o[d] * o[d];
            const float rs = 1.f / sqrtf(ss * (1.f / 64.f) + RMS_EPS);
#pragma unroll
            for (int d = 0; d < 64; ++d) o[d] = o[d] * rs * g[d];
            const int pos = 16 * i + 31;
#pragma unroll
            for (int d = 0; d < 32; ++d) { float cs, sn; rope_cs(pos, d, cs, sn);
                const float x1 = o[d], x2 = o[d + 32]; o[d] = x1 * cs - x2 * sn; o[d + 32] = x2 * cs + x1 * sn; }
        }
        st64(WSP(bf16, which == 0 ? AR_KC : AR_VC) + ((size_t)bg * (SEQ / 16) + i) * 64, o);
        if (which == 1) { bf16* vt = WSP(bf16, AR_VCT) + (size_t)bg * 64 * (SEQ / 16);
#pragma unroll
            for (int d = 0; d < 64; ++d) { vt[(size_t)d * (SEQ / 16) + i] = f2bf(o[d]); if (i == 0) vt[(size_t)d * (SEQ / 16) + NC] = 0; } }
    }
}

DEV_INLINE void ph_conv(const P& p, int layer, long gtid, long NT) {
    const bf16* UB = WSP(bf16, AR_UB); bf16* CO = WSP(bf16, AR_CO);
    const float* cw = p.conv_w + (size_t)layer * CONV_K * CONV_CH; const float* cv = p.conv_vec + (size_t)layer * 3 * CONV_CH;
    for (long t = gtid; t < T; t += NT) {
        const int pos = (int)(t % SEQ); const int j0 = pos >= 30 ? 0 : 30 - pos;
        float s1 = 0.f, s2 = 0.f;
        for (int pass = 0; pass < 2; ++pass) {
            const float mean = s1 * (1.f / CONV_CH), var = s2 * (1.f / CONV_CH) - mean * mean, rstd = 1.f / sqrtf((var > 0.f ? var : 0.f) + LN_EPS);
            for (int c0 = 0; c0 < CONV_CH; c0 += 8) {
                float a[8];
#pragma unroll
                for (int k = 0; k < 8; ++k) a[k] = cv[c0 + k];
                for (int j = j0; j < CONV_K; ++j) {
                    const U4 v = *(const U4*)(UB + (size_t)(t - 30 + j) * CONV_CH + c0); const float* w = cw + j * CONV_CH + c0;
                    a[0] += blo(v.x) * w[0]; a[1] += bhi(v.x) * w[1]; a[2] += blo(v.y) * w[2]; a[3] += bhi(v.y) * w[3];
                    a[4] += blo(v.z) * w[4]; a[5] += bhi(v.z) * w[5]; a[6] += blo(v.w) * w[6]; a[7] += bhi(v.w) * w[7];
                }
                if (pass == 0) {
#pragma unroll
                    for (int k = 0; k < 8; ++k) { s1 += a[k]; s2 += a[k] * a[k]; }
                } else {
                    float o[8];
#pragma unroll
                    for (int k = 0; k < 8; ++k) { const float y = (a[k] - mean) * rstd * cv[CONV_CH + c0 + k] + cv[2 * CONV_CH + c0 + k]; o[k] = y * sigmoidf_(y); }
                    U4 ov; ov.x = (unsigned)f2bf(o[0]) | ((unsigned)f2bf(o[1]) << 16); ov.y = (unsigned)f2bf(o[2]) | ((unsigned)f2bf(o[3]) << 16);
                    ov.z = (unsigned)f2bf(o[4]) | ((unsigned)f2bf(o[5]) << 16); ov.w = (unsigned)f2bf(o[6]) | ((unsigned)f2bf(o[7]) << 16);
                    *(U4*)(CO + (size_t)t * CONV_CH + c0) = ov;
                }
            }
        }
    }
}

DEV_INLINE void ph_rwkv_b1(const P& p, int layer, long gtid, long NT) {
    bf16* RW = WSP(bf16, AR_RW); bf16* Wm = WSP(bf16, AR_W); bf16* Am = WSP(bf16, AR_A); bf16* Gm = WSP(bf16, AR_G); bf16* VF = WSP(bf16, WS_VF);
    float* INVN = WSP(float, AR_INVN); float* NG = WSP(float, AR_NG);
    const float* vec = p.rwkv_vec + (size_t)layer * 7 * RC;
    const float* wup = p.w_up + (size_t)layer * 64 * RC; const float* aup = p.a_up + (size_t)layer * 64 * RC; const float* gup = p.g_up + (size_t)layer * 160 * RC;
    const long n = (long)T * RC;
    for (long it = gtid; it < n; it += NT) {
        const int t = (int)(it / RC), c = (int)(it % RC);
        bf16* row = RW + (size_t)t * LDRW; const bf16* L = row + LBLK;
        float wl = vec[c], alin = vec[RC + c], g = 0.f;
        for (int j = 0; j < 64; ++j) { wl += bf2f(L[j]) * wup[j * RC + c]; alin += bf2f(L[64 + j]) * aup[j * RC + c]; }
        for (int j = 0; j < 160; ++j) g += bf2f(L[128 + j]) * gup[j * RC + c];
        const float nx = -wl, sp = (nx > 0.f ? nx : 0.f) + log1pf(expf(-fabsf(nx)));
        const float e = expf(-sp - 0.5f);
        Wm[it] = f2bf(-expm1f(-e));
        Am[it] = f2bf(sigmoidf_(alin));
        Gm[it] = f2bf(g);
        float v = bf2f(row[1024 + c]);
        if (layer == 0) VF[it] = row[1024 + c];
        else {
            float vl = p.vres_b[c]; const float* vu = p.vres_up;
            for (int j = 0; j < 32; ++j) vl += bf2f(L[288 + j]) * vu[j * RC + c];
            const float vf = bf2f(VF[it]); v = v + (vf - v) * sigmoidf_(vl); row[1024 + c] = f2bf(v);
        }
        if ((c & 63) == 0) { float ss = 0.f; for (int k = 0; k < 64; ++k) { const float kk = bf2f(row[512 + c + k]) * vec[2 * RC + c + k]; ss += kk * kk; }
            const float nrm = sqrtf(ss); INVN[(size_t)t * 8 + (c >> 6)] = 1.f / (nrm > 1e-12f ? nrm : 1e-12f); }
        if (c < 24) NG[(size_t)t * 24 + c] = sigmoidf_(bf2f(L[320 + c]));
    }
}
DEV_INLINE void ph_rwkv_b2(const P& p, int layer, long gtid, long NT) {
    bf16* RW = WSP(bf16, AR_RW); const bf16* Am = WSP(bf16, AR_A); const float* INVN = WSP(float, AR_INVN);
    const float* vec = p.rwkv_vec + (size_t)layer * 7 * RC;
    const long n = (long)T * RC;
    for (long it = gtid; it < n; it += NT) {
        const int t = (int)(it / RC), c = (int)(it % RC);
        bf16* row = RW + (size_t)t * LDRW;
        const float k = bf2f(row[512 + c]), a = bf2f(Am[it]);
        row[LBLK + c] = f2bf(k * vec[2 * RC + c] * INVN[(size_t)t * 8 + (c >> 6)]);
        row[512 + c] = f2bf(k * (1.f + (a - 1.f) * vec[3 * RC + c]));
    }
}
DEV_INLINE void ph_scan_naive(const P& p, long gtid, long NT) {
    const bf16* RW = WSP(bf16, AR_RW); const bf16* Wm = WSP(bf16, AR_W); const bf16* Am = WSP(bf16, AR_A); bf16* Y = WSP(bf16, AR_UB);
    const long n = (long)BATCH * 8 * 64;
    for (long it = gtid; it < n; it += NT) {
        const int vr = (int)(it % 64), h = (int)((it / 64) % 8), b = (int)(it / 512);
        float s[64];
#pragma unroll
        for (int k = 0; k < 64; ++k) s[k] = 0.f;
        for (int tt = 0; tt < SEQ; ++tt) {
            const size_t t = (size_t)b * SEQ + tt; const bf16* row = RW + t * LDRW;
            float skk = 0.f;
#pragma unroll
            for (int c8 = 0; c8 < 8; ++c8) { const U4 v = *(const U4*)(row + LBLK + h * 64 + c8 * 8);
                skk += s[c8 * 8] * blo(v.x) + s[c8 * 8 + 1] * bhi(v.x) + s[c8 * 8 + 2] * blo(v.y) + s[c8 * 8 + 3] * bhi(v.y) + s[c8 * 8 + 4] * blo(v.z) + s[c8 * 8 + 5] * bhi(v.z) + s[c8 * 8 + 6] * blo(v.w) + s[c8 * 8 + 7] * bhi(v.w); }
            const float vv = bf2f(row[1024 + h * 64 + vr]);
            float y = 0.f;
#pragma unroll
            for (int c8 = 0; c8 < 8; ++c8) {
                const U4 vk = *(const U4*)(row + LBLK + h * 64 + c8 * 8), va = *(const U4*)(Am + t * RC + h * 64 + c8 * 8), vw = *(const U4*)(Wm + t * RC + h * 64 + c8 * 8);
                const U4 vt = *(const U4*)(row + 512 + h * 64 + c8 * 8), vr4 = *(const U4*)(row + h * 64 + c8 * 8);
#define SCAN_EL(j, KK, AA, WW, KT, RR) { float& sj = s[c8 * 8 + j]; sj = sj - sj * (WW) - skk * ((KK) * (AA)) + vv * (KT); y += sj * (RR); }
                SCAN_EL(0, blo(vk.x), blo(va.x), blo(vw.x), blo(vt.x), blo(vr4.x)) SCAN_EL(1, bhi(vk.x), bhi(va.x), bhi(vw.x), bhi(vt.x), bhi(vr4.x))
                SCAN_EL(2, blo(vk.y), blo(va.y), blo(vw.y), blo(vt.y), blo(vr4.y)) SCAN_EL(3, bhi(vk.y), bhi(va.y), bhi(vw.y), bhi(vt.y), bhi(vr4.y))
                SCAN_EL(4, blo(vk.z), blo(va.z), blo(vw.z), blo(vt.z), blo(vr4.z)) SCAN_EL(5, bhi(vk.z), bhi(va.z), bhi(vw.z), bhi(vt.z), bhi(vr4.z))
                SCAN_EL(6, blo(vk.w), blo(va.w), blo(vw.w), blo(vt.w), blo(vr4.w)) SCAN_EL(7, bhi(vk.w), bhi(va.w), bhi(vw.w), bhi(vt.w), bhi(vr4.w))
#undef SCAN_EL
                FENCE();
            }
            Y[t * RC + h * 64 + vr] = f2bf(y);
        }
    }
}
DEV_INLINE void ph_rwkv_post(const P& p, int layer, long gtid, long NT) {
    const bf16* RW = WSP(bf16, AR_RW); const bf16* Y = WSP(bf16, AR_UB); const bf16* Gm = WSP(bf16, AR_G); bf16* YO = WSP(bf16, AR_A);
    const float* vec = p.rwkv_vec + (size_t)layer * 7 * RC;
    const long n = (long)T * RC;
    for (long it = gtid; it < n; it += NT) {
        const int t = (int)(it / RC), c = (int)(it % RC), h0 = c & ~63;
        const bf16* row = RW + (size_t)t * LDRW; const bf16* y = Y + (size_t)t * RC + h0;
        float m = 0.f; for (int k = 0; k < 64; ++k) m += bf2f(y[k]); m *= (1.f / 64.f);
        float vq = 0.f, bon = 0.f;
        for (int k = 0; k < 64; ++k) { const float d = bf2f(y[k]) - m; vq += d * d; bon += bf2f(row[h0 + k]) * bf2f(row[512 + h0 + k]) * vec[4 * RC + h0 + k]; }
        const float yn = (bf2f(y[c - h0]) - m) / sqrtf(vq * (1.f / 64.f) + GN_EPS) * vec[5 * RC + c] + vec[6 * RC + c];
        YO[it] = f2bf((yn + bon * bf2f(row[1024 + c])) * bf2f(Gm[it]));
    }
}

DEV_INLINE void nsa_select_one(const P& p, long item, float* imp) {
    const bf16* QB = WSP(bf16, AR_QB); const bf16* KC = WSP(bf16, AR_KC); int* SEL = WSP(int, AR_SEL);
    const int t = (int)(item % SEQ), bg = (int)(item / SEQ), b = bg / NKV, g = bg % NKV;
    for (int j = 0; j < NS; ++j) imp[j] = 0.f;
    int nv = t >= 31 ? (t - 31) / 16 + 1 : 0; if (nv > NC) nv = NC;
    const bf16* kc = KC + (size_t)bg * (SEQ / 16) * 64;
    for (int hh = 0; hh < HG && nv > 0; ++hh) {
        float q[64]; ld64(QB + (size_t)(b * SEQ + t) * LDQ + (g * HG + hh) * 64, q);
        float m = -1e30f;
        for (int c = 0; c < nv; ++c) { const float s = dot64(q, kc + (size_t)c * 64) * 0.125f; m = s > m ? s : m; }
        float l = 0.f;
        for (int c = 0; c < nv; ++c) l += expf(dot64(q, kc + (size_t)c * 64) * 0.125f - m);
        const float il = 1.f / l;
        for (int c = 0; c < nv; ++c) { const float pc = expf(dot64(q, kc + (size_t)c * 64) * 0.125f - m) * il;
            imp[c >> 2] += pc; if ((c & 3) == 3) imp[(c + 1) >> 2] += pc; }
    }
    const int cur = t / 64;
    for (int j = 0; j < NS; ++j) { const bool forced = (j == 0) || (j == cur) || (j == cur - 1); imp[j] = forced ? 1e4f : (j <= cur ? imp[j] : -1.f); }
    const int nsel = NSEL < NS ? NSEL : NS;
    for (int r = 0; r < nsel; ++r) { int bj = 0; float bv = imp[0]; for (int j = 1; j < NS; ++j) if (imp[j] > bv) { bv = imp[j]; bj = j; }
        SEL[(size_t)item * 8 + r] = bj; imp[bj] = -3e38f; }
}

DEV_INLINE void ph_nsa_attn_naive(const P& p, long gtid, long NT) {
    bf16* QB = WSP(bf16, AR_QB); const bf16* KV = WSP(bf16, AR_KV); const bf16* KC = WSP(bf16, AR_KC); const bf16* VC = WSP(bf16, AR_VC);
    const int* SEL = WSP(int, AR_SEL); const float* NG = WSP(float, AR_NG);
    const long n = (long)BATCH * NHEAD * SEQ;
    for (long it = gtid; it < n; it += NT) {
        const int t = (int)(it % SEQ), hd = (int)((it / SEQ) % NHEAD), b = (int)(it / ((long)SEQ * NHEAD)), g = hd / HG, hh = hd % HG, bg = b * NKV + g;
        const size_t tok = (size_t)b * SEQ + t;
        U4 q[8]; { const U4* qs = (const U4*)(QB + tok * LDQ + hd * 64);
#pragma unroll
            for (int i = 0; i < 8; ++i) q[i] = qs[i]; }
        const float* gt = NG + tok * 24 + g * 12 + hh * 3;
        for (int br = 0; br < 3; ++br) {
            float o[64];
#pragma unroll
            for (int d = 0; d < 64; ++d) o[d] = 0.f;
            float m = -1e30f, l = 0.f;
            if (br == 0) {
                int nv = t >= 31 ? (t - 31) / 16 + 1 : 0; if (nv > NC) nv = NC;
                for (int c = 0; c < nv; ++c) { const size_t r = ((size_t)bg * (SEQ / 16) + c) * 64;
                    const float s = dot64p(q, KC + r) * 0.125f; const float mn = s > m ? s : m, sc = expf(m - mn), pw = expf(s - mn);
#pragma unroll
                    for (int d = 0; d < 64; ++d) o[d] *= sc;
                    axpy64(o, pw, VC + r); l = l * sc + pw; m = mn; }
            } else if (br == 1) {
                const int* sel = SEL + ((size_t)bg * SEQ + t) * 8;
                for (int r8 = 0; r8 < 8; ++r8) { const int j = sel[r8];
                    for (int kk = 0; kk < 64; ++kk) { const int kt = j * 64 + kk; if (kt > t) break;
                        const size_t r = ((size_t)b * SEQ + kt) * LDKV + g * 64;
                        const float s = dot64p(q, KV + r + 256) * 0.125f; const float mn = s > m ? s : m, sc = expf(m - mn), pw = expf(s - mn);
#pragma unroll
                        for (int d = 0; d < 64; ++d) o[d] *= sc;
                        axpy64(o, pw, KV + r + 384); l = l * sc + pw; m = mn; } }
            } else {
                const int k0 = t - (WINDOW - 1) > 0 ? t - (WINDOW - 1) : 0;
                for (int kt = k0; kt <= t; ++kt) { const size_t r = ((size_t)b * SEQ + kt) * LDKV + g * 64;
                    const float s = dot64p(q, KV + r + 512) * 0.125f; const float mn = s > m ? s : m, sc = expf(m - mn), pw = expf(s - mn);
#pragma unroll
                    for (int d = 0; d < 64; ++d) o[d] *= sc;
                    axpy64(o, pw, KV + r + 640); l = l * sc + pw; m = mn; }
            }
            const float w = l > 0.f ? gt[br] / l : 0.f;
            FENCE();
            if (br == 0) {
#pragma unroll
                for (int d = 0; d < 64; ++d) o[d] *= w;
            } else axpy64s(o, w, QB + tok * LDQ + hd * 64);
            st64(QB + tok * LDQ + hd * 64, o);
            FENCE();
        }
    }
}
namespace pg8 {
#define PG8_LAS __attribute__((address_space(3)))
typedef unsigned short bf16_t;
typedef short bf16x8 __attribute__((ext_vector_type(8)));
typedef float f32x4 __attribute__((ext_vector_type(4)));
typedef unsigned u32x4 __attribute__((ext_vector_type(4)));
constexpr int BM = 256, BK = 64, HALF = 128, HTB = HALF * BK * 2  , STAGE_BYTES = 8 * HTB, NXCD = 8, WGM = 8;

__host__ __device__ __forceinline__ int lds_byte(int r, int c) { const int st = (r >> 4) * 2 + (c >> 5), rr = r & 15, cc = c & 31, ob = rr * 64 + cc * 2; return st * 1024 + (ob ^ (((ob >> 9) & 1) << 5)); }
__host__ __device__ __forceinline__ void stage_rc(int b, int& R, int& C) { const int st = b / 1024, sb = b % 1024, swz = sb ^ (((sb >> 9) & 1) << 5); R = (st >> 1) * 16 + swz / 64; C = (st & 1) * 32 + (swz % 64) / 2; }
__host__ __device__ __forceinline__ int perm32(int rho) { const int n = rho >> 4, i = rho & 15; return 8 * (i >> 2) + 4 * n + (i & 3); }

struct Unit { int pm, pn; };
struct Gemm { const bf16_t* A; const bf16_t* Bt; int M, N, K; };

struct StaticOrder {
    int nM, nN, nwg, G, c;
    __host__ __device__ void init(int M, int N, int G_, int c_) { nM = M / BM; nN = N / BM; nwg = nM * nN; G = G_; c = c_; }
    __host__ __device__ bool next(int i, Unit& u) const {
        const long L = (long)i * G + c; if (L >= nwg) return false;
        int wgid = (int)L; { const int q = nwg / NXCD, r = nwg % NXCD, xcd = wgid % NXCD, off = wgid / NXCD; wgid = (xcd < r ? xcd * (q + 1) : r * (q + 1) + (xcd - r) * q) + off; }
        const int nig = WGM * nN, gid = wgid / nig, fm = gid * WGM, gsz = (nM - fm) < WGM ? (nM - fm) : WGM;
        u.pm = fm + ((wgid % nig) % gsz); u.pn = (wgid % nig) / gsz; return true;
    }
    __device__ __forceinline__ void a_ready(const Unit&) const {}
    __device__ __forceinline__ void done(const Unit&) const {}
};

__device__ __forceinline__ unsigned cvt_pk_bf16(float lo, float hi) { unsigned r; asm volatile("v_cvt_pk_bf16_f32 %0, %1, %2" : "=v"(r) : "v"(lo), "v"(hi)); return r; }
typedef float f32x2 __attribute__((ext_vector_type(2)));
template <class Epi, class Sched, bool ALIGN_EPI = false, bool SP2 = false>
__device__ __forceinline__ void gemm_phase(PG8_LAS unsigned char* lds, const Gemm g, const Sched& S, const Epi& E) {
    int tid_ = threadIdx.x; asm volatile("" : "+v"(tid_));
    const int tid = tid_, wid = __builtin_amdgcn_readfirstlane(tid >> 6), lane = tid & 63, wr = wid >> 2, wc = wid & 3, fr = lane & 15, fq = lane >> 4;
    const int K = g.K, nt = K / BK;
    unsigned voffA[2], voffB[2];
#pragma unroll
    for (int i = 0; i < 2; ++i) { int R, C; stage_rc(tid * 16 + i * 8192, R, C); const int Rb = Epi::PERM ? ((R & ~31) + perm32(R & 31)) : R;
        voffA[i] = (unsigned)(R * K + C) * 2u; voffB[i] = (unsigned)(Rb * K + C) * 2u; }
    const size_t kstep = (size_t)(BK * 2);
    const size_t hstep = (size_t)HALF * K * 2;
    const size_t tstep = 2 * hstep;
    const unsigned ldsw = (unsigned)wid * 1024u;
    const int aoff = lds_byte(wr * 64 + fr, fq * 8), boff = lds_byte(wc * 32 + fr, fq * 8);
#define PG8_SA(b, h) (((b) * 2 + (h)) * HTB)
#define PG8_SB(b, h) ((4 + (b) * 2 + (h)) * HTB)
#define PG8_STAGE(bufoff, gbase, voff) do { _Pragma("unroll") for (int _i = 0; _i < 2; ++_i) \
        __builtin_amdgcn_global_load_lds((const unsigned*)((const char*)(gbase) + (voff)[_i]), (PG8_LAS unsigned*)(lds + (bufoff) + ldsw + _i * 8192), 16, 0, 0); } while (0)
#define PG8_LDA(dst, b, h) do { _Pragma("unroll") for (int m = 0; m < 4; ++m) _Pragma("unroll") for (int k = 0; k < 2; ++k) dst[m][k] = *(const PG8_LAS bf16x8*)(lds + PG8_SA(b, h) + aoff + m * 2048 + k * 1024); } while (0)
#define PG8_LDB(dst, b, h) do { _Pragma("unroll") for (int n = 0; n < 2; ++n) _Pragma("unroll") for (int k = 0; k < 2; ++k) dst[n][k] = *(const PG8_LAS bf16x8*)(lds + PG8_SB(b, h) + boff + n * 2048 + k * 1024); } while (0)
#define PG8_MMA(ai, bj, At, Bt) do { __builtin_amdgcn_s_setprio(1); _Pragma("unroll") for (int m = 0; m < 4; ++m) _Pragma("unroll") for (int n = 0; n < 2; ++n) _Pragma("unroll") for (int k = 0; k < 2; ++k) \
        acc[ai][bj][m][n] = __builtin_amdgcn_mfma_f32_16x16x32_bf16(Bt[n][k], At[m][k], acc[ai][bj][m][n], 0, 0, 0); __builtin_amdgcn_s_setprio(0); } while (0)
#define PG8_WAIT_V(n) asm volatile("s_waitcnt vmcnt(" #n ")" ::: "memory")
#define PG8_WAIT_L(n) asm volatile("s_waitcnt lgkmcnt(" #n ")" ::: "memory")
#define PG8_BAR __builtin_amdgcn_s_barrier()
#define PG8_SCHED __builtin_amdgcn_sched_barrier(0)
    Unit cur, nxt; int ui = 0;
    if (!S.next(0, cur)) return;
    f32x4 acc[2][2][4][2];
#pragma unroll
    for (int a = 0; a < 2; ++a)
#pragma unroll
        for (int b = 0; b < 2; ++b)
#pragma unroll
            for (int m = 0; m < 4; ++m)
#pragma unroll
                for (int n = 0; n < 2; ++n) acc[a][b][m][n] = (f32x4){0.f, 0.f, 0.f, 0.f};
    bf16x8 At[4][2], B0[2][2], B1[2][2];
    const char* cA = (const char*)g.A + (size_t)cur.pm * tstep; const char* cB = (const char*)g.Bt + (size_t)cur.pn * tstep;
    S.a_ready(cur);
    if constexpr (SP2) {
        PG8_STAGE(PG8_SB(0, 0), cB, voffB); PG8_STAGE(PG8_SB(0, 1), cB + hstep, voffB); PG8_STAGE(PG8_SA(0, 0), cA, voffA); PG8_STAGE(PG8_SA(0, 1), cA + hstep, voffA);
        if (wr == 1) PG8_BAR;
        PG8_WAIT_V(2); PG8_BAR;
        PG8_STAGE(PG8_SB(1, 0), cB + kstep, voffB); PG8_STAGE(PG8_SA(1, 0), cA + kstep, voffA); PG8_STAGE(PG8_SB(1, 1), cB + hstep + kstep, voffB);
        PG8_WAIT_V(6); PG8_BAR;
    } else {
        PG8_STAGE(PG8_SB(0, 0), cB, voffB); PG8_STAGE(PG8_SA(0, 0), cA, voffA); PG8_STAGE(PG8_SB(0, 1), cB + hstep, voffB); PG8_STAGE(PG8_SA(0, 1), cA + hstep, voffA);
        if (wr == 1) PG8_BAR;
        PG8_WAIT_V(4); PG8_BAR;
        PG8_STAGE(PG8_SB(1, 0), cB + kstep, voffB); PG8_STAGE(PG8_SA(1, 0), cA + kstep, voffA); PG8_STAGE(PG8_SB(1, 1), cB + hstep + kstep, voffB);
        PG8_WAIT_V(6); PG8_BAR;
    }
    for (;;) {
        const bool has_next = S.next(ui + 1, nxt);
        const char* nA = has_next ? (const char*)g.A + (size_t)nxt.pm * tstep : cA; const char* nB = has_next ? (const char*)g.Bt + (size_t)nxt.pn * tstep : cB;
        for (int t = 0; t < nt; t += 2) {
            const bool last = (t == nt - 2);
            const char* a1 = cA + (size_t)(t + 1) * kstep;
            const char* a2 = last ? nA : cA + (size_t)(t + 2) * kstep; const char* b2 = last ? nB : cB + (size_t)(t + 2) * kstep;
            const char* a3 = a2 + kstep; const char* b3 = b2 + kstep;
            if (last && has_next) S.a_ready(nxt);
            if constexpr (SP2) {
            PG8_LDB(B0, 0, 0); PG8_LDB(B1, 0, 1); PG8_SCHED; PG8_LDA(At, 0, 0); PG8_STAGE(PG8_SA(1, 1), a1 + hstep, voffA);
            PG8_WAIT_V(8); PG8_WAIT_L(0); PG8_BAR; PG8_MMA(0, 0, At, B0); PG8_MMA(0, 1, At, B1); PG8_BAR; PG8_SCHED;
            PG8_LDA(At, 0, 1); PG8_STAGE(PG8_SB(0, 0), b2, voffB); PG8_STAGE(PG8_SB(0, 1), b2 + hstep, voffB); PG8_STAGE(PG8_SA(0, 0), a2, voffA);
            PG8_WAIT_V(8); PG8_WAIT_L(0); PG8_BAR; PG8_MMA(1, 0, At, B0); PG8_MMA(1, 1, At, B1); PG8_BAR; PG8_SCHED;
            PG8_LDB(B0, 1, 0); PG8_LDB(B1, 1, 1); PG8_SCHED; PG8_LDA(At, 1, 0); PG8_STAGE(PG8_SA(0, 1), a2 + hstep, voffA);
            PG8_WAIT_V(8); PG8_WAIT_L(0); PG8_BAR; PG8_MMA(0, 0, At, B0); PG8_MMA(0, 1, At, B1); PG8_BAR; PG8_SCHED;
            PG8_LDA(At, 1, 1); PG8_STAGE(PG8_SB(1, 0), b3, voffB); PG8_STAGE(PG8_SB(1, 1), b3 + hstep, voffB); PG8_STAGE(PG8_SA(1, 0), a3, voffA);
            PG8_WAIT_V(8); PG8_WAIT_L(0); PG8_BAR; PG8_MMA(1, 0, At, B0); PG8_MMA(1, 1, At, B1); PG8_BAR; PG8_SCHED;
            } else {
            PG8_LDB(B0, 0, 0); PG8_SCHED; PG8_LDA(At, 0, 0); PG8_STAGE(PG8_SA(1, 1), a1 + hstep, voffA);
            PG8_WAIT_L(8); PG8_BAR; PG8_WAIT_L(0); PG8_MMA(0, 0, At, B0); PG8_BAR; PG8_SCHED;
            PG8_LDB(B1, 0, 1); PG8_STAGE(PG8_SB(0, 0), b2, voffB);
            PG8_BAR; PG8_WAIT_L(0); PG8_MMA(0, 1, At, B1); PG8_BAR;
            PG8_LDA(At, 0, 1); PG8_STAGE(PG8_SA(0, 0), a2, voffA);
            PG8_BAR; PG8_WAIT_L(0); PG8_MMA(1, 0, At, B0); PG8_BAR; PG8_SCHED;
            PG8_STAGE(PG8_SB(0, 1), b2 + hstep, voffB);
            PG8_WAIT_V(6); PG8_BAR; PG8_MMA(1, 1, At, B1); PG8_BAR;
            PG8_LDB(B0, 1, 0); PG8_SCHED; PG8_LDA(At, 1, 0); PG8_STAGE(PG8_SA(0, 1), a2 + hstep, voffA);
            PG8_WAIT_L(8); PG8_BAR; PG8_WAIT_L(0); PG8_MMA(0, 0, At, B0); PG8_BAR; PG8_SCHED;
            PG8_LDB(B1, 1, 1); PG8_STAGE(PG8_SB(1, 0), b3, voffB);
            PG8_BAR; PG8_WAIT_L(0); PG8_MMA(0, 1, At, B1); PG8_BAR;
            PG8_LDA(At, 1, 1); PG8_STAGE(PG8_SA(1, 0), a3, voffA);
            PG8_BAR; PG8_WAIT_L(0); PG8_MMA(1, 0, At, B0); PG8_BAR; PG8_SCHED;
            PG8_STAGE(PG8_SB(1, 1), b3 + hstep, voffB);
            PG8_WAIT_V(6); PG8_BAR; PG8_MMA(1, 1, At, B1); PG8_BAR;
            }
        }
        if constexpr (ALIGN_EPI) { if (wr == 0) PG8_BAR; }
        if constexpr (!Epi::AFTER_DRAIN) { E(acc, cur, wr, wc, fr, fq); S.done(cur); }
        if (!has_next) break;
#pragma unroll
        for (int a = 0; a < 2; ++a)
#pragma unroll
            for (int b = 0; b < 2; ++b)
#pragma unroll
                for (int m = 0; m < 4; ++m)
#pragma unroll
                    for (int n = 0; n < 2; ++n) acc[a][b][m][n] = (f32x4){0.f, 0.f, 0.f, 0.f};
        cur = nxt; cA = nA; cB = nB; ++ui;
        if constexpr (ALIGN_EPI) { if (wr == 1) PG8_BAR; }
    }
    PG8_WAIT_V(0);
    if constexpr (!ALIGN_EPI) { if (wr == 0) PG8_BAR; }
    PG8_BAR;
    if constexpr (Epi::AFTER_DRAIN) { E.fused(acc, cur, wr, wc, fr, fq, lds, wid, lane); S.done(cur); }
#undef PG8_SA
#undef PG8_SB
#undef PG8_STAGE
#undef PG8_LDA
#undef PG8_LDB
#undef PG8_MMA
#undef PG8_WAIT_V
#undef PG8_WAIT_L
#undef PG8_BAR
#undef PG8_SCHED
}
}

#define LAS __attribute__((address_space(3)))
#define XB_TMO      128
#define XB_XCNT(j)  (256  + 64 * (j))
#define XB_XSUB(j)  (1280 + 64 * (j))
#define XB_XGEN(j)  (2304 + 64 * (j))
#define XB_TOP      3328
#define XB_TOPGEN   3392
#define XCD_BAR_WORDS 3456
#define XB_SPIN_CAP (1u << 22)

__device__ __forceinline__ unsigned xb_ld(unsigned* p)              { return __hip_atomic_load(p, __ATOMIC_RELAXED, __HIP_MEMORY_SCOPE_AGENT); }
__device__ __forceinline__ unsigned xb_add(unsigned* p, unsigned v) { return __hip_atomic_fetch_add(p, v, __ATOMIC_RELAXED, __HIP_MEMORY_SCOPE_AGENT); }
__device__ __forceinline__ unsigned xb_xcc_id() { return (unsigned)__builtin_amdgcn_s_getreg((3 << 11) | 20) & 0xFu; }
#define XB_SPIN(cond, bar) do { unsigned _sp = 0; while (cond) { __builtin_amdgcn_s_sleep(1); \
    if ((++_sp & 255u) == 0u) { if (xb_ld(&(bar)[XB_TMO])) break; if (_sp > XB_SPIN_CAP) { atomicAdd(&(bar)[XB_TMO], 1u); break; } } } } while (0)

struct XcdBarrier {
    unsigned* bar; unsigned x;
    volatile LAS unsigned* st;
};

__device__ __forceinline__ XcdBarrier xcd_barrier_post(unsigned* bar, volatile LAS unsigned* st) {
    XcdBarrier b; b.bar = bar; b.x = xb_xcc_id(); b.st = st;
    if (threadIdx.x == 0) (void)xb_add(&bar[XB_XCNT(b.x)], 1u);
    return b;
}
__device__ __forceinline__ void xcd_barrier_complete(unsigned* bar, unsigned x, unsigned& nloc, unsigned& nx) {
    const unsigned G = gridDim.x * gridDim.y * gridDim.z;
    unsigned sum, cnt, mine, sp = 0u;
    for (;;) {
        sum = 0u; cnt = 0u; mine = 0u;
#pragma unroll
        for (unsigned j = 0; j < 16; ++j) { const unsigned c = xb_ld(&bar[XB_XCNT(j)]); sum += c; cnt += (c > 0u) ? 1u : 0u; mine = (j == x) ? c : mine; }
        if (sum == G) break;
        __builtin_amdgcn_s_sleep(1);
        if ((++sp & 255u) == 0u) { if (xb_ld(&bar[XB_TMO])) break; if (sp > XB_SPIN_CAP) { atomicAdd(&bar[XB_TMO], 1u); break; } }
    }
    nloc = mine > 0u ? mine : 1u; nx = cnt > 0u ? cnt : 1u;
}

__device__ __forceinline__ void xcd_barrier(const XcdBarrier& b) {
    asm volatile("s_waitcnt vmcnt(0)" ::: "memory");
    __syncthreads();
    if (threadIdx.x == 0) {
        unsigned* bar = b.bar; asm volatile("" : "+s"(bar));
        __builtin_amdgcn_s_waitcnt(0);
        unsigned nloc = b.st[0], nx = b.st[1];
        if (nloc == 0u) { xcd_barrier_complete(bar, b.x, nloc, nx); b.st[0] = nloc; b.st[1] = nx; }
        const unsigned old = xb_add(&bar[XB_XSUB(b.x)], 1u);
        const unsigned gen = old / nloc;
        if (old + 1u == (gen + 1u) * nloc) {
            __builtin_amdgcn_fence(__ATOMIC_RELEASE, "agent");
            asm volatile("s_waitcnt vmcnt(0)" ::: "memory");
            const unsigned og = xb_add(&bar[XB_TOP], 1u);
            const unsigned tg = og / nx;
            if (og + 1u == (tg + 1u) * nx) xb_add(&bar[XB_TOPGEN], 1u);
            else XB_SPIN(xb_ld(&bar[XB_TOPGEN]) == tg, bar);
            __builtin_amdgcn_fence(__ATOMIC_ACQUIRE, "agent");
            xb_add(&bar[XB_XGEN(b.x)], 1u);
            asm volatile("s_waitcnt vmcnt(0)" ::: "memory");
        } else {
            XB_SPIN(xb_ld(&bar[XB_XGEN(b.x)]) == gen, bar);
            __builtin_amdgcn_fence(__ATOMIC_ACQUIRE, "agent");
            asm volatile("s_waitcnt vmcnt(0)" ::: "memory");
        }
    }
    __syncthreads();
}
#define GAS __attribute__((address_space(1)))
typedef unsigned v4u __attribute__((ext_vector_type(4)));
typedef unsigned v2u __attribute__((ext_vector_type(2)));
typedef GAS unsigned gu32;
#define RLX_AGENT __ATOMIC_RELAXED, __HIP_MEMORY_SCOPE_AGENT
#define LDS_WAIT() asm volatile("s_waitcnt lgkmcnt(0)" ::: "memory")
#define VM_WAIT() asm volatile("s_waitcnt vmcnt(0)" ::: "memory")
using pg8::f32x4; using pg8::Unit; using pg8::Gemm; using pg8::BM; using pg8::HALF; using pg8::cvt_pk_bf16; using pg8::u32x4;

constexpr int NWAVES = 8, NTHREADS = 512;
constexpr int RING_BYTES = 131072, LDSCTL_OFF = 147456 - 1024, MISC_OFF = LDSCTL_OFF + 320, LDS_BYTES = 147456;

__device__ __forceinline__ float wave_sum(float v, int lane) {
#pragma unroll
    for (int o = 1; o < 64; o <<= 1) v += __builtin_bit_cast(float, __builtin_amdgcn_ds_bpermute((lane ^ o) << 2, __builtin_bit_cast(int, v)));
    return v;
}
__device__ __forceinline__ float fsig(float x) { return __builtin_amdgcn_rcpf(1.f + __expf(-x)); }

__device__ __forceinline__ int rfl(int v) { return __builtin_amdgcn_readfirstlane(v); }
struct SOrder {
    pg8::StaticOrder s;
    __device__ void init(int M, int N, int G, int c) { s.init(M, N, G, c); }
    __device__ bool next(int i, Unit& u) const { Unit t; t.pm = 0; t.pn = 0; const bool ok = s.next(i, t); u.pm = rfl(t.pm); u.pn = rfl(t.pn); return ok; }
    __device__ __forceinline__ void a_ready(const Unit&) const {}
    __device__ __forceinline__ void done(const Unit&) const {}
};
struct StackOrder {
    int nM, nN, nb, G, c;
    __device__ bool next(int i, Unit& u) const { const long L = (long)i * G + c; if (L >= (long)nb * nM * nN) return false;
        const int br = (int)(L / (nM * nN)), rem = (int)(L % (nM * nN)); u.pm = rfl(br * nM + rem / nN); u.pn = rfl(br * nN + rem % nN); return true; }
    __device__ __forceinline__ void a_ready(const Unit&) const {}
    __device__ __forceinline__ void done(const Unit&) const {}
};
struct GateOrder {
    int nM, nN, G, c;
    __device__ bool next(int i, Unit& u) const { const int j = i / 3, br = i - 3 * j; const long L = (long)j * G + c; if (L >= (long)nM * nN) return false;
        u.pm = rfl((int)(L / nN)); u.pn = rfl(br * nN + (int)(L % nN)); return true; }
    __device__ __forceinline__ void a_ready(const Unit&) const {}
    __device__ __forceinline__ void done(const Unit&) const {}
};
struct MoeOrder {
    int nN, G, c, e0, e1, e2, e3, e4, e5, e6, e7;
    __device__ void init(const unsigned* cnt, int nN_, int G_, int c_) { nN = nN_; G = G_; c = c_;
        int s = 0; s += (cnt[0] + 255) >> 8; e0 = s; s += (cnt[1] + 255) >> 8; e1 = s; s += (cnt[2] + 255) >> 8; e2 = s; s += (cnt[3] + 255) >> 8; e3 = s;
        s += (cnt[4] + 255) >> 8; e4 = s; s += (cnt[5] + 255) >> 8; e5 = s; s += (cnt[6] + 255) >> 8; e6 = s; s += (cnt[7] + 255) >> 8; e7 = s; }
    __device__ bool next(int i, Unit& u) const { const long L = (long)i * G + c; if (L >= (long)e7 * nN) return false;
        const int pm = (int)(L / nN), pl = (int)(L % nN);
        const int e = (pm >= e0) + (pm >= e1) + (pm >= e2) + (pm >= e3) + (pm >= e4) + (pm >= e5) + (pm >= e6);
        u.pm = rfl(pm); u.pn = rfl(e * nN + pl); return true; }
    __device__ __forceinline__ void a_ready(const Unit&) const {}
    __device__ __forceinline__ void done(const Unit&) const {}
};

__device__ __forceinline__ u32x4 pack8(f32x4 v0, f32x4 v1) { u32x4 w; w.x = cvt_pk_bf16(v0[0], v0[1]); w.y = cvt_pk_bf16(v0[2], v0[3]); w.z = cvt_pk_bf16(v1[0], v1[1]); w.w = cvt_pk_bf16(v1[2], v1[3]); return w; }
__device__ __forceinline__ void unpack8(u32x4 w, f32x4& v0, f32x4& v1) {
    v0 = (f32x4){blo(w.x), bhi(w.x), blo(w.y), bhi(w.y)}; v1 = (f32x4){blo(w.z), bhi(w.z), blo(w.w), bhi(w.w)}; }

struct EpiProj {
    static constexpr bool PERM = true, AFTER_DRAIN = false;
    bf16 *QB, *KV, *UB, *RW, *HALO;
    __device__ __forceinline__ void operator()(const f32x4 (&acc)[2][2][4][2], const Unit& u, int wr, int wc, int fr, int fq) const {
        const int row0 = u.pm * BM + wr * 64 + fr, cl = wc * 32 + 8 * fq;
        if (u.pn >= 5 && u.pn < 9) {
#pragma unroll
            for (int ai = 0; ai < 2; ++ai)
#pragma unroll
                for (int m = 0; m < 4; ++m) { f32x4 a0 = acc[ai][0][m][0], a1 = acc[ai][0][m][1]; const f32x4 b0 = acc[ai][1][m][0], b1 = acc[ai][1][m][1];
#pragma unroll
                    for (int k = 0; k < 4; ++k) { a0[k] *= fsig(b0[k]); a1[k] *= fsig(b1[k]); }
                    *(u32x4*)(UB + (size_t)(row0 + ai * HALF + m * 16) * 512 + (u.pn - 5) * 128 + cl) = pack8(a0, a1); }
            return;
        }
        bf16* base; int ld, c0;
        if (u.pn < 2) { base = QB; ld = LDQ; c0 = u.pn * 256; } else if (u.pn < 5) { base = KV; ld = LDKV; c0 = (u.pn - 2) * 256; } else { base = RW; ld = LDRW; c0 = (u.pn - 9) * 256; }
#pragma unroll
        for (int ai = 0; ai < 2; ++ai)
#pragma unroll
            for (int m = 0; m < 4; ++m)
#pragma unroll
                for (int bj = 0; bj < 2; ++bj) { const u32x4 w = pack8(acc[ai][bj][m][0], acc[ai][bj][m][1]);
                    *(u32x4*)(base + (size_t)(row0 + ai * HALF + m * 16) * ld + c0 + bj * HALF + cl) = w;
                    if (u.pn >= 9 && ai == 1 && m == 3 && wr == 1 && fr == 15) *(u32x4*)(HALO + (size_t)u.pm * LDRW + c0 + bj * HALF + cl) = w; }
    }
};
struct EpiStore {
    static constexpr bool PERM = true, AFTER_DRAIN = false;
    bf16* O; int ld, ntn;
    __device__ __forceinline__ void operator()(const f32x4 (&acc)[2][2][4][2], const Unit& u, int wr, int wc, int fr, int fq) const {
        const int row0 = u.pm * BM + wr * 64 + fr, c0 = (u.pn % ntn) * 256 + wc * 32 + 8 * fq;
#pragma unroll
        for (int ai = 0; ai < 2; ++ai)
#pragma unroll
            for (int m = 0; m < 4; ++m)
#pragma unroll
                for (int bj = 0; bj < 2; ++bj) *(u32x4*)(O + (size_t)(row0 + ai * HALF + m * 16) * ld + c0 + bj * HALF) = pack8(acc[ai][bj][m][0], acc[ai][bj][m][1]);
    }
};
struct EpiGate {
    static constexpr bool PERM = true, AFTER_DRAIN = false;
    const bf16* OB; bf16* MIX; int ntn;
    __device__ __forceinline__ void operator()(const f32x4 (&acc)[2][2][4][2], const Unit& u, int wr, int wc, int fr, int fq) const {
        const int br = u.pn / ntn, row0 = u.pm * BM + wr * 64 + fr, c0 = (u.pn % ntn) * 256 + wc * 32 + 8 * fq;
        const bf16* ob = OB + (size_t)br * T * DM;
#pragma unroll
        for (int ai = 0; ai < 2; ++ai)
#pragma unroll
            for (int m = 0; m < 4; ++m)
#pragma unroll
                for (int bj = 0; bj < 2; ++bj) { const size_t off = (size_t)(row0 + ai * HALF + m * 16) * DM + c0 + bj * HALF;
                    f32x4 o0, o1; unpack8(*(const u32x4*)(ob + off), o0, o1);
                    f32x4 g0 = acc[ai][bj][m][0], g1 = acc[ai][bj][m][1];
#pragma unroll
                    for (int k = 0; k < 4; ++k) { g0[k] = fsig(g0[k]) * o0[k]; g1[k] = fsig(g1[k]) * o1[k]; }
                    if (br != 0) { f32x4 p0, p1; unpack8(*(const u32x4*)(MIX + off), p0, p1); g0 += p0; g1 += p1; }
                    *(u32x4*)(MIX + off) = pack8(g0, g1); }
    }
};
struct EpiResid {
    static constexpr bool PERM = true, AFTER_DRAIN = false;
    const float* base; float* out;
    __device__ __forceinline__ void operator()(const f32x4 (&acc)[2][2][4][2], const Unit& u, int wr, int wc, int fr, int fq) const {
        const int row0 = u.pm * BM + wr * 64 + fr, c0 = u.pn * 256 + wc * 32 + 8 * fq;
#pragma unroll
        for (int ai = 0; ai < 2; ++ai)
#pragma unroll
            for (int m = 0; m < 4; ++m)
#pragma unroll
                for (int bj = 0; bj < 2; ++bj) { const size_t off = (size_t)(row0 + ai * HALF + m * 16) * DM + c0 + bj * HALF;
                    const f32x4 x0 = *(const f32x4*)(base + off), x1 = *(const f32x4*)(base + off + 4);
                    *(f32x4*)(out + off) = x0 + acc[ai][bj][m][0]; *(f32x4*)(out + off + 4) = x1 + acc[ai][bj][m][1]; }
    }
};
struct EpiSwiglu {
    static constexpr bool PERM = true, AFTER_DRAIN = false;
    bf16* ACT; int ld, ntn;
    __device__ __forceinline__ void operator()(const f32x4 (&acc)[2][2][4][2], const Unit& u, int wr, int wc, int fr, int fq) const {
        const int row0 = u.pm * BM + wr * 64 + fr, c0 = (u.pn % ntn) * 128 + wc * 32 + 8 * fq;
#pragma unroll
        for (int ai = 0; ai < 2; ++ai)
#pragma unroll
            for (int m = 0; m < 4; ++m) { f32x4 g0 = acc[ai][0][m][0], g1 = acc[ai][0][m][1]; const f32x4 u0 = acc[ai][1][m][0], u1 = acc[ai][1][m][1];
#pragma unroll
                for (int k = 0; k < 4; ++k) { g0[k] = g0[k] * fsig(g0[k]) * u0[k]; g1[k] = g1[k] * fsig(g1[k]) * u1[k]; }
                *(u32x4*)(ACT + (size_t)(row0 + ai * HALF + m * 16) * ld + c0) = pack8(g0, g1); }
    }
};
struct EpiMoeDown {
    static constexpr bool PERM = true, AFTER_DRAIN = false;
    float* out; const int* rtok; const float* rw; int ntn;
    __device__ __forceinline__ void operator()(const f32x4 (&acc)[2][2][4][2], const Unit& u, int wr, int wc, int fr, int fq) const {
        const int row0 = u.pm * BM + wr * 64 + fr, c0 = (u.pn % ntn) * 256 + wc * 32 + 8 * fq;
#pragma unroll
        for (int ai = 0; ai < 2; ++ai)
#pragma unroll
            for (int m = 0; m < 4; ++m) { const int row = row0 + ai * HALF + m * 16; const int tok = rtok[row]; const float w = rw[row];
                if (tok >= 0) {
#pragma unroll
                    for (int bj = 0; bj < 2; ++bj) { float* o = out + (size_t)tok * DM + c0 + bj * HALF;
                        const f32x4 x0 = *(const f32x4*)o, x1 = *(const f32x4*)(o + 4);
                        *(f32x4*)o = x0 + acc[ai][bj][m][0] * w; *(f32x4*)(o + 4) = x1 + acc[ai][bj][m][1] * w; } } }
    }
};

typedef short bf16x8_t __attribute__((ext_vector_type(8)));
#define MFMA16(a, b, c) __builtin_amdgcn_mfma_f32_16x16x32_bf16((a), (b), (c), 0, 0, 0)
constexpr float ATT_C = 0.125f * 1.4426950408889634f;
constexpr int AW_IMP = 0, AW_SEL = 8448, AW_QS = 8960, AW_BYTES = 8960 + 8192;
__device__ __forceinline__ float bperm_f(float v, int srclane) { return __builtin_bit_cast(float, __builtin_amdgcn_ds_bpermute(srclane << 2, __builtin_bit_cast(int, v))); }
__device__ __forceinline__ int bperm_i(int v, int srclane) { return __builtin_amdgcn_ds_bpermute(srclane << 2, v); }
__device__ __forceinline__ bf16x8_t ldg8(const bf16* p) { return *(const bf16x8_t*)p; }
__device__ __forceinline__ bf16x8_t pack_p(const f32x4& a, const f32x4& b) {
    v4u w; w.x = cvt_pk_bf16(a[0], a[1]); w.y = cvt_pk_bf16(a[2], a[3]); w.z = cvt_pk_bf16(b[0], b[1]); w.w = cvt_pk_bf16(b[2], b[3]); return __builtin_bit_cast(bf16x8_t, w); }

__device__ __forceinline__ void nsa_attn_item(const P& p, int item, int lane, LAS unsigned char* wl) {
    const bf16* KV = WSP(bf16, AR_KV); const bf16* KC = WSP(bf16, AR_KC); const bf16* VcT = WSP(bf16, AR_VCT); const bf16* VsT = WSP(bf16, WS_VST); const bf16* VwT = WSP(bf16, WS_VWT);
    bf16* QB = WSP(bf16, AR_QB); const float* NG = WSP(float, AR_NG);
    const int bg = item / (SEQ / 16), t0 = (item % (SEQ / 16)) * 16, b = bg >> 1, g = bg & 1;
    const int col = lane & 15, fq = lane >> 4, tok = t0 + col;
    const size_t grow = (size_t)b * SEQ + tok;
    LAS float* IMP = (LAS float*)(wl + AW_IMP); LAS int* SEL = (LAS int*)(wl + AW_SEL); LAS bf16* OS = (LAS bf16*)(wl + AW_IMP);
    const int krowA = 8 * (col >> 2) + (col & 3);
    const float* gate = NG + grow * 24 + g * 12;
    LAS bf16x8_t* QS = (LAS bf16x8_t*)(wl + AW_QS) + lane;
#pragma unroll
    for (int hh = 0; hh < 4; ++hh)
#pragma unroll
        for (int ks = 0; ks < 2; ++ks) QS[(hh * 2 + ks) * 64] = ldg8(QB + grow * LDQ + (g * 4 + hh) * 64 + ks * 32 + fq * 8);
#define Qc(hh, ks) (QS[((hh) * 2 + (ks)) * 64])
    for (int i = lane; i < 16 * 132; i += 64) IMP[i] = 0.f;
    const f32x4 z4 = {0.f, 0.f, 0.f, 0.f};
    f32x4 O[4][4];
    int nvmax = (t0 + 15 >= 31) ? (((t0 + 15 - 31) >> 4) + 1) : 0; if (nvmax > NC) nvmax = NC;
    const int nch = (nvmax + 31) >> 5;
    const bf16* kcb = KC + (size_t)bg * 512 * 64; const bf16* vcb = VcT + (size_t)bg * 64 * 512;
    float linv[4] = {0.f, 0.f, 0.f, 0.f};
#pragma unroll
    for (int hh = 0; hh < 4; ++hh)
#pragma unroll
        for (int mt = 0; mt < 4; ++mt) O[hh][mt] = z4;
#pragma unroll 1
    for (int pass = 0; pass < 2; ++pass) {
#pragma unroll 1
        for (int ch = 0; ch < nch; ++ch) {
            asm volatile("" ::: "memory");
            const int k0 = 32 * ch;
            bf16x8_t ka[2][2];
#pragma unroll
            for (int tl = 0; tl < 2; ++tl)
#pragma unroll
                for (int ks = 0; ks < 2; ++ks) ka[tl][ks] = ldg8(kcb + (size_t)(k0 + krowA + 4 * tl) * 64 + ks * 32 + fq * 8);
            bf16x8_t va[4];
            if (pass == 1) {
#pragma unroll
                for (int mt = 0; mt < 4; ++mt) va[mt] = ldg8(vcb + (size_t)(16 * mt + col) * 512 + k0 + 8 * fq);
            }
            float ps[8] = {0.f, 0.f, 0.f, 0.f, 0.f, 0.f, 0.f, 0.f};
#pragma unroll
            for (int hh = 0; hh < 4; ++hh) {
                const bf16x8_t q0_ = Qc(hh, 0), q1_ = Qc(hh, 1);
                f32x4 sa = MFMA16(ka[0][0], q0_, z4); sa = MFMA16(ka[0][1], q1_, sa);
                f32x4 sb = MFMA16(ka[1][0], q0_, z4); sb = MFMA16(ka[1][1], q1_, sb);
#pragma unroll
                for (int i = 0; i < 4; ++i) { const int c = k0 + 8 * fq + i;
                    sa[i] = (16 * c + 31 <= tok) ? __builtin_amdgcn_exp2f(sa[i] * ATT_C) : 0.f; sb[i] = (16 * (c + 4) + 31 <= tok) ? __builtin_amdgcn_exp2f(sb[i] * ATT_C) : 0.f; }
                if (pass == 0) { linv[hh] += (sa[0] + sa[1]) + (sa[2] + sa[3]) + (sb[0] + sb[1]) + (sb[2] + sb[3]); }
                else {
                    sa = sa * linv[hh]; sb = sb * linv[hh];
#pragma unroll
                    for (int i = 0; i < 4; ++i) { ps[i] += sa[i]; ps[4 + i] += sb[i]; }
                    const bf16x8_t pt = pack_p(sa, sb);
#pragma unroll
                    for (int mt = 0; mt < 4; ++mt) O[hh][mt] = MFMA16(va[mt], pt, O[hh][mt]);
                }
            }
            if (pass == 1) {
                const int G0 = 8 * ch + 2 * fq; LAS float* ir = IMP + col * 132 + G0;
                __hip_atomic_fetch_add(ir, (ps[0] + ps[1]) + (ps[2] + ps[3]), __ATOMIC_RELAXED, __HIP_MEMORY_SCOPE_WORKGROUP);
                __hip_atomic_fetch_add(ir + 1, ps[3] + ((ps[4] + ps[5]) + (ps[6] + ps[7])), __ATOMIC_RELAXED, __HIP_MEMORY_SCOPE_WORKGROUP);
                if (G0 + 2 < NS) __hip_atomic_fetch_add(ir + 2, ps[7], __ATOMIC_RELAXED, __HIP_MEMORY_SCOPE_WORKGROUP);
            }
        }
        if (pass == 0) {
#pragma unroll
            for (int hh = 0; hh < 4; ++hh) { float l = linv[hh]; l += bperm_f(l, lane ^ 16); l += bperm_f(l, lane ^ 32); linv[hh] = l > 0.f ? 1.f / l : 0.f; }
        }
    }
    LDS_WAIT(); asm volatile("" ::: "memory");
    {
        const int cur = tok >> 6; LAS float* sc = IMP + col * 132;
        for (int j = fq * 32; j < fq * 32 + 32; ++j) { const bool forced = (j == 0) || (j == cur) || (j == cur - 1); const float v = sc[j]; sc[j] = forced ? 1e4f : (j <= cur ? v : -1.f); }
        LDS_WAIT(); asm volatile("" ::: "memory");
#pragma unroll 1
        for (int r = 0; r < 8; ++r) {
            float bv = sc[fq * 32]; int bj = fq * 32;
            for (int j = fq * 32 + 1; j < fq * 32 + 32; ++j) { const float v = sc[j]; if (v > bv) { bv = v; bj = j; } }
#pragma unroll
            for (int o = 16; o <= 32; o <<= 1) { const float ov = bperm_f(bv, lane ^ o); const int oj = bperm_i(bj, lane ^ o); if (ov > bv || (ov == bv && oj < bj)) { bv = ov; bj = oj; } }
            if ((bj >> 5) == fq) sc[bj] = -3e38f;
            if (fq == 0) SEL[col * 8 + r] = bj;
            LDS_WAIT(); asm volatile("" ::: "memory");
        }
    }
#pragma unroll
    for (int hh = 0; hh < 4; ++hh) { const float g0 = gate[hh * 3 + 0];
#pragma unroll
        for (int mt = 0; mt < 4; ++mt) { const f32x4 o = O[hh][mt] * g0; v2u w; w.x = cvt_pk_bf16(o[0], o[1]); w.y = cvt_pk_bf16(o[2], o[3]);
            *(LAS v2u*)(OS + (col * 4 + hh) * 64 + 16 * mt + 4 * fq) = w; } }
    LDS_WAIT(); asm volatile("" ::: "memory");
    {
        const bf16* ksb = KV + (size_t)b * SEQ * LDKV + 256 + g * 64; const bf16* vsb = VsT + (size_t)bg * 64 * SEQ;
#pragma unroll 1
        for (int tt = 0; tt < 16; ++tt) {
            const int tq = t0 + tt; const size_t qrow = (size_t)b * SEQ + tq;
            bf16x8_t Qh[2];
#pragma unroll
            for (int ks = 0; ks < 2; ++ks) { Qh[ks] = ldg8(QB + qrow * LDQ + (g * 4 + (col & 3)) * 64 + ks * 32 + fq * 8); if (col >= 4) Qh[ks] = (bf16x8_t){0, 0, 0, 0, 0, 0, 0, 0}; }
            f32x4 Os[4] = {z4, z4, z4, z4}; float ls = 0.f;
#pragma unroll 1
            for (int r8 = 0; r8 < 8; ++r8) {
                const int j = __builtin_amdgcn_readfirstlane(SEL[tt * 8 + r8]);
                if (64 * j > tq) continue;
#pragma unroll
                for (int hf = 0; hf < 2; ++hf) {
                    const int k0 = 64 * j + 32 * hf;
                    bf16x8_t ka[2][2], va[4];
#pragma unroll
                    for (int tl = 0; tl < 2; ++tl)
#pragma unroll
                        for (int ks = 0; ks < 2; ++ks) ka[tl][ks] = ldg8(ksb + (size_t)(k0 + krowA + 4 * tl) * LDKV + ks * 32 + fq * 8);
#pragma unroll
                    for (int mt = 0; mt < 4; ++mt) va[mt] = ldg8(vsb + (size_t)(16 * mt + col) * SEQ + k0 + 8 * fq);
                    f32x4 sa = MFMA16(ka[0][0], Qh[0], z4); sa = MFMA16(ka[0][1], Qh[1], sa);
                    f32x4 sb = MFMA16(ka[1][0], Qh[0], z4); sb = MFMA16(ka[1][1], Qh[1], sb);
#pragma unroll
                    for (int i = 0; i < 4; ++i) { const int kt = k0 + 8 * fq + i;
                        sa[i] = (kt <= tq) ? __builtin_amdgcn_exp2f(sa[i] * ATT_C) : 0.f; sb[i] = (kt + 4 <= tq) ? __builtin_amdgcn_exp2f(sb[i] * ATT_C) : 0.f; }
                    ls += (sa[0] + sa[1]) + (sa[2] + sa[3]) + (sb[0] + sb[1]) + (sb[2] + sb[3]);
                    const bf16x8_t pt = pack_p(sa, sb);
#pragma unroll
                    for (int mt = 0; mt < 4; ++mt) Os[mt] = MFMA16(va[mt], pt, Os[mt]);
                }
            }
            ls += bperm_f(ls, lane ^ 16); ls += bperm_f(ls, lane ^ 32);
            if (col < 4) {
                const float w = ls > 0.f ? (NG + qrow * 24 + g * 12)[col * 3 + 1] / ls : 0.f;
#pragma unroll
                for (int mt = 0; mt < 4; ++mt) { LAS v2u* dp = (LAS v2u*)(OS + (tt * 4 + col) * 64 + 16 * mt + 4 * fq); const v2u old = *dp;
                    v2u w2; w2.x = cvt_pk_bf16(blo(old.x) + w * Os[mt][0], bhi(old.x) + w * Os[mt][1]); w2.y = cvt_pk_bf16(blo(old.y) + w * Os[mt][2], bhi(old.y) + w * Os[mt][3]); *dp = w2; }
            }
        }
    }
    LDS_WAIT(); asm volatile("" ::: "memory");
    {
        const bf16* kwb = KV + (size_t)b * SEQ * LDKV + 512 + g * 64; const bf16* vwb = VwT + (size_t)bg * 64 * SEQ;
        float lw[4] = {0.f, 0.f, 0.f, 0.f};
#pragma unroll
        for (int hh = 0; hh < 4; ++hh)
#pragma unroll
            for (int mt = 0; mt < 4; ++mt) O[hh][mt] = z4;
        int kst = t0 - (WINDOW - 1); if (kst < 0) kst = 0; kst &= ~31;
#pragma unroll 1
        for (int k0 = kst; k0 <= t0 + 15; k0 += 32) {
            asm volatile("" ::: "memory");
            bf16x8_t ka[2][2], va[4];
#pragma unroll
            for (int tl = 0; tl < 2; ++tl)
#pragma unroll
                for (int ks = 0; ks < 2; ++ks) ka[tl][ks] = ldg8(kwb + (size_t)(k0 + krowA + 4 * tl) * LDKV + ks * 32 + fq * 8);
#pragma unroll
            for (int mt = 0; mt < 4; ++mt) va[mt] = ldg8(vwb + (size_t)(16 * mt + col) * SEQ + k0 + 8 * fq);
#pragma unroll
            for (int hh = 0; hh < 4; ++hh) {
                const bf16x8_t q0_ = Qc(hh, 0), q1_ = Qc(hh, 1);
                f32x4 sa = MFMA16(ka[0][0], q0_, z4); sa = MFMA16(ka[0][1], q1_, sa);
                f32x4 sb = MFMA16(ka[1][0], q0_, z4); sb = MFMA16(ka[1][1], q1_, sb);
#pragma unroll
                for (int i = 0; i < 4; ++i) { const int kt = k0 + 8 * fq + i;
                    sa[i] = (kt <= tok && kt + WINDOW > tok) ? __builtin_amdgcn_exp2f(sa[i] * ATT_C) : 0.f; sb[i] = (kt + 4 <= tok && kt + 4 + WINDOW > tok) ? __builtin_amdgcn_exp2f(sb[i] * ATT_C) : 0.f; }
                lw[hh] += (sa[0] + sa[1]) + (sa[2] + sa[3]) + (sb[0] + sb[1]) + (sb[2] + sb[3]);
                const bf16x8_t pt = pack_p(sa, sb);
#pragma unroll
                for (int mt = 0; mt < 4; ++mt) O[hh][mt] = MFMA16(va[mt], pt, O[hh][mt]);
            }
        }
#pragma unroll
        for (int hh = 0; hh < 4; ++hh) { float l = lw[hh]; l += bperm_f(l, lane ^ 16); l += bperm_f(l, lane ^ 32); const float w = l > 0.f ? gate[hh * 3 + 2] / l : 0.f;
#pragma unroll
            for (int mt = 0; mt < 4; ++mt) { const v2u old = *(LAS v2u*)(OS + (col * 4 + hh) * 64 + 16 * mt + 4 * fq);
                v2u w2; w2.x = cvt_pk_bf16(blo(old.x) + w * O[hh][mt][0], bhi(old.x) + w * O[hh][mt][1]); w2.y = cvt_pk_bf16(blo(old.y) + w * O[hh][mt][2], bhi(old.y) + w * O[hh][mt][3]);
                *(v2u*)(QB + grow * LDQ + (g * 4 + hh) * 64 + 16 * mt + 4 * fq) = w2; } }
    }
    LDS_WAIT(); asm volatile("" ::: "memory");
#undef Qc
}

constexpr int SC_STEPS = 8, SC_BUF = 6 * 1024;
__device__ __forceinline__ float dpp_sum16(float v) {
    v += __builtin_bit_cast(float, __builtin_amdgcn_update_dpp(0, __builtin_bit_cast(int, v), 0xB1, 0xF, 0xF, true));
    v += __builtin_bit_cast(float, __builtin_amdgcn_update_dpp(0, __builtin_bit_cast(int, v), 0x4E, 0xF, 0xF, true));
    v += __builtin_bit_cast(float, __builtin_amdgcn_update_dpp(0, __builtin_bit_cast(int, v), 0x141, 0xF, 0xF, true));
    v += __builtin_bit_cast(float, __builtin_amdgcn_update_dpp(0, __builtin_bit_cast(int, v), 0x140, 0xF, 0xF, true));
    return v;
}
__device__ __forceinline__ void scan_fill(const bf16* RW, const bf16* Wm, const bf16* Am, size_t trow, int h, int lane, LAS unsigned char* buf) {
    const size_t t = trow + (lane >> 3); const int sub = (lane & 7) * 8;
    const bf16* row = RW + t * LDRW + h * 64 + sub;
    __builtin_amdgcn_global_load_lds((const unsigned*)(row + LBLK), (LAS unsigned*)(buf + 0 * 1024), 16, 0, 0);
    __builtin_amdgcn_global_load_lds((const unsigned*)(Am + t * RC + h * 64 + sub), (LAS unsigned*)(buf + 1 * 1024), 16, 0, 0);
    __builtin_amdgcn_global_load_lds((const unsigned*)(Wm + t * RC + h * 64 + sub), (LAS unsigned*)(buf + 2 * 1024), 16, 0, 0);
    __builtin_amdgcn_global_load_lds((const unsigned*)(row + 512), (LAS unsigned*)(buf + 3 * 1024), 16, 0, 0);
    __builtin_amdgcn_global_load_lds((const unsigned*)(row), (LAS unsigned*)(buf + 4 * 1024), 16, 0, 0);
    __builtin_amdgcn_global_load_lds((const unsigned*)(row + 1024), (LAS unsigned*)(buf + 5 * 1024), 16, 0, 0);
}
__device__ __forceinline__ void scan_unit(const P& p, int unit, int lane, LAS unsigned char* wl) {
    const bf16* RW = WSP(bf16, AR_RW); const bf16* Wm = WSP(bf16, AR_W); const bf16* Am = WSP(bf16, AR_A); bf16* Y = WSP(bf16, AR_UB);
    const int rg = unit & 15, h = (unit >> 4) & 7, b = unit >> 7, row = rg * 4 + (lane >> 4), kq = lane & 15;
    const size_t tb = (size_t)b * SEQ;
    float s0 = 0.f, s1 = 0.f, s2 = 0.f, s3 = 0.f;
    scan_fill(RW, Wm, Am, tb, h, lane, wl);
#pragma unroll 1
    for (int c = 0; c < SEQ / SC_STEPS; ++c) {
        LAS unsigned char* buf = wl + (c & 1) * SC_BUF;
        asm volatile("s_waitcnt vmcnt(0) lgkmcnt(0)" ::: "memory");
        if (c + 1 < SEQ / SC_STEPS) scan_fill(RW, Wm, Am, tb + (size_t)(c + 1) * SC_STEPS, h, lane, wl + ((c + 1) & 1) * SC_BUF);
#pragma unroll
        for (int st = 0; st < SC_STEPS; ++st) {
            const LAS unsigned char* o = buf + st * 128 + kq * 8;
            const v2u kk = *(const LAS v2u*)(o), aa = *(const LAS v2u*)(o + 1024), ee = *(const LAS v2u*)(o + 2048), kt = *(const LAS v2u*)(o + 3072), rr = *(const LAS v2u*)(o + 4096);
            const float vv = bf2f(*(const LAS bf16*)(buf + 5 * 1024 + st * 128 + row * 2));
            const float k0 = blo(kk.x), k1 = bhi(kk.x), k2 = blo(kk.y), k3 = bhi(kk.y);
            const float skk = dpp_sum16((s0 * k0 + s1 * k1) + (s2 * k2 + s3 * k3));
            s0 = s0 - s0 * blo(ee.x) - skk * (k0 * blo(aa.x)) + vv * blo(kt.x);
            s1 = s1 - s1 * bhi(ee.x) - skk * (k1 * bhi(aa.x)) + vv * bhi(kt.x);
            s2 = s2 - s2 * blo(ee.y) - skk * (k2 * blo(aa.y)) + vv * blo(kt.y);
            s3 = s3 - s3 * bhi(ee.y) - skk * (k3 * bhi(aa.y)) + vv * bhi(kt.y);
            const float y = dpp_sum16((s0 * blo(rr.x) + s1 * bhi(rr.x)) + (s2 * blo(rr.y) + s3 * bhi(rr.y)));
            if (kq == 0) Y[(tb + (size_t)c * SC_STEPS + st) * RC + h * 64 + row] = f2bf(y);
        }
    }
    asm volatile("s_waitcnt vmcnt(0) lgkmcnt(0)" ::: "memory");
}

struct MapPlain { bf16* base; int K; __device__ __forceinline__ bf16* operator()(int col) const { return base + (size_t)col * K; } };
struct MapGlu { bf16* base; int K, ff; __device__ __forceinline__ bf16* operator()(int col) const { return base + (size_t)glu_dest(col, ff) * K; } };
struct MapWin { unsigned char* wl; int layer; __device__ __forceinline__ bf16* operator()(int col) const { int which; const int r = win_dest(col, layer, which); const size_t off = (which ? OFF_WG : OFF_WIN) + (size_t)(r < 0 ? 0 : r) * DM * 2; return r < 0 ? nullptr : (bf16*)(wl + off); } };
template <class Map>
__device__ __forceinline__ void transpose_item(const float* W, int K, int N, const Map& mp, LAS float* scr, int item, int lane) {
    const int nblk = (N + 31) / 32, kb = item / nblk, nb = item % nblk, k0 = 64 * kb, n0 = 32 * nb;
    const int col = n0 + (lane & 31);
#pragma unroll 8
    for (int i = 0; i < 32; ++i) { const int kk = 2 * i + (lane >> 5); scr[kk * 33 + (lane & 31)] = col < N ? W[(size_t)(k0 + kk) * N + col] : 0.f; }
    LDS_WAIT(); asm volatile("" ::: "memory");
    const int c = lane & 7;
#pragma unroll
    for (int j = 0; j < 4; ++j) { const int n = (lane >> 3) + 8 * j; const LAS float* s = scr + (8 * c) * 33 + n;
        v4u o; o.x = (unsigned)f2bf(s[0]) | ((unsigned)f2bf(s[33]) << 16); o.y = (unsigned)f2bf(s[66]) | ((unsigned)f2bf(s[99]) << 16);
        o.z = (unsigned)f2bf(s[132]) | ((unsigned)f2bf(s[165]) << 16); o.w = (unsigned)f2bf(s[198]) | ((unsigned)f2bf(s[231]) << 16);
        if (n0 + n < N) { bf16* d = mp(n0 + n); if (d) *(v4u*)(d + k0 + 8 * c) = o; } }
    LDS_WAIT(); asm volatile("" ::: "memory");
}
template <class Map>
__device__ __forceinline__ bool conv_job(int& r, const float* W, int K, int N, const Map& mp, LAS float* scr, int lane) {
    const int items = (K / 64) * ((N + 31) / 32);
    if (r < items) { transpose_item(W, K, N, mp, scr, r, lane); return true; }
    r -= items; return false;
}

__device__ __forceinline__ void rms_row(const P& p, const float* xrow, const float* g, bf16* orow, int lane, bool route, int t) {
    const f32x4* xr = (const f32x4*)xrow + lane; const f32x4* gr = (const f32x4*)g + lane;
    f32x4 v[DM / 256]; float ss = 0.f;
#pragma unroll
    for (int j = 0; j < DM / 256; ++j) { v[j] = xr[64 * j]; ss += (v[j].x * v[j].x + v[j].y * v[j].y) + (v[j].z * v[j].z + v[j].w * v[j].w); }
    const float rs = 1.f / sqrtf(wave_sum(ss, lane) * (1.f / DM) + RMS_EPS);
    v2u* o8 = (v2u*)orow + lane;
#pragma unroll
    for (int j = 0; j < DM / 256; ++j) { const f32x4 gg = gr[64 * j]; v[j].x *= rs * gg.x; v[j].y *= rs * gg.y; v[j].z *= rs * gg.z; v[j].w *= rs * gg.w;
        v2u w; w.x = cvt_pk_bf16(v[j].x, v[j].y); w.y = cvt_pk_bf16(v[j].z, v[j].w); o8[64 * j] = w; }
    if (route) {
        float lg[NEXP];
#pragma unroll
        for (int e = 0; e < NEXP; ++e) lg[e] = 0.f;
#pragma unroll
        for (int j = 0; j < DM / 256; ++j) { const float* rw = p.router_w + (size_t)(4 * (lane + 64 * j)) * NEXP;
#pragma unroll
            for (int e = 0; e < NEXP; ++e) lg[e] += v[j].x * rw[e] + v[j].y * rw[NEXP + e] + v[j].z * rw[2 * NEXP + e] + v[j].w * rw[3 * NEXP + e]; }
#pragma unroll
        for (int e = 0; e < NEXP; ++e) lg[e] = wave_sum(lg[e], lane) + p.router_b[e];
        int e0 = 0; float l0 = lg[0];
#pragma unroll
        for (int e = 1; e < NEXP; ++e) if (lg[e] > l0) { l0 = lg[e]; e0 = e; }
        int e1 = -1; float l1 = -3e38f;
#pragma unroll
        for (int e = 0; e < NEXP; ++e) if (e != e0 && lg[e] > l1) { l1 = lg[e]; e1 = e; }
        if (lane == 0) { const float w0 = 1.f / (1.f + expf(l1 - l0));
            WSP(int, AR_RTE)[t] = e0 | (e1 << 8); float* rw = WSP(float, AR_RTW) + (size_t)t * 2; rw[0] = w0; rw[1] = 1.f - w0;
            unsigned* ctl = WSP(unsigned, WS_CTL); atomicAdd(ctl + CW_CNT + e0, 1u); atomicAdd(ctl + CW_CNT + 8 + e1, 1u); }
    }
}
__device__ __forceinline__ void copy_row_wave(const bf16* src, bf16* dst, int lane) {
#pragma unroll
    for (int j = 0; j < DM / 512; ++j) ((v4u*)dst)[lane + 64 * j] = ((const v4u*)src)[lane + 64 * j];
}
__device__ __forceinline__ int moe_seg_start(const unsigned* cnt, int e) { int s = 0;
#pragma unroll
    for (int k = 0; k < NEXP; ++k) s += (k < e) ? (int)((cnt[k] + 255u) & ~255u) : 0;
    return s; }

#ifndef PHMASK
#define PHMASK 0xFFFFFFFFu
#endif
#define PHM(k) (((PHMASK) >> (k)) & 1u)
constexpr int NPH = 16, NPHASES = 1 + 2 * NPH;
struct Args { const float* in[29]; float* out; unsigned char* ws; int ph_lo, ph_hi; };

__device__ __forceinline__ bool in_phase(int k, int lo, int hi) { asm volatile("" : "+s"(lo), "+s"(hi)); return lo <= k && k < hi; }
typedef const Args __attribute__((address_space(4)))* CArgsP;
__device__ __forceinline__ void fill_params_k(P& p, CArgsP a) {
    p.x = a->in[0]; p.mix_norm_g = a->in[1]; p.w_in_first = a->in[2]; p.w_in_rest = a->in[3]; p.mu_first = a->in[4]; p.mu_rest = a->in[5]; p.qk_g = a->in[6]; p.cmp_pos = a->in[7];
    p.cmp_w1 = a->in[8]; p.cmp_w2 = a->in[9]; p.nsa_w_o = a->in[10]; p.conv_w = a->in[11]; p.conv_vec = a->in[12]; p.conv_w_o = a->in[13]; p.rwkv_vec = a->in[14]; p.w_up = a->in[15];
    p.a_up = a->in[16]; p.g_up = a->in[17]; p.vres_up = a->in[18]; p.vres_b = a->in[19]; p.rwkv_w_o = a->in[20]; p.w_out = a->in[21]; p.ffn_norm_g = a->in[22]; p.dense_gu = a->in[23];
    p.dense_down = a->in[24]; p.router_w = a->in[25]; p.router_b = a->in[26]; p.moe_gu = a->in[27]; p.moe_down = a->in[28]; p.out = a->out; p.ws = a->ws;
}
__global__ void __launch_bounds__(NTHREADS, 2) mk_fwd(Args args) {
    extern __shared__ __attribute__((aligned(16))) unsigned char lds_raw[];
    LAS unsigned char* lds = (LAS unsigned char*)lds_raw;
    const int tid = threadIdx.x, lane = tid & 63, wave = __builtin_amdgcn_readfirstlane(tid >> 6);
    const int G = gridDim.x, bid = blockIdx.x;
    unsigned* ctl = (unsigned*)(args.ws + WS_CTL);
    for (int u = tid; u < (LDS_BYTES - LDSCTL_OFF) / 4; u += NTHREADS) ((LAS unsigned*)(lds + LDSCTL_OFF))[u] = 0u;
    __syncthreads();
    const int lo = args.ph_lo, hi = args.ph_hi;
    XcdBarrier bar; bar.bar = ctl + CW_BAR; bar.x = 0; bar.st = nullptr;
    if (hi - lo > 1) bar = xcd_barrier_post(ctl + CW_BAR, (volatile LAS unsigned*)(lds + MISC_OFF) + 8);
#define IN(k) in_phase((k), lo, hi)
#define MKP CArgsP ap_ = (CArgsP)__builtin_amdgcn_kernarg_segment_ptr(); asm volatile("" : "+s"(ap_)); P p; fill_params_k(p, ap_); int tid = threadIdx.x; asm volatile("" : "+v"(tid)); const int lane = tid & 63, wave = __builtin_amdgcn_readfirstlane(tid >> 6); int G = gridDim.x, bid = blockIdx.x; asm volatile("" : "+s"(G), "+s"(bid)); unsigned* ctl = WSP(unsigned, WS_CTL); const long gtid = (long)bid * NTHREADS + tid, NT = (long)G * NTHREADS; const int gw = bid * NWAVES + wave, NGW = G * NWAVES; LAS float* scrw = (LAS float*)(lds + wave * 16384); (void)gtid; (void)NT; (void)gw; (void)NGW; (void)scrw; (void)lane; (void)ctl
#define SEAM(k) do { if ((k) + 1 < hi) xcd_barrier(bar); } while (0)

    if (PHM(16) && IN(0)) { MKP;
        constexpr int IT_WIN0 = (DM / 64) * ((N_IN_FIRST + 31) / 32), IT_WIN1 = (DM / 64) * ((N_IN_REST + 31) / 32), IT_WO = (512 / 64) * (DM / 32), IT_WOUT = (DM / 64) * (DM / 32);
        constexpr int total = IT_WIN0 + IT_WIN1 + 6 * IT_WO + 2 * IT_WOUT + (DM / 64) * (2 * DENSE_FF / 32) + (DENSE_FF / 64) * (DM / 32);
        bf16* wl0 = WSP(bf16, WS_W); bf16* wl1 = WSP(bf16, WS_W + SZ_LAYERW);
#define WOFF(b, o) ((bf16*)((unsigned char*)(b) + (o)))
        for (int it = gw; it < total; it += NGW) {
            int r = it;
            if (conv_job(r, p.w_in_first, DM, N_IN_FIRST, MapWin{(unsigned char*)wl0, 0}, scrw, lane)) continue;
            if (conv_job(r, p.w_in_rest, DM, N_IN_REST, MapWin{(unsigned char*)wl1, 1}, scrw, lane)) continue;
            if (conv_job(r, p.nsa_w_o, 512, DM, MapPlain{WOFF(wl0, OFF_WO3), 512}, scrw, lane)) continue;
            if (conv_job(r, p.rwkv_w_o, 512, DM, MapPlain{WOFF(wl0, OFF_WO3) + (size_t)DM * 512, 512}, scrw, lane)) continue;
            if (conv_job(r, p.conv_w_o, 512, DM, MapPlain{WOFF(wl0, OFF_WO3) + (size_t)2 * DM * 512, 512}, scrw, lane)) continue;
            if (conv_job(r, p.nsa_w_o + (size_t)512 * DM, 512, DM, MapPlain{WOFF(wl1, OFF_WO3), 512}, scrw, lane)) continue;
            if (conv_job(r, p.rwkv_w_o + (size_t)512 * DM, 512, DM, MapPlain{WOFF(wl1, OFF_WO3) + (size_t)DM * 512, 512}, scrw, lane)) continue;
            if (conv_job(r, p.conv_w_o + (size_t)512 * DM, 512, DM, MapPlain{WOFF(wl1, OFF_WO3) + (size_t)2 * DM * 512, 512}, scrw, lane)) continue;
            if (conv_job(r, p.w_out, DM, DM, MapPlain{WOFF(wl0, OFF_WOUT), DM}, scrw, lane)) continue;
            if (conv_job(r, p.w_out + (size_t)DM * DM, DM, DM, MapPlain{WOFF(wl1, OFF_WOUT), DM}, scrw, lane)) continue;
            if (conv_job(r, p.dense_gu, DM, 2 * DENSE_FF, MapGlu{WSP(bf16, WS_DGU), DM, DENSE_FF}, scrw, lane)) continue;
            conv_job(r, p.dense_down, DENSE_FF, DM, MapPlain{WSP(bf16, WS_DDN), DENSE_FF}, scrw, lane);
        }
        SEAM(0);
    }

    for (int layer = 0; layer < 2; ++layer) {
        const int pb = 1 + layer * NPH;
        if (PHM(0) && IN(pb + 0)) { MKP;
            const float* xin = layer == 0 ? p.x : p.out;
            for (int m = gw; m < T; m += NGW) rms_row(p, xin + (size_t)m * DM, p.mix_norm_g + (size_t)layer * DM, WSP(bf16, WS_H) + (size_t)m * DM, lane, false, m);
            SEAM(pb + 0);
        }
        if (PHM(1) && IN(pb + 1)) { MKP;
            Gemm g{WSP(bf16, WS_H), (const bf16*)(p.ws + WS_W + (size_t)layer * SZ_LAYERW + OFF_WIN), T, NPROJ, DM}; SOrder S; S.init(T, NPROJ, G, bid);
            EpiProj E{WSP(bf16, AR_QB), WSP(bf16, AR_KV), WSP(bf16, AR_UB), WSP(bf16, AR_RW), WSP(bf16, AR_HALO)};
            pg8::gemm_phase<EpiProj, SOrder, true, true>(lds, g, S, E);
            SEAM(pb + 1);
        }
        if (PHM(2) && IN(pb + 2)) { MKP;
#ifndef D_SHIFT
 ph_shift(p, layer, gtid, NT);
#endif
#ifndef D_PREP
 ph_nsa_prep(p, layer, gtid, NT);
#endif
#ifndef D_CMP1
 ph_cmp1(p, layer, gtid, NT);
#endif
#ifndef D_CONV
 ph_conv(p, layer, gtid, NT);
#endif
 ph_vtrans(p, gtid, NT);
 SEAM(pb + 2); }
        if (PHM(3) && IN(pb + 3)) { MKP;
#ifndef D_B1
 ph_rwkv_b1(p, layer, gtid, NT);
#endif
#ifndef D_CMP2
 ph_cmp2(p, layer, gtid, NT);
#endif
 SEAM(pb + 3); }
        if (PHM(4) && IN(pb + 4)) { MKP;
            ph_rwkv_b2(p, layer, gtid, NT);
            SEAM(pb + 4);
        }
        if (PHM(5) && IN(pb + 5)) { MKP;
            { LAS unsigned char* wl = lds + wave * AW_BYTES; constexpr int NSC = BATCH * 8 * 16, NIT = BATCH * NKV * (SEQ / 16);
              for (;;) { int it = 0; if (lane == 0) it = (int)atomicAdd(ctl + CW_ATT + layer, 1u); it = __builtin_amdgcn_readfirstlane(it); if (it >= NSC + NIT) break;
                  if (it < NSC) { scan_unit(p, it, lane, wl); continue; }
                  it -= NSC; const int bg = it % (BATCH * NKV), t16 = (SEQ / 16 - 1) - it / (BATCH * NKV);
                  nsa_attn_item(p, bg * (SEQ / 16) + t16, lane, wl); } }
 SEAM(pb + 5); }
        if (PHM(6) && IN(pb + 6)) { MKP; ph_rwkv_post(p, layer, gtid, NT); SEAM(pb + 6); }
        if (PHM(7) && IN(pb + 7)) { MKP;
            Gemm g{WSP(bf16, AR_QB), (const bf16*)(p.ws + WS_W + (size_t)layer * SZ_LAYERW + OFF_WO3), 3 * T, 3 * DM, 512}; StackOrder S{T / 256, DM / 256, 3, G, bid};
            EpiStore E{WSP(bf16, AR_OBUF), DM, DM / 256};
            pg8::gemm_phase<EpiStore, StackOrder, true, true>(lds, g, S, E);
            { const float* xin = layer == 0 ? p.x : p.out;
              for (int m = gw; m < T; m += NGW) rms_row(p, xin + (size_t)m * DM, p.mix_norm_g + (size_t)layer * DM, WSP(bf16, WS_H) + (size_t)m * DM, lane, false, m); }
            SEAM(pb + 7);
        }
        if (PHM(8) && IN(pb + 8)) { MKP;
            Gemm g{WSP(bf16, WS_H), (const bf16*)(p.ws + WS_W + (size_t)layer * SZ_LAYERW + OFF_WG), T, 3 * DM, DM}; GateOrder S{T / 256, DM / 256, G, bid};
            EpiGate E{WSP(bf16, AR_OBUF), WSP(bf16, AR_MIX), DM / 256};
            pg8::gemm_phase<EpiGate, GateOrder, true, true>(lds, g, S, E);
            SEAM(pb + 8);
        }
        if (PHM(9) && IN(pb + 9)) { MKP;
            Gemm g{WSP(bf16, AR_MIX), (const bf16*)(p.ws + WS_W + (size_t)layer * SZ_LAYERW + OFF_WOUT), T, DM, DM}; SOrder S; S.init(T, DM, G, bid);
            EpiResid E{layer == 0 ? p.x : p.out, p.out};
            pg8::gemm_phase<EpiResid, SOrder, true, true>(lds, g, S, E);
            SEAM(pb + 9);
        }
        if (PHM(10) && IN(pb + 10)) { MKP;
            for (int m = gw; m < T; m += NGW) rms_row(p, p.out + (size_t)m * DM, p.ffn_norm_g + (size_t)layer * DM, WSP(bf16, WS_H) + (size_t)m * DM, lane, layer == 1, m);
            if (layer == 1) { int* rt = WSP(int, AR_RTOK); for (long i = gtid; i < 2L * MOE_ROWS; i += NT) rt[i] = -1; }
            SEAM(pb + 10);
        }
        if (layer == 0) {
            if (PHM(11) && IN(pb + 11)) { MKP;
                Gemm g{WSP(bf16, WS_H), WSP(bf16, WS_DGU), T, 2 * DENSE_FF, DM}; SOrder S; S.init(T, 2 * DENSE_FF, G, bid);
                EpiSwiglu E{WSP(bf16, AR_ACT), DENSE_FF, 2 * DENSE_FF / 256};
                pg8::gemm_phase<EpiSwiglu, SOrder, true, true>(lds, g, S, E);
                SEAM(pb + 11);
            }
            if (PHM(12) && IN(pb + 12)) { MKP;
                Gemm g{WSP(bf16, AR_ACT), WSP(bf16, WS_DDN), T, DM, DENSE_FF}; SOrder S; S.init(T, DM, G, bid);
                EpiResid E{p.out, p.out};
                pg8::gemm_phase<EpiResid, SOrder, true, true>(lds, g, S, E);
                SEAM(pb + 12);
            }
        } else {
            if (PHM(11) && IN(pb + 11)) { MKP;
                const int ig = (DM / 64) * (2 * EXPERT_FF / 32), id = (EXPERT_FF / 64) * (DM / 32);
                for (int it = gw; it < NEXP * (ig + id); it += NGW) { const int e = it / (ig + id); int r = it % (ig + id);
                    if (conv_job(r, p.moe_gu + (size_t)e * DM * 2 * EXPERT_FF, DM, 2 * EXPERT_FF, MapGlu{WSP(bf16, AR_MGU) + (size_t)e * 2 * EXPERT_FF * DM, DM, EXPERT_FF}, scrw, lane)) continue;
                    conv_job(r, p.moe_down + (size_t)e * EXPERT_FF * DM, EXPERT_FF, DM, MapPlain{WSP(bf16, AR_MDN) + (size_t)e * DM * EXPERT_FF, EXPERT_FF}, scrw, lane); }
                int* rtok = WSP(int, AR_RTOK); float* rww = WSP(float, AR_RW8); int* trow = WSP(int, AR_TROW);
                for (int t = gw; t < T; t += NGW) {
                    int row0 = 0;
                    if (lane == 0) { const int ee = WSP(int, AR_RTE)[t], e0 = ee & 255, e1 = ee >> 8; const float* w = WSP(float, AR_RTW) + (size_t)t * 2;
                        row0 = moe_seg_start(ctl + CW_CNT, e0) + (int)atomicAdd(ctl + CW_FILL + e0, 1u);
                        const int row1 = moe_seg_start(ctl + CW_CNT + 8, e1) + (int)atomicAdd(ctl + CW_FILL + 8 + e1, 1u);
                        rtok[row0] = t; rww[row0] = w[0]; rtok[MOE_ROWS + row1] = t; rww[MOE_ROWS + row1] = w[1]; trow[T + t] = row1; }
                    row0 = __builtin_amdgcn_readfirstlane(row0);
                    copy_row_wave(WSP(bf16, WS_H) + (size_t)t * DM, WSP(bf16, AR_XG) + (size_t)row0 * DM, lane);
                }
                SEAM(pb + 11);
            }
#pragma unroll
            for (int pass = 0; pass < 2; ++pass) {
                if (PHM(12) && IN(pb + 12 + 2 * pass)) { MKP;
                    Gemm g{WSP(bf16, AR_XG), WSP(bf16, AR_MGU), MOE_ROWS, NEXP * 2 * EXPERT_FF, DM}; MoeOrder S; S.init(ctl + CW_CNT + 8 * pass, 2 * EXPERT_FF / 256, G, bid);
                    EpiSwiglu E{WSP(bf16, AR_MACT), EXPERT_FF, 2 * EXPERT_FF / 256};
                    pg8::gemm_phase<EpiSwiglu, MoeOrder, true, true>(lds, g, S, E);
                    SEAM(pb + 12 + 2 * pass);
                }
                if (PHM(13) && IN(pb + 13 + 2 * pass)) { MKP;
                    Gemm g{WSP(bf16, AR_MACT), WSP(bf16, AR_MDN), MOE_ROWS, NEXP * DM, EXPERT_FF}; MoeOrder S; S.init(ctl + CW_CNT + 8 * pass, DM / 256, G, bid);
                    EpiMoeDown E{p.out, WSP(int, AR_RTOK) + (size_t)pass * MOE_ROWS, WSP(float, AR_RW8) + (size_t)pass * MOE_ROWS, DM / 256};
                    pg8::gemm_phase<EpiMoeDown, MoeOrder, true, true>(lds, g, S, E);
                    if (pass == 0) { const int* trow = WSP(int, AR_TROW);
                        for (int t = gw; t < T; t += NGW) copy_row_wave(WSP(bf16, WS_H) + (size_t)t * DM, WSP(bf16, AR_XG) + (size_t)trow[T + t] * DM, lane); }
                    SEAM(pb + 13 + 2 * pass);
                }
            }
        }
    }
#undef IN
#undef SEAM
}

#ifndef MK_ONE_LAUNCH
#define MK_ONE_LAUNCH 1
#endif
extern "C" void kernel_launch(void* const* d_in, const int* in_sizes, int n_in, void* d_out, int out_size, void* d_ws, size_t ws_size, hipStream_t stream) {
    static int grid = 0;
    if (grid == 0) {
        if (n_in != 29 || in_sizes[0] != T * DM || out_size != T * DM || ws_size < WS_END) { fprintf(stderr, "kernel_launch: unexpected shapes / workspace (%d inputs, ws %zu, need %zu)\n", n_in, ws_size, (size_t)WS_END); grid = -1; return; }
        int dev = 0, cus = 0;
        if (hipGetDevice(&dev) != hipSuccess || hipDeviceGetAttribute(&cus, hipDeviceAttributeMultiprocessorCount, dev) != hipSuccess) { grid = -1; return; }
        if (hipFuncSetAttribute((const void*)mk_fwd, hipFuncAttributeMaxDynamicSharedMemorySize, LDS_BYTES) != hipSuccess) { fprintf(stderr, "kernel_launch: hipFuncSetAttribute failed\n"); grid = -1; return; }
        int per_cu = 0;
        if (hipOccupancyMaxActiveBlocksPerMultiprocessor(&per_cu, (const void*)mk_fwd, NTHREADS, LDS_BYTES) != hipSuccess || per_cu < 1) { fprintf(stderr, "kernel_launch: occupancy query says %d\n", per_cu); }
        (void)hipGetLastError();
        grid = cus;
    }
    if (grid < 0) return;
    if (hipMemsetAsync((char*)d_ws + WS_CTL, 0, CTL_BYTES, stream) != hipSuccess) return;
    Args a{};
    for (int i = 0; i < 29; ++i) a.in[i] = (const float*)d_in[i];
    a.out = (float*)d_out; a.ws = (unsigned char*)d_ws;
#if MK_ONE_LAUNCH
    a.ph_lo = 0; a.ph_hi = NPHASES;
    hipLaunchKernelGGL(mk_fwd, dim3(grid), dim3(NTHREADS), LDS_BYTES, stream, a);
#else
    for (int k = 0; k < NPHASES; ++k) {
        if (k >= 1 + 13 && k < 1 + NPH) continue;
        a.ph_lo = k; a.ph_hi = k + 1;
        hipLaunchKernelGGL(mk_fwd, dim3(grid), dim3(NTHREADS), LDS_BYTES, stream, a);
    }
#endif
}
```

```cpp
#include <hip/hip_runtime.h>
#include <cstdio>
#include <cstdint>
#include <cmath>
#include <cstring>
#ifdef HOST_EMU
#define HD
#define DEV_INLINE inline
#else
#define HD __host__ __device__
#define DEV_INLINE __device__ __forceinline__
#endif

typedef unsigned short bf16;
struct alignas(16) U4 { unsigned x, y, z, w; };

#ifdef SMALL_CFG
constexpr int BATCH = 1, SEQ = 1024, DM = 128, DENSE_FF = 256, EXPERT_FF = 256;
#else
constexpr int BATCH = 8, SEQ = 8192, DM = 1024, DENSE_FF = 2816, EXPERT_FF = 3584;
#endif
constexpr int T = BATCH * SEQ;
constexpr int NHEAD = 8, NKV = 2, HG = 4, DH = 64;
constexpr int NC = SEQ / 16 - 1, NS = SEQ / 64, NSEL = 8, WINDOW = 512;
constexpr int CONV_CH = 512, CONV_K = 31, RC = 512;
constexpr int NEXP = 8;
constexpr int NSA_IN = 1304, OFF_CONV = 1304, OFF_GATE = 2328, OFF_RWKV = OFF_GATE + 3 * DM;
constexpr int N_IN_FIRST = OFF_RWKV + 1824, N_IN_REST = OFF_RWKV + 1856;
constexpr int NPROJ = 4352;
constexpr int LDQ = 512, LDKV = 512, LDRW = 2048, LBLK = 1536;
constexpr int MOE_ROWS = T + NEXP * 256;
constexpr float RMS_EPS = 1e-6f, LN_EPS = 1e-5f, GN_EPS = 64e-5f;

constexpr size_t al(size_t x) { return (x + 255) & ~(size_t)255; }
constexpr size_t WS_CTL = 0, CTL_BYTES = 1u << 20;
constexpr size_t SZ_WIN = (size_t)NPROJ * DM * 2, SZ_WG = (size_t)3 * DM * DM * 2, SZ_WO3 = (size_t)3 * DM * 512 * 2, SZ_WOUT = (size_t)DM * DM * 2;
constexpr size_t SZ_LW = (size_t)2048 * 384 * 2, SZ_CW1 = (size_t)2 * 256 * 1024 * 2, SZ_PEC = 1024;
constexpr size_t SZ_LAYERW = SZ_WIN + SZ_WG + SZ_WO3 + SZ_WOUT + SZ_LW + SZ_CW1 + SZ_PEC;
constexpr size_t WS_W = CTL_BYTES;
constexpr size_t OFF_WIN = 0, OFF_WG = SZ_WIN, OFF_WO3 = OFF_WG + SZ_WG, OFF_WOUT = OFF_WO3 + SZ_WO3, OFF_LW = OFF_WOUT + SZ_WOUT, OFF_CW1 = OFF_LW + SZ_LW, OFF_PEC = OFF_CW1 + SZ_CW1;
constexpr size_t WS_DGU = WS_W + 2 * SZ_LAYERW, SZ_DGU = (size_t)2 * DENSE_FF * DM * 2;
constexpr size_t WS_DDN = WS_DGU + SZ_DGU, SZ_DDN = (size_t)DM * DENSE_FF * 2;
constexpr size_t WS_VF = al(WS_DDN + SZ_DDN), SZ_TC = (size_t)T * 512 * 2;
constexpr size_t WS_H = WS_VF + SZ_TC, SZ_H = (size_t)T * DM * 2;
constexpr size_t WS_AR = al(WS_H + SZ_H);
constexpr size_t AR_QB = WS_AR, AR_A = AR_QB + SZ_TC, AR_CO = AR_A + SZ_TC;
constexpr size_t AR_KV = AR_CO + SZ_TC, SZ_KV = (size_t)T * LDKV * 2;
constexpr size_t AR_RW = AR_KV + SZ_KV, SZ_RW = (size_t)T * LDRW * 2;
constexpr size_t AR_W = AR_RW + SZ_RW, AR_G = AR_W + SZ_TC, AR_UB = AR_G + SZ_TC;
constexpr size_t AR_NG = AR_UB + SZ_TC, SZ_NG = (size_t)T * 24 * 4;
constexpr size_t AR_HALO = al(AR_NG + SZ_NG), SZ_HALO = (size_t)(T / 256) * LDRW * 2;
constexpr size_t AR_KC = al(AR_HALO + SZ_HALO), SZ_CMP = (size_t)BATCH * NKV * (SEQ / 16) * 64 * 2;
constexpr size_t AR_VC = AR_KC + SZ_CMP;
constexpr size_t AR_HID = al(AR_VC + SZ_CMP), SZ_HID = (size_t)BATCH * NKV * (SEQ / 16) * 2 * 128 * 4;
constexpr size_t AR_SEL = al(AR_HID + SZ_HID), SZ_SEL = (size_t)T * NKV * 8 * 4;
constexpr size_t AR_INVN = al(AR_SEL + SZ_SEL), SZ_INVN = (size_t)T * 8 * 4;
constexpr size_t AR_VCT = al(AR_INVN + SZ_INVN);
constexpr size_t AR_CKV = al(AR_VCT + SZ_CMP), SZ_CKV = (size_t)2 * T * 128;
constexpr size_t AR_END1 = al(AR_CKV + SZ_CKV * 2);
constexpr size_t WS_VST = WS_H, WS_VWT = WS_H + (size_t)T * 128 * 2, WS_LB = WS_VWT + (size_t)T * 128 * 2;
constexpr size_t AR_OBUF = AR_KV, SZ_OBUF = (size_t)3 * T * DM * 2;
constexpr size_t AR_MIX = AR_OBUF + SZ_OBUF, SZ_MIX = (size_t)T * DM * 2;
constexpr size_t AR_END2 = AR_MIX + SZ_MIX;
constexpr size_t AR_ACT = WS_AR;
constexpr size_t AR_MGU = WS_AR, SZ_MGU = (size_t)NEXP * 2 * EXPERT_FF * DM * 2;
constexpr size_t AR_MDN = AR_MGU + SZ_MGU, SZ_MDN = (size_t)NEXP * DM * EXPERT_FF * 2;
constexpr size_t AR_XG = al(AR_MDN + SZ_MDN), SZ_XG = (size_t)MOE_ROWS * DM * 2;
constexpr size_t AR_MACT = al(AR_XG + SZ_XG), SZ_MACT = (size_t)MOE_ROWS * EXPERT_FF * 2;
constexpr size_t AR_RTOK = al(AR_MACT + SZ_MACT), SZ_RTOK = (size_t)2 * MOE_ROWS * 4;
constexpr size_t AR_RW8 = al(AR_RTOK + SZ_RTOK);
constexpr size_t AR_TROW = al(AR_RW8 + SZ_RTOK), SZ_TROW = (size_t)2 * T * 4;
constexpr size_t AR_RTE = al(AR_TROW + SZ_TROW);
constexpr size_t AR_RTW = al(AR_RTE + (size_t)T * 4);
constexpr size_t AR_END3 = al(AR_RTW + (size_t)T * 8);
constexpr size_t WS_END = (AR_END1 > AR_END2 ? (AR_END1 > AR_END3 ? AR_END1 : AR_END3) : (AR_END2 > AR_END3 ? AR_END2 : AR_END3));
constexpr int CW_CNT = 64, CW_FILL = 128;
constexpr int CW_ATT = 256;
constexpr int CW_BAR = 4096;

struct P {
    const float *x, *mix_norm_g, *w_in_first, *w_in_rest, *mu_first, *mu_rest, *qk_g, *cmp_pos, *cmp_w1, *cmp_w2, *nsa_w_o, *conv_w, *conv_vec, *conv_w_o,
        *rwkv_vec, *w_up, *a_up, *g_up, *vres_up, *vres_b, *rwkv_w_o, *w_out, *ffn_norm_g, *dense_gu, *dense_down, *router_w, *router_b, *moe_gu, *moe_down;
    float* out; unsigned char* ws;
};
HD inline void fill_params(P& p, const float* const* in, float* out, unsigned char* ws) {
    p.x = in[0]; p.mix_norm_g = in[1]; p.w_in_first = in[2]; p.w_in_rest = in[3]; p.mu_first = in[4]; p.mu_rest = in[5]; p.qk_g = in[6]; p.cmp_pos = in[7];
    p.cmp_w1 = in[8]; p.cmp_w2 = in[9]; p.nsa_w_o = in[10]; p.conv_w = in[11]; p.conv_vec = in[12]; p.conv_w_o = in[13]; p.rwkv_vec = in[14]; p.w_up = in[15];
    p.a_up = in[16]; p.g_up = in[17]; p.vres_up = in[18]; p.vres_b = in[19]; p.rwkv_w_o = in[20]; p.w_out = in[21]; p.ffn_norm_g = in[22]; p.dense_gu = in[23];
    p.dense_down = in[24]; p.router_w = in[25]; p.router_b = in[26]; p.moe_gu = in[27]; p.moe_down = in[28]; p.out = out; p.ws = ws;
}
#define WSP(type, off) ((type*)(p.ws + (off)))

#ifdef HOST_EMU
#define FENCE()
#else
#define FENCE() asm volatile("" ::: "memory")
#endif
HD inline float bf2f(bf16 v) { unsigned u = (unsigned)v << 16; float f; memcpy(&f, &u, 4); return f; }
HD inline bf16 f2bf(float f) { unsigned u; memcpy(&u, &f, 4); return (bf16)((u + 0x7fffu + ((u >> 16) & 1u)) >> 16); }
HD inline float blo(unsigned v) { unsigned u = v << 16; float f; memcpy(&f, &u, 4); return f; }
HD inline float bhi(unsigned v) { unsigned u = v & 0xffff0000u; float f; memcpy(&f, &u, 4); return f; }
HD inline float sigmoidf_(float x) { return 1.f / (1.f + expf(-x)); }
HD inline float dot64(const float* q, const bf16* kp) {
    const U4* k4 = (const U4*)kp; float s0 = 0.f, s1 = 0.f;
#pragma unroll
    for (int i = 0; i < 8; ++i) { const U4 v = k4[i];
        s0 += q[8 * i + 0] * blo(v.x) + q[8 * i + 2] * blo(v.y) + q[8 * i + 4] * blo(v.z) + q[8 * i + 6] * blo(v.w);
        s1 += q[8 * i + 1] * bhi(v.x) + q[8 * i + 3] * bhi(v.y) + q[8 * i + 5] * bhi(v.z) + q[8 * i + 7] * bhi(v.w); }
    return s0 + s1;
}
HD inline float dot64p(const U4* q, const bf16* kp) {
    const U4* k4 = (const U4*)kp; float s0 = 0.f, s1 = 0.f;
#pragma unroll
    for (int i = 0; i < 8; ++i) { const U4 v = k4[i], w = q[i];
        s0 += blo(w.x) * blo(v.x) + blo(w.y) * blo(v.y) + blo(w.z) * blo(v.z) + blo(w.w) * blo(v.w);
        s1 += bhi(w.x) * bhi(v.x) + bhi(w.y) * bhi(v.y) + bhi(w.z) * bhi(v.z) + bhi(w.w) * bhi(v.w); }
    return s0 + s1;
}
HD inline void ld64(const bf16* kp, float* q) {
    const U4* k4 = (const U4*)kp;
#pragma unroll
    for (int i = 0; i < 8; ++i) { const U4 v = k4[i]; q[8 * i] = blo(v.x); q[8 * i + 1] = bhi(v.x); q[8 * i + 2] = blo(v.y); q[8 * i + 3] = bhi(v.y);
        q[8 * i + 4] = blo(v.z); q[8 * i + 5] = bhi(v.z); q[8 * i + 6] = blo(v.w); q[8 * i + 7] = bhi(v.w); }
}
HD inline void axpy64(float* o, float w, const bf16* vp) {
    const U4* k4 = (const U4*)vp;
#pragma unroll
    for (int i = 0; i < 8; ++i) { const U4 v = k4[i]; o[8 * i] += w * blo(v.x); o[8 * i + 1] += w * bhi(v.x); o[8 * i + 2] += w * blo(v.y); o[8 * i + 3] += w * bhi(v.y);
        o[8 * i + 4] += w * blo(v.z); o[8 * i + 5] += w * bhi(v.z); o[8 * i + 6] += w * blo(v.w); o[8 * i + 7] += w * bhi(v.w); }
}
HD inline void axpy64s(float* o, float w, const bf16* vp) {
    const U4* k4 = (const U4*)vp;
#pragma unroll
    for (int i = 0; i < 8; ++i) { const U4 v = k4[i]; o[8 * i] = w * o[8 * i] + blo(v.x); o[8 * i + 1] = w * o[8 * i + 1] + bhi(v.x); o[8 * i + 2] = w * o[8 * i + 2] + blo(v.y); o[8 * i + 3] = w * o[8 * i + 3] + bhi(v.y);
        o[8 * i + 4] = w * o[8 * i + 4] + blo(v.z); o[8 * i + 5] = w * o[8 * i + 5] + bhi(v.z); o[8 * i + 6] = w * o[8 * i + 6] + blo(v.w); o[8 * i + 7] = w * o[8 * i + 7] + bhi(v.w); }
}
HD inline void st64(bf16* op, const float* o) {
    U4* o4 = (U4*)op;
#pragma unroll
    for (int i = 0; i < 8; ++i) { U4 v; v.x = (unsigned)f2bf(o[8 * i]) | ((unsigned)f2bf(o[8 * i + 1]) << 16); v.y = (unsigned)f2bf(o[8 * i + 2]) | ((unsigned)f2bf(o[8 * i + 3]) << 16);
        v.z = (unsigned)f2bf(o[8 * i + 4]) | ((unsigned)f2bf(o[8 * i + 5]) << 16); v.w = (unsigned)f2bf(o[8 * i + 6]) | ((unsigned)f2bf(o[8 * i + 7]) << 16); o4[i] = v; }
}

HD inline void rope_cs(int pos, int i, float& cs, float& sn) {
    const float c = exp2f(-(float)i * 0.41524101186092f) * 0.15915494309189535f, pf = (float)pos;
    const float prod = pf * c, err = fmaf(pf, c, -prod), fr = (prod - rintf(prod)) + err;
#ifdef HOST_EMU
    cs = cosf(6.283185307179586f * fr); sn = sinf(6.283185307179586f * fr);
#else
    cs = __builtin_amdgcn_cosf(fr); sn = __builtin_amdgcn_sinf(fr);
#endif
}
HD inline int win_dest(int j, int layer, int& which) {
    which = 0;
    if (j < 1280) return j;
    if (j < 1304) return 3840 + 320 + (j - 1280);
    if (j < 1816) { const int cc = j - 1304; return 1280 + 256 * (cc / 128) + cc % 128; }
    if (j < 2328) { const int cc = j - 1816; return 1280 + 256 * (cc / 128) + 128 + cc % 128; }
    if (j < OFF_RWKV) { which = 1; const int gg = j - OFF_GATE, br = gg / DM; return (br == 0 ? 0 : (br == 1 ? 2 * DM : DM)) + gg % DM; }
    const int rr = j - OFF_RWKV;
    if (rr < 1536) return 2304 + rr;
    if (rr < 1824) return 3840 + (rr - 1536);
    if (rr < 1856 && layer == 1) return 3840 + 288 + (rr - 1824);
    return -1;
}
HD inline int glu_dest(int j, int ff) { return j < ff ? 256 * (j / 128) + j % 128 : 256 * ((j - ff) / 128) + 128 + (j - ff) % 128; }

DEV_INLINE void ph_shift(const P& p, int layer, long gtid, long NT) {
    bf16* RW = WSP(bf16, AR_RW); const bf16* HALO = WSP(bf16, AR_HALO); bf16* VF = WSP(bf16, WS_VF); bf16* LB = WSP(bf16, WS_LB);
    const float* mu = layer == 0 ? p.mu_first : p.mu_rest;
    const long n = (long)(T / 256) * (LBLK + 384);
    for (long it = gtid; it < n; it += NT) {
        const int pm = (int)(it / (LBLK + 384)), c = (int)(it % (LBLK + 384));
        int mi = -1, act = 0;
        if (c < LBLK) mi = c;
        else { const int w = c - LBLK; if (w < 288) { mi = 1536 + w; act = w < 64 ? 1 : (w >= 128 ? 2 : 0); } else if (w < 320 && layer == 1) mi = 1824 + (w - 288); }
        if (mi < 0) { for (int r = 0; r < 256; ++r) LB[((size_t)pm * 256 + r) * 384 + (c - LBLK)] = 0; continue; }
        const float m = mu[mi];
        float prev = ((pm * 256) % SEQ == 0) ? 0.f : bf2f(HALO[(size_t)(pm - 1) * LDRW + c]);
        bf16* col = RW + (size_t)pm * 256 * LDRW + c;
        for (int r = 0; r < 256; ++r) {
            const float pv = bf2f(col[(size_t)r * LDRW]);
            float u = pv + (prev - pv) * m; prev = pv;
            if (act == 1) u = tanhf(u); else if (act == 2) u = sigmoidf_(u);
            if (c < LBLK) { col[(size_t)r * LDRW] = f2bf(u); if (layer == 0 && c >= 1024) VF[((size_t)pm * 256 + r) * RC + (c - 1024)] = f2bf(u); }
            else LB[((size_t)pm * 256 + r) * 384 + (c - LBLK)] = f2bf(u);
        }
    }
}

DEV_INLINE void ph_nsa_prep(const P& p, int layer, long gtid, long NT) {
    bf16* QB = WSP(bf16, AR_QB); bf16* KV = WSP(bf16, AR_KV);
    const long n = (long)T * 12;
    for (long it = gtid; it < n; it += NT) {
        const int t = (int)(it / 12), s = (int)(it % 12), pos = t % SEQ;
        bf16* ptr; const float* g;
        if (s < 8) { ptr = QB + (size_t)t * LDQ + s * 64; g = p.qk_g + (layer * 4 + 0) * 64; }
        else if (s < 10) { ptr = KV + (size_t)t * LDKV + (s - 8) * 64; g = p.qk_g + (layer * 4 + 2) * 64; }
        else { ptr = KV + (size_t)t * LDKV + 256 + (s - 10) * 64; g = p.qk_g + (layer * 4 + 3) * 64; }
        float v[64]; ld64(ptr, v);
        float ss = 0.f;
#pragma unroll
        for (int i = 0; i < 64; ++i) ss += v[i] * v[i];
        const float rs = 1.f / sqrtf(ss * (1.f / 64.f) + RMS_EPS);
#pragma unroll
        for (int i = 0; i < 64; ++i) v[i] = v[i] * rs * g[i];
#pragma unroll
        for (int i = 0; i < 32; ++i) {
            float cs, sn; rope_cs(pos, i, cs, sn);
            const float x1 = v[i], x2 = v[i + 32]; v[i] = x1 * cs - x2 * sn; v[i + 32] = x2 * cs + x1 * sn;
        }
        st64(ptr, v);
    }
}

DEV_INLINE void ph_vtrans(const P& p, long gtid, long NT) {
    const bf16* KV = WSP(bf16, AR_KV); bf16* VsT = WSP(bf16, WS_VST); bf16* VwT = WSP(bf16, WS_VWT);
    const long n = (long)BATCH * NKV * (SEQ / 8) * 64;
    for (long it = gtid; it < n; it += NT) {
        const int d = (int)(it % 64); long r = it / 64; const int t8 = (int)(r % (SEQ / 8)); const int bg = (int)(r / (SEQ / 8)), b = bg / NKV, g = bg % NKV;
        const bf16* src = KV + (size_t)(b * SEQ + 8 * t8) * LDKV + g * 64 + d;
        U4 s, w; unsigned short sv[8], wv[8];
#pragma unroll
        for (int j = 0; j < 8; ++j) { sv[j] = src[(size_t)j * LDKV + 128]; wv[j] = src[(size_t)j * LDKV + 384]; }
        s.x = sv[0] | ((unsigned)sv[1] << 16); s.y = sv[2] | ((unsigned)sv[3] << 16); s.z = sv[4] | ((unsigned)sv[5] << 16); s.w = sv[6] | ((unsigned)sv[7] << 16);
        w.x = wv[0] | ((unsigned)wv[1] << 16); w.y = wv[2] | ((unsigned)wv[3] << 16); w.z = wv[4] | ((unsigned)wv[5] << 16); w.w = wv[6] | ((unsigned)wv[7] << 16);
        *(U4*)(VsT + ((size_t)bg * 64 + d) * SEQ + 8 * t8) = s; *(U4*)(VwT + ((size_t)bg * 64 + d) * SEQ + 8 * t8) = w;
    }
}
namespace pg8 {
#define PG8_LAS __attribute__((address_space(3)))
typedef unsigned short bf16_t;
typedef short bf16x8 __attribute__((ext_vector_type(8)));
typedef float f32x4 __attribute__((ext_vector_type(4)));
typedef unsigned u32x4 __attribute__((ext_vector_type(4)));
constexpr int BM = 256, BK = 64, HALF = 128, HTB = HALF * BK * 2  , STAGE_BYTES = 8 * HTB, NXCD = 8, WGM = 8;

__host__ __device__ __forceinline__ int lds_byte(int r, int c) { const int st = (r >> 4) * 2 + (c >> 5), rr = r & 15, cc = c & 31, ob = rr * 64 + cc * 2; return st * 1024 + (ob ^ (((ob >> 9) & 1) << 5)); }
__host__ __device__ __forceinline__ void stage_rc(int b, int& R, int& C) { const int st = b / 1024, sb = b % 1024, swz = sb ^ (((sb >> 9) & 1) << 5); R = (st >> 1) * 16 + swz / 64; C = (st & 1) * 32 + (swz % 64) / 2; }
__host__ __device__ __forceinline__ int perm32(int rho) { const int n = rho >> 4, i = rho & 15; return 8 * (i >> 2) + 4 * n + (i & 3); }

struct Unit { int pm, pn; };
struct Gemm { const bf16_t* A; const bf16_t* Bt; int M, N, K; int lda; };

struct StaticOrder {
    int nM, nN, nwg, G, c;
    __host__ __device__ void init(int M, int N, int G_, int c_) { nM = M / BM; nN = N / BM; nwg = nM * nN; G = G_; c = c_; }
    __host__ __device__ bool next(int i, Unit& u) const {
        const long L = (long)i * G + c; if (L >= nwg) return false;
        int wgid = (int)L; { const int q = nwg / NXCD, r = nwg % NXCD, xcd = wgid % NXCD, off = wgid / NXCD; wgid = (xcd < r ? xcd * (q + 1) : r * (q + 1) + (xcd - r) * q) + off; }
        const int nig = WGM * nN, gid = wgid / nig, fm = gid * WGM, gsz = (nM - fm) < WGM ? (nM - fm) : WGM;
        u.pm = fm + ((wgid % nig) % gsz); u.pn = (wgid % nig) / gsz; return true;
    }
    __device__ __forceinline__ void a_ready(const Unit&) const {}
    __device__ __forceinline__ void done(const Unit&) const {}
};

__device__ __forceinline__ unsigned cvt_pk_bf16(float lo, float hi) { unsigned r; asm volatile("v_cvt_pk_bf16_f32 %0, %1, %2" : "=v"(r) : "v"(lo), "v"(hi)); return r; }
typedef float f32x2 __attribute__((ext_vector_type(2)));
template <class Epi, class Sched, bool ALIGN_EPI = false, bool SP2 = false>
__device__ __forceinline__ void gemm_phase(PG8_LAS unsigned char* lds, const Gemm g, const Sched& S, const Epi& E, int tid_in) {
    int tid_ = tid_in; asm volatile("" : "+v"(tid_));
    const int tid = tid_, wid = __builtin_amdgcn_readfirstlane(tid >> 6), lane = tid & 63, wr = wid >> 2, wc = wid & 3, fr = lane & 15, fq = lane >> 4;
    const int K = g.K, nt = K / BK, lda = g.lda ? g.lda : K;
    unsigned voffA[2], voffB[2];
#pragma unroll
    for (int i = 0; i < 2; ++i) { int R, C; stage_rc(tid * 16 + i * 8192, R, C); const int Rb = Epi::PERM ? ((R & ~31) + perm32(R & 31)) : R;
        voffA[i] = (unsigned)(R * lda + C) * 2u; voffB[i] = (unsigned)(Rb * K + C) * 2u; }
    const size_t kstep = (size_t)(BK * 2);
    const size_t hstepA = (size_t)HALF * lda * 2, hstepB = (size_t)HALF * K * 2;
    const size_t hstep_unused = (size_t)HALF * K * 2;
    const size_t tstepA = 2 * hstepA, tstepB = 2 * hstepB;
    const unsigned ldsw = (unsigned)wid * 1024u;
    const int aoff = lds_byte(wr * 64 + fr, fq * 8), boff = lds_byte(wc * 32 + fr, fq * 8);
#define PG8_SA(b, h) (((b) * 2 + (h)) * HTB)
#define PG8_SB(b, h) ((4 + (b) * 2 + (h)) * HTB)
#define PG8_STAGE(bufoff, gbase, voff) do { _Pragma("unroll") for (int _i = 0; _i < 2; ++_i) \
        __builtin_amdgcn_global_load_lds((const unsigned*)((const char*)(gbase) + (voff)[_i]), (PG8_LAS unsigned*)(lds + (bufoff) + ldsw + _i * 8192), 16, 0, 0); } while (0)
#define PG8_LDA(dst, b, h) do { _Pragma("unroll") for (int m = 0; m < 4; ++m) _Pragma("unroll") for (int k = 0; k < 2; ++k) dst[m][k] = *(const PG8_LAS bf16x8*)(lds + PG8_SA(b, h) + aoff + m * 2048 + k * 1024); } while (0)
#define PG8_LDB(dst, b, h) do { _Pragma("unroll") for (int n = 0; n < 2; ++n) _Pragma("unroll") for (int k = 0; k < 2; ++k) dst[n][k] = *(const PG8_LAS bf16x8*)(lds + PG8_SB(b, h) + boff + n * 2048 + k * 1024); } while (0)
#define PG8_MMA(ai, bj, At, Bt) do { __builtin_amdgcn_s_setprio(1); _Pragma("unroll") for (int m = 0; m < 4; ++m) _Pragma("unroll") for (int n = 0; n < 2; ++n) _Pragma("unroll") for (int k = 0; k < 2; ++k) \
        acc[ai][bj][m][n] = __builtin_amdgcn_mfma_f32_16x16x32_bf16(Bt[n][k], At[m][k], acc[ai][bj][m][n], 0, 0, 0); __builtin_amdgcn_s_setprio(0); } while (0)
#define PG8_WAIT_V(n) asm volatile("s_waitcnt vmcnt(" #n ")" ::: "memory")
#define PG8_WAIT_L(n) asm volatile("s_waitcnt lgkmcnt(" #n ")" ::: "memory")
#define PG8_BAR __builtin_amdgcn_s_barrier()
#define PG8_SCHED __builtin_amdgcn_sched_barrier(0)
    Unit cur, nxt; int ui = 0;
    if (!S.next(0, cur)) return;
    f32x4 acc[2][2][4][2];
#pragma unroll
    for (int a = 0; a < 2; ++a)
#pragma unroll
        for (int b = 0; b < 2; ++b)
#pragma unroll
            for (int m = 0; m < 4; ++m)
#pragma unroll
                for (int n = 0; n < 2; ++n) acc[a][b][m][n] = (f32x4){0.f, 0.f, 0.f, 0.f};
    bf16x8 At[4][2], B0[2][2], B1[2][2];
    const char* cA = (const char*)g.A + (size_t)cur.pm * tstepA; const char* cB = (const char*)g.Bt + (size_t)cur.pn * tstepB;
    S.a_ready(cur);
    if constexpr (SP2) {
        PG8_STAGE(PG8_SB(0, 0), cB, voffB); PG8_STAGE(PG8_SB(0, 1), cB + hstepB, voffB); PG8_STAGE(PG8_SA(0, 0), cA, voffA); PG8_STAGE(PG8_SA(0, 1), cA + hstepA, voffA);
        if (wr == 1) PG8_BAR;
        PG8_WAIT_V(2); PG8_BAR;
        PG8_STAGE(PG8_SB(1, 0), cB + kstep, voffB); PG8_STAGE(PG8_SA(1, 0), cA + kstep, voffA); PG8_STAGE(PG8_SB(1, 1), cB + hstepB + kstep, voffB);
        PG8_WAIT_V(6); PG8_BAR;
    } else {
        PG8_STAGE(PG8_SB(0, 0), cB, voffB); PG8_STAGE(PG8_SA(0, 0), cA, voffA); PG8_STAGE(PG8_SB(0, 1), cB + hstepB, voffB); PG8_STAGE(PG8_SA(0, 1), cA + hstepA, voffA);
        if (wr == 1) PG8_BAR;
        PG8_WAIT_V(4); PG8_BAR;
        PG8_STAGE(PG8_SB(1, 0), cB + kstep, voffB); PG8_STAGE(PG8_SA(1, 0), cA + kstep, voffA); PG8_STAGE(PG8_SB(1, 1), cB + hstepB + kstep, voffB);
        PG8_WAIT_V(6); PG8_BAR;
    }
    for (;;) {
        const bool has_next = S.next(ui + 1, nxt);
        const char* nA = has_next ? (const char*)g.A + (size_t)nxt.pm * tstepA : cA; const char* nB = has_next ? (const char*)g.Bt + (size_t)nxt.pn * tstepB : cB;
        for (int t = 0; t < nt; t += 2) {
            const bool last = (t == nt - 2);
            const char* a1 = cA + (size_t)(t + 1) * kstep;
            const char* a2 = last ? nA : cA + (size_t)(t + 2) * kstep; const char* b2 = last ? nB : cB + (size_t)(t + 2) * kstep;
            const char* a3 = a2 + kstep; const char* b3 = b2 + kstep;
            if (last && has_next) S.a_ready(nxt);
            if constexpr (SP2) {
            PG8_LDB(B0, 0, 0); PG8_LDB(B1, 0, 1); PG8_SCHED; PG8_LDA(At, 0, 0); PG8_STAGE(PG8_SA(1, 1), a1 + hstepA, voffA);
            PG8_WAIT_V(8); PG8_WAIT_L(0); PG8_BAR; PG8_MMA(0, 0, At, B0); PG8_MMA(0, 1, At, B1); PG8_BAR; PG8_SCHED;
            PG8_LDA(At, 0, 1); PG8_STAGE(PG8_SB(0, 0), b2, voffB); PG8_STAGE(PG8_SB(0, 1), b2 + hstepB, voffB); PG8_STAGE(PG8_SA(0, 0), a2, voffA);
            PG8_WAIT_V(8); PG8_WAIT_L(0); PG8_BAR; PG8_MMA(1, 0, At, B0); PG8_MMA(1, 1, At, B1); PG8_BAR; PG8_SCHED;
            PG8_LDB(B0, 1, 0); PG8_LDB(B1, 1, 1); PG8_SCHED; PG8_LDA(At, 1, 0); PG8_STAGE(PG8_SA(0, 1), a2 + hstepA, voffA);
            PG8_WAIT_V(8); PG8_WAIT_L(0); PG8_BAR; PG8_MMA(0, 0, At, B0); PG8_MMA(0, 1, At, B1); PG8_BAR; PG8_SCHED;
            PG8_LDA(At, 1, 1); PG8_STAGE(PG8_SB(1, 0), b3, voffB); PG8_STAGE(PG8_SB(1, 1), b3 + hstepB, voffB); PG8_STAGE(PG8_SA(1, 0), a3, voffA);
            PG8_WAIT_V(8); PG8_WAIT_L(0); PG8_BAR; PG8_MMA(1, 0, At, B0); PG8_MMA(1, 1, At, B1); PG8_BAR; PG8_SCHED;
            } else {
            PG8_LDB(B0, 0, 0); PG8_SCHED; PG8_LDA(At, 0, 0); PG8_STAGE(PG8_SA(1, 1), a1 + hstepA, voffA);
            PG8_WAIT_L(8); PG8_BAR; PG8_WAIT_L(0); PG8_MMA(0, 0, At, B0); PG8_BAR; PG8_SCHED;
            PG8_LDB(B1, 0, 1); PG8_STAGE(PG8_SB(0, 0), b2, voffB);
            PG8_BAR; PG8_WAIT_L(0); PG8_MMA(0, 1, At, B1); PG8_BAR;
            PG8_LDA(At, 0, 1); PG8_STAGE(PG8_SA(0, 0), a2, voffA);
            PG8_BAR; PG8_WAIT_L(0); PG8_MMA(1, 0, At, B0); PG8_BAR; PG8_SCHED;
            PG8_STAGE(PG8_SB(0, 1), b2 + hstepB, voffB);
            PG8_WAIT_V(6); PG8_BAR; PG8_MMA(1, 1, At, B1); PG8_BAR;
            PG8_LDB(B0, 1, 0); PG8_SCHED; PG8_LDA(At, 1, 0); PG8_STAGE(PG8_SA(0, 1), a2 + hstepA, voffA);
            PG8_WAIT_L(8); PG8_BAR; PG8_WAIT_L(0); PG8_MMA(0, 0, At, B0); PG8_BAR; PG8_SCHED;
            PG8_LDB(B1, 1, 1); PG8_STAGE(PG8_SB(1, 0), b3, voffB);
            PG8_BAR; PG8_WAIT_L(0); PG8_MMA(0, 1, At, B1); PG8_BAR;
            PG8_LDA(At, 1, 1); PG8_STAGE(PG8_SA(1, 0), a3, voffA);
            PG8_BAR; PG8_WAIT_L(0); PG8_MMA(1, 0, At, B0); PG8_BAR; PG8_SCHED;
            PG8_STAGE(PG8_SB(1, 1), b3 + hstepB, voffB);
            PG8_WAIT_V(6); PG8_BAR; PG8_MMA(1, 1, At, B1); PG8_BAR;
            }
        }
        if constexpr (ALIGN_EPI) { if (wr == 0) PG8_BAR; }
        if constexpr (!Epi::AFTER_DRAIN) { E(acc, cur, wr, wc, fr, fq); S.done(cur); }
        if (!has_next) break;
#pragma unroll
        for (int a = 0; a < 2; ++a)
#pragma unroll
            for (int b = 0; b < 2; ++b)
#pragma unroll
                for (int m = 0; m < 4; ++m)
#pragma unroll
                    for (int n = 0; n < 2; ++n) acc[a][b][m][n] = (f32x4){0.f, 0.f, 0.f, 0.f};
        cur = nxt; cA = nA; cB = nB; ++ui;
        if constexpr (ALIGN_EPI) { if (wr == 1) PG8_BAR; }
    }
    PG8_WAIT_V(0);
    if constexpr (!ALIGN_EPI) { if (wr == 0) PG8_BAR; }
    PG8_BAR;
    if constexpr (Epi::AFTER_DRAIN) { E.fused(acc, cur, wr, wc, fr, fq, lds, wid, lane); S.done(cur); }
#undef PG8_SA
#undef PG8_SB
#undef PG8_STAGE
#undef PG8_LDA
#undef PG8_LDB
#undef PG8_MMA
#undef PG8_WAIT_V
#undef PG8_WAIT_L
#undef PG8_BAR
#undef PG8_SCHED
}
}

#define LAS __attribute__((address_space(3)))
#define XB_TMO      128
#define XB_XCNT(j)  (256  + 64 * (j))
#define XB_XSUB(j)  (1280 + 64 * (j))
#define XB_XGEN(j)  (2304 + 64 * (j))
#define XB_TOP      3328
#define XB_TOPGEN   3392
#define XCD_BAR_WORDS 3456
#define XB_SPIN_CAP (1u << 22)

__device__ __forceinline__ unsigned xb_ld(unsigned* p)              { return __hip_atomic_load(p, __ATOMIC_RELAXED, __HIP_MEMORY_SCOPE_AGENT); }
__device__ __forceinline__ unsigned xb_add(unsigned* p, unsigned v) { return __hip_atomic_fetch_add(p, v, __ATOMIC_RELAXED, __HIP_MEMORY_SCOPE_AGENT); }
__device__ __forceinline__ unsigned xb_xcc_id() { return (unsigned)__builtin_amdgcn_s_getreg((3 << 11) | 20) & 0xFu; }
#define XB_SPIN(cond, bar) do { unsigned _sp = 0; while (cond) { __builtin_amdgcn_s_sleep(1); \
    if ((++_sp & 255u) == 0u) { if (xb_ld(&(bar)[XB_TMO])) break; if (_sp > XB_SPIN_CAP) { atomicAdd(&(bar)[XB_TMO], 1u); break; } } } } while (0)

struct XcdBarrier {
    unsigned* bar; unsigned x;
    volatile LAS unsigned* st;
};

__device__ __forceinline__ XcdBarrier xcd_barrier_post(unsigned* bar, volatile LAS unsigned* st) {
    XcdBarrier b; b.bar = bar; b.x = xb_xcc_id(); b.st = st;
    if (threadIdx.x == 0) (void)xb_add(&bar[XB_XCNT(b.x)], 1u);
    return b;
}
__device__ __forceinline__ void xcd_barrier_complete(unsigned* bar, unsigned x, unsigned& nloc, unsigned& nx) {
    const unsigned G = gridDim.x * gridDim.y * gridDim.z;
    unsigned sum, cnt, mine, sp = 0u;
    for (;;) {
        sum = 0u; cnt = 0u; mine = 0u;
#pragma unroll
        for (unsigned j = 0; j < 16; ++j) { const unsigned c = xb_ld(&bar[XB_XCNT(j)]); sum += c; cnt += (c > 0u) ? 1u : 0u; mine = (j == x) ? c : mine; }
        if (sum == G) break;
        __builtin_amdgcn_s_sleep(1);
        if ((++sp & 255u) == 0u) { if (xb_ld(&bar[XB_TMO])) break; if (sp > XB_SPIN_CAP) { atomicAdd(&bar[XB_TMO], 1u); break; } }
    }
    nloc = mine > 0u ? mine : 1u; nx = cnt > 0u ? cnt : 1u;
}

__device__ __forceinline__ void xcd_barrier(const XcdBarrier& b, int tid_x  ) {
    asm volatile("s_waitcnt vmcnt(0)" ::: "memory");
    __syncthreads();
    if (tid_x == 0) {
        unsigned* bar = b.bar; asm volatile("" : "+s"(bar));
        unsigned xx = b.x; asm volatile("" : "+s"(xx));
        __builtin_amdgcn_s_waitcnt(0);
        unsigned nloc = b.st[0], nx = b.st[1];
        if (nloc == 0u) { xcd_barrier_complete(bar, xx, nloc, nx); b.st[0] = nloc; b.st[1] = nx; }
        const unsigned old = xb_add(&bar[XB_XSUB(xx)], 1u);
        const unsigned gen = old / nloc;
        if (old + 1u == (gen + 1u) * nloc) {
            __builtin_amdgcn_fence(__ATOMIC_RELEASE, "agent");
            asm volatile("s_waitcnt vmcnt(0)" ::: "memory");
            const unsigned og = xb_add(&bar[XB_TOP], 1u);
            const unsigned tg = og / nx;
            if (og + 1u == (tg + 1u) * nx) xb_add(&bar[XB_TOPGEN], 1u);
            else XB_SPIN(xb_ld(&bar[XB_TOPGEN]) == tg, bar);
            __builtin_amdgcn_fence(__ATOMIC_ACQUIRE, "agent");
            xb_add(&bar[XB_XGEN(xx)], 1u);
            asm volatile("s_waitcnt vmcnt(0)" ::: "memory");
        } else {
            XB_SPIN(xb_ld(&bar[XB_XGEN(xx)]) == gen, bar);
            __builtin_amdgcn_fence(__ATOMIC_ACQUIRE, "agent");
            asm volatile("s_waitcnt vmcnt(0)" ::: "memory");
        }
    }
    __syncthreads();
}
#define GAS __attribute__((address_space(1)))
typedef unsigned v4u __attribute__((ext_vector_type(4)));
typedef unsigned v2u __attribute__((ext_vector_type(2)));
typedef GAS unsigned gu32;
#define RLX_AGENT __ATOMIC_RELAXED, __HIP_MEMORY_SCOPE_AGENT
#define LDS_WAIT() asm volatile("s_waitcnt lgkmcnt(0)" ::: "memory")
#define VM_WAIT() asm volatile("s_waitcnt vmcnt(0)" ::: "memory")
using pg8::f32x4; using pg8::Unit; using pg8::Gemm; using pg8::BM; using pg8::HALF; using pg8::cvt_pk_bf16; using pg8::u32x4;

constexpr int NWAVES = 8, NTHREADS = 512;
constexpr int RING_BYTES = 131072, LDSCTL_OFF = 147456 - 1024, MISC_OFF = LDSCTL_OFF + 320, LDS_BYTES = 147456;

__device__ __forceinline__ float wave_sum(float v, int lane) {
#pragma unroll
    for (int o = 1; o < 64; o <<= 1) v += __builtin_bit_cast(float, __builtin_amdgcn_ds_bpermute((lane ^ o) << 2, __builtin_bit_cast(int, v)));
    return v;
}
__device__ __forceinline__ float fsig(float x) { return __builtin_amdgcn_rcpf(1.f + __expf(-x)); }

__device__ __forceinline__ int lane_id_opaque() { int l; asm volatile("v_mbcnt_lo_u32_b32 %0, -1, 0\n\tv_mbcnt_hi_u32_b32 %0, -1, %0" : "=v"(l)); return l; }
__device__ __forceinline__ int rfl(int v) { return __builtin_amdgcn_readfirstlane(v); }
struct SOrder {
    pg8::StaticOrder s;
    __device__ void init(int M, int N, int G, int c) { s.init(M, N, G, c); }
    __device__ bool next(int i, Unit& u) const { Unit t; t.pm = 0; t.pn = 0; const bool ok = s.next(i, t); u.pm = rfl(t.pm); u.pn = rfl(t.pn); return ok; }
    __device__ __forceinline__ void a_ready(const Unit&) const {}
    __device__ __forceinline__ void done(const Unit&) const {}
};
struct StackOrder {
    int nM, nN, nb, G, c;
    __device__ bool next(int i, Unit& u) const { const long L = (long)i * G + c; if (L >= (long)nb * nM * nN) return false;
        const int br = (int)(L / (nM * nN)), rem = (int)(L % (nM * nN)); u.pm = rfl(br * nM + rem / nN); u.pn = rfl(br * nN + rem % nN); return true; }
    __device__ __forceinline__ void a_ready(const Unit&) const {}
    __device__ __forceinline__ void done(const Unit&) const {}
};
struct GateOrder {
    int nM, nN, G, c;
    __device__ bool next(int i, Unit& u) const { const int j = i / 3, br = i - 3 * j; const long L = (long)j * G + c; if (L >= (long)nM * nN) return false;
        u.pm = rfl((int)(L / nN)); u.pn = rfl(br * nN + (int)(L % nN)); return true; }
    __device__ __forceinline__ void a_ready(const Unit&) const {}
    __device__ __forceinline__ void done(const Unit&) const {}
};
struct MoeOrder {
    int nN, G, c, e0, e1, e2, e3, e4, e5, e6, e7;
    __device__ void init(const unsigned* cnt, int nN_, int G_, int c_) { nN = nN_; G = G_; c = c_;
        int s = 0; s += (cnt[0] + 255) >> 8; e0 = s; s += (cnt[1] + 255) >> 8; e1 = s; s += (cnt[2] + 255) >> 8; e2 = s; s += (cnt[3] + 255) >> 8; e3 = s;
        s += (cnt[4] + 255) >> 8; e4 = s; s += (cnt[5] + 255) >> 8; e5 = s; s += (cnt[6] + 255) >> 8; e6 = s; s += (cnt[7] + 255) >> 8; e7 = s; }
    __device__ bool next(int i, Unit& u) const { const long L = (long)i * G + c; if (L >= (long)e7 * nN) return false;
        const int pm = (int)(L / nN), pl = (int)(L % nN);
        const int e = (pm >= e0) + (pm >= e1) + (pm >= e2) + (pm >= e3) + (pm >= e4) + (pm >= e5) + (pm >= e6);
        u.pm = rfl(pm); u.pn = rfl(e * nN + pl); return true; }
    __device__ __forceinline__ void a_ready(const Unit&) const {}
    __device__ __forceinline__ void done(const Unit&) const {}
};

__device__ __forceinline__ u32x4 pack8(f32x4 v0, f32x4 v1) { u32x4 w; w.x = cvt_pk_bf16(v0[0], v0[1]); w.y = cvt_pk_bf16(v0[2], v0[3]); w.z = cvt_pk_bf16(v1[0], v1[1]); w.w = cvt_pk_bf16(v1[2], v1[3]); return w; }
__device__ __forceinline__ void unpack8(u32x4 w, f32x4& v0, f32x4& v1) {
    v0 = (f32x4){blo(w.x), bhi(w.x), blo(w.y), bhi(w.y)}; v1 = (f32x4){blo(w.z), bhi(w.z), blo(w.w), bhi(w.w)}; }

struct EpiProj {
    static constexpr bool PERM = true, AFTER_DRAIN = false;
    unsigned char* ws;
    __device__ __forceinline__ void operator()(const f32x4 (&acc)[2][2][4][2], const Unit& u, int wr, int wc, int fr, int fq) const {
        bf16* const QB = (bf16*)(ws + AR_QB); bf16* const KV = (bf16*)(ws + AR_KV); bf16* const UB = (bf16*)(ws + AR_UB); bf16* const RW = (bf16*)(ws + AR_RW); bf16* const HALO = (bf16*)(ws + AR_HALO); bf16* const CKV = (bf16*)(ws + AR_CKV);
        const int row0 = u.pm * BM + wr * 64 + fr, cl = wc * 32 + 8 * fq;
        if (u.pn >= 5 && u.pn < 9) {
#pragma unroll
            for (int ai = 0; ai < 2; ++ai)
#pragma unroll
                for (int m = 0; m < 4; ++m) { f32x4 a0 = acc[ai][0][m][0], a1 = acc[ai][0][m][1]; const f32x4 b0 = acc[ai][1][m][0], b1 = acc[ai][1][m][1];
#pragma unroll
                    for (int k = 0; k < 4; ++k) { a0[k] *= fsig(b0[k]); a1[k] *= fsig(b1[k]); }
                    *(u32x4*)(UB + (size_t)(row0 + ai * HALF + m * 16) * 512 + (u.pn - 5) * 128 + cl) = pack8(a0, a1); }
            return;
        }
        if (u.pn == 2) {
#pragma unroll
            for (int ai = 0; ai < 2; ++ai)
#pragma unroll
                for (int m = 0; m < 4; ++m) { const int row = row0 + ai * HALF + m * 16, b = row / SEQ, tt = row % SEQ;
#pragma unroll
                    for (int bj = 0; bj < 2; ++bj) *(u32x4*)(CKV + (((size_t)bj * (BATCH * NKV) + b * NKV + (cl >> 6)) * SEQ + tt) * 64 + (cl & 63)) = pack8(acc[ai][bj][m][0], acc[ai][bj][m][1]); }
            return;
        }
        bf16* base; int ld, c0;
        if (u.pn < 2) { base = QB; ld = LDQ; c0 = u.pn * 256; } else if (u.pn < 5) { base = KV; ld = LDKV; c0 = (u.pn - 3) * 256; } else { base = RW; ld = LDRW; c0 = (u.pn - 9) * 256; }
#pragma unroll
        for (int ai = 0; ai < 2; ++ai)
#pragma unroll
            for (int m = 0; m < 4; ++m)
#pragma unroll
                for (int bj = 0; bj < 2; ++bj) { const u32x4 w = pack8(acc[ai][bj][m][0], acc[ai][bj][m][1]);
                    *(u32x4*)(base + (size_t)(row0 + ai * HALF + m * 16) * ld + c0 + bj * HALF + cl) = w;
                    if (u.pn >= 9 && ai == 1 && m == 3 && wr == 1 && fr == 15) *(u32x4*)(HALO + (size_t)u.pm * LDRW + c0 + bj * HALF + cl) = w; }
    }
};
struct EpiStore {
    static constexpr bool PERM = true, AFTER_DRAIN = false;
    bf16* O; int ld, ntn;
    __device__ __forceinline__ void operator()(const f32x4 (&acc)[2][2][4][2], const Unit& u, int wr, int wc, int fr, int fq) const {
        const int row0 = u.pm * BM + wr * 64 + fr, c0 = (u.pn % ntn) * 256 + wc * 32 + 8 * fq;
#pragma unroll
        for (int ai = 0; ai < 2; ++ai)
#pragma unroll
            for (int m = 0; m < 4; ++m)
#pragma unroll
                for (int bj = 0; bj < 2; ++bj) *(u32x4*)(O + (size_t)(row0 + ai * HALF + m * 16) * ld + c0 + bj * HALF) = pack8(acc[ai][bj][m][0], acc[ai][bj][m][1]);
    }
};
struct EpiGate {
    static constexpr bool PERM = true, AFTER_DRAIN = false;
    unsigned char* ws; int ntn;
    __device__ __forceinline__ void operator()(const f32x4 (&acc)[2][2][4][2], const Unit& u, int wr, int wc, int fr, int fq) const {
        const bf16* const OB = (const bf16*)(ws + AR_OBUF); bf16* const MIX = (bf16*)(ws + AR_MIX);
        const int br = u.pn / ntn, row0 = u.pm * BM + wr * 64 + fr, c0 = (u.pn % ntn) * 256 + wc * 32 + 8 * fq;
        const bf16* ob = OB + (size_t)br * T * DM;
#pragma unroll
        for (int ai = 0; ai < 2; ++ai)
#pragma unroll
            for (int m = 0; m < 4; ++m)
#pragma unroll
                for (int bj = 0; bj < 2; ++bj) { const size_t off = (size_t)(row0 + ai * HALF + m * 16) * DM + c0 + bj * HALF;
                    f32x4 o0, o1; unpack8(*(const u32x4*)(ob + off), o0, o1);
                    f32x4 g0 = acc[ai][bj][m][0], g1 = acc[ai][bj][m][1];
#pragma unroll
                    for (int k = 0; k < 4; ++k) { g0[k] = fsig(g0[k]) * o0[k]; g1[k] = fsig(g1[k]) * o1[k]; }
                    if (br != 0) { f32x4 p0, p1; unpack8(*(const u32x4*)(MIX + off), p0, p1); g0 += p0; g1 += p1; }
                    *(u32x4*)(MIX + off) = pack8(g0, g1); }
    }
};
struct EpiResid {
    static constexpr bool PERM = true, AFTER_DRAIN = false;
    const float* base; float* out;
    __device__ __forceinline__ void operator()(const f32x4 (&acc)[2][2][4][2], const Unit& u, int wr, int wc, int fr, int fq) const {
        const int row0 = u.pm * BM + wr * 64 + fr, c0 = u.pn * 256 + wc * 32 + 8 * fq;
#pragma unroll
        for (int ai = 0; ai < 2; ++ai)
#pragma unroll
            for (int m = 0; m < 4; ++m)
#pragma unroll
                for (int bj = 0; bj < 2; ++bj) { const size_t off = (size_t)(row0 + ai * HALF + m * 16) * DM + c0 + bj * HALF;
                    const f32x4 x0 = *(const f32x4*)(base + off), x1 = *(const f32x4*)(base + off + 4);
                    *(f32x4*)(out + off) = x0 + acc[ai][bj][m][0]; *(f32x4*)(out + off + 4) = x1 + acc[ai][bj][m][1]; }
    }
};
struct EpiSwiglu {
    static constexpr bool PERM = true, AFTER_DRAIN = false;
    bf16* ACT; int ld, ntn;
    __device__ __forceinline__ void operator()(const f32x4 (&acc)[2][2][4][2], const Unit& u, int wr, int wc, int fr, int fq) const {
        const int row0 = u.pm * BM + wr * 64 + fr, c0 = (u.pn % ntn) * 128 + wc * 32 + 8 * fq;
#pragma unroll
        for (int ai = 0; ai < 2; ++ai)
#pragma unroll
            for (int m = 0; m < 4; ++m) { f32x4 g0 = acc[ai][0][m][0], g1 = acc[ai][0][m][1]; const f32x4 u0 = acc[ai][1][m][0], u1 = acc[ai][1][m][1];
#pragma unroll
                for (int k = 0; k < 4; ++k) { g0[k] = g0[k] * fsig(g0[k]) * u0[k]; g1[k] = g1[k] * fsig(g1[k]) * u1[k]; }
                *(u32x4*)(ACT + (size_t)(row0 + ai * HALF + m * 16) * ld + c0) = pack8(g0, g1); }
    }
};
struct EpiMoeDown {
    static constexpr bool PERM = true, AFTER_DRAIN = false;
    float* out; const int* rtok; const float* rw; int ntn;
    __device__ __forceinline__ void operator()(const f32x4 (&acc)[2][2][4][2], const Unit& u, int wr, int wc, int fr, int fq) const {
        const int row0 = u.pm * BM + wr * 64 + fr, c0 = (u.pn % ntn) * 256 + wc * 32 + 8 * fq;
#pragma unroll
        for (int ai = 0; ai < 2; ++ai)
#pragma unroll
            for (int m = 0; m < 4; ++m) { const int row = row0 + ai * HALF + m * 16; const int tok = rtok[row]; const float w = rw[row];
                if (tok >= 0) {
#pragma unroll
                    for (int bj = 0; bj < 2; ++bj) { float* o = out + (size_t)tok * DM + c0 + bj * HALF;
                        const f32x4 x0 = *(const f32x4*)o, x1 = *(const f32x4*)(o + 4);
                        *(f32x4*)o = x0 + acc[ai][bj][m][0] * w; *(f32x4*)(o + 4) = x1 + acc[ai][bj][m][1] * w; } } }
    }
};

typedef short bf16x8_t __attribute__((ext_vector_type(8)));
#define MFMA16(a, b, c) __builtin_amdgcn_mfma_f32_16x16x32_bf16((a), (b), (c), 0, 0, 0)
constexpr float ATT_C = 0.125f * 1.4426950408889634f;
constexpr int AW_IMP = 0, AW_SEL = 8448, AW_QS = 8960, AW_BYTES = 8960 + 8192;
__device__ __forceinline__ float bperm_f(float v, int srclane) { return __builtin_bit_cast(float, __builtin_amdgcn_ds_bpermute(srclane << 2, __builtin_bit_cast(int, v))); }
__device__ __forceinline__ int bperm_i(int v, int srclane) { return __builtin_amdgcn_ds_bpermute(srclane << 2, v); }
__device__ __forceinline__ bf16x8_t ldg8(const bf16* p) { return *(const bf16x8_t*)p; }
__device__ __forceinline__ bf16x8_t pack_p(const f32x4& a, const f32x4& b) {
    v4u w; w.x = cvt_pk_bf16(a[0], a[1]); w.y = cvt_pk_bf16(a[2], a[3]); w.z = cvt_pk_bf16(b[0], b[1]); w.w = cvt_pk_bf16(b[2], b[3]); return __builtin_bit_cast(bf16x8_t, w); }

__device__ __forceinline__ void nsa_attn_item(const P& p, int item, int lane, LAS unsigned char* wl) {
    const bf16* KV = WSP(bf16, AR_KV); const bf16* KC = WSP(bf16, AR_KC); const bf16* VcT = WSP(bf16, AR_VCT); const bf16* VsT = WSP(bf16, WS_VST); const bf16* VwT = WSP(bf16, WS_VWT);
    bf16* QB = WSP(bf16, AR_QB); const float* NG = WSP(float, AR_NG);
    const int bg = item / (SEQ / 16), t0 = (item % (SEQ / 16)) * 16, b = bg >> 1, g = bg & 1;
    const int col = lane & 15, fq = lane >> 4, tok = t0 + col;
    const size_t grow = (size_t)b * SEQ + tok;
    LAS float* IMP = (LAS float*)(wl + AW_IMP); LAS int* SEL = (LAS int*)(wl + AW_SEL); LAS bf16* OS = (LAS bf16*)(wl + AW_IMP);
    const int krowA = 8 * (col >> 2) + (col & 3);
    const float* gate = NG + grow * 24 + g * 12;
    LAS bf16x8_t* QS = (LAS bf16x8_t*)(wl + AW_QS) + lane;
#pragma unroll
    for (int hh = 0; hh < 4; ++hh)
#pragma unroll
        for (int ks = 0; ks < 2; ++ks) QS[(hh * 2 + ks) * 64] = ldg8(QB + grow * LDQ + (g * 4 + hh) * 64 + ks * 32 + fq * 8);
#define Qc(hh, ks) (QS[((hh) * 2 + (ks)) * 64])
    for (int i = lane; i < 16 * 132; i += 64) IMP[i] = 0.f;
    const f32x4 z4 = {0.f, 0.f, 0.f, 0.f};
    f32x4 O[4][4];
    int nvmax = (t0 + 15 >= 31) ? (((t0 + 15 - 31) >> 4) + 1) : 0; if (nvmax > NC) nvmax = NC;
    const int nch = (nvmax + 31) >> 5;
    const bf16* kcb = KC + (size_t)bg * 512 * 64; const bf16* vcb = VcT + (size_t)bg * 64 * 512;
    float linv[4] = {0.f, 0.f, 0.f, 0.f};
#pragma unroll
    for (int hh = 0; hh < 4; ++hh)
#pragma unroll
        for (int mt = 0; mt < 4; ++mt) O[hh][mt] = z4;
#pragma unroll 1
    for (int pass = 0; pass < 2; ++pass) {
#pragma unroll 1
        for (int ch = 0; ch < nch; ++ch) {
            asm volatile("" ::: "memory");
            const int k0 = 32 * ch;
            bf16x8_t ka[2][2];
#pragma unroll
            for (int tl = 0; tl < 2; ++tl)
#pragma unroll
                for (int ks = 0; ks < 2; ++ks) ka[tl][ks] = ldg8(kcb + (size_t)(k0 + krowA + 4 * tl) * 64 + ks * 32 + fq * 8);
            bf16x8_t va[4];
            if (pass == 1) {
#pragma unroll
                for (int mt = 0; mt < 4; ++mt) va[mt] = ldg8(vcb + (size_t)(16 * mt + col) * 512 + k0 + 8 * fq);
            }
            float ps[8] = {0.f, 0.f, 0.f, 0.f, 0.f, 0.f, 0.f, 0.f};
#pragma unroll
            for (int hh = 0; hh < 4; ++hh) {
                const bf16x8_t q0_ = Qc(hh, 0), q1_ = Qc(hh, 1);
                f32x4 sa = MFMA16(ka[0][0], q0_, z4); sa = MFMA16(ka[0][1], q1_, sa);
                f32x4 sb = MFMA16(ka[1][0], q0_, z4); sb = MFMA16(ka[1][1], q1_, sb);
#pragma unroll
                for (int i = 0; i < 4; ++i) { const int c = k0 + 8 * fq + i;
                    sa[i] = (16 * c + 31 <= tok) ? __builtin_amdgcn_exp2f(sa[i] * ATT_C) : 0.f; sb[i] = (16 * (c + 4) + 31 <= tok) ? __builtin_amdgcn_exp2f(sb[i] * ATT_C) : 0.f; }
                if (pass == 0) { linv[hh] += (sa[0] + sa[1]) + (sa[2] + sa[3]) + (sb[0] + sb[1]) + (sb[2] + sb[3]); }
                else {
                    sa = sa * linv[hh]; sb = sb * linv[hh];
#pragma unroll
                    for (int i = 0; i < 4; ++i) { ps[i] += sa[i]; ps[4 + i] += sb[i]; }
                    const bf16x8_t pt = pack_p(sa, sb);
#pragma unroll
                    for (int mt = 0; mt < 4; ++mt) O[hh][mt] = MFMA16(va[mt], pt, O[hh][mt]);
                }
            }
            if (pass == 1) {
                const int G0 = 8 * ch + 2 * fq; LAS float* ir = IMP + col * 132 + G0;
                __hip_atomic_fetch_add(ir, (ps[0] + ps[1]) + (ps[2] + ps[3]), __ATOMIC_RELAXED, __HIP_MEMORY_SCOPE_WORKGROUP);
                __hip_atomic_fetch_add(ir + 1, ps[3] + ((ps[4] + ps[5]) + (ps[6] + ps[7])), __ATOMIC_RELAXED, __HIP_MEMORY_SCOPE_WORKGROUP);
                if (G0 + 2 < NS) __hip_atomic_fetch_add(ir + 2, ps[7], __ATOMIC_RELAXED, __HIP_MEMORY_SCOPE_WORKGROUP);
            }
        }
        if (pass == 0) {
#pragma unroll
            for (int hh = 0; hh < 4; ++hh) { float l = linv[hh]; l += bperm_f(l, lane ^ 16); l += bperm_f(l, lane ^ 32); linv[hh] = l > 0.f ? 1.f / l : 0.f; }
        }
    }
    LDS_WAIT(); asm volatile("" ::: "memory");
    {
        const int cur = tok >> 6; LAS float* sc = IMP + col * 132;
        for (int j = fq * 32; j < fq * 32 + 32; ++j) { const bool forced = (j == 0) || (j == cur) || (j == cur - 1); const float v = sc[j]; sc[j] = forced ? 1e4f : (j <= cur ? v : -1.f); }
        LDS_WAIT(); asm volatile("" ::: "memory");
#pragma unroll 1
        for (int r = 0; r < 8; ++r) {
            float bv = sc[fq * 32]; int bj = fq * 32;
            for (int j = fq * 32 + 1; j < fq * 32 + 32; ++j) { const float v = sc[j]; if (v > bv) { bv = v; bj = j; } }
#pragma unroll
            for (int o = 16; o <= 32; o <<= 1) { const float ov = bperm_f(bv, lane ^ o); const int oj = bperm_i(bj, lane ^ o); if (ov > bv || (ov == bv && oj < bj)) { bv = ov; bj = oj; } }
            if ((bj >> 5) == fq) sc[bj] = -3e38f;
            if (fq == 0) SEL[col * 8 + r] = bj;
            LDS_WAIT(); asm volatile("" ::: "memory");
        }
    }
#pragma unroll
    for (int hh = 0; hh < 4; ++hh) { const float g0 = gate[hh * 3 + 0];
#pragma unroll
        for (int mt = 0; mt < 4; ++mt) { const f32x4 o = O[hh][mt] * g0; v2u w; w.x = cvt_pk_bf16(o[0], o[1]); w.y = cvt_pk_bf16(o[2], o[3]);
            *(LAS v2u*)(OS + (col * 4 + hh) * 64 + 16 * mt + 4 * fq) = w; } }
    LDS_WAIT(); asm volatile("" ::: "memory");
    {
        const bf16* ksb = KV + (size_t)b * SEQ * LDKV + g * 64; const bf16* vsb = VsT + (size_t)bg * 64 * SEQ;
#pragma unroll 1
        for (int tt = 0; tt < 16; ++tt) {
            const int tq = t0 + tt; const size_t qrow = (size_t)b * SEQ + tq;
            bf16x8_t Qh[2];
#pragma unroll
            for (int ks = 0; ks < 2; ++ks) { Qh[ks] = ldg8(QB + qrow * LDQ + (g * 4 + (col & 3)) * 64 + ks * 32 + fq * 8); if (col >= 4) Qh[ks] = (bf16x8_t){0, 0, 0, 0, 0, 0, 0, 0}; }
            f32x4 Os[4] = {z4, z4, z4, z4}; float ls = 0.f;
#pragma unroll 1
            for (int r8 = 0; r8 < 8; ++r8) {
                const int j = __builtin_amdgcn_readfirstlane(SEL[tt * 8 + r8]);
                if (64 * j > tq) continue;
#pragma unroll
                for (int hf = 0; hf < 2; ++hf) {
                    const int k0 = 64 * j + 32 * hf;
                    bf16x8_t ka[2][2], va[4];
#pragma unroll
                    for (int tl = 0; tl < 2; ++tl)
#pragma unroll
                        for (int ks = 0; ks < 2; ++ks) ka[tl][ks] = ldg8(ksb + (size_t)(k0 + krowA + 4 * tl) * LDKV + ks * 32 + fq * 8);
#pragma unroll
                    for (int mt = 0; mt < 4; ++mt) va[mt] = ldg8(vsb + (size_t)(16 * mt + col) * SEQ + k0 + 8 * fq);
                    f32x4 sa = MFMA16(ka[0][0], Qh[0], z4); sa = MFMA16(ka[0][1], Qh[1], sa);
                    f32x4 sb = MFMA16(ka[1][0], Qh[0], z4); sb = MFMA16(ka[1][1], Qh[1], sb);
#pragma unroll
                    for (int i = 0; i < 4; ++i) { const int kt = k0 + 8 * fq + i;
                        sa[i] = (kt <= tq) ? __builtin_amdgcn_exp2f(sa[i] * ATT_C) : 0.f; sb[i] = (kt + 4 <= tq) ? __builtin_amdgcn_exp2f(sb[i] * ATT_C) : 0.f; }
                    ls += (sa[0] + sa[1]) + (sa[2] + sa[3]) + (sb[0] + sb[1]) + (sb[2] + sb[3]);
                    const bf16x8_t pt = pack_p(sa, sb);
#pragma unroll
                    for (int mt = 0; mt < 4; ++mt) Os[mt] = MFMA16(va[mt], pt, Os[mt]);
                }
            }
            ls += bperm_f(ls, lane ^ 16); ls += bperm_f(ls, lane ^ 32);
            if (col < 4) {
                const float w = ls > 0.f ? (NG + qrow * 24 + g * 12)[col * 3 + 1] / ls : 0.f;
#pragma unroll
                for (int mt = 0; mt < 4; ++mt) { LAS v2u* dp = (LAS v2u*)(OS + (tt * 4 + col) * 64 + 16 * mt + 4 * fq); const v2u old = *dp;
                    v2u w2; w2.x = cvt_pk_bf16(blo(old.x) + w * Os[mt][0], bhi(old.x) + w * Os[mt][1]); w2.y = cvt_pk_bf16(blo(old.y) + w * Os[mt][2], bhi(old.y) + w * Os[mt][3]); *dp = w2; }
            }
        }
    }
    LDS_WAIT(); asm volatile("" ::: "memory");
    {
        const bf16* kwb = KV + (size_t)b * SEQ * LDKV + 256 + g * 64; const bf16* vwb = VwT + (size_t)bg * 64 * SEQ;
        float lw[4] = {0.f, 0.f, 0.f, 0.f};
#pragma unroll
        for (int hh = 0; hh < 4; ++hh)
#pragma unroll
            for (int mt = 0; mt < 4; ++mt) O[hh][mt] = z4;
        int kst = t0 - (WINDOW - 1); if (kst < 0) kst = 0; kst &= ~31;
#pragma unroll 1
        for (int k0 = kst; k0 <= t0 + 15; k0 += 32) {
            asm volatile("" ::: "memory");
            bf16x8_t ka[2][2], va[4];
#pragma unroll
            for (int tl = 0; tl < 2; ++tl)
#pragma unroll
                for (int ks = 0; ks < 2; ++ks) ka[tl][ks] = ldg8(kwb + (size_t)(k0 + krowA + 4 * tl) * LDKV + ks * 32 + fq * 8);
#pragma unroll
            for (int mt = 0; mt < 4; ++mt) va[mt] = ldg8(vwb + (size_t)(16 * mt + col) * SEQ + k0 + 8 * fq);
#pragma unroll
            for (int hh = 0; hh < 4; ++hh) {
                const bf16x8_t q0_ = Qc(hh, 0), q1_ = Qc(hh, 1);
                f32x4 sa = MFMA16(ka[0][0], q0_, z4); sa = MFMA16(ka[0][1], q1_, sa);
                f32x4 sb = MFMA16(ka[1][0], q0_, z4); sb = MFMA16(ka[1][1], q1_, sb);
#pragma unroll
                for (int i = 0; i < 4; ++i) { const int kt = k0 + 8 * fq + i;
                    sa[i] = (kt <= tok && kt + WINDOW > tok) ? __builtin_amdgcn_exp2f(sa[i] * ATT_C) : 0.f; sb[i] = (kt + 4 <= tok && kt + 4 + WINDOW > tok) ? __builtin_amdgcn_exp2f(sb[i] * ATT_C) : 0.f; }
                lw[hh] += (sa[0] + sa[1]) + (sa[2] + sa[3]) + (sb[0] + sb[1]) + (sb[2] + sb[3]);
                const bf16x8_t pt = pack_p(sa, sb);
#pragma unroll
                for (int mt = 0; mt < 4; ++mt) O[hh][mt] = MFMA16(va[mt], pt, O[hh][mt]);
            }
        }
#pragma unroll
        for (int hh = 0; hh < 4; ++hh) { float l = lw[hh]; l += bperm_f(l, lane ^ 16); l += bperm_f(l, lane ^ 32); const float w = l > 0.f ? gate[hh * 3 + 2] / l : 0.f;
#pragma unroll
            for (int mt = 0; mt < 4; ++mt) { const v2u old = *(LAS v2u*)(OS + (col * 4 + hh) * 64 + 16 * mt + 4 * fq);
                v2u w2; w2.x = cvt_pk_bf16(blo(old.x) + w * O[hh][mt][0], bhi(old.x) + w * O[hh][mt][1]); w2.y = cvt_pk_bf16(blo(old.y) + w * O[hh][mt][2], bhi(old.y) + w * O[hh][mt][3]);
                *(v2u*)(QB + grow * LDQ + (g * 4 + hh) * 64 + 16 * mt + 4 * fq) = w2; } }
    }
    LDS_WAIT(); asm volatile("" ::: "memory");
#undef Qc
}

constexpr int SC_STEPS = 8, SC_BUF = 6 * 1024;
__device__ __forceinline__ float dpp_sum16(float v) {
    v += __builtin_bit_cast(float, __builtin_amdgcn_update_dpp(0, __builtin_bit_cast(int, v), 0xB1, 0xF, 0xF, true));
    v += __builtin_bit_cast(float, __builtin_amdgcn_update_dpp(0, __builtin_bit_cast(int, v), 0x4E, 0xF, 0xF, true));
    v += __builtin_bit_cast(float, __builtin_amdgcn_update_dpp(0, __builtin_bit_cast(int, v), 0x141, 0xF, 0xF, true));
    v += __builtin_bit_cast(float, __builtin_amdgcn_update_dpp(0, __builtin_bit_cast(int, v), 0x140, 0xF, 0xF, true));
    return v;
}
__device__ __forceinline__ void scan_fill(const bf16* RW, const bf16* Wm, const bf16* Am, size_t trow, int h, int lane, LAS unsigned char* buf) {
    const size_t t = trow + (lane >> 3); const int sub = (lane & 7) * 8;
    const bf16* row = RW + t * LDRW + h * 64 + sub;
    __builtin_amdgcn_global_load_lds((const unsigned*)(row + LBLK), (LAS unsigned*)(buf + 0 * 1024), 16, 0, 0);
    __builtin_amdgcn_global_load_lds((const unsigned*)(Am + t * RC + h * 64 + sub), (LAS unsigned*)(buf + 1 * 1024), 16, 0, 0);
    __builtin_amdgcn_global_load_lds((const unsigned*)(Wm + t * RC + h * 64 + sub), (LAS unsigned*)(buf + 2 * 1024), 16, 0, 0);
    __builtin_amdgcn_global_load_lds((const unsigned*)(row + 512), (LAS unsigned*)(buf + 3 * 1024), 16, 0, 0);
    __builtin_amdgcn_global_load_lds((const unsigned*)(row), (LAS unsigned*)(buf + 4 * 1024), 16, 0, 0);
    __builtin_amdgcn_global_load_lds((const unsigned*)(row + 1024), (LAS unsigned*)(buf + 5 * 1024), 16, 0, 0);
}
__device__ __forceinline__ void scan_unit(const P& p, int unit, int lane, LAS unsigned char* wl) {
    const bf16* RW = WSP(bf16, AR_RW); const bf16* Wm = WSP(bf16, AR_W); const bf16* Am = WSP(bf16, AR_A); bf16* Y = WSP(bf16, AR_UB);
    const int rg = unit & 15, h = (unit >> 4) & 7, b = unit >> 7, row = rg * 4 + (lane >> 4), kq = lane & 15;
    const size_t tb = (size_t)b * SEQ;
    float s0 = 0.f, s1 = 0.f, s2 = 0.f, s3 = 0.f;
    scan_fill(RW, Wm, Am, tb, h, lane, wl);
#pragma unroll 1
    for (int c = 0; c < SEQ / SC_STEPS; ++c) {
        LAS unsigned char* buf = wl + (c & 1) * SC_BUF;
        asm volatile("s_waitcnt vmcnt(0) lgkmcnt(0)" ::: "memory");
        if (c + 1 < SEQ / SC_STEPS) scan_fill(RW, Wm, Am, tb + (size_t)(c + 1) * SC_STEPS, h, lane, wl + ((c + 1) & 1) * SC_BUF);
#pragma unroll
        for (int st = 0; st < SC_STEPS; ++st) {
            const LAS unsigned char* o = buf + st * 128 + kq * 8;
            const v2u kk = *(const LAS v2u*)(o), aa = *(const LAS v2u*)(o + 1024), ee = *(const LAS v2u*)(o + 2048), kt = *(const LAS v2u*)(o + 3072), rr = *(const LAS v2u*)(o + 4096);
            const float vv = bf2f(*(const LAS bf16*)(buf + 5 * 1024 + st * 128 + row * 2));
            const float k0 = blo(kk.x), k1 = bhi(kk.x), k2 = blo(kk.y), k3 = bhi(kk.y);
            const float skk = dpp_sum16((s0 * k0 + s1 * k1) + (s2 * k2 + s3 * k3));
            s0 = s0 - s0 * blo(ee.x) - skk * (k0 * blo(aa.x)) + vv * blo(kt.x);
            s1 = s1 - s1 * bhi(ee.x) - skk * (k1 * bhi(aa.x)) + vv * bhi(kt.x);
            s2 = s2 - s2 * blo(ee.y) - skk * (k2 * blo(aa.y)) + vv * blo(kt.y);
            s3 = s3 - s3 * bhi(ee.y) - skk * (k3 * bhi(aa.y)) + vv * bhi(kt.y);
            const float y = dpp_sum16((s0 * blo(rr.x) + s1 * bhi(rr.x)) + (s2 * blo(rr.y) + s3 * bhi(rr.y)));
            if (kq == 0) Y[(tb + (size_t)c * SC_STEPS + st) * RC + h * 64 + row] = f2bf(y);
        }
    }
    asm volatile("s_waitcnt vmcnt(0) lgkmcnt(0)" ::: "memory");
}

__device__ __forceinline__ float sum8(float v) {
    v += __builtin_bit_cast(float, __builtin_amdgcn_update_dpp(0, __builtin_bit_cast(int, v), 0xB1, 0xF, 0xF, true));
    v += __builtin_bit_cast(float, __builtin_amdgcn_update_dpp(0, __builtin_bit_cast(int, v), 0x4E, 0xF, 0xF, true));
    v += __builtin_bit_cast(float, __builtin_amdgcn_update_dpp(0, __builtin_bit_cast(int, v), 0x141, 0xF, 0xF, true));
    return v;
}
__device__ __forceinline__ void up8(v4u w, float* f) { f[0] = blo(w.x); f[1] = bhi(w.x); f[2] = blo(w.y); f[3] = bhi(w.y); f[4] = blo(w.z); f[5] = bhi(w.z); f[6] = blo(w.w); f[7] = bhi(w.w); }
__device__ __forceinline__ v4u pk8(const float* f) { v4u w; w.x = cvt_pk_bf16(f[0], f[1]); w.y = cvt_pk_bf16(f[2], f[3]); w.z = cvt_pk_bf16(f[4], f[5]); w.w = cvt_pk_bf16(f[6], f[7]); return w; }
__device__ __forceinline__ void ldf8(const float* p, float* f) { const f32x4 a = *(const f32x4*)p, b = *(const f32x4*)(p + 4); f[0] = a[0]; f[1] = a[1]; f[2] = a[2]; f[3] = a[3]; f[4] = b[0]; f[5] = b[1]; f[6] = b[2]; f[7] = b[3]; }

struct EpiLora {
    static constexpr bool PERM = true, AFTER_DRAIN = false;
    unsigned char* ws;
    __device__ __forceinline__ void operator()(const f32x4 (&acc)[2][2][4][2], const Unit& u, int wr, int wc, int fr, int fq) const {
        const int which = u.pn >> 1, row0 = u.pm * BM + wr * 64 + fr, c0 = (u.pn & 1) * 256 + wc * 32 + 8 * fq;
        bf16* const O = (bf16*)(ws + (which == 0 ? AR_W : (which == 1 ? AR_A : (which == 2 ? AR_G : AR_UB))));
#pragma unroll
        for (int ai = 0; ai < 2; ++ai)
#pragma unroll
            for (int m = 0; m < 4; ++m)
#pragma unroll
                for (int bj = 0; bj < 2; ++bj) *(u32x4*)(O + (size_t)(row0 + ai * HALF + m * 16) * RC + c0 + bj * HALF) = pack8(acc[ai][bj][m][0], acc[ai][bj][m][1]);
    }
};
__device__ __forceinline__ void ph_rwkv_b2w(const P& p, int layer, int gw, int NGW, int lane) {
    bf16* RW = WSP(bf16, AR_RW); bf16* Am = WSP(bf16, AR_A); bf16* Wm = WSP(bf16, AR_W); const bf16* VR = WSP(bf16, AR_UB); const bf16* VF = WSP(bf16, WS_VF); float* NG = WSP(float, AR_NG);
    const float* vec = p.rwkv_vec + (size_t)layer * 7 * RC; float v0[8], v1[8], v2[8], v3[8], vb[8];
    ldf8(vec + 8 * lane, v0); ldf8(vec + RC + 8 * lane, v1); ldf8(vec + 2 * RC + 8 * lane, v2); ldf8(vec + 3 * RC + 8 * lane, v3); ldf8(p.vres_b + 8 * lane, vb);
    for (int t = gw; t < T; t += NGW) {
        bf16* row = RW + (size_t)t * LDRW;
        float k[8], a[8], w[8]; up8(*(const v4u*)(row + 512 + 8 * lane), k); up8(*(const v4u*)(Am + (size_t)t * RC + 8 * lane), a); up8(*(const v4u*)(Wm + (size_t)t * RC + 8 * lane), w);
        const float gt = lane < 24 ? bf2f(row[LBLK + 320 + lane]) : 0.f;
        float kk[8], ss = 0.f;
#pragma unroll
        for (int i = 0; i < 8; ++i) {
            a[i] = fsig(a[i] + v1[i]);
            const float nx = -(w[i] + v0[i]), sp = fmaxf(nx, 0.f) + __logf(1.f + __expf(-fabsf(nx))), e = __expf(-sp - 0.5f); w[i] = 1.f - __expf(-e);
            kk[i] = k[i] * v2[i]; ss += kk[i] * kk[i]; }
        ss = sum8(ss); const float nrm = sqrtf(ss), inv = 1.f / (nrm > 1e-12f ? nrm : 1e-12f);
#pragma unroll
        for (int i = 0; i < 8; ++i) { kk[i] *= inv; k[i] = k[i] * (1.f + (a[i] - 1.f) * v3[i]); }
        if (layer == 1) { float vr[8], vv[8], vf[8]; up8(*(const v4u*)(VR + (size_t)t * RC + 8 * lane), vr); up8(*(const v4u*)(row + 1024 + 8 * lane), vv); up8(*(const v4u*)(VF + (size_t)t * RC + 8 * lane), vf);
#pragma unroll
            for (int i = 0; i < 8; ++i) vv[i] = vv[i] + (vf[i] - vv[i]) * fsig(vr[i] + vb[i]);
            *(v4u*)(row + 1024 + 8 * lane) = pk8(vv); }
        VM_WAIT();
        if (lane < 24) NG[(size_t)t * 24 + lane] = fsig(gt);
        *(v4u*)(row + LBLK + 8 * lane) = pk8(kk); *(v4u*)(row + 512 + 8 * lane) = pk8(k);
        *(v4u*)(Am + (size_t)t * RC + 8 * lane) = pk8(a); *(v4u*)(Wm + (size_t)t * RC + 8 * lane) = pk8(w);
    }
}
__device__ __forceinline__ void ph_rwkv_postw(const P& p, int layer, int gw, int NGW, int lane) {
    const bf16* RW = WSP(bf16, AR_RW); const bf16* Y = WSP(bf16, AR_UB); const bf16* Gm = WSP(bf16, AR_G); bf16* YO = WSP(bf16, AR_A);
    const float* vec = p.rwkv_vec + (size_t)layer * 7 * RC; float v4_[8], v5[8], v6[8]; ldf8(vec + 4 * RC + 8 * lane, v4_); ldf8(vec + 5 * RC + 8 * lane, v5); ldf8(vec + 6 * RC + 8 * lane, v6);
    for (int t = gw; t < T; t += NGW) {
        const bf16* row = RW + (size_t)t * LDRW;
        float y[8], r[8], k[8], v[8], g[8]; up8(*(const v4u*)(Y + (size_t)t * RC + 8 * lane), y); up8(*(const v4u*)(row + 8 * lane), r); up8(*(const v4u*)(row + 512 + 8 * lane), k);
        up8(*(const v4u*)(row + 1024 + 8 * lane), v); up8(*(const v4u*)(Gm + (size_t)t * RC + 8 * lane), g);
        float s = 0.f, bon = 0.f;
#pragma unroll
        for (int i = 0; i < 8; ++i) { s += y[i]; bon += r[i] * k[i] * v4_[i]; }
        const float m = sum8(s) * (1.f / 64.f); bon = sum8(bon);
        float q = 0.f;
#pragma unroll
        for (int i = 0; i < 8; ++i) { y[i] -= m; q += y[i] * y[i]; }
        const float rstd = 1.f / sqrtf(sum8(q) * (1.f / 64.f) + GN_EPS);
#pragma unroll
        for (int i = 0; i < 8; ++i) y[i] = (y[i] * rstd * v5[i] + v6[i] + bon * v[i]) * g[i];
        *(v4u*)(YO + (size_t)t * RC + 8 * lane) = pk8(y);
    }
}
__device__ __forceinline__ void ph_convw(const P& p, int layer, int gw, int NGW, int lane, int tid, LAS unsigned char* lds) {
    const bf16* UB = WSP(bf16, AR_UB); bf16* CO = WSP(bf16, AR_CO);
    const float* cw = p.conv_w + (size_t)layer * CONV_K * CONV_CH; const float* cv = p.conv_vec + (size_t)layer * 3 * CONV_CH;
    LAS float* wl = (LAS float*)lds;
    for (int i = tid; i < CONV_K * CONV_CH; i += NTHREADS) wl[i] = cw[i];
    __syncthreads();
    float b0[8], g1[8], b2[8]; ldf8(cv + 8 * lane, b0); ldf8(cv + CONV_CH + 8 * lane, g1); ldf8(cv + 2 * CONV_CH + 8 * lane, b2);
    for (int t = gw; t < T; t += NGW) {
        const int pos = t % SEQ, j0 = pos >= 30 ? 0 : 30 - pos;
        float a[8];
#pragma unroll
        for (int i = 0; i < 8; ++i) a[i] = b0[i];
        for (int j = j0; j < CONV_K; ++j) { float u[8]; up8(*(const v4u*)(UB + (size_t)(t - 30 + j) * CONV_CH + 8 * lane), u);
            const f32x4 w0 = *(const LAS f32x4*)(wl + j * CONV_CH + 8 * lane), w1 = *(const LAS f32x4*)(wl + j * CONV_CH + 8 * lane + 4);
#pragma unroll
            for (int i = 0; i < 4; ++i) { a[i] += u[i] * w0[i]; a[4 + i] += u[4 + i] * w1[i]; } }
        float s = 0.f;
#pragma unroll
        for (int i = 0; i < 8; ++i) s += a[i];
        const float mean = wave_sum(s, lane) * (1.f / CONV_CH); float q = 0.f;
#pragma unroll
        for (int i = 0; i < 8; ++i) { a[i] -= mean; q += a[i] * a[i]; }
        const float rstd = 1.f / sqrtf(wave_sum(q, lane) * (1.f / CONV_CH) + LN_EPS);
#pragma unroll
        for (int i = 0; i < 8; ++i) { const float y = a[i] * rstd * g1[i] + b2[i]; a[i] = y * fsig(y); }
        *(v4u*)(CO + (size_t)t * CONV_CH + 8 * lane) = pk8(a);
    }
    __syncthreads();
}
__device__ __forceinline__ void ph_cmp2w(const P& p, int layer, int gw, int NGW, int lane, LAS float* hl  ) {
    const bf16* Z = WSP(bf16, AR_HID); const float* pec = (const float*)(p.ws + WS_W + (size_t)layer * SZ_LAYERW + OFF_PEC);
    for (int it = gw; it < 2 * BATCH * NKV * NC; it += NGW) {
        const int i = it % NC, r = it / NC, bg = r % (BATCH * NKV), which = r / (BATCH * NKV);
        const bf16* z1 = Z + ((size_t)which * (BATCH * NKV * 512) + (size_t)bg * 512 + i) * 256; const bf16* z2 = z1 + 256 + 128;
#pragma unroll
        for (int jj = 0; jj < 2; ++jj) { const int j = lane + 64 * jj; const float x = bf2f(z1[j]) + bf2f(z2[j]) + pec[which * 128 + j];
            const float e = __expf(fminf(2.f * 0.7978845608028654f * (x + 0.044715f * x * x * x), 30.f)); hl[j] = 0.5f * x * (1.f + (e - 1.f) / (e + 1.f)); }
        LDS_WAIT(); asm volatile("" ::: "memory");
        const float* w2 = p.cmp_w2 + (size_t)(layer * 2 + which) * 128 * 64 + lane; float o = 0.f;
#pragma unroll 8
        for (int j = 0; j < 128; ++j) o += hl[j] * w2[j * 64];
        if (which == 0) {
            const float rs = 1.f / sqrtf(wave_sum(o * o, lane) * (1.f / 64.f) + RMS_EPS); o = o * rs * p.qk_g[(layer * 4 + 1) * 64 + lane];
            const float other = bperm_f(o, lane ^ 32); float cs, sn; rope_cs(16 * i + 31, lane & 31, cs, sn);
            o = lane < 32 ? o * cs - other * sn : o * cs + other * sn;
            WSP(bf16, AR_KC)[((size_t)bg * 512 + i) * 64 + lane] = f2bf(o);
        } else { bf16* vt = WSP(bf16, AR_VCT) + ((size_t)bg * 64 + lane) * 512; vt[i] = f2bf(o); if (i == 0) vt[NC] = 0; }
        LDS_WAIT(); asm volatile("" ::: "memory");
    }
}

struct MapPlain { bf16* base; int K; __device__ __forceinline__ bf16* operator()(int col) const { return base + (size_t)col * K; } };
struct MapGlu { bf16* base; int K, ff; __device__ __forceinline__ bf16* operator()(int col) const { return base + (size_t)glu_dest(col, ff) * K; } };
struct MapWin { unsigned char* wl; int layer; __device__ __forceinline__ bf16* operator()(int col) const { int which; const int r = win_dest(col, layer, which); const size_t off = (which ? OFF_WG : OFF_WIN) + (size_t)(r < 0 ? 0 : r) * DM * 2; return r < 0 ? nullptr : (bf16*)(wl + off); } };
template <class Map>
__device__ __forceinline__ void transpose_item(const float* W, int K, int N, const Map& mp, LAS float* scr, int item, int lane) {
    const int nblk = (N + 31) / 32, kb = item / nblk, nb = item % nblk, k0 = 64 * kb, n0 = 32 * nb;
    const int col = n0 + (lane & 31);
#pragma unroll 8
    for (int i = 0; i < 32; ++i) { const int kk = 2 * i + (lane >> 5); scr[kk * 33 + (lane & 31)] = col < N ? W[(size_t)(k0 + kk) * N + col] : 0.f; }
    LDS_WAIT(); asm volatile("" ::: "memory");
    const int c = lane & 7;
#pragma unroll
    for (int j = 0; j < 4; ++j) { const int n = (lane >> 3) + 8 * j; const LAS float* s = scr + (8 * c) * 33 + n;
        v4u o; o.x = (unsigned)f2bf(s[0]) | ((unsigned)f2bf(s[33]) << 16); o.y = (unsigned)f2bf(s[66]) | ((unsigned)f2bf(s[99]) << 16);
        o.z = (unsigned)f2bf(s[132]) | ((unsigned)f2bf(s[165]) << 16); o.w = (unsigned)f2bf(s[198]) | ((unsigned)f2bf(s[231]) << 16);
        if (n0 + n < N) { bf16* d = mp(n0 + n); if (d) *(v4u*)(d + k0 + 8 * c) = o; } }
    LDS_WAIT(); asm volatile("" ::: "memory");
}
template <class Map>
__device__ __forceinline__ bool conv_job(int& r, const float* W, int K, int N, const Map& mp, LAS float* scr, int lane) {
    const int items = (K / 64) * ((N + 31) / 32);
    if (r < items) { transpose_item(W, K, N, mp, scr, r, lane); return true; }
    r -= items; return false;
}

__device__ __forceinline__ void rms_row(const P& p, const float* xrow, const float* g, bf16* orow, int lane, bool route, int t) {
    const f32x4* xr = (const f32x4*)xrow + lane; const f32x4* gr = (const f32x4*)g + lane;
    f32x4 v[DM / 256]; float ss = 0.f;
#pragma unroll
    for (int j = 0; j < DM / 256; ++j) { v[j] = xr[64 * j]; ss += (v[j].x * v[j].x + v[j].y * v[j].y) + (v[j].z * v[j].z + v[j].w * v[j].w); }
    const float rs = 1.f / sqrtf(wave_sum(ss, lane) * (1.f / DM) + RMS_EPS);
    v2u* o8 = (v2u*)orow + lane;
#pragma unroll
    for (int j = 0; j < DM / 256; ++j) { const f32x4 gg = gr[64 * j]; v[j].x *= rs * gg.x; v[j].y *= rs * gg.y; v[j].z *= rs * gg.z; v[j].w *= rs * gg.w;
        v2u w; w.x = cvt_pk_bf16(v[j].x, v[j].y); w.y = cvt_pk_bf16(v[j].z, v[j].w); o8[64 * j] = w; }
    if (route) {
        float lg[NEXP];
#pragma unroll
        for (int e = 0; e < NEXP; ++e) lg[e] = 0.f;
#pragma unroll
        for (int j = 0; j < DM / 256; ++j) { const float* rw = p.router_w + (size_t)(4 * (lane + 64 * j)) * NEXP;
#pragma unroll
            for (int e = 0; e < NEXP; ++e) lg[e] += v[j].x * rw[e] + v[j].y * rw[NEXP + e] + v[j].z * rw[2 * NEXP + e] + v[j].w * rw[3 * NEXP + e]; }
#pragma unroll
        for (int e = 0; e < NEXP; ++e) lg[e] = wave_sum(lg[e], lane) + p.router_b[e];
        int e0 = 0; float l0 = lg[0];
#pragma unroll
        for (int e = 1; e < NEXP; ++e) if (lg[e] > l0) { l0 = lg[e]; e0 = e; }
        int e1 = -1; float l1 = -3e38f;
#pragma unroll
        for (int e = 0; e < NEXP; ++e) if (e != e0 && lg[e] > l1) { l1 = lg[e]; e1 = e; }
        if (lane == 0) { const float w0 = 1.f / (1.f + expf(l1 - l0));
            WSP(int, AR_RTE)[t] = e0 | (e1 << 8); float* rw = WSP(float, AR_RTW) + (size_t)t * 2; rw[0] = w0; rw[1] = 1.f - w0;
            unsigned* ctl = WSP(unsigned, WS_CTL); atomicAdd(ctl + CW_CNT + e0, 1u); atomicAdd(ctl + CW_CNT + 8 + e1, 1u); }
    }
}
__device__ __forceinline__ void copy_row_wave(const bf16* src, bf16* dst, int lane) {
#pragma unroll
    for (int j = 0; j < DM / 512; ++j) ((v4u*)dst)[lane + 64 * j] = ((const v4u*)src)[lane + 64 * j];
}
__device__ __forceinline__ int moe_seg_start(const unsigned* cnt, int e) { int s = 0;
#pragma unroll
    for (int k = 0; k < NEXP; ++k) s += (k < e) ? (int)((cnt[k] + 255u) & ~255u) : 0;
    return s; }

#ifndef PHMASK
#define PHMASK 0xFFFFFFFFu
#endif
#define PHM(k) (((PHMASK) >> (k)) & 1u)
constexpr int NPH = 16, NPHASES = 1 + 2 * NPH;
struct Args { const float* in[29]; float* out; unsigned char* ws; int ph_lo, ph_hi; };

__device__ __forceinline__ bool in_phase(int k, int lo, int hi) { asm volatile("" : "+s"(lo), "+s"(hi)); return lo <= k && k < hi; }
typedef const Args __attribute__((address_space(4)))* CArgsP;
__device__ __forceinline__ void fill_params_k(P& p, CArgsP a) {
    p.x = a->in[0]; p.mix_norm_g = a->in[1]; p.w_in_first = a->in[2]; p.w_in_rest = a->in[3]; p.mu_first = a->in[4]; p.mu_rest = a->in[5]; p.qk_g = a->in[6]; p.cmp_pos = a->in[7];
    p.cmp_w1 = a->in[8]; p.cmp_w2 = a->in[9]; p.nsa_w_o = a->in[10]; p.conv_w = a->in[11]; p.conv_vec = a->in[12]; p.conv_w_o = a->in[13]; p.rwkv_vec = a->in[14]; p.w_up = a->in[15];
    p.a_up = a->in[16]; p.g_up = a->in[17]; p.vres_up = a->in[18]; p.vres_b = a->in[19]; p.rwkv_w_o = a->in[20]; p.w_out = a->in[21]; p.ffn_norm_g = a->in[22]; p.dense_gu = a->in[23];
    p.dense_down = a->in[24]; p.router_w = a->in[25]; p.router_b = a->in[26]; p.moe_gu = a->in[27]; p.moe_down = a->in[28]; p.out = a->out; p.ws = a->ws;
}
__global__ void __launch_bounds__(NTHREADS, 2) mk_fwd(Args args) {
    extern __shared__ __attribute__((aligned(16))) unsigned char lds_raw[];
    LAS unsigned char* lds = (LAS unsigned char*)lds_raw;
    const int wave0 = __builtin_amdgcn_readfirstlane((int)threadIdx.x >> 6);
    const int tid = wave0 * 64 + lane_id_opaque();
    unsigned* ctl = (unsigned*)(args.ws + WS_CTL);
    for (int u = tid; u < (LDS_BYTES - LDSCTL_OFF) / 4; u += NTHREADS) ((LAS unsigned*)(lds + LDSCTL_OFF))[u] = 0u;
    __syncthreads();
    const int lo = args.ph_lo, hi = args.ph_hi;
    XcdBarrier bar; bar.bar = ctl + CW_BAR; bar.x = 0; bar.st = nullptr;
    if (hi - lo > 1) { bar.x = xb_xcc_id(); bar.st = (volatile LAS unsigned*)(lds + MISC_OFF) + 8; if (tid == 0) (void)xb_add(ctl + CW_BAR + XB_XCNT(bar.x), 1u); }
#define IN(k) in_phase((k), lo, hi)
#define MKP CArgsP ap_ = (CArgsP)__builtin_amdgcn_kernarg_segment_ptr(); asm volatile("" : "+s"(ap_)); P p; fill_params_k(p, ap_); int w0_ = wave0; asm volatile("" : "+s"(w0_)); int tid = w0_ * 64 + lane_id_opaque(); asm volatile("" : "+v"(tid)); const int lane = tid & 63, wave = __builtin_amdgcn_readfirstlane(tid >> 6); int G = gridDim.x, bid = blockIdx.x; asm volatile("" : "+s"(G), "+s"(bid)); unsigned* ctl = WSP(unsigned, WS_CTL); const long gtid = (long)bid * NTHREADS + tid, NT = (long)G * NTHREADS; const int gw = bid * NWAVES + wave, NGW = G * NWAVES; LAS float* scrw = (LAS float*)(lds + wave * 16384); (void)gtid; (void)NT; (void)gw; (void)NGW; (void)scrw; (void)lane; (void)ctl
#define SEAM(k) do { if ((k) + 1 < hi) { int w_ = wave0; asm volatile("" : "+s"(w_)); xcd_barrier(bar, w_ * 64 + lane_id_opaque()); } } while (0)

    if (PHM(16) && IN(0)) { MKP;
        constexpr int IT_WIN0 = (DM / 64) * ((N_IN_FIRST + 31) / 32), IT_WIN1 = (DM / 64) * ((N_IN_REST + 31) / 32), IT_WO = (512 / 64) * (DM / 32), IT_WOUT = (DM / 64) * (DM / 32);
        constexpr int total = IT_WIN0 + IT_WIN1 + 6 * IT_WO + 2 * IT_WOUT + (DM / 64) * (2 * DENSE_FF / 32) + (DENSE_FF / 64) * (DM / 32);
        bf16* wl0 = WSP(bf16, WS_W); bf16* wl1 = WSP(bf16, WS_W + SZ_LAYERW);
#define WOFF(b, o) ((bf16*)((unsigned char*)(b) + (o)))
        for (int it = gw; it < total; it += NGW) {
            int r = it;
            if (conv_job(r, p.w_in_first, DM, N_IN_FIRST, MapWin{(unsigned char*)wl0, 0}, scrw, lane)) continue;
            if (conv_job(r, p.w_in_rest, DM, N_IN_REST, MapWin{(unsigned char*)wl1, 1}, scrw, lane)) continue;
            if (conv_job(r, p.nsa_w_o, 512, DM, MapPlain{WOFF(wl0, OFF_WO3), 512}, scrw, lane)) continue;
            if (conv_job(r, p.rwkv_w_o, 512, DM, MapPlain{WOFF(wl0, OFF_WO3) + (size_t)DM * 512, 512}, scrw, lane)) continue;
            if (conv_job(r, p.conv_w_o, 512, DM, MapPlain{WOFF(wl0, OFF_WO3) + (size_t)2 * DM * 512, 512}, scrw, lane)) continue;
            if (conv_job(r, p.nsa_w_o + (size_t)512 * DM, 512, DM, MapPlain{WOFF(wl1, OFF_WO3), 512}, scrw, lane)) continue;
            if (conv_job(r, p.rwkv_w_o + (size_t)512 * DM, 512, DM, MapPlain{WOFF(wl1, OFF_WO3) + (size_t)DM * 512, 512}, scrw, lane)) continue;
            if (conv_job(r, p.conv_w_o + (size_t)512 * DM, 512, DM, MapPlain{WOFF(wl1, OFF_WO3) + (size_t)2 * DM * 512, 512}, scrw, lane)) continue;
            if (conv_job(r, p.w_out, DM, DM, MapPlain{WOFF(wl0, OFF_WOUT), DM}, scrw, lane)) continue;
            if (conv_job(r, p.w_out + (size_t)DM * DM, DM, DM, MapPlain{WOFF(wl1, OFF_WOUT), DM}, scrw, lane)) continue;
            if (conv_job(r, p.dense_gu, DM, 2 * DENSE_FF, MapGlu{WSP(bf16, WS_DGU), DM, DENSE_FF}, scrw, lane)) continue;
            conv_job(r, p.dense_down, DENSE_FF, DM, MapPlain{WSP(bf16, WS_DDN), DENSE_FF}, scrw, lane);
        }
        for (int l = 0; l < 2; ++l) {
            unsigned char* wlb = p.ws + WS_W + (size_t)l * SZ_LAYERW;
            bf16* win = (bf16*)(wlb + OFF_WIN);
            for (long i = gtid; i < 512L * DM; i += NT) { const int w = (int)(i / DM); const bool src = w < 288 || (w < 320 && l == 1) || (w >= 320 && w < 344); if (!src) win[(size_t)(3840 + w) * DM + i % DM] = 0; }
            bf16* lw = (bf16*)(wlb + OFF_LW);
            for (long i = gtid; i < 2048L * 384; i += NT) { const int n = (int)(i / 384), k = (int)(i % 384), blk = n >> 9, c = n & 511; float v = 0.f;
                if (blk == 0 && k < 64) v = p.w_up[((size_t)l * 64 + k) * RC + c]; else if (blk == 1 && k >= 64 && k < 128) v = p.a_up[((size_t)l * 64 + k - 64) * RC + c];
                else if (blk == 2 && k >= 128 && k < 288) v = p.g_up[((size_t)l * 160 + k - 128) * RC + c]; else if (blk == 3 && k >= 288 && k < 320 && l == 1) v = p.vres_up[(size_t)(k - 288) * RC + c];
                lw[i] = f2bf(v); }
            bf16* cw1 = (bf16*)(wlb + OFF_CW1);
            for (long i = gtid; i < 2L * 256 * 1024; i += NT) { const int k = (int)(i % 1024), n = (int)((i / 1024) % 256), which = (int)(i / (256 * 1024));
                cw1[i] = f2bf(p.cmp_w1[((size_t)(l * 2 + which) * 2048 + (n < 128 ? k : 1024 + k)) * 128 + (n & 127)]); }
            float* pec = (float*)(wlb + OFF_PEC);
            for (long i = gtid; i < 256; i += NT) { const int which = (int)(i >> 7), n = (int)(i & 127); const float* pe = p.cmp_pos + (size_t)(l * 2 + which) * 2048; const float* w1 = p.cmp_w1 + (size_t)(l * 2 + which) * 2048 * 128 + n;
                float s = 0.f; for (int k = 0; k < 2048; ++k) s += pe[k] * w1[(size_t)k * 128]; pec[i] = s; }
        }
        SEAM(0);
    }

    for (int layer = 0; layer < 2; ++layer) {
        const int pb = 1 + layer * NPH;
        if (PHM(0) && IN(pb + 0)) { MKP;
            const float* xin = layer == 0 ? p.x : p.out;
            for (int m = gw; m < T; m += NGW) rms_row(p, xin + (size_t)m * DM, p.mix_norm_g + (size_t)layer * DM, WSP(bf16, WS_H) + (size_t)m * DM, lane, false, m);
            SEAM(pb + 0);
        }
        if (PHM(1) && IN(pb + 1)) { MKP;
            Gemm g{WSP(bf16, WS_H), (const bf16*)(p.ws + WS_W + (size_t)layer * SZ_LAYERW + OFF_WIN), T, NPROJ, DM}; SOrder S; S.init(T, NPROJ, G, bid);
            EpiProj E{p.ws};
            pg8::gemm_phase<EpiProj, SOrder, true, true>(lds, g, S, E, tid);
            SEAM(pb + 1);
        }
        if (PHM(2) && IN(pb + 2)) { MKP;
            { Gemm g{WSP(bf16, AR_CKV), (const bf16*)(p.ws + WS_W + (size_t)layer * SZ_LAYERW + OFF_CW1), 2 * BATCH * NKV * 512, 512, 1024, 0}; StackOrder S{BATCH * NKV * 512 / 256, 1, 2, G, bid};
              EpiStore E{WSP(bf16, AR_HID), 256, 1};
              pg8::gemm_phase<EpiStore, StackOrder, true, true>(lds, g, S, E, tid); }
            ph_shift(p, layer, gtid, NT); ph_nsa_prep(p, layer, gtid, NT); ph_vtrans(p, gtid, NT);
            ph_convw(p, layer, gw, NGW, lane, tid, lds);
            SEAM(pb + 2); }
        if (PHM(3) && IN(pb + 3)) { MKP;
#ifndef LORA_NAIVE
            { Gemm g{WSP(bf16, WS_LB), (const bf16*)(p.ws + WS_W + (size_t)layer * SZ_LAYERW + OFF_LW), T, 2048, 384, 0}; SOrder S; S.init(T, 2048, G, bid);
              EpiLora E{p.ws};
              pg8::gemm_phase<EpiLora, SOrder, false, true>(lds, g, S, E, tid); }
#else
            { bf16* RW = WSP(bf16, AR_RW); bf16* Wm = WSP(bf16, AR_W); bf16* Am = WSP(bf16, AR_A); bf16* Gm = WSP(bf16, AR_G); const bf16* VF = WSP(bf16, WS_VF);
              const float* vec = p.rwkv_vec + (size_t)layer * 7 * RC; const float* wup = p.w_up + (size_t)layer * 64 * RC; const float* aup = p.a_up + (size_t)layer * 64 * RC; const float* gup = p.g_up + (size_t)layer * 160 * RC;
              for (long it = gtid; it < (long)T * RC; it += NT) { const int t = (int)(it / RC), c = (int)(it % RC); bf16* row = RW + (size_t)t * LDRW; const bf16* L = row + LBLK;
                  float wl = vec[c], alin = vec[RC + c], g = 0.f;
                  for (int j = 0; j < 64; ++j) { wl += bf2f(L[j]) * bf2f(f2bf(wup[j * RC + c])); alin += bf2f(L[64 + j]) * bf2f(f2bf(aup[j * RC + c])); }
                  for (int j = 0; j < 160; ++j) g += bf2f(L[128 + j]) * bf2f(f2bf(gup[j * RC + c]));
                  const float nx = -wl, sp = fmaxf(nx, 0.f) + __logf(1.f + __expf(-fabsf(nx))), e = __expf(-sp - 0.5f);
                  Wm[it] = f2bf(1.f - __expf(-e)); Am[it] = f2bf(fsig(alin)); Gm[it] = f2bf(g);
                  if (layer == 1) { float vl = p.vres_b[c]; for (int j = 0; j < 32; ++j) vl += bf2f(L[288 + j]) * bf2f(f2bf(p.vres_up[j * RC + c]));
                      const float v = bf2f(row[1024 + c]), vf = bf2f(VF[it]); row[1024 + c] = f2bf(v + (vf - v) * fsig(vl)); } } }
#endif
            SEAM(pb + 3); }
        if (PHM(4) && IN(pb + 4)) { MKP; ph_rwkv_b2w(p, layer, gw, NGW, lane); ph_cmp2w(p, layer, gw, NGW, lane, (LAS float*)(lds + wave * 512)); SEAM(pb + 4); }
        if (PHM(5) && IN(pb + 5)) { MKP;
            { LAS unsigned char* wl = lds + wave * AW_BYTES; constexpr int NSC = BATCH * 8 * 16, NIT = BATCH * NKV * (SEQ / 16);
              for (;;) { int it = 0; if (lane == 0) it = (int)atomicAdd(ctl + CW_ATT + layer, 1u); it = __builtin_amdgcn_readfirstlane(it); if (it >= NSC + NIT) break;
                  if (it < NSC) { scan_unit(p, it, lane, wl); continue; }
                  it -= NSC; const int bg = it % (BATCH * NKV), t16 = (SEQ / 16 - 1) - it / (BATCH * NKV);
                  nsa_attn_item(p, bg * (SEQ / 16) + t16, lane, wl); } }
 SEAM(pb + 5); }
        if (PHM(6) && IN(pb + 6)) { MKP; ph_rwkv_postw(p, layer, gw, NGW, lane); SEAM(pb + 6); }
        if (PHM(7) && IN(pb + 7)) { MKP;
            Gemm g{WSP(bf16, AR_QB), (const bf16*)(p.ws + WS_W + (size_t)layer * SZ_LAYERW + OFF_WO3), 3 * T, 3 * DM, 512}; StackOrder S{T / 256, DM / 256, 3, G, bid};
            EpiStore E{WSP(bf16, AR_OBUF), DM, DM / 256};
            pg8::gemm_phase<EpiStore, StackOrder, true, true>(lds, g, S, E, tid);
            { const float* xin = layer == 0 ? p.x : p.out;
              for (int m = gw; m < T; m += NGW) rms_row(p, xin + (size_t)m * DM, p.mix_norm_g + (size_t)layer * DM, WSP(bf16, WS_H) + (size_t)m * DM, lane, false, m); }
            SEAM(pb + 7);
        }
        if (PHM(8) && IN(pb + 8)) { MKP;
            Gemm g{WSP(bf16, WS_H), (const bf16*)(p.ws + WS_W + (size_t)layer * SZ_LAYERW + OFF_WG), T, 3 * DM, DM}; GateOrder S{T / 256, DM / 256, G, bid};
            EpiGate E{p.ws, DM / 256};
            pg8::gemm_phase<EpiGate, GateOrder, true, true>(lds, g, S, E, tid);
            SEAM(pb + 8);
        }
        if (PHM(9) && IN(pb + 9)) { MKP;
            Gemm g{WSP(bf16, AR_MIX), (const bf16*)(p.ws + WS_W + (size_t)layer * SZ_LAYERW + OFF_WOUT), T, DM, DM}; SOrder S; S.init(T, DM, G, bid);
            EpiResid E{layer == 0 ? p.x : p.out, p.out};
            pg8::gemm_phase<EpiResid, SOrder, true, true>(lds, g, S, E, tid);
            SEAM(pb + 9);
        }
        if (PHM(10) && IN(pb + 10)) { MKP;
            for (int m = gw; m < T; m += NGW) rms_row(p, p.out + (size_t)m * DM, p.ffn_norm_g + (size_t)layer * DM, WSP(bf16, WS_H) + (size_t)m * DM, lane, layer == 1, m);
            if (layer == 1) { int* rt = WSP(int, AR_RTOK); for (long i = gtid; i < 2L * MOE_ROWS; i += NT) rt[i] = -1; }
            SEAM(pb + 10);
        }
        if (layer == 0) {
            if (PHM(11) && IN(pb + 11)) { MKP;
                Gemm g{WSP(bf16, WS_H), WSP(bf16, WS_DGU), T, 2 * DENSE_FF, DM}; SOrder S; S.init(T, 2 * DENSE_FF, G, bid);
                EpiSwiglu E{WSP(bf16, AR_ACT), DENSE_FF, 2 * DENSE_FF / 256};
                pg8::gemm_phase<EpiSwiglu, SOrder, true, true>(lds, g, S, E, tid);
                SEAM(pb + 11);
            }
            if (PHM(12) && IN(pb + 12)) { MKP;
                Gemm g{WSP(bf16, AR_ACT), WSP(bf16, WS_DDN), T, DM, DENSE_FF}; SOrder S; S.init(T, DM, G, bid);
                EpiResid E{p.out, p.out};
                pg8::gemm_phase<EpiResid, SOrder, true, true>(lds, g, S, E, tid);
                SEAM(pb + 12);
            }
        } else {
            if (PHM(11) && IN(pb + 11)) { MKP;
                const int ig = (DM / 64) * (2 * EXPERT_FF / 32), id = (EXPERT_FF / 64) * (DM / 32);
                for (int it = gw; it < NEXP * (ig + id); it += NGW) { const int e = it / (ig + id); int r = it % (ig + id);
                    if (conv_job(r, p.moe_gu + (size_t)e * DM * 2 * EXPERT_FF, DM, 2 * EXPERT_FF, MapGlu{WSP(bf16, AR_MGU) + (size_t)e * 2 * EXPERT_FF * DM, DM, EXPERT_FF}, scrw, lane)) continue;
                    conv_job(r, p.moe_down + (size_t)e * EXPERT_FF * DM, EXPERT_FF, DM, MapPlain{WSP(bf16, AR_MDN) + (size_t)e * DM * EXPERT_FF, EXPERT_FF}, scrw, lane); }
                int* rtok = WSP(int, AR_RTOK); float* rww = WSP(float, AR_RW8); int* trow = WSP(int, AR_TROW);
                for (int t = gw; t < T; t += NGW) {
                    int row0 = 0;
                    if (lane == 0) { const int ee = WSP(int, AR_RTE)[t], e0 = ee & 255, e1 = ee >> 8; const float* w = WSP(float, AR_RTW) + (size_t)t * 2;
                        row0 = moe_seg_start(ctl + CW_CNT, e0) + (int)atomicAdd(ctl + CW_FILL + e0, 1u);
                        const int row1 = moe_seg_start(ctl + CW_CNT + 8, e1) + (int)atomicAdd(ctl + CW_FILL + 8 + e1, 1u);
                        rtok[row0] = t; rww[row0] = w[0]; rtok[MOE_ROWS + row1] = t; rww[MOE_ROWS + row1] = w[1]; trow[T + t] = row1; }
                    row0 = __builtin_amdgcn_readfirstlane(row0);
                    copy_row_wave(WSP(bf16, WS_H) + (size_t)t * DM, WSP(bf16, AR_XG) + (size_t)row0 * DM, lane);
                }
                SEAM(pb + 11);
            }
#pragma unroll
            for (int pass = 0; pass < 2; ++pass) {
                if (PHM(12) && IN(pb + 12 + 2 * pass)) { MKP;
                    Gemm g{WSP(bf16, AR_XG), WSP(bf16, AR_MGU), MOE_ROWS, NEXP * 2 * EXPERT_FF, DM}; MoeOrder S; S.init(ctl + CW_CNT + 8 * pass, 2 * EXPERT_FF / 256, G, bid);
                    EpiSwiglu E{WSP(bf16, AR_MACT), EXPERT_FF, 2 * EXPERT_FF / 256};
                    pg8::gemm_phase<EpiSwiglu, MoeOrder, true, true>(lds, g, S, E, tid);
                    SEAM(pb + 12 + 2 * pass);
                }
                if (PHM(13) && IN(pb + 13 + 2 * pass)) { MKP;
                    Gemm g{WSP(bf16, AR_MACT), WSP(bf16, AR_MDN), MOE_ROWS, NEXP * DM, EXPERT_FF}; MoeOrder S; S.init(ctl + CW_CNT + 8 * pass, DM / 256, G, bid);
                    EpiMoeDown E{p.out, WSP(int, AR_RTOK) + (size_t)pass * MOE_ROWS, WSP(float, AR_RW8) + (size_t)pass * MOE_ROWS, DM / 256};
                    pg8::gemm_phase<EpiMoeDown, MoeOrder, true, true>(lds, g, S, E, tid);
                    if (pass == 0) { const int* trow = WSP(int, AR_TROW);
                        for (int t = gw; t < T; t += NGW) copy_row_wave(WSP(bf16, WS_H) + (size_t)t * DM, WSP(bf16, AR_XG) + (size_t)trow[T + t] * DM, lane); }
                    SEAM(pb + 13 + 2 * pass);
                }
            }
        }
    }
#undef IN
#undef SEAM
}

#ifndef MK_ONE_LAUNCH
#define MK_ONE_LAUNCH 1
#endif
extern "C" void kernel_launch(void* const* d_in, const int* in_sizes, int n_in, void* d_out, int out_size, void* d_ws, size_t ws_size, hipStream_t stream) {
    static int grid = 0;
    if (grid == 0) {
        if (n_in != 29 || in_sizes[0] != T * DM || out_size != T * DM || ws_size < WS_END) { fprintf(stderr, "kernel_launch: unexpected shapes / workspace (%d inputs, ws %zu, need %zu)\n", n_in, ws_size, (size_t)WS_END); grid = -1; return; }
        int dev = 0, cus = 0;
        if (hipGetDevice(&dev) != hipSuccess || hipDeviceGetAttribute(&cus, hipDeviceAttributeMultiprocessorCount, dev) != hipSuccess) { grid = -1; return; }
        if (hipFuncSetAttribute((const void*)mk_fwd, hipFuncAttributeMaxDynamicSharedMemorySize, LDS_BYTES) != hipSuccess) { fprintf(stderr, "kernel_launch: hipFuncSetAttribute failed\n"); grid = -1; return; }
        int per_cu = 0;
        if (hipOccupancyMaxActiveBlocksPerMultiprocessor(&per_cu, (const void*)mk_fwd, NTHREADS, LDS_BYTES) != hipSuccess || per_cu < 1) { fprintf(stderr, "kernel_launch: occupancy query says %d\n", per_cu); }
        (void)hipGetLastError();
        grid = cus;
    }
    if (grid < 0) return;
    if (hipMemsetAsync((char*)d_ws + WS_CTL, 0, CTL_BYTES, stream) != hipSuccess) return;
    Args a{};
    for (int i = 0; i < 29; ++i) a.in[i] = (const float*)d_in[i];
    a.out = (float*)d_out; a.ws = (unsigned char*)d_ws;
#if MK_ONE_LAUNCH
    a.ph_lo = 0; a.ph_hi = NPHASES;
    hipLaunchKernelGGL(mk_fwd, dim3(grid), dim3(NTHREADS), LDS_BYTES, stream, a);
#else
    for (int k = 0; k < NPHASES; ++k) {
        if (k >= 1 + 13 && k < 1 + NPH) continue;
        a.ph_lo = k; a.ph_hi = k + 1;
        hipLaunchKernelGGL(mk_fwd, dim3(grid), dim3(NTHREADS), LDS_BYTES, stream, a);
    }
#endif
}
```

```cpp
#include <hip/hip_runtime.h>
#include <cstdio>
#include <cstdint>
#include <cmath>
#include <cstring>
#ifdef HOST_EMU
#define HD
#define DEV_INLINE inline
#else
#define HD __host__ __device__
#define DEV_INLINE __device__ __forceinline__
#endif

typedef unsigned short bf16;
struct alignas(16) U4 { unsigned x, y, z, w; };

#ifdef SMALL_CFG
constexpr int BATCH = 1, SEQ = 1024, DM = 128, DENSE_FF = 256, EXPERT_FF = 256;
#else
constexpr int BATCH = 8, SEQ = 8192, DM = 1024, DENSE_FF = 2816, EXPERT_FF = 3584;
#endif
constexpr int T = BATCH * SEQ;
constexpr int NHEAD = 8, NKV = 2, HG = 4, DH = 64;
constexpr int NC = SEQ / 16 - 1, NS = SEQ / 64, NSEL = 8, WINDOW = 512;
constexpr int CONV_CH = 512, CONV_K = 31, RC = 512;
constexpr int NEXP = 8;
constexpr int NSA_IN = 1304, OFF_CONV = 1304, OFF_GATE = 2328, OFF_RWKV = OFF_GATE + 3 * DM;
constexpr int N_IN_FIRST = OFF_RWKV + 1824, N_IN_REST = OFF_RWKV + 1856;
constexpr int NPROJ = 4352;
constexpr int LDQ = 512, LDKV = 512, LDRW = 2048, LBLK = 1536;
constexpr int MOE_ROWS = T + NEXP * 256;
constexpr float RMS_EPS = 1e-6f, LN_EPS = 1e-5f, GN_EPS = 64e-5f;

constexpr size_t al(size_t x) { return (x + 255) & ~(size_t)255; }
constexpr size_t WS_CTL = 0, CTL_BYTES = 1u << 20;
constexpr size_t SZ_WIN = (size_t)NPROJ * DM * 2, SZ_WG = (size_t)3 * DM * DM * 2, SZ_WO3 = (size_t)3 * DM * 512 * 2, SZ_WOUT = (size_t)DM * DM * 2;
constexpr size_t SZ_LW = (size_t)2048 * 384 * 2, SZ_CW1 = (size_t)2 * 256 * 1024 * 2, SZ_PEC = 1024;
constexpr size_t SZ_LAYERW = SZ_WIN + SZ_WG + SZ_WO3 + SZ_WOUT + SZ_LW + SZ_CW1 + SZ_PEC;
constexpr size_t WS_W = CTL_BYTES;
constexpr size_t OFF_WIN = 0, OFF_WG = SZ_WIN, OFF_WO3 = OFF_WG + SZ_WG, OFF_WOUT = OFF_WO3 + SZ_WO3, OFF_LW = OFF_WOUT + SZ_WOUT, OFF_CW1 = OFF_LW + SZ_LW, OFF_PEC = OFF_CW1 + SZ_CW1;
constexpr size_t WS_DGU = WS_W + 2 * SZ_LAYERW, SZ_DGU = (size_t)2 * DENSE_FF * DM * 2;
constexpr size_t WS_DDN = WS_DGU + SZ_DGU, SZ_DDN = (size_t)DM * DENSE_FF * 2;
constexpr size_t WS_VF = al(WS_DDN + SZ_DDN), SZ_TC = (size_t)T * 512 * 2;
constexpr size_t WS_H = WS_VF + SZ_TC, SZ_H = (size_t)T * DM * 2;
constexpr size_t WS_AR = al(WS_H + SZ_H);
constexpr size_t AR_QB = WS_AR, AR_A = AR_QB + SZ_TC, AR_CO = AR_A + SZ_TC;
constexpr size_t AR_KV = AR_CO + SZ_TC, SZ_KV = (size_t)T * LDKV * 2;
constexpr size_t AR_RW = AR_KV + SZ_KV, SZ_RW = (size_t)T * LDRW * 2;
constexpr size_t AR_W = AR_RW + SZ_RW, AR_G = AR_W + SZ_TC, AR_UB = AR_G + SZ_TC;
constexpr size_t AR_NG = AR_UB + SZ_TC, SZ_NG = (size_t)T * 24 * 4;
constexpr size_t AR_HALO = al(AR_NG + SZ_NG), SZ_HALO = (size_t)(T / 256) * LDRW * 2;
constexpr size_t AR_KC = al(AR_HALO + SZ_HALO), SZ_CMP = (size_t)BATCH * NKV * (SEQ / 16) * 64 * 2;
constexpr size_t AR_VC = AR_KC + SZ_CMP;
constexpr size_t AR_HID = al(AR_VC + SZ_CMP), SZ_HID = (size_t)BATCH * NKV * (SEQ / 16) * 2 * 128 * 4;
constexpr size_t AR_SEL = al(AR_HID + SZ_HID), SZ_SEL = (size_t)T * NKV * 8 * 4;
constexpr size_t AR_INVN = al(AR_SEL + SZ_SEL), SZ_INVN = (size_t)T * 8 * 4;
constexpr size_t AR_VCT = al(AR_INVN + SZ_INVN);
constexpr size_t AR_CKV = al(AR_VCT + SZ_CMP), SZ_CKV = (size_t)2 * T * 128;
constexpr size_t AR_END1 = al(AR_CKV + SZ_CKV * 2);
constexpr size_t WS_VST = WS_H, WS_VWT = WS_H + (size_t)T * 128 * 2, WS_LB = WS_VWT + (size_t)T * 128 * 2;
constexpr size_t AR_OBUF = AR_KV, SZ_OBUF = (size_t)3 * T * DM * 2;
constexpr size_t AR_MIX = AR_OBUF + SZ_OBUF, SZ_MIX = (size_t)T * DM * 2;
constexpr size_t AR_END2 = AR_MIX + SZ_MIX;
constexpr size_t AR_ACT = WS_AR;
constexpr size_t AR_MGU = WS_AR, SZ_MGU = (size_t)NEXP * 2 * EXPERT_FF * DM * 2;
constexpr size_t AR_MDN = AR_MGU + SZ_MGU, SZ_MDN = (size_t)NEXP * DM * EXPERT_FF * 2;
constexpr size_t AR_XG = al(AR_MDN + SZ_MDN), SZ_XG = (size_t)MOE_ROWS * DM * 2;
constexpr size_t AR_MACT = al(AR_XG + SZ_XG), SZ_MACT = (size_t)MOE_ROWS * EXPERT_FF * 2;
constexpr size_t AR_RTOK = al(AR_MACT + SZ_MACT), SZ_RTOK = (size_t)2 * MOE_ROWS * 4;
constexpr size_t AR_RW8 = al(AR_RTOK + SZ_RTOK);
constexpr size_t AR_TROW = al(AR_RW8 + SZ_RTOK), SZ_TROW = (size_t)2 * T * 4;
constexpr size_t AR_RTE = al(AR_TROW + SZ_TROW);
constexpr size_t AR_RTW = al(AR_RTE + (size_t)T * 4);
constexpr size_t AR_END3 = al(AR_RTW + (size_t)T * 8);
constexpr size_t WS_END = (AR_END1 > AR_END2 ? (AR_END1 > AR_END3 ? AR_END1 : AR_END3) : (AR_END2 > AR_END3 ? AR_END2 : AR_END3));
constexpr int CW_CNT = 64, CW_FILL = 128;
constexpr int CW_ATT = 256;
constexpr int CW_BAR = 4096;

struct P {
    const float *x, *mix_norm_g, *w_in_first, *w_in_rest, *mu_first, *mu_rest, *qk_g, *cmp_pos, *cmp_w1, *cmp_w2, *nsa_w_o, *conv_w, *conv_vec, *conv_w_o,
        *rwkv_vec, *w_up, *a_up, *g_up, *vres_up, *vres_b, *rwkv_w_o, *w_out, *ffn_norm_g, *dense_gu, *dense_down, *router_w, *router_b, *moe_gu, *moe_down;
    float* out; unsigned char* ws;
};
HD inline void fill_params(P& p, const float* const* in, float* out, unsigned char* ws) {
    p.x = in[0]; p.mix_norm_g = in[1]; p.w_in_first = in[2]; p.w_in_rest = in[3]; p.mu_first = in[4]; p.mu_rest = in[5]; p.qk_g = in[6]; p.cmp_pos = in[7];
    p.cmp_w1 = in[8]; p.cmp_w2 = in[9]; p.nsa_w_o = in[10]; p.conv_w = in[11]; p.conv_vec = in[12]; p.conv_w_o = in[13]; p.rwkv_vec = in[14]; p.w_up = in[15];
    p.a_up = in[16]; p.g_up = in[17]; p.vres_up = in[18]; p.vres_b = in[19]; p.rwkv_w_o = in[20]; p.w_out = in[21]; p.ffn_norm_g = in[22]; p.dense_gu = in[23];
    p.dense_down = in[24]; p.router_w = in[25]; p.router_b = in[26]; p.moe_gu = in[27]; p.moe_down = in[28]; p.out = out; p.ws = ws;
}
#define WSP(type, off) ((type*)(p.ws + (off)))

#ifdef HOST_EMU
#define FENCE()
#else
#define FENCE() asm volatile("" ::: "memory")
#endif
HD inline float bf2f(bf16 v) { unsigned u = (unsigned)v << 16; float f; memcpy(&f, &u, 4); return f; }
HD inline bf16 f2bf(float f) { unsigned u; memcpy(&u, &f, 4); return (bf16)((u + 0x7fffu + ((u >> 16) & 1u)) >> 16); }
HD inline float blo(unsigned v) { unsigned u = v << 16; float f; memcpy(&f, &u, 4); return f; }
HD inline float bhi(unsigned v) { unsigned u = v & 0xffff0000u; float f; memcpy(&f, &u, 4); return f; }
#if !defined(SCAN_BF16) && !defined(RKV_BF16)
HD inline bf16 f2h(float f) { return __builtin_bit_cast(unsigned short, (_Float16)f); }
#else
HD inline bf16 f2bf(float f);
HD inline bf16 f2h(float f) { return f2bf(f); }
#endif
HD inline float h2f(bf16 v) { return (float)__builtin_bit_cast(_Float16, v); }
HD inline float sigmoidf_(float x) { return 1.f / (1.f + expf(-x)); }
HD inline float dot64(const float* q, const bf16* kp) {
    const U4* k4 = (const U4*)kp; float s0 = 0.f, s1 = 0.f;
#pragma unroll
    for (int i = 0; i < 8; ++i) { const U4 v = k4[i];
        s0 += q[8 * i + 0] * blo(v.x) + q[8 * i + 2] * blo(v.y) + q[8 * i + 4] * blo(v.z) + q[8 * i + 6] * blo(v.w);
        s1 += q[8 * i + 1] * bhi(v.x) + q[8 * i + 3] * bhi(v.y) + q[8 * i + 5] * bhi(v.z) + q[8 * i + 7] * bhi(v.w); }
    return s0 + s1;
}
HD inline float dot64p(const U4* q, const bf16* kp) {
    const U4* k4 = (const U4*)kp; float s0 = 0.f, s1 = 0.f;
#pragma unroll
    for (int i = 0; i < 8; ++i) { const U4 v = k4[i], w = q[i];
        s0 += blo(w.x) * blo(v.x) + blo(w.y) * blo(v.y) + blo(w.z) * blo(v.z) + blo(w.w) * blo(v.w);
        s1 += bhi(w.x) * bhi(v.x) + bhi(w.y) * bhi(v.y) + bhi(w.z) * bhi(v.z) + bhi(w.w) * bhi(v.w); }
    return s0 + s1;
}
HD inline void ld64(const bf16* kp, float* q) {
    const U4* k4 = (const U4*)kp;
#pragma unroll
    for (int i = 0; i < 8; ++i) { const U4 v = k4[i]; q[8 * i] = blo(v.x); q[8 * i + 1] = bhi(v.x); q[8 * i + 2] = blo(v.y); q[8 * i + 3] = bhi(v.y);
        q[8 * i + 4] = blo(v.z); q[8 * i + 5] = bhi(v.z); q[8 * i + 6] = blo(v.w); q[8 * i + 7] = bhi(v.w); }
}
HD inline void axpy64(float* o, float w, const bf16* vp) {
    const U4* k4 = (const U4*)vp;
#pragma unroll
    for (int i = 0; i < 8; ++i) { const U4 v = k4[i]; o[8 * i] += w * blo(v.x); o[8 * i + 1] += w * bhi(v.x); o[8 * i + 2] += w * blo(v.y); o[8 * i + 3] += w * bhi(v.y);
        o[8 * i + 4] += w * blo(v.z); o[8 * i + 5] += w * bhi(v.z); o[8 * i + 6] += w * blo(v.w); o[8 * i + 7] += w * bhi(v.w); }
}
HD inline void axpy64s(float* o, float w, const bf16* vp) {
    const U4* k4 = (const U4*)vp;
#pragma unroll
    for (int i = 0; i < 8; ++i) { const U4 v = k4[i]; o[8 * i] = w * o[8 * i] + blo(v.x); o[8 * i + 1] = w * o[8 * i + 1] + bhi(v.x); o[8 * i + 2] = w * o[8 * i + 2] + blo(v.y); o[8 * i + 3] = w * o[8 * i + 3] + bhi(v.y);
        o[8 * i + 4] = w * o[8 * i + 4] + blo(v.z); o[8 * i + 5] = w * o[8 * i + 5] + bhi(v.z); o[8 * i + 6] = w * o[8 * i + 6] + blo(v.w); o[8 * i + 7] = w * o[8 * i + 7] + bhi(v.w); }
}
HD inline void st64(bf16* op, const float* o) {
    U4* o4 = (U4*)op;
#pragma unroll
    for (int i = 0; i < 8; ++i) { U4 v; v.x = (unsigned)f2bf(o[8 * i]) | ((unsigned)f2bf(o[8 * i + 1]) << 16); v.y = (unsigned)f2bf(o[8 * i + 2]) | ((unsigned)f2bf(o[8 * i + 3]) << 16);
        v.z = (unsigned)f2bf(o[8 * i + 4]) | ((unsigned)f2bf(o[8 * i + 5]) << 16); v.w = (unsigned)f2bf(o[8 * i + 6]) | ((unsigned)f2bf(o[8 * i + 7]) << 16); o4[i] = v; }
}

HD inline void rope_cs(int pos, int i, float& cs, float& sn) {
    const float c = exp2f(-(float)i * 0.41524101186092f) * 0.15915494309189535f, pf = (float)pos;
    const float prod = pf * c, err = fmaf(pf, c, -prod), fr = (prod - rintf(prod)) + err;
#ifdef HOST_EMU
    cs = cosf(6.283185307179586f * fr); sn = sinf(6.283185307179586f * fr);
#else
    cs = __builtin_amdgcn_cosf(fr); sn = __builtin_amdgcn_sinf(fr);
#endif
}
HD inline int win_dest(int j, int layer, int& which) {
    which = 0;
    if (j < 1280) return j;
    if (j < 1304) return 3840 + 320 + (j - 1280);
    if (j < 1816) { const int cc = j - 1304; return 1280 + 256 * (cc / 128) + cc % 128; }
    if (j < 2328) { const int cc = j - 1816; return 1280 + 256 * (cc / 128) + 128 + cc % 128; }
    if (j < OFF_RWKV) { which = 1; const int gg = j - OFF_GATE, br = gg / DM; return (br == 0 ? 0 : (br == 1 ? 2 * DM : DM)) + gg % DM; }
    const int rr = j - OFF_RWKV;
    if (rr < 1536) return 2304 + rr;
    if (rr < 1824) return 3840 + (rr - 1536);
    if (rr < 1856 && layer == 1) return 3840 + 288 + (rr - 1824);
    return -1;
}
HD inline int glu_dest(int j, int ff) { return j < ff ? 256 * (j / 128) + j % 128 : 256 * ((j - ff) / 128) + 128 + (j - ff) % 128; }

DEV_INLINE void ph_shift(const P& p, int layer, long gtid, long NT) {
    bf16* RW = WSP(bf16, AR_RW); const bf16* HALO = WSP(bf16, AR_HALO); bf16* VF = WSP(bf16, WS_VF); bf16* LB = WSP(bf16, WS_LB);
    const float* mu = layer == 0 ? p.mu_first : p.mu_rest;
    const long n = (long)(T / 256) * (LBLK + 384);
    for (long it = gtid; it < n; it += NT) {
        const int pm = (int)(it / (LBLK + 384)), c = (int)(it % (LBLK + 384));
        int mi = -1, act = 0;
        if (c < LBLK) mi = c;
        else { const int w = c - LBLK; if (w < 288) { mi = 1536 + w; act = w < 64 ? 1 : (w >= 128 ? 2 : 0); } else if (w < 320 && layer == 1) mi = 1824 + (w - 288); }
        if (mi < 0) { for (int r = 0; r < 256; ++r) LB[((size_t)pm * 256 + r) * 384 + (c - LBLK)] = 0; continue; }
        const float m = mu[mi];
        float prev = ((pm * 256) % SEQ == 0) ? 0.f : bf2f(HALO[(size_t)(pm - 1) * LDRW + c]);
        bf16* col = RW + (size_t)pm * 256 * LDRW + c;
        for (int r = 0; r < 256; ++r) {
            const float pv = bf2f(col[(size_t)r * LDRW]);
            float u = pv + (prev - pv) * m; prev = pv;
            if (act == 1) u = tanhf(u); else if (act == 2) u = sigmoidf_(u);
            if (c < LBLK) { col[(size_t)r * LDRW] = f2h(u); if (layer == 0 && c >= 1024) VF[((size_t)pm * 256 + r) * RC + (c - 1024)] = f2h(u); }
            else LB[((size_t)pm * 256 + r) * 384 + (c - LBLK)] = f2bf(u);
        }
    }
}

DEV_INLINE void ph_nsa_prep(const P& p, int layer, long gtid, long NT) {
    bf16* QB = WSP(bf16, AR_QB); bf16* KV = WSP(bf16, AR_KV);
    const long n = (long)T * 12;
    for (long it = gtid; it < n; it += NT) {
        const int t = (int)(it / 12), s = (int)(it % 12), pos = t % SEQ;
        bf16* ptr; const float* g;
        if (s < 8) { ptr = QB + (size_t)t * LDQ + s * 64; g = p.qk_g + (layer * 4 + 0) * 64; }
        else if (s < 10) { ptr = KV + (size_t)t * LDKV + (s - 8) * 64; g = p.qk_g + (layer * 4 + 2) * 64; }
        else { ptr = KV + (size_t)t * LDKV + 256 + (s - 10) * 64; g = p.qk_g + (layer * 4 + 3) * 64; }
        float v[64]; ld64(ptr, v);
        float ss = 0.f;
#pragma unroll
        for (int i = 0; i < 64; ++i) ss += v[i] * v[i];
        const float rs = 1.f / sqrtf(ss * (1.f / 64.f) + RMS_EPS);
#pragma unroll
        for (int i = 0; i < 64; ++i) v[i] = v[i] * rs * g[i];
#pragma unroll
        for (int i = 0; i < 32; ++i) {
            float cs, sn; rope_cs(pos, i, cs, sn);
            const float x1 = v[i], x2 = v[i + 32]; v[i] = x1 * cs - x2 * sn; v[i + 32] = x2 * cs + x1 * sn;
        }
        st64(ptr, v);
    }
}

DEV_INLINE void ph_vtrans(const P& p, long gtid, long NT) {
    const bf16* KV = WSP(bf16, AR_KV); bf16* VsT = WSP(bf16, WS_VST); bf16* VwT = WSP(bf16, WS_VWT);
    const long n = (long)BATCH * NKV * (SEQ / 8) * 64;
    for (long it = gtid; it < n; it += NT) {
        const int d = (int)(it % 64); long r = it / 64; const int t8 = (int)(r % (SEQ / 8)); const int bg = (int)(r / (SEQ / 8)), b = bg / NKV, g = bg % NKV;
        const bf16* src = KV + (size_t)(b * SEQ + 8 * t8) * LDKV + g * 64 + d;
        U4 s, w; unsigned short sv[8], wv[8];
#pragma unroll
        for (int j = 0; j < 8; ++j) { sv[j] = src[(size_t)j * LDKV + 128]; wv[j] = src[(size_t)j * LDKV + 384]; }
        s.x = sv[0] | ((unsigned)sv[1] << 16); s.y = sv[2] | ((unsigned)sv[3] << 16); s.z = sv[4] | ((unsigned)sv[5] << 16); s.w = sv[6] | ((unsigned)sv[7] << 16);
        w.x = wv[0] | ((unsigned)wv[1] << 16); w.y = wv[2] | ((unsigned)wv[3] << 16); w.z = wv[4] | ((unsigned)wv[5] << 16); w.w = wv[6] | ((unsigned)wv[7] << 16);
        *(U4*)(VsT + ((size_t)bg * 64 + d) * SEQ + 8 * t8) = s; *(U4*)(VwT + ((size_t)bg * 64 + d) * SEQ + 8 * t8) = w;
    }
}
namespace pg8 {
#define PG8_LAS __attribute__((address_space(3)))
typedef unsigned short bf16_t;
typedef short bf16x8 __attribute__((ext_vector_type(8)));
typedef float f32x4 __attribute__((ext_vector_type(4)));
typedef unsigned u32x4 __attribute__((ext_vector_type(4)));
constexpr int BM = 256, BK = 64, HALF = 128, HTB = HALF * BK * 2  , STAGE_BYTES = 8 * HTB, NXCD = 8, WGM = 8;

__host__ __device__ __forceinline__ int lds_byte(int r, int c) { const int st = (r >> 4) * 2 + (c >> 5), rr = r & 15, cc = c & 31, ob = rr * 64 + cc * 2; return st * 1024 + (ob ^ (((ob >> 9) & 1) << 5)); }
__host__ __device__ __forceinline__ void stage_rc(int b, int& R, int& C) { const int st = b / 1024, sb = b % 1024, swz = sb ^ (((sb >> 9) & 1) << 5); R = (st >> 1) * 16 + swz / 64; C = (st & 1) * 32 + (swz % 64) / 2; }
__host__ __device__ __forceinline__ int perm32(int rho) { const int n = rho >> 4, i = rho & 15; return 8 * (i >> 2) + 4 * n + (i & 3); }

struct Unit { int pm, pn; };
struct Gemm { const bf16_t* A; const bf16_t* Bt; int M, N, K; int lda; };

struct StaticOrder {
    int nM, nN, nwg, G, c;
    __host__ __device__ void init(int M, int N, int G_, int c_) { nM = M / BM; nN = N / BM; nwg = nM * nN; G = G_; c = c_; }
    __host__ __device__ bool next(int i, Unit& u) const {
        const long L = (long)i * G + c; if (L >= nwg) return false;
        int wgid = (int)L; { const int q = nwg / NXCD, r = nwg % NXCD, xcd = wgid % NXCD, off = wgid / NXCD; wgid = (xcd < r ? xcd * (q + 1) : r * (q + 1) + (xcd - r) * q) + off; }
        const int nig = WGM * nN, gid = wgid / nig, fm = gid * WGM, gsz = (nM - fm) < WGM ? (nM - fm) : WGM;
        u.pm = fm + ((wgid % nig) % gsz); u.pn = (wgid % nig) / gsz; return true;
    }
    __device__ __forceinline__ void a_ready(const Unit&) const {}
    __device__ __forceinline__ void done(const Unit&) const {}
};

__device__ __forceinline__ unsigned cvt_pk_bf16(float lo, float hi) { unsigned r; asm volatile("v_cvt_pk_bf16_f32 %0, %1, %2" : "=v"(r) : "v"(lo), "v"(hi)); return r; }
typedef float f32x2 __attribute__((ext_vector_type(2)));
template <class Epi, class Sched, bool ALIGN_EPI = false, bool SP2 = false>
__device__ __forceinline__ void gemm_phase(PG8_LAS unsigned char* lds, const Gemm g, const Sched& S, const Epi& E, int tid_in) {
    int tid_ = tid_in; asm volatile("" : "+v"(tid_));
    const int tid = tid_, wid = __builtin_amdgcn_readfirstlane(tid >> 6), lane = tid & 63, wr = wid >> 2, wc = wid & 3, fr = lane & 15, fq = lane >> 4;
    const int K = g.K, nt = K / BK, lda = g.lda ? g.lda : K;
    unsigned voffA[2], voffB[2];
#pragma unroll
    for (int i = 0; i < 2; ++i) { int R, C; stage_rc(tid * 16 + i * 8192, R, C); const int Rb = Epi::PERM ? ((R & ~31) + perm32(R & 31)) : R;
        voffA[i] = (unsigned)(R * lda + C) * 2u; voffB[i] = (unsigned)(Rb * K + C) * 2u; }
    const size_t kstep = (size_t)(BK * 2);
    const size_t hstepA = (size_t)HALF * lda * 2, hstepB = (size_t)HALF * K * 2;
    const size_t hstep_unused = (size_t)HALF * K * 2;
    const size_t tstepA = 2 * hstepA, tstepB = 2 * hstepB;
    const unsigned ldsw = (unsigned)wid * 1024u;
    const int aoff = lds_byte(wr * 64 + fr, fq * 8), boff = lds_byte(wc * 32 + fr, fq * 8);
#define PG8_SA(b, h) (((b) * 2 + (h)) * HTB)
#define PG8_SB(b, h) ((4 + (b) * 2 + (h)) * HTB)
#define PG8_STAGE(bufoff, gbase, voff) do { _Pragma("unroll") for (int _i = 0; _i < 2; ++_i) \
        __builtin_amdgcn_global_load_lds((const unsigned*)((const char*)(gbase) + (voff)[_i]), (PG8_LAS unsigned*)(lds + (bufoff) + ldsw + _i * 8192), 16, 0, 0); } while (0)
#define PG8_LDA(dst, b, h) do { _Pragma("unroll") for (int m = 0; m < 4; ++m) _Pragma("unroll") for (int k = 0; k < 2; ++k) dst[m][k] = *(const PG8_LAS bf16x8*)(lds + PG8_SA(b, h) + aoff + m * 2048 + k * 1024); } while (0)
#define PG8_LDB(dst, b, h) do { _Pragma("unroll") for (int n = 0; n < 2; ++n) _Pragma("unroll") for (int k = 0; k < 2; ++k) dst[n][k] = *(const PG8_LAS bf16x8*)(lds + PG8_SB(b, h) + boff + n * 2048 + k * 1024); } while (0)
#define PG8_MMA(ai, bj, At, Bt) do { __builtin_amdgcn_s_setprio(1); _Pragma("unroll") for (int m = 0; m < 4; ++m) _Pragma("unroll") for (int n = 0; n < 2; ++n) _Pragma("unroll") for (int k = 0; k < 2; ++k) \
        acc[ai][bj][m][n] = __builtin_amdgcn_mfma_f32_16x16x32_bf16(Bt[n][k], At[m][k], acc[ai][bj][m][n], 0, 0, 0); __builtin_amdgcn_s_setprio(0); } while (0)
#define PG8_WAIT_V(n) asm volatile("s_waitcnt vmcnt(" #n ")" ::: "memory")
#define PG8_WAIT_L(n) asm volatile("s_waitcnt lgkmcnt(" #n ")" ::: "memory")
#define PG8_BAR __builtin_amdgcn_s_barrier()
#define PG8_SCHED __builtin_amdgcn_sched_barrier(0)
    Unit cur, nxt; int ui = 0;
    if (!S.next(0, cur)) return;
    f32x4 acc[2][2][4][2];
#pragma unroll
    for (int a = 0; a < 2; ++a)
#pragma unroll
        for (int b = 0; b < 2; ++b)
#pragma unroll
            for (int m = 0; m < 4; ++m)
#pragma unroll
                for (int n = 0; n < 2; ++n) acc[a][b][m][n] = (f32x4){0.f, 0.f, 0.f, 0.f};
    bf16x8 At[4][2], B0[2][2], B1[2][2];
    const char* cA = (const char*)g.A + (size_t)cur.pm * tstepA; const char* cB = (const char*)g.Bt + (size_t)cur.pn * tstepB;
    S.a_ready(cur);
    if constexpr (SP2) {
        PG8_STAGE(PG8_SB(0, 0), cB, voffB); PG8_STAGE(PG8_SB(0, 1), cB + hstepB, voffB); PG8_STAGE(PG8_SA(0, 0), cA, voffA); PG8_STAGE(PG8_SA(0, 1), cA + hstepA, voffA);
        if (wr == 1) PG8_BAR;
        PG8_WAIT_V(2); PG8_BAR;
        PG8_STAGE(PG8_SB(1, 0), cB + kstep, voffB); PG8_STAGE(PG8_SA(1, 0), cA + kstep, voffA); PG8_STAGE(PG8_SB(1, 1), cB + hstepB + kstep, voffB);
        PG8_WAIT_V(6); PG8_BAR;
    } else {
        PG8_STAGE(PG8_SB(0, 0), cB, voffB); PG8_STAGE(PG8_SA(0, 0), cA, voffA); PG8_STAGE(PG8_SB(0, 1), cB + hstepB, voffB); PG8_STAGE(PG8_SA(0, 1), cA + hstepA, voffA);
        if (wr == 1) PG8_BAR;
        PG8_WAIT_V(4); PG8_BAR;
        PG8_STAGE(PG8_SB(1, 0), cB + kstep, voffB); PG8_STAGE(PG8_SA(1, 0), cA + kstep, voffA); PG8_STAGE(PG8_SB(1, 1), cB + hstepB + kstep, voffB);
        PG8_WAIT_V(6); PG8_BAR;
    }
    for (;;) {
        const bool has_next = S.next(ui + 1, nxt);
        const char* nA = has_next ? (const char*)g.A + (size_t)nxt.pm * tstepA : cA; const char* nB = has_next ? (const char*)g.Bt + (size_t)nxt.pn * tstepB : cB;
        for (int t = 0; t < nt; t += 2) {
            const bool last = (t == nt - 2);
            const char* a1 = cA + (size_t)(t + 1) * kstep;
            const char* a2 = last ? nA : cA + (size_t)(t + 2) * kstep; const char* b2 = last ? nB : cB + (size_t)(t + 2) * kstep;
            const char* a3 = a2 + kstep; const char* b3 = b2 + kstep;
            if (last && has_next) S.a_ready(nxt);
            if constexpr (SP2) {
            PG8_LDB(B0, 0, 0); PG8_LDB(B1, 0, 1); PG8_SCHED; PG8_LDA(At, 0, 0); PG8_STAGE(PG8_SA(1, 1), a1 + hstepA, voffA);
            PG8_WAIT_V(8); PG8_WAIT_L(0); PG8_BAR; PG8_MMA(0, 0, At, B0); PG8_MMA(0, 1, At, B1); PG8_BAR; PG8_SCHED;
            PG8_LDA(At, 0, 1); PG8_STAGE(PG8_SB(0, 0), b2, voffB); PG8_STAGE(PG8_SB(0, 1), b2 + hstepB, voffB); PG8_STAGE(PG8_SA(0, 0), a2, voffA);
            PG8_WAIT_V(8); PG8_WAIT_L(0); PG8_BAR; PG8_MMA(1, 0, At, B0); PG8_MMA(1, 1, At, B1); PG8_BAR; PG8_SCHED;
            PG8_LDB(B0, 1, 0); PG8_LDB(B1, 1, 1); PG8_SCHED; PG8_LDA(At, 1, 0); PG8_STAGE(PG8_SA(0, 1), a2 + hstepA, voffA);
            PG8_WAIT_V(8); PG8_WAIT_L(0); PG8_BAR; PG8_MMA(0, 0, At, B0); PG8_MMA(0, 1, At, B1); PG8_BAR; PG8_SCHED;
            PG8_LDA(At, 1, 1); PG8_STAGE(PG8_SB(1, 0), b3, voffB); PG8_STAGE(PG8_SB(1, 1), b3 + hstepB, voffB); PG8_STAGE(PG8_SA(1, 0), a3, voffA);
            PG8_WAIT_V(8); PG8_WAIT_L(0); PG8_BAR; PG8_MMA(1, 0, At, B0); PG8_MMA(1, 1, At, B1); PG8_BAR; PG8_SCHED;
            } else {
            PG8_LDB(B0, 0, 0); PG8_SCHED; PG8_LDA(At, 0, 0); PG8_STAGE(PG8_SA(1, 1), a1 + hstepA, voffA);
            PG8_WAIT_L(8); PG8_BAR; PG8_WAIT_L(0); PG8_MMA(0, 0, At, B0); PG8_BAR; PG8_SCHED;
            PG8_LDB(B1, 0, 1); PG8_STAGE(PG8_SB(0, 0), b2, voffB);
            PG8_BAR; PG8_WAIT_L(0); PG8_MMA(0, 1, At, B1); PG8_BAR;
            PG8_LDA(At, 0, 1); PG8_STAGE(PG8_SA(0, 0), a2, voffA);
            PG8_BAR; PG8_WAIT_L(0); PG8_MMA(1, 0, At, B0); PG8_BAR; PG8_SCHED;
            PG8_STAGE(PG8_SB(0, 1), b2 + hstepB, voffB);
            PG8_WAIT_V(6); PG8_BAR; PG8_MMA(1, 1, At, B1); PG8_BAR;
            PG8_LDB(B0, 1, 0); PG8_SCHED; PG8_LDA(At, 1, 0); PG8_STAGE(PG8_SA(0, 1), a2 + hstepA, voffA);
            PG8_WAIT_L(8); PG8_BAR; PG8_WAIT_L(0); PG8_MMA(0, 0, At, B0); PG8_BAR; PG8_SCHED;
            PG8_LDB(B1, 1, 1); PG8_STAGE(PG8_SB(1, 0), b3, voffB);
            PG8_BAR; PG8_WAIT_L(0); PG8_MMA(0, 1, At, B1); PG8_BAR;
            PG8_LDA(At, 1, 1); PG8_STAGE(PG8_SA(1, 0), a3, voffA);
            PG8_BAR; PG8_WAIT_L(0); PG8_MMA(1, 0, At, B0); PG8_BAR; PG8_SCHED;
            PG8_STAGE(PG8_SB(1, 1), b3 + hstepB, voffB);
            PG8_WAIT_V(6); PG8_BAR; PG8_MMA(1, 1, At, B1); PG8_BAR;
            }
        }
        if constexpr (ALIGN_EPI) { if (wr == 0) PG8_BAR; }
        if constexpr (!Epi::AFTER_DRAIN) { E(acc, cur, wr, wc, fr, fq); S.done(cur); }
        if (!has_next) break;
#pragma unroll
        for (int a = 0; a < 2; ++a)
#pragma unroll
            for (int b = 0; b < 2; ++b)
#pragma unroll
                for (int m = 0; m < 4; ++m)
#pragma unroll
                    for (int n = 0; n < 2; ++n) acc[a][b][m][n] = (f32x4){0.f, 0.f, 0.f, 0.f};
        cur = nxt; cA = nA; cB = nB; ++ui;
        if constexpr (ALIGN_EPI) { if (wr == 1) PG8_BAR; }
    }
    PG8_WAIT_V(0);
    if constexpr (!ALIGN_EPI) { if (wr == 0) PG8_BAR; }
    PG8_BAR;
    if constexpr (Epi::AFTER_DRAIN) { E.fused(acc, cur, wr, wc, fr, fq, lds, wid, lane); S.done(cur); }
#undef PG8_SA
#undef PG8_SB
#undef PG8_STAGE
#undef PG8_LDA
#undef PG8_LDB
#undef PG8_MMA
#undef PG8_WAIT_V
#undef PG8_WAIT_L
#undef PG8_BAR
#undef PG8_SCHED
}
}

#define LAS __attribute__((address_space(3)))
#define XB_TMO      128
#define XB_XCNT(j)  (256  + 64 * (j))
#define XB_XSUB(j)  (1280 + 64 * (j))
#define XB_XGEN(j)  (2304 + 64 * (j))
#define XB_TOP      3328
#define XB_TOPGEN   3392
#define XCD_BAR_WORDS 3456
#define XB_SPIN_CAP (1u << 22)

__device__ __forceinline__ unsigned xb_ld(unsigned* p)              { return __hip_atomic_load(p, __ATOMIC_RELAXED, __HIP_MEMORY_SCOPE_AGENT); }
__device__ __forceinline__ unsigned xb_add(unsigned* p, unsigned v) { return __hip_atomic_fetch_add(p, v, __ATOMIC_RELAXED, __HIP_MEMORY_SCOPE_AGENT); }
__device__ __forceinline__ unsigned xb_xcc_id() { return (unsigned)__builtin_amdgcn_s_getreg((3 << 11) | 20) & 0xFu; }
#define XB_SPIN(cond, bar) do { unsigned _sp = 0; while (cond) { __builtin_amdgcn_s_sleep(1); \
    if ((++_sp & 255u) == 0u) { if (xb_ld(&(bar)[XB_TMO])) break; if (_sp > XB_SPIN_CAP) { atomicAdd(&(bar)[XB_TMO], 1u); break; } } } } while (0)

struct XcdBarrier {
    unsigned* bar; unsigned x;
    volatile LAS unsigned* st;
};

__device__ __forceinline__ XcdBarrier xcd_barrier_post(unsigned* bar, volatile LAS unsigned* st) {
    XcdBarrier b; b.bar = bar; b.x = xb_xcc_id(); b.st = st;
    if (threadIdx.x == 0) (void)xb_add(&bar[XB_XCNT(b.x)], 1u);
    return b;
}
__device__ __forceinline__ void xcd_barrier_complete(unsigned* bar, unsigned x, unsigned& nloc, unsigned& nx) {
    const unsigned G = gridDim.x * gridDim.y * gridDim.z;
    unsigned sum, cnt, mine, sp = 0u;
    for (;;) {
        sum = 0u; cnt = 0u; mine = 0u;
#pragma unroll
        for (unsigned j = 0; j < 16; ++j) { const unsigned c = xb_ld(&bar[XB_XCNT(j)]); sum += c; cnt += (c > 0u) ? 1u : 0u; mine = (j == x) ? c : mine; }
        if (sum == G) break;
        __builtin_amdgcn_s_sleep(1);
        if ((++sp & 255u) == 0u) { if (xb_ld(&bar[XB_TMO])) break; if (sp > XB_SPIN_CAP) { atomicAdd(&bar[XB_TMO], 1u); break; } }
    }
    nloc = mine > 0u ? mine : 1u; nx = cnt > 0u ? cnt : 1u;
}

__device__ __forceinline__ void xcd_barrier(const XcdBarrier& b, int tid_x  ) {
    asm volatile("s_waitcnt vmcnt(0)" ::: "memory");
    __syncthreads();
    if (tid_x == 0) {
        unsigned* bar = b.bar; asm volatile("" : "+s"(bar));
        unsigned xx = b.x; asm volatile("" : "+s"(xx));
        __builtin_amdgcn_s_waitcnt(0);
        unsigned nloc = b.st[0], nx = b.st[1];
        if (nloc == 0u) { xcd_barrier_complete(bar, xx, nloc, nx); b.st[0] = nloc; b.st[1] = nx; }
        const unsigned old = xb_add(&bar[XB_XSUB(xx)], 1u);
        const unsigned gen = old / nloc;
        if (old + 1u == (gen + 1u) * nloc) {
            __builtin_amdgcn_fence(__ATOMIC_RELEASE, "agent");
            asm volatile("s_waitcnt vmcnt(0)" ::: "memory");
            const unsigned og = xb_add(&bar[XB_TOP], 1u);
            const unsigned tg = og / nx;
            if (og + 1u == (tg + 1u) * nx) xb_add(&bar[XB_TOPGEN], 1u);
            else XB_SPIN(xb_ld(&bar[XB_TOPGEN]) == tg, bar);
            __builtin_amdgcn_fence(__ATOMIC_ACQUIRE, "agent");
            xb_add(&bar[XB_XGEN(xx)], 1u);
            asm volatile("s_waitcnt vmcnt(0)" ::: "memory");
        } else {
            XB_SPIN(xb_ld(&bar[XB_XGEN(xx)]) == gen, bar);
            __builtin_amdgcn_fence(__ATOMIC_ACQUIRE, "agent");
            asm volatile("s_waitcnt vmcnt(0)" ::: "memory");
        }
    }
    __syncthreads();
}
#define GAS __attribute__((address_space(1)))
typedef unsigned v4u __attribute__((ext_vector_type(4)));
typedef unsigned v2u __attribute__((ext_vector_type(2)));
typedef GAS unsigned gu32;
#define RLX_AGENT __ATOMIC_RELAXED, __HIP_MEMORY_SCOPE_AGENT
#define LDS_WAIT() asm volatile("s_waitcnt lgkmcnt(0)" ::: "memory")
#define VM_WAIT() asm volatile("s_waitcnt vmcnt(0)" ::: "memory")
using pg8::f32x4; using pg8::Unit; using pg8::Gemm; using pg8::BM; using pg8::HALF; using pg8::cvt_pk_bf16; using pg8::u32x4;

constexpr int NWAVES = 8, NTHREADS = 512;
constexpr int RING_BYTES = 131072, LDSCTL_OFF = 147456 - 1024, MISC_OFF = LDSCTL_OFF + 320, LDS_BYTES = 147456;

__device__ __forceinline__ float wave_sum(float v, int lane) {
#pragma unroll
    for (int o = 1; o < 64; o <<= 1) v += __builtin_bit_cast(float, __builtin_amdgcn_ds_bpermute((lane ^ o) << 2, __builtin_bit_cast(int, v)));
    return v;
}
__device__ __forceinline__ float fsig(float x) { return __builtin_amdgcn_rcpf(1.f + __expf(-x)); }

__device__ __forceinline__ int lane_id_opaque() { int l; asm volatile("v_mbcnt_lo_u32_b32 %0, -1, 0\n\tv_mbcnt_hi_u32_b32 %0, -1, %0" : "=v"(l)); return l; }
__device__ __forceinline__ int rfl(int v) { return __builtin_amdgcn_readfirstlane(v); }
struct SOrder {
    pg8::StaticOrder s;
    __device__ void init(int M, int N, int G, int c) { s.init(M, N, G, c); }
    __device__ bool next(int i, Unit& u) const { Unit t; t.pm = 0; t.pn = 0; const bool ok = s.next(i, t); u.pm = rfl(t.pm); u.pn = rfl(t.pn); return ok; }
    __device__ __forceinline__ void a_ready(const Unit&) const {}
    __device__ __forceinline__ void done(const Unit&) const {}
};
struct StackOrder {
    int nM, nN, nb, G, c;
    __device__ bool next(int i, Unit& u) const { const long L = (long)i * G + c; if (L >= (long)nb * nM * nN) return false;
        const int br = (int)(L / (nM * nN)), rem = (int)(L % (nM * nN)); u.pm = rfl(br * nM + rem / nN); u.pn = rfl(br * nN + rem % nN); return true; }
    __device__ __forceinline__ void a_ready(const Unit&) const {}
    __device__ __forceinline__ void done(const Unit&) const {}
};
struct GateOrder {
    int nM, nN, G, c;
    __device__ bool next(int i, Unit& u) const { const int j = i / 3, br = i - 3 * j; const long L = (long)j * G + c; if (L >= (long)nM * nN) return false;
        u.pm = rfl((int)(L / nN)); u.pn = rfl(br * nN + (int)(L % nN)); return true; }
    __device__ __forceinline__ void a_ready(const Unit&) const {}
    __device__ __forceinline__ void done(const Unit&) const {}
};
struct MoeOrder {
    int nN, G, c, e0, e1, e2, e3, e4, e5, e6, e7;
    __device__ void init(const unsigned* cnt, int nN_, int G_, int c_) { nN = nN_; G = G_; c = c_;
        int s = 0; s += (cnt[0] + 255) >> 8; e0 = s; s += (cnt[1] + 255) >> 8; e1 = s; s += (cnt[2] + 255) >> 8; e2 = s; s += (cnt[3] + 255) >> 8; e3 = s;
        s += (cnt[4] + 255) >> 8; e4 = s; s += (cnt[5] + 255) >> 8; e5 = s; s += (cnt[6] + 255) >> 8; e6 = s; s += (cnt[7] + 255) >> 8; e7 = s; }
    __device__ bool next(int i, Unit& u) const { const long L = (long)i * G + c; if (L >= (long)e7 * nN) return false;
        const int pm = (int)(L / nN), pl = (int)(L % nN);
        const int e = (pm >= e0) + (pm >= e1) + (pm >= e2) + (pm >= e3) + (pm >= e4) + (pm >= e5) + (pm >= e6);
        u.pm = rfl(pm); u.pn = rfl(e * nN + pl); return true; }
    __device__ __forceinline__ void a_ready(const Unit&) const {}
    __device__ __forceinline__ void done(const Unit&) const {}
};

__device__ __forceinline__ u32x4 pack8(f32x4 v0, f32x4 v1) { u32x4 w; w.x = cvt_pk_bf16(v0[0], v0[1]); w.y = cvt_pk_bf16(v0[2], v0[3]); w.z = cvt_pk_bf16(v1[0], v1[1]); w.w = cvt_pk_bf16(v1[2], v1[3]); return w; }
__device__ __forceinline__ void unpack8(u32x4 w, f32x4& v0, f32x4& v1) {
    v0 = (f32x4){blo(w.x), bhi(w.x), blo(w.y), bhi(w.y)}; v1 = (f32x4){blo(w.z), bhi(w.z), blo(w.w), bhi(w.w)}; }

struct EpiProj {
    static constexpr bool PERM = true, AFTER_DRAIN = false;
    unsigned char* ws;
    __device__ __forceinline__ void operator()(const f32x4 (&acc)[2][2][4][2], const Unit& u, int wr, int wc, int fr, int fq) const {
        bf16* const QB = (bf16*)(ws + AR_QB); bf16* const KV = (bf16*)(ws + AR_KV); bf16* const UB = (bf16*)(ws + AR_UB); bf16* const RW = (bf16*)(ws + AR_RW); bf16* const HALO = (bf16*)(ws + AR_HALO); bf16* const CKV = (bf16*)(ws + AR_CKV);
        const int row0 = u.pm * BM + wr * 64 + fr, cl = wc * 32 + 8 * fq;
        if (u.pn >= 5 && u.pn < 9) {
#pragma unroll
            for (int ai = 0; ai < 2; ++ai)
#pragma unroll
                for (int m = 0; m < 4; ++m) { f32x4 a0 = acc[ai][0][m][0], a1 = acc[ai][0][m][1]; const f32x4 b0 = acc[ai][1][m][0], b1 = acc[ai][1][m][1];
#pragma unroll
                    for (int k = 0; k < 4; ++k) { a0[k] *= fsig(b0[k]); a1[k] *= fsig(b1[k]); }
                    *(u32x4*)(UB + (size_t)(row0 + ai * HALF + m * 16) * 512 + (u.pn - 5) * 128 + cl) = pack8(a0, a1); }
            return;
        }
        if (u.pn == 2) {
#pragma unroll
            for (int ai = 0; ai < 2; ++ai)
#pragma unroll
                for (int m = 0; m < 4; ++m) { const int row = row0 + ai * HALF + m * 16, b = row / SEQ, tt = row % SEQ;
#pragma unroll
                    for (int bj = 0; bj < 2; ++bj) *(u32x4*)(CKV + (((size_t)bj * (BATCH * NKV) + b * NKV + (cl >> 6)) * SEQ + tt) * 64 + (cl & 63)) = pack8(acc[ai][bj][m][0], acc[ai][bj][m][1]); }
            return;
        }
        bf16* base; int ld, c0;
        if (u.pn < 2) { base = QB; ld = LDQ; c0 = u.pn * 256; } else if (u.pn < 5) { base = KV; ld = LDKV; c0 = (u.pn - 3) * 256; } else { base = RW; ld = LDRW; c0 = (u.pn - 9) * 256; }
#pragma unroll
        for (int ai = 0; ai < 2; ++ai)
#pragma unroll
            for (int m = 0; m < 4; ++m)
#pragma unroll
                for (int bj = 0; bj < 2; ++bj) { const u32x4 w = pack8(acc[ai][bj][m][0], acc[ai][bj][m][1]);
                    *(u32x4*)(base + (size_t)(row0 + ai * HALF + m * 16) * ld + c0 + bj * HALF + cl) = w;
                    if (u.pn >= 9 && ai == 1 && m == 3 && wr == 1 && fr == 15) *(u32x4*)(HALO + (size_t)u.pm * LDRW + c0 + bj * HALF + cl) = w; }
    }
};
struct EpiStore {
    static constexpr bool PERM = true, AFTER_DRAIN = false;
    bf16* O; int ld, ntn;
    __device__ __forceinline__ void operator()(const f32x4 (&acc)[2][2][4][2], const Unit& u, int wr, int wc, int fr, int fq) const {
        const int row0 = u.pm * BM + wr * 64 + fr, c0 = (u.pn % ntn) * 256 + wc * 32 + 8 * fq;
#pragma unroll
        for (int ai = 0; ai < 2; ++ai)
#pragma unroll
            for (int m = 0; m < 4; ++m)
#pragma unroll
                for (int bj = 0; bj < 2; ++bj) *(u32x4*)(O + (size_t)(row0 + ai * HALF + m * 16) * ld + c0 + bj * HALF) = pack8(acc[ai][bj][m][0], acc[ai][bj][m][1]);
    }
};
struct EpiGate {
    static constexpr bool PERM = true, AFTER_DRAIN = false;
    unsigned char* ws; int ntn;
    __device__ __forceinline__ void operator()(const f32x4 (&acc)[2][2][4][2], const Unit& u, int wr, int wc, int fr, int fq) const {
        const bf16* const OB = (const bf16*)(ws + AR_OBUF); bf16* const MIX = (bf16*)(ws + AR_MIX);
        const int br = u.pn / ntn, row0 = u.pm * BM + wr * 64 + fr, c0 = (u.pn % ntn) * 256 + wc * 32 + 8 * fq;
        const bf16* ob = OB + (size_t)br * T * DM;
#pragma unroll
        for (int ai = 0; ai < 2; ++ai)
#pragma unroll
            for (int m = 0; m < 4; ++m)
#pragma unroll
                for (int bj = 0; bj < 2; ++bj) { const size_t off = (size_t)(row0 + ai * HALF + m * 16) * DM + c0 + bj * HALF;
                    f32x4 o0, o1; unpack8(*(const u32x4*)(ob + off), o0, o1);
                    f32x4 g0 = acc[ai][bj][m][0], g1 = acc[ai][bj][m][1];
#pragma unroll
                    for (int k = 0; k < 4; ++k) { g0[k] = fsig(g0[k]) * o0[k]; g1[k] = fsig(g1[k]) * o1[k]; }
                    if (br != 0) { f32x4 p0, p1; unpack8(*(const u32x4*)(MIX + off), p0, p1); g0 += p0; g1 += p1; }
                    *(u32x4*)(MIX + off) = pack8(g0, g1); }
    }
};
struct EpiResid {
    static constexpr bool PERM = true, AFTER_DRAIN = false;
    const float* base; float* out;
    __device__ __forceinline__ void operator()(const f32x4 (&acc)[2][2][4][2], const Unit& u, int wr, int wc, int fr, int fq) const {
        const int row0 = u.pm * BM + wr * 64 + fr, c0 = u.pn * 256 + wc * 32 + 8 * fq;
#pragma unroll
        for (int ai = 0; ai < 2; ++ai)
#pragma unroll
            for (int m = 0; m < 4; ++m)
#pragma unroll
                for (int bj = 0; bj < 2; ++bj) { const size_t off = (size_t)(row0 + ai * HALF + m * 16) * DM + c0 + bj * HALF;
                    const f32x4 x0 = *(const f32x4*)(base + off), x1 = *(const f32x4*)(base + off + 4);
                    *(f32x4*)(out + off) = x0 + acc[ai][bj][m][0]; *(f32x4*)(out + off + 4) = x1 + acc[ai][bj][m][1]; }
    }
};
struct EpiSwiglu {
    static constexpr bool PERM = true, AFTER_DRAIN = false;
    bf16* ACT; int ld, ntn;
    __device__ __forceinline__ void operator()(const f32x4 (&acc)[2][2][4][2], const Unit& u, int wr, int wc, int fr, int fq) const {
        const int row0 = u.pm * BM + wr * 64 + fr, c0 = (u.pn % ntn) * 128 + wc * 32 + 8 * fq;
#pragma unroll
        for (int ai = 0; ai < 2; ++ai)
#pragma unroll
            for (int m = 0; m < 4; ++m) { f32x4 g0 = acc[ai][0][m][0], g1 = acc[ai][0][m][1]; const f32x4 u0 = acc[ai][1][m][0], u1 = acc[ai][1][m][1];
#pragma unroll
                for (int k = 0; k < 4; ++k) { g0[k] = g0[k] * fsig(g0[k]) * u0[k]; g1[k] = g1[k] * fsig(g1[k]) * u1[k]; }
                *(u32x4*)(ACT + (size_t)(row0 + ai * HALF + m * 16) * ld + c0) = pack8(g0, g1); }
    }
};
struct EpiMoeDown {
    static constexpr bool PERM = true, AFTER_DRAIN = false;
    float* out; const int* rtok; const float* rw; int ntn;
    __device__ __forceinline__ void operator()(const f32x4 (&acc)[2][2][4][2], const Unit& u, int wr, int wc, int fr, int fq) const {
        const int row0 = u.pm * BM + wr * 64 + fr, c0 = (u.pn % ntn) * 256 + wc * 32 + 8 * fq;
#pragma unroll
        for (int ai = 0; ai < 2; ++ai)
#pragma unroll
            for (int m = 0; m < 4; ++m) { const int row = row0 + ai * HALF + m * 16; const int tok = rtok[row]; const float w = rw[row];
                if (tok >= 0) {
#pragma unroll
                    for (int bj = 0; bj < 2; ++bj) { float* o = out + (size_t)tok * DM + c0 + bj * HALF;
                        const f32x4 x0 = *(const f32x4*)o, x1 = *(const f32x4*)(o + 4);
                        *(f32x4*)o = x0 + acc[ai][bj][m][0] * w; *(f32x4*)(o + 4) = x1 + acc[ai][bj][m][1] * w; } } }
    }
};

typedef short bf16x8_t __attribute__((ext_vector_type(8)));
#define MFMA16(a, b, c) __builtin_amdgcn_mfma_f32_16x16x32_bf16((a), (b), (c), 0, 0, 0)
constexpr float ATT_C = 0.125f * 1.4426950408889634f;
constexpr int AW_IMP = 0, AW_SEL = 8448, AW_QS = 8960, AW_BYTES = 8960 + 8192;
__device__ __forceinline__ float bperm_f(float v, int srclane) { return __builtin_bit_cast(float, __builtin_amdgcn_ds_bpermute(srclane << 2, __builtin_bit_cast(int, v))); }
__device__ __forceinline__ int bperm_i(int v, int srclane) { return __builtin_amdgcn_ds_bpermute(srclane << 2, v); }
__device__ __forceinline__ bf16x8_t ldg8(const bf16* p) { return *(const bf16x8_t*)p; }
__device__ __forceinline__ bf16x8_t pack_p(const f32x4& a, const f32x4& b) {
    v4u w; w.x = cvt_pk_bf16(a[0], a[1]); w.y = cvt_pk_bf16(a[2], a[3]); w.z = cvt_pk_bf16(b[0], b[1]); w.w = cvt_pk_bf16(b[2], b[3]); return __builtin_bit_cast(bf16x8_t, w); }

__device__ __forceinline__ void nsa_attn_item(const P& p, int item, int lane, LAS unsigned char* wl) {
    const bf16* KV = WSP(bf16, AR_KV); const bf16* KC = WSP(bf16, AR_KC); const bf16* VcT = WSP(bf16, AR_VCT); const bf16* VsT = WSP(bf16, WS_VST); const bf16* VwT = WSP(bf16, WS_VWT);
    bf16* QB = WSP(bf16, AR_QB); const float* NG = WSP(float, AR_NG);
    const int bg = item / (SEQ / 16), t0 = (item % (SEQ / 16)) * 16, b = bg >> 1, g = bg & 1;
    const int col = lane & 15, fq = lane >> 4, tok = t0 + col;
    const size_t grow = (size_t)b * SEQ + tok;
    LAS float* IMP = (LAS float*)(wl + AW_IMP); LAS int* SEL = (LAS int*)(wl + AW_SEL); LAS bf16* OS = (LAS bf16*)(wl + AW_IMP);
    const int krowA = 8 * (col >> 2) + (col & 3);
    const float* gate = NG + grow * 24 + g * 12;
    LAS bf16x8_t* QS = (LAS bf16x8_t*)(wl + AW_QS) + lane;
#pragma unroll
    for (int hh = 0; hh < 4; ++hh)
#pragma unroll
        for (int ks = 0; ks < 2; ++ks) QS[(hh * 2 + ks) * 64] = ldg8(QB + grow * LDQ + (g * 4 + hh) * 64 + ks * 32 + fq * 8);
#define Qc(hh, ks) (QS[((hh) * 2 + (ks)) * 64])
    for (int i = lane; i < 16 * 132; i += 64) IMP[i] = 0.f;
    const f32x4 z4 = {0.f, 0.f, 0.f, 0.f};
    f32x4 O[4][4];
    int nvmax = (t0 + 15 >= 31) ? (((t0 + 15 - 31) >> 4) + 1) : 0; if (nvmax > NC) nvmax = NC;
    const int nch = (nvmax + 31) >> 5;
    const bf16* kcb = KC + (size_t)bg * 512 * 64; const bf16* vcb = VcT + (size_t)bg * 64 * 512;
    float linv[4] = {0.f, 0.f, 0.f, 0.f};
#pragma unroll
    for (int hh = 0; hh < 4; ++hh)
#pragma unroll
        for (int mt = 0; mt < 4; ++mt) O[hh][mt] = z4;
#pragma unroll 1
    for (int pass = 0; pass < 2; ++pass) {
#pragma unroll 1
        for (int ch = 0; ch < nch; ++ch) {
            asm volatile("" ::: "memory");
            const int k0 = 32 * ch;
            bf16x8_t ka[2][2];
#pragma unroll
            for (int tl = 0; tl < 2; ++tl)
#pragma unroll
                for (int ks = 0; ks < 2; ++ks) ka[tl][ks] = ldg8(kcb + (size_t)(k0 + krowA + 4 * tl) * 64 + ks * 32 + fq * 8);
            bf16x8_t va[4];
            if (pass == 1) {
#pragma unroll
                for (int mt = 0; mt < 4; ++mt) va[mt] = ldg8(vcb + (size_t)(16 * mt + col) * 512 + k0 + 8 * fq);
            }
            float ps[8] = {0.f, 0.f, 0.f, 0.f, 0.f, 0.f, 0.f, 0.f};
#pragma unroll
            for (int hh = 0; hh < 4; ++hh) {
                const bf16x8_t q0_ = Qc(hh, 0), q1_ = Qc(hh, 1);
                f32x4 sa = MFMA16(ka[0][0], q0_, z4); sa = MFMA16(ka[0][1], q1_, sa);
                f32x4 sb = MFMA16(ka[1][0], q0_, z4); sb = MFMA16(ka[1][1], q1_, sb);
#pragma unroll
                for (int i = 0; i < 4; ++i) { const int c = k0 + 8 * fq + i;
                    sa[i] = (16 * c + 31 <= tok) ? __builtin_amdgcn_exp2f(sa[i] * ATT_C) : 0.f; sb[i] = (16 * (c + 4) + 31 <= tok) ? __builtin_amdgcn_exp2f(sb[i] * ATT_C) : 0.f; }
                if (pass == 0) { linv[hh] += (sa[0] + sa[1]) + (sa[2] + sa[3]) + (sb[0] + sb[1]) + (sb[2] + sb[3]); }
                else {
                    sa = sa * linv[hh]; sb = sb * linv[hh];
#pragma unroll
                    for (int i = 0; i < 4; ++i) { ps[i] += sa[i]; ps[4 + i] += sb[i]; }
                    const bf16x8_t pt = pack_p(sa, sb);
#pragma unroll
                    for (int mt = 0; mt < 4; ++mt) O[hh][mt] = MFMA16(va[mt], pt, O[hh][mt]);
                }
            }
            if (pass == 1) {
                const int G0 = 8 * ch + 2 * fq; LAS float* ir = IMP + col * 132 + G0;
                __hip_atomic_fetch_add(ir, (ps[0] + ps[1]) + (ps[2] + ps[3]), __ATOMIC_RELAXED, __HIP_MEMORY_SCOPE_WORKGROUP);
                __hip_atomic_fetch_add(ir + 1, ps[3] + ((ps[4] + ps[5]) + (ps[6] + ps[7])), __ATOMIC_RELAXED, __HIP_MEMORY_SCOPE_WORKGROUP);
                if (G0 + 2 < NS) __hip_atomic_fetch_add(ir + 2, ps[7], __ATOMIC_RELAXED, __HIP_MEMORY_SCOPE_WORKGROUP);
            }
        }
        if (pass == 0) {
#pragma unroll
            for (int hh = 0; hh < 4; ++hh) { float l = linv[hh]; l += bperm_f(l, lane ^ 16); l += bperm_f(l, lane ^ 32); linv[hh] = l > 0.f ? 1.f / l : 0.f; }
        }
    }
    LDS_WAIT(); asm volatile("" ::: "memory");
    {
        const int cur = tok >> 6; LAS float* sc = IMP + col * 132;
        for (int j = fq * 32; j < fq * 32 + 32; ++j) { const bool forced = (j == 0) || (j == cur) || (j == cur - 1); const float v = sc[j]; sc[j] = forced ? 1e4f : (j <= cur ? v : -1.f); }
        LDS_WAIT(); asm volatile("" ::: "memory");
#pragma unroll 1
        for (int r = 0; r < 8; ++r) {
            float bv = sc[fq * 32]; int bj = fq * 32;
            for (int j = fq * 32 + 1; j < fq * 32 + 32; ++j) { const float v = sc[j]; if (v > bv) { bv = v; bj = j; } }
#pragma unroll
            for (int o = 16; o <= 32; o <<= 1) { const float ov = bperm_f(bv, lane ^ o); const int oj = bperm_i(bj, lane ^ o); if (ov > bv || (ov == bv && oj < bj)) { bv = ov; bj = oj; } }
            if ((bj >> 5) == fq) sc[bj] = -3e38f;
            if (fq == 0) SEL[col * 8 + r] = bj;
            LDS_WAIT(); asm volatile("" ::: "memory");
        }
    }
#pragma unroll
    for (int hh = 0; hh < 4; ++hh) { const float g0 = gate[hh * 3 + 0];
#pragma unroll
        for (int mt = 0; mt < 4; ++mt) { const f32x4 o = O[hh][mt] * g0; v2u w; w.x = cvt_pk_bf16(o[0], o[1]); w.y = cvt_pk_bf16(o[2], o[3]);
            *(LAS v2u*)(OS + (col * 4 + hh) * 64 + 16 * mt + 4 * fq) = w; } }
    LDS_WAIT(); asm volatile("" ::: "memory");
    {
        const bf16* ksb = KV + (size_t)b * SEQ * LDKV + g * 64; const bf16* vsb = VsT + (size_t)bg * 64 * SEQ;
#pragma unroll 1
        for (int tt = 0; tt < 16; ++tt) {
            const int tq = t0 + tt; const size_t qrow = (size_t)b * SEQ + tq;
            bf16x8_t Qh[2];
#pragma unroll
            for (int ks = 0; ks < 2; ++ks) { Qh[ks] = ldg8(QB + qrow * LDQ + (g * 4 + (col & 3)) * 64 + ks * 32 + fq * 8); if (col >= 4) Qh[ks] = (bf16x8_t){0, 0, 0, 0, 0, 0, 0, 0}; }
            f32x4 Os[4] = {z4, z4, z4, z4}; float ls = 0.f;
#pragma unroll 1
            for (int r8 = 0; r8 < 8; ++r8) {
                const int j = __builtin_amdgcn_readfirstlane(SEL[tt * 8 + r8]);
                if (64 * j > tq) continue;
#pragma unroll
                for (int hf = 0; hf < 2; ++hf) {
                    const int k0 = 64 * j + 32 * hf;
                    bf16x8_t ka[2][2], va[4];
#pragma unroll
                    for (int tl = 0; tl < 2; ++tl)
#pragma unroll
                        for (int ks = 0; ks < 2; ++ks) ka[tl][ks] = ldg8(ksb + (size_t)(k0 + krowA + 4 * tl) * LDKV + ks * 32 + fq * 8);
#pragma unroll
                    for (int mt = 0; mt < 4; ++mt) va[mt] = ldg8(vsb + (size_t)(16 * mt + col) * SEQ + k0 + 8 * fq);
                    f32x4 sa = MFMA16(ka[0][0], Qh[0], z4); sa = MFMA16(ka[0][1], Qh[1], sa);
                    f32x4 sb = MFMA16(ka[1][0], Qh[0], z4); sb = MFMA16(ka[1][1], Qh[1], sb);
#pragma unroll
                    for (int i = 0; i < 4; ++i) { const int kt = k0 + 8 * fq + i;
                        sa[i] = (kt <= tq) ? __builtin_amdgcn_exp2f(sa[i] * ATT_C) : 0.f; sb[i] = (kt + 4 <= tq) ? __builtin_amdgcn_exp2f(sb[i] * ATT_C) : 0.f; }
                    ls += (sa[0] + sa[1]) + (sa[2] + sa[3]) + (sb[0] + sb[1]) + (sb[2] + sb[3]);
                    const bf16x8_t pt = pack_p(sa, sb);
#pragma unroll
                    for (int mt = 0; mt < 4; ++mt) Os[mt] = MFMA16(va[mt], pt, Os[mt]);
                }
            }
            ls += bperm_f(ls, lane ^ 16); ls += bperm_f(ls, lane ^ 32);
            if (col < 4) {
                const float w = ls > 0.f ? (NG + qrow * 24 + g * 12)[col * 3 + 1] / ls : 0.f;
#pragma unroll
                for (int mt = 0; mt < 4; ++mt) { LAS v2u* dp = (LAS v2u*)(OS + (tt * 4 + col) * 64 + 16 * mt + 4 * fq); const v2u old = *dp;
                    v2u w2; w2.x = cvt_pk_bf16(blo(old.x) + w * Os[mt][0], bhi(old.x) + w * Os[mt][1]); w2.y = cvt_pk_bf16(blo(old.y) + w * Os[mt][2], bhi(old.y) + w * Os[mt][3]); *dp = w2; }
            }
        }
    }
    LDS_WAIT(); asm volatile("" ::: "memory");
    {
        const bf16* kwb = KV + (size_t)b * SEQ * LDKV + 256 + g * 64; const bf16* vwb = VwT + (size_t)bg * 64 * SEQ;
        float lw[4] = {0.f, 0.f, 0.f, 0.f};
#pragma unroll
        for (int hh = 0; hh < 4; ++hh)
#pragma unroll
            for (int mt = 0; mt < 4; ++mt) O[hh][mt] = z4;
        int kst = t0 - (WINDOW - 1); if (kst < 0) kst = 0; kst &= ~31;
#pragma unroll 1
        for (int k0 = kst; k0 <= t0 + 15; k0 += 32) {
            asm volatile("" ::: "memory");
            bf16x8_t ka[2][2], va[4];
#pragma unroll
            for (int tl = 0; tl < 2; ++tl)
#pragma unroll
                for (int ks = 0; ks < 2; ++ks) ka[tl][ks] = ldg8(kwb + (size_t)(k0 + krowA + 4 * tl) * LDKV + ks * 32 + fq * 8);
#pragma unroll
            for (int mt = 0; mt < 4; ++mt) va[mt] = ldg8(vwb + (size_t)(16 * mt + col) * SEQ + k0 + 8 * fq);
#pragma unroll
            for (int hh = 0; hh < 4; ++hh) {
                const bf16x8_t q0_ = Qc(hh, 0), q1_ = Qc(hh, 1);
                f32x4 sa = MFMA16(ka[0][0], q0_, z4); sa = MFMA16(ka[0][1], q1_, sa);
                f32x4 sb = MFMA16(ka[1][0], q0_, z4); sb = MFMA16(ka[1][1], q1_, sb);
#pragma unroll
                for (int i = 0; i < 4; ++i) { const int kt = k0 + 8 * fq + i;
                    sa[i] = (kt <= tok && kt + WINDOW > tok) ? __builtin_amdgcn_exp2f(sa[i] * ATT_C) : 0.f; sb[i] = (kt + 4 <= tok && kt + 4 + WINDOW > tok) ? __builtin_amdgcn_exp2f(sb[i] * ATT_C) : 0.f; }
                lw[hh] += (sa[0] + sa[1]) + (sa[2] + sa[3]) + (sb[0] + sb[1]) + (sb[2] + sb[3]);
                const bf16x8_t pt = pack_p(sa, sb);
#pragma unroll
                for (int mt = 0; mt < 4; ++mt) O[hh][mt] = MFMA16(va[mt], pt, O[hh][mt]);
            }
        }
#pragma unroll
        for (int hh = 0; hh < 4; ++hh) { float l = lw[hh]; l += bperm_f(l, lane ^ 16); l += bperm_f(l, lane ^ 32); const float w = l > 0.f ? gate[hh * 3 + 2] / l : 0.f;
#pragma unroll
            for (int mt = 0; mt < 4; ++mt) { const v2u old = *(LAS v2u*)(OS + (col * 4 + hh) * 64 + 16 * mt + 4 * fq);
                v2u w2; w2.x = cvt_pk_bf16(blo(old.x) + w * O[hh][mt][0], bhi(old.x) + w * O[hh][mt][1]); w2.y = cvt_pk_bf16(blo(old.y) + w * O[hh][mt][2], bhi(old.y) + w * O[hh][mt][3]);
                *(v2u*)(QB + grow * LDQ + (g * 4 + hh) * 64 + 16 * mt + 4 * fq) = w2; } }
    }
    LDS_WAIT(); asm volatile("" ::: "memory");
#undef Qc
}

typedef _Float16 h16x2 __attribute__((ext_vector_type(2)));
__device__ __forceinline__ h16x2 as_h2(unsigned u) { h16x2 r; __builtin_memcpy(&r, &u, 4); return r; }
constexpr int SC_STEPS = 8, SC_BUF = 6 * 1024;
__device__ __forceinline__ float dpp_sum16(float v) {
    v += __builtin_bit_cast(float, __builtin_amdgcn_update_dpp(0, __builtin_bit_cast(int, v), 0xB1, 0xF, 0xF, true));
    v += __builtin_bit_cast(float, __builtin_amdgcn_update_dpp(0, __builtin_bit_cast(int, v), 0x4E, 0xF, 0xF, true));
    v += __builtin_bit_cast(float, __builtin_amdgcn_update_dpp(0, __builtin_bit_cast(int, v), 0x141, 0xF, 0xF, true));
    v += __builtin_bit_cast(float, __builtin_amdgcn_update_dpp(0, __builtin_bit_cast(int, v), 0x140, 0xF, 0xF, true));
    return v;
}
__device__ __forceinline__ void scan_fill(const bf16* RW, const bf16* Wm, const bf16* Am, size_t trow, int h, int lane, LAS unsigned char* buf) {
    const size_t t = trow + (lane >> 3); const int sub = (lane & 7) * 8;
    const bf16* row = RW + t * LDRW + h * 64 + sub;
    __builtin_amdgcn_global_load_lds((const unsigned*)(row + LBLK), (LAS unsigned*)(buf + 0 * 1024), 16, 0, 0);
    __builtin_amdgcn_global_load_lds((const unsigned*)(Am + t * RC + h * 64 + sub), (LAS unsigned*)(buf + 1 * 1024), 16, 0, 0);
    __builtin_amdgcn_global_load_lds((const unsigned*)(Wm + t * RC + h * 64 + sub), (LAS unsigned*)(buf + 2 * 1024), 16, 0, 0);
    __builtin_amdgcn_global_load_lds((const unsigned*)(row + 512), (LAS unsigned*)(buf + 3 * 1024), 16, 0, 0);
    __builtin_amdgcn_global_load_lds((const unsigned*)(row), (LAS unsigned*)(buf + 4 * 1024), 16, 0, 0);
    __builtin_amdgcn_global_load_lds((const unsigned*)(row + 1024), (LAS unsigned*)(buf + 5 * 1024), 16, 0, 0);
}
__device__ __forceinline__ void scan_unit(const P& p, int unit, int lane, LAS unsigned char* wl) {
    const bf16* RW = WSP(bf16, AR_RW); const bf16* Wm = WSP(bf16, AR_W); const bf16* Am = WSP(bf16, AR_A); bf16* Y = WSP(bf16, AR_UB);
    const int rg = unit & 15, h = (unit >> 4) & 7, b = unit >> 7, row = rg * 4 + (lane >> 4), kq = lane & 15;
    const size_t tb = (size_t)b * SEQ;
    float s0 = 0.f, s1 = 0.f, s2 = 0.f, s3 = 0.f;
    __builtin_amdgcn_s_setprio(3);
    scan_fill(RW, Wm, Am, tb, h, lane, wl);
#pragma unroll 1
    for (int c = 0; c < SEQ / SC_STEPS; ++c) {
        LAS unsigned char* buf = wl + (c & 1) * SC_BUF;
        asm volatile("s_waitcnt vmcnt(0) lgkmcnt(0)" ::: "memory");
        if (c + 1 < SEQ / SC_STEPS) scan_fill(RW, Wm, Am, tb + (size_t)(c + 1) * SC_STEPS, h, lane, wl + ((c + 1) & 1) * SC_BUF);
#ifndef SCAN_VARB
        float ys[SC_STEPS];
#pragma unroll
        for (int st = 0; st < SC_STEPS; ++st) {
            const LAS unsigned char* o = buf + st * 128 + kq * 8;
            const v2u kkw = *(const LAS v2u*)(o), bbw = *(const LAS v2u*)(o + 1024), eew = *(const LAS v2u*)(o + 2048), ktw = *(const LAS v2u*)(o + 3072), rrw = *(const LAS v2u*)(o + 4096);
#ifdef SCAN_BF16
            struct F2 { float x, y; }; const F2 kk0{blo(kkw.x), bhi(kkw.x)}, kk1{blo(kkw.y), bhi(kkw.y)}, bb0{blo(bbw.x), bhi(bbw.x)}, bb1{blo(bbw.y), bhi(bbw.y)}, ee0{blo(eew.x), bhi(eew.x)}, ee1{blo(eew.y), bhi(eew.y)}, kt0{blo(ktw.x), bhi(ktw.x)}, kt1{blo(ktw.y), bhi(ktw.y)}, rr0{blo(rrw.x), bhi(rrw.x)}, rr1{blo(rrw.y), bhi(rrw.y)};
            const float vv = bf2f(*(const LAS unsigned short*)(buf + 5 * 1024 + st * 128 + row * 2));
#else
            const h16x2 kk0 = as_h2(kkw.x), kk1 = as_h2(kkw.y), bb0 = as_h2(bbw.x), bb1 = as_h2(bbw.y);
            const h16x2 ee0 = as_h2(eew.x), ee1 = as_h2(eew.y);
#ifdef RKV_BF16
            struct F2 { float x, y; }; const F2 kt0{blo(ktw.x), bhi(ktw.x)}, kt1{blo(ktw.y), bhi(ktw.y)}, rr0{blo(rrw.x), bhi(rrw.x)}, rr1{blo(rrw.y), bhi(rrw.y)};
            const float vv = bf2f(*(const LAS unsigned short*)(buf + 5 * 1024 + st * 128 + row * 2));
#else
            const h16x2 kt0 = as_h2(ktw.x), kt1 = as_h2(ktw.y);
            const h16x2 rr0 = as_h2(rrw.x), rr1 = as_h2(rrw.y);
            const float vv = (float)__builtin_bit_cast(_Float16, *(const LAS unsigned short*)(buf + 5 * 1024 + st * 128 + row * 2));
#endif
#endif
            float d0 = s0 * (float)kk0.x; d0 = __builtin_fmaf(s1, (float)kk0.y, d0); float d1 = s2 * (float)kk1.x; d1 = __builtin_fmaf(s3, (float)kk1.y, d1);
            const float nskk = -dpp_sum16(d0 + d1);
            s0 = __builtin_fmaf(s0, -(float)ee0.x, s0); s1 = __builtin_fmaf(s1, -(float)ee0.y, s1); s2 = __builtin_fmaf(s2, -(float)ee1.x, s2); s3 = __builtin_fmaf(s3, -(float)ee1.y, s3);
            s0 = __builtin_fmaf(nskk, (float)bb0.x, s0); s1 = __builtin_fmaf(nskk, (float)bb0.y, s1); s2 = __builtin_fmaf(nskk, (float)bb1.x, s2); s3 = __builtin_fmaf(nskk, (float)bb1.y, s3);
            s0 = __builtin_fmaf(vv, (float)kt0.x, s0); s1 = __builtin_fmaf(vv, (float)kt0.y, s1); s2 = __builtin_fmaf(vv, (float)kt1.x, s2); s3 = __builtin_fmaf(vv, (float)kt1.y, s3);
            float y0 = s0 * (float)rr0.x; y0 = __builtin_fmaf(s1, (float)rr0.y, y0); float y1 = s2 * (float)rr1.x; y1 = __builtin_fmaf(s3, (float)rr1.y, y1);
            ys[st] = dpp_sum16(y0 + y1);
        }
        if (kq < SC_STEPS) { float yv = ys[0];
#pragma unroll
            for (int st = 1; st < SC_STEPS; ++st) yv = (kq == st) ? ys[st] : yv;
            Y[(tb + (size_t)c * SC_STEPS + kq) * RC + h * 64 + row] = f2bf(yv); }
    }
#else
#pragma unroll
        for (int st = 0; st < SC_STEPS; ++st) {
            const LAS unsigned char* o = buf + st * 128 + kq * 8;
            float kk[4], bb[4], ee[4], kt[4], rr[4];
            { const v2u w = *(const LAS v2u*)(o); const h16x2 a = as_h2(w.x), b2 = as_h2(w.y); kk[0] = (float)a.x; kk[1] = (float)a.y; kk[2] = (float)b2.x; kk[3] = (float)b2.y; }
            { const v2u w = *(const LAS v2u*)(o + 1024); const h16x2 a = as_h2(w.x), b2 = as_h2(w.y); bb[0] = (float)a.x; bb[1] = (float)a.y; bb[2] = (float)b2.x; bb[3] = (float)b2.y; }
            { const v2u w = *(const LAS v2u*)(o + 2048); const h16x2 a = as_h2(w.x), b2 = as_h2(w.y); ee[0] = (float)a.x; ee[1] = (float)a.y; ee[2] = (float)b2.x; ee[3] = (float)b2.y; }
            { const v2u w = *(const LAS v2u*)(o + 3072); const h16x2 a = as_h2(w.x), b2 = as_h2(w.y); kt[0] = (float)a.x; kt[1] = (float)a.y; kt[2] = (float)b2.x; kt[3] = (float)b2.y; }
            { const v2u w = *(const LAS v2u*)(o + 4096); const h16x2 a = as_h2(w.x), b2 = as_h2(w.y); rr[0] = (float)a.x; rr[1] = (float)a.y; rr[2] = (float)b2.x; rr[3] = (float)b2.y; }
            const float vv = (float)__builtin_bit_cast(_Float16, *(const LAS unsigned short*)(buf + 5 * 1024 + st * 128 + row * 2));
            const float skk = dpp_sum16((s0 * kk[0] + s1 * kk[1]) + (s2 * kk[2] + s3 * kk[3]));
            s0 = s0 - s0 * ee[0] - skk * bb[0] + vv * kt[0]; s1 = s1 - s1 * ee[1] - skk * bb[1] + vv * kt[1]; s2 = s2 - s2 * ee[2] - skk * bb[2] + vv * kt[2]; s3 = s3 - s3 * ee[3] - skk * bb[3] + vv * kt[3];
            const float y = dpp_sum16((s0 * rr[0] + s1 * rr[1]) + (s2 * rr[2] + s3 * rr[3]));
            if (kq == 0) Y[(tb + (size_t)c * SC_STEPS + st) * RC + h * 64 + row] = f2bf(y);
        }
    }
#endif
    asm volatile("s_waitcnt vmcnt(0) lgkmcnt(0)" ::: "memory");
    __builtin_amdgcn_s_setprio(0);
}
__device__ __forceinline__ float sum8(float v) {
    v += __builtin_bit_cast(float, __builtin_amdgcn_update_dpp(0, __builtin_bit_cast(int, v), 0xB1, 0xF, 0xF, true));
    v += __builtin_bit_cast(float, __builtin_amdgcn_update_dpp(0, __builtin_bit_cast(int, v), 0x4E, 0xF, 0xF, true));
    v += __builtin_bit_cast(float, __builtin_amdgcn_update_dpp(0, __builtin_bit_cast(int, v), 0x141, 0xF, 0xF, true));
    return v;
}
__device__ __forceinline__ void up8(v4u w, float* f) { f[0] = blo(w.x); f[1] = bhi(w.x); f[2] = blo(w.y); f[3] = bhi(w.y); f[4] = blo(w.z); f[5] = bhi(w.z); f[6] = blo(w.w); f[7] = bhi(w.w); }
#ifdef SCAN_BF16
#define uph8 up8
#define pkh8 pk8
#else
#define uph8 uph8_
#define pkh8 pkh8_
#endif
__device__ __forceinline__ void uph8_(v4u w, float* f) { const h16x2 a = as_h2(w.x), b = as_h2(w.y), c = as_h2(w.z), d = as_h2(w.w);
    f[0] = (float)a.x; f[1] = (float)a.y; f[2] = (float)b.x; f[3] = (float)b.y; f[4] = (float)c.x; f[5] = (float)c.y; f[6] = (float)d.x; f[7] = (float)d.y; }
__device__ __forceinline__ unsigned pkh2(float lo, float hi) { h16x2 v; v.x = (_Float16)lo; v.y = (_Float16)hi; return __builtin_bit_cast(unsigned, v); }
__device__ __forceinline__ v4u pkh8_(const float* f) { v4u w; w.x = pkh2(f[0], f[1]); w.y = pkh2(f[2], f[3]); w.z = pkh2(f[4], f[5]); w.w = pkh2(f[6], f[7]); return w; }
__device__ __forceinline__ v4u pk8(const float* f) { v4u w; w.x = cvt_pk_bf16(f[0], f[1]); w.y = cvt_pk_bf16(f[2], f[3]); w.z = cvt_pk_bf16(f[4], f[5]); w.w = cvt_pk_bf16(f[6], f[7]); return w; }
__device__ __forceinline__ void ldf8(const float* p, float* f) { const f32x4 a = *(const f32x4*)p, b = *(const f32x4*)(p + 4); f[0] = a[0]; f[1] = a[1]; f[2] = a[2]; f[3] = a[3]; f[4] = b[0]; f[5] = b[1]; f[6] = b[2]; f[7] = b[3]; }

struct EpiLora {
    static constexpr bool PERM = true, AFTER_DRAIN = false;
    unsigned char* ws;
    __device__ __forceinline__ void operator()(const f32x4 (&acc)[2][2][4][2], const Unit& u, int wr, int wc, int fr, int fq) const {
        const int which = u.pn >> 1, row0 = u.pm * BM + wr * 64 + fr, c0 = (u.pn & 1) * 256 + wc * 32 + 8 * fq;
        bf16* const O = (bf16*)(ws + (which == 0 ? AR_W : (which == 1 ? AR_A : (which == 2 ? AR_G : AR_UB))));
#pragma unroll
        for (int ai = 0; ai < 2; ++ai)
#pragma unroll
            for (int m = 0; m < 4; ++m)
#pragma unroll
                for (int bj = 0; bj < 2; ++bj) *(u32x4*)(O + (size_t)(row0 + ai * HALF + m * 16) * RC + c0 + bj * HALF) = pack8(acc[ai][bj][m][0], acc[ai][bj][m][1]);
    }
};
#ifdef RKV_BF16
#define UPR up8
#define PKR pk8
#else
#define UPR uph8
#define PKR pkh8
#endif
__device__ __forceinline__ void ph_rwkv_b2w(const P& p, int layer, int gw, int NGW, int lane) {
    bf16* RW = WSP(bf16, AR_RW); bf16* Am = WSP(bf16, AR_A); bf16* Wm = WSP(bf16, AR_W); const bf16* VR = WSP(bf16, AR_UB); const bf16* VF = WSP(bf16, WS_VF); float* NG = WSP(float, AR_NG);
    const float* vec = p.rwkv_vec + (size_t)layer * 7 * RC; float v0[8], v1[8], v2[8], v3[8], vb[8];
    ldf8(vec + 8 * lane, v0); ldf8(vec + RC + 8 * lane, v1); ldf8(vec + 2 * RC + 8 * lane, v2); ldf8(vec + 3 * RC + 8 * lane, v3); ldf8(p.vres_b + 8 * lane, vb);
    for (int t = gw; t < T; t += NGW) {
        bf16* row = RW + (size_t)t * LDRW;
        float k[8], a[8], w[8]; UPR(*(const v4u*)(row + 512 + 8 * lane), k); up8(*(const v4u*)(Am + (size_t)t * RC + 8 * lane), a); up8(*(const v4u*)(Wm + (size_t)t * RC + 8 * lane), w);
        const float gt = lane < 24 ? bf2f(row[LBLK + 320 + lane]) : 0.f;
        float kk[8], ss = 0.f;
#pragma unroll
        for (int i = 0; i < 8; ++i) {
            a[i] = fsig(a[i] + v1[i]);
            const float nx = -(w[i] + v0[i]), sp = fmaxf(nx, 0.f) + __logf(1.f + __expf(-fabsf(nx))), e = __expf(-sp - 0.5f); w[i] = 1.f - __expf(-e);
            kk[i] = k[i] * v2[i]; ss += kk[i] * kk[i]; }
        ss = sum8(ss); const float nrm = sqrtf(ss), inv = 1.f / (nrm > 1e-12f ? nrm : 1e-12f);
#pragma unroll
        for (int i = 0; i < 8; ++i) { kk[i] *= inv; k[i] = k[i] * (1.f + (a[i] - 1.f) * v3[i]); a[i] *= kk[i]; }
        if (layer == 1) { float vr[8], vv[8], vf[8]; up8(*(const v4u*)(VR + (size_t)t * RC + 8 * lane), vr); UPR(*(const v4u*)(row + 1024 + 8 * lane), vv); UPR(*(const v4u*)(VF + (size_t)t * RC + 8 * lane), vf);
#pragma unroll
            for (int i = 0; i < 8; ++i) vv[i] = vv[i] + (vf[i] - vv[i]) * fsig(vr[i] + vb[i]);
            *(v4u*)(row + 1024 + 8 * lane) = PKR(vv); }
        VM_WAIT();
        if (lane < 24) NG[(size_t)t * 24 + lane] = fsig(gt);
        *(v4u*)(row + LBLK + 8 * lane) = pkh8(kk); *(v4u*)(row + 512 + 8 * lane) = PKR(k);
        *(v4u*)(Am + (size_t)t * RC + 8 * lane) = pkh8(a); *(v4u*)(Wm + (size_t)t * RC + 8 * lane) = pkh8(w);
    }
}
__device__ __forceinline__ void ph_rwkv_postw(const P& p, int layer, int gw, int NGW, int lane) {
    const bf16* RW = WSP(bf16, AR_RW); const bf16* Y = WSP(bf16, AR_UB); const bf16* Gm = WSP(bf16, AR_G); bf16* YO = WSP(bf16, AR_A);
    const float* vec = p.rwkv_vec + (size_t)layer * 7 * RC; float v4_[8], v5[8], v6[8]; ldf8(vec + 4 * RC + 8 * lane, v4_); ldf8(vec + 5 * RC + 8 * lane, v5); ldf8(vec + 6 * RC + 8 * lane, v6);
    for (int t = gw; t < T; t += NGW) {
        const bf16* row = RW + (size_t)t * LDRW;
        float y[8], r[8], k[8], v[8], g[8]; up8(*(const v4u*)(Y + (size_t)t * RC + 8 * lane), y); UPR(*(const v4u*)(row + 8 * lane), r); UPR(*(const v4u*)(row + 512 + 8 * lane), k);
        UPR(*(const v4u*)(row + 1024 + 8 * lane), v); up8(*(const v4u*)(Gm + (size_t)t * RC + 8 * lane), g);
        float s = 0.f, bon = 0.f;
#pragma unroll
        for (int i = 0; i < 8; ++i) { s += y[i]; bon += r[i] * k[i] * v4_[i]; }
        const float m = sum8(s) * (1.f / 64.f); bon = sum8(bon);
        float q = 0.f;
#pragma unroll
        for (int i = 0; i < 8; ++i) { y[i] -= m; q += y[i] * y[i]; }
        const float rstd = 1.f / sqrtf(sum8(q) * (1.f / 64.f) + GN_EPS);
#pragma unroll
        for (int i = 0; i < 8; ++i) y[i] = (y[i] * rstd * v5[i] + v6[i] + bon * v[i]) * g[i];
        *(v4u*)(YO + (size_t)t * RC + 8 * lane) = pk8(y);
    }
}
__device__ __forceinline__ void ph_convw(const P& p, int layer, int gw, int NGW, int lane, int tid, LAS unsigned char* lds) {
    const bf16* UB = WSP(bf16, AR_UB); bf16* CO = WSP(bf16, AR_CO);
    const float* cw = p.conv_w + (size_t)layer * CONV_K * CONV_CH; const float* cv = p.conv_vec + (size_t)layer * 3 * CONV_CH;
    LAS float* wl = (LAS float*)lds;
    for (int i = tid; i < CONV_K * CONV_CH; i += NTHREADS) wl[i] = cw[i];
    __syncthreads();
    float b0[8], g1[8], b2[8]; ldf8(cv + 8 * lane, b0); ldf8(cv + CONV_CH + 8 * lane, g1); ldf8(cv + 2 * CONV_CH + 8 * lane, b2);
    for (int t = gw; t < T; t += NGW) {
        const int pos = t % SEQ, j0 = pos >= 30 ? 0 : 30 - pos;
        float a[8];
#pragma unroll
        for (int i = 0; i < 8; ++i) a[i] = b0[i];
        for (int j = j0; j < CONV_K; ++j) { float u[8]; up8(*(const v4u*)(UB + (size_t)(t - 30 + j) * CONV_CH + 8 * lane), u);
            const f32x4 w0 = *(const LAS f32x4*)(wl + j * CONV_CH + 8 * lane), w1 = *(const LAS f32x4*)(wl + j * CONV_CH + 8 * lane + 4);
#pragma unroll
            for (int i = 0; i < 4; ++i) { a[i] += u[i] * w0[i]; a[4 + i] += u[4 + i] * w1[i]; } }
        float s = 0.f;
#pragma unroll
        for (int i = 0; i < 8; ++i) s += a[i];
        const float mean = wave_sum(s, lane) * (1.f / CONV_CH); float q = 0.f;
#pragma unroll
        for (int i = 0; i < 8; ++i) { a[i] -= mean; q += a[i] * a[i]; }
        const float rstd = 1.f / sqrtf(wave_sum(q, lane) * (1.f / CONV_CH) + LN_EPS);
#pragma unroll
        for (int i = 0; i < 8; ++i) { const float y = a[i] * rstd * g1[i] + b2[i]; a[i] = y * fsig(y); }
        *(v4u*)(CO + (size_t)t * CONV_CH + 8 * lane) = pk8(a);
    }
    __syncthreads();
}
__device__ __forceinline__ void ph_cmp2w(const P& p, int layer, int gw, int NGW, int lane, LAS float* hl  ) {
    const bf16* Z = WSP(bf16, AR_HID); const float* pec = (const float*)(p.ws + WS_W + (size_t)layer * SZ_LAYERW + OFF_PEC);
    for (int it = gw; it < 2 * BATCH * NKV * NC; it += NGW) {
        const int i = it % NC, r = it / NC, bg = r % (BATCH * NKV), which = r / (BATCH * NKV);
        const bf16* z1 = Z + ((size_t)which * (BATCH * NKV * 512) + (size_t)bg * 512 + i) * 256; const bf16* z2 = z1 + 256 + 128;
#pragma unroll
        for (int jj = 0; jj < 2; ++jj) { const int j = lane + 64 * jj; const float x = bf2f(z1[j]) + bf2f(z2[j]) + pec[which * 128 + j];
            const float e = __expf(fminf(2.f * 0.7978845608028654f * (x + 0.044715f * x * x * x), 30.f)); hl[j] = 0.5f * x * (1.f + (e - 1.f) / (e + 1.f)); }
        LDS_WAIT(); asm volatile("" ::: "memory");
        const float* w2 = p.cmp_w2 + (size_t)(layer * 2 + which) * 128 * 64 + lane; float o = 0.f;
#pragma unroll 8
        for (int j = 0; j < 128; ++j) o += hl[j] * w2[j * 64];
        if (which == 0) {
            const float rs = 1.f / sqrtf(wave_sum(o * o, lane) * (1.f / 64.f) + RMS_EPS); o = o * rs * p.qk_g[(layer * 4 + 1) * 64 + lane];
            const float other = bperm_f(o, lane ^ 32); float cs, sn; rope_cs(16 * i + 31, lane & 31, cs, sn);
            o = lane < 32 ? o * cs - other * sn : o * cs + other * sn;
            WSP(bf16, AR_KC)[((size_t)bg * 512 + i) * 64 + lane] = f2bf(o);
        } else { bf16* vt = WSP(bf16, AR_VCT) + ((size_t)bg * 64 + lane) * 512; vt[i] = f2bf(o); if (i == 0) vt[NC] = 0; }
        LDS_WAIT(); asm volatile("" ::: "memory");
    }
}

struct MapPlain { bf16* base; int K; __device__ __forceinline__ bf16* operator()(int col) const { return base + (size_t)col * K; } };
struct MapGlu { bf16* base; int K, ff; __device__ __forceinline__ bf16* operator()(int col) const { return base + (size_t)glu_dest(col, ff) * K; } };
struct MapWin { unsigned char* wl; int layer; __device__ __forceinline__ bf16* operator()(int col) const { int which; const int r = win_dest(col, layer, which); const size_t off = (which ? OFF_WG : OFF_WIN) + (size_t)(r < 0 ? 0 : r) * DM * 2; return r < 0 ? nullptr : (bf16*)(wl + off); } };
template <class Map>
__device__ __forceinline__ void transpose_item(const float* W, int K, int N, const Map& mp, LAS float* scr, int item, int lane) {
    const int nblk = (N + 31) / 32, kb = item / nblk, nb = item % nblk, k0 = 64 * kb, n0 = 32 * nb;
    const int col = n0 + (lane & 31);
#pragma unroll 8
    for (int i = 0; i < 32; ++i) { const int kk = 2 * i + (lane >> 5); scr[kk * 33 + (lane & 31)] = col < N ? W[(size_t)(k0 + kk) * N + col] : 0.f; }
    LDS_WAIT(); asm volatile("" ::: "memory");
    const int c = lane & 7;
#pragma unroll
    for (int j = 0; j < 4; ++j) { const int n = (lane >> 3) + 8 * j; const LAS float* s = scr + (8 * c) * 33 + n;
        v4u o; o.x = (unsigned)f2bf(s[0]) | ((unsigned)f2bf(s[33]) << 16); o.y = (unsigned)f2bf(s[66]) | ((unsigned)f2bf(s[99]) << 16);
        o.z = (unsigned)f2bf(s[132]) | ((unsigned)f2bf(s[165]) << 16); o.w = (unsigned)f2bf(s[198]) | ((unsigned)f2bf(s[231]) << 16);
        if (n0 + n < N) { bf16* d = mp(n0 + n); if (d) *(v4u*)(d + k0 + 8 * c) = o; } }
    LDS_WAIT(); asm volatile("" ::: "memory");
}
template <class Map>
__device__ __forceinline__ bool conv_job(int& r, const float* W, int K, int N, const Map& mp, LAS float* scr, int lane) {
    const int items = (K / 64) * ((N + 31) / 32);
    if (r < items) { transpose_item(W, K, N, mp, scr, r, lane); return true; }
    r -= items; return false;
}

__device__ __forceinline__ void rms_row(const P& p, const float* xrow, const float* g, bf16* orow, int lane, bool route, int t) {
    const f32x4* xr = (const f32x4*)xrow + lane; const f32x4* gr = (const f32x4*)g + lane;
    f32x4 v[DM / 256]; float ss = 0.f;
#pragma unroll
    for (int j = 0; j < DM / 256; ++j) { v[j] = xr[64 * j]; ss += (v[j].x * v[j].x + v[j].y * v[j].y) + (v[j].z * v[j].z + v[j].w * v[j].w); }
    const float rs = 1.f / sqrtf(wave_sum(ss, lane) * (1.f / DM) + RMS_EPS);
    v2u* o8 = (v2u*)orow + lane;
#pragma unroll
    for (int j = 0; j < DM / 256; ++j) { const f32x4 gg = gr[64 * j]; v[j].x *= rs * gg.x; v[j].y *= rs * gg.y; v[j].z *= rs * gg.z; v[j].w *= rs * gg.w;
        v2u w; w.x = cvt_pk_bf16(v[j].x, v[j].y); w.y = cvt_pk_bf16(v[j].z, v[j].w); o8[64 * j] = w; }
    if (route) {
        float lg[NEXP];
#pragma unroll
        for (int e = 0; e < NEXP; ++e) lg[e] = 0.f;
#pragma unroll
        for (int j = 0; j < DM / 256; ++j) { const float* rw = p.router_w + (size_t)(4 * (lane + 64 * j)) * NEXP;
#pragma unroll
            for (int e = 0; e < NEXP; ++e) lg[e] += v[j].x * rw[e] + v[j].y * rw[NEXP + e] + v[j].z * rw[2 * NEXP + e] + v[j].w * rw[3 * NEXP + e]; }
#pragma unroll
        for (int e = 0; e < NEXP; ++e) lg[e] = wave_sum(lg[e], lane) + p.router_b[e];
        int e0 = 0; float l0 = lg[0];
#pragma unroll
        for (int e = 1; e < NEXP; ++e) if (lg[e] > l0) { l0 = lg[e]; e0 = e; }
        int e1 = -1; float l1 = -3e38f;
#pragma unroll
        for (int e = 0; e < NEXP; ++e) if (e != e0 && lg[e] > l1) { l1 = lg[e]; e1 = e; }
        if (lane == 0) { const float w0 = 1.f / (1.f + expf(l1 - l0));
            WSP(int, AR_RTE)[t] = e0 | (e1 << 8); float* rw = WSP(float, AR_RTW) + (size_t)t * 2; rw[0] = w0; rw[1] = 1.f - w0;
            unsigned* ctl = WSP(unsigned, WS_CTL); atomicAdd(ctl + CW_CNT + e0, 1u); atomicAdd(ctl + CW_CNT + 8 + e1, 1u); }
    }
}
__device__ __forceinline__ void copy_row_wave(const bf16* src, bf16* dst, int lane) {
#pragma unroll
    for (int j = 0; j < DM / 512; ++j) ((v4u*)dst)[lane + 64 * j] = ((const v4u*)src)[lane + 64 * j];
}
__device__ __forceinline__ int moe_seg_start(const unsigned* cnt, int e) { int s = 0;
#pragma unroll
    for (int k = 0; k < NEXP; ++k) s += (k < e) ? (int)((cnt[k] + 255u) & ~255u) : 0;
    return s; }

#ifndef PHMASK
#define PHMASK 0xFFFFFFFFu
#endif
#define PHM(k) (((PHMASK) >> (k)) & 1u)
#ifdef PROBE_LO
constexpr int PR_LO = PROBE_LO, PR_HI = PROBE_HI;
#else
constexpr int PR_LO = -1, PR_HI = -1;
#endif
constexpr int NPH = 16, NPHASES = 1 + 2 * NPH;
struct Args { const float* in[29]; float* out; unsigned char* ws; int ph_lo, ph_hi; };

__device__ __forceinline__ bool in_phase(int k, int lo, int hi) { asm volatile("" : "+s"(lo), "+s"(hi)); return lo <= k && k < hi; }
typedef const Args __attribute__((address_space(4)))* CArgsP;
__device__ __forceinline__ void fill_params_k(P& p, CArgsP a) {
    p.x = a->in[0]; p.mix_norm_g = a->in[1]; p.w_in_first = a->in[2]; p.w_in_rest = a->in[3]; p.mu_first = a->in[4]; p.mu_rest = a->in[5]; p.qk_g = a->in[6]; p.cmp_pos = a->in[7];
    p.cmp_w1 = a->in[8]; p.cmp_w2 = a->in[9]; p.nsa_w_o = a->in[10]; p.conv_w = a->in[11]; p.conv_vec = a->in[12]; p.conv_w_o = a->in[13]; p.rwkv_vec = a->in[14]; p.w_up = a->in[15];
    p.a_up = a->in[16]; p.g_up = a->in[17]; p.vres_up = a->in[18]; p.vres_b = a->in[19]; p.rwkv_w_o = a->in[20]; p.w_out = a->in[21]; p.ffn_norm_g = a->in[22]; p.dense_gu = a->in[23];
    p.dense_down = a->in[24]; p.router_w = a->in[25]; p.router_b = a->in[26]; p.moe_gu = a->in[27]; p.moe_down = a->in[28]; p.out = a->out; p.ws = a->ws;
}
__global__ void __launch_bounds__(NTHREADS, 2) mk_fwd(Args args) {
    extern __shared__ __attribute__((aligned(16))) unsigned char lds_raw[];
    LAS unsigned char* lds = (LAS unsigned char*)lds_raw;
    const int wave0 = __builtin_amdgcn_readfirstlane((int)threadIdx.x >> 6);
    const int tid = wave0 * 64 + lane_id_opaque();
    unsigned* ctl = (unsigned*)(args.ws + WS_CTL);
    for (int u = tid; u < (LDS_BYTES - LDSCTL_OFF) / 4; u += NTHREADS) ((LAS unsigned*)(lds + LDSCTL_OFF))[u] = 0u;
    __syncthreads();
    const int lo = args.ph_lo, hi = args.ph_hi;
    XcdBarrier bar; bar.bar = ctl + CW_BAR; bar.x = 0; bar.st = nullptr;
    if (hi - lo > 1) { bar.x = xb_xcc_id(); bar.st = (volatile LAS unsigned*)(lds + MISC_OFF) + 8; if (tid == 0) (void)xb_add(ctl + CW_BAR + XB_XCNT(bar.x), 1u); }
#define IN(k) (in_phase((k), lo, hi) && (PR_LO < 0 || (st == 0 ? (k) <= PR_HI : (st == 1 ? ((k) >= PR_LO && (k) <= PR_HI) : (k) > PR_HI))))
#define MKP CArgsP ap_ = (CArgsP)__builtin_amdgcn_kernarg_segment_ptr(); asm volatile("" : "+s"(ap_)); P p; fill_params_k(p, ap_); int w0_ = wave0; asm volatile("" : "+s"(w0_)); int tid = w0_ * 64 + lane_id_opaque(); asm volatile("" : "+v"(tid)); const int lane = tid & 63, wave = __builtin_amdgcn_readfirstlane(tid >> 6); int G = gridDim.x, bid = blockIdx.x; asm volatile("" : "+s"(G), "+s"(bid)); unsigned* ctl = WSP(unsigned, WS_CTL); const long gtid = (long)bid * NTHREADS + tid, NT = (long)G * NTHREADS; const int gw = bid * NWAVES + wave, NGW = G * NWAVES; LAS float* scrw = (LAS float*)(lds + wave * 16384); (void)gtid; (void)NT; (void)gw; (void)NGW; (void)scrw; (void)lane; (void)ctl
#define SEAM(k) do { if ((k) + 1 < hi) { int w_ = wave0; asm volatile("" : "+s"(w_)); xcd_barrier(bar, w_ * 64 + lane_id_opaque()); } } while (0)

    for (int st = 0; st < (PR_LO >= 0 ? 3 : 1); ++st) {
    if (PHM(16) && IN(0)) { MKP;
        constexpr int IT_WIN0 = (DM / 64) * ((N_IN_FIRST + 31) / 32), IT_WIN1 = (DM / 64) * ((N_IN_REST + 31) / 32), IT_WO = (512 / 64) * (DM / 32), IT_WOUT = (DM / 64) * (DM / 32);
        constexpr int total = IT_WIN0 + IT_WIN1 + 6 * IT_WO + 2 * IT_WOUT + (DM / 64) * (2 * DENSE_FF / 32) + (DENSE_FF / 64) * (DM / 32);
        bf16* wl0 = WSP(bf16, WS_W); bf16* wl1 = WSP(bf16, WS_W + SZ_LAYERW);
#define WOFF(b, o) ((bf16*)((unsigned char*)(b) + (o)))
        for (int it = gw; it < total; it += NGW) {
            int r = it;
            if (conv_job(r, p.w_in_first, DM, N_IN_FIRST, MapWin{(unsigned char*)wl0, 0}, scrw, lane)) continue;
            if (conv_job(r, p.w_in_rest, DM, N_IN_REST, MapWin{(unsigned char*)wl1, 1}, scrw, lane)) continue;
            if (conv_job(r, p.nsa_w_o, 512, DM, MapPlain{WOFF(wl0, OFF_WO3), 512}, scrw, lane)) continue;
            if (conv_job(r, p.rwkv_w_o, 512, DM, MapPlain{WOFF(wl0, OFF_WO3) + (size_t)DM * 512, 512}, scrw, lane)) continue;
            if (conv_job(r, p.conv_w_o, 512, DM, MapPlain{WOFF(wl0, OFF_WO3) + (size_t)2 * DM * 512, 512}, scrw, lane)) continue;
            if (conv_job(r, p.nsa_w_o + (size_t)512 * DM, 512, DM, MapPlain{WOFF(wl1, OFF_WO3), 512}, scrw, lane)) continue;
            if (conv_job(r, p.rwkv_w_o + (size_t)512 * DM, 512, DM, MapPlain{WOFF(wl1, OFF_WO3) + (size_t)DM * 512, 512}, scrw, lane)) continue;
            if (conv_job(r, p.conv_w_o + (size_t)512 * DM, 512, DM, MapPlain{WOFF(wl1, OFF_WO3) + (size_t)2 * DM * 512, 512}, scrw, lane)) continue;
            if (conv_job(r, p.w_out, DM, DM, MapPlain{WOFF(wl0, OFF_WOUT), DM}, scrw, lane)) continue;
            if (conv_job(r, p.w_out + (size_t)DM * DM, DM, DM, MapPlain{WOFF(wl1, OFF_WOUT), DM}, scrw, lane)) continue;
            if (conv_job(r, p.dense_gu, DM, 2 * DENSE_FF, MapGlu{WSP(bf16, WS_DGU), DM, DENSE_FF}, scrw, lane)) continue;
            conv_job(r, p.dense_down, DENSE_FF, DM, MapPlain{WSP(bf16, WS_DDN), DENSE_FF}, scrw, lane);
        }
        for (int l = 0; l < 2; ++l) {
            unsigned char* wlb = p.ws + WS_W + (size_t)l * SZ_LAYERW;
            bf16* win = (bf16*)(wlb + OFF_WIN);
            for (long i = gtid; i < 512L * DM; i += NT) { const int w = (int)(i / DM); const bool src = w < 288 || (w < 320 && l == 1) || (w >= 320 && w < 344); if (!src) win[(size_t)(3840 + w) * DM + i % DM] = 0; }
            bf16* lw = (bf16*)(wlb + OFF_LW);
            for (long i = gtid; i < 2048L * 384; i += NT) { const int n = (int)(i / 384), k = (int)(i % 384), blk = n >> 9, c = n & 511; float v = 0.f;
                if (blk == 0 && k < 64) v = p.w_up[((size_t)l * 64 + k) * RC + c]; else if (blk == 1 && k >= 64 && k < 128) v = p.a_up[((size_t)l * 64 + k - 64) * RC + c];
                else if (blk == 2 && k >= 128 && k < 288) v = p.g_up[((size_t)l * 160 + k - 128) * RC + c]; else if (blk == 3 && k >= 288 && k < 320 && l == 1) v = p.vres_up[(size_t)(k - 288) * RC + c];
                lw[i] = f2bf(v); }
            bf16* cw1 = (bf16*)(wlb + OFF_CW1);
            for (long i = gtid; i < 2L * 256 * 1024; i += NT) { const int k = (int)(i % 1024), n = (int)((i / 1024) % 256), which = (int)(i / (256 * 1024));
                cw1[i] = f2bf(p.cmp_w1[((size_t)(l * 2 + which) * 2048 + (n < 128 ? k : 1024 + k)) * 128 + (n & 127)]); }
            float* pec = (float*)(wlb + OFF_PEC);
            for (long i = gtid; i < 256; i += NT) { const int which = (int)(i >> 7), n = (int)(i & 127); const float* pe = p.cmp_pos + (size_t)(l * 2 + which) * 2048; const float* w1 = p.cmp_w1 + (size_t)(l * 2 + which) * 2048 * 128 + n;
                float s = 0.f; for (int k = 0; k < 2048; ++k) s += pe[k] * w1[(size_t)k * 128]; pec[i] = s; }
        }
        SEAM(0);
    }

    for (int layer = 0; layer < 2; ++layer) {
        const int pb = 1 + layer * NPH;
        if (PHM(0) && IN(pb + 0)) { MKP;
            const float* xin = layer == 0 ? p.x : p.out;
            for (int m = gw; m < T; m += NGW) rms_row(p, xin + (size_t)m * DM, p.mix_norm_g + (size_t)layer * DM, WSP(bf16, WS_H) + (size_t)m * DM, lane, false, m);
            SEAM(pb + 0);
        }
        if (PHM(1) && IN(pb + 1)) { MKP;
            Gemm g{WSP(bf16, WS_H), (const bf16*)(p.ws + WS_W + (size_t)layer * SZ_LAYERW + OFF_WIN), T, NPROJ, DM}; SOrder S; S.init(T, NPROJ, G, bid);
            EpiProj E{p.ws};
            pg8::gemm_phase<EpiProj, SOrder, true, true>(lds, g, S, E, tid);
            SEAM(pb + 1);
        }
        if (PHM(2) && IN(pb + 2)) { MKP;
            { Gemm g{WSP(bf16, AR_CKV), (const bf16*)(p.ws + WS_W + (size_t)layer * SZ_LAYERW + OFF_CW1), 2 * BATCH * NKV * 512, 512, 1024, 0}; StackOrder S{BATCH * NKV * 512 / 256, 1, 2, G, bid};
              EpiStore E{WSP(bf16, AR_HID), 256, 1};
              pg8::gemm_phase<EpiStore, StackOrder, true, true>(lds, g, S, E, tid); }
            ph_shift(p, layer, gtid, NT); ph_nsa_prep(p, layer, gtid, NT); ph_vtrans(p, gtid, NT);
            ph_convw(p, layer, gw, NGW, lane, tid, lds);
            SEAM(pb + 2); }
        if (PHM(3) && IN(pb + 3)) { MKP;
#ifndef LORA_NAIVE
            { Gemm g{WSP(bf16, WS_LB), (const bf16*)(p.ws + WS_W + (size_t)layer * SZ_LAYERW + OFF_LW), T, 2048, 384, 0}; SOrder S; S.init(T, 2048, G, bid);
              EpiLora E{p.ws};
              pg8::gemm_phase<EpiLora, SOrder, false, true>(lds, g, S, E, tid); }
#else
            { bf16* RW = WSP(bf16, AR_RW); bf16* Wm = WSP(bf16, AR_W); bf16* Am = WSP(bf16, AR_A); bf16* Gm = WSP(bf16, AR_G); const bf16* VF = WSP(bf16, WS_VF);
              const float* vec = p.rwkv_vec + (size_t)layer * 7 * RC; const float* wup = p.w_up + (size_t)layer * 64 * RC; const float* aup = p.a_up + (size_t)layer * 64 * RC; const float* gup = p.g_up + (size_t)layer * 160 * RC;
              for (long it = gtid; it < (long)T * RC; it += NT) { const int t = (int)(it / RC), c = (int)(it % RC); bf16* row = RW + (size_t)t * LDRW; const bf16* L = row + LBLK;
                  float wl = vec[c], alin = vec[RC + c], g = 0.f;
                  for (int j = 0; j < 64; ++j) { wl += bf2f(L[j]) * bf2f(f2bf(wup[j * RC + c])); alin += bf2f(L[64 + j]) * bf2f(f2bf(aup[j * RC + c])); }
                  for (int j = 0; j < 160; ++j) g += bf2f(L[128 + j]) * bf2f(f2bf(gup[j * RC + c]));
                  const float nx = -wl, sp = fmaxf(nx, 0.f) + __logf(1.f + __expf(-fabsf(nx))), e = __expf(-sp - 0.5f);
                  Wm[it] = f2bf(1.f - __expf(-e)); Am[it] = f2bf(fsig(alin)); Gm[it] = f2bf(g);
                  if (layer == 1) { float vl = p.vres_b[c]; for (int j = 0; j < 32; ++j) vl += bf2f(L[288 + j]) * bf2f(f2bf(p.vres_up[j * RC + c]));
                      const float v = bf2f(row[1024 + c]), vf = bf2f(VF[it]); row[1024 + c] = f2bf(v + (vf - v) * fsig(vl)); } } }
#endif
            SEAM(pb + 3); }
        if (PHM(4) && IN(pb + 4)) { MKP; ph_rwkv_b2w(p, layer, gw, NGW, lane); ph_cmp2w(p, layer, gw, NGW, lane, (LAS float*)(lds + wave * 512)); SEAM(pb + 4); }
        if (PHM(5) && IN(pb + 5)) { MKP;
            { LAS unsigned char* wl = lds + wave * AW_BYTES; constexpr int NSC = BATCH * 8 * 16, NIT = BATCH * NKV * (SEQ / 16);
#ifndef SCAN_QUEUE
              if (wave < 4) for (int u = bid * 4 + wave; u < NSC; u += G * 4) scan_unit(p, u, lane, wl);
#endif
              for (;;) { int it = 0; if (lane == 0) it = (int)atomicAdd(ctl + CW_ATT + layer + 2 * st, 1u); it = __builtin_amdgcn_readfirstlane(it);
#ifdef SCAN_QUEUE
                  if (it >= NSC + NIT) break; if (it < NSC) { scan_unit(p, it, lane, wl); continue; } it -= NSC;
#else
                  if (it >= NIT) break;
#endif
                  const int bg = it % (BATCH * NKV), t16 = (SEQ / 16 - 1) - it / (BATCH * NKV);
                  nsa_attn_item(p, bg * (SEQ / 16) + t16, lane, wl); } }
 SEAM(pb + 5); }
        if (PHM(6) && IN(pb + 6)) { MKP; ph_rwkv_postw(p, layer, gw, NGW, lane); SEAM(pb + 6); }
        if (PHM(7) && IN(pb + 7)) { MKP;
            Gemm g{WSP(bf16, AR_QB), (const bf16*)(p.ws + WS_W + (size_t)layer * SZ_LAYERW + OFF_WO3), 3 * T, 3 * DM, 512}; StackOrder S{T / 256, DM / 256, 3, G, bid};
            EpiStore E{WSP(bf16, AR_OBUF), DM, DM / 256};
            pg8::gemm_phase<EpiStore, StackOrder, true, true>(lds, g, S, E, tid);
            { const float* xin = layer == 0 ? p.x : p.out;
              for (int m = gw; m < T; m += NGW) rms_row(p, xin + (size_t)m * DM, p.mix_norm_g + (size_t)layer * DM, WSP(bf16, WS_H) + (size_t)m * DM, lane, false, m); }
            SEAM(pb + 7);
        }
        if (PHM(8) && IN(pb + 8)) { MKP;
            Gemm g{WSP(bf16, WS_H), (const bf16*)(p.ws + WS_W + (size_t)layer * SZ_LAYERW + OFF_WG), T, 3 * DM, DM}; GateOrder S{T / 256, DM / 256, G, bid};
            EpiGate E{p.ws, DM / 256};
            pg8::gemm_phase<EpiGate, GateOrder, true, true>(lds, g, S, E, tid);
            SEAM(pb + 8);
        }
        if (PHM(9) && IN(pb + 9)) { MKP;
            Gemm g{WSP(bf16, AR_MIX), (const bf16*)(p.ws + WS_W + (size_t)layer * SZ_LAYERW + OFF_WOUT), T, DM, DM}; SOrder S; S.init(T, DM, G, bid);
            EpiResid E{layer == 0 ? p.x : p.out, p.out};
            pg8::gemm_phase<EpiResid, SOrder, true, true>(lds, g, S, E, tid);
            SEAM(pb + 9);
        }
        if (PHM(10) && IN(pb + 10)) { MKP;
            for (int m = gw; m < T; m += NGW) rms_row(p, p.out + (size_t)m * DM, p.ffn_norm_g + (size_t)layer * DM, WSP(bf16, WS_H) + (size_t)m * DM, lane, layer == 1, m);
            if (layer == 1) { int* rt = WSP(int, AR_RTOK); for (long i = gtid; i < 2L * MOE_ROWS; i += NT) rt[i] = -1; }
            SEAM(pb + 10);
        }
        if (layer == 0) {
            if (PHM(11) && IN(pb + 11)) { MKP;
                Gemm g{WSP(bf16, WS_H), WSP(bf16, WS_DGU), T, 2 * DENSE_FF, DM}; SOrder S; S.init(T, 2 * DENSE_FF, G, bid);
                EpiSwiglu E{WSP(bf16, AR_ACT), DENSE_FF, 2 * DENSE_FF / 256};
                pg8::gemm_phase<EpiSwiglu, SOrder, true, true>(lds, g, S, E, tid);
                SEAM(pb + 11);
            }
            if (PHM(12) && IN(pb + 12)) { MKP;
                Gemm g{WSP(bf16, AR_ACT), WSP(bf16, WS_DDN), T, DM, DENSE_FF}; SOrder S; S.init(T, DM, G, bid);
                EpiResid E{p.out, p.out};
                pg8::gemm_phase<EpiResid, SOrder, true, true>(lds, g, S, E, tid);
                SEAM(pb + 12);
            }
        } else {
            if (PHM(11) && IN(pb + 11)) { MKP;
                const int ig = (DM / 64) * (2 * EXPERT_FF / 32), id = (EXPERT_FF / 64) * (DM / 32);
                for (int it = gw; it < NEXP * (ig + id); it += NGW) { const int e = it / (ig + id); int r = it % (ig + id);
                    if (conv_job(r, p.moe_gu + (size_t)e * DM * 2 * EXPERT_FF, DM, 2 * EXPERT_FF, MapGlu{WSP(bf16, AR_MGU) + (size_t)e * 2 * EXPERT_FF * DM, DM, EXPERT_FF}, scrw, lane)) continue;
                    conv_job(r, p.moe_down + (size_t)e * EXPERT_FF * DM, EXPERT_FF, DM, MapPlain{WSP(bf16, AR_MDN) + (size_t)e * DM * EXPERT_FF, EXPERT_FF}, scrw, lane); }
                int* rtok = WSP(int, AR_RTOK); float* rww = WSP(float, AR_RW8); int* trow = WSP(int, AR_TROW);
                for (int t = gw; t < T; t += NGW) {
                    int row0 = 0;
                    if (lane == 0) { const int ee = WSP(int, AR_RTE)[t], e0 = ee & 255, e1 = ee >> 8; const float* w = WSP(float, AR_RTW) + (size_t)t * 2;
                        row0 = moe_seg_start(ctl + CW_CNT, e0) + (int)atomicAdd(ctl + CW_FILL + e0, 1u);
                        const int row1 = moe_seg_start(ctl + CW_CNT + 8, e1) + (int)atomicAdd(ctl + CW_FILL + 8 + e1, 1u);
                        rtok[row0] = t; rww[row0] = w[0]; rtok[MOE_ROWS + row1] = t; rww[MOE_ROWS + row1] = w[1]; trow[T + t] = row1; }
                    row0 = __builtin_amdgcn_readfirstlane(row0);
                    copy_row_wave(WSP(bf16, WS_H) + (size_t)t * DM, WSP(bf16, AR_XG) + (size_t)row0 * DM, lane);
                }
                SEAM(pb + 11);
            }
#pragma unroll
            for (int pass = 0; pass < 2; ++pass) {
                if (PHM(12) && IN(pb + 12 + 2 * pass)) { MKP;
                    Gemm g{WSP(bf16, AR_XG), WSP(bf16, AR_MGU), MOE_ROWS, NEXP * 2 * EXPERT_FF, DM}; MoeOrder S; S.init(ctl + CW_CNT + 8 * pass, 2 * EXPERT_FF / 256, G, bid);
                    EpiSwiglu E{WSP(bf16, AR_MACT), EXPERT_FF, 2 * EXPERT_FF / 256};
                    pg8::gemm_phase<EpiSwiglu, MoeOrder, true, true>(lds, g, S, E, tid);
                    SEAM(pb + 12 + 2 * pass);
                }
                if (PHM(13) && IN(pb + 13 + 2 * pass)) { MKP;
                    Gemm g{WSP(bf16, AR_MACT), WSP(bf16, AR_MDN), MOE_ROWS, NEXP * DM, EXPERT_FF}; MoeOrder S; S.init(ctl + CW_CNT + 8 * pass, DM / 256, G, bid);
                    EpiMoeDown E{p.out, WSP(int, AR_RTOK) + (size_t)pass * MOE_ROWS, WSP(float, AR_RW8) + (size_t)pass * MOE_ROWS, DM / 256};
                    pg8::gemm_phase<EpiMoeDown, MoeOrder, true, true>(lds, g, S, E, tid);
                    if (pass == 0) { const int* trow = WSP(int, AR_TROW);
                        for (int t = gw; t < T; t += NGW) copy_row_wave(WSP(bf16, WS_H) + (size_t)t * DM, WSP(bf16, AR_XG) + (size_t)trow[T + t] * DM, lane); }
                    SEAM(pb + 13 + 2 * pass);
                }
            }
        }
    }
    }
#undef IN
#undef SEAM
}

#ifndef MK_ONE_LAUNCH
#define MK_ONE_LAUNCH 1
#endif
extern "C" void kernel_launch(void* const* d_in, const int* in_sizes, int n_in, void* d_out, int out_size, void* d_ws, size_t ws_size, hipStream_t stream) {
    static int grid = 0;
    if (grid == 0) {
        if (n_in != 29 || in_sizes[0] != T * DM || out_size != T * DM || ws_size < WS_END) { fprintf(stderr, "kernel_launch: unexpected shapes / workspace (%d inputs, ws %zu, need %zu)\n", n_in, ws_size, (size_t)WS_END); grid = -1; return; }
        int dev = 0, cus = 0;
        if (hipGetDevice(&dev) != hipSuccess || hipDeviceGetAttribute(&cus, hipDeviceAttributeMultiprocessorCount, dev) != hipSuccess) { grid = -1; return; }
        if (hipFuncSetAttribute((const void*)mk_fwd, hipFuncAttributeMaxDynamicSharedMemorySize, LDS_BYTES) != hipSuccess) { fprintf(stderr, "kernel_launch: hipFuncSetAttribute failed\n"); grid = -1; return; }
        int per_cu = 0;
        if (hipOccupancyMaxActiveBlocksPerMultiprocessor(&per_cu, (const void*)mk_fwd, NTHREADS, LDS_BYTES) != hipSuccess || per_cu < 1) { fprintf(stderr, "kernel_launch: occupancy query says %d\n", per_cu); }
        (void)hipGetLastError();
        grid = cus;
    }
    if (grid < 0) return;
    if (hipMemsetAsync((char*)d_ws + WS_CTL, 0, CTL_BYTES, stream) != hipSuccess) return;
    Args a{};
    for (int i = 0; i < 29; ++i) a.in[i] = (const float*)d_in[i];
    a.out = (float*)d_out; a.ws = (unsigned char*)d_ws;
#if MK_ONE_LAUNCH
    a.ph_lo = 0; a.ph_hi = NPHASES;
    hipLaunchKernelGGL(mk_fwd, dim3(grid), dim3(NTHREADS), LDS_BYTES, stream, a);
#else
    for (int k = 0; k < NPHASES; ++k) {
        if (k >= 1 + 13 && k < 1 + NPH) continue;
        a.ph_lo = k; a.ph_hi = k + 1;
        hipLaunchKernelGGL(mk_fwd, dim3(grid), dim3(NTHREADS), LDS_BYTES, stream, a);
    }
#endif
}
```

```cpp
#include <hip/hip_runtime.h>
#include <cstdio>
#include <cstdint>
#include <cmath>
#include <cstring>
#ifdef HOST_EMU
#define HD
#define DEV_INLINE inline
#else
#define HD __host__ __device__
#define DEV_INLINE __device__ __forceinline__
#endif

typedef unsigned short bf16;
struct alignas(16) U4 { unsigned x, y, z, w; };

#ifdef SMALL_CFG
constexpr int BATCH = 1, SEQ = 1024, DM = 128, DENSE_FF = 256, EXPERT_FF = 256;
#else
constexpr int BATCH = 8, SEQ = 8192, DM = 1024, DENSE_FF = 2816, EXPERT_FF = 3584;
#endif
constexpr int T = BATCH * SEQ;
constexpr int NHEAD = 8, NKV = 2, HG = 4, DH = 64;
constexpr int NC = SEQ / 16 - 1, NS = SEQ / 64, NSEL = 8, WINDOW = 512;
constexpr int CONV_CH = 512, CONV_K = 31, RC = 512;
constexpr int NEXP = 8;
constexpr int NSA_IN = 1304, OFF_CONV = 1304, OFF_GATE = 2328, OFF_RWKV = OFF_GATE + 3 * DM;
constexpr int N_IN_FIRST = OFF_RWKV + 1824, N_IN_REST = OFF_RWKV + 1856;
constexpr int NPROJ = 4352;
constexpr int LDQ = 512, LDKV = 512, LDRW = 2048, LBLK = 1536;
constexpr int MOE_ROWS = T + NEXP * 256;
constexpr float RMS_EPS = 1e-6f, LN_EPS = 1e-5f, GN_EPS = 64e-5f;

constexpr size_t al(size_t x) { return (x + 255) & ~(size_t)255; }
constexpr size_t WS_CTL = 0, CTL_BYTES = 1u << 20;
constexpr size_t SZ_WIN = (size_t)NPROJ * DM * 2, SZ_WG = (size_t)3 * DM * DM * 2, SZ_WO3 = (size_t)3 * DM * 512 * 2, SZ_WOUT = (size_t)DM * DM * 2;
constexpr size_t SZ_LW = (size_t)2048 * 384 * 2, SZ_CW1 = (size_t)2 * 256 * 1024 * 2, SZ_PEC = 1024;
constexpr size_t SZ_LAYERW = SZ_WIN + SZ_WG + SZ_WO3 + SZ_WOUT + SZ_LW + SZ_CW1 + SZ_PEC;
constexpr size_t WS_W = CTL_BYTES;
constexpr size_t OFF_WIN = 0, OFF_WG = SZ_WIN, OFF_WO3 = OFF_WG + SZ_WG, OFF_WOUT = OFF_WO3 + SZ_WO3, OFF_LW = OFF_WOUT + SZ_WOUT, OFF_CW1 = OFF_LW + SZ_LW, OFF_PEC = OFF_CW1 + SZ_CW1;
constexpr size_t WS_DGU = WS_W + 2 * SZ_LAYERW, SZ_DGU = (size_t)2 * DENSE_FF * DM * 2;
constexpr size_t WS_DDN = WS_DGU + SZ_DGU, SZ_DDN = (size_t)DM * DENSE_FF * 2;
constexpr size_t WS_VF = al(WS_DDN + SZ_DDN), SZ_TC = (size_t)T * 512 * 2;
constexpr size_t WS_H = WS_VF + SZ_TC, SZ_H = (size_t)T * DM * 2;
constexpr size_t WS_AR = al(WS_H + SZ_H);
constexpr size_t AR_QB = WS_AR, AR_A = AR_QB + SZ_TC, AR_CO = AR_A + SZ_TC;
constexpr size_t AR_KV = AR_CO + SZ_TC, SZ_KV = (size_t)T * LDKV * 2;
constexpr size_t AR_RW = AR_KV + SZ_KV, SZ_RW = (size_t)T * LDRW * 2;
constexpr size_t AR_W = AR_RW + SZ_RW, AR_G = AR_W + SZ_TC, AR_UB = AR_G + SZ_TC;
constexpr size_t AR_NG = AR_UB + SZ_TC, SZ_NG = (size_t)T * 24 * 4;
constexpr size_t AR_HALO = al(AR_NG + SZ_NG), SZ_HALO = (size_t)(T / 256) * LDRW * 2;
constexpr size_t AR_KC = al(AR_HALO + SZ_HALO), SZ_CMP = (size_t)BATCH * NKV * (SEQ / 16) * 64 * 2;
constexpr size_t AR_VC = AR_KC + SZ_CMP;
constexpr size_t AR_HID = al(AR_VC + SZ_CMP), SZ_HID = (size_t)BATCH * NKV * (SEQ / 16) * 2 * 128 * 4;
constexpr size_t AR_SEL = al(AR_HID + SZ_HID), SZ_SEL = (size_t)T * NKV * 8 * 4;
constexpr size_t AR_INVN = al(AR_SEL + SZ_SEL), SZ_INVN = (size_t)T * 8 * 4;
constexpr size_t AR_VCT = al(AR_INVN + SZ_INVN);
constexpr size_t AR_CKV = al(AR_VCT + SZ_CMP), SZ_CKV = (size_t)2 * T * 128;
constexpr size_t AR_END1 = al(AR_CKV + SZ_CKV * 2);
constexpr size_t WS_VST = WS_H, WS_VWT = WS_H + (size_t)T * 128 * 2, WS_LB = WS_VWT + (size_t)T * 128 * 2;
constexpr size_t AR_OBUF = AR_KV, SZ_OBUF = (size_t)3 * T * DM * 2;
constexpr size_t AR_MIX = AR_OBUF + SZ_OBUF, SZ_MIX = (size_t)T * DM * 2;
constexpr size_t AR_END2 = AR_MIX + SZ_MIX;
constexpr size_t AR_ACT = WS_AR;
constexpr size_t AR_MGU = WS_AR, SZ_MGU = (size_t)NEXP * 2 * EXPERT_FF * DM * 2;
constexpr size_t AR_MDN = AR_MGU + SZ_MGU, SZ_MDN = (size_t)NEXP * DM * EXPERT_FF * 2;
constexpr size_t AR_XG = al(AR_MDN + SZ_MDN), SZ_XG = (size_t)MOE_ROWS * DM * 2;
constexpr size_t AR_MACT = al(AR_XG + SZ_XG), SZ_MACT = (size_t)MOE_ROWS * EXPERT_FF * 2;
constexpr size_t AR_RTOK = al(AR_MACT + SZ_MACT), SZ_RTOK = (size_t)2 * MOE_ROWS * 4;
constexpr size_t AR_RW8 = al(AR_RTOK + SZ_RTOK);
constexpr size_t AR_TROW = al(AR_RW8 + SZ_RTOK), SZ_TROW = (size_t)2 * T * 4;
constexpr size_t AR_RTE = al(AR_TROW + SZ_TROW);
constexpr size_t AR_RTW = al(AR_RTE + (size_t)T * 4);
constexpr size_t AR_WBASE = al(AR_RTW + (size_t)T * 8);
constexpr size_t AR_END3 = al(AR_WBASE + (size_t)4096 * 16 * 4);
constexpr size_t WS_END = (AR_END1 > AR_END2 ? (AR_END1 > AR_END3 ? AR_END1 : AR_END3) : (AR_END2 > AR_END3 ? AR_END2 : AR_END3));
constexpr int CW_CNT = 1024;
constexpr int CW_ATT = 256;
constexpr int CW_BAR = 4096;

struct P {
    const float *x, *mix_norm_g, *w_in_first, *w_in_rest, *mu_first, *mu_rest, *qk_g, *cmp_pos, *cmp_w1, *cmp_w2, *nsa_w_o, *conv_w, *conv_vec, *conv_w_o,
        *rwkv_vec, *w_up, *a_up, *g_up, *vres_up, *vres_b, *rwkv_w_o, *w_out, *ffn_norm_g, *dense_gu, *dense_down, *router_w, *router_b, *moe_gu, *moe_down;
    float* out; unsigned char* ws;
};
HD inline void fill_params(P& p, const float* const* in, float* out, unsigned char* ws) {
    p.x = in[0]; p.mix_norm_g = in[1]; p.w_in_first = in[2]; p.w_in_rest = in[3]; p.mu_first = in[4]; p.mu_rest = in[5]; p.qk_g = in[6]; p.cmp_pos = in[7];
    p.cmp_w1 = in[8]; p.cmp_w2 = in[9]; p.nsa_w_o = in[10]; p.conv_w = in[11]; p.conv_vec = in[12]; p.conv_w_o = in[13]; p.rwkv_vec = in[14]; p.w_up = in[15];
    p.a_up = in[16]; p.g_up = in[17]; p.vres_up = in[18]; p.vres_b = in[19]; p.rwkv_w_o = in[20]; p.w_out = in[21]; p.ffn_norm_g = in[22]; p.dense_gu = in[23];
    p.dense_down = in[24]; p.router_w = in[25]; p.router_b = in[26]; p.moe_gu = in[27]; p.moe_down = in[28]; p.out = out; p.ws = ws;
}
#define WSP(type, off) ((type*)(p.ws + (off)))

#ifdef HOST_EMU
#define FENCE()
#else
#define FENCE() asm volatile("" ::: "memory")
#endif
HD inline float bf2f(bf16 v) { unsigned u = (unsigned)v << 16; float f; memcpy(&f, &u, 4); return f; }
HD inline bf16 f2bf(float f) { unsigned u; memcpy(&u, &f, 4); return (bf16)((u + 0x7fffu + ((u >> 16) & 1u)) >> 16); }
HD inline float blo(unsigned v) { unsigned u = v << 16; float f; memcpy(&f, &u, 4); return f; }
HD inline float bhi(unsigned v) { unsigned u = v & 0xffff0000u; float f; memcpy(&f, &u, 4); return f; }
#if !defined(SCAN_BF16) && !defined(RKV_BF16)
HD inline bf16 f2h(float f) { return __builtin_bit_cast(unsigned short, (_Float16)f); }
#else
HD inline bf16 f2bf(float f);
HD inline bf16 f2h(float f) { return f2bf(f); }
#endif
HD inline float h2f(bf16 v) { return (float)__builtin_bit_cast(_Float16, v); }
HD inline float sigmoidf_(float x) { return 1.f / (1.f + expf(-x)); }
HD inline float dot64(const float* q, const bf16* kp) {
    const U4* k4 = (const U4*)kp; float s0 = 0.f, s1 = 0.f;
#pragma unroll
    for (int i = 0; i < 8; ++i) { const U4 v = k4[i];
        s0 += q[8 * i + 0] * blo(v.x) + q[8 * i + 2] * blo(v.y) + q[8 * i + 4] * blo(v.z) + q[8 * i + 6] * blo(v.w);
        s1 += q[8 * i + 1] * bhi(v.x) + q[8 * i + 3] * bhi(v.y) + q[8 * i + 5] * bhi(v.z) + q[8 * i + 7] * bhi(v.w); }
    return s0 + s1;
}
HD inline float dot64p(const U4* q, const bf16* kp) {
    const U4* k4 = (const U4*)kp; float s0 = 0.f, s1 = 0.f;
#pragma unroll
    for (int i = 0; i < 8; ++i) { const U4 v = k4[i], w = q[i];
        s0 += blo(w.x) * blo(v.x) + blo(w.y) * blo(v.y) + blo(w.z) * blo(v.z) + blo(w.w) * blo(v.w);
        s1 += bhi(w.x) * bhi(v.x) + bhi(w.y) * bhi(v.y) + bhi(w.z) * bhi(v.z) + bhi(w.w) * bhi(v.w); }
    return s0 + s1;
}
HD inline void ld64(const bf16* kp, float* q) {
    const U4* k4 = (const U4*)kp;
#pragma unroll
    for (int i = 0; i < 8; ++i) { const U4 v = k4[i]; q[8 * i] = blo(v.x); q[8 * i + 1] = bhi(v.x); q[8 * i + 2] = blo(v.y); q[8 * i + 3] = bhi(v.y);
        q[8 * i + 4] = blo(v.z); q[8 * i + 5] = bhi(v.z); q[8 * i + 6] = blo(v.w); q[8 * i + 7] = bhi(v.w); }
}
HD inline void axpy64(float* o, float w, const bf16* vp) {
    const U4* k4 = (const U4*)vp;
#pragma unroll
    for (int i = 0; i < 8; ++i) { const U4 v = k4[i]; o[8 * i] += w * blo(v.x); o[8 * i + 1] += w * bhi(v.x); o[8 * i + 2] += w * blo(v.y); o[8 * i + 3] += w * bhi(v.y);
        o[8 * i + 4] += w * blo(v.z); o[8 * i + 5] += w * bhi(v.z); o[8 * i + 6] += w * blo(v.w); o[8 * i + 7] += w * bhi(v.w); }
}
HD inline void axpy64s(float* o, float w, const bf16* vp) {
    const U4* k4 = (const U4*)vp;
#pragma unroll
    for (int i = 0; i < 8; ++i) { const U4 v = k4[i]; o[8 * i] = w * o[8 * i] + blo(v.x); o[8 * i + 1] = w * o[8 * i + 1] + bhi(v.x); o[8 * i + 2] = w * o[8 * i + 2] + blo(v.y); o[8 * i + 3] = w * o[8 * i + 3] + bhi(v.y);
        o[8 * i + 4] = w * o[8 * i + 4] + blo(v.z); o[8 * i + 5] = w * o[8 * i + 5] + bhi(v.z); o[8 * i + 6] = w * o[8 * i + 6] + blo(v.w); o[8 * i + 7] = w * o[8 * i + 7] + bhi(v.w); }
}
HD inline void st64(bf16* op, const float* o) {
    U4* o4 = (U4*)op;
#pragma unroll
    for (int i = 0; i < 8; ++i) { U4 v; v.x = (unsigned)f2bf(o[8 * i]) | ((unsigned)f2bf(o[8 * i + 1]) << 16); v.y = (unsigned)f2bf(o[8 * i + 2]) | ((unsigned)f2bf(o[8 * i + 3]) << 16);
        v.z = (unsigned)f2bf(o[8 * i + 4]) | ((unsigned)f2bf(o[8 * i + 5]) << 16); v.w = (unsigned)f2bf(o[8 * i + 6]) | ((unsigned)f2bf(o[8 * i + 7]) << 16); o4[i] = v; }
}

HD inline void rope_cs(int pos, int i, float& cs, float& sn) {
    const float c = exp2f(-(float)i * 0.41524101186092f) * 0.15915494309189535f, pf = (float)pos;
    const float prod = pf * c, err = fmaf(pf, c, -prod), fr = (prod - rintf(prod)) + err;
#ifdef HOST_EMU
    cs = cosf(6.283185307179586f * fr); sn = sinf(6.283185307179586f * fr);
#else
    cs = __builtin_amdgcn_cosf(fr); sn = __builtin_amdgcn_sinf(fr);
#endif
}
HD inline int win_dest(int j, int layer, int& which) {
    which = 0;
    if (j < 1280) return j;
    if (j < 1304) return 3840 + 320 + (j - 1280);
    if (j < 1816) { const int cc = j - 1304; return 1280 + 256 * (cc / 128) + cc % 128; }
    if (j < 2328) { const int cc = j - 1816; return 1280 + 256 * (cc / 128) + 128 + cc % 128; }
    if (j < OFF_RWKV) { which = 1; const int gg = j - OFF_GATE, br = gg / DM; return (br == 0 ? 0 : (br == 1 ? 2 * DM : DM)) + gg % DM; }
    const int rr = j - OFF_RWKV;
    if (rr < 1536) return 2304 + rr;
    if (rr < 1824) return 3840 + (rr - 1536);
    if (rr < 1856 && layer == 1) return 3840 + 288 + (rr - 1824);
    return -1;
}
HD inline int glu_dest(int j, int ff) { return j < ff ? 256 * (j / 128) + j % 128 : 256 * ((j - ff) / 128) + 128 + (j - ff) % 128; }

DEV_INLINE void ph_shift(const P& p, int layer, long gtid, long NT) {
    bf16* RW = WSP(bf16, AR_RW); const bf16* HALO = WSP(bf16, AR_HALO); bf16* VF = WSP(bf16, WS_VF); bf16* LB = WSP(bf16, WS_LB);
    const float* mu = layer == 0 ? p.mu_first : p.mu_rest;
    const long n = (long)(T / 256) * (LBLK + 384);
    for (long it = gtid; it < n; it += NT) {
        const int pm = (int)(it / (LBLK + 384)), c = (int)(it % (LBLK + 384));
        int mi = -1, act = 0;
        if (c < LBLK) mi = c;
        else { const int w = c - LBLK; if (w < 288) { mi = 1536 + w; act = w < 64 ? 1 : (w >= 128 ? 2 : 0); } else if (w < 320 && layer == 1) mi = 1824 + (w - 288); }
        if (mi < 0) { for (int r = 0; r < 256; ++r) LB[((size_t)pm * 256 + r) * 384 + (c - LBLK)] = 0; continue; }
        const float m = mu[mi];
        float prev = ((pm * 256) % SEQ == 0) ? 0.f : bf2f(HALO[(size_t)(pm - 1) * LDRW + c]);
        bf16* col = RW + (size_t)pm * 256 * LDRW + c;
        for (int r = 0; r < 256; ++r) {
            const float pv = bf2f(col[(size_t)r * LDRW]);
            float u = pv + (prev - pv) * m; prev = pv;
            if (act == 1) u = tanhf(u); else if (act == 2) u = sigmoidf_(u);
            if (c < LBLK) { col[(size_t)r * LDRW] = f2h(u); if (layer == 0 && c >= 1024) VF[((size_t)pm * 256 + r) * RC + (c - 1024)] = f2h(u); }
            else LB[((size_t)pm * 256 + r) * 384 + (c - LBLK)] = f2bf(u);
        }
    }
}

DEV_INLINE void ph_nsa_prep(const P& p, int layer, long gtid, long NT) {
    bf16* QB = WSP(bf16, AR_QB); bf16* KV = WSP(bf16, AR_KV);
    const long n = (long)T * 12;
    for (long it = gtid; it < n; it += NT) {
        const int t = (int)(it / 12), s = (int)(it % 12), pos = t % SEQ;
        bf16* ptr; const float* g;
        if (s < 8) { ptr = QB + (size_t)t * LDQ + s * 64; g = p.qk_g + (layer * 4 + 0) * 64; }
        else if (s < 10) { ptr = KV + (size_t)t * LDKV + (s - 8) * 64; g = p.qk_g + (layer * 4 + 2) * 64; }
        else { ptr = KV + (size_t)t * LDKV + 256 + (s - 10) * 64; g = p.qk_g + (layer * 4 + 3) * 64; }
        float v[64]; ld64(ptr, v);
        float ss = 0.f;
#pragma unroll
        for (int i = 0; i < 64; ++i) ss += v[i] * v[i];
        const float rs = 1.f / sqrtf(ss * (1.f / 64.f) + RMS_EPS);
#pragma unroll
        for (int i = 0; i < 64; ++i) v[i] = v[i] * rs * g[i];
#pragma unroll
        for (int i = 0; i < 32; ++i) {
            float cs, sn; rope_cs(pos, i, cs, sn);
            const float x1 = v[i], x2 = v[i + 32]; v[i] = x1 * cs - x2 * sn; v[i + 32] = x2 * cs + x1 * sn;
        }
        if (s < 8) {
#pragma unroll
            for (int i = 0; i < 64; ++i) v[i] *= 0.125f * 1.4426950408889634f; }
        st64(ptr, v);
    }
}

DEV_INLINE void ph_vtrans(const P& p, long gtid, long NT) {
    const bf16* KV = WSP(bf16, AR_KV); bf16* VsT = WSP(bf16, WS_VST); bf16* VwT = WSP(bf16, WS_VWT);
    const long n = (long)BATCH * NKV * (SEQ / 8) * 64;
    for (long it = gtid; it < n; it += NT) {
        const int d = (int)(it % 64); long r = it / 64; const int t8 = (int)(r % (SEQ / 8)); const int bg = (int)(r / (SEQ / 8)), b = bg / NKV, g = bg % NKV;
        const bf16* src = KV + (size_t)(b * SEQ + 8 * t8) * LDKV + g * 64 + d;
        U4 s, w; unsigned short sv[8], wv[8];
#pragma unroll
        for (int j = 0; j < 8; ++j) { sv[j] = src[(size_t)j * LDKV + 128]; wv[j] = src[(size_t)j * LDKV + 384]; }
        s.x = sv[0] | ((unsigned)sv[1] << 16); s.y = sv[2] | ((unsigned)sv[3] << 16); s.z = sv[4] | ((unsigned)sv[5] << 16); s.w = sv[6] | ((unsigned)sv[7] << 16);
        w.x = wv[0] | ((unsigned)wv[1] << 16); w.y = wv[2] | ((unsigned)wv[3] << 16); w.z = wv[4] | ((unsigned)wv[5] << 16); w.w = wv[6] | ((unsigned)wv[7] << 16);
        *(U4*)(VsT + ((size_t)bg * 64 + d) * SEQ + 8 * t8) = s; *(U4*)(VwT + ((size_t)bg * 64 + d) * SEQ + 8 * t8) = w;
    }
}
namespace pg8 {
#define PG8_LAS __attribute__((address_space(3)))
typedef unsigned short bf16_t;
typedef short bf16x8 __attribute__((ext_vector_type(8)));
typedef float f32x4 __attribute__((ext_vector_type(4)));
typedef unsigned u32x4 __attribute__((ext_vector_type(4)));
constexpr int BM = 256, BK = 64, HALF = 128, HTB = HALF * BK * 2  , STAGE_BYTES = 8 * HTB, NXCD = 8, WGM = 8;

__host__ __device__ __forceinline__ int lds_byte(int r, int c) { const int st = (r >> 4) * 2 + (c >> 5), rr = r & 15, cc = c & 31, ob = rr * 64 + cc * 2; return st * 1024 + (ob ^ (((ob >> 9) & 1) << 5)); }
__host__ __device__ __forceinline__ void stage_rc(int b, int& R, int& C) { const int st = b / 1024, sb = b % 1024, swz = sb ^ (((sb >> 9) & 1) << 5); R = (st >> 1) * 16 + swz / 64; C = (st & 1) * 32 + (swz % 64) / 2; }
__host__ __device__ __forceinline__ int perm32(int rho) { const int n = rho >> 4, i = rho & 15; return 8 * (i >> 2) + 4 * n + (i & 3); }

struct Unit { int pm, pn; };
struct Gemm { const bf16_t* A; const bf16_t* Bt; int M, N, K; int lda; };

struct StaticOrder {
    int nM, nN, nwg, G, c;
    __host__ __device__ void init(int M, int N, int G_, int c_) { nM = M / BM; nN = N / BM; nwg = nM * nN; G = G_; c = c_; }
    __host__ __device__ bool next(int i, Unit& u) const {
        const long L = (long)i * G + c; if (L >= nwg) return false;
        int wgid = (int)L; { const int q = nwg / NXCD, r = nwg % NXCD, xcd = wgid % NXCD, off = wgid / NXCD; wgid = (xcd < r ? xcd * (q + 1) : r * (q + 1) + (xcd - r) * q) + off; }
        const int nig = WGM * nN, gid = wgid / nig, fm = gid * WGM, gsz = (nM - fm) < WGM ? (nM - fm) : WGM;
        u.pm = fm + ((wgid % nig) % gsz); u.pn = (wgid % nig) / gsz; return true;
    }
    __device__ __forceinline__ void a_ready(const Unit&) const {}
    __device__ __forceinline__ void done(const Unit&) const {}
};

__device__ __forceinline__ unsigned cvt_pk_bf16(float lo, float hi) { unsigned r; asm volatile("v_cvt_pk_bf16_f32 %0, %1, %2" : "=v"(r) : "v"(lo), "v"(hi)); return r; }
typedef float f32x2 __attribute__((ext_vector_type(2)));
template <class Epi, class Sched, bool ALIGN_EPI = false, bool SP2 = false>
__device__ __forceinline__ void gemm_phase(PG8_LAS unsigned char* lds, const Gemm g, const Sched& S, const Epi& E, int tid_in) {
    int tid_ = tid_in; asm volatile("" : "+v"(tid_));
    const int tid = tid_, wid = __builtin_amdgcn_readfirstlane(tid >> 6), lane = tid & 63, wr = wid >> 2, wc = wid & 3, fr = lane & 15, fq = lane >> 4;
    const int K = g.K, nt = K / BK, lda = g.lda ? g.lda : K;
    unsigned voffA[2], voffB[2];
#pragma unroll
    for (int i = 0; i < 2; ++i) { int R, C; stage_rc(tid * 16 + i * 8192, R, C); const int Rb = Epi::PERM ? ((R & ~31) + perm32(R & 31)) : R;
        voffA[i] = (unsigned)(R * lda + C) * 2u; voffB[i] = (unsigned)(Rb * K + C) * 2u; }
    const size_t kstep = (size_t)(BK * 2);
    const size_t hstepA = (size_t)HALF * lda * 2, hstepB = (size_t)HALF * K * 2;
    const size_t hstep_unused = (size_t)HALF * K * 2;
    const size_t tstepA = 2 * hstepA, tstepB = 2 * hstepB;
    const unsigned ldsw = (unsigned)wid * 1024u;
    const int aoff = lds_byte(wr * 64 + fr, fq * 8), boff = lds_byte(wc * 32 + fr, fq * 8);
#define PG8_SA(b, h) (((b) * 2 + (h)) * HTB)
#define PG8_SB(b, h) ((4 + (b) * 2 + (h)) * HTB)
#define PG8_STAGE(bufoff, gbase, voff) do { _Pragma("unroll") for (int _i = 0; _i < 2; ++_i) \
        __builtin_amdgcn_global_load_lds((const unsigned*)((const char*)(gbase) + (voff)[_i]), (PG8_LAS unsigned*)(lds + (bufoff) + ldsw + _i * 8192), 16, 0, 0); } while (0)
#define PG8_LDA(dst, b, h) do { _Pragma("unroll") for (int m = 0; m < 4; ++m) _Pragma("unroll") for (int k = 0; k < 2; ++k) dst[m][k] = *(const PG8_LAS bf16x8*)(lds + PG8_SA(b, h) + aoff + m * 2048 + k * 1024); } while (0)
#define PG8_LDB(dst, b, h) do { _Pragma("unroll") for (int n = 0; n < 2; ++n) _Pragma("unroll") for (int k = 0; k < 2; ++k) dst[n][k] = *(const PG8_LAS bf16x8*)(lds + PG8_SB(b, h) + boff + n * 2048 + k * 1024); } while (0)
#define PG8_MMA(ai, bj, At, Bt) do { __builtin_amdgcn_s_setprio(1); _Pragma("unroll") for (int m = 0; m < 4; ++m) _Pragma("unroll") for (int n = 0; n < 2; ++n) _Pragma("unroll") for (int k = 0; k < 2; ++k) \
        acc[ai][bj][m][n] = __builtin_amdgcn_mfma_f32_16x16x32_bf16(Bt[n][k], At[m][k], acc[ai][bj][m][n], 0, 0, 0); __builtin_amdgcn_s_setprio(0); } while (0)
#define PG8_WAIT_V(n) asm volatile("s_waitcnt vmcnt(" #n ")" ::: "memory")
#define PG8_WAIT_L(n) asm volatile("s_waitcnt lgkmcnt(" #n ")" ::: "memory")
#define PG8_BAR __builtin_amdgcn_s_barrier()
#define PG8_SCHED __builtin_amdgcn_sched_barrier(0)
    Unit cur, nxt; int ui = 0;
    if (!S.next(0, cur)) return;
    f32x4 acc[2][2][4][2];
#pragma unroll
    for (int a = 0; a < 2; ++a)
#pragma unroll
        for (int b = 0; b < 2; ++b)
#pragma unroll
            for (int m = 0; m < 4; ++m)
#pragma unroll
                for (int n = 0; n < 2; ++n) acc[a][b][m][n] = (f32x4){0.f, 0.f, 0.f, 0.f};
    bf16x8 At[4][2], B0[2][2], B1[2][2];
    const char* cA = (const char*)g.A + (size_t)cur.pm * tstepA; const char* cB = (const char*)g.Bt + (size_t)cur.pn * tstepB;
    S.a_ready(cur);
    if constexpr (SP2) {
        PG8_STAGE(PG8_SB(0, 0), cB, voffB); PG8_STAGE(PG8_SB(0, 1), cB + hstepB, voffB); PG8_STAGE(PG8_SA(0, 0), cA, voffA); PG8_STAGE(PG8_SA(0, 1), cA + hstepA, voffA);
        if (wr == 1) PG8_BAR;
        PG8_WAIT_V(2); PG8_BAR;
        PG8_STAGE(PG8_SB(1, 0), cB + kstep, voffB); PG8_STAGE(PG8_SA(1, 0), cA + kstep, voffA); PG8_STAGE(PG8_SB(1, 1), cB + hstepB + kstep, voffB);
        PG8_WAIT_V(6); PG8_BAR;
    } else {
        PG8_STAGE(PG8_SB(0, 0), cB, voffB); PG8_STAGE(PG8_SA(0, 0), cA, voffA); PG8_STAGE(PG8_SB(0, 1), cB + hstepB, voffB); PG8_STAGE(PG8_SA(0, 1), cA + hstepA, voffA);
        if (wr == 1) PG8_BAR;
        PG8_WAIT_V(4); PG8_BAR;
        PG8_STAGE(PG8_SB(1, 0), cB + kstep, voffB); PG8_STAGE(PG8_SA(1, 0), cA + kstep, voffA); PG8_STAGE(PG8_SB(1, 1), cB + hstepB + kstep, voffB);
        PG8_WAIT_V(6); PG8_BAR;
    }
    for (;;) {
        const bool has_next = S.next(ui + 1, nxt);
        const char* nA = has_next ? (const char*)g.A + (size_t)nxt.pm * tstepA : cA; const char* nB = has_next ? (const char*)g.Bt + (size_t)nxt.pn * tstepB : cB;
        for (int t = 0; t < nt; t += 2) {
            const bool last = (t == nt - 2);
            const char* a1 = cA + (size_t)(t + 1) * kstep;
            const char* a2 = last ? nA : cA + (size_t)(t + 2) * kstep; const char* b2 = last ? nB : cB + (size_t)(t + 2) * kstep;
            const char* a3 = a2 + kstep; const char* b3 = b2 + kstep;
            if (last && has_next) S.a_ready(nxt);
            if constexpr (SP2) {
            PG8_LDB(B0, 0, 0); PG8_LDB(B1, 0, 1); PG8_SCHED; PG8_LDA(At, 0, 0); PG8_STAGE(PG8_SA(1, 1), a1 + hstepA, voffA);
            PG8_WAIT_V(8); PG8_WAIT_L(0); PG8_BAR; PG8_MMA(0, 0, At, B0); PG8_MMA(0, 1, At, B1); PG8_BAR; PG8_SCHED;
            PG8_LDA(At, 0, 1); PG8_STAGE(PG8_SB(0, 0), b2, voffB); PG8_STAGE(PG8_SB(0, 1), b2 + hstepB, voffB); PG8_STAGE(PG8_SA(0, 0), a2, voffA);
            PG8_WAIT_V(8); PG8_WAIT_L(0); PG8_BAR; PG8_MMA(1, 0, At, B0); PG8_MMA(1, 1, At, B1); PG8_BAR; PG8_SCHED;
            PG8_LDB(B0, 1, 0); PG8_LDB(B1, 1, 1); PG8_SCHED; PG8_LDA(At, 1, 0); PG8_STAGE(PG8_SA(0, 1), a2 + hstepA, voffA);
            PG8_WAIT_V(8); PG8_WAIT_L(0); PG8_BAR; PG8_MMA(0, 0, At, B0); PG8_MMA(0, 1, At, B1); PG8_BAR; PG8_SCHED;
            PG8_LDA(At, 1, 1); PG8_STAGE(PG8_SB(1, 0), b3, voffB); PG8_STAGE(PG8_SB(1, 1), b3 + hstepB, voffB); PG8_STAGE(PG8_SA(1, 0), a3, voffA);
            PG8_WAIT_V(8); PG8_WAIT_L(0); PG8_BAR; PG8_MMA(1, 0, At, B0); PG8_MMA(1, 1, At, B1); PG8_BAR; PG8_SCHED;
            } else {
            PG8_LDB(B0, 0, 0); PG8_SCHED; PG8_LDA(At, 0, 0); PG8_STAGE(PG8_SA(1, 1), a1 + hstepA, voffA);
            PG8_WAIT_L(8); PG8_BAR; PG8_WAIT_L(0); PG8_MMA(0, 0, At, B0); PG8_BAR; PG8_SCHED;
            PG8_LDB(B1, 0, 1); PG8_STAGE(PG8_SB(0, 0), b2, voffB);
            PG8_BAR; PG8_WAIT_L(0); PG8_MMA(0, 1, At, B1); PG8_BAR;
            PG8_LDA(At, 0, 1); PG8_STAGE(PG8_SA(0, 0), a2, voffA);
            PG8_BAR; PG8_WAIT_L(0); PG8_MMA(1, 0, At, B0); PG8_BAR; PG8_SCHED;
            PG8_STAGE(PG8_SB(0, 1), b2 + hstepB, voffB);
            PG8_WAIT_V(6); PG8_BAR; PG8_MMA(1, 1, At, B1); PG8_BAR;
            PG8_LDB(B0, 1, 0); PG8_SCHED; PG8_LDA(At, 1, 0); PG8_STAGE(PG8_SA(0, 1), a2 + hstepA, voffA);
            PG8_WAIT_L(8); PG8_BAR; PG8_WAIT_L(0); PG8_MMA(0, 0, At, B0); PG8_BAR; PG8_SCHED;
            PG8_LDB(B1, 1, 1); PG8_STAGE(PG8_SB(1, 0), b3, voffB);
            PG8_BAR; PG8_WAIT_L(0); PG8_MMA(0, 1, At, B1); PG8_BAR;
            PG8_LDA(At, 1, 1); PG8_STAGE(PG8_SA(1, 0), a3, voffA);
            PG8_BAR; PG8_WAIT_L(0); PG8_MMA(1, 0, At, B0); PG8_BAR; PG8_SCHED;
            PG8_STAGE(PG8_SB(1, 1), b3 + hstepB, voffB);
            PG8_WAIT_V(6); PG8_BAR; PG8_MMA(1, 1, At, B1); PG8_BAR;
            }
        }
        if constexpr (ALIGN_EPI) { if (wr == 0) PG8_BAR; }
        if constexpr (!Epi::AFTER_DRAIN) { E(acc, cur, wr, wc, fr, fq); S.done(cur); }
        if (!has_next) break;
#pragma unroll
        for (int a = 0; a < 2; ++a)
#pragma unroll
            for (int b = 0; b < 2; ++b)
#pragma unroll
                for (int m = 0; m < 4; ++m)
#pragma unroll
                    for (int n = 0; n < 2; ++n) acc[a][b][m][n] = (f32x4){0.f, 0.f, 0.f, 0.f};
        cur = nxt; cA = nA; cB = nB; ++ui;
        if constexpr (ALIGN_EPI) { if (wr == 1) PG8_BAR; }
    }
    PG8_WAIT_V(0);
    if constexpr (!ALIGN_EPI) { if (wr == 0) PG8_BAR; }
    PG8_BAR;
    if constexpr (Epi::AFTER_DRAIN) { E.fused(acc, cur, wr, wc, fr, fq, lds, wid, lane); S.done(cur); }
#undef PG8_SA
#undef PG8_SB
#undef PG8_STAGE
#undef PG8_LDA
#undef PG8_LDB
#undef PG8_MMA
#undef PG8_WAIT_V
#undef PG8_WAIT_L
#undef PG8_BAR
#undef PG8_SCHED
}
}

#define LAS __attribute__((address_space(3)))
#define XB_TMO      128
#define XB_XCNT(j)  (256  + 64 * (j))
#define XB_XSUB(j)  (1280 + 64 * (j))
#define XB_XGEN(j)  (2304 + 64 * (j))
#define XB_TOP      3328
#define XB_TOPGEN   3392
#define XCD_BAR_WORDS 3456
#define XB_SPIN_CAP (1u << 22)

__device__ __forceinline__ unsigned xb_ld(unsigned* p)              { return __hip_atomic_load(p, __ATOMIC_RELAXED, __HIP_MEMORY_SCOPE_AGENT); }
__device__ __forceinline__ unsigned xb_add(unsigned* p, unsigned v) { return __hip_atomic_fetch_add(p, v, __ATOMIC_RELAXED, __HIP_MEMORY_SCOPE_AGENT); }
__device__ __forceinline__ unsigned xb_xcc_id() { return (unsigned)__builtin_amdgcn_s_getreg((3 << 11) | 20) & 0xFu; }
#define XB_SPIN(cond, bar) do { unsigned _sp = 0; while (cond) { __builtin_amdgcn_s_sleep(1); \
    if ((++_sp & 255u) == 0u) { if (xb_ld(&(bar)[XB_TMO])) break; if (_sp > XB_SPIN_CAP) { atomicAdd(&(bar)[XB_TMO], 1u); break; } } } } while (0)

struct XcdBarrier {
    unsigned* bar; unsigned x;
    volatile LAS unsigned* st;
};

__device__ __forceinline__ XcdBarrier xcd_barrier_post(unsigned* bar, volatile LAS unsigned* st) {
    XcdBarrier b; b.bar = bar; b.x = xb_xcc_id(); b.st = st;
    if (threadIdx.x == 0) (void)xb_add(&bar[XB_XCNT(b.x)], 1u);
    return b;
}
__device__ __forceinline__ void xcd_barrier_complete(unsigned* bar, unsigned x, unsigned& nloc, unsigned& nx) {
    const unsigned G = gridDim.x * gridDim.y * gridDim.z;
    unsigned sum, cnt, mine, sp = 0u;
    for (;;) {
        sum = 0u; cnt = 0u; mine = 0u;
#pragma unroll
        for (unsigned j = 0; j < 16; ++j) { const unsigned c = xb_ld(&bar[XB_XCNT(j)]); sum += c; cnt += (c > 0u) ? 1u : 0u; mine = (j == x) ? c : mine; }
        if (sum == G) break;
        __builtin_amdgcn_s_sleep(1);
        if ((++sp & 255u) == 0u) { if (xb_ld(&bar[XB_TMO])) break; if (sp > XB_SPIN_CAP) { atomicAdd(&bar[XB_TMO], 1u); break; } }
    }
    nloc = mine > 0u ? mine : 1u; nx = cnt > 0u ? cnt : 1u;
}

__device__ __forceinline__ void xcd_barrier(const XcdBarrier& b, int tid_x  ) {
    asm volatile("s_waitcnt vmcnt(0)" ::: "memory");
    __syncthreads();
    if (tid_x == 0) {
        unsigned* bar = b.bar; asm volatile("" : "+s"(bar));
        unsigned xx = b.x; asm volatile("" : "+s"(xx));
        __builtin_amdgcn_s_waitcnt(0);
        unsigned nloc = b.st[0], nx = b.st[1];
        if (nloc == 0u) { xcd_barrier_complete(bar, xx, nloc, nx); b.st[0] = nloc; b.st[1] = nx; }
        const unsigned old = xb_add(&bar[XB_XSUB(xx)], 1u);
        const unsigned gen = old / nloc;
        if (old + 1u == (gen + 1u) * nloc) {
            __builtin_amdgcn_fence(__ATOMIC_RELEASE, "agent");
            asm volatile("s_waitcnt vmcnt(0)" ::: "memory");
            const unsigned og = xb_add(&bar[XB_TOP], 1u);
            const unsigned tg = og / nx;
            if (og + 1u == (tg + 1u) * nx) xb_add(&bar[XB_TOPGEN], 1u);
            else XB_SPIN(xb_ld(&bar[XB_TOPGEN]) == tg, bar);
            __builtin_amdgcn_fence(__ATOMIC_ACQUIRE, "agent");
            xb_add(&bar[XB_XGEN(xx)], 1u);
            asm volatile("s_waitcnt vmcnt(0)" ::: "memory");
        } else {
            XB_SPIN(xb_ld(&bar[XB_XGEN(xx)]) == gen, bar);
            __builtin_amdgcn_fence(__ATOMIC_ACQUIRE, "agent");
            asm volatile("s_waitcnt vmcnt(0)" ::: "memory");
        }
    }
    __syncthreads();
}
#define GAS __attribute__((address_space(1)))
typedef unsigned v4u __attribute__((ext_vector_type(4)));
typedef unsigned v2u __attribute__((ext_vector_type(2)));
typedef GAS unsigned gu32;
#define RLX_AGENT __ATOMIC_RELAXED, __HIP_MEMORY_SCOPE_AGENT
#define LDS_WAIT() asm volatile("s_waitcnt lgkmcnt(0)" ::: "memory")
#define VM_WAIT() asm volatile("s_waitcnt vmcnt(0)" ::: "memory")
using pg8::f32x4; using pg8::Unit; using pg8::Gemm; using pg8::BM; using pg8::HALF; using pg8::cvt_pk_bf16; using pg8::u32x4;

constexpr int NWAVES = 8, NTHREADS = 512;
constexpr int RING_BYTES = 131072, LDSCTL_OFF = 147456 - 1024, MISC_OFF = LDSCTL_OFF + 320, LDS_BYTES = 147456;

__device__ __forceinline__ float wave_sum(float v, int lane) {
#pragma unroll
    for (int o = 1; o < 64; o <<= 1) v += __builtin_bit_cast(float, __builtin_amdgcn_ds_bpermute((lane ^ o) << 2, __builtin_bit_cast(int, v)));
    return v;
}
__device__ __forceinline__ float fsig(float x) { return __builtin_amdgcn_rcpf(1.f + __expf(-x)); }

__device__ __forceinline__ int lane_id_opaque() { int l; asm volatile("v_mbcnt_lo_u32_b32 %0, -1, 0\n\tv_mbcnt_hi_u32_b32 %0, -1, %0" : "=v"(l)); return l; }
__device__ __forceinline__ int rfl(int v) { return __builtin_amdgcn_readfirstlane(v); }
struct SOrder {
    pg8::StaticOrder s;
    __device__ void init(int M, int N, int G, int c) { s.init(M, N, G, c); }
    __device__ bool next(int i, Unit& u) const { Unit t; t.pm = 0; t.pn = 0; const bool ok = s.next(i, t); u.pm = rfl(t.pm); u.pn = rfl(t.pn); return ok; }
    __device__ __forceinline__ void a_ready(const Unit&) const {}
    __device__ __forceinline__ void done(const Unit&) const {}
};
struct StackOrder {
    int nM, nN, nb, G, c;
    __device__ bool next(int i, Unit& u) const { const long L = (long)i * G + c; if (L >= (long)nb * nM * nN) return false;
        const int br = (int)(L / (nM * nN)), rem = (int)(L % (nM * nN)); u.pm = rfl(br * nM + rem / nN); u.pn = rfl(br * nN + rem % nN); return true; }
    __device__ __forceinline__ void a_ready(const Unit&) const {}
    __device__ __forceinline__ void done(const Unit&) const {}
};
struct GateOrder {
    int nM, nN, G, c;
    __device__ bool next(int i, Unit& u) const { const int j = i / 3, br = i - 3 * j; const long L = (long)j * G + c; if (L >= (long)nM * nN) return false;
        u.pm = rfl((int)(L / nN)); u.pn = rfl(br * nN + (int)(L % nN)); return true; }
    __device__ __forceinline__ void a_ready(const Unit&) const {}
    __device__ __forceinline__ void done(const Unit&) const {}
};
struct MoeOrder {
    pg8::StaticOrder s; int nN, e0, e1, e2, e3, e4, e5, e6, e7;
    __device__ void init(const unsigned* cnt  , int nN_, int G_, int c_) { nN = nN_;
        int t = 0; t += (cnt[0] + 255) >> 8; e0 = t; t += (cnt[64] + 255) >> 8; e1 = t; t += (cnt[128] + 255) >> 8; e2 = t; t += (cnt[192] + 255) >> 8; e3 = t;
        t += (cnt[256] + 255) >> 8; e4 = t; t += (cnt[320] + 255) >> 8; e5 = t; t += (cnt[384] + 255) >> 8; e6 = t; t += (cnt[448] + 255) >> 8; e7 = t;
        s.init(e7 * 256, nN_ * 256, G_, c_); }
    __device__ bool next(int i, Unit& u) const { Unit t; t.pm = 0; t.pn = 0; if (!s.next(i, t)) return false;
        const int pm = t.pm, e = (pm >= e0) + (pm >= e1) + (pm >= e2) + (pm >= e3) + (pm >= e4) + (pm >= e5) + (pm >= e6);
        u.pm = rfl(pm); u.pn = rfl(e * nN + t.pn); return true; }
    __device__ __forceinline__ void a_ready(const Unit&) const {}
    __device__ __forceinline__ void done(const Unit&) const {}
};

__device__ __forceinline__ u32x4 pack8(f32x4 v0, f32x4 v1) { u32x4 w; w.x = cvt_pk_bf16(v0[0], v0[1]); w.y = cvt_pk_bf16(v0[2], v0[3]); w.z = cvt_pk_bf16(v1[0], v1[1]); w.w = cvt_pk_bf16(v1[2], v1[3]); return w; }
__device__ __forceinline__ void unpack8(u32x4 w, f32x4& v0, f32x4& v1) {
    v0 = (f32x4){blo(w.x), bhi(w.x), blo(w.y), bhi(w.y)}; v1 = (f32x4){blo(w.z), bhi(w.z), blo(w.w), bhi(w.w)}; }

struct EpiProj {
    static constexpr bool PERM = true, AFTER_DRAIN = false;
    unsigned char* ws;
    __device__ __forceinline__ void operator()(const f32x4 (&acc)[2][2][4][2], const Unit& u, int wr, int wc, int fr, int fq) const {
        bf16* const QB = (bf16*)(ws + AR_QB); bf16* const KV = (bf16*)(ws + AR_KV); bf16* const UB = (bf16*)(ws + AR_UB); bf16* const RW = (bf16*)(ws + AR_RW); bf16* const HALO = (bf16*)(ws + AR_HALO); bf16* const CKV = (bf16*)(ws + AR_CKV);
        const int row0 = u.pm * BM + wr * 64 + fr, cl = wc * 32 + 8 * fq;
        if (u.pn >= 5 && u.pn < 9) {
#pragma unroll
            for (int ai = 0; ai < 2; ++ai)
#pragma unroll
                for (int m = 0; m < 4; ++m) { f32x4 a0 = acc[ai][0][m][0], a1 = acc[ai][0][m][1]; const f32x4 b0 = acc[ai][1][m][0], b1 = acc[ai][1][m][1];
#pragma unroll
                    for (int k = 0; k < 4; ++k) { a0[k] *= fsig(b0[k]); a1[k] *= fsig(b1[k]); }
                    *(u32x4*)(UB + (size_t)(row0 + ai * HALF + m * 16) * 512 + (u.pn - 5) * 128 + cl) = pack8(a0, a1); }
            return;
        }
        if (u.pn == 2) {
#pragma unroll
            for (int ai = 0; ai < 2; ++ai)
#pragma unroll
                for (int m = 0; m < 4; ++m) { const int row = row0 + ai * HALF + m * 16, b = row / SEQ, tt = row % SEQ;
#pragma unroll
                    for (int bj = 0; bj < 2; ++bj) *(u32x4*)(CKV + (((size_t)bj * (BATCH * NKV) + b * NKV + (cl >> 6)) * SEQ + tt) * 64 + (cl & 63)) = pack8(acc[ai][bj][m][0], acc[ai][bj][m][1]); }
            return;
        }
        bf16* base; int ld, c0;
        if (u.pn < 2) { base = QB; ld = LDQ; c0 = u.pn * 256; } else if (u.pn < 5) { base = KV; ld = LDKV; c0 = (u.pn - 3) * 256; } else { base = RW; ld = LDRW; c0 = (u.pn - 9) * 256; }
#pragma unroll
        for (int ai = 0; ai < 2; ++ai)
#pragma unroll
            for (int m = 0; m < 4; ++m)
#pragma unroll
                for (int bj = 0; bj < 2; ++bj) { const u32x4 w = pack8(acc[ai][bj][m][0], acc[ai][bj][m][1]);
                    *(u32x4*)(base + (size_t)(row0 + ai * HALF + m * 16) * ld + c0 + bj * HALF + cl) = w;
                    if (u.pn >= 9 && ai == 1 && m == 3 && wr == 1 && fr == 15) *(u32x4*)(HALO + (size_t)u.pm * LDRW + c0 + bj * HALF + cl) = w; }
    }
};
struct EpiStore {
    static constexpr bool PERM = true, AFTER_DRAIN = false;
    bf16* O; int ld, ntn;
    __device__ __forceinline__ void operator()(const f32x4 (&acc)[2][2][4][2], const Unit& u, int wr, int wc, int fr, int fq) const {
        const int row0 = u.pm * BM + wr * 64 + fr, c0 = (u.pn % ntn) * 256 + wc * 32 + 8 * fq;
#pragma unroll
        for (int ai = 0; ai < 2; ++ai)
#pragma unroll
            for (int m = 0; m < 4; ++m)
#pragma unroll
                for (int bj = 0; bj < 2; ++bj) *(u32x4*)(O + (size_t)(row0 + ai * HALF + m * 16) * ld + c0 + bj * HALF) = pack8(acc[ai][bj][m][0], acc[ai][bj][m][1]);
    }
};
struct EpiGate {
    static constexpr bool PERM = true, AFTER_DRAIN = false;
    unsigned char* ws; int ntn;
    __device__ __forceinline__ void operator()(const f32x4 (&acc)[2][2][4][2], const Unit& u, int wr, int wc, int fr, int fq) const {
        const bf16* const OB = (const bf16*)(ws + AR_OBUF); bf16* const MIX = (bf16*)(ws + AR_MIX);
        const int br = u.pn / ntn, row0 = u.pm * BM + wr * 64 + fr, c0 = (u.pn % ntn) * 256 + wc * 32 + 8 * fq;
        const bf16* ob = OB + (size_t)br * T * DM;
#pragma unroll
        for (int ai = 0; ai < 2; ++ai)
#pragma unroll
            for (int m = 0; m < 4; ++m)
#pragma unroll
                for (int bj = 0; bj < 2; ++bj) { const size_t off = (size_t)(row0 + ai * HALF + m * 16) * DM + c0 + bj * HALF;
                    f32x4 o0, o1; unpack8(*(const u32x4*)(ob + off), o0, o1);
                    f32x4 g0 = acc[ai][bj][m][0], g1 = acc[ai][bj][m][1];
#pragma unroll
                    for (int k = 0; k < 4; ++k) { g0[k] = fsig(g0[k]) * o0[k]; g1[k] = fsig(g1[k]) * o1[k]; }
                    if (br != 0) { f32x4 p0, p1; unpack8(*(const u32x4*)(MIX + off), p0, p1); g0 += p0; g1 += p1; }
                    *(u32x4*)(MIX + off) = pack8(g0, g1); }
    }
};
struct EpiResid {
    static constexpr bool PERM = true, AFTER_DRAIN = false;
    const float* base; float* out;
    __device__ __forceinline__ void operator()(const f32x4 (&acc)[2][2][4][2], const Unit& u, int wr, int wc, int fr, int fq) const {
        const int row0 = u.pm * BM + wr * 64 + fr, c0 = u.pn * 256 + wc * 32 + 8 * fq;
#pragma unroll
        for (int ai = 0; ai < 2; ++ai)
#pragma unroll
            for (int m = 0; m < 4; ++m)
#pragma unroll
                for (int bj = 0; bj < 2; ++bj) { const size_t off = (size_t)(row0 + ai * HALF + m * 16) * DM + c0 + bj * HALF;
                    const f32x4 x0 = *(const f32x4*)(base + off), x1 = *(const f32x4*)(base + off + 4);
                    *(f32x4*)(out + off) = x0 + acc[ai][bj][m][0]; *(f32x4*)(out + off + 4) = x1 + acc[ai][bj][m][1]; }
    }
};
struct EpiSwiglu {
    static constexpr bool PERM = true, AFTER_DRAIN = false;
    bf16* ACT; int ld, ntn;
    __device__ __forceinline__ void operator()(const f32x4 (&acc)[2][2][4][2], const Unit& u, int wr, int wc, int fr, int fq) const {
        const int row0 = u.pm * BM + wr * 64 + fr, c0 = (u.pn % ntn) * 128 + wc * 32 + 8 * fq;
#pragma unroll
        for (int ai = 0; ai < 2; ++ai)
#pragma unroll
            for (int m = 0; m < 4; ++m) { f32x4 g0 = acc[ai][0][m][0], g1 = acc[ai][0][m][1]; const f32x4 u0 = acc[ai][1][m][0], u1 = acc[ai][1][m][1];
#pragma unroll
                for (int k = 0; k < 4; ++k) { g0[k] = g0[k] * fsig(g0[k]) * u0[k]; g1[k] = g1[k] * fsig(g1[k]) * u1[k]; }
                *(u32x4*)(ACT + (size_t)(row0 + ai * HALF + m * 16) * ld + c0) = pack8(g0, g1); }
    }
};
struct EpiMoeDown {
    static constexpr bool PERM = true, AFTER_DRAIN = false;
    float* out; const int* rtok; const float* rw; int ntn; float sc;
    __device__ __forceinline__ void operator()(const f32x4 (&acc)[2][2][4][2], const Unit& u, int wr, int wc, int fr, int fq) const {
        const int row0 = u.pm * BM + wr * 64 + fr, c0 = (u.pn % ntn) * 256 + wc * 32 + 8 * fq;
#pragma unroll
        for (int ai = 0; ai < 2; ++ai)
#pragma unroll
            for (int m = 0; m < 4; ++m) { const int row = row0 + ai * HALF + m * 16; const int tok = rtok[row]; const float w = rw[row] * sc;
                if (tok >= 0) {
#pragma unroll
                    for (int bj = 0; bj < 2; ++bj) { float* o = out + (size_t)tok * DM + c0 + bj * HALF;
                        const f32x4 x0 = *(const f32x4*)o, x1 = *(const f32x4*)(o + 4);
                        *(f32x4*)o = x0 + acc[ai][bj][m][0] * w; *(f32x4*)(o + 4) = x1 + acc[ai][bj][m][1] * w; } } }
    }
};

typedef short bf16x8_t __attribute__((ext_vector_type(8)));
#define MFMA16(a, b, c) __builtin_amdgcn_mfma_f32_16x16x32_bf16((a), (b), (c), 0, 0, 0)
constexpr float ATT_C = 0.125f * 1.4426950408889634f;
constexpr int AW_IMP = 0, AW_SEL = 8448, AW_QS = 8960, AW_BYTES = 8960 + 8192;
__device__ __forceinline__ float bperm_f(float v, int srclane) { return __builtin_bit_cast(float, __builtin_amdgcn_ds_bpermute(srclane << 2, __builtin_bit_cast(int, v))); }
__device__ __forceinline__ int bperm_i(int v, int srclane) { return __builtin_amdgcn_ds_bpermute(srclane << 2, v); }
__device__ __forceinline__ bf16x8_t ldg8(const bf16* p) { return *(const bf16x8_t*)p; }
__device__ __forceinline__ bf16x8_t pack_p(const f32x4& a, const f32x4& b) {
    v4u w; w.x = cvt_pk_bf16(a[0], a[1]); w.y = cvt_pk_bf16(a[2], a[3]); w.z = cvt_pk_bf16(b[0], b[1]); w.w = cvt_pk_bf16(b[2], b[3]); return __builtin_bit_cast(bf16x8_t, w); }

__device__ __forceinline__ void nsa_attn_item(const P& p, int item, int lane, LAS unsigned char* wl) {
    const bf16* KV = WSP(bf16, AR_KV); const bf16* KC = WSP(bf16, AR_KC); const bf16* VcT = WSP(bf16, AR_VCT); const bf16* VsT = WSP(bf16, WS_VST); const bf16* VwT = WSP(bf16, WS_VWT);
    bf16* QB = WSP(bf16, AR_QB); const float* NG = WSP(float, AR_NG);
    const int bg = item / (SEQ / 16), t0 = (item % (SEQ / 16)) * 16, b = bg >> 1, g = bg & 1;
    const int col = lane & 15, fq = lane >> 4, tok = t0 + col;
    const size_t grow = (size_t)b * SEQ + tok;
    LAS float* IMP = (LAS float*)(wl + AW_IMP); LAS int* SEL = (LAS int*)(wl + AW_SEL); LAS bf16* OS = (LAS bf16*)(wl + AW_IMP);
    const int krowA = 8 * (col >> 2) + (col & 3);
    const float* gate = NG + grow * 24 + g * 12;
    LAS bf16x8_t* QS = (LAS bf16x8_t*)(wl + AW_QS) + lane;
#pragma unroll
    for (int hh = 0; hh < 4; ++hh)
#pragma unroll
        for (int ks = 0; ks < 2; ++ks) QS[(hh * 2 + ks) * 64] = ldg8(QB + grow * LDQ + (g * 4 + hh) * 64 + ks * 32 + fq * 8);
#define Qc(hh, ks) (QS[((hh) * 2 + (ks)) * 64])
    for (int i = lane; i < 16 * 132; i += 64) IMP[i] = 0.f;
    const f32x4 z4 = {0.f, 0.f, 0.f, 0.f};
    f32x4 O[4][4];
    int nvmax = (t0 + 15 >= 31) ? (((t0 + 15 - 31) >> 4) + 1) : 0; if (nvmax > NC) nvmax = NC;
    const int nch = (nvmax + 31) >> 5;
    const bf16* kcb = KC + (size_t)bg * 512 * 64; const bf16* vcb = VcT + (size_t)bg * 64 * 512;
    float linv[4] = {0.f, 0.f, 0.f, 0.f};
#pragma unroll
    for (int hh = 0; hh < 4; ++hh)
#pragma unroll
        for (int mt = 0; mt < 4; ++mt) O[hh][mt] = z4;
#pragma unroll 1
    for (int pass = 0; pass < 2; ++pass) {
#pragma unroll 1
        for (int ch = 0; ch < nch; ++ch) {
            asm volatile("" ::: "memory");
            const int k0 = 32 * ch; const bool cfull = 16 * (k0 + 31) + 31 <= t0;
            bf16x8_t ka[2][2];
#pragma unroll
            for (int tl = 0; tl < 2; ++tl)
#pragma unroll
                for (int ks = 0; ks < 2; ++ks) ka[tl][ks] = ldg8(kcb + (size_t)(k0 + krowA + 4 * tl) * 64 + ks * 32 + fq * 8);
            bf16x8_t va[4];
            if (pass == 1) {
#pragma unroll
                for (int mt = 0; mt < 4; ++mt) va[mt] = ldg8(vcb + (size_t)(16 * mt + col) * 512 + k0 + 8 * fq);
            }
            float ps[8] = {0.f, 0.f, 0.f, 0.f, 0.f, 0.f, 0.f, 0.f};
#pragma unroll
            for (int hh = 0; hh < 4; ++hh) {
                const bf16x8_t q0_ = Qc(hh, 0), q1_ = Qc(hh, 1);
                f32x4 sa = MFMA16(ka[0][0], q0_, z4); sa = MFMA16(ka[0][1], q1_, sa);
                f32x4 sb = MFMA16(ka[1][0], q0_, z4); sb = MFMA16(ka[1][1], q1_, sb);
#pragma unroll
                for (int i = 0; i < 4; ++i) { sa[i] = __builtin_amdgcn_exp2f(sa[i]); sb[i] = __builtin_amdgcn_exp2f(sb[i]); }
                if (!cfull) {
#pragma unroll
                    for (int i = 0; i < 4; ++i) { const int c = k0 + 8 * fq + i; sa[i] = (16 * c + 31 <= tok) ? sa[i] : 0.f; sb[i] = (16 * (c + 4) + 31 <= tok) ? sb[i] : 0.f; } }
                if (pass == 0) { linv[hh] += (sa[0] + sa[1]) + (sa[2] + sa[3]) + (sb[0] + sb[1]) + (sb[2] + sb[3]); }
                else {
#pragma unroll
                    for (int i = 0; i < 4; ++i) { ps[i] = __builtin_fmaf(sa[i], linv[hh], ps[i]); ps[4 + i] = __builtin_fmaf(sb[i], linv[hh], ps[4 + i]); }
                    const bf16x8_t pt = pack_p(sa, sb);
#pragma unroll
                    for (int mt = 0; mt < 4; ++mt) O[hh][mt] = MFMA16(va[mt], pt, O[hh][mt]);
                }
            }
            if (pass == 1) {
                const int G0 = 8 * ch + 2 * fq; LAS float* ir = IMP + col * 132 + G0;
                __hip_atomic_fetch_add(ir, (ps[0] + ps[1]) + (ps[2] + ps[3]), __ATOMIC_RELAXED, __HIP_MEMORY_SCOPE_WORKGROUP);
                __hip_atomic_fetch_add(ir + 1, ps[3] + ((ps[4] + ps[5]) + (ps[6] + ps[7])), __ATOMIC_RELAXED, __HIP_MEMORY_SCOPE_WORKGROUP);
                if (G0 + 2 < NS) __hip_atomic_fetch_add(ir + 2, ps[7], __ATOMIC_RELAXED, __HIP_MEMORY_SCOPE_WORKGROUP);
            }
        }
        if (pass == 0) {
#pragma unroll
            for (int hh = 0; hh < 4; ++hh) { float l = linv[hh]; l += bperm_f(l, lane ^ 16); l += bperm_f(l, lane ^ 32); linv[hh] = l > 0.f ? 1.f / l : 0.f; }
        }
    }
    LDS_WAIT(); asm volatile("" ::: "memory");
    {
        const int cur = tok >> 6; LAS float* sc = IMP + col * 132;
        for (int j = fq * 32; j < fq * 32 + 32; ++j) { const bool forced = (j == 0) || (j == cur) || (j == cur - 1); const float v = sc[j]; sc[j] = forced ? 1e4f : (j <= cur ? v : -1.f); }
        LDS_WAIT(); asm volatile("" ::: "memory");
#pragma unroll 1
        for (int r = 0; r < 8; ++r) {
            float bv = sc[fq * 32]; int bj = fq * 32;
            for (int j = fq * 32 + 1; j < fq * 32 + 32; ++j) { const float v = sc[j]; if (v > bv) { bv = v; bj = j; } }
#pragma unroll
            for (int o = 16; o <= 32; o <<= 1) { const float ov = bperm_f(bv, lane ^ o); const int oj = bperm_i(bj, lane ^ o); if (ov > bv || (ov == bv && oj < bj)) { bv = ov; bj = oj; } }
            if ((bj >> 5) == fq) sc[bj] = -3e38f;
            if (fq == 0) SEL[col * 8 + r] = bj;
            LDS_WAIT(); asm volatile("" ::: "memory");
        }
    }
#pragma unroll
    for (int hh = 0; hh < 4; ++hh) { const float g0 = gate[hh * 3 + 0] * linv[hh];
#pragma unroll
        for (int mt = 0; mt < 4; ++mt) { const f32x4 o = O[hh][mt] * g0; v2u w; w.x = cvt_pk_bf16(o[0], o[1]); w.y = cvt_pk_bf16(o[2], o[3]);
            *(LAS v2u*)(OS + (col * 4 + hh) * 64 + 16 * mt + 4 * fq) = w; } }
    LDS_WAIT(); asm volatile("" ::: "memory");
    const int cur = t0 >> 6;
    {
        const bf16* kwb = KV + (size_t)b * SEQ * LDKV + 256 + g * 64; const bf16* vwb = VwT + (size_t)bg * 64 * SEQ;
        const bf16* ksb = KV + (size_t)b * SEQ * LDKV + g * 64; const bf16* vsb = VsT + (size_t)bg * 64 * SEQ;
        int kst = t0 - (WINDOW - 1); if (kst < 0) kst = 0; kst &= ~31;
        const int nwin = ((t0 + 15 - kst) >> 5) + 1, nfb = cur >= 2 ? 3 : cur + 1;
#pragma unroll 1
        for (int part = 0; part < 2; ++part) {
            float lw[4] = {0.f, 0.f, 0.f, 0.f};
#pragma unroll
            for (int hh = 0; hh < 4; ++hh)
#pragma unroll
                for (int mt = 0; mt < 4; ++mt) O[hh][mt] = z4;
            const bf16* kb = part ? ksb : kwb; const bf16* vb = part ? vsb : vwb;
            const int nchk = part ? 2 * nfb : nwin;
#pragma unroll 1
            for (int ci = 0; ci < nchk; ++ci) {
                asm volatile("" ::: "memory");
                int k0;
                if (part == 0) k0 = kst + 32 * ci; else { const int fb = ci >> 1, j = fb == 0 ? 0 : (fb == 1 ? cur : cur - 1); k0 = 64 * j + 32 * (ci & 1); }
                bf16x8_t ka[2][2], va[4];
#pragma unroll
                for (int tl = 0; tl < 2; ++tl)
#pragma unroll
                    for (int ks = 0; ks < 2; ++ks) ka[tl][ks] = ldg8(kb + (size_t)(k0 + krowA + 4 * tl) * LDKV + ks * 32 + fq * 8);
#pragma unroll
                for (int mt = 0; mt < 4; ++mt) va[mt] = ldg8(vb + (size_t)(16 * mt + col) * SEQ + k0 + 8 * fq);
                const int lowk = part ? -1 : tok - WINDOW; const bool dfull = (k0 + 31 <= t0) && (part || k0 > t0 + 15 - WINDOW);
#pragma unroll
                for (int hh = 0; hh < 4; ++hh) {
                    const bf16x8_t q0_ = Qc(hh, 0), q1_ = Qc(hh, 1);
                    f32x4 sa = MFMA16(ka[0][0], q0_, z4); sa = MFMA16(ka[0][1], q1_, sa);
                    f32x4 sb = MFMA16(ka[1][0], q0_, z4); sb = MFMA16(ka[1][1], q1_, sb);
#pragma unroll
                    for (int i = 0; i < 4; ++i) { sa[i] = __builtin_amdgcn_exp2f(sa[i]); sb[i] = __builtin_amdgcn_exp2f(sb[i]); }
                    if (!dfull) {
#pragma unroll
                        for (int i = 0; i < 4; ++i) { const int kt = k0 + 8 * fq + i; sa[i] = (kt <= tok && kt > lowk) ? sa[i] : 0.f; sb[i] = (kt + 4 <= tok && kt + 4 > lowk) ? sb[i] : 0.f; } }
                    lw[hh] += (sa[0] + sa[1]) + (sa[2] + sa[3]) + (sb[0] + sb[1]) + (sb[2] + sb[3]);
                    const bf16x8_t pt = pack_p(sa, sb);
#pragma unroll
                    for (int mt = 0; mt < 4; ++mt) O[hh][mt] = MFMA16(va[mt], pt, O[hh][mt]);
                }
            }
            LDS_WAIT(); asm volatile("" ::: "memory");
            if (part == 0) {
#pragma unroll
                for (int hh = 0; hh < 4; ++hh) { float l = lw[hh]; l += bperm_f(l, lane ^ 16); l += bperm_f(l, lane ^ 32); const float w = l > 0.f ? gate[hh * 3 + 2] / l : 0.f;
#pragma unroll
                    for (int mt = 0; mt < 4; ++mt) { LAS v2u* dp = (LAS v2u*)(OS + (col * 4 + hh) * 64 + 16 * mt + 4 * fq); const v2u old = *dp;
                        v2u w2; w2.x = cvt_pk_bf16(blo(old.x) + w * O[hh][mt][0], bhi(old.x) + w * O[hh][mt][1]); w2.y = cvt_pk_bf16(blo(old.y) + w * O[hh][mt][2], bhi(old.y) + w * O[hh][mt][3]); *dp = w2; } }
            } else {
                LAS bf16* OF = (LAS bf16*)(wl + AW_QS); LAS float* LF = (LAS float*)(wl + AW_IMP + 8192);
#pragma unroll
                for (int hh = 0; hh < 4; ++hh) { float l = lw[hh]; l += bperm_f(l, lane ^ 16); l += bperm_f(l, lane ^ 32); if (fq == 0) LF[col * 4 + hh] = l;
#pragma unroll
                    for (int mt = 0; mt < 4; ++mt) { v2u w2; w2.x = cvt_pk_bf16(O[hh][mt][0], O[hh][mt][1]); w2.y = cvt_pk_bf16(O[hh][mt][2], O[hh][mt][3]); *(LAS v2u*)(OF + (col * 4 + hh) * 64 + 16 * mt + 4 * fq) = w2; } }
            }
            LDS_WAIT(); asm volatile("" ::: "memory");
        }
    }
    {
        const bf16* ksb = KV + (size_t)b * SEQ * LDKV + g * 64; const bf16* vsb = VsT + (size_t)bg * 64 * SEQ;
        const LAS bf16* OF = (const LAS bf16*)(wl + AW_QS); const LAS float* LF = (const LAS float*)(wl + AW_IMP + 8192);
#pragma unroll 1
        for (int tt = 0; tt < 16; ++tt) {
            const int tq = t0 + tt; const size_t qrow = (size_t)b * SEQ + tq;
            bf16x8_t Qh[2];
#pragma unroll
            for (int ks = 0; ks < 2; ++ks) { Qh[ks] = ldg8(QB + qrow * LDQ + (g * 4 + (col & 3)) * 64 + ks * 32 + fq * 8); if (col >= 4) Qh[ks] = (bf16x8_t){0, 0, 0, 0, 0, 0, 0, 0}; }
            f32x4 Os[4] = {z4, z4, z4, z4}; float ls = 0.f;
#ifdef APROBE_SEL
            for (int rp = 0; rp < 2; ++rp) { Os[0] = z4; Os[1] = z4; Os[2] = z4; Os[3] = z4; ls = 0.f; asm volatile("" ::: "memory");
#endif
#pragma unroll 1
            for (int r8 = 0; r8 < 8; ++r8) {
                const int j = __builtin_amdgcn_readfirstlane(SEL[tt * 8 + r8]);
                if (64 * j > tq || j == 0 || j == cur || j == cur - 1) continue;
                const int kb0 = 64 * j;
                bf16x8_t ka[2][2][2], va[2][4];
#pragma unroll
                for (int hf = 0; hf < 2; ++hf) {
#pragma unroll
                    for (int tl = 0; tl < 2; ++tl)
#pragma unroll
                        for (int ks = 0; ks < 2; ++ks) ka[hf][tl][ks] = ldg8(ksb + (size_t)(kb0 + 32 * hf + krowA + 4 * tl) * LDKV + ks * 32 + fq * 8);
#pragma unroll
                    for (int mt = 0; mt < 4; ++mt) va[hf][mt] = ldg8(vsb + (size_t)(16 * mt + col) * SEQ + kb0 + 32 * hf + 8 * fq);
                }
#pragma unroll
                for (int hf = 0; hf < 2; ++hf) {
                    f32x4 sa = MFMA16(ka[hf][0][0], Qh[0], z4); sa = MFMA16(ka[hf][0][1], Qh[1], sa);
                    f32x4 sb = MFMA16(ka[hf][1][0], Qh[0], z4); sb = MFMA16(ka[hf][1][1], Qh[1], sb);
#pragma unroll
                    for (int i = 0; i < 4; ++i) { sa[i] = __builtin_amdgcn_exp2f(sa[i]); sb[i] = __builtin_amdgcn_exp2f(sb[i]); }
                    ls += (sa[0] + sa[1]) + (sa[2] + sa[3]) + (sb[0] + sb[1]) + (sb[2] + sb[3]);
                    const bf16x8_t pt = pack_p(sa, sb);
#pragma unroll
                    for (int mt = 0; mt < 4; ++mt) Os[mt] = MFMA16(va[hf][mt], pt, Os[mt]);
                }
            }
#ifdef APROBE_SEL
            }
#endif
            ls += bperm_f(ls, lane ^ 16); ls += bperm_f(ls, lane ^ 32);
            if (col < 4) {
                const float den = ls + LF[tt * 4 + col]; const float w = den > 0.f ? (NG + qrow * 24 + g * 12)[col * 3 + 1] / den : 0.f;
#pragma unroll
                for (int mt = 0; mt < 4; ++mt) { const int e = (tt * 4 + col) * 64 + 16 * mt + 4 * fq; const v2u old = *(const LAS v2u*)(OS + e), fo = *(const LAS v2u*)(OF + e);
                    v2u w2; w2.x = cvt_pk_bf16(blo(old.x) + w * (Os[mt][0] + blo(fo.x)), bhi(old.x) + w * (Os[mt][1] + bhi(fo.x))); w2.y = cvt_pk_bf16(blo(old.y) + w * (Os[mt][2] + blo(fo.y)), bhi(old.y) + w * (Os[mt][3] + bhi(fo.y)));
                    *(v2u*)(QB + qrow * LDQ + (g * 4 + col) * 64 + 16 * mt + 4 * fq) = w2; }
            }
        }
    }
    LDS_WAIT(); asm volatile("" ::: "memory");
#undef Qc
}

typedef _Float16 h16x2 __attribute__((ext_vector_type(2)));
__device__ __forceinline__ h16x2 as_h2(unsigned u) { h16x2 r; __builtin_memcpy(&r, &u, 4); return r; }
constexpr int SC_STEPS = 8, SC_BUF = 6 * 1024;
__device__ __forceinline__ float dpp_sum16(float v) {
    v += __builtin_bit_cast(float, __builtin_amdgcn_update_dpp(0, __builtin_bit_cast(int, v), 0xB1, 0xF, 0xF, true));
    v += __builtin_bit_cast(float, __builtin_amdgcn_update_dpp(0, __builtin_bit_cast(int, v), 0x4E, 0xF, 0xF, true));
    v += __builtin_bit_cast(float, __builtin_amdgcn_update_dpp(0, __builtin_bit_cast(int, v), 0x141, 0xF, 0xF, true));
    v += __builtin_bit_cast(float, __builtin_amdgcn_update_dpp(0, __builtin_bit_cast(int, v), 0x140, 0xF, 0xF, true));
    return v;
}
__device__ __forceinline__ void scan_fill(const bf16* RW, const bf16* Wm, const bf16* Am, size_t trow, int h, int lane, LAS unsigned char* buf) {
    const size_t t = trow + (lane >> 3); const int sub = (lane & 7) * 8;
    const bf16* row = RW + t * LDRW + h * 64 + sub;
    __builtin_amdgcn_global_load_lds((const unsigned*)(row + LBLK), (LAS unsigned*)(buf + 0 * 1024), 16, 0, 0);
    __builtin_amdgcn_global_load_lds((const unsigned*)(Am + t * RC + h * 64 + sub), (LAS unsigned*)(buf + 1 * 1024), 16, 0, 0);
    __builtin_amdgcn_global_load_lds((const unsigned*)(Wm + t * RC + h * 64 + sub), (LAS unsigned*)(buf + 2 * 1024), 16, 0, 0);
    __builtin_amdgcn_global_load_lds((const unsigned*)(row + 512), (LAS unsigned*)(buf + 3 * 1024), 16, 0, 0);
    __builtin_amdgcn_global_load_lds((const unsigned*)(row), (LAS unsigned*)(buf + 4 * 1024), 16, 0, 0);
    __builtin_amdgcn_global_load_lds((const unsigned*)(row + 1024), (LAS unsigned*)(buf + 5 * 1024), 16, 0, 0);
}
__device__ __forceinline__ void scan_unit(const P& p, int unit, int lane, LAS unsigned char* wl) {
    const bf16* RW = WSP(bf16, AR_RW); const bf16* Wm = WSP(bf16, AR_W); const bf16* Am = WSP(bf16, AR_A); bf16* Y = WSP(bf16, AR_UB);
    const int rg = unit & 15, h = (unit >> 4) & 7, b = unit >> 7, row = rg * 4 + (lane >> 4), kq = lane & 15;
    const size_t tb = (size_t)b * SEQ;
    float s0 = 0.f, s1 = 0.f, s2 = 0.f, s3 = 0.f;
    __builtin_amdgcn_s_setprio(3);
    scan_fill(RW, Wm, Am, tb, h, lane, wl);
#pragma unroll 1
    for (int c = 0; c < SEQ / SC_STEPS; ++c) {
        LAS unsigned char* buf = wl + (c & 1) * SC_BUF;
        asm volatile("s_waitcnt vmcnt(0) lgkmcnt(0)" ::: "memory");
        if (c + 1 < SEQ / SC_STEPS) scan_fill(RW, Wm, Am, tb + (size_t)(c + 1) * SC_STEPS, h, lane, wl + ((c + 1) & 1) * SC_BUF);
#ifndef SCAN_VARB
        float ys[SC_STEPS];
#pragma unroll
        for (int st = 0; st < SC_STEPS; ++st) {
            const LAS unsigned char* o = buf + st * 128 + kq * 8;
            const v2u kkw = *(const LAS v2u*)(o), bbw = *(const LAS v2u*)(o + 1024), eew = *(const LAS v2u*)(o + 2048), ktw = *(const LAS v2u*)(o + 3072), rrw = *(const LAS v2u*)(o + 4096);
#ifdef SCAN_BF16
            struct F2 { float x, y; }; const F2 kk0{blo(kkw.x), bhi(kkw.x)}, kk1{blo(kkw.y), bhi(kkw.y)}, bb0{blo(bbw.x), bhi(bbw.x)}, bb1{blo(bbw.y), bhi(bbw.y)}, ee0{blo(eew.x), bhi(eew.x)}, ee1{blo(eew.y), bhi(eew.y)}, kt0{blo(ktw.x), bhi(ktw.x)}, kt1{blo(ktw.y), bhi(ktw.y)}, rr0{blo(rrw.x), bhi(rrw.x)}, rr1{blo(rrw.y), bhi(rrw.y)};
            const float vv = bf2f(*(const LAS unsigned short*)(buf + 5 * 1024 + st * 128 + row * 2));
#else
            const h16x2 kk0 = as_h2(kkw.x), kk1 = as_h2(kkw.y), bb0 = as_h2(bbw.x), bb1 = as_h2(bbw.y);
            const h16x2 ee0 = as_h2(eew.x), ee1 = as_h2(eew.y);
#ifdef RKV_BF16
            struct F2 { float x, y; }; const F2 kt0{blo(ktw.x), bhi(ktw.x)}, kt1{blo(ktw.y), bhi(ktw.y)}, rr0{blo(rrw.x), bhi(rrw.x)}, rr1{blo(rrw.y), bhi(rrw.y)};
            const float vv = bf2f(*(const LAS unsigned short*)(buf + 5 * 1024 + st * 128 + row * 2));
#else
            const h16x2 kt0 = as_h2(ktw.x), kt1 = as_h2(ktw.y);
            const h16x2 rr0 = as_h2(rrw.x), rr1 = as_h2(rrw.y);
            const float vv = (float)__builtin_bit_cast(_Float16, *(const LAS unsigned short*)(buf + 5 * 1024 + st * 128 + row * 2));
#endif
#endif
            float d0 = s0 * (float)kk0.x; d0 = __builtin_fmaf(s1, (float)kk0.y, d0); float d1 = s2 * (float)kk1.x; d1 = __builtin_fmaf(s3, (float)kk1.y, d1);
            const float nskk = -dpp_sum16(d0 + d1);
            s0 = __builtin_fmaf(s0, -(float)ee0.x, s0); s1 = __builtin_fmaf(s1, -(float)ee0.y, s1); s2 = __builtin_fmaf(s2, -(float)ee1.x, s2); s3 = __builtin_fmaf(s3, -(float)ee1.y, s3);
            s0 = __builtin_fmaf(nskk, (float)bb0.x, s0); s1 = __builtin_fmaf(nskk, (float)bb0.y, s1); s2 = __builtin_fmaf(nskk, (float)bb1.x, s2); s3 = __builtin_fmaf(nskk, (float)bb1.y, s3);
            s0 = __builtin_fmaf(vv, (float)kt0.x, s0); s1 = __builtin_fmaf(vv, (float)kt0.y, s1); s2 = __builtin_fmaf(vv, (float)kt1.x, s2); s3 = __builtin_fmaf(vv, (float)kt1.y, s3);
            float y0 = s0 * (float)rr0.x; y0 = __builtin_fmaf(s1, (float)rr0.y, y0); float y1 = s2 * (float)rr1.x; y1 = __builtin_fmaf(s3, (float)rr1.y, y1);
            ys[st] = dpp_sum16(y0 + y1);
        }
        if (kq < SC_STEPS) { float yv = ys[0];
#pragma unroll
            for (int st = 1; st < SC_STEPS; ++st) yv = (kq == st) ? ys[st] : yv;
            Y[(tb + (size_t)c * SC_STEPS + kq) * RC + h * 64 + row] = f2bf(yv); }
    }
#else
#pragma unroll
        for (int st = 0; st < SC_STEPS; ++st) {
            const LAS unsigned char* o = buf + st * 128 + kq * 8;
            float kk[4], bb[4], ee[4], kt[4], rr[4];
            { const v2u w = *(const LAS v2u*)(o); const h16x2 a = as_h2(w.x), b2 = as_h2(w.y); kk[0] = (float)a.x; kk[1] = (float)a.y; kk[2] = (float)b2.x; kk[3] = (float)b2.y; }
            { const v2u w = *(const LAS v2u*)(o + 1024); const h16x2 a = as_h2(w.x), b2 = as_h2(w.y); bb[0] = (float)a.x; bb[1] = (float)a.y; bb[2] = (float)b2.x; bb[3] = (float)b2.y; }
            { const v2u w = *(const LAS v2u*)(o + 2048); const h16x2 a = as_h2(w.x), b2 = as_h2(w.y); ee[0] = (float)a.x; ee[1] = (float)a.y; ee[2] = (float)b2.x; ee[3] = (float)b2.y; }
            { const v2u w = *(const LAS v2u*)(o + 3072); const h16x2 a = as_h2(w.x), b2 = as_h2(w.y); kt[0] = (float)a.x; kt[1] = (float)a.y; kt[2] = (float)b2.x; kt[3] = (float)b2.y; }
            { const v2u w = *(const LAS v2u*)(o + 4096); const h16x2 a = as_h2(w.x), b2 = as_h2(w.y); rr[0] = (float)a.x; rr[1] = (float)a.y; rr[2] = (float)b2.x; rr[3] = (float)b2.y; }
            const float vv = (float)__builtin_bit_cast(_Float16, *(const LAS unsigned short*)(buf + 5 * 1024 + st * 128 + row * 2));
            const float skk = dpp_sum16((s0 * kk[0] + s1 * kk[1]) + (s2 * kk[2] + s3 * kk[3]));
            s0 = s0 - s0 * ee[0] - skk * bb[0] + vv * kt[0]; s1 = s1 - s1 * ee[1] - skk * bb[1] + vv * kt[1]; s2 = s2 - s2 * ee[2] - skk * bb[2] + vv * kt[2]; s3 = s3 - s3 * ee[3] - skk * bb[3] + vv * kt[3];
            const float y = dpp_sum16((s0 * rr[0] + s1 * rr[1]) + (s2 * rr[2] + s3 * rr[3]));
            if (kq == 0) Y[(tb + (size_t)c * SC_STEPS + st) * RC + h * 64 + row] = f2bf(y);
        }
    }
#endif
    asm volatile("s_waitcnt vmcnt(0) lgkmcnt(0)" ::: "memory");
    __builtin_amdgcn_s_setprio(0);
}
__device__ __forceinline__ float sum8(float v) {
    v += __builtin_bit_cast(float, __builtin_amdgcn_update_dpp(0, __builtin_bit_cast(int, v), 0xB1, 0xF, 0xF, true));
    v += __builtin_bit_cast(float, __builtin_amdgcn_update_dpp(0, __builtin_bit_cast(int, v), 0x4E, 0xF, 0xF, true));
    v += __builtin_bit_cast(float, __builtin_amdgcn_update_dpp(0, __builtin_bit_cast(int, v), 0x141, 0xF, 0xF, true));
    return v;
}
__device__ __forceinline__ void up8(v4u w, float* f) { f[0] = blo(w.x); f[1] = bhi(w.x); f[2] = blo(w.y); f[3] = bhi(w.y); f[4] = blo(w.z); f[5] = bhi(w.z); f[6] = blo(w.w); f[7] = bhi(w.w); }
#ifdef SCAN_BF16
#define uph8 up8
#define pkh8 pk8
#else
#define uph8 uph8_
#define pkh8 pkh8_
#endif
__device__ __forceinline__ void uph8_(v4u w, float* f) { const h16x2 a = as_h2(w.x), b = as_h2(w.y), c = as_h2(w.z), d = as_h2(w.w);
    f[0] = (float)a.x; f[1] = (float)a.y; f[2] = (float)b.x; f[3] = (float)b.y; f[4] = (float)c.x; f[5] = (float)c.y; f[6] = (float)d.x; f[7] = (float)d.y; }
__device__ __forceinline__ unsigned pkh2(float lo, float hi) { h16x2 v; v.x = (_Float16)lo; v.y = (_Float16)hi; return __builtin_bit_cast(unsigned, v); }
__device__ __forceinline__ v4u pkh8_(const float* f) { v4u w; w.x = pkh2(f[0], f[1]); w.y = pkh2(f[2], f[3]); w.z = pkh2(f[4], f[5]); w.w = pkh2(f[6], f[7]); return w; }
__device__ __forceinline__ v4u pk8(const float* f) { v4u w; w.x = cvt_pk_bf16(f[0], f[1]); w.y = cvt_pk_bf16(f[2], f[3]); w.z = cvt_pk_bf16(f[4], f[5]); w.w = cvt_pk_bf16(f[6], f[7]); return w; }
__device__ __forceinline__ void ldf8(const float* p, float* f) { const f32x4 a = *(const f32x4*)p, b = *(const f32x4*)(p + 4); f[0] = a[0]; f[1] = a[1]; f[2] = a[2]; f[3] = a[3]; f[4] = b[0]; f[5] = b[1]; f[6] = b[2]; f[7] = b[3]; }

struct EpiLora {
    static constexpr bool PERM = true, AFTER_DRAIN = false;
    unsigned char* ws;
    __device__ __forceinline__ void operator()(const f32x4 (&acc)[2][2][4][2], const Unit& u, int wr, int wc, int fr, int fq) const {
        const int which = u.pn >> 1, row0 = u.pm * BM + wr * 64 + fr, c0 = (u.pn & 1) * 256 + wc * 32 + 8 * fq;
        bf16* const O = (bf16*)(ws + (which == 0 ? AR_W : (which == 1 ? AR_A : (which == 2 ? AR_G : AR_UB))));
#pragma unroll
        for (int ai = 0; ai < 2; ++ai)
#pragma unroll
            for (int m = 0; m < 4; ++m)
#pragma unroll
                for (int bj = 0; bj < 2; ++bj) *(u32x4*)(O + (size_t)(row0 + ai * HALF + m * 16) * RC + c0 + bj * HALF) = pack8(acc[ai][bj][m][0], acc[ai][bj][m][1]);
    }
};
#ifdef RKV_BF16
#define UPR up8
#define PKR pk8
#else
#define UPR uph8
#define PKR pkh8
#endif
__device__ __forceinline__ void ph_rwkv_b2w(const P& p, int layer, int gw, int NGW, int lane) {
    bf16* RW = WSP(bf16, AR_RW); bf16* Am = WSP(bf16, AR_A); bf16* Wm = WSP(bf16, AR_W); const bf16* VR = WSP(bf16, AR_UB); const bf16* VF = WSP(bf16, WS_VF); float* NG = WSP(float, AR_NG);
    const float* vec = p.rwkv_vec + (size_t)layer * 7 * RC; float v0[8], v1[8], v2[8], v3[8], vb[8];
    ldf8(vec + 8 * lane, v0); ldf8(vec + RC + 8 * lane, v1); ldf8(vec + 2 * RC + 8 * lane, v2); ldf8(vec + 3 * RC + 8 * lane, v3); ldf8(p.vres_b + 8 * lane, vb);
    for (int t = gw; t < T; t += NGW) {
        bf16* row = RW + (size_t)t * LDRW;
        float k[8], a[8], w[8]; UPR(*(const v4u*)(row + 512 + 8 * lane), k); up8(*(const v4u*)(Am + (size_t)t * RC + 8 * lane), a); up8(*(const v4u*)(Wm + (size_t)t * RC + 8 * lane), w);
        const float gt = lane < 24 ? bf2f(row[LBLK + 320 + lane]) : 0.f;
        float kk[8], ss = 0.f;
#pragma unroll
        for (int i = 0; i < 8; ++i) {
            a[i] = fsig(a[i] + v1[i]);
            const float nx = -(w[i] + v0[i]), sp = fmaxf(nx, 0.f) + __logf(1.f + __expf(-fabsf(nx))), e = __expf(-sp - 0.5f); w[i] = 1.f - __expf(-e);
            kk[i] = k[i] * v2[i]; ss += kk[i] * kk[i]; }
        ss = sum8(ss); const float nrm = sqrtf(ss), inv = 1.f / (nrm > 1e-12f ? nrm : 1e-12f);
#pragma unroll
        for (int i = 0; i < 8; ++i) { kk[i] *= inv; k[i] = k[i] * (1.f + (a[i] - 1.f) * v3[i]); a[i] *= kk[i]; }
        if (layer == 1) { float vr[8], vv[8], vf[8]; up8(*(const v4u*)(VR + (size_t)t * RC + 8 * lane), vr); UPR(*(const v4u*)(row + 1024 + 8 * lane), vv); UPR(*(const v4u*)(VF + (size_t)t * RC + 8 * lane), vf);
#pragma unroll
            for (int i = 0; i < 8; ++i) vv[i] = vv[i] + (vf[i] - vv[i]) * fsig(vr[i] + vb[i]);
            *(v4u*)(row + 1024 + 8 * lane) = PKR(vv); }
        VM_WAIT();
        if (lane < 24) NG[(size_t)t * 24 + lane] = fsig(gt);
        *(v4u*)(row + LBLK + 8 * lane) = pkh8(kk); *(v4u*)(row + 512 + 8 * lane) = PKR(k);
        *(v4u*)(Am + (size_t)t * RC + 8 * lane) = pkh8(a); *(v4u*)(Wm + (size_t)t * RC + 8 * lane) = pkh8(w);
    }
}
__device__ __forceinline__ void ph_rwkv_postw(const P& p, int layer, int gw, int NGW, int lane) {
    const bf16* RW = WSP(bf16, AR_RW); const bf16* Y = WSP(bf16, AR_UB); const bf16* Gm = WSP(bf16, AR_G); bf16* YO = WSP(bf16, AR_A);
    const float* vec = p.rwkv_vec + (size_t)layer * 7 * RC; float v4_[8], v5[8], v6[8]; ldf8(vec + 4 * RC + 8 * lane, v4_); ldf8(vec + 5 * RC + 8 * lane, v5); ldf8(vec + 6 * RC + 8 * lane, v6);
    for (int t = gw; t < T; t += NGW) {
        const bf16* row = RW + (size_t)t * LDRW;
        float y[8], r[8], k[8], v[8], g[8]; up8(*(const v4u*)(Y + (size_t)t * RC + 8 * lane), y); UPR(*(const v4u*)(row + 8 * lane), r); UPR(*(const v4u*)(row + 512 + 8 * lane), k);
        UPR(*(const v4u*)(row + 1024 + 8 * lane), v); up8(*(const v4u*)(Gm + (size_t)t * RC + 8 * lane), g);
        float s = 0.f, bon = 0.f;
#pragma unroll
        for (int i = 0; i < 8; ++i) { s += y[i]; bon += r[i] * k[i] * v4_[i]; }
        const float m = sum8(s) * (1.f / 64.f); bon = sum8(bon);
        float q = 0.f;
#pragma unroll
        for (int i = 0; i < 8; ++i) { y[i] -= m; q += y[i] * y[i]; }
        const float rstd = 1.f / sqrtf(sum8(q) * (1.f / 64.f) + GN_EPS);
#pragma unroll
        for (int i = 0; i < 8; ++i) y[i] = (y[i] * rstd * v5[i] + v6[i] + bon * v[i]) * g[i];
        *(v4u*)(YO + (size_t)t * RC + 8 * lane) = pk8(y);
    }
}
__device__ __forceinline__ void ph_convw(const P& p, int layer, int gw, int NGW, int lane, int tid, LAS unsigned char* lds) {
    const bf16* UB = WSP(bf16, AR_UB); bf16* CO = WSP(bf16, AR_CO);
    const float* cw = p.conv_w + (size_t)layer * CONV_K * CONV_CH; const float* cv = p.conv_vec + (size_t)layer * 3 * CONV_CH;
    LAS float* wl = (LAS float*)lds;
    for (int i = tid; i < CONV_K * CONV_CH; i += NTHREADS) wl[i] = cw[i];
    __syncthreads();
    float b0[8], g1[8], b2[8]; ldf8(cv + 8 * lane, b0); ldf8(cv + CONV_CH + 8 * lane, g1); ldf8(cv + 2 * CONV_CH + 8 * lane, b2);
    for (int t = gw; t < T; t += NGW) {
        const int pos = t % SEQ, j0 = pos >= 30 ? 0 : 30 - pos;
        float a[8];
#pragma unroll
        for (int i = 0; i < 8; ++i) a[i] = b0[i];
        for (int j = j0; j < CONV_K; ++j) { float u[8]; up8(*(const v4u*)(UB + (size_t)(t - 30 + j) * CONV_CH + 8 * lane), u);
            const f32x4 w0 = *(const LAS f32x4*)(wl + j * CONV_CH + 8 * lane), w1 = *(const LAS f32x4*)(wl + j * CONV_CH + 8 * lane + 4);
#pragma unroll
            for (int i = 0; i < 4; ++i) { a[i] += u[i] * w0[i]; a[4 + i] += u[4 + i] * w1[i]; } }
        float s = 0.f;
#pragma unroll
        for (int i = 0; i < 8; ++i) s += a[i];
        const float mean = wave_sum(s, lane) * (1.f / CONV_CH); float q = 0.f;
#pragma unroll
        for (int i = 0; i < 8; ++i) { a[i] -= mean; q += a[i] * a[i]; }
        const float rstd = 1.f / sqrtf(wave_sum(q, lane) * (1.f / CONV_CH) + LN_EPS);
#pragma unroll
        for (int i = 0; i < 8; ++i) { const float y = a[i] * rstd * g1[i] + b2[i]; a[i] = y * fsig(y); }
        *(v4u*)(CO + (size_t)t * CONV_CH + 8 * lane) = pk8(a);
    }
    __syncthreads();
}
__device__ __forceinline__ void ph_cmp2w(const P& p, int layer, int gw, int NGW, int lane, LAS float* hl  ) {
    const bf16* Z = WSP(bf16, AR_HID); const float* pec = (const float*)(p.ws + WS_W + (size_t)layer * SZ_LAYERW + OFF_PEC);
    for (int it = gw; it < 2 * BATCH * NKV * NC; it += NGW) {
        const int i = it % NC, r = it / NC, bg = r % (BATCH * NKV), which = r / (BATCH * NKV);
        const bf16* z1 = Z + ((size_t)which * (BATCH * NKV * 512) + (size_t)bg * 512 + i) * 256; const bf16* z2 = z1 + 256 + 128;
#pragma unroll
        for (int jj = 0; jj < 2; ++jj) { const int j = lane + 64 * jj; const float x = bf2f(z1[j]) + bf2f(z2[j]) + pec[which * 128 + j];
            const float e = __expf(fminf(2.f * 0.7978845608028654f * (x + 0.044715f * x * x * x), 30.f)); hl[j] = 0.5f * x * (1.f + (e - 1.f) / (e + 1.f)); }
        LDS_WAIT(); asm volatile("" ::: "memory");
        const float* w2 = p.cmp_w2 + (size_t)(layer * 2 + which) * 128 * 64 + lane; float o = 0.f;
#pragma unroll 8
        for (int j = 0; j < 128; ++j) o += hl[j] * w2[j * 64];
        if (which == 0) {
            const float rs = 1.f / sqrtf(wave_sum(o * o, lane) * (1.f / 64.f) + RMS_EPS); o = o * rs * p.qk_g[(layer * 4 + 1) * 64 + lane];
            const float other = bperm_f(o, lane ^ 32); float cs, sn; rope_cs(16 * i + 31, lane & 31, cs, sn);
            o = lane < 32 ? o * cs - other * sn : o * cs + other * sn;
            WSP(bf16, AR_KC)[((size_t)bg * 512 + i) * 64 + lane] = f2bf(o);
        } else { bf16* vt = WSP(bf16, AR_VCT) + ((size_t)bg * 64 + lane) * 512; vt[i] = f2bf(o); if (i == 0) vt[NC] = 0; }
        LDS_WAIT(); asm volatile("" ::: "memory");
    }
}

struct MapPlain { bf16* base; int K; __device__ __forceinline__ bf16* operator()(int col) const { return base + (size_t)col * K; } };
struct MapGlu { bf16* base; int K, ff; __device__ __forceinline__ bf16* operator()(int col) const { return base + (size_t)glu_dest(col, ff) * K; } };
struct MapWin { unsigned char* wl; int layer; __device__ __forceinline__ bf16* operator()(int col) const { int which; const int r = win_dest(col, layer, which); const size_t off = (which ? OFF_WG : OFF_WIN) + (size_t)(r < 0 ? 0 : r) * DM * 2; return r < 0 ? nullptr : (bf16*)(wl + off); } };
template <class Map>
__device__ __forceinline__ void transpose_item(const float* W, int K, int N, const Map& mp, LAS float* scr, int item, int lane) {
    const int nblk = (N + 31) / 32, kb = item / nblk, nb = item % nblk, k0 = 64 * kb, n0 = 32 * nb;
    const int col = n0 + (lane & 31);
#pragma unroll 8
    for (int i = 0; i < 32; ++i) { const int kk = 2 * i + (lane >> 5); scr[kk * 33 + (lane & 31)] = col < N ? W[(size_t)(k0 + kk) * N + col] : 0.f; }
    LDS_WAIT(); asm volatile("" ::: "memory");
    const int c = lane & 7;
#pragma unroll
    for (int j = 0; j < 4; ++j) { const int n = (lane >> 3) + 8 * j; const LAS float* s = scr + (8 * c) * 33 + n;
        v4u o; o.x = (unsigned)f2bf(s[0]) | ((unsigned)f2bf(s[33]) << 16); o.y = (unsigned)f2bf(s[66]) | ((unsigned)f2bf(s[99]) << 16);
        o.z = (unsigned)f2bf(s[132]) | ((unsigned)f2bf(s[165]) << 16); o.w = (unsigned)f2bf(s[198]) | ((unsigned)f2bf(s[231]) << 16);
        if (n0 + n < N) { bf16* d = mp(n0 + n); if (d) *(v4u*)(d + k0 + 8 * c) = o; } }
    LDS_WAIT(); asm volatile("" ::: "memory");
}
template <class Map>
__device__ __forceinline__ bool conv_job(int& r, const float* W, int K, int N, const Map& mp, LAS float* scr, int lane) {
    const int items = (K / 64) * ((N + 31) / 32);
    if (r < items) { transpose_item(W, K, N, mp, scr, r, lane); return true; }
    r -= items; return false;
}

__device__ __forceinline__ void rms_row(const P& p, const float* xrow, const float* g, bf16* orow, int lane, bool route, int t, unsigned long long& c0, unsigned long long& c1) {
    const f32x4* xr = (const f32x4*)xrow + lane; const f32x4* gr = (const f32x4*)g + lane;
    f32x4 v[DM / 256]; float ss = 0.f;
#pragma unroll
    for (int j = 0; j < DM / 256; ++j) { v[j] = xr[64 * j]; ss += (v[j].x * v[j].x + v[j].y * v[j].y) + (v[j].z * v[j].z + v[j].w * v[j].w); }
    const float rs = 1.f / sqrtf(wave_sum(ss, lane) * (1.f / DM) + RMS_EPS);
    v2u* o8 = (v2u*)orow + lane;
#pragma unroll
    for (int j = 0; j < DM / 256; ++j) { const f32x4 gg = gr[64 * j]; v[j].x *= rs * gg.x; v[j].y *= rs * gg.y; v[j].z *= rs * gg.z; v[j].w *= rs * gg.w;
        v2u w; w.x = cvt_pk_bf16(v[j].x, v[j].y); w.y = cvt_pk_bf16(v[j].z, v[j].w); o8[64 * j] = w; }
    if (route) {
        float lg[NEXP];
#pragma unroll
        for (int e = 0; e < NEXP; ++e) lg[e] = 0.f;
#pragma unroll
        for (int j = 0; j < DM / 256; ++j) { const float* rw = p.router_w + (size_t)(4 * (lane + 64 * j)) * NEXP;
#pragma unroll
            for (int e = 0; e < NEXP; ++e) lg[e] += v[j].x * rw[e] + v[j].y * rw[NEXP + e] + v[j].z * rw[2 * NEXP + e] + v[j].w * rw[3 * NEXP + e]; }
#pragma unroll
        for (int e = 0; e < NEXP; ++e) lg[e] = wave_sum(lg[e], lane) + p.router_b[e];
        int e0 = 0; float l0 = lg[0];
#pragma unroll
        for (int e = 1; e < NEXP; ++e) if (lg[e] > l0) { l0 = lg[e]; e0 = e; }
        int e1 = -1; float l1 = -3e38f;
#pragma unroll
        for (int e = 0; e < NEXP; ++e) if (e != e0 && lg[e] > l1) { l1 = lg[e]; e1 = e; }
        e0 = __builtin_amdgcn_readfirstlane(e0); e1 = __builtin_amdgcn_readfirstlane(e1);
        const int r0 = (int)((c0 >> (8 * e0)) & 255ull), r1 = (int)((c1 >> (8 * e1)) & 255ull);
        c0 += 1ull << (8 * e0); c1 += 1ull << (8 * e1);
        if (lane == 0) { const float w0 = 1.f / (1.f + expf(l1 - l0));
            WSP(int, AR_RTE)[t] = e0 | (e1 << 8) | (r0 << 16) | (r1 << 24); float* rw = WSP(float, AR_RTW) + (size_t)t * 2; rw[0] = w0; rw[1] = 1.f - w0; }
    }
}
__device__ __forceinline__ void copy_row_wave(const bf16* src, bf16* dst, int lane) {
#pragma unroll
    for (int j = 0; j < DM / 512; ++j) ((v4u*)dst)[lane + 64 * j] = ((const v4u*)src)[lane + 64 * j];
}
__device__ __forceinline__ int moe_seg_start(const unsigned* cnt, int e) { int s = 0;
#pragma unroll
    for (int k = 0; k < NEXP; ++k) s += (k < e) ? (int)((cnt[k] + 255u) & ~255u) : 0;
    return s; }

#ifndef PHMASK
#define PHMASK 0xFFFFFFFFu
#endif
#define PHM(k) (((PHMASK) >> (k)) & 1u)
#ifdef PROBE_LO
constexpr int PR_LO = PROBE_LO, PR_HI = PROBE_HI;
#else
constexpr int PR_LO = -1, PR_HI = -1;
#endif
constexpr int NPH = 16, NPHASES = 1 + 2 * NPH;
struct Args { const float* in[29]; float* out; unsigned char* ws; int ph_lo, ph_hi; };

__device__ __forceinline__ bool in_phase(int k, int lo, int hi) { asm volatile("" : "+s"(lo), "+s"(hi)); return lo <= k && k < hi; }
typedef const Args __attribute__((address_space(4)))* CArgsP;
__device__ __forceinline__ void fill_params_k(P& p, CArgsP a) {
    p.x = a->in[0]; p.mix_norm_g = a->in[1]; p.w_in_first = a->in[2]; p.w_in_rest = a->in[3]; p.mu_first = a->in[4]; p.mu_rest = a->in[5]; p.qk_g = a->in[6]; p.cmp_pos = a->in[7];
    p.cmp_w1 = a->in[8]; p.cmp_w2 = a->in[9]; p.nsa_w_o = a->in[10]; p.conv_w = a->in[11]; p.conv_vec = a->in[12]; p.conv_w_o = a->in[13]; p.rwkv_vec = a->in[14]; p.w_up = a->in[15];
    p.a_up = a->in[16]; p.g_up = a->in[17]; p.vres_up = a->in[18]; p.vres_b = a->in[19]; p.rwkv_w_o = a->in[20]; p.w_out = a->in[21]; p.ffn_norm_g = a->in[22]; p.dense_gu = a->in[23];
    p.dense_down = a->in[24]; p.router_w = a->in[25]; p.router_b = a->in[26]; p.moe_gu = a->in[27]; p.moe_down = a->in[28]; p.out = a->out; p.ws = a->ws;
}
__global__ void __launch_bounds__(NTHREADS, 2) mk_fwd(Args args) {
    extern __shared__ __attribute__((aligned(16))) unsigned char lds_raw[];
    LAS unsigned char* lds = (LAS unsigned char*)lds_raw;
    const int wave0 = __builtin_amdgcn_readfirstlane((int)threadIdx.x >> 6);
    const int tid = wave0 * 64 + lane_id_opaque();
    unsigned* ctl = (unsigned*)(args.ws + WS_CTL);
    for (int u = tid; u < (LDS_BYTES - LDSCTL_OFF) / 4; u += NTHREADS) ((LAS unsigned*)(lds + LDSCTL_OFF))[u] = 0u;
    __syncthreads();
    const int lo = args.ph_lo, hi = args.ph_hi;
    XcdBarrier bar; bar.bar = ctl + CW_BAR; bar.x = 0; bar.st = nullptr;
    if (hi - lo > 1) { bar.x = xb_xcc_id(); bar.st = (volatile LAS unsigned*)(lds + MISC_OFF) + 8; if (tid == 0) (void)xb_add(ctl + CW_BAR + XB_XCNT(bar.x), 1u); }
#define IN(k) (in_phase((k), lo, hi) && (PR_LO < 0 || (st == 0 ? (k) <= PR_HI : (st == 1 ? ((k) >= PR_LO && (k) <= PR_HI) : (k) > PR_HI))))
#define MKP unsigned long long cdum0 = 0ull, cdum1 = 0ull; (void)cdum0; (void)cdum1; CArgsP ap_ = (CArgsP)__builtin_amdgcn_kernarg_segment_ptr(); asm volatile("" : "+s"(ap_)); P p; fill_params_k(p, ap_); int w0_ = wave0; asm volatile("" : "+s"(w0_)); int tid = w0_ * 64 + lane_id_opaque(); asm volatile("" : "+v"(tid)); const int lane = tid & 63, wave = __builtin_amdgcn_readfirstlane(tid >> 6); int G = gridDim.x, bid = blockIdx.x; asm volatile("" : "+s"(G), "+s"(bid)); unsigned* ctl = WSP(unsigned, WS_CTL); const long gtid = (long)bid * NTHREADS + tid, NT = (long)G * NTHREADS; const int gw = bid * NWAVES + wave, NGW = G * NWAVES; LAS float* scrw = (LAS float*)(lds + wave * 16384); (void)gtid; (void)NT; (void)gw; (void)NGW; (void)scrw; (void)lane; (void)ctl
#define SEAM(k) do { if ((k) + 1 < hi) { int w_ = wave0; asm volatile("" : "+s"(w_)); xcd_barrier(bar, w_ * 64 + lane_id_opaque()); } } while (0)

    for (int st = 0; st < (PR_LO >= 0 ? 3 : 1); ++st) {
    if (PHM(16) && IN(0)) { MKP;
        constexpr int IT_WIN0 = (DM / 64) * ((N_IN_FIRST + 31) / 32), IT_WIN1 = (DM / 64) * ((N_IN_REST + 31) / 32), IT_WO = (512 / 64) * (DM / 32), IT_WOUT = (DM / 64) * (DM / 32);
        constexpr int total = IT_WIN0 + IT_WIN1 + 6 * IT_WO + 2 * IT_WOUT + (DM / 64) * (2 * DENSE_FF / 32) + (DENSE_FF / 64) * (DM / 32);
        bf16* wl0 = WSP(bf16, WS_W); bf16* wl1 = WSP(bf16, WS_W + SZ_LAYERW);
#define WOFF(b, o) ((bf16*)((unsigned char*)(b) + (o)))
        for (int it = gw; it < total; it += NGW) {
            int r = it;
            if (conv_job(r, p.w_in_first, DM, N_IN_FIRST, MapWin{(unsigned char*)wl0, 0}, scrw, lane)) continue;
            if (conv_job(r, p.w_in_rest, DM, N_IN_REST, MapWin{(unsigned char*)wl1, 1}, scrw, lane)) continue;
            if (conv_job(r, p.nsa_w_o, 512, DM, MapPlain{WOFF(wl0, OFF_WO3), 512}, scrw, lane)) continue;
            if (conv_job(r, p.rwkv_w_o, 512, DM, MapPlain{WOFF(wl0, OFF_WO3) + (size_t)DM * 512, 512}, scrw, lane)) continue;
            if (conv_job(r, p.conv_w_o, 512, DM, MapPlain{WOFF(wl0, OFF_WO3) + (size_t)2 * DM * 512, 512}, scrw, lane)) continue;
            if (conv_job(r, p.nsa_w_o + (size_t)512 * DM, 512, DM, MapPlain{WOFF(wl1, OFF_WO3), 512}, scrw, lane)) continue;
            if (conv_job(r, p.rwkv_w_o + (size_t)512 * DM, 512, DM, MapPlain{WOFF(wl1, OFF_WO3) + (size_t)DM * 512, 512}, scrw, lane)) continue;
            if (conv_job(r, p.conv_w_o + (size_t)512 * DM, 512, DM, MapPlain{WOFF(wl1, OFF_WO3) + (size_t)2 * DM * 512, 512}, scrw, lane)) continue;
            if (conv_job(r, p.w_out, DM, DM, MapPlain{WOFF(wl0, OFF_WOUT), DM}, scrw, lane)) continue;
            if (conv_job(r, p.w_out + (size_t)DM * DM, DM, DM, MapPlain{WOFF(wl1, OFF_WOUT), DM}, scrw, lane)) continue;
            if (conv_job(r, p.dense_gu, DM, 2 * DENSE_FF, MapGlu{WSP(bf16, WS_DGU), DM, DENSE_FF}, scrw, lane)) continue;
            conv_job(r, p.dense_down, DENSE_FF, DM, MapPlain{WSP(bf16, WS_DDN), DENSE_FF}, scrw, lane);
        }
        for (int l = 0; l < 2; ++l) {
            unsigned char* wlb = p.ws + WS_W + (size_t)l * SZ_LAYERW;
            bf16* win = (bf16*)(wlb + OFF_WIN);
            for (long i = gtid; i < 512L * DM; i += NT) { const int w = (int)(i / DM); const bool src = w < 288 || (w < 320 && l == 1) || (w >= 320 && w < 344); if (!src) win[(size_t)(3840 + w) * DM + i % DM] = 0; }
            bf16* lw = (bf16*)(wlb + OFF_LW);
            for (long i = gtid; i < 2048L * 384; i += NT) { const int n = (int)(i / 384), k = (int)(i % 384), blk = n >> 9, c = n & 511; float v = 0.f;
                if (blk == 0 && k < 64) v = p.w_up[((size_t)l * 64 + k) * RC + c]; else if (blk == 1 && k >= 64 && k < 128) v = p.a_up[((size_t)l * 64 + k - 64) * RC + c];
                else if (blk == 2 && k >= 128 && k < 288) v = p.g_up[((size_t)l * 160 + k - 128) * RC + c]; else if (blk == 3 && k >= 288 && k < 320 && l == 1) v = p.vres_up[(size_t)(k - 288) * RC + c];
                lw[i] = f2bf(v); }
            bf16* cw1 = (bf16*)(wlb + OFF_CW1);
            for (long i = gtid; i < 2L * 256 * 1024; i += NT) { const int k = (int)(i % 1024), n = (int)((i / 1024) % 256), which = (int)(i / (256 * 1024));
                cw1[i] = f2bf(p.cmp_w1[((size_t)(l * 2 + which) * 2048 + (n < 128 ? k : 1024 + k)) * 128 + (n & 127)]); }
            float* pec = (float*)(wlb + OFF_PEC);
            for (long i = gtid; i < 256; i += NT) { const int which = (int)(i >> 7), n = (int)(i & 127); const float* pe = p.cmp_pos + (size_t)(l * 2 + which) * 2048; const float* w1 = p.cmp_w1 + (size_t)(l * 2 + which) * 2048 * 128 + n;
                float s = 0.f; for (int k = 0; k < 2048; ++k) s += pe[k] * w1[(size_t)k * 128]; pec[i] = s; }
        }
        SEAM(0);
    }

    for (int layer = 0; layer < 2; ++layer) {
        const int pb = 1 + layer * NPH;
        if (PHM(0) && IN(pb + 0)) { MKP;
            const float* xin = layer == 0 ? p.x : p.out;
            for (int m = gw; m < T; m += NGW) rms_row(p, xin + (size_t)m * DM, p.mix_norm_g + (size_t)layer * DM, WSP(bf16, WS_H) + (size_t)m * DM, lane, false, m, cdum0, cdum1);
            SEAM(pb + 0);
        }
        if (PHM(1) && IN(pb + 1)) { MKP;
            Gemm g{WSP(bf16, WS_H), (const bf16*)(p.ws + WS_W + (size_t)layer * SZ_LAYERW + OFF_WIN), T, NPROJ, DM}; SOrder S; S.init(T, NPROJ, G, bid);
            EpiProj E{p.ws};
            pg8::gemm_phase<EpiProj, SOrder, true, true>(lds, g, S, E, tid);
            SEAM(pb + 1);
        }
        if (PHM(2) && IN(pb + 2)) { MKP;
            { Gemm g{WSP(bf16, AR_CKV), (const bf16*)(p.ws + WS_W + (size_t)layer * SZ_LAYERW + OFF_CW1), 2 * BATCH * NKV * 512, 512, 1024, 0}; StackOrder S{BATCH * NKV * 512 / 256, 1, 2, G, bid};
              EpiStore E{WSP(bf16, AR_HID), 256, 1};
              pg8::gemm_phase<EpiStore, StackOrder, true, true>(lds, g, S, E, tid); }
            ph_shift(p, layer, gtid, NT); ph_nsa_prep(p, layer, gtid, NT); ph_vtrans(p, gtid, NT);
            ph_convw(p, layer, gw, NGW, lane, tid, lds);
            SEAM(pb + 2); }
        if (PHM(3) && IN(pb + 3)) { MKP;
#ifndef LORA_NAIVE
            { Gemm g{WSP(bf16, WS_LB), (const bf16*)(p.ws + WS_W + (size_t)layer * SZ_LAYERW + OFF_LW), T, 2048, 384, 0}; SOrder S; S.init(T, 2048, G, bid);
              EpiLora E{p.ws};
              pg8::gemm_phase<EpiLora, SOrder, false, true>(lds, g, S, E, tid); }
#else
            { bf16* RW = WSP(bf16, AR_RW); bf16* Wm = WSP(bf16, AR_W); bf16* Am = WSP(bf16, AR_A); bf16* Gm = WSP(bf16, AR_G); const bf16* VF = WSP(bf16, WS_VF);
              const float* vec = p.rwkv_vec + (size_t)layer * 7 * RC; const float* wup = p.w_up + (size_t)layer * 64 * RC; const float* aup = p.a_up + (size_t)layer * 64 * RC; const float* gup = p.g_up + (size_t)layer * 160 * RC;
              for (long it = gtid; it < (long)T * RC; it += NT) { const int t = (int)(it / RC), c = (int)(it % RC); bf16* row = RW + (size_t)t * LDRW; const bf16* L = row + LBLK;
                  float wl = vec[c], alin = vec[RC + c], g = 0.f;
                  for (int j = 0; j < 64; ++j) { wl += bf2f(L[j]) * bf2f(f2bf(wup[j * RC + c])); alin += bf2f(L[64 + j]) * bf2f(f2bf(aup[j * RC + c])); }
                  for (int j = 0; j < 160; ++j) g += bf2f(L[128 + j]) * bf2f(f2bf(gup[j * RC + c]));
                  const float nx = -wl, sp = fmaxf(nx, 0.f) + __logf(1.f + __expf(-fabsf(nx))), e = __expf(-sp - 0.5f);
                  Wm[it] = f2bf(1.f - __expf(-e)); Am[it] = f2bf(fsig(alin)); Gm[it] = f2bf(g);
                  if (layer == 1) { float vl = p.vres_b[c]; for (int j = 0; j < 32; ++j) vl += bf2f(L[288 + j]) * bf2f(f2bf(p.vres_up[j * RC + c]));
                      const float v = bf2f(row[1024 + c]), vf = bf2f(VF[it]); row[1024 + c] = f2bf(v + (vf - v) * fsig(vl)); } } }
#endif
            SEAM(pb + 3); }
        if (PHM(4) && IN(pb + 4)) { MKP; ph_rwkv_b2w(p, layer, gw, NGW, lane); ph_cmp2w(p, layer, gw, NGW, lane, (LAS float*)(lds + wave * 512)); SEAM(pb + 4); }
        if (PHM(5) && IN(pb + 5)) { MKP;
            { LAS unsigned char* wl = lds + wave * AW_BYTES; constexpr int NSC = BATCH * 8 * 16, NIT = BATCH * NKV * (SEQ / 16);
#ifndef SCAN_QUEUE
              if (wave < 4) for (int u = bid * 4 + wave; u < NSC; u += G * 4) scan_unit(p, u, lane, wl);
#endif
              const int xme = (int)(xb_xcc_id() & 7u);
              for (int qq = 0; qq < 8; ++qq) { const int qx = (xme + qq) & 7; unsigned* head = ctl + CW_ATT + ((layer * 3 + st) * 8 + qx) * 16;
                  for (;;) { int it = 0; if (lane == 0) it = (int)atomicAdd(head, 1u); it = __builtin_amdgcn_readfirstlane(it); if (it >= NIT / 8) break;
                      const int bg = 2 * qx + it / (SEQ / 16), t16 = (SEQ / 16 - 1) - it % (SEQ / 16);
                      nsa_attn_item(p, bg * (SEQ / 16) + t16, lane, wl); } } }
 SEAM(pb + 5); }
        if (PHM(6) && IN(pb + 6)) { MKP; ph_rwkv_postw(p, layer, gw, NGW, lane); SEAM(pb + 6); }
        if (PHM(7) && IN(pb + 7)) { MKP;
            Gemm g{WSP(bf16, AR_QB), (const bf16*)(p.ws + WS_W + (size_t)layer * SZ_LAYERW + OFF_WO3), 3 * T, 3 * DM, 512}; StackOrder S{T / 256, DM / 256, 3, G, bid};
            EpiStore E{WSP(bf16, AR_OBUF), DM, DM / 256};
            pg8::gemm_phase<EpiStore, StackOrder, true, true>(lds, g, S, E, tid);
            { const float* xin = layer == 0 ? p.x : p.out;
              for (int m = gw; m < T; m += NGW) rms_row(p, xin + (size_t)m * DM, p.mix_norm_g + (size_t)layer * DM, WSP(bf16, WS_H) + (size_t)m * DM, lane, false, m, cdum0, cdum1); }
            SEAM(pb + 7);
        }
        if (PHM(8) && IN(pb + 8)) { MKP;
            Gemm g{WSP(bf16, WS_H), (const bf16*)(p.ws + WS_W + (size_t)layer * SZ_LAYERW + OFF_WG), T, 3 * DM, DM}; GateOrder S{T / 256, DM / 256, G, bid};
            EpiGate E{p.ws, DM / 256};
            pg8::gemm_phase<EpiGate, GateOrder, true, true>(lds, g, S, E, tid);
            SEAM(pb + 8);
        }
        if (PHM(9) && IN(pb + 9)) { MKP;
            Gemm g{WSP(bf16, AR_MIX), (const bf16*)(p.ws + WS_W + (size_t)layer * SZ_LAYERW + OFF_WOUT), T, DM, DM}; SOrder S; S.init(T, DM, G, bid);
            EpiResid E{layer == 0 ? p.x : p.out, p.out};
            pg8::gemm_phase<EpiResid, SOrder, true, true>(lds, g, S, E, tid);
            SEAM(pb + 9);
        }
        if (PHM(10) && IN(pb + 10)) { MKP;
            unsigned long long c0 = 0ull, c1 = 0ull;
            for (int m = gw; m < T; m += NGW) rms_row(p, p.out + (size_t)m * DM, p.ffn_norm_g + (size_t)layer * DM, WSP(bf16, WS_H) + (size_t)m * DM, lane, layer == 1, m, c0, c1);
            if (layer == 1 && lane < 16) {
                const unsigned cn = (unsigned)(((lane < 8 ? c0 : c1) >> (8 * (lane & 7))) & 255ull);
                WSP(unsigned, AR_WBASE)[(size_t)gw * 16 + lane] = atomicAdd(ctl + CW_CNT + lane * 64, cn); }
            if (layer == 1) { int* rt = WSP(int, AR_RTOK); for (long i = gtid; i < 2L * MOE_ROWS; i += NT) rt[i] = -1; }
            SEAM(pb + 10);
        }
        if (layer == 0) {
            if (PHM(11) && IN(pb + 11)) { MKP;
                Gemm g{WSP(bf16, WS_H), WSP(bf16, WS_DGU), T, 2 * DENSE_FF, DM}; SOrder S; S.init(T, 2 * DENSE_FF, G, bid);
                EpiSwiglu E{WSP(bf16, AR_ACT), DENSE_FF, 2 * DENSE_FF / 256};
                pg8::gemm_phase<EpiSwiglu, SOrder, true, true>(lds, g, S, E, tid);
                SEAM(pb + 11);
            }
            if (PHM(12) && IN(pb + 12)) { MKP;
                Gemm g{WSP(bf16, AR_ACT), WSP(bf16, WS_DDN), T, DM, DENSE_FF}; SOrder S; S.init(T, DM, G, bid);
                EpiResid E{p.out, p.out};
                pg8::gemm_phase<EpiResid, SOrder, true, true>(lds, g, S, E, tid);
                SEAM(pb + 12);
            }
        } else {
            if (PHM(11) && IN(pb + 11)) { MKP;
                const int ig = (DM / 64) * (2 * EXPERT_FF / 32), id = (EXPERT_FF / 64) * (DM / 32);
                for (int it = gw; it < NEXP * (ig + id); it += NGW) { const int e = it / (ig + id); int r = it % (ig + id);
                    if (conv_job(r, p.moe_gu + (size_t)e * DM * 2 * EXPERT_FF, DM, 2 * EXPERT_FF, MapGlu{WSP(bf16, AR_MGU) + (size_t)e * 2 * EXPERT_FF * DM, DM, EXPERT_FF}, scrw, lane)) continue;
                    conv_job(r, p.moe_down + (size_t)e * EXPERT_FF * DM, EXPERT_FF, DM, MapPlain{WSP(bf16, AR_MDN) + (size_t)e * DM * EXPERT_FF, EXPERT_FF}, scrw, lane); }
                int* rtok = WSP(int, AR_RTOK); float* rww = WSP(float, AR_RW8); int* trow = WSP(int, AR_TROW);
                int segv = 0; { const int pc = lane < 16 ? (int)((ctl[CW_CNT + lane * 64] + 255u) & ~255u) : 0;
#pragma unroll
                    for (int k = 0; k < 8; ++k) { const int ck = bperm_i(pc, (lane & 8) + k); segv += (k < (lane & 7)) ? ck : 0; } }
                for (int tb = gw * 64; tb < T; tb += NGW * 64) {
                    const int t = tb + lane; const int ee = WSP(int, AR_RTE)[t], e0 = ee & 255, e1 = (ee >> 8) & 255, r0 = (ee >> 16) & 255, r1 = (ee >> 24) & 255;
                    const float* w = WSP(float, AR_RTW) + (size_t)t * 2; const unsigned* wb = WSP(unsigned, AR_WBASE) + (size_t)(t % NGW) * 16;
                    const int row0 = bperm_i(segv, e0) + (int)wb[e0] + r0, row1 = bperm_i(segv, 8 + e1) + (int)wb[8 + e1] + r1;
                    rtok[row0] = t; rww[row0] = w[0]; rtok[MOE_ROWS + row1] = t; rww[MOE_ROWS + row1] = w[1]; trow[T + t] = row1;
                    for (int l = 0; l < 64; ++l) copy_row_wave(WSP(bf16, WS_H) + (size_t)(tb + l) * DM, WSP(bf16, AR_XG) + (size_t)__builtin_amdgcn_readlane(row0, l) * DM, lane);
                }
                SEAM(pb + 11);
            }
#pragma unroll
            for (int pass = 0; pass < 2; ++pass) {
                if (PHM(12) && IN(pb + 12 + 2 * pass)) { MKP;
                    Gemm g{WSP(bf16, AR_XG), WSP(bf16, AR_MGU), MOE_ROWS, NEXP * 2 * EXPERT_FF, DM}; MoeOrder S; S.init(ctl + CW_CNT + 8 * 64 * pass, 2 * EXPERT_FF / 256, G, bid);
                    EpiSwiglu E{WSP(bf16, AR_MACT), EXPERT_FF, 2 * EXPERT_FF / 256};
                    pg8::gemm_phase<EpiSwiglu, MoeOrder, true, true>(lds, g, S, E, tid);
                    SEAM(pb + 12 + 2 * pass);
                }
                if (PHM(13) && IN(pb + 13 + 2 * pass)) { MKP;
                    Gemm g{WSP(bf16, AR_MACT), WSP(bf16, AR_MDN), MOE_ROWS, NEXP * DM, EXPERT_FF}; MoeOrder S; S.init(ctl + CW_CNT + 8 * 64 * pass, DM / 256, G, bid);
                    EpiMoeDown E{p.out, WSP(int, AR_RTOK) + (size_t)pass * MOE_ROWS, WSP(float, AR_RW8) + (size_t)pass * MOE_ROWS, DM / 256, (PR_LO >= 0 && st == 0 && pb + 13 + 2 * pass >= PR_LO && pb + 13 + 2 * pass <= PR_HI) ? 0.f : 1.f};
                    pg8::gemm_phase<EpiMoeDown, MoeOrder, true, true>(lds, g, S, E, tid);
                    if (pass == 0) { const int* trow = WSP(int, AR_TROW);
                        for (int t = gw; t < T; t += NGW) copy_row_wave(WSP(bf16, WS_H) + (size_t)t * DM, WSP(bf16, AR_XG) + (size_t)trow[T + t] * DM, lane); }
                    SEAM(pb + 13 + 2 * pass);
                }
            }
        }
    }
    }
#undef IN
#undef SEAM
}

#ifndef MK_ONE_LAUNCH
#define MK_ONE_LAUNCH 1
#endif
extern "C" void kernel_launch(void* const* d_in, const int* in_sizes, int n_in, void* d_out, int out_size, void* d_ws, size_t ws_size, hipStream_t stream) {
    static int grid = 0;
    if (grid == 0) {
        if (n_in != 29 || in_sizes[0] != T * DM || out_size != T * DM || ws_size < WS_END) { fprintf(stderr, "kernel_launch: unexpected shapes / workspace (%d inputs, ws %zu, need %zu)\n", n_in, ws_size, (size_t)WS_END); grid = -1; return; }
        int dev = 0, cus = 0;
        if (hipGetDevice(&dev) != hipSuccess || hipDeviceGetAttribute(&cus, hipDeviceAttributeMultiprocessorCount, dev) != hipSuccess) { grid = -1; return; }
        if (hipFuncSetAttribute((const void*)mk_fwd, hipFuncAttributeMaxDynamicSharedMemorySize, LDS_BYTES) != hipSuccess) { fprintf(stderr, "kernel_launch: hipFuncSetAttribute failed\n"); grid = -1; return; }
        int per_cu = 0;
        if (hipOccupancyMaxActiveBlocksPerMultiprocessor(&per_cu, (const void*)mk_fwd, NTHREADS, LDS_BYTES) != hipSuccess || per_cu < 1) { fprintf(stderr, "kernel_launch: occupancy query says %d\n", per_cu); }
        (void)hipGetLastError();
        grid = cus;
    }
    if (grid < 0) return;
    if (hipMemsetAsync((char*)d_ws + WS_CTL, 0, CTL_BYTES, stream) != hipSuccess) return;
    Args a{};
    for (int i = 0; i < 29; ++i) a.in[i] = (const float*)d_in[i];
    a.out = (float*)d_out; a.ws = (unsigned char*)d_ws;
#if MK_ONE_LAUNCH
    a.ph_lo = 0; a.ph_hi = NPHASES;
    hipLaunchKernelGGL(mk_fwd, dim3(grid), dim3(NTHREADS), LDS_BYTES, stream, a);
#else
    for (int k = 0; k < NPHASES; ++k) {
        if (k >= 1 + 13 && k < 1 + NPH) continue;
        a.ph_lo = k; a.ph_hi = k + 1;
        hipLaunchKernelGGL(mk_fwd, dim3(grid), dim3(NTHREADS), LDS_BYTES, stream, a);
    }
#endif
}
```

```cpp
#include <hip/hip_runtime.h>
#include <cstdio>
#include <cstdint>
#include <cmath>
#include <cstring>
#ifdef HOST_EMU
#define HD
#define DEV_INLINE inline
#else
#define HD __host__ __device__
#define DEV_INLINE __device__ __forceinline__
#endif

typedef unsigned short bf16;
struct alignas(16) U4 { unsigned x, y, z, w; };

#ifdef SMALL_CFG
constexpr int BATCH = 1, SEQ = 1024, DM = 128, DENSE_FF = 256, EXPERT_FF = 256;
#else
constexpr int BATCH = 8, SEQ = 8192, DM = 1024, DENSE_FF = 2816, EXPERT_FF = 3584;
#endif
constexpr int T = BATCH * SEQ;
constexpr int NHEAD = 8, NKV = 2, HG = 4, DH = 64;
constexpr int NC = SEQ / 16 - 1, NS = SEQ / 64, NSEL = 8, WINDOW = 512;
constexpr int CONV_CH = 512, CONV_K = 31, RC = 512;
constexpr int NEXP = 8;
constexpr int NSA_IN = 1304, OFF_CONV = 1304, OFF_GATE = 2328, OFF_RWKV = OFF_GATE + 3 * DM;
constexpr int N_IN_FIRST = OFF_RWKV + 1824, N_IN_REST = OFF_RWKV + 1856;
constexpr int NPROJ = 4352;
constexpr int LDQ = 512, LDKV = 512, LDRW = 2048, LBLK = 1536;
constexpr int MOE_ROWS = T + NEXP * 256;
constexpr float RMS_EPS = 1e-6f, LN_EPS = 1e-5f, GN_EPS = 64e-5f;

constexpr size_t al(size_t x) { return (x + 255) & ~(size_t)255; }
constexpr size_t WS_CTL = 0, CTL_BYTES = 1u << 20;
constexpr size_t SZ_WIN = (size_t)NPROJ * DM * 2, SZ_WG = (size_t)3 * DM * DM * 2, SZ_WO3 = (size_t)3 * DM * 512 * 2, SZ_WOUT = (size_t)DM * DM * 2;
constexpr size_t SZ_LW = (size_t)2048 * 384 * 2, SZ_CW1 = (size_t)2 * 256 * 1024 * 2, SZ_PEC = 1024;
constexpr size_t SZ_LAYERW = SZ_WIN + SZ_WG + SZ_WO3 + SZ_WOUT + SZ_LW + SZ_CW1 + SZ_PEC;
constexpr size_t WS_W = CTL_BYTES;
constexpr size_t OFF_WIN = 0, OFF_WG = SZ_WIN, OFF_WO3 = OFF_WG + SZ_WG, OFF_WOUT = OFF_WO3 + SZ_WO3, OFF_LW = OFF_WOUT + SZ_WOUT, OFF_CW1 = OFF_LW + SZ_LW, OFF_PEC = OFF_CW1 + SZ_CW1;
constexpr size_t WS_DGU = WS_W + 2 * SZ_LAYERW, SZ_DGU = (size_t)2 * DENSE_FF * DM * 2;
constexpr size_t WS_DDN = WS_DGU + SZ_DGU, SZ_DDN = (size_t)DM * DENSE_FF * 2;
constexpr size_t WS_VF = al(WS_DDN + SZ_DDN), SZ_TC = (size_t)T * 512 * 2;
constexpr size_t WS_H = WS_VF + SZ_TC, SZ_H = (size_t)T * DM * 2;
constexpr size_t WS_AR = al(WS_H + SZ_H);
constexpr size_t AR_QB = WS_AR, AR_A = AR_QB + SZ_TC, AR_CO = AR_A + SZ_TC;
constexpr size_t AR_KV = AR_CO + SZ_TC, SZ_KV = (size_t)T * LDKV * 2;
constexpr size_t AR_RW = AR_KV + SZ_KV, SZ_RW = (size_t)T * LDRW * 2;
constexpr size_t AR_W = AR_RW + SZ_RW, AR_G = AR_W + SZ_TC, AR_UB = AR_G + SZ_TC;
constexpr size_t AR_NG = AR_UB + SZ_TC, SZ_NG = (size_t)T * 24 * 4;
constexpr size_t AR_HALO = al(AR_NG + SZ_NG), SZ_HALO = (size_t)(T / 256) * LDRW * 2;
constexpr size_t AR_KC = al(AR_HALO + SZ_HALO), SZ_CMP = (size_t)BATCH * NKV * (SEQ / 16) * 64 * 2;
constexpr size_t AR_VC = AR_KC + SZ_CMP;
constexpr size_t AR_HID = al(AR_VC + SZ_CMP), SZ_HID = (size_t)BATCH * NKV * (SEQ / 16) * 2 * 128 * 4;
constexpr size_t AR_SEL = al(AR_HID + SZ_HID), SZ_SEL = (size_t)T * NKV * 8 * 4;
constexpr size_t AR_INVN = al(AR_SEL + SZ_SEL), SZ_INVN = (size_t)T * 8 * 4;
constexpr size_t AR_VCT = al(AR_INVN + SZ_INVN);
constexpr size_t AR_CKV = al(AR_VCT + SZ_CMP), SZ_CKV = (size_t)2 * T * 128;
constexpr size_t AR_END1 = al(AR_CKV + SZ_CKV * 2);
constexpr size_t WS_VST = WS_H, WS_VWT = WS_H + (size_t)T * 128 * 2, WS_LB = WS_VWT + (size_t)T * 128 * 2, WS_KS8 = WS_LB + (size_t)T * 384 * 2, WS_KW8 = WS_KS8 + (size_t)T * 128 * 2;
constexpr size_t AR_OBUF = AR_KV, SZ_OBUF = (size_t)3 * T * DM * 2;
constexpr size_t AR_MIX = AR_OBUF + SZ_OBUF, SZ_MIX = (size_t)T * DM * 2;
constexpr size_t AR_END2 = AR_MIX + SZ_MIX;
constexpr size_t AR_ACT = WS_AR;
constexpr size_t AR_MGU = WS_AR, SZ_MGU = (size_t)NEXP * 2 * EXPERT_FF * DM * 2;
constexpr size_t AR_MDN = AR_MGU + SZ_MGU, SZ_MDN = (size_t)NEXP * DM * EXPERT_FF * 2;
constexpr size_t AR_XG = al(AR_MDN + SZ_MDN), SZ_XG = (size_t)MOE_ROWS * DM * 2;
constexpr size_t AR_MACT = al(AR_XG + SZ_XG), SZ_MACT = (size_t)MOE_ROWS * EXPERT_FF * 2;
constexpr size_t AR_RTOK = al(AR_MACT + SZ_MACT), SZ_RTOK = (size_t)2 * MOE_ROWS * 4;
constexpr size_t AR_RW8 = al(AR_RTOK + SZ_RTOK);
constexpr size_t AR_TROW = al(AR_RW8 + SZ_RTOK), SZ_TROW = (size_t)2 * T * 4;
constexpr size_t AR_RTE = al(AR_TROW + SZ_TROW);
constexpr size_t AR_RTW = al(AR_RTE + (size_t)T * 4);
constexpr size_t AR_WBASE = al(AR_RTW + (size_t)T * 8);
constexpr size_t AR_END3 = al(AR_WBASE + (size_t)4096 * 16 * 4);
constexpr size_t WS_END = (AR_END1 > AR_END2 ? (AR_END1 > AR_END3 ? AR_END1 : AR_END3) : (AR_END2 > AR_END3 ? AR_END2 : AR_END3));
constexpr int CW_CNT = 1024;
constexpr int CW_ATT = 256;
constexpr int CW_BAR = 4096;

struct P {
    const float *x, *mix_norm_g, *w_in_first, *w_in_rest, *mu_first, *mu_rest, *qk_g, *cmp_pos, *cmp_w1, *cmp_w2, *nsa_w_o, *conv_w, *conv_vec, *conv_w_o,
        *rwkv_vec, *w_up, *a_up, *g_up, *vres_up, *vres_b, *rwkv_w_o, *w_out, *ffn_norm_g, *dense_gu, *dense_down, *router_w, *router_b, *moe_gu, *moe_down;
    float* out; unsigned char* ws;
};
HD inline void fill_params(P& p, const float* const* in, float* out, unsigned char* ws) {
    p.x = in[0]; p.mix_norm_g = in[1]; p.w_in_first = in[2]; p.w_in_rest = in[3]; p.mu_first = in[4]; p.mu_rest = in[5]; p.qk_g = in[6]; p.cmp_pos = in[7];
    p.cmp_w1 = in[8]; p.cmp_w2 = in[9]; p.nsa_w_o = in[10]; p.conv_w = in[11]; p.conv_vec = in[12]; p.conv_w_o = in[13]; p.rwkv_vec = in[14]; p.w_up = in[15];
    p.a_up = in[16]; p.g_up = in[17]; p.vres_up = in[18]; p.vres_b = in[19]; p.rwkv_w_o = in[20]; p.w_out = in[21]; p.ffn_norm_g = in[22]; p.dense_gu = in[23];
    p.dense_down = in[24]; p.router_w = in[25]; p.router_b = in[26]; p.moe_gu = in[27]; p.moe_down = in[28]; p.out = out; p.ws = ws;
}
#define WSP(type, off) ((type*)(p.ws + (off)))

#ifdef HOST_EMU
#define FENCE()
#else
#define FENCE() asm volatile("" ::: "memory")
#endif
HD inline float bf2f(bf16 v) { unsigned u = (unsigned)v << 16; float f; memcpy(&f, &u, 4); return f; }
HD inline bf16 f2bf(float f) { unsigned u; memcpy(&u, &f, 4); return (bf16)((u + 0x7fffu + ((u >> 16) & 1u)) >> 16); }
HD inline float blo(unsigned v) { unsigned u = v << 16; float f; memcpy(&f, &u, 4); return f; }
HD inline float bhi(unsigned v) { unsigned u = v & 0xffff0000u; float f; memcpy(&f, &u, 4); return f; }
#if !defined(SCAN_BF16) && !defined(RKV_BF16)
HD inline bf16 f2h(float f) { return __builtin_bit_cast(unsigned short, (_Float16)f); }
#else
HD inline bf16 f2bf(float f);
HD inline bf16 f2h(float f) { return f2bf(f); }
#endif
HD inline float h2f(bf16 v) { return (float)__builtin_bit_cast(_Float16, v); }
HD inline float sigmoidf_(float x) { return 1.f / (1.f + expf(-x)); }
HD inline float dot64(const float* q, const bf16* kp) {
    const U4* k4 = (const U4*)kp; float s0 = 0.f, s1 = 0.f;
#pragma unroll
    for (int i = 0; i < 8; ++i) { const U4 v = k4[i];
        s0 += q[8 * i + 0] * blo(v.x) + q[8 * i + 2] * blo(v.y) + q[8 * i + 4] * blo(v.z) + q[8 * i + 6] * blo(v.w);
        s1 += q[8 * i + 1] * bhi(v.x) + q[8 * i + 3] * bhi(v.y) + q[8 * i + 5] * bhi(v.z) + q[8 * i + 7] * bhi(v.w); }
    return s0 + s1;
}
HD inline float dot64p(const U4* q, const bf16* kp) {
    const U4* k4 = (const U4*)kp; float s0 = 0.f, s1 = 0.f;
#pragma unroll
    for (int i = 0; i < 8; ++i) { const U4 v = k4[i], w = q[i];
        s0 += blo(w.x) * blo(v.x) + blo(w.y) * blo(v.y) + blo(w.z) * blo(v.z) + blo(w.w) * blo(v.w);
        s1 += bhi(w.x) * bhi(v.x) + bhi(w.y) * bhi(v.y) + bhi(w.z) * bhi(v.z) + bhi(w.w) * bhi(v.w); }
    return s0 + s1;
}
HD inline void ld64(const bf16* kp, float* q) {
    const U4* k4 = (const U4*)kp;
#pragma unroll
    for (int i = 0; i < 8; ++i) { const U4 v = k4[i]; q[8 * i] = blo(v.x); q[8 * i + 1] = bhi(v.x); q[8 * i + 2] = blo(v.y); q[8 * i + 3] = bhi(v.y);
        q[8 * i + 4] = blo(v.z); q[8 * i + 5] = bhi(v.z); q[8 * i + 6] = blo(v.w); q[8 * i + 7] = bhi(v.w); }
}
HD inline void axpy64(float* o, float w, const bf16* vp) {
    const U4* k4 = (const U4*)vp;
#pragma unroll
    for (int i = 0; i < 8; ++i) { const U4 v = k4[i]; o[8 * i] += w * blo(v.x); o[8 * i + 1] += w * bhi(v.x); o[8 * i + 2] += w * blo(v.y); o[8 * i + 3] += w * bhi(v.y);
        o[8 * i + 4] += w * blo(v.z); o[8 * i + 5] += w * bhi(v.z); o[8 * i + 6] += w * blo(v.w); o[8 * i + 7] += w * bhi(v.w); }
}
HD inline void axpy64s(float* o, float w, const bf16* vp) {
    const U4* k4 = (const U4*)vp;
#pragma unroll
    for (int i = 0; i < 8; ++i) { const U4 v = k4[i]; o[8 * i] = w * o[8 * i] + blo(v.x); o[8 * i + 1] = w * o[8 * i + 1] + bhi(v.x); o[8 * i + 2] = w * o[8 * i + 2] + blo(v.y); o[8 * i + 3] = w * o[8 * i + 3] + bhi(v.y);
        o[8 * i + 4] = w * o[8 * i + 4] + blo(v.z); o[8 * i + 5] = w * o[8 * i + 5] + bhi(v.z); o[8 * i + 6] = w * o[8 * i + 6] + blo(v.w); o[8 * i + 7] = w * o[8 * i + 7] + bhi(v.w); }
}
HD inline void st64(bf16* op, const float* o) {
    U4* o4 = (U4*)op;
#pragma unroll
    for (int i = 0; i < 8; ++i) { U4 v; v.x = (unsigned)f2bf(o[8 * i]) | ((unsigned)f2bf(o[8 * i + 1]) << 16); v.y = (unsigned)f2bf(o[8 * i + 2]) | ((unsigned)f2bf(o[8 * i + 3]) << 16);
        v.z = (unsigned)f2bf(o[8 * i + 4]) | ((unsigned)f2bf(o[8 * i + 5]) << 16); v.w = (unsigned)f2bf(o[8 * i + 6]) | ((unsigned)f2bf(o[8 * i + 7]) << 16); o4[i] = v; }
}

HD inline void rope_cs(int pos, int i, float& cs, float& sn) {
    const float c = exp2f(-(float)i * 0.41524101186092f) * 0.15915494309189535f, pf = (float)pos;
    const float prod = pf * c, err = fmaf(pf, c, -prod), fr = (prod - rintf(prod)) + err;
#ifdef HOST_EMU
    cs = cosf(6.283185307179586f * fr); sn = sinf(6.283185307179586f * fr);
#else
    cs = __builtin_amdgcn_cosf(fr); sn = __builtin_amdgcn_sinf(fr);
#endif
}
HD inline int win_dest(int j, int layer, int& which) {
    which = 0;
    if (j < 1280) return j;
    if (j < 1304) return 3840 + 320 + (j - 1280);
    if (j < 1816) { const int cc = j - 1304; return 1280 + 256 * (cc / 128) + cc % 128; }
    if (j < 2328) { const int cc = j - 1816; return 1280 + 256 * (cc / 128) + 128 + cc % 128; }
    if (j < OFF_RWKV) { which = 1; const int gg = j - OFF_GATE, br = gg / DM; return (br == 0 ? 0 : (br == 1 ? 2 * DM : DM)) + gg % DM; }
    const int rr = j - OFF_RWKV;
    if (rr < 1536) return 2304 + rr;
    if (rr < 1824) return 3840 + (rr - 1536);
    if (rr < 1856 && layer == 1) return 3840 + 288 + (rr - 1824);
    return -1;
}
HD inline int glu_dest(int j, int ff) { return j < ff ? 256 * (j / 128) + j % 128 : 256 * ((j - ff) / 128) + 128 + (j - ff) % 128; }

DEV_INLINE void ph_shift(const P& p, int layer, long gtid, long NT) {
    bf16* RW = WSP(bf16, AR_RW); const bf16* HALO = WSP(bf16, AR_HALO); bf16* VF = WSP(bf16, WS_VF); bf16* LB = WSP(bf16, WS_LB);
    const float* mu = layer == 0 ? p.mu_first : p.mu_rest;
    const long n = (long)(T / 256) * (LBLK + 384);
    for (long it = gtid; it < n; it += NT) {
        const int pm = (int)(it / (LBLK + 384)), c = (int)(it % (LBLK + 384));
        int mi = -1, act = 0;
        if (c < LBLK) mi = c;
        else { const int w = c - LBLK; if (w < 288) { mi = 1536 + w; act = w < 64 ? 1 : (w >= 128 ? 2 : 0); } else if (w < 320 && layer == 1) mi = 1824 + (w - 288); }
        if (mi < 0) { for (int r = 0; r < 256; ++r) LB[((size_t)pm * 256 + r) * 384 + (c - LBLK)] = 0; continue; }
        const float m = mu[mi];
        float prev = ((pm * 256) % SEQ == 0) ? 0.f : bf2f(HALO[(size_t)(pm - 1) * LDRW + c]);
        bf16* col = RW + (size_t)pm * 256 * LDRW + c;
        for (int r = 0; r < 256; ++r) {
            const float pv = bf2f(col[(size_t)r * LDRW]);
            float u = pv + (prev - pv) * m; prev = pv;
            if (act == 1) u = tanhf(u); else if (act == 2) u = sigmoidf_(u);
            if (c < LBLK) { col[(size_t)r * LDRW] = f2h(u); if (layer == 0 && c >= 1024) VF[((size_t)pm * 256 + r) * RC + (c - 1024)] = f2h(u); }
            else LB[((size_t)pm * 256 + r) * 384 + (c - LBLK)] = f2bf(u);
        }
    }
}

DEV_INLINE void ph_nsa_prep(const P& p, int layer, long gtid, long NT) {
    bf16* QB = WSP(bf16, AR_QB); bf16* KV = WSP(bf16, AR_KV);
    const long n = (long)T * 12;
    for (long it = gtid; it < n; it += NT) {
        const int t = (int)(it / 12), s = (int)(it % 12), pos = t % SEQ;
        bf16* ptr; const float* g;
        if (s < 8) { ptr = QB + (size_t)t * LDQ + s * 64; g = p.qk_g + (layer * 4 + 0) * 64; }
        else if (s < 10) { ptr = KV + (size_t)t * LDKV + (s - 8) * 64; g = p.qk_g + (layer * 4 + 2) * 64; }
        else { ptr = KV + (size_t)t * LDKV + 256 + (s - 10) * 64; g = p.qk_g + (layer * 4 + 3) * 64; }
        float v[64]; ld64(ptr, v);
        float ss = 0.f;
#pragma unroll
        for (int i = 0; i < 64; ++i) ss += v[i] * v[i];
        const float rs = 1.f / sqrtf(ss * (1.f / 64.f) + RMS_EPS);
#pragma unroll
        for (int i = 0; i < 64; ++i) v[i] = v[i] * rs * g[i];
#pragma unroll
        for (int i = 0; i < 32; ++i) {
            float cs, sn; rope_cs(pos, i, cs, sn);
            const float x1 = v[i], x2 = v[i + 32]; v[i] = x1 * cs - x2 * sn; v[i + 32] = x2 * cs + x1 * sn;
        }
        if (s < 8) {
#pragma unroll
            for (int i = 0; i < 64; ++i) v[i] *= 0.125f * 1.4426950408889634f; }
        if (s < 8) st64(ptr, v);
        else {
            const int gg = (s - 8) & 1, bq = t / SEQ; bf16* k8 = WSP(bf16, s < 10 ? WS_KS8 : WS_KW8) + (size_t)(bq * NKV + gg) * 8 * SEQ * 8;
#pragma unroll
            for (int dg = 0; dg < 8; ++dg) { U4 w; w.x = (unsigned)f2bf(v[8 * dg]) | ((unsigned)f2bf(v[8 * dg + 1]) << 16); w.y = (unsigned)f2bf(v[8 * dg + 2]) | ((unsigned)f2bf(v[8 * dg + 3]) << 16);
                w.z = (unsigned)f2bf(v[8 * dg + 4]) | ((unsigned)f2bf(v[8 * dg + 5]) << 16); w.w = (unsigned)f2bf(v[8 * dg + 6]) | ((unsigned)f2bf(v[8 * dg + 7]) << 16);
                *(U4*)(k8 + ((size_t)dg * SEQ + pos) * 8) = w; } }
    }
}

DEV_INLINE void ph_vtrans(const P& p, long gtid, long NT) {
    const bf16* KV = WSP(bf16, AR_KV); bf16* VsT = WSP(bf16, WS_VST); bf16* VwT = WSP(bf16, WS_VWT);
    const long n = (long)BATCH * NKV * (SEQ / 8) * 64;
    for (long it = gtid; it < n; it += NT) {
        const int d = (int)(it % 64); long r = it / 64; const int kg = (int)(r % (SEQ / 8)); const int bg = (int)(r / (SEQ / 8)), b = bg / NKV, g = bg % NKV;
        const int kbase = (kg >> 2) * 32 + 4 * (kg & 3);
        const bf16* src = KV + (size_t)(b * SEQ + kbase) * LDKV + g * 64 + d;
        U4 s, w; unsigned short sv[8], wv[8];
#pragma unroll
        for (int j = 0; j < 8; ++j) { const size_t ro = (size_t)((j & 3) + 16 * (j >> 2)) * LDKV; sv[j] = src[ro + 128]; wv[j] = src[ro + 384]; }
        s.x = sv[0] | ((unsigned)sv[1] << 16); s.y = sv[2] | ((unsigned)sv[3] << 16); s.z = sv[4] | ((unsigned)sv[5] << 16); s.w = sv[6] | ((unsigned)sv[7] << 16);
        w.x = wv[0] | ((unsigned)wv[1] << 16); w.y = wv[2] | ((unsigned)wv[3] << 16); w.z = wv[4] | ((unsigned)wv[5] << 16); w.w = wv[6] | ((unsigned)wv[7] << 16);
        *(U4*)(VsT + (((size_t)bg * (SEQ / 8) + kg) * 64 + d) * 8) = s; *(U4*)(VwT + (((size_t)bg * (SEQ / 8) + kg) * 64 + d) * 8) = w;
    }
}
namespace pg8 {
#define PG8_LAS __attribute__((address_space(3)))
typedef unsigned short bf16_t;
typedef short bf16x8 __attribute__((ext_vector_type(8)));
typedef float f32x4 __attribute__((ext_vector_type(4)));
typedef unsigned u32x4 __attribute__((ext_vector_type(4)));
constexpr int BM = 256, BK = 64, HALF = 128, HTB = HALF * BK * 2  , STAGE_BYTES = 8 * HTB, NXCD = 8, WGM = 8;

__host__ __device__ __forceinline__ int lds_byte(int r, int c) { const int st = (r >> 4) * 2 + (c >> 5), rr = r & 15, cc = c & 31, ob = rr * 64 + cc * 2; return st * 1024 + (ob ^ (((ob >> 9) & 1) << 5)); }
__host__ __device__ __forceinline__ void stage_rc(int b, int& R, int& C) { const int st = b / 1024, sb = b % 1024, swz = sb ^ (((sb >> 9) & 1) << 5); R = (st >> 1) * 16 + swz / 64; C = (st & 1) * 32 + (swz % 64) / 2; }
__host__ __device__ __forceinline__ int perm32(int rho) { const int n = rho >> 4, i = rho & 15; return 8 * (i >> 2) + 4 * n + (i & 3); }

struct Unit { int pm, pn; };
struct Gemm { const bf16_t* A; const bf16_t* Bt; int M, N, K; int lda; };

struct StaticOrder {
    int nM, nN, nwg, G, c;
    __host__ __device__ void init(int M, int N, int G_, int c_) { nM = M / BM; nN = N / BM; nwg = nM * nN; G = G_; c = c_; }
    __host__ __device__ bool next(int i, Unit& u) const {
        const long L = (long)i * G + c; if (L >= nwg) return false;
        int wgid = (int)L; { const int q = nwg / NXCD, r = nwg % NXCD, xcd = wgid % NXCD, off = wgid / NXCD; wgid = (xcd < r ? xcd * (q + 1) : r * (q + 1) + (xcd - r) * q) + off; }
        const int nig = WGM * nN, gid = wgid / nig, fm = gid * WGM, gsz = (nM - fm) < WGM ? (nM - fm) : WGM;
        u.pm = fm + ((wgid % nig) % gsz); u.pn = (wgid % nig) / gsz; return true;
    }
    __device__ __forceinline__ void a_ready(const Unit&) const {}
    __device__ __forceinline__ void done(const Unit&) const {}
};

__device__ __forceinline__ unsigned cvt_pk_bf16(float lo, float hi) { unsigned r; asm volatile("v_cvt_pk_bf16_f32 %0, %1, %2" : "=v"(r) : "v"(lo), "v"(hi)); return r; }
typedef float f32x2 __attribute__((ext_vector_type(2)));
template <class Epi, class Sched, bool ALIGN_EPI = false, bool SP2 = false>
__device__ __forceinline__ void gemm_phase(PG8_LAS unsigned char* lds, const Gemm g, const Sched& S, const Epi& E, int tid_in) {
    int tid_ = tid_in; asm volatile("" : "+v"(tid_));
    const int tid = tid_, wid = __builtin_amdgcn_readfirstlane(tid >> 6), lane = tid & 63, wr = wid >> 2, wc = wid & 3, fr = lane & 15, fq = lane >> 4;
    const int K = g.K, nt = K / BK, lda = g.lda ? g.lda : K;
    unsigned voffA[2], voffB[2];
#pragma unroll
    for (int i = 0; i < 2; ++i) { int R, C; stage_rc(tid * 16 + i * 8192, R, C); const int Rb = Epi::PERM ? ((R & ~31) + perm32(R & 31)) : R;
        voffA[i] = (unsigned)(R * lda + C) * 2u; voffB[i] = (unsigned)(Rb * K + C) * 2u; }
    const size_t kstep = (size_t)(BK * 2);
    const size_t hstepA = (size_t)HALF * lda * 2, hstepB = (size_t)HALF * K * 2;
    const size_t hstep_unused = (size_t)HALF * K * 2;
    const size_t tstepA = 2 * hstepA, tstepB = 2 * hstepB;
    const unsigned ldsw = (unsigned)wid * 1024u;
    const int aoff = lds_byte(wr * 64 + fr, fq * 8), boff = lds_byte(wc * 32 + fr, fq * 8);
#define PG8_SA(b, h) (((b) * 2 + (h)) * HTB)
#define PG8_SB(b, h) ((4 + (b) * 2 + (h)) * HTB)
#define PG8_STAGE(bufoff, gbase, voff) do { _Pragma("unroll") for (int _i = 0; _i < 2; ++_i) \
        __builtin_amdgcn_global_load_lds((const unsigned*)((const char*)(gbase) + (voff)[_i]), (PG8_LAS unsigned*)(lds + (bufoff) + ldsw + _i * 8192), 16, 0, 0); } while (0)
#define PG8_LDA(dst, b, h) do { _Pragma("unroll") for (int m = 0; m < 4; ++m) _Pragma("unroll") for (int k = 0; k < 2; ++k) dst[m][k] = *(const PG8_LAS bf16x8*)(lds + PG8_SA(b, h) + aoff + m * 2048 + k * 1024); } while (0)
#define PG8_LDB(dst, b, h) do { _Pragma("unroll") for (int n = 0; n < 2; ++n) _Pragma("unroll") for (int k = 0; k < 2; ++k) dst[n][k] = *(const PG8_LAS bf16x8*)(lds + PG8_SB(b, h) + boff + n * 2048 + k * 1024); } while (0)
#define PG8_MMA(ai, bj, At, Bt) do { __builtin_amdgcn_s_setprio(1); _Pragma("unroll") for (int m = 0; m < 4; ++m) _Pragma("unroll") for (int n = 0; n < 2; ++n) _Pragma("unroll") for (int k = 0; k < 2; ++k) \
        acc[ai][bj][m][n] = __builtin_amdgcn_mfma_f32_16x16x32_bf16(Bt[n][k], At[m][k], acc[ai][bj][m][n], 0, 0, 0); __builtin_amdgcn_s_setprio(0); } while (0)
#define PG8_WAIT_V(n) asm volatile("s_waitcnt vmcnt(" #n ")" ::: "memory")
#define PG8_WAIT_L(n) asm volatile("s_waitcnt lgkmcnt(" #n ")" ::: "memory")
#define PG8_BAR __builtin_amdgcn_s_barrier()
#define PG8_SCHED __builtin_amdgcn_sched_barrier(0)
    Unit cur, nxt; int ui = 0;
    if (!S.next(0, cur)) return;
    f32x4 acc[2][2][4][2];
#pragma unroll
    for (int a = 0; a < 2; ++a)
#pragma unroll
        for (int b = 0; b < 2; ++b)
#pragma unroll
            for (int m = 0; m < 4; ++m)
#pragma unroll
                for (int n = 0; n < 2; ++n) acc[a][b][m][n] = (f32x4){0.f, 0.f, 0.f, 0.f};
    bf16x8 At[4][2], B0[2][2], B1[2][2];
    const char* cA = (const char*)g.A + (size_t)cur.pm * tstepA; const char* cB = (const char*)g.Bt + (size_t)cur.pn * tstepB;
    S.a_ready(cur);
    if constexpr (SP2) {
        PG8_STAGE(PG8_SB(0, 0), cB, voffB); PG8_STAGE(PG8_SB(0, 1), cB + hstepB, voffB); PG8_STAGE(PG8_SA(0, 0), cA, voffA); PG8_STAGE(PG8_SA(0, 1), cA + hstepA, voffA);
        if (wr == 1) PG8_BAR;
        PG8_WAIT_V(2); PG8_BAR;
        PG8_STAGE(PG8_SB(1, 0), cB + kstep, voffB); PG8_STAGE(PG8_SA(1, 0), cA + kstep, voffA); PG8_STAGE(PG8_SB(1, 1), cB + hstepB + kstep, voffB);
        PG8_WAIT_V(6); PG8_BAR;
    } else {
        PG8_STAGE(PG8_SB(0, 0), cB, voffB); PG8_STAGE(PG8_SA(0, 0), cA, voffA); PG8_STAGE(PG8_SB(0, 1), cB + hstepB, voffB); PG8_STAGE(PG8_SA(0, 1), cA + hstepA, voffA);
        if (wr == 1) PG8_BAR;
        PG8_WAIT_V(4); PG8_BAR;
        PG8_STAGE(PG8_SB(1, 0), cB + kstep, voffB); PG8_STAGE(PG8_SA(1, 0), cA + kstep, voffA); PG8_STAGE(PG8_SB(1, 1), cB + hstepB + kstep, voffB);
        PG8_WAIT_V(6); PG8_BAR;
    }
    for (;;) {
        const bool has_next = S.next(ui + 1, nxt);
        const char* nA = has_next ? (const char*)g.A + (size_t)nxt.pm * tstepA : cA; const char* nB = has_next ? (const char*)g.Bt + (size_t)nxt.pn * tstepB : cB;
        for (int t = 0; t < nt; t += 2) {
            const bool last = (t == nt - 2);
            const char* a1 = cA + (size_t)(t + 1) * kstep;
            const char* a2 = last ? nA : cA + (size_t)(t + 2) * kstep; const char* b2 = last ? nB : cB + (size_t)(t + 2) * kstep;
            const char* a3 = a2 + kstep; const char* b3 = b2 + kstep;
            if (last && has_next) S.a_ready(nxt);
            if constexpr (SP2) {
            PG8_LDB(B0, 0, 0); PG8_LDB(B1, 0, 1); PG8_SCHED; PG8_LDA(At, 0, 0); PG8_STAGE(PG8_SA(1, 1), a1 + hstepA, voffA);
            PG8_WAIT_V(8); PG8_WAIT_L(0); PG8_BAR; PG8_MMA(0, 0, At, B0); PG8_MMA(0, 1, At, B1); PG8_BAR; PG8_SCHED;
            PG8_LDA(At, 0, 1); PG8_STAGE(PG8_SB(0, 0), b2, voffB); PG8_STAGE(PG8_SB(0, 1), b2 + hstepB, voffB); PG8_STAGE(PG8_SA(0, 0), a2, voffA);
            PG8_WAIT_V(8); PG8_WAIT_L(0); PG8_BAR; PG8_MMA(1, 0, At, B0); PG8_MMA(1, 1, At, B1); PG8_BAR; PG8_SCHED;
            PG8_LDB(B0, 1, 0); PG8_LDB(B1, 1, 1); PG8_SCHED; PG8_LDA(At, 1, 0); PG8_STAGE(PG8_SA(0, 1), a2 + hstepA, voffA);
            PG8_WAIT_V(8); PG8_WAIT_L(0); PG8_BAR; PG8_MMA(0, 0, At, B0); PG8_MMA(0, 1, At, B1); PG8_BAR; PG8_SCHED;
            PG8_LDA(At, 1, 1); PG8_STAGE(PG8_SB(1, 0), b3, voffB); PG8_STAGE(PG8_SB(1, 1), b3 + hstepB, voffB); PG8_STAGE(PG8_SA(1, 0), a3, voffA);
            PG8_WAIT_V(8); PG8_WAIT_L(0); PG8_BAR; PG8_MMA(1, 0, At, B0); PG8_MMA(1, 1, At, B1); PG8_BAR; PG8_SCHED;
            } else {
            PG8_LDB(B0, 0, 0); PG8_SCHED; PG8_LDA(At, 0, 0); PG8_STAGE(PG8_SA(1, 1), a1 + hstepA, voffA);
            PG8_WAIT_L(8); PG8_BAR; PG8_WAIT_L(0); PG8_MMA(0, 0, At, B0); PG8_BAR; PG8_SCHED;
            PG8_LDB(B1, 0, 1); PG8_STAGE(PG8_SB(0, 0), b2, voffB);
            PG8_BAR; PG8_WAIT_L(0); PG8_MMA(0, 1, At, B1); PG8_BAR;
            PG8_LDA(At, 0, 1); PG8_STAGE(PG8_SA(0, 0), a2, voffA);
            PG8_BAR; PG8_WAIT_L(0); PG8_MMA(1, 0, At, B0); PG8_BAR; PG8_SCHED;
            PG8_STAGE(PG8_SB(0, 1), b2 + hstepB, voffB);
            PG8_WAIT_V(6); PG8_BAR; PG8_MMA(1, 1, At, B1); PG8_BAR;
            PG8_LDB(B0, 1, 0); PG8_SCHED; PG8_LDA(At, 1, 0); PG8_STAGE(PG8_SA(0, 1), a2 + hstepA, voffA);
            PG8_WAIT_L(8); PG8_BAR; PG8_WAIT_L(0); PG8_MMA(0, 0, At, B0); PG8_BAR; PG8_SCHED;
            PG8_LDB(B1, 1, 1); PG8_STAGE(PG8_SB(1, 0), b3, voffB);
            PG8_BAR; PG8_WAIT_L(0); PG8_MMA(0, 1, At, B1); PG8_BAR;
            PG8_LDA(At, 1, 1); PG8_STAGE(PG8_SA(1, 0), a3, voffA);
            PG8_BAR; PG8_WAIT_L(0); PG8_MMA(1, 0, At, B0); PG8_BAR; PG8_SCHED;
            PG8_STAGE(PG8_SB(1, 1), b3 + hstepB, voffB);
            PG8_WAIT_V(6); PG8_BAR; PG8_MMA(1, 1, At, B1); PG8_BAR;
            }
        }
        if constexpr (ALIGN_EPI) { if (wr == 0) PG8_BAR; }
        if constexpr (!Epi::AFTER_DRAIN) { E(acc, cur, wr, wc, fr, fq); S.done(cur); }
        if (!has_next) break;
#pragma unroll
        for (int a = 0; a < 2; ++a)
#pragma unroll
            for (int b = 0; b < 2; ++b)
#pragma unroll
                for (int m = 0; m < 4; ++m)
#pragma unroll
                    for (int n = 0; n < 2; ++n) acc[a][b][m][n] = (f32x4){0.f, 0.f, 0.f, 0.f};
        cur = nxt; cA = nA; cB = nB; ++ui;
        if constexpr (ALIGN_EPI) { if (wr == 1) PG8_BAR; }
    }
    PG8_WAIT_V(0);
    if constexpr (!ALIGN_EPI) { if (wr == 0) PG8_BAR; }
    PG8_BAR;
    if constexpr (Epi::AFTER_DRAIN) { E.fused(acc, cur, wr, wc, fr, fq, lds, wid, lane); S.done(cur); }
#undef PG8_SA
#undef PG8_SB
#undef PG8_STAGE
#undef PG8_LDA
#undef PG8_LDB
#undef PG8_MMA
#undef PG8_WAIT_V
#undef PG8_WAIT_L
#undef PG8_BAR
#undef PG8_SCHED
}
}

#define LAS __attribute__((address_space(3)))
#define XB_TMO      128
#define XB_XCNT(j)  (256  + 64 * (j))
#define XB_XSUB(j)  (1280 + 64 * (j))
#define XB_XGEN(j)  (2304 + 64 * (j))
#define XB_TOP      3328
#define XB_TOPGEN   3392
#define XCD_BAR_WORDS 3456
#define XB_SPIN_CAP (1u << 22)

__device__ __forceinline__ unsigned xb_ld(unsigned* p)              { return __hip_atomic_load(p, __ATOMIC_RELAXED, __HIP_MEMORY_SCOPE_AGENT); }
__device__ __forceinline__ unsigned xb_add(unsigned* p, unsigned v) { return __hip_atomic_fetch_add(p, v, __ATOMIC_RELAXED, __HIP_MEMORY_SCOPE_AGENT); }
__device__ __forceinline__ unsigned xb_xcc_id() { return (unsigned)__builtin_amdgcn_s_getreg((3 << 11) | 20) & 0xFu; }
#define XB_SPIN(cond, bar) do { unsigned _sp = 0; while (cond) { __builtin_amdgcn_s_sleep(1); \
    if ((++_sp & 255u) == 0u) { if (xb_ld(&(bar)[XB_TMO])) break; if (_sp > XB_SPIN_CAP) { atomicAdd(&(bar)[XB_TMO], 1u); break; } } } } while (0)

struct XcdBarrier {
    unsigned* bar; unsigned x;
    volatile LAS unsigned* st;
};

__device__ __forceinline__ XcdBarrier xcd_barrier_post(unsigned* bar, volatile LAS unsigned* st) {
    XcdBarrier b; b.bar = bar; b.x = xb_xcc_id(); b.st = st;
    if (threadIdx.x == 0) (void)xb_add(&bar[XB_XCNT(b.x)], 1u);
    return b;
}
__device__ __forceinline__ void xcd_barrier_complete(unsigned* bar, unsigned x, unsigned& nloc, unsigned& nx) {
    const unsigned G = gridDim.x * gridDim.y * gridDim.z;
    unsigned sum, cnt, mine, sp = 0u;
    for (;;) {
        sum = 0u; cnt = 0u; mine = 0u;
#pragma unroll
        for (unsigned j = 0; j < 16; ++j) { const unsigned c = xb_ld(&bar[XB_XCNT(j)]); sum += c; cnt += (c > 0u) ? 1u : 0u; mine = (j == x) ? c : mine; }
        if (sum == G) break;
        __builtin_amdgcn_s_sleep(1);
        if ((++sp & 255u) == 0u) { if (xb_ld(&bar[XB_TMO])) break; if (sp > XB_SPIN_CAP) { atomicAdd(&bar[XB_TMO], 1u); break; } }
    }
    nloc = mine > 0u ? mine : 1u; nx = cnt > 0u ? cnt : 1u;
}

__device__ __forceinline__ void xcd_barrier(const XcdBarrier& b, int tid_x  ) {
    asm volatile("s_waitcnt vmcnt(0)" ::: "memory");
    __syncthreads();
    if (tid_x == 0) {
        unsigned* bar = b.bar; asm volatile("" : "+s"(bar));
        unsigned xx = b.x; asm volatile("" : "+s"(xx));
        __builtin_amdgcn_s_waitcnt(0);
        unsigned nloc = b.st[0], nx = b.st[1];
        if (nloc == 0u) { xcd_barrier_complete(bar, xx, nloc, nx); b.st[0] = nloc; b.st[1] = nx; }
        const unsigned old = xb_add(&bar[XB_XSUB(xx)], 1u);
        const unsigned gen = old / nloc;
        if (old + 1u == (gen + 1u) * nloc) {
            __builtin_amdgcn_fence(__ATOMIC_RELEASE, "agent");
            asm volatile("s_waitcnt vmcnt(0)" ::: "memory");
            const unsigned og = xb_add(&bar[XB_TOP], 1u);
            const unsigned tg = og / nx;
            if (og + 1u == (tg + 1u) * nx) xb_add(&bar[XB_TOPGEN], 1u);
            else XB_SPIN(xb_ld(&bar[XB_TOPGEN]) == tg, bar);
            __builtin_amdgcn_fence(__ATOMIC_ACQUIRE, "agent");
            xb_add(&bar[XB_XGEN(xx)], 1u);
            asm volatile("s_waitcnt vmcnt(0)" ::: "memory");
        } else {
            XB_SPIN(xb_ld(&bar[XB_XGEN(xx)]) == gen, bar);
            __builtin_amdgcn_fence(__ATOMIC_ACQUIRE, "agent");
            asm volatile("s_waitcnt vmcnt(0)" ::: "memory");
        }
    }
    __syncthreads();
}
#define GAS __attribute__((address_space(1)))
typedef unsigned v4u __attribute__((ext_vector_type(4)));
typedef unsigned v2u __attribute__((ext_vector_type(2)));
typedef GAS unsigned gu32;
#define RLX_AGENT __ATOMIC_RELAXED, __HIP_MEMORY_SCOPE_AGENT
#define LDS_WAIT() asm volatile("s_waitcnt lgkmcnt(0)" ::: "memory")
#define VM_WAIT() asm volatile("s_waitcnt vmcnt(0)" ::: "memory")
using pg8::f32x4; using pg8::Unit; using pg8::Gemm; using pg8::BM; using pg8::HALF; using pg8::cvt_pk_bf16; using pg8::u32x4;

constexpr int NWAVES = 8, NTHREADS = 512;
constexpr int RING_BYTES = 131072, LDSCTL_OFF = 147456 - 1024, MISC_OFF = LDSCTL_OFF + 320, LDS_BYTES = 147456;

__device__ __forceinline__ float wave_sum(float v, int lane) {
#pragma unroll
    for (int o = 1; o < 64; o <<= 1) v += __builtin_bit_cast(float, __builtin_amdgcn_ds_bpermute((lane ^ o) << 2, __builtin_bit_cast(int, v)));
    return v;
}
__device__ __forceinline__ float fsig(float x) { return __builtin_amdgcn_rcpf(1.f + __expf(-x)); }

__device__ __forceinline__ int lane_id_opaque() { int l; asm volatile("v_mbcnt_lo_u32_b32 %0, -1, 0\n\tv_mbcnt_hi_u32_b32 %0, -1, %0" : "=v"(l)); return l; }
__device__ __forceinline__ int rfl(int v) { return __builtin_amdgcn_readfirstlane(v); }
struct SOrder {
    pg8::StaticOrder s;
    __device__ void init(int M, int N, int G, int c) { s.init(M, N, G, c); }
    __device__ bool next(int i, Unit& u) const { Unit t; t.pm = 0; t.pn = 0; const bool ok = s.next(i, t); u.pm = rfl(t.pm); u.pn = rfl(t.pn); return ok; }
    __device__ __forceinline__ void a_ready(const Unit&) const {}
    __device__ __forceinline__ void done(const Unit&) const {}
};
struct StackOrder {
    int nM, nN, nb, G, c;
    __device__ bool next(int i, Unit& u) const { const long L = (long)i * G + c; if (L >= (long)nb * nM * nN) return false;
        const int br = (int)(L / (nM * nN)), rem = (int)(L % (nM * nN)); u.pm = rfl(br * nM + rem / nN); u.pn = rfl(br * nN + rem % nN); return true; }
    __device__ __forceinline__ void a_ready(const Unit&) const {}
    __device__ __forceinline__ void done(const Unit&) const {}
};
struct GateOrder {
    int nM, nN, G, c;
    __device__ bool next(int i, Unit& u) const { const int j = i / 3, br = i - 3 * j; const long L = (long)j * G + c; if (L >= (long)nM * nN) return false;
        u.pm = rfl((int)(L / nN)); u.pn = rfl(br * nN + (int)(L % nN)); return true; }
    __device__ __forceinline__ void a_ready(const Unit&) const {}
    __device__ __forceinline__ void done(const Unit&) const {}
};
struct MoeOrder {
    pg8::StaticOrder s; int nN, e0, e1, e2, e3, e4, e5, e6, e7;
    __device__ void init(const unsigned* cnt  , int nN_, int G_, int c_) { nN = nN_;
        int t = 0; t += (cnt[0] + 255) >> 8; e0 = t; t += (cnt[64] + 255) >> 8; e1 = t; t += (cnt[128] + 255) >> 8; e2 = t; t += (cnt[192] + 255) >> 8; e3 = t;
        t += (cnt[256] + 255) >> 8; e4 = t; t += (cnt[320] + 255) >> 8; e5 = t; t += (cnt[384] + 255) >> 8; e6 = t; t += (cnt[448] + 255) >> 8; e7 = t;
        s.init(e7 * 256, nN_ * 256, G_, c_); }
    __device__ bool next(int i, Unit& u) const { Unit t; t.pm = 0; t.pn = 0; if (!s.next(i, t)) return false;
        const int pm = t.pm, e = (pm >= e0) + (pm >= e1) + (pm >= e2) + (pm >= e3) + (pm >= e4) + (pm >= e5) + (pm >= e6);
        u.pm = rfl(pm); u.pn = rfl(e * nN + t.pn); return true; }
    __device__ __forceinline__ void a_ready(const Unit&) const {}
    __device__ __forceinline__ void done(const Unit&) const {}
};

__device__ __forceinline__ u32x4 pack8(f32x4 v0, f32x4 v1) { u32x4 w; w.x = cvt_pk_bf16(v0[0], v0[1]); w.y = cvt_pk_bf16(v0[2], v0[3]); w.z = cvt_pk_bf16(v1[0], v1[1]); w.w = cvt_pk_bf16(v1[2], v1[3]); return w; }
__device__ __forceinline__ void unpack8(u32x4 w, f32x4& v0, f32x4& v1) {
    v0 = (f32x4){blo(w.x), bhi(w.x), blo(w.y), bhi(w.y)}; v1 = (f32x4){blo(w.z), bhi(w.z), blo(w.w), bhi(w.w)}; }

struct EpiProj {
    static constexpr bool PERM = true, AFTER_DRAIN = false;
    unsigned char* ws;
    __device__ __forceinline__ void operator()(const f32x4 (&acc)[2][2][4][2], const Unit& u, int wr, int wc, int fr, int fq) const {
        bf16* const QB = (bf16*)(ws + AR_QB); bf16* const KV = (bf16*)(ws + AR_KV); bf16* const UB = (bf16*)(ws + AR_UB); bf16* const RW = (bf16*)(ws + AR_RW); bf16* const HALO = (bf16*)(ws + AR_HALO); bf16* const CKV = (bf16*)(ws + AR_CKV);
        const int row0 = u.pm * BM + wr * 64 + fr, cl = wc * 32 + 8 * fq;
        if (u.pn >= 5 && u.pn < 9) {
#pragma unroll
            for (int ai = 0; ai < 2; ++ai)
#pragma unroll
                for (int m = 0; m < 4; ++m) { f32x4 a0 = acc[ai][0][m][0], a1 = acc[ai][0][m][1]; const f32x4 b0 = acc[ai][1][m][0], b1 = acc[ai][1][m][1];
#pragma unroll
                    for (int k = 0; k < 4; ++k) { a0[k] *= fsig(b0[k]); a1[k] *= fsig(b1[k]); }
                    *(u32x4*)(UB + (size_t)(row0 + ai * HALF + m * 16) * 512 + (u.pn - 5) * 128 + cl) = pack8(a0, a1); }
            return;
        }
        if (u.pn == 2) {
#pragma unroll
            for (int ai = 0; ai < 2; ++ai)
#pragma unroll
                for (int m = 0; m < 4; ++m) { const int row = row0 + ai * HALF + m * 16, b = row / SEQ, tt = row % SEQ;
#pragma unroll
                    for (int bj = 0; bj < 2; ++bj) *(u32x4*)(CKV + (((size_t)bj * (BATCH * NKV) + b * NKV + (cl >> 6)) * SEQ + tt) * 64 + (cl & 63)) = pack8(acc[ai][bj][m][0], acc[ai][bj][m][1]); }
            return;
        }
        bf16* base; int ld, c0;
        if (u.pn < 2) { base = QB; ld = LDQ; c0 = u.pn * 256; } else if (u.pn < 5) { base = KV; ld = LDKV; c0 = (u.pn - 3) * 256; } else { base = RW; ld = LDRW; c0 = (u.pn - 9) * 256; }
#pragma unroll
        for (int ai = 0; ai < 2; ++ai)
#pragma unroll
            for (int m = 0; m < 4; ++m)
#pragma unroll
                for (int bj = 0; bj < 2; ++bj) { const u32x4 w = pack8(acc[ai][bj][m][0], acc[ai][bj][m][1]);
                    *(u32x4*)(base + (size_t)(row0 + ai * HALF + m * 16) * ld + c0 + bj * HALF + cl) = w;
                    if (u.pn >= 9 && ai == 1 && m == 3 && wr == 1 && fr == 15) *(u32x4*)(HALO + (size_t)u.pm * LDRW + c0 + bj * HALF + cl) = w; }
    }
};
struct EpiStore {
    static constexpr bool PERM = true, AFTER_DRAIN = false;
    bf16* O; int ld, ntn;
    __device__ __forceinline__ void operator()(const f32x4 (&acc)[2][2][4][2], const Unit& u, int wr, int wc, int fr, int fq) const {
        const int row0 = u.pm * BM + wr * 64 + fr, c0 = (u.pn % ntn) * 256 + wc * 32 + 8 * fq;
#pragma unroll
        for (int ai = 0; ai < 2; ++ai)
#pragma unroll
            for (int m = 0; m < 4; ++m)
#pragma unroll
                for (int bj = 0; bj < 2; ++bj) *(u32x4*)(O + (size_t)(row0 + ai * HALF + m * 16) * ld + c0 + bj * HALF) = pack8(acc[ai][bj][m][0], acc[ai][bj][m][1]);
    }
};
struct EpiGate {
    static constexpr bool PERM = true, AFTER_DRAIN = false;
    unsigned char* ws; int ntn;
    __device__ __forceinline__ void operator()(const f32x4 (&acc)[2][2][4][2], const Unit& u, int wr, int wc, int fr, int fq) const {
        const bf16* const OB = (const bf16*)(ws + AR_OBUF); bf16* const MIX = (bf16*)(ws + AR_MIX);
        const int br = u.pn / ntn, row0 = u.pm * BM + wr * 64 + fr, c0 = (u.pn % ntn) * 256 + wc * 32 + 8 * fq;
        const bf16* ob = OB + (size_t)br * T * DM;
#pragma unroll
        for (int ai = 0; ai < 2; ++ai)
#pragma unroll
            for (int m = 0; m < 4; ++m)
#pragma unroll
                for (int bj = 0; bj < 2; ++bj) { const size_t off = (size_t)(row0 + ai * HALF + m * 16) * DM + c0 + bj * HALF;
                    f32x4 o0, o1; unpack8(*(const u32x4*)(ob + off), o0, o1);
                    f32x4 g0 = acc[ai][bj][m][0], g1 = acc[ai][bj][m][1];
#pragma unroll
                    for (int k = 0; k < 4; ++k) { g0[k] = fsig(g0[k]) * o0[k]; g1[k] = fsig(g1[k]) * o1[k]; }
                    if (br != 0) { f32x4 p0, p1; unpack8(*(const u32x4*)(MIX + off), p0, p1); g0 += p0; g1 += p1; }
                    *(u32x4*)(MIX + off) = pack8(g0, g1); }
    }
};
struct EpiResid {
    static constexpr bool PERM = true, AFTER_DRAIN = false;
    const float* base; float* out;
    __device__ __forceinline__ void operator()(const f32x4 (&acc)[2][2][4][2], const Unit& u, int wr, int wc, int fr, int fq) const {
        const int row0 = u.pm * BM + wr * 64 + fr, c0 = u.pn * 256 + wc * 32 + 8 * fq;
#pragma unroll
        for (int ai = 0; ai < 2; ++ai)
#pragma unroll
            for (int m = 0; m < 4; ++m)
#pragma unroll
                for (int bj = 0; bj < 2; ++bj) { const size_t off = (size_t)(row0 + ai * HALF + m * 16) * DM + c0 + bj * HALF;
                    const f32x4 x0 = *(const f32x4*)(base + off), x1 = *(const f32x4*)(base + off + 4);
                    *(f32x4*)(out + off) = x0 + acc[ai][bj][m][0]; *(f32x4*)(out + off + 4) = x1 + acc[ai][bj][m][1]; }
    }
};
struct EpiSwiglu {
    static constexpr bool PERM = true, AFTER_DRAIN = false;
    bf16* ACT; int ld, ntn;
    __device__ __forceinline__ void operator()(const f32x4 (&acc)[2][2][4][2], const Unit& u, int wr, int wc, int fr, int fq) const {
        const int row0 = u.pm * BM + wr * 64 + fr, c0 = (u.pn % ntn) * 128 + wc * 32 + 8 * fq;
#pragma unroll
        for (int ai = 0; ai < 2; ++ai)
#pragma unroll
            for (int m = 0; m < 4; ++m) { f32x4 g0 = acc[ai][0][m][0], g1 = acc[ai][0][m][1]; const f32x4 u0 = acc[ai][1][m][0], u1 = acc[ai][1][m][1];
#pragma unroll
                for (int k = 0; k < 4; ++k) { g0[k] = g0[k] * fsig(g0[k]) * u0[k]; g1[k] = g1[k] * fsig(g1[k]) * u1[k]; }
                *(u32x4*)(ACT + (size_t)(row0 + ai * HALF + m * 16) * ld + c0) = pack8(g0, g1); }
    }
};
struct EpiMoeDown {
    static constexpr bool PERM = true, AFTER_DRAIN = false;
    float* out; const int* rtok; const float* rw; int ntn; float sc;
    __device__ __forceinline__ void operator()(const f32x4 (&acc)[2][2][4][2], const Unit& u, int wr, int wc, int fr, int fq) const {
        const int row0 = u.pm * BM + wr * 64 + fr, c0 = (u.pn % ntn) * 256 + wc * 32 + 8 * fq;
#pragma unroll
        for (int ai = 0; ai < 2; ++ai)
#pragma unroll
            for (int m = 0; m < 4; ++m) { const int row = row0 + ai * HALF + m * 16; const int tok = rtok[row]; const float w = rw[row] * sc;
                if (tok >= 0) {
#pragma unroll
                    for (int bj = 0; bj < 2; ++bj) { float* o = out + (size_t)tok * DM + c0 + bj * HALF;
                        const f32x4 x0 = *(const f32x4*)o, x1 = *(const f32x4*)(o + 4);
                        *(f32x4*)o = x0 + acc[ai][bj][m][0] * w; *(f32x4*)(o + 4) = x1 + acc[ai][bj][m][1] * w; } } }
    }
};

typedef short bf16x8_t __attribute__((ext_vector_type(8)));
#define MFMA16(a, b, c) __builtin_amdgcn_mfma_f32_16x16x32_bf16((a), (b), (c), 0, 0, 0)
constexpr float ATT_C = 0.125f * 1.4426950408889634f;
constexpr int AW_IMP = 0, AW_SEL = 8448, AW_QS = 8960, AW_BYTES = 8960 + 8192;
__device__ __forceinline__ float bperm_f(float v, int srclane) { return __builtin_bit_cast(float, __builtin_amdgcn_ds_bpermute(srclane << 2, __builtin_bit_cast(int, v))); }
__device__ __forceinline__ int bperm_i(int v, int srclane) { return __builtin_amdgcn_ds_bpermute(srclane << 2, v); }
__device__ __forceinline__ bf16x8_t ldg8(const bf16* p) { return *(const bf16x8_t*)p; }
__device__ __forceinline__ bf16x8_t pack_p(const f32x4& a, const f32x4& b) {
    v4u w; w.x = cvt_pk_bf16(a[0], a[1]); w.y = cvt_pk_bf16(a[2], a[3]); w.z = cvt_pk_bf16(b[0], b[1]); w.w = cvt_pk_bf16(b[2], b[3]); return __builtin_bit_cast(bf16x8_t, w); }

__device__ __forceinline__ void nsa_attn_item(const P& p, int item, int lane, LAS unsigned char* wl) {
    const bf16* KV = WSP(bf16, AR_KV); const bf16* KC = WSP(bf16, AR_KC); const bf16* VcT = WSP(bf16, AR_VCT); const bf16* VsT = WSP(bf16, WS_VST); const bf16* VwT = WSP(bf16, WS_VWT);
    bf16* QB = WSP(bf16, AR_QB); const float* NG = WSP(float, AR_NG);
    const int bg = item / (SEQ / 16), t0 = (item % (SEQ / 16)) * 16, b = bg >> 1, g = bg & 1;
    const int col = lane & 15, fq = lane >> 4, tok = t0 + col;
    const size_t grow = (size_t)b * SEQ + tok;
    LAS float* IMP = (LAS float*)(wl + AW_IMP); LAS int* SEL = (LAS int*)(wl + AW_SEL); LAS bf16* OS = (LAS bf16*)(wl + AW_IMP);
    const int krowA = 8 * (col >> 2) + (col & 3);
    const float* gate = NG + grow * 24 + g * 12;
    LAS bf16x8_t* QS = (LAS bf16x8_t*)(wl + AW_QS) + lane;
#pragma unroll
    for (int hh = 0; hh < 4; ++hh)
#pragma unroll
        for (int ks = 0; ks < 2; ++ks) QS[(hh * 2 + ks) * 64] = ldg8(QB + grow * LDQ + (g * 4 + hh) * 64 + ks * 32 + fq * 8);
#define Qc(hh, ks) (QS[((hh) * 2 + (ks)) * 64])
    for (int i = lane; i < 16 * 132; i += 64) IMP[i] = 0.f;
    const f32x4 z4 = {0.f, 0.f, 0.f, 0.f};
    f32x4 O[4][4];
    int nvmax = (t0 + 15 >= 31) ? (((t0 + 15 - 31) >> 4) + 1) : 0; if (nvmax > NC) nvmax = NC;
    const int nch = (nvmax + 31) >> 5;
    const bf16* kcb = KC + (size_t)bg * 512 * 64; const bf16* vcb = VcT + (size_t)bg * 64 * 512;
    float linv[4] = {0.f, 0.f, 0.f, 0.f};
#pragma unroll
    for (int hh = 0; hh < 4; ++hh)
#pragma unroll
        for (int mt = 0; mt < 4; ++mt) O[hh][mt] = z4;
#pragma unroll 1
    for (int pass = 0; pass < 2; ++pass) {
#pragma unroll 1
        for (int ch = 0; ch < nch; ++ch) {
            asm volatile("" ::: "memory");
            const int k0 = 32 * ch; const bool cfull = 16 * (k0 + 31) + 31 <= t0;
            bf16x8_t ka[2][2];
#pragma unroll
            for (int tl = 0; tl < 2; ++tl)
#pragma unroll
                for (int ks = 0; ks < 2; ++ks) ka[tl][ks] = ldg8(kcb + ((size_t)(4 * ks + fq) * 512 + k0 + 16 * tl + col) * 8);
            bf16x8_t va[4];
            if (pass == 1) {
#pragma unroll
                for (int mt = 0; mt < 4; ++mt) va[mt] = ldg8(vcb + ((size_t)((k0 >> 3) + fq) * 64 + 16 * mt + col) * 8);
            }
            float ps[8] = {0.f, 0.f, 0.f, 0.f, 0.f, 0.f, 0.f, 0.f};
#pragma unroll
            for (int hh = 0; hh < 4; ++hh) {
                const bf16x8_t q0_ = Qc(hh, 0), q1_ = Qc(hh, 1);
                f32x4 sa = MFMA16(ka[0][0], q0_, z4); sa = MFMA16(ka[0][1], q1_, sa);
                f32x4 sb = MFMA16(ka[1][0], q0_, z4); sb = MFMA16(ka[1][1], q1_, sb);
#pragma unroll
                for (int i = 0; i < 4; ++i) { sa[i] = __builtin_amdgcn_exp2f(sa[i]); sb[i] = __builtin_amdgcn_exp2f(sb[i]); }
                if (!cfull) {
#pragma unroll
                    for (int i = 0; i < 4; ++i) { const int c = k0 + 4 * fq + i; sa[i] = (16 * c + 31 <= tok) ? sa[i] : 0.f; sb[i] = (16 * (c + 16) + 31 <= tok) ? sb[i] : 0.f; } }
                if (pass == 0) { linv[hh] += (sa[0] + sa[1]) + (sa[2] + sa[3]) + (sb[0] + sb[1]) + (sb[2] + sb[3]); }
                else {
#pragma unroll
                    for (int i = 0; i < 4; ++i) { ps[i] = __builtin_fmaf(sa[i], linv[hh], ps[i]); ps[4 + i] = __builtin_fmaf(sb[i], linv[hh], ps[4 + i]); }
                    const bf16x8_t pt = pack_p(sa, sb);
#pragma unroll
                    for (int mt = 0; mt < 4; ++mt) O[hh][mt] = MFMA16(va[mt], pt, O[hh][mt]);
                }
            }
            if (pass == 1) {
                const int Ga = 8 * ch + fq; LAS float* ir = IMP + col * 132 + Ga;
                __hip_atomic_fetch_add(ir, (ps[0] + ps[1]) + (ps[2] + ps[3]), __ATOMIC_RELAXED, __HIP_MEMORY_SCOPE_WORKGROUP);
                __hip_atomic_fetch_add(ir + 1, ps[3], __ATOMIC_RELAXED, __HIP_MEMORY_SCOPE_WORKGROUP);
                __hip_atomic_fetch_add(ir + 4, (ps[4] + ps[5]) + (ps[6] + ps[7]), __ATOMIC_RELAXED, __HIP_MEMORY_SCOPE_WORKGROUP);
                if (Ga + 5 < NS) __hip_atomic_fetch_add(ir + 5, ps[7], __ATOMIC_RELAXED, __HIP_MEMORY_SCOPE_WORKGROUP);
            }
        }
        if (pass == 0) {
#pragma unroll
            for (int hh = 0; hh < 4; ++hh) { float l = linv[hh]; l += bperm_f(l, lane ^ 16); l += bperm_f(l, lane ^ 32); linv[hh] = l > 0.f ? 1.f / l : 0.f; }
        }
    }
    LDS_WAIT(); asm volatile("" ::: "memory");
    {
        const int cur = tok >> 6; LAS float* sc = IMP + col * 132;
        for (int j = fq * 32; j < fq * 32 + 32; ++j) { const bool forced = (j == 0) || (j == cur) || (j == cur - 1); const float v = sc[j]; sc[j] = forced ? 1e4f : (j <= cur ? v : -1.f); }
        LDS_WAIT(); asm volatile("" ::: "memory");
#pragma unroll 1
        for (int r = 0; r < 8; ++r) {
            float bv = sc[fq * 32]; int bj = fq * 32;
            for (int j = fq * 32 + 1; j < fq * 32 + 32; ++j) { const float v = sc[j]; if (v > bv) { bv = v; bj = j; } }
#pragma unroll
            for (int o = 16; o <= 32; o <<= 1) { const float ov = bperm_f(bv, lane ^ o); const int oj = bperm_i(bj, lane ^ o); if (ov > bv || (ov == bv && oj < bj)) { bv = ov; bj = oj; } }
            if ((bj >> 5) == fq) sc[bj] = -3e38f;
            if (fq == 0) SEL[col * 8 + r] = bj;
            LDS_WAIT(); asm volatile("" ::: "memory");
        }
    }
#pragma unroll
    for (int hh = 0; hh < 4; ++hh) { const float g0 = gate[hh * 3 + 0] * linv[hh];
#pragma unroll
        for (int mt = 0; mt < 4; ++mt) { const f32x4 o = O[hh][mt] * g0; v2u w; w.x = cvt_pk_bf16(o[0], o[1]); w.y = cvt_pk_bf16(o[2], o[3]);
            *(LAS v2u*)(OS + (col * 4 + hh) * 64 + 16 * mt + 4 * fq) = w; } }
    LDS_WAIT(); asm volatile("" ::: "memory");
    const int cur = t0 >> 6;
    {
        const bf16* kwb = WSP(bf16, WS_KW8) + (size_t)bg * 8 * SEQ * 8; const bf16* vwb = VwT + (size_t)bg * 64 * SEQ;
        const bf16* ksb = WSP(bf16, WS_KS8) + (size_t)bg * 8 * SEQ * 8; const bf16* vsb = VsT + (size_t)bg * 64 * SEQ;
        int kst = t0 - (WINDOW - 1); if (kst < 0) kst = 0; kst &= ~31;
        const int nwin = ((t0 + 15 - kst) >> 5) + 1, nfb = cur >= 2 ? 3 : cur + 1;
#pragma unroll 1
        for (int part = 0; part < 2; ++part) {
            float lw[4] = {0.f, 0.f, 0.f, 0.f};
#pragma unroll
            for (int hh = 0; hh < 4; ++hh)
#pragma unroll
                for (int mt = 0; mt < 4; ++mt) O[hh][mt] = z4;
            const bf16* kb = part ? ksb : kwb; const bf16* vb = part ? vsb : vwb;
            const int nchk = part ? 2 * nfb : nwin;
#pragma unroll 1
            for (int ci = 0; ci < nchk; ++ci) {
                asm volatile("" ::: "memory");
                int k0;
                if (part == 0) k0 = kst + 32 * ci; else { const int fb = ci >> 1, j = fb == 0 ? 0 : (fb == 1 ? cur : cur - 1); k0 = 64 * j + 32 * (ci & 1); }
                bf16x8_t ka[2][2], va[4];
#pragma unroll
                for (int tl = 0; tl < 2; ++tl)
#pragma unroll
                    for (int ks = 0; ks < 2; ++ks) ka[tl][ks] = ldg8(kb + ((size_t)(4 * ks + fq) * SEQ + k0 + 16 * tl + col) * 8);
#pragma unroll
                for (int mt = 0; mt < 4; ++mt) va[mt] = ldg8(vb + ((size_t)((k0 >> 3) + fq) * 64 + 16 * mt + col) * 8);
                const int lowk = part ? -1 : tok - WINDOW; const bool dfull = (k0 + 31 <= t0) && (part || k0 > t0 + 15 - WINDOW);
#pragma unroll
                for (int hh = 0; hh < 4; ++hh) {
                    const bf16x8_t q0_ = Qc(hh, 0), q1_ = Qc(hh, 1);
                    f32x4 sa = MFMA16(ka[0][0], q0_, z4); sa = MFMA16(ka[0][1], q1_, sa);
                    f32x4 sb = MFMA16(ka[1][0], q0_, z4); sb = MFMA16(ka[1][1], q1_, sb);
#pragma unroll
                    for (int i = 0; i < 4; ++i) { sa[i] = __builtin_amdgcn_exp2f(sa[i]); sb[i] = __builtin_amdgcn_exp2f(sb[i]); }
                    if (!dfull) {
#pragma unroll
                        for (int i = 0; i < 4; ++i) { const int kt = k0 + 4 * fq + i; sa[i] = (kt <= tok && kt > lowk) ? sa[i] : 0.f; sb[i] = (kt + 16 <= tok && kt + 16 > lowk) ? sb[i] : 0.f; } }
                    lw[hh] += (sa[0] + sa[1]) + (sa[2] + sa[3]) + (sb[0] + sb[1]) + (sb[2] + sb[3]);
                    const bf16x8_t pt = pack_p(sa, sb);
#pragma unroll
                    for (int mt = 0; mt < 4; ++mt) O[hh][mt] = MFMA16(va[mt], pt, O[hh][mt]);
                }
            }
            LDS_WAIT(); asm volatile("" ::: "memory");
            if (part == 0) {
#pragma unroll
                for (int hh = 0; hh < 4; ++hh) { float l = lw[hh]; l += bperm_f(l, lane ^ 16); l += bperm_f(l, lane ^ 32); const float w = l > 0.f ? gate[hh * 3 + 2] / l : 0.f;
#pragma unroll
                    for (int mt = 0; mt < 4; ++mt) { LAS v2u* dp = (LAS v2u*)(OS + (col * 4 + hh) * 64 + 16 * mt + 4 * fq); const v2u old = *dp;
                        v2u w2; w2.x = cvt_pk_bf16(blo(old.x) + w * O[hh][mt][0], bhi(old.x) + w * O[hh][mt][1]); w2.y = cvt_pk_bf16(blo(old.y) + w * O[hh][mt][2], bhi(old.y) + w * O[hh][mt][3]); *dp = w2; } }
            } else {
                LAS bf16* OF = (LAS bf16*)(wl + AW_QS); LAS float* LF = (LAS float*)(wl + AW_IMP + 8192);
#pragma unroll
                for (int hh = 0; hh < 4; ++hh) { float l = lw[hh]; l += bperm_f(l, lane ^ 16); l += bperm_f(l, lane ^ 32); if (fq == 0) LF[col * 4 + hh] = l;
#pragma unroll
                    for (int mt = 0; mt < 4; ++mt) { v2u w2; w2.x = cvt_pk_bf16(O[hh][mt][0], O[hh][mt][1]); w2.y = cvt_pk_bf16(O[hh][mt][2], O[hh][mt][3]); *(LAS v2u*)(OF + (col * 4 + hh) * 64 + 16 * mt + 4 * fq) = w2; } }
            }
            LDS_WAIT(); asm volatile("" ::: "memory");
        }
    }
    {
        const bf16* ksb = WSP(bf16, WS_KS8) + (size_t)bg * 8 * SEQ * 8; const bf16* vsb = VsT + (size_t)bg * 64 * SEQ;
        const LAS bf16* OF = (const LAS bf16*)(wl + AW_QS); const LAS float* LF = (const LAS float*)(wl + AW_IMP + 8192);
#pragma unroll 1
        for (int tt = 0; tt < 16; ++tt) {
            const int tq = t0 + tt; const size_t qrow = (size_t)b * SEQ + tq;
            bf16x8_t Qh[2];
#pragma unroll
            for (int ks = 0; ks < 2; ++ks) { Qh[ks] = ldg8(QB + qrow * LDQ + (g * 4 + (col & 3)) * 64 + ks * 32 + fq * 8); if (col >= 4) Qh[ks] = (bf16x8_t){0, 0, 0, 0, 0, 0, 0, 0}; }
            f32x4 Os[4] = {z4, z4, z4, z4}; float ls = 0.f;
#ifdef APROBE_SEL
            for (int rp = 0; rp < 2; ++rp) { Os[0] = z4; Os[1] = z4; Os[2] = z4; Os[3] = z4; ls = 0.f; asm volatile("" ::: "memory");
#endif
#pragma unroll 1
            for (int r8 = 0; r8 < 8; ++r8) {
                const int j = __builtin_amdgcn_readfirstlane(SEL[tt * 8 + r8]);
                if (64 * j > tq || j == 0 || j == cur || j == cur - 1) continue;
                const int kb0 = 64 * j;
                bf16x8_t ka[2][2][2], va[2][4];
#pragma unroll
                for (int hf = 0; hf < 2; ++hf) {
#pragma unroll
                    for (int tl = 0; tl < 2; ++tl)
#pragma unroll
                        for (int ks = 0; ks < 2; ++ks) ka[hf][tl][ks] = ldg8(ksb + ((size_t)(4 * ks + fq) * SEQ + kb0 + 32 * hf + 16 * tl + col) * 8);
#pragma unroll
                    for (int mt = 0; mt < 4; ++mt) va[hf][mt] = ldg8(vsb + ((size_t)(((kb0 + 32 * hf) >> 3) + fq) * 64 + 16 * mt + col) * 8);
                }
#pragma unroll
                for (int hf = 0; hf < 2; ++hf) {
                    f32x4 sa = MFMA16(ka[hf][0][0], Qh[0], z4); sa = MFMA16(ka[hf][0][1], Qh[1], sa);
                    f32x4 sb = MFMA16(ka[hf][1][0], Qh[0], z4); sb = MFMA16(ka[hf][1][1], Qh[1], sb);
#pragma unroll
                    for (int i = 0; i < 4; ++i) { sa[i] = __builtin_amdgcn_exp2f(sa[i]); sb[i] = __builtin_amdgcn_exp2f(sb[i]); }
                    ls += (sa[0] + sa[1]) + (sa[2] + sa[3]) + (sb[0] + sb[1]) + (sb[2] + sb[3]);
                    const bf16x8_t pt = pack_p(sa, sb);
#pragma unroll
                    for (int mt = 0; mt < 4; ++mt) Os[mt] = MFMA16(va[hf][mt], pt, Os[mt]);
                }
            }
#ifdef APROBE_SEL
            }
#endif
            ls += bperm_f(ls, lane ^ 16); ls += bperm_f(ls, lane ^ 32);
            if (col < 4) {
                const float den = ls + LF[tt * 4 + col]; const float w = den > 0.f ? (NG + qrow * 24 + g * 12)[col * 3 + 1] / den : 0.f;
#pragma unroll
                for (int mt = 0; mt < 4; ++mt) { const int e = (tt * 4 + col) * 64 + 16 * mt + 4 * fq; const v2u old = *(const LAS v2u*)(OS + e), fo = *(const LAS v2u*)(OF + e);
                    v2u w2; w2.x = cvt_pk_bf16(blo(old.x) + w * (Os[mt][0] + blo(fo.x)), bhi(old.x) + w * (Os[mt][1] + bhi(fo.x))); w2.y = cvt_pk_bf16(blo(old.y) + w * (Os[mt][2] + blo(fo.y)), bhi(old.y) + w * (Os[mt][3] + bhi(fo.y)));
                    *(v2u*)(QB + qrow * LDQ + (g * 4 + col) * 64 + 16 * mt + 4 * fq) = w2; }
            }
        }
    }
    LDS_WAIT(); asm volatile("" ::: "memory");
#undef Qc
}

typedef _Float16 h16x2 __attribute__((ext_vector_type(2)));
__device__ __forceinline__ h16x2 as_h2(unsigned u) { h16x2 r; __builtin_memcpy(&r, &u, 4); return r; }
constexpr int SC_STEPS = 8, SC_BUF = 6 * 1024;
__device__ __forceinline__ float dpp_sum16(float v) {
    v += __builtin_bit_cast(float, __builtin_amdgcn_update_dpp(0, __builtin_bit_cast(int, v), 0xB1, 0xF, 0xF, true));
    v += __builtin_bit_cast(float, __builtin_amdgcn_update_dpp(0, __builtin_bit_cast(int, v), 0x4E, 0xF, 0xF, true));
    v += __builtin_bit_cast(float, __builtin_amdgcn_update_dpp(0, __builtin_bit_cast(int, v), 0x141, 0xF, 0xF, true));
    v += __builtin_bit_cast(float, __builtin_amdgcn_update_dpp(0, __builtin_bit_cast(int, v), 0x140, 0xF, 0xF, true));
    return v;
}
__device__ __forceinline__ void scan_fill(const bf16* RW, const bf16* Wm, const bf16* Am, size_t trow, int h, int lane, LAS unsigned char* buf) {
    const size_t t = trow + (lane >> 3); const int sub = (lane & 7) * 8;
    const bf16* row = RW + t * LDRW + h * 64 + sub;
    __builtin_amdgcn_global_load_lds((const unsigned*)(row + LBLK), (LAS unsigned*)(buf + 0 * 1024), 16, 0, 0);
    __builtin_amdgcn_global_load_lds((const unsigned*)(Am + t * RC + h * 64 + sub), (LAS unsigned*)(buf + 1 * 1024), 16, 0, 0);
    __builtin_amdgcn_global_load_lds((const unsigned*)(Wm + t * RC + h * 64 + sub), (LAS unsigned*)(buf + 2 * 1024), 16, 0, 0);
    __builtin_amdgcn_global_load_lds((const unsigned*)(row + 512), (LAS unsigned*)(buf + 3 * 1024), 16, 0, 0);
    __builtin_amdgcn_global_load_lds((const unsigned*)(row), (LAS unsigned*)(buf + 4 * 1024), 16, 0, 0);
    __builtin_amdgcn_global_load_lds((const unsigned*)(row + 1024), (LAS unsigned*)(buf + 5 * 1024), 16, 0, 0);
}
__device__ __forceinline__ void scan_unit(const P& p, int unit, int lane, LAS unsigned char* wl) {
    const bf16* RW = WSP(bf16, AR_RW); const bf16* Wm = WSP(bf16, AR_W); const bf16* Am = WSP(bf16, AR_A); bf16* Y = WSP(bf16, AR_UB);
    const int rg = unit & 15, h = (unit >> 4) & 7, b = unit >> 7, row = rg * 4 + (lane >> 4), kq = lane & 15;
    const size_t tb = (size_t)b * SEQ;
    float s0 = 0.f, s1 = 0.f, s2 = 0.f, s3 = 0.f;
    __builtin_amdgcn_s_setprio(3);
    scan_fill(RW, Wm, Am, tb, h, lane, wl);
#pragma unroll 1
    for (int c = 0; c < SEQ / SC_STEPS; ++c) {
        LAS unsigned char* buf = wl + (c & 1) * SC_BUF;
        asm volatile("s_waitcnt vmcnt(0) lgkmcnt(0)" ::: "memory");
        if (c + 1 < SEQ / SC_STEPS) scan_fill(RW, Wm, Am, tb + (size_t)(c + 1) * SC_STEPS, h, lane, wl + ((c + 1) & 1) * SC_BUF);
#ifndef SCAN_VARB
        float ys[SC_STEPS];
#pragma unroll
        for (int st = 0; st < SC_STEPS; ++st) {
            const LAS unsigned char* o = buf + st * 128 + kq * 8;
            const v2u kkw = *(const LAS v2u*)(o), bbw = *(const LAS v2u*)(o + 1024), eew = *(const LAS v2u*)(o + 2048), ktw = *(const LAS v2u*)(o + 3072), rrw = *(const LAS v2u*)(o + 4096);
#ifdef SCAN_BF16
            struct F2 { float x, y; }; const F2 kk0{blo(kkw.x), bhi(kkw.x)}, kk1{blo(kkw.y), bhi(kkw.y)}, bb0{blo(bbw.x), bhi(bbw.x)}, bb1{blo(bbw.y), bhi(bbw.y)}, ee0{blo(eew.x), bhi(eew.x)}, ee1{blo(eew.y), bhi(eew.y)}, kt0{blo(ktw.x), bhi(ktw.x)}, kt1{blo(ktw.y), bhi(ktw.y)}, rr0{blo(rrw.x), bhi(rrw.x)}, rr1{blo(rrw.y), bhi(rrw.y)};
            const float vv = bf2f(*(const LAS unsigned short*)(buf + 5 * 1024 + st * 128 + row * 2));
#else
            const h16x2 kk0 = as_h2(kkw.x), kk1 = as_h2(kkw.y), bb0 = as_h2(bbw.x), bb1 = as_h2(bbw.y);
            const h16x2 ee0 = as_h2(eew.x), ee1 = as_h2(eew.y);
#ifdef RKV_BF16
            struct F2 { float x, y; }; const F2 kt0{blo(ktw.x), bhi(ktw.x)}, kt1{blo(ktw.y), bhi(ktw.y)}, rr0{blo(rrw.x), bhi(rrw.x)}, rr1{blo(rrw.y), bhi(rrw.y)};
            const float vv = bf2f(*(const LAS unsigned short*)(buf + 5 * 1024 + st * 128 + row * 2));
#else
            const h16x2 kt0 = as_h2(ktw.x), kt1 = as_h2(ktw.y);
            const h16x2 rr0 = as_h2(rrw.x), rr1 = as_h2(rrw.y);
            const float vv = (float)__builtin_bit_cast(_Float16, *(const LAS unsigned short*)(buf + 5 * 1024 + st * 128 + row * 2));
#endif
#endif
            float d0 = s0 * (float)kk0.x; d0 = __builtin_fmaf(s1, (float)kk0.y, d0); float d1 = s2 * (float)kk1.x; d1 = __builtin_fmaf(s3, (float)kk1.y, d1);
            const float nskk = -dpp_sum16(d0 + d1);
            s0 = __builtin_fmaf(s0, -(float)ee0.x, s0); s1 = __builtin_fmaf(s1, -(float)ee0.y, s1); s2 = __builtin_fmaf(s2, -(float)ee1.x, s2); s3 = __builtin_fmaf(s3, -(float)ee1.y, s3);
            s0 = __builtin_fmaf(nskk, (float)bb0.x, s0); s1 = __builtin_fmaf(nskk, (float)bb0.y, s1); s2 = __builtin_fmaf(nskk, (float)bb1.x, s2); s3 = __builtin_fmaf(nskk, (float)bb1.y, s3);
            s0 = __builtin_fmaf(vv, (float)kt0.x, s0); s1 = __builtin_fmaf(vv, (float)kt0.y, s1); s2 = __builtin_fmaf(vv, (float)kt1.x, s2); s3 = __builtin_fmaf(vv, (float)kt1.y, s3);
            float y0 = s0 * (float)rr0.x; y0 = __builtin_fmaf(s1, (float)rr0.y, y0); float y1 = s2 * (float)rr1.x; y1 = __builtin_fmaf(s3, (float)rr1.y, y1);
            ys[st] = dpp_sum16(y0 + y1);
        }
        if (kq < SC_STEPS) { float yv = ys[0];
#pragma unroll
            for (int st = 1; st < SC_STEPS; ++st) yv = (kq == st) ? ys[st] : yv;
            Y[(tb + (size_t)c * SC_STEPS + kq) * RC + h * 64 + row] = f2bf(yv); }
    }
#else
#pragma unroll
        for (int st = 0; st < SC_STEPS; ++st) {
            const LAS unsigned char* o = buf + st * 128 + kq * 8;
            float kk[4], bb[4], ee[4], kt[4], rr[4];
            { const v2u w = *(const LAS v2u*)(o); const h16x2 a = as_h2(w.x), b2 = as_h2(w.y); kk[0] = (float)a.x; kk[1] = (float)a.y; kk[2] = (float)b2.x; kk[3] = (float)b2.y; }
            { const v2u w = *(const LAS v2u*)(o + 1024); const h16x2 a = as_h2(w.x), b2 = as_h2(w.y); bb[0] = (float)a.x; bb[1] = (float)a.y; bb[2] = (float)b2.x; bb[3] = (float)b2.y; }
            { const v2u w = *(const LAS v2u*)(o + 2048); const h16x2 a = as_h2(w.x), b2 = as_h2(w.y); ee[0] = (float)a.x; ee[1] = (float)a.y; ee[2] = (float)b2.x; ee[3] = (float)b2.y; }
            { const v2u w = *(const LAS v2u*)(o + 3072); const h16x2 a = as_h2(w.x), b2 = as_h2(w.y); kt[0] = (float)a.x; kt[1] = (float)a.y; kt[2] = (float)b2.x; kt[3] = (float)b2.y; }
            { const v2u w = *(const LAS v2u*)(o + 4096); const h16x2 a = as_h2(w.x), b2 = as_h2(w.y); rr[0] = (float)a.x; rr[1] = (float)a.y; rr[2] = (float)b2.x; rr[3] = (float)b2.y; }
            const float vv = (float)__builtin_bit_cast(_Float16, *(const LAS unsigned short*)(buf + 5 * 1024 + st * 128 + row * 2));
            const float skk = dpp_sum16((s0 * kk[0] + s1 * kk[1]) + (s2 * kk[2] + s3 * kk[3]));
            s0 = s0 - s0 * ee[0] - skk * bb[0] + vv * kt[0]; s1 = s1 - s1 * ee[1] - skk * bb[1] + vv * kt[1]; s2 = s2 - s2 * ee[2] - skk * bb[2] + vv * kt[2]; s3 = s3 - s3 * ee[3] - skk * bb[3] + vv * kt[3];
            const float y = dpp_sum16((s0 * rr[0] + s1 * rr[1]) + (s2 * rr[2] + s3 * rr[3]));
            if (kq == 0) Y[(tb + (size_t)c * SC_STEPS + st) * RC + h * 64 + row] = f2bf(y);
        }
    }
#endif
    asm volatile("s_waitcnt vmcnt(0) lgkmcnt(0)" ::: "memory");
    __builtin_amdgcn_s_setprio(0);
}
__device__ __forceinline__ float sum8(float v) {
    v += __builtin_bit_cast(float, __builtin_amdgcn_update_dpp(0, __builtin_bit_cast(int, v), 0xB1, 0xF, 0xF, true));
    v += __builtin_bit_cast(float, __builtin_amdgcn_update_dpp(0, __builtin_bit_cast(int, v), 0x4E, 0xF, 0xF, true));
    v += __builtin_bit_cast(float, __builtin_amdgcn_update_dpp(0, __builtin_bit_cast(int, v), 0x141, 0xF, 0xF, true));
    return v;
}
__device__ __forceinline__ void up8(v4u w, float* f) { f[0] = blo(w.x); f[1] = bhi(w.x); f[2] = blo(w.y); f[3] = bhi(w.y); f[4] = blo(w.z); f[5] = bhi(w.z); f[6] = blo(w.w); f[7] = bhi(w.w); }
#ifdef SCAN_BF16
#define uph8 up8
#define pkh8 pk8
#else
#define uph8 uph8_
#define pkh8 pkh8_
#endif
__device__ __forceinline__ void uph8_(v4u w, float* f) { const h16x2 a = as_h2(w.x), b = as_h2(w.y), c = as_h2(w.z), d = as_h2(w.w);
    f[0] = (float)a.x; f[1] = (float)a.y; f[2] = (float)b.x; f[3] = (float)b.y; f[4] = (float)c.x; f[5] = (float)c.y; f[6] = (float)d.x; f[7] = (float)d.y; }
__device__ __forceinline__ unsigned pkh2(float lo, float hi) { h16x2 v; v.x = (_Float16)lo; v.y = (_Float16)hi; return __builtin_bit_cast(unsigned, v); }
__device__ __forceinline__ v4u pkh8_(const float* f) { v4u w; w.x = pkh2(f[0], f[1]); w.y = pkh2(f[2], f[3]); w.z = pkh2(f[4], f[5]); w.w = pkh2(f[6], f[7]); return w; }
__device__ __forceinline__ v4u pk8(const float* f) { v4u w; w.x = cvt_pk_bf16(f[0], f[1]); w.y = cvt_pk_bf16(f[2], f[3]); w.z = cvt_pk_bf16(f[4], f[5]); w.w = cvt_pk_bf16(f[6], f[7]); return w; }
__device__ __forceinline__ void ldf8(const float* p, float* f) { const f32x4 a = *(const f32x4*)p, b = *(const f32x4*)(p + 4); f[0] = a[0]; f[1] = a[1]; f[2] = a[2]; f[3] = a[3]; f[4] = b[0]; f[5] = b[1]; f[6] = b[2]; f[7] = b[3]; }

struct EpiLora {
    static constexpr bool PERM = true, AFTER_DRAIN = false;
    unsigned char* ws;
    __device__ __forceinline__ void operator()(const f32x4 (&acc)[2][2][4][2], const Unit& u, int wr, int wc, int fr, int fq) const {
        const int which = u.pn >> 1, row0 = u.pm * BM + wr * 64 + fr, c0 = (u.pn & 1) * 256 + wc * 32 + 8 * fq;
        bf16* const O = (bf16*)(ws + (which == 0 ? AR_W : (which == 1 ? AR_A : (which == 2 ? AR_G : AR_UB))));
#pragma unroll
        for (int ai = 0; ai < 2; ++ai)
#pragma unroll
            for (int m = 0; m < 4; ++m)
#pragma unroll
                for (int bj = 0; bj < 2; ++bj) *(u32x4*)(O + (size_t)(row0 + ai * HALF + m * 16) * RC + c0 + bj * HALF) = pack8(acc[ai][bj][m][0], acc[ai][bj][m][1]);
    }
};
#ifdef RKV_BF16
#define UPR up8
#define PKR pk8
#else
#define UPR uph8
#define PKR pkh8
#endif
__device__ __forceinline__ void ph_rwkv_b2w(const P& p, int layer, int gw, int NGW, int lane) {
    bf16* RW = WSP(bf16, AR_RW); bf16* Am = WSP(bf16, AR_A); bf16* Wm = WSP(bf16, AR_W); const bf16* VR = WSP(bf16, AR_UB); const bf16* VF = WSP(bf16, WS_VF); float* NG = WSP(float, AR_NG);
    const float* vec = p.rwkv_vec + (size_t)layer * 7 * RC; float v0[8], v1[8], v2[8], v3[8], vb[8];
    ldf8(vec + 8 * lane, v0); ldf8(vec + RC + 8 * lane, v1); ldf8(vec + 2 * RC + 8 * lane, v2); ldf8(vec + 3 * RC + 8 * lane, v3); ldf8(p.vres_b + 8 * lane, vb);
    for (int t = gw; t < T; t += NGW) {
        bf16* row = RW + (size_t)t * LDRW;
        float k[8], a[8], w[8]; UPR(*(const v4u*)(row + 512 + 8 * lane), k); up8(*(const v4u*)(Am + (size_t)t * RC + 8 * lane), a); up8(*(const v4u*)(Wm + (size_t)t * RC + 8 * lane), w);
        const float gt = lane < 24 ? bf2f(row[LBLK + 320 + lane]) : 0.f;
        float kk[8], ss = 0.f;
#pragma unroll
        for (int i = 0; i < 8; ++i) {
            a[i] = fsig(a[i] + v1[i]);
            const float nx = -(w[i] + v0[i]), sp = fmaxf(nx, 0.f) + __logf(1.f + __expf(-fabsf(nx))), e = __expf(-sp - 0.5f); w[i] = 1.f - __expf(-e);
            kk[i] = k[i] * v2[i]; ss += kk[i] * kk[i]; }
        ss = sum8(ss); const float nrm = sqrtf(ss), inv = 1.f / (nrm > 1e-12f ? nrm : 1e-12f);
#pragma unroll
        for (int i = 0; i < 8; ++i) { kk[i] *= inv; k[i] = k[i] * (1.f + (a[i] - 1.f) * v3[i]); a[i] *= kk[i]; }
        if (layer == 1) { float vr[8], vv[8], vf[8]; up8(*(const v4u*)(VR + (size_t)t * RC + 8 * lane), vr); UPR(*(const v4u*)(row + 1024 + 8 * lane), vv); UPR(*(const v4u*)(VF + (size_t)t * RC + 8 * lane), vf);
#pragma unroll
            for (int i = 0; i < 8; ++i) vv[i] = vv[i] + (vf[i] - vv[i]) * fsig(vr[i] + vb[i]);
            *(v4u*)(row + 1024 + 8 * lane) = PKR(vv); }
        VM_WAIT();
        if (lane < 24) NG[(size_t)t * 24 + lane] = fsig(gt);
        *(v4u*)(row + LBLK + 8 * lane) = pkh8(kk); *(v4u*)(row + 512 + 8 * lane) = PKR(k);
        *(v4u*)(Am + (size_t)t * RC + 8 * lane) = pkh8(a); *(v4u*)(Wm + (size_t)t * RC + 8 * lane) = pkh8(w);
    }
}
__device__ __forceinline__ void ph_rwkv_postw(const P& p, int layer, int gw, int NGW, int lane) {
    const bf16* RW = WSP(bf16, AR_RW); const bf16* Y = WSP(bf16, AR_UB); const bf16* Gm = WSP(bf16, AR_G); bf16* YO = WSP(bf16, AR_A);
    const float* vec = p.rwkv_vec + (size_t)layer * 7 * RC; float v4_[8], v5[8], v6[8]; ldf8(vec + 4 * RC + 8 * lane, v4_); ldf8(vec + 5 * RC + 8 * lane, v5); ldf8(vec + 6 * RC + 8 * lane, v6);
    for (int t = gw; t < T; t += NGW) {
        const bf16* row = RW + (size_t)t * LDRW;
        float y[8], r[8], k[8], v[8], g[8]; up8(*(const v4u*)(Y + (size_t)t * RC + 8 * lane), y); UPR(*(const v4u*)(row + 8 * lane), r); UPR(*(const v4u*)(row + 512 + 8 * lane), k);
        UPR(*(const v4u*)(row + 1024 + 8 * lane), v); up8(*(const v4u*)(Gm + (size_t)t * RC + 8 * lane), g);
        float s = 0.f, bon = 0.f;
#pragma unroll
        for (int i = 0; i < 8; ++i) { s += y[i]; bon += r[i] * k[i] * v4_[i]; }
        const float m = sum8(s) * (1.f / 64.f); bon = sum8(bon);
        float q = 0.f;
#pragma unroll
        for (int i = 0; i < 8; ++i) { y[i] -= m; q += y[i] * y[i]; }
        const float rstd = 1.f / sqrtf(sum8(q) * (1.f / 64.f) + GN_EPS);
#pragma unroll
        for (int i = 0; i < 8; ++i) y[i] = (y[i] * rstd * v5[i] + v6[i] + bon * v[i]) * g[i];
        *(v4u*)(YO + (size_t)t * RC + 8 * lane) = pk8(y);
    }
}
__device__ __forceinline__ void ph_convw(const P& p, int layer, int gw, int NGW, int lane, int tid, LAS unsigned char* lds) {
    const bf16* UB = WSP(bf16, AR_UB); bf16* CO = WSP(bf16, AR_CO);
    const float* cw = p.conv_w + (size_t)layer * CONV_K * CONV_CH; const float* cv = p.conv_vec + (size_t)layer * 3 * CONV_CH;
    LAS float* wl = (LAS float*)lds;
    for (int i = tid; i < CONV_K * CONV_CH; i += NTHREADS) wl[i] = cw[i];
    __syncthreads();
    float b0[8], g1[8], b2[8]; ldf8(cv + 8 * lane, b0); ldf8(cv + CONV_CH + 8 * lane, g1); ldf8(cv + 2 * CONV_CH + 8 * lane, b2);
    for (int t = gw; t < T; t += NGW) {
        const int pos = t % SEQ, j0 = pos >= 30 ? 0 : 30 - pos;
        float a[8];
#pragma unroll
        for (int i = 0; i < 8; ++i) a[i] = b0[i];
        for (int j = j0; j < CONV_K; ++j) { float u[8]; up8(*(const v4u*)(UB + (size_t)(t - 30 + j) * CONV_CH + 8 * lane), u);
            const f32x4 w0 = *(const LAS f32x4*)(wl + j * CONV_CH + 8 * lane), w1 = *(const LAS f32x4*)(wl + j * CONV_CH + 8 * lane + 4);
#pragma unroll
            for (int i = 0; i < 4; ++i) { a[i] += u[i] * w0[i]; a[4 + i] += u[4 + i] * w1[i]; } }
        float s = 0.f;
#pragma unroll
        for (int i = 0; i < 8; ++i) s += a[i];
        const float mean = wave_sum(s, lane) * (1.f / CONV_CH); float q = 0.f;
#pragma unroll
        for (int i = 0; i < 8; ++i) { a[i] -= mean; q += a[i] * a[i]; }
        const float rstd = 1.f / sqrtf(wave_sum(q, lane) * (1.f / CONV_CH) + LN_EPS);
#pragma unroll
        for (int i = 0; i < 8; ++i) { const float y = a[i] * rstd * g1[i] + b2[i]; a[i] = y * fsig(y); }
        *(v4u*)(CO + (size_t)t * CONV_CH + 8 * lane) = pk8(a);
    }
    __syncthreads();
}
__device__ __forceinline__ void ph_cmp2w(const P& p, int layer, int gw, int NGW, int lane, LAS float* hl  ) {
    const bf16* Z = WSP(bf16, AR_HID); const float* pec = (const float*)(p.ws + WS_W + (size_t)layer * SZ_LAYERW + OFF_PEC);
    for (int it = gw; it < 2 * BATCH * NKV * NC; it += NGW) {
        const int i = it % NC, r = it / NC, bg = r % (BATCH * NKV), which = r / (BATCH * NKV);
        const bf16* z1 = Z + ((size_t)which * (BATCH * NKV * 512) + (size_t)bg * 512 + i) * 256; const bf16* z2 = z1 + 256 + 128;
#pragma unroll
        for (int jj = 0; jj < 2; ++jj) { const int j = lane + 64 * jj; const float x = bf2f(z1[j]) + bf2f(z2[j]) + pec[which * 128 + j];
            const float e = __expf(fminf(2.f * 0.7978845608028654f * (x + 0.044715f * x * x * x), 30.f)); hl[j] = 0.5f * x * (1.f + (e - 1.f) / (e + 1.f)); }
        LDS_WAIT(); asm volatile("" ::: "memory");
        const float* w2 = p.cmp_w2 + (size_t)(layer * 2 + which) * 128 * 64 + lane; float o = 0.f;
#pragma unroll 8
        for (int j = 0; j < 128; ++j) o += hl[j] * w2[j * 64];
        if (which == 0) {
            const float rs = 1.f / sqrtf(wave_sum(o * o, lane) * (1.f / 64.f) + RMS_EPS); o = o * rs * p.qk_g[(layer * 4 + 1) * 64 + lane];
            const float other = bperm_f(o, lane ^ 32); float cs, sn; rope_cs(16 * i + 31, lane & 31, cs, sn);
            o = lane < 32 ? o * cs - other * sn : o * cs + other * sn;
            WSP(bf16, AR_KC)[(((size_t)bg * 8 + (lane >> 3)) * 512 + i) * 8 + (lane & 7)] = f2bf(o);
        } else { bf16* vt = WSP(bf16, AR_VCT) + (size_t)bg * 64 * 512 + lane * 8;
            vt[(size_t)((i >> 5) * 4 + ((i & 15) >> 2)) * 512 + (i & 3) + 4 * ((i >> 4) & 1)] = f2bf(o); if (i == 0) vt[(size_t)((NC >> 5) * 4 + ((NC & 15) >> 2)) * 512 + (NC & 3) + 4 * ((NC >> 4) & 1)] = 0; }
        LDS_WAIT(); asm volatile("" ::: "memory");
    }
}

struct MapPlain { bf16* base; int K; __device__ __forceinline__ bf16* operator()(int col) const { return base + (size_t)col * K; } };
struct MapGlu { bf16* base; int K, ff; __device__ __forceinline__ bf16* operator()(int col) const { return base + (size_t)glu_dest(col, ff) * K; } };
struct MapWin { unsigned char* wl; int layer; __device__ __forceinline__ bf16* operator()(int col) const { int which; const int r = win_dest(col, layer, which); const size_t off = (which ? OFF_WG : OFF_WIN) + (size_t)(r < 0 ? 0 : r) * DM * 2; return r < 0 ? nullptr : (bf16*)(wl + off); } };
template <class Map>
__device__ __forceinline__ void transpose_item(const float* W, int K, int N, const Map& mp, LAS float* scr, int item, int lane) {
    const int nblk = (N + 31) / 32, kb = item / nblk, nb = item % nblk, k0 = 64 * kb, n0 = 32 * nb;
    const int col = n0 + (lane & 31);
#pragma unroll 8
    for (int i = 0; i < 32; ++i) { const int kk = 2 * i + (lane >> 5); scr[kk * 33 + (lane & 31)] = col < N ? W[(size_t)(k0 + kk) * N + col] : 0.f; }
    LDS_WAIT(); asm volatile("" ::: "memory");
    const int c = lane & 7;
#pragma unroll
    for (int j = 0; j < 4; ++j) { const int n = (lane >> 3) + 8 * j; const LAS float* s = scr + (8 * c) * 33 + n;
        v4u o; o.x = (unsigned)f2bf(s[0]) | ((unsigned)f2bf(s[33]) << 16); o.y = (unsigned)f2bf(s[66]) | ((unsigned)f2bf(s[99]) << 16);
        o.z = (unsigned)f2bf(s[132]) | ((unsigned)f2bf(s[165]) << 16); o.w = (unsigned)f2bf(s[198]) | ((unsigned)f2bf(s[231]) << 16);
        if (n0 + n < N) { bf16* d = mp(n0 + n); if (d) *(v4u*)(d + k0 + 8 * c) = o; } }
    LDS_WAIT(); asm volatile("" ::: "memory");
}
template <class Map>
__device__ __forceinline__ bool conv_job(int& r, const float* W, int K, int N, const Map& mp, LAS float* scr, int lane) {
    const int items = (K / 64) * ((N + 31) / 32);
    if (r < items) { transpose_item(W, K, N, mp, scr, r, lane); return true; }
    r -= items; return false;
}

__device__ __forceinline__ void rms_row(const P& p, const float* xrow, const float* g, bf16* orow, int lane, bool route, int t, unsigned long long& c0, unsigned long long& c1) {
    const f32x4* xr = (const f32x4*)xrow + lane; const f32x4* gr = (const f32x4*)g + lane;
    f32x4 v[DM / 256]; float ss = 0.f;
#pragma unroll
    for (int j = 0; j < DM / 256; ++j) { v[j] = xr[64 * j]; ss += (v[j].x * v[j].x + v[j].y * v[j].y) + (v[j].z * v[j].z + v[j].w * v[j].w); }
    const float rs = 1.f / sqrtf(wave_sum(ss, lane) * (1.f / DM) + RMS_EPS);
    v2u* o8 = (v2u*)orow + lane;
#pragma unroll
    for (int j = 0; j < DM / 256; ++j) { const f32x4 gg = gr[64 * j]; v[j].x *= rs * gg.x; v[j].y *= rs * gg.y; v[j].z *= rs * gg.z; v[j].w *= rs * gg.w;
        v2u w; w.x = cvt_pk_bf16(v[j].x, v[j].y); w.y = cvt_pk_bf16(v[j].z, v[j].w); o8[64 * j] = w; }
    if (route) {
        float lg[NEXP];
#pragma unroll
        for (int e = 0; e < NEXP; ++e) lg[e] = 0.f;
#pragma unroll
        for (int j = 0; j < DM / 256; ++j) { const float* rw = p.router_w + (size_t)(4 * (lane + 64 * j)) * NEXP;
#pragma unroll
            for (int e = 0; e < NEXP; ++e) lg[e] += v[j].x * rw[e] + v[j].y * rw[NEXP + e] + v[j].z * rw[2 * NEXP + e] + v[j].w * rw[3 * NEXP + e]; }
#pragma unroll
        for (int e = 0; e < NEXP; ++e) lg[e] = wave_sum(lg[e], lane) + p.router_b[e];
        int e0 = 0; float l0 = lg[0];
#pragma unroll
        for (int e = 1; e < NEXP; ++e) if (lg[e] > l0) { l0 = lg[e]; e0 = e; }
        int e1 = -1; float l1 = -3e38f;
#pragma unroll
        for (int e = 0; e < NEXP; ++e) if (e != e0 && lg[e] > l1) { l1 = lg[e]; e1 = e; }
        e0 = __builtin_amdgcn_readfirstlane(e0); e1 = __builtin_amdgcn_readfirstlane(e1);
        const int r0 = (int)((c0 >> (8 * e0)) & 255ull), r1 = (int)((c1 >> (8 * e1)) & 255ull);
        c0 += 1ull << (8 * e0); c1 += 1ull << (8 * e1);
        if (lane == 0) { const float w0 = 1.f / (1.f + expf(l1 - l0));
            WSP(int, AR_RTE)[t] = e0 | (e1 << 8) | (r0 << 16) | (r1 << 24); float* rw = WSP(float, AR_RTW) + (size_t)t * 2; rw[0] = w0; rw[1] = 1.f - w0; }
    }
}
__device__ __forceinline__ void copy_row_wave(const bf16* src, bf16* dst, int lane) {
#pragma unroll
    for (int j = 0; j < DM / 512; ++j) ((v4u*)dst)[lane + 64 * j] = ((const v4u*)src)[lane + 64 * j];
}
__device__ __forceinline__ int moe_seg_start(const unsigned* cnt, int e) { int s = 0;
#pragma unroll
    for (int k = 0; k < NEXP; ++k) s += (k < e) ? (int)((cnt[k] + 255u) & ~255u) : 0;
    return s; }

#ifndef PHMASK
#define PHMASK 0xFFFFFFFFu
#endif
#define PHM(k) (((PHMASK) >> (k)) & 1u)
#ifdef PROBE_LO
constexpr int PR_LO = PROBE_LO, PR_HI = PROBE_HI;
#else
constexpr int PR_LO = -1, PR_HI = -1;
#endif
constexpr int NPH = 16, NPHASES = 1 + 2 * NPH;
struct Args { const float* in[29]; float* out; unsigned char* ws; int ph_lo, ph_hi; };

__device__ __forceinline__ bool in_phase(int k, int lo, int hi) { asm volatile("" : "+s"(lo), "+s"(hi)); return lo <= k && k < hi; }
typedef const Args __attribute__((address_space(4)))* CArgsP;
__device__ __forceinline__ void fill_params_k(P& p, CArgsP a) {
    p.x = a->in[0]; p.mix_norm_g = a->in[1]; p.w_in_first = a->in[2]; p.w_in_rest = a->in[3]; p.mu_first = a->in[4]; p.mu_rest = a->in[5]; p.qk_g = a->in[6]; p.cmp_pos = a->in[7];
    p.cmp_w1 = a->in[8]; p.cmp_w2 = a->in[9]; p.nsa_w_o = a->in[10]; p.conv_w = a->in[11]; p.conv_vec = a->in[12]; p.conv_w_o = a->in[13]; p.rwkv_vec = a->in[14]; p.w_up = a->in[15];
    p.a_up = a->in[16]; p.g_up = a->in[17]; p.vres_up = a->in[18]; p.vres_b = a->in[19]; p.rwkv_w_o = a->in[20]; p.w_out = a->in[21]; p.ffn_norm_g = a->in[22]; p.dense_gu = a->in[23];
    p.dense_down = a->in[24]; p.router_w = a->in[25]; p.router_b = a->in[26]; p.moe_gu = a->in[27]; p.moe_down = a->in[28]; p.out = a->out; p.ws = a->ws;
}
__global__ void __launch_bounds__(NTHREADS, 2) mk_fwd(Args args) {
    extern __shared__ __attribute__((aligned(16))) unsigned char lds_raw[];
    LAS unsigned char* lds = (LAS unsigned char*)lds_raw;
    const int wave0 = __builtin_amdgcn_readfirstlane((int)threadIdx.x >> 6);
    const int tid = wave0 * 64 + lane_id_opaque();
    unsigned* ctl = (unsigned*)(args.ws + WS_CTL);
    for (int u = tid; u < (LDS_BYTES - LDSCTL_OFF) / 4; u += NTHREADS) ((LAS unsigned*)(lds + LDSCTL_OFF))[u] = 0u;
    __syncthreads();
    const int lo = args.ph_lo, hi = args.ph_hi;
    XcdBarrier bar; bar.bar = ctl + CW_BAR; bar.x = 0; bar.st = nullptr;
    if (hi - lo > 1) { bar.x = xb_xcc_id(); bar.st = (volatile LAS unsigned*)(lds + MISC_OFF) + 8; if (tid == 0) (void)xb_add(ctl + CW_BAR + XB_XCNT(bar.x), 1u); }
#define IN(k) (in_phase((k), lo, hi) && (PR_LO < 0 || (st == 0 ? (k) <= PR_HI : (st == 1 ? ((k) >= PR_LO && (k) <= PR_HI) : (k) > PR_HI))))
#define MKP unsigned long long cdum0 = 0ull, cdum1 = 0ull; (void)cdum0; (void)cdum1; CArgsP ap_ = (CArgsP)__builtin_amdgcn_kernarg_segment_ptr(); asm volatile("" : "+s"(ap_)); P p; fill_params_k(p, ap_); int w0_ = wave0; asm volatile("" : "+s"(w0_)); int tid = w0_ * 64 + lane_id_opaque(); asm volatile("" : "+v"(tid)); const int lane = tid & 63, wave = __builtin_amdgcn_readfirstlane(tid >> 6); int G = gridDim.x, bid = blockIdx.x; asm volatile("" : "+s"(G), "+s"(bid)); unsigned* ctl = WSP(unsigned, WS_CTL); const long gtid = (long)bid * NTHREADS + tid, NT = (long)G * NTHREADS; const int gw = bid * NWAVES + wave, NGW = G * NWAVES; LAS float* scrw = (LAS float*)(lds + wave * 16384); (void)gtid; (void)NT; (void)gw; (void)NGW; (void)scrw; (void)lane; (void)ctl
#define SEAM(k) do { if ((k) + 1 < hi) { int w_ = wave0; asm volatile("" : "+s"(w_)); xcd_barrier(bar, w_ * 64 + lane_id_opaque()); } } while (0)

    for (int st = 0; st < (PR_LO >= 0 ? 3 : 1); ++st) {
    if (PHM(16) && IN(0)) { MKP;
        constexpr int IT_WIN0 = (DM / 64) * ((N_IN_FIRST + 31) / 32), IT_WIN1 = (DM / 64) * ((N_IN_REST + 31) / 32), IT_WO = (512 / 64) * (DM / 32), IT_WOUT = (DM / 64) * (DM / 32);
        constexpr int total = IT_WIN0 + IT_WIN1 + 6 * IT_WO + 2 * IT_WOUT + (DM / 64) * (2 * DENSE_FF / 32) + (DENSE_FF / 64) * (DM / 32);
        bf16* wl0 = WSP(bf16, WS_W); bf16* wl1 = WSP(bf16, WS_W + SZ_LAYERW);
#define WOFF(b, o) ((bf16*)((unsigned char*)(b) + (o)))
        for (int it = gw; it < total; it += NGW) {
            int r = it;
            if (conv_job(r, p.w_in_first, DM, N_IN_FIRST, MapWin{(unsigned char*)wl0, 0}, scrw, lane)) continue;
            if (conv_job(r, p.w_in_rest, DM, N_IN_REST, MapWin{(unsigned char*)wl1, 1}, scrw, lane)) continue;
            if (conv_job(r, p.nsa_w_o, 512, DM, MapPlain{WOFF(wl0, OFF_WO3), 512}, scrw, lane)) continue;
            if (conv_job(r, p.rwkv_w_o, 512, DM, MapPlain{WOFF(wl0, OFF_WO3) + (size_t)DM * 512, 512}, scrw, lane)) continue;
            if (conv_job(r, p.conv_w_o, 512, DM, MapPlain{WOFF(wl0, OFF_WO3) + (size_t)2 * DM * 512, 512}, scrw, lane)) continue;
            if (conv_job(r, p.nsa_w_o + (size_t)512 * DM, 512, DM, MapPlain{WOFF(wl1, OFF_WO3), 512}, scrw, lane)) continue;
            if (conv_job(r, p.rwkv_w_o + (size_t)512 * DM, 512, DM, MapPlain{WOFF(wl1, OFF_WO3) + (size_t)DM * 512, 512}, scrw, lane)) continue;
            if (conv_job(r, p.conv_w_o + (size_t)512 * DM, 512, DM, MapPlain{WOFF(wl1, OFF_WO3) + (size_t)2 * DM * 512, 512}, scrw, lane)) continue;
            if (conv_job(r, p.w_out, DM, DM, MapPlain{WOFF(wl0, OFF_WOUT), DM}, scrw, lane)) continue;
            if (conv_job(r, p.w_out + (size_t)DM * DM, DM, DM, MapPlain{WOFF(wl1, OFF_WOUT), DM}, scrw, lane)) continue;
            if (conv_job(r, p.dense_gu, DM, 2 * DENSE_FF, MapGlu{WSP(bf16, WS_DGU), DM, DENSE_FF}, scrw, lane)) continue;
            conv_job(r, p.dense_down, DENSE_FF, DM, MapPlain{WSP(bf16, WS_DDN), DENSE_FF}, scrw, lane);
        }
        for (int l = 0; l < 2; ++l) {
            unsigned char* wlb = p.ws + WS_W + (size_t)l * SZ_LAYERW;
            bf16* win = (bf16*)(wlb + OFF_WIN);
            for (long i = gtid; i < 512L * DM; i += NT) { const int w = (int)(i / DM); const bool src = w < 288 || (w < 320 && l == 1) || (w >= 320 && w < 344); if (!src) win[(size_t)(3840 + w) * DM + i % DM] = 0; }
            bf16* lw = (bf16*)(wlb + OFF_LW);
            for (long i = gtid; i < 2048L * 384; i += NT) { const int n = (int)(i / 384), k = (int)(i % 384), blk = n >> 9, c = n & 511; float v = 0.f;
                if (blk == 0 && k < 64) v = p.w_up[((size_t)l * 64 + k) * RC + c]; else if (blk == 1 && k >= 64 && k < 128) v = p.a_up[((size_t)l * 64 + k - 64) * RC + c];
                else if (blk == 2 && k >= 128 && k < 288) v = p.g_up[((size_t)l * 160 + k - 128) * RC + c]; else if (blk == 3 && k >= 288 && k < 320 && l == 1) v = p.vres_up[(size_t)(k - 288) * RC + c];
                lw[i] = f2bf(v); }
            bf16* cw1 = (bf16*)(wlb + OFF_CW1);
            for (long i = gtid; i < 2L * 256 * 1024; i += NT) { const int k = (int)(i % 1024), n = (int)((i / 1024) % 256), which = (int)(i / (256 * 1024));
                cw1[i] = f2bf(p.cmp_w1[((size_t)(l * 2 + which) * 2048 + (n < 128 ? k : 1024 + k)) * 128 + (n & 127)]); }
            float* pec = (float*)(wlb + OFF_PEC);
            for (long i = gtid; i < 256; i += NT) { const int which = (int)(i >> 7), n = (int)(i & 127); const float* pe = p.cmp_pos + (size_t)(l * 2 + which) * 2048; const float* w1 = p.cmp_w1 + (size_t)(l * 2 + which) * 2048 * 128 + n;
                float s = 0.f; for (int k = 0; k < 2048; ++k) s += pe[k] * w1[(size_t)k * 128]; pec[i] = s; }
        }
        SEAM(0);
    }

    for (int layer = 0; layer < 2; ++layer) {
        const int pb = 1 + layer * NPH;
        if (PHM(0) && IN(pb + 0)) { MKP;
            const float* xin = layer == 0 ? p.x : p.out;
            for (int m = gw; m < T; m += NGW) rms_row(p, xin + (size_t)m * DM, p.mix_norm_g + (size_t)layer * DM, WSP(bf16, WS_H) + (size_t)m * DM, lane, false, m, cdum0, cdum1);
            SEAM(pb + 0);
        }
        if (PHM(1) && IN(pb + 1)) { MKP;
            Gemm g{WSP(bf16, WS_H), (const bf16*)(p.ws + WS_W + (size_t)layer * SZ_LAYERW + OFF_WIN), T, NPROJ, DM}; SOrder S; S.init(T, NPROJ, G, bid);
            EpiProj E{p.ws};
            pg8::gemm_phase<EpiProj, SOrder, true, true>(lds, g, S, E, tid);
            SEAM(pb + 1);
        }
        if (PHM(2) && IN(pb + 2)) { MKP;
            { Gemm g{WSP(bf16, AR_CKV), (const bf16*)(p.ws + WS_W + (size_t)layer * SZ_LAYERW + OFF_CW1), 2 * BATCH * NKV * 512, 512, 1024, 0}; StackOrder S{BATCH * NKV * 512 / 256, 1, 2, G, bid};
              EpiStore E{WSP(bf16, AR_HID), 256, 1};
              pg8::gemm_phase<EpiStore, StackOrder, true, true>(lds, g, S, E, tid); }
            ph_shift(p, layer, gtid, NT); ph_nsa_prep(p, layer, gtid, NT); ph_vtrans(p, gtid, NT);
            ph_convw(p, layer, gw, NGW, lane, tid, lds);
            SEAM(pb + 2); }
        if (PHM(3) && IN(pb + 3)) { MKP;
#ifndef LORA_NAIVE
            { Gemm g{WSP(bf16, WS_LB), (const bf16*)(p.ws + WS_W + (size_t)layer * SZ_LAYERW + OFF_LW), T, 2048, 384, 0}; SOrder S; S.init(T, 2048, G, bid);
              EpiLora E{p.ws};
              pg8::gemm_phase<EpiLora, SOrder, false, true>(lds, g, S, E, tid); }
#else
            { bf16* RW = WSP(bf16, AR_RW); bf16* Wm = WSP(bf16, AR_W); bf16* Am = WSP(bf16, AR_A); bf16* Gm = WSP(bf16, AR_G); const bf16* VF = WSP(bf16, WS_VF);
              const float* vec = p.rwkv_vec + (size_t)layer * 7 * RC; const float* wup = p.w_up + (size_t)layer * 64 * RC; const float* aup = p.a_up + (size_t)layer * 64 * RC; const float* gup = p.g_up + (size_t)layer * 160 * RC;
              for (long it = gtid; it < (long)T * RC; it += NT) { const int t = (int)(it / RC), c = (int)(it % RC); bf16* row = RW + (size_t)t * LDRW; const bf16* L = row + LBLK;
                  float wl = vec[c], alin = vec[RC + c], g = 0.f;
                  for (int j = 0; j < 64; ++j) { wl += bf2f(L[j]) * bf2f(f2bf(wup[j * RC + c])); alin += bf2f(L[64 + j]) * bf2f(f2bf(aup[j * RC + c])); }
                  for (int j = 0; j < 160; ++j) g += bf2f(L[128 + j]) * bf2f(f2bf(gup[j * RC + c]));
                  const float nx = -wl, sp = fmaxf(nx, 0.f) + __logf(1.f + __expf(-fabsf(nx))), e = __expf(-sp - 0.5f);
                  Wm[it] = f2bf(1.f - __expf(-e)); Am[it] = f2bf(fsig(alin)); Gm[it] = f2bf(g);
                  if (layer == 1) { float vl = p.vres_b[c]; for (int j = 0; j < 32; ++j) vl += bf2f(L[288 + j]) * bf2f(f2bf(p.vres_up[j * RC + c]));
                      const float v = bf2f(row[1024 + c]), vf = bf2f(VF[it]); row[1024 + c] = f2bf(v + (vf - v) * fsig(vl)); } } }
#endif
            SEAM(pb + 3); }
        if (PHM(4) && IN(pb + 4)) { MKP; ph_rwkv_b2w(p, layer, gw, NGW, lane); ph_cmp2w(p, layer, gw, NGW, lane, (LAS float*)(lds + wave * 512)); SEAM(pb + 4); }
        if (PHM(5) && IN(pb + 5)) { MKP;
            { LAS unsigned char* wl = lds + wave * AW_BYTES; constexpr int NSC = BATCH * 8 * 16, NIT = BATCH * NKV * (SEQ / 16);
#ifndef SCAN_QUEUE
              if (wave < 4) {
                  if (G * 4 == NSC && (G & 7) == 0) scan_unit(p, (bid & 7) * (NSC / 8) + (bid >> 3) * 4 + wave, lane, wl);
                  else for (int u = bid * 4 + wave; u < NSC; u += G * 4) scan_unit(p, u, lane, wl); }
#endif
              const int xme = (int)(xb_xcc_id() & 7u);
              for (int qq = 0; qq < 8; ++qq) { const int qx = (xme + qq) & 7; unsigned* head = ctl + CW_ATT + ((layer * 3 + st) * 8 + qx) * 16;
                  for (;;) { int it = 0; if (lane == 0) it = (int)atomicAdd(head, 1u); it = __builtin_amdgcn_readfirstlane(it); if (it >= NIT / 8) break;
                      const int bg = 2 * qx + it / (SEQ / 16), t16 = (SEQ / 16 - 1) - it % (SEQ / 16);
                      nsa_attn_item(p, bg * (SEQ / 16) + t16, lane, wl); } } }
 SEAM(pb + 5); }
        if (PHM(6) && IN(pb + 6)) { MKP; ph_rwkv_postw(p, layer, gw, NGW, lane); SEAM(pb + 6); }
        if (PHM(7) && IN(pb + 7)) { MKP;
            Gemm g{WSP(bf16, AR_QB), (const bf16*)(p.ws + WS_W + (size_t)layer * SZ_LAYERW + OFF_WO3), 3 * T, 3 * DM, 512}; StackOrder S{T / 256, DM / 256, 3, G, bid};
            EpiStore E{WSP(bf16, AR_OBUF), DM, DM / 256};
            pg8::gemm_phase<EpiStore, StackOrder, true, true>(lds, g, S, E, tid);
            { const float* xin = layer == 0 ? p.x : p.out;
              for (int m = gw; m < T; m += NGW) rms_row(p, xin + (size_t)m * DM, p.mix_norm_g + (size_t)layer * DM, WSP(bf16, WS_H) + (size_t)m * DM, lane, false, m, cdum0, cdum1); }
            SEAM(pb + 7);
        }
        if (PHM(8) && IN(pb + 8)) { MKP;
            Gemm g{WSP(bf16, WS_H), (const bf16*)(p.ws + WS_W + (size_t)layer * SZ_LAYERW + OFF_WG), T, 3 * DM, DM}; GateOrder S{T / 256, DM / 256, G, bid};
            EpiGate E{p.ws, DM / 256};
            pg8::gemm_phase<EpiGate, GateOrder, true, true>(lds, g, S, E, tid);
            SEAM(pb + 8);
        }
        if (PHM(9) && IN(pb + 9)) { MKP;
            Gemm g{WSP(bf16, AR_MIX), (const bf16*)(p.ws + WS_W + (size_t)layer * SZ_LAYERW + OFF_WOUT), T, DM, DM}; SOrder S; S.init(T, DM, G, bid);
            EpiResid E{layer == 0 ? p.x : p.out, p.out};
            pg8::gemm_phase<EpiResid, SOrder, true, true>(lds, g, S, E, tid);
            SEAM(pb + 9);
        }
        if (PHM(10) && IN(pb + 10)) { MKP;
            unsigned long long c0 = 0ull, c1 = 0ull;
            for (int m = gw; m < T; m += NGW) rms_row(p, p.out + (size_t)m * DM, p.ffn_norm_g + (size_t)layer * DM, WSP(bf16, WS_H) + (size_t)m * DM, lane, layer == 1, m, c0, c1);
            if (layer == 1 && lane < 16) {
                const unsigned cn = (unsigned)(((lane < 8 ? c0 : c1) >> (8 * (lane & 7))) & 255ull);
                WSP(unsigned, AR_WBASE)[(size_t)gw * 16 + lane] = atomicAdd(ctl + CW_CNT + lane * 64, cn); }
            if (layer == 1) { int* rt = WSP(int, AR_RTOK); for (long i = gtid; i < 2L * MOE_ROWS; i += NT) rt[i] = -1; }
            SEAM(pb + 10);
        }
        if (layer == 0) {
            if (PHM(11) && IN(pb + 11)) { MKP;
                Gemm g{WSP(bf16, WS_H), WSP(bf16, WS_DGU), T, 2 * DENSE_FF, DM}; SOrder S; S.init(T, 2 * DENSE_FF, G, bid);
                EpiSwiglu E{WSP(bf16, AR_ACT), DENSE_FF, 2 * DENSE_FF / 256};
                pg8::gemm_phase<EpiSwiglu, SOrder, true, true>(lds, g, S, E, tid);
                SEAM(pb + 11);
            }
            if (PHM(12) && IN(pb + 12)) { MKP;
                Gemm g{WSP(bf16, AR_ACT), WSP(bf16, WS_DDN), T, DM, DENSE_FF}; SOrder S; S.init(T, DM, G, bid);
                EpiResid E{p.out, p.out};
                pg8::gemm_phase<EpiResid, SOrder, true, true>(lds, g, S, E, tid);
                SEAM(pb + 12);
            }
        } else {
            if (PHM(11) && IN(pb + 11)) { MKP;
                const int ig = (DM / 64) * (2 * EXPERT_FF / 32), id = (EXPERT_FF / 64) * (DM / 32);
                for (int it = gw; it < NEXP * (ig + id); it += NGW) { const int e = it / (ig + id); int r = it % (ig + id);
                    if (conv_job(r, p.moe_gu + (size_t)e * DM * 2 * EXPERT_FF, DM, 2 * EXPERT_FF, MapGlu{WSP(bf16, AR_MGU) + (size_t)e * 2 * EXPERT_FF * DM, DM, EXPERT_FF}, scrw, lane)) continue;
                    conv_job(r, p.moe_down + (size_t)e * EXPERT_FF * DM, EXPERT_FF, DM, MapPlain{WSP(bf16, AR_MDN) + (size_t)e * DM * EXPERT_FF, EXPERT_FF}, scrw, lane); }
                int* rtok = WSP(int, AR_RTOK); float* rww = WSP(float, AR_RW8); int* trow = WSP(int, AR_TROW);
                int segv = 0; { const int pc = lane < 16 ? (int)((ctl[CW_CNT + lane * 64] + 255u) & ~255u) : 0;
#pragma unroll
                    for (int k = 0; k < 8; ++k) { const int ck = bperm_i(pc, (lane & 8) + k); segv += (k < (lane & 7)) ? ck : 0; } }
                for (int tb = gw * 64; tb < T; tb += NGW * 64) {
                    const int t = tb + lane; const int ee = WSP(int, AR_RTE)[t], e0 = ee & 255, e1 = (ee >> 8) & 255, r0 = (ee >> 16) & 255, r1 = (ee >> 24) & 255;
                    const float* w = WSP(float, AR_RTW) + (size_t)t * 2; const unsigned* wb = WSP(unsigned, AR_WBASE) + (size_t)(t % NGW) * 16;
                    const int row0 = bperm_i(segv, e0) + (int)wb[e0] + r0, row1 = bperm_i(segv, 8 + e1) + (int)wb[8 + e1] + r1;
                    rtok[row0] = t; rww[row0] = w[0]; rtok[MOE_ROWS + row1] = t; rww[MOE_ROWS + row1] = w[1]; trow[T + t] = row1;
                    for (int l = 0; l < 64; ++l) copy_row_wave(WSP(bf16, WS_H) + (size_t)(tb + l) * DM, WSP(bf16, AR_XG) + (size_t)__builtin_amdgcn_readlane(row0, l) * DM, lane);
                }
                SEAM(pb + 11);
            }
#pragma unroll
            for (int pass = 0; pass < 2; ++pass) {
                if (PHM(12) && IN(pb + 12 + 2 * pass)) { MKP;
                    Gemm g{WSP(bf16, AR_XG), WSP(bf16, AR_MGU), MOE_ROWS, NEXP * 2 * EXPERT_FF, DM}; MoeOrder S; S.init(ctl + CW_CNT + 8 * 64 * pass, 2 * EXPERT_FF / 256, G, bid);
                    EpiSwiglu E{WSP(bf16, AR_MACT), EXPERT_FF, 2 * EXPERT_FF / 256};
                    pg8::gemm_phase<EpiSwiglu, MoeOrder, true, true>(lds, g, S, E, tid);
                    SEAM(pb + 12 + 2 * pass);
                }
                if (PHM(13) && IN(pb + 13 + 2 * pass)) { MKP;
                    Gemm g{WSP(bf16, AR_MACT), WSP(bf16, AR_MDN), MOE_ROWS, NEXP * DM, EXPERT_FF}; MoeOrder S; S.init(ctl + CW_CNT + 8 * 64 * pass, DM / 256, G, bid);
                    EpiMoeDown E{p.out, WSP(int, AR_RTOK) + (size_t)pass * MOE_ROWS, WSP(float, AR_RW8) + (size_t)pass * MOE_ROWS, DM / 256, (PR_LO >= 0 && st == 0 && pb + 13 + 2 * pass >= PR_LO && pb + 13 + 2 * pass <= PR_HI) ? 0.f : 1.f};
                    pg8::gemm_phase<EpiMoeDown, MoeOrder, true, true>(lds, g, S, E, tid);
                    if (pass == 0) { const int* trow = WSP(int, AR_TROW);
                        for (int t = gw; t < T; t += NGW) copy_row_wave(WSP(bf16, WS_H) + (size_t)t * DM, WSP(bf16, AR_XG) + (size_t)trow[T + t] * DM, lane); }
                    SEAM(pb + 13 + 2 * pass);
                }
            }
        }
    }
    }
#undef IN
#undef SEAM
}

#ifndef MK_ONE_LAUNCH
#define MK_ONE_LAUNCH 1
#endif
extern "C" void kernel_launch(void* const* d_in, const int* in_sizes, int n_in, void* d_out, int out_size, void* d_ws, size_t ws_size, hipStream_t stream) {
    static int grid = 0;
    if (grid == 0) {
        if (n_in != 29 || in_sizes[0] != T * DM || out_size != T * DM || ws_size < WS_END) { fprintf(stderr, "kernel_launch: unexpected shapes / workspace (%d inputs, ws %zu, need %zu)\n", n_in, ws_size, (size_t)WS_END); grid = -1; return; }
        int dev = 0, cus = 0;
        if (hipGetDevice(&dev) != hipSuccess || hipDeviceGetAttribute(&cus, hipDeviceAttributeMultiprocessorCount, dev) != hipSuccess) { grid = -1; return; }
        if (hipFuncSetAttribute((const void*)mk_fwd, hipFuncAttributeMaxDynamicSharedMemorySize, LDS_BYTES) != hipSuccess) { fprintf(stderr, "kernel_launch: hipFuncSetAttribute failed\n"); grid = -1; return; }
        int per_cu = 0;
        if (hipOccupancyMaxActiveBlocksPerMultiprocessor(&per_cu, (const void*)mk_fwd, NTHREADS, LDS_BYTES) != hipSuccess || per_cu < 1) { fprintf(stderr, "kernel_launch: occupancy query says %d\n", per_cu); }
        (void)hipGetLastError();
        grid = cus;
    }
    if (grid < 0) return;
    if (hipMemsetAsync((char*)d_ws + WS_CTL, 0, CTL_BYTES, stream) != hipSuccess) return;
    Args a{};
    for (int i = 0; i < 29; ++i) a.in[i] = (const float*)d_in[i];
    a.out = (float*)d_out; a.ws = (unsigned char*)d_ws;
#if MK_ONE_LAUNCH
    a.ph_lo = 0; a.ph_hi = NPHASES;
    hipLaunchKernelGGL(mk_fwd, dim3(grid), dim3(NTHREADS), LDS_BYTES, stream, a);
#else
    for (int k = 0; k < NPHASES; ++k) {
        if (k >= 1 + 13 && k < 1 + NPH) continue;
        a.ph_lo = k; a.ph_hi = k + 1;
        hipLaunchKernelGGL(mk_fwd, dim3(grid), dim3(NTHREADS), LDS_BYTES, stream, a);
    }
#endif
}
```

```cpp
#include <hip/hip_runtime.h>
#include <cstdio>
#include <cstdint>
#include <cmath>
#include <cstring>
#ifdef HOST_EMU
#define HD
#define DEV_INLINE inline
#else
#define HD __host__ __device__
#define DEV_INLINE __device__ __forceinline__
#endif

typedef unsigned short bf16;
struct alignas(16) U4 { unsigned x, y, z, w; };

#ifdef SMALL_CFG
constexpr int BATCH = 1, SEQ = 1024, DM = 128, DENSE_FF = 256, EXPERT_FF = 256;
#else
constexpr int BATCH = 8, SEQ = 8192, DM = 1024, DENSE_FF = 2816, EXPERT_FF = 3584;
#endif
constexpr int T = BATCH * SEQ;
constexpr int NHEAD = 8, NKV = 2, HG = 4, DH = 64;
constexpr int NC = SEQ / 16 - 1, NS = SEQ / 64, NSEL = 8, WINDOW = 512;
constexpr int CONV_CH = 512, CONV_K = 31, RC = 512;
constexpr int NEXP = 8;
constexpr int NSA_IN = 1304, OFF_CONV = 1304, OFF_GATE = 2328, OFF_RWKV = OFF_GATE + 3 * DM;
constexpr int N_IN_FIRST = OFF_RWKV + 1824, N_IN_REST = OFF_RWKV + 1856;
constexpr int NPROJ = 4352;
constexpr int LDQ = 512, LDKV = 512, LDRW = 2048, LBLK = 1536;
constexpr int MOE_ROWS = T + NEXP * 256;
constexpr float RMS_EPS = 1e-6f, LN_EPS = 1e-5f, GN_EPS = 64e-5f;

constexpr size_t al(size_t x) { return (x + 255) & ~(size_t)255; }
constexpr size_t WS_CTL = 0, CTL_BYTES = 1u << 20;
constexpr size_t SZ_WIN = (size_t)NPROJ * DM * 2, SZ_WG = (size_t)3 * DM * DM * 2, SZ_WO3 = (size_t)3 * DM * 512 * 2, SZ_WOUT = (size_t)DM * DM * 2;
constexpr size_t SZ_LW = (size_t)2048 * 384 * 2, SZ_CW1 = (size_t)2 * 256 * 1024 * 2, SZ_PEC = 1024;
constexpr size_t SZ_LAYERW = SZ_WIN + SZ_WG + SZ_WO3 + SZ_WOUT + SZ_LW + SZ_CW1 + SZ_PEC;
constexpr size_t WS_W = CTL_BYTES;
constexpr size_t OFF_WIN = 0, OFF_WG = SZ_WIN, OFF_WO3 = OFF_WG + SZ_WG, OFF_WOUT = OFF_WO3 + SZ_WO3, OFF_LW = OFF_WOUT + SZ_WOUT, OFF_CW1 = OFF_LW + SZ_LW, OFF_PEC = OFF_CW1 + SZ_CW1;
constexpr size_t WS_DGU = WS_W + 2 * SZ_LAYERW, SZ_DGU = (size_t)2 * DENSE_FF * DM * 2;
constexpr size_t WS_DDN = WS_DGU + SZ_DGU, SZ_DDN = (size_t)DM * DENSE_FF * 2;
constexpr size_t WS_VF = al(WS_DDN + SZ_DDN), SZ_TC = (size_t)T * 512 * 2;
constexpr size_t WS_H = WS_VF + SZ_TC, SZ_H = (size_t)T * DM * 2;
constexpr size_t WS_AR = al(WS_H + SZ_H);
constexpr size_t AR_QB = WS_AR, AR_A = AR_QB + SZ_TC, AR_CO = AR_A + SZ_TC;
constexpr size_t AR_KV = AR_CO + SZ_TC, SZ_KV = (size_t)T * LDKV * 2;
constexpr size_t AR_RW = AR_KV + SZ_KV, SZ_RW = (size_t)T * LDRW * 2;
constexpr size_t AR_W = AR_RW + SZ_RW, AR_G = AR_W + SZ_TC, AR_UB = AR_G + SZ_TC;
constexpr size_t AR_NG = AR_UB + SZ_TC, SZ_NG = (size_t)T * 24 * 4;
constexpr size_t AR_HALO = al(AR_NG + SZ_NG), SZ_HALO = (size_t)(T / 256) * LDRW * 2;
constexpr size_t AR_KC = al(AR_HALO + SZ_HALO), SZ_CMP = (size_t)BATCH * NKV * (SEQ / 16) * 64 * 2;
constexpr size_t AR_VC = AR_KC + SZ_CMP;
constexpr size_t AR_HID = al(AR_VC + SZ_CMP), SZ_HID = (size_t)BATCH * NKV * (SEQ / 16) * 2 * 128 * 4;
constexpr size_t AR_SEL = al(AR_HID + SZ_HID), SZ_SEL = (size_t)T * NKV * 8 * 4;
constexpr size_t AR_INVN = al(AR_SEL + SZ_SEL), SZ_INVN = (size_t)T * 8 * 4;
constexpr size_t AR_VCT = al(AR_INVN + SZ_INVN);
constexpr size_t AR_CKV = al(AR_VCT + SZ_CMP), SZ_CKV = (size_t)2 * T * 128;
constexpr size_t AR_END1 = al(AR_CKV + SZ_CKV * 2);
constexpr size_t WS_VST = WS_H, WS_VWT = WS_H + (size_t)T * 128 * 2, WS_LB = WS_VWT + (size_t)T * 128 * 2, WS_KS8 = WS_LB + (size_t)T * 384 * 2, WS_KW8 = WS_KS8 + (size_t)T * 128 * 2;
constexpr size_t AR_OBUF = AR_KV, SZ_OBUF = (size_t)3 * T * DM * 2;
constexpr size_t AR_MIX = AR_OBUF + SZ_OBUF, SZ_MIX = (size_t)T * DM * 2;
constexpr size_t AR_END2 = AR_MIX + SZ_MIX;
constexpr size_t AR_ACT = WS_AR;
constexpr size_t AR_MGU = WS_AR, SZ_MGU = (size_t)NEXP * 2 * EXPERT_FF * DM * 2;
constexpr size_t AR_MDN = AR_MGU + SZ_MGU, SZ_MDN = (size_t)NEXP * DM * EXPERT_FF * 2;
constexpr size_t AR_XG = al(AR_MDN + SZ_MDN), SZ_XG = (size_t)MOE_ROWS * DM * 2;
constexpr size_t AR_MACT = al(AR_XG + SZ_XG), SZ_MACT = (size_t)MOE_ROWS * EXPERT_FF * 2;
constexpr size_t AR_RTOK = al(AR_MACT + SZ_MACT), SZ_RTOK = (size_t)2 * MOE_ROWS * 4;
constexpr size_t AR_RW8 = al(AR_RTOK + SZ_RTOK);
constexpr size_t AR_TROW = al(AR_RW8 + SZ_RTOK), SZ_TROW = (size_t)2 * T * 4;
constexpr size_t AR_RTE = al(AR_TROW + SZ_TROW);
constexpr size_t AR_RTW = al(AR_RTE + (size_t)T * 4);
constexpr size_t AR_WBASE = al(AR_RTW + (size_t)T * 8);
constexpr size_t AR_END3 = al(AR_WBASE + (size_t)4096 * 16 * 4);
constexpr size_t WS_END = (AR_END1 > AR_END2 ? (AR_END1 > AR_END3 ? AR_END1 : AR_END3) : (AR_END2 > AR_END3 ? AR_END2 : AR_END3));
constexpr int CW_CNT = 1024;
constexpr int CW_ATT = 256;
constexpr int CW_BAR = 4096;

struct P {
    const float *x, *mix_norm_g, *w_in_first, *w_in_rest, *mu_first, *mu_rest, *qk_g, *cmp_pos, *cmp_w1, *cmp_w2, *nsa_w_o, *conv_w, *conv_vec, *conv_w_o,
        *rwkv_vec, *w_up, *a_up, *g_up, *vres_up, *vres_b, *rwkv_w_o, *w_out, *ffn_norm_g, *dense_gu, *dense_down, *router_w, *router_b, *moe_gu, *moe_down;
    float* out; unsigned char* ws;
};
HD inline void fill_params(P& p, const float* const* in, float* out, unsigned char* ws) {
    p.x = in[0]; p.mix_norm_g = in[1]; p.w_in_first = in[2]; p.w_in_rest = in[3]; p.mu_first = in[4]; p.mu_rest = in[5]; p.qk_g = in[6]; p.cmp_pos = in[7];
    p.cmp_w1 = in[8]; p.cmp_w2 = in[9]; p.nsa_w_o = in[10]; p.conv_w = in[11]; p.conv_vec = in[12]; p.conv_w_o = in[13]; p.rwkv_vec = in[14]; p.w_up = in[15];
    p.a_up = in[16]; p.g_up = in[17]; p.vres_up = in[18]; p.vres_b = in[19]; p.rwkv_w_o = in[20]; p.w_out = in[21]; p.ffn_norm_g = in[22]; p.dense_gu = in[23];
    p.dense_down = in[24]; p.router_w = in[25]; p.router_b = in[26]; p.moe_gu = in[27]; p.moe_down = in[28]; p.out = out; p.ws = ws;
}
#define WSP(type, off) ((type*)(p.ws + (off)))

#ifdef HOST_EMU
#define FENCE()
#else
#define FENCE() asm volatile("" ::: "memory")
#endif
HD inline float bf2f(bf16 v) { unsigned u = (unsigned)v << 16; float f; memcpy(&f, &u, 4); return f; }
HD inline bf16 f2bf(float f) { unsigned u; memcpy(&u, &f, 4); return (bf16)((u + 0x7fffu + ((u >> 16) & 1u)) >> 16); }
HD inline float blo(unsigned v) { unsigned u = v << 16; float f; memcpy(&f, &u, 4); return f; }
HD inline float bhi(unsigned v) { unsigned u = v & 0xffff0000u; float f; memcpy(&f, &u, 4); return f; }
#if !defined(SCAN_BF16) && !defined(RKV_BF16)
HD inline bf16 f2h(float f) { return __builtin_bit_cast(unsigned short, (_Float16)f); }
#else
HD inline bf16 f2bf(float f);
HD inline bf16 f2h(float f) { return f2bf(f); }
#endif
HD inline float h2f(bf16 v) { return (float)__builtin_bit_cast(_Float16, v); }
HD inline float sigmoidf_(float x) { return 1.f / (1.f + expf(-x)); }
HD inline float dot64(const float* q, const bf16* kp) {
    const U4* k4 = (const U4*)kp; float s0 = 0.f, s1 = 0.f;
#pragma unroll
    for (int i = 0; i < 8; ++i) { const U4 v = k4[i];
        s0 += q[8 * i + 0] * blo(v.x) + q[8 * i + 2] * blo(v.y) + q[8 * i + 4] * blo(v.z) + q[8 * i + 6] * blo(v.w);
        s1 += q[8 * i + 1] * bhi(v.x) + q[8 * i + 3] * bhi(v.y) + q[8 * i + 5] * bhi(v.z) + q[8 * i + 7] * bhi(v.w); }
    return s0 + s1;
}
HD inline float dot64p(const U4* q, const bf16* kp) {
    const U4* k4 = (const U4*)kp; float s0 = 0.f, s1 = 0.f;
#pragma unroll
    for (int i = 0; i < 8; ++i) { const U4 v = k4[i], w = q[i];
        s0 += blo(w.x) * blo(v.x) + blo(w.y) * blo(v.y) + blo(w.z) * blo(v.z) + blo(w.w) * blo(v.w);
        s1 += bhi(w.x) * bhi(v.x) + bhi(w.y) * bhi(v.y) + bhi(w.z) * bhi(v.z) + bhi(w.w) * bhi(v.w); }
    return s0 + s1;
}
HD inline void ld64(const bf16* kp, float* q) {
    const U4* k4 = (const U4*)kp;
#pragma unroll
    for (int i = 0; i < 8; ++i) { const U4 v = k4[i]; q[8 * i] = blo(v.x); q[8 * i + 1] = bhi(v.x); q[8 * i + 2] = blo(v.y); q[8 * i + 3] = bhi(v.y);
        q[8 * i + 4] = blo(v.z); q[8 * i + 5] = bhi(v.z); q[8 * i + 6] = blo(v.w); q[8 * i + 7] = bhi(v.w); }
}
HD inline void axpy64(float* o, float w, const bf16* vp) {
    const U4* k4 = (const U4*)vp;
#pragma unroll
    for (int i = 0; i < 8; ++i) { const U4 v = k4[i]; o[8 * i] += w * blo(v.x); o[8 * i + 1] += w * bhi(v.x); o[8 * i + 2] += w * blo(v.y); o[8 * i + 3] += w * bhi(v.y);
        o[8 * i + 4] += w * blo(v.z); o[8 * i + 5] += w * bhi(v.z); o[8 * i + 6] += w * blo(v.w); o[8 * i + 7] += w * bhi(v.w); }
}
HD inline void axpy64s(float* o, float w, const bf16* vp) {
    const U4* k4 = (const U4*)vp;
#pragma unroll
    for (int i = 0; i < 8; ++i) { const U4 v = k4[i]; o[8 * i] = w * o[8 * i] + blo(v.x); o[8 * i + 1] = w * o[8 * i + 1] + bhi(v.x); o[8 * i + 2] = w * o[8 * i + 2] + blo(v.y); o[8 * i + 3] = w * o[8 * i + 3] + bhi(v.y);
        o[8 * i + 4] = w * o[8 * i + 4] + blo(v.z); o[8 * i + 5] = w * o[8 * i + 5] + bhi(v.z); o[8 * i + 6] = w * o[8 * i + 6] + blo(v.w); o[8 * i + 7] = w * o[8 * i + 7] + bhi(v.w); }
}
HD inline void st64(bf16* op, const float* o) {
    U4* o4 = (U4*)op;
#pragma unroll
    for (int i = 0; i < 8; ++i) { U4 v; v.x = (unsigned)f2bf(o[8 * i]) | ((unsigned)f2bf(o[8 * i + 1]) << 16); v.y = (unsigned)f2bf(o[8 * i + 2]) | ((unsigned)f2bf(o[8 * i + 3]) << 16);
        v.z = (unsigned)f2bf(o[8 * i + 4]) | ((unsigned)f2bf(o[8 * i + 5]) << 16); v.w = (unsigned)f2bf(o[8 * i + 6]) | ((unsigned)f2bf(o[8 * i + 7]) << 16); o4[i] = v; }
}

HD inline void rope_cs(int pos, int i, float& cs, float& sn) {
    const float c = exp2f(-(float)i * 0.41524101186092f) * 0.15915494309189535f, pf = (float)pos;
    const float prod = pf * c, err = fmaf(pf, c, -prod), fr = (prod - rintf(prod)) + err;
#ifdef HOST_EMU
    cs = cosf(6.283185307179586f * fr); sn = sinf(6.283185307179586f * fr);
#else
    cs = __builtin_amdgcn_cosf(fr); sn = __builtin_amdgcn_sinf(fr);
#endif
}
HD inline int win_dest(int j, int layer, int& which) {
    which = 0;
    if (j < 1280) return j;
    if (j < 1304) return 3840 + 320 + (j - 1280);
    if (j < 1816) { const int cc = j - 1304; return 1280 + 256 * (cc / 128) + cc % 128; }
    if (j < 2328) { const int cc = j - 1816; return 1280 + 256 * (cc / 128) + 128 + cc % 128; }
    if (j < OFF_RWKV) { which = 1; const int gg = j - OFF_GATE, br = gg / DM; return (br == 0 ? 0 : (br == 1 ? 2 * DM : DM)) + gg % DM; }
    const int rr = j - OFF_RWKV;
    if (rr < 1536) return 2304 + rr;
    if (rr < 1824) return 3840 + (rr - 1536);
    if (rr < 1856 && layer == 1) return 3840 + 288 + (rr - 1824);
    return -1;
}
HD inline int glu_dest(int j, int ff) { return j < ff ? 256 * (j / 128) + j % 128 : 256 * ((j - ff) / 128) + 128 + (j - ff) % 128; }

DEV_INLINE void ph_shift(const P& p, int layer, long gtid, long NT) {
    bf16* RW = WSP(bf16, AR_RW); const bf16* HALO = WSP(bf16, AR_HALO); bf16* VF = WSP(bf16, WS_VF); bf16* LB = WSP(bf16, WS_LB);
    const float* mu = layer == 0 ? p.mu_first : p.mu_rest;
    const long n = (long)(T / 256) * (LBLK + 384);
    for (long it = gtid; it < n; it += NT) {
        const int pm = (int)(it / (LBLK + 384)), c = (int)(it % (LBLK + 384));
        int mi = -1, act = 0;
        if (c < LBLK) mi = c;
        else { const int w = c - LBLK; if (w < 288) { mi = 1536 + w; act = w < 64 ? 1 : (w >= 128 ? 2 : 0); } else if (w < 320 && layer == 1) mi = 1824 + (w - 288); }
        if (mi < 0) { for (int r = 0; r < 256; ++r) LB[((size_t)pm * 256 + r) * 384 + (c - LBLK)] = 0; continue; }
        const float m = mu[mi];
        float prev = ((pm * 256) % SEQ == 0) ? 0.f : bf2f(HALO[(size_t)(pm - 1) * LDRW + c]);
        bf16* col = RW + (size_t)pm * 256 * LDRW + c;
        for (int r0 = 0; r0 < 256; r0 += 16) {
            float pv[16];
#pragma unroll
            for (int k = 0; k < 16; ++k) pv[k] = bf2f(col[(size_t)(r0 + k) * LDRW]);
#pragma unroll
            for (int k = 0; k < 16; ++k) { const int r = r0 + k;
                float u = pv[k] + (prev - pv[k]) * m; prev = pv[k];
                if (act == 1) u = tanhf(u); else if (act == 2) u = sigmoidf_(u);
                if (c < LBLK) { col[(size_t)r * LDRW] = f2h(u); if (layer == 0 && c >= 1024) VF[((size_t)pm * 256 + r) * RC + (c - 1024)] = f2h(u); }
                else LB[((size_t)pm * 256 + r) * 384 + (c - LBLK)] = f2bf(u); }
        }
    }
}

DEV_INLINE void ph_nsa_prep(const P& p, int layer, long gtid, long NT) {
    bf16* QB = WSP(bf16, AR_QB); bf16* KV = WSP(bf16, AR_KV);
    const long n = (long)T * 12;
    for (long it = gtid; it < n; it += NT) {
        const int t = (int)(it / 12), s = (int)(it % 12), pos = t % SEQ;
        bf16* ptr; const float* g;
        if (s < 8) { ptr = QB + (size_t)t * LDQ + s * 64; g = p.qk_g + (layer * 4 + 0) * 64; }
        else if (s < 10) { ptr = KV + (size_t)t * LDKV + (s - 8) * 64; g = p.qk_g + (layer * 4 + 2) * 64; }
        else { ptr = KV + (size_t)t * LDKV + 256 + (s - 10) * 64; g = p.qk_g + (layer * 4 + 3) * 64; }
        float v[64]; ld64(ptr, v);
        float ss = 0.f;
#pragma unroll
        for (int i = 0; i < 64; ++i) ss += v[i] * v[i];
        const float rs = 1.f / sqrtf(ss * (1.f / 64.f) + RMS_EPS);
#pragma unroll
        for (int i = 0; i < 64; ++i) v[i] = v[i] * rs * g[i];
#pragma unroll
        for (int i = 0; i < 32; ++i) {
            float cs, sn; rope_cs(pos, i, cs, sn);
            const float x1 = v[i], x2 = v[i + 32]; v[i] = x1 * cs - x2 * sn; v[i + 32] = x2 * cs + x1 * sn;
        }
        if (s < 8) {
#pragma unroll
            for (int i = 0; i < 64; ++i) v[i] *= 0.125f * 1.4426950408889634f; }
        if (s < 8) st64(ptr, v);
        else {
            const int gg = (s - 8) & 1, bq = t / SEQ; bf16* k8 = WSP(bf16, s < 10 ? WS_KS8 : WS_KW8) + (size_t)(bq * NKV + gg) * 8 * SEQ * 8;
#pragma unroll
            for (int dg = 0; dg < 8; ++dg) { U4 w; w.x = (unsigned)f2bf(v[8 * dg]) | ((unsigned)f2bf(v[8 * dg + 1]) << 16); w.y = (unsigned)f2bf(v[8 * dg + 2]) | ((unsigned)f2bf(v[8 * dg + 3]) << 16);
                w.z = (unsigned)f2bf(v[8 * dg + 4]) | ((unsigned)f2bf(v[8 * dg + 5]) << 16); w.w = (unsigned)f2bf(v[8 * dg + 6]) | ((unsigned)f2bf(v[8 * dg + 7]) << 16);
                *(U4*)(k8 + ((size_t)dg * SEQ + pos) * 8) = w; } }
    }
}

DEV_INLINE void ph_vtrans(const P& p, long gtid, long NT) {
    const bf16* KV = WSP(bf16, AR_KV); bf16* VsT = WSP(bf16, WS_VST); bf16* VwT = WSP(bf16, WS_VWT);
    const long n = (long)BATCH * NKV * (SEQ / 8) * 64;
    for (long it = gtid; it < n; it += NT) {
        const int d = (int)(it % 64); long r = it / 64; const int kg = (int)(r % (SEQ / 8)); const int bg = (int)(r / (SEQ / 8)), b = bg / NKV, g = bg % NKV;
        const int kbase = (kg >> 2) * 32 + 4 * (kg & 3);
        const bf16* src = KV + (size_t)(b * SEQ + kbase) * LDKV + g * 64 + d;
        U4 s, w; unsigned short sv[8], wv[8];
#pragma unroll
        for (int j = 0; j < 8; ++j) { const size_t ro = (size_t)((j & 3) + 16 * (j >> 2)) * LDKV; sv[j] = src[ro + 128]; wv[j] = src[ro + 384]; }
        s.x = sv[0] | ((unsigned)sv[1] << 16); s.y = sv[2] | ((unsigned)sv[3] << 16); s.z = sv[4] | ((unsigned)sv[5] << 16); s.w = sv[6] | ((unsigned)sv[7] << 16);
        w.x = wv[0] | ((unsigned)wv[1] << 16); w.y = wv[2] | ((unsigned)wv[3] << 16); w.z = wv[4] | ((unsigned)wv[5] << 16); w.w = wv[6] | ((unsigned)wv[7] << 16);
        *(U4*)(VsT + (((size_t)bg * (SEQ / 8) + kg) * 64 + d) * 8) = s; *(U4*)(VwT + (((size_t)bg * (SEQ / 8) + kg) * 64 + d) * 8) = w;
    }
}
namespace pg8 {
#define PG8_LAS __attribute__((address_space(3)))
typedef unsigned short bf16_t;
typedef short bf16x8 __attribute__((ext_vector_type(8)));
typedef float f32x4 __attribute__((ext_vector_type(4)));
typedef unsigned u32x4 __attribute__((ext_vector_type(4)));
constexpr int BM = 256, BK = 64, HALF = 128, HTB = HALF * BK * 2  , STAGE_BYTES = 8 * HTB, NXCD = 8, WGM = 8;

__host__ __device__ __forceinline__ int lds_byte(int r, int c) { const int st = (r >> 4) * 2 + (c >> 5), rr = r & 15, cc = c & 31, ob = rr * 64 + cc * 2; return st * 1024 + (ob ^ (((ob >> 9) & 1) << 5)); }
__host__ __device__ __forceinline__ void stage_rc(int b, int& R, int& C) { const int st = b / 1024, sb = b % 1024, swz = sb ^ (((sb >> 9) & 1) << 5); R = (st >> 1) * 16 + swz / 64; C = (st & 1) * 32 + (swz % 64) / 2; }
__host__ __device__ __forceinline__ int perm32(int rho) { const int n = rho >> 4, i = rho & 15; return 8 * (i >> 2) + 4 * n + (i & 3); }

struct Unit { int pm, pn; };
struct Gemm { const bf16_t* A; const bf16_t* Bt; int M, N, K; int lda; };

struct StaticOrder {
    int nM, nN, nwg, G, c;
    __host__ __device__ void init(int M, int N, int G_, int c_) { nM = M / BM; nN = N / BM; nwg = nM * nN; G = G_; c = c_; }
    __host__ __device__ bool next(int i, Unit& u) const {
        const long L = (long)i * G + c; if (L >= nwg) return false;
        int wgid = (int)L; { const int q = nwg / NXCD, r = nwg % NXCD, xcd = wgid % NXCD, off = wgid / NXCD; wgid = (xcd < r ? xcd * (q + 1) : r * (q + 1) + (xcd - r) * q) + off; }
        const int nig = WGM * nN, gid = wgid / nig, fm = gid * WGM, gsz = (nM - fm) < WGM ? (nM - fm) : WGM;
        u.pm = fm + ((wgid % nig) % gsz); u.pn = (wgid % nig) / gsz; return true;
    }
    __device__ __forceinline__ void a_ready(const Unit&) const {}
    __device__ __forceinline__ void done(const Unit&) const {}
};

__device__ __forceinline__ unsigned cvt_pk_bf16(float lo, float hi) { unsigned r; asm volatile("v_cvt_pk_bf16_f32 %0, %1, %2" : "=v"(r) : "v"(lo), "v"(hi)); return r; }
typedef float f32x2 __attribute__((ext_vector_type(2)));
template <class Epi, class Sched, bool ALIGN_EPI = false, bool SP2 = false>
__device__ __forceinline__ void gemm_phase(PG8_LAS unsigned char* lds, const Gemm g, const Sched& S, const Epi& E, int tid_in) {
    int tid_ = tid_in; asm volatile("" : "+v"(tid_));
    const int tid = tid_, wid = __builtin_amdgcn_readfirstlane(tid >> 6), lane = tid & 63, wr = wid >> 2, wc = wid & 3, fr = lane & 15, fq = lane >> 4;
    const int K = g.K, nt = K / BK, lda = g.lda ? g.lda : K;
    unsigned voffA[2], voffB[2];
#pragma unroll
    for (int i = 0; i < 2; ++i) { int R, C; stage_rc(tid * 16 + i * 8192, R, C); const int Rb = Epi::PERM ? ((R & ~31) + perm32(R & 31)) : R;
        voffA[i] = (unsigned)(R * lda + C) * 2u; voffB[i] = (unsigned)(Rb * K + C) * 2u; }
    const size_t kstep = (size_t)(BK * 2);
    const size_t hstepA = (size_t)HALF * lda * 2, hstepB = (size_t)HALF * K * 2;
    const size_t hstep_unused = (size_t)HALF * K * 2;
    const size_t tstepA = 2 * hstepA, tstepB = 2 * hstepB;
    const unsigned ldsw = (unsigned)wid * 1024u;
    const int aoff = lds_byte(wr * 64 + fr, fq * 8), boff = lds_byte(wc * 32 + fr, fq * 8);
#define PG8_SA(b, h) (((b) * 2 + (h)) * HTB)
#define PG8_SB(b, h) ((4 + (b) * 2 + (h)) * HTB)
#define PG8_STAGE(bufoff, gbase, voff) do { _Pragma("unroll") for (int _i = 0; _i < 2; ++_i) \
        __builtin_amdgcn_global_load_lds((const unsigned*)((const char*)(gbase) + (voff)[_i]), (PG8_LAS unsigned*)(lds + (bufoff) + ldsw + _i * 8192), 16, 0, 0); } while (0)
#define PG8_LDA(dst, b, h) do { _Pragma("unroll") for (int m = 0; m < 4; ++m) _Pragma("unroll") for (int k = 0; k < 2; ++k) dst[m][k] = *(const PG8_LAS bf16x8*)(lds + PG8_SA(b, h) + aoff + m * 2048 + k * 1024); } while (0)
#define PG8_LDB(dst, b, h) do { _Pragma("unroll") for (int n = 0; n < 2; ++n) _Pragma("unroll") for (int k = 0; k < 2; ++k) dst[n][k] = *(const PG8_LAS bf16x8*)(lds + PG8_SB(b, h) + boff + n * 2048 + k * 1024); } while (0)
#define PG8_MMA(ai, bj, At, Bt) do { __builtin_amdgcn_s_setprio(1); _Pragma("unroll") for (int m = 0; m < 4; ++m) _Pragma("unroll") for (int n = 0; n < 2; ++n) _Pragma("unroll") for (int k = 0; k < 2; ++k) \
        acc[ai][bj][m][n] = __builtin_amdgcn_mfma_f32_16x16x32_bf16(Bt[n][k], At[m][k], acc[ai][bj][m][n], 0, 0, 0); __builtin_amdgcn_s_setprio(0); } while (0)
#define PG8_WAIT_V(n) asm volatile("s_waitcnt vmcnt(" #n ")" ::: "memory")
#define PG8_WAIT_L(n) asm volatile("s_waitcnt lgkmcnt(" #n ")" ::: "memory")
#define PG8_BAR __builtin_amdgcn_s_barrier()
#define PG8_SCHED __builtin_amdgcn_sched_barrier(0)
    Unit cur, nxt; int ui = 0;
    if (!S.next(0, cur)) return;
    f32x4 acc[2][2][4][2];
#pragma unroll
    for (int a = 0; a < 2; ++a)
#pragma unroll
        for (int b = 0; b < 2; ++b)
#pragma unroll
            for (int m = 0; m < 4; ++m)
#pragma unroll
                for (int n = 0; n < 2; ++n) acc[a][b][m][n] = (f32x4){0.f, 0.f, 0.f, 0.f};
    bf16x8 At[4][2], B0[2][2], B1[2][2];
    const char* cA = (const char*)g.A + (size_t)cur.pm * tstepA; const char* cB = (const char*)g.Bt + (size_t)cur.pn * tstepB;
    S.a_ready(cur);
    if constexpr (SP2) {
        PG8_STAGE(PG8_SB(0, 0), cB, voffB); PG8_STAGE(PG8_SB(0, 1), cB + hstepB, voffB); PG8_STAGE(PG8_SA(0, 0), cA, voffA); PG8_STAGE(PG8_SA(0, 1), cA + hstepA, voffA);
        if (wr == 1) PG8_BAR;
        PG8_WAIT_V(2); PG8_BAR;
        PG8_STAGE(PG8_SB(1, 0), cB + kstep, voffB); PG8_STAGE(PG8_SA(1, 0), cA + kstep, voffA); PG8_STAGE(PG8_SB(1, 1), cB + hstepB + kstep, voffB);
        PG8_WAIT_V(6); PG8_BAR;
    } else {
        PG8_STAGE(PG8_SB(0, 0), cB, voffB); PG8_STAGE(PG8_SA(0, 0), cA, voffA); PG8_STAGE(PG8_SB(0, 1), cB + hstepB, voffB); PG8_STAGE(PG8_SA(0, 1), cA + hstepA, voffA);
        if (wr == 1) PG8_BAR;
        PG8_WAIT_V(4); PG8_BAR;
        PG8_STAGE(PG8_SB(1, 0), cB + kstep, voffB); PG8_STAGE(PG8_SA(1, 0), cA + kstep, voffA); PG8_STAGE(PG8_SB(1, 1), cB + hstepB + kstep, voffB);
        PG8_WAIT_V(6); PG8_BAR;
    }
    for (;;) {
        const bool has_next = S.next(ui + 1, nxt);
        const char* nA = has_next ? (const char*)g.A + (size_t)nxt.pm * tstepA : cA; const char* nB = has_next ? (const char*)g.Bt + (size_t)nxt.pn * tstepB : cB;
        for (int t = 0; t < nt; t += 2) {
            const bool last = (t == nt - 2);
            const char* a1 = cA + (size_t)(t + 1) * kstep;
            const char* a2 = last ? nA : cA + (size_t)(t + 2) * kstep; const char* b2 = last ? nB : cB + (size_t)(t + 2) * kstep;
            const char* a3 = a2 + kstep; const char* b3 = b2 + kstep;
            if (last && has_next) S.a_ready(nxt);
            if constexpr (SP2) {
            PG8_LDB(B0, 0, 0); PG8_LDB(B1, 0, 1); PG8_SCHED; PG8_LDA(At, 0, 0); PG8_STAGE(PG8_SA(1, 1), a1 + hstepA, voffA);
            PG8_WAIT_V(8); PG8_WAIT_L(0); PG8_BAR; PG8_MMA(0, 0, At, B0); PG8_MMA(0, 1, At, B1); PG8_BAR; PG8_SCHED;
            PG8_LDA(At, 0, 1); PG8_STAGE(PG8_SB(0, 0), b2, voffB); PG8_STAGE(PG8_SB(0, 1), b2 + hstepB, voffB); PG8_STAGE(PG8_SA(0, 0), a2, voffA);
            PG8_WAIT_V(8); PG8_WAIT_L(0); PG8_BAR; PG8_MMA(1, 0, At, B0); PG8_MMA(1, 1, At, B1); PG8_BAR; PG8_SCHED;
            PG8_LDB(B0, 1, 0); PG8_LDB(B1, 1, 1); PG8_SCHED; PG8_LDA(At, 1, 0); PG8_STAGE(PG8_SA(0, 1), a2 + hstepA, voffA);
            PG8_WAIT_V(8); PG8_WAIT_L(0); PG8_BAR; PG8_MMA(0, 0, At, B0); PG8_MMA(0, 1, At, B1); PG8_BAR; PG8_SCHED;
            PG8_LDA(At, 1, 1); PG8_STAGE(PG8_SB(1, 0), b3, voffB); PG8_STAGE(PG8_SB(1, 1), b3 + hstepB, voffB); PG8_STAGE(PG8_SA(1, 0), a3, voffA);
            PG8_WAIT_V(8); PG8_WAIT_L(0); PG8_BAR; PG8_MMA(1, 0, At, B0); PG8_MMA(1, 1, At, B1); PG8_BAR; PG8_SCHED;
            } else {
            PG8_LDB(B0, 0, 0); PG8_SCHED; PG8_LDA(At, 0, 0); PG8_STAGE(PG8_SA(1, 1), a1 + hstepA, voffA);
            PG8_WAIT_L(8); PG8_BAR; PG8_WAIT_L(0); PG8_MMA(0, 0, At, B0); PG8_BAR; PG8_SCHED;
            PG8_LDB(B1, 0, 1); PG8_STAGE(PG8_SB(0, 0), b2, voffB);
            PG8_BAR; PG8_WAIT_L(0); PG8_MMA(0, 1, At, B1); PG8_BAR;
            PG8_LDA(At, 0, 1); PG8_STAGE(PG8_SA(0, 0), a2, voffA);
            PG8_BAR; PG8_WAIT_L(0); PG8_MMA(1, 0, At, B0); PG8_BAR; PG8_SCHED;
            PG8_STAGE(PG8_SB(0, 1), b2 + hstepB, voffB);
            PG8_WAIT_V(6); PG8_BAR; PG8_MMA(1, 1, At, B1); PG8_BAR;
            PG8_LDB(B0, 1, 0); PG8_SCHED; PG8_LDA(At, 1, 0); PG8_STAGE(PG8_SA(0, 1), a2 + hstepA, voffA);
            PG8_WAIT_L(8); PG8_BAR; PG8_WAIT_L(0); PG8_MMA(0, 0, At, B0); PG8_BAR; PG8_SCHED;
            PG8_LDB(B1, 1, 1); PG8_STAGE(PG8_SB(1, 0), b3, voffB);
            PG8_BAR; PG8_WAIT_L(0); PG8_MMA(0, 1, At, B1); PG8_BAR;
            PG8_LDA(At, 1, 1); PG8_STAGE(PG8_SA(1, 0), a3, voffA);
            PG8_BAR; PG8_WAIT_L(0); PG8_MMA(1, 0, At, B0); PG8_BAR; PG8_SCHED;
            PG8_STAGE(PG8_SB(1, 1), b3 + hstepB, voffB);
            PG8_WAIT_V(6); PG8_BAR; PG8_MMA(1, 1, At, B1); PG8_BAR;
            }
        }
        if constexpr (ALIGN_EPI) { if (wr == 0) PG8_BAR; }
        if constexpr (!Epi::AFTER_DRAIN) { E(acc, cur, wr, wc, fr, fq); S.done(cur); }
        if (!has_next) break;
#pragma unroll
        for (int a = 0; a < 2; ++a)
#pragma unroll
            for (int b = 0; b < 2; ++b)
#pragma unroll
                for (int m = 0; m < 4; ++m)
#pragma unroll
                    for (int n = 0; n < 2; ++n) acc[a][b][m][n] = (f32x4){0.f, 0.f, 0.f, 0.f};
        cur = nxt; cA = nA; cB = nB; ++ui;
        if constexpr (ALIGN_EPI) { if (wr == 1) PG8_BAR; }
    }
    PG8_WAIT_V(0);
    if constexpr (!ALIGN_EPI) { if (wr == 0) PG8_BAR; }
    PG8_BAR;
    if constexpr (Epi::AFTER_DRAIN) { E.fused(acc, cur, wr, wc, fr, fq, lds, wid, lane); S.done(cur); }
#undef PG8_SA
#undef PG8_SB
#undef PG8_STAGE
#undef PG8_LDA
#undef PG8_LDB
#undef PG8_MMA
#undef PG8_WAIT_V
#undef PG8_WAIT_L
#undef PG8_BAR
#undef PG8_SCHED
}
}

#define LAS __attribute__((address_space(3)))
#define XB_TMO      128
#define XB_XCNT(j)  (256  + 64 * (j))
#define XB_XSUB(j)  (1280 + 64 * (j))
#define XB_XGEN(j)  (2304 + 64 * (j))
#define XB_TOP      3328
#define XB_TOPGEN   3392
#define XCD_BAR_WORDS 3456
#define XB_SPIN_CAP (1u << 22)

__device__ __forceinline__ unsigned xb_ld(unsigned* p)              { return __hip_atomic_load(p, __ATOMIC_RELAXED, __HIP_MEMORY_SCOPE_AGENT); }
__device__ __forceinline__ unsigned xb_add(unsigned* p, unsigned v) { return __hip_atomic_fetch_add(p, v, __ATOMIC_RELAXED, __HIP_MEMORY_SCOPE_AGENT); }
__device__ __forceinline__ unsigned xb_xcc_id() { return (unsigned)__builtin_amdgcn_s_getreg((3 << 11) | 20) & 0xFu; }
#define XB_SPIN(cond, bar) do { unsigned _sp = 0; while (cond) { __builtin_amdgcn_s_sleep(1); \
    if ((++_sp & 255u) == 0u) { if (xb_ld(&(bar)[XB_TMO])) break; if (_sp > XB_SPIN_CAP) { atomicAdd(&(bar)[XB_TMO], 1u); break; } } } } while (0)

struct XcdBarrier {
    unsigned* bar; unsigned x;
    volatile LAS unsigned* st;
};

__device__ __forceinline__ XcdBarrier xcd_barrier_post(unsigned* bar, volatile LAS unsigned* st) {
    XcdBarrier b; b.bar = bar; b.x = xb_xcc_id(); b.st = st;
    if (threadIdx.x == 0) (void)xb_add(&bar[XB_XCNT(b.x)], 1u);
    return b;
}
__device__ __forceinline__ void xcd_barrier_complete(unsigned* bar, unsigned x, unsigned& nloc, unsigned& nx) {
    const unsigned G = gridDim.x * gridDim.y * gridDim.z;
    unsigned sum, cnt, mine, sp = 0u;
    for (;;) {
        sum = 0u; cnt = 0u; mine = 0u;
#pragma unroll
        for (unsigned j = 0; j < 16; ++j) { const unsigned c = xb_ld(&bar[XB_XCNT(j)]); sum += c; cnt += (c > 0u) ? 1u : 0u; mine = (j == x) ? c : mine; }
        if (sum == G) break;
        __builtin_amdgcn_s_sleep(1);
        if ((++sp & 255u) == 0u) { if (xb_ld(&bar[XB_TMO])) break; if (sp > XB_SPIN_CAP) { atomicAdd(&bar[XB_TMO], 1u); break; } }
    }
    nloc = mine > 0u ? mine : 1u; nx = cnt > 0u ? cnt : 1u;
}

__device__ __forceinline__ void xcd_barrier(const XcdBarrier& b, int tid_x  ) {
    asm volatile("s_waitcnt vmcnt(0)" ::: "memory");
    __syncthreads();
    if (tid_x == 0) {
        unsigned* bar = b.bar; asm volatile("" : "+s"(bar));
        unsigned xx = b.x; asm volatile("" : "+s"(xx));
        __builtin_amdgcn_s_waitcnt(0);
        unsigned nloc = b.st[0], nx = b.st[1];
        if (nloc == 0u) { xcd_barrier_complete(bar, xx, nloc, nx); b.st[0] = nloc; b.st[1] = nx; }
        const unsigned old = xb_add(&bar[XB_XSUB(xx)], 1u);
        const unsigned gen = old / nloc;
        if (old + 1u == (gen + 1u) * nloc) {
            __builtin_amdgcn_fence(__ATOMIC_RELEASE, "agent");
            asm volatile("s_waitcnt vmcnt(0)" ::: "memory");
            const unsigned og = xb_add(&bar[XB_TOP], 1u);
            const unsigned tg = og / nx;
            if (og + 1u == (tg + 1u) * nx) xb_add(&bar[XB_TOPGEN], 1u);
            else XB_SPIN(xb_ld(&bar[XB_TOPGEN]) == tg, bar);
            __builtin_amdgcn_fence(__ATOMIC_ACQUIRE, "agent");
            xb_add(&bar[XB_XGEN(xx)], 1u);
            asm volatile("s_waitcnt vmcnt(0)" ::: "memory");
        } else {
            XB_SPIN(xb_ld(&bar[XB_XGEN(xx)]) == gen, bar);
            __builtin_amdgcn_fence(__ATOMIC_ACQUIRE, "agent");
            asm volatile("s_waitcnt vmcnt(0)" ::: "memory");
        }
    }
    __syncthreads();
}
#define GAS __attribute__((address_space(1)))
typedef unsigned v4u __attribute__((ext_vector_type(4)));
typedef unsigned v2u __attribute__((ext_vector_type(2)));
typedef GAS unsigned gu32;
#define RLX_AGENT __ATOMIC_RELAXED, __HIP_MEMORY_SCOPE_AGENT
#define LDS_WAIT() asm volatile("s_waitcnt lgkmcnt(0)" ::: "memory")
#define VM_WAIT() asm volatile("s_waitcnt vmcnt(0)" ::: "memory")
using pg8::f32x4; using pg8::Unit; using pg8::Gemm; using pg8::BM; using pg8::HALF; using pg8::cvt_pk_bf16; using pg8::u32x4;

constexpr int NWAVES = 8, NTHREADS = 512;
constexpr int RING_BYTES = 131072, LDSCTL_OFF = 147456 - 1024, MISC_OFF = LDSCTL_OFF + 320, LDS_BYTES = 147456;

__device__ __forceinline__ float wave_sum(float v, int lane) {
#pragma unroll
    for (int o = 1; o < 64; o <<= 1) v += __builtin_bit_cast(float, __builtin_amdgcn_ds_bpermute((lane ^ o) << 2, __builtin_bit_cast(int, v)));
    return v;
}
__device__ __forceinline__ float fsig(float x) { return __builtin_amdgcn_rcpf(1.f + __expf(-x)); }

__device__ __forceinline__ int lane_id_opaque() { int l; asm volatile("v_mbcnt_lo_u32_b32 %0, -1, 0\n\tv_mbcnt_hi_u32_b32 %0, -1, %0" : "=v"(l)); return l; }
__device__ __forceinline__ int rfl(int v) { return __builtin_amdgcn_readfirstlane(v); }
struct SOrder {
    pg8::StaticOrder s;
    __device__ void init(int M, int N, int G, int c) { s.init(M, N, G, c); }
    __device__ bool next(int i, Unit& u) const { Unit t; t.pm = 0; t.pn = 0; const bool ok = s.next(i, t); u.pm = rfl(t.pm); u.pn = rfl(t.pn); return ok; }
    __device__ __forceinline__ void a_ready(const Unit&) const {}
    __device__ __forceinline__ void done(const Unit&) const {}
};
struct StackOrder {
    int nM, nN, nb, G, c;
    __device__ bool next(int i, Unit& u) const { const long L = (long)i * G + c; if (L >= (long)nb * nM * nN) return false;
        const int br = (int)(L / (nM * nN)), rem = (int)(L % (nM * nN)); u.pm = rfl(br * nM + rem / nN); u.pn = rfl(br * nN + rem % nN); return true; }
    __device__ __forceinline__ void a_ready(const Unit&) const {}
    __device__ __forceinline__ void done(const Unit&) const {}
};
struct GateOrder {
    int nM, nN, G, c;
    __device__ bool next(int i, Unit& u) const { const int j = i / 3, br = i - 3 * j; const long L = (long)j * G + c; if (L >= (long)nM * nN) return false;
        u.pm = rfl((int)(L / nN)); u.pn = rfl(br * nN + (int)(L % nN)); return true; }
    __device__ __forceinline__ void a_ready(const Unit&) const {}
    __device__ __forceinline__ void done(const Unit&) const {}
};
struct MoeOrder {
    pg8::StaticOrder s; int nN, e0, e1, e2, e3, e4, e5, e6, e7;
    __device__ void init(const unsigned* cnt  , int nN_, int G_, int c_) { nN = nN_;
        int t = 0; t += (cnt[0] + 255) >> 8; e0 = t; t += (cnt[64] + 255) >> 8; e1 = t; t += (cnt[128] + 255) >> 8; e2 = t; t += (cnt[192] + 255) >> 8; e3 = t;
        t += (cnt[256] + 255) >> 8; e4 = t; t += (cnt[320] + 255) >> 8; e5 = t; t += (cnt[384] + 255) >> 8; e6 = t; t += (cnt[448] + 255) >> 8; e7 = t;
        s.init(e7 * 256, nN_ * 256, G_, c_); }
    __device__ bool next(int i, Unit& u) const { Unit t; t.pm = 0; t.pn = 0; if (!s.next(i, t)) return false;
        const int pm = t.pm, e = (pm >= e0) + (pm >= e1) + (pm >= e2) + (pm >= e3) + (pm >= e4) + (pm >= e5) + (pm >= e6);
        u.pm = rfl(pm); u.pn = rfl(e * nN + t.pn); return true; }
    __device__ __forceinline__ void a_ready(const Unit&) const {}
    __device__ __forceinline__ void done(const Unit&) const {}
};

__device__ __forceinline__ u32x4 pack8(f32x4 v0, f32x4 v1) { u32x4 w; w.x = cvt_pk_bf16(v0[0], v0[1]); w.y = cvt_pk_bf16(v0[2], v0[3]); w.z = cvt_pk_bf16(v1[0], v1[1]); w.w = cvt_pk_bf16(v1[2], v1[3]); return w; }
__device__ __forceinline__ void unpack8(u32x4 w, f32x4& v0, f32x4& v1) {
    v0 = (f32x4){blo(w.x), bhi(w.x), blo(w.y), bhi(w.y)}; v1 = (f32x4){blo(w.z), bhi(w.z), blo(w.w), bhi(w.w)}; }

struct EpiProj {
    static constexpr bool PERM = true, AFTER_DRAIN = false;
    unsigned char* ws;
    __device__ __forceinline__ void operator()(const f32x4 (&acc)[2][2][4][2], const Unit& u, int wr, int wc, int fr, int fq) const {
        bf16* const QB = (bf16*)(ws + AR_QB); bf16* const KV = (bf16*)(ws + AR_KV); bf16* const UB = (bf16*)(ws + AR_UB); bf16* const RW = (bf16*)(ws + AR_RW); bf16* const HALO = (bf16*)(ws + AR_HALO); bf16* const CKV = (bf16*)(ws + AR_CKV);
        const int row0 = u.pm * BM + wr * 64 + fr, cl = wc * 32 + 8 * fq;
        if (u.pn >= 5 && u.pn < 9) {
#pragma unroll
            for (int ai = 0; ai < 2; ++ai)
#pragma unroll
                for (int m = 0; m < 4; ++m) { f32x4 a0 = acc[ai][0][m][0], a1 = acc[ai][0][m][1]; const f32x4 b0 = acc[ai][1][m][0], b1 = acc[ai][1][m][1];
#pragma unroll
                    for (int k = 0; k < 4; ++k) { a0[k] *= fsig(b0[k]); a1[k] *= fsig(b1[k]); }
                    *(u32x4*)(UB + (size_t)(row0 + ai * HALF + m * 16) * 512 + (u.pn - 5) * 128 + cl) = pack8(a0, a1); }
            return;
        }
        if (u.pn == 2) {
#pragma unroll
            for (int ai = 0; ai < 2; ++ai)
#pragma unroll
                for (int m = 0; m < 4; ++m) { const int row = row0 + ai * HALF + m * 16, b = row / SEQ, tt = row % SEQ;
#pragma unroll
                    for (int bj = 0; bj < 2; ++bj) *(u32x4*)(CKV + (((size_t)bj * (BATCH * NKV) + b * NKV + (cl >> 6)) * SEQ + tt) * 64 + (cl & 63)) = pack8(acc[ai][bj][m][0], acc[ai][bj][m][1]); }
            return;
        }
        bf16* base; int ld, c0;
        if (u.pn < 2) { base = QB; ld = LDQ; c0 = u.pn * 256; } else if (u.pn < 5) { base = KV; ld = LDKV; c0 = (u.pn - 3) * 256; } else { base = RW; ld = LDRW; c0 = (u.pn - 9) * 256; }
#pragma unroll
        for (int ai = 0; ai < 2; ++ai)
#pragma unroll
            for (int m = 0; m < 4; ++m)
#pragma unroll
                for (int bj = 0; bj < 2; ++bj) { const u32x4 w = pack8(acc[ai][bj][m][0], acc[ai][bj][m][1]);
                    *(u32x4*)(base + (size_t)(row0 + ai * HALF + m * 16) * ld + c0 + bj * HALF + cl) = w;
                    if (u.pn >= 9 && ai == 1 && m == 3 && wr == 1 && fr == 15) *(u32x4*)(HALO + (size_t)u.pm * LDRW + c0 + bj * HALF + cl) = w; }
    }
};
struct EpiStore {
    static constexpr bool PERM = true, AFTER_DRAIN = false;
    bf16* O; int ld, ntn;
    __device__ __forceinline__ void operator()(const f32x4 (&acc)[2][2][4][2], const Unit& u, int wr, int wc, int fr, int fq) const {
        const int row0 = u.pm * BM + wr * 64 + fr, c0 = (u.pn % ntn) * 256 + wc * 32 + 8 * fq;
#pragma unroll
        for (int ai = 0; ai < 2; ++ai)
#pragma unroll
            for (int m = 0; m < 4; ++m)
#pragma unroll
                for (int bj = 0; bj < 2; ++bj) *(u32x4*)(O + (size_t)(row0 + ai * HALF + m * 16) * ld + c0 + bj * HALF) = pack8(acc[ai][bj][m][0], acc[ai][bj][m][1]);
    }
};
struct EpiGate {
    static constexpr bool PERM = true, AFTER_DRAIN = false;
    unsigned char* ws; int ntn;
    __device__ __forceinline__ void operator()(const f32x4 (&acc)[2][2][4][2], const Unit& u, int wr, int wc, int fr, int fq) const {
        const bf16* const OB = (const bf16*)(ws + AR_OBUF); bf16* const MIX = (bf16*)(ws + AR_MIX);
        const int br = u.pn / ntn, row0 = u.pm * BM + wr * 64 + fr, c0 = (u.pn % ntn) * 256 + wc * 32 + 8 * fq;
        const bf16* ob = OB + (size_t)br * T * DM;
#pragma unroll
        for (int ai = 0; ai < 2; ++ai)
#pragma unroll
            for (int m = 0; m < 4; ++m)
#pragma unroll
                for (int bj = 0; bj < 2; ++bj) { const size_t off = (size_t)(row0 + ai * HALF + m * 16) * DM + c0 + bj * HALF;
                    f32x4 o0, o1; unpack8(*(const u32x4*)(ob + off), o0, o1);
                    f32x4 g0 = acc[ai][bj][m][0], g1 = acc[ai][bj][m][1];
#pragma unroll
                    for (int k = 0; k < 4; ++k) { g0[k] = fsig(g0[k]) * o0[k]; g1[k] = fsig(g1[k]) * o1[k]; }
                    if (br != 0) { f32x4 p0, p1; unpack8(*(const u32x4*)(MIX + off), p0, p1); g0 += p0; g1 += p1; }
                    *(u32x4*)(MIX + off) = pack8(g0, g1); }
    }
};
struct EpiResid {
    static constexpr bool PERM = true, AFTER_DRAIN = false;
    const float* base; float* out;
    __device__ __forceinline__ void operator()(const f32x4 (&acc)[2][2][4][2], const Unit& u, int wr, int wc, int fr, int fq) const {
        const int row0 = u.pm * BM + wr * 64 + fr, c0 = u.pn * 256 + wc * 32 + 8 * fq;
#pragma unroll
        for (int ai = 0; ai < 2; ++ai)
#pragma unroll
            for (int m = 0; m < 4; ++m)
#pragma unroll
                for (int bj = 0; bj < 2; ++bj) { const size_t off = (size_t)(row0 + ai * HALF + m * 16) * DM + c0 + bj * HALF;
                    const f32x4 x0 = *(const f32x4*)(base + off), x1 = *(const f32x4*)(base + off + 4);
                    *(f32x4*)(out + off) = x0 + acc[ai][bj][m][0]; *(f32x4*)(out + off + 4) = x1 + acc[ai][bj][m][1]; }
    }
};
struct EpiSwiglu {
    static constexpr bool PERM = true, AFTER_DRAIN = false;
    bf16* ACT; int ld, ntn;
    __device__ __forceinline__ void operator()(const f32x4 (&acc)[2][2][4][2], const Unit& u, int wr, int wc, int fr, int fq) const {
        const int row0 = u.pm * BM + wr * 64 + fr, c0 = (u.pn % ntn) * 128 + wc * 32 + 8 * fq;
#pragma unroll
        for (int ai = 0; ai < 2; ++ai)
#pragma unroll
            for (int m = 0; m < 4; ++m) { f32x4 g0 = acc[ai][0][m][0], g1 = acc[ai][0][m][1]; const f32x4 u0 = acc[ai][1][m][0], u1 = acc[ai][1][m][1];
#pragma unroll
                for (int k = 0; k < 4; ++k) { g0[k] = g0[k] * fsig(g0[k]) * u0[k]; g1[k] = g1[k] * fsig(g1[k]) * u1[k]; }
                *(u32x4*)(ACT + (size_t)(row0 + ai * HALF + m * 16) * ld + c0) = pack8(g0, g1); }
    }
};
struct EpiMoeDown {
    static constexpr bool PERM = true, AFTER_DRAIN = false;
    float* out; const int* rtok; const float* rw; int ntn; float sc;
    __device__ __forceinline__ void operator()(const f32x4 (&acc)[2][2][4][2], const Unit& u, int wr, int wc, int fr, int fq) const {
        const int row0 = u.pm * BM + wr * 64 + fr, c0 = (u.pn % ntn) * 256 + wc * 32 + 8 * fq;
#pragma unroll
        for (int ai = 0; ai < 2; ++ai)
#pragma unroll
            for (int m = 0; m < 4; ++m) { const int row = row0 + ai * HALF + m * 16; const int tok = rtok[row]; const float w = rw[row] * sc;
                if (tok >= 0) {
#pragma unroll
                    for (int bj = 0; bj < 2; ++bj) { float* o = out + (size_t)tok * DM + c0 + bj * HALF;
                        const f32x4 x0 = *(const f32x4*)o, x1 = *(const f32x4*)(o + 4);
                        *(f32x4*)o = x0 + acc[ai][bj][m][0] * w; *(f32x4*)(o + 4) = x1 + acc[ai][bj][m][1] * w; } } }
    }
};

typedef short bf16x8_t __attribute__((ext_vector_type(8)));
#define MFMA16(a, b, c) __builtin_amdgcn_mfma_f32_16x16x32_bf16((a), (b), (c), 0, 0, 0)
constexpr float ATT_C = 0.125f * 1.4426950408889634f;
constexpr int AW_IMP = 0, AW_SEL = 8448, AW_QS = 8960, AW_BYTES = 8960 + 8192;
__device__ __forceinline__ float bperm_f(float v, int srclane) { return __builtin_bit_cast(float, __builtin_amdgcn_ds_bpermute(srclane << 2, __builtin_bit_cast(int, v))); }
__device__ __forceinline__ int bperm_i(int v, int srclane) { return __builtin_amdgcn_ds_bpermute(srclane << 2, v); }
__device__ __forceinline__ bf16x8_t ldg8(const bf16* p) { return *(const bf16x8_t*)p; }
__device__ __forceinline__ bf16x8_t pack_p(const f32x4& a, const f32x4& b) {
    v4u w; w.x = cvt_pk_bf16(a[0], a[1]); w.y = cvt_pk_bf16(a[2], a[3]); w.z = cvt_pk_bf16(b[0], b[1]); w.w = cvt_pk_bf16(b[2], b[3]); return __builtin_bit_cast(bf16x8_t, w); }

__device__ __forceinline__ void nsa_attn_item(const P& p, int item, int lane, LAS unsigned char* wl) {
    const bf16* KV = WSP(bf16, AR_KV); const bf16* KC = WSP(bf16, AR_KC); const bf16* VcT = WSP(bf16, AR_VCT); const bf16* VsT = WSP(bf16, WS_VST); const bf16* VwT = WSP(bf16, WS_VWT);
    bf16* QB = WSP(bf16, AR_QB); const float* NG = WSP(float, AR_NG);
    const int bg = item / (SEQ / 16), t0 = (item % (SEQ / 16)) * 16, b = bg >> 1, g = bg & 1;
    const int col = lane & 15, fq = lane >> 4, tok = t0 + col;
    const size_t grow = (size_t)b * SEQ + tok;
    LAS float* IMP = (LAS float*)(wl + AW_IMP); LAS int* SEL = (LAS int*)(wl + AW_SEL); LAS bf16* OS = (LAS bf16*)(wl + AW_IMP);
    const int krowA = 8 * (col >> 2) + (col & 3);
    const float* gate = NG + grow * 24 + g * 12;
    LAS bf16x8_t* QS = (LAS bf16x8_t*)(wl + AW_QS) + lane;
#pragma unroll
    for (int hh = 0; hh < 4; ++hh)
#pragma unroll
        for (int ks = 0; ks < 2; ++ks) QS[(hh * 2 + ks) * 64] = ldg8(QB + grow * LDQ + (g * 4 + hh) * 64 + ks * 32 + fq * 8);
#define Qc(hh, ks) (QS[((hh) * 2 + (ks)) * 64])
    for (int i = lane; i < 16 * 132; i += 64) IMP[i] = 0.f;
    const f32x4 z4 = {0.f, 0.f, 0.f, 0.f};
    f32x4 O[4][4];
    int nvmax = (t0 + 15 >= 31) ? (((t0 + 15 - 31) >> 4) + 1) : 0; if (nvmax > NC) nvmax = NC;
    const int nch = (nvmax + 31) >> 5;
    const bf16* kcb = KC + (size_t)bg * 512 * 64; const bf16* vcb = VcT + (size_t)bg * 64 * 512;
    float linv[4] = {0.f, 0.f, 0.f, 0.f};
#pragma unroll
    for (int hh = 0; hh < 4; ++hh)
#pragma unroll
        for (int mt = 0; mt < 4; ++mt) O[hh][mt] = z4;
#pragma unroll 1
    for (int pass = 0; pass < 2; ++pass) {
#pragma unroll 1
        for (int ch = 0; ch < nch; ++ch) {
            asm volatile("" ::: "memory");
            const int k0 = 32 * ch; const bool cfull = 16 * (k0 + 31) + 31 <= t0;
            bf16x8_t ka[2][2];
#pragma unroll
            for (int tl = 0; tl < 2; ++tl)
#pragma unroll
                for (int ks = 0; ks < 2; ++ks) ka[tl][ks] = ldg8(kcb + ((size_t)(4 * ks + fq) * 512 + k0 + 16 * tl + col) * 8);
            bf16x8_t va[4];
            if (pass == 1) {
#pragma unroll
                for (int mt = 0; mt < 4; ++mt) va[mt] = ldg8(vcb + ((size_t)((k0 >> 3) + fq) * 64 + 16 * mt + col) * 8);
            }
            float ps[8] = {0.f, 0.f, 0.f, 0.f, 0.f, 0.f, 0.f, 0.f};
#pragma unroll
            for (int hh = 0; hh < 4; ++hh) {
                const bf16x8_t q0_ = Qc(hh, 0), q1_ = Qc(hh, 1);
                f32x4 sa = MFMA16(ka[0][0], q0_, z4); sa = MFMA16(ka[0][1], q1_, sa);
                f32x4 sb = MFMA16(ka[1][0], q0_, z4); sb = MFMA16(ka[1][1], q1_, sb);
#pragma unroll
                for (int i = 0; i < 4; ++i) { sa[i] = __builtin_amdgcn_exp2f(sa[i]); sb[i] = __builtin_amdgcn_exp2f(sb[i]); }
                if (!cfull) {
#pragma unroll
                    for (int i = 0; i < 4; ++i) { const int c = k0 + 4 * fq + i; sa[i] = (16 * c + 31 <= tok) ? sa[i] : 0.f; sb[i] = (16 * (c + 16) + 31 <= tok) ? sb[i] : 0.f; } }
                if (pass == 0) { linv[hh] += (sa[0] + sa[1]) + (sa[2] + sa[3]) + (sb[0] + sb[1]) + (sb[2] + sb[3]); }
                else {
#pragma unroll
                    for (int i = 0; i < 4; ++i) { ps[i] = __builtin_fmaf(sa[i], linv[hh], ps[i]); ps[4 + i] = __builtin_fmaf(sb[i], linv[hh], ps[4 + i]); }
                    const bf16x8_t pt = pack_p(sa, sb);
#pragma unroll
                    for (int mt = 0; mt < 4; ++mt) O[hh][mt] = MFMA16(va[mt], pt, O[hh][mt]);
                }
            }
            if (pass == 1) {
                const int Ga = 8 * ch + fq; LAS float* ir = IMP + col * 132 + Ga;
                __hip_atomic_fetch_add(ir, (ps[0] + ps[1]) + (ps[2] + ps[3]), __ATOMIC_RELAXED, __HIP_MEMORY_SCOPE_WORKGROUP);
                __hip_atomic_fetch_add(ir + 1, ps[3], __ATOMIC_RELAXED, __HIP_MEMORY_SCOPE_WORKGROUP);
                __hip_atomic_fetch_add(ir + 4, (ps[4] + ps[5]) + (ps[6] + ps[7]), __ATOMIC_RELAXED, __HIP_MEMORY_SCOPE_WORKGROUP);
                if (Ga + 5 < NS) __hip_atomic_fetch_add(ir + 5, ps[7], __ATOMIC_RELAXED, __HIP_MEMORY_SCOPE_WORKGROUP);
            }
        }
        if (pass == 0) {
#pragma unroll
            for (int hh = 0; hh < 4; ++hh) { float l = linv[hh]; l += bperm_f(l, lane ^ 16); l += bperm_f(l, lane ^ 32); linv[hh] = l > 0.f ? 1.f / l : 0.f; }
        }
    }
    LDS_WAIT(); asm volatile("" ::: "memory");
    {
        const int cur = tok >> 6; LAS float* sc = IMP + col * 132;
        for (int j = fq * 32; j < fq * 32 + 32; ++j) { const bool forced = (j == 0) || (j == cur) || (j == cur - 1); const float v = sc[j]; sc[j] = forced ? 1e4f : (j <= cur ? v : -1.f); }
        LDS_WAIT(); asm volatile("" ::: "memory");
#pragma unroll 1
        for (int r = 0; r < 8; ++r) {
            float bv = sc[fq * 32]; int bj = fq * 32;
            for (int j = fq * 32 + 1; j < fq * 32 + 32; ++j) { const float v = sc[j]; if (v > bv) { bv = v; bj = j; } }
#pragma unroll
            for (int o = 16; o <= 32; o <<= 1) { const float ov = bperm_f(bv, lane ^ o); const int oj = bperm_i(bj, lane ^ o); if (ov > bv || (ov == bv && oj < bj)) { bv = ov; bj = oj; } }
            if ((bj >> 5) == fq) sc[bj] = -3e38f;
            if (fq == 0) SEL[col * 8 + r] = bj;
            LDS_WAIT(); asm volatile("" ::: "memory");
        }
    }
#pragma unroll
    for (int hh = 0; hh < 4; ++hh) { const float g0 = gate[hh * 3 + 0] * linv[hh];
#pragma unroll
        for (int mt = 0; mt < 4; ++mt) { const f32x4 o = O[hh][mt] * g0; v2u w; w.x = cvt_pk_bf16(o[0], o[1]); w.y = cvt_pk_bf16(o[2], o[3]);
            *(LAS v2u*)(OS + (col * 4 + hh) * 64 + 16 * mt + 4 * fq) = w; } }
    LDS_WAIT(); asm volatile("" ::: "memory");
    const int cur = t0 >> 6;
    {
        const bf16* kwb = WSP(bf16, WS_KW8) + (size_t)bg * 8 * SEQ * 8; const bf16* vwb = VwT + (size_t)bg * 64 * SEQ;
        const bf16* ksb = WSP(bf16, WS_KS8) + (size_t)bg * 8 * SEQ * 8; const bf16* vsb = VsT + (size_t)bg * 64 * SEQ;
        int kst = t0 - (WINDOW - 1); if (kst < 0) kst = 0; kst &= ~31;
        const int nwin = ((t0 + 15 - kst) >> 5) + 1, nfb = cur >= 2 ? 3 : cur + 1;
#pragma unroll 1
        for (int part = 0; part < 2; ++part) {
            float lw[4] = {0.f, 0.f, 0.f, 0.f};
#pragma unroll
            for (int hh = 0; hh < 4; ++hh)
#pragma unroll
                for (int mt = 0; mt < 4; ++mt) O[hh][mt] = z4;
            const bf16* kb = part ? ksb : kwb; const bf16* vb = part ? vsb : vwb;
            const int nchk = part ? 2 * nfb : nwin;
#pragma unroll 1
            for (int ci = 0; ci < nchk; ++ci) {
                asm volatile("" ::: "memory");
                int k0;
                if (part == 0) k0 = kst + 32 * ci; else { const int fb = ci >> 1, j = fb == 0 ? 0 : (fb == 1 ? cur : cur - 1); k0 = 64 * j + 32 * (ci & 1); }
                bf16x8_t ka[2][2], va[4];
#pragma unroll
                for (int tl = 0; tl < 2; ++tl)
#pragma unroll
                    for (int ks = 0; ks < 2; ++ks) ka[tl][ks] = ldg8(kb + ((size_t)(4 * ks + fq) * SEQ + k0 + 16 * tl + col) * 8);
#pragma unroll
                for (int mt = 0; mt < 4; ++mt) va[mt] = ldg8(vb + ((size_t)((k0 >> 3) + fq) * 64 + 16 * mt + col) * 8);
                const int lowk = part ? -1 : tok - WINDOW; const bool dfull = (k0 + 31 <= t0) && (part || k0 > t0 + 15 - WINDOW);
#pragma unroll
                for (int hh = 0; hh < 4; ++hh) {
                    const bf16x8_t q0_ = Qc(hh, 0), q1_ = Qc(hh, 1);
                    f32x4 sa = MFMA16(ka[0][0], q0_, z4); sa = MFMA16(ka[0][1], q1_, sa);
                    f32x4 sb = MFMA16(ka[1][0], q0_, z4); sb = MFMA16(ka[1][1], q1_, sb);
#pragma unroll
                    for (int i = 0; i < 4; ++i) { sa[i] = __builtin_amdgcn_exp2f(sa[i]); sb[i] = __builtin_amdgcn_exp2f(sb[i]); }
                    if (!dfull) {
#pragma unroll
                        for (int i = 0; i < 4; ++i) { const int kt = k0 + 4 * fq + i; sa[i] = (kt <= tok && kt > lowk) ? sa[i] : 0.f; sb[i] = (kt + 16 <= tok && kt + 16 > lowk) ? sb[i] : 0.f; } }
                    lw[hh] += (sa[0] + sa[1]) + (sa[2] + sa[3]) + (sb[0] + sb[1]) + (sb[2] + sb[3]);
                    const bf16x8_t pt = pack_p(sa, sb);
#pragma unroll
                    for (int mt = 0; mt < 4; ++mt) O[hh][mt] = MFMA16(va[mt], pt, O[hh][mt]);
                }
            }
            LDS_WAIT(); asm volatile("" ::: "memory");
            if (part == 0) {
#pragma unroll
                for (int hh = 0; hh < 4; ++hh) { float l = lw[hh]; l += bperm_f(l, lane ^ 16); l += bperm_f(l, lane ^ 32); const float w = l > 0.f ? gate[hh * 3 + 2] / l : 0.f;
#pragma unroll
                    for (int mt = 0; mt < 4; ++mt) { LAS v2u* dp = (LAS v2u*)(OS + (col * 4 + hh) * 64 + 16 * mt + 4 * fq); const v2u old = *dp;
                        v2u w2; w2.x = cvt_pk_bf16(blo(old.x) + w * O[hh][mt][0], bhi(old.x) + w * O[hh][mt][1]); w2.y = cvt_pk_bf16(blo(old.y) + w * O[hh][mt][2], bhi(old.y) + w * O[hh][mt][3]); *dp = w2; } }
            } else {
                LAS bf16* OF = (LAS bf16*)(wl + AW_QS); LAS float* LF = (LAS float*)(wl + AW_IMP + 8192);
#pragma unroll
                for (int hh = 0; hh < 4; ++hh) { float l = lw[hh]; l += bperm_f(l, lane ^ 16); l += bperm_f(l, lane ^ 32); if (fq == 0) LF[col * 4 + hh] = l;
#pragma unroll
                    for (int mt = 0; mt < 4; ++mt) { v2u w2; w2.x = cvt_pk_bf16(O[hh][mt][0], O[hh][mt][1]); w2.y = cvt_pk_bf16(O[hh][mt][2], O[hh][mt][3]); *(LAS v2u*)(OF + (col * 4 + hh) * 64 + 16 * mt + 4 * fq) = w2; } }
            }
            LDS_WAIT(); asm volatile("" ::: "memory");
        }
    }
    {
        const bf16* ksb = WSP(bf16, WS_KS8) + (size_t)bg * 8 * SEQ * 8; const bf16* vsb = VsT + (size_t)bg * 64 * SEQ;
        const LAS bf16* OF = (const LAS bf16*)(wl + AW_QS); const LAS float* LF = (const LAS float*)(wl + AW_IMP + 8192);
#pragma unroll 1
        for (int tt = 0; tt < 16; ++tt) {
            const int tq = t0 + tt; const size_t qrow = (size_t)b * SEQ + tq;
            bf16x8_t Qh[2];
#pragma unroll
            for (int ks = 0; ks < 2; ++ks) { Qh[ks] = ldg8(QB + qrow * LDQ + (g * 4 + (col & 3)) * 64 + ks * 32 + fq * 8); if (col >= 4) Qh[ks] = (bf16x8_t){0, 0, 0, 0, 0, 0, 0, 0}; }
            f32x4 Os[4] = {z4, z4, z4, z4}; float ls = 0.f;
#ifdef APROBE_SEL
            for (int rp = 0; rp < 2; ++rp) { Os[0] = z4; Os[1] = z4; Os[2] = z4; Os[3] = z4; ls = 0.f; asm volatile("" ::: "memory");
#endif
#pragma unroll 1
            for (int r8 = 0; r8 < 8; ++r8) {
                const int j = __builtin_amdgcn_readfirstlane(SEL[tt * 8 + r8]);
                if (64 * j > tq || j == 0 || j == cur || j == cur - 1) continue;
                const int kb0 = 64 * j;
                bf16x8_t ka[2][2][2], va[2][4];
#pragma unroll
                for (int hf = 0; hf < 2; ++hf) {
#pragma unroll
                    for (int tl = 0; tl < 2; ++tl)
#pragma unroll
                        for (int ks = 0; ks < 2; ++ks) ka[hf][tl][ks] = ldg8(ksb + ((size_t)(4 * ks + fq) * SEQ + kb0 + 32 * hf + 16 * tl + col) * 8);
#pragma unroll
                    for (int mt = 0; mt < 4; ++mt) va[hf][mt] = ldg8(vsb + ((size_t)(((kb0 + 32 * hf) >> 3) + fq) * 64 + 16 * mt + col) * 8);
                }
#pragma unroll
                for (int hf = 0; hf < 2; ++hf) {
                    f32x4 sa = MFMA16(ka[hf][0][0], Qh[0], z4); sa = MFMA16(ka[hf][0][1], Qh[1], sa);
                    f32x4 sb = MFMA16(ka[hf][1][0], Qh[0], z4); sb = MFMA16(ka[hf][1][1], Qh[1], sb);
#pragma unroll
                    for (int i = 0; i < 4; ++i) { sa[i] = __builtin_amdgcn_exp2f(sa[i]); sb[i] = __builtin_amdgcn_exp2f(sb[i]); }
                    ls += (sa[0] + sa[1]) + (sa[2] + sa[3]) + (sb[0] + sb[1]) + (sb[2] + sb[3]);
                    const bf16x8_t pt = pack_p(sa, sb);
#pragma unroll
                    for (int mt = 0; mt < 4; ++mt) Os[mt] = MFMA16(va[hf][mt], pt, Os[mt]);
                }
            }
#ifdef APROBE_SEL
            }
#endif
            ls += bperm_f(ls, lane ^ 16); ls += bperm_f(ls, lane ^ 32);
            if (col < 4) {
                const float den = ls + LF[tt * 4 + col]; const float w = den > 0.f ? (NG + qrow * 24 + g * 12)[col * 3 + 1] / den : 0.f;
#pragma unroll
                for (int mt = 0; mt < 4; ++mt) { const int e = (tt * 4 + col) * 64 + 16 * mt + 4 * fq; const v2u old = *(const LAS v2u*)(OS + e), fo = *(const LAS v2u*)(OF + e);
                    v2u w2; w2.x = cvt_pk_bf16(blo(old.x) + w * (Os[mt][0] + blo(fo.x)), bhi(old.x) + w * (Os[mt][1] + bhi(fo.x))); w2.y = cvt_pk_bf16(blo(old.y) + w * (Os[mt][2] + blo(fo.y)), bhi(old.y) + w * (Os[mt][3] + bhi(fo.y)));
                    *(v2u*)(QB + qrow * LDQ + (g * 4 + col) * 64 + 16 * mt + 4 * fq) = w2; }
            }
        }
    }
    LDS_WAIT(); asm volatile("" ::: "memory");
#undef Qc
}

typedef _Float16 h16x2 __attribute__((ext_vector_type(2)));
__device__ __forceinline__ h16x2 as_h2(unsigned u) { h16x2 r; __builtin_memcpy(&r, &u, 4); return r; }
constexpr int SC_STEPS = 8, SC_BUF = 6 * 1024;
__device__ __forceinline__ float dpp_sum16(float v) {
    v += __builtin_bit_cast(float, __builtin_amdgcn_update_dpp(0, __builtin_bit_cast(int, v), 0xB1, 0xF, 0xF, true));
    v += __builtin_bit_cast(float, __builtin_amdgcn_update_dpp(0, __builtin_bit_cast(int, v), 0x4E, 0xF, 0xF, true));
    v += __builtin_bit_cast(float, __builtin_amdgcn_update_dpp(0, __builtin_bit_cast(int, v), 0x141, 0xF, 0xF, true));
    v += __builtin_bit_cast(float, __builtin_amdgcn_update_dpp(0, __builtin_bit_cast(int, v), 0x140, 0xF, 0xF, true));
    return v;
}
__device__ __forceinline__ void scan_fill(const bf16* RW, const bf16* Wm, const bf16* Am, size_t trow, int h, int lane, LAS unsigned char* buf) {
    const size_t t = trow + (lane >> 3); const int sub = (lane & 7) * 8;
    const bf16* row = RW + t * LDRW + h * 64 + sub;
    __builtin_amdgcn_global_load_lds((const unsigned*)(row + LBLK), (LAS unsigned*)(buf + 0 * 1024), 16, 0, 0);
    __builtin_amdgcn_global_load_lds((const unsigned*)(Am + t * RC + h * 64 + sub), (LAS unsigned*)(buf + 1 * 1024), 16, 0, 0);
    __builtin_amdgcn_global_load_lds((const unsigned*)(Wm + t * RC + h * 64 + sub), (LAS unsigned*)(buf + 2 * 1024), 16, 0, 0);
    __builtin_amdgcn_global_load_lds((const unsigned*)(row + 512), (LAS unsigned*)(buf + 3 * 1024), 16, 0, 0);
    __builtin_amdgcn_global_load_lds((const unsigned*)(row), (LAS unsigned*)(buf + 4 * 1024), 16, 0, 0);
    __builtin_amdgcn_global_load_lds((const unsigned*)(row + 1024), (LAS unsigned*)(buf + 5 * 1024), 16, 0, 0);
}
__device__ __forceinline__ void scan_unit(const P& p, int unit, int lane, LAS unsigned char* wl) {
    const bf16* RW = WSP(bf16, AR_RW); const bf16* Wm = WSP(bf16, AR_W); const bf16* Am = WSP(bf16, AR_A); bf16* Y = WSP(bf16, AR_UB);
    const int rg = unit & 15, h = (unit >> 4) & 7, b = unit >> 7, row = rg * 4 + (lane >> 4), kq = lane & 15;
    const size_t tb = (size_t)b * SEQ;
    float s0 = 0.f, s1 = 0.f, s2 = 0.f, s3 = 0.f;
    __builtin_amdgcn_s_setprio(3);
    scan_fill(RW, Wm, Am, tb, h, lane, wl);
#pragma unroll 1
    for (int c = 0; c < SEQ / SC_STEPS; ++c) {
        LAS unsigned char* buf = wl + (c & 1) * SC_BUF;
        asm volatile("s_waitcnt vmcnt(0) lgkmcnt(0)" ::: "memory");
        if (c + 1 < SEQ / SC_STEPS) scan_fill(RW, Wm, Am, tb + (size_t)(c + 1) * SC_STEPS, h, lane, wl + ((c + 1) & 1) * SC_BUF);
#ifndef SCAN_VARB
        float ys[SC_STEPS];
#pragma unroll
        for (int st = 0; st < SC_STEPS; ++st) {
            const LAS unsigned char* o = buf + st * 128 + kq * 8;
            const v2u kkw = *(const LAS v2u*)(o), bbw = *(const LAS v2u*)(o + 1024), eew = *(const LAS v2u*)(o + 2048), ktw = *(const LAS v2u*)(o + 3072), rrw = *(const LAS v2u*)(o + 4096);
#ifdef SCAN_BF16
            struct F2 { float x, y; }; const F2 kk0{blo(kkw.x), bhi(kkw.x)}, kk1{blo(kkw.y), bhi(kkw.y)}, bb0{blo(bbw.x), bhi(bbw.x)}, bb1{blo(bbw.y), bhi(bbw.y)}, ee0{blo(eew.x), bhi(eew.x)}, ee1{blo(eew.y), bhi(eew.y)}, kt0{blo(ktw.x), bhi(ktw.x)}, kt1{blo(ktw.y), bhi(ktw.y)}, rr0{blo(rrw.x), bhi(rrw.x)}, rr1{blo(rrw.y), bhi(rrw.y)};
            const float vv = bf2f(*(const LAS unsigned short*)(buf + 5 * 1024 + st * 128 + row * 2));
#else
            const h16x2 kk0 = as_h2(kkw.x), kk1 = as_h2(kkw.y), bb0 = as_h2(bbw.x), bb1 = as_h2(bbw.y);
            const h16x2 ee0 = as_h2(eew.x), ee1 = as_h2(eew.y);
#ifdef RKV_BF16
            struct F2 { float x, y; }; const F2 kt0{blo(ktw.x), bhi(ktw.x)}, kt1{blo(ktw.y), bhi(ktw.y)}, rr0{blo(rrw.x), bhi(rrw.x)}, rr1{blo(rrw.y), bhi(rrw.y)};
            const float vv = bf2f(*(const LAS unsigned short*)(buf + 5 * 1024 + st * 128 + row * 2));
#else
            const h16x2 kt0 = as_h2(ktw.x), kt1 = as_h2(ktw.y);
            const h16x2 rr0 = as_h2(rrw.x), rr1 = as_h2(rrw.y);
            const float vv = (float)__builtin_bit_cast(_Float16, *(const LAS unsigned short*)(buf + 5 * 1024 + st * 128 + row * 2));
#endif
#endif
            float d0 = __builtin_fmaf(s0, (float)kk0.x, 0.f); d0 = __builtin_fmaf(s1, (float)kk0.y, d0); float d1 = __builtin_fmaf(s2, (float)kk1.x, 0.f); d1 = __builtin_fmaf(s3, (float)kk1.y, d1);
            const float nskk = -dpp_sum16(d0 + d1);
            s0 = __builtin_fmaf(s0, -(float)ee0.x, s0); s1 = __builtin_fmaf(s1, -(float)ee0.y, s1); s2 = __builtin_fmaf(s2, -(float)ee1.x, s2); s3 = __builtin_fmaf(s3, -(float)ee1.y, s3);
            s0 = __builtin_fmaf(nskk, (float)bb0.x, s0); s1 = __builtin_fmaf(nskk, (float)bb0.y, s1); s2 = __builtin_fmaf(nskk, (float)bb1.x, s2); s3 = __builtin_fmaf(nskk, (float)bb1.y, s3);
            s0 = __builtin_fmaf(vv, (float)kt0.x, s0); s1 = __builtin_fmaf(vv, (float)kt0.y, s1); s2 = __builtin_fmaf(vv, (float)kt1.x, s2); s3 = __builtin_fmaf(vv, (float)kt1.y, s3);
            float y0 = __builtin_fmaf(s0, (float)rr0.x, 0.f); y0 = __builtin_fmaf(s1, (float)rr0.y, y0); float y1 = __builtin_fmaf(s2, (float)rr1.x, 0.f); y1 = __builtin_fmaf(s3, (float)rr1.y, y1);
            ys[st] = dpp_sum16(y0 + y1);
        }
        if (kq < SC_STEPS) { float yv = ys[0];
#pragma unroll
            for (int st = 1; st < SC_STEPS; ++st) yv = (kq == st) ? ys[st] : yv;
            Y[(tb + (size_t)c * SC_STEPS + kq) * RC + h * 64 + row] = f2bf(yv); }
    }
#else
#pragma unroll
        for (int st = 0; st < SC_STEPS; ++st) {
            const LAS unsigned char* o = buf + st * 128 + kq * 8;
            float kk[4], bb[4], ee[4], kt[4], rr[4];
            { const v2u w = *(const LAS v2u*)(o); const h16x2 a = as_h2(w.x), b2 = as_h2(w.y); kk[0] = (float)a.x; kk[1] = (float)a.y; kk[2] = (float)b2.x; kk[3] = (float)b2.y; }
            { const v2u w = *(const LAS v2u*)(o + 1024); const h16x2 a = as_h2(w.x), b2 = as_h2(w.y); bb[0] = (float)a.x; bb[1] = (float)a.y; bb[2] = (float)b2.x; bb[3] = (float)b2.y; }
            { const v2u w = *(const LAS v2u*)(o + 2048); const h16x2 a = as_h2(w.x), b2 = as_h2(w.y); ee[0] = (float)a.x; ee[1] = (float)a.y; ee[2] = (float)b2.x; ee[3] = (float)b2.y; }
            { const v2u w = *(const LAS v2u*)(o + 3072); const h16x2 a = as_h2(w.x), b2 = as_h2(w.y); kt[0] = (float)a.x; kt[1] = (float)a.y; kt[2] = (float)b2.x; kt[3] = (float)b2.y; }
            { const v2u w = *(const LAS v2u*)(o + 4096); const h16x2 a = as_h2(w.x), b2 = as_h2(w.y); rr[0] = (float)a.x; rr[1] = (float)a.y; rr[2] = (float)b2.x; rr[3] = (float)b2.y; }
            const float vv = (float)__builtin_bit_cast(_Float16, *(const LAS unsigned short*)(buf + 5 * 1024 + st * 128 + row * 2));
            const float skk = dpp_sum16((s0 * kk[0] + s1 * kk[1]) + (s2 * kk[2] + s3 * kk[3]));
            s0 = s0 - s0 * ee[0] - skk * bb[0] + vv * kt[0]; s1 = s1 - s1 * ee[1] - skk * bb[1] + vv * kt[1]; s2 = s2 - s2 * ee[2] - skk * bb[2] + vv * kt[2]; s3 = s3 - s3 * ee[3] - skk * bb[3] + vv * kt[3];
            const float y = dpp_sum16((s0 * rr[0] + s1 * rr[1]) + (s2 * rr[2] + s3 * rr[3]));
            if (kq == 0) Y[(tb + (size_t)c * SC_STEPS + st) * RC + h * 64 + row] = f2bf(y);
        }
    }
#endif
    asm volatile("s_waitcnt vmcnt(0) lgkmcnt(0)" ::: "memory");
    __builtin_amdgcn_s_setprio(0);
}
__device__ __forceinline__ float sum8(float v) {
    v += __builtin_bit_cast(float, __builtin_amdgcn_update_dpp(0, __builtin_bit_cast(int, v), 0xB1, 0xF, 0xF, true));
    v += __builtin_bit_cast(float, __builtin_amdgcn_update_dpp(0, __builtin_bit_cast(int, v), 0x4E, 0xF, 0xF, true));
    v += __builtin_bit_cast(float, __builtin_amdgcn_update_dpp(0, __builtin_bit_cast(int, v), 0x141, 0xF, 0xF, true));
    return v;
}
__device__ __forceinline__ void up8(v4u w, float* f) { f[0] = blo(w.x); f[1] = bhi(w.x); f[2] = blo(w.y); f[3] = bhi(w.y); f[4] = blo(w.z); f[5] = bhi(w.z); f[6] = blo(w.w); f[7] = bhi(w.w); }
#ifdef SCAN_BF16
#define uph8 up8
#define pkh8 pk8
#else
#define uph8 uph8_
#define pkh8 pkh8_
#endif
__device__ __forceinline__ void uph8_(v4u w, float* f) { const h16x2 a = as_h2(w.x), b = as_h2(w.y), c = as_h2(w.z), d = as_h2(w.w);
    f[0] = (float)a.x; f[1] = (float)a.y; f[2] = (float)b.x; f[3] = (float)b.y; f[4] = (float)c.x; f[5] = (float)c.y; f[6] = (float)d.x; f[7] = (float)d.y; }
__device__ __forceinline__ unsigned pkh2(float lo, float hi) { h16x2 v; v.x = (_Float16)lo; v.y = (_Float16)hi; return __builtin_bit_cast(unsigned, v); }
__device__ __forceinline__ v4u pkh8_(const float* f) { v4u w; w.x = pkh2(f[0], f[1]); w.y = pkh2(f[2], f[3]); w.z = pkh2(f[4], f[5]); w.w = pkh2(f[6], f[7]); return w; }
__device__ __forceinline__ v4u pk8(const float* f) { v4u w; w.x = cvt_pk_bf16(f[0], f[1]); w.y = cvt_pk_bf16(f[2], f[3]); w.z = cvt_pk_bf16(f[4], f[5]); w.w = cvt_pk_bf16(f[6], f[7]); return w; }
__device__ __forceinline__ void ldf8(const float* p, float* f) { const f32x4 a = *(const f32x4*)p, b = *(const f32x4*)(p + 4); f[0] = a[0]; f[1] = a[1]; f[2] = a[2]; f[3] = a[3]; f[4] = b[0]; f[5] = b[1]; f[6] = b[2]; f[7] = b[3]; }

struct EpiLora {
    static constexpr bool PERM = true, AFTER_DRAIN = false;
    unsigned char* ws;
    __device__ __forceinline__ void operator()(const f32x4 (&acc)[2][2][4][2], const Unit& u, int wr, int wc, int fr, int fq) const {
        const int which = u.pn >> 1, row0 = u.pm * BM + wr * 64 + fr, c0 = (u.pn & 1) * 256 + wc * 32 + 8 * fq;
        bf16* const O = (bf16*)(ws + (which == 0 ? AR_W : (which == 1 ? AR_A : (which == 2 ? AR_G : AR_UB))));
#pragma unroll
        for (int ai = 0; ai < 2; ++ai)
#pragma unroll
            for (int m = 0; m < 4; ++m)
#pragma unroll
                for (int bj = 0; bj < 2; ++bj) *(u32x4*)(O + (size_t)(row0 + ai * HALF + m * 16) * RC + c0 + bj * HALF) = pack8(acc[ai][bj][m][0], acc[ai][bj][m][1]);
    }
};
#ifdef RKV_BF16
#define UPR up8
#define PKR pk8
#else
#define UPR uph8
#define PKR pkh8
#endif
struct B2In { v4u k, a, w, vr, vv, vf; float gt; };
__device__ __forceinline__ void b2w_load(B2In& in, const P& p, int layer, int t, int lane) {
    const bf16* row = WSP(bf16, AR_RW) + (size_t)t * LDRW;
    in.k = *(const v4u*)(row + 512 + 8 * lane); in.a = *(const v4u*)(WSP(bf16, AR_A) + (size_t)t * RC + 8 * lane); in.w = *(const v4u*)(WSP(bf16, AR_W) + (size_t)t * RC + 8 * lane);
    in.gt = lane < 24 ? bf2f(row[LBLK + 320 + lane]) : 0.f;
    if (layer == 1) { in.vr = *(const v4u*)(WSP(bf16, AR_UB) + (size_t)t * RC + 8 * lane); in.vv = *(const v4u*)(row + 1024 + 8 * lane); in.vf = *(const v4u*)(WSP(bf16, WS_VF) + (size_t)t * RC + 8 * lane); }
}
__device__ __forceinline__ void b2w_compute(const B2In& in, const P& p, int layer, int t, int lane, const float* v0, const float* v1, const float* v2, const float* v3, const float* vb) {
    bf16* row = WSP(bf16, AR_RW) + (size_t)t * LDRW; bf16* Am = WSP(bf16, AR_A); bf16* Wm = WSP(bf16, AR_W); float* NG = WSP(float, AR_NG);
    float k[8], a[8], w[8]; uph8(in.k, k); up8(in.a, a); up8(in.w, w);
    const float ngv = fsig(in.gt);
    float kk[8], ss = 0.f;
#pragma unroll
    for (int i = 0; i < 8; ++i) {
        a[i] = fsig(a[i] + v1[i]);
        const float nx = -(w[i] + v0[i]), sp = fmaxf(nx, 0.f) + __logf(1.f + __expf(-fabsf(nx))), e = __expf(-sp - 0.5f); w[i] = 1.f - __expf(-e);
        kk[i] = k[i] * v2[i]; ss += kk[i] * kk[i]; }
    ss = sum8(ss); const float nrm = sqrtf(ss), inv = 1.f / (nrm > 1e-12f ? nrm : 1e-12f);
#pragma unroll
    for (int i = 0; i < 8; ++i) { kk[i] *= inv; k[i] = k[i] * (1.f + (a[i] - 1.f) * v3[i]); a[i] *= kk[i]; }
    asm volatile("" :: "v"(ngv));
    if (layer == 1) { float vr[8], vv[8], vf[8]; up8(in.vr, vr); uph8(in.vv, vv); uph8(in.vf, vf);
#pragma unroll
        for (int i = 0; i < 8; ++i) vv[i] = vv[i] + (vf[i] - vv[i]) * fsig(vr[i] + vb[i]);
        *(v4u*)(row + 1024 + 8 * lane) = pkh8(vv); }
    if (lane < 24) NG[(size_t)t * 24 + lane] = ngv;
    *(v4u*)(row + LBLK + 8 * lane) = pkh8(kk); *(v4u*)(row + 512 + 8 * lane) = pkh8(k);
    *(v4u*)(Am + (size_t)t * RC + 8 * lane) = pkh8(a); *(v4u*)(Wm + (size_t)t * RC + 8 * lane) = pkh8(w);
}
__device__ __forceinline__ void ph_rwkv_b2w(const P& p, int layer, int gw, int NGW, int lane) {
    const float* vec = p.rwkv_vec + (size_t)layer * 7 * RC; float v0[8], v1[8], v2[8], v3[8], vb[8];
    ldf8(vec + 8 * lane, v0); ldf8(vec + RC + 8 * lane, v1); ldf8(vec + 2 * RC + 8 * lane, v2); ldf8(vec + 3 * RC + 8 * lane, v3); ldf8(p.vres_b + 8 * lane, vb);
    int t = gw; if (t >= T) return;
    B2In A, B; b2w_load(A, p, layer, t, lane);
    for (; t < T; t += 2 * NGW) { const int t1 = t + NGW, t2 = t1 + NGW;
        b2w_load(B, p, layer, t1 < T ? t1 : t, lane); b2w_compute(A, p, layer, t, lane, v0, v1, v2, v3, vb);
        if (t1 < T) { b2w_load(A, p, layer, t2 < T ? t2 : t1, lane); b2w_compute(B, p, layer, t1, lane, v0, v1, v2, v3, vb); } }
}
struct PoIn { v4u y, r, k, v, g; };
__device__ __forceinline__ void post_load(PoIn& in, const P& p, int t, int lane) { const bf16* row = WSP(bf16, AR_RW) + (size_t)t * LDRW;
    in.y = *(const v4u*)(WSP(bf16, AR_UB) + (size_t)t * RC + 8 * lane); in.r = *(const v4u*)(row + 8 * lane); in.k = *(const v4u*)(row + 512 + 8 * lane); in.v = *(const v4u*)(row + 1024 + 8 * lane); in.g = *(const v4u*)(WSP(bf16, AR_G) + (size_t)t * RC + 8 * lane); }
__device__ __forceinline__ void post_compute(const PoIn& in, const P& p, int t, int lane, const float* v4_, const float* v5, const float* v6) {
    float y[8], r[8], k[8], v[8], g[8]; up8(in.y, y); uph8(in.r, r); uph8(in.k, k); uph8(in.v, v); up8(in.g, g);
    float s = 0.f, bon = 0.f;
#pragma unroll
    for (int i = 0; i < 8; ++i) { s += y[i]; bon += r[i] * k[i] * v4_[i]; }
    const float m = sum8(s) * (1.f / 64.f); bon = sum8(bon);
    float q = 0.f;
#pragma unroll
    for (int i = 0; i < 8; ++i) { y[i] -= m; q += y[i] * y[i]; }
    const float rstd = 1.f / sqrtf(sum8(q) * (1.f / 64.f) + GN_EPS);
#pragma unroll
    for (int i = 0; i < 8; ++i) y[i] = (y[i] * rstd * v5[i] + v6[i] + bon * v[i]) * g[i];
    *(v4u*)(WSP(bf16, AR_A) + (size_t)t * RC + 8 * lane) = pk8(y);
}
__device__ __forceinline__ void ph_rwkv_postw(const P& p, int layer, int gw, int NGW, int lane) {
    const float* vec = p.rwkv_vec + (size_t)layer * 7 * RC; float v4_[8], v5[8], v6[8]; ldf8(vec + 4 * RC + 8 * lane, v4_); ldf8(vec + 5 * RC + 8 * lane, v5); ldf8(vec + 6 * RC + 8 * lane, v6);
    int t = gw; if (t >= T) return;
    PoIn A, B; post_load(A, p, t, lane);
    for (; t < T; t += 2 * NGW) { const int t1 = t + NGW, t2 = t1 + NGW;
        post_load(B, p, t1 < T ? t1 : t, lane); post_compute(A, p, t, lane, v4_, v5, v6);
        if (t1 < T) { post_load(A, p, t2 < T ? t2 : t1, lane); post_compute(B, p, t1, lane, v4_, v5, v6); } }
}
__device__ __forceinline__ void ph_convw(const P& p, int layer, int gw, int NGW, int lane, int tid, LAS unsigned char* lds) {
    const bf16* UB = WSP(bf16, AR_UB); bf16* CO = WSP(bf16, AR_CO);
    const float* cw = p.conv_w + (size_t)layer * CONV_K * CONV_CH; const float* cv = p.conv_vec + (size_t)layer * 3 * CONV_CH;
    LAS float* wl = (LAS float*)lds;
    for (int i = tid; i < CONV_K * CONV_CH; i += NTHREADS) wl[i] = cw[i];
    __syncthreads();
    float b0[8], g1[8], b2[8]; ldf8(cv + 8 * lane, b0); ldf8(cv + CONV_CH + 8 * lane, g1); ldf8(cv + 2 * CONV_CH + 8 * lane, b2);
    for (int tb = gw * 4; tb < T; tb += NGW * 4) {
        const int pos0 = tb % SEQ, j0 = pos0 >= 30 ? 0 : 30 - pos0;
        float a[4][8], wt[4][8];
#pragma unroll
        for (int q = 0; q < 4; ++q)
#pragma unroll
            for (int i = 0; i < 8; ++i) a[q][i] = b0[i];
#pragma unroll 1
        for (int j4 = 0; j4 < CONV_K + 3; j4 += 4) {
#pragma unroll
            for (int jj = 0; jj < 4; ++jj) { const int j = j4 + jj;
                if (j < CONV_K) { const f32x4 w0 = *(const LAS f32x4*)(wl + j * CONV_CH + 8 * lane), w1 = *(const LAS f32x4*)(wl + j * CONV_CH + 8 * lane + 4);
#pragma unroll
                    for (int i = 0; i < 4; ++i) { wt[jj][i] = w0[i]; wt[jj][4 + i] = w1[i]; } }
                float u[8];
                if (j >= j0 && j < CONV_K + 3) up8(*(const v4u*)(UB + (size_t)(tb - 30 + j) * CONV_CH + 8 * lane), u); else {
#pragma unroll
                    for (int i = 0; i < 8; ++i) u[i] = 0.f; }
#pragma unroll
                for (int q = 0; q < 4; ++q) { const int tap = j - q; if (tap >= 0 && tap < CONV_K) {
#pragma unroll
                    for (int i = 0; i < 8; ++i) a[q][i] += u[i] * wt[(jj - q) & 3][i]; } }
            }
        }
#pragma unroll
        for (int q = 0; q < 4; ++q) {
            float s = 0.f;
#pragma unroll
            for (int i = 0; i < 8; ++i) s += a[q][i];
            const float mean = wave_sum(s, lane) * (1.f / CONV_CH); float qq = 0.f;
#pragma unroll
            for (int i = 0; i < 8; ++i) { a[q][i] -= mean; qq += a[q][i] * a[q][i]; }
            const float rstd = 1.f / sqrtf(wave_sum(qq, lane) * (1.f / CONV_CH) + LN_EPS);
#pragma unroll
            for (int i = 0; i < 8; ++i) { const float y = a[q][i] * rstd * g1[i] + b2[i]; a[q][i] = y * fsig(y); }
            *(v4u*)(CO + (size_t)(tb + q) * CONV_CH + 8 * lane) = pk8(a[q]);
        }
    }
    __syncthreads();
}
__device__ __forceinline__ void ph_cmp2w(const P& p, int layer, int gw, int NGW, int lane, LAS float* hl  ) {
    const bf16* Z = WSP(bf16, AR_HID); const float* pec = (const float*)(p.ws + WS_W + (size_t)layer * SZ_LAYERW + OFF_PEC);
    for (int it = gw; it < 2 * BATCH * NKV * NC; it += NGW) {
        const int i = it % NC, r = it / NC, bg = r % (BATCH * NKV), which = r / (BATCH * NKV);
        const bf16* z1 = Z + ((size_t)which * (BATCH * NKV * 512) + (size_t)bg * 512 + i) * 256; const bf16* z2 = z1 + 256 + 128;
#pragma unroll
        for (int jj = 0; jj < 2; ++jj) { const int j = lane + 64 * jj; const float x = bf2f(z1[j]) + bf2f(z2[j]) + pec[which * 128 + j];
            const float e = __expf(fminf(2.f * 0.7978845608028654f * (x + 0.044715f * x * x * x), 30.f)); hl[j] = 0.5f * x * (1.f + (e - 1.f) / (e + 1.f)); }
        LDS_WAIT(); asm volatile("" ::: "memory");
        const float* w2 = p.cmp_w2 + (size_t)(layer * 2 + which) * 128 * 64 + lane; float o = 0.f;
#pragma unroll 8
        for (int j = 0; j < 128; ++j) o += hl[j] * w2[j * 64];
        if (which == 0) {
            const float rs = 1.f / sqrtf(wave_sum(o * o, lane) * (1.f / 64.f) + RMS_EPS); o = o * rs * p.qk_g[(layer * 4 + 1) * 64 + lane];
            const float other = bperm_f(o, lane ^ 32); float cs, sn; rope_cs(16 * i + 31, lane & 31, cs, sn);
            o = lane < 32 ? o * cs - other * sn : o * cs + other * sn;
            WSP(bf16, AR_KC)[(((size_t)bg * 8 + (lane >> 3)) * 512 + i) * 8 + (lane & 7)] = f2bf(o);
        } else { bf16* vt = WSP(bf16, AR_VCT) + (size_t)bg * 64 * 512 + lane * 8;
            vt[(size_t)((i >> 5) * 4 + ((i & 15) >> 2)) * 512 + (i & 3) + 4 * ((i >> 4) & 1)] = f2bf(o); if (i == 0) vt[(size_t)((NC >> 5) * 4 + ((NC & 15) >> 2)) * 512 + (NC & 3) + 4 * ((NC >> 4) & 1)] = 0; }
        LDS_WAIT(); asm volatile("" ::: "memory");
    }
}

struct MapPlain { bf16* base; int K; __device__ __forceinline__ bf16* operator()(int col) const { return base + (size_t)col * K; } };
struct MapGlu { bf16* base; int K, ff; __device__ __forceinline__ bf16* operator()(int col) const { return base + (size_t)glu_dest(col, ff) * K; } };
struct MapWin { unsigned char* wl; int layer; __device__ __forceinline__ bf16* operator()(int col) const { int which; const int r = win_dest(col, layer, which); const size_t off = (which ? OFF_WG : OFF_WIN) + (size_t)(r < 0 ? 0 : r) * DM * 2; return r < 0 ? nullptr : (bf16*)(wl + off); } };
template <class Map>
__device__ __forceinline__ void transpose_item(const float* W, int K, int N, const Map& mp, LAS float* scr, int item, int lane) {
    const int nblk = (N + 31) / 32, kb = item / nblk, nb = item % nblk, k0 = 64 * kb, n0 = 32 * nb;
    const int col = n0 + (lane & 31);
#pragma unroll 8
    for (int i = 0; i < 32; ++i) { const int kk = 2 * i + (lane >> 5); scr[kk * 33 + (lane & 31)] = col < N ? W[(size_t)(k0 + kk) * N + col] : 0.f; }
    LDS_WAIT(); asm volatile("" ::: "memory");
    const int c = lane & 7;
#pragma unroll
    for (int j = 0; j < 4; ++j) { const int n = (lane >> 3) + 8 * j; const LAS float* s = scr + (8 * c) * 33 + n;
        v4u o; o.x = (unsigned)f2bf(s[0]) | ((unsigned)f2bf(s[33]) << 16); o.y = (unsigned)f2bf(s[66]) | ((unsigned)f2bf(s[99]) << 16);
        o.z = (unsigned)f2bf(s[132]) | ((unsigned)f2bf(s[165]) << 16); o.w = (unsigned)f2bf(s[198]) | ((unsigned)f2bf(s[231]) << 16);
        if (n0 + n < N) { bf16* d = mp(n0 + n); if (d) *(v4u*)(d + k0 + 8 * c) = o; } }
    LDS_WAIT(); asm volatile("" ::: "memory");
}
template <class Map>
__device__ __forceinline__ bool conv_job(int& r, const float* W, int K, int N, const Map& mp, LAS float* scr, int lane) {
    const int items = (K / 64) * ((N + 31) / 32);
    if (r < items) { transpose_item(W, K, N, mp, scr, r, lane); return true; }
    r -= items; return false;
}

struct RmsIn { f32x4 v[DM / 256]; };
__device__ __forceinline__ void rms_load(RmsIn& r, const float* xrow, int lane) { const f32x4* xr = (const f32x4*)xrow + lane;
#pragma unroll
    for (int j = 0; j < DM / 256; ++j) r.v[j] = xr[64 * j]; }
__device__ __forceinline__ void rms_row(const P& p, const RmsIn& rin, const float* g, bf16* orow, int lane, bool route, int t, unsigned long long& c0, unsigned long long& c1) {
    const f32x4* gr = (const f32x4*)g + lane;
    f32x4 v[DM / 256]; float ss = 0.f;
#pragma unroll
    for (int j = 0; j < DM / 256; ++j) { v[j] = rin.v[j]; ss += (v[j].x * v[j].x + v[j].y * v[j].y) + (v[j].z * v[j].z + v[j].w * v[j].w); }
    const float rs = 1.f / sqrtf(wave_sum(ss, lane) * (1.f / DM) + RMS_EPS);
    v2u* o8 = (v2u*)orow + lane;
#pragma unroll
    for (int j = 0; j < DM / 256; ++j) { const f32x4 gg = gr[64 * j]; v[j].x *= rs * gg.x; v[j].y *= rs * gg.y; v[j].z *= rs * gg.z; v[j].w *= rs * gg.w;
        v2u w; w.x = cvt_pk_bf16(v[j].x, v[j].y); w.y = cvt_pk_bf16(v[j].z, v[j].w); o8[64 * j] = w; }
    if (route) {
        float lg[NEXP];
#pragma unroll
        for (int e = 0; e < NEXP; ++e) lg[e] = 0.f;
#pragma unroll
        for (int j = 0; j < DM / 256; ++j) { const float* rw = p.router_w + (size_t)(4 * (lane + 64 * j)) * NEXP;
#pragma unroll
            for (int e = 0; e < NEXP; ++e) lg[e] += v[j].x * rw[e] + v[j].y * rw[NEXP + e] + v[j].z * rw[2 * NEXP + e] + v[j].w * rw[3 * NEXP + e]; }
#pragma unroll
        for (int e = 0; e < NEXP; ++e) lg[e] = wave_sum(lg[e], lane) + p.router_b[e];
        int e0 = 0; float l0 = lg[0];
#pragma unroll
        for (int e = 1; e < NEXP; ++e) if (lg[e] > l0) { l0 = lg[e]; e0 = e; }
        int e1 = -1; float l1 = -3e38f;
#pragma unroll
        for (int e = 0; e < NEXP; ++e) if (e != e0 && lg[e] > l1) { l1 = lg[e]; e1 = e; }
        e0 = __builtin_amdgcn_readfirstlane(e0); e1 = __builtin_amdgcn_readfirstlane(e1);
        const int r0 = (int)((c0 >> (8 * e0)) & 255ull), r1 = (int)((c1 >> (8 * e1)) & 255ull);
        c0 += 1ull << (8 * e0); c1 += 1ull << (8 * e1);
        if (lane == 0) { const float w0 = 1.f / (1.f + expf(l1 - l0));
            WSP(int, AR_RTE)[t] = e0 | (e1 << 8) | (r0 << 16) | (r1 << 24); float* rw = WSP(float, AR_RTW) + (size_t)t * 2; rw[0] = w0; rw[1] = 1.f - w0; }
    }
}
__device__ __forceinline__ void copy_rows4(const bf16* s0, const bf16* s1, const bf16* s2, const bf16* s3, bf16* d0, bf16* d1, bf16* d2, bf16* d3, int lane) {
    v4u a[4][DM / 512];
#pragma unroll
    for (int j = 0; j < DM / 512; ++j) { a[0][j] = ((const v4u*)s0)[lane + 64 * j]; a[1][j] = ((const v4u*)s1)[lane + 64 * j]; a[2][j] = ((const v4u*)s2)[lane + 64 * j]; a[3][j] = ((const v4u*)s3)[lane + 64 * j]; }
#pragma unroll
    for (int j = 0; j < DM / 512; ++j) { ((v4u*)d0)[lane + 64 * j] = a[0][j]; ((v4u*)d1)[lane + 64 * j] = a[1][j]; ((v4u*)d2)[lane + 64 * j] = a[2][j]; ((v4u*)d3)[lane + 64 * j] = a[3][j]; }
}
__device__ __forceinline__ void copy_row_wave(const bf16* src, bf16* dst, int lane) {
#pragma unroll
    for (int j = 0; j < DM / 512; ++j) ((v4u*)dst)[lane + 64 * j] = ((const v4u*)src)[lane + 64 * j];
}
__device__ __forceinline__ int moe_seg_start(const unsigned* cnt, int e) { int s = 0;
#pragma unroll
    for (int k = 0; k < NEXP; ++k) s += (k < e) ? (int)((cnt[k] + 255u) & ~255u) : 0;
    return s; }

#ifndef PHMASK
#define PHMASK 0xFFFFFFFFu
#endif
#define PHM(k) (((PHMASK) >> (k)) & 1u)
#ifdef PROBE_LO
constexpr int PR_LO = PROBE_LO, PR_HI = PROBE_HI;
#else
constexpr int PR_LO = -1, PR_HI = -1;
#endif
constexpr int NPH = 16, NPHASES = 1 + 2 * NPH;
struct Args { const float* in[29]; float* out; unsigned char* ws; int ph_lo, ph_hi; };

__device__ __forceinline__ bool in_phase(int k, int lo, int hi) { asm volatile("" : "+s"(lo), "+s"(hi)); return lo <= k && k < hi; }
typedef const Args __attribute__((address_space(4)))* CArgsP;
__device__ __forceinline__ void fill_params_k(P& p, CArgsP a) {
    p.x = a->in[0]; p.mix_norm_g = a->in[1]; p.w_in_first = a->in[2]; p.w_in_rest = a->in[3]; p.mu_first = a->in[4]; p.mu_rest = a->in[5]; p.qk_g = a->in[6]; p.cmp_pos = a->in[7];
    p.cmp_w1 = a->in[8]; p.cmp_w2 = a->in[9]; p.nsa_w_o = a->in[10]; p.conv_w = a->in[11]; p.conv_vec = a->in[12]; p.conv_w_o = a->in[13]; p.rwkv_vec = a->in[14]; p.w_up = a->in[15];
    p.a_up = a->in[16]; p.g_up = a->in[17]; p.vres_up = a->in[18]; p.vres_b = a->in[19]; p.rwkv_w_o = a->in[20]; p.w_out = a->in[21]; p.ffn_norm_g = a->in[22]; p.dense_gu = a->in[23];
    p.dense_down = a->in[24]; p.router_w = a->in[25]; p.router_b = a->in[26]; p.moe_gu = a->in[27]; p.moe_down = a->in[28]; p.out = a->out; p.ws = a->ws;
}
__global__ void __launch_bounds__(NTHREADS, 2) mk_fwd(Args args) {
    extern __shared__ __attribute__((aligned(16))) unsigned char lds_raw[];
    LAS unsigned char* lds = (LAS unsigned char*)lds_raw;
    const int wave0 = __builtin_amdgcn_readfirstlane((int)threadIdx.x >> 6);
    const int tid = wave0 * 64 + lane_id_opaque();
    unsigned* ctl = (unsigned*)(args.ws + WS_CTL);
    for (int u = tid; u < (LDS_BYTES - LDSCTL_OFF) / 4; u += NTHREADS) ((LAS unsigned*)(lds + LDSCTL_OFF))[u] = 0u;
    __syncthreads();
    const int lo = args.ph_lo, hi = args.ph_hi;
    XcdBarrier bar; bar.bar = ctl + CW_BAR; bar.x = 0; bar.st = nullptr;
    if (hi - lo > 1) { bar.x = xb_xcc_id(); bar.st = (volatile LAS unsigned*)(lds + MISC_OFF) + 8; if (tid == 0) (void)xb_add(ctl + CW_BAR + XB_XCNT(bar.x), 1u); }
#define RMS_LOOP(X, GN, ROUTE, C0, C1) do { int m_ = gw; if (m_ < T) { RmsIn ra_, rb_; rms_load(ra_, (X) + (size_t)m_ * DM, lane); \
        for (; m_ < T; m_ += 2 * NGW) { const int m1_ = m_ + NGW, m2_ = m1_ + NGW; rms_load(rb_, (X) + (size_t)(m1_ < T ? m1_ : m_) * DM, lane); \
            rms_row(p, ra_, (GN), WSP(bf16, WS_H) + (size_t)m_ * DM, lane, (ROUTE), m_, C0, C1); \
            if (m1_ < T) { rms_load(ra_, (X) + (size_t)(m2_ < T ? m2_ : m1_) * DM, lane); rms_row(p, rb_, (GN), WSP(bf16, WS_H) + (size_t)m1_ * DM, lane, (ROUTE), m1_, C0, C1); } } } } while (0)
#define IN(k) (in_phase((k), lo, hi) && (PR_LO < 0 || (st == 0 ? (k) <= PR_HI : (st == 1 ? ((k) >= PR_LO && (k) <= PR_HI) : (k) > PR_HI))))
#define MKP unsigned long long cdum0 = 0ull, cdum1 = 0ull; (void)cdum0; (void)cdum1; CArgsP ap_ = (CArgsP)__builtin_amdgcn_kernarg_segment_ptr(); asm volatile("" : "+s"(ap_)); P p; fill_params_k(p, ap_); int w0_ = wave0; asm volatile("" : "+s"(w0_)); int tid = w0_ * 64 + lane_id_opaque(); asm volatile("" : "+v"(tid)); const int lane = tid & 63, wave = __builtin_amdgcn_readfirstlane(tid >> 6); int G = gridDim.x, bid = blockIdx.x; asm volatile("" : "+s"(G), "+s"(bid)); unsigned* ctl = WSP(unsigned, WS_CTL); const long gtid = (long)bid * NTHREADS + tid, NT = (long)G * NTHREADS; const int gw = bid * NWAVES + wave, NGW = G * NWAVES; LAS float* scrw = (LAS float*)(lds + wave * 16384); (void)gtid; (void)NT; (void)gw; (void)NGW; (void)scrw; (void)lane; (void)ctl
#define SEAM(k) do { if ((k) + 1 < hi) { int w_ = wave0; asm volatile("" : "+s"(w_)); xcd_barrier(bar, w_ * 64 + lane_id_opaque()); } } while (0)

    for (int st = 0; st < (PR_LO >= 0 ? 3 : 1); ++st) {
    if (PHM(16) && IN(0)) { MKP;
        constexpr int IT_WIN0 = (DM / 64) * ((N_IN_FIRST + 31) / 32), IT_WIN1 = (DM / 64) * ((N_IN_REST + 31) / 32), IT_WO = (512 / 64) * (DM / 32), IT_WOUT = (DM / 64) * (DM / 32);
        constexpr int total = IT_WIN0 + IT_WIN1 + 6 * IT_WO + 2 * IT_WOUT + (DM / 64) * (2 * DENSE_FF / 32) + (DENSE_FF / 64) * (DM / 32);
        bf16* wl0 = WSP(bf16, WS_W); bf16* wl1 = WSP(bf16, WS_W + SZ_LAYERW);
#define WOFF(b, o) ((bf16*)((unsigned char*)(b) + (o)))
        for (int it = gw; it < total; it += NGW) {
            int r = it;
            if (conv_job(r, p.w_in_first, DM, N_IN_FIRST, MapWin{(unsigned char*)wl0, 0}, scrw, lane)) continue;
            if (conv_job(r, p.w_in_rest, DM, N_IN_REST, MapWin{(unsigned char*)wl1, 1}, scrw, lane)) continue;
            if (conv_job(r, p.nsa_w_o, 512, DM, MapPlain{WOFF(wl0, OFF_WO3), 512}, scrw, lane)) continue;
            if (conv_job(r, p.rwkv_w_o, 512, DM, MapPlain{WOFF(wl0, OFF_WO3) + (size_t)DM * 512, 512}, scrw, lane)) continue;
            if (conv_job(r, p.conv_w_o, 512, DM, MapPlain{WOFF(wl0, OFF_WO3) + (size_t)2 * DM * 512, 512}, scrw, lane)) continue;
            if (conv_job(r, p.nsa_w_o + (size_t)512 * DM, 512, DM, MapPlain{WOFF(wl1, OFF_WO3), 512}, scrw, lane)) continue;
            if (conv_job(r, p.rwkv_w_o + (size_t)512 * DM, 512, DM, MapPlain{WOFF(wl1, OFF_WO3) + (size_t)DM * 512, 512}, scrw, lane)) continue;
            if (conv_job(r, p.conv_w_o + (size_t)512 * DM, 512, DM, MapPlain{WOFF(wl1, OFF_WO3) + (size_t)2 * DM * 512, 512}, scrw, lane)) continue;
            if (conv_job(r, p.w_out, DM, DM, MapPlain{WOFF(wl0, OFF_WOUT), DM}, scrw, lane)) continue;
            if (conv_job(r, p.w_out + (size_t)DM * DM, DM, DM, MapPlain{WOFF(wl1, OFF_WOUT), DM}, scrw, lane)) continue;
            if (conv_job(r, p.dense_gu, DM, 2 * DENSE_FF, MapGlu{WSP(bf16, WS_DGU), DM, DENSE_FF}, scrw, lane)) continue;
            conv_job(r, p.dense_down, DENSE_FF, DM, MapPlain{WSP(bf16, WS_DDN), DENSE_FF}, scrw, lane);
        }
        for (int l = 0; l < 2; ++l) {
            unsigned char* wlb = p.ws + WS_W + (size_t)l * SZ_LAYERW;
            bf16* win = (bf16*)(wlb + OFF_WIN);
            for (long i = gtid; i < 512L * DM; i += NT) { const int w = (int)(i / DM); const bool src = w < 288 || (w < 320 && l == 1) || (w >= 320 && w < 344); if (!src) win[(size_t)(3840 + w) * DM + i % DM] = 0; }
            bf16* lw = (bf16*)(wlb + OFF_LW);
            for (long i = gtid; i < 2048L * 384; i += NT) { const int n = (int)(i / 384), k = (int)(i % 384), blk = n >> 9, c = n & 511; float v = 0.f;
                if (blk == 0 && k < 64) v = p.w_up[((size_t)l * 64 + k) * RC + c]; else if (blk == 1 && k >= 64 && k < 128) v = p.a_up[((size_t)l * 64 + k - 64) * RC + c];
                else if (blk == 2 && k >= 128 && k < 288) v = p.g_up[((size_t)l * 160 + k - 128) * RC + c]; else if (blk == 3 && k >= 288 && k < 320 && l == 1) v = p.vres_up[(size_t)(k - 288) * RC + c];
                lw[i] = f2bf(v); }
            bf16* cw1 = (bf16*)(wlb + OFF_CW1);
            for (long i = gtid; i < 2L * 256 * 1024; i += NT) { const int k = (int)(i % 1024), n = (int)((i / 1024) % 256), which = (int)(i / (256 * 1024));
                cw1[i] = f2bf(p.cmp_w1[((size_t)(l * 2 + which) * 2048 + (n < 128 ? k : 1024 + k)) * 128 + (n & 127)]); }
            float* pec = (float*)(wlb + OFF_PEC);
            for (long i = gtid; i < 256; i += NT) { const int which = (int)(i >> 7), n = (int)(i & 127); const float* pe = p.cmp_pos + (size_t)(l * 2 + which) * 2048; const float* w1 = p.cmp_w1 + (size_t)(l * 2 + which) * 2048 * 128 + n;
                float s = 0.f; for (int k = 0; k < 2048; ++k) s += pe[k] * w1[(size_t)k * 128]; pec[i] = s; }
        }
        SEAM(0);
    }

    for (int layer = 0; layer < 2; ++layer) {
        const int pb = 1 + layer * NPH;
        if (PHM(0) && IN(pb + 0)) { MKP;
            const float* xin = layer == 0 ? p.x : p.out;
            RMS_LOOP(xin, p.mix_norm_g + (size_t)layer * DM, false, cdum0, cdum1);
            SEAM(pb + 0);
        }
        if (PHM(1) && IN(pb + 1)) { MKP;
            Gemm g{WSP(bf16, WS_H), (const bf16*)(p.ws + WS_W + (size_t)layer * SZ_LAYERW + OFF_WIN), T, NPROJ, DM}; SOrder S; S.init(T, NPROJ, G, bid);
            EpiProj E{p.ws};
            pg8::gemm_phase<EpiProj, SOrder, true, true>(lds, g, S, E, tid);
            SEAM(pb + 1);
        }
        if (PHM(2) && IN(pb + 2)) { MKP;
            { Gemm g{WSP(bf16, AR_CKV), (const bf16*)(p.ws + WS_W + (size_t)layer * SZ_LAYERW + OFF_CW1), 2 * BATCH * NKV * 512, 512, 1024, 0}; StackOrder S{BATCH * NKV * 512 / 256, 1, 2, G, bid};
              EpiStore E{WSP(bf16, AR_HID), 256, 1};
              pg8::gemm_phase<EpiStore, StackOrder, true, true>(lds, g, S, E, tid); }
            ph_shift(p, layer, gtid, NT); ph_nsa_prep(p, layer, gtid, NT); ph_vtrans(p, gtid, NT);
            ph_convw(p, layer, gw, NGW, lane, tid, lds);
#ifdef APROBE_CONV
            ph_convw(p, layer, gw, NGW, lane, tid, lds);
#endif
#ifdef APROBE_VT
            ph_vtrans(p, gtid, NT);
#endif
            SEAM(pb + 2); }
        if (PHM(3) && IN(pb + 3)) { MKP;
#ifndef LORA_NAIVE
            { Gemm g{WSP(bf16, WS_LB), (const bf16*)(p.ws + WS_W + (size_t)layer * SZ_LAYERW + OFF_LW), T, 2048, 384, 0}; SOrder S; S.init(T, 2048, G, bid);
              EpiLora E{p.ws};
              pg8::gemm_phase<EpiLora, SOrder, false, true>(lds, g, S, E, tid); }
#else
            { bf16* RW = WSP(bf16, AR_RW); bf16* Wm = WSP(bf16, AR_W); bf16* Am = WSP(bf16, AR_A); bf16* Gm = WSP(bf16, AR_G); const bf16* VF = WSP(bf16, WS_VF);
              const float* vec = p.rwkv_vec + (size_t)layer * 7 * RC; const float* wup = p.w_up + (size_t)layer * 64 * RC; const float* aup = p.a_up + (size_t)layer * 64 * RC; const float* gup = p.g_up + (size_t)layer * 160 * RC;
              for (long it = gtid; it < (long)T * RC; it += NT) { const int t = (int)(it / RC), c = (int)(it % RC); bf16* row = RW + (size_t)t * LDRW; const bf16* L = row + LBLK;
                  float wl = vec[c], alin = vec[RC + c], g = 0.f;
                  for (int j = 0; j < 64; ++j) { wl += bf2f(L[j]) * bf2f(f2bf(wup[j * RC + c])); alin += bf2f(L[64 + j]) * bf2f(f2bf(aup[j * RC + c])); }
                  for (int j = 0; j < 160; ++j) g += bf2f(L[128 + j]) * bf2f(f2bf(gup[j * RC + c]));
                  const float nx = -wl, sp = fmaxf(nx, 0.f) + __logf(1.f + __expf(-fabsf(nx))), e = __expf(-sp - 0.5f);
                  Wm[it] = f2bf(1.f - __expf(-e)); Am[it] = f2bf(fsig(alin)); Gm[it] = f2bf(g);
                  if (layer == 1) { float vl = p.vres_b[c]; for (int j = 0; j < 32; ++j) vl += bf2f(L[288 + j]) * bf2f(f2bf(p.vres_up[j * RC + c]));
                      const float v = bf2f(row[1024 + c]), vf = bf2f(VF[it]); row[1024 + c] = f2bf(v + (vf - v) * fsig(vl)); } } }
#endif
            SEAM(pb + 3); }
        if (PHM(4) && IN(pb + 4)) { MKP; ph_rwkv_b2w(p, layer, gw, NGW, lane); ph_cmp2w(p, layer, gw, NGW, lane, (LAS float*)(lds + wave * 512)); SEAM(pb + 4); }
        if (PHM(5) && IN(pb + 5)) { MKP;
            { LAS unsigned char* wl = lds + wave * AW_BYTES; constexpr int NSC = BATCH * 8 * 16, NIT = BATCH * NKV * (SEQ / 16);
#ifndef SCAN_QUEUE
              if (wave < 4) {
                  if (G * 4 == NSC && (G & 7) == 0) scan_unit(p, (bid & 7) * (NSC / 8) + (bid >> 3) * 4 + wave, lane, wl);
                  else for (int u = bid * 4 + wave; u < NSC; u += G * 4) scan_unit(p, u, lane, wl); }
#endif
#ifdef APROBE_SPLIT
              xcd_barrier(bar, tid);
#endif
              const int xme = (int)(xb_xcc_id() & 7u);
              for (int qq = 0; qq < 8; ++qq) { const int qx = (xme + qq) & 7; unsigned* head = ctl + CW_ATT + ((layer * 3 + st) * 8 + qx) * 16;
                  for (;;) { int it = 0; if (lane == 0) it = (int)atomicAdd(head, 1u); it = __builtin_amdgcn_readfirstlane(it); if (it >= NIT / 8) break;
                      const int bg = 2 * qx + it / (SEQ / 16), t16 = (SEQ / 16 - 1) - it % (SEQ / 16);
                      nsa_attn_item(p, bg * (SEQ / 16) + t16, lane, wl); } } }
 SEAM(pb + 5); }
        if (PHM(6) && IN(pb + 6)) { MKP; ph_rwkv_postw(p, layer, gw, NGW, lane); SEAM(pb + 6); }
        if (PHM(7) && IN(pb + 7)) { MKP;
            Gemm g{WSP(bf16, AR_QB), (const bf16*)(p.ws + WS_W + (size_t)layer * SZ_LAYERW + OFF_WO3), 3 * T, 3 * DM, 512}; StackOrder S{T / 256, DM / 256, 3, G, bid};
            EpiStore E{WSP(bf16, AR_OBUF), DM, DM / 256};
            pg8::gemm_phase<EpiStore, StackOrder, true, true>(lds, g, S, E, tid);
            { MKP; const float* xin = layer == 0 ? p.x : p.out;
              RMS_LOOP(xin, p.mix_norm_g + (size_t)layer * DM, false, cdum0, cdum1); }
            SEAM(pb + 7);
        }
        if (PHM(8) && IN(pb + 8)) { MKP;
            Gemm g{WSP(bf16, WS_H), (const bf16*)(p.ws + WS_W + (size_t)layer * SZ_LAYERW + OFF_WG), T, 3 * DM, DM}; GateOrder S{T / 256, DM / 256, G, bid};
            EpiGate E{p.ws, DM / 256};
            pg8::gemm_phase<EpiGate, GateOrder, true, true>(lds, g, S, E, tid);
            SEAM(pb + 8);
        }
        if (PHM(9) && IN(pb + 9)) { MKP;
            Gemm g{WSP(bf16, AR_MIX), (const bf16*)(p.ws + WS_W + (size_t)layer * SZ_LAYERW + OFF_WOUT), T, DM, DM}; SOrder S; S.init(T, DM, G, bid);
            EpiResid E{layer == 0 ? p.x : p.out, p.out};
            pg8::gemm_phase<EpiResid, SOrder, true, true>(lds, g, S, E, tid);
            SEAM(pb + 9);
        }
        if (PHM(10) && IN(pb + 10)) { MKP;
            unsigned long long c0 = 0ull, c1 = 0ull;
            RMS_LOOP(p.out, p.ffn_norm_g + (size_t)layer * DM, layer == 1, c0, c1);
            if (layer == 1 && lane < 16) {
                const unsigned cn = (unsigned)(((lane < 8 ? c0 : c1) >> (8 * (lane & 7))) & 255ull);
                WSP(unsigned, AR_WBASE)[(size_t)gw * 16 + lane] = atomicAdd(ctl + CW_CNT + lane * 64, cn); }
            if (layer == 1) { int* rt = WSP(int, AR_RTOK); for (long i = gtid; i < 2L * MOE_ROWS; i += NT) rt[i] = -1; }
            SEAM(pb + 10);
        }
        if (layer == 0) {
            if (PHM(11) && IN(pb + 11)) { MKP;
                Gemm g{WSP(bf16, WS_H), WSP(bf16, WS_DGU), T, 2 * DENSE_FF, DM}; SOrder S; S.init(T, 2 * DENSE_FF, G, bid);
                EpiSwiglu E{WSP(bf16, AR_ACT), DENSE_FF, 2 * DENSE_FF / 256};
                pg8::gemm_phase<EpiSwiglu, SOrder, true, true>(lds, g, S, E, tid);
                SEAM(pb + 11);
            }
            if (PHM(12) && IN(pb + 12)) { MKP;
                Gemm g{WSP(bf16, AR_ACT), WSP(bf16, WS_DDN), T, DM, DENSE_FF}; SOrder S; S.init(T, DM, G, bid);
                EpiResid E{p.out, p.out};
                pg8::gemm_phase<EpiResid, SOrder, true, true>(lds, g, S, E, tid);
                SEAM(pb + 12);
            }
        } else {
            if (PHM(11) && IN(pb + 11)) { MKP;
                const int ig = (DM / 64) * (2 * EXPERT_FF / 32), id = (EXPERT_FF / 64) * (DM / 32);
                for (int it = gw; it < NEXP * (ig + id); it += NGW) { const int e = it / (ig + id); int r = it % (ig + id);
                    if (conv_job(r, p.moe_gu + (size_t)e * DM * 2 * EXPERT_FF, DM, 2 * EXPERT_FF, MapGlu{WSP(bf16, AR_MGU) + (size_t)e * 2 * EXPERT_FF * DM, DM, EXPERT_FF}, scrw, lane)) continue;
                    conv_job(r, p.moe_down + (size_t)e * EXPERT_FF * DM, EXPERT_FF, DM, MapPlain{WSP(bf16, AR_MDN) + (size_t)e * DM * EXPERT_FF, EXPERT_FF}, scrw, lane); }
                int* rtok = WSP(int, AR_RTOK); float* rww = WSP(float, AR_RW8); int* trow = WSP(int, AR_TROW);
                int segv = 0; { const int pc = lane < 16 ? (int)((ctl[CW_CNT + lane * 64] + 255u) & ~255u) : 0;
#pragma unroll
                    for (int k = 0; k < 8; ++k) { const int ck = bperm_i(pc, (lane & 8) + k); segv += (k < (lane & 7)) ? ck : 0; } }
                for (int tb = gw * 64; tb < T; tb += NGW * 64) {
                    const int t = tb + lane; const int ee = WSP(int, AR_RTE)[t], e0 = ee & 255, e1 = (ee >> 8) & 255, r0 = (ee >> 16) & 255, r1 = (ee >> 24) & 255;
                    const float* w = WSP(float, AR_RTW) + (size_t)t * 2; const unsigned* wb = WSP(unsigned, AR_WBASE) + (size_t)(t % NGW) * 16;
                    const int row0 = bperm_i(segv, e0) + (int)wb[e0] + r0, row1 = bperm_i(segv, 8 + e1) + (int)wb[8 + e1] + r1;
                    rtok[row0] = t; rww[row0] = w[0]; rtok[MOE_ROWS + row1] = t; rww[MOE_ROWS + row1] = w[1]; trow[T + t] = row1;
                    for (int l = 0; l < 64; l += 4) { const bf16* hs = WSP(bf16, WS_H) + (size_t)(tb + l) * DM; bf16* xg = WSP(bf16, AR_XG);
                        copy_rows4(hs, hs + DM, hs + 2 * DM, hs + 3 * DM, xg + (size_t)__builtin_amdgcn_readlane(row0, l) * DM, xg + (size_t)__builtin_amdgcn_readlane(row0, l + 1) * DM, xg + (size_t)__builtin_amdgcn_readlane(row0, l + 2) * DM, xg + (size_t)__builtin_amdgcn_readlane(row0, l + 3) * DM, lane); }
                }
                SEAM(pb + 11);
            }
#pragma unroll
            for (int pass = 0; pass < 2; ++pass) {
                if (PHM(12) && IN(pb + 12 + 2 * pass)) { MKP;
                    Gemm g{WSP(bf16, AR_XG), WSP(bf16, AR_MGU), MOE_ROWS, NEXP * 2 * EXPERT_FF, DM}; MoeOrder S; S.init(ctl + CW_CNT + 8 * 64 * pass, 2 * EXPERT_FF / 256, G, bid);
                    EpiSwiglu E{WSP(bf16, AR_MACT), EXPERT_FF, 2 * EXPERT_FF / 256};
                    pg8::gemm_phase<EpiSwiglu, MoeOrder, true, true>(lds, g, S, E, tid);
                    SEAM(pb + 12 + 2 * pass);
                }
                if (PHM(13) && IN(pb + 13 + 2 * pass)) { MKP;
                    Gemm g{WSP(bf16, AR_MACT), WSP(bf16, AR_MDN), MOE_ROWS, NEXP * DM, EXPERT_FF}; MoeOrder S; S.init(ctl + CW_CNT + 8 * 64 * pass, DM / 256, G, bid);
                    EpiMoeDown E{p.out, WSP(int, AR_RTOK) + (size_t)pass * MOE_ROWS, WSP(float, AR_RW8) + (size_t)pass * MOE_ROWS, DM / 256, (PR_LO >= 0 && st == 0 && pb + 13 + 2 * pass >= PR_LO && pb + 13 + 2 * pass <= PR_HI) ? 0.f : 1.f};
                    pg8::gemm_phase<EpiMoeDown, MoeOrder, true, true>(lds, g, S, E, tid);
                    if (pass == 0) { const int* trow = WSP(int, AR_TROW);
                        for (int t = gw * 4; t < T; t += NGW * 4) { const bf16* hs = WSP(bf16, WS_H) + (size_t)t * DM; bf16* xg = WSP(bf16, AR_XG);
                            copy_rows4(hs, hs + DM, hs + 2 * DM, hs + 3 * DM, xg + (size_t)trow[T + t] * DM, xg + (size_t)trow[T + t + 1] * DM, xg + (size_t)trow[T + t + 2] * DM, xg + (size_t)trow[T + t + 3] * DM, lane); } }
                    SEAM(pb + 13 + 2 * pass);
                }
            }
        }
    }
    }
#undef IN
#undef SEAM
}

#ifndef MK_ONE_LAUNCH
#define MK_ONE_LAUNCH 1
#endif
extern "C" void kernel_launch(void* const* d_in, const int* in_sizes, int n_in, void* d_out, int out_size, void* d_ws, size_t ws_size, hipStream_t stream) {
    static int grid = 0;
    if (grid == 0) {
        if (n_in != 29 || in_sizes[0] != T * DM || out_size != T * DM || ws_size < WS_END) { fprintf(stderr, "kernel_launch: unexpected shapes / workspace (%d inputs, ws %zu, need %zu)\n", n_in, ws_size, (size_t)WS_END); grid = -1; return; }
        int dev = 0, cus = 0;
        if (hipGetDevice(&dev) != hipSuccess || hipDeviceGetAttribute(&cus, hipDeviceAttributeMultiprocessorCount, dev) != hipSuccess) { grid = -1; return; }
        if (hipFuncSetAttribute((const void*)mk_fwd, hipFuncAttributeMaxDynamicSharedMemorySize, LDS_BYTES) != hipSuccess) { fprintf(stderr, "kernel_launch: hipFuncSetAttribute failed\n"); grid = -1; return; }
        int per_cu = 0;
        if (hipOccupancyMaxActiveBlocksPerMultiprocessor(&per_cu, (const void*)mk_fwd, NTHREADS, LDS_BYTES) != hipSuccess || per_cu < 1) { fprintf(stderr, "kernel_launch: occupancy query says %d\n", per_cu); }
        (void)hipGetLastError();
        grid = cus;
    }
    if (grid < 0) return;
    if (hipMemsetAsync((char*)d_ws + WS_CTL, 0, CTL_BYTES, stream) != hipSuccess) return;
    Args a{};
    for (int i = 0; i < 29; ++i) a.in[i] = (const float*)d_in[i];
    a.out = (float*)d_out; a.ws = (unsigned char*)d_ws;
#if MK_ONE_LAUNCH
    a.ph_lo = 0; a.ph_hi = NPHASES;
    hipLaunchKernelGGL(mk_fwd, dim3(grid), dim3(NTHREADS), LDS_BYTES, stream, a);
#else
    for (int k = 0; k < NPHASES; ++k) {
        if (k >= 1 + 13 && k < 1 + NPH) continue;
        a.ph_lo = k; a.ph_hi = k + 1;
        hipLaunchKernelGGL(mk_fwd, dim3(grid), dim3(NTHREADS), LDS_BYTES, stream, a);
    }
#endif
}
```

```cpp
#include <hip/hip_runtime.h>
#include <cstdio>
#include <cstdint>
#include <cmath>
#include <cstring>
#ifdef HOST_EMU
#define HD
#define DEV_INLINE inline
#else
#define HD __host__ __device__
#define DEV_INLINE __device__ __forceinline__
#endif

typedef unsigned short bf16;
struct alignas(16) U4 { unsigned x, y, z, w; };

#ifdef SMALL_CFG
constexpr int BATCH = 1, SEQ = 1024, DM = 128, DENSE_FF = 256, EXPERT_FF = 256;
#else
constexpr int BATCH = 8, SEQ = 8192, DM = 1024, DENSE_FF = 2816, EXPERT_FF = 3584;
#endif
constexpr int T = BATCH * SEQ;
constexpr int NHEAD = 8, NKV = 2, HG = 4, DH = 64;
constexpr int NC = SEQ / 16 - 1, NS = SEQ / 64, NSEL = 8, WINDOW = 512;
constexpr int CONV_CH = 512, CONV_K = 31, RC = 512;
constexpr int NEXP = 8;
constexpr int NSA_IN = 1304, OFF_CONV = 1304, OFF_GATE = 2328, OFF_RWKV = OFF_GATE + 3 * DM;
constexpr int N_IN_FIRST = OFF_RWKV + 1824, N_IN_REST = OFF_RWKV + 1856;
constexpr int NPROJ = 4352;
constexpr int LDQ = 512, LDKV = 512, LDRW = 2048, LBLK = 1536;
constexpr int MOE_ROWS = T + NEXP * 256;
constexpr float RMS_EPS = 1e-6f, LN_EPS = 1e-5f, GN_EPS = 64e-5f;

constexpr size_t al(size_t x) { return (x + 255) & ~(size_t)255; }
constexpr size_t WS_CTL = 0, CTL_BYTES = 1u << 20;
constexpr size_t SZ_WIN = (size_t)NPROJ * DM * 2, SZ_WG = (size_t)3 * DM * DM * 2, SZ_WO3 = (size_t)3 * DM * 512 * 2, SZ_WOUT = (size_t)DM * DM * 2;
constexpr size_t SZ_LW = (size_t)2048 * 384 * 2, SZ_CW1 = (size_t)2 * 256 * 1024 * 2, SZ_PEC = 1024;
constexpr size_t SZ_LAYERW = SZ_WIN + SZ_WG + SZ_WO3 + SZ_WOUT + SZ_LW + SZ_CW1 + SZ_PEC;
constexpr size_t WS_W = CTL_BYTES;
constexpr size_t OFF_WIN = 0, OFF_WG = SZ_WIN, OFF_WO3 = OFF_WG + SZ_WG, OFF_WOUT = OFF_WO3 + SZ_WO3, OFF_LW = OFF_WOUT + SZ_WOUT, OFF_CW1 = OFF_LW + SZ_LW, OFF_PEC = OFF_CW1 + SZ_CW1;
constexpr size_t WS_DGU = WS_W + 2 * SZ_LAYERW, SZ_DGU = (size_t)2 * DENSE_FF * DM * 2;
constexpr size_t WS_DDN = WS_DGU + SZ_DGU, SZ_DDN = (size_t)DM * DENSE_FF * 2;
constexpr size_t WS_VF = al(WS_DDN + SZ_DDN), SZ_TC = (size_t)T * 512 * 2;
constexpr size_t WS_H = WS_VF + SZ_TC, SZ_H = (size_t)T * DM * 2;
constexpr size_t WS_AR = al(WS_H + SZ_H);
constexpr size_t AR_QB = WS_AR, AR_A = AR_QB + SZ_TC, AR_CO = AR_A + SZ_TC;
constexpr size_t AR_KV = AR_CO + SZ_TC, SZ_KV = (size_t)T * LDKV * 2;
constexpr size_t AR_RW = AR_KV + SZ_KV, SZ_RW = (size_t)T * LDRW * 2;
constexpr size_t AR_W = AR_RW + SZ_RW, AR_G = AR_W + SZ_TC, AR_UB = AR_G + SZ_TC;
constexpr size_t AR_NG = AR_UB + SZ_TC, SZ_NG = (size_t)T * 24 * 4;
constexpr size_t AR_HALO = al(AR_NG + SZ_NG), SZ_HALO = (size_t)(T / 256) * LDRW * 2;
constexpr size_t AR_KC = al(AR_HALO + SZ_HALO), SZ_CMP = (size_t)BATCH * NKV * (SEQ / 16) * 64 * 2;
constexpr size_t AR_VC = AR_KC + SZ_CMP;
constexpr size_t AR_HID = al(AR_VC + SZ_CMP), SZ_HID = (size_t)BATCH * NKV * (SEQ / 16) * 2 * 128 * 4;
constexpr size_t AR_SEL = al(AR_HID + SZ_HID), SZ_SEL = (size_t)T * NKV * 8 * 4;
constexpr size_t AR_INVN = al(AR_SEL + SZ_SEL), SZ_INVN = (size_t)T * 8 * 4;
constexpr size_t AR_VCT = al(AR_INVN + SZ_INVN);
constexpr size_t AR_CKV = al(AR_VCT + SZ_CMP), SZ_CKV = (size_t)2 * T * 128;
constexpr size_t AR_END1 = al(AR_CKV + SZ_CKV * 2);
constexpr size_t WS_VST = WS_H, WS_VWT = WS_H + (size_t)T * 128 * 2, WS_LB = WS_VWT + (size_t)T * 128 * 2, WS_KS8 = WS_LB + (size_t)T * 384 * 2, WS_KW8 = WS_KS8 + (size_t)T * 128 * 2;
constexpr size_t AR_OBUF = AR_KV, SZ_OBUF = (size_t)3 * T * DM * 2;
constexpr size_t AR_MIX = AR_OBUF + SZ_OBUF, SZ_MIX = (size_t)T * DM * 2;
constexpr size_t AR_END2 = AR_MIX + SZ_MIX;
constexpr size_t AR_ACT = WS_AR;
constexpr size_t AR_MGU = WS_AR, SZ_MGU = (size_t)NEXP * 2 * EXPERT_FF * DM * 2;
constexpr size_t AR_MDN = AR_MGU + SZ_MGU, SZ_MDN = (size_t)NEXP * DM * EXPERT_FF * 2;
constexpr size_t AR_XG = al(AR_MDN + SZ_MDN), SZ_XG = (size_t)MOE_ROWS * DM * 2;
constexpr size_t AR_MACT = al(AR_XG + SZ_XG), SZ_MACT = (size_t)MOE_ROWS * EXPERT_FF * 2;
constexpr size_t AR_RTOK = al(AR_MACT + SZ_MACT), SZ_RTOK = (size_t)2 * MOE_ROWS * 4;
constexpr size_t AR_RW8 = al(AR_RTOK + SZ_RTOK);
constexpr size_t AR_TROW = al(AR_RW8 + SZ_RTOK), SZ_TROW = (size_t)2 * T * 4;
constexpr size_t AR_RTE = al(AR_TROW + SZ_TROW);
constexpr size_t AR_RTW = al(AR_RTE + (size_t)T * 4);
constexpr size_t AR_WBASE = al(AR_RTW + (size_t)T * 8);
constexpr size_t AR_END3 = al(AR_WBASE + (size_t)4096 * 16 * 4);
constexpr size_t WS_END = (AR_END1 > AR_END2 ? (AR_END1 > AR_END3 ? AR_END1 : AR_END3) : (AR_END2 > AR_END3 ? AR_END2 : AR_END3));
constexpr int CW_CNT = 1024;
constexpr int CW_ATT = 256;
constexpr int CW_BAR = 4096;

struct P {
    const float *x, *mix_norm_g, *w_in_first, *w_in_rest, *mu_first, *mu_rest, *qk_g, *cmp_pos, *cmp_w1, *cmp_w2, *nsa_w_o, *conv_w, *conv_vec, *conv_w_o,
        *rwkv_vec, *w_up, *a_up, *g_up, *vres_up, *vres_b, *rwkv_w_o, *w_out, *ffn_norm_g, *dense_gu, *dense_down, *router_w, *router_b, *moe_gu, *moe_down;
    float* out; unsigned char* ws;
};
HD inline void fill_params(P& p, const float* const* in, float* out, unsigned char* ws) {
    p.x = in[0]; p.mix_norm_g = in[1]; p.w_in_first = in[2]; p.w_in_rest = in[3]; p.mu_first = in[4]; p.mu_rest = in[5]; p.qk_g = in[6]; p.cmp_pos = in[7];
    p.cmp_w1 = in[8]; p.cmp_w2 = in[9]; p.nsa_w_o = in[10]; p.conv_w = in[11]; p.conv_vec = in[12]; p.conv_w_o = in[13]; p.rwkv_vec = in[14]; p.w_up = in[15];
    p.a_up = in[16]; p.g_up = in[17]; p.vres_up = in[18]; p.vres_b = in[19]; p.rwkv_w_o = in[20]; p.w_out = in[21]; p.ffn_norm_g = in[22]; p.dense_gu = in[23];
    p.dense_down = in[24]; p.router_w = in[25]; p.router_b = in[26]; p.moe_gu = in[27]; p.moe_down = in[28]; p.out = out; p.ws = ws;
}
#define WSP(type, off) ((type*)(p.ws + (off)))

#ifdef HOST_EMU
#define FENCE()
#else
#define FENCE() asm volatile("" ::: "memory")
#endif
HD inline float bf2f(bf16 v) { unsigned u = (unsigned)v << 16; float f; memcpy(&f, &u, 4); return f; }
HD inline bf16 f2bf(float f) { unsigned u; memcpy(&u, &f, 4); return (bf16)((u + 0x7fffu + ((u >> 16) & 1u)) >> 16); }
HD inline float blo(unsigned v) { unsigned u = v << 16; float f; memcpy(&f, &u, 4); return f; }
HD inline float bhi(unsigned v) { unsigned u = v & 0xffff0000u; float f; memcpy(&f, &u, 4); return f; }
#if !defined(SCAN_BF16) && !defined(RKV_BF16)
HD inline bf16 f2h(float f) { return __builtin_bit_cast(unsigned short, (_Float16)f); }
#else
HD inline bf16 f2bf(float f);
HD inline bf16 f2h(float f) { return f2bf(f); }
#endif
HD inline float h2f(bf16 v) { return (float)__builtin_bit_cast(_Float16, v); }
HD inline float sigmoidf_(float x) { return 1.f / (1.f + expf(-x)); }
HD inline float dot64(const float* q, const bf16* kp) {
    const U4* k4 = (const U4*)kp; float s0 = 0.f, s1 = 0.f;
#pragma unroll
    for (int i = 0; i < 8; ++i) { const U4 v = k4[i];
        s0 += q[8 * i + 0] * blo(v.x) + q[8 * i + 2] * blo(v.y) + q[8 * i + 4] * blo(v.z) + q[8 * i + 6] * blo(v.w);
        s1 += q[8 * i + 1] * bhi(v.x) + q[8 * i + 3] * bhi(v.y) + q[8 * i + 5] * bhi(v.z) + q[8 * i + 7] * bhi(v.w); }
    return s0 + s1;
}
HD inline float dot64p(const U4* q, const bf16* kp) {
    const U4* k4 = (const U4*)kp; float s0 = 0.f, s1 = 0.f;
#pragma unroll
    for (int i = 0; i < 8; ++i) { const U4 v = k4[i], w = q[i];
        s0 += blo(w.x) * blo(v.x) + blo(w.y) * blo(v.y) + blo(w.z) * blo(v.z) + blo(w.w) * blo(v.w);
        s1 += bhi(w.x) * bhi(v.x) + bhi(w.y) * bhi(v.y) + bhi(w.z) * bhi(v.z) + bhi(w.w) * bhi(v.w); }
    return s0 + s1;
}
HD inline void ld64(const bf16* kp, float* q) {
    const U4* k4 = (const U4*)kp;
#pragma unroll
    for (int i = 0; i < 8; ++i) { const U4 v = k4[i]; q[8 * i] = blo(v.x); q[8 * i + 1] = bhi(v.x); q[8 * i + 2] = blo(v.y); q[8 * i + 3] = bhi(v.y);
        q[8 * i + 4] = blo(v.z); q[8 * i + 5] = bhi(v.z); q[8 * i + 6] = blo(v.w); q[8 * i + 7] = bhi(v.w); }
}
HD inline void axpy64(float* o, float w, const bf16* vp) {
    const U4* k4 = (const U4*)vp;
#pragma unroll
    for (int i = 0; i < 8; ++i) { const U4 v = k4[i]; o[8 * i] += w * blo(v.x); o[8 * i + 1] += w * bhi(v.x); o[8 * i + 2] += w * blo(v.y); o[8 * i + 3] += w * bhi(v.y);
        o[8 * i + 4] += w * blo(v.z); o[8 * i + 5] += w * bhi(v.z); o[8 * i + 6] += w * blo(v.w); o[8 * i + 7] += w * bhi(v.w); }
}
HD inline void axpy64s(float* o, float w, const bf16* vp) {
    const U4* k4 = (const U4*)vp;
#pragma unroll
    for (int i = 0; i < 8; ++i) { const U4 v = k4[i]; o[8 * i] = w * o[8 * i] + blo(v.x); o[8 * i + 1] = w * o[8 * i + 1] + bhi(v.x); o[8 * i + 2] = w * o[8 * i + 2] + blo(v.y); o[8 * i + 3] = w * o[8 * i + 3] + bhi(v.y);
        o[8 * i + 4] = w * o[8 * i + 4] + blo(v.z); o[8 * i + 5] = w * o[8 * i + 5] + bhi(v.z); o[8 * i + 6] = w * o[8 * i + 6] + blo(v.w); o[8 * i + 7] = w * o[8 * i + 7] + bhi(v.w); }
}
HD inline void st64(bf16* op, const float* o) {
    U4* o4 = (U4*)op;
#pragma unroll
    for (int i = 0; i < 8; ++i) { U4 v; v.x = (unsigned)f2bf(o[8 * i]) | ((unsigned)f2bf(o[8 * i + 1]) << 16); v.y = (unsigned)f2bf(o[8 * i + 2]) | ((unsigned)f2bf(o[8 * i + 3]) << 16);
        v.z = (unsigned)f2bf(o[8 * i + 4]) | ((unsigned)f2bf(o[8 * i + 5]) << 16); v.w = (unsigned)f2bf(o[8 * i + 6]) | ((unsigned)f2bf(o[8 * i + 7]) << 16); o4[i] = v; }
}

HD inline void rope_cs(int pos, int i, float& cs, float& sn) {
    const float c = exp2f(-(float)i * 0.41524101186092f) * 0.15915494309189535f, pf = (float)pos;
    const float prod = pf * c, err = fmaf(pf, c, -prod), fr = (prod - rintf(prod)) + err;
#ifdef HOST_EMU
    cs = cosf(6.283185307179586f * fr); sn = sinf(6.283185307179586f * fr);
#else
    cs = __builtin_amdgcn_cosf(fr); sn = __builtin_amdgcn_sinf(fr);
#endif
}
HD inline int win_dest(int j, int layer, int& which) {
    which = 0;
    if (j < 1280) return j;
    if (j < 1304) return 3840 + 320 + (j - 1280);
    if (j < 1816) { const int cc = j - 1304; return 1280 + 256 * (cc / 128) + cc % 128; }
    if (j < 2328) { const int cc = j - 1816; return 1280 + 256 * (cc / 128) + 128 + cc % 128; }
    if (j < OFF_RWKV) { which = 1; const int gg = j - OFF_GATE, br = gg / DM; return (br == 0 ? 0 : (br == 1 ? 2 * DM : DM)) + gg % DM; }
    const int rr = j - OFF_RWKV;
    if (rr < 1536) return 2304 + rr;
    if (rr < 1824) return 3840 + (rr - 1536);
    if (rr < 1856 && layer == 1) return 3840 + 288 + (rr - 1824);
    return -1;
}
HD inline int glu_dest(int j, int ff) { return j < ff ? 256 * (j / 128) + j % 128 : 256 * ((j - ff) / 128) + 128 + (j - ff) % 128; }

DEV_INLINE void ph_shift(const P& p, int layer, long gtid, long NT) {
    bf16* RW = WSP(bf16, AR_RW); const bf16* HALO = WSP(bf16, AR_HALO); bf16* VF = WSP(bf16, WS_VF); bf16* LB = WSP(bf16, WS_LB);
    const float* mu = layer == 0 ? p.mu_first : p.mu_rest;
    const long n = (long)(T / 256) * (LBLK + 384);
    for (long it = gtid; it < n; it += NT) {
        const int pm = (int)(it / (LBLK + 384)), c = (int)(it % (LBLK + 384));
        int mi = -1, act = 0;
        if (c < LBLK) mi = c;
        else { const int w = c - LBLK; if (w < 288) { mi = 1536 + w; act = w < 64 ? 1 : (w >= 128 ? 2 : 0); } else if (w < 320 && layer == 1) mi = 1824 + (w - 288); }
        if (mi < 0) { for (int r = 0; r < 256; ++r) LB[((size_t)pm * 256 + r) * 384 + (c - LBLK)] = 0; continue; }
        const float m = mu[mi];
        float prev = ((pm * 256) % SEQ == 0) ? 0.f : bf2f(HALO[(size_t)(pm - 1) * LDRW + c]);
        bf16* col = RW + (size_t)pm * 256 * LDRW + c;
        for (int r0 = 0; r0 < 256; r0 += 16) {
            float pv[16];
#pragma unroll
            for (int k = 0; k < 16; ++k) pv[k] = bf2f(col[(size_t)(r0 + k) * LDRW]);
#pragma unroll
            for (int k = 0; k < 16; ++k) { const int r = r0 + k;
                float u = pv[k] + (prev - pv[k]) * m; prev = pv[k];
                if (act == 1) u = tanhf(u); else if (act == 2) u = sigmoidf_(u);
                if (c < LBLK) { col[(size_t)r * LDRW] = f2h(u); if (layer == 0 && c >= 1024) VF[((size_t)pm * 256 + r) * RC + (c - 1024)] = f2h(u); }
                else LB[((size_t)pm * 256 + r) * 384 + (c - LBLK)] = f2bf(u); }
        }
    }
}

DEV_INLINE void ph_nsa_prep(const P& p, int layer, long gtid, long NT) {
    bf16* QB = WSP(bf16, AR_QB); bf16* KV = WSP(bf16, AR_KV);
    const long n = (long)T * 12;
    for (long it = gtid; it < n; it += NT) {
        const int t = (int)(it / 12), s = (int)(it % 12), pos = t % SEQ;
        bf16* ptr; const float* g;
        if (s < 8) { ptr = QB + (size_t)t * LDQ + s * 64; g = p.qk_g + (layer * 4 + 0) * 64; }
        else if (s < 10) { ptr = KV + (size_t)t * LDKV + (s - 8) * 64; g = p.qk_g + (layer * 4 + 2) * 64; }
        else { ptr = KV + (size_t)t * LDKV + 256 + (s - 10) * 64; g = p.qk_g + (layer * 4 + 3) * 64; }
        float v[64]; ld64(ptr, v);
        float ss = 0.f;
#pragma unroll
        for (int i = 0; i < 64; ++i) ss += v[i] * v[i];
        const float rs = 1.f / sqrtf(ss * (1.f / 64.f) + RMS_EPS);
#pragma unroll
        for (int i = 0; i < 64; ++i) v[i] = v[i] * rs * g[i];
#pragma unroll
        for (int i = 0; i < 32; ++i) {
            float cs, sn; rope_cs(pos, i, cs, sn);
            const float x1 = v[i], x2 = v[i + 32]; v[i] = x1 * cs - x2 * sn; v[i + 32] = x2 * cs + x1 * sn;
        }
        if (s < 8) {
#pragma unroll
            for (int i = 0; i < 64; ++i) v[i] *= 0.125f * 1.4426950408889634f; }
        if (s < 8) st64(ptr, v);
        else {
            const int gg = (s - 8) & 1, bq = t / SEQ; bf16* k8 = WSP(bf16, s < 10 ? WS_KS8 : WS_KW8) + (size_t)(bq * NKV + gg) * 8 * SEQ * 8;
#pragma unroll
            for (int dg = 0; dg < 8; ++dg) { U4 w; w.x = (unsigned)f2bf(v[8 * dg]) | ((unsigned)f2bf(v[8 * dg + 1]) << 16); w.y = (unsigned)f2bf(v[8 * dg + 2]) | ((unsigned)f2bf(v[8 * dg + 3]) << 16);
                w.z = (unsigned)f2bf(v[8 * dg + 4]) | ((unsigned)f2bf(v[8 * dg + 5]) << 16); w.w = (unsigned)f2bf(v[8 * dg + 6]) | ((unsigned)f2bf(v[8 * dg + 7]) << 16);
                *(U4*)(k8 + ((size_t)dg * SEQ + pos) * 8) = w; } }
    }
}

DEV_INLINE void ph_vtrans(const P& p, long gtid, long NT) {
    const bf16* KV = WSP(bf16, AR_KV); bf16* VsT = WSP(bf16, WS_VST); bf16* VwT = WSP(bf16, WS_VWT);
    const long n = (long)BATCH * NKV * (SEQ / 8) * 64;
    for (long it = gtid; it < n; it += NT) {
        const int d = (int)(it % 64); long r = it / 64; const int kg = (int)(r % (SEQ / 8)); const int bg = (int)(r / (SEQ / 8)), b = bg / NKV, g = bg % NKV;
        const int kbase = (kg >> 2) * 32 + 4 * (kg & 3);
        const bf16* src = KV + (size_t)(b * SEQ + kbase) * LDKV + g * 64 + d;
        U4 s, w; unsigned short sv[8], wv[8];
#pragma unroll
        for (int j = 0; j < 8; ++j) { const size_t ro = (size_t)((j & 3) + 16 * (j >> 2)) * LDKV; sv[j] = src[ro + 128]; wv[j] = src[ro + 384]; }
        s.x = sv[0] | ((unsigned)sv[1] << 16); s.y = sv[2] | ((unsigned)sv[3] << 16); s.z = sv[4] | ((unsigned)sv[5] << 16); s.w = sv[6] | ((unsigned)sv[7] << 16);
        w.x = wv[0] | ((unsigned)wv[1] << 16); w.y = wv[2] | ((unsigned)wv[3] << 16); w.z = wv[4] | ((unsigned)wv[5] << 16); w.w = wv[6] | ((unsigned)wv[7] << 16);
        *(U4*)(VsT + (((size_t)bg * (SEQ / 8) + kg) * 64 + d) * 8) = s; *(U4*)(VwT + (((size_t)bg * (SEQ / 8) + kg) * 64 + d) * 8) = w;
    }
}
namespace pg8 {
#define PG8_LAS __attribute__((address_space(3)))
typedef unsigned short bf16_t;
typedef short bf16x8 __attribute__((ext_vector_type(8)));
typedef float f32x4 __attribute__((ext_vector_type(4)));
typedef unsigned u32x4 __attribute__((ext_vector_type(4)));
constexpr int BM = 256, BK = 64, HALF = 128, HTB = HALF * BK * 2  , STAGE_BYTES = 8 * HTB, NXCD = 8, WGM = 8;

__host__ __device__ __forceinline__ int lds_byte(int r, int c) { const int st = (r >> 4) * 2 + (c >> 5), rr = r & 15, cc = c & 31, ob = rr * 64 + cc * 2; return st * 1024 + (ob ^ (((ob >> 9) & 1) << 5)); }
__host__ __device__ __forceinline__ void stage_rc(int b, int& R, int& C) { const int st = b / 1024, sb = b % 1024, swz = sb ^ (((sb >> 9) & 1) << 5); R = (st >> 1) * 16 + swz / 64; C = (st & 1) * 32 + (swz % 64) / 2; }
__host__ __device__ __forceinline__ int perm32(int rho) { const int n = rho >> 4, i = rho & 15; return 8 * (i >> 2) + 4 * n + (i & 3); }

struct Unit { int pm, pn; };
struct Gemm { const bf16_t* A; const bf16_t* Bt; int M, N, K; int lda; };

struct StaticOrder {
    int nM, nN, nwg, G, c;
    __host__ __device__ void init(int M, int N, int G_, int c_) { nM = M / BM; nN = N / BM; nwg = nM * nN; G = G_; c = c_; }
    __host__ __device__ bool next(int i, Unit& u) const {
        const long L = (long)i * G + c; if (L >= nwg) return false;
        int wgid = (int)L; { const int q = nwg / NXCD, r = nwg % NXCD, xcd = wgid % NXCD, off = wgid / NXCD; wgid = (xcd < r ? xcd * (q + 1) : r * (q + 1) + (xcd - r) * q) + off; }
        const int nig = WGM * nN, gid = wgid / nig, fm = gid * WGM, gsz = (nM - fm) < WGM ? (nM - fm) : WGM;
        u.pm = fm + ((wgid % nig) % gsz); u.pn = (wgid % nig) / gsz; return true;
    }
    __device__ __forceinline__ void a_ready(const Unit&) const {}
    __device__ __forceinline__ void done(const Unit&) const {}
};

__device__ __forceinline__ unsigned cvt_pk_bf16(float lo, float hi) { unsigned r; asm volatile("v_cvt_pk_bf16_f32 %0, %1, %2" : "=v"(r) : "v"(lo), "v"(hi)); return r; }
typedef float f32x2 __attribute__((ext_vector_type(2)));
template <class Epi, class Sched, bool ALIGN_EPI = false, bool SP2 = false>
__device__ __forceinline__ void gemm_phase(PG8_LAS unsigned char* lds, const Gemm g, const Sched& S, const Epi& E, int tid_in) {
    int tid_ = tid_in; asm volatile("" : "+v"(tid_));
    const int tid = tid_, wid = __builtin_amdgcn_readfirstlane(tid >> 6), lane = tid & 63, wr = wid >> 2, wc = wid & 3, fr = lane & 15, fq = lane >> 4;
    const int K = g.K, nt = K / BK, lda = g.lda ? g.lda : K;
    unsigned voffA[2], voffB[2];
#pragma unroll
    for (int i = 0; i < 2; ++i) { int R, C; stage_rc(tid * 16 + i * 8192, R, C); const int Rb = Epi::PERM ? ((R & ~31) + perm32(R & 31)) : R;
        voffA[i] = (unsigned)(R * lda + C) * 2u; voffB[i] = (unsigned)(Rb * K + C) * 2u; }
    const size_t kstep = (size_t)(BK * 2);
    const size_t hstepA = (size_t)HALF * lda * 2, hstepB = (size_t)HALF * K * 2;
    const size_t hstep_unused = (size_t)HALF * K * 2;
    const size_t tstepA = 2 * hstepA, tstepB = 2 * hstepB;
    const unsigned ldsw = (unsigned)wid * 1024u;
    const int aoff = lds_byte(wr * 64 + fr, fq * 8), boff = lds_byte(wc * 32 + fr, fq * 8);
#define PG8_SA(b, h) (((b) * 2 + (h)) * HTB)
#define PG8_SB(b, h) ((4 + (b) * 2 + (h)) * HTB)
#define PG8_STAGE(bufoff, gbase, voff) do { _Pragma("unroll") for (int _i = 0; _i < 2; ++_i) \
        __builtin_amdgcn_global_load_lds((const unsigned*)((const char*)(gbase) + (voff)[_i]), (PG8_LAS unsigned*)(lds + (bufoff) + ldsw + _i * 8192), 16, 0, 0); } while (0)
#define PG8_LDA(dst, b, h) do { _Pragma("unroll") for (int m = 0; m < 4; ++m) _Pragma("unroll") for (int k = 0; k < 2; ++k) dst[m][k] = *(const PG8_LAS bf16x8*)(lds + PG8_SA(b, h) + aoff + m * 2048 + k * 1024); } while (0)
#define PG8_LDB(dst, b, h) do { _Pragma("unroll") for (int n = 0; n < 2; ++n) _Pragma("unroll") for (int k = 0; k < 2; ++k) dst[n][k] = *(const PG8_LAS bf16x8*)(lds + PG8_SB(b, h) + boff + n * 2048 + k * 1024); } while (0)
#define PG8_MMA(ai, bj, At, Bt) do { __builtin_amdgcn_s_setprio(1); _Pragma("unroll") for (int m = 0; m < 4; ++m) _Pragma("unroll") for (int n = 0; n < 2; ++n) _Pragma("unroll") for (int k = 0; k < 2; ++k) \
        acc[ai][bj][m][n] = __builtin_amdgcn_mfma_f32_16x16x32_bf16(Bt[n][k], At[m][k], acc[ai][bj][m][n], 0, 0, 0); __builtin_amdgcn_s_setprio(0); } while (0)
#define PG8_WAIT_V(n) asm volatile("s_waitcnt vmcnt(" #n ")" ::: "memory")
#define PG8_WAIT_L(n) asm volatile("s_waitcnt lgkmcnt(" #n ")" ::: "memory")
#define PG8_BAR __builtin_amdgcn_s_barrier()
#define PG8_SCHED __builtin_amdgcn_sched_barrier(0)
    Unit cur, nxt; int ui = 0;
    if (!S.next(0, cur)) return;
    f32x4 acc[2][2][4][2];
#pragma unroll
    for (int a = 0; a < 2; ++a)
#pragma unroll
        for (int b = 0; b < 2; ++b)
#pragma unroll
            for (int m = 0; m < 4; ++m)
#pragma unroll
                for (int n = 0; n < 2; ++n) acc[a][b][m][n] = (f32x4){0.f, 0.f, 0.f, 0.f};
    bf16x8 At[4][2], B0[2][2], B1[2][2];
    const char* cA = (const char*)g.A + (size_t)cur.pm * tstepA; const char* cB = (const char*)g.Bt + (size_t)cur.pn * tstepB;
    S.a_ready(cur);
    if constexpr (SP2) {
        PG8_STAGE(PG8_SB(0, 0), cB, voffB); PG8_STAGE(PG8_SB(0, 1), cB + hstepB, voffB); PG8_STAGE(PG8_SA(0, 0), cA, voffA); PG8_STAGE(PG8_SA(0, 1), cA + hstepA, voffA);
        if (wr == 1) PG8_BAR;
        PG8_WAIT_V(2); PG8_BAR;
        PG8_STAGE(PG8_SB(1, 0), cB + kstep, voffB); PG8_STAGE(PG8_SA(1, 0), cA + kstep, voffA); PG8_STAGE(PG8_SB(1, 1), cB + hstepB + kstep, voffB);
        PG8_WAIT_V(6); PG8_BAR;
    } else {
        PG8_STAGE(PG8_SB(0, 0), cB, voffB); PG8_STAGE(PG8_SA(0, 0), cA, voffA); PG8_STAGE(PG8_SB(0, 1), cB + hstepB, voffB); PG8_STAGE(PG8_SA(0, 1), cA + hstepA, voffA);
        if (wr == 1) PG8_BAR;
        PG8_WAIT_V(4); PG8_BAR;
        PG8_STAGE(PG8_SB(1, 0), cB + kstep, voffB); PG8_STAGE(PG8_SA(1, 0), cA + kstep, voffA); PG8_STAGE(PG8_SB(1, 1), cB + hstepB + kstep, voffB);
        PG8_WAIT_V(6); PG8_BAR;
    }
    for (;;) {
        const bool has_next = S.next(ui + 1, nxt);
        const char* nA = has_next ? (const char*)g.A + (size_t)nxt.pm * tstepA : cA; const char* nB = has_next ? (const char*)g.Bt + (size_t)nxt.pn * tstepB : cB;
        for (int t = 0; t < nt; t += 2) {
            const bool last = (t == nt - 2);
            const char* a1 = cA + (size_t)(t + 1) * kstep;
            const char* a2 = last ? nA : cA + (size_t)(t + 2) * kstep; const char* b2 = last ? nB : cB + (size_t)(t + 2) * kstep;
            const char* a3 = a2 + kstep; const char* b3 = b2 + kstep;
            if (last && has_next) S.a_ready(nxt);
            if constexpr (SP2) {
            PG8_LDB(B0, 0, 0); PG8_LDB(B1, 0, 1); PG8_SCHED; PG8_LDA(At, 0, 0); PG8_STAGE(PG8_SA(1, 1), a1 + hstepA, voffA);
            PG8_WAIT_V(8); PG8_WAIT_L(0); PG8_BAR; PG8_MMA(0, 0, At, B0); PG8_MMA(0, 1, At, B1); PG8_BAR; PG8_SCHED;
            PG8_LDA(At, 0, 1); PG8_STAGE(PG8_SB(0, 0), b2, voffB); PG8_STAGE(PG8_SB(0, 1), b2 + hstepB, voffB); PG8_STAGE(PG8_SA(0, 0), a2, voffA);
            PG8_WAIT_V(8); PG8_WAIT_L(0); PG8_BAR; PG8_MMA(1, 0, At, B0); PG8_MMA(1, 1, At, B1); PG8_BAR; PG8_SCHED;
            PG8_LDB(B0, 1, 0); PG8_LDB(B1, 1, 1); PG8_SCHED; PG8_LDA(At, 1, 0); PG8_STAGE(PG8_SA(0, 1), a2 + hstepA, voffA);
            PG8_WAIT_V(8); PG8_WAIT_L(0); PG8_BAR; PG8_MMA(0, 0, At, B0); PG8_MMA(0, 1, At, B1); PG8_BAR; PG8_SCHED;
            PG8_LDA(At, 1, 1); PG8_STAGE(PG8_SB(1, 0), b3, voffB); PG8_STAGE(PG8_SB(1, 1), b3 + hstepB, voffB); PG8_STAGE(PG8_SA(1, 0), a3, voffA);
            PG8_WAIT_V(8); PG8_WAIT_L(0); PG8_BAR; PG8_MMA(1, 0, At, B0); PG8_MMA(1, 1, At, B1); PG8_BAR; PG8_SCHED;
            } else {
            PG8_LDB(B0, 0, 0); PG8_SCHED; PG8_LDA(At, 0, 0); PG8_STAGE(PG8_SA(1, 1), a1 + hstepA, voffA);
            PG8_WAIT_L(8); PG8_BAR; PG8_WAIT_L(0); PG8_MMA(0, 0, At, B0); PG8_BAR; PG8_SCHED;
            PG8_LDB(B1, 0, 1); PG8_STAGE(PG8_SB(0, 0), b2, voffB);
            PG8_BAR; PG8_WAIT_L(0); PG8_MMA(0, 1, At, B1); PG8_BAR;
            PG8_LDA(At, 0, 1); PG8_STAGE(PG8_SA(0, 0), a2, voffA);
            PG8_BAR; PG8_WAIT_L(0); PG8_MMA(1, 0, At, B0); PG8_BAR; PG8_SCHED;
            PG8_STAGE(PG8_SB(0, 1), b2 + hstepB, voffB);
            PG8_WAIT_V(6); PG8_BAR; PG8_MMA(1, 1, At, B1); PG8_BAR;
            PG8_LDB(B0, 1, 0); PG8_SCHED; PG8_LDA(At, 1, 0); PG8_STAGE(PG8_SA(0, 1), a2 + hstepA, voffA);
            PG8_WAIT_L(8); PG8_BAR; PG8_WAIT_L(0); PG8_MMA(0, 0, At, B0); PG8_BAR; PG8_SCHED;
            PG8_LDB(B1, 1, 1); PG8_STAGE(PG8_SB(1, 0), b3, voffB);
            PG8_BAR; PG8_WAIT_L(0); PG8_MMA(0, 1, At, B1); PG8_BAR;
            PG8_LDA(At, 1, 1); PG8_STAGE(PG8_SA(1, 0), a3, voffA);
            PG8_BAR; PG8_WAIT_L(0); PG8_MMA(1, 0, At, B0); PG8_BAR; PG8_SCHED;
            PG8_STAGE(PG8_SB(1, 1), b3 + hstepB, voffB);
            PG8_WAIT_V(6); PG8_BAR; PG8_MMA(1, 1, At, B1); PG8_BAR;
            }
        }
        if constexpr (ALIGN_EPI) { if (wr == 0) PG8_BAR; }
        if constexpr (!Epi::AFTER_DRAIN) { E(acc, cur, wr, wc, fr, fq); S.done(cur); }
        if (!has_next) break;
#pragma unroll
        for (int a = 0; a < 2; ++a)
#pragma unroll
            for (int b = 0; b < 2; ++b)
#pragma unroll
                for (int m = 0; m < 4; ++m)
#pragma unroll
                    for (int n = 0; n < 2; ++n) acc[a][b][m][n] = (f32x4){0.f, 0.f, 0.f, 0.f};
        cur = nxt; cA = nA; cB = nB; ++ui;
        if constexpr (ALIGN_EPI) { if (wr == 1) PG8_BAR; }
    }
    PG8_WAIT_V(0);
    if constexpr (!ALIGN_EPI) { if (wr == 0) PG8_BAR; }
    PG8_BAR;
    if constexpr (Epi::AFTER_DRAIN) { E.fused(acc, cur, wr, wc, fr, fq, lds, wid, lane); S.done(cur); }
#undef PG8_SA
#undef PG8_SB
#undef PG8_STAGE
#undef PG8_LDA
#undef PG8_LDB
#undef PG8_MMA
#undef PG8_WAIT_V
#undef PG8_WAIT_L
#undef PG8_BAR
#undef PG8_SCHED
}
}

#define LAS __attribute__((address_space(3)))
#define XB_TMO      128
#define XB_XCNT(j)  (256  + 64 * (j))
#define XB_XSUB(j)  (1280 + 64 * (j))
#define XB_XGEN(j)  (2304 + 64 * (j))
#define XB_TOP      3328
#define XB_TOPGEN   3392
#define XCD_BAR_WORDS 3456
#define XB_SPIN_CAP (1u << 22)

__device__ __forceinline__ unsigned xb_ld(unsigned* p)              { return __hip_atomic_load(p, __ATOMIC_RELAXED, __HIP_MEMORY_SCOPE_AGENT); }
__device__ __forceinline__ unsigned xb_add(unsigned* p, unsigned v) { return __hip_atomic_fetch_add(p, v, __ATOMIC_RELAXED, __HIP_MEMORY_SCOPE_AGENT); }
__device__ __forceinline__ unsigned xb_xcc_id() { return (unsigned)__builtin_amdgcn_s_getreg((3 << 11) | 20) & 0xFu; }
#define XB_SPIN(cond, bar) do { unsigned _sp = 0; while (cond) { __builtin_amdgcn_s_sleep(1); \
    if ((++_sp & 255u) == 0u) { if (xb_ld(&(bar)[XB_TMO])) break; if (_sp > XB_SPIN_CAP) { atomicAdd(&(bar)[XB_TMO], 1u); break; } } } } while (0)

struct XcdBarrier {
    unsigned* bar; unsigned x;
    volatile LAS unsigned* st;
};

__device__ __forceinline__ XcdBarrier xcd_barrier_post(unsigned* bar, volatile LAS unsigned* st) {
    XcdBarrier b; b.bar = bar; b.x = xb_xcc_id(); b.st = st;
    if (threadIdx.x == 0) (void)xb_add(&bar[XB_XCNT(b.x)], 1u);
    return b;
}
__device__ __forceinline__ void xcd_barrier_complete(unsigned* bar, unsigned x, unsigned& nloc, unsigned& nx) {
    const unsigned G = gridDim.x * gridDim.y * gridDim.z;
    unsigned sum, cnt, mine, sp = 0u;
    for (;;) {
        sum = 0u; cnt = 0u; mine = 0u;
#pragma unroll
        for (unsigned j = 0; j < 16; ++j) { const unsigned c = xb_ld(&bar[XB_XCNT(j)]); sum += c; cnt += (c > 0u) ? 1u : 0u; mine = (j == x) ? c : mine; }
        if (sum == G) break;
        __builtin_amdgcn_s_sleep(1);
        if ((++sp & 255u) == 0u) { if (xb_ld(&bar[XB_TMO])) break; if (sp > XB_SPIN_CAP) { atomicAdd(&bar[XB_TMO], 1u); break; } }
    }
    nloc = mine > 0u ? mine : 1u; nx = cnt > 0u ? cnt : 1u;
}

__device__ __forceinline__ void xcd_barrier(const XcdBarrier& b, int tid_x  ) {
    asm volatile("s_waitcnt vmcnt(0)" ::: "memory");
    __syncthreads();
    if (tid_x == 0) {
        unsigned* bar = b.bar; asm volatile("" : "+s"(bar));
        unsigned xx = b.x; asm volatile("" : "+s"(xx));
        __builtin_amdgcn_s_waitcnt(0);
        unsigned nloc = b.st[0], nx = b.st[1];
        if (nloc == 0u) { xcd_barrier_complete(bar, xx, nloc, nx); b.st[0] = nloc; b.st[1] = nx; }
        const unsigned old = xb_add(&bar[XB_XSUB(xx)], 1u);
        const unsigned gen = old / nloc;
        if (old + 1u == (gen + 1u) * nloc) {
            __builtin_amdgcn_fence(__ATOMIC_RELEASE, "agent");
            asm volatile("s_waitcnt vmcnt(0)" ::: "memory");
            const unsigned og = xb_add(&bar[XB_TOP], 1u);
            const unsigned tg = og / nx;
            if (og + 1u == (tg + 1u) * nx) xb_add(&bar[XB_TOPGEN], 1u);
            else XB_SPIN(xb_ld(&bar[XB_TOPGEN]) == tg, bar);
            __builtin_amdgcn_fence(__ATOMIC_ACQUIRE, "agent");
            xb_add(&bar[XB_XGEN(xx)], 1u);
            asm volatile("s_waitcnt vmcnt(0)" ::: "memory");
        } else {
            XB_SPIN(xb_ld(&bar[XB_XGEN(xx)]) == gen, bar);
            __builtin_amdgcn_fence(__ATOMIC_ACQUIRE, "agent");
            asm volatile("s_waitcnt vmcnt(0)" ::: "memory");
        }
    }
    __syncthreads();
}
#define GAS __attribute__((address_space(1)))
typedef unsigned v4u __attribute__((ext_vector_type(4)));
typedef unsigned v2u __attribute__((ext_vector_type(2)));
typedef GAS unsigned gu32;
#define RLX_AGENT __ATOMIC_RELAXED, __HIP_MEMORY_SCOPE_AGENT
#define LDS_WAIT() asm volatile("s_waitcnt lgkmcnt(0)" ::: "memory")
#define VM_WAIT() asm volatile("s_waitcnt vmcnt(0)" ::: "memory")
using pg8::f32x4; using pg8::Unit; using pg8::Gemm; using pg8::BM; using pg8::HALF; using pg8::cvt_pk_bf16; using pg8::u32x4;

constexpr int NWAVES = 8, NTHREADS = 512;
constexpr int RING_BYTES = 131072, LDSCTL_OFF = 147456 - 1024, MISC_OFF = LDSCTL_OFF + 320, LDS_BYTES = 147456;

__device__ __forceinline__ float wave_sum(float v, int lane) {
#pragma unroll
    for (int o = 1; o < 64; o <<= 1) v += __builtin_bit_cast(float, __builtin_amdgcn_ds_bpermute((lane ^ o) << 2, __builtin_bit_cast(int, v)));
    return v;
}
__device__ __forceinline__ float fsig(float x) { return __builtin_amdgcn_rcpf(1.f + __expf(-x)); }

__device__ __forceinline__ int lane_id_opaque() { int l; asm volatile("v_mbcnt_lo_u32_b32 %0, -1, 0\n\tv_mbcnt_hi_u32_b32 %0, -1, %0" : "=v"(l)); return l; }
__device__ __forceinline__ int rfl(int v) { return __builtin_amdgcn_readfirstlane(v); }
struct SOrder {
    pg8::StaticOrder s;
    __device__ void init(int M, int N, int G, int c) { s.init(M, N, G, c); }
    __device__ bool next(int i, Unit& u) const { Unit t; t.pm = 0; t.pn = 0; const bool ok = s.next(i, t); u.pm = rfl(t.pm); u.pn = rfl(t.pn); return ok; }
    __device__ __forceinline__ void a_ready(const Unit&) const {}
    __device__ __forceinline__ void done(const Unit&) const {}
};
struct StackOrder {
    pg8::StaticOrder s; int nM, nN;
    __device__ StackOrder(int nM_, int nN_, int nb, int G, int c) : nM(nM_), nN(nN_) { s.init(nb * nM_ * 256, nN_ * 256, G, c); }
    __device__ bool next(int i, Unit& u) const { Unit t; t.pm = 0; t.pn = 0; if (!s.next(i, t)) return false; u.pm = rfl(t.pm); u.pn = rfl((t.pm / nM) * nN + t.pn); return true; }
    __device__ __forceinline__ void a_ready(const Unit&) const {}
    __device__ __forceinline__ void done(const Unit&) const {}
};
struct GateOrder {
    pg8::StaticOrder s; int nN;
    __device__ GateOrder(int nM_, int nN_, int G, int c) : nN(nN_) { s.init(nM_ * 256, nN_ * 256, G, c); }
    __device__ bool next(int i, Unit& u) const { const int j = i / 3, br = i - 3 * j; Unit t; t.pm = 0; t.pn = 0; if (!s.next(j, t)) return false; u.pm = rfl(t.pm); u.pn = rfl(br * nN + t.pn); return true; }
    __device__ __forceinline__ void a_ready(const Unit&) const {}
    __device__ __forceinline__ void done(const Unit&) const {}
};
struct MoeOrder {
    pg8::StaticOrder s; int nN, e0, e1, e2, e3, e4, e5, e6, e7;
    __device__ void init(const unsigned* cnt  , int nN_, int G_, int c_) { nN = nN_;
        int t = 0; t += (cnt[0] + 255) >> 8; e0 = t; t += (cnt[64] + 255) >> 8; e1 = t; t += (cnt[128] + 255) >> 8; e2 = t; t += (cnt[192] + 255) >> 8; e3 = t;
        t += (cnt[256] + 255) >> 8; e4 = t; t += (cnt[320] + 255) >> 8; e5 = t; t += (cnt[384] + 255) >> 8; e6 = t; t += (cnt[448] + 255) >> 8; e7 = t;
        s.init(e7 * 256, nN_ * 256, G_, c_); }
    __device__ bool next(int i, Unit& u) const { Unit t; t.pm = 0; t.pn = 0; if (!s.next(i, t)) return false;
        const int pm = t.pm, e = (pm >= e0) + (pm >= e1) + (pm >= e2) + (pm >= e3) + (pm >= e4) + (pm >= e5) + (pm >= e6);
        u.pm = rfl(pm); u.pn = rfl(e * nN + t.pn); return true; }
    __device__ __forceinline__ void a_ready(const Unit&) const {}
    __device__ __forceinline__ void done(const Unit&) const {}
};

__device__ __forceinline__ u32x4 pack8(f32x4 v0, f32x4 v1) { u32x4 w; w.x = cvt_pk_bf16(v0[0], v0[1]); w.y = cvt_pk_bf16(v0[2], v0[3]); w.z = cvt_pk_bf16(v1[0], v1[1]); w.w = cvt_pk_bf16(v1[2], v1[3]); return w; }
__device__ __forceinline__ void unpack8(u32x4 w, f32x4& v0, f32x4& v1) {
    v0 = (f32x4){blo(w.x), bhi(w.x), blo(w.y), bhi(w.y)}; v1 = (f32x4){blo(w.z), bhi(w.z), blo(w.w), bhi(w.w)}; }

struct EpiProj {
    static constexpr bool PERM = true, AFTER_DRAIN = false;
    unsigned char* ws;
    __device__ __forceinline__ void operator()(const f32x4 (&acc)[2][2][4][2], const Unit& u, int wr, int wc, int fr, int fq) const {
        bf16* const QB = (bf16*)(ws + AR_QB); bf16* const KV = (bf16*)(ws + AR_KV); bf16* const UB = (bf16*)(ws + AR_UB); bf16* const RW = (bf16*)(ws + AR_RW); bf16* const HALO = (bf16*)(ws + AR_HALO); bf16* const CKV = (bf16*)(ws + AR_CKV);
        const int row0 = u.pm * BM + wr * 64 + fr, cl = wc * 32 + 8 * fq;
        if (u.pn >= 5 && u.pn < 9) {
#pragma unroll
            for (int ai = 0; ai < 2; ++ai)
#pragma unroll
                for (int m = 0; m < 4; ++m) { f32x4 a0 = acc[ai][0][m][0], a1 = acc[ai][0][m][1]; const f32x4 b0 = acc[ai][1][m][0], b1 = acc[ai][1][m][1];
#pragma unroll
                    for (int k = 0; k < 4; ++k) { a0[k] *= fsig(b0[k]); a1[k] *= fsig(b1[k]); }
                    *(u32x4*)(UB + (size_t)(row0 + ai * HALF + m * 16) * 512 + (u.pn - 5) * 128 + cl) = pack8(a0, a1); }
            return;
        }
        if (u.pn == 2) {
#pragma unroll
            for (int ai = 0; ai < 2; ++ai)
#pragma unroll
                for (int m = 0; m < 4; ++m) { const int row = row0 + ai * HALF + m * 16, b = row / SEQ, tt = row % SEQ;
#pragma unroll
                    for (int bj = 0; bj < 2; ++bj) *(u32x4*)(CKV + (((size_t)bj * (BATCH * NKV) + b * NKV + (cl >> 6)) * SEQ + tt) * 64 + (cl & 63)) = pack8(acc[ai][bj][m][0], acc[ai][bj][m][1]); }
            return;
        }
        bf16* base; int ld, c0;
        if (u.pn < 2) { base = QB; ld = LDQ; c0 = u.pn * 256; } else if (u.pn < 5) { base = KV; ld = LDKV; c0 = (u.pn - 3) * 256; } else { base = RW; ld = LDRW; c0 = (u.pn - 9) * 256; }
#pragma unroll
        for (int ai = 0; ai < 2; ++ai)
#pragma unroll
            for (int m = 0; m < 4; ++m)
#pragma unroll
                for (int bj = 0; bj < 2; ++bj) { const u32x4 w = pack8(acc[ai][bj][m][0], acc[ai][bj][m][1]);
                    *(u32x4*)(base + (size_t)(row0 + ai * HALF + m * 16) * ld + c0 + bj * HALF + cl) = w;
                    if (u.pn >= 9 && ai == 1 && m == 3 && wr == 1 && fr == 15) *(u32x4*)(HALO + (size_t)u.pm * LDRW + c0 + bj * HALF + cl) = w; }
    }
};
struct EpiStore {
    static constexpr bool PERM = true, AFTER_DRAIN = false;
    bf16* O; int ld, ntn;
    __device__ __forceinline__ void operator()(const f32x4 (&acc)[2][2][4][2], const Unit& u, int wr, int wc, int fr, int fq) const {
        const int row0 = u.pm * BM + wr * 64 + fr, c0 = (u.pn % ntn) * 256 + wc * 32 + 8 * fq;
#pragma unroll
        for (int ai = 0; ai < 2; ++ai)
#pragma unroll
            for (int m = 0; m < 4; ++m)
#pragma unroll
                for (int bj = 0; bj < 2; ++bj) *(u32x4*)(O + (size_t)(row0 + ai * HALF + m * 16) * ld + c0 + bj * HALF) = pack8(acc[ai][bj][m][0], acc[ai][bj][m][1]);
    }
};
struct EpiGate {
    static constexpr bool PERM = true, AFTER_DRAIN = false;
    unsigned char* ws; int ntn;
    __device__ __forceinline__ void operator()(const f32x4 (&acc)[2][2][4][2], const Unit& u, int wr, int wc, int fr, int fq) const {
        const bf16* const OB = (const bf16*)(ws + AR_OBUF); bf16* const MIX = (bf16*)(ws + AR_MIX);
        const int br = u.pn / ntn, row0 = u.pm * BM + wr * 64 + fr, c0 = (u.pn % ntn) * 256 + wc * 32 + 8 * fq;
        const bf16* ob = OB + (size_t)br * T * DM;
#pragma unroll
        for (int ai = 0; ai < 2; ++ai) {
            u32x4 o[4][2], mx[4][2];
#pragma unroll
            for (int m = 0; m < 4; ++m)
#pragma unroll
                for (int bj = 0; bj < 2; ++bj) { const size_t off = (size_t)(row0 + ai * HALF + m * 16) * DM + c0 + bj * HALF; o[m][bj] = *(const u32x4*)(ob + off); if (br != 0) mx[m][bj] = *(const u32x4*)(MIX + off); }
#pragma unroll
            for (int m = 0; m < 4; ++m)
#pragma unroll
                for (int bj = 0; bj < 2; ++bj) { const size_t off = (size_t)(row0 + ai * HALF + m * 16) * DM + c0 + bj * HALF;
                    f32x4 o0, o1; unpack8(o[m][bj], o0, o1);
                    f32x4 g0 = acc[ai][bj][m][0], g1 = acc[ai][bj][m][1];
#pragma unroll
                    for (int k = 0; k < 4; ++k) { g0[k] = fsig(g0[k]) * o0[k]; g1[k] = fsig(g1[k]) * o1[k]; }
                    if (br != 0) { f32x4 p0, p1; unpack8(mx[m][bj], p0, p1); g0 += p0; g1 += p1; }
                    *(u32x4*)(MIX + off) = pack8(g0, g1); }
        }
    }
};
struct EpiResid {
    static constexpr bool PERM = true, AFTER_DRAIN = false;
    const float* base; float* out;
    __device__ __forceinline__ void operator()(const f32x4 (&acc)[2][2][4][2], const Unit& u, int wr, int wc, int fr, int fq) const {
        const int row0 = u.pm * BM + wr * 64 + fr, c0 = u.pn * 256 + wc * 32 + 8 * fq;
#pragma unroll
        for (int ai = 0; ai < 2; ++ai)
#pragma unroll
            for (int mh = 0; mh < 2; ++mh) {
                f32x4 x[2][2][2];
#pragma unroll
                for (int mm = 0; mm < 2; ++mm)
#pragma unroll
                    for (int bj = 0; bj < 2; ++bj) { const size_t off = (size_t)(row0 + ai * HALF + (2 * mh + mm) * 16) * DM + c0 + bj * HALF; x[mm][bj][0] = *(const f32x4*)(base + off); x[mm][bj][1] = *(const f32x4*)(base + off + 4); }
#pragma unroll
                for (int mm = 0; mm < 2; ++mm)
#pragma unroll
                    for (int bj = 0; bj < 2; ++bj) { const int m = 2 * mh + mm; const size_t off = (size_t)(row0 + ai * HALF + m * 16) * DM + c0 + bj * HALF;
                        *(f32x4*)(out + off) = x[mm][bj][0] + acc[ai][bj][m][0]; *(f32x4*)(out + off + 4) = x[mm][bj][1] + acc[ai][bj][m][1]; }
            }
    }
};
struct EpiSwiglu {
    static constexpr bool PERM = true, AFTER_DRAIN = false;
    bf16* ACT; int ld, ntn;
    __device__ __forceinline__ void operator()(const f32x4 (&acc)[2][2][4][2], const Unit& u, int wr, int wc, int fr, int fq) const {
        const int row0 = u.pm * BM + wr * 64 + fr, c0 = (u.pn % ntn) * 128 + wc * 32 + 8 * fq;
#pragma unroll
        for (int ai = 0; ai < 2; ++ai)
#pragma unroll
            for (int m = 0; m < 4; ++m) { f32x4 g0 = acc[ai][0][m][0], g1 = acc[ai][0][m][1]; const f32x4 u0 = acc[ai][1][m][0], u1 = acc[ai][1][m][1];
#pragma unroll
                for (int k = 0; k < 4; ++k) { g0[k] = g0[k] * fsig(g0[k]) * u0[k]; g1[k] = g1[k] * fsig(g1[k]) * u1[k]; }
                *(u32x4*)(ACT + (size_t)(row0 + ai * HALF + m * 16) * ld + c0) = pack8(g0, g1); }
    }
};
struct EpiMoeDown {
    static constexpr bool PERM = true, AFTER_DRAIN = false;
    float* out; const int* rtok; const float* rw; int ntn; float sc;
    __device__ __forceinline__ void operator()(const f32x4 (&acc)[2][2][4][2], const Unit& u, int wr, int wc, int fr, int fq) const {
        const int row0 = u.pm * BM + wr * 64 + fr, c0 = (u.pn % ntn) * 256 + wc * 32 + 8 * fq;
#pragma unroll
        for (int ai = 0; ai < 2; ++ai)
#pragma unroll
            for (int mh = 0; mh < 2; ++mh) {
                int tok[2]; float w[2]; f32x4 x[2][2][2];
#pragma unroll
                for (int mm = 0; mm < 2; ++mm) { const int row = row0 + ai * HALF + (2 * mh + mm) * 16; tok[mm] = rtok[row]; w[mm] = rw[row] * sc; }
#pragma unroll
                for (int mm = 0; mm < 2; ++mm)
#pragma unroll
                    for (int bj = 0; bj < 2; ++bj) { const float* o = out + (size_t)(tok[mm] >= 0 ? tok[mm] : 0) * DM + c0 + bj * HALF; x[mm][bj][0] = *(const f32x4*)o; x[mm][bj][1] = *(const f32x4*)(o + 4); }
#pragma unroll
                for (int mm = 0; mm < 2; ++mm)
#pragma unroll
                    for (int bj = 0; bj < 2; ++bj) if (tok[mm] >= 0) { const int m = 2 * mh + mm; float* o = out + (size_t)tok[mm] * DM + c0 + bj * HALF;
                        *(f32x4*)o = x[mm][bj][0] + acc[ai][bj][m][0] * w[mm]; *(f32x4*)(o + 4) = x[mm][bj][1] + acc[ai][bj][m][1] * w[mm]; }
            }
    }
};

typedef short bf16x8_t __attribute__((ext_vector_type(8)));
#define MFMA16(a, b, c) __builtin_amdgcn_mfma_f32_16x16x32_bf16((a), (b), (c), 0, 0, 0)
constexpr float ATT_C = 0.125f * 1.4426950408889634f;
constexpr int AW_IMP = 0, AW_SEL = 8448, AW_QS = 8960, AW_BYTES = 8960 + 8192;
__device__ __forceinline__ float bperm_f(float v, int srclane) { return __builtin_bit_cast(float, __builtin_amdgcn_ds_bpermute(srclane << 2, __builtin_bit_cast(int, v))); }
__device__ __forceinline__ int bperm_i(int v, int srclane) { return __builtin_amdgcn_ds_bpermute(srclane << 2, v); }
__device__ __forceinline__ bf16x8_t ldg8(const bf16* p) { return *(const bf16x8_t*)p; }
__device__ __forceinline__ bf16x8_t pack_p(const f32x4& a, const f32x4& b) {
    v4u w; w.x = cvt_pk_bf16(a[0], a[1]); w.y = cvt_pk_bf16(a[2], a[3]); w.z = cvt_pk_bf16(b[0], b[1]); w.w = cvt_pk_bf16(b[2], b[3]); return __builtin_bit_cast(bf16x8_t, w); }

__device__ __forceinline__ void nsa_attn_item(const P& p, int item, int lane, LAS unsigned char* wl) {
    const bf16* KV = WSP(bf16, AR_KV); const bf16* KC = WSP(bf16, AR_KC); const bf16* VcT = WSP(bf16, AR_VCT); const bf16* VsT = WSP(bf16, WS_VST); const bf16* VwT = WSP(bf16, WS_VWT);
    bf16* QB = WSP(bf16, AR_QB); const float* NG = WSP(float, AR_NG);
    const int bg = item / (SEQ / 16), t0 = (item % (SEQ / 16)) * 16, b = bg >> 1, g = bg & 1;
    const int col = lane & 15, fq = lane >> 4, tok = t0 + col;
    const size_t grow = (size_t)b * SEQ + tok;
    LAS float* IMP = (LAS float*)(wl + AW_IMP); LAS int* SEL = (LAS int*)(wl + AW_SEL); LAS bf16* OS = (LAS bf16*)(wl + AW_IMP);
    const int krowA = 8 * (col >> 2) + (col & 3);
    const float* gate = NG + grow * 24 + g * 12;
    LAS bf16x8_t* QS = (LAS bf16x8_t*)(wl + AW_QS) + lane;
#pragma unroll
    for (int hh = 0; hh < 4; ++hh)
#pragma unroll
        for (int ks = 0; ks < 2; ++ks) QS[(hh * 2 + ks) * 64] = ldg8(QB + grow * LDQ + (g * 4 + hh) * 64 + ks * 32 + fq * 8);
#define Qc(hh, ks) (QS[((hh) * 2 + (ks)) * 64])
    for (int i = lane; i < 16 * 132; i += 64) IMP[i] = 0.f;
    const f32x4 z4 = {0.f, 0.f, 0.f, 0.f};
    f32x4 O[4][4];
    int nvmax = (t0 + 15 >= 31) ? (((t0 + 15 - 31) >> 4) + 1) : 0; if (nvmax > NC) nvmax = NC;
    const int nch = (nvmax + 31) >> 5;
    const bf16* kcb = KC + (size_t)bg * 512 * 64; const bf16* vcb = VcT + (size_t)bg * 64 * 512;
    float linv[4] = {0.f, 0.f, 0.f, 0.f};
#pragma unroll
    for (int hh = 0; hh < 4; ++hh)
#pragma unroll
        for (int mt = 0; mt < 4; ++mt) O[hh][mt] = z4;
#pragma unroll 1
    for (int pass = 0; pass < 2; ++pass) {
#pragma unroll 1
        for (int ch = 0; ch < nch; ++ch) {
            asm volatile("" ::: "memory");
            const int k0 = 32 * ch; const bool cfull = 16 * (k0 + 31) + 31 <= t0;
            bf16x8_t ka[2][2];
#pragma unroll
            for (int tl = 0; tl < 2; ++tl)
#pragma unroll
                for (int ks = 0; ks < 2; ++ks) ka[tl][ks] = ldg8(kcb + ((size_t)(4 * ks + fq) * 512 + k0 + 16 * tl + col) * 8);
            bf16x8_t va[4];
            if (pass == 1) {
#pragma unroll
                for (int mt = 0; mt < 4; ++mt) va[mt] = ldg8(vcb + ((size_t)((k0 >> 3) + fq) * 64 + 16 * mt + col) * 8);
            }
            float ps[8] = {0.f, 0.f, 0.f, 0.f, 0.f, 0.f, 0.f, 0.f};
#pragma unroll
            for (int hh = 0; hh < 4; ++hh) {
                const bf16x8_t q0_ = Qc(hh, 0), q1_ = Qc(hh, 1);
                f32x4 sa = MFMA16(ka[0][0], q0_, z4); sa = MFMA16(ka[0][1], q1_, sa);
                f32x4 sb = MFMA16(ka[1][0], q0_, z4); sb = MFMA16(ka[1][1], q1_, sb);
#pragma unroll
                for (int i = 0; i < 4; ++i) { sa[i] = __builtin_amdgcn_exp2f(sa[i]); sb[i] = __builtin_amdgcn_exp2f(sb[i]); }
                if (!cfull) {
#pragma unroll
                    for (int i = 0; i < 4; ++i) { const int c = k0 + 4 * fq + i; sa[i] = (16 * c + 31 <= tok) ? sa[i] : 0.f; sb[i] = (16 * (c + 16) + 31 <= tok) ? sb[i] : 0.f; } }
                if (pass == 0) { linv[hh] += (sa[0] + sa[1]) + (sa[2] + sa[3]) + (sb[0] + sb[1]) + (sb[2] + sb[3]); }
                else {
#pragma unroll
                    for (int i = 0; i < 4; ++i) { ps[i] = __builtin_fmaf(sa[i], linv[hh], ps[i]); ps[4 + i] = __builtin_fmaf(sb[i], linv[hh], ps[4 + i]); }
                    const bf16x8_t pt = pack_p(sa, sb);
#pragma unroll
                    for (int mt = 0; mt < 4; ++mt) O[hh][mt] = MFMA16(va[mt], pt, O[hh][mt]);
                }
            }
            if (pass == 1) {
                const int Ga = 8 * ch + fq; LAS float* ir = IMP + col * 132 + Ga;
                __hip_atomic_fetch_add(ir, (ps[0] + ps[1]) + (ps[2] + ps[3]), __ATOMIC_RELAXED, __HIP_MEMORY_SCOPE_WORKGROUP);
                __hip_atomic_fetch_add(ir + 1, ps[3], __ATOMIC_RELAXED, __HIP_MEMORY_SCOPE_WORKGROUP);
                __hip_atomic_fetch_add(ir + 4, (ps[4] + ps[5]) + (ps[6] + ps[7]), __ATOMIC_RELAXED, __HIP_MEMORY_SCOPE_WORKGROUP);
                if (Ga + 5 < NS) __hip_atomic_fetch_add(ir + 5, ps[7], __ATOMIC_RELAXED, __HIP_MEMORY_SCOPE_WORKGROUP);
            }
        }
        if (pass == 0) {
#pragma unroll
            for (int hh = 0; hh < 4; ++hh) { float l = linv[hh]; l += bperm_f(l, lane ^ 16); l += bperm_f(l, lane ^ 32); linv[hh] = l > 0.f ? 1.f / l : 0.f; }
        }
    }
    LDS_WAIT(); asm volatile("" ::: "memory");
    {
        const int cur = tok >> 6; LAS float* sc = IMP + col * 132;
        for (int j = fq * 32; j < fq * 32 + 32; ++j) { const bool forced = (j == 0) || (j == cur) || (j == cur - 1); const float v = sc[j]; sc[j] = forced ? 1e4f : (j <= cur ? v : -1.f); }
        LDS_WAIT(); asm volatile("" ::: "memory");
#pragma unroll 1
        for (int r = 0; r < 8; ++r) {
            float bv = sc[fq * 32]; int bj = fq * 32;
            for (int j = fq * 32 + 1; j < fq * 32 + 32; ++j) { const float v = sc[j]; if (v > bv) { bv = v; bj = j; } }
#pragma unroll
            for (int o = 16; o <= 32; o <<= 1) { const float ov = bperm_f(bv, lane ^ o); const int oj = bperm_i(bj, lane ^ o); if (ov > bv || (ov == bv && oj < bj)) { bv = ov; bj = oj; } }
            if ((bj >> 5) == fq) sc[bj] = -3e38f;
            if (fq == 0) SEL[col * 8 + r] = bj;
            LDS_WAIT(); asm volatile("" ::: "memory");
        }
    }
#pragma unroll
    for (int hh = 0; hh < 4; ++hh) { const float g0 = gate[hh * 3 + 0] * linv[hh];
#pragma unroll
        for (int mt = 0; mt < 4; ++mt) { const f32x4 o = O[hh][mt] * g0; v2u w; w.x = cvt_pk_bf16(o[0], o[1]); w.y = cvt_pk_bf16(o[2], o[3]);
            *(LAS v2u*)(OS + (col * 4 + hh) * 64 + 16 * mt + 4 * fq) = w; } }
    LDS_WAIT(); asm volatile("" ::: "memory");
    const int cur = t0 >> 6;
    {
        const bf16* kwb = WSP(bf16, WS_KW8) + (size_t)bg * 8 * SEQ * 8; const bf16* vwb = VwT + (size_t)bg * 64 * SEQ;
        const bf16* ksb = WSP(bf16, WS_KS8) + (size_t)bg * 8 * SEQ * 8; const bf16* vsb = VsT + (size_t)bg * 64 * SEQ;
        int kst = t0 - (WINDOW - 1); if (kst < 0) kst = 0; kst &= ~31;
        const int nwin = ((t0 + 15 - kst) >> 5) + 1, nfb = cur >= 2 ? 3 : cur + 1;
#pragma unroll 1
        for (int part = 0; part < 2; ++part) {
            float lw[4] = {0.f, 0.f, 0.f, 0.f};
#pragma unroll
            for (int hh = 0; hh < 4; ++hh)
#pragma unroll
                for (int mt = 0; mt < 4; ++mt) O[hh][mt] = z4;
            const bf16* kb = part ? ksb : kwb; const bf16* vb = part ? vsb : vwb;
            const int nchk = part ? 2 * nfb : nwin;
#pragma unroll 1
            for (int ci = 0; ci < nchk; ++ci) {
                asm volatile("" ::: "memory");
                int k0;
                if (part == 0) k0 = kst + 32 * ci; else { const int fb = ci >> 1, j = fb == 0 ? 0 : (fb == 1 ? cur : cur - 1); k0 = 64 * j + 32 * (ci & 1); }
                bf16x8_t ka[2][2], va[4];
#pragma unroll
                for (int tl = 0; tl < 2; ++tl)
#pragma unroll
                    for (int ks = 0; ks < 2; ++ks) ka[tl][ks] = ldg8(kb + ((size_t)(4 * ks + fq) * SEQ + k0 + 16 * tl + col) * 8);
#pragma unroll
                for (int mt = 0; mt < 4; ++mt) va[mt] = ldg8(vb + ((size_t)((k0 >> 3) + fq) * 64 + 16 * mt + col) * 8);
                const int lowk = part ? -1 : tok - WINDOW; const bool dfull = (k0 + 31 <= t0) && (part || k0 > t0 + 15 - WINDOW);
#pragma unroll
                for (int hh = 0; hh < 4; ++hh) {
                    const bf16x8_t q0_ = Qc(hh, 0), q1_ = Qc(hh, 1);
                    f32x4 sa = MFMA16(ka[0][0], q0_, z4); sa = MFMA16(ka[0][1], q1_, sa);
                    f32x4 sb = MFMA16(ka[1][0], q0_, z4); sb = MFMA16(ka[1][1], q1_, sb);
#pragma unroll
                    for (int i = 0; i < 4; ++i) { sa[i] = __builtin_amdgcn_exp2f(sa[i]); sb[i] = __builtin_amdgcn_exp2f(sb[i]); }
                    if (!dfull) {
#pragma unroll
                        for (int i = 0; i < 4; ++i) { const int kt = k0 + 4 * fq + i; sa[i] = (kt <= tok && kt > lowk) ? sa[i] : 0.f; sb[i] = (kt + 16 <= tok && kt + 16 > lowk) ? sb[i] : 0.f; } }
                    lw[hh] += (sa[0] + sa[1]) + (sa[2] + sa[3]) + (sb[0] + sb[1]) + (sb[2] + sb[3]);
                    const bf16x8_t pt = pack_p(sa, sb);
#pragma unroll
                    for (int mt = 0; mt < 4; ++mt) O[hh][mt] = MFMA16(va[mt], pt, O[hh][mt]);
                }
            }
            LDS_WAIT(); asm volatile("" ::: "memory");
            if (part == 0) {
#pragma unroll
                for (int hh = 0; hh < 4; ++hh) { float l = lw[hh]; l += bperm_f(l, lane ^ 16); l += bperm_f(l, lane ^ 32); const float w = l > 0.f ? gate[hh * 3 + 2] / l : 0.f;
#pragma unroll
                    for (int mt = 0; mt < 4; ++mt) { LAS v2u* dp = (LAS v2u*)(OS + (col * 4 + hh) * 64 + 16 * mt + 4 * fq); const v2u old = *dp;
                        v2u w2; w2.x = cvt_pk_bf16(blo(old.x) + w * O[hh][mt][0], bhi(old.x) + w * O[hh][mt][1]); w2.y = cvt_pk_bf16(blo(old.y) + w * O[hh][mt][2], bhi(old.y) + w * O[hh][mt][3]); *dp = w2; } }
            } else {
                LAS bf16* OF = (LAS bf16*)(wl + AW_QS); LAS float* LF = (LAS float*)(wl + AW_IMP + 8192);
#pragma unroll
                for (int hh = 0; hh < 4; ++hh) { float l = lw[hh]; l += bperm_f(l, lane ^ 16); l += bperm_f(l, lane ^ 32); if (fq == 0) LF[col * 4 + hh] = l;
#pragma unroll
                    for (int mt = 0; mt < 4; ++mt) { v2u w2; w2.x = cvt_pk_bf16(O[hh][mt][0], O[hh][mt][1]); w2.y = cvt_pk_bf16(O[hh][mt][2], O[hh][mt][3]); *(LAS v2u*)(OF + (col * 4 + hh) * 64 + 16 * mt + 4 * fq) = w2; } }
            }
            LDS_WAIT(); asm volatile("" ::: "memory");
        }
    }
    {
        const bf16* ksb = WSP(bf16, WS_KS8) + (size_t)bg * 8 * SEQ * 8; const bf16* vsb = VsT + (size_t)bg * 64 * SEQ;
        const LAS bf16* OF = (const LAS bf16*)(wl + AW_QS); const LAS float* LF = (const LAS float*)(wl + AW_IMP + 8192);
#pragma unroll 1
        for (int tt = 0; tt < 16; ++tt) {
            const int tq = t0 + tt; const size_t qrow = (size_t)b * SEQ + tq;
            bf16x8_t Qh[2];
#pragma unroll
            for (int ks = 0; ks < 2; ++ks) { Qh[ks] = ldg8(QB + qrow * LDQ + (g * 4 + (col & 3)) * 64 + ks * 32 + fq * 8); if (col >= 4) Qh[ks] = (bf16x8_t){0, 0, 0, 0, 0, 0, 0, 0}; }
            f32x4 Os[4] = {z4, z4, z4, z4}; float ls = 0.f;
#ifdef APROBE_SEL
            for (int rp = 0; rp < 2; ++rp) { Os[0] = z4; Os[1] = z4; Os[2] = z4; Os[3] = z4; ls = 0.f; asm volatile("" ::: "memory");
#endif
#pragma unroll 1
            for (int r8 = 0; r8 < 8; ++r8) {
                const int j = __builtin_amdgcn_readfirstlane(SEL[tt * 8 + r8]);
                if (64 * j > tq || j == 0 || j == cur || j == cur - 1) continue;
                const int kb0 = 64 * j;
                bf16x8_t ka[2][2][2], va[2][4];
#pragma unroll
                for (int hf = 0; hf < 2; ++hf) {
#pragma unroll
                    for (int tl = 0; tl < 2; ++tl)
#pragma unroll
                        for (int ks = 0; ks < 2; ++ks) ka[hf][tl][ks] = ldg8(ksb + ((size_t)(4 * ks + fq) * SEQ + kb0 + 32 * hf + 16 * tl + col) * 8);
#pragma unroll
                    for (int mt = 0; mt < 4; ++mt) va[hf][mt] = ldg8(vsb + ((size_t)(((kb0 + 32 * hf) >> 3) + fq) * 64 + 16 * mt + col) * 8);
                }
#pragma unroll
                for (int hf = 0; hf < 2; ++hf) {
                    f32x4 sa = MFMA16(ka[hf][0][0], Qh[0], z4); sa = MFMA16(ka[hf][0][1], Qh[1], sa);
                    f32x4 sb = MFMA16(ka[hf][1][0], Qh[0], z4); sb = MFMA16(ka[hf][1][1], Qh[1], sb);
#pragma unroll
                    for (int i = 0; i < 4; ++i) { sa[i] = __builtin_amdgcn_exp2f(sa[i]); sb[i] = __builtin_amdgcn_exp2f(sb[i]); }
                    ls += (sa[0] + sa[1]) + (sa[2] + sa[3]) + (sb[0] + sb[1]) + (sb[2] + sb[3]);
                    const bf16x8_t pt = pack_p(sa, sb);
#pragma unroll
                    for (int mt = 0; mt < 4; ++mt) Os[mt] = MFMA16(va[hf][mt], pt, Os[mt]);
                }
            }
#ifdef APROBE_SEL
            }
#endif
            ls += bperm_f(ls, lane ^ 16); ls += bperm_f(ls, lane ^ 32);
            if (col < 4) {
                const float den = ls + LF[tt * 4 + col]; const float w = den > 0.f ? (NG + qrow * 24 + g * 12)[col * 3 + 1] / den : 0.f;
#pragma unroll
                for (int mt = 0; mt < 4; ++mt) { const int e = (tt * 4 + col) * 64 + 16 * mt + 4 * fq; const v2u old = *(const LAS v2u*)(OS + e), fo = *(const LAS v2u*)(OF + e);
                    v2u w2; w2.x = cvt_pk_bf16(blo(old.x) + w * (Os[mt][0] + blo(fo.x)), bhi(old.x) + w * (Os[mt][1] + bhi(fo.x))); w2.y = cvt_pk_bf16(blo(old.y) + w * (Os[mt][2] + blo(fo.y)), bhi(old.y) + w * (Os[mt][3] + bhi(fo.y)));
                    *(v2u*)(QB + qrow * LDQ + (g * 4 + col) * 64 + 16 * mt + 4 * fq) = w2; }
            }
        }
    }
    LDS_WAIT(); asm volatile("" ::: "memory");
#undef Qc
}

typedef _Float16 h16x2 __attribute__((ext_vector_type(2)));
__device__ __forceinline__ h16x2 as_h2(unsigned u) { h16x2 r; __builtin_memcpy(&r, &u, 4); return r; }
constexpr int SC_STEPS = 8, SC_BUF = 6 * 1024;
__device__ __forceinline__ float dpp_sum16(float v) {
    v += __builtin_bit_cast(float, __builtin_amdgcn_update_dpp(0, __builtin_bit_cast(int, v), 0xB1, 0xF, 0xF, true));
    v += __builtin_bit_cast(float, __builtin_amdgcn_update_dpp(0, __builtin_bit_cast(int, v), 0x4E, 0xF, 0xF, true));
    v += __builtin_bit_cast(float, __builtin_amdgcn_update_dpp(0, __builtin_bit_cast(int, v), 0x141, 0xF, 0xF, true));
    v += __builtin_bit_cast(float, __builtin_amdgcn_update_dpp(0, __builtin_bit_cast(int, v), 0x140, 0xF, 0xF, true));
    return v;
}
__device__ __forceinline__ void scan_fill(const bf16* RW, const bf16* Wm, const bf16* Am, size_t trow, int h, int lane, LAS unsigned char* buf) {
    const size_t t = trow + (lane >> 3); const int sub = (lane & 7) * 8;
    const bf16* row = RW + t * LDRW + h * 64 + sub;
    __builtin_amdgcn_global_load_lds((const unsigned*)(row + LBLK), (LAS unsigned*)(buf + 0 * 1024), 16, 0, 0);
    __builtin_amdgcn_global_load_lds((const unsigned*)(Am + t * RC + h * 64 + sub), (LAS unsigned*)(buf + 1 * 1024), 16, 0, 0);
    __builtin_amdgcn_global_load_lds((const unsigned*)(Wm + t * RC + h * 64 + sub), (LAS unsigned*)(buf + 2 * 1024), 16, 0, 0);
    __builtin_amdgcn_global_load_lds((const unsigned*)(row + 512), (LAS unsigned*)(buf + 3 * 1024), 16, 0, 0);
    __builtin_amdgcn_global_load_lds((const unsigned*)(row), (LAS unsigned*)(buf + 4 * 1024), 16, 0, 0);
    __builtin_amdgcn_global_load_lds((const unsigned*)(row + 1024), (LAS unsigned*)(buf + 5 * 1024), 16, 0, 0);
}
__device__ __forceinline__ void scan_unit(const P& p, int unit, int lane, LAS unsigned char* wl) {
    const bf16* RW = WSP(bf16, AR_RW); const bf16* Wm = WSP(bf16, AR_W); const bf16* Am = WSP(bf16, AR_A); bf16* Y = WSP(bf16, AR_UB);
    const int rg = unit & 15, h = (unit >> 4) & 7, b = unit >> 7, row = rg * 4 + (lane >> 4), kq = lane & 15;
    const size_t tb = (size_t)b * SEQ;
    float s0 = 0.f, s1 = 0.f, s2 = 0.f, s3 = 0.f;
    __builtin_amdgcn_s_setprio(3);
    scan_fill(RW, Wm, Am, tb, h, lane, wl);
#pragma unroll 1
    for (int c = 0; c < SEQ / SC_STEPS; ++c) {
        LAS unsigned char* buf = wl + (c & 1) * SC_BUF;
        asm volatile("s_waitcnt vmcnt(0) lgkmcnt(0)" ::: "memory");
        if (c + 1 < SEQ / SC_STEPS) scan_fill(RW, Wm, Am, tb + (size_t)(c + 1) * SC_STEPS, h, lane, wl + ((c + 1) & 1) * SC_BUF);
#ifndef SCAN_VARB
        float ys[SC_STEPS];
#pragma unroll
        for (int st = 0; st < SC_STEPS; ++st) {
            const LAS unsigned char* o = buf + st * 128 + kq * 8;
            const v2u kkw = *(const LAS v2u*)(o), bbw = *(const LAS v2u*)(o + 1024), eew = *(const LAS v2u*)(o + 2048), ktw = *(const LAS v2u*)(o + 3072), rrw = *(const LAS v2u*)(o + 4096);
#ifdef SCAN_BF16
            struct F2 { float x, y; }; const F2 kk0{blo(kkw.x), bhi(kkw.x)}, kk1{blo(kkw.y), bhi(kkw.y)}, bb0{blo(bbw.x), bhi(bbw.x)}, bb1{blo(bbw.y), bhi(bbw.y)}, ee0{blo(eew.x), bhi(eew.x)}, ee1{blo(eew.y), bhi(eew.y)}, kt0{blo(ktw.x), bhi(ktw.x)}, kt1{blo(ktw.y), bhi(ktw.y)}, rr0{blo(rrw.x), bhi(rrw.x)}, rr1{blo(rrw.y), bhi(rrw.y)};
            const float vv = bf2f(*(const LAS unsigned short*)(buf + 5 * 1024 + st * 128 + row * 2));
#else
            const h16x2 kk0 = as_h2(kkw.x), kk1 = as_h2(kkw.y), bb0 = as_h2(bbw.x), bb1 = as_h2(bbw.y);
            const h16x2 ee0 = as_h2(eew.x), ee1 = as_h2(eew.y);
#ifdef RKV_BF16
            struct F2 { float x, y; }; const F2 kt0{blo(ktw.x), bhi(ktw.x)}, kt1{blo(ktw.y), bhi(ktw.y)}, rr0{blo(rrw.x), bhi(rrw.x)}, rr1{blo(rrw.y), bhi(rrw.y)};
            const float vv = bf2f(*(const LAS unsigned short*)(buf + 5 * 1024 + st * 128 + row * 2));
#else
            const h16x2 kt0 = as_h2(ktw.x), kt1 = as_h2(ktw.y);
            const h16x2 rr0 = as_h2(rrw.x), rr1 = as_h2(rrw.y);
            const float vv = (float)__builtin_bit_cast(_Float16, *(const LAS unsigned short*)(buf + 5 * 1024 + st * 128 + row * 2));
#endif
#endif
            float d0 = __builtin_fmaf(s0, (float)kk0.x, 0.f); d0 = __builtin_fmaf(s1, (float)kk0.y, d0); float d1 = __builtin_fmaf(s2, (float)kk1.x, 0.f); d1 = __builtin_fmaf(s3, (float)kk1.y, d1);
            const float nskk = -dpp_sum16(d0 + d1);
            s0 = __builtin_fmaf(s0, -(float)ee0.x, s0); s1 = __builtin_fmaf(s1, -(float)ee0.y, s1); s2 = __builtin_fmaf(s2, -(float)ee1.x, s2); s3 = __builtin_fmaf(s3, -(float)ee1.y, s3);
            s0 = __builtin_fmaf(nskk, (float)bb0.x, s0); s1 = __builtin_fmaf(nskk, (float)bb0.y, s1); s2 = __builtin_fmaf(nskk, (float)bb1.x, s2); s3 = __builtin_fmaf(nskk, (float)bb1.y, s3);
            s0 = __builtin_fmaf(vv, (float)kt0.x, s0); s1 = __builtin_fmaf(vv, (float)kt0.y, s1); s2 = __builtin_fmaf(vv, (float)kt1.x, s2); s3 = __builtin_fmaf(vv, (float)kt1.y, s3);
            float y0 = __builtin_fmaf(s0, (float)rr0.x, 0.f); y0 = __builtin_fmaf(s1, (float)rr0.y, y0); float y1 = __builtin_fmaf(s2, (float)rr1.x, 0.f); y1 = __builtin_fmaf(s3, (float)rr1.y, y1);
            ys[st] = dpp_sum16(y0 + y1);
        }
        if (kq < SC_STEPS) { float yv = ys[0];
#pragma unroll
            for (int st = 1; st < SC_STEPS; ++st) yv = (kq == st) ? ys[st] : yv;
            Y[(tb + (size_t)c * SC_STEPS + kq) * RC + h * 64 + row] = f2bf(yv); }
    }
#else
#pragma unroll
        for (int st = 0; st < SC_STEPS; ++st) {
            const LAS unsigned char* o = buf + st * 128 + kq * 8;
            float kk[4], bb[4], ee[4], kt[4], rr[4];
            { const v2u w = *(const LAS v2u*)(o); const h16x2 a = as_h2(w.x), b2 = as_h2(w.y); kk[0] = (float)a.x; kk[1] = (float)a.y; kk[2] = (float)b2.x; kk[3] = (float)b2.y; }
            { const v2u w = *(const LAS v2u*)(o + 1024); const h16x2 a = as_h2(w.x), b2 = as_h2(w.y); bb[0] = (float)a.x; bb[1] = (float)a.y; bb[2] = (float)b2.x; bb[3] = (float)b2.y; }
            { const v2u w = *(const LAS v2u*)(o + 2048); const h16x2 a = as_h2(w.x), b2 = as_h2(w.y); ee[0] = (float)a.x; ee[1] = (float)a.y; ee[2] = (float)b2.x; ee[3] = (float)b2.y; }
            { const v2u w = *(const LAS v2u*)(o + 3072); const h16x2 a = as_h2(w.x), b2 = as_h2(w.y); kt[0] = (float)a.x; kt[1] = (float)a.y; kt[2] = (float)b2.x; kt[3] = (float)b2.y; }
            { const v2u w = *(const LAS v2u*)(o + 4096); const h16x2 a = as_h2(w.x), b2 = as_h2(w.y); rr[0] = (float)a.x; rr[1] = (float)a.y; rr[2] = (float)b2.x; rr[3] = (float)b2.y; }
            const float vv = (float)__builtin_bit_cast(_Float16, *(const LAS unsigned short*)(buf + 5 * 1024 + st * 128 + row * 2));
            const float skk = dpp_sum16((s0 * kk[0] + s1 * kk[1]) + (s2 * kk[2] + s3 * kk[3]));
            s0 = s0 - s0 * ee[0] - skk * bb[0] + vv * kt[0]; s1 = s1 - s1 * ee[1] - skk * bb[1] + vv * kt[1]; s2 = s2 - s2 * ee[2] - skk * bb[2] + vv * kt[2]; s3 = s3 - s3 * ee[3] - skk * bb[3] + vv * kt[3];
            const float y = dpp_sum16((s0 * rr[0] + s1 * rr[1]) + (s2 * rr[2] + s3 * rr[3]));
            if (kq == 0) Y[(tb + (size_t)c * SC_STEPS + st) * RC + h * 64 + row] = f2bf(y);
        }
    }
#endif
    asm volatile("s_waitcnt vmcnt(0) lgkmcnt(0)" ::: "memory");
    __builtin_amdgcn_s_setprio(0);
}
__device__ __forceinline__ float sum8(float v) {
    v += __builtin_bit_cast(float, __builtin_amdgcn_update_dpp(0, __builtin_bit_cast(int, v), 0xB1, 0xF, 0xF, true));
    v += __builtin_bit_cast(float, __builtin_amdgcn_update_dpp(0, __builtin_bit_cast(int, v), 0x4E, 0xF, 0xF, true));
    v += __builtin_bit_cast(float, __builtin_amdgcn_update_dpp(0, __builtin_bit_cast(int, v), 0x141, 0xF, 0xF, true));
    return v;
}
__device__ __forceinline__ void up8(v4u w, float* f) { f[0] = blo(w.x); f[1] = bhi(w.x); f[2] = blo(w.y); f[3] = bhi(w.y); f[4] = blo(w.z); f[5] = bhi(w.z); f[6] = blo(w.w); f[7] = bhi(w.w); }
#ifdef SCAN_BF16
#define uph8 up8
#define pkh8 pk8
#else
#define uph8 uph8_
#define pkh8 pkh8_
#endif
__device__ __forceinline__ void uph8_(v4u w, float* f) { const h16x2 a = as_h2(w.x), b = as_h2(w.y), c = as_h2(w.z), d = as_h2(w.w);
    f[0] = (float)a.x; f[1] = (float)a.y; f[2] = (float)b.x; f[3] = (float)b.y; f[4] = (float)c.x; f[5] = (float)c.y; f[6] = (float)d.x; f[7] = (float)d.y; }
__device__ __forceinline__ unsigned pkh2(float lo, float hi) { h16x2 v; v.x = (_Float16)lo; v.y = (_Float16)hi; return __builtin_bit_cast(unsigned, v); }
__device__ __forceinline__ v4u pkh8_(const float* f) { v4u w; w.x = pkh2(f[0], f[1]); w.y = pkh2(f[2], f[3]); w.z = pkh2(f[4], f[5]); w.w = pkh2(f[6], f[7]); return w; }
__device__ __forceinline__ v4u pk8(const float* f) { v4u w; w.x = cvt_pk_bf16(f[0], f[1]); w.y = cvt_pk_bf16(f[2], f[3]); w.z = cvt_pk_bf16(f[4], f[5]); w.w = cvt_pk_bf16(f[6], f[7]); return w; }
__device__ __forceinline__ void ldf8(const float* p, float* f) { const f32x4 a = *(const f32x4*)p, b = *(const f32x4*)(p + 4); f[0] = a[0]; f[1] = a[1]; f[2] = a[2]; f[3] = a[3]; f[4] = b[0]; f[5] = b[1]; f[6] = b[2]; f[7] = b[3]; }

struct EpiLora {
    static constexpr bool PERM = true, AFTER_DRAIN = false;
    unsigned char* ws;
    __device__ __forceinline__ void operator()(const f32x4 (&acc)[2][2][4][2], const Unit& u, int wr, int wc, int fr, int fq) const {
        const int which = u.pn >> 1, row0 = u.pm * BM + wr * 64 + fr, c0 = (u.pn & 1) * 256 + wc * 32 + 8 * fq;
        bf16* const O = (bf16*)(ws + (which == 0 ? AR_W : (which == 1 ? AR_A : (which == 2 ? AR_G : AR_UB))));
#pragma unroll
        for (int ai = 0; ai < 2; ++ai)
#pragma unroll
            for (int m = 0; m < 4; ++m)
#pragma unroll
                for (int bj = 0; bj < 2; ++bj) *(u32x4*)(O + (size_t)(row0 + ai * HALF + m * 16) * RC + c0 + bj * HALF) = pack8(acc[ai][bj][m][0], acc[ai][bj][m][1]);
    }
};
#ifdef RKV_BF16
#define UPR up8
#define PKR pk8
#else
#define UPR uph8
#define PKR pkh8
#endif
struct B2In { v4u k, a, w, vr, vv, vf; float gt; };
__device__ __forceinline__ void b2w_load(B2In& in, const P& p, int layer, int t, int lane) {
    const bf16* row = WSP(bf16, AR_RW) + (size_t)t * LDRW;
    in.k = *(const v4u*)(row + 512 + 8 * lane); in.a = *(const v4u*)(WSP(bf16, AR_A) + (size_t)t * RC + 8 * lane); in.w = *(const v4u*)(WSP(bf16, AR_W) + (size_t)t * RC + 8 * lane);
    in.gt = lane < 24 ? bf2f(row[LBLK + 320 + lane]) : 0.f;
    if (layer == 1) { in.vr = *(const v4u*)(WSP(bf16, AR_UB) + (size_t)t * RC + 8 * lane); in.vv = *(const v4u*)(row + 1024 + 8 * lane); in.vf = *(const v4u*)(WSP(bf16, WS_VF) + (size_t)t * RC + 8 * lane); }
}
__device__ __forceinline__ void b2w_compute(const B2In& in, const P& p, int layer, int t, int lane, const float* v0, const float* v1, const float* v2, const float* v3, const float* vb) {
    bf16* row = WSP(bf16, AR_RW) + (size_t)t * LDRW; bf16* Am = WSP(bf16, AR_A); bf16* Wm = WSP(bf16, AR_W); float* NG = WSP(float, AR_NG);
    float k[8], a[8], w[8]; uph8(in.k, k); up8(in.a, a); up8(in.w, w);
    const float ngv = fsig(in.gt);
    float kk[8], ss = 0.f;
#pragma unroll
    for (int i = 0; i < 8; ++i) {
        a[i] = fsig(a[i] + v1[i]);
        const float nx = -(w[i] + v0[i]), sp = fmaxf(nx, 0.f) + __logf(1.f + __expf(-fabsf(nx))), e = __expf(-sp - 0.5f); w[i] = 1.f - __expf(-e);
        kk[i] = k[i] * v2[i]; ss += kk[i] * kk[i]; }
    ss = sum8(ss); const float nrm = sqrtf(ss), inv = 1.f / (nrm > 1e-12f ? nrm : 1e-12f);
#pragma unroll
    for (int i = 0; i < 8; ++i) { kk[i] *= inv; k[i] = k[i] * (1.f + (a[i] - 1.f) * v3[i]); a[i] *= kk[i]; }
    asm volatile("" :: "v"(ngv));
    if (layer == 1) { float vr[8], vv[8], vf[8]; up8(in.vr, vr); uph8(in.vv, vv); uph8(in.vf, vf);
#pragma unroll
        for (int i = 0; i < 8; ++i) vv[i] = vv[i] + (vf[i] - vv[i]) * fsig(vr[i] + vb[i]);
        *(v4u*)(row + 1024 + 8 * lane) = pkh8(vv); }
    if (lane < 24) NG[(size_t)t * 24 + lane] = ngv;
    *(v4u*)(row + LBLK + 8 * lane) = pkh8(kk); *(v4u*)(row + 512 + 8 * lane) = pkh8(k);
    *(v4u*)(Am + (size_t)t * RC + 8 * lane) = pkh8(a); *(v4u*)(Wm + (size_t)t * RC + 8 * lane) = pkh8(w);
}
__device__ __forceinline__ void ph_rwkv_b2w(const P& p, int layer, int gw, int NGW, int lane) {
    const float* vec = p.rwkv_vec + (size_t)layer * 7 * RC; float v0[8], v1[8], v2[8], v3[8], vb[8];
    ldf8(vec + 8 * lane, v0); ldf8(vec + RC + 8 * lane, v1); ldf8(vec + 2 * RC + 8 * lane, v2); ldf8(vec + 3 * RC + 8 * lane, v3); ldf8(p.vres_b + 8 * lane, vb);
    int t = gw; if (t >= T) return;
    B2In A, B; b2w_load(A, p, layer, t, lane);
    for (; t < T; t += 2 * NGW) { const int t1 = t + NGW, t2 = t1 + NGW;
        b2w_load(B, p, layer, t1 < T ? t1 : t, lane); b2w_compute(A, p, layer, t, lane, v0, v1, v2, v3, vb);
        if (t1 < T) { b2w_load(A, p, layer, t2 < T ? t2 : t1, lane); b2w_compute(B, p, layer, t1, lane, v0, v1, v2, v3, vb); } }
}
struct PoIn { v4u y, r, k, v, g; };
__device__ __forceinline__ void post_load(PoIn& in, const P& p, int t, int lane) { const bf16* row = WSP(bf16, AR_RW) + (size_t)t * LDRW;
    in.y = *(const v4u*)(WSP(bf16, AR_UB) + (size_t)t * RC + 8 * lane); in.r = *(const v4u*)(row + 8 * lane); in.k = *(const v4u*)(row + 512 + 8 * lane); in.v = *(const v4u*)(row + 1024 + 8 * lane); in.g = *(const v4u*)(WSP(bf16, AR_G) + (size_t)t * RC + 8 * lane); }
__device__ __forceinline__ void post_compute(const PoIn& in, const P& p, int t, int lane, const float* v4_, const float* v5, const float* v6) {
    float y[8], r[8], k[8], v[8], g[8]; up8(in.y, y); uph8(in.r, r); uph8(in.k, k); uph8(in.v, v); up8(in.g, g);
    float s = 0.f, bon = 0.f;
#pragma unroll
    for (int i = 0; i < 8; ++i) { s += y[i]; bon += r[i] * k[i] * v4_[i]; }
    const float m = sum8(s) * (1.f / 64.f); bon = sum8(bon);
    float q = 0.f;
#pragma unroll
    for (int i = 0; i < 8; ++i) { y[i] -= m; q += y[i] * y[i]; }
    const float rstd = 1.f / sqrtf(sum8(q) * (1.f / 64.f) + GN_EPS);
#pragma unroll
    for (int i = 0; i < 8; ++i) y[i] = (y[i] * rstd * v5[i] + v6[i] + bon * v[i]) * g[i];
    *(v4u*)(WSP(bf16, AR_A) + (size_t)t * RC + 8 * lane) = pk8(y);
}
__device__ __forceinline__ void ph_rwkv_postw(const P& p, int layer, int gw, int NGW, int lane) {
    const float* vec = p.rwkv_vec + (size_t)layer * 7 * RC; float v4_[8], v5[8], v6[8]; ldf8(vec + 4 * RC + 8 * lane, v4_); ldf8(vec + 5 * RC + 8 * lane, v5); ldf8(vec + 6 * RC + 8 * lane, v6);
    int t = gw; if (t >= T) return;
    PoIn A, B; post_load(A, p, t, lane);
    for (; t < T; t += 2 * NGW) { const int t1 = t + NGW, t2 = t1 + NGW;
        post_load(B, p, t1 < T ? t1 : t, lane); post_compute(A, p, t, lane, v4_, v5, v6);
        if (t1 < T) { post_load(A, p, t2 < T ? t2 : t1, lane); post_compute(B, p, t1, lane, v4_, v5, v6); } }
}
__device__ __forceinline__ void ph_convw(const P& p, int layer, int gw, int NGW, int lane, int tid, LAS unsigned char* lds) {
    const bf16* UB = WSP(bf16, AR_UB); bf16* CO = WSP(bf16, AR_CO);
    const float* cw = p.conv_w + (size_t)layer * CONV_K * CONV_CH; const float* cv = p.conv_vec + (size_t)layer * 3 * CONV_CH;
    LAS float* wl = (LAS float*)lds;
    for (int i = tid; i < CONV_K * CONV_CH; i += NTHREADS) wl[i] = cw[i];
    __syncthreads();
    float b0[8], g1[8], b2[8]; ldf8(cv + 8 * lane, b0); ldf8(cv + CONV_CH + 8 * lane, g1); ldf8(cv + 2 * CONV_CH + 8 * lane, b2);
    for (int tb = gw * 4; tb < T; tb += NGW * 4) {
        const int pos0 = tb % SEQ, j0 = pos0 >= 30 ? 0 : 30 - pos0;
        float a[4][8], wt[4][8];
#pragma unroll
        for (int q = 0; q < 4; ++q)
#pragma unroll
            for (int i = 0; i < 8; ++i) a[q][i] = b0[i];
#pragma unroll 1
        for (int j4 = 0; j4 < CONV_K + 3; j4 += 4) {
#pragma unroll
            for (int jj = 0; jj < 4; ++jj) { const int j = j4 + jj;
                if (j < CONV_K) { const f32x4 w0 = *(const LAS f32x4*)(wl + j * CONV_CH + 8 * lane), w1 = *(const LAS f32x4*)(wl + j * CONV_CH + 8 * lane + 4);
#pragma unroll
                    for (int i = 0; i < 4; ++i) { wt[jj][i] = w0[i]; wt[jj][4 + i] = w1[i]; } }
                float u[8];
                if (j >= j0 && j < CONV_K + 3) up8(*(const v4u*)(UB + (size_t)(tb - 30 + j) * CONV_CH + 8 * lane), u); else {
#pragma unroll
                    for (int i = 0; i < 8; ++i) u[i] = 0.f; }
#pragma unroll
                for (int q = 0; q < 4; ++q) { const int tap = j - q; if (tap >= 0 && tap < CONV_K) {
#pragma unroll
                    for (int i = 0; i < 8; ++i) a[q][i] += u[i] * wt[(jj - q) & 3][i]; } }
            }
        }
#pragma unroll
        for (int q = 0; q < 4; ++q) {
            float s = 0.f;
#pragma unroll
            for (int i = 0; i < 8; ++i) s += a[q][i];
            const float mean = wave_sum(s, lane) * (1.f / CONV_CH); float qq = 0.f;
#pragma unroll
            for (int i = 0; i < 8; ++i) { a[q][i] -= mean; qq += a[q][i] * a[q][i]; }
            const float rstd = 1.f / sqrtf(wave_sum(qq, lane) * (1.f / CONV_CH) + LN_EPS);
#pragma unroll
            for (int i = 0; i < 8; ++i) { const float y = a[q][i] * rstd * g1[i] + b2[i]; a[q][i] = y * fsig(y); }
            *(v4u*)(CO + (size_t)(tb + q) * CONV_CH + 8 * lane) = pk8(a[q]);
        }
    }
    __syncthreads();
}
__device__ __forceinline__ void ph_cmp2w(const P& p, int layer, int gw, int NGW, int lane, LAS float* hl  ) {
    const bf16* Z = WSP(bf16, AR_HID); const float* pec = (const float*)(p.ws + WS_W + (size_t)layer * SZ_LAYERW + OFF_PEC);
    for (int it = gw; it < 2 * BATCH * NKV * NC; it += NGW) {
        const int i = it % NC, r = it / NC, bg = r % (BATCH * NKV), which = r / (BATCH * NKV);
        const bf16* z1 = Z + ((size_t)which * (BATCH * NKV * 512) + (size_t)bg * 512 + i) * 256; const bf16* z2 = z1 + 256 + 128;
#pragma unroll
        for (int jj = 0; jj < 2; ++jj) { const int j = lane + 64 * jj; const float x = bf2f(z1[j]) + bf2f(z2[j]) + pec[which * 128 + j];
            const float e = __expf(fminf(2.f * 0.7978845608028654f * (x + 0.044715f * x * x * x), 30.f)); hl[j] = 0.5f * x * (1.f + (e - 1.f) / (e + 1.f)); }
        LDS_WAIT(); asm volatile("" ::: "memory");
        const float* w2 = p.cmp_w2 + (size_t)(layer * 2 + which) * 128 * 64 + lane; float o = 0.f;
#pragma unroll 8
        for (int j = 0; j < 128; ++j) o += hl[j] * w2[j * 64];
        if (which == 0) {
            const float rs = 1.f / sqrtf(wave_sum(o * o, lane) * (1.f / 64.f) + RMS_EPS); o = o * rs * p.qk_g[(layer * 4 + 1) * 64 + lane];
            const float other = bperm_f(o, lane ^ 32); float cs, sn; rope_cs(16 * i + 31, lane & 31, cs, sn);
            o = lane < 32 ? o * cs - other * sn : o * cs + other * sn;
            WSP(bf16, AR_KC)[(((size_t)bg * 8 + (lane >> 3)) * 512 + i) * 8 + (lane & 7)] = f2bf(o);
        } else { bf16* vt = WSP(bf16, AR_VCT) + (size_t)bg * 64 * 512 + lane * 8;
            vt[(size_t)((i >> 5) * 4 + ((i & 15) >> 2)) * 512 + (i & 3) + 4 * ((i >> 4) & 1)] = f2bf(o); if (i == 0) vt[(size_t)((NC >> 5) * 4 + ((NC & 15) >> 2)) * 512 + (NC & 3) + 4 * ((NC >> 4) & 1)] = 0; }
        LDS_WAIT(); asm volatile("" ::: "memory");
    }
}

struct MapPlain { bf16* base; int K; __device__ __forceinline__ bf16* operator()(int col) const { return base + (size_t)col * K; } };
struct MapGlu { bf16* base; int K, ff; __device__ __forceinline__ bf16* operator()(int col) const { return base + (size_t)glu_dest(col, ff) * K; } };
struct MapWin { unsigned char* wl; int layer; __device__ __forceinline__ bf16* operator()(int col) const { int which; const int r = win_dest(col, layer, which); const size_t off = (which ? OFF_WG : OFF_WIN) + (size_t)(r < 0 ? 0 : r) * DM * 2; return r < 0 ? nullptr : (bf16*)(wl + off); } };
template <class Map>
__device__ __forceinline__ void transpose_item(const float* W, int K, int N, const Map& mp, LAS float* scr, int item, int lane) {
    const int nblk = (N + 31) / 32, kb = item / nblk, nb = item % nblk, k0 = 64 * kb, n0 = 32 * nb;
    const int col = n0 + (lane & 31);
#pragma unroll 8
    for (int i = 0; i < 32; ++i) { const int kk = 2 * i + (lane >> 5); scr[kk * 33 + (lane & 31)] = col < N ? W[(size_t)(k0 + kk) * N + col] : 0.f; }
    LDS_WAIT(); asm volatile("" ::: "memory");
    const int c = lane & 7;
#pragma unroll
    for (int j = 0; j < 4; ++j) { const int n = (lane >> 3) + 8 * j; const LAS float* s = scr + (8 * c) * 33 + n;
        v4u o; o.x = (unsigned)f2bf(s[0]) | ((unsigned)f2bf(s[33]) << 16); o.y = (unsigned)f2bf(s[66]) | ((unsigned)f2bf(s[99]) << 16);
        o.z = (unsigned)f2bf(s[132]) | ((unsigned)f2bf(s[165]) << 16); o.w = (unsigned)f2bf(s[198]) | ((unsigned)f2bf(s[231]) << 16);
        if (n0 + n < N) { bf16* d = mp(n0 + n); if (d) *(v4u*)(d + k0 + 8 * c) = o; } }
    LDS_WAIT(); asm volatile("" ::: "memory");
}
template <class Map>
__device__ __forceinline__ bool conv_job(int& r, const float* W, int K, int N, const Map& mp, LAS float* scr, int lane) {
    const int items = (K / 64) * ((N + 31) / 32);
    if (r < items) { transpose_item(W, K, N, mp, scr, r, lane); return true; }
    r -= items; return false;
}

struct RmsIn { f32x4 v[DM / 256]; };
__device__ __forceinline__ void rms_load(RmsIn& r, const float* xrow, int lane) { const f32x4* xr = (const f32x4*)xrow + lane;
#pragma unroll
    for (int j = 0; j < DM / 256; ++j) r.v[j] = xr[64 * j]; }
__device__ __forceinline__ void rms_row(const P& p, const RmsIn& rin, const float* g, bf16* orow, int lane, bool route, int t, unsigned long long& c0, unsigned long long& c1) {
    const f32x4* gr = (const f32x4*)g + lane;
    f32x4 v[DM / 256]; float ss = 0.f;
#pragma unroll
    for (int j = 0; j < DM / 256; ++j) { v[j] = rin.v[j]; ss += (v[j].x * v[j].x + v[j].y * v[j].y) + (v[j].z * v[j].z + v[j].w * v[j].w); }
    const float rs = 1.f / sqrtf(wave_sum(ss, lane) * (1.f / DM) + RMS_EPS);
    v2u* o8 = (v2u*)orow + lane;
#pragma unroll
    for (int j = 0; j < DM / 256; ++j) { const f32x4 gg = gr[64 * j]; v[j].x *= rs * gg.x; v[j].y *= rs * gg.y; v[j].z *= rs * gg.z; v[j].w *= rs * gg.w;
        v2u w; w.x = cvt_pk_bf16(v[j].x, v[j].y); w.y = cvt_pk_bf16(v[j].z, v[j].w); o8[64 * j] = w; }
    if (route) {
        float lg[NEXP];
#pragma unroll
        for (int e = 0; e < NEXP; ++e) lg[e] = 0.f;
#pragma unroll
        for (int j = 0; j < DM / 256; ++j) { const float* rw = p.router_w + (size_t)(4 * (lane + 64 * j)) * NEXP;
#pragma unroll
            for (int e = 0; e < NEXP; ++e) lg[e] += v[j].x * rw[e] + v[j].y * rw[NEXP + e] + v[j].z * rw[2 * NEXP + e] + v[j].w * rw[3 * NEXP + e]; }
#pragma unroll
        for (int e = 0; e < NEXP; ++e) lg[e] = wave_sum(lg[e], lane) + p.router_b[e];
        int e0 = 0; float l0 = lg[0];
#pragma unroll
        for (int e = 1; e < NEXP; ++e) if (lg[e] > l0) { l0 = lg[e]; e0 = e; }
        int e1 = -1; float l1 = -3e38f;
#pragma unroll
        for (int e = 0; e < NEXP; ++e) if (e != e0 && lg[e] > l1) { l1 = lg[e]; e1 = e; }
        e0 = __builtin_amdgcn_readfirstlane(e0); e1 = __builtin_amdgcn_readfirstlane(e1);
        const int r0 = (int)((c0 >> (8 * e0)) & 255ull), r1 = (int)((c1 >> (8 * e1)) & 255ull);
        c0 += 1ull << (8 * e0); c1 += 1ull << (8 * e1);
        if (lane == 0) { const float w0 = 1.f / (1.f + expf(l1 - l0));
            WSP(int, AR_RTE)[t] = e0 | (e1 << 8) | (r0 << 16) | (r1 << 24); float* rw = WSP(float, AR_RTW) + (size_t)t * 2; rw[0] = w0; rw[1] = 1.f - w0; }
    }
}
__device__ __forceinline__ void copy_rows4(const bf16* s0, const bf16* s1, const bf16* s2, const bf16* s3, bf16* d0, bf16* d1, bf16* d2, bf16* d3, int lane) {
    v4u a[4][DM / 512];
#pragma unroll
    for (int j = 0; j < DM / 512; ++j) { a[0][j] = ((const v4u*)s0)[lane + 64 * j]; a[1][j] = ((const v4u*)s1)[lane + 64 * j]; a[2][j] = ((const v4u*)s2)[lane + 64 * j]; a[3][j] = ((const v4u*)s3)[lane + 64 * j]; }
#pragma unroll
    for (int j = 0; j < DM / 512; ++j) { ((v4u*)d0)[lane + 64 * j] = a[0][j]; ((v4u*)d1)[lane + 64 * j] = a[1][j]; ((v4u*)d2)[lane + 64 * j] = a[2][j]; ((v4u*)d3)[lane + 64 * j] = a[3][j]; }
}
__device__ __forceinline__ void copy_row_wave(const bf16* src, bf16* dst, int lane) {
#pragma unroll
    for (int j = 0; j < DM / 512; ++j) ((v4u*)dst)[lane + 64 * j] = ((const v4u*)src)[lane + 64 * j];
}
__device__ __forceinline__ int moe_seg_start(const unsigned* cnt, int e) { int s = 0;
#pragma unroll
    for (int k = 0; k < NEXP; ++k) s += (k < e) ? (int)((cnt[k] + 255u) & ~255u) : 0;
    return s; }

#ifndef PHMASK
#define PHMASK 0xFFFFFFFFu
#endif
#define PHM(k) (((PHMASK) >> (k)) & 1u)
#ifdef PROBE_LO
constexpr int PR_LO = PROBE_LO, PR_HI = PROBE_HI;
#else
constexpr int PR_LO = -1, PR_HI = -1;
#endif
constexpr int NPH = 16, NPHASES = 1 + 2 * NPH;
struct Args { const float* in[29]; float* out; unsigned char* ws; int ph_lo, ph_hi; };

__device__ __forceinline__ bool in_phase(int k, int lo, int hi) { asm volatile("" : "+s"(lo), "+s"(hi)); return lo <= k && k < hi; }
typedef const Args __attribute__((address_space(4)))* CArgsP;
__device__ __forceinline__ void fill_params_k(P& p, CArgsP a) {
    p.x = a->in[0]; p.mix_norm_g = a->in[1]; p.w_in_first = a->in[2]; p.w_in_rest = a->in[3]; p.mu_first = a->in[4]; p.mu_rest = a->in[5]; p.qk_g = a->in[6]; p.cmp_pos = a->in[7];
    p.cmp_w1 = a->in[8]; p.cmp_w2 = a->in[9]; p.nsa_w_o = a->in[10]; p.conv_w = a->in[11]; p.conv_vec = a->in[12]; p.conv_w_o = a->in[13]; p.rwkv_vec = a->in[14]; p.w_up = a->in[15];
    p.a_up = a->in[16]; p.g_up = a->in[17]; p.vres_up = a->in[18]; p.vres_b = a->in[19]; p.rwkv_w_o = a->in[20]; p.w_out = a->in[21]; p.ffn_norm_g = a->in[22]; p.dense_gu = a->in[23];
    p.dense_down = a->in[24]; p.router_w = a->in[25]; p.router_b = a->in[26]; p.moe_gu = a->in[27]; p.moe_down = a->in[28]; p.out = a->out; p.ws = a->ws;
}
__global__ void __launch_bounds__(NTHREADS, 2) mk_fwd(Args args) {
    extern __shared__ __attribute__((aligned(16))) unsigned char lds_raw[];
    LAS unsigned char* lds = (LAS unsigned char*)lds_raw;
    const int wave0 = __builtin_amdgcn_readfirstlane((int)threadIdx.x >> 6);
    const int tid = wave0 * 64 + lane_id_opaque();
    unsigned* ctl = (unsigned*)(args.ws + WS_CTL);
    for (int u = tid; u < (LDS_BYTES - LDSCTL_OFF) / 4; u += NTHREADS) ((LAS unsigned*)(lds + LDSCTL_OFF))[u] = 0u;
    __syncthreads();
    const int lo = args.ph_lo, hi = args.ph_hi;
    XcdBarrier bar; bar.bar = ctl + CW_BAR; bar.x = 0; bar.st = nullptr;
    if (hi - lo > 1) { bar.x = xb_xcc_id(); bar.st = (volatile LAS unsigned*)(lds + MISC_OFF) + 8; if (tid == 0) (void)xb_add(ctl + CW_BAR + XB_XCNT(bar.x), 1u); }
#define RMS_LOOP(X, GN, ROUTE, C0, C1) do { int m_ = gw; if (m_ < T) { RmsIn ra_, rb_; rms_load(ra_, (X) + (size_t)m_ * DM, lane); \
        for (; m_ < T; m_ += 2 * NGW) { const int m1_ = m_ + NGW, m2_ = m1_ + NGW; rms_load(rb_, (X) + (size_t)(m1_ < T ? m1_ : m_) * DM, lane); \
            rms_row(p, ra_, (GN), WSP(bf16, WS_H) + (size_t)m_ * DM, lane, (ROUTE), m_, C0, C1); \
            if (m1_ < T) { rms_load(ra_, (X) + (size_t)(m2_ < T ? m2_ : m1_) * DM, lane); rms_row(p, rb_, (GN), WSP(bf16, WS_H) + (size_t)m1_ * DM, lane, (ROUTE), m1_, C0, C1); } } } } while (0)
#define IN(k) (in_phase((k), lo, hi) && (PR_LO < 0 || (st == 0 ? (k) <= PR_HI : (st == 1 ? ((k) >= PR_LO && (k) <= PR_HI) : (k) > PR_HI))))
#define MKP unsigned long long cdum0 = 0ull, cdum1 = 0ull; (void)cdum0; (void)cdum1; CArgsP ap_ = (CArgsP)__builtin_amdgcn_kernarg_segment_ptr(); asm volatile("" : "+s"(ap_)); P p; fill_params_k(p, ap_); int w0_ = wave0; asm volatile("" : "+s"(w0_)); int tid = w0_ * 64 + lane_id_opaque(); asm volatile("" : "+v"(tid)); const int lane = tid & 63, wave = __builtin_amdgcn_readfirstlane(tid >> 6); int G = gridDim.x, bid = blockIdx.x; asm volatile("" : "+s"(G), "+s"(bid)); unsigned* ctl = WSP(unsigned, WS_CTL); const long gtid = (long)bid * NTHREADS + tid, NT = (long)G * NTHREADS; const int gw = bid * NWAVES + wave, NGW = G * NWAVES; LAS float* scrw = (LAS float*)(lds + wave * 16384); (void)gtid; (void)NT; (void)gw; (void)NGW; (void)scrw; (void)lane; (void)ctl
#define SEAM(k) do { if ((k) + 1 < hi) { int w_ = wave0; asm volatile("" : "+s"(w_)); xcd_barrier(bar, w_ * 64 + lane_id_opaque()); } } while (0)

    for (int st = 0; st < (PR_LO >= 0 ? 3 : 1); ++st) {
    if (PHM(16) && IN(0)) { MKP;
        constexpr int IT_WIN0 = (DM / 64) * ((N_IN_FIRST + 31) / 32), IT_WIN1 = (DM / 64) * ((N_IN_REST + 31) / 32), IT_WO = (512 / 64) * (DM / 32), IT_WOUT = (DM / 64) * (DM / 32);
        constexpr int total = IT_WIN0 + IT_WIN1 + 6 * IT_WO + 2 * IT_WOUT + (DM / 64) * (2 * DENSE_FF / 32) + (DENSE_FF / 64) * (DM / 32);
        bf16* wl0 = WSP(bf16, WS_W); bf16* wl1 = WSP(bf16, WS_W + SZ_LAYERW);
#define WOFF(b, o) ((bf16*)((unsigned char*)(b) + (o)))
        for (int it = gw; it < total; it += NGW) {
            int r = it;
            if (conv_job(r, p.w_in_first, DM, N_IN_FIRST, MapWin{(unsigned char*)wl0, 0}, scrw, lane)) continue;
            if (conv_job(r, p.w_in_rest, DM, N_IN_REST, MapWin{(unsigned char*)wl1, 1}, scrw, lane)) continue;
            if (conv_job(r, p.nsa_w_o, 512, DM, MapPlain{WOFF(wl0, OFF_WO3), 512}, scrw, lane)) continue;
            if (conv_job(r, p.rwkv_w_o, 512, DM, MapPlain{WOFF(wl0, OFF_WO3) + (size_t)DM * 512, 512}, scrw, lane)) continue;
            if (conv_job(r, p.conv_w_o, 512, DM, MapPlain{WOFF(wl0, OFF_WO3) + (size_t)2 * DM * 512, 512}, scrw, lane)) continue;
            if (conv_job(r, p.nsa_w_o + (size_t)512 * DM, 512, DM, MapPlain{WOFF(wl1, OFF_WO3), 512}, scrw, lane)) continue;
            if (conv_job(r, p.rwkv_w_o + (size_t)512 * DM, 512, DM, MapPlain{WOFF(wl1, OFF_WO3) + (size_t)DM * 512, 512}, scrw, lane)) continue;
            if (conv_job(r, p.conv_w_o + (size_t)512 * DM, 512, DM, MapPlain{WOFF(wl1, OFF_WO3) + (size_t)2 * DM * 512, 512}, scrw, lane)) continue;
            if (conv_job(r, p.w_out, DM, DM, MapPlain{WOFF(wl0, OFF_WOUT), DM}, scrw, lane)) continue;
            if (conv_job(r, p.w_out + (size_t)DM * DM, DM, DM, MapPlain{WOFF(wl1, OFF_WOUT), DM}, scrw, lane)) continue;
            if (conv_job(r, p.dense_gu, DM, 2 * DENSE_FF, MapGlu{WSP(bf16, WS_DGU), DM, DENSE_FF}, scrw, lane)) continue;
            conv_job(r, p.dense_down, DENSE_FF, DM, MapPlain{WSP(bf16, WS_DDN), DENSE_FF}, scrw, lane);
        }
        for (int l = 0; l < 2; ++l) {
            unsigned char* wlb = p.ws + WS_W + (size_t)l * SZ_LAYERW;
            bf16* win = (bf16*)(wlb + OFF_WIN);
            for (long i = gtid; i < 512L * DM; i += NT) { const int w = (int)(i / DM); const bool src = w < 288 || (w < 320 && l == 1) || (w >= 320 && w < 344); if (!src) win[(size_t)(3840 + w) * DM + i % DM] = 0; }
            bf16* lw = (bf16*)(wlb + OFF_LW);
            for (long i = gtid; i < 2048L * 384; i += NT) { const int n = (int)(i / 384), k = (int)(i % 384), blk = n >> 9, c = n & 511; float v = 0.f;
                if (blk == 0 && k < 64) v = p.w_up[((size_t)l * 64 + k) * RC + c]; else if (blk == 1 && k >= 64 && k < 128) v = p.a_up[((size_t)l * 64 + k - 64) * RC + c];
                else if (blk == 2 && k >= 128 && k < 288) v = p.g_up[((size_t)l * 160 + k - 128) * RC + c]; else if (blk == 3 && k >= 288 && k < 320 && l == 1) v = p.vres_up[(size_t)(k - 288) * RC + c];
                lw[i] = f2bf(v); }
            bf16* cw1 = (bf16*)(wlb + OFF_CW1);
            for (long i = gtid; i < 2L * 256 * 1024; i += NT) { const int k = (int)(i % 1024), n = (int)((i / 1024) % 256), which = (int)(i / (256 * 1024));
                cw1[i] = f2bf(p.cmp_w1[((size_t)(l * 2 + which) * 2048 + (n < 128 ? k : 1024 + k)) * 128 + (n & 127)]); }
            float* pec = (float*)(wlb + OFF_PEC);
            for (long i = gtid; i < 256; i += NT) { const int which = (int)(i >> 7), n = (int)(i & 127); const float* pe = p.cmp_pos + (size_t)(l * 2 + which) * 2048; const float* w1 = p.cmp_w1 + (size_t)(l * 2 + which) * 2048 * 128 + n;
                float s = 0.f; for (int k = 0; k < 2048; ++k) s += pe[k] * w1[(size_t)k * 128]; pec[i] = s; }
        }
        SEAM(0);
    }

    for (int layer = 0; layer < 2; ++layer) {
        const int pb = 1 + layer * NPH;
        if (PHM(0) && IN(pb + 0)) { MKP;
            const float* xin = layer == 0 ? p.x : p.out;
            RMS_LOOP(xin, p.mix_norm_g + (size_t)layer * DM, false, cdum0, cdum1);
            SEAM(pb + 0);
        }
        if (PHM(1) && IN(pb + 1)) { MKP;
            Gemm g{WSP(bf16, WS_H), (const bf16*)(p.ws + WS_W + (size_t)layer * SZ_LAYERW + OFF_WIN), T, NPROJ, DM}; SOrder S; S.init(T, NPROJ, G, bid);
            EpiProj E{p.ws};
            pg8::gemm_phase<EpiProj, SOrder, true, true>(lds, g, S, E, tid);
            SEAM(pb + 1);
        }
        if (PHM(2) && IN(pb + 2)) { MKP;
            { Gemm g{WSP(bf16, AR_CKV), (const bf16*)(p.ws + WS_W + (size_t)layer * SZ_LAYERW + OFF_CW1), 2 * BATCH * NKV * 512, 512, 1024, 0}; StackOrder S{BATCH * NKV * 512 / 256, 1, 2, G, bid};
              EpiStore E{WSP(bf16, AR_HID), 256, 1};
              pg8::gemm_phase<EpiStore, StackOrder, true, true>(lds, g, S, E, tid); }
            ph_shift(p, layer, gtid, NT); ph_nsa_prep(p, layer, gtid, NT); ph_vtrans(p, gtid, NT);
            ph_convw(p, layer, gw, NGW, lane, tid, lds);
#ifdef APROBE_CONV
            ph_convw(p, layer, gw, NGW, lane, tid, lds);
#endif
#ifdef APROBE_VT
            ph_vtrans(p, gtid, NT);
#endif
            SEAM(pb + 2); }
        if (PHM(3) && IN(pb + 3)) { MKP;
#ifndef LORA_NAIVE
            { Gemm g{WSP(bf16, WS_LB), (const bf16*)(p.ws + WS_W + (size_t)layer * SZ_LAYERW + OFF_LW), T, 2048, 384, 0}; SOrder S; S.init(T, 2048, G, bid);
              EpiLora E{p.ws};
              pg8::gemm_phase<EpiLora, SOrder, false, true>(lds, g, S, E, tid); }
#else
            { bf16* RW = WSP(bf16, AR_RW); bf16* Wm = WSP(bf16, AR_W); bf16* Am = WSP(bf16, AR_A); bf16* Gm = WSP(bf16, AR_G); const bf16* VF = WSP(bf16, WS_VF);
              const float* vec = p.rwkv_vec + (size_t)layer * 7 * RC; const float* wup = p.w_up + (size_t)layer * 64 * RC; const float* aup = p.a_up + (size_t)layer * 64 * RC; const float* gup = p.g_up + (size_t)layer * 160 * RC;
              for (long it = gtid; it < (long)T * RC; it += NT) { const int t = (int)(it / RC), c = (int)(it % RC); bf16* row = RW + (size_t)t * LDRW; const bf16* L = row + LBLK;
                  float wl = vec[c], alin = vec[RC + c], g = 0.f;
                  for (int j = 0; j < 64; ++j) { wl += bf2f(L[j]) * bf2f(f2bf(wup[j * RC + c])); alin += bf2f(L[64 + j]) * bf2f(f2bf(aup[j * RC + c])); }
                  for (int j = 0; j < 160; ++j) g += bf2f(L[128 + j]) * bf2f(f2bf(gup[j * RC + c]));
                  const float nx = -wl, sp = fmaxf(nx, 0.f) + __logf(1.f + __expf(-fabsf(nx))), e = __expf(-sp - 0.5f);
                  Wm[it] = f2bf(1.f - __expf(-e)); Am[it] = f2bf(fsig(alin)); Gm[it] = f2bf(g);
                  if (layer == 1) { float vl = p.vres_b[c]; for (int j = 0; j < 32; ++j) vl += bf2f(L[288 + j]) * bf2f(f2bf(p.vres_up[j * RC + c]));
                      const float v = bf2f(row[1024 + c]), vf = bf2f(VF[it]); row[1024 + c] = f2bf(v + (vf - v) * fsig(vl)); } } }
#endif
            SEAM(pb + 3); }
        if (PHM(4) && IN(pb + 4)) { MKP; ph_rwkv_b2w(p, layer, gw, NGW, lane); ph_cmp2w(p, layer, gw, NGW, lane, (LAS float*)(lds + wave * 512)); SEAM(pb + 4); }
        if (PHM(5) && IN(pb + 5)) { MKP;
            { LAS unsigned char* wl = lds + wave * AW_BYTES; constexpr int NSC = BATCH * 8 * 16, NIT = BATCH * NKV * (SEQ / 16);
#ifndef SCAN_QUEUE
              if (wave < 4) {
                  if (G * 4 == NSC && (G & 7) == 0) scan_unit(p, (bid & 7) * (NSC / 8) + (bid >> 3) * 4 + wave, lane, wl);
                  else for (int u = bid * 4 + wave; u < NSC; u += G * 4) scan_unit(p, u, lane, wl); }
#endif
#ifdef APROBE_SPLIT
              xcd_barrier(bar, tid);
#endif
              const int xme = (int)(xb_xcc_id() & 7u);
              for (int qq = 0; qq < 8; ++qq) { const int qx = (xme + qq) & 7; unsigned* head = ctl + CW_ATT + ((layer * 3 + st) * 8 + qx) * 16;
                  for (;;) { int it = 0; if (lane == 0) it = (int)atomicAdd(head, 1u); it = __builtin_amdgcn_readfirstlane(it); if (it >= NIT / 8) break;
                      const int bg = 2 * qx + it / (SEQ / 16), t16 = (SEQ / 16 - 1) - it % (SEQ / 16);
                      nsa_attn_item(p, bg * (SEQ / 16) + t16, lane, wl); } } }
 SEAM(pb + 5); }
        if (PHM(6) && IN(pb + 6)) { MKP; ph_rwkv_postw(p, layer, gw, NGW, lane); SEAM(pb + 6); }
        if (PHM(7) && IN(pb + 7)) { MKP;
            Gemm g{WSP(bf16, AR_QB), (const bf16*)(p.ws + WS_W + (size_t)layer * SZ_LAYERW + OFF_WO3), 3 * T, 3 * DM, 512}; StackOrder S{T / 256, DM / 256, 3, G, bid};
            EpiStore E{WSP(bf16, AR_OBUF), DM, DM / 256};
            pg8::gemm_phase<EpiStore, StackOrder, true, true>(lds, g, S, E, tid);
            { MKP; const float* xin = layer == 0 ? p.x : p.out;
              RMS_LOOP(xin, p.mix_norm_g + (size_t)layer * DM, false, cdum0, cdum1); }
            SEAM(pb + 7);
        }
        if (PHM(8) && IN(pb + 8)) { MKP;
            Gemm g{WSP(bf16, WS_H), (const bf16*)(p.ws + WS_W + (size_t)layer * SZ_LAYERW + OFF_WG), T, 3 * DM, DM}; GateOrder S{T / 256, DM / 256, G, bid};
            EpiGate E{p.ws, DM / 256};
            pg8::gemm_phase<EpiGate, GateOrder, true, true>(lds, g, S, E, tid);
            SEAM(pb + 8);
        }
        if (PHM(9) && IN(pb + 9)) { MKP;
            Gemm g{WSP(bf16, AR_MIX), (const bf16*)(p.ws + WS_W + (size_t)layer * SZ_LAYERW + OFF_WOUT), T, DM, DM}; SOrder S; S.init(T, DM, G, bid);
            EpiResid E{layer == 0 ? p.x : p.out, p.out};
            pg8::gemm_phase<EpiResid, SOrder, true, true>(lds, g, S, E, tid);
            SEAM(pb + 9);
        }
        if (PHM(10) && IN(pb + 10)) { MKP;
            unsigned long long c0 = 0ull, c1 = 0ull;
            RMS_LOOP(p.out, p.ffn_norm_g + (size_t)layer * DM, layer == 1, c0, c1);
            if (layer == 1 && lane < 16) {
                const unsigned cn = (unsigned)(((lane < 8 ? c0 : c1) >> (8 * (lane & 7))) & 255ull);
                WSP(unsigned, AR_WBASE)[(size_t)gw * 16 + lane] = atomicAdd(ctl + CW_CNT + lane * 64, cn); }
            if (layer == 1) { int* rt = WSP(int, AR_RTOK); for (long i = gtid; i < 2L * MOE_ROWS; i += NT) rt[i] = -1; }
            SEAM(pb + 10);
        }
        if (layer == 0) {
            if (PHM(11) && IN(pb + 11)) { MKP;
                Gemm g{WSP(bf16, WS_H), WSP(bf16, WS_DGU), T, 2 * DENSE_FF, DM}; SOrder S; S.init(T, 2 * DENSE_FF, G, bid);
                EpiSwiglu E{WSP(bf16, AR_ACT), DENSE_FF, 2 * DENSE_FF / 256};
                pg8::gemm_phase<EpiSwiglu, SOrder, true, true>(lds, g, S, E, tid);
                SEAM(pb + 11);
            }
            if (PHM(12) && IN(pb + 12)) { MKP;
                Gemm g{WSP(bf16, AR_ACT), WSP(bf16, WS_DDN), T, DM, DENSE_FF}; SOrder S; S.init(T, DM, G, bid);
                EpiResid E{p.out, p.out};
                pg8::gemm_phase<EpiResid, SOrder, true, true>(lds, g, S, E, tid);
                SEAM(pb + 12);
            }
        } else {
            if (PHM(11) && IN(pb + 11)) { MKP;
                const int ig = (DM / 64) * (2 * EXPERT_FF / 32), id = (EXPERT_FF / 64) * (DM / 32);
                for (int it = gw; it < NEXP * (ig + id); it += NGW) { const int e = it / (ig + id); int r = it % (ig + id);
                    if (conv_job(r, p.moe_gu + (size_t)e * DM * 2 * EXPERT_FF, DM, 2 * EXPERT_FF, MapGlu{WSP(bf16, AR_MGU) + (size_t)e * 2 * EXPERT_FF * DM, DM, EXPERT_FF}, scrw, lane)) continue;
                    conv_job(r, p.moe_down + (size_t)e * EXPERT_FF * DM, EXPERT_FF, DM, MapPlain{WSP(bf16, AR_MDN) + (size_t)e * DM * EXPERT_FF, EXPERT_FF}, scrw, lane); }
                int* rtok = WSP(int, AR_RTOK); float* rww = WSP(float, AR_RW8); int* trow = WSP(int, AR_TROW);
                int segv = 0; { const int pc = lane < 16 ? (int)((ctl[CW_CNT + lane * 64] + 255u) & ~255u) : 0;
#pragma unroll
                    for (int k = 0; k < 8; ++k) { const int ck = bperm_i(pc, (lane & 8) + k); segv += (k < (lane & 7)) ? ck : 0; } }
                for (int tb = gw * 64; tb < T; tb += NGW * 64) {
                    const int t = tb + lane; const int ee = WSP(int, AR_RTE)[t], e0 = ee & 255, e1 = (ee >> 8) & 255, r0 = (ee >> 16) & 255, r1 = (ee >> 24) & 255;
                    const float* w = WSP(float, AR_RTW) + (size_t)t * 2; const unsigned* wb = WSP(unsigned, AR_WBASE) + (size_t)(t % NGW) * 16;
                    const int row0 = bperm_i(segv, e0) + (int)wb[e0] + r0, row1 = bperm_i(segv, 8 + e1) + (int)wb[8 + e1] + r1;
                    rtok[row0] = t; rww[row0] = w[0]; rtok[MOE_ROWS + row1] = t; rww[MOE_ROWS + row1] = w[1]; trow[T + t] = row1;
                    for (int l = 0; l < 64; l += 4) { const bf16* hs = WSP(bf16, WS_H) + (size_t)(tb + l) * DM; bf16* xg = WSP(bf16, AR_XG);
                        copy_rows4(hs, hs + DM, hs + 2 * DM, hs + 3 * DM, xg + (size_t)__builtin_amdgcn_readlane(row0, l) * DM, xg + (size_t)__builtin_amdgcn_readlane(row0, l + 1) * DM, xg + (size_t)__builtin_amdgcn_readlane(row0, l + 2) * DM, xg + (size_t)__builtin_amdgcn_readlane(row0, l + 3) * DM, lane); }
                }
                SEAM(pb + 11);
            }
#pragma unroll
            for (int pass = 0; pass < 2; ++pass) {
                if (PHM(12) && IN(pb + 12 + 2 * pass)) { MKP;
                    Gemm g{WSP(bf16, AR_XG), WSP(bf16, AR_MGU), MOE_ROWS, NEXP * 2 * EXPERT_FF, DM}; MoeOrder S; S.init(ctl + CW_CNT + 8 * 64 * pass, 2 * EXPERT_FF / 256, G, bid);
                    EpiSwiglu E{WSP(bf16, AR_MACT), EXPERT_FF, 2 * EXPERT_FF / 256};
                    pg8::gemm_phase<EpiSwiglu, MoeOrder, true, true>(lds, g, S, E, tid);
                    SEAM(pb + 12 + 2 * pass);
                }
                if (PHM(13) && IN(pb + 13 + 2 * pass)) { MKP;
                    Gemm g{WSP(bf16, AR_MACT), WSP(bf16, AR_MDN), MOE_ROWS, NEXP * DM, EXPERT_FF}; MoeOrder S; S.init(ctl + CW_CNT + 8 * 64 * pass, DM / 256, G, bid);
                    EpiMoeDown E{p.out, WSP(int, AR_RTOK) + (size_t)pass * MOE_ROWS, WSP(float, AR_RW8) + (size_t)pass * MOE_ROWS, DM / 256, (PR_LO >= 0 && st == 0 && pb + 13 + 2 * pass >= PR_LO && pb + 13 + 2 * pass <= PR_HI) ? 0.f : 1.f};
                    pg8::gemm_phase<EpiMoeDown, MoeOrder, true, true>(lds, g, S, E, tid);
                    if (pass == 0) { const int* trow = WSP(int, AR_TROW);
                        for (int t = gw * 4; t < T; t += NGW * 4) { const bf16* hs = WSP(bf16, WS_H) + (size_t)t * DM; bf16* xg = WSP(bf16, AR_XG);
                            copy_rows4(hs, hs + DM, hs + 2 * DM, hs + 3 * DM, xg + (size_t)trow[T + t] * DM, xg + (size_t)trow[T + t + 1] * DM, xg + (size_t)trow[T + t + 2] * DM, xg + (size_t)trow[T + t + 3] * DM, lane); } }
                    SEAM(pb + 13 + 2 * pass);
                }
            }
        }
    }
    }
#undef IN
#undef SEAM
}

#ifndef MK_ONE_LAUNCH
#define MK_ONE_LAUNCH 1
#endif
extern "C" void kernel_launch(void* const* d_in, const int* in_sizes, int n_in, void* d_out, int out_size, void* d_ws, size_t ws_size, hipStream_t stream) {
    static int grid = 0;
    if (grid == 0) {
        if (n_in != 29 || in_sizes[0] != T * DM || out_size != T * DM || ws_size < WS_END) { fprintf(stderr, "kernel_launch: unexpected shapes / workspace (%d inputs, ws %zu, need %zu)\n", n_in, ws_size, (size_t)WS_END); grid = -1; return; }
        int dev = 0, cus = 0;
        if (hipGetDevice(&dev) != hipSuccess || hipDeviceGetAttribute(&cus, hipDeviceAttributeMultiprocessorCount, dev) != hipSuccess) { grid = -1; return; }
        if (hipFuncSetAttribute((const void*)mk_fwd, hipFuncAttributeMaxDynamicSharedMemorySize, LDS_BYTES) != hipSuccess) { fprintf(stderr, "kernel_launch: hipFuncSetAttribute failed\n"); grid = -1; return; }
        int per_cu = 0;
        if (hipOccupancyMaxActiveBlocksPerMultiprocessor(&per_cu, (const void*)mk_fwd, NTHREADS, LDS_BYTES) != hipSuccess || per_cu < 1) { fprintf(stderr, "kernel_launch: occupancy query says %d\n", per_cu); }
        (void)hipGetLastError();
        grid = cus;
    }
    if (grid < 0) return;
    if (hipMemsetAsync((char*)d_ws + WS_CTL, 0, CTL_BYTES, stream) != hipSuccess) return;
    Args a{};
    for (int i = 0; i < 29; ++i) a.in[i] = (const float*)d_in[i];
    a.out = (float*)d_out; a.ws = (unsigned char*)d_ws;
#if MK_ONE_LAUNCH
    a.ph_lo = 0; a.ph_hi = NPHASES;
    hipLaunchKernelGGL(mk_fwd, dim3(grid), dim3(NTHREADS), LDS_BYTES, stream, a);
#else
    for (int k = 0; k < NPHASES; ++k) {
        if (k >= 1 + 13 && k < 1 + NPH) continue;
        a.ph_lo = k; a.ph_hi = k + 1;
        hipLaunchKernelGGL(mk_fwd, dim3(grid), dim3(NTHREADS), LDS_BYTES, stream, a);
    }
#endif
}
```

```cpp
#include <hip/hip_runtime.h>
#include <cstdio>
#include <cstdint>
#include <cmath>
#include <cstring>
#ifdef HOST_EMU
#define HD
#define DEV_INLINE inline
#else
#define HD __host__ __device__
#define DEV_INLINE __device__ __forceinline__
#endif

typedef unsigned short bf16;
struct alignas(16) U4 { unsigned x, y, z, w; };

#ifdef SMALL_CFG
constexpr int BATCH = 1, SEQ = 1024, DM = 128, DENSE_FF = 256, EXPERT_FF = 256;
#else
constexpr int BATCH = 8, SEQ = 8192, DM = 1024, DENSE_FF = 2816, EXPERT_FF = 3584;
#endif
constexpr int T = BATCH * SEQ;
constexpr int NHEAD = 8, NKV = 2, HG = 4, DH = 64;
constexpr int NC = SEQ / 16 - 1, NS = SEQ / 64, NSEL = 8, WINDOW = 512;
constexpr int CONV_CH = 512, CONV_K = 31, RC = 512;
constexpr int NEXP = 8;
constexpr int NSA_IN = 1304, OFF_CONV = 1304, OFF_GATE = 2328, OFF_RWKV = OFF_GATE + 3 * DM;
constexpr int N_IN_FIRST = OFF_RWKV + 1824, N_IN_REST = OFF_RWKV + 1856;
constexpr int NPROJ = 4352;
constexpr int LDQ = 512, LDKV = 512, LDRW = 2048, LBLK = 1536;
constexpr int MOE_ROWS = T + NEXP * 256;
constexpr float RMS_EPS = 1e-6f, LN_EPS = 1e-5f, GN_EPS = 64e-5f;

constexpr size_t al(size_t x) { return (x + 255) & ~(size_t)255; }
constexpr size_t WS_CTL = 0, CTL_BYTES = 1u << 20;
constexpr size_t SZ_WIN = (size_t)NPROJ * DM * 2, SZ_WG = (size_t)3 * DM * DM * 2, SZ_WO3 = (size_t)3 * DM * 512 * 2, SZ_WOUT = (size_t)DM * DM * 2;
constexpr size_t SZ_LW = (size_t)2048 * 384 * 2, SZ_CW1 = (size_t)2 * 256 * 1024 * 2, SZ_PEC = 1024;
constexpr size_t SZ_LAYERW = SZ_WIN + SZ_WG + SZ_WO3 + SZ_WOUT + SZ_LW + SZ_CW1 + SZ_PEC;
constexpr size_t WS_W = CTL_BYTES;
constexpr size_t OFF_WIN = 0, OFF_WG = SZ_WIN, OFF_WO3 = OFF_WG + SZ_WG, OFF_WOUT = OFF_WO3 + SZ_WO3, OFF_LW = OFF_WOUT + SZ_WOUT, OFF_CW1 = OFF_LW + SZ_LW, OFF_PEC = OFF_CW1 + SZ_CW1;
constexpr size_t WS_DGU = WS_W + 2 * SZ_LAYERW, SZ_DGU = (size_t)2 * DENSE_FF * DM * 2;
constexpr size_t WS_DDN = WS_DGU + SZ_DGU, SZ_DDN = (size_t)DM * DENSE_FF * 2;
constexpr size_t WS_VF = al(WS_DDN + SZ_DDN), SZ_TC = (size_t)T * 512 * 2;
constexpr size_t WS_H = WS_VF + SZ_TC, SZ_H = (size_t)T * DM * 2;
constexpr size_t WS_AR = al(WS_H + SZ_H);
constexpr size_t AR_QB = WS_AR, AR_A = AR_QB + SZ_TC, AR_CO = AR_A + SZ_TC;
constexpr size_t AR_KV = AR_CO + SZ_TC, SZ_KV = (size_t)T * LDKV * 2;
constexpr size_t AR_RW = AR_KV + SZ_KV, SZ_RW = (size_t)T * LDRW * 2;
constexpr size_t AR_W = AR_RW + SZ_RW, AR_G = AR_W + SZ_TC, AR_UB = AR_G + SZ_TC;
constexpr size_t AR_NG = AR_UB + SZ_TC, SZ_NG = (size_t)T * 24 * 4;
constexpr size_t AR_HALO = al(AR_NG + SZ_NG), SZ_HALO = (size_t)(T / 256) * LDRW * 2;
constexpr size_t AR_KC = al(AR_HALO + SZ_HALO), SZ_CMP = (size_t)BATCH * NKV * (SEQ / 16) * 64 * 2;
constexpr size_t AR_VC = AR_KC + SZ_CMP;
constexpr size_t AR_HID = al(AR_VC + SZ_CMP), SZ_HID = (size_t)BATCH * NKV * (SEQ / 16) * 2 * 128 * 4;
constexpr size_t AR_SEL = al(AR_HID + SZ_HID), SZ_SEL = (size_t)T * NKV * 8 * 4;
constexpr size_t AR_INVN = al(AR_SEL + SZ_SEL), SZ_INVN = (size_t)T * 8 * 4;
constexpr size_t AR_VCT = al(AR_INVN + SZ_INVN);
constexpr size_t AR_CKV = al(AR_VCT + SZ_CMP), SZ_CKV = (size_t)2 * T * 128;
constexpr size_t AR_END1 = al(AR_CKV + SZ_CKV * 2);
constexpr size_t WS_VST = WS_H, WS_VWT = WS_H + (size_t)T * 128 * 2, WS_LB = WS_VWT + (size_t)T * 128 * 2, WS_KS8 = WS_LB + (size_t)T * 384 * 2, WS_KW8 = WS_KS8 + (size_t)T * 128 * 2;
constexpr size_t AR_OBUF = AR_KV, SZ_OBUF = (size_t)3 * T * DM * 2;
constexpr size_t AR_MIX = AR_OBUF + SZ_OBUF, SZ_MIX = (size_t)T * DM * 2;
constexpr size_t AR_END2 = AR_MIX + SZ_MIX;
constexpr size_t AR_ACT = WS_AR;
constexpr size_t AR_MGU = WS_AR, SZ_MGU = (size_t)NEXP * 2 * EXPERT_FF * DM * 2;
constexpr size_t AR_MDN = AR_MGU + SZ_MGU, SZ_MDN = (size_t)NEXP * DM * EXPERT_FF * 2;
constexpr size_t AR_XG = al(AR_MDN + SZ_MDN), SZ_XG = (size_t)MOE_ROWS * DM * 2;
constexpr size_t AR_MACT = al(AR_XG + SZ_XG), SZ_MACT = (size_t)MOE_ROWS * EXPERT_FF * 2;
constexpr size_t AR_RTOK = al(AR_MACT + SZ_MACT), SZ_RTOK = (size_t)2 * MOE_ROWS * 4;
constexpr size_t AR_RW8 = al(AR_RTOK + SZ_RTOK);
constexpr size_t AR_TROW = al(AR_RW8 + SZ_RTOK), SZ_TROW = (size_t)2 * T * 4;
constexpr size_t AR_RTE = al(AR_TROW + SZ_TROW);
constexpr size_t AR_RTW = al(AR_RTE + (size_t)T * 4);
constexpr size_t AR_WBASE = al(AR_RTW + (size_t)T * 8);
constexpr size_t AR_END3 = al(AR_WBASE + (size_t)4096 * 16 * 4);
constexpr size_t WS_END = (AR_END1 > AR_END2 ? (AR_END1 > AR_END3 ? AR_END1 : AR_END3) : (AR_END2 > AR_END3 ? AR_END2 : AR_END3));
constexpr int CW_CNT = 1024;
constexpr int CW_ATT = 256;
constexpr int CW_BAR = 4096;

struct P {
    const float *x, *mix_norm_g, *w_in_first, *w_in_rest, *mu_first, *mu_rest, *qk_g, *cmp_pos, *cmp_w1, *cmp_w2, *nsa_w_o, *conv_w, *conv_vec, *conv_w_o,
        *rwkv_vec, *w_up, *a_up, *g_up, *vres_up, *vres_b, *rwkv_w_o, *w_out, *ffn_norm_g, *dense_gu, *dense_down, *router_w, *router_b, *moe_gu, *moe_down;
    float* out; unsigned char* ws;
};
HD inline void fill_params(P& p, const float* const* in, float* out, unsigned char* ws) {
    p.x = in[0]; p.mix_norm_g = in[1]; p.w_in_first = in[2]; p.w_in_rest = in[3]; p.mu_first = in[4]; p.mu_rest = in[5]; p.qk_g = in[6]; p.cmp_pos = in[7];
    p.cmp_w1 = in[8]; p.cmp_w2 = in[9]; p.nsa_w_o = in[10]; p.conv_w = in[11]; p.conv_vec = in[12]; p.conv_w_o = in[13]; p.rwkv_vec = in[14]; p.w_up = in[15];
    p.a_up = in[16]; p.g_up = in[17]; p.vres_up = in[18]; p.vres_b = in[19]; p.rwkv_w_o = in[20]; p.w_out = in[21]; p.ffn_norm_g = in[22]; p.dense_gu = in[23];
    p.dense_down = in[24]; p.router_w = in[25]; p.router_b = in[26]; p.moe_gu = in[27]; p.moe_down = in[28]; p.out = out; p.ws = ws;
}
#define WSP(type, off) ((type*)(p.ws + (off)))

#ifdef HOST_EMU
#define FENCE()
#else
#define FENCE() asm volatile("" ::: "memory")
#endif
HD inline float bf2f(bf16 v) { unsigned u = (unsigned)v << 16; float f; memcpy(&f, &u, 4); return f; }
HD inline bf16 f2bf(float f) { unsigned u; memcpy(&u, &f, 4); return (bf16)((u + 0x7fffu + ((u >> 16) & 1u)) >> 16); }
HD inline float blo(unsigned v) { unsigned u = v << 16; float f; memcpy(&f, &u, 4); return f; }
HD inline float bhi(unsigned v) { unsigned u = v & 0xffff0000u; float f; memcpy(&f, &u, 4); return f; }
#if !defined(SCAN_BF16) && !defined(RKV_BF16)
HD inline bf16 f2h(float f) { return __builtin_bit_cast(unsigned short, (_Float16)f); }
#else
HD inline bf16 f2bf(float f);
HD inline bf16 f2h(float f) { return f2bf(f); }
#endif
HD inline float h2f(bf16 v) { return (float)__builtin_bit_cast(_Float16, v); }
HD inline float sigmoidf_(float x) { return 1.f / (1.f + expf(-x)); }
HD inline float dot64(const float* q, const bf16* kp) {
    const U4* k4 = (const U4*)kp; float s0 = 0.f, s1 = 0.f;
#pragma unroll
    for (int i = 0; i < 8; ++i) { const U4 v = k4[i];
        s0 += q[8 * i + 0] * blo(v.x) + q[8 * i + 2] * blo(v.y) + q[8 * i + 4] * blo(v.z) + q[8 * i + 6] * blo(v.w);
        s1 += q[8 * i + 1] * bhi(v.x) + q[8 * i + 3] * bhi(v.y) + q[8 * i + 5] * bhi(v.z) + q[8 * i + 7] * bhi(v.w); }
    return s0 + s1;
}
HD inline float dot64p(const U4* q, const bf16* kp) {
    const U4* k4 = (const U4*)kp; float s0 = 0.f, s1 = 0.f;
#pragma unroll
    for (int i = 0; i < 8; ++i) { const U4 v = k4[i], w = q[i];
        s0 += blo(w.x) * blo(v.x) + blo(w.y) * blo(v.y) + blo(w.z) * blo(v.z) + blo(w.w) * blo(v.w);
        s1 += bhi(w.x) * bhi(v.x) + bhi(w.y) * bhi(v.y) + bhi(w.z) * bhi(v.z) + bhi(w.w) * bhi(v.w); }
    return s0 + s1;
}
HD inline void ld64(const bf16* kp, float* q) {
    const U4* k4 = (const U4*)kp;
#pragma unroll
    for (int i = 0; i < 8; ++i) { const U4 v = k4[i]; q[8 * i] = blo(v.x); q[8 * i + 1] = bhi(v.x); q[8 * i + 2] = blo(v.y); q[8 * i + 3] = bhi(v.y);
        q[8 * i + 4] = blo(v.z); q[8 * i + 5] = bhi(v.z); q[8 * i + 6] = blo(v.w); q[8 * i + 7] = bhi(v.w); }
}
HD inline void axpy64(float* o, float w, const bf16* vp) {
    const U4* k4 = (const U4*)vp;
#pragma unroll
    for (int i = 0; i < 8; ++i) { const U4 v = k4[i]; o[8 * i] += w * blo(v.x); o[8 * i + 1] += w * bhi(v.x); o[8 * i + 2] += w * blo(v.y); o[8 * i + 3] += w * bhi(v.y);
        o[8 * i + 4] += w * blo(v.z); o[8 * i + 5] += w * bhi(v.z); o[8 * i + 6] += w * blo(v.w); o[8 * i + 7] += w * bhi(v.w); }
}
HD inline void axpy64s(float* o, float w, const bf16* vp) {
    const U4* k4 = (const U4*)vp;
#pragma unroll
    for (int i = 0; i < 8; ++i) { const U4 v = k4[i]; o[8 * i] = w * o[8 * i] + blo(v.x); o[8 * i + 1] = w * o[8 * i + 1] + bhi(v.x); o[8 * i + 2] = w * o[8 * i + 2] + blo(v.y); o[8 * i + 3] = w * o[8 * i + 3] + bhi(v.y);
        o[8 * i + 4] = w * o[8 * i + 4] + blo(v.z); o[8 * i + 5] = w * o[8 * i + 5] + bhi(v.z); o[8 * i + 6] = w * o[8 * i + 6] + blo(v.w); o[8 * i + 7] = w * o[8 * i + 7] + bhi(v.w); }
}
HD inline void st64(bf16* op, const float* o) {
    U4* o4 = (U4*)op;
#pragma unroll
    for (int i = 0; i < 8; ++i) { U4 v; v.x = (unsigned)f2bf(o[8 * i]) | ((unsigned)f2bf(o[8 * i + 1]) << 16); v.y = (unsigned)f2bf(o[8 * i + 2]) | ((unsigned)f2bf(o[8 * i + 3]) << 16);
        v.z = (unsigned)f2bf(o[8 * i + 4]) | ((unsigned)f2bf(o[8 * i + 5]) << 16); v.w = (unsigned)f2bf(o[8 * i + 6]) | ((unsigned)f2bf(o[8 * i + 7]) << 16); o4[i] = v; }
}

HD inline void rope_cs(int pos, int i, float& cs, float& sn) {
    const float c = exp2f(-(float)i * 0.41524101186092f) * 0.15915494309189535f, pf = (float)pos;
    const float prod = pf * c, err = fmaf(pf, c, -prod), fr = (prod - rintf(prod)) + err;
#ifdef HOST_EMU
    cs = cosf(6.283185307179586f * fr); sn = sinf(6.283185307179586f * fr);
#else
    cs = __builtin_amdgcn_cosf(fr); sn = __builtin_amdgcn_sinf(fr);
#endif
}
HD inline int win_dest(int j, int layer, int& which) {
    which = 0;
    if (j < 1280) return j;
    if (j < 1304) return 3840 + 320 + (j - 1280);
    if (j < 1816) { const int cc = j - 1304; return 1280 + 256 * (cc / 128) + cc % 128; }
    if (j < 2328) { const int cc = j - 1816; return 1280 + 256 * (cc / 128) + 128 + cc % 128; }
    if (j < OFF_RWKV) { which = 1; const int gg = j - OFF_GATE, br = gg / DM; return (br == 0 ? 0 : (br == 1 ? 2 * DM : DM)) + gg % DM; }
    const int rr = j - OFF_RWKV;
    if (rr < 1536) return 2304 + rr;
    if (rr < 1824) return 3840 + (rr - 1536);
    if (rr < 1856 && layer == 1) return 3840 + 288 + (rr - 1824);
    return -1;
}
HD inline int glu_dest(int j, int ff) { return j < ff ? 256 * (j / 128) + j % 128 : 256 * ((j - ff) / 128) + 128 + (j - ff) % 128; }

DEV_INLINE void ph_shift(const P& p, int layer, long gtid, long NT) {
    bf16* RW = WSP(bf16, AR_RW); const bf16* HALO = WSP(bf16, AR_HALO); bf16* VF = WSP(bf16, WS_VF); bf16* LB = WSP(bf16, WS_LB);
    const float* mu = layer == 0 ? p.mu_first : p.mu_rest;
    constexpr int NCP = (LBLK + 384) / 2;
    const long n = (long)(T / 256) * NCP;
    for (long it = gtid; it < n; it += NT) {
        const int pm = (int)(it / NCP), c = 2 * (int)(it % NCP);
        int mi = -1, act = 0;
        if (c < LBLK) mi = c;
        else { const int w = c - LBLK; if (w < 288) { mi = 1536 + w; act = w < 64 ? 1 : (w >= 128 ? 2 : 0); } else if (w < 320 && layer == 1) mi = 1824 + (w - 288); }
        if (mi < 0) { for (int r = 0; r < 256; ++r) *(unsigned*)(LB + ((size_t)pm * 256 + r) * 384 + (c - LBLK)) = 0u; continue; }
        const float m0 = mu[mi], m1 = mu[mi + 1];
        float prev0 = 0.f, prev1 = 0.f;
        if ((pm * 256) % SEQ != 0) { const unsigned hv = *(const unsigned*)(HALO + (size_t)(pm - 1) * LDRW + c); prev0 = blo(hv); prev1 = bhi(hv); }
        bf16* col = RW + (size_t)pm * 256 * LDRW + c;
        for (int r0 = 0; r0 < 256; r0 += 16) {
            unsigned pv[16];
#pragma unroll
            for (int k = 0; k < 16; ++k) pv[k] = *(const unsigned*)(col + (size_t)(r0 + k) * LDRW);
#pragma unroll
            for (int k = 0; k < 16; ++k) { const int r = r0 + k; const float p0 = blo(pv[k]), p1 = bhi(pv[k]);
                float u0 = p0 + (prev0 - p0) * m0, u1 = p1 + (prev1 - p1) * m1; prev0 = p0; prev1 = p1;
                if (act == 1) { u0 = tanhf(u0); u1 = tanhf(u1); } else if (act == 2) { u0 = sigmoidf_(u0); u1 = sigmoidf_(u1); }
                if (c < LBLK) { const unsigned hv = (unsigned)f2h(u0) | ((unsigned)f2h(u1) << 16); *(unsigned*)(col + (size_t)r * LDRW) = hv;
                    if (layer == 0 && c >= 1024) *(unsigned*)(VF + ((size_t)pm * 256 + r) * RC + (c - 1024)) = hv; }
                else *(unsigned*)(LB + ((size_t)pm * 256 + r) * 384 + (c - LBLK)) = (unsigned)f2bf(u0) | ((unsigned)f2bf(u1) << 16); }
        }
    }
}

DEV_INLINE void ph_nsa_prep(const P& p, int layer, long gtid, long NT) {
    bf16* QB = WSP(bf16, AR_QB); bf16* KV = WSP(bf16, AR_KV);
    const long n = (long)T * 12;
    for (long it = gtid; it < n; it += NT) {
        const int t = (int)(it / 12), s = (int)(it % 12), pos = t % SEQ;
        bf16* ptr; const float* g;
        if (s < 8) { ptr = QB + (size_t)t * LDQ + s * 64; g = p.qk_g + (layer * 4 + 0) * 64; }
        else if (s < 10) { ptr = KV + (size_t)t * LDKV + (s - 8) * 64; g = p.qk_g + (layer * 4 + 2) * 64; }
        else { ptr = KV + (size_t)t * LDKV + 256 + (s - 10) * 64; g = p.qk_g + (layer * 4 + 3) * 64; }
        float v[64]; ld64(ptr, v);
        float ss = 0.f;
#pragma unroll
        for (int i = 0; i < 64; ++i) ss += v[i] * v[i];
        const float rs = 1.f / sqrtf(ss * (1.f / 64.f) + RMS_EPS);
#pragma unroll
        for (int i = 0; i < 64; ++i) v[i] = v[i] * rs * g[i];
#pragma unroll
        for (int i = 0; i < 32; ++i) {
            float cs, sn; rope_cs(pos, i, cs, sn);
            const float x1 = v[i], x2 = v[i + 32]; v[i] = x1 * cs - x2 * sn; v[i + 32] = x2 * cs + x1 * sn;
        }
        if (s < 8) {
#pragma unroll
            for (int i = 0; i < 64; ++i) v[i] *= 0.125f * 1.4426950408889634f; }
        if (s < 8) st64(ptr, v);
        else {
            const int gg = (s - 8) & 1, bq = t / SEQ; bf16* k8 = WSP(bf16, s < 10 ? WS_KS8 : WS_KW8) + (size_t)(bq * NKV + gg) * 8 * SEQ * 8;
#pragma unroll
            for (int dg = 0; dg < 8; ++dg) { U4 w; w.x = (unsigned)f2bf(v[8 * dg]) | ((unsigned)f2bf(v[8 * dg + 1]) << 16); w.y = (unsigned)f2bf(v[8 * dg + 2]) | ((unsigned)f2bf(v[8 * dg + 3]) << 16);
                w.z = (unsigned)f2bf(v[8 * dg + 4]) | ((unsigned)f2bf(v[8 * dg + 5]) << 16); w.w = (unsigned)f2bf(v[8 * dg + 6]) | ((unsigned)f2bf(v[8 * dg + 7]) << 16);
                *(U4*)(k8 + ((size_t)dg * SEQ + pos) * 8) = w; } }
    }
}

DEV_INLINE void ph_vtrans(const P& p, long gtid, long NT) {
    const bf16* KV = WSP(bf16, AR_KV); bf16* VsT = WSP(bf16, WS_VST); bf16* VwT = WSP(bf16, WS_VWT);
    const long n = (long)BATCH * NKV * (SEQ / 8) * 64;
    for (long it = gtid; it < n; it += NT) {
        const int d = (int)(it % 64); long r = it / 64; const int kg = (int)(r % (SEQ / 8)); const int bg = (int)(r / (SEQ / 8)), b = bg / NKV, g = bg % NKV;
        const int kbase = (kg >> 2) * 32 + 4 * (kg & 3);
        const bf16* src = KV + (size_t)(b * SEQ + kbase) * LDKV + g * 64 + d;
        U4 s, w; unsigned short sv[8], wv[8];
#pragma unroll
        for (int j = 0; j < 8; ++j) { const size_t ro = (size_t)((j & 3) + 16 * (j >> 2)) * LDKV; sv[j] = src[ro + 128]; wv[j] = src[ro + 384]; }
        s.x = sv[0] | ((unsigned)sv[1] << 16); s.y = sv[2] | ((unsigned)sv[3] << 16); s.z = sv[4] | ((unsigned)sv[5] << 16); s.w = sv[6] | ((unsigned)sv[7] << 16);
        w.x = wv[0] | ((unsigned)wv[1] << 16); w.y = wv[2] | ((unsigned)wv[3] << 16); w.z = wv[4] | ((unsigned)wv[5] << 16); w.w = wv[6] | ((unsigned)wv[7] << 16);
        *(U4*)(VsT + (((size_t)bg * (SEQ / 8) + kg) * 64 + d) * 8) = s; *(U4*)(VwT + (((size_t)bg * (SEQ / 8) + kg) * 64 + d) * 8) = w;
    }
}
namespace pg8 {
#define PG8_LAS __attribute__((address_space(3)))
typedef unsigned short bf16_t;
typedef short bf16x8 __attribute__((ext_vector_type(8)));
typedef float f32x4 __attribute__((ext_vector_type(4)));
typedef unsigned u32x4 __attribute__((ext_vector_type(4)));
constexpr int BM = 256, BK = 64, HALF = 128, HTB = HALF * BK * 2  , STAGE_BYTES = 8 * HTB, NXCD = 8, WGM = 8;

__host__ __device__ __forceinline__ int lds_byte(int r, int c) { const int st = (r >> 4) * 2 + (c >> 5), rr = r & 15, cc = c & 31, ob = rr * 64 + cc * 2; return st * 1024 + (ob ^ (((ob >> 9) & 1) << 5)); }
__host__ __device__ __forceinline__ void stage_rc(int b, int& R, int& C) { const int st = b / 1024, sb = b % 1024, swz = sb ^ (((sb >> 9) & 1) << 5); R = (st >> 1) * 16 + swz / 64; C = (st & 1) * 32 + (swz % 64) / 2; }
__host__ __device__ __forceinline__ int perm32(int rho) { const int n = rho >> 4, i = rho & 15; return 8 * (i >> 2) + 4 * n + (i & 3); }

struct Unit { int pm, pn; };
struct Gemm { const bf16_t* A; const bf16_t* Bt; int M, N, K; int lda; };

struct StaticOrder {
    int nM, nN, nwg, G, c;
    __host__ __device__ void init(int M, int N, int G_, int c_) { nM = M / BM; nN = N / BM; nwg = nM * nN; G = G_; c = c_; }
    __host__ __device__ bool next(int i, Unit& u) const {
        const long L = (long)i * G + c; if (L >= nwg) return false;
        int wgid = (int)L; { const int q = nwg / NXCD, r = nwg % NXCD, xcd = wgid % NXCD, off = wgid / NXCD; wgid = (xcd < r ? xcd * (q + 1) : r * (q + 1) + (xcd - r) * q) + off; }
        const int nig = WGM * nN, gid = wgid / nig, fm = gid * WGM, gsz = (nM - fm) < WGM ? (nM - fm) : WGM;
        u.pm = fm + ((wgid % nig) % gsz); u.pn = (wgid % nig) / gsz; return true;
    }
    __device__ __forceinline__ void a_ready(const Unit&) const {}
    __device__ __forceinline__ void done(const Unit&) const {}
};

__device__ __forceinline__ unsigned cvt_pk_bf16(float lo, float hi) { unsigned r; asm volatile("v_cvt_pk_bf16_f32 %0, %1, %2" : "=v"(r) : "v"(lo), "v"(hi)); return r; }
typedef float f32x2 __attribute__((ext_vector_type(2)));
template <class Epi, class Sched, bool ALIGN_EPI = false, bool SP2 = false>
__device__ __forceinline__ void gemm_phase(PG8_LAS unsigned char* lds, const Gemm g, const Sched& S, const Epi& E, int tid_in) {
    int tid_ = tid_in; asm volatile("" : "+v"(tid_));
    const int tid = tid_, wid = __builtin_amdgcn_readfirstlane(tid >> 6), lane = tid & 63, wr = wid >> 2, wc = wid & 3, fr = lane & 15, fq = lane >> 4;
    const int K = g.K, nt = K / BK, lda = g.lda ? g.lda : K;
    unsigned voffA[2], voffB[2];
#pragma unroll
    for (int i = 0; i < 2; ++i) { int R, C; stage_rc(tid * 16 + i * 8192, R, C); const int Rb = Epi::PERM ? ((R & ~31) + perm32(R & 31)) : R;
        voffA[i] = (unsigned)(R * lda + C) * 2u; voffB[i] = (unsigned)(Rb * K + C) * 2u; }
    const size_t kstep = (size_t)(BK * 2);
    const size_t hstepA = (size_t)HALF * lda * 2, hstepB = (size_t)HALF * K * 2;
    const size_t hstep_unused = (size_t)HALF * K * 2;
    const size_t tstepA = 2 * hstepA, tstepB = 2 * hstepB;
    const unsigned ldsw = (unsigned)wid * 1024u;
    const int aoff = lds_byte(wr * 64 + fr, fq * 8), boff = lds_byte(wc * 32 + fr, fq * 8);
#define PG8_SA(b, h) (((b) * 2 + (h)) * HTB)
#define PG8_SB(b, h) ((4 + (b) * 2 + (h)) * HTB)
#define PG8_STAGE(bufoff, gbase, voff) do { _Pragma("unroll") for (int _i = 0; _i < 2; ++_i) \
        __builtin_amdgcn_global_load_lds((const unsigned*)((const char*)(gbase) + (voff)[_i]), (PG8_LAS unsigned*)(lds + (bufoff) + ldsw + _i * 8192), 16, 0, 0); } while (0)
#define PG8_LDA(dst, b, h) do { _Pragma("unroll") for (int m = 0; m < 4; ++m) _Pragma("unroll") for (int k = 0; k < 2; ++k) dst[m][k] = *(const PG8_LAS bf16x8*)(lds + PG8_SA(b, h) + aoff + m * 2048 + k * 1024); } while (0)
#define PG8_LDB(dst, b, h) do { _Pragma("unroll") for (int n = 0; n < 2; ++n) _Pragma("unroll") for (int k = 0; k < 2; ++k) dst[n][k] = *(const PG8_LAS bf16x8*)(lds + PG8_SB(b, h) + boff + n * 2048 + k * 1024); } while (0)
#define PG8_MMA(ai, bj, At, Bt) do { __builtin_amdgcn_s_setprio(1); _Pragma("unroll") for (int m = 0; m < 4; ++m) _Pragma("unroll") for (int n = 0; n < 2; ++n) _Pragma("unroll") for (int k = 0; k < 2; ++k) \
        acc[ai][bj][m][n] = __builtin_amdgcn_mfma_f32_16x16x32_bf16(Bt[n][k], At[m][k], acc[ai][bj][m][n], 0, 0, 0); __builtin_amdgcn_s_setprio(0); } while (0)
#define PG8_WAIT_V(n) asm volatile("s_waitcnt vmcnt(" #n ")" ::: "memory")
#define PG8_WAIT_L(n) asm volatile("s_waitcnt lgkmcnt(" #n ")" ::: "memory")
#define PG8_BAR __builtin_amdgcn_s_barrier()
#define PG8_SCHED __builtin_amdgcn_sched_barrier(0)
    Unit cur, nxt; int ui = 0;
    if (!S.next(0, cur)) return;
    f32x4 acc[2][2][4][2];
#pragma unroll
    for (int a = 0; a < 2; ++a)
#pragma unroll
        for (int b = 0; b < 2; ++b)
#pragma unroll
            for (int m = 0; m < 4; ++m)
#pragma unroll
                for (int n = 0; n < 2; ++n) acc[a][b][m][n] = (f32x4){0.f, 0.f, 0.f, 0.f};
    bf16x8 At[4][2], B0[2][2], B1[2][2];
    const char* cA = (const char*)g.A + (size_t)cur.pm * tstepA; const char* cB = (const char*)g.Bt + (size_t)cur.pn * tstepB;
    S.a_ready(cur);
    if constexpr (SP2) {
        PG8_STAGE(PG8_SB(0, 0), cB, voffB); PG8_STAGE(PG8_SB(0, 1), cB + hstepB, voffB); PG8_STAGE(PG8_SA(0, 0), cA, voffA); PG8_STAGE(PG8_SA(0, 1), cA + hstepA, voffA);
        if (wr == 1) PG8_BAR;
        PG8_WAIT_V(2); PG8_BAR;
        PG8_STAGE(PG8_SB(1, 0), cB + kstep, voffB); PG8_STAGE(PG8_SA(1, 0), cA + kstep, voffA); PG8_STAGE(PG8_SB(1, 1), cB + hstepB + kstep, voffB);
        PG8_WAIT_V(6); PG8_BAR;
    } else {
        PG8_STAGE(PG8_SB(0, 0), cB, voffB); PG8_STAGE(PG8_SA(0, 0), cA, voffA); PG8_STAGE(PG8_SB(0, 1), cB + hstepB, voffB); PG8_STAGE(PG8_SA(0, 1), cA + hstepA, voffA);
        if (wr == 1) PG8_BAR;
        PG8_WAIT_V(4); PG8_BAR;
        PG8_STAGE(PG8_SB(1, 0), cB + kstep, voffB); PG8_STAGE(PG8_SA(1, 0), cA + kstep, voffA); PG8_STAGE(PG8_SB(1, 1), cB + hstepB + kstep, voffB);
        PG8_WAIT_V(6); PG8_BAR;
    }
    for (;;) {
        const bool has_next = S.next(ui + 1, nxt);
        const char* nA = has_next ? (const char*)g.A + (size_t)nxt.pm * tstepA : cA; const char* nB = has_next ? (const char*)g.Bt + (size_t)nxt.pn * tstepB : cB;
        for (int t = 0; t < nt; t += 2) {
            const bool last = (t == nt - 2);
            const char* a1 = cA + (size_t)(t + 1) * kstep;
            const char* a2 = last ? nA : cA + (size_t)(t + 2) * kstep; const char* b2 = last ? nB : cB + (size_t)(t + 2) * kstep;
            const char* a3 = a2 + kstep; const char* b3 = b2 + kstep;
            if (last && has_next) S.a_ready(nxt);
            if constexpr (SP2) {
            PG8_LDB(B0, 0, 0); PG8_LDB(B1, 0, 1); PG8_SCHED; PG8_LDA(At, 0, 0); PG8_STAGE(PG8_SA(1, 1), a1 + hstepA, voffA);
            PG8_WAIT_V(8); PG8_WAIT_L(0); PG8_BAR; PG8_MMA(0, 0, At, B0); PG8_MMA(0, 1, At, B1); PG8_BAR; PG8_SCHED;
            PG8_LDA(At, 0, 1); PG8_STAGE(PG8_SB(0, 0), b2, voffB); PG8_STAGE(PG8_SB(0, 1), b2 + hstepB, voffB); PG8_STAGE(PG8_SA(0, 0), a2, voffA);
            PG8_WAIT_V(8); PG8_WAIT_L(0); PG8_BAR; PG8_MMA(1, 0, At, B0); PG8_MMA(1, 1, At, B1); PG8_BAR; PG8_SCHED;
            PG8_LDB(B0, 1, 0); PG8_LDB(B1, 1, 1); PG8_SCHED; PG8_LDA(At, 1, 0); PG8_STAGE(PG8_SA(0, 1), a2 + hstepA, voffA);
            PG8_WAIT_V(8); PG8_WAIT_L(0); PG8_BAR; PG8_MMA(0, 0, At, B0); PG8_MMA(0, 1, At, B1); PG8_BAR; PG8_SCHED;
            PG8_LDA(At, 1, 1); PG8_STAGE(PG8_SB(1, 0), b3, voffB); PG8_STAGE(PG8_SB(1, 1), b3 + hstepB, voffB); PG8_STAGE(PG8_SA(1, 0), a3, voffA);
            PG8_WAIT_V(8); PG8_WAIT_L(0); PG8_BAR; PG8_MMA(1, 0, At, B0); PG8_MMA(1, 1, At, B1); PG8_BAR; PG8_SCHED;
            } else {
            PG8_LDB(B0, 0, 0); PG8_SCHED; PG8_LDA(At, 0, 0); PG8_STAGE(PG8_SA(1, 1), a1 + hstepA, voffA);
            PG8_WAIT_L(8); PG8_BAR; PG8_WAIT_L(0); PG8_MMA(0, 0, At, B0); PG8_BAR; PG8_SCHED;
            PG8_LDB(B1, 0, 1); PG8_STAGE(PG8_SB(0, 0), b2, voffB);
            PG8_BAR; PG8_WAIT_L(0); PG8_MMA(0, 1, At, B1); PG8_BAR;
            PG8_LDA(At, 0, 1); PG8_STAGE(PG8_SA(0, 0), a2, voffA);
            PG8_BAR; PG8_WAIT_L(0); PG8_MMA(1, 0, At, B0); PG8_BAR; PG8_SCHED;
            PG8_STAGE(PG8_SB(0, 1), b2 + hstepB, voffB);
            PG8_WAIT_V(6); PG8_BAR; PG8_MMA(1, 1, At, B1); PG8_BAR;
            PG8_LDB(B0, 1, 0); PG8_SCHED; PG8_LDA(At, 1, 0); PG8_STAGE(PG8_SA(0, 1), a2 + hstepA, voffA);
            PG8_WAIT_L(8); PG8_BAR; PG8_WAIT_L(0); PG8_MMA(0, 0, At, B0); PG8_BAR; PG8_SCHED;
            PG8_LDB(B1, 1, 1); PG8_STAGE(PG8_SB(1, 0), b3, voffB);
            PG8_BAR; PG8_WAIT_L(0); PG8_MMA(0, 1, At, B1); PG8_BAR;
            PG8_LDA(At, 1, 1); PG8_STAGE(PG8_SA(1, 0), a3, voffA);
            PG8_BAR; PG8_WAIT_L(0); PG8_MMA(1, 0, At, B0); PG8_BAR; PG8_SCHED;
            PG8_STAGE(PG8_SB(1, 1), b3 + hstepB, voffB);
            PG8_WAIT_V(6); PG8_BAR; PG8_MMA(1, 1, At, B1); PG8_BAR;
            }
        }
        if constexpr (ALIGN_EPI) { if (wr == 0) PG8_BAR; }
        if constexpr (!Epi::AFTER_DRAIN) { E(acc, cur, wr, wc, fr, fq); S.done(cur); }
        if (!has_next) break;
#pragma unroll
        for (int a = 0; a < 2; ++a)
#pragma unroll
            for (int b = 0; b < 2; ++b)
#pragma unroll
                for (int m = 0; m < 4; ++m)
#pragma unroll
                    for (int n = 0; n < 2; ++n) acc[a][b][m][n] = (f32x4){0.f, 0.f, 0.f, 0.f};
        cur = nxt; cA = nA; cB = nB; ++ui;
        if constexpr (ALIGN_EPI) { if (wr == 1) PG8_BAR; }
    }
    PG8_WAIT_V(0);
    if constexpr (!ALIGN_EPI) { if (wr == 0) PG8_BAR; }
    PG8_BAR;
    if constexpr (Epi::AFTER_DRAIN) { E.fused(acc, cur, wr, wc, fr, fq, lds, wid, lane); S.done(cur); }
#undef PG8_SA
#undef PG8_SB
#undef PG8_STAGE
#undef PG8_LDA
#undef PG8_LDB
#undef PG8_MMA
#undef PG8_WAIT_V
#undef PG8_WAIT_L
#undef PG8_BAR
#undef PG8_SCHED
}
}

#define LAS __attribute__((address_space(3)))
#define XB_TMO      128
#define XB_XCNT(j)  (256  + 64 * (j))
#define XB_XSUB(j)  (1280 + 64 * (j))
#define XB_XGEN(j)  (2304 + 64 * (j))
#define XB_TOP      3328
#define XB_TOPGEN   3392
#define XCD_BAR_WORDS 3456
#define XB_SPIN_CAP (1u << 22)

__device__ __forceinline__ unsigned xb_ld(unsigned* p)              { return __hip_atomic_load(p, __ATOMIC_RELAXED, __HIP_MEMORY_SCOPE_AGENT); }
__device__ __forceinline__ unsigned xb_add(unsigned* p, unsigned v) { return __hip_atomic_fetch_add(p, v, __ATOMIC_RELAXED, __HIP_MEMORY_SCOPE_AGENT); }
__device__ __forceinline__ unsigned xb_xcc_id() { return (unsigned)__builtin_amdgcn_s_getreg((3 << 11) | 20) & 0xFu; }
#define XB_SPIN(cond, bar) do { unsigned _sp = 0; while (cond) { __builtin_amdgcn_s_sleep(1); \
    if ((++_sp & 255u) == 0u) { if (xb_ld(&(bar)[XB_TMO])) break; if (_sp > XB_SPIN_CAP) { atomicAdd(&(bar)[XB_TMO], 1u); break; } } } } while (0)

struct XcdBarrier {
    unsigned* bar; unsigned x;
    volatile LAS unsigned* st;
};

__device__ __forceinline__ XcdBarrier xcd_barrier_post(unsigned* bar, volatile LAS unsigned* st) {
    XcdBarrier b; b.bar = bar; b.x = xb_xcc_id(); b.st = st;
    if (threadIdx.x == 0) (void)xb_add(&bar[XB_XCNT(b.x)], 1u);
    return b;
}
__device__ __forceinline__ void xcd_barrier_complete(unsigned* bar, unsigned x, unsigned& nloc, unsigned& nx) {
    const unsigned G = gridDim.x * gridDim.y * gridDim.z;
    unsigned sum, cnt, mine, sp = 0u;
    for (;;) {
        sum = 0u; cnt = 0u; mine = 0u;
#pragma unroll
        for (unsigned j = 0; j < 16; ++j) { const unsigned c = xb_ld(&bar[XB_XCNT(j)]); sum += c; cnt += (c > 0u) ? 1u : 0u; mine = (j == x) ? c : mine; }
        if (sum == G) break;
        __builtin_amdgcn_s_sleep(1);
        if ((++sp & 255u) == 0u) { if (xb_ld(&bar[XB_TMO])) break; if (sp > XB_SPIN_CAP) { atomicAdd(&bar[XB_TMO], 1u); break; } }
    }
    nloc = mine > 0u ? mine : 1u; nx = cnt > 0u ? cnt : 1u;
}

__device__ __forceinline__ void xcd_barrier(const XcdBarrier& b, int tid_x  ) {
    asm volatile("s_waitcnt vmcnt(0)" ::: "memory");
    __syncthreads();
    if (tid_x == 0) {
        unsigned* bar = b.bar; asm volatile("" : "+s"(bar));
        unsigned xx = b.x; asm volatile("" : "+s"(xx));
        __builtin_amdgcn_s_waitcnt(0);
        unsigned nloc = b.st[0], nx = b.st[1];
        if (nloc == 0u) { xcd_barrier_complete(bar, xx, nloc, nx); b.st[0] = nloc; b.st[1] = nx; }
        const unsigned old = xb_add(&bar[XB_XSUB(xx)], 1u);
        const unsigned gen = old / nloc;
        if (old + 1u == (gen + 1u) * nloc) {
            __builtin_amdgcn_fence(__ATOMIC_RELEASE, "agent");
            asm volatile("s_waitcnt vmcnt(0)" ::: "memory");
            const unsigned og = xb_add(&bar[XB_TOP], 1u);
            const unsigned tg = og / nx;
            if (og + 1u == (tg + 1u) * nx) xb_add(&bar[XB_TOPGEN], 1u);
            else XB_SPIN(xb_ld(&bar[XB_TOPGEN]) == tg, bar);
            __builtin_amdgcn_fence(__ATOMIC_ACQUIRE, "agent");
            xb_add(&bar[XB_XGEN(xx)], 1u);
            asm volatile("s_waitcnt vmcnt(0)" ::: "memory");
        } else {
            XB_SPIN(xb_ld(&bar[XB_XGEN(xx)]) == gen, bar);
            __builtin_amdgcn_fence(__ATOMIC_ACQUIRE, "agent");
            asm volatile("s_waitcnt vmcnt(0)" ::: "memory");
        }
    }
    __syncthreads();
}
#define GAS __attribute__((address_space(1)))
typedef unsigned v4u __attribute__((ext_vector_type(4)));
typedef unsigned v2u __attribute__((ext_vector_type(2)));
typedef GAS unsigned gu32;
#define RLX_AGENT __ATOMIC_RELAXED, __HIP_MEMORY_SCOPE_AGENT
#define LDS_WAIT() asm volatile("s_waitcnt lgkmcnt(0)" ::: "memory")
#define VM_WAIT() asm volatile("s_waitcnt vmcnt(0)" ::: "memory")
using pg8::f32x4; using pg8::Unit; using pg8::Gemm; using pg8::BM; using pg8::HALF; using pg8::cvt_pk_bf16; using pg8::u32x4;

constexpr int NWAVES = 8, NTHREADS = 512;
constexpr int RING_BYTES = 131072, LDSCTL_OFF = 147456 - 1024, MISC_OFF = LDSCTL_OFF + 320, LDS_BYTES = 147456;

__device__ __forceinline__ float wave_sum(float v, int lane) {
#pragma unroll
    for (int o = 1; o < 64; o <<= 1) v += __builtin_bit_cast(float, __builtin_amdgcn_ds_bpermute((lane ^ o) << 2, __builtin_bit_cast(int, v)));
    return v;
}
__device__ __forceinline__ float fsig(float x) { return __builtin_amdgcn_rcpf(1.f + __expf(-x)); }

__device__ __forceinline__ int lane_id_opaque() { int l; asm volatile("v_mbcnt_lo_u32_b32 %0, -1, 0\n\tv_mbcnt_hi_u32_b32 %0, -1, %0" : "=v"(l)); return l; }
__device__ __forceinline__ int rfl(int v) { return __builtin_amdgcn_readfirstlane(v); }
struct SOrder {
    pg8::StaticOrder s;
    __device__ void init(int M, int N, int G, int c) { s.init(M, N, G, c); }
    __device__ bool next(int i, Unit& u) const { Unit t; t.pm = 0; t.pn = 0; const bool ok = s.next(i, t); u.pm = rfl(t.pm); u.pn = rfl(t.pn); return ok; }
    __device__ __forceinline__ void a_ready(const Unit&) const {}
    __device__ __forceinline__ void done(const Unit&) const {}
};
struct StackOrder {
    pg8::StaticOrder s; int nM, nN;
    __device__ StackOrder(int nM_, int nN_, int nb, int G, int c) : nM(nM_), nN(nN_) { s.init(nb * nM_ * 256, nN_ * 256, G, c); }
    __device__ bool next(int i, Unit& u) const { Unit t; t.pm = 0; t.pn = 0; if (!s.next(i, t)) return false; u.pm = rfl(t.pm); u.pn = rfl((t.pm / nM) * nN + t.pn); return true; }
    __device__ __forceinline__ void a_ready(const Unit&) const {}
    __device__ __forceinline__ void done(const Unit&) const {}
};
struct GateOrder {
    pg8::StaticOrder s; int nN;
    __device__ GateOrder(int nM_, int nN_, int G, int c) : nN(nN_) { s.init(nM_ * 256, nN_ * 256, G, c); }
    __device__ bool next(int i, Unit& u) const { const int j = i / 3, br = i - 3 * j; Unit t; t.pm = 0; t.pn = 0; if (!s.next(j, t)) return false; u.pm = rfl(t.pm); u.pn = rfl(br * nN + t.pn); return true; }
    __device__ __forceinline__ void a_ready(const Unit&) const {}
    __device__ __forceinline__ void done(const Unit&) const {}
};
struct MoeOrder {
    pg8::StaticOrder s; int nN, e0, e1, e2, e3, e4, e5, e6, e7;
    __device__ void init(const unsigned* cnt  , int nN_, int G_, int c_) { nN = nN_;
        int t = 0; t += (cnt[0] + 255) >> 8; e0 = t; t += (cnt[64] + 255) >> 8; e1 = t; t += (cnt[128] + 255) >> 8; e2 = t; t += (cnt[192] + 255) >> 8; e3 = t;
        t += (cnt[256] + 255) >> 8; e4 = t; t += (cnt[320] + 255) >> 8; e5 = t; t += (cnt[384] + 255) >> 8; e6 = t; t += (cnt[448] + 255) >> 8; e7 = t;
        s.init(e7 * 256, nN_ * 256, G_, c_); }
    __device__ bool next(int i, Unit& u) const { Unit t; t.pm = 0; t.pn = 0; if (!s.next(i, t)) return false;
        const int pm = t.pm, e = (pm >= e0) + (pm >= e1) + (pm >= e2) + (pm >= e3) + (pm >= e4) + (pm >= e5) + (pm >= e6);
        u.pm = rfl(pm); u.pn = rfl(e * nN + t.pn); return true; }
    __device__ __forceinline__ void a_ready(const Unit&) const {}
    __device__ __forceinline__ void done(const Unit&) const {}
};

__device__ __forceinline__ u32x4 pack8(f32x4 v0, f32x4 v1) { u32x4 w; w.x = cvt_pk_bf16(v0[0], v0[1]); w.y = cvt_pk_bf16(v0[2], v0[3]); w.z = cvt_pk_bf16(v1[0], v1[1]); w.w = cvt_pk_bf16(v1[2], v1[3]); return w; }
__device__ __forceinline__ void unpack8(u32x4 w, f32x4& v0, f32x4& v1) {
    v0 = (f32x4){blo(w.x), bhi(w.x), blo(w.y), bhi(w.y)}; v1 = (f32x4){blo(w.z), bhi(w.z), blo(w.w), bhi(w.w)}; }

struct EpiProj {
    static constexpr bool PERM = true, AFTER_DRAIN = false;
    unsigned char* ws;
    __device__ __forceinline__ void operator()(const f32x4 (&acc)[2][2][4][2], const Unit& u, int wr, int wc, int fr, int fq) const {
        bf16* const QB = (bf16*)(ws + AR_QB); bf16* const KV = (bf16*)(ws + AR_KV); bf16* const UB = (bf16*)(ws + AR_UB); bf16* const RW = (bf16*)(ws + AR_RW); bf16* const HALO = (bf16*)(ws + AR_HALO); bf16* const CKV = (bf16*)(ws + AR_CKV);
        const int row0 = u.pm * BM + wr * 64 + fr, cl = wc * 32 + 8 * fq;
        if (u.pn >= 5 && u.pn < 9) {
#pragma unroll
            for (int ai = 0; ai < 2; ++ai)
#pragma unroll
                for (int m = 0; m < 4; ++m) { f32x4 a0 = acc[ai][0][m][0], a1 = acc[ai][0][m][1]; const f32x4 b0 = acc[ai][1][m][0], b1 = acc[ai][1][m][1];
#pragma unroll
                    for (int k = 0; k < 4; ++k) { a0[k] *= fsig(b0[k]); a1[k] *= fsig(b1[k]); }
                    *(u32x4*)(UB + (size_t)(row0 + ai * HALF + m * 16) * 512 + (u.pn - 5) * 128 + cl) = pack8(a0, a1); }
            return;
        }
        if (u.pn == 2) {
#pragma unroll
            for (int ai = 0; ai < 2; ++ai)
#pragma unroll
                for (int m = 0; m < 4; ++m) { const int row = row0 + ai * HALF + m * 16, b = row / SEQ, tt = row % SEQ;
#pragma unroll
                    for (int bj = 0; bj < 2; ++bj) *(u32x4*)(CKV + (((size_t)bj * (BATCH * NKV) + b * NKV + (cl >> 6)) * SEQ + tt) * 64 + (cl & 63)) = pack8(acc[ai][bj][m][0], acc[ai][bj][m][1]); }
            return;
        }
        bf16* base; int ld, c0;
        if (u.pn < 2) { base = QB; ld = LDQ; c0 = u.pn * 256; } else if (u.pn < 5) { base = KV; ld = LDKV; c0 = (u.pn - 3) * 256; } else { base = RW; ld = LDRW; c0 = (u.pn - 9) * 256; }
#pragma unroll
        for (int ai = 0; ai < 2; ++ai)
#pragma unroll
            for (int m = 0; m < 4; ++m)
#pragma unroll
                for (int bj = 0; bj < 2; ++bj) { const u32x4 w = pack8(acc[ai][bj][m][0], acc[ai][bj][m][1]);
                    *(u32x4*)(base + (size_t)(row0 + ai * HALF + m * 16) * ld + c0 + bj * HALF + cl) = w;
                    if (u.pn >= 9 && ai == 1 && m == 3 && wr == 1 && fr == 15) *(u32x4*)(HALO + (size_t)u.pm * LDRW + c0 + bj * HALF + cl) = w; }
    }
};
struct EpiStore {
    static constexpr bool PERM = true, AFTER_DRAIN = false;
    bf16* O; int ld, ntn;
    __device__ __forceinline__ void operator()(const f32x4 (&acc)[2][2][4][2], const Unit& u, int wr, int wc, int fr, int fq) const {
        const int row0 = u.pm * BM + wr * 64 + fr, c0 = (u.pn % ntn) * 256 + wc * 32 + 8 * fq;
#pragma unroll
        for (int ai = 0; ai < 2; ++ai)
#pragma unroll
            for (int m = 0; m < 4; ++m)
#pragma unroll
                for (int bj = 0; bj < 2; ++bj) *(u32x4*)(O + (size_t)(row0 + ai * HALF + m * 16) * ld + c0 + bj * HALF) = pack8(acc[ai][bj][m][0], acc[ai][bj][m][1]);
    }
};
struct EpiGate {
    static constexpr bool PERM = true, AFTER_DRAIN = false;
    unsigned char* ws; int ntn;
    __device__ __forceinline__ void operator()(const f32x4 (&acc)[2][2][4][2], const Unit& u, int wr, int wc, int fr, int fq) const {
        const bf16* const OB = (const bf16*)(ws + AR_OBUF); bf16* const MIX = (bf16*)(ws + AR_MIX);
        const int br = u.pn / ntn, row0 = u.pm * BM + wr * 64 + fr, c0 = (u.pn % ntn) * 256 + wc * 32 + 8 * fq;
        const bf16* ob = OB + (size_t)br * T * DM;
#pragma unroll
        for (int ai = 0; ai < 2; ++ai) {
            u32x4 o[4][2], mx[4][2];
#pragma unroll
            for (int m = 0; m < 4; ++m)
#pragma unroll
                for (int bj = 0; bj < 2; ++bj) { const size_t off = (size_t)(row0 + ai * HALF + m * 16) * DM + c0 + bj * HALF; o[m][bj] = *(const u32x4*)(ob + off); if (br != 0) mx[m][bj] = *(const u32x4*)(MIX + off); }
#pragma unroll
            for (int m = 0; m < 4; ++m)
#pragma unroll
                for (int bj = 0; bj < 2; ++bj) { const size_t off = (size_t)(row0 + ai * HALF + m * 16) * DM + c0 + bj * HALF;
                    f32x4 o0, o1; unpack8(o[m][bj], o0, o1);
                    f32x4 g0 = acc[ai][bj][m][0], g1 = acc[ai][bj][m][1];
#pragma unroll
                    for (int k = 0; k < 4; ++k) { g0[k] = fsig(g0[k]) * o0[k]; g1[k] = fsig(g1[k]) * o1[k]; }
                    if (br != 0) { f32x4 p0, p1; unpack8(mx[m][bj], p0, p1); g0 += p0; g1 += p1; }
                    *(u32x4*)(MIX + off) = pack8(g0, g1); }
        }
    }
};
struct EpiResid {
    static constexpr bool PERM = true, AFTER_DRAIN = false;
    const float* base; float* out;
    __device__ __forceinline__ void operator()(const f32x4 (&acc)[2][2][4][2], const Unit& u, int wr, int wc, int fr, int fq) const {
        const int row0 = u.pm * BM + wr * 64 + fr, c0 = u.pn * 256 + wc * 32 + 8 * fq;
#pragma unroll
        for (int ai = 0; ai < 2; ++ai)
#pragma unroll
            for (int mh = 0; mh < 2; ++mh) {
                f32x4 x[2][2][2];
#pragma unroll
                for (int mm = 0; mm < 2; ++mm)
#pragma unroll
                    for (int bj = 0; bj < 2; ++bj) { const size_t off = (size_t)(row0 + ai * HALF + (2 * mh + mm) * 16) * DM + c0 + bj * HALF; x[mm][bj][0] = *(const f32x4*)(base + off); x[mm][bj][1] = *(const f32x4*)(base + off + 4); }
#pragma unroll
                for (int mm = 0; mm < 2; ++mm)
#pragma unroll
                    for (int bj = 0; bj < 2; ++bj) { const int m = 2 * mh + mm; const size_t off = (size_t)(row0 + ai * HALF + m * 16) * DM + c0 + bj * HALF;
                        *(f32x4*)(out + off) = x[mm][bj][0] + acc[ai][bj][m][0]; *(f32x4*)(out + off + 4) = x[mm][bj][1] + acc[ai][bj][m][1]; }
            }
    }
};
struct EpiSwiglu {
    static constexpr bool PERM = true, AFTER_DRAIN = false;
    bf16* ACT; int ld, ntn;
    __device__ __forceinline__ void operator()(const f32x4 (&acc)[2][2][4][2], const Unit& u, int wr, int wc, int fr, int fq) const {
        const int row0 = u.pm * BM + wr * 64 + fr, c0 = (u.pn % ntn) * 128 + wc * 32 + 8 * fq;
#pragma unroll
        for (int ai = 0; ai < 2; ++ai)
#pragma unroll
            for (int m = 0; m < 4; ++m) { f32x4 g0 = acc[ai][0][m][0], g1 = acc[ai][0][m][1]; const f32x4 u0 = acc[ai][1][m][0], u1 = acc[ai][1][m][1];
#pragma unroll
                for (int k = 0; k < 4; ++k) { g0[k] = g0[k] * fsig(g0[k]) * u0[k]; g1[k] = g1[k] * fsig(g1[k]) * u1[k]; }
                *(u32x4*)(ACT + (size_t)(row0 + ai * HALF + m * 16) * ld + c0) = pack8(g0, g1); }
    }
};
struct EpiMoeDown {
    static constexpr bool PERM = true, AFTER_DRAIN = false;
    float* out; const int* rtok; const float* rw; int ntn; float sc;
    __device__ __forceinline__ void operator()(const f32x4 (&acc)[2][2][4][2], const Unit& u, int wr, int wc, int fr, int fq) const {
        const int row0 = u.pm * BM + wr * 64 + fr, c0 = (u.pn % ntn) * 256 + wc * 32 + 8 * fq;
#pragma unroll
        for (int ai = 0; ai < 2; ++ai)
#pragma unroll
            for (int mh = 0; mh < 2; ++mh) {
                int tok[2]; float w[2]; f32x4 x[2][2][2];
#pragma unroll
                for (int mm = 0; mm < 2; ++mm) { const int row = row0 + ai * HALF + (2 * mh + mm) * 16; tok[mm] = rtok[row]; w[mm] = rw[row] * sc; }
#pragma unroll
                for (int mm = 0; mm < 2; ++mm)
#pragma unroll
                    for (int bj = 0; bj < 2; ++bj) { const float* o = out + (size_t)(tok[mm] >= 0 ? tok[mm] : 0) * DM + c0 + bj * HALF; x[mm][bj][0] = *(const f32x4*)o; x[mm][bj][1] = *(const f32x4*)(o + 4); }
#pragma unroll
                for (int mm = 0; mm < 2; ++mm)
#pragma unroll
                    for (int bj = 0; bj < 2; ++bj) if (tok[mm] >= 0) { const int m = 2 * mh + mm; float* o = out + (size_t)tok[mm] * DM + c0 + bj * HALF;
                        *(f32x4*)o = x[mm][bj][0] + acc[ai][bj][m][0] * w[mm]; *(f32x4*)(o + 4) = x[mm][bj][1] + acc[ai][bj][m][1] * w[mm]; }
            }
    }
};

typedef short bf16x8_t __attribute__((ext_vector_type(8)));
#define MFMA16(a, b, c) __builtin_amdgcn_mfma_f32_16x16x32_bf16((a), (b), (c), 0, 0, 0)
constexpr float ATT_C = 0.125f * 1.4426950408889634f;
constexpr int AW_IMP = 0, AW_SEL = 8448, AW_QS = 8960, AW_BYTES = 8960 + 8192;
__device__ __forceinline__ float bperm_f(float v, int srclane) { return __builtin_bit_cast(float, __builtin_amdgcn_ds_bpermute(srclane << 2, __builtin_bit_cast(int, v))); }
__device__ __forceinline__ int bperm_i(int v, int srclane) { return __builtin_amdgcn_ds_bpermute(srclane << 2, v); }
__device__ __forceinline__ bf16x8_t ldg8(const bf16* p) { return *(const bf16x8_t*)p; }
__device__ __forceinline__ bf16x8_t pack_p(const f32x4& a, const f32x4& b) {
    v4u w; w.x = cvt_pk_bf16(a[0], a[1]); w.y = cvt_pk_bf16(a[2], a[3]); w.z = cvt_pk_bf16(b[0], b[1]); w.w = cvt_pk_bf16(b[2], b[3]); return __builtin_bit_cast(bf16x8_t, w); }

__device__ __forceinline__ void nsa_attn_item(const P& p, int item, int lane, LAS unsigned char* wl) {
    const bf16* KV = WSP(bf16, AR_KV); const bf16* KC = WSP(bf16, AR_KC); const bf16* VcT = WSP(bf16, AR_VCT); const bf16* VsT = WSP(bf16, WS_VST); const bf16* VwT = WSP(bf16, WS_VWT);
    bf16* QB = WSP(bf16, AR_QB); const float* NG = WSP(float, AR_NG);
    const int bg = item / (SEQ / 16), t0 = (item % (SEQ / 16)) * 16, b = bg >> 1, g = bg & 1;
    const int col = lane & 15, fq = lane >> 4, tok = t0 + col;
    const size_t grow = (size_t)b * SEQ + tok;
    LAS float* IMP = (LAS float*)(wl + AW_IMP); LAS int* SEL = (LAS int*)(wl + AW_SEL); LAS bf16* OS = (LAS bf16*)(wl + AW_IMP);
    const int krowA = 8 * (col >> 2) + (col & 3);
    const float* gate = NG + grow * 24 + g * 12;
    LAS bf16x8_t* QS = (LAS bf16x8_t*)(wl + AW_QS) + lane;
#pragma unroll
    for (int hh = 0; hh < 4; ++hh)
#pragma unroll
        for (int ks = 0; ks < 2; ++ks) QS[(hh * 2 + ks) * 64] = ldg8(QB + grow * LDQ + (g * 4 + hh) * 64 + ks * 32 + fq * 8);
#define Qc(hh, ks) (QS[((hh) * 2 + (ks)) * 64])
    for (int i = lane; i < 16 * 132; i += 64) IMP[i] = 0.f;
    const f32x4 z4 = {0.f, 0.f, 0.f, 0.f};
    f32x4 O[4][4];
    int nvmax = (t0 + 15 >= 31) ? (((t0 + 15 - 31) >> 4) + 1) : 0; if (nvmax > NC) nvmax = NC;
    const int nch = (nvmax + 31) >> 5;
    const bf16* kcb = KC + (size_t)bg * 512 * 64; const bf16* vcb = VcT + (size_t)bg * 64 * 512;
    float linv[4] = {0.f, 0.f, 0.f, 0.f};
#pragma unroll
    for (int hh = 0; hh < 4; ++hh)
#pragma unroll
        for (int mt = 0; mt < 4; ++mt) O[hh][mt] = z4;
#pragma unroll 1
    for (int pass = 0; pass < 2; ++pass) {
#pragma unroll 1
        for (int ch = 0; ch < nch; ++ch) {
            asm volatile("" ::: "memory");
            const int k0 = 32 * ch; const bool cfull = 16 * (k0 + 31) + 31 <= t0;
            bf16x8_t ka[2][2];
#pragma unroll
            for (int tl = 0; tl < 2; ++tl)
#pragma unroll
                for (int ks = 0; ks < 2; ++ks) ka[tl][ks] = ldg8(kcb + ((size_t)(4 * ks + fq) * 512 + k0 + 16 * tl + col) * 8);
            bf16x8_t va[4];
            if (pass == 1) {
#pragma unroll
                for (int mt = 0; mt < 4; ++mt) va[mt] = ldg8(vcb + ((size_t)((k0 >> 3) + fq) * 64 + 16 * mt + col) * 8);
            }
            float ps[8] = {0.f, 0.f, 0.f, 0.f, 0.f, 0.f, 0.f, 0.f};
#pragma unroll
            for (int hh = 0; hh < 4; ++hh) {
                const bf16x8_t q0_ = Qc(hh, 0), q1_ = Qc(hh, 1);
                f32x4 sa = MFMA16(ka[0][0], q0_, z4); sa = MFMA16(ka[0][1], q1_, sa);
                f32x4 sb = MFMA16(ka[1][0], q0_, z4); sb = MFMA16(ka[1][1], q1_, sb);
#pragma unroll
                for (int i = 0; i < 4; ++i) { sa[i] = __builtin_amdgcn_exp2f(sa[i]); sb[i] = __builtin_amdgcn_exp2f(sb[i]); }
                if (!cfull) {
#pragma unroll
                    for (int i = 0; i < 4; ++i) { const int c = k0 + 4 * fq + i; sa[i] = (16 * c + 31 <= tok) ? sa[i] : 0.f; sb[i] = (16 * (c + 16) + 31 <= tok) ? sb[i] : 0.f; } }
                if (pass == 0) { linv[hh] += (sa[0] + sa[1]) + (sa[2] + sa[3]) + (sb[0] + sb[1]) + (sb[2] + sb[3]); }
                else {
#pragma unroll
                    for (int i = 0; i < 4; ++i) { ps[i] = __builtin_fmaf(sa[i], linv[hh], ps[i]); ps[4 + i] = __builtin_fmaf(sb[i], linv[hh], ps[4 + i]); }
                    const bf16x8_t pt = pack_p(sa, sb);
#pragma unroll
                    for (int mt = 0; mt < 4; ++mt) O[hh][mt] = MFMA16(va[mt], pt, O[hh][mt]);
                }
            }
            if (pass == 1) {
                const int Ga = 8 * ch + fq; LAS float* ir = IMP + col * 132 + Ga;
                __hip_atomic_fetch_add(ir, (ps[0] + ps[1]) + (ps[2] + ps[3]), __ATOMIC_RELAXED, __HIP_MEMORY_SCOPE_WORKGROUP);
                __hip_atomic_fetch_add(ir + 1, ps[3], __ATOMIC_RELAXED, __HIP_MEMORY_SCOPE_WORKGROUP);
                __hip_atomic_fetch_add(ir + 4, (ps[4] + ps[5]) + (ps[6] + ps[7]), __ATOMIC_RELAXED, __HIP_MEMORY_SCOPE_WORKGROUP);
                if (Ga + 5 < NS) __hip_atomic_fetch_add(ir + 5, ps[7], __ATOMIC_RELAXED, __HIP_MEMORY_SCOPE_WORKGROUP);
            }
        }
        if (pass == 0) {
#pragma unroll
            for (int hh = 0; hh < 4; ++hh) { float l = linv[hh]; l += bperm_f(l, lane ^ 16); l += bperm_f(l, lane ^ 32); linv[hh] = l > 0.f ? 1.f / l : 0.f; }
        }
    }
    LDS_WAIT(); asm volatile("" ::: "memory");
    {
        const int cur = tok >> 6; LAS float* sc = IMP + col * 132;
        for (int j = fq * 32; j < fq * 32 + 32; ++j) { const bool forced = (j == 0) || (j == cur) || (j == cur - 1); const float v = sc[j]; sc[j] = forced ? 1e4f : (j <= cur ? v : -1.f); }
        LDS_WAIT(); asm volatile("" ::: "memory");
#pragma unroll 1
        for (int r = 0; r < 8; ++r) {
            float bv = sc[fq * 32]; int bj = fq * 32;
            for (int j = fq * 32 + 1; j < fq * 32 + 32; ++j) { const float v = sc[j]; if (v > bv) { bv = v; bj = j; } }
#pragma unroll
            for (int o = 16; o <= 32; o <<= 1) { const float ov = bperm_f(bv, lane ^ o); const int oj = bperm_i(bj, lane ^ o); if (ov > bv || (ov == bv && oj < bj)) { bv = ov; bj = oj; } }
            if ((bj >> 5) == fq) sc[bj] = -3e38f;
            if (fq == 0) SEL[col * 8 + r] = bj;
            LDS_WAIT(); asm volatile("" ::: "memory");
        }
    }
#pragma unroll
    for (int hh = 0; hh < 4; ++hh) { const float g0 = gate[hh * 3 + 0] * linv[hh];
#pragma unroll
        for (int mt = 0; mt < 4; ++mt) { const f32x4 o = O[hh][mt] * g0; v2u w; w.x = cvt_pk_bf16(o[0], o[1]); w.y = cvt_pk_bf16(o[2], o[3]);
            *(LAS v2u*)(OS + (col * 4 + hh) * 64 + 16 * mt + 4 * fq) = w; } }
    LDS_WAIT(); asm volatile("" ::: "memory");
    const int cur = t0 >> 6;
    {
        const bf16* kwb = WSP(bf16, WS_KW8) + (size_t)bg * 8 * SEQ * 8; const bf16* vwb = VwT + (size_t)bg * 64 * SEQ;
        const bf16* ksb = WSP(bf16, WS_KS8) + (size_t)bg * 8 * SEQ * 8; const bf16* vsb = VsT + (size_t)bg * 64 * SEQ;
        int kst = t0 - (WINDOW - 1); if (kst < 0) kst = 0; kst &= ~31;
        const int nwin = ((t0 + 15 - kst) >> 5) + 1, nfb = cur >= 2 ? 3 : cur + 1;
#pragma unroll 1
        for (int part = 0; part < 2; ++part) {
            float lw[4] = {0.f, 0.f, 0.f, 0.f};
#pragma unroll
            for (int hh = 0; hh < 4; ++hh)
#pragma unroll
                for (int mt = 0; mt < 4; ++mt) O[hh][mt] = z4;
            const bf16* kb = part ? ksb : kwb; const bf16* vb = part ? vsb : vwb;
            const int nchk = part ? 2 * nfb : nwin;
#pragma unroll 1
            for (int ci = 0; ci < nchk; ++ci) {
                asm volatile("" ::: "memory");
                int k0;
                if (part == 0) k0 = kst + 32 * ci; else { const int fb = ci >> 1, j = fb == 0 ? 0 : (fb == 1 ? cur : cur - 1); k0 = 64 * j + 32 * (ci & 1); }
                bf16x8_t ka[2][2], va[4];
#pragma unroll
                for (int tl = 0; tl < 2; ++tl)
#pragma unroll
                    for (int ks = 0; ks < 2; ++ks) ka[tl][ks] = ldg8(kb + ((size_t)(4 * ks + fq) * SEQ + k0 + 16 * tl + col) * 8);
#pragma unroll
                for (int mt = 0; mt < 4; ++mt) va[mt] = ldg8(vb + ((size_t)((k0 >> 3) + fq) * 64 + 16 * mt + col) * 8);
                const int lowk = part ? -1 : tok - WINDOW; const bool dfull = (k0 + 31 <= t0) && (part || k0 > t0 + 15 - WINDOW);
#pragma unroll
                for (int hh = 0; hh < 4; ++hh) {
                    const bf16x8_t q0_ = Qc(hh, 0), q1_ = Qc(hh, 1);
                    f32x4 sa = MFMA16(ka[0][0], q0_, z4); sa = MFMA16(ka[0][1], q1_, sa);
                    f32x4 sb = MFMA16(ka[1][0], q0_, z4); sb = MFMA16(ka[1][1], q1_, sb);
#pragma unroll
                    for (int i = 0; i < 4; ++i) { sa[i] = __builtin_amdgcn_exp2f(sa[i]); sb[i] = __builtin_amdgcn_exp2f(sb[i]); }
                    if (!dfull) {
#pragma unroll
                        for (int i = 0; i < 4; ++i) { const int kt = k0 + 4 * fq + i; sa[i] = (kt <= tok && kt > lowk) ? sa[i] : 0.f; sb[i] = (kt + 16 <= tok && kt + 16 > lowk) ? sb[i] : 0.f; } }
                    lw[hh] += (sa[0] + sa[1]) + (sa[2] + sa[3]) + (sb[0] + sb[1]) + (sb[2] + sb[3]);
                    const bf16x8_t pt = pack_p(sa, sb);
#pragma unroll
                    for (int mt = 0; mt < 4; ++mt) O[hh][mt] = MFMA16(va[mt], pt, O[hh][mt]);
                }
            }
            LDS_WAIT(); asm volatile("" ::: "memory");
            if (part == 0) {
#pragma unroll
                for (int hh = 0; hh < 4; ++hh) { float l = lw[hh]; l += bperm_f(l, lane ^ 16); l += bperm_f(l, lane ^ 32); const float w = l > 0.f ? gate[hh * 3 + 2] / l : 0.f;
#pragma unroll
                    for (int mt = 0; mt < 4; ++mt) { LAS v2u* dp = (LAS v2u*)(OS + (col * 4 + hh) * 64 + 16 * mt + 4 * fq); const v2u old = *dp;
                        v2u w2; w2.x = cvt_pk_bf16(blo(old.x) + w * O[hh][mt][0], bhi(old.x) + w * O[hh][mt][1]); w2.y = cvt_pk_bf16(blo(old.y) + w * O[hh][mt][2], bhi(old.y) + w * O[hh][mt][3]); *dp = w2; } }
            } else {
                LAS bf16* OF = (LAS bf16*)(wl + AW_QS); LAS float* LF = (LAS float*)(wl + AW_IMP + 8192);
#pragma unroll
                for (int hh = 0; hh < 4; ++hh) { float l = lw[hh]; l += bperm_f(l, lane ^ 16); l += bperm_f(l, lane ^ 32); if (fq == 0) LF[col * 4 + hh] = l;
#pragma unroll
                    for (int mt = 0; mt < 4; ++mt) { v2u w2; w2.x = cvt_pk_bf16(O[hh][mt][0], O[hh][mt][1]); w2.y = cvt_pk_bf16(O[hh][mt][2], O[hh][mt][3]); *(LAS v2u*)(OF + (col * 4 + hh) * 64 + 16 * mt + 4 * fq) = w2; } }
            }
            LDS_WAIT(); asm volatile("" ::: "memory");
        }
    }
    {
        const bf16* ksb = WSP(bf16, WS_KS8) + (size_t)bg * 8 * SEQ * 8; const bf16* vsb = VsT + (size_t)bg * 64 * SEQ;
        const LAS bf16* OF = (const LAS bf16*)(wl + AW_QS); const LAS float* LF = (const LAS float*)(wl + AW_IMP + 8192);
#pragma unroll 1
        for (int tt = 0; tt < 16; ++tt) {
            const int tq = t0 + tt; const size_t qrow = (size_t)b * SEQ + tq;
            bf16x8_t Qh[2];
#pragma unroll
            for (int ks = 0; ks < 2; ++ks) { Qh[ks] = ldg8(QB + qrow * LDQ + (g * 4 + (col & 3)) * 64 + ks * 32 + fq * 8); if (col >= 4) Qh[ks] = (bf16x8_t){0, 0, 0, 0, 0, 0, 0, 0}; }
            f32x4 Os[4] = {z4, z4, z4, z4}; float ls = 0.f;
#ifdef APROBE_SEL
            for (int rp = 0; rp < 2; ++rp) { Os[0] = z4; Os[1] = z4; Os[2] = z4; Os[3] = z4; ls = 0.f; asm volatile("" ::: "memory");
#endif
#pragma unroll 1
            for (int r8 = 0; r8 < 8; ++r8) {
                const int j = __builtin_amdgcn_readfirstlane(SEL[tt * 8 + r8]);
                if (64 * j > tq || j == 0 || j == cur || j == cur - 1) continue;
                const int kb0 = 64 * j;
                bf16x8_t ka[2][2][2], va[2][4];
#pragma unroll
                for (int hf = 0; hf < 2; ++hf) {
#pragma unroll
                    for (int tl = 0; tl < 2; ++tl)
#pragma unroll
                        for (int ks = 0; ks < 2; ++ks) ka[hf][tl][ks] = ldg8(ksb + ((size_t)(4 * ks + fq) * SEQ + kb0 + 32 * hf + 16 * tl + col) * 8);
#pragma unroll
                    for (int mt = 0; mt < 4; ++mt) va[hf][mt] = ldg8(vsb + ((size_t)(((kb0 + 32 * hf) >> 3) + fq) * 64 + 16 * mt + col) * 8);
                }
#pragma unroll
                for (int hf = 0; hf < 2; ++hf) {
                    f32x4 sa = MFMA16(ka[hf][0][0], Qh[0], z4); sa = MFMA16(ka[hf][0][1], Qh[1], sa);
                    f32x4 sb = MFMA16(ka[hf][1][0], Qh[0], z4); sb = MFMA16(ka[hf][1][1], Qh[1], sb);
#pragma unroll
                    for (int i = 0; i < 4; ++i) { sa[i] = __builtin_amdgcn_exp2f(sa[i]); sb[i] = __builtin_amdgcn_exp2f(sb[i]); }
                    ls += (sa[0] + sa[1]) + (sa[2] + sa[3]) + (sb[0] + sb[1]) + (sb[2] + sb[3]);
                    const bf16x8_t pt = pack_p(sa, sb);
#pragma unroll
                    for (int mt = 0; mt < 4; ++mt) Os[mt] = MFMA16(va[hf][mt], pt, Os[mt]);
                }
            }
#ifdef APROBE_SEL
            }
#endif
            ls += bperm_f(ls, lane ^ 16); ls += bperm_f(ls, lane ^ 32);
            if (col < 4) {
                const float den = ls + LF[tt * 4 + col]; const float w = den > 0.f ? (NG + qrow * 24 + g * 12)[col * 3 + 1] / den : 0.f;
#pragma unroll
                for (int mt = 0; mt < 4; ++mt) { const int e = (tt * 4 + col) * 64 + 16 * mt + 4 * fq; const v2u old = *(const LAS v2u*)(OS + e), fo = *(const LAS v2u*)(OF + e);
                    v2u w2; w2.x = cvt_pk_bf16(blo(old.x) + w * (Os[mt][0] + blo(fo.x)), bhi(old.x) + w * (Os[mt][1] + bhi(fo.x))); w2.y = cvt_pk_bf16(blo(old.y) + w * (Os[mt][2] + blo(fo.y)), bhi(old.y) + w * (Os[mt][3] + bhi(fo.y)));
                    *(v2u*)(QB + qrow * LDQ + (g * 4 + col) * 64 + 16 * mt + 4 * fq) = w2; }
            }
        }
    }
    LDS_WAIT(); asm volatile("" ::: "memory");
#undef Qc
}

typedef _Float16 h16x2 __attribute__((ext_vector_type(2)));
__device__ __forceinline__ h16x2 as_h2(unsigned u) { h16x2 r; __builtin_memcpy(&r, &u, 4); return r; }
constexpr int SC_STEPS = 8, SC_BUF = 6 * 1024;
__device__ __forceinline__ float dpp_sum16(float v) {
    v += __builtin_bit_cast(float, __builtin_amdgcn_update_dpp(0, __builtin_bit_cast(int, v), 0xB1, 0xF, 0xF, true));
    v += __builtin_bit_cast(float, __builtin_amdgcn_update_dpp(0, __builtin_bit_cast(int, v), 0x4E, 0xF, 0xF, true));
    v += __builtin_bit_cast(float, __builtin_amdgcn_update_dpp(0, __builtin_bit_cast(int, v), 0x141, 0xF, 0xF, true));
    v += __builtin_bit_cast(float, __builtin_amdgcn_update_dpp(0, __builtin_bit_cast(int, v), 0x140, 0xF, 0xF, true));
    return v;
}
__device__ __forceinline__ void scan_fill(const bf16* RW, const bf16* Wm, const bf16* Am, size_t trow, int h, int lane, LAS unsigned char* buf) {
    const size_t t = trow + (lane >> 3); const int sub = (lane & 7) * 8;
    const bf16* row = RW + t * LDRW + h * 64 + sub;
    __builtin_amdgcn_global_load_lds((const unsigned*)(row + LBLK), (LAS unsigned*)(buf + 0 * 1024), 16, 0, 0);
    __builtin_amdgcn_global_load_lds((const unsigned*)(Am + t * RC + h * 64 + sub), (LAS unsigned*)(buf + 1 * 1024), 16, 0, 0);
    __builtin_amdgcn_global_load_lds((const unsigned*)(Wm + t * RC + h * 64 + sub), (LAS unsigned*)(buf + 2 * 1024), 16, 0, 0);
    __builtin_amdgcn_global_load_lds((const unsigned*)(row + 512), (LAS unsigned*)(buf + 3 * 1024), 16, 0, 0);
    __builtin_amdgcn_global_load_lds((const unsigned*)(row), (LAS unsigned*)(buf + 4 * 1024), 16, 0, 0);
    __builtin_amdgcn_global_load_lds((const unsigned*)(row + 1024), (LAS unsigned*)(buf + 5 * 1024), 16, 0, 0);
}
__device__ __forceinline__ void scan_unit(const P& p, int unit, int lane, LAS unsigned char* wl) {
    const bf16* RW = WSP(bf16, AR_RW); const bf16* Wm = WSP(bf16, AR_W); const bf16* Am = WSP(bf16, AR_A); bf16* Y = WSP(bf16, AR_UB);
    const int rg = unit & 15, h = (unit >> 4) & 7, b = unit >> 7, row = rg * 4 + (lane >> 4), kq = lane & 15;
    const size_t tb = (size_t)b * SEQ;
    float s0 = 0.f, s1 = 0.f, s2 = 0.f, s3 = 0.f;
    __builtin_amdgcn_s_setprio(3);
    scan_fill(RW, Wm, Am, tb, h, lane, wl);
#pragma unroll 1
    for (int c = 0; c < SEQ / SC_STEPS; ++c) {
        LAS unsigned char* buf = wl + (c & 1) * SC_BUF;
        asm volatile("s_waitcnt vmcnt(0) lgkmcnt(0)" ::: "memory");
        if (c + 1 < SEQ / SC_STEPS) scan_fill(RW, Wm, Am, tb + (size_t)(c + 1) * SC_STEPS, h, lane, wl + ((c + 1) & 1) * SC_BUF);
#ifndef SCAN_VARB
        float ys[SC_STEPS];
#pragma unroll
        for (int st = 0; st < SC_STEPS; ++st) {
            const LAS unsigned char* o = buf + st * 128 + kq * 8;
            const v2u kkw = *(const LAS v2u*)(o), bbw = *(const LAS v2u*)(o + 1024), eew = *(const LAS v2u*)(o + 2048), ktw = *(const LAS v2u*)(o + 3072), rrw = *(const LAS v2u*)(o + 4096);
#ifdef SCAN_BF16
            struct F2 { float x, y; }; const F2 kk0{blo(kkw.x), bhi(kkw.x)}, kk1{blo(kkw.y), bhi(kkw.y)}, bb0{blo(bbw.x), bhi(bbw.x)}, bb1{blo(bbw.y), bhi(bbw.y)}, ee0{blo(eew.x), bhi(eew.x)}, ee1{blo(eew.y), bhi(eew.y)}, kt0{blo(ktw.x), bhi(ktw.x)}, kt1{blo(ktw.y), bhi(ktw.y)}, rr0{blo(rrw.x), bhi(rrw.x)}, rr1{blo(rrw.y), bhi(rrw.y)};
            const float vv = bf2f(*(const LAS unsigned short*)(buf + 5 * 1024 + st * 128 + row * 2));
#else
            const h16x2 kk0 = as_h2(kkw.x), kk1 = as_h2(kkw.y), bb0 = as_h2(bbw.x), bb1 = as_h2(bbw.y);
            const h16x2 ee0 = as_h2(eew.x), ee1 = as_h2(eew.y);
#ifdef RKV_BF16
            struct F2 { float x, y; }; const F2 kt0{blo(ktw.x), bhi(ktw.x)}, kt1{blo(ktw.y), bhi(ktw.y)}, rr0{blo(rrw.x), bhi(rrw.x)}, rr1{blo(rrw.y), bhi(rrw.y)};
            const float vv = bf2f(*(const LAS unsigned short*)(buf + 5 * 1024 + st * 128 + row * 2));
#else
            const h16x2 kt0 = as_h2(ktw.x), kt1 = as_h2(ktw.y);
            const h16x2 rr0 = as_h2(rrw.x), rr1 = as_h2(rrw.y);
            const float vv = (float)__builtin_bit_cast(_Float16, *(const LAS unsigned short*)(buf + 5 * 1024 + st * 128 + row * 2));
#endif
#endif
            float d0 = __builtin_fmaf(s0, (float)kk0.x, 0.f); d0 = __builtin_fmaf(s1, (float)kk0.y, d0); float d1 = __builtin_fmaf(s2, (float)kk1.x, 0.f); d1 = __builtin_fmaf(s3, (float)kk1.y, d1);
            const float nskk = -dpp_sum16(d0 + d1);
            s0 = __builtin_fmaf(s0, -(float)ee0.x, s0); s1 = __builtin_fmaf(s1, -(float)ee0.y, s1); s2 = __builtin_fmaf(s2, -(float)ee1.x, s2); s3 = __builtin_fmaf(s3, -(float)ee1.y, s3);
            s0 = __builtin_fmaf(nskk, (float)bb0.x, s0); s1 = __builtin_fmaf(nskk, (float)bb0.y, s1); s2 = __builtin_fmaf(nskk, (float)bb1.x, s2); s3 = __builtin_fmaf(nskk, (float)bb1.y, s3);
            s0 = __builtin_fmaf(vv, (float)kt0.x, s0); s1 = __builtin_fmaf(vv, (float)kt0.y, s1); s2 = __builtin_fmaf(vv, (float)kt1.x, s2); s3 = __builtin_fmaf(vv, (float)kt1.y, s3);
            float y0 = __builtin_fmaf(s0, (float)rr0.x, 0.f); y0 = __builtin_fmaf(s1, (float)rr0.y, y0); float y1 = __builtin_fmaf(s2, (float)rr1.x, 0.f); y1 = __builtin_fmaf(s3, (float)rr1.y, y1);
            ys[st] = dpp_sum16(y0 + y1);
        }
        if (kq < SC_STEPS) { float yv = ys[0];
#pragma unroll
            for (int st = 1; st < SC_STEPS; ++st) yv = (kq == st) ? ys[st] : yv;
            Y[(tb + (size_t)c * SC_STEPS + kq) * RC + h * 64 + row] = f2bf(yv); }
    }
#else
#pragma unroll
        for (int st = 0; st < SC_STEPS; ++st) {
            const LAS unsigned char* o = buf + st * 128 + kq * 8;
            float kk[4], bb[4], ee[4], kt[4], rr[4];
            { const v2u w = *(const LAS v2u*)(o); const h16x2 a = as_h2(w.x), b2 = as_h2(w.y); kk[0] = (float)a.x; kk[1] = (float)a.y; kk[2] = (float)b2.x; kk[3] = (float)b2.y; }
            { const v2u w = *(const LAS v2u*)(o + 1024); const h16x2 a = as_h2(w.x), b2 = as_h2(w.y); bb[0] = (float)a.x; bb[1] = (float)a.y; bb[2] = (float)b2.x; bb[3] = (float)b2.y; }
            { const v2u w = *(const LAS v2u*)(o + 2048); const h16x2 a = as_h2(w.x), b2 = as_h2(w.y); ee[0] = (float)a.x; ee[1] = (float)a.y; ee[2] = (float)b2.x; ee[3] = (float)b2.y; }
            { const v2u w = *(const LAS v2u*)(o + 3072); const h16x2 a = as_h2(w.x), b2 = as_h2(w.y); kt[0] = (float)a.x; kt[1] = (float)a.y; kt[2] = (float)b2.x; kt[3] = (float)b2.y; }
            { const v2u w = *(const LAS v2u*)(o + 4096); const h16x2 a = as_h2(w.x), b2 = as_h2(w.y); rr[0] = (float)a.x; rr[1] = (float)a.y; rr[2] = (float)b2.x; rr[3] = (float)b2.y; }
            const float vv = (float)__builtin_bit_cast(_Float16, *(const LAS unsigned short*)(buf + 5 * 1024 + st * 128 + row * 2));
            const float skk = dpp_sum16((s0 * kk[0] + s1 * kk[1]) + (s2 * kk[2] + s3 * kk[3]));
            s0 = s0 - s0 * ee[0] - skk * bb[0] + vv * kt[0]; s1 = s1 - s1 * ee[1] - skk * bb[1] + vv * kt[1]; s2 = s2 - s2 * ee[2] - skk * bb[2] + vv * kt[2]; s3 = s3 - s3 * ee[3] - skk * bb[3] + vv * kt[3];
            const float y = dpp_sum16((s0 * rr[0] + s1 * rr[1]) + (s2 * rr[2] + s3 * rr[3]));
            if (kq == 0) Y[(tb + (size_t)c * SC_STEPS + st) * RC + h * 64 + row] = f2bf(y);
        }
    }
#endif
    asm volatile("s_waitcnt vmcnt(0) lgkmcnt(0)" ::: "memory");
    __builtin_amdgcn_s_setprio(0);
}
__device__ __forceinline__ float sum8(float v) {
    v += __builtin_bit_cast(float, __builtin_amdgcn_update_dpp(0, __builtin_bit_cast(int, v), 0xB1, 0xF, 0xF, true));
    v += __builtin_bit_cast(float, __builtin_amdgcn_update_dpp(0, __builtin_bit_cast(int, v), 0x4E, 0xF, 0xF, true));
    v += __builtin_bit_cast(float, __builtin_amdgcn_update_dpp(0, __builtin_bit_cast(int, v), 0x141, 0xF, 0xF, true));
    return v;
}
__device__ __forceinline__ void up8(v4u w, float* f) { f[0] = blo(w.x); f[1] = bhi(w.x); f[2] = blo(w.y); f[3] = bhi(w.y); f[4] = blo(w.z); f[5] = bhi(w.z); f[6] = blo(w.w); f[7] = bhi(w.w); }
#ifdef SCAN_BF16
#define uph8 up8
#define pkh8 pk8
#else
#define uph8 uph8_
#define pkh8 pkh8_
#endif
__device__ __forceinline__ void uph8_(v4u w, float* f) { const h16x2 a = as_h2(w.x), b = as_h2(w.y), c = as_h2(w.z), d = as_h2(w.w);
    f[0] = (float)a.x; f[1] = (float)a.y; f[2] = (float)b.x; f[3] = (float)b.y; f[4] = (float)c.x; f[5] = (float)c.y; f[6] = (float)d.x; f[7] = (float)d.y; }
__device__ __forceinline__ unsigned pkh2(float lo, float hi) { h16x2 v; v.x = (_Float16)lo; v.y = (_Float16)hi; return __builtin_bit_cast(unsigned, v); }
__device__ __forceinline__ v4u pkh8_(const float* f) { v4u w; w.x = pkh2(f[0], f[1]); w.y = pkh2(f[2], f[3]); w.z = pkh2(f[4], f[5]); w.w = pkh2(f[6], f[7]); return w; }
__device__ __forceinline__ v4u pk8(const float* f) { v4u w; w.x = cvt_pk_bf16(f[0], f[1]); w.y = cvt_pk_bf16(f[2], f[3]); w.z = cvt_pk_bf16(f[4], f[5]); w.w = cvt_pk_bf16(f[6], f[7]); return w; }
__device__ __forceinline__ void ldf8(const float* p, float* f) { const f32x4 a = *(const f32x4*)p, b = *(const f32x4*)(p + 4); f[0] = a[0]; f[1] = a[1]; f[2] = a[2]; f[3] = a[3]; f[4] = b[0]; f[5] = b[1]; f[6] = b[2]; f[7] = b[3]; }

struct EpiLora {
    static constexpr bool PERM = true, AFTER_DRAIN = false;
    unsigned char* ws;
    __device__ __forceinline__ void operator()(const f32x4 (&acc)[2][2][4][2], const Unit& u, int wr, int wc, int fr, int fq) const {
        const int which = u.pn >> 1, row0 = u.pm * BM + wr * 64 + fr, c0 = (u.pn & 1) * 256 + wc * 32 + 8 * fq;
        bf16* const O = (bf16*)(ws + (which == 0 ? AR_W : (which == 1 ? AR_A : (which == 2 ? AR_G : AR_UB))));
#pragma unroll
        for (int ai = 0; ai < 2; ++ai)
#pragma unroll
            for (int m = 0; m < 4; ++m)
#pragma unroll
                for (int bj = 0; bj < 2; ++bj) *(u32x4*)(O + (size_t)(row0 + ai * HALF + m * 16) * RC + c0 + bj * HALF) = pack8(acc[ai][bj][m][0], acc[ai][bj][m][1]);
    }
};
#ifdef RKV_BF16
#define UPR up8
#define PKR pk8
#else
#define UPR uph8
#define PKR pkh8
#endif
struct B2In { v4u k, a, w, vr, vv, vf; float gt; };
__device__ __forceinline__ void b2w_load(B2In& in, const P& p, int layer, int t, int lane) {
    const bf16* row = WSP(bf16, AR_RW) + (size_t)t * LDRW;
    in.k = *(const v4u*)(row + 512 + 8 * lane); in.a = *(const v4u*)(WSP(bf16, AR_A) + (size_t)t * RC + 8 * lane); in.w = *(const v4u*)(WSP(bf16, AR_W) + (size_t)t * RC + 8 * lane);
    in.gt = lane < 24 ? bf2f(row[LBLK + 320 + lane]) : 0.f;
    if (layer == 1) { in.vr = *(const v4u*)(WSP(bf16, AR_UB) + (size_t)t * RC + 8 * lane); in.vv = *(const v4u*)(row + 1024 + 8 * lane); in.vf = *(const v4u*)(WSP(bf16, WS_VF) + (size_t)t * RC + 8 * lane); }
}
__device__ __forceinline__ void b2w_compute(const B2In& in, const P& p, int layer, int t, int lane, const float* v0, const float* v1, const float* v2, const float* v3, const float* vb) {
    bf16* row = WSP(bf16, AR_RW) + (size_t)t * LDRW; bf16* Am = WSP(bf16, AR_A); bf16* Wm = WSP(bf16, AR_W); float* NG = WSP(float, AR_NG);
    float k[8], a[8], w[8]; uph8(in.k, k); up8(in.a, a); up8(in.w, w);
    const float ngv = fsig(in.gt);
    float kk[8], ss = 0.f;
#pragma unroll
    for (int i = 0; i < 8; ++i) {
        a[i] = fsig(a[i] + v1[i]);
        const float nx = -(w[i] + v0[i]), sp = fmaxf(nx, 0.f) + __logf(1.f + __expf(-fabsf(nx))), e = __expf(-sp - 0.5f); w[i] = 1.f - __expf(-e);
        kk[i] = k[i] * v2[i]; ss += kk[i] * kk[i]; }
    ss = sum8(ss); const float nrm = sqrtf(ss), inv = 1.f / (nrm > 1e-12f ? nrm : 1e-12f);
#pragma unroll
    for (int i = 0; i < 8; ++i) { kk[i] *= inv; k[i] = k[i] * (1.f + (a[i] - 1.f) * v3[i]); a[i] *= kk[i]; }
    asm volatile("" :: "v"(ngv));
    if (layer == 1) { float vr[8], vv[8], vf[8]; up8(in.vr, vr); uph8(in.vv, vv); uph8(in.vf, vf);
#pragma unroll
        for (int i = 0; i < 8; ++i) vv[i] = vv[i] + (vf[i] - vv[i]) * fsig(vr[i] + vb[i]);
        *(v4u*)(row + 1024 + 8 * lane) = pkh8(vv); }
    if (lane < 24) NG[(size_t)t * 24 + lane] = ngv;
    *(v4u*)(row + LBLK + 8 * lane) = pkh8(kk); *(v4u*)(row + 512 + 8 * lane) = pkh8(k);
    *(v4u*)(Am + (size_t)t * RC + 8 * lane) = pkh8(a); *(v4u*)(Wm + (size_t)t * RC + 8 * lane) = pkh8(w);
}
__device__ __forceinline__ void ph_rwkv_b2w(const P& p, int layer, int gw, int NGW, int lane) {
    const float* vec = p.rwkv_vec + (size_t)layer * 7 * RC; float v0[8], v1[8], v2[8], v3[8], vb[8];
    ldf8(vec + 8 * lane, v0); ldf8(vec + RC + 8 * lane, v1); ldf8(vec + 2 * RC + 8 * lane, v2); ldf8(vec + 3 * RC + 8 * lane, v3); ldf8(p.vres_b + 8 * lane, vb);
    int t = gw; if (t >= T) return;
    B2In A, B; b2w_load(A, p, layer, t, lane);
    for (; t < T; t += 2 * NGW) { const int t1 = t + NGW, t2 = t1 + NGW;
        b2w_load(B, p, layer, t1 < T ? t1 : t, lane); b2w_compute(A, p, layer, t, lane, v0, v1, v2, v3, vb);
        if (t1 < T) { b2w_load(A, p, layer, t2 < T ? t2 : t1, lane); b2w_compute(B, p, layer, t1, lane, v0, v1, v2, v3, vb); } }
}
struct PoIn { v4u y, r, k, v, g; };
__device__ __forceinline__ void post_load(PoIn& in, const P& p, int t, int lane) { const bf16* row = WSP(bf16, AR_RW) + (size_t)t * LDRW;
    in.y = *(const v4u*)(WSP(bf16, AR_UB) + (size_t)t * RC + 8 * lane); in.r = *(const v4u*)(row + 8 * lane); in.k = *(const v4u*)(row + 512 + 8 * lane); in.v = *(const v4u*)(row + 1024 + 8 * lane); in.g = *(const v4u*)(WSP(bf16, AR_G) + (size_t)t * RC + 8 * lane); }
__device__ __forceinline__ void post_compute(const PoIn& in, const P& p, int t, int lane, const float* v4_, const float* v5, const float* v6) {
    float y[8], r[8], k[8], v[8], g[8]; up8(in.y, y); uph8(in.r, r); uph8(in.k, k); uph8(in.v, v); up8(in.g, g);
    float s = 0.f, bon = 0.f;
#pragma unroll
    for (int i = 0; i < 8; ++i) { s += y[i]; bon += r[i] * k[i] * v4_[i]; }
    const float m = sum8(s) * (1.f / 64.f); bon = sum8(bon);
    float q = 0.f;
#pragma unroll
    for (int i = 0; i < 8; ++i) { y[i] -= m; q += y[i] * y[i]; }
    const float rstd = 1.f / sqrtf(sum8(q) * (1.f / 64.f) + GN_EPS);
#pragma unroll
    for (int i = 0; i < 8; ++i) y[i] = (y[i] * rstd * v5[i] + v6[i] + bon * v[i]) * g[i];
    *(v4u*)(WSP(bf16, AR_A) + (size_t)t * RC + 8 * lane) = pk8(y);
}
__device__ __forceinline__ void ph_rwkv_postw(const P& p, int layer, int gw, int NGW, int lane) {
    const float* vec = p.rwkv_vec + (size_t)layer * 7 * RC; float v4_[8], v5[8], v6[8]; ldf8(vec + 4 * RC + 8 * lane, v4_); ldf8(vec + 5 * RC + 8 * lane, v5); ldf8(vec + 6 * RC + 8 * lane, v6);
    int t = gw; if (t >= T) return;
    PoIn A, B; post_load(A, p, t, lane);
    for (; t < T; t += 2 * NGW) { const int t1 = t + NGW, t2 = t1 + NGW;
        post_load(B, p, t1 < T ? t1 : t, lane); post_compute(A, p, t, lane, v4_, v5, v6);
        if (t1 < T) { post_load(A, p, t2 < T ? t2 : t1, lane); post_compute(B, p, t1, lane, v4_, v5, v6); } }
}
__device__ __forceinline__ void ph_convw(const P& p, int layer, int gw, int NGW, int lane, int tid, LAS unsigned char* lds) {
    const bf16* UB = WSP(bf16, AR_UB); bf16* CO = WSP(bf16, AR_CO);
    const float* cw = p.conv_w + (size_t)layer * CONV_K * CONV_CH; const float* cv = p.conv_vec + (size_t)layer * 3 * CONV_CH;
    LAS float* wl = (LAS float*)lds;
    for (int i = tid; i < CONV_K * CONV_CH; i += NTHREADS) wl[i] = cw[i];
    __syncthreads();
    float b0[8], g1[8], b2[8]; ldf8(cv + 8 * lane, b0); ldf8(cv + CONV_CH + 8 * lane, g1); ldf8(cv + 2 * CONV_CH + 8 * lane, b2);
    for (int tb = gw * 4; tb < T; tb += NGW * 4) {
        const int pos0 = tb % SEQ, j0 = pos0 >= 30 ? 0 : 30 - pos0;
        float a[4][8], wt[4][8];
#pragma unroll
        for (int q = 0; q < 4; ++q)
#pragma unroll
            for (int i = 0; i < 8; ++i) a[q][i] = b0[i];
#pragma unroll 1
        for (int j4 = 0; j4 < CONV_K + 3; j4 += 4) {
#pragma unroll
            for (int jj = 0; jj < 4; ++jj) { const int j = j4 + jj;
                if (j < CONV_K) { const f32x4 w0 = *(const LAS f32x4*)(wl + j * CONV_CH + 8 * lane), w1 = *(const LAS f32x4*)(wl + j * CONV_CH + 8 * lane + 4);
#pragma unroll
                    for (int i = 0; i < 4; ++i) { wt[jj][i] = w0[i]; wt[jj][4 + i] = w1[i]; } }
                float u[8];
                if (j >= j0 && j < CONV_K + 3) up8(*(const v4u*)(UB + (size_t)(tb - 30 + j) * CONV_CH + 8 * lane), u); else {
#pragma unroll
                    for (int i = 0; i < 8; ++i) u[i] = 0.f; }
#pragma unroll
                for (int q = 0; q < 4; ++q) { const int tap = j - q; if (tap >= 0 && tap < CONV_K) {
#pragma unroll
                    for (int i = 0; i < 8; ++i) a[q][i] += u[i] * wt[(jj - q) & 3][i]; } }
            }
        }
#pragma unroll
        for (int q = 0; q < 4; ++q) {
            float s = 0.f;
#pragma unroll
            for (int i = 0; i < 8; ++i) s += a[q][i];
            const float mean = wave_sum(s, lane) * (1.f / CONV_CH); float qq = 0.f;
#pragma unroll
            for (int i = 0; i < 8; ++i) { a[q][i] -= mean; qq += a[q][i] * a[q][i]; }
            const float rstd = 1.f / sqrtf(wave_sum(qq, lane) * (1.f / CONV_CH) + LN_EPS);
#pragma unroll
            for (int i = 0; i < 8; ++i) { const float y = a[q][i] * rstd * g1[i] + b2[i]; a[q][i] = y * fsig(y); }
            *(v4u*)(CO + (size_t)(tb + q) * CONV_CH + 8 * lane) = pk8(a[q]);
        }
    }
    __syncthreads();
}
__device__ __forceinline__ void ph_cmp2w(const P& p, int layer, int gw, int NGW, int lane, LAS float* hl  ) {
    const bf16* Z = WSP(bf16, AR_HID); const float* pec = (const float*)(p.ws + WS_W + (size_t)layer * SZ_LAYERW + OFF_PEC);
    for (int it = gw; it < 2 * BATCH * NKV * NC; it += NGW) {
        const int i = it % NC, r = it / NC, bg = r % (BATCH * NKV), which = r / (BATCH * NKV);
        const bf16* z1 = Z + ((size_t)which * (BATCH * NKV * 512) + (size_t)bg * 512 + i) * 256; const bf16* z2 = z1 + 256 + 128;
#pragma unroll
        for (int jj = 0; jj < 2; ++jj) { const int j = lane + 64 * jj; const float x = bf2f(z1[j]) + bf2f(z2[j]) + pec[which * 128 + j];
            const float e = __expf(fminf(2.f * 0.7978845608028654f * (x + 0.044715f * x * x * x), 30.f)); hl[j] = 0.5f * x * (1.f + (e - 1.f) / (e + 1.f)); }
        LDS_WAIT(); asm volatile("" ::: "memory");
        const float* w2 = p.cmp_w2 + (size_t)(layer * 2 + which) * 128 * 64 + lane; float o = 0.f;
#pragma unroll 8
        for (int j = 0; j < 128; ++j) o += hl[j] * w2[j * 64];
        if (which == 0) {
            const float rs = 1.f / sqrtf(wave_sum(o * o, lane) * (1.f / 64.f) + RMS_EPS); o = o * rs * p.qk_g[(layer * 4 + 1) * 64 + lane];
            const float other = bperm_f(o, lane ^ 32); float cs, sn; rope_cs(16 * i + 31, lane & 31, cs, sn);
            o = lane < 32 ? o * cs - other * sn : o * cs + other * sn;
            WSP(bf16, AR_KC)[(((size_t)bg * 8 + (lane >> 3)) * 512 + i) * 8 + (lane & 7)] = f2bf(o);
        } else { bf16* vt = WSP(bf16, AR_VCT) + (size_t)bg * 64 * 512 + lane * 8;
            vt[(size_t)((i >> 5) * 4 + ((i & 15) >> 2)) * 512 + (i & 3) + 4 * ((i >> 4) & 1)] = f2bf(o); if (i == 0) vt[(size_t)((NC >> 5) * 4 + ((NC & 15) >> 2)) * 512 + (NC & 3) + 4 * ((NC >> 4) & 1)] = 0; }
        LDS_WAIT(); asm volatile("" ::: "memory");
    }
}

struct MapPlain { bf16* base; int K; __device__ __forceinline__ bf16* operator()(int col) const { return base + (size_t)col * K; } };
struct MapGlu { bf16* base; int K, ff; __device__ __forceinline__ bf16* operator()(int col) const { return base + (size_t)glu_dest(col, ff) * K; } };
struct MapWin { unsigned char* wl; int layer; __device__ __forceinline__ bf16* operator()(int col) const { int which; const int r = win_dest(col, layer, which); const size_t off = (which ? OFF_WG : OFF_WIN) + (size_t)(r < 0 ? 0 : r) * DM * 2; return r < 0 ? nullptr : (bf16*)(wl + off); } };
template <class Map>
__device__ __forceinline__ void transpose_item(const float* W, int K, int N, const Map& mp, LAS float* scr, int item, int lane) {
    const int nblk = (N + 31) / 32, kb = item / nblk, nb = item % nblk, k0 = 64 * kb, n0 = 32 * nb;
    const int col = n0 + (lane & 31);
#pragma unroll 8
    for (int i = 0; i < 32; ++i) { const int kk = 2 * i + (lane >> 5); scr[kk * 33 + (lane & 31)] = col < N ? W[(size_t)(k0 + kk) * N + col] : 0.f; }
    LDS_WAIT(); asm volatile("" ::: "memory");
    const int c = lane & 7;
#pragma unroll
    for (int j = 0; j < 4; ++j) { const int n = (lane >> 3) + 8 * j; const LAS float* s = scr + (8 * c) * 33 + n;
        v4u o; o.x = (unsigned)f2bf(s[0]) | ((unsigned)f2bf(s[33]) << 16); o.y = (unsigned)f2bf(s[66]) | ((unsigned)f2bf(s[99]) << 16);
        o.z = (unsigned)f2bf(s[132]) | ((unsigned)f2bf(s[165]) << 16); o.w = (unsigned)f2bf(s[198]) | ((unsigned)f2bf(s[231]) << 16);
        if (n0 + n < N) { bf16* d = mp(n0 + n); if (d) *(v4u*)(d + k0 + 8 * c) = o; } }
    LDS_WAIT(); asm volatile("" ::: "memory");
}
template <class Map>
__device__ __forceinline__ bool conv_job(int& r, const float* W, int K, int N, const Map& mp, LAS float* scr, int lane) {
    const int items = (K / 64) * ((N + 31) / 32);
    if (r < items) { transpose_item(W, K, N, mp, scr, r, lane); return true; }
    r -= items; return false;
}

struct RmsIn { f32x4 v[DM / 256]; };
__device__ __forceinline__ void rms_load(RmsIn& r, const float* xrow, int lane) { const f32x4* xr = (const f32x4*)xrow + lane;
#pragma unroll
    for (int j = 0; j < DM / 256; ++j) r.v[j] = xr[64 * j]; }
__device__ __forceinline__ void rms_row(const P& p, const RmsIn& rin, const float* g, bf16* orow, int lane, bool route, int t, unsigned long long& c0, unsigned long long& c1) {
    const f32x4* gr = (const f32x4*)g + lane;
    f32x4 v[DM / 256]; float ss = 0.f;
#pragma unroll
    for (int j = 0; j < DM / 256; ++j) { v[j] = rin.v[j]; ss += (v[j].x * v[j].x + v[j].y * v[j].y) + (v[j].z * v[j].z + v[j].w * v[j].w); }
    const float rs = 1.f / sqrtf(wave_sum(ss, lane) * (1.f / DM) + RMS_EPS);
    v2u* o8 = (v2u*)orow + lane;
#pragma unroll
    for (int j = 0; j < DM / 256; ++j) { const f32x4 gg = gr[64 * j]; v[j].x *= rs * gg.x; v[j].y *= rs * gg.y; v[j].z *= rs * gg.z; v[j].w *= rs * gg.w;
        v2u w; w.x = cvt_pk_bf16(v[j].x, v[j].y); w.y = cvt_pk_bf16(v[j].z, v[j].w); o8[64 * j] = w; }
    if (route) {
        float lg[NEXP];
#pragma unroll
        for (int e = 0; e < NEXP; ++e) lg[e] = 0.f;
#pragma unroll
        for (int j = 0; j < DM / 256; ++j) { const float* rw = p.router_w + (size_t)(4 * (lane + 64 * j)) * NEXP;
#pragma unroll
            for (int e = 0; e < NEXP; ++e) lg[e] += v[j].x * rw[e] + v[j].y * rw[NEXP + e] + v[j].z * rw[2 * NEXP + e] + v[j].w * rw[3 * NEXP + e]; }
#pragma unroll
        for (int e = 0; e < NEXP; ++e) lg[e] = wave_sum(lg[e], lane) + p.router_b[e];
        int e0 = 0; float l0 = lg[0];
#pragma unroll
        for (int e = 1; e < NEXP; ++e) if (lg[e] > l0) { l0 = lg[e]; e0 = e; }
        int e1 = -1; float l1 = -3e38f;
#pragma unroll
        for (int e = 0; e < NEXP; ++e) if (e != e0 && lg[e] > l1) { l1 = lg[e]; e1 = e; }
        e0 = __builtin_amdgcn_readfirstlane(e0); e1 = __builtin_amdgcn_readfirstlane(e1);
        const int r0 = (int)((c0 >> (8 * e0)) & 255ull), r1 = (int)((c1 >> (8 * e1)) & 255ull);
        c0 += 1ull << (8 * e0); c1 += 1ull << (8 * e1);
        if (lane == 0) { const float w0 = 1.f / (1.f + expf(l1 - l0));
            WSP(int, AR_RTE)[t] = e0 | (e1 << 8) | (r0 << 16) | (r1 << 24); float* rw = WSP(float, AR_RTW) + (size_t)t * 2; rw[0] = w0; rw[1] = 1.f - w0; }
    }
}
__device__ __forceinline__ void copy_rows4(const bf16* s0, const bf16* s1, const bf16* s2, const bf16* s3, bf16* d0, bf16* d1, bf16* d2, bf16* d3, int lane) {
    v4u a[4][DM / 512];
#pragma unroll
    for (int j = 0; j < DM / 512; ++j) { a[0][j] = ((const v4u*)s0)[lane + 64 * j]; a[1][j] = ((const v4u*)s1)[lane + 64 * j]; a[2][j] = ((const v4u*)s2)[lane + 64 * j]; a[3][j] = ((const v4u*)s3)[lane + 64 * j]; }
#pragma unroll
    for (int j = 0; j < DM / 512; ++j) { ((v4u*)d0)[lane + 64 * j] = a[0][j]; ((v4u*)d1)[lane + 64 * j] = a[1][j]; ((v4u*)d2)[lane + 64 * j] = a[2][j]; ((v4u*)d3)[lane + 64 * j] = a[3][j]; }
}
__device__ __forceinline__ void copy_row_wave(const bf16* src, bf16* dst, int lane) {
#pragma unroll
    for (int j = 0; j < DM / 512; ++j) ((v4u*)dst)[lane + 64 * j] = ((const v4u*)src)[lane + 64 * j];
}
__device__ __forceinline__ int moe_seg_start(const unsigned* cnt, int e) { int s = 0;
#pragma unroll
    for (int k = 0; k < NEXP; ++k) s += (k < e) ? (int)((cnt[k] + 255u) & ~255u) : 0;
    return s; }

#ifndef PHMASK
#define PHMASK 0xFFFFFFFFu
#endif
#define PHM(k) (((PHMASK) >> (k)) & 1u)
#ifdef PROBE_LO
constexpr int PR_LO = PROBE_LO, PR_HI = PROBE_HI;
#else
constexpr int PR_LO = -1, PR_HI = -1;
#endif
constexpr int NPH = 16, NPHASES = 1 + 2 * NPH;
struct Args { const float* in[29]; float* out; unsigned char* ws; int ph_lo, ph_hi; };

__device__ __forceinline__ bool in_phase(int k, int lo, int hi) { asm volatile("" : "+s"(lo), "+s"(hi)); return lo <= k && k < hi; }
typedef const Args __attribute__((address_space(4)))* CArgsP;
__device__ __forceinline__ void fill_params_k(P& p, CArgsP a) {
    p.x = a->in[0]; p.mix_norm_g = a->in[1]; p.w_in_first = a->in[2]; p.w_in_rest = a->in[3]; p.mu_first = a->in[4]; p.mu_rest = a->in[5]; p.qk_g = a->in[6]; p.cmp_pos = a->in[7];
    p.cmp_w1 = a->in[8]; p.cmp_w2 = a->in[9]; p.nsa_w_o = a->in[10]; p.conv_w = a->in[11]; p.conv_vec = a->in[12]; p.conv_w_o = a->in[13]; p.rwkv_vec = a->in[14]; p.w_up = a->in[15];
    p.a_up = a->in[16]; p.g_up = a->in[17]; p.vres_up = a->in[18]; p.vres_b = a->in[19]; p.rwkv_w_o = a->in[20]; p.w_out = a->in[21]; p.ffn_norm_g = a->in[22]; p.dense_gu = a->in[23];
    p.dense_down = a->in[24]; p.router_w = a->in[25]; p.router_b = a->in[26]; p.moe_gu = a->in[27]; p.moe_down = a->in[28]; p.out = a->out; p.ws = a->ws;
}
__global__ void __launch_bounds__(NTHREADS, 2) mk_fwd(Args args) {
    extern __shared__ __attribute__((aligned(16))) unsigned char lds_raw[];
    LAS unsigned char* lds = (LAS unsigned char*)lds_raw;
    const int wave0 = __builtin_amdgcn_readfirstlane((int)threadIdx.x >> 6);
    const int tid = wave0 * 64 + lane_id_opaque();
    unsigned* ctl = (unsigned*)(args.ws + WS_CTL);
    for (int u = tid; u < (LDS_BYTES - LDSCTL_OFF) / 4; u += NTHREADS) ((LAS unsigned*)(lds + LDSCTL_OFF))[u] = 0u;
    __syncthreads();
    const int lo = args.ph_lo, hi = args.ph_hi;
    XcdBarrier bar; bar.bar = ctl + CW_BAR; bar.x = 0; bar.st = nullptr;
    if (hi - lo > 1) { bar.x = xb_xcc_id(); bar.st = (volatile LAS unsigned*)(lds + MISC_OFF) + 8; if (tid == 0) (void)xb_add(ctl + CW_BAR + XB_XCNT(bar.x), 1u); }
#define RMS_LOOP(X, GN, ROUTE, C0, C1) do { int m_ = gw; if (m_ < T) { RmsIn ra_, rb_; rms_load(ra_, (X) + (size_t)m_ * DM, lane); \
        for (; m_ < T; m_ += 2 * NGW) { const int m1_ = m_ + NGW, m2_ = m1_ + NGW; rms_load(rb_, (X) + (size_t)(m1_ < T ? m1_ : m_) * DM, lane); \
            rms_row(p, ra_, (GN), WSP(bf16, WS_H) + (size_t)m_ * DM, lane, (ROUTE), m_, C0, C1); \
            if (m1_ < T) { rms_load(ra_, (X) + (size_t)(m2_ < T ? m2_ : m1_) * DM, lane); rms_row(p, rb_, (GN), WSP(bf16, WS_H) + (size_t)m1_ * DM, lane, (ROUTE), m1_, C0, C1); } } } } while (0)
#define IN(k) (in_phase((k), lo, hi) && (PR_LO < 0 || (st == 0 ? (k) <= PR_HI : (st == 1 ? ((k) >= PR_LO && (k) <= PR_HI) : (k) > PR_HI))))
#define MKP unsigned long long cdum0 = 0ull, cdum1 = 0ull; (void)cdum0; (void)cdum1; CArgsP ap_ = (CArgsP)__builtin_amdgcn_kernarg_segment_ptr(); asm volatile("" : "+s"(ap_)); P p; fill_params_k(p, ap_); int w0_ = wave0; asm volatile("" : "+s"(w0_)); int tid = w0_ * 64 + lane_id_opaque(); asm volatile("" : "+v"(tid)); const int lane = tid & 63, wave = __builtin_amdgcn_readfirstlane(tid >> 6); int G = gridDim.x, bid = blockIdx.x; asm volatile("" : "+s"(G), "+s"(bid)); unsigned* ctl = WSP(unsigned, WS_CTL); const long gtid = (long)bid * NTHREADS + tid, NT = (long)G * NTHREADS; const int gw = bid * NWAVES + wave, NGW = G * NWAVES; LAS float* scrw = (LAS float*)(lds + wave * 16384); (void)gtid; (void)NT; (void)gw; (void)NGW; (void)scrw; (void)lane; (void)ctl
#define SEAM(k) do { if ((k) + 1 < hi) { int w_ = wave0; asm volatile("" : "+s"(w_)); xcd_barrier(bar, w_ * 64 + lane_id_opaque()); } } while (0)

    for (int st = 0; st < (PR_LO >= 0 ? 3 : 1); ++st) {
    if (PHM(16) && IN(0)) { MKP;
        constexpr int IT_WIN0 = (DM / 64) * ((N_IN_FIRST + 31) / 32), IT_WIN1 = (DM / 64) * ((N_IN_REST + 31) / 32), IT_WO = (512 / 64) * (DM / 32), IT_WOUT = (DM / 64) * (DM / 32);
        constexpr int total = IT_WIN0 + IT_WIN1 + 6 * IT_WO + 2 * IT_WOUT + (DM / 64) * (2 * DENSE_FF / 32) + (DENSE_FF / 64) * (DM / 32);
        bf16* wl0 = WSP(bf16, WS_W); bf16* wl1 = WSP(bf16, WS_W + SZ_LAYERW);
#define WOFF(b, o) ((bf16*)((unsigned char*)(b) + (o)))
        for (int it = gw; it < total; it += NGW) {
            int r = it;
            if (conv_job(r, p.w_in_first, DM, N_IN_FIRST, MapWin{(unsigned char*)wl0, 0}, scrw, lane)) continue;
            if (conv_job(r, p.w_in_rest, DM, N_IN_REST, MapWin{(unsigned char*)wl1, 1}, scrw, lane)) continue;
            if (conv_job(r, p.nsa_w_o, 512, DM, MapPlain{WOFF(wl0, OFF_WO3), 512}, scrw, lane)) continue;
            if (conv_job(r, p.rwkv_w_o, 512, DM, MapPlain{WOFF(wl0, OFF_WO3) + (size_t)DM * 512, 512}, scrw, lane)) continue;
            if (conv_job(r, p.conv_w_o, 512, DM, MapPlain{WOFF(wl0, OFF_WO3) + (size_t)2 * DM * 512, 512}, scrw, lane)) continue;
            if (conv_job(r, p.nsa_w_o + (size_t)512 * DM, 512, DM, MapPlain{WOFF(wl1, OFF_WO3), 512}, scrw, lane)) continue;
            if (conv_job(r, p.rwkv_w_o + (size_t)512 * DM, 512, DM, MapPlain{WOFF(wl1, OFF_WO3) + (size_t)DM * 512, 512}, scrw, lane)) continue;
            if (conv_job(r, p.conv_w_o + (size_t)512 * DM, 512, DM, MapPlain{WOFF(wl1, OFF_WO3) + (size_t)2 * DM * 512, 512}, scrw, lane)) continue;
            if (conv_job(r, p.w_out, DM, DM, MapPlain{WOFF(wl0, OFF_WOUT), DM}, scrw, lane)) continue;
            if (conv_job(r, p.w_out + (size_t)DM * DM, DM, DM, MapPlain{WOFF(wl1, OFF_WOUT), DM}, scrw, lane)) continue;
            if (conv_job(r, p.dense_gu, DM, 2 * DENSE_FF, MapGlu{WSP(bf16, WS_DGU), DM, DENSE_FF}, scrw, lane)) continue;
            conv_job(r, p.dense_down, DENSE_FF, DM, MapPlain{WSP(bf16, WS_DDN), DENSE_FF}, scrw, lane);
        }
        for (int l = 0; l < 2; ++l) {
            unsigned char* wlb = p.ws + WS_W + (size_t)l * SZ_LAYERW;
            bf16* win = (bf16*)(wlb + OFF_WIN);
            for (long i = gtid; i < 512L * DM; i += NT) { const int w = (int)(i / DM); const bool src = w < 288 || (w < 320 && l == 1) || (w >= 320 && w < 344); if (!src) win[(size_t)(3840 + w) * DM + i % DM] = 0; }
            bf16* lw = (bf16*)(wlb + OFF_LW);
            for (long i = gtid; i < 2048L * 384; i += NT) { const int n = (int)(i / 384), k = (int)(i % 384), blk = n >> 9, c = n & 511; float v = 0.f;
                if (blk == 0 && k < 64) v = p.w_up[((size_t)l * 64 + k) * RC + c]; else if (blk == 1 && k >= 64 && k < 128) v = p.a_up[((size_t)l * 64 + k - 64) * RC + c];
                else if (blk == 2 && k >= 128 && k < 288) v = p.g_up[((size_t)l * 160 + k - 128) * RC + c]; else if (blk == 3 && k >= 288 && k < 320 && l == 1) v = p.vres_up[(size_t)(k - 288) * RC + c];
                lw[i] = f2bf(v); }
            bf16* cw1 = (bf16*)(wlb + OFF_CW1);
            for (long i = gtid; i < 2L * 256 * 1024; i += NT) { const int k = (int)(i % 1024), n = (int)((i / 1024) % 256), which = (int)(i / (256 * 1024));
                cw1[i] = f2bf(p.cmp_w1[((size_t)(l * 2 + which) * 2048 + (n < 128 ? k : 1024 + k)) * 128 + (n & 127)]); }
            float* pec = (float*)(wlb + OFF_PEC);
            for (long i = gtid; i < 256; i += NT) { const int which = (int)(i >> 7), n = (int)(i & 127); const float* pe = p.cmp_pos + (size_t)(l * 2 + which) * 2048; const float* w1 = p.cmp_w1 + (size_t)(l * 2 + which) * 2048 * 128 + n;
                float s = 0.f; for (int k = 0; k < 2048; ++k) s += pe[k] * w1[(size_t)k * 128]; pec[i] = s; }
        }
    }

    for (int layer = 0; layer < 2; ++layer) {
        const int pb = 1 + layer * NPH;
        if (PHM(0) && IN(pb + 0)) { MKP;
            const float* xin = layer == 0 ? p.x : p.out;
            RMS_LOOP(xin, p.mix_norm_g + (size_t)layer * DM, false, cdum0, cdum1);
            SEAM(pb + 0);
        }
        if (PHM(1) && IN(pb + 1)) { MKP;
            Gemm g{WSP(bf16, WS_H), (const bf16*)(p.ws + WS_W + (size_t)layer * SZ_LAYERW + OFF_WIN), T, NPROJ, DM}; SOrder S; S.init(T, NPROJ, G, bid);
            EpiProj E{p.ws};
            pg8::gemm_phase<EpiProj, SOrder, true, true>(lds, g, S, E, tid);
            SEAM(pb + 1);
        }
        if (PHM(2) && IN(pb + 2)) { MKP;
            { Gemm g{WSP(bf16, AR_CKV), (const bf16*)(p.ws + WS_W + (size_t)layer * SZ_LAYERW + OFF_CW1), 2 * BATCH * NKV * 512, 512, 1024, 0}; StackOrder S{BATCH * NKV * 512 / 256, 1, 2, G, bid};
              EpiStore E{WSP(bf16, AR_HID), 256, 1};
              pg8::gemm_phase<EpiStore, StackOrder, true, true>(lds, g, S, E, tid); }
            ph_shift(p, layer, gtid, NT); ph_nsa_prep(p, layer, gtid, NT); ph_vtrans(p, gtid, NT);
            ph_convw(p, layer, gw, NGW, lane, tid, lds);
#ifdef APROBE_CONV
            ph_convw(p, layer, gw, NGW, lane, tid, lds);
#endif
#ifdef APROBE_VT
            ph_vtrans(p, gtid, NT);
#endif
            SEAM(pb + 2); }
        if (PHM(3) && IN(pb + 3)) { MKP;
#ifndef LORA_NAIVE
            { Gemm g{WSP(bf16, WS_LB), (const bf16*)(p.ws + WS_W + (size_t)layer * SZ_LAYERW + OFF_LW), T, 2048, 384, 0}; SOrder S; S.init(T, 2048, G, bid);
              EpiLora E{p.ws};
              pg8::gemm_phase<EpiLora, SOrder, false, true>(lds, g, S, E, tid); }
#else
            { bf16* RW = WSP(bf16, AR_RW); bf16* Wm = WSP(bf16, AR_W); bf16* Am = WSP(bf16, AR_A); bf16* Gm = WSP(bf16, AR_G); const bf16* VF = WSP(bf16, WS_VF);
              const float* vec = p.rwkv_vec + (size_t)layer * 7 * RC; const float* wup = p.w_up + (size_t)layer * 64 * RC; const float* aup = p.a_up + (size_t)layer * 64 * RC; const float* gup = p.g_up + (size_t)layer * 160 * RC;
              for (long it = gtid; it < (long)T * RC; it += NT) { const int t = (int)(it / RC), c = (int)(it % RC); bf16* row = RW + (size_t)t * LDRW; const bf16* L = row + LBLK;
                  float wl = vec[c], alin = vec[RC + c], g = 0.f;
                  for (int j = 0; j < 64; ++j) { wl += bf2f(L[j]) * bf2f(f2bf(wup[j * RC + c])); alin += bf2f(L[64 + j]) * bf2f(f2bf(aup[j * RC + c])); }
                  for (int j = 0; j < 160; ++j) g += bf2f(L[128 + j]) * bf2f(f2bf(gup[j * RC + c]));
                  const float nx = -wl, sp = fmaxf(nx, 0.f) + __logf(1.f + __expf(-fabsf(nx))), e = __expf(-sp - 0.5f);
                  Wm[it] = f2bf(1.f - __expf(-e)); Am[it] = f2bf(fsig(alin)); Gm[it] = f2bf(g);
                  if (layer == 1) { float vl = p.vres_b[c]; for (int j = 0; j < 32; ++j) vl += bf2f(L[288 + j]) * bf2f(f2bf(p.vres_up[j * RC + c]));
                      const float v = bf2f(row[1024 + c]), vf = bf2f(VF[it]); row[1024 + c] = f2bf(v + (vf - v) * fsig(vl)); } } }
#endif
            SEAM(pb + 3); }
        if (PHM(4) && IN(pb + 4)) { MKP; ph_rwkv_b2w(p, layer, gw, NGW, lane); ph_cmp2w(p, layer, gw, NGW, lane, (LAS float*)(lds + wave * 512)); SEAM(pb + 4); }
        if (PHM(5) && IN(pb + 5)) { MKP;
            { LAS unsigned char* wl = lds + wave * AW_BYTES; constexpr int NSC = BATCH * 8 * 16, NIT = BATCH * NKV * (SEQ / 16);
#ifndef SCAN_QUEUE
              if (wave < 4) {
                  if (G * 4 == NSC && (G & 7) == 0) scan_unit(p, (bid & 7) * (NSC / 8) + (bid >> 3) * 4 + wave, lane, wl);
                  else for (int u = bid * 4 + wave; u < NSC; u += G * 4) scan_unit(p, u, lane, wl); }
#endif
#ifdef APROBE_SPLIT
              xcd_barrier(bar, tid);
#endif
              const int xme = (int)(xb_xcc_id() & 7u);
              for (int qq = 0; qq < 8; ++qq) { const int qx = (xme + qq) & 7; unsigned* head = ctl + CW_ATT + ((layer * 3 + st) * 8 + qx) * 16;
                  for (;;) { int it = 0; if (lane == 0) it = (int)atomicAdd(head, 1u); it = __builtin_amdgcn_readfirstlane(it); if (it >= NIT / 8) break;
                      const int bg = 2 * qx + it / (SEQ / 16), t16 = (SEQ / 16 - 1) - it % (SEQ / 16);
                      nsa_attn_item(p, bg * (SEQ / 16) + t16, lane, wl); } } }
 SEAM(pb + 5); }
        if (PHM(6) && IN(pb + 6)) { MKP; ph_rwkv_postw(p, layer, gw, NGW, lane); SEAM(pb + 6); }
        if (PHM(7) && IN(pb + 7)) { MKP;
            Gemm g{WSP(bf16, AR_QB), (const bf16*)(p.ws + WS_W + (size_t)layer * SZ_LAYERW + OFF_WO3), 3 * T, 3 * DM, 512}; StackOrder S{T / 256, DM / 256, 3, G, bid};
            EpiStore E{WSP(bf16, AR_OBUF), DM, DM / 256};
            pg8::gemm_phase<EpiStore, StackOrder, true, true>(lds, g, S, E, tid);
            { MKP; const float* xin = layer == 0 ? p.x : p.out;
              RMS_LOOP(xin, p.mix_norm_g + (size_t)layer * DM, false, cdum0, cdum1); }
            SEAM(pb + 7);
        }
        if (PHM(8) && IN(pb + 8)) { MKP;
            Gemm g{WSP(bf16, WS_H), (const bf16*)(p.ws + WS_W + (size_t)layer * SZ_LAYERW + OFF_WG), T, 3 * DM, DM}; GateOrder S{T / 256, DM / 256, G, bid};
            EpiGate E{p.ws, DM / 256};
            pg8::gemm_phase<EpiGate, GateOrder, true, true>(lds, g, S, E, tid);
            SEAM(pb + 8);
        }
        if (PHM(9) && IN(pb + 9)) { MKP;
            Gemm g{WSP(bf16, AR_MIX), (const bf16*)(p.ws + WS_W + (size_t)layer * SZ_LAYERW + OFF_WOUT), T, DM, DM}; SOrder S; S.init(T, DM, G, bid);
            EpiResid E{layer == 0 ? p.x : p.out, p.out};
            pg8::gemm_phase<EpiResid, SOrder, true, true>(lds, g, S, E, tid);
            SEAM(pb + 9);
        }
        if (PHM(10) && IN(pb + 10)) { MKP;
            unsigned long long c0 = 0ull, c1 = 0ull;
            RMS_LOOP(p.out, p.ffn_norm_g + (size_t)layer * DM, layer == 1, c0, c1);
            if (layer == 1 && lane < 16) {
                const unsigned cn = (unsigned)(((lane < 8 ? c0 : c1) >> (8 * (lane & 7))) & 255ull);
                WSP(unsigned, AR_WBASE)[(size_t)gw * 16 + lane] = atomicAdd(ctl + CW_CNT + lane * 64, cn); }
            if (layer == 1) { int* rt = WSP(int, AR_RTOK); for (long i = gtid; i < 2L * MOE_ROWS; i += NT) rt[i] = -1; }
            SEAM(pb + 10);
        }
        if (layer == 0) {
            if (PHM(11) && IN(pb + 11)) { MKP;
                Gemm g{WSP(bf16, WS_H), WSP(bf16, WS_DGU), T, 2 * DENSE_FF, DM}; SOrder S; S.init(T, 2 * DENSE_FF, G, bid);
                EpiSwiglu E{WSP(bf16, AR_ACT), DENSE_FF, 2 * DENSE_FF / 256};
                pg8::gemm_phase<EpiSwiglu, SOrder, true, true>(lds, g, S, E, tid);
                SEAM(pb + 11);
            }
            if (PHM(12) && IN(pb + 12)) { MKP;
                Gemm g{WSP(bf16, AR_ACT), WSP(bf16, WS_DDN), T, DM, DENSE_FF}; SOrder S; S.init(T, DM, G, bid);
                EpiResid E{p.out, p.out};
                pg8::gemm_phase<EpiResid, SOrder, true, true>(lds, g, S, E, tid);
                SEAM(pb + 12);
            }
        } else {
            if (PHM(11) && IN(pb + 11)) { MKP;
                const int ig = (DM / 64) * (2 * EXPERT_FF / 32), id = (EXPERT_FF / 64) * (DM / 32);
                for (int it = gw; it < NEXP * (ig + id); it += NGW) { const int e = it / (ig + id); int r = it % (ig + id);
                    if (conv_job(r, p.moe_gu + (size_t)e * DM * 2 * EXPERT_FF, DM, 2 * EXPERT_FF, MapGlu{WSP(bf16, AR_MGU) + (size_t)e * 2 * EXPERT_FF * DM, DM, EXPERT_FF}, scrw, lane)) continue;
                    conv_job(r, p.moe_down + (size_t)e * EXPERT_FF * DM, EXPERT_FF, DM, MapPlain{WSP(bf16, AR_MDN) + (size_t)e * DM * EXPERT_FF, EXPERT_FF}, scrw, lane); }
                int* rtok = WSP(int, AR_RTOK); float* rww = WSP(float, AR_RW8); int* trow = WSP(int, AR_TROW);
                int segv = 0; { const int pc = lane < 16 ? (int)((ctl[CW_CNT + lane * 64] + 255u) & ~255u) : 0;
#pragma unroll
                    for (int k = 0; k < 8; ++k) { const int ck = bperm_i(pc, (lane & 8) + k); segv += (k < (lane & 7)) ? ck : 0; } }
                for (int tb = gw * 64; tb < T; tb += NGW * 64) {
                    const int t = tb + lane; const int ee = WSP(int, AR_RTE)[t], e0 = ee & 255, e1 = (ee >> 8) & 255, r0 = (ee >> 16) & 255, r1 = (ee >> 24) & 255;
                    const float* w = WSP(float, AR_RTW) + (size_t)t * 2; const unsigned* wb = WSP(unsigned, AR_WBASE) + (size_t)(t % NGW) * 16;
                    const int row0 = bperm_i(segv, e0) + (int)wb[e0] + r0, row1 = bperm_i(segv, 8 + e1) + (int)wb[8 + e1] + r1;
                    rtok[row0] = t; rww[row0] = w[0]; rtok[MOE_ROWS + row1] = t; rww[MOE_ROWS + row1] = w[1]; trow[T + t] = row1;
                    for (int l = 0; l < 64; l += 4) { const bf16* hs = WSP(bf16, WS_H) + (size_t)(tb + l) * DM; bf16* xg = WSP(bf16, AR_XG);
                        copy_rows4(hs, hs + DM, hs + 2 * DM, hs + 3 * DM, xg + (size_t)__builtin_amdgcn_readlane(row0, l) * DM, xg + (size_t)__builtin_amdgcn_readlane(row0, l + 1) * DM, xg + (size_t)__builtin_amdgcn_readlane(row0, l + 2) * DM, xg + (size_t)__builtin_amdgcn_readlane(row0, l + 3) * DM, lane); }
                }
                SEAM(pb + 11);
            }
#pragma unroll
            for (int pass = 0; pass < 2; ++pass) {
                if (PHM(12) && IN(pb + 12 + 2 * pass)) { MKP;
                    Gemm g{WSP(bf16, AR_XG), WSP(bf16, AR_MGU), MOE_ROWS, NEXP * 2 * EXPERT_FF, DM}; MoeOrder S; S.init(ctl + CW_CNT + 8 * 64 * pass, 2 * EXPERT_FF / 256, G, bid);
                    EpiSwiglu E{WSP(bf16, AR_MACT), EXPERT_FF, 2 * EXPERT_FF / 256};
                    pg8::gemm_phase<EpiSwiglu, MoeOrder, true, true>(lds, g, S, E, tid);
                    SEAM(pb + 12 + 2 * pass);
                }
                if (PHM(13) && IN(pb + 13 + 2 * pass)) { MKP;
                    Gemm g{WSP(bf16, AR_MACT), WSP(bf16, AR_MDN), MOE_ROWS, NEXP * DM, EXPERT_FF}; MoeOrder S; S.init(ctl + CW_CNT + 8 * 64 * pass, DM / 256, G, bid);
                    EpiMoeDown E{p.out, WSP(int, AR_RTOK) + (size_t)pass * MOE_ROWS, WSP(float, AR_RW8) + (size_t)pass * MOE_ROWS, DM / 256, (PR_LO >= 0 && st == 0 && pb + 13 + 2 * pass >= PR_LO && pb + 13 + 2 * pass <= PR_HI) ? 0.f : 1.f};
                    pg8::gemm_phase<EpiMoeDown, MoeOrder, true, true>(lds, g, S, E, tid);
                    if (pass == 0) { const int* trow = WSP(int, AR_TROW);
                        for (int t = gw * 4; t < T; t += NGW * 4) { const bf16* hs = WSP(bf16, WS_H) + (size_t)t * DM; bf16* xg = WSP(bf16, AR_XG);
                            copy_rows4(hs, hs + DM, hs + 2 * DM, hs + 3 * DM, xg + (size_t)trow[T + t] * DM, xg + (size_t)trow[T + t + 1] * DM, xg + (size_t)trow[T + t + 2] * DM, xg + (size_t)trow[T + t + 3] * DM, lane); } }
                    SEAM(pb + 13 + 2 * pass);
                }
            }
        }
    }
    }
#undef IN
#undef SEAM
}

#ifndef MK_ONE_LAUNCH
#define MK_ONE_LAUNCH 1
#endif
extern "C" void kernel_launch(void* const* d_in, const int* in_sizes, int n_in, void* d_out, int out_size, void* d_ws, size_t ws_size, hipStream_t stream) {
    static int grid = 0;
    if (grid == 0) {
        if (n_in != 29 || in_sizes[0] != T * DM || out_size != T * DM || ws_size < WS_END) { fprintf(stderr, "kernel_launch: unexpected shapes / workspace (%d inputs, ws %zu, need %zu)\n", n_in, ws_size, (size_t)WS_END); grid = -1; return; }
        int dev = 0, cus = 0;
        if (hipGetDevice(&dev) != hipSuccess || hipDeviceGetAttribute(&cus, hipDeviceAttributeMultiprocessorCount, dev) != hipSuccess) { grid = -1; return; }
        if (hipFuncSetAttribute((const void*)mk_fwd, hipFuncAttributeMaxDynamicSharedMemorySize, LDS_BYTES) != hipSuccess) { fprintf(stderr, "kernel_launch: hipFuncSetAttribute failed\n"); grid = -1; return; }
        int per_cu = 0;
        if (hipOccupancyMaxActiveBlocksPerMultiprocessor(&per_cu, (const void*)mk_fwd, NTHREADS, LDS_BYTES) != hipSuccess || per_cu < 1) { fprintf(stderr, "kernel_launch: occupancy query says %d\n", per_cu); }
        (void)hipGetLastError();
        grid = cus;
    }
    if (grid < 0) return;
    if (hipMemsetAsync((char*)d_ws + WS_CTL, 0, CTL_BYTES, stream) != hipSuccess) return;
    Args a{};
    for (int i = 0; i < 29; ++i) a.in[i] = (const float*)d_in[i];
    a.out = (float*)d_out; a.ws = (unsigned char*)d_ws;
#if MK_ONE_LAUNCH
    a.ph_lo = 0; a.ph_hi = NPHASES;
    hipLaunchKernelGGL(mk_fwd, dim3(grid), dim3(NTHREADS), LDS_BYTES, stream, a);
#else
    for (int k = 0; k < NPHASES; ++k) {
        if (k >= 1 + 13 && k < 1 + NPH) continue;
        a.ph_lo = k; a.ph_hi = k + 1;
        hipLaunchKernelGGL(mk_fwd, dim3(grid), dim3(NTHREADS), LDS_BYTES, stream, a);
    }
#endif
}
```

```cpp
#include <hip/hip_runtime.h>
#include <cstdio>
#include <cstdint>
#include <cmath>
#include <cstring>
#ifdef HOST_EMU
#define HD
#define DEV_INLINE inline
#else
#define HD __host__ __device__
#define DEV_INLINE __device__ __forceinline__
#endif

typedef unsigned short bf16;
struct alignas(16) U4 { unsigned x, y, z, w; };

#ifdef SMALL_CFG
constexpr int BATCH = 1, SEQ = 1024, DM = 128, DENSE_FF = 256, EXPERT_FF = 256;
#else
constexpr int BATCH = 8, SEQ = 8192, DM = 1024, DENSE_FF = 2816, EXPERT_FF = 3584;
#endif
constexpr int T = BATCH * SEQ;
constexpr int NHEAD = 8, NKV = 2, HG = 4, DH = 64;
constexpr int NC = SEQ / 16 - 1, NS = SEQ / 64, NSEL = 8, WINDOW = 512;
constexpr int CONV_CH = 512, CONV_K = 31, RC = 512;
constexpr int NEXP = 8;
constexpr int NSA_IN = 1304, OFF_CONV = 1304, OFF_GATE = 2328, OFF_RWKV = OFF_GATE + 3 * DM;
constexpr int N_IN_FIRST = OFF_RWKV + 1824, N_IN_REST = OFF_RWKV + 1856;
constexpr int NPROJ = 4352;
constexpr int LDQ = 512, LDKV = 512, LDRW = 2048, LBLK = 1536;
constexpr int MOE_ROWS = T + NEXP * 256;
constexpr float RMS_EPS = 1e-6f, LN_EPS = 1e-5f, GN_EPS = 64e-5f;

constexpr size_t al(size_t x) { return (x + 255) & ~(size_t)255; }
constexpr size_t WS_CTL = 0, CTL_BYTES = 1u << 20;
constexpr size_t SZ_WIN = (size_t)NPROJ * DM * 2, SZ_WG = (size_t)3 * DM * DM * 2, SZ_WO3 = (size_t)3 * DM * 512 * 2, SZ_WOUT = (size_t)DM * DM * 2;
constexpr size_t SZ_LW = (size_t)2048 * 384 * 2, SZ_CW1 = (size_t)2 * 256 * 1024 * 2, SZ_PEC = 1024;
constexpr size_t SZ_LAYERW = SZ_WIN + SZ_WG + SZ_WO3 + SZ_WOUT + SZ_LW + SZ_CW1 + SZ_PEC;
constexpr size_t WS_W = CTL_BYTES;
constexpr size_t OFF_WIN = 0, OFF_WG = SZ_WIN, OFF_WO3 = OFF_WG + SZ_WG, OFF_WOUT = OFF_WO3 + SZ_WO3, OFF_LW = OFF_WOUT + SZ_WOUT, OFF_CW1 = OFF_LW + SZ_LW, OFF_PEC = OFF_CW1 + SZ_CW1;
constexpr size_t WS_DGU = WS_W + 2 * SZ_LAYERW, SZ_DGU = (size_t)2 * DENSE_FF * DM * 2;
constexpr size_t WS_DDN = WS_DGU + SZ_DGU, SZ_DDN = (size_t)DM * DENSE_FF * 2;
constexpr size_t WS_VF = al(WS_DDN + SZ_DDN), SZ_TC = (size_t)T * 512 * 2;
constexpr size_t WS_H = WS_VF + SZ_TC, SZ_H = (size_t)T * DM * 2;
constexpr size_t WS_PART = WS_VF;
static_assert((size_t)32 * 7 * 65536 * 4 <= SZ_TC, "WS_PART");
constexpr size_t WS_AR = al(WS_H + SZ_H);
constexpr size_t AR_QB = WS_AR, AR_A = AR_QB + SZ_TC, AR_CO = AR_A + SZ_TC;
constexpr size_t AR_KV = AR_CO + SZ_TC, SZ_KV = (size_t)T * LDKV * 2;
constexpr size_t AR_RW = AR_KV + SZ_KV, SZ_RW = (size_t)T * LDRW * 2;
constexpr size_t AR_W = AR_RW + SZ_RW, AR_G = AR_W + SZ_TC, AR_UB = AR_G + SZ_TC;
constexpr size_t AR_NG = AR_UB + SZ_TC, SZ_NG = (size_t)T * 24 * 4;
constexpr size_t AR_HALO = al(AR_NG + SZ_NG), SZ_HALO = (size_t)(T / 256) * LDRW * 2;
constexpr size_t AR_KC = al(AR_HALO + SZ_HALO), SZ_CMP = (size_t)BATCH * NKV * (SEQ / 16) * 64 * 2;
constexpr size_t AR_VC = AR_KC + SZ_CMP;
constexpr size_t AR_HID = al(AR_VC + SZ_CMP), SZ_HID = (size_t)BATCH * NKV * (SEQ / 16) * 2 * 128 * 4;
constexpr size_t AR_SEL = al(AR_HID + SZ_HID), SZ_SEL = (size_t)T * NKV * 8 * 4;
constexpr size_t AR_INVN = al(AR_SEL + SZ_SEL), SZ_INVN = (size_t)T * 8 * 4;
constexpr size_t AR_VCT = al(AR_INVN + SZ_INVN);
constexpr size_t AR_CKV = al(AR_VCT + SZ_CMP), SZ_CKV = (size_t)2 * T * 128;
constexpr size_t AR_END1 = al(AR_CKV + SZ_CKV * 2);
constexpr size_t WS_VST = WS_H, WS_VWT = WS_H + (size_t)T * 128 * 2, WS_LB = WS_VWT + (size_t)T * 128 * 2, WS_KS8 = WS_LB + (size_t)T * 384 * 2, WS_KW8 = WS_KS8 + (size_t)T * 128 * 2;
constexpr size_t AR_OBUF = AR_KV, SZ_OBUF = (size_t)3 * T * DM * 2;
constexpr size_t AR_MIX = AR_OBUF + SZ_OBUF, SZ_MIX = (size_t)T * DM * 2;
constexpr size_t AR_END2 = AR_MIX + SZ_MIX;
constexpr size_t AR_ACT = WS_AR;
constexpr size_t AR_MGU = WS_AR, SZ_MGU = (size_t)NEXP * 2 * EXPERT_FF * DM * 2;
constexpr size_t AR_MDN = AR_MGU + SZ_MGU, SZ_MDN = (size_t)NEXP * DM * EXPERT_FF * 2;
constexpr size_t AR_XG = al(AR_MDN + SZ_MDN), SZ_XG = (size_t)MOE_ROWS * DM * 2;
constexpr size_t AR_MACT = al(AR_XG + SZ_XG), SZ_MACT = (size_t)MOE_ROWS * EXPERT_FF * 2;
constexpr size_t AR_RTOK = al(AR_MACT + SZ_MACT), SZ_RTOK = (size_t)2 * MOE_ROWS * 4;
constexpr size_t AR_RW8 = al(AR_RTOK + SZ_RTOK);
constexpr size_t AR_TROW = al(AR_RW8 + SZ_RTOK), SZ_TROW = (size_t)2 * T * 4;
constexpr size_t AR_RTE = al(AR_TROW + SZ_TROW);
constexpr size_t AR_RTW = al(AR_RTE + (size_t)T * 4);
constexpr size_t AR_WBASE = al(AR_RTW + (size_t)T * 8);
constexpr size_t AR_END3 = al(AR_WBASE + (size_t)4096 * 16 * 4);
constexpr size_t WS_END = (AR_END1 > AR_END2 ? (AR_END1 > AR_END3 ? AR_END1 : AR_END3) : (AR_END2 > AR_END3 ? AR_END2 : AR_END3));
constexpr int CW_CNT = 1024;
constexpr int CW_ATT = 256;
constexpr int CW_BAR = 4096;

struct P {
    const float *x, *mix_norm_g, *w_in_first, *w_in_rest, *mu_first, *mu_rest, *qk_g, *cmp_pos, *cmp_w1, *cmp_w2, *nsa_w_o, *conv_w, *conv_vec, *conv_w_o,
        *rwkv_vec, *w_up, *a_up, *g_up, *vres_up, *vres_b, *rwkv_w_o, *w_out, *ffn_norm_g, *dense_gu, *dense_down, *router_w, *router_b, *moe_gu, *moe_down;
    float* out; unsigned char* ws;
};
HD inline void fill_params(P& p, const float* const* in, float* out, unsigned char* ws) {
    p.x = in[0]; p.mix_norm_g = in[1]; p.w_in_first = in[2]; p.w_in_rest = in[3]; p.mu_first = in[4]; p.mu_rest = in[5]; p.qk_g = in[6]; p.cmp_pos = in[7];
    p.cmp_w1 = in[8]; p.cmp_w2 = in[9]; p.nsa_w_o = in[10]; p.conv_w = in[11]; p.conv_vec = in[12]; p.conv_w_o = in[13]; p.rwkv_vec = in[14]; p.w_up = in[15];
    p.a_up = in[16]; p.g_up = in[17]; p.vres_up = in[18]; p.vres_b = in[19]; p.rwkv_w_o = in[20]; p.w_out = in[21]; p.ffn_norm_g = in[22]; p.dense_gu = in[23];
    p.dense_down = in[24]; p.router_w = in[25]; p.router_b = in[26]; p.moe_gu = in[27]; p.moe_down = in[28]; p.out = out; p.ws = ws;
}
#define WSP(type, off) ((type*)(p.ws + (off)))

#ifdef HOST_EMU
#define FENCE()
#else
#define FENCE() asm volatile("" ::: "memory")
#endif
HD inline float bf2f(bf16 v) { unsigned u = (unsigned)v << 16; float f; memcpy(&f, &u, 4); return f; }
HD inline bf16 f2bf(float f) { unsigned u; memcpy(&u, &f, 4); return (bf16)((u + 0x7fffu + ((u >> 16) & 1u)) >> 16); }
HD inline float blo(unsigned v) { unsigned u = v << 16; float f; memcpy(&f, &u, 4); return f; }
HD inline float bhi(unsigned v) { unsigned u = v & 0xffff0000u; float f; memcpy(&f, &u, 4); return f; }
#if !defined(SCAN_BF16) && !defined(RKV_BF16)
HD inline bf16 f2h(float f) { return __builtin_bit_cast(unsigned short, (_Float16)f); }
#else
HD inline bf16 f2bf(float f);
HD inline bf16 f2h(float f) { return f2bf(f); }
#endif
HD inline float h2f(bf16 v) { return (float)__builtin_bit_cast(_Float16, v); }
HD inline float sigmoidf_(float x) { return 1.f / (1.f + expf(-x)); }
HD inline float dot64(const float* q, const bf16* kp) {
    const U4* k4 = (const U4*)kp; float s0 = 0.f, s1 = 0.f;
#pragma unroll
    for (int i = 0; i < 8; ++i) { const U4 v = k4[i];
        s0 += q[8 * i + 0] * blo(v.x) + q[8 * i + 2] * blo(v.y) + q[8 * i + 4] * blo(v.z) + q[8 * i + 6] * blo(v.w);
        s1 += q[8 * i + 1] * bhi(v.x) + q[8 * i + 3] * bhi(v.y) + q[8 * i + 5] * bhi(v.z) + q[8 * i + 7] * bhi(v.w); }
    return s0 + s1;
}
HD inline float dot64p(const U4* q, const bf16* kp) {
    const U4* k4 = (const U4*)kp; float s0 = 0.f, s1 = 0.f;
#pragma unroll
    for (int i = 0; i < 8; ++i) { const U4 v = k4[i], w = q[i];
        s0 += blo(w.x) * blo(v.x) + blo(w.y) * blo(v.y) + blo(w.z) * blo(v.z) + blo(w.w) * blo(v.w);
        s1 += bhi(w.x) * bhi(v.x) + bhi(w.y) * bhi(v.y) + bhi(w.z) * bhi(v.z) + bhi(w.w) * bhi(v.w); }
    return s0 + s1;
}
HD inline void ld64(const bf16* kp, float* q) {
    const U4* k4 = (const U4*)kp;
#pragma unroll
    for (int i = 0; i < 8; ++i) { const U4 v = k4[i]; q[8 * i] = blo(v.x); q[8 * i + 1] = bhi(v.x); q[8 * i + 2] = blo(v.y); q[8 * i + 3] = bhi(v.y);
        q[8 * i + 4] = blo(v.z); q[8 * i + 5] = bhi(v.z); q[8 * i + 6] = blo(v.w); q[8 * i + 7] = bhi(v.w); }
}
HD inline void axpy64(float* o, float w, const bf16* vp) {
    const U4* k4 = (const U4*)vp;
#pragma unroll
    for (int i = 0; i < 8; ++i) { const U4 v = k4[i]; o[8 * i] += w * blo(v.x); o[8 * i + 1] += w * bhi(v.x); o[8 * i + 2] += w * blo(v.y); o[8 * i + 3] += w * bhi(v.y);
        o[8 * i + 4] += w * blo(v.z); o[8 * i + 5] += w * bhi(v.z); o[8 * i + 6] += w * blo(v.w); o[8 * i + 7] += w * bhi(v.w); }
}
HD inline void axpy64s(float* o, float w, const bf16* vp) {
    const U4* k4 = (const U4*)vp;
#pragma unroll
    for (int i = 0; i < 8; ++i) { const U4 v = k4[i]; o[8 * i] = w * o[8 * i] + blo(v.x); o[8 * i + 1] = w * o[8 * i + 1] + bhi(v.x); o[8 * i + 2] = w * o[8 * i + 2] + blo(v.y); o[8 * i + 3] = w * o[8 * i + 3] + bhi(v.y);
        o[8 * i + 4] = w * o[8 * i + 4] + blo(v.z); o[8 * i + 5] = w * o[8 * i + 5] + bhi(v.z); o[8 * i + 6] = w * o[8 * i + 6] + blo(v.w); o[8 * i + 7] = w * o[8 * i + 7] + bhi(v.w); }
}
HD inline void st64(bf16* op, const float* o) {
    U4* o4 = (U4*)op;
#pragma unroll
    for (int i = 0; i < 8; ++i) { U4 v; v.x = (unsigned)f2bf(o[8 * i]) | ((unsigned)f2bf(o[8 * i + 1]) << 16); v.y = (unsigned)f2bf(o[8 * i + 2]) | ((unsigned)f2bf(o[8 * i + 3]) << 16);
        v.z = (unsigned)f2bf(o[8 * i + 4]) | ((unsigned)f2bf(o[8 * i + 5]) << 16); v.w = (unsigned)f2bf(o[8 * i + 6]) | ((unsigned)f2bf(o[8 * i + 7]) << 16); o4[i] = v; }
}

HD inline void rope_cs(int pos, int i, float& cs, float& sn) {
    const float c = exp2f(-(float)i * 0.41524101186092f) * 0.15915494309189535f, pf = (float)pos;
    const float prod = pf * c, err = fmaf(pf, c, -prod), fr = (prod - rintf(prod)) + err;
#ifdef HOST_EMU
    cs = cosf(6.283185307179586f * fr); sn = sinf(6.283185307179586f * fr);
#else
    cs = __builtin_amdgcn_cosf(fr); sn = __builtin_amdgcn_sinf(fr);
#endif
}
HD inline int win_dest(int j, int layer, int& which) {
    which = 0;
    if (j < 1280) return j;
    if (j < 1304) return 3840 + 320 + (j - 1280);
    if (j < 1816) { const int cc = j - 1304; return 1280 + 256 * (cc / 128) + cc % 128; }
    if (j < 2328) { const int cc = j - 1816; return 1280 + 256 * (cc / 128) + 128 + cc % 128; }
    if (j < OFF_RWKV) { which = 1; const int gg = j - OFF_GATE, br = gg / DM; return (br == 0 ? 0 : (br == 1 ? 2 * DM : DM)) + gg % DM; }
    const int rr = j - OFF_RWKV;
    if (rr < 1536) return 2304 + rr;
    if (rr < 1824) return 3840 + (rr - 1536);
    if (rr < 1856 && layer == 1) return 3840 + 288 + (rr - 1824);
    return -1;
}
HD inline int glu_dest(int j, int ff) { return j < ff ? 256 * (j / 128) + j % 128 : 256 * ((j - ff) / 128) + 128 + (j - ff) % 128; }

DEV_INLINE void ph_shift(const P& p, int layer, long gtid, long NT) {
    bf16* RW = WSP(bf16, AR_RW); const bf16* HALO = WSP(bf16, AR_HALO); bf16* VF = WSP(bf16, WS_VF); bf16* LB = WSP(bf16, WS_LB);
    const float* mu = layer == 0 ? p.mu_first : p.mu_rest;
    constexpr int NCP = (LBLK + 384) / 2;
    const long n = (long)(T / 256) * NCP;
    for (long it = gtid; it < n; it += NT) {
        const int pm = (int)(it / NCP), c = 2 * (int)(it % NCP);
        int mi = -1, act = 0;
        if (c < LBLK) mi = c;
        else { const int w = c - LBLK; if (w < 288) { mi = 1536 + w; act = w < 64 ? 1 : (w >= 128 ? 2 : 0); } else if (w < 320 && layer == 1) mi = 1824 + (w - 288); }
        if (mi < 0) { for (int r = 0; r < 256; ++r) *(unsigned*)(LB + ((size_t)pm * 256 + r) * 384 + (c - LBLK)) = 0u; continue; }
        const float m0 = mu[mi], m1 = mu[mi + 1];
        float prev0 = 0.f, prev1 = 0.f;
        if ((pm * 256) % SEQ != 0) { const unsigned hv = *(const unsigned*)(HALO + (size_t)(pm - 1) * LDRW + c); prev0 = blo(hv); prev1 = bhi(hv); }
        bf16* col = RW + (size_t)pm * 256 * LDRW + c;
        for (int r0 = 0; r0 < 256; r0 += 16) {
            unsigned pv[16];
#pragma unroll
            for (int k = 0; k < 16; ++k) pv[k] = *(const unsigned*)(col + (size_t)(r0 + k) * LDRW);
#pragma unroll
            for (int k = 0; k < 16; ++k) { const int r = r0 + k; const float p0 = blo(pv[k]), p1 = bhi(pv[k]);
                float u0 = p0 + (prev0 - p0) * m0, u1 = p1 + (prev1 - p1) * m1; prev0 = p0; prev1 = p1;
                if (act == 1) { u0 = tanhf(u0); u1 = tanhf(u1); } else if (act == 2) { u0 = sigmoidf_(u0); u1 = sigmoidf_(u1); }
                if (c < LBLK) { const unsigned hv = (unsigned)f2h(u0) | ((unsigned)f2h(u1) << 16); *(unsigned*)(col + (size_t)r * LDRW) = hv;
                    if (layer == 0 && c >= 1024) *(unsigned*)(VF + ((size_t)pm * 256 + r) * RC + (c - 1024)) = hv; }
                else *(unsigned*)(LB + ((size_t)pm * 256 + r) * 384 + (c - LBLK)) = (unsigned)f2bf(u0) | ((unsigned)f2bf(u1) << 16); }
        }
    }
}

DEV_INLINE void ph_nsa_prep(const P& p, int layer, long gtid, long NT) {
    bf16* QB = WSP(bf16, AR_QB); bf16* KV = WSP(bf16, AR_KV);
    const long n = (long)T * 12;
    for (long it = gtid; it < n; it += NT) {
        const int t = (int)(it / 12), s = (int)(it % 12), pos = t % SEQ;
        bf16* ptr; const float* g;
        if (s < 8) { ptr = QB + (size_t)t * LDQ + s * 64; g = p.qk_g + (layer * 4 + 0) * 64; }
        else if (s < 10) { ptr = KV + (size_t)t * LDKV + (s - 8) * 64; g = p.qk_g + (layer * 4 + 2) * 64; }
        else { ptr = KV + (size_t)t * LDKV + 256 + (s - 10) * 64; g = p.qk_g + (layer * 4 + 3) * 64; }
        float v[64]; ld64(ptr, v);
        float ss = 0.f;
#pragma unroll
        for (int i = 0; i < 64; ++i) ss += v[i] * v[i];
        const float rs = 1.f / sqrtf(ss * (1.f / 64.f) + RMS_EPS);
#pragma unroll
        for (int i = 0; i < 64; ++i) v[i] = v[i] * rs * g[i];
#pragma unroll
        for (int i = 0; i < 32; ++i) {
            float cs, sn; rope_cs(pos, i, cs, sn);
            const float x1 = v[i], x2 = v[i + 32]; v[i] = x1 * cs - x2 * sn; v[i + 32] = x2 * cs + x1 * sn;
        }
        if (s < 8) {
#pragma unroll
            for (int i = 0; i < 64; ++i) v[i] *= 0.125f * 1.4426950408889634f; }
        if (s < 8) st64(ptr, v);
        else {
            const int gg = (s - 8) & 1, bq = t / SEQ; bf16* k8 = WSP(bf16, s < 10 ? WS_KS8 : WS_KW8) + (size_t)(bq * NKV + gg) * 8 * SEQ * 8;
#pragma unroll
            for (int dg = 0; dg < 8; ++dg) { U4 w; w.x = (unsigned)f2bf(v[8 * dg]) | ((unsigned)f2bf(v[8 * dg + 1]) << 16); w.y = (unsigned)f2bf(v[8 * dg + 2]) | ((unsigned)f2bf(v[8 * dg + 3]) << 16);
                w.z = (unsigned)f2bf(v[8 * dg + 4]) | ((unsigned)f2bf(v[8 * dg + 5]) << 16); w.w = (unsigned)f2bf(v[8 * dg + 6]) | ((unsigned)f2bf(v[8 * dg + 7]) << 16);
                *(U4*)(k8 + ((size_t)dg * SEQ + pos) * 8) = w; } }
    }
}

DEV_INLINE void ph_vtrans(const P& p, long gtid, long NT) {
    const bf16* KV = WSP(bf16, AR_KV); bf16* VsT = WSP(bf16, WS_VST); bf16* VwT = WSP(bf16, WS_VWT);
    const long n = (long)BATCH * NKV * (SEQ / 8) * 64;
    for (long it = gtid; it < n; it += NT) {
        const int d = (int)(it % 64); long r = it / 64; const int kg = (int)(r % (SEQ / 8)); const int bg = (int)(r / (SEQ / 8)), b = bg / NKV, g = bg % NKV;
        const int kbase = (kg >> 2) * 32 + 4 * (kg & 3);
        const bf16* src = KV + (size_t)(b * SEQ + kbase) * LDKV + g * 64 + d;
        U4 s, w; unsigned short sv[8], wv[8];
#pragma unroll
        for (int j = 0; j < 8; ++j) { const size_t ro = (size_t)((j & 3) + 16 * (j >> 2)) * LDKV; sv[j] = src[ro + 128]; wv[j] = src[ro + 384]; }
        s.x = sv[0] | ((unsigned)sv[1] << 16); s.y = sv[2] | ((unsigned)sv[3] << 16); s.z = sv[4] | ((unsigned)sv[5] << 16); s.w = sv[6] | ((unsigned)sv[7] << 16);
        w.x = wv[0] | ((unsigned)wv[1] << 16); w.y = wv[2] | ((unsigned)wv[3] << 16); w.z = wv[4] | ((unsigned)wv[5] << 16); w.w = wv[6] | ((unsigned)wv[7] << 16);
        *(U4*)(VsT + (((size_t)bg * (SEQ / 8) + kg) * 64 + d) * 8) = s; *(U4*)(VwT + (((size_t)bg * (SEQ / 8) + kg) * 64 + d) * 8) = w;
    }
}
namespace pg8 {
#define PG8_LAS __attribute__((address_space(3)))
typedef unsigned short bf16_t;
typedef short bf16x8 __attribute__((ext_vector_type(8)));
typedef float f32x4 __attribute__((ext_vector_type(4)));
typedef unsigned u32x4 __attribute__((ext_vector_type(4)));
constexpr int BM = 256, BK = 64, HALF = 128, HTB = HALF * BK * 2  , STAGE_BYTES = 8 * HTB, NXCD = 8, WGM = 8;

__host__ __device__ __forceinline__ int lds_byte(int r, int c) { const int st = (r >> 4) * 2 + (c >> 5), rr = r & 15, cc = c & 31, ob = rr * 64 + cc * 2; return st * 1024 + (ob ^ (((ob >> 9) & 1) << 5)); }
__host__ __device__ __forceinline__ void stage_rc(int b, int& R, int& C) { const int st = b / 1024, sb = b % 1024, swz = sb ^ (((sb >> 9) & 1) << 5); R = (st >> 1) * 16 + swz / 64; C = (st & 1) * 32 + (swz % 64) / 2; }
__host__ __device__ __forceinline__ int perm32(int rho) { const int n = rho >> 4, i = rho & 15; return 8 * (i >> 2) + 4 * n + (i & 3); }

struct Unit { int pm, pn; };
struct Gemm { const bf16_t* A; const bf16_t* Bt; int M, N, K; int lda; int ldb; };

struct StaticOrder {
    int nM, nN, nwg, G, c;
    __host__ __device__ void init(int M, int N, int G_, int c_) { nM = M / BM; nN = N / BM; nwg = nM * nN; G = G_; c = c_; }
    __host__ __device__ bool next(int i, Unit& u) const {
        const long L = (long)i * G + c; if (L >= nwg) return false;
        int wgid = (int)L; { const int q = nwg / NXCD, r = nwg % NXCD, xcd = wgid % NXCD, off = wgid / NXCD; wgid = (xcd < r ? xcd * (q + 1) : r * (q + 1) + (xcd - r) * q) + off; }
        const int nig = WGM * nN, gid = wgid / nig, fm = gid * WGM, gsz = (nM - fm) < WGM ? (nM - fm) : WGM;
        u.pm = fm + ((wgid % nig) % gsz); u.pn = (wgid % nig) / gsz; return true;
    }
    __device__ __forceinline__ void a_ready(const Unit&) const {}
    __device__ __forceinline__ void done(const Unit&) const {}
};

__device__ __forceinline__ unsigned cvt_pk_bf16(float lo, float hi) { unsigned r; asm volatile("v_cvt_pk_bf16_f32 %0, %1, %2" : "=v"(r) : "v"(lo), "v"(hi)); return r; }
typedef float f32x2 __attribute__((ext_vector_type(2)));
template <class Epi, class Sched, bool ALIGN_EPI = false, bool SP2 = false, bool KSPLIT = false>
__device__ __forceinline__ void gemm_phase(PG8_LAS unsigned char* lds, const Gemm g, const Sched& S, const Epi& E, int tid_in) {
    int tid_ = tid_in; asm volatile("" : "+v"(tid_));
    const int tid = tid_, wid = __builtin_amdgcn_readfirstlane(tid >> 6), lane = tid & 63, wr = wid >> 2, wc = wid & 3, fr = lane & 15, fq = lane >> 4;
    const int K = g.K, nt = K / BK, lda = g.lda ? g.lda : K, ldb = g.ldb ? g.ldb : K;
    unsigned voffA[2], voffB[2];
#pragma unroll
    for (int i = 0; i < 2; ++i) { int R, C; stage_rc(tid * 16 + i * 8192, R, C); const int Rb = Epi::PERM ? ((R & ~31) + perm32(R & 31)) : R;
        voffA[i] = (unsigned)(R * lda + C) * 2u; voffB[i] = (unsigned)(Rb * ldb + C) * 2u; }
    const size_t kstep = (size_t)(BK * 2);
    const size_t hstepA = (size_t)HALF * lda * 2, hstepB = (size_t)HALF * ldb * 2;
    const size_t hstep_unused = (size_t)HALF * K * 2;
    const size_t tstepA = 2 * hstepA, tstepB = 2 * hstepB;
    const unsigned ldsw = (unsigned)wid * 1024u;
    const int aoff = lds_byte(wr * 64 + fr, fq * 8), boff = lds_byte(wc * 32 + fr, fq * 8);
#define PG8_SA(b, h) (((b) * 2 + (h)) * HTB)
#define PG8_SB(b, h) ((4 + (b) * 2 + (h)) * HTB)
#define PG8_STAGE(bufoff, gbase, voff) do { _Pragma("unroll") for (int _i = 0; _i < 2; ++_i) \
        __builtin_amdgcn_global_load_lds((const unsigned*)((const char*)(gbase) + (voff)[_i]), (PG8_LAS unsigned*)(lds + (bufoff) + ldsw + _i * 8192), 16, 0, 0); } while (0)
#define PG8_LDA(dst, b, h) do { _Pragma("unroll") for (int m = 0; m < 4; ++m) _Pragma("unroll") for (int k = 0; k < 2; ++k) dst[m][k] = *(const PG8_LAS bf16x8*)(lds + PG8_SA(b, h) + aoff + m * 2048 + k * 1024); } while (0)
#define PG8_LDB(dst, b, h) do { _Pragma("unroll") for (int n = 0; n < 2; ++n) _Pragma("unroll") for (int k = 0; k < 2; ++k) dst[n][k] = *(const PG8_LAS bf16x8*)(lds + PG8_SB(b, h) + boff + n * 2048 + k * 1024); } while (0)
#define PG8_MMA(ai, bj, At, Bt) do { __builtin_amdgcn_s_setprio(1); _Pragma("unroll") for (int m = 0; m < 4; ++m) _Pragma("unroll") for (int n = 0; n < 2; ++n) _Pragma("unroll") for (int k = 0; k < 2; ++k) \
        acc[ai][bj][m][n] = __builtin_amdgcn_mfma_f32_16x16x32_bf16(Bt[n][k], At[m][k], acc[ai][bj][m][n], 0, 0, 0); __builtin_amdgcn_s_setprio(0); } while (0)
#define PG8_WAIT_V(n) asm volatile("s_waitcnt vmcnt(" #n ")" ::: "memory")
#define PG8_WAIT_L(n) asm volatile("s_waitcnt lgkmcnt(" #n ")" ::: "memory")
#define PG8_BAR __builtin_amdgcn_s_barrier()
#define PG8_SCHED __builtin_amdgcn_sched_barrier(0)
    Unit cur, nxt; int ui = 0;
    if (!S.next(0, cur)) return;
    f32x4 acc[2][2][4][2];
#pragma unroll
    for (int a = 0; a < 2; ++a)
#pragma unroll
        for (int b = 0; b < 2; ++b)
#pragma unroll
            for (int m = 0; m < 4; ++m)
#pragma unroll
                for (int n = 0; n < 2; ++n) acc[a][b][m][n] = (f32x4){0.f, 0.f, 0.f, 0.f};
    bf16x8 At[4][2], B0[2][2], B1[2][2];
    const char* cA = (const char*)g.A + (size_t)cur.pm * tstepA + (KSPLIT ? (size_t)(cur.pn >> 16) * K * 2 : 0); const char* cB = (const char*)g.Bt + (size_t)(KSPLIT ? (cur.pn & 0xffff) : cur.pn) * tstepB + (KSPLIT ? (size_t)(cur.pn >> 16) * K * 2 : 0);
    S.a_ready(cur);
    if constexpr (SP2) {
        PG8_STAGE(PG8_SB(0, 0), cB, voffB); PG8_STAGE(PG8_SB(0, 1), cB + hstepB, voffB); PG8_STAGE(PG8_SA(0, 0), cA, voffA); PG8_STAGE(PG8_SA(0, 1), cA + hstepA, voffA);
        if (wr == 1) PG8_BAR;
        PG8_WAIT_V(2); PG8_BAR;
        PG8_STAGE(PG8_SB(1, 0), cB + kstep, voffB); PG8_STAGE(PG8_SA(1, 0), cA + kstep, voffA); PG8_STAGE(PG8_SB(1, 1), cB + hstepB + kstep, voffB);
        PG8_WAIT_V(6); PG8_BAR;
    } else {
        PG8_STAGE(PG8_SB(0, 0), cB, voffB); PG8_STAGE(PG8_SA(0, 0), cA, voffA); PG8_STAGE(PG8_SB(0, 1), cB + hstepB, voffB); PG8_STAGE(PG8_SA(0, 1), cA + hstepA, voffA);
        if (wr == 1) PG8_BAR;
        PG8_WAIT_V(4); PG8_BAR;
        PG8_STAGE(PG8_SB(1, 0), cB + kstep, voffB); PG8_STAGE(PG8_SA(1, 0), cA + kstep, voffA); PG8_STAGE(PG8_SB(1, 1), cB + hstepB + kstep, voffB);
        PG8_WAIT_V(6); PG8_BAR;
    }
    for (;;) {
        const bool has_next = S.next(ui + 1, nxt);
        const char* nA = has_next ? (const char*)g.A + (size_t)nxt.pm * tstepA + (KSPLIT ? (size_t)(nxt.pn >> 16) * K * 2 : 0) : cA; const char* nB = has_next ? (const char*)g.Bt + (size_t)(KSPLIT ? (nxt.pn & 0xffff) : nxt.pn) * tstepB + (KSPLIT ? (size_t)(nxt.pn >> 16) * K * 2 : 0) : cB;
        for (int t = 0; t < nt; t += 2) {
            const bool last = (t == nt - 2);
            const char* a1 = cA + (size_t)(t + 1) * kstep;
            const char* a2 = last ? nA : cA + (size_t)(t + 2) * kstep; const char* b2 = last ? nB : cB + (size_t)(t + 2) * kstep;
            const char* a3 = a2 + kstep; const char* b3 = b2 + kstep;
            if (last && has_next) S.a_ready(nxt);
            if constexpr (SP2) {
            PG8_LDB(B0, 0, 0); PG8_LDB(B1, 0, 1); PG8_SCHED; PG8_LDA(At, 0, 0); PG8_STAGE(PG8_SA(1, 1), a1 + hstepA, voffA);
            PG8_WAIT_V(8); PG8_WAIT_L(0); PG8_BAR; PG8_MMA(0, 0, At, B0); PG8_MMA(0, 1, At, B1); PG8_BAR; PG8_SCHED;
            PG8_LDA(At, 0, 1); PG8_STAGE(PG8_SB(0, 0), b2, voffB); PG8_STAGE(PG8_SB(0, 1), b2 + hstepB, voffB); PG8_STAGE(PG8_SA(0, 0), a2, voffA);
            PG8_WAIT_V(8); PG8_WAIT_L(0); PG8_BAR; PG8_MMA(1, 0, At, B0); PG8_MMA(1, 1, At, B1); PG8_BAR; PG8_SCHED;
            PG8_LDB(B0, 1, 0); PG8_LDB(B1, 1, 1); PG8_SCHED; PG8_LDA(At, 1, 0); PG8_STAGE(PG8_SA(0, 1), a2 + hstepA, voffA);
            PG8_WAIT_V(8); PG8_WAIT_L(0); PG8_BAR; PG8_MMA(0, 0, At, B0); PG8_MMA(0, 1, At, B1); PG8_BAR; PG8_SCHED;
            PG8_LDA(At, 1, 1); PG8_STAGE(PG8_SB(1, 0), b3, voffB); PG8_STAGE(PG8_SB(1, 1), b3 + hstepB, voffB); PG8_STAGE(PG8_SA(1, 0), a3, voffA);
            PG8_WAIT_V(8); PG8_WAIT_L(0); PG8_BAR; PG8_MMA(1, 0, At, B0); PG8_MMA(1, 1, At, B1); PG8_BAR; PG8_SCHED;
            } else {
            PG8_LDB(B0, 0, 0); PG8_SCHED; PG8_LDA(At, 0, 0); PG8_STAGE(PG8_SA(1, 1), a1 + hstepA, voffA);
            PG8_WAIT_L(8); PG8_BAR; PG8_WAIT_L(0); PG8_MMA(0, 0, At, B0); PG8_BAR; PG8_SCHED;
            PG8_LDB(B1, 0, 1); PG8_STAGE(PG8_SB(0, 0), b2, voffB);
            PG8_BAR; PG8_WAIT_L(0); PG8_MMA(0, 1, At, B1); PG8_BAR;
            PG8_LDA(At, 0, 1); PG8_STAGE(PG8_SA(0, 0), a2, voffA);
            PG8_BAR; PG8_WAIT_L(0); PG8_MMA(1, 0, At, B0); PG8_BAR; PG8_SCHED;
            PG8_STAGE(PG8_SB(0, 1), b2 + hstepB, voffB);
            PG8_WAIT_V(6); PG8_BAR; PG8_MMA(1, 1, At, B1); PG8_BAR;
            PG8_LDB(B0, 1, 0); PG8_SCHED; PG8_LDA(At, 1, 0); PG8_STAGE(PG8_SA(0, 1), a2 + hstepA, voffA);
            PG8_WAIT_L(8); PG8_BAR; PG8_WAIT_L(0); PG8_MMA(0, 0, At, B0); PG8_BAR; PG8_SCHED;
            PG8_LDB(B1, 1, 1); PG8_STAGE(PG8_SB(1, 0), b3, voffB);
            PG8_BAR; PG8_WAIT_L(0); PG8_MMA(0, 1, At, B1); PG8_BAR;
            PG8_LDA(At, 1, 1); PG8_STAGE(PG8_SA(1, 0), a3, voffA);
            PG8_BAR; PG8_WAIT_L(0); PG8_MMA(1, 0, At, B0); PG8_BAR; PG8_SCHED;
            PG8_STAGE(PG8_SB(1, 1), b3 + hstepB, voffB);
            PG8_WAIT_V(6); PG8_BAR; PG8_MMA(1, 1, At, B1); PG8_BAR;
            }
        }
        if constexpr (ALIGN_EPI) { if (wr == 0) PG8_BAR; }
        if constexpr (!Epi::AFTER_DRAIN) { E(acc, cur, wr, wc, fr, fq); S.done(cur); }
        if (!has_next) break;
#pragma unroll
        for (int a = 0; a < 2; ++a)
#pragma unroll
            for (int b = 0; b < 2; ++b)
#pragma unroll
                for (int m = 0; m < 4; ++m)
#pragma unroll
                    for (int n = 0; n < 2; ++n) acc[a][b][m][n] = (f32x4){0.f, 0.f, 0.f, 0.f};
        cur = nxt; cA = nA; cB = nB; ++ui;
        if constexpr (ALIGN_EPI) { if (wr == 1) PG8_BAR; }
    }
    PG8_WAIT_V(0);
    if constexpr (!ALIGN_EPI) { if (wr == 0) PG8_BAR; }
    PG8_BAR;
    if constexpr (Epi::AFTER_DRAIN) { E.fused(acc, cur, wr, wc, fr, fq, lds, wid, lane); S.done(cur); }
#undef PG8_SA
#undef PG8_SB
#undef PG8_STAGE
#undef PG8_LDA
#undef PG8_LDB
#undef PG8_MMA
#undef PG8_WAIT_V
#undef PG8_WAIT_L
#undef PG8_BAR
#undef PG8_SCHED
}
}

#define LAS __attribute__((address_space(3)))
#define XB_TMO      128
#define XB_XCNT(j)  (256  + 64 * (j))
#define XB_XSUB(j)  (1280 + 64 * (j))
#define XB_XGEN(j)  (2304 + 64 * (j))
#define XB_TOP      3328
#define XB_TOPGEN   3392
#define XCD_BAR_WORDS 3456
#define XB_SPIN_CAP (1u << 22)

__device__ __forceinline__ unsigned xb_ld(unsigned* p)              { return __hip_atomic_load(p, __ATOMIC_RELAXED, __HIP_MEMORY_SCOPE_AGENT); }
__device__ __forceinline__ unsigned xb_add(unsigned* p, unsigned v) { return __hip_atomic_fetch_add(p, v, __ATOMIC_RELAXED, __HIP_MEMORY_SCOPE_AGENT); }
__device__ __forceinline__ unsigned xb_xcc_id() { return (unsigned)__builtin_amdgcn_s_getreg((3 << 11) | 20) & 0xFu; }
#define XB_SPIN(cond, bar) do { unsigned _sp = 0; while (cond) { __builtin_amdgcn_s_sleep(1); \
    if ((++_sp & 255u) == 0u) { if (xb_ld(&(bar)[XB_TMO])) break; if (_sp > XB_SPIN_CAP) { atomicAdd(&(bar)[XB_TMO], 1u); break; } } } } while (0)

struct XcdBarrier {
    unsigned* bar; unsigned x;
    volatile LAS unsigned* st;
};

__device__ __forceinline__ XcdBarrier xcd_barrier_post(unsigned* bar, volatile LAS unsigned* st) {
    XcdBarrier b; b.bar = bar; b.x = xb_xcc_id(); b.st = st;
    if (threadIdx.x == 0) (void)xb_add(&bar[XB_XCNT(b.x)], 1u);
    return b;
}
__device__ __forceinline__ void xcd_barrier_complete(unsigned* bar, unsigned x, unsigned& nloc, unsigned& nx) {
    const unsigned G = gridDim.x * gridDim.y * gridDim.z;
    unsigned sum, cnt, mine, sp = 0u;
    for (;;) {
        sum = 0u; cnt = 0u; mine = 0u;
#pragma unroll
        for (unsigned j = 0; j < 16; ++j) { const unsigned c = xb_ld(&bar[XB_XCNT(j)]); sum += c; cnt += (c > 0u) ? 1u : 0u; mine = (j == x) ? c : mine; }
        if (sum == G) break;
        __builtin_amdgcn_s_sleep(1);
        if ((++sp & 255u) == 0u) { if (xb_ld(&bar[XB_TMO])) break; if (sp > XB_SPIN_CAP) { atomicAdd(&bar[XB_TMO], 1u); break; } }
    }
    nloc = mine > 0u ? mine : 1u; nx = cnt > 0u ? cnt : 1u;
}

__device__ __forceinline__ void xcd_barrier(const XcdBarrier& b, int tid_x  ) {
    asm volatile("s_waitcnt vmcnt(0)" ::: "memory");
    __syncthreads();
    if (tid_x == 0) {
        unsigned* bar = b.bar; asm volatile("" : "+s"(bar));
        unsigned xx = b.x; asm volatile("" : "+s"(xx));
        __builtin_amdgcn_s_waitcnt(0);
        unsigned nloc = b.st[0], nx = b.st[1];
        if (nloc == 0u) { xcd_barrier_complete(bar, xx, nloc, nx); b.st[0] = nloc; b.st[1] = nx; }
        const unsigned old = xb_add(&bar[XB_XSUB(xx)], 1u);
        const unsigned gen = old / nloc;
        if (old + 1u == (gen + 1u) * nloc) {
            __builtin_amdgcn_fence(__ATOMIC_RELEASE, "agent");
            asm volatile("s_waitcnt vmcnt(0)" ::: "memory");
            const unsigned og = xb_add(&bar[XB_TOP], 1u);
            const unsigned tg = og / nx;
            if (og + 1u == (tg + 1u) * nx) xb_add(&bar[XB_TOPGEN], 1u);
            else XB_SPIN(xb_ld(&bar[XB_TOPGEN]) == tg, bar);
            __builtin_amdgcn_fence(__ATOMIC_ACQUIRE, "agent");
            xb_add(&bar[XB_XGEN(xx)], 1u);
            asm volatile("s_waitcnt vmcnt(0)" ::: "memory");
        } else {
            XB_SPIN(xb_ld(&bar[XB_XGEN(xx)]) == gen, bar);
            __builtin_amdgcn_fence(__ATOMIC_ACQUIRE, "agent");
            asm volatile("s_waitcnt vmcnt(0)" ::: "memory");
        }
    }
    __syncthreads();
}
#define GAS __attribute__((address_space(1)))
typedef unsigned v4u __attribute__((ext_vector_type(4)));
typedef unsigned v2u __attribute__((ext_vector_type(2)));
typedef GAS unsigned gu32;
#define RLX_AGENT __ATOMIC_RELAXED, __HIP_MEMORY_SCOPE_AGENT
#define LDS_WAIT() asm volatile("s_waitcnt lgkmcnt(0)" ::: "memory")
#define VM_WAIT() asm volatile("s_waitcnt vmcnt(0)" ::: "memory")
using pg8::f32x4; using pg8::Unit; using pg8::Gemm; using pg8::BM; using pg8::HALF; using pg8::cvt_pk_bf16; using pg8::u32x4;

constexpr int NWAVES = 8, NTHREADS = 512;
constexpr int RING_BYTES = 131072, LDSCTL_OFF = 147456 - 1024, MISC_OFF = LDSCTL_OFF + 320, LDS_BYTES = 147456;

__device__ __forceinline__ float wave_sum(float v, int lane) {
#pragma unroll
    for (int o = 1; o < 64; o <<= 1) v += __builtin_bit_cast(float, __builtin_amdgcn_ds_bpermute((lane ^ o) << 2, __builtin_bit_cast(int, v)));
    return v;
}
__device__ __forceinline__ float fsig(float x) { return __builtin_amdgcn_rcpf(1.f + __expf(-x)); }

__device__ __forceinline__ int lane_id_opaque() { int l; asm volatile("v_mbcnt_lo_u32_b32 %0, -1, 0\n\tv_mbcnt_hi_u32_b32 %0, -1, %0" : "=v"(l)); return l; }
__device__ __forceinline__ int rfl(int v) { return __builtin_amdgcn_readfirstlane(v); }
struct SOrder {
    pg8::StaticOrder s;
    __device__ void init(int M, int N, int G, int c) { s.init(M, N, G, c); }
    __device__ bool next(int i, Unit& u) const { Unit t; t.pm = 0; t.pn = 0; const bool ok = s.next(i, t); u.pm = rfl(t.pm); u.pn = rfl(t.pn); return ok; }
    __device__ __forceinline__ void a_ready(const Unit&) const {}
    __device__ __forceinline__ void done(const Unit&) const {}
};
struct StackOrder {
    pg8::StaticOrder s; int nM, nN;
    __device__ StackOrder(int nM_, int nN_, int nb, int G, int c) : nM(nM_), nN(nN_) { s.init(nb * nM_ * 256, nN_ * 256, G, c); }
    __device__ bool next(int i, Unit& u) const { Unit t; t.pm = 0; t.pn = 0; if (!s.next(i, t)) return false; u.pm = rfl(t.pm); u.pn = rfl((t.pm / nM) * nN + t.pn); return true; }
    __device__ __forceinline__ void a_ready(const Unit&) const {}
    __device__ __forceinline__ void done(const Unit&) const {}
};
struct GateOrder {
    pg8::StaticOrder s; int nN;
    __device__ GateOrder(int nM_, int nN_, int G, int c) : nN(nN_) { s.init(nM_ * 256, nN_ * 256, G, c); }
    __device__ bool next(int i, Unit& u) const { const int j = i / 3, br = i - 3 * j; Unit t; t.pm = 0; t.pn = 0; if (!s.next(j, t)) return false; u.pm = rfl(t.pm); u.pn = rfl(br * nN + t.pn); return true; }
    __device__ __forceinline__ void a_ready(const Unit&) const {}
    __device__ __forceinline__ void done(const Unit&) const {}
};
struct MoeOrder {
    pg8::StaticOrder s; int nN, e0, e1, e2, e3, e4, e5, e6, e7;
    __device__ void init(const unsigned* cnt  , int nN_, int G_, int c_) { nN = nN_;
        int t = 0; t += (cnt[0] + 255) >> 8; e0 = t; t += (cnt[64] + 255) >> 8; e1 = t; t += (cnt[128] + 255) >> 8; e2 = t; t += (cnt[192] + 255) >> 8; e3 = t;
        t += (cnt[256] + 255) >> 8; e4 = t; t += (cnt[320] + 255) >> 8; e5 = t; t += (cnt[384] + 255) >> 8; e6 = t; t += (cnt[448] + 255) >> 8; e7 = t;
        s.init(e7 * 256, nN_ * 256, G_, c_); }
    __device__ bool next(int i, Unit& u) const { Unit t; t.pm = 0; t.pn = 0; if (!s.next(i, t)) return false;
        const int pm = t.pm, e = (pm >= e0) + (pm >= e1) + (pm >= e2) + (pm >= e3) + (pm >= e4) + (pm >= e5) + (pm >= e6);
        u.pm = rfl(pm); u.pn = rfl(e * nN + t.pn); return true; }
    __device__ __forceinline__ void a_ready(const Unit&) const {}
    __device__ __forceinline__ void done(const Unit&) const {}
};

__device__ __forceinline__ u32x4 pack8(f32x4 v0, f32x4 v1) { u32x4 w; w.x = cvt_pk_bf16(v0[0], v0[1]); w.y = cvt_pk_bf16(v0[2], v0[3]); w.z = cvt_pk_bf16(v1[0], v1[1]); w.w = cvt_pk_bf16(v1[2], v1[3]); return w; }
__device__ __forceinline__ void unpack8(u32x4 w, f32x4& v0, f32x4& v1) {
    v0 = (f32x4){blo(w.x), bhi(w.x), blo(w.y), bhi(w.y)}; v1 = (f32x4){blo(w.z), bhi(w.z), blo(w.w), bhi(w.w)}; }

struct EpiProj {
    static constexpr bool PERM = true, AFTER_DRAIN = false;
    unsigned char* ws;
    __device__ __forceinline__ void operator()(const f32x4 (&acc)[2][2][4][2], const Unit& u, int wr, int wc, int fr, int fq) const {
        bf16* const QB = (bf16*)(ws + AR_QB); bf16* const KV = (bf16*)(ws + AR_KV); bf16* const UB = (bf16*)(ws + AR_UB); bf16* const RW = (bf16*)(ws + AR_RW); bf16* const HALO = (bf16*)(ws + AR_HALO); bf16* const CKV = (bf16*)(ws + AR_CKV);
        const int row0 = u.pm * BM + wr * 64 + fr, cl = wc * 32 + 8 * fq;
        if (u.pn >= 5 && u.pn < 9) {
#pragma unroll
            for (int ai = 0; ai < 2; ++ai)
#pragma unroll
                for (int m = 0; m < 4; ++m) { f32x4 a0 = acc[ai][0][m][0], a1 = acc[ai][0][m][1]; const f32x4 b0 = acc[ai][1][m][0], b1 = acc[ai][1][m][1];
#pragma unroll
                    for (int k = 0; k < 4; ++k) { a0[k] *= fsig(b0[k]); a1[k] *= fsig(b1[k]); }
                    *(u32x4*)(UB + (size_t)(row0 + ai * HALF + m * 16) * 512 + (u.pn - 5) * 128 + cl) = pack8(a0, a1); }
            return;
        }
        if (u.pn == 2) {
#pragma unroll
            for (int ai = 0; ai < 2; ++ai)
#pragma unroll
                for (int m = 0; m < 4; ++m) { const int row = row0 + ai * HALF + m * 16, b = row / SEQ, tt = row % SEQ;
#pragma unroll
                    for (int bj = 0; bj < 2; ++bj) *(u32x4*)(CKV + (((size_t)bj * (BATCH * NKV) + b * NKV + (cl >> 6)) * SEQ + tt) * 64 + (cl & 63)) = pack8(acc[ai][bj][m][0], acc[ai][bj][m][1]); }
            return;
        }
        bf16* base; int ld, c0;
        if (u.pn < 2) { base = QB; ld = LDQ; c0 = u.pn * 256; } else if (u.pn < 5) { base = KV; ld = LDKV; c0 = (u.pn - 3) * 256; } else { base = RW; ld = LDRW; c0 = (u.pn - 9) * 256; }
#pragma unroll
        for (int ai = 0; ai < 2; ++ai)
#pragma unroll
            for (int m = 0; m < 4; ++m)
#pragma unroll
                for (int bj = 0; bj < 2; ++bj) { const u32x4 w = pack8(acc[ai][bj][m][0], acc[ai][bj][m][1]);
                    *(u32x4*)(base + (size_t)(row0 + ai * HALF + m * 16) * ld + c0 + bj * HALF + cl) = w;
                    if (u.pn >= 9 && ai == 1 && m == 3 && wr == 1 && fr == 15) *(u32x4*)(HALO + (size_t)u.pm * LDRW + c0 + bj * HALF + cl) = w; }
    }
};
struct EpiStore {
    static constexpr bool PERM = true, AFTER_DRAIN = false;
    bf16* O; int ld, ntn;
    __device__ __forceinline__ void operator()(const f32x4 (&acc)[2][2][4][2], const Unit& u, int wr, int wc, int fr, int fq) const {
        const int row0 = u.pm * BM + wr * 64 + fr, c0 = (u.pn % ntn) * 256 + wc * 32 + 8 * fq;
#pragma unroll
        for (int ai = 0; ai < 2; ++ai)
#pragma unroll
            for (int m = 0; m < 4; ++m)
#pragma unroll
                for (int bj = 0; bj < 2; ++bj) *(u32x4*)(O + (size_t)(row0 + ai * HALF + m * 16) * ld + c0 + bj * HALF) = pack8(acc[ai][bj][m][0], acc[ai][bj][m][1]);
    }
};
struct EpiGate {
    static constexpr bool PERM = true, AFTER_DRAIN = false;
    unsigned char* ws; int ntn;
    __device__ __forceinline__ void operator()(const f32x4 (&acc)[2][2][4][2], const Unit& u, int wr, int wc, int fr, int fq) const {
        const bf16* const OB = (const bf16*)(ws + AR_OBUF); bf16* const MIX = (bf16*)(ws + AR_MIX);
        const int br = u.pn / ntn, row0 = u.pm * BM + wr * 64 + fr, c0 = (u.pn % ntn) * 256 + wc * 32 + 8 * fq;
        const bf16* ob = OB + (size_t)br * T * DM;
#pragma unroll
        for (int ai = 0; ai < 2; ++ai) {
            u32x4 o[4][2], mx[4][2];
#pragma unroll
            for (int m = 0; m < 4; ++m)
#pragma unroll
                for (int bj = 0; bj < 2; ++bj) { const size_t off = (size_t)(row0 + ai * HALF + m * 16) * DM + c0 + bj * HALF; o[m][bj] = *(const u32x4*)(ob + off); if (br != 0) mx[m][bj] = *(const u32x4*)(MIX + off); }
#pragma unroll
            for (int m = 0; m < 4; ++m)
#pragma unroll
                for (int bj = 0; bj < 2; ++bj) { const size_t off = (size_t)(row0 + ai * HALF + m * 16) * DM + c0 + bj * HALF;
                    f32x4 o0, o1; unpack8(o[m][bj], o0, o1);
                    f32x4 g0 = acc[ai][bj][m][0], g1 = acc[ai][bj][m][1];
#pragma unroll
                    for (int k = 0; k < 4; ++k) { g0[k] = fsig(g0[k]) * o0[k]; g1[k] = fsig(g1[k]) * o1[k]; }
                    if (br != 0) { f32x4 p0, p1; unpack8(mx[m][bj], p0, p1); g0 += p0; g1 += p1; }
                    *(u32x4*)(MIX + off) = pack8(g0, g1); }
        }
    }
};
struct EpiResid {
    static constexpr bool PERM = true, AFTER_DRAIN = false;
    const float* base; float* out;
    __device__ __forceinline__ void operator()(const f32x4 (&acc)[2][2][4][2], const Unit& u, int wr, int wc, int fr, int fq) const {
        const int row0 = u.pm * BM + wr * 64 + fr, c0 = u.pn * 256 + wc * 32 + 8 * fq;
#pragma unroll
        for (int ai = 0; ai < 2; ++ai)
#pragma unroll
            for (int mh = 0; mh < 2; ++mh) {
                f32x4 x[2][2][2];
#pragma unroll
                for (int mm = 0; mm < 2; ++mm)
#pragma unroll
                    for (int bj = 0; bj < 2; ++bj) { const size_t off = (size_t)(row0 + ai * HALF + (2 * mh + mm) * 16) * DM + c0 + bj * HALF; x[mm][bj][0] = *(const f32x4*)(base + off); x[mm][bj][1] = *(const f32x4*)(base + off + 4); }
#pragma unroll
                for (int mm = 0; mm < 2; ++mm)
#pragma unroll
                    for (int bj = 0; bj < 2; ++bj) { const int m = 2 * mh + mm; const size_t off = (size_t)(row0 + ai * HALF + m * 16) * DM + c0 + bj * HALF;
                        *(f32x4*)(out + off) = x[mm][bj][0] + acc[ai][bj][m][0]; *(f32x4*)(out + off + 4) = x[mm][bj][1] + acc[ai][bj][m][1]; }
            }
    }
};
struct EpiSwiglu {
    static constexpr bool PERM = true, AFTER_DRAIN = false;
    bf16* ACT; int ld, ntn;
    __device__ __forceinline__ void operator()(const f32x4 (&acc)[2][2][4][2], const Unit& u, int wr, int wc, int fr, int fq) const {
        const int row0 = u.pm * BM + wr * 64 + fr, c0 = (u.pn % ntn) * 128 + wc * 32 + 8 * fq;
#pragma unroll
        for (int ai = 0; ai < 2; ++ai)
#pragma unroll
            for (int m = 0; m < 4; ++m) { f32x4 g0 = acc[ai][0][m][0], g1 = acc[ai][0][m][1]; const f32x4 u0 = acc[ai][1][m][0], u1 = acc[ai][1][m][1];
#pragma unroll
                for (int k = 0; k < 4; ++k) { g0[k] = g0[k] * fsig(g0[k]) * u0[k]; g1[k] = g1[k] * fsig(g1[k]) * u1[k]; }
                *(u32x4*)(ACT + (size_t)(row0 + ai * HALF + m * 16) * ld + c0) = pack8(g0, g1); }
    }
};
struct EpiMoeDown {
    static constexpr bool PERM = true, AFTER_DRAIN = false;
    float* out; const int* rtok; const float* rw; int ntn; float sc;
    __device__ __forceinline__ void operator()(const f32x4 (&acc)[2][2][4][2], const Unit& u, int wr, int wc, int fr, int fq) const {
        const int row0 = u.pm * BM + wr * 64 + fr, c0 = (u.pn % ntn) * 256 + wc * 32 + 8 * fq;
#pragma unroll
        for (int ai = 0; ai < 2; ++ai)
#pragma unroll
            for (int mh = 0; mh < 2; ++mh) {
                int tok[2]; float w[2]; f32x4 x[2][2][2];
#pragma unroll
                for (int mm = 0; mm < 2; ++mm) { const int row = row0 + ai * HALF + (2 * mh + mm) * 16; tok[mm] = rtok[row]; w[mm] = rw[row] * sc; }
#pragma unroll
                for (int mm = 0; mm < 2; ++mm)
#pragma unroll
                    for (int bj = 0; bj < 2; ++bj) { const float* o = out + (size_t)(tok[mm] >= 0 ? tok[mm] : 0) * DM + c0 + bj * HALF; x[mm][bj][0] = *(const f32x4*)o; x[mm][bj][1] = *(const f32x4*)(o + 4); }
#pragma unroll
                for (int mm = 0; mm < 2; ++mm)
#pragma unroll
                    for (int bj = 0; bj < 2; ++bj) if (tok[mm] >= 0) { const int m = 2 * mh + mm; float* o = out + (size_t)tok[mm] * DM + c0 + bj * HALF;
                        *(f32x4*)o = x[mm][bj][0] + acc[ai][bj][m][0] * w[mm]; *(f32x4*)(o + 4) = x[mm][bj][1] + acc[ai][bj][m][1] * w[mm]; }
            }
    }
};

constexpr int MT_KS = 7, MT_K = EXPERT_FF / MT_KS;
struct MoeTailOrder {
    int nN, pm0, nsub, G, c, e0, e1, e2, e3, e4, e5, e6;
    __device__ void init(const MoeOrder& m, int pm0_, int ntiles, int G_, int c_) { nN = m.nN; pm0 = pm0_; nsub = ntiles * MT_KS; G = G_; c = c_; e0 = m.e0; e1 = m.e1; e2 = m.e2; e3 = m.e3; e4 = m.e4; e5 = m.e5; e6 = m.e6; }
    __device__ bool next(int i, Unit& u) const { const int L = i * G + c; if (L >= nsub) return false;
        const int j = L / MT_KS, ks = L - j * MT_KS, pm = pm0 + j / nN, pl = j % nN, e = (pm >= e0) + (pm >= e1) + (pm >= e2) + (pm >= e3) + (pm >= e4) + (pm >= e5) + (pm >= e6);
        u.pm = rfl(pm); u.pn = rfl((e * nN + pl) | (ks << 16)); return true; }
    __device__ __forceinline__ void a_ready(const Unit&) const {}
    __device__ __forceinline__ void done(const Unit&) const {}
};
struct EpiPart {
    static constexpr bool PERM = true, AFTER_DRAIN = false;
    float* part; int pm0, nN;
    __device__ __forceinline__ void operator()(const f32x4 (&acc)[2][2][4][2], const Unit& u, int wr, int wc, int fr, int fq) const {
        const int slot = ((u.pm - pm0) * nN + (u.pn & 0xffff) % nN) * MT_KS + (u.pn >> 16);
        float* b = part + (size_t)slot * 65536 + (size_t)(((wr * 4 + wc) * 64 + fq * 16 + fr) * 4);
#pragma unroll
        for (int ai = 0; ai < 2; ++ai)
#pragma unroll
            for (int bj = 0; bj < 2; ++bj)
#pragma unroll
                for (int m = 0; m < 4; ++m)
#pragma unroll
                    for (int n = 0; n < 2; ++n) *(f32x4*)(b + (((ai * 2 + bj) * 4 + m) * 2 + n) * 2048) = acc[ai][bj][m][n];
    }
};
__device__ __forceinline__ void moe_tail_combine(const EpiMoeDown& E, const MoeOrder& mo, const float* part, int pm0, int job, int lane_in) {
    int lane = lane_in; asm volatile("" : "+v"(lane));
    const int q = job & 3, role = (job >> 2) & 7, j = job >> 5, ai = q >> 1, mh = q & 1, pm = pm0 + j / mo.nN, pl = j % mo.nN, wr = role >> 2, wc = role & 3, fr = lane & 15, fq = lane >> 4;
    const float* b = part + (size_t)j * MT_KS * 65536 + (size_t)((role * 64 + lane) * 4);
    f32x4 a[2][2][2];
#pragma unroll
    for (int mm = 0; mm < 2; ++mm)
#pragma unroll
        for (int bj = 0; bj < 2; ++bj)
#pragma unroll
            for (int n = 0; n < 2; ++n) a[mm][bj][n] = *(const f32x4*)(b + (((ai * 2 + bj) * 4 + 2 * mh + mm) * 2 + n) * 2048);
#pragma unroll
    for (int ks = 1; ks < MT_KS; ++ks)
#pragma unroll
        for (int mm = 0; mm < 2; ++mm)
#pragma unroll
            for (int bj = 0; bj < 2; ++bj)
#pragma unroll
                for (int n = 0; n < 2; ++n) a[mm][bj][n] += *(const f32x4*)(b + (size_t)ks * 65536 + (((ai * 2 + bj) * 4 + 2 * mh + mm) * 2 + n) * 2048);
    const int row0 = pm * BM + wr * 64 + fr + ai * HALF + 2 * mh * 16, c0 = pl * 256 + wc * 32 + 8 * fq;
#pragma unroll
    for (int mm = 0; mm < 2; ++mm) { const int tok = E.rtok[row0 + mm * 16]; const float w = E.rw[row0 + mm * 16] * E.sc;
        if (tok >= 0) {
#pragma unroll
            for (int bj = 0; bj < 2; ++bj) { float* o = E.out + (size_t)tok * DM + c0 + bj * HALF; const f32x4 x0 = *(const f32x4*)o, x1 = *(const f32x4*)(o + 4);
                *(f32x4*)o = x0 + a[mm][bj][0] * w; *(f32x4*)(o + 4) = x1 + a[mm][bj][1] * w; } } }
}

typedef short bf16x8_t __attribute__((ext_vector_type(8)));
#define MFMA16(a, b, c) __builtin_amdgcn_mfma_f32_16x16x32_bf16((a), (b), (c), 0, 0, 0)
constexpr float ATT_C = 0.125f * 1.4426950408889634f;
constexpr int AW_IMP = 0, AW_SEL = 8448, AW_QS = 8960, AW_BYTES = 8960 + 8192;
__device__ __forceinline__ float bperm_f(float v, int srclane) { return __builtin_bit_cast(float, __builtin_amdgcn_ds_bpermute(srclane << 2, __builtin_bit_cast(int, v))); }
__device__ __forceinline__ int bperm_i(int v, int srclane) { return __builtin_amdgcn_ds_bpermute(srclane << 2, v); }
__device__ __forceinline__ bf16x8_t ldg8(const bf16* p) { return *(const bf16x8_t*)p; }
__device__ __forceinline__ bf16x8_t pack_p(const f32x4& a, const f32x4& b) {
    v4u w; w.x = cvt_pk_bf16(a[0], a[1]); w.y = cvt_pk_bf16(a[2], a[3]); w.z = cvt_pk_bf16(b[0], b[1]); w.w = cvt_pk_bf16(b[2], b[3]); return __builtin_bit_cast(bf16x8_t, w); }

__device__ __forceinline__ void nsa_attn_item(const P& p, int item, int lane, LAS unsigned char* wl) {
    const bf16* KV = WSP(bf16, AR_KV); const bf16* KC = WSP(bf16, AR_KC); const bf16* VcT = WSP(bf16, AR_VCT); const bf16* VsT = WSP(bf16, WS_VST); const bf16* VwT = WSP(bf16, WS_VWT);
    bf16* QB = WSP(bf16, AR_QB); const float* NG = WSP(float, AR_NG);
    const int bg = item / (SEQ / 16), t0 = (item % (SEQ / 16)) * 16, b = bg >> 1, g = bg & 1;
    const int col = lane & 15, fq = lane >> 4, tok = t0 + col;
    const size_t grow = (size_t)b * SEQ + tok;
    LAS float* IMP = (LAS float*)(wl + AW_IMP); LAS int* SEL = (LAS int*)(wl + AW_SEL); LAS bf16* OS = (LAS bf16*)(wl + AW_IMP);
    const int krowA = 8 * (col >> 2) + (col & 3);
    const float* gate = NG + grow * 24 + g * 12;
    LAS bf16x8_t* QS = (LAS bf16x8_t*)(wl + AW_QS) + lane;
#pragma unroll
    for (int hh = 0; hh < 4; ++hh)
#pragma unroll
        for (int ks = 0; ks < 2; ++ks) QS[(hh * 2 + ks) * 64] = ldg8(QB + grow * LDQ + (g * 4 + hh) * 64 + ks * 32 + fq * 8);
#define Qc(hh, ks) (QS[((hh) * 2 + (ks)) * 64])
    for (int i = lane; i < 16 * 132; i += 64) IMP[i] = 0.f;
    const f32x4 z4 = {0.f, 0.f, 0.f, 0.f};
    f32x4 O[4][4];
    int nvmax = (t0 + 15 >= 31) ? (((t0 + 15 - 31) >> 4) + 1) : 0; if (nvmax > NC) nvmax = NC;
    const int nch = (nvmax + 31) >> 5;
    const bf16* kcb = KC + (size_t)bg * 512 * 64; const bf16* vcb = VcT + (size_t)bg * 64 * 512;
    float linv[4] = {0.f, 0.f, 0.f, 0.f};
#pragma unroll
    for (int hh = 0; hh < 4; ++hh)
#pragma unroll
        for (int mt = 0; mt < 4; ++mt) O[hh][mt] = z4;
#pragma unroll 1
    for (int pass = 0; pass < 2; ++pass) {
#pragma unroll 1
        for (int ch = 0; ch < nch; ++ch) {
            asm volatile("" ::: "memory");
            const int k0 = 32 * ch; const bool cfull = 16 * (k0 + 31) + 31 <= t0;
            bf16x8_t ka[2][2];
#pragma unroll
            for (int tl = 0; tl < 2; ++tl)
#pragma unroll
                for (int ks = 0; ks < 2; ++ks) ka[tl][ks] = ldg8(kcb + ((size_t)(4 * ks + fq) * 512 + k0 + 16 * tl + col) * 8);
            bf16x8_t va[4];
            if (pass == 1) {
#pragma unroll
                for (int mt = 0; mt < 4; ++mt) va[mt] = ldg8(vcb + ((size_t)((k0 >> 3) + fq) * 64 + 16 * mt + col) * 8);
            }
            float ps[8] = {0.f, 0.f, 0.f, 0.f, 0.f, 0.f, 0.f, 0.f};
#pragma unroll
            for (int hh = 0; hh < 4; ++hh) {
                const bf16x8_t q0_ = Qc(hh, 0), q1_ = Qc(hh, 1);
                f32x4 sa = MFMA16(ka[0][0], q0_, z4); sa = MFMA16(ka[0][1], q1_, sa);
                f32x4 sb = MFMA16(ka[1][0], q0_, z4); sb = MFMA16(ka[1][1], q1_, sb);
#pragma unroll
                for (int i = 0; i < 4; ++i) { sa[i] = __builtin_amdgcn_exp2f(sa[i]); sb[i] = __builtin_amdgcn_exp2f(sb[i]); }
                if (!cfull) {
#pragma unroll
                    for (int i = 0; i < 4; ++i) { const int c = k0 + 4 * fq + i; sa[i] = (16 * c + 31 <= tok) ? sa[i] : 0.f; sb[i] = (16 * (c + 16) + 31 <= tok) ? sb[i] : 0.f; } }
                if (pass == 0) { linv[hh] += (sa[0] + sa[1]) + (sa[2] + sa[3]) + (sb[0] + sb[1]) + (sb[2] + sb[3]); }
                else {
#pragma unroll
                    for (int i = 0; i < 4; ++i) { ps[i] = __builtin_fmaf(sa[i], linv[hh], ps[i]); ps[4 + i] = __builtin_fmaf(sb[i], linv[hh], ps[4 + i]); }
                    const bf16x8_t pt = pack_p(sa, sb);
#pragma unroll
                    for (int mt = 0; mt < 4; ++mt) O[hh][mt] = MFMA16(va[mt], pt, O[hh][mt]);
                }
            }
            if (pass == 1) {
                const int Ga = 8 * ch + fq; LAS float* ir = IMP + col * 132 + Ga;
                __hip_atomic_fetch_add(ir, (ps[0] + ps[1]) + (ps[2] + ps[3]), __ATOMIC_RELAXED, __HIP_MEMORY_SCOPE_WORKGROUP);
                __hip_atomic_fetch_add(ir + 1, ps[3], __ATOMIC_RELAXED, __HIP_MEMORY_SCOPE_WORKGROUP);
                __hip_atomic_fetch_add(ir + 4, (ps[4] + ps[5]) + (ps[6] + ps[7]), __ATOMIC_RELAXED, __HIP_MEMORY_SCOPE_WORKGROUP);
                if (Ga + 5 < NS) __hip_atomic_fetch_add(ir + 5, ps[7], __ATOMIC_RELAXED, __HIP_MEMORY_SCOPE_WORKGROUP);
            }
        }
        if (pass == 0) {
#pragma unroll
            for (int hh = 0; hh < 4; ++hh) { float l = linv[hh]; l += bperm_f(l, lane ^ 16); l += bperm_f(l, lane ^ 32); linv[hh] = l > 0.f ? 1.f / l : 0.f; }
        }
    }
    LDS_WAIT(); asm volatile("" ::: "memory");
    {
        const int cur = tok >> 6; LAS float* sc = IMP + col * 132;
        for (int j = fq * 32; j < fq * 32 + 32; ++j) { const bool forced = (j == 0) || (j == cur) || (j == cur - 1); const float v = sc[j]; sc[j] = forced ? 1e4f : (j <= cur ? v : -1.f); }
        LDS_WAIT(); asm volatile("" ::: "memory");
#pragma unroll 1
        for (int r = 0; r < 8; ++r) {
            float bv = sc[fq * 32]; int bj = fq * 32;
            for (int j = fq * 32 + 1; j < fq * 32 + 32; ++j) { const float v = sc[j]; if (v > bv) { bv = v; bj = j; } }
#pragma unroll
            for (int o = 16; o <= 32; o <<= 1) { const float ov = bperm_f(bv, lane ^ o); const int oj = bperm_i(bj, lane ^ o); if (ov > bv || (ov == bv && oj < bj)) { bv = ov; bj = oj; } }
            if ((bj >> 5) == fq) sc[bj] = -3e38f;
            if (fq == 0) SEL[col * 8 + r] = bj;
            LDS_WAIT(); asm volatile("" ::: "memory");
        }
    }
#pragma unroll
    for (int hh = 0; hh < 4; ++hh) { const float g0 = gate[hh * 3 + 0] * linv[hh];
#pragma unroll
        for (int mt = 0; mt < 4; ++mt) { const f32x4 o = O[hh][mt] * g0; v2u w; w.x = cvt_pk_bf16(o[0], o[1]); w.y = cvt_pk_bf16(o[2], o[3]);
            *(LAS v2u*)(OS + (col * 4 + hh) * 64 + 16 * mt + 4 * fq) = w; } }
    LDS_WAIT(); asm volatile("" ::: "memory");
    const int cur = t0 >> 6;
    {
        const bf16* kwb = WSP(bf16, WS_KW8) + (size_t)bg * 8 * SEQ * 8; const bf16* vwb = VwT + (size_t)bg * 64 * SEQ;
        const bf16* ksb = WSP(bf16, WS_KS8) + (size_t)bg * 8 * SEQ * 8; const bf16* vsb = VsT + (size_t)bg * 64 * SEQ;
        int kst = t0 - (WINDOW - 1); if (kst < 0) kst = 0; kst &= ~31;
        const int nwin = ((t0 + 15 - kst) >> 5) + 1, nfb = cur >= 2 ? 3 : cur + 1;
#pragma unroll 1
        for (int part = 0; part < 2; ++part) {
            float lw[4] = {0.f, 0.f, 0.f, 0.f};
#pragma unroll
            for (int hh = 0; hh < 4; ++hh)
#pragma unroll
                for (int mt = 0; mt < 4; ++mt) O[hh][mt] = z4;
            const bf16* kb = part ? ksb : kwb; const bf16* vb = part ? vsb : vwb;
            const int nchk = part ? 2 * nfb : nwin;
#pragma unroll 1
            for (int ci = 0; ci < nchk; ++ci) {
                asm volatile("" ::: "memory");
                int k0;
                if (part == 0) k0 = kst + 32 * ci; else { const int fb = ci >> 1, j = fb == 0 ? 0 : (fb == 1 ? cur : cur - 1); k0 = 64 * j + 32 * (ci & 1); }
                bf16x8_t ka[2][2], va[4];
#pragma unroll
                for (int tl = 0; tl < 2; ++tl)
#pragma unroll
                    for (int ks = 0; ks < 2; ++ks) ka[tl][ks] = ldg8(kb + ((size_t)(4 * ks + fq) * SEQ + k0 + 16 * tl + col) * 8);
#pragma unroll
                for (int mt = 0; mt < 4; ++mt) va[mt] = ldg8(vb + ((size_t)((k0 >> 3) + fq) * 64 + 16 * mt + col) * 8);
                const int lowk = part ? -1 : tok - WINDOW; const bool dfull = (k0 + 31 <= t0) && (part || k0 > t0 + 15 - WINDOW);
#pragma unroll
                for (int hh = 0; hh < 4; ++hh) {
                    const bf16x8_t q0_ = Qc(hh, 0), q1_ = Qc(hh, 1);
                    f32x4 sa = MFMA16(ka[0][0], q0_, z4); sa = MFMA16(ka[0][1], q1_, sa);
                    f32x4 sb = MFMA16(ka[1][0], q0_, z4); sb = MFMA16(ka[1][1], q1_, sb);
#pragma unroll
                    for (int i = 0; i < 4; ++i) { sa[i] = __builtin_amdgcn_exp2f(sa[i]); sb[i] = __builtin_amdgcn_exp2f(sb[i]); }
                    if (!dfull) {
#pragma unroll
                        for (int i = 0; i < 4; ++i) { const int kt = k0 + 4 * fq + i; sa[i] = (kt <= tok && kt > lowk) ? sa[i] : 0.f; sb[i] = (kt + 16 <= tok && kt + 16 > lowk) ? sb[i] : 0.f; } }
                    lw[hh] += (sa[0] + sa[1]) + (sa[2] + sa[3]) + (sb[0] + sb[1]) + (sb[2] + sb[3]);
                    const bf16x8_t pt = pack_p(sa, sb);
#pragma unroll
                    for (int mt = 0; mt < 4; ++mt) O[hh][mt] = MFMA16(va[mt], pt, O[hh][mt]);
                }
            }
            LDS_WAIT(); asm volatile("" ::: "memory");
            if (part == 0) {
#pragma unroll
                for (int hh = 0; hh < 4; ++hh) { float l = lw[hh]; l += bperm_f(l, lane ^ 16); l += bperm_f(l, lane ^ 32); const float w = l > 0.f ? gate[hh * 3 + 2] / l : 0.f;
#pragma unroll
                    for (int mt = 0; mt < 4; ++mt) { LAS v2u* dp = (LAS v2u*)(OS + (col * 4 + hh) * 64 + 16 * mt + 4 * fq); const v2u old = *dp;
                        v2u w2; w2.x = cvt_pk_bf16(blo(old.x) + w * O[hh][mt][0], bhi(old.x) + w * O[hh][mt][1]); w2.y = cvt_pk_bf16(blo(old.y) + w * O[hh][mt][2], bhi(old.y) + w * O[hh][mt][3]); *dp = w2; } }
            } else {
                LAS bf16* OF = (LAS bf16*)(wl + AW_QS); LAS float* LF = (LAS float*)(wl + AW_IMP + 8192);
#pragma unroll
                for (int hh = 0; hh < 4; ++hh) { float l = lw[hh]; l += bperm_f(l, lane ^ 16); l += bperm_f(l, lane ^ 32); if (fq == 0) LF[col * 4 + hh] = l;
#pragma unroll
                    for (int mt = 0; mt < 4; ++mt) { v2u w2; w2.x = cvt_pk_bf16(O[hh][mt][0], O[hh][mt][1]); w2.y = cvt_pk_bf16(O[hh][mt][2], O[hh][mt][3]); *(LAS v2u*)(OF + (col * 4 + hh) * 64 + 16 * mt + 4 * fq) = w2; } }
            }
            LDS_WAIT(); asm volatile("" ::: "memory");
        }
    }
    {
        const bf16* ksb = WSP(bf16, WS_KS8) + (size_t)bg * 8 * SEQ * 8; const bf16* vsb = VsT + (size_t)bg * 64 * SEQ;
        const LAS bf16* OF = (const LAS bf16*)(wl + AW_QS); const LAS float* LF = (const LAS float*)(wl + AW_IMP + 8192);
#pragma unroll 1
        for (int tt = 0; tt < 16; ++tt) {
            const int tq = t0 + tt; const size_t qrow = (size_t)b * SEQ + tq;
            bf16x8_t Qh[2];
#pragma unroll
            for (int ks = 0; ks < 2; ++ks) { Qh[ks] = ldg8(QB + qrow * LDQ + (g * 4 + (col & 3)) * 64 + ks * 32 + fq * 8); if (col >= 4) Qh[ks] = (bf16x8_t){0, 0, 0, 0, 0, 0, 0, 0}; }
            f32x4 Os[4] = {z4, z4, z4, z4}; float ls = 0.f;
#ifdef APROBE_SEL
            for (int rp = 0; rp < 2; ++rp) { Os[0] = z4; Os[1] = z4; Os[2] = z4; Os[3] = z4; ls = 0.f; asm volatile("" ::: "memory");
#endif
#pragma unroll 1
            for (int r8 = 0; r8 < 8; ++r8) {
                const int j = __builtin_amdgcn_readfirstlane(SEL[tt * 8 + r8]);
                if (64 * j > tq || j == 0 || j == cur || j == cur - 1) continue;
                const int kb0 = 64 * j;
                bf16x8_t ka[2][2][2], va[2][4];
#pragma unroll
                for (int hf = 0; hf < 2; ++hf) {
#pragma unroll
                    for (int tl = 0; tl < 2; ++tl)
#pragma unroll
                        for (int ks = 0; ks < 2; ++ks) ka[hf][tl][ks] = ldg8(ksb + ((size_t)(4 * ks + fq) * SEQ + kb0 + 32 * hf + 16 * tl + col) * 8);
#pragma unroll
                    for (int mt = 0; mt < 4; ++mt) va[hf][mt] = ldg8(vsb + ((size_t)(((kb0 + 32 * hf) >> 3) + fq) * 64 + 16 * mt + col) * 8);
                }
#pragma unroll
                for (int hf = 0; hf < 2; ++hf) {
                    f32x4 sa = MFMA16(ka[hf][0][0], Qh[0], z4); sa = MFMA16(ka[hf][0][1], Qh[1], sa);
                    f32x4 sb = MFMA16(ka[hf][1][0], Qh[0], z4); sb = MFMA16(ka[hf][1][1], Qh[1], sb);
#pragma unroll
                    for (int i = 0; i < 4; ++i) { sa[i] = __builtin_amdgcn_exp2f(sa[i]); sb[i] = __builtin_amdgcn_exp2f(sb[i]); }
                    ls += (sa[0] + sa[1]) + (sa[2] + sa[3]) + (sb[0] + sb[1]) + (sb[2] + sb[3]);
                    const bf16x8_t pt = pack_p(sa, sb);
#pragma unroll
                    for (int mt = 0; mt < 4; ++mt) Os[mt] = MFMA16(va[hf][mt], pt, Os[mt]);
                }
            }
#ifdef APROBE_SEL
            }
#endif
            ls += bperm_f(ls, lane ^ 16); ls += bperm_f(ls, lane ^ 32);
            if (col < 4) {
                const float den = ls + LF[tt * 4 + col]; const float w = den > 0.f ? (NG + qrow * 24 + g * 12)[col * 3 + 1] / den : 0.f;
#pragma unroll
                for (int mt = 0; mt < 4; ++mt) { const int e = (tt * 4 + col) * 64 + 16 * mt + 4 * fq; const v2u old = *(const LAS v2u*)(OS + e), fo = *(const LAS v2u*)(OF + e);
                    v2u w2; w2.x = cvt_pk_bf16(blo(old.x) + w * (Os[mt][0] + blo(fo.x)), bhi(old.x) + w * (Os[mt][1] + bhi(fo.x))); w2.y = cvt_pk_bf16(blo(old.y) + w * (Os[mt][2] + blo(fo.y)), bhi(old.y) + w * (Os[mt][3] + bhi(fo.y)));
                    *(v2u*)(QB + qrow * LDQ + (g * 4 + col) * 64 + 16 * mt + 4 * fq) = w2; }
            }
        }
    }
    LDS_WAIT(); asm volatile("" ::: "memory");
#undef Qc
}

typedef _Float16 h16x2 __attribute__((ext_vector_type(2)));
__device__ __forceinline__ h16x2 as_h2(unsigned u) { h16x2 r; __builtin_memcpy(&r, &u, 4); return r; }
constexpr int SC_STEPS = 8, SC_BUF = 6 * 1024;
__device__ __forceinline__ float dpp_sum16(float v) {
    v += __builtin_bit_cast(float, __builtin_amdgcn_update_dpp(0, __builtin_bit_cast(int, v), 0xB1, 0xF, 0xF, true));
    v += __builtin_bit_cast(float, __builtin_amdgcn_update_dpp(0, __builtin_bit_cast(int, v), 0x4E, 0xF, 0xF, true));
    v += __builtin_bit_cast(float, __builtin_amdgcn_update_dpp(0, __builtin_bit_cast(int, v), 0x141, 0xF, 0xF, true));
    v += __builtin_bit_cast(float, __builtin_amdgcn_update_dpp(0, __builtin_bit_cast(int, v), 0x140, 0xF, 0xF, true));
    return v;
}
__device__ __forceinline__ void scan_fill(const bf16* RW, const bf16* Wm, const bf16* Am, size_t trow, int h, int lane, LAS unsigned char* buf) {
    const size_t t = trow + (lane >> 3); const int sub = (lane & 7) * 8;
    const bf16* row = RW + t * LDRW + h * 64 + sub;
    __builtin_amdgcn_global_load_lds((const unsigned*)(row + LBLK), (LAS unsigned*)(buf + 0 * 1024), 16, 0, 0);
    __builtin_amdgcn_global_load_lds((const unsigned*)(Am + t * RC + h * 64 + sub), (LAS unsigned*)(buf + 1 * 1024), 16, 0, 0);
    __builtin_amdgcn_global_load_lds((const unsigned*)(Wm + t * RC + h * 64 + sub), (LAS unsigned*)(buf + 2 * 1024), 16, 0, 0);
    __builtin_amdgcn_global_load_lds((const unsigned*)(row + 512), (LAS unsigned*)(buf + 3 * 1024), 16, 0, 0);
    __builtin_amdgcn_global_load_lds((const unsigned*)(row), (LAS unsigned*)(buf + 4 * 1024), 16, 0, 0);
    __builtin_amdgcn_global_load_lds((const unsigned*)(row + 1024), (LAS unsigned*)(buf + 5 * 1024), 16, 0, 0);
}
__device__ __forceinline__ void scan_unit(const P& p, int unit, int lane, LAS unsigned char* wl) {
    const bf16* RW = WSP(bf16, AR_RW); const bf16* Wm = WSP(bf16, AR_W); const bf16* Am = WSP(bf16, AR_A); bf16* Y = WSP(bf16, AR_UB);
    const int rg = unit & 15, h = (unit >> 4) & 7, b = unit >> 7, row = rg * 4 + (lane >> 4), kq = lane & 15;
    const size_t tb = (size_t)b * SEQ;
    float s0 = 0.f, s1 = 0.f, s2 = 0.f, s3 = 0.f;
    __builtin_amdgcn_s_setprio(3);
    scan_fill(RW, Wm, Am, tb, h, lane, wl);
#pragma unroll 1
    for (int c = 0; c < SEQ / SC_STEPS; ++c) {
        LAS unsigned char* buf = wl + (c & 1) * SC_BUF;
        asm volatile("s_waitcnt vmcnt(0) lgkmcnt(0)" ::: "memory");
        if (c + 1 < SEQ / SC_STEPS) scan_fill(RW, Wm, Am, tb + (size_t)(c + 1) * SC_STEPS, h, lane, wl + ((c + 1) & 1) * SC_BUF);
#ifndef SCAN_VARB
        float ys[SC_STEPS];
#pragma unroll
        for (int st = 0; st < SC_STEPS; ++st) {
            const LAS unsigned char* o = buf + st * 128 + kq * 8;
            const v2u kkw = *(const LAS v2u*)(o), bbw = *(const LAS v2u*)(o + 1024), eew = *(const LAS v2u*)(o + 2048), ktw = *(const LAS v2u*)(o + 3072), rrw = *(const LAS v2u*)(o + 4096);
#ifdef SCAN_BF16
            struct F2 { float x, y; }; const F2 kk0{blo(kkw.x), bhi(kkw.x)}, kk1{blo(kkw.y), bhi(kkw.y)}, bb0{blo(bbw.x), bhi(bbw.x)}, bb1{blo(bbw.y), bhi(bbw.y)}, ee0{blo(eew.x), bhi(eew.x)}, ee1{blo(eew.y), bhi(eew.y)}, kt0{blo(ktw.x), bhi(ktw.x)}, kt1{blo(ktw.y), bhi(ktw.y)}, rr0{blo(rrw.x), bhi(rrw.x)}, rr1{blo(rrw.y), bhi(rrw.y)};
            const float vv = bf2f(*(const LAS unsigned short*)(buf + 5 * 1024 + st * 128 + row * 2));
#else
            const h16x2 kk0 = as_h2(kkw.x), kk1 = as_h2(kkw.y), bb0 = as_h2(bbw.x), bb1 = as_h2(bbw.y);
            const h16x2 ee0 = as_h2(eew.x), ee1 = as_h2(eew.y);
#ifdef RKV_BF16
            struct F2 { float x, y; }; const F2 kt0{blo(ktw.x), bhi(ktw.x)}, kt1{blo(ktw.y), bhi(ktw.y)}, rr0{blo(rrw.x), bhi(rrw.x)}, rr1{blo(rrw.y), bhi(rrw.y)};
            const float vv = bf2f(*(const LAS unsigned short*)(buf + 5 * 1024 + st * 128 + row * 2));
#else
            const h16x2 kt0 = as_h2(ktw.x), kt1 = as_h2(ktw.y);
            const h16x2 rr0 = as_h2(rrw.x), rr1 = as_h2(rrw.y);
            const float vv = (float)__builtin_bit_cast(_Float16, *(const LAS unsigned short*)(buf + 5 * 1024 + st * 128 + row * 2));
#endif
#endif
            float d0 = __builtin_fmaf(s0, (float)kk0.x, 0.f); d0 = __builtin_fmaf(s1, (float)kk0.y, d0); float d1 = __builtin_fmaf(s2, (float)kk1.x, 0.f); d1 = __builtin_fmaf(s3, (float)kk1.y, d1);
            const float nskk = -dpp_sum16(d0 + d1);
            s0 = __builtin_fmaf(s0, -(float)ee0.x, s0); s1 = __builtin_fmaf(s1, -(float)ee0.y, s1); s2 = __builtin_fmaf(s2, -(float)ee1.x, s2); s3 = __builtin_fmaf(s3, -(float)ee1.y, s3);
            s0 = __builtin_fmaf(nskk, (float)bb0.x, s0); s1 = __builtin_fmaf(nskk, (float)bb0.y, s1); s2 = __builtin_fmaf(nskk, (float)bb1.x, s2); s3 = __builtin_fmaf(nskk, (float)bb1.y, s3);
            s0 = __builtin_fmaf(vv, (float)kt0.x, s0); s1 = __builtin_fmaf(vv, (float)kt0.y, s1); s2 = __builtin_fmaf(vv, (float)kt1.x, s2); s3 = __builtin_fmaf(vv, (float)kt1.y, s3);
            float y0 = __builtin_fmaf(s0, (float)rr0.x, 0.f); y0 = __builtin_fmaf(s1, (float)rr0.y, y0); float y1 = __builtin_fmaf(s2, (float)rr1.x, 0.f); y1 = __builtin_fmaf(s3, (float)rr1.y, y1);
            ys[st] = dpp_sum16(y0 + y1);
        }
        if (kq < SC_STEPS) { float yv = ys[0];
#pragma unroll
            for (int st = 1; st < SC_STEPS; ++st) yv = (kq == st) ? ys[st] : yv;
            Y[(tb + (size_t)c * SC_STEPS + kq) * RC + h * 64 + row] = f2bf(yv); }
    }
#else
#pragma unroll
        for (int st = 0; st < SC_STEPS; ++st) {
            const LAS unsigned char* o = buf + st * 128 + kq * 8;
            float kk[4], bb[4], ee[4], kt[4], rr[4];
            { const v2u w = *(const LAS v2u*)(o); const h16x2 a = as_h2(w.x), b2 = as_h2(w.y); kk[0] = (float)a.x; kk[1] = (float)a.y; kk[2] = (float)b2.x; kk[3] = (float)b2.y; }
            { const v2u w = *(const LAS v2u*)(o + 1024); const h16x2 a = as_h2(w.x), b2 = as_h2(w.y); bb[0] = (float)a.x; bb[1] = (float)a.y; bb[2] = (float)b2.x; bb[3] = (float)b2.y; }
            { const v2u w = *(const LAS v2u*)(o + 2048); const h16x2 a = as_h2(w.x), b2 = as_h2(w.y); ee[0] = (float)a.x; ee[1] = (float)a.y; ee[2] = (float)b2.x; ee[3] = (float)b2.y; }
            { const v2u w = *(const LAS v2u*)(o + 3072); const h16x2 a = as_h2(w.x), b2 = as_h2(w.y); kt[0] = (float)a.x; kt[1] = (float)a.y; kt[2] = (float)b2.x; kt[3] = (float)b2.y; }
            { const v2u w = *(const LAS v2u*)(o + 4096); const h16x2 a = as_h2(w.x), b2 = as_h2(w.y); rr[0] = (float)a.x; rr[1] = (float)a.y; rr[2] = (float)b2.x; rr[3] = (float)b2.y; }
            const float vv = (float)__builtin_bit_cast(_Float16, *(const LAS unsigned short*)(buf + 5 * 1024 + st * 128 + row * 2));
            const float skk = dpp_sum16((s0 * kk[0] + s1 * kk[1]) + (s2 * kk[2] + s3 * kk[3]));
            s0 = s0 - s0 * ee[0] - skk * bb[0] + vv * kt[0]; s1 = s1 - s1 * ee[1] - skk * bb[1] + vv * kt[1]; s2 = s2 - s2 * ee[2] - skk * bb[2] + vv * kt[2]; s3 = s3 - s3 * ee[3] - skk * bb[3] + vv * kt[3];
            const float y = dpp_sum16((s0 * rr[0] + s1 * rr[1]) + (s2 * rr[2] + s3 * rr[3]));
            if (kq == 0) Y[(tb + (size_t)c * SC_STEPS + st) * RC + h * 64 + row] = f2bf(y);
        }
    }
#endif
    asm volatile("s_waitcnt vmcnt(0) lgkmcnt(0)" ::: "memory");
    __builtin_amdgcn_s_setprio(0);
}
__device__ __forceinline__ float sum8(float v) {
    v += __builtin_bit_cast(float, __builtin_amdgcn_update_dpp(0, __builtin_bit_cast(int, v), 0xB1, 0xF, 0xF, true));
    v += __builtin_bit_cast(float, __builtin_amdgcn_update_dpp(0, __builtin_bit_cast(int, v), 0x4E, 0xF, 0xF, true));
    v += __builtin_bit_cast(float, __builtin_amdgcn_update_dpp(0, __builtin_bit_cast(int, v), 0x141, 0xF, 0xF, true));
    return v;
}
__device__ __forceinline__ void up8(v4u w, float* f) { f[0] = blo(w.x); f[1] = bhi(w.x); f[2] = blo(w.y); f[3] = bhi(w.y); f[4] = blo(w.z); f[5] = bhi(w.z); f[6] = blo(w.w); f[7] = bhi(w.w); }
#ifdef SCAN_BF16
#define uph8 up8
#define pkh8 pk8
#else
#define uph8 uph8_
#define pkh8 pkh8_
#endif
__device__ __forceinline__ void uph8_(v4u w, float* f) { const h16x2 a = as_h2(w.x), b = as_h2(w.y), c = as_h2(w.z), d = as_h2(w.w);
    f[0] = (float)a.x; f[1] = (float)a.y; f[2] = (float)b.x; f[3] = (float)b.y; f[4] = (float)c.x; f[5] = (float)c.y; f[6] = (float)d.x; f[7] = (float)d.y; }
__device__ __forceinline__ unsigned pkh2(float lo, float hi) { h16x2 v; v.x = (_Float16)lo; v.y = (_Float16)hi; return __builtin_bit_cast(unsigned, v); }
__device__ __forceinline__ v4u pkh8_(const float* f) { v4u w; w.x = pkh2(f[0], f[1]); w.y = pkh2(f[2], f[3]); w.z = pkh2(f[4], f[5]); w.w = pkh2(f[6], f[7]); return w; }
__device__ __forceinline__ v4u pk8(const float* f) { v4u w; w.x = cvt_pk_bf16(f[0], f[1]); w.y = cvt_pk_bf16(f[2], f[3]); w.z = cvt_pk_bf16(f[4], f[5]); w.w = cvt_pk_bf16(f[6], f[7]); return w; }
__device__ __forceinline__ void ldf8(const float* p, float* f) { const f32x4 a = *(const f32x4*)p, b = *(const f32x4*)(p + 4); f[0] = a[0]; f[1] = a[1]; f[2] = a[2]; f[3] = a[3]; f[4] = b[0]; f[5] = b[1]; f[6] = b[2]; f[7] = b[3]; }

struct EpiLora {
    static constexpr bool PERM = true, AFTER_DRAIN = false;
    unsigned char* ws;
    __device__ __forceinline__ void operator()(const f32x4 (&acc)[2][2][4][2], const Unit& u, int wr, int wc, int fr, int fq) const {
        const int which = u.pn >> 1, row0 = u.pm * BM + wr * 64 + fr, c0 = (u.pn & 1) * 256 + wc * 32 + 8 * fq;
        bf16* const O = (bf16*)(ws + (which == 0 ? AR_W : (which == 1 ? AR_A : (which == 2 ? AR_G : AR_UB))));
#pragma unroll
        for (int ai = 0; ai < 2; ++ai)
#pragma unroll
            for (int m = 0; m < 4; ++m)
#pragma unroll
                for (int bj = 0; bj < 2; ++bj) *(u32x4*)(O + (size_t)(row0 + ai * HALF + m * 16) * RC + c0 + bj * HALF) = pack8(acc[ai][bj][m][0], acc[ai][bj][m][1]);
    }
};
#ifdef RKV_BF16
#define UPR up8
#define PKR pk8
#else
#define UPR uph8
#define PKR pkh8
#endif
struct B2In { v4u k, a, w, vr, vv, vf; float gt; };
__device__ __forceinline__ void b2w_load(B2In& in, const P& p, int layer, int t, int lane) {
    const bf16* row = WSP(bf16, AR_RW) + (size_t)t * LDRW;
    in.k = *(const v4u*)(row + 512 + 8 * lane); in.a = *(const v4u*)(WSP(bf16, AR_A) + (size_t)t * RC + 8 * lane); in.w = *(const v4u*)(WSP(bf16, AR_W) + (size_t)t * RC + 8 * lane);
    in.gt = lane < 24 ? bf2f(row[LBLK + 320 + lane]) : 0.f;
    if (layer == 1) { in.vr = *(const v4u*)(WSP(bf16, AR_UB) + (size_t)t * RC + 8 * lane); in.vv = *(const v4u*)(row + 1024 + 8 * lane); in.vf = *(const v4u*)(WSP(bf16, WS_VF) + (size_t)t * RC + 8 * lane); }
}
__device__ __forceinline__ void b2w_compute(const B2In& in, const P& p, int layer, int t, int lane, const float* v0, const float* v1, const float* v2, const float* v3, const float* vb) {
    bf16* row = WSP(bf16, AR_RW) + (size_t)t * LDRW; bf16* Am = WSP(bf16, AR_A); bf16* Wm = WSP(bf16, AR_W); float* NG = WSP(float, AR_NG);
    float k[8], a[8], w[8]; uph8(in.k, k); up8(in.a, a); up8(in.w, w);
    const float ngv = fsig(in.gt);
    float kk[8], ss = 0.f;
#pragma unroll
    for (int i = 0; i < 8; ++i) {
        a[i] = fsig(a[i] + v1[i]);
        const float nx = -(w[i] + v0[i]), sp = fmaxf(nx, 0.f) + __logf(1.f + __expf(-fabsf(nx))), e = __expf(-sp - 0.5f); w[i] = 1.f - __expf(-e);
        kk[i] = k[i] * v2[i]; ss += kk[i] * kk[i]; }
    ss = sum8(ss); const float nrm = sqrtf(ss), inv = 1.f / (nrm > 1e-12f ? nrm : 1e-12f);
#pragma unroll
    for (int i = 0; i < 8; ++i) { kk[i] *= inv; k[i] = k[i] * (1.f + (a[i] - 1.f) * v3[i]); a[i] *= kk[i]; }
    asm volatile("" :: "v"(ngv));
    if (layer == 1) { float vr[8], vv[8], vf[8]; up8(in.vr, vr); uph8(in.vv, vv); uph8(in.vf, vf);
#pragma unroll
        for (int i = 0; i < 8; ++i) vv[i] = vv[i] + (vf[i] - vv[i]) * fsig(vr[i] + vb[i]);
        *(v4u*)(row + 1024 + 8 * lane) = pkh8(vv); }
    if (lane < 24) NG[(size_t)t * 24 + lane] = ngv;
    *(v4u*)(row + LBLK + 8 * lane) = pkh8(kk); *(v4u*)(row + 512 + 8 * lane) = pkh8(k);
    *(v4u*)(Am + (size_t)t * RC + 8 * lane) = pkh8(a); *(v4u*)(Wm + (size_t)t * RC + 8 * lane) = pkh8(w);
}
__device__ __forceinline__ void ph_rwkv_b2w(const P& p, int layer, int gw, int NGW, int lane) {
    const float* vec = p.rwkv_vec + (size_t)layer * 7 * RC; float v0[8], v1[8], v2[8], v3[8], vb[8];
    ldf8(vec + 8 * lane, v0); ldf8(vec + RC + 8 * lane, v1); ldf8(vec + 2 * RC + 8 * lane, v2); ldf8(vec + 3 * RC + 8 * lane, v3); ldf8(p.vres_b + 8 * lane, vb);
    int t = gw; if (t >= T) return;
    B2In A, B; b2w_load(A, p, layer, t, lane);
    for (; t < T; t += 2 * NGW) { const int t1 = t + NGW, t2 = t1 + NGW;
        b2w_load(B, p, layer, t1 < T ? t1 : t, lane); b2w_compute(A, p, layer, t, lane, v0, v1, v2, v3, vb);
        if (t1 < T) { b2w_load(A, p, layer, t2 < T ? t2 : t1, lane); b2w_compute(B, p, layer, t1, lane, v0, v1, v2, v3, vb); } }
}
struct PoIn { v4u y, r, k, v, g; };
__device__ __forceinline__ void post_load(PoIn& in, const P& p, int t, int lane) { const bf16* row = WSP(bf16, AR_RW) + (size_t)t * LDRW;
    in.y = *(const v4u*)(WSP(bf16, AR_UB) + (size_t)t * RC + 8 * lane); in.r = *(const v4u*)(row + 8 * lane); in.k = *(const v4u*)(row + 512 + 8 * lane); in.v = *(const v4u*)(row + 1024 + 8 * lane); in.g = *(const v4u*)(WSP(bf16, AR_G) + (size_t)t * RC + 8 * lane); }
__device__ __forceinline__ void post_compute(const PoIn& in, const P& p, int t, int lane, const float* v4_, const float* v5, const float* v6) {
    float y[8], r[8], k[8], v[8], g[8]; up8(in.y, y); uph8(in.r, r); uph8(in.k, k); uph8(in.v, v); up8(in.g, g);
    float s = 0.f, bon = 0.f;
#pragma unroll
    for (int i = 0; i < 8; ++i) { s += y[i]; bon += r[i] * k[i] * v4_[i]; }
    const float m = sum8(s) * (1.f / 64.f); bon = sum8(bon);
    float q = 0.f;
#pragma unroll
    for (int i = 0; i < 8; ++i) { y[i] -= m; q += y[i] * y[i]; }
    const float rstd = 1.f / sqrtf(sum8(q) * (1.f / 64.f) + GN_EPS);
#pragma unroll
    for (int i = 0; i < 8; ++i) y[i] = (y[i] * rstd * v5[i] + v6[i] + bon * v[i]) * g[i];
    *(v4u*)(WSP(bf16, AR_A) + (size_t)t * RC + 8 * lane) = pk8(y);
}
__device__ __forceinline__ void ph_rwkv_postw(const P& p, int layer, int gw, int NGW, int lane) {
    const float* vec = p.rwkv_vec + (size_t)layer * 7 * RC; float v4_[8], v5[8], v6[8]; ldf8(vec + 4 * RC + 8 * lane, v4_); ldf8(vec + 5 * RC + 8 * lane, v5); ldf8(vec + 6 * RC + 8 * lane, v6);
    int t = gw; if (t >= T) return;
    PoIn A, B; post_load(A, p, t, lane);
    for (; t < T; t += 2 * NGW) { const int t1 = t + NGW, t2 = t1 + NGW;
        post_load(B, p, t1 < T ? t1 : t, lane); post_compute(A, p, t, lane, v4_, v5, v6);
        if (t1 < T) { post_load(A, p, t2 < T ? t2 : t1, lane); post_compute(B, p, t1, lane, v4_, v5, v6); } }
}
__device__ __forceinline__ void ph_convw(const P& p, int layer, int gw, int NGW, int lane, int tid, LAS unsigned char* lds) {
    const bf16* UB = WSP(bf16, AR_UB); bf16* CO = WSP(bf16, AR_CO);
    const float* cw = p.conv_w + (size_t)layer * CONV_K * CONV_CH; const float* cv = p.conv_vec + (size_t)layer * 3 * CONV_CH;
    LAS float* wl = (LAS float*)lds;
    for (int i = tid; i < CONV_K * CONV_CH; i += NTHREADS) wl[i] = cw[i];
    __syncthreads();
    float b0[8], g1[8], b2[8]; ldf8(cv + 8 * lane, b0); ldf8(cv + CONV_CH + 8 * lane, g1); ldf8(cv + 2 * CONV_CH + 8 * lane, b2);
    for (int tb = gw * 4; tb < T; tb += NGW * 4) {
        const int pos0 = tb % SEQ, j0 = pos0 >= 30 ? 0 : 30 - pos0;
        float a[4][8], wt[4][8];
#pragma unroll
        for (int q = 0; q < 4; ++q)
#pragma unroll
            for (int i = 0; i < 8; ++i) a[q][i] = b0[i];
#pragma unroll 1
        for (int j4 = 0; j4 < CONV_K + 3; j4 += 4) {
#pragma unroll
            for (int jj = 0; jj < 4; ++jj) { const int j = j4 + jj;
                if (j < CONV_K) { const f32x4 w0 = *(const LAS f32x4*)(wl + j * CONV_CH + 8 * lane), w1 = *(const LAS f32x4*)(wl + j * CONV_CH + 8 * lane + 4);
#pragma unroll
                    for (int i = 0; i < 4; ++i) { wt[jj][i] = w0[i]; wt[jj][4 + i] = w1[i]; } }
                float u[8];
                if (j >= j0 && j < CONV_K + 3) up8(*(const v4u*)(UB + (size_t)(tb - 30 + j) * CONV_CH + 8 * lane), u); else {
#pragma unroll
                    for (int i = 0; i < 8; ++i) u[i] = 0.f; }
#pragma unroll
                for (int q = 0; q < 4; ++q) { const int tap = j - q; if (tap >= 0 && tap < CONV_K) {
#pragma unroll
                    for (int i = 0; i < 8; ++i) a[q][i] += u[i] * wt[(jj - q) & 3][i]; } }
            }
        }
#pragma unroll
        for (int q = 0; q < 4; ++q) {
            float s = 0.f;
#pragma unroll
            for (int i = 0; i < 8; ++i) s += a[q][i];
            const float mean = wave_sum(s, lane) * (1.f / CONV_CH); float qq = 0.f;
#pragma unroll
            for (int i = 0; i < 8; ++i) { a[q][i] -= mean; qq += a[q][i] * a[q][i]; }
            const float rstd = 1.f / sqrtf(wave_sum(qq, lane) * (1.f / CONV_CH) + LN_EPS);
#pragma unroll
            for (int i = 0; i < 8; ++i) { const float y = a[q][i] * rstd * g1[i] + b2[i]; a[q][i] = y * fsig(y); }
            *(v4u*)(CO + (size_t)(tb + q) * CONV_CH + 8 * lane) = pk8(a[q]);
        }
    }
    __syncthreads();
}
__device__ __forceinline__ void ph_cmp2w(const P& p, int layer, int gw, int NGW, int lane, LAS float* hl  ) {
    const bf16* Z = WSP(bf16, AR_HID); const float* pec = (const float*)(p.ws + WS_W + (size_t)layer * SZ_LAYERW + OFF_PEC);
    for (int it = gw; it < 2 * BATCH * NKV * NC; it += NGW) {
        const int i = it % NC, r = it / NC, bg = r % (BATCH * NKV), which = r / (BATCH * NKV);
        const bf16* z1 = Z + ((size_t)which * (BATCH * NKV * 512) + (size_t)bg * 512 + i) * 256; const bf16* z2 = z1 + 256 + 128;
#pragma unroll
        for (int jj = 0; jj < 2; ++jj) { const int j = lane + 64 * jj; const float x = bf2f(z1[j]) + bf2f(z2[j]) + pec[which * 128 + j];
            const float e = __expf(fminf(2.f * 0.7978845608028654f * (x + 0.044715f * x * x * x), 30.f)); hl[j] = 0.5f * x * (1.f + (e - 1.f) / (e + 1.f)); }
        LDS_WAIT(); asm volatile("" ::: "memory");
        const float* w2 = p.cmp_w2 + (size_t)(layer * 2 + which) * 128 * 64 + lane; float o = 0.f;
#pragma unroll 8
        for (int j = 0; j < 128; ++j) o += hl[j] * w2[j * 64];
        if (which == 0) {
            const float rs = 1.f / sqrtf(wave_sum(o * o, lane) * (1.f / 64.f) + RMS_EPS); o = o * rs * p.qk_g[(layer * 4 + 1) * 64 + lane];
            const float other = bperm_f(o, lane ^ 32); float cs, sn; rope_cs(16 * i + 31, lane & 31, cs, sn);
            o = lane < 32 ? o * cs - other * sn : o * cs + other * sn;
            WSP(bf16, AR_KC)[(((size_t)bg * 8 + (lane >> 3)) * 512 + i) * 8 + (lane & 7)] = f2bf(o);
        } else { bf16* vt = WSP(bf16, AR_VCT) + (size_t)bg * 64 * 512 + lane * 8;
            vt[(size_t)((i >> 5) * 4 + ((i & 15) >> 2)) * 512 + (i & 3) + 4 * ((i >> 4) & 1)] = f2bf(o); if (i == 0) vt[(size_t)((NC >> 5) * 4 + ((NC & 15) >> 2)) * 512 + (NC & 3) + 4 * ((NC >> 4) & 1)] = 0; }
        LDS_WAIT(); asm volatile("" ::: "memory");
    }
}

struct MapPlain { bf16* base; int K; __device__ __forceinline__ bf16* operator()(int col) const { return base + (size_t)col * K; } };
struct MapGlu { bf16* base; int K, ff; __device__ __forceinline__ bf16* operator()(int col) const { return base + (size_t)glu_dest(col, ff) * K; } };
struct MapWin { unsigned char* wl; int layer; __device__ __forceinline__ bf16* operator()(int col) const { int which; const int r = win_dest(col, layer, which); const size_t off = (which ? OFF_WG : OFF_WIN) + (size_t)(r < 0 ? 0 : r) * DM * 2; return r < 0 ? nullptr : (bf16*)(wl + off); } };
template <class Map>
__device__ __forceinline__ void transpose_item(const float* W, int K, int N, const Map& mp, LAS float* scr, int item, int lane) {
    const int nblk = (N + 31) / 32, kb = item / nblk, nb = item % nblk, k0 = 64 * kb, n0 = 32 * nb;
    const int col = n0 + (lane & 31);
#pragma unroll 8
    for (int i = 0; i < 32; ++i) { const int kk = 2 * i + (lane >> 5); scr[kk * 33 + (lane & 31)] = col < N ? W[(size_t)(k0 + kk) * N + col] : 0.f; }
    LDS_WAIT(); asm volatile("" ::: "memory");
    const int c = lane & 7;
#pragma unroll
    for (int j = 0; j < 4; ++j) { const int n = (lane >> 3) + 8 * j; const LAS float* s = scr + (8 * c) * 33 + n;
        v4u o; o.x = (unsigned)f2bf(s[0]) | ((unsigned)f2bf(s[33]) << 16); o.y = (unsigned)f2bf(s[66]) | ((unsigned)f2bf(s[99]) << 16);
        o.z = (unsigned)f2bf(s[132]) | ((unsigned)f2bf(s[165]) << 16); o.w = (unsigned)f2bf(s[198]) | ((unsigned)f2bf(s[231]) << 16);
        if (n0 + n < N) { bf16* d = mp(n0 + n); if (d) *(v4u*)(d + k0 + 8 * c) = o; } }
    LDS_WAIT(); asm volatile("" ::: "memory");
}
template <class Map>
__device__ __forceinline__ bool conv_job(int& r, const float* W, int K, int N, const Map& mp, LAS float* scr, int lane) {
    const int items = (K / 64) * ((N + 31) / 32);
    if (r < items) { transpose_item(W, K, N, mp, scr, r, lane); return true; }
    r -= items; return false;
}

struct RmsIn { f32x4 v[DM / 256]; };
__device__ __forceinline__ void rms_load(RmsIn& r, const float* xrow, int lane) { const f32x4* xr = (const f32x4*)xrow + lane;
#pragma unroll
    for (int j = 0; j < DM / 256; ++j) r.v[j] = xr[64 * j]; }
__device__ __forceinline__ void rms_row(const P& p, const RmsIn& rin, const float* g, bf16* orow, int lane, bool route, int t, unsigned long long& c0, unsigned long long& c1) {
    const f32x4* gr = (const f32x4*)g + lane;
    f32x4 v[DM / 256]; float ss = 0.f;
#pragma unroll
    for (int j = 0; j < DM / 256; ++j) { v[j] = rin.v[j]; ss += (v[j].x * v[j].x + v[j].y * v[j].y) + (v[j].z * v[j].z + v[j].w * v[j].w); }
    const float rs = 1.f / sqrtf(wave_sum(ss, lane) * (1.f / DM) + RMS_EPS);
    v2u* o8 = (v2u*)orow + lane;
#pragma unroll
    for (int j = 0; j < DM / 256; ++j) { const f32x4 gg = gr[64 * j]; v[j].x *= rs * gg.x; v[j].y *= rs * gg.y; v[j].z *= rs * gg.z; v[j].w *= rs * gg.w;
        v2u w; w.x = cvt_pk_bf16(v[j].x, v[j].y); w.y = cvt_pk_bf16(v[j].z, v[j].w); o8[64 * j] = w; }
    if (route) {
        float lg[NEXP];
#pragma unroll
        for (int e = 0; e < NEXP; ++e) lg[e] = 0.f;
#pragma unroll
        for (int j = 0; j < DM / 256; ++j) { const float* rw = p.router_w + (size_t)(4 * (lane + 64 * j)) * NEXP;
#pragma unroll
            for (int e = 0; e < NEXP; ++e) lg[e] += v[j].x * rw[e] + v[j].y * rw[NEXP + e] + v[j].z * rw[2 * NEXP + e] + v[j].w * rw[3 * NEXP + e]; }
#pragma unroll
        for (int e = 0; e < NEXP; ++e) lg[e] = wave_sum(lg[e], lane) + p.router_b[e];
        int e0 = 0; float l0 = lg[0];
#pragma unroll
        for (int e = 1; e < NEXP; ++e) if (lg[e] > l0) { l0 = lg[e]; e0 = e; }
        int e1 = -1; float l1 = -3e38f;
#pragma unroll
        for (int e = 0; e < NEXP; ++e) if (e != e0 && lg[e] > l1) { l1 = lg[e]; e1 = e; }
        e0 = __builtin_amdgcn_readfirstlane(e0); e1 = __builtin_amdgcn_readfirstlane(e1);
        const int r0 = (int)((c0 >> (8 * e0)) & 255ull), r1 = (int)((c1 >> (8 * e1)) & 255ull);
        c0 += 1ull << (8 * e0); c1 += 1ull << (8 * e1);
        if (lane == 0) { const float w0 = 1.f / (1.f + expf(l1 - l0));
            WSP(int, AR_RTE)[t] = e0 | (e1 << 8) | (r0 << 16) | (r1 << 24); float* rw = WSP(float, AR_RTW) + (size_t)t * 2; rw[0] = w0; rw[1] = 1.f - w0; }
    }
}
__device__ __forceinline__ void copy_rows4(const bf16* s0, const bf16* s1, const bf16* s2, const bf16* s3, bf16* d0, bf16* d1, bf16* d2, bf16* d3, int lane) {
    v4u a[4][DM / 512];
#pragma unroll
    for (int j = 0; j < DM / 512; ++j) { a[0][j] = ((const v4u*)s0)[lane + 64 * j]; a[1][j] = ((const v4u*)s1)[lane + 64 * j]; a[2][j] = ((const v4u*)s2)[lane + 64 * j]; a[3][j] = ((const v4u*)s3)[lane + 64 * j]; }
#pragma unroll
    for (int j = 0; j < DM / 512; ++j) { ((v4u*)d0)[lane + 64 * j] = a[0][j]; ((v4u*)d1)[lane + 64 * j] = a[1][j]; ((v4u*)d2)[lane + 64 * j] = a[2][j]; ((v4u*)d3)[lane + 64 * j] = a[3][j]; }
}
__device__ __forceinline__ void copy_row_wave(const bf16* src, bf16* dst, int lane) {
#pragma unroll
    for (int j = 0; j < DM / 512; ++j) ((v4u*)dst)[lane + 64 * j] = ((const v4u*)src)[lane + 64 * j];
}
__device__ __forceinline__ int moe_seg_start(const unsigned* cnt, int e) { int s = 0;
#pragma unroll
    for (int k = 0; k < NEXP; ++k) s += (k < e) ? (int)((cnt[k] + 255u) & ~255u) : 0;
    return s; }

#ifndef PHMASK
#define PHMASK 0xFFFFFFFFu
#endif
#define PHM(k) (((PHMASK) >> (k)) & 1u)
#ifdef PROBE_LO
constexpr int PR_LO = PROBE_LO, PR_HI = PROBE_HI;
#else
constexpr int PR_LO = -1, PR_HI = -1;
#endif
constexpr int NPH = 16, NPHASES = 1 + 2 * NPH;
struct Args { const float* in[29]; float* out; unsigned char* ws; int ph_lo, ph_hi; };

__device__ __forceinline__ bool in_phase(int k, int lo, int hi) { asm volatile("" : "+s"(lo), "+s"(hi)); return lo <= k && k < hi; }
typedef const Args __attribute__((address_space(4)))* CArgsP;
__device__ __forceinline__ void fill_params_k(P& p, CArgsP a) {
    p.x = a->in[0]; p.mix_norm_g = a->in[1]; p.w_in_first = a->in[2]; p.w_in_rest = a->in[3]; p.mu_first = a->in[4]; p.mu_rest = a->in[5]; p.qk_g = a->in[6]; p.cmp_pos = a->in[7];
    p.cmp_w1 = a->in[8]; p.cmp_w2 = a->in[9]; p.nsa_w_o = a->in[10]; p.conv_w = a->in[11]; p.conv_vec = a->in[12]; p.conv_w_o = a->in[13]; p.rwkv_vec = a->in[14]; p.w_up = a->in[15];
    p.a_up = a->in[16]; p.g_up = a->in[17]; p.vres_up = a->in[18]; p.vres_b = a->in[19]; p.rwkv_w_o = a->in[20]; p.w_out = a->in[21]; p.ffn_norm_g = a->in[22]; p.dense_gu = a->in[23];
    p.dense_down = a->in[24]; p.router_w = a->in[25]; p.router_b = a->in[26]; p.moe_gu = a->in[27]; p.moe_down = a->in[28]; p.out = a->out; p.ws = a->ws;
}
__global__ void __launch_bounds__(NTHREADS, 2) mk_fwd(Args args) {
    extern __shared__ __attribute__((aligned(16))) unsigned char lds_raw[];
    LAS unsigned char* lds = (LAS unsigned char*)lds_raw;
    const int wave0 = __builtin_amdgcn_readfirstlane((int)threadIdx.x >> 6);
    const int tid = wave0 * 64 + lane_id_opaque();
    unsigned* ctl = (unsigned*)(args.ws + WS_CTL);
    for (int u = tid; u < (LDS_BYTES - LDSCTL_OFF) / 4; u += NTHREADS) ((LAS unsigned*)(lds + LDSCTL_OFF))[u] = 0u;
    __syncthreads();
    const int lo = args.ph_lo, hi = args.ph_hi;
    XcdBarrier bar; bar.bar = ctl + CW_BAR; bar.x = 0; bar.st = nullptr;
    if (hi - lo > 1) { bar.x = xb_xcc_id(); bar.st = (volatile LAS unsigned*)(lds + MISC_OFF) + 8; if (tid == 0) (void)xb_add(ctl + CW_BAR + XB_XCNT(bar.x), 1u); }
#define RMS_LOOP(X, GN, ROUTE, C0, C1) do { int m_ = gw; if (m_ < T) { RmsIn ra_, rb_; rms_load(ra_, (X) + (size_t)m_ * DM, lane); \
        for (; m_ < T; m_ += 2 * NGW) { const int m1_ = m_ + NGW, m2_ = m1_ + NGW; rms_load(rb_, (X) + (size_t)(m1_ < T ? m1_ : m_) * DM, lane); \
            rms_row(p, ra_, (GN), WSP(bf16, WS_H) + (size_t)m_ * DM, lane, (ROUTE), m_, C0, C1); \
            if (m1_ < T) { rms_load(ra_, (X) + (size_t)(m2_ < T ? m2_ : m1_) * DM, lane); rms_row(p, rb_, (GN), WSP(bf16, WS_H) + (size_t)m1_ * DM, lane, (ROUTE), m1_, C0, C1); } } } } while (0)
#define IN(k) (in_phase((k), lo, hi) && (PR_LO < 0 || (st == 0 ? (k) <= PR_HI : (st == 1 ? ((k) >= PR_LO && (k) <= PR_HI) : (k) > PR_HI))))
#define MKP unsigned long long cdum0 = 0ull, cdum1 = 0ull; (void)cdum0; (void)cdum1; CArgsP ap_ = (CArgsP)__builtin_amdgcn_kernarg_segment_ptr(); asm volatile("" : "+s"(ap_)); P p; fill_params_k(p, ap_); int w0_ = wave0; asm volatile("" : "+s"(w0_)); int tid = w0_ * 64 + lane_id_opaque(); asm volatile("" : "+v"(tid)); const int lane = tid & 63, wave = __builtin_amdgcn_readfirstlane(tid >> 6); int G = gridDim.x, bid = blockIdx.x; asm volatile("" : "+s"(G), "+s"(bid)); unsigned* ctl = WSP(unsigned, WS_CTL); const long gtid = (long)bid * NTHREADS + tid, NT = (long)G * NTHREADS; const int gw = bid * NWAVES + wave, NGW = G * NWAVES; LAS float* scrw = (LAS float*)(lds + wave * 16384); (void)gtid; (void)NT; (void)gw; (void)NGW; (void)scrw; (void)lane; (void)ctl
#define SEAM(k) do { if ((k) + 1 < hi) { int w_ = wave0; asm volatile("" : "+s"(w_)); xcd_barrier(bar, w_ * 64 + lane_id_opaque()); } } while (0)

    for (int st = 0; st < (PR_LO >= 0 ? 3 : 1); ++st) {
    if (PHM(16) && IN(0)) { MKP;
        constexpr int IT_WIN0 = (DM / 64) * ((N_IN_FIRST + 31) / 32), IT_WIN1 = (DM / 64) * ((N_IN_REST + 31) / 32), IT_WO = (512 / 64) * (DM / 32), IT_WOUT = (DM / 64) * (DM / 32);
        constexpr int total = IT_WIN0 + IT_WIN1 + 6 * IT_WO + 2 * IT_WOUT + (DM / 64) * (2 * DENSE_FF / 32) + (DENSE_FF / 64) * (DM / 32);
        bf16* wl0 = WSP(bf16, WS_W); bf16* wl1 = WSP(bf16, WS_W + SZ_LAYERW);
#define WOFF(b, o) ((bf16*)((unsigned char*)(b) + (o)))
        for (int it = gw; it < total; it += NGW) {
            int r = it;
            if (conv_job(r, p.w_in_first, DM, N_IN_FIRST, MapWin{(unsigned char*)wl0, 0}, scrw, lane)) continue;
            if (conv_job(r, p.w_in_rest, DM, N_IN_REST, MapWin{(unsigned char*)wl1, 1}, scrw, lane)) continue;
            if (conv_job(r, p.nsa_w_o, 512, DM, MapPlain{WOFF(wl0, OFF_WO3), 512}, scrw, lane)) continue;
            if (conv_job(r, p.rwkv_w_o, 512, DM, MapPlain{WOFF(wl0, OFF_WO3) + (size_t)DM * 512, 512}, scrw, lane)) continue;
            if (conv_job(r, p.conv_w_o, 512, DM, MapPlain{WOFF(wl0, OFF_WO3) + (size_t)2 * DM * 512, 512}, scrw, lane)) continue;
            if (conv_job(r, p.nsa_w_o + (size_t)512 * DM, 512, DM, MapPlain{WOFF(wl1, OFF_WO3), 512}, scrw, lane)) continue;
            if (conv_job(r, p.rwkv_w_o + (size_t)512 * DM, 512, DM, MapPlain{WOFF(wl1, OFF_WO3) + (size_t)DM * 512, 512}, scrw, lane)) continue;
            if (conv_job(r, p.conv_w_o + (size_t)512 * DM, 512, DM, MapPlain{WOFF(wl1, OFF_WO3) + (size_t)2 * DM * 512, 512}, scrw, lane)) continue;
            if (conv_job(r, p.w_out, DM, DM, MapPlain{WOFF(wl0, OFF_WOUT), DM}, scrw, lane)) continue;
            if (conv_job(r, p.w_out + (size_t)DM * DM, DM, DM, MapPlain{WOFF(wl1, OFF_WOUT), DM}, scrw, lane)) continue;
            if (conv_job(r, p.dense_gu, DM, 2 * DENSE_FF, MapGlu{WSP(bf16, WS_DGU), DM, DENSE_FF}, scrw, lane)) continue;
            conv_job(r, p.dense_down, DENSE_FF, DM, MapPlain{WSP(bf16, WS_DDN), DENSE_FF}, scrw, lane);
        }
        for (int l = 0; l < 2; ++l) {
            unsigned char* wlb = p.ws + WS_W + (size_t)l * SZ_LAYERW;
            bf16* win = (bf16*)(wlb + OFF_WIN);
            for (long i = gtid; i < 512L * DM; i += NT) { const int w = (int)(i / DM); const bool src = w < 288 || (w < 320 && l == 1) || (w >= 320 && w < 344); if (!src) win[(size_t)(3840 + w) * DM + i % DM] = 0; }
            bf16* lw = (bf16*)(wlb + OFF_LW);
            for (long i = gtid; i < 2048L * 384; i += NT) { const int n = (int)(i / 384), k = (int)(i % 384), blk = n >> 9, c = n & 511; float v = 0.f;
                if (blk == 0 && k < 64) v = p.w_up[((size_t)l * 64 + k) * RC + c]; else if (blk == 1 && k >= 64 && k < 128) v = p.a_up[((size_t)l * 64 + k - 64) * RC + c];
                else if (blk == 2 && k >= 128 && k < 288) v = p.g_up[((size_t)l * 160 + k - 128) * RC + c]; else if (blk == 3 && k >= 288 && k < 320 && l == 1) v = p.vres_up[(size_t)(k - 288) * RC + c];
                lw[i] = f2bf(v); }
            bf16* cw1 = (bf16*)(wlb + OFF_CW1);
            for (long i = gtid; i < 2L * 256 * 1024; i += NT) { const int k = (int)(i % 1024), n = (int)((i / 1024) % 256), which = (int)(i / (256 * 1024));
                cw1[i] = f2bf(p.cmp_w1[((size_t)(l * 2 + which) * 2048 + (n < 128 ? k : 1024 + k)) * 128 + (n & 127)]); }
            float* pec = (float*)(wlb + OFF_PEC);
            for (long i = gtid; i < 256; i += NT) { const int which = (int)(i >> 7), n = (int)(i & 127); const float* pe = p.cmp_pos + (size_t)(l * 2 + which) * 2048; const float* w1 = p.cmp_w1 + (size_t)(l * 2 + which) * 2048 * 128 + n;
                float s = 0.f; for (int k = 0; k < 2048; ++k) s += pe[k] * w1[(size_t)k * 128]; pec[i] = s; }
        }
    }

    for (int layer = 0; layer < 2; ++layer) {
        const int pb = 1 + layer * NPH;
        if (PHM(0) && IN(pb + 0)) { MKP;
            const float* xin = layer == 0 ? p.x : p.out;
            RMS_LOOP(xin, p.mix_norm_g + (size_t)layer * DM, false, cdum0, cdum1);
            SEAM(pb + 0);
        }
        if (PHM(1) && IN(pb + 1)) { MKP;
            Gemm g{WSP(bf16, WS_H), (const bf16*)(p.ws + WS_W + (size_t)layer * SZ_LAYERW + OFF_WIN), T, NPROJ, DM}; SOrder S; S.init(T, NPROJ, G, bid);
            EpiProj E{p.ws};
            pg8::gemm_phase<EpiProj, SOrder, true, true>(lds, g, S, E, tid);
            SEAM(pb + 1);
        }
        if (PHM(2) && IN(pb + 2)) { MKP;
            { Gemm g{WSP(bf16, AR_CKV), (const bf16*)(p.ws + WS_W + (size_t)layer * SZ_LAYERW + OFF_CW1), 2 * BATCH * NKV * 512, 512, 1024, 0}; StackOrder S{BATCH * NKV * 512 / 256, 1, 2, G, bid};
              EpiStore E{WSP(bf16, AR_HID), 256, 1};
              pg8::gemm_phase<EpiStore, StackOrder, true, true>(lds, g, S, E, tid); }
            ph_shift(p, layer, gtid, NT); ph_nsa_prep(p, layer, gtid, NT); ph_vtrans(p, gtid, NT);
            ph_convw(p, layer, gw, NGW, lane, tid, lds);
#ifdef APROBE_CONV
            ph_convw(p, layer, gw, NGW, lane, tid, lds);
#endif
#ifdef APROBE_VT
            ph_vtrans(p, gtid, NT);
#endif
            SEAM(pb + 2); }
        if (PHM(3) && IN(pb + 3)) { MKP;
#ifndef LORA_NAIVE
            { Gemm g{WSP(bf16, WS_LB), (const bf16*)(p.ws + WS_W + (size_t)layer * SZ_LAYERW + OFF_LW), T, 2048, 384, 0}; SOrder S; S.init(T, 2048, G, bid);
              EpiLora E{p.ws};
              pg8::gemm_phase<EpiLora, SOrder, false, true>(lds, g, S, E, tid); }
#else
            { bf16* RW = WSP(bf16, AR_RW); bf16* Wm = WSP(bf16, AR_W); bf16* Am = WSP(bf16, AR_A); bf16* Gm = WSP(bf16, AR_G); const bf16* VF = WSP(bf16, WS_VF);
              const float* vec = p.rwkv_vec + (size_t)layer * 7 * RC; const float* wup = p.w_up + (size_t)layer * 64 * RC; const float* aup = p.a_up + (size_t)layer * 64 * RC; const float* gup = p.g_up + (size_t)layer * 160 * RC;
              for (long it = gtid; it < (long)T * RC; it += NT) { const int t = (int)(it / RC), c = (int)(it % RC); bf16* row = RW + (size_t)t * LDRW; const bf16* L = row + LBLK;
                  float wl = vec[c], alin = vec[RC + c], g = 0.f;
                  for (int j = 0; j < 64; ++j) { wl += bf2f(L[j]) * bf2f(f2bf(wup[j * RC + c])); alin += bf2f(L[64 + j]) * bf2f(f2bf(aup[j * RC + c])); }
                  for (int j = 0; j < 160; ++j) g += bf2f(L[128 + j]) * bf2f(f2bf(gup[j * RC + c]));
                  const float nx = -wl, sp = fmaxf(nx, 0.f) + __logf(1.f + __expf(-fabsf(nx))), e = __expf(-sp - 0.5f);
                  Wm[it] = f2bf(1.f - __expf(-e)); Am[it] = f2bf(fsig(alin)); Gm[it] = f2bf(g);
                  if (layer == 1) { float vl = p.vres_b[c]; for (int j = 0; j < 32; ++j) vl += bf2f(L[288 + j]) * bf2f(f2bf(p.vres_up[j * RC + c]));
                      const float v = bf2f(row[1024 + c]), vf = bf2f(VF[it]); row[1024 + c] = f2bf(v + (vf - v) * fsig(vl)); } } }
#endif
            SEAM(pb + 3); }
        if (PHM(4) && IN(pb + 4)) { MKP; ph_rwkv_b2w(p, layer, gw, NGW, lane); ph_cmp2w(p, layer, gw, NGW, lane, (LAS float*)(lds + wave * 512)); SEAM(pb + 4); }
        if (PHM(5) && IN(pb + 5)) { MKP;
            { LAS unsigned char* wl = lds + wave * AW_BYTES; constexpr int NSC = BATCH * 8 * 16, NIT = BATCH * NKV * (SEQ / 16);
#ifndef SCAN_QUEUE
              if (wave < 4) {
                  if (G * 4 == NSC && (G & 7) == 0) scan_unit(p, (bid & 7) * (NSC / 8) + (bid >> 3) * 4 + wave, lane, wl);
                  else for (int u = bid * 4 + wave; u < NSC; u += G * 4) scan_unit(p, u, lane, wl); }
#endif
#ifdef APROBE_SPLIT
              xcd_barrier(bar, tid);
#endif
              const int xme = (int)(xb_xcc_id() & 7u);
              for (int qq = 0; qq < 8; ++qq) { const int qx = (xme + qq) & 7; unsigned* head = ctl + CW_ATT + ((layer * 3 + st) * 8 + qx) * 16;
                  for (;;) { int it = 0; if (lane == 0) it = (int)atomicAdd(head, 1u); it = __builtin_amdgcn_readfirstlane(it); if (it >= NIT / 8) break;
                      const int bg = 2 * qx + it / (SEQ / 16), t16 = (SEQ / 16 - 1) - it % (SEQ / 16);
                      nsa_attn_item(p, bg * (SEQ / 16) + t16, lane, wl); } } }
 SEAM(pb + 5); }
        if (PHM(6) && IN(pb + 6)) { MKP; ph_rwkv_postw(p, layer, gw, NGW, lane); SEAM(pb + 6); }
        if (PHM(7) && IN(pb + 7)) { MKP;
            Gemm g{WSP(bf16, AR_QB), (const bf16*)(p.ws + WS_W + (size_t)layer * SZ_LAYERW + OFF_WO3), 3 * T, 3 * DM, 512}; StackOrder S{T / 256, DM / 256, 3, G, bid};
            EpiStore E{WSP(bf16, AR_OBUF), DM, DM / 256};
            pg8::gemm_phase<EpiStore, StackOrder, true, true>(lds, g, S, E, tid);
            { MKP; const float* xin = layer == 0 ? p.x : p.out;
              RMS_LOOP(xin, p.mix_norm_g + (size_t)layer * DM, false, cdum0, cdum1); }
            SEAM(pb + 7);
        }
        if (PHM(8) && IN(pb + 8)) { MKP;
            Gemm g{WSP(bf16, WS_H), (const bf16*)(p.ws + WS_W + (size_t)layer * SZ_LAYERW + OFF_WG), T, 3 * DM, DM}; GateOrder S{T / 256, DM / 256, G, bid};
            EpiGate E{p.ws, DM / 256};
            pg8::gemm_phase<EpiGate, GateOrder, true, true>(lds, g, S, E, tid);
            SEAM(pb + 8);
        }
        if (PHM(9) && IN(pb + 9)) { MKP;
            Gemm g{WSP(bf16, AR_MIX), (const bf16*)(p.ws + WS_W + (size_t)layer * SZ_LAYERW + OFF_WOUT), T, DM, DM}; SOrder S; S.init(T, DM, G, bid);
            EpiResid E{layer == 0 ? p.x : p.out, p.out};
            pg8::gemm_phase<EpiResid, SOrder, true, true>(lds, g, S, E, tid);
            SEAM(pb + 9);
        }
        if (PHM(10) && IN(pb + 10)) { MKP;
            unsigned long long c0 = 0ull, c1 = 0ull;
            RMS_LOOP(p.out, p.ffn_norm_g + (size_t)layer * DM, layer == 1, c0, c1);
            if (layer == 1 && lane < 16) {
                const unsigned cn = (unsigned)(((lane < 8 ? c0 : c1) >> (8 * (lane & 7))) & 255ull);
                WSP(unsigned, AR_WBASE)[(size_t)gw * 16 + lane] = atomicAdd(ctl + CW_CNT + lane * 64, cn); }
            if (layer == 1) { int* rt = WSP(int, AR_RTOK); for (long i = gtid; i < 2L * MOE_ROWS; i += NT) rt[i] = -1; }
            SEAM(pb + 10);
        }
        if (layer == 0) {
            if (PHM(11) && IN(pb + 11)) { MKP;
                Gemm g{WSP(bf16, WS_H), WSP(bf16, WS_DGU), T, 2 * DENSE_FF, DM}; SOrder S; S.init(T, 2 * DENSE_FF, G, bid);
                EpiSwiglu E{WSP(bf16, AR_ACT), DENSE_FF, 2 * DENSE_FF / 256};
                pg8::gemm_phase<EpiSwiglu, SOrder, true, true>(lds, g, S, E, tid);
                SEAM(pb + 11);
            }
            if (PHM(12) && IN(pb + 12)) { MKP;
                Gemm g{WSP(bf16, AR_ACT), WSP(bf16, WS_DDN), T, DM, DENSE_FF}; SOrder S; S.init(T, DM, G, bid);
                EpiResid E{p.out, p.out};
                pg8::gemm_phase<EpiResid, SOrder, true, true>(lds, g, S, E, tid);
                SEAM(pb + 12);
            }
        } else {
            if (PHM(11) && IN(pb + 11)) { MKP;
                const int ig = (DM / 64) * (2 * EXPERT_FF / 32), id = (EXPERT_FF / 64) * (DM / 32);
                for (int it = gw; it < NEXP * (ig + id); it += NGW) { const int e = it / (ig + id); int r = it % (ig + id);
                    if (conv_job(r, p.moe_gu + (size_t)e * DM * 2 * EXPERT_FF, DM, 2 * EXPERT_FF, MapGlu{WSP(bf16, AR_MGU) + (size_t)e * 2 * EXPERT_FF * DM, DM, EXPERT_FF}, scrw, lane)) continue;
                    conv_job(r, p.moe_down + (size_t)e * EXPERT_FF * DM, EXPERT_FF, DM, MapPlain{WSP(bf16, AR_MDN) + (size_t)e * DM * EXPERT_FF, EXPERT_FF}, scrw, lane); }
                int* rtok = WSP(int, AR_RTOK); float* rww = WSP(float, AR_RW8); int* trow = WSP(int, AR_TROW);
                int segv = 0; { const int pc = lane < 16 ? (int)((ctl[CW_CNT + lane * 64] + 255u) & ~255u) : 0;
#pragma unroll
                    for (int k = 0; k < 8; ++k) { const int ck = bperm_i(pc, (lane & 8) + k); segv += (k < (lane & 7)) ? ck : 0; } }
                for (int tb = gw * 64; tb < T; tb += NGW * 64) {
                    const int t = tb + lane; const int ee = WSP(int, AR_RTE)[t], e0 = ee & 255, e1 = (ee >> 8) & 255, r0 = (ee >> 16) & 255, r1 = (ee >> 24) & 255;
                    const float* w = WSP(float, AR_RTW) + (size_t)t * 2; const unsigned* wb = WSP(unsigned, AR_WBASE) + (size_t)(t % NGW) * 16;
                    const int row0 = bperm_i(segv, e0) + (int)wb[e0] + r0, row1 = bperm_i(segv, 8 + e1) + (int)wb[8 + e1] + r1;
                    rtok[row0] = t; rww[row0] = w[0]; rtok[MOE_ROWS + row1] = t; rww[MOE_ROWS + row1] = w[1]; trow[T + t] = row1;
                    for (int l = 0; l < 64; l += 4) { const bf16* hs = WSP(bf16, WS_H) + (size_t)(tb + l) * DM; bf16* xg = WSP(bf16, AR_XG);
                        copy_rows4(hs, hs + DM, hs + 2 * DM, hs + 3 * DM, xg + (size_t)__builtin_amdgcn_readlane(row0, l) * DM, xg + (size_t)__builtin_amdgcn_readlane(row0, l + 1) * DM, xg + (size_t)__builtin_amdgcn_readlane(row0, l + 2) * DM, xg + (size_t)__builtin_amdgcn_readlane(row0, l + 3) * DM, lane); }
                }
                SEAM(pb + 11);
            }
#pragma unroll
            for (int pass = 0; pass < 2; ++pass) {
                if (PHM(12) && IN(pb + 12 + 2 * pass)) { MKP;
                    Gemm g{WSP(bf16, AR_XG), WSP(bf16, AR_MGU), MOE_ROWS, NEXP * 2 * EXPERT_FF, DM}; MoeOrder S; S.init(ctl + CW_CNT + 8 * 64 * pass, 2 * EXPERT_FF / 256, G, bid);
                    EpiSwiglu E{WSP(bf16, AR_MACT), EXPERT_FF, 2 * EXPERT_FF / 256};
                    if (pass == 1) {
                        MoeOrder S0; S0.init(ctl + CW_CNT, DM / 256, G, bid); const int nwg = S0.s.nwg, mainw = (nwg / G) * G, ttiles = nwg - mainw;
                        if (bar.st != nullptr && (G & 31) == 0 && mainw > 0 && ttiles > 0 && ttiles <= 32) {
                            EpiMoeDown E0{p.out, WSP(int, AR_RTOK), WSP(float, AR_RW8), DM / 256, (PR_LO >= 0 && st == 0 && pb + 14 >= PR_LO && pb + 14 <= PR_HI) ? 0.f : 1.f};
                            for (int job = wave * G + bid; job < ttiles * 32; job += NWAVES * G) moe_tail_combine(E0, S0, WSP(float, WS_PART), mainw / (DM / 256), job, lane); } }
                    pg8::gemm_phase<EpiSwiglu, MoeOrder, true, true>(lds, g, S, E, tid);
                    SEAM(pb + 12 + 2 * pass);
                }
                if (PHM(13) && IN(pb + 13 + 2 * pass)) { MKP;
                    Gemm g{WSP(bf16, AR_MACT), WSP(bf16, AR_MDN), MOE_ROWS, NEXP * DM, EXPERT_FF}; MoeOrder S; S.init(ctl + CW_CNT + 8 * 64 * pass, DM / 256, G, bid);
                    EpiMoeDown E{p.out, WSP(int, AR_RTOK) + (size_t)pass * MOE_ROWS, WSP(float, AR_RW8) + (size_t)pass * MOE_ROWS, DM / 256, (PR_LO >= 0 && st == 0 && pb + 13 + 2 * pass >= PR_LO && pb + 13 + 2 * pass <= PR_HI) ? 0.f : 1.f};
                    if (pass == 0) { const int* trow = WSP(int, AR_TROW);
                        for (int t = gw * 4; t < T; t += NGW * 4) { const bf16* hs = WSP(bf16, WS_H) + (size_t)t * DM; bf16* xg = WSP(bf16, AR_XG);
                            copy_rows4(hs, hs + DM, hs + 2 * DM, hs + 3 * DM, xg + (size_t)trow[T + t] * DM, xg + (size_t)trow[T + t + 1] * DM, xg + (size_t)trow[T + t + 2] * DM, xg + (size_t)trow[T + t + 3] * DM, lane); } }
                    const int nwg = S.s.nwg, mainw = (nwg / G) * G, ttiles = nwg - mainw; const bool split = bar.st != nullptr && (G & 31) == 0 && mainw > 0 && ttiles > 0 && ttiles <= 32;
                    if (split) S.s.nwg = mainw;
                    pg8::gemm_phase<EpiMoeDown, MoeOrder, true, true>(lds, g, S, E, tid);
                    if (split) { Gemm g2{WSP(bf16, AR_MACT), WSP(bf16, AR_MDN), MOE_ROWS, NEXP * DM, MT_K, EXPERT_FF, EXPERT_FF}; MoeTailOrder S2; S2.init(S, mainw / (DM / 256), ttiles, G, bid);
                        EpiPart E2{WSP(float, WS_PART), mainw / (DM / 256), DM / 256};
                        pg8::gemm_phase<EpiPart, MoeTailOrder, true, true, true>(lds, g2, S2, E2, tid); }
                    if (pass == 1 && split) { { int w_ = wave0; asm volatile("" : "+s"(w_)); xcd_barrier(bar, w_ * 64 + lane_id_opaque()); }
                        for (int job = wave * G + bid; job < ttiles * 32; job += NWAVES * G) moe_tail_combine(E, S, WSP(float, WS_PART), mainw / (DM / 256), job, lane); }
                    SEAM(pb + 13 + 2 * pass);
                }
            }
        }
    }
    }
#undef IN
#undef SEAM
}

#ifndef MK_ONE_LAUNCH
#define MK_ONE_LAUNCH 1
#endif
extern "C" void kernel_launch(void* const* d_in, const int* in_sizes, int n_in, void* d_out, int out_size, void* d_ws, size_t ws_size, hipStream_t stream) {
    static int grid = 0;
    if (grid == 0) {
        if (n_in != 29 || in_sizes[0] != T * DM || out_size != T * DM || ws_size < WS_END) { fprintf(stderr, "kernel_launch: unexpected shapes / workspace (%d inputs, ws %zu, need %zu)\n", n_in, ws_size, (size_t)WS_END); grid = -1; return; }
        int dev = 0, cus = 0;
        if (hipGetDevice(&dev) != hipSuccess || hipDeviceGetAttribute(&cus, hipDeviceAttributeMultiprocessorCount, dev) != hipSuccess) { grid = -1; return; }
        if (hipFuncSetAttribute((const void*)mk_fwd, hipFuncAttributeMaxDynamicSharedMemorySize, LDS_BYTES) != hipSuccess) { fprintf(stderr, "kernel_launch: hipFuncSetAttribute failed\n"); grid = -1; return; }
        int per_cu = 0;
        if (hipOccupancyMaxActiveBlocksPerMultiprocessor(&per_cu, (const void*)mk_fwd, NTHREADS, LDS_BYTES) != hipSuccess || per_cu < 1) { fprintf(stderr, "kernel_launch: occupancy query says %d\n", per_cu); }
        (void)hipGetLastError();
        grid = cus;
    }
    if (grid < 0) return;
    if (hipMemsetAsync((char*)d_ws + WS_CTL, 0, CTL_BYTES, stream) != hipSuccess) return;
    Args a{};
    for (int i = 0; i < 29; ++i) a.in[i] = (const float*)d_in[i];
    a.out = (float*)d_out; a.ws = (unsigned char*)d_ws;
#if MK_ONE_LAUNCH
    a.ph_lo = 0; a.ph_hi = NPHASES;
    hipLaunchKernelGGL(mk_fwd, dim3(grid), dim3(NTHREADS), LDS_BYTES, stream, a);
#else
    for (int k = 0; k < NPHASES; ++k) {
        if (k >= 1 + 13 && k < 1 + NPH) continue;
        a.ph_lo = k; a.ph_hi = k + 1;
        hipLaunchKernelGGL(mk_fwd, dim3(grid), dim3(NTHREADS), LDS_BYTES, stream, a);
    }
#endif
}
```

```cpp
#include <hip/hip_runtime.h>
#include <cstdio>
#include <cstdint>
#include <cmath>
#include <cstring>
#ifdef HOST_EMU
#define HD
#define DEV_INLINE inline
#else
#define HD __host__ __device__
#define DEV_INLINE __device__ __forceinline__
#endif

typedef unsigned short bf16;
struct alignas(16) U4 { unsigned x, y, z, w; };

#ifdef SMALL_CFG
constexpr int BATCH = 1, SEQ = 1024, DM = 128, DENSE_FF = 256, EXPERT_FF = 256;
#else
constexpr int BATCH = 8, SEQ = 8192, DM = 1024, DENSE_FF = 2816, EXPERT_FF = 3584;
#endif
constexpr int T = BATCH * SEQ;
constexpr int NHEAD = 8, NKV = 2, HG = 4, DH = 64;
constexpr int NC = SEQ / 16 - 1, NS = SEQ / 64, NSEL = 8, WINDOW = 512;
constexpr int CONV_CH = 512, CONV_K = 31, RC = 512;
constexpr int NEXP = 8;
constexpr int NSA_IN = 1304, OFF_CONV = 1304, OFF_GATE = 2328, OFF_RWKV = OFF_GATE + 3 * DM;
constexpr int N_IN_FIRST = OFF_RWKV + 1824, N_IN_REST = OFF_RWKV + 1856;
constexpr int NPROJ = 4352;
constexpr int LDQ = 512, LDKV = 512, LDRW = 2048, LBLK = 1536;
constexpr int MOE_ROWS = T + NEXP * 256;
constexpr float RMS_EPS = 1e-6f, LN_EPS = 1e-5f, GN_EPS = 64e-5f;

constexpr size_t al(size_t x) { return (x + 255) & ~(size_t)255; }
constexpr size_t WS_CTL = 0, CTL_BYTES = 1u << 20;
constexpr size_t SZ_WIN = (size_t)NPROJ * DM * 2, SZ_WG = (size_t)3 * DM * DM * 2, SZ_WO3 = (size_t)3 * DM * 512 * 2, SZ_WOUT = (size_t)DM * DM * 2;
constexpr size_t SZ_LW = (size_t)2048 * 384 * 2, SZ_CW1 = (size_t)2 * 256 * 1024 * 2, SZ_PEC = 1024;
constexpr size_t SZ_LAYERW = SZ_WIN + SZ_WG + SZ_WO3 + SZ_WOUT + SZ_LW + SZ_CW1 + SZ_PEC;
constexpr size_t WS_W = CTL_BYTES;
constexpr size_t OFF_WIN = 0, OFF_WG = SZ_WIN, OFF_WO3 = OFF_WG + SZ_WG, OFF_WOUT = OFF_WO3 + SZ_WO3, OFF_LW = OFF_WOUT + SZ_WOUT, OFF_CW1 = OFF_LW + SZ_LW, OFF_PEC = OFF_CW1 + SZ_CW1;
constexpr size_t WS_DGU = WS_W + 2 * SZ_LAYERW, SZ_DGU = (size_t)2 * DENSE_FF * DM * 2;
constexpr size_t WS_DDN = WS_DGU + SZ_DGU, SZ_DDN = (size_t)DM * DENSE_FF * 2;
constexpr size_t WS_VF = al(WS_DDN + SZ_DDN), SZ_TC = (size_t)T * 512 * 2;
constexpr size_t WS_H = WS_VF + SZ_TC, SZ_H = (size_t)T * DM * 2;
constexpr size_t WS_PART = WS_VF;
static_assert((size_t)32 * 7 * 65536 * 4 <= SZ_TC, "WS_PART");
constexpr size_t WS_AR = al(WS_H + SZ_H);
constexpr size_t AR_QB = WS_AR, AR_A = AR_QB + SZ_TC, AR_CO = AR_A + SZ_TC;
constexpr size_t AR_KV = AR_CO + SZ_TC, SZ_KV = (size_t)T * LDKV * 2;
constexpr size_t AR_RW = AR_KV + SZ_KV, SZ_RW = (size_t)T * LDRW * 2;
constexpr size_t AR_W = AR_RW + SZ_RW, AR_G = AR_W + SZ_TC, AR_UB = AR_G + SZ_TC;
constexpr size_t AR_NG = AR_UB + SZ_TC, SZ_NG = (size_t)T * 24 * 4;
constexpr size_t AR_HALO = al(AR_NG + SZ_NG), SZ_HALO = (size_t)(T / 256) * LDRW * 2;
constexpr size_t AR_KC = al(AR_HALO + SZ_HALO), SZ_CMP = (size_t)BATCH * NKV * (SEQ / 16) * 64 * 2;
constexpr size_t AR_VC = AR_KC + SZ_CMP;
constexpr size_t AR_HID = al(AR_VC + SZ_CMP), SZ_HID = (size_t)BATCH * NKV * (SEQ / 16) * 2 * 128 * 4;
constexpr size_t AR_SEL = al(AR_HID + SZ_HID), SZ_SEL = (size_t)T * NKV * 8 * 4;
constexpr size_t AR_INVN = al(AR_SEL + SZ_SEL), SZ_INVN = (size_t)T * 8 * 4;
constexpr size_t AR_VCT = al(AR_INVN + SZ_INVN);
constexpr size_t AR_CKV = al(AR_VCT + SZ_CMP), SZ_CKV = (size_t)2 * T * 128;
constexpr size_t AR_END1 = al(AR_CKV + SZ_CKV * 2);
constexpr size_t WS_VST = WS_H, WS_VWT = WS_H + (size_t)T * 128 * 2, WS_LB = WS_VWT + (size_t)T * 128 * 2, WS_KS8 = WS_LB + (size_t)T * 384 * 2, WS_KW8 = WS_KS8 + (size_t)T * 128 * 2;
constexpr size_t AR_OBUF = AR_KV, SZ_OBUF = (size_t)3 * T * DM * 2;
constexpr size_t AR_MIX = AR_OBUF + SZ_OBUF, SZ_MIX = (size_t)T * DM * 2;
constexpr size_t AR_END2 = AR_MIX + SZ_MIX;
constexpr size_t AR_ACT = WS_AR;
constexpr size_t AR_MGU = WS_AR, SZ_MGU = (size_t)NEXP * 2 * EXPERT_FF * DM * 2;
constexpr size_t AR_MDN = AR_MGU + SZ_MGU, SZ_MDN = (size_t)NEXP * DM * EXPERT_FF * 2;
constexpr size_t AR_XG = al(AR_MDN + SZ_MDN), SZ_XG = (size_t)MOE_ROWS * DM * 2;
constexpr size_t AR_MACT = al(AR_XG + SZ_XG), SZ_MACT = (size_t)MOE_ROWS * EXPERT_FF * 2;
constexpr size_t AR_RTOK = al(AR_MACT + SZ_MACT), SZ_RTOK = (size_t)2 * MOE_ROWS * 4;
constexpr size_t AR_RW8 = al(AR_RTOK + SZ_RTOK);
constexpr size_t AR_TROW = al(AR_RW8 + SZ_RTOK), SZ_TROW = (size_t)2 * T * 4;
constexpr size_t AR_RTE = al(AR_TROW + SZ_TROW);
constexpr size_t AR_RTW = al(AR_RTE + (size_t)T * 4);
constexpr size_t AR_WBASE = al(AR_RTW + (size_t)T * 8);
constexpr size_t AR_END3 = al(AR_WBASE + (size_t)4096 * 16 * 4);
constexpr size_t WS_END = (AR_END1 > AR_END2 ? (AR_END1 > AR_END3 ? AR_END1 : AR_END3) : (AR_END2 > AR_END3 ? AR_END2 : AR_END3));
constexpr int CW_CNT = 1024;
constexpr int CW_ATT = 256;
constexpr int CW_BAR = 4096;

struct P {
    const float *x, *mix_norm_g, *w_in_first, *w_in_rest, *mu_first, *mu_rest, *qk_g, *cmp_pos, *cmp_w1, *cmp_w2, *nsa_w_o, *conv_w, *conv_vec, *conv_w_o,
        *rwkv_vec, *w_up, *a_up, *g_up, *vres_up, *vres_b, *rwkv_w_o, *w_out, *ffn_norm_g, *dense_gu, *dense_down, *router_w, *router_b, *moe_gu, *moe_down;
    float* out; unsigned char* ws;
};
HD inline void fill_params(P& p, const float* const* in, float* out, unsigned char* ws) {
    p.x = in[0]; p.mix_norm_g = in[1]; p.w_in_first = in[2]; p.w_in_rest = in[3]; p.mu_first = in[4]; p.mu_rest = in[5]; p.qk_g = in[6]; p.cmp_pos = in[7];
    p.cmp_w1 = in[8]; p.cmp_w2 = in[9]; p.nsa_w_o = in[10]; p.conv_w = in[11]; p.conv_vec = in[12]; p.conv_w_o = in[13]; p.rwkv_vec = in[14]; p.w_up = in[15];
    p.a_up = in[16]; p.g_up = in[17]; p.vres_up = in[18]; p.vres_b = in[19]; p.rwkv_w_o = in[20]; p.w_out = in[21]; p.ffn_norm_g = in[22]; p.dense_gu = in[23];
    p.dense_down = in[24]; p.router_w = in[25]; p.router_b = in[26]; p.moe_gu = in[27]; p.moe_down = in[28]; p.out = out; p.ws = ws;
}
#define WSP(type, off) ((type*)(p.ws + (off)))

#ifdef HOST_EMU
#define FENCE()
#else
#define FENCE() asm volatile("" ::: "memory")
#endif
HD inline float bf2f(bf16 v) { unsigned u = (unsigned)v << 16; float f; memcpy(&f, &u, 4); return f; }
HD inline bf16 f2bf(float f) { unsigned u; memcpy(&u, &f, 4); return (bf16)((u + 0x7fffu + ((u >> 16) & 1u)) >> 16); }
HD inline float blo(unsigned v) { unsigned u = v << 16; float f; memcpy(&f, &u, 4); return f; }
HD inline float bhi(unsigned v) { unsigned u = v & 0xffff0000u; float f; memcpy(&f, &u, 4); return f; }
#if !defined(SCAN_BF16) && !defined(RKV_BF16)
HD inline bf16 f2h(float f) { return __builtin_bit_cast(unsigned short, (_Float16)f); }
#else
HD inline bf16 f2bf(float f);
HD inline bf16 f2h(float f) { return f2bf(f); }
#endif
HD inline float h2f(bf16 v) { return (float)__builtin_bit_cast(_Float16, v); }
HD inline float sigmoidf_(float x) { return 1.f / (1.f + expf(-x)); }
HD inline float dot64(const float* q, const bf16* kp) {
    const U4* k4 = (const U4*)kp; float s0 = 0.f, s1 = 0.f;
#pragma unroll
    for (int i = 0; i < 8; ++i) { const U4 v = k4[i];
        s0 += q[8 * i + 0] * blo(v.x) + q[8 * i + 2] * blo(v.y) + q[8 * i + 4] * blo(v.z) + q[8 * i + 6] * blo(v.w);
        s1 += q[8 * i + 1] * bhi(v.x) + q[8 * i + 3] * bhi(v.y) + q[8 * i + 5] * bhi(v.z) + q[8 * i + 7] * bhi(v.w); }
    return s0 + s1;
}
HD inline float dot64p(const U4* q, const bf16* kp) {
    const U4* k4 = (const U4*)kp; float s0 = 0.f, s1 = 0.f;
#pragma unroll
    for (int i = 0; i < 8; ++i) { const U4 v = k4[i], w = q[i];
        s0 += blo(w.x) * blo(v.x) + blo(w.y) * blo(v.y) + blo(w.z) * blo(v.z) + blo(w.w) * blo(v.w);
        s1 += bhi(w.x) * bhi(v.x) + bhi(w.y) * bhi(v.y) + bhi(w.z) * bhi(v.z) + bhi(w.w) * bhi(v.w); }
    return s0 + s1;
}
HD inline void ld64(const bf16* kp, float* q) {
    const U4* k4 = (const U4*)kp;
#pragma unroll
    for (int i = 0; i < 8; ++i) { const U4 v = k4[i]; q[8 * i] = blo(v.x); q[8 * i + 1] = bhi(v.x); q[8 * i + 2] = blo(v.y); q[8 * i + 3] = bhi(v.y);
        q[8 * i + 4] = blo(v.z); q[8 * i + 5] = bhi(v.z); q[8 * i + 6] = blo(v.w); q[8 * i + 7] = bhi(v.w); }
}
HD inline void axpy64(float* o, float w, const bf16* vp) {
    const U4* k4 = (const U4*)vp;
#pragma unroll
    for (int i = 0; i < 8; ++i) { const U4 v = k4[i]; o[8 * i] += w * blo(v.x); o[8 * i + 1] += w * bhi(v.x); o[8 * i + 2] += w * blo(v.y); o[8 * i + 3] += w * bhi(v.y);
        o[8 * i + 4] += w * blo(v.z); o[8 * i + 5] += w * bhi(v.z); o[8 * i + 6] += w * blo(v.w); o[8 * i + 7] += w * bhi(v.w); }
}
HD inline void axpy64s(float* o, float w, const bf16* vp) {
    const U4* k4 = (const U4*)vp;
#pragma unroll
    for (int i = 0; i < 8; ++i) { const U4 v = k4[i]; o[8 * i] = w * o[8 * i] + blo(v.x); o[8 * i + 1] = w * o[8 * i + 1] + bhi(v.x); o[8 * i + 2] = w * o[8 * i + 2] + blo(v.y); o[8 * i + 3] = w * o[8 * i + 3] + bhi(v.y);
        o[8 * i + 4] = w * o[8 * i + 4] + blo(v.z); o[8 * i + 5] = w * o[8 * i + 5] + bhi(v.z); o[8 * i + 6] = w * o[8 * i + 6] + blo(v.w); o[8 * i + 7] = w * o[8 * i + 7] + bhi(v.w); }
}
HD inline void st64(bf16* op, const float* o) {
    U4* o4 = (U4*)op;
#pragma unroll
    for (int i = 0; i < 8; ++i) { U4 v; v.x = (unsigned)f2bf(o[8 * i]) | ((unsigned)f2bf(o[8 * i + 1]) << 16); v.y = (unsigned)f2bf(o[8 * i + 2]) | ((unsigned)f2bf(o[8 * i + 3]) << 16);
        v.z = (unsigned)f2bf(o[8 * i + 4]) | ((unsigned)f2bf(o[8 * i + 5]) << 16); v.w = (unsigned)f2bf(o[8 * i + 6]) | ((unsigned)f2bf(o[8 * i + 7]) << 16); o4[i] = v; }
}

HD inline void rope_cs(int pos, int i, float& cs, float& sn) {
    const float c = exp2f(-(float)i * 0.41524101186092f) * 0.15915494309189535f, pf = (float)pos;
    const float prod = pf * c, err = fmaf(pf, c, -prod), fr = (prod - rintf(prod)) + err;
#ifdef HOST_EMU
    cs = cosf(6.283185307179586f * fr); sn = sinf(6.283185307179586f * fr);
#else
    cs = __builtin_amdgcn_cosf(fr); sn = __builtin_amdgcn_sinf(fr);
#endif
}
HD inline int win_dest(int j, int layer, int& which) {
    which = 0;
    if (j < 1280) return j;
    if (j < 1304) return 3840 + 320 + (j - 1280);
    if (j < 1816) { const int cc = j - 1304; return 1280 + 256 * (cc / 128) + cc % 128; }
    if (j < 2328) { const int cc = j - 1816; return 1280 + 256 * (cc / 128) + 128 + cc % 128; }
    if (j < OFF_RWKV) { which = 1; const int gg = j - OFF_GATE, br = gg / DM; return (br == 0 ? 0 : (br == 1 ? 2 * DM : DM)) + gg % DM; }
    const int rr = j - OFF_RWKV;
    if (rr < 1536) return 2304 + rr;
    if (rr < 1824) return 3840 + (rr - 1536);
    if (rr < 1856 && layer == 1) return 3840 + 288 + (rr - 1824);
    return -1;
}
HD inline int glu_dest(int j, int ff) { return j < ff ? 256 * (j / 128) + j % 128 : 256 * ((j - ff) / 128) + 128 + (j - ff) % 128; }

DEV_INLINE void ph_shift(const P& p, int layer, long gtid, long NT) {
    bf16* RW = WSP(bf16, AR_RW); const bf16* HALO = WSP(bf16, AR_HALO); bf16* VF = WSP(bf16, WS_VF); bf16* LB = WSP(bf16, WS_LB);
    const float* mu = layer == 0 ? p.mu_first : p.mu_rest;
    constexpr int NCP = (LBLK + 384) / 2;
    const long n = (long)(T / 256) * NCP;
    for (long it = gtid; it < n; it += NT) {
        const int pm = (int)(it / NCP), c = 2 * (int)(it % NCP);
        int mi = -1, act = 0;
        if (c < LBLK) mi = c;
        else { const int w = c - LBLK; if (w < 288) { mi = 1536 + w; act = w < 64 ? 1 : (w >= 128 ? 2 : 0); } else if (w < 320 && layer == 1) mi = 1824 + (w - 288); }
        if (mi < 0) { for (int r = 0; r < 256; ++r) *(unsigned*)(LB + ((size_t)pm * 256 + r) * 384 + (c - LBLK)) = 0u; continue; }
        const float m0 = mu[mi], m1 = mu[mi + 1];
        float prev0 = 0.f, prev1 = 0.f;
        if ((pm * 256) % SEQ != 0) { const unsigned hv = *(const unsigned*)(HALO + (size_t)(pm - 1) * LDRW + c); prev0 = blo(hv); prev1 = bhi(hv); }
        bf16* col = RW + (size_t)pm * 256 * LDRW + c;
        for (int r0 = 0; r0 < 256; r0 += 16) {
            unsigned pv[16];
#pragma unroll
            for (int k = 0; k < 16; ++k) pv[k] = *(const unsigned*)(col + (size_t)(r0 + k) * LDRW);
#pragma unroll
            for (int k = 0; k < 16; ++k) { const int r = r0 + k; const float p0 = blo(pv[k]), p1 = bhi(pv[k]);
                float u0 = p0 + (prev0 - p0) * m0, u1 = p1 + (prev1 - p1) * m1; prev0 = p0; prev1 = p1;
                if (act == 1) { u0 = tanhf(u0); u1 = tanhf(u1); } else if (act == 2) { u0 = sigmoidf_(u0); u1 = sigmoidf_(u1); }
                if (c < LBLK) { const unsigned hv = (unsigned)f2h(u0) | ((unsigned)f2h(u1) << 16); *(unsigned*)(col + (size_t)r * LDRW) = hv;
                    if (layer == 0 && c >= 1024) *(unsigned*)(VF + ((size_t)pm * 256 + r) * RC + (c - 1024)) = hv; }
                else *(unsigned*)(LB + ((size_t)pm * 256 + r) * 384 + (c - LBLK)) = (unsigned)f2bf(u0) | ((unsigned)f2bf(u1) << 16); }
        }
    }
}

DEV_INLINE void ph_nsa_prep(const P& p, int layer, long gtid, long NT) {
    bf16* QB = WSP(bf16, AR_QB); bf16* KV = WSP(bf16, AR_KV);
    const long n = (long)T * 12;
    for (long it = gtid; it < n; it += NT) {
        const int t = (int)(it / 12), s = (int)(it % 12), pos = t % SEQ;
        bf16* ptr; const float* g;
        if (s < 8) { ptr = QB + (size_t)t * LDQ + s * 64; g = p.qk_g + (layer * 4 + 0) * 64; }
        else if (s < 10) { ptr = KV + (size_t)t * LDKV + (s - 8) * 64; g = p.qk_g + (layer * 4 + 2) * 64; }
        else { ptr = KV + (size_t)t * LDKV + 256 + (s - 10) * 64; g = p.qk_g + (layer * 4 + 3) * 64; }
        float v[64]; ld64(ptr, v);
        float ss = 0.f;
#pragma unroll
        for (int i = 0; i < 64; ++i) ss += v[i] * v[i];
        const float rs = 1.f / sqrtf(ss * (1.f / 64.f) + RMS_EPS);
#pragma unroll
        for (int i = 0; i < 64; ++i) v[i] = v[i] * rs * g[i];
#pragma unroll
        for (int i = 0; i < 32; ++i) {
            float cs, sn; rope_cs(pos, i, cs, sn);
            const float x1 = v[i], x2 = v[i + 32]; v[i] = x1 * cs - x2 * sn; v[i + 32] = x2 * cs + x1 * sn;
        }
        if (s < 8) {
#pragma unroll
            for (int i = 0; i < 64; ++i) v[i] *= 0.125f * 1.4426950408889634f; }
        if (s < 8) st64(ptr, v);
        else {
            const int gg = (s - 8) & 1, bq = t / SEQ; bf16* k8 = WSP(bf16, s < 10 ? WS_KS8 : WS_KW8) + (size_t)(bq * NKV + gg) * 8 * SEQ * 8;
#pragma unroll
            for (int dg = 0; dg < 8; ++dg) { U4 w; w.x = (unsigned)f2bf(v[8 * dg]) | ((unsigned)f2bf(v[8 * dg + 1]) << 16); w.y = (unsigned)f2bf(v[8 * dg + 2]) | ((unsigned)f2bf(v[8 * dg + 3]) << 16);
                w.z = (unsigned)f2bf(v[8 * dg + 4]) | ((unsigned)f2bf(v[8 * dg + 5]) << 16); w.w = (unsigned)f2bf(v[8 * dg + 6]) | ((unsigned)f2bf(v[8 * dg + 7]) << 16);
                *(U4*)(k8 + ((size_t)dg * SEQ + pos) * 8) = w; } }
    }
}

DEV_INLINE void ph_vtrans(const P& p, long gtid, long NT) {
    const bf16* KV = WSP(bf16, AR_KV); bf16* VsT = WSP(bf16, WS_VST); bf16* VwT = WSP(bf16, WS_VWT);
    const long n = (long)BATCH * NKV * (SEQ / 8) * 64;
    for (long it = gtid; it < n; it += NT) {
        const int d = (int)(it % 64); long r = it / 64; const int kg = (int)(r % (SEQ / 8)); const int bg = (int)(r / (SEQ / 8)), b = bg / NKV, g = bg % NKV;
        const int kbase = (kg >> 2) * 32 + 4 * (kg & 3);
        const bf16* src = KV + (size_t)(b * SEQ + kbase) * LDKV + g * 64 + d;
        U4 s, w; unsigned short sv[8], wv[8];
#pragma unroll
        for (int j = 0; j < 8; ++j) { const size_t ro = (size_t)((j & 3) + 16 * (j >> 2)) * LDKV; sv[j] = src[ro + 128]; wv[j] = src[ro + 384]; }
        s.x = sv[0] | ((unsigned)sv[1] << 16); s.y = sv[2] | ((unsigned)sv[3] << 16); s.z = sv[4] | ((unsigned)sv[5] << 16); s.w = sv[6] | ((unsigned)sv[7] << 16);
        w.x = wv[0] | ((unsigned)wv[1] << 16); w.y = wv[2] | ((unsigned)wv[3] << 16); w.z = wv[4] | ((unsigned)wv[5] << 16); w.w = wv[6] | ((unsigned)wv[7] << 16);
        *(U4*)(VsT + (((size_t)bg * (SEQ / 8) + kg) * 64 + d) * 8) = s; *(U4*)(VwT + (((size_t)bg * (SEQ / 8) + kg) * 64 + d) * 8) = w;
    }
}
namespace pg8 {
#define PG8_LAS __attribute__((address_space(3)))
typedef unsigned short bf16_t;
typedef short bf16x8 __attribute__((ext_vector_type(8)));
typedef float f32x4 __attribute__((ext_vector_type(4)));
typedef unsigned u32x4 __attribute__((ext_vector_type(4)));
constexpr int BM = 256, BK = 64, HALF = 128, HTB = HALF * BK * 2  , STAGE_BYTES = 8 * HTB, NXCD = 8, WGM = 8;

__host__ __device__ __forceinline__ int lds_byte(int r, int c) { const int st = (r >> 4) * 2 + (c >> 5), rr = r & 15, cc = c & 31, ob = rr * 64 + cc * 2; return st * 1024 + (ob ^ (((ob >> 9) & 1) << 5)); }
__host__ __device__ __forceinline__ void stage_rc(int b, int& R, int& C) { const int st = b / 1024, sb = b % 1024, swz = sb ^ (((sb >> 9) & 1) << 5); R = (st >> 1) * 16 + swz / 64; C = (st & 1) * 32 + (swz % 64) / 2; }
__host__ __device__ __forceinline__ int perm32(int rho) { const int n = rho >> 4, i = rho & 15; return 8 * (i >> 2) + 4 * n + (i & 3); }

struct Unit { int pm, pn; };
struct Gemm { const bf16_t* A; const bf16_t* Bt; int M, N, K; int lda; int ldb; };

struct StaticOrder {
    int nM, nN, nwg, G, c;
    __host__ __device__ void init(int M, int N, int G_, int c_) { nM = M / BM; nN = N / BM; nwg = nM * nN; G = G_; c = c_; }
    __host__ __device__ bool next(int i, Unit& u) const {
        const long L = (long)i * G + c; if (L >= nwg) return false;
        int wgid = (int)L; { const int q = nwg / NXCD, r = nwg % NXCD, xcd = wgid % NXCD, off = wgid / NXCD; wgid = (xcd < r ? xcd * (q + 1) : r * (q + 1) + (xcd - r) * q) + off; }
        const int nig = WGM * nN, gid = wgid / nig, fm = gid * WGM, gsz = (nM - fm) < WGM ? (nM - fm) : WGM;
        u.pm = fm + ((wgid % nig) % gsz); u.pn = (wgid % nig) / gsz; return true;
    }
    __device__ __forceinline__ void a_ready(const Unit&) const {}
    __device__ __forceinline__ void done(const Unit&) const {}
};

__device__ __forceinline__ unsigned cvt_pk_bf16(float lo, float hi) { unsigned r; asm volatile("v_cvt_pk_bf16_f32 %0, %1, %2" : "=v"(r) : "v"(lo), "v"(hi)); return r; }
typedef float f32x2 __attribute__((ext_vector_type(2)));
template <class Epi, class Sched, bool ALIGN_EPI = false, bool SP2 = false, bool KSPLIT = false>
__device__ __forceinline__ void gemm_phase(PG8_LAS unsigned char* lds, const Gemm g, const Sched& S, const Epi& E, int tid_in) {
    int tid_ = tid_in; asm volatile("" : "+v"(tid_));
    const int tid = tid_, wid = __builtin_amdgcn_readfirstlane(tid >> 6), lane = tid & 63, wr = wid >> 2, wc = wid & 3, fr = lane & 15, fq = lane >> 4;
    const int K = g.K, nt = K / BK, lda = g.lda ? g.lda : K, ldb = g.ldb ? g.ldb : K;
    unsigned voffA[2], voffB[2];
#pragma unroll
    for (int i = 0; i < 2; ++i) { int R, C; stage_rc(tid * 16 + i * 8192, R, C); const int Rb = Epi::PERM ? ((R & ~31) + perm32(R & 31)) : R;
        voffA[i] = (unsigned)(R * lda + C) * 2u; voffB[i] = (unsigned)(Rb * ldb + C) * 2u; }
    const size_t kstep = (size_t)(BK * 2);
    const size_t hstepA = (size_t)HALF * lda * 2, hstepB = (size_t)HALF * ldb * 2;
    const size_t hstep_unused = (size_t)HALF * K * 2;
    const size_t tstepA = 2 * hstepA, tstepB = 2 * hstepB;
    const unsigned ldsw = (unsigned)wid * 1024u;
    const int aoff = lds_byte(wr * 64 + fr, fq * 8), boff = lds_byte(wc * 32 + fr, fq * 8);
#define PG8_SA(b, h) (((b) * 2 + (h)) * HTB)
#define PG8_SB(b, h) ((4 + (b) * 2 + (h)) * HTB)
#define PG8_STAGE(bufoff, gbase, voff) do { _Pragma("unroll") for (int _i = 0; _i < 2; ++_i) \
        __builtin_amdgcn_global_load_lds((const unsigned*)((const char*)(gbase) + (voff)[_i]), (PG8_LAS unsigned*)(lds + (bufoff) + ldsw + _i * 8192), 16, 0, 0); } while (0)
#define PG8_LDA(dst, b, h) do { _Pragma("unroll") for (int m = 0; m < 4; ++m) _Pragma("unroll") for (int k = 0; k < 2; ++k) dst[m][k] = *(const PG8_LAS bf16x8*)(lds + PG8_SA(b, h) + aoff + m * 2048 + k * 1024); } while (0)
#define PG8_LDB(dst, b, h) do { _Pragma("unroll") for (int n = 0; n < 2; ++n) _Pragma("unroll") for (int k = 0; k < 2; ++k) dst[n][k] = *(const PG8_LAS bf16x8*)(lds + PG8_SB(b, h) + boff + n * 2048 + k * 1024); } while (0)
#define PG8_MMA(ai, bj, At, Bt) do { __builtin_amdgcn_s_setprio(1); _Pragma("unroll") for (int m = 0; m < 4; ++m) _Pragma("unroll") for (int n = 0; n < 2; ++n) _Pragma("unroll") for (int k = 0; k < 2; ++k) \
        acc[ai][bj][m][n] = __builtin_amdgcn_mfma_f32_16x16x32_bf16(Bt[n][k], At[m][k], acc[ai][bj][m][n], 0, 0, 0); __builtin_amdgcn_s_setprio(0); } while (0)
#define PG8_WAIT_V(n) asm volatile("s_waitcnt vmcnt(" #n ")" ::: "memory")
#define PG8_WAIT_L(n) asm volatile("s_waitcnt lgkmcnt(" #n ")" ::: "memory")
#define PG8_BAR __builtin_amdgcn_s_barrier()
#define PG8_SCHED __builtin_amdgcn_sched_barrier(0)
    Unit cur, nxt; int ui = 0;
    if (!S.next(0, cur)) return;
    f32x4 acc[2][2][4][2];
#pragma unroll
    for (int a = 0; a < 2; ++a)
#pragma unroll
        for (int b = 0; b < 2; ++b)
#pragma unroll
            for (int m = 0; m < 4; ++m)
#pragma unroll
                for (int n = 0; n < 2; ++n) acc[a][b][m][n] = (f32x4){0.f, 0.f, 0.f, 0.f};
    bf16x8 At[4][2], B0[2][2], B1[2][2];
    const char* cA = (const char*)g.A + (size_t)cur.pm * tstepA + (KSPLIT ? (size_t)(cur.pn >> 16) * K * 2 : 0); const char* cB = (const char*)g.Bt + (size_t)(KSPLIT ? (cur.pn & 0xffff) : cur.pn) * tstepB + (KSPLIT ? (size_t)(cur.pn >> 16) * K * 2 : 0);
    S.a_ready(cur);
    if constexpr (SP2) {
        PG8_STAGE(PG8_SB(0, 0), cB, voffB); PG8_STAGE(PG8_SB(0, 1), cB + hstepB, voffB); PG8_STAGE(PG8_SA(0, 0), cA, voffA); PG8_STAGE(PG8_SA(0, 1), cA + hstepA, voffA);
        if (wr == 1) PG8_BAR;
        PG8_WAIT_V(2); PG8_BAR;
        PG8_STAGE(PG8_SB(1, 0), cB + kstep, voffB); PG8_STAGE(PG8_SA(1, 0), cA + kstep, voffA); PG8_STAGE(PG8_SB(1, 1), cB + hstepB + kstep, voffB);
        PG8_WAIT_V(6); PG8_BAR;
    } else {
        PG8_STAGE(PG8_SB(0, 0), cB, voffB); PG8_STAGE(PG8_SA(0, 0), cA, voffA); PG8_STAGE(PG8_SB(0, 1), cB + hstepB, voffB); PG8_STAGE(PG8_SA(0, 1), cA + hstepA, voffA);
        if (wr == 1) PG8_BAR;
        PG8_WAIT_V(4); PG8_BAR;
        PG8_STAGE(PG8_SB(1, 0), cB + kstep, voffB); PG8_STAGE(PG8_SA(1, 0), cA + kstep, voffA); PG8_STAGE(PG8_SB(1, 1), cB + hstepB + kstep, voffB);
        PG8_WAIT_V(6); PG8_BAR;
    }
    for (;;) {
        const bool has_next = S.next(ui + 1, nxt);
        const char* nA = has_next ? (const char*)g.A + (size_t)nxt.pm * tstepA + (KSPLIT ? (size_t)(nxt.pn >> 16) * K * 2 : 0) : cA; const char* nB = has_next ? (const char*)g.Bt + (size_t)(KSPLIT ? (nxt.pn & 0xffff) : nxt.pn) * tstepB + (KSPLIT ? (size_t)(nxt.pn >> 16) * K * 2 : 0) : cB;
        for (int t = 0; t < nt; t += 2) {
            const bool last = (t == nt - 2);
            const char* a1 = cA + (size_t)(t + 1) * kstep;
            const char* a2 = last ? nA : cA + (size_t)(t + 2) * kstep; const char* b2 = last ? nB : cB + (size_t)(t + 2) * kstep;
            const char* a3 = a2 + kstep; const char* b3 = b2 + kstep;
            if (last && has_next) S.a_ready(nxt);
            if constexpr (SP2) {
            PG8_LDB(B0, 0, 0); PG8_LDB(B1, 0, 1); PG8_SCHED; PG8_LDA(At, 0, 0); PG8_STAGE(PG8_SA(1, 1), a1 + hstepA, voffA);
            PG8_WAIT_V(8); PG8_WAIT_L(0); PG8_BAR; PG8_MMA(0, 0, At, B0); PG8_MMA(0, 1, At, B1); PG8_BAR; PG8_SCHED;
            PG8_LDA(At, 0, 1); PG8_STAGE(PG8_SB(0, 0), b2, voffB); PG8_STAGE(PG8_SB(0, 1), b2 + hstepB, voffB); PG8_STAGE(PG8_SA(0, 0), a2, voffA);
            PG8_WAIT_V(8); PG8_WAIT_L(0); PG8_BAR; PG8_MMA(1, 0, At, B0); PG8_MMA(1, 1, At, B1); PG8_BAR; PG8_SCHED;
            PG8_LDB(B0, 1, 0); PG8_LDB(B1, 1, 1); PG8_SCHED; PG8_LDA(At, 1, 0); PG8_STAGE(PG8_SA(0, 1), a2 + hstepA, voffA);
            PG8_WAIT_V(8); PG8_WAIT_L(0); PG8_BAR; PG8_MMA(0, 0, At, B0); PG8_MMA(0, 1, At, B1); PG8_BAR; PG8_SCHED;
            PG8_LDA(At, 1, 1); PG8_STAGE(PG8_SB(1, 0), b3, voffB); PG8_STAGE(PG8_SB(1, 1), b3 + hstepB, voffB); PG8_STAGE(PG8_SA(1, 0), a3, voffA);
            PG8_WAIT_V(8); PG8_WAIT_L(0); PG8_BAR; PG8_MMA(1, 0, At, B0); PG8_MMA(1, 1, At, B1); PG8_BAR; PG8_SCHED;
            } else {
            PG8_LDB(B0, 0, 0); PG8_SCHED; PG8_LDA(At, 0, 0); PG8_STAGE(PG8_SA(1, 1), a1 + hstepA, voffA);
            PG8_WAIT_L(8); PG8_BAR; PG8_WAIT_L(0); PG8_MMA(0, 0, At, B0); PG8_BAR; PG8_SCHED;
            PG8_LDB(B1, 0, 1); PG8_STAGE(PG8_SB(0, 0), b2, voffB);
            PG8_BAR; PG8_WAIT_L(0); PG8_MMA(0, 1, At, B1); PG8_BAR;
            PG8_LDA(At, 0, 1); PG8_STAGE(PG8_SA(0, 0), a2, voffA);
            PG8_BAR; PG8_WAIT_L(0); PG8_MMA(1, 0, At, B0); PG8_BAR; PG8_SCHED;
            PG8_STAGE(PG8_SB(0, 1), b2 + hstepB, voffB);
            PG8_WAIT_V(6); PG8_BAR; PG8_MMA(1, 1, At, B1); PG8_BAR;
            PG8_LDB(B0, 1, 0); PG8_SCHED; PG8_LDA(At, 1, 0); PG8_STAGE(PG8_SA(0, 1), a2 + hstepA, voffA);
            PG8_WAIT_L(8); PG8_BAR; PG8_WAIT_L(0); PG8_MMA(0, 0, At, B0); PG8_BAR; PG8_SCHED;
            PG8_LDB(B1, 1, 1); PG8_STAGE(PG8_SB(1, 0), b3, voffB);
            PG8_BAR; PG8_WAIT_L(0); PG8_MMA(0, 1, At, B1); PG8_BAR;
            PG8_LDA(At, 1, 1); PG8_STAGE(PG8_SA(1, 0), a3, voffA);
            PG8_BAR; PG8_WAIT_L(0); PG8_MMA(1, 0, At, B0); PG8_BAR; PG8_SCHED;
            PG8_STAGE(PG8_SB(1, 1), b3 + hstepB, voffB);
            PG8_WAIT_V(6); PG8_BAR; PG8_MMA(1, 1, At, B1); PG8_BAR;
            }
        }
        if constexpr (ALIGN_EPI) { if (wr == 0) PG8_BAR; }
        if constexpr (!Epi::AFTER_DRAIN) { E(acc, cur, wr, wc, fr, fq); S.done(cur); }
        if (!has_next) break;
#pragma unroll
        for (int a = 0; a < 2; ++a)
#pragma unroll
            for (int b = 0; b < 2; ++b)
#pragma unroll
                for (int m = 0; m < 4; ++m)
#pragma unroll
                    for (int n = 0; n < 2; ++n) acc[a][b][m][n] = (f32x4){0.f, 0.f, 0.f, 0.f};
        cur = nxt; cA = nA; cB = nB; ++ui;
        if constexpr (ALIGN_EPI) { if (wr == 1) PG8_BAR; }
    }
    PG8_WAIT_V(0);
    if constexpr (!ALIGN_EPI) { if (wr == 0) PG8_BAR; }
    PG8_BAR;
    if constexpr (Epi::AFTER_DRAIN) { E.fused(acc, cur, wr, wc, fr, fq, lds, wid, lane); S.done(cur); }
#undef PG8_SA
#undef PG8_SB
#undef PG8_STAGE
#undef PG8_LDA
#undef PG8_LDB
#undef PG8_MMA
#undef PG8_WAIT_V
#undef PG8_WAIT_L
#undef PG8_BAR
#undef PG8_SCHED
}
}

#define LAS __attribute__((address_space(3)))
#define XB_TMO      128
#define XB_XCNT(j)  (256  + 64 * (j))
#define XB_XSUB(j)  (1280 + 64 * (j))
#define XB_XGEN(j)  (2304 + 64 * (j))
#define XB_TOP      3328
#define XB_TOPGEN   3392
#define XCD_BAR_WORDS 3456
#define XB_SPIN_CAP (1u << 22)

__device__ __forceinline__ unsigned xb_ld(unsigned* p)              { return __hip_atomic_load(p, __ATOMIC_RELAXED, __HIP_MEMORY_SCOPE_AGENT); }
__device__ __forceinline__ unsigned xb_add(unsigned* p, unsigned v) { return __hip_atomic_fetch_add(p, v, __ATOMIC_RELAXED, __HIP_MEMORY_SCOPE_AGENT); }
__device__ __forceinline__ unsigned xb_xcc_id() { return (unsigned)__builtin_amdgcn_s_getreg((3 << 11) | 20) & 0xFu; }
#define XB_SPIN(cond, bar) do { unsigned _sp = 0; while (cond) { __builtin_amdgcn_s_sleep(1); \
    if ((++_sp & 255u) == 0u) { if (xb_ld(&(bar)[XB_TMO])) break; if (_sp > XB_SPIN_CAP) { atomicAdd(&(bar)[XB_TMO], 1u); break; } } } } while (0)

struct XcdBarrier {
    unsigned* bar; unsigned x;
    volatile LAS unsigned* st;
};

__device__ __forceinline__ XcdBarrier xcd_barrier_post(unsigned* bar, volatile LAS unsigned* st) {
    XcdBarrier b; b.bar = bar; b.x = xb_xcc_id(); b.st = st;
    if (threadIdx.x == 0) (void)xb_add(&bar[XB_XCNT(b.x)], 1u);
    return b;
}
__device__ __forceinline__ void xcd_barrier_complete(unsigned* bar, unsigned x, unsigned& nloc, unsigned& nx) {
    const unsigned G = gridDim.x * gridDim.y * gridDim.z;
    unsigned sum, cnt, mine, sp = 0u;
    for (;;) {
        sum = 0u; cnt = 0u; mine = 0u;
#pragma unroll
        for (unsigned j = 0; j < 16; ++j) { const unsigned c = xb_ld(&bar[XB_XCNT(j)]); sum += c; cnt += (c > 0u) ? 1u : 0u; mine = (j == x) ? c : mine; }
        if (sum == G) break;
        __builtin_amdgcn_s_sleep(1);
        if ((++sp & 255u) == 0u) { if (xb_ld(&bar[XB_TMO])) break; if (sp > XB_SPIN_CAP) { atomicAdd(&bar[XB_TMO], 1u); break; } }
    }
    nloc = mine > 0u ? mine : 1u; nx = cnt > 0u ? cnt : 1u;
}

__device__ __forceinline__ void xcd_barrier(const XcdBarrier& b, int tid_x  ) {
    asm volatile("s_waitcnt vmcnt(0)" ::: "memory");
    __syncthreads();
    if (tid_x == 0) {
        unsigned* bar = b.bar; asm volatile("" : "+s"(bar));
        unsigned xx = b.x; asm volatile("" : "+s"(xx));
        __builtin_amdgcn_s_waitcnt(0);
        unsigned nloc = b.st[0], nx = b.st[1];
        if (nloc == 0u) { xcd_barrier_complete(bar, xx, nloc, nx); b.st[0] = nloc; b.st[1] = nx; }
        const unsigned old = xb_add(&bar[XB_XSUB(xx)], 1u);
        const unsigned gen = old / nloc;
        if (old + 1u == (gen + 1u) * nloc) {
            __builtin_amdgcn_fence(__ATOMIC_RELEASE, "agent");
            asm volatile("s_waitcnt vmcnt(0)" ::: "memory");
            const unsigned og = xb_add(&bar[XB_TOP], 1u);
            const unsigned tg = og / nx;
            if (og + 1u == (tg + 1u) * nx) xb_add(&bar[XB_TOPGEN], 1u);
            else XB_SPIN(xb_ld(&bar[XB_TOPGEN]) == tg, bar);
            __builtin_amdgcn_fence(__ATOMIC_ACQUIRE, "agent");
            xb_add(&bar[XB_XGEN(xx)], 1u);
            asm volatile("s_waitcnt vmcnt(0)" ::: "memory");
        } else {
            XB_SPIN(xb_ld(&bar[XB_XGEN(xx)]) == gen, bar);
            __builtin_amdgcn_fence(__ATOMIC_ACQUIRE, "agent");
            asm volatile("s_waitcnt vmcnt(0)" ::: "memory");
        }
    }
    __syncthreads();
}
#define GAS __attribute__((address_space(1)))
typedef unsigned v4u __attribute__((ext_vector_type(4)));
typedef unsigned v2u __attribute__((ext_vector_type(2)));
typedef GAS unsigned gu32;
#define RLX_AGENT __ATOMIC_RELAXED, __HIP_MEMORY_SCOPE_AGENT
#define LDS_WAIT() asm volatile("s_waitcnt lgkmcnt(0)" ::: "memory")
#define VM_WAIT() asm volatile("s_waitcnt vmcnt(0)" ::: "memory")
using pg8::f32x4; using pg8::Unit; using pg8::Gemm; using pg8::BM; using pg8::HALF; using pg8::cvt_pk_bf16; using pg8::u32x4;

constexpr int NWAVES = 8, NTHREADS = 512;
constexpr int RING_BYTES = 131072, LDSCTL_OFF = 147456 - 1024, MISC_OFF = LDSCTL_OFF + 320, LDS_BYTES = 147456;

__device__ __forceinline__ float wave_sum(float v, int lane) {
#pragma unroll
    for (int o = 1; o < 64; o <<= 1) v += __builtin_bit_cast(float, __builtin_amdgcn_ds_bpermute((lane ^ o) << 2, __builtin_bit_cast(int, v)));
    return v;
}
__device__ __forceinline__ float fsig(float x) { return __builtin_amdgcn_rcpf(1.f + __expf(-x)); }

__device__ __forceinline__ int lane_id_opaque() { int l; asm volatile("v_mbcnt_lo_u32_b32 %0, -1, 0\n\tv_mbcnt_hi_u32_b32 %0, -1, %0" : "=v"(l)); return l; }
__device__ __forceinline__ int rfl(int v) { return __builtin_amdgcn_readfirstlane(v); }
struct SOrder {
    pg8::StaticOrder s;
    __device__ void init(int M, int N, int G, int c) { s.init(M, N, G, c); }
    __device__ bool next(int i, Unit& u) const { Unit t; t.pm = 0; t.pn = 0; const bool ok = s.next(i, t); u.pm = rfl(t.pm); u.pn = rfl(t.pn); return ok; }
    __device__ __forceinline__ void a_ready(const Unit&) const {}
    __device__ __forceinline__ void done(const Unit&) const {}
};
struct StackOrder {
    pg8::StaticOrder s; int nM, nN;
    __device__ StackOrder(int nM_, int nN_, int nb, int G, int c) : nM(nM_), nN(nN_) { s.init(nb * nM_ * 256, nN_ * 256, G, c); }
    __device__ bool next(int i, Unit& u) const { Unit t; t.pm = 0; t.pn = 0; if (!s.next(i, t)) return false; u.pm = rfl(t.pm); u.pn = rfl((t.pm / nM) * nN + t.pn); return true; }
    __device__ __forceinline__ void a_ready(const Unit&) const {}
    __device__ __forceinline__ void done(const Unit&) const {}
};
struct GateOrder {
    pg8::StaticOrder s; int nN;
    __device__ GateOrder(int nM_, int nN_, int G, int c) : nN(nN_) { s.init(nM_ * 256, nN_ * 256, G, c); }
    __device__ bool next(int i, Unit& u) const { const int j = i / 3, br = i - 3 * j; Unit t; t.pm = 0; t.pn = 0; if (!s.next(j, t)) return false; u.pm = rfl(t.pm); u.pn = rfl(br * nN + t.pn); return true; }
    __device__ __forceinline__ void a_ready(const Unit&) const {}
    __device__ __forceinline__ void done(const Unit&) const {}
};
struct MoeOrder {
    pg8::StaticOrder s; int nN, e0, e1, e2, e3, e4, e5, e6, e7;
    __device__ void init(const unsigned* cnt  , int nN_, int G_, int c_) { nN = nN_;
        int t = 0; t += (cnt[0] + 255) >> 8; e0 = t; t += (cnt[64] + 255) >> 8; e1 = t; t += (cnt[128] + 255) >> 8; e2 = t; t += (cnt[192] + 255) >> 8; e3 = t;
        t += (cnt[256] + 255) >> 8; e4 = t; t += (cnt[320] + 255) >> 8; e5 = t; t += (cnt[384] + 255) >> 8; e6 = t; t += (cnt[448] + 255) >> 8; e7 = t;
        s.init(e7 * 256, nN_ * 256, G_, c_); }
    __device__ bool next(int i, Unit& u) const { Unit t; t.pm = 0; t.pn = 0; if (!s.next(i, t)) return false;
        const int pm = t.pm, e = (pm >= e0) + (pm >= e1) + (pm >= e2) + (pm >= e3) + (pm >= e4) + (pm >= e5) + (pm >= e6);
        u.pm = rfl(pm); u.pn = rfl(e * nN + t.pn); return true; }
    __device__ __forceinline__ void a_ready(const Unit&) const {}
    __device__ __forceinline__ void done(const Unit&) const {}
};

__device__ __forceinline__ u32x4 pack8(f32x4 v0, f32x4 v1) { u32x4 w; w.x = cvt_pk_bf16(v0[0], v0[1]); w.y = cvt_pk_bf16(v0[2], v0[3]); w.z = cvt_pk_bf16(v1[0], v1[1]); w.w = cvt_pk_bf16(v1[2], v1[3]); return w; }
__device__ __forceinline__ void unpack8(u32x4 w, f32x4& v0, f32x4& v1) {
    v0 = (f32x4){blo(w.x), bhi(w.x), blo(w.y), bhi(w.y)}; v1 = (f32x4){blo(w.z), bhi(w.z), blo(w.w), bhi(w.w)}; }

struct EpiProj {
    static constexpr bool PERM = true, AFTER_DRAIN = false;
    unsigned char* ws;
    __device__ __forceinline__ void operator()(const f32x4 (&acc)[2][2][4][2], const Unit& u, int wr, int wc, int fr, int fq) const {
        bf16* const QB = (bf16*)(ws + AR_QB); bf16* const KV = (bf16*)(ws + AR_KV); bf16* const UB = (bf16*)(ws + AR_UB); bf16* const RW = (bf16*)(ws + AR_RW); bf16* const HALO = (bf16*)(ws + AR_HALO); bf16* const CKV = (bf16*)(ws + AR_CKV);
        const int row0 = u.pm * BM + wr * 64 + fr, cl = wc * 32 + 8 * fq;
        if (u.pn >= 5 && u.pn < 9) {
#pragma unroll
            for (int ai = 0; ai < 2; ++ai)
#pragma unroll
                for (int m = 0; m < 4; ++m) { f32x4 a0 = acc[ai][0][m][0], a1 = acc[ai][0][m][1]; const f32x4 b0 = acc[ai][1][m][0], b1 = acc[ai][1][m][1];
#pragma unroll
                    for (int k = 0; k < 4; ++k) { a0[k] *= fsig(b0[k]); a1[k] *= fsig(b1[k]); }
                    *(u32x4*)(UB + (size_t)(row0 + ai * HALF + m * 16) * 512 + (u.pn - 5) * 128 + cl) = pack8(a0, a1); }
            return;
        }
        if (u.pn == 2) {
#pragma unroll
            for (int ai = 0; ai < 2; ++ai)
#pragma unroll
                for (int m = 0; m < 4; ++m) { const int row = row0 + ai * HALF + m * 16, b = row / SEQ, tt = row % SEQ;
#pragma unroll
                    for (int bj = 0; bj < 2; ++bj) *(u32x4*)(CKV + (((size_t)bj * (BATCH * NKV) + b * NKV + (cl >> 6)) * SEQ + tt) * 64 + (cl & 63)) = pack8(acc[ai][bj][m][0], acc[ai][bj][m][1]); }
            return;
        }
        bf16* base; int ld, c0;
        if (u.pn < 2) { base = QB; ld = LDQ; c0 = u.pn * 256; } else if (u.pn < 5) { base = KV; ld = LDKV; c0 = (u.pn - 3) * 256; } else { base = RW; ld = LDRW; c0 = (u.pn - 9) * 256; }
#pragma unroll
        for (int ai = 0; ai < 2; ++ai)
#pragma unroll
            for (int m = 0; m < 4; ++m)
#pragma unroll
                for (int bj = 0; bj < 2; ++bj) { const u32x4 w = pack8(acc[ai][bj][m][0], acc[ai][bj][m][1]);
                    *(u32x4*)(base + (size_t)(row0 + ai * HALF + m * 16) * ld + c0 + bj * HALF + cl) = w;
                    if (u.pn >= 9 && ai == 1 && m == 3 && wr == 1 && fr == 15) *(u32x4*)(HALO + (size_t)u.pm * LDRW + c0 + bj * HALF + cl) = w; }
    }
};
struct EpiStore {
    static constexpr bool PERM = true, AFTER_DRAIN = false;
    bf16* O; int ld, ntn;
    __device__ __forceinline__ void operator()(const f32x4 (&acc)[2][2][4][2], const Unit& u, int wr, int wc, int fr, int fq) const {
        const int row0 = u.pm * BM + wr * 64 + fr, c0 = (u.pn % ntn) * 256 + wc * 32 + 8 * fq;
#pragma unroll
        for (int ai = 0; ai < 2; ++ai)
#pragma unroll
            for (int m = 0; m < 4; ++m)
#pragma unroll
                for (int bj = 0; bj < 2; ++bj) *(u32x4*)(O + (size_t)(row0 + ai * HALF + m * 16) * ld + c0 + bj * HALF) = pack8(acc[ai][bj][m][0], acc[ai][bj][m][1]);
    }
};
struct EpiGate {
    static constexpr bool PERM = true, AFTER_DRAIN = false;
    unsigned char* ws; int ntn;
    __device__ __forceinline__ void operator()(const f32x4 (&acc)[2][2][4][2], const Unit& u, int wr, int wc, int fr, int fq) const {
        const bf16* const OB = (const bf16*)(ws + AR_OBUF); bf16* const MIX = (bf16*)(ws + AR_MIX);
        const int br = u.pn / ntn, row0 = u.pm * BM + wr * 64 + fr, c0 = (u.pn % ntn) * 256 + wc * 32 + 8 * fq;
        const bf16* ob = OB + (size_t)br * T * DM;
#pragma unroll
        for (int ai = 0; ai < 2; ++ai) {
            u32x4 o[4][2], mx[4][2];
#pragma unroll
            for (int m = 0; m < 4; ++m)
#pragma unroll
                for (int bj = 0; bj < 2; ++bj) { const size_t off = (size_t)(row0 + ai * HALF + m * 16) * DM + c0 + bj * HALF; o[m][bj] = *(const u32x4*)(ob + off); if (br != 0) mx[m][bj] = *(const u32x4*)(MIX + off); }
#pragma unroll
            for (int m = 0; m < 4; ++m)
#pragma unroll
                for (int bj = 0; bj < 2; ++bj) { const size_t off = (size_t)(row0 + ai * HALF + m * 16) * DM + c0 + bj * HALF;
                    f32x4 o0, o1; unpack8(o[m][bj], o0, o1);
                    f32x4 g0 = acc[ai][bj][m][0], g1 = acc[ai][bj][m][1];
#pragma unroll
                    for (int k = 0; k < 4; ++k) { g0[k] = fsig(g0[k]) * o0[k]; g1[k] = fsig(g1[k]) * o1[k]; }
                    if (br != 0) { f32x4 p0, p1; unpack8(mx[m][bj], p0, p1); g0 += p0; g1 += p1; }
                    *(u32x4*)(MIX + off) = pack8(g0, g1); }
        }
    }
};
struct EpiResid {
    static constexpr bool PERM = true, AFTER_DRAIN = false;
    const float* base; float* out;
    __device__ __forceinline__ void operator()(const f32x4 (&acc)[2][2][4][2], const Unit& u, int wr, int wc, int fr, int fq) const {
        const int row0 = u.pm * BM + wr * 64 + fr, c0 = u.pn * 256 + wc * 32 + 8 * fq;
#pragma unroll
        for (int ai = 0; ai < 2; ++ai)
#pragma unroll
            for (int mh = 0; mh < 2; ++mh) {
                f32x4 x[2][2][2];
#pragma unroll
                for (int mm = 0; mm < 2; ++mm)
#pragma unroll
                    for (int bj = 0; bj < 2; ++bj) { const size_t off = (size_t)(row0 + ai * HALF + (2 * mh + mm) * 16) * DM + c0 + bj * HALF; x[mm][bj][0] = *(const f32x4*)(base + off); x[mm][bj][1] = *(const f32x4*)(base + off + 4); }
#pragma unroll
                for (int mm = 0; mm < 2; ++mm)
#pragma unroll
                    for (int bj = 0; bj < 2; ++bj) { const int m = 2 * mh + mm; const size_t off = (size_t)(row0 + ai * HALF + m * 16) * DM + c0 + bj * HALF;
                        *(f32x4*)(out + off) = x[mm][bj][0] + acc[ai][bj][m][0]; *(f32x4*)(out + off + 4) = x[mm][bj][1] + acc[ai][bj][m][1]; }
            }
    }
};
struct EpiSwiglu {
    static constexpr bool PERM = true, AFTER_DRAIN = false;
    bf16* ACT; int ld, ntn;
    __device__ __forceinline__ void operator()(const f32x4 (&acc)[2][2][4][2], const Unit& u, int wr, int wc, int fr, int fq) const {
        const int row0 = u.pm * BM + wr * 64 + fr, c0 = (u.pn % ntn) * 128 + wc * 32 + 8 * fq;
#pragma unroll
        for (int ai = 0; ai < 2; ++ai)
#pragma unroll
            for (int m = 0; m < 4; ++m) { f32x4 g0 = acc[ai][0][m][0], g1 = acc[ai][0][m][1]; const f32x4 u0 = acc[ai][1][m][0], u1 = acc[ai][1][m][1];
#pragma unroll
                for (int k = 0; k < 4; ++k) { g0[k] = g0[k] * fsig(g0[k]) * u0[k]; g1[k] = g1[k] * fsig(g1[k]) * u1[k]; }
                *(u32x4*)(ACT + (size_t)(row0 + ai * HALF + m * 16) * ld + c0) = pack8(g0, g1); }
    }
};
struct EpiMoeDown {
    static constexpr bool PERM = true, AFTER_DRAIN = false;
    float* out; const int* rtok; const float* rw; int ntn; float sc;
    __device__ __forceinline__ void operator()(const f32x4 (&acc)[2][2][4][2], const Unit& u, int wr, int wc, int fr, int fq) const {
        const int row0 = u.pm * BM + wr * 64 + fr, c0 = (u.pn % ntn) * 256 + wc * 32 + 8 * fq;
#pragma unroll
        for (int ai = 0; ai < 2; ++ai)
#pragma unroll
            for (int mh = 0; mh < 2; ++mh) {
                int tok[2]; float w[2]; f32x4 x[2][2][2];
#pragma unroll
                for (int mm = 0; mm < 2; ++mm) { const int row = row0 + ai * HALF + (2 * mh + mm) * 16; tok[mm] = rtok[row]; w[mm] = rw[row] * sc; }
#pragma unroll
                for (int mm = 0; mm < 2; ++mm)
#pragma unroll
                    for (int bj = 0; bj < 2; ++bj) { const float* o = out + (size_t)(tok[mm] >= 0 ? tok[mm] : 0) * DM + c0 + bj * HALF; x[mm][bj][0] = *(const f32x4*)o; x[mm][bj][1] = *(const f32x4*)(o + 4); }
#pragma unroll
                for (int mm = 0; mm < 2; ++mm)
#pragma unroll
                    for (int bj = 0; bj < 2; ++bj) if (tok[mm] >= 0) { const int m = 2 * mh + mm; float* o = out + (size_t)tok[mm] * DM + c0 + bj * HALF;
                        *(f32x4*)o = x[mm][bj][0] + acc[ai][bj][m][0] * w[mm]; *(f32x4*)(o + 4) = x[mm][bj][1] + acc[ai][bj][m][1] * w[mm]; }
            }
    }
};

constexpr int MT_KS = 7, MT_K = EXPERT_FF / MT_KS;
struct MoeTailOrder {
    int nN, pm0, nsub, G, c, e0, e1, e2, e3, e4, e5, e6;
    __device__ void init(const MoeOrder& m, int pm0_, int ntiles, int G_, int c_) { nN = m.nN; pm0 = pm0_; nsub = ntiles * MT_KS; G = G_; c = c_; e0 = m.e0; e1 = m.e1; e2 = m.e2; e3 = m.e3; e4 = m.e4; e5 = m.e5; e6 = m.e6; }
    __device__ bool next(int i, Unit& u) const { const int L = i * G + c; if (L >= nsub) return false;
        const int j = L / MT_KS, ks = L - j * MT_KS, pm = pm0 + j / nN, pl = j % nN, e = (pm >= e0) + (pm >= e1) + (pm >= e2) + (pm >= e3) + (pm >= e4) + (pm >= e5) + (pm >= e6);
        u.pm = rfl(pm); u.pn = rfl((e * nN + pl) | (ks << 16)); return true; }
    __device__ __forceinline__ void a_ready(const Unit&) const {}
    __device__ __forceinline__ void done(const Unit&) const {}
};
struct EpiPart {
    static constexpr bool PERM = true, AFTER_DRAIN = false;
    float* part; int pm0, nN;
    __device__ __forceinline__ void operator()(const f32x4 (&acc)[2][2][4][2], const Unit& u, int wr, int wc, int fr, int fq) const {
        const int slot = ((u.pm - pm0) * nN + (u.pn & 0xffff) % nN) * MT_KS + (u.pn >> 16);
        float* b = part + (size_t)slot * 65536 + (size_t)(((wr * 4 + wc) * 64 + fq * 16 + fr) * 4);
#pragma unroll
        for (int ai = 0; ai < 2; ++ai)
#pragma unroll
            for (int bj = 0; bj < 2; ++bj)
#pragma unroll
                for (int m = 0; m < 4; ++m)
#pragma unroll
                    for (int n = 0; n < 2; ++n) *(f32x4*)(b + (((ai * 2 + bj) * 4 + m) * 2 + n) * 2048) = acc[ai][bj][m][n];
    }
};
__device__ __forceinline__ void moe_tail_combine(const EpiMoeDown& E, const MoeOrder& mo, const float* part, int pm0, int job, int lane_in) {
    int lane = lane_in; asm volatile("" : "+v"(lane));
    const int q = job & 3, role = (job >> 2) & 7, j = job >> 5, ai = q >> 1, mh = q & 1, pm = pm0 + j / mo.nN, pl = j % mo.nN, wr = role >> 2, wc = role & 3, fr = lane & 15, fq = lane >> 4;
    const float* b = part + (size_t)j * MT_KS * 65536 + (size_t)((role * 64 + lane) * 4);
    f32x4 a[2][2][2];
#pragma unroll
    for (int mm = 0; mm < 2; ++mm)
#pragma unroll
        for (int bj = 0; bj < 2; ++bj)
#pragma unroll
            for (int n = 0; n < 2; ++n) a[mm][bj][n] = *(const f32x4*)(b + (((ai * 2 + bj) * 4 + 2 * mh + mm) * 2 + n) * 2048);
#pragma unroll
    for (int ks = 1; ks < MT_KS; ++ks)
#pragma unroll
        for (int mm = 0; mm < 2; ++mm)
#pragma unroll
            for (int bj = 0; bj < 2; ++bj)
#pragma unroll
                for (int n = 0; n < 2; ++n) a[mm][bj][n] += *(const f32x4*)(b + (size_t)ks * 65536 + (((ai * 2 + bj) * 4 + 2 * mh + mm) * 2 + n) * 2048);
    const int row0 = pm * BM + wr * 64 + fr + ai * HALF + 2 * mh * 16, c0 = pl * 256 + wc * 32 + 8 * fq;
#pragma unroll
    for (int mm = 0; mm < 2; ++mm) { const int tok = E.rtok[row0 + mm * 16]; const float w = E.rw[row0 + mm * 16] * E.sc;
        if (tok >= 0) {
#pragma unroll
            for (int bj = 0; bj < 2; ++bj) { float* o = E.out + (size_t)tok * DM + c0 + bj * HALF; const f32x4 x0 = *(const f32x4*)o, x1 = *(const f32x4*)(o + 4);
                *(f32x4*)o = x0 + a[mm][bj][0] * w; *(f32x4*)(o + 4) = x1 + a[mm][bj][1] * w; } } }
}

typedef short bf16x8_t __attribute__((ext_vector_type(8)));
#define MFMA16(a, b, c) __builtin_amdgcn_mfma_f32_16x16x32_bf16((a), (b), (c), 0, 0, 0)
constexpr float ATT_C = 0.125f * 1.4426950408889634f;
constexpr int AW_IMP = 0, AW_SEL = 8448, AW_QS = 8960, AW_BYTES = 8960 + 8192;
__device__ __forceinline__ float bperm_f(float v, int srclane) { return __builtin_bit_cast(float, __builtin_amdgcn_ds_bpermute(srclane << 2, __builtin_bit_cast(int, v))); }
__device__ __forceinline__ int bperm_i(int v, int srclane) { return __builtin_amdgcn_ds_bpermute(srclane << 2, v); }
__device__ __forceinline__ bf16x8_t ldg8(const bf16* p) { return *(const bf16x8_t*)p; }
__device__ __forceinline__ bf16x8_t pack_p(const f32x4& a, const f32x4& b) {
    v4u w; w.x = cvt_pk_bf16(a[0], a[1]); w.y = cvt_pk_bf16(a[2], a[3]); w.z = cvt_pk_bf16(b[0], b[1]); w.w = cvt_pk_bf16(b[2], b[3]); return __builtin_bit_cast(bf16x8_t, w); }

__device__ __forceinline__ void nsa_attn_item(const P& p, int item, int lane, LAS unsigned char* wl) {
    const bf16* KV = WSP(bf16, AR_KV); const bf16* KC = WSP(bf16, AR_KC); const bf16* VcT = WSP(bf16, AR_VCT); const bf16* VsT = WSP(bf16, WS_VST); const bf16* VwT = WSP(bf16, WS_VWT);
    bf16* QB = WSP(bf16, AR_QB); const float* NG = WSP(float, AR_NG);
    const int bg = item / (SEQ / 16), t0 = (item % (SEQ / 16)) * 16, b = bg >> 1, g = bg & 1;
    const int col = lane & 15, fq = lane >> 4, tok = t0 + col;
    const size_t grow = (size_t)b * SEQ + tok;
    LAS float* IMP = (LAS float*)(wl + AW_IMP); LAS int* SEL = (LAS int*)(wl + AW_SEL); LAS bf16* OS = (LAS bf16*)(wl + AW_IMP);
    const int krowA = 8 * (col >> 2) + (col & 3);
    const float* gate = NG + grow * 24 + g * 12;
    LAS bf16x8_t* QS = (LAS bf16x8_t*)(wl + AW_QS) + lane;
#pragma unroll
    for (int hh = 0; hh < 4; ++hh)
#pragma unroll
        for (int ks = 0; ks < 2; ++ks) QS[(hh * 2 + ks) * 64] = ldg8(QB + grow * LDQ + (g * 4 + hh) * 64 + ks * 32 + fq * 8);
#define Qc(hh, ks) (QS[((hh) * 2 + (ks)) * 64])
    for (int i = lane; i < 16 * 132; i += 64) IMP[i] = 0.f;
    const f32x4 z4 = {0.f, 0.f, 0.f, 0.f};
    f32x4 O[4][4];
    int nvmax = (t0 + 15 >= 31) ? (((t0 + 15 - 31) >> 4) + 1) : 0; if (nvmax > NC) nvmax = NC;
    const int nch = (nvmax + 31) >> 5;
    const bf16* kcb = KC + (size_t)bg * 512 * 64; const bf16* vcb = VcT + (size_t)bg * 64 * 512;
    float linv[4] = {0.f, 0.f, 0.f, 0.f};
#pragma unroll
    for (int hh = 0; hh < 4; ++hh)
#pragma unroll
        for (int mt = 0; mt < 4; ++mt) O[hh][mt] = z4;
#pragma unroll 1
    for (int pass = 0; pass < 2; ++pass) {
#pragma unroll 1
        for (int ch = 0; ch < nch; ++ch) {
            asm volatile("" ::: "memory");
            const int k0 = 32 * ch; const bool cfull = 16 * (k0 + 31) + 31 <= t0;
            bf16x8_t ka[2][2];
#pragma unroll
            for (int tl = 0; tl < 2; ++tl)
#pragma unroll
                for (int ks = 0; ks < 2; ++ks) ka[tl][ks] = ldg8(kcb + ((size_t)(4 * ks + fq) * 512 + k0 + 16 * tl + col) * 8);
            bf16x8_t va[4];
            if (pass == 1) {
#pragma unroll
                for (int mt = 0; mt < 4; ++mt) va[mt] = ldg8(vcb + ((size_t)((k0 >> 3) + fq) * 64 + 16 * mt + col) * 8);
            }
            float ps[8] = {0.f, 0.f, 0.f, 0.f, 0.f, 0.f, 0.f, 0.f};
#pragma unroll
            for (int hh = 0; hh < 4; ++hh) {
                const bf16x8_t q0_ = Qc(hh, 0), q1_ = Qc(hh, 1);
                f32x4 sa = MFMA16(ka[0][0], q0_, z4); sa = MFMA16(ka[0][1], q1_, sa);
                f32x4 sb = MFMA16(ka[1][0], q0_, z4); sb = MFMA16(ka[1][1], q1_, sb);
#pragma unroll
                for (int i = 0; i < 4; ++i) { sa[i] = __builtin_amdgcn_exp2f(sa[i]); sb[i] = __builtin_amdgcn_exp2f(sb[i]); }
                if (!cfull) {
#pragma unroll
                    for (int i = 0; i < 4; ++i) { const int c = k0 + 4 * fq + i; sa[i] = (16 * c + 31 <= tok) ? sa[i] : 0.f; sb[i] = (16 * (c + 16) + 31 <= tok) ? sb[i] : 0.f; } }
                if (pass == 0) { linv[hh] += (sa[0] + sa[1]) + (sa[2] + sa[3]) + (sb[0] + sb[1]) + (sb[2] + sb[3]); }
                else {
#pragma unroll
                    for (int i = 0; i < 4; ++i) { ps[i] = __builtin_fmaf(sa[i], linv[hh], ps[i]); ps[4 + i] = __builtin_fmaf(sb[i], linv[hh], ps[4 + i]); }
                    const bf16x8_t pt = pack_p(sa, sb);
#pragma unroll
                    for (int mt = 0; mt < 4; ++mt) O[hh][mt] = MFMA16(va[mt], pt, O[hh][mt]);
                }
            }
            if (pass == 1) {
                const int Ga = 8 * ch + fq; LAS float* ir = IMP + col * 132 + Ga;
                __hip_atomic_fetch_add(ir, (ps[0] + ps[1]) + (ps[2] + ps[3]), __ATOMIC_RELAXED, __HIP_MEMORY_SCOPE_WORKGROUP);
                __hip_atomic_fetch_add(ir + 1, ps[3], __ATOMIC_RELAXED, __HIP_MEMORY_SCOPE_WORKGROUP);
                __hip_atomic_fetch_add(ir + 4, (ps[4] + ps[5]) + (ps[6] + ps[7]), __ATOMIC_RELAXED, __HIP_MEMORY_SCOPE_WORKGROUP);
                if (Ga + 5 < NS) __hip_atomic_fetch_add(ir + 5, ps[7], __ATOMIC_RELAXED, __HIP_MEMORY_SCOPE_WORKGROUP);
            }
        }
        if (pass == 0) {
#pragma unroll
            for (int hh = 0; hh < 4; ++hh) { float l = linv[hh]; l += bperm_f(l, lane ^ 16); l += bperm_f(l, lane ^ 32); linv[hh] = l > 0.f ? 1.f / l : 0.f; }
        }
    }
    LDS_WAIT(); asm volatile("" ::: "memory");
    {
        const int cur = tok >> 6; LAS float* sc = IMP + col * 132;
        for (int j = fq * 32; j < fq * 32 + 32; ++j) { const bool forced = (j == 0) || (j == cur) || (j == cur - 1); const float v = sc[j]; sc[j] = forced ? 1e4f : (j <= cur ? v : -1.f); }
        LDS_WAIT(); asm volatile("" ::: "memory");
#pragma unroll 1
        for (int r = 0; r < 8; ++r) {
            float bv = sc[fq * 32]; int bj = fq * 32;
            for (int j = fq * 32 + 1; j < fq * 32 + 32; ++j) { const float v = sc[j]; if (v > bv) { bv = v; bj = j; } }
#pragma unroll
            for (int o = 16; o <= 32; o <<= 1) { const float ov = bperm_f(bv, lane ^ o); const int oj = bperm_i(bj, lane ^ o); if (ov > bv || (ov == bv && oj < bj)) { bv = ov; bj = oj; } }
            if ((bj >> 5) == fq) sc[bj] = -3e38f;
            if (fq == 0) SEL[col * 8 + r] = bj;
            LDS_WAIT(); asm volatile("" ::: "memory");
        }
    }
#pragma unroll
    for (int hh = 0; hh < 4; ++hh) { const float g0 = gate[hh * 3 + 0] * linv[hh];
#pragma unroll
        for (int mt = 0; mt < 4; ++mt) { const f32x4 o = O[hh][mt] * g0; v2u w; w.x = cvt_pk_bf16(o[0], o[1]); w.y = cvt_pk_bf16(o[2], o[3]);
            *(LAS v2u*)(OS + (col * 4 + hh) * 64 + 16 * mt + 4 * fq) = w; } }
    LDS_WAIT(); asm volatile("" ::: "memory");
    const int cur = t0 >> 6;
    {
        const bf16* kwb = WSP(bf16, WS_KW8) + (size_t)bg * 8 * SEQ * 8; const bf16* vwb = VwT + (size_t)bg * 64 * SEQ;
        const bf16* ksb = WSP(bf16, WS_KS8) + (size_t)bg * 8 * SEQ * 8; const bf16* vsb = VsT + (size_t)bg * 64 * SEQ;
        int kst = t0 - (WINDOW - 1); if (kst < 0) kst = 0; kst &= ~31;
        const int nwin = ((t0 + 15 - kst) >> 5) + 1, nfb = cur >= 2 ? 3 : cur + 1;
#pragma unroll 1
        for (int part = 0; part < 2; ++part) {
            float lw[4] = {0.f, 0.f, 0.f, 0.f};
#pragma unroll
            for (int hh = 0; hh < 4; ++hh)
#pragma unroll
                for (int mt = 0; mt < 4; ++mt) O[hh][mt] = z4;
            const bf16* kb = part ? ksb : kwb; const bf16* vb = part ? vsb : vwb;
            const int nchk = part ? 2 * nfb : nwin;
#pragma unroll 1
            for (int ci = 0; ci < nchk; ++ci) {
                asm volatile("" ::: "memory");
                int k0;
                if (part == 0) k0 = kst + 32 * ci; else { const int fb = ci >> 1, j = fb == 0 ? 0 : (fb == 1 ? cur : cur - 1); k0 = 64 * j + 32 * (ci & 1); }
                bf16x8_t ka[2][2], va[4];
#pragma unroll
                for (int tl = 0; tl < 2; ++tl)
#pragma unroll
                    for (int ks = 0; ks < 2; ++ks) ka[tl][ks] = ldg8(kb + ((size_t)(4 * ks + fq) * SEQ + k0 + 16 * tl + col) * 8);
#pragma unroll
                for (int mt = 0; mt < 4; ++mt) va[mt] = ldg8(vb + ((size_t)((k0 >> 3) + fq) * 64 + 16 * mt + col) * 8);
                const int lowk = part ? -1 : tok - WINDOW; const bool dfull = (k0 + 31 <= t0) && (part || k0 > t0 + 15 - WINDOW);
#pragma unroll
                for (int hh = 0; hh < 4; ++hh) {
                    const bf16x8_t q0_ = Qc(hh, 0), q1_ = Qc(hh, 1);
                    f32x4 sa = MFMA16(ka[0][0], q0_, z4); sa = MFMA16(ka[0][1], q1_, sa);
                    f32x4 sb = MFMA16(ka[1][0], q0_, z4); sb = MFMA16(ka[1][1], q1_, sb);
#pragma unroll
                    for (int i = 0; i < 4; ++i) { sa[i] = __builtin_amdgcn_exp2f(sa[i]); sb[i] = __builtin_amdgcn_exp2f(sb[i]); }
                    if (!dfull) {
#pragma unroll
                        for (int i = 0; i < 4; ++i) { const int kt = k0 + 4 * fq + i; sa[i] = (kt <= tok && kt > lowk) ? sa[i] : 0.f; sb[i] = (kt + 16 <= tok && kt + 16 > lowk) ? sb[i] : 0.f; } }
                    lw[hh] += (sa[0] + sa[1]) + (sa[2] + sa[3]) + (sb[0] + sb[1]) + (sb[2] + sb[3]);
                    const bf16x8_t pt = pack_p(sa, sb);
#pragma unroll
                    for (int mt = 0; mt < 4; ++mt) O[hh][mt] = MFMA16(va[mt], pt, O[hh][mt]);
                }
            }
            LDS_WAIT(); asm volatile("" ::: "memory");
            if (part == 0) {
#pragma unroll
                for (int hh = 0; hh < 4; ++hh) { float l = lw[hh]; l += bperm_f(l, lane ^ 16); l += bperm_f(l, lane ^ 32); const float w = l > 0.f ? gate[hh * 3 + 2] / l : 0.f;
#pragma unroll
                    for (int mt = 0; mt < 4; ++mt) { LAS v2u* dp = (LAS v2u*)(OS + (col * 4 + hh) * 64 + 16 * mt + 4 * fq); const v2u old = *dp;
                        v2u w2; w2.x = cvt_pk_bf16(blo(old.x) + w * O[hh][mt][0], bhi(old.x) + w * O[hh][mt][1]); w2.y = cvt_pk_bf16(blo(old.y) + w * O[hh][mt][2], bhi(old.y) + w * O[hh][mt][3]); *dp = w2; } }
            } else {
                LAS bf16* OF = (LAS bf16*)(wl + AW_QS); LAS float* LF = (LAS float*)(wl + AW_IMP + 8192);
#pragma unroll
                for (int hh = 0; hh < 4; ++hh) { float l = lw[hh]; l += bperm_f(l, lane ^ 16); l += bperm_f(l, lane ^ 32); if (fq == 0) LF[col * 4 + hh] = l;
#pragma unroll
                    for (int mt = 0; mt < 4; ++mt) { v2u w2; w2.x = cvt_pk_bf16(O[hh][mt][0], O[hh][mt][1]); w2.y = cvt_pk_bf16(O[hh][mt][2], O[hh][mt][3]); *(LAS v2u*)(OF + (col * 4 + hh) * 64 + 16 * mt + 4 * fq) = w2; } }
            }
            LDS_WAIT(); asm volatile("" ::: "memory");
        }
    }
    {
        const bf16* ksb = WSP(bf16, WS_KS8) + (size_t)bg * 8 * SEQ * 8; const bf16* vsb = VsT + (size_t)bg * 64 * SEQ;
        const LAS bf16* OF = (const LAS bf16*)(wl + AW_QS); const LAS float* LF = (const LAS float*)(wl + AW_IMP + 8192);
#pragma unroll 1
        for (int tt = 0; tt < 16; ++tt) {
            const int tq = t0 + tt; const size_t qrow = (size_t)b * SEQ + tq;
            bf16x8_t Qh[2];
#pragma unroll
            for (int ks = 0; ks < 2; ++ks) { Qh[ks] = ldg8(QB + qrow * LDQ + (g * 4 + (col & 3)) * 64 + ks * 32 + fq * 8); if (col >= 4) Qh[ks] = (bf16x8_t){0, 0, 0, 0, 0, 0, 0, 0}; }
            f32x4 Os[4] = {z4, z4, z4, z4}; float ls = 0.f;
#ifdef APROBE_SEL
            for (int rp = 0; rp < 2; ++rp) { Os[0] = z4; Os[1] = z4; Os[2] = z4; Os[3] = z4; ls = 0.f; asm volatile("" ::: "memory");
#endif
#pragma unroll 1
            for (int r8 = 0; r8 < 8; ++r8) {
                const int j = __builtin_amdgcn_readfirstlane(SEL[tt * 8 + r8]);
                if (64 * j > tq || j == 0 || j == cur || j == cur - 1) continue;
                const int kb0 = 64 * j;
                bf16x8_t ka[2][2][2], va[2][4];
#pragma unroll
                for (int hf = 0; hf < 2; ++hf) {
#pragma unroll
                    for (int tl = 0; tl < 2; ++tl)
#pragma unroll
                        for (int ks = 0; ks < 2; ++ks) ka[hf][tl][ks] = ldg8(ksb + ((size_t)(4 * ks + fq) * SEQ + kb0 + 32 * hf + 16 * tl + col) * 8);
#pragma unroll
                    for (int mt = 0; mt < 4; ++mt) va[hf][mt] = ldg8(vsb + ((size_t)(((kb0 + 32 * hf) >> 3) + fq) * 64 + 16 * mt + col) * 8);
                }
#pragma unroll
                for (int hf = 0; hf < 2; ++hf) {
                    f32x4 sa = MFMA16(ka[hf][0][0], Qh[0], z4); sa = MFMA16(ka[hf][0][1], Qh[1], sa);
                    f32x4 sb = MFMA16(ka[hf][1][0], Qh[0], z4); sb = MFMA16(ka[hf][1][1], Qh[1], sb);
#pragma unroll
                    for (int i = 0; i < 4; ++i) { sa[i] = __builtin_amdgcn_exp2f(sa[i]); sb[i] = __builtin_amdgcn_exp2f(sb[i]); }
                    ls += (sa[0] + sa[1]) + (sa[2] + sa[3]) + (sb[0] + sb[1]) + (sb[2] + sb[3]);
                    const bf16x8_t pt = pack_p(sa, sb);
#pragma unroll
                    for (int mt = 0; mt < 4; ++mt) Os[mt] = MFMA16(va[hf][mt], pt, Os[mt]);
                }
            }
#ifdef APROBE_SEL
            }
#endif
            ls += bperm_f(ls, lane ^ 16); ls += bperm_f(ls, lane ^ 32);
            if (col < 4) {
                const float den = ls + LF[tt * 4 + col]; const float w = den > 0.f ? (NG + qrow * 24 + g * 12)[col * 3 + 1] / den : 0.f;
#pragma unroll
                for (int mt = 0; mt < 4; ++mt) { const int e = (tt * 4 + col) * 64 + 16 * mt + 4 * fq; const v2u old = *(const LAS v2u*)(OS + e), fo = *(const LAS v2u*)(OF + e);
                    v2u w2; w2.x = cvt_pk_bf16(blo(old.x) + w * (Os[mt][0] + blo(fo.x)), bhi(old.x) + w * (Os[mt][1] + bhi(fo.x))); w2.y = cvt_pk_bf16(blo(old.y) + w * (Os[mt][2] + blo(fo.y)), bhi(old.y) + w * (Os[mt][3] + bhi(fo.y)));
                    *(v2u*)(QB + qrow * LDQ + (g * 4 + col) * 64 + 16 * mt + 4 * fq) = w2; }
            }
        }
    }
    LDS_WAIT(); asm volatile("" ::: "memory");
#undef Qc
}

typedef _Float16 h16x2 __attribute__((ext_vector_type(2)));
__device__ __forceinline__ h16x2 as_h2(unsigned u) { h16x2 r; __builtin_memcpy(&r, &u, 4); return r; }
constexpr int SC_STEPS = 8, SC_BUF = 6 * 1024;
__device__ __forceinline__ float dpp_sum16(float v) {
    v += __builtin_bit_cast(float, __builtin_amdgcn_update_dpp(0, __builtin_bit_cast(int, v), 0xB1, 0xF, 0xF, true));
    v += __builtin_bit_cast(float, __builtin_amdgcn_update_dpp(0, __builtin_bit_cast(int, v), 0x4E, 0xF, 0xF, true));
    v += __builtin_bit_cast(float, __builtin_amdgcn_update_dpp(0, __builtin_bit_cast(int, v), 0x141, 0xF, 0xF, true));
    v += __builtin_bit_cast(float, __builtin_amdgcn_update_dpp(0, __builtin_bit_cast(int, v), 0x140, 0xF, 0xF, true));
    return v;
}
__device__ __forceinline__ void scan_fill(const bf16* RW, const bf16* Wm, const bf16* Am, size_t trow, int h, int lane, LAS unsigned char* buf) {
    const size_t t = trow + (lane >> 3); const int sub = (lane & 7) * 8;
    const bf16* row = RW + t * LDRW + h * 64 + sub;
    __builtin_amdgcn_global_load_lds((const unsigned*)(row + LBLK), (LAS unsigned*)(buf + 0 * 1024), 16, 0, 0);
    __builtin_amdgcn_global_load_lds((const unsigned*)(Am + t * RC + h * 64 + sub), (LAS unsigned*)(buf + 1 * 1024), 16, 0, 0);
    __builtin_amdgcn_global_load_lds((const unsigned*)(Wm + t * RC + h * 64 + sub), (LAS unsigned*)(buf + 2 * 1024), 16, 0, 0);
    __builtin_amdgcn_global_load_lds((const unsigned*)(row + 512), (LAS unsigned*)(buf + 3 * 1024), 16, 0, 0);
    __builtin_amdgcn_global_load_lds((const unsigned*)(row), (LAS unsigned*)(buf + 4 * 1024), 16, 0, 0);
    __builtin_amdgcn_global_load_lds((const unsigned*)(row + 1024), (LAS unsigned*)(buf + 5 * 1024), 16, 0, 0);
}
__device__ __forceinline__ void scan_unit(const P& p, int unit, int lane, LAS unsigned char* wl) {
    const bf16* RW = WSP(bf16, AR_RW); const bf16* Wm = WSP(bf16, AR_W); const bf16* Am = WSP(bf16, AR_A); bf16* Y = WSP(bf16, AR_UB);
    const int rg = unit & 15, h = (unit >> 4) & 7, b = unit >> 7, row = rg * 4 + (lane >> 4), kq = lane & 15;
    const size_t tb = (size_t)b * SEQ;
    float s0 = 0.f, s1 = 0.f, s2 = 0.f, s3 = 0.f;
    __builtin_amdgcn_s_setprio(3);
    scan_fill(RW, Wm, Am, tb, h, lane, wl);
#pragma unroll 1
    for (int c = 0; c < SEQ / SC_STEPS; ++c) {
        LAS unsigned char* buf = wl + (c & 1) * SC_BUF;
        asm volatile("s_waitcnt vmcnt(0) lgkmcnt(0)" ::: "memory");
        if (c + 1 < SEQ / SC_STEPS) scan_fill(RW, Wm, Am, tb + (size_t)(c + 1) * SC_STEPS, h, lane, wl + ((c + 1) & 1) * SC_BUF);
#ifndef SCAN_VARB
        float ys[SC_STEPS];
#pragma unroll
        for (int st = 0; st < SC_STEPS; ++st) {
            const LAS unsigned char* o = buf + st * 128 + kq * 8;
            const v2u kkw = *(const LAS v2u*)(o), bbw = *(const LAS v2u*)(o + 1024), eew = *(const LAS v2u*)(o + 2048), ktw = *(const LAS v2u*)(o + 3072), rrw = *(const LAS v2u*)(o + 4096);
#ifdef SCAN_BF16
            struct F2 { float x, y; }; const F2 kk0{blo(kkw.x), bhi(kkw.x)}, kk1{blo(kkw.y), bhi(kkw.y)}, bb0{blo(bbw.x), bhi(bbw.x)}, bb1{blo(bbw.y), bhi(bbw.y)}, ee0{blo(eew.x), bhi(eew.x)}, ee1{blo(eew.y), bhi(eew.y)}, kt0{blo(ktw.x), bhi(ktw.x)}, kt1{blo(ktw.y), bhi(ktw.y)}, rr0{blo(rrw.x), bhi(rrw.x)}, rr1{blo(rrw.y), bhi(rrw.y)};
            const float vv = bf2f(*(const LAS unsigned short*)(buf + 5 * 1024 + st * 128 + row * 2));
#else
            const h16x2 kk0 = as_h2(kkw.x), kk1 = as_h2(kkw.y), bb0 = as_h2(bbw.x), bb1 = as_h2(bbw.y);
            const h16x2 ee0 = as_h2(eew.x), ee1 = as_h2(eew.y);
#ifdef RKV_BF16
            struct F2 { float x, y; }; const F2 kt0{blo(ktw.x), bhi(ktw.x)}, kt1{blo(ktw.y), bhi(ktw.y)}, rr0{blo(rrw.x), bhi(rrw.x)}, rr1{blo(rrw.y), bhi(rrw.y)};
            const float vv = bf2f(*(const LAS unsigned short*)(buf + 5 * 1024 + st * 128 + row * 2));
#else
            const h16x2 kt0 = as_h2(ktw.x), kt1 = as_h2(ktw.y);
            const h16x2 rr0 = as_h2(rrw.x), rr1 = as_h2(rrw.y);
            const float vv = (float)__builtin_bit_cast(_Float16, *(const LAS unsigned short*)(buf + 5 * 1024 + st * 128 + row * 2));
#endif
#endif
            float d0 = __builtin_fmaf(s0, (float)kk0.x, 0.f); d0 = __builtin_fmaf(s1, (float)kk0.y, d0); float d1 = __builtin_fmaf(s2, (float)kk1.x, 0.f); d1 = __builtin_fmaf(s3, (float)kk1.y, d1);
            const float nskk = -dpp_sum16(d0 + d1);
            s0 = __builtin_fmaf(s0, -(float)ee0.x, s0); s1 = __builtin_fmaf(s1, -(float)ee0.y, s1); s2 = __builtin_fmaf(s2, -(float)ee1.x, s2); s3 = __builtin_fmaf(s3, -(float)ee1.y, s3);
            s0 = __builtin_fmaf(nskk, (float)bb0.x, s0); s1 = __builtin_fmaf(nskk, (float)bb0.y, s1); s2 = __builtin_fmaf(nskk, (float)bb1.x, s2); s3 = __builtin_fmaf(nskk, (float)bb1.y, s3);
            s0 = __builtin_fmaf(vv, (float)kt0.x, s0); s1 = __builtin_fmaf(vv, (float)kt0.y, s1); s2 = __builtin_fmaf(vv, (float)kt1.x, s2); s3 = __builtin_fmaf(vv, (float)kt1.y, s3);
            float y0 = __builtin_fmaf(s0, (float)rr0.x, 0.f); y0 = __builtin_fmaf(s1, (float)rr0.y, y0); float y1 = __builtin_fmaf(s2, (float)rr1.x, 0.f); y1 = __builtin_fmaf(s3, (float)rr1.y, y1);
            ys[st] = dpp_sum16(y0 + y1);
        }
        if (kq < SC_STEPS) { float yv = ys[0];
#pragma unroll
            for (int st = 1; st < SC_STEPS; ++st) yv = (kq == st) ? ys[st] : yv;
            Y[(tb + (size_t)c * SC_STEPS + kq) * RC + h * 64 + row] = f2bf(yv); }
    }
#else
#pragma unroll
        for (int st = 0; st < SC_STEPS; ++st) {
            const LAS unsigned char* o = buf + st * 128 + kq * 8;
            float kk[4], bb[4], ee[4], kt[4], rr[4];
            { const v2u w = *(const LAS v2u*)(o); const h16x2 a = as_h2(w.x), b2 = as_h2(w.y); kk[0] = (float)a.x; kk[1] = (float)a.y; kk[2] = (float)b2.x; kk[3] = (float)b2.y; }
            { const v2u w = *(const LAS v2u*)(o + 1024); const h16x2 a = as_h2(w.x), b2 = as_h2(w.y); bb[0] = (float)a.x; bb[1] = (float)a.y; bb[2] = (float)b2.x; bb[3] = (float)b2.y; }
            { const v2u w = *(const LAS v2u*)(o + 2048); const h16x2 a = as_h2(w.x), b2 = as_h2(w.y); ee[0] = (float)a.x; ee[1] = (float)a.y; ee[2] = (float)b2.x; ee[3] = (float)b2.y; }
            { const v2u w = *(const LAS v2u*)(o + 3072); const h16x2 a = as_h2(w.x), b2 = as_h2(w.y); kt[0] = (float)a.x; kt[1] = (float)a.y; kt[2] = (float)b2.x; kt[3] = (float)b2.y; }
            { const v2u w = *(const LAS v2u*)(o + 4096); const h16x2 a = as_h2(w.x), b2 = as_h2(w.y); rr[0] = (float)a.x; rr[1] = (float)a.y; rr[2] = (float)b2.x; rr[3] = (float)b2.y; }
            const float vv = (float)__builtin_bit_cast(_Float16, *(const LAS unsigned short*)(buf + 5 * 1024 + st * 128 + row * 2));
            const float skk = dpp_sum16((s0 * kk[0] + s1 * kk[1]) + (s2 * kk[2] + s3 * kk[3]));
            s0 = s0 - s0 * ee[0] - skk * bb[0] + vv * kt[0]; s1 = s1 - s1 * ee[1] - skk * bb[1] + vv * kt[1]; s2 = s2 - s2 * ee[2] - skk * bb[2] + vv * kt[2]; s3 = s3 - s3 * ee[3] - skk * bb[3] + vv * kt[3];
            const float y = dpp_sum16((s0 * rr[0] + s1 * rr[1]) + (s2 * rr[2] + s3 * rr[3]));
            if (kq == 0) Y[(tb + (size_t)c * SC_STEPS + st) * RC + h * 64 + row] = f2bf(y);
        }
    }
#endif
    asm volatile("s_waitcnt vmcnt(0) lgkmcnt(0)" ::: "memory");
    __builtin_amdgcn_s_setprio(0);
}
__device__ __forceinline__ float sum8(float v) {
    v += __builtin_bit_cast(float, __builtin_amdgcn_update_dpp(0, __builtin_bit_cast(int, v), 0xB1, 0xF, 0xF, true));
    v += __builtin_bit_cast(float, __builtin_amdgcn_update_dpp(0, __builtin_bit_cast(int, v), 0x4E, 0xF, 0xF, true));
    v += __builtin_bit_cast(float, __builtin_amdgcn_update_dpp(0, __builtin_bit_cast(int, v), 0x141, 0xF, 0xF, true));
    return v;
}
__device__ __forceinline__ void up8(v4u w, float* f) { f[0] = blo(w.x); f[1] = bhi(w.x); f[2] = blo(w.y); f[3] = bhi(w.y); f[4] = blo(w.z); f[5] = bhi(w.z); f[6] = blo(w.w); f[7] = bhi(w.w); }
#ifdef SCAN_BF16
#define uph8 up8
#define pkh8 pk8
#else
#define uph8 uph8_
#define pkh8 pkh8_
#endif
__device__ __forceinline__ void uph8_(v4u w, float* f) { const h16x2 a = as_h2(w.x), b = as_h2(w.y), c = as_h2(w.z), d = as_h2(w.w);
    f[0] = (float)a.x; f[1] = (float)a.y; f[2] = (float)b.x; f[3] = (float)b.y; f[4] = (float)c.x; f[5] = (float)c.y; f[6] = (float)d.x; f[7] = (float)d.y; }
__device__ __forceinline__ unsigned pkh2(float lo, float hi) { h16x2 v; v.x = (_Float16)lo; v.y = (_Float16)hi; return __builtin_bit_cast(unsigned, v); }
__device__ __forceinline__ v4u pkh8_(const float* f) { v4u w; w.x = pkh2(f[0], f[1]); w.y = pkh2(f[2], f[3]); w.z = pkh2(f[4], f[5]); w.w = pkh2(f[6], f[7]); return w; }
__device__ __forceinline__ v4u pk8(const float* f) { v4u w; w.x = cvt_pk_bf16(f[0], f[1]); w.y = cvt_pk_bf16(f[2], f[3]); w.z = cvt_pk_bf16(f[4], f[5]); w.w = cvt_pk_bf16(f[6], f[7]); return w; }
__device__ __forceinline__ void ldf8(const float* p, float* f) { const f32x4 a = *(const f32x4*)p, b = *(const f32x4*)(p + 4); f[0] = a[0]; f[1] = a[1]; f[2] = a[2]; f[3] = a[3]; f[4] = b[0]; f[5] = b[1]; f[6] = b[2]; f[7] = b[3]; }

struct EpiLora {
    static constexpr bool PERM = true, AFTER_DRAIN = false;
    unsigned char* ws;
    __device__ __forceinline__ void operator()(const f32x4 (&acc)[2][2][4][2], const Unit& u, int wr, int wc, int fr, int fq) const {
        const int which = u.pn >> 1, row0 = u.pm * BM + wr * 64 + fr, c0 = (u.pn & 1) * 256 + wc * 32 + 8 * fq;
        bf16* const O = (bf16*)(ws + (which == 0 ? AR_W : (which == 1 ? AR_A : (which == 2 ? AR_G : AR_UB))));
#pragma unroll
        for (int ai = 0; ai < 2; ++ai)
#pragma unroll
            for (int m = 0; m < 4; ++m)
#pragma unroll
                for (int bj = 0; bj < 2; ++bj) *(u32x4*)(O + (size_t)(row0 + ai * HALF + m * 16) * RC + c0 + bj * HALF) = pack8(acc[ai][bj][m][0], acc[ai][bj][m][1]);
    }
};
#ifdef RKV_BF16
#define UPR up8
#define PKR pk8
#else
#define UPR uph8
#define PKR pkh8
#endif
struct B2In { v4u k, a, w, vr, vv, vf; float gt; };
__device__ __forceinline__ void b2w_load(B2In& in, const P& p, int layer, int t, int lane) {
    const bf16* row = WSP(bf16, AR_RW) + (size_t)t * LDRW;
    in.k = *(const v4u*)(row + 512 + 8 * lane); in.a = *(const v4u*)(WSP(bf16, AR_A) + (size_t)t * RC + 8 * lane); in.w = *(const v4u*)(WSP(bf16, AR_W) + (size_t)t * RC + 8 * lane);
    in.gt = lane < 24 ? bf2f(row[LBLK + 320 + lane]) : 0.f;
    if (layer == 1) { in.vr = *(const v4u*)(WSP(bf16, AR_UB) + (size_t)t * RC + 8 * lane); in.vv = *(const v4u*)(row + 1024 + 8 * lane); in.vf = *(const v4u*)(WSP(bf16, WS_VF) + (size_t)t * RC + 8 * lane); }
}
__device__ __forceinline__ void b2w_compute(const B2In& in, const P& p, int layer, int t, int lane, const float* v0, const float* v1, const float* v2, const float* v3, const float* vb) {
    bf16* row = WSP(bf16, AR_RW) + (size_t)t * LDRW; bf16* Am = WSP(bf16, AR_A); bf16* Wm = WSP(bf16, AR_W); float* NG = WSP(float, AR_NG);
    float k[8], a[8], w[8]; uph8(in.k, k); up8(in.a, a); up8(in.w, w);
    const float ngv = fsig(in.gt);
    float kk[8], ss = 0.f;
#pragma unroll
    for (int i = 0; i < 8; ++i) {
        a[i] = fsig(a[i] + v1[i]);
        const float nx = -(w[i] + v0[i]), sp = fmaxf(nx, 0.f) + __logf(1.f + __expf(-fabsf(nx))), e = __expf(-sp - 0.5f); w[i] = 1.f - __expf(-e);
        kk[i] = k[i] * v2[i]; ss += kk[i] * kk[i]; }
    ss = sum8(ss); const float nrm = sqrtf(ss), inv = 1.f / (nrm > 1e-12f ? nrm : 1e-12f);
#pragma unroll
    for (int i = 0; i < 8; ++i) { kk[i] *= inv; k[i] = k[i] * (1.f + (a[i] - 1.f) * v3[i]); a[i] *= kk[i]; }
    asm volatile("" :: "v"(ngv));
    if (layer == 1) { float vr[8], vv[8], vf[8]; up8(in.vr, vr); uph8(in.vv, vv); uph8(in.vf, vf);
#pragma unroll
        for (int i = 0; i < 8; ++i) vv[i] = vv[i] + (vf[i] - vv[i]) * fsig(vr[i] + vb[i]);
        *(v4u*)(row + 1024 + 8 * lane) = pkh8(vv); }
    if (lane < 24) NG[(size_t)t * 24 + lane] = ngv;
    *(v4u*)(row + LBLK + 8 * lane) = pkh8(kk); *(v4u*)(row + 512 + 8 * lane) = pkh8(k);
    *(v4u*)(Am + (size_t)t * RC + 8 * lane) = pkh8(a); *(v4u*)(Wm + (size_t)t * RC + 8 * lane) = pkh8(w);
}
__device__ __forceinline__ void ph_rwkv_b2w(const P& p, int layer, int gw, int NGW, int lane) {
    const float* vec = p.rwkv_vec + (size_t)layer * 7 * RC; float v0[8], v1[8], v2[8], v3[8], vb[8];
    ldf8(vec + 8 * lane, v0); ldf8(vec + RC + 8 * lane, v1); ldf8(vec + 2 * RC + 8 * lane, v2); ldf8(vec + 3 * RC + 8 * lane, v3); ldf8(p.vres_b + 8 * lane, vb);
    int t = gw; if (t >= T) return;
    B2In A, B; b2w_load(A, p, layer, t, lane);
    for (; t < T; t += 2 * NGW) { const int t1 = t + NGW, t2 = t1 + NGW;
        b2w_load(B, p, layer, t1 < T ? t1 : t, lane); b2w_compute(A, p, layer, t, lane, v0, v1, v2, v3, vb);
        if (t1 < T) { b2w_load(A, p, layer, t2 < T ? t2 : t1, lane); b2w_compute(B, p, layer, t1, lane, v0, v1, v2, v3, vb); } }
}
struct PoIn { v4u y, r, k, v, g; };
__device__ __forceinline__ void post_load(PoIn& in, const P& p, int t, int lane) { const bf16* row = WSP(bf16, AR_RW) + (size_t)t * LDRW;
    in.y = *(const v4u*)(WSP(bf16, AR_UB) + (size_t)t * RC + 8 * lane); in.r = *(const v4u*)(row + 8 * lane); in.k = *(const v4u*)(row + 512 + 8 * lane); in.v = *(const v4u*)(row + 1024 + 8 * lane); in.g = *(const v4u*)(WSP(bf16, AR_G) + (size_t)t * RC + 8 * lane); }
__device__ __forceinline__ void post_compute(const PoIn& in, const P& p, int t, int lane, const float* v4_, const float* v5, const float* v6) {
    float y[8], r[8], k[8], v[8], g[8]; up8(in.y, y); uph8(in.r, r); uph8(in.k, k); uph8(in.v, v); up8(in.g, g);
    float s = 0.f, bon = 0.f;
#pragma unroll
    for (int i = 0; i < 8; ++i) { s += y[i]; bon += r[i] * k[i] * v4_[i]; }
    const float m = sum8(s) * (1.f / 64.f); bon = sum8(bon);
    float q = 0.f;
#pragma unroll
    for (int i = 0; i < 8; ++i) { y[i] -= m; q += y[i] * y[i]; }
    const float rstd = 1.f / sqrtf(sum8(q) * (1.f / 64.f) + GN_EPS);
#pragma unroll
    for (int i = 0; i < 8; ++i) y[i] = (y[i] * rstd * v5[i] + v6[i] + bon * v[i]) * g[i];
    *(v4u*)(WSP(bf16, AR_A) + (size_t)t * RC + 8 * lane) = pk8(y);
}
__device__ __forceinline__ void ph_rwkv_postw(const P& p, int layer, int gw, int NGW, int lane) {
    const float* vec = p.rwkv_vec + (size_t)layer * 7 * RC; float v4_[8], v5[8], v6[8]; ldf8(vec + 4 * RC + 8 * lane, v4_); ldf8(vec + 5 * RC + 8 * lane, v5); ldf8(vec + 6 * RC + 8 * lane, v6);
    int t = gw; if (t >= T) return;
    PoIn A, B; post_load(A, p, t, lane);
    for (; t < T; t += 2 * NGW) { const int t1 = t + NGW, t2 = t1 + NGW;
        post_load(B, p, t1 < T ? t1 : t, lane); post_compute(A, p, t, lane, v4_, v5, v6);
        if (t1 < T) { post_load(A, p, t2 < T ? t2 : t1, lane); post_compute(B, p, t1, lane, v4_, v5, v6); } }
}
__device__ __forceinline__ void ph_convw(const P& p, int layer, int gw, int NGW, int lane, int tid, LAS unsigned char* lds) {
    const bf16* UB = WSP(bf16, AR_UB); bf16* CO = WSP(bf16, AR_CO);
    const float* cw = p.conv_w + (size_t)layer * CONV_K * CONV_CH; const float* cv = p.conv_vec + (size_t)layer * 3 * CONV_CH;
    LAS float* wl = (LAS float*)lds;
    for (int i = tid; i < CONV_K * CONV_CH; i += NTHREADS) wl[i] = cw[i];
    __syncthreads();
    float b0[8], g1[8], b2[8]; ldf8(cv + 8 * lane, b0); ldf8(cv + CONV_CH + 8 * lane, g1); ldf8(cv + 2 * CONV_CH + 8 * lane, b2);
    for (int tb = gw * 4; tb < T; tb += NGW * 4) {
        const int pos0 = tb % SEQ, j0 = pos0 >= 30 ? 0 : 30 - pos0;
        float a[4][8], wt[4][8];
#pragma unroll
        for (int q = 0; q < 4; ++q)
#pragma unroll
            for (int i = 0; i < 8; ++i) a[q][i] = b0[i];
#pragma unroll 1
        for (int j4 = 0; j4 < CONV_K + 3; j4 += 4) {
#pragma unroll
            for (int jj = 0; jj < 4; ++jj) { const int j = j4 + jj;
                if (j < CONV_K) { const f32x4 w0 = *(const LAS f32x4*)(wl + j * CONV_CH + 8 * lane), w1 = *(const LAS f32x4*)(wl + j * CONV_CH + 8 * lane + 4);
#pragma unroll
                    for (int i = 0; i < 4; ++i) { wt[jj][i] = w0[i]; wt[jj][4 + i] = w1[i]; } }
                float u[8];
                if (j >= j0 && j < CONV_K + 3) up8(*(const v4u*)(UB + (size_t)(tb - 30 + j) * CONV_CH + 8 * lane), u); else {
#pragma unroll
                    for (int i = 0; i < 8; ++i) u[i] = 0.f; }
#pragma unroll
                for (int q = 0; q < 4; ++q) { const int tap = j - q; if (tap >= 0 && tap < CONV_K) {
#pragma unroll
                    for (int i = 0; i < 8; ++i) a[q][i] += u[i] * wt[(jj - q) & 3][i]; } }
            }
        }
#pragma unroll
        for (int q = 0; q < 4; ++q) {
            float s = 0.f;
#pragma unroll
            for (int i = 0; i < 8; ++i) s += a[q][i];
            const float mean = wave_sum(s, lane) * (1.f / CONV_CH); float qq = 0.f;
#pragma unroll
            for (int i = 0; i < 8; ++i) { a[q][i] -= mean; qq += a[q][i] * a[q][i]; }
            const float rstd = 1.f / sqrtf(wave_sum(qq, lane) * (1.f / CONV_CH) + LN_EPS);
#pragma unroll
            for (int i = 0; i < 8; ++i) { const float y = a[q][i] * rstd * g1[i] + b2[i]; a[q][i] = y * fsig(y); }
            *(v4u*)(CO + (size_t)(tb + q) * CONV_CH + 8 * lane) = pk8(a[q]);
        }
    }
    __syncthreads();
}
__device__ __forceinline__ void ph_cmp2w(const P& p, int layer, int gw, int NGW, int lane, LAS float* hl  ) {
    const bf16* Z = WSP(bf16, AR_HID); const float* pec = (const float*)(p.ws + WS_W + (size_t)layer * SZ_LAYERW + OFF_PEC);
    for (int it = gw; it < 2 * BATCH * NKV * NC; it += NGW) {
        const int i = it % NC, r = it / NC, bg = r % (BATCH * NKV), which = r / (BATCH * NKV);
        const bf16* z1 = Z + ((size_t)which * (BATCH * NKV * 512) + (size_t)bg * 512 + i) * 256; const bf16* z2 = z1 + 256 + 128;
#pragma unroll
        for (int jj = 0; jj < 2; ++jj) { const int j = lane + 64 * jj; const float x = bf2f(z1[j]) + bf2f(z2[j]) + pec[which * 128 + j];
            const float e = __expf(fminf(2.f * 0.7978845608028654f * (x + 0.044715f * x * x * x), 30.f)); hl[j] = 0.5f * x * (1.f + (e - 1.f) / (e + 1.f)); }
        LDS_WAIT(); asm volatile("" ::: "memory");
        const float* w2 = p.cmp_w2 + (size_t)(layer * 2 + which) * 128 * 64 + lane; float o = 0.f;
#pragma unroll 8
        for (int j = 0; j < 128; ++j) o += hl[j] * w2[j * 64];
        if (which == 0) {
            const float rs = 1.f / sqrtf(wave_sum(o * o, lane) * (1.f / 64.f) + RMS_EPS); o = o * rs * p.qk_g[(layer * 4 + 1) * 64 + lane];
            const float other = bperm_f(o, lane ^ 32); float cs, sn; rope_cs(16 * i + 31, lane & 31, cs, sn);
            o = lane < 32 ? o * cs - other * sn : o * cs + other * sn;
            WSP(bf16, AR_KC)[(((size_t)bg * 8 + (lane >> 3)) * 512 + i) * 8 + (lane & 7)] = f2bf(o);
        } else { bf16* vt = WSP(bf16, AR_VCT) + (size_t)bg * 64 * 512 + lane * 8;
            vt[(size_t)((i >> 5) * 4 + ((i & 15) >> 2)) * 512 + (i & 3) + 4 * ((i >> 4) & 1)] = f2bf(o); if (i == 0) vt[(size_t)((NC >> 5) * 4 + ((NC & 15) >> 2)) * 512 + (NC & 3) + 4 * ((NC >> 4) & 1)] = 0; }
        LDS_WAIT(); asm volatile("" ::: "memory");
    }
}

struct MapPlain { bf16* base; int K; __device__ __forceinline__ bf16* operator()(int col) const { return base + (size_t)col * K; } };
struct MapGlu { bf16* base; int K, ff; __device__ __forceinline__ bf16* operator()(int col) const { return base + (size_t)glu_dest(col, ff) * K; } };
struct MapWin { unsigned char* wl; int layer; __device__ __forceinline__ bf16* operator()(int col) const { int which; const int r = win_dest(col, layer, which); const size_t off = (which ? OFF_WG : OFF_WIN) + (size_t)(r < 0 ? 0 : r) * DM * 2; return r < 0 ? nullptr : (bf16*)(wl + off); } };
template <class Map>
__device__ __forceinline__ void transpose_item(const float* W, int K, int N, const Map& mp, LAS float* scr, int item, int lane) {
    const int nblk = (N + 31) / 32, kb = item / nblk, nb = item % nblk, k0 = 64 * kb, n0 = 32 * nb;
    const int c4 = 4 * (lane & 7), col = n0 + c4;
    f32x4 v[8];
#pragma unroll
    for (int i = 0; i < 8; ++i) v[i] = col < N ? *(const f32x4*)(W + (size_t)(k0 + (lane >> 3) + 8 * i) * N + col) : (f32x4){0.f, 0.f, 0.f, 0.f};
#pragma unroll
    for (int i = 0; i < 8; ++i) { LAS float* d = scr + ((lane >> 3) + 8 * i) * 33 + c4; d[0] = v[i].x; d[1] = v[i].y; d[2] = v[i].z; d[3] = v[i].w; }
    LDS_WAIT(); asm volatile("" ::: "memory");
    const int c = lane & 7;
#pragma unroll
    for (int j = 0; j < 4; ++j) { const int n = (lane >> 3) + 8 * j; const LAS float* s = scr + (8 * c) * 33 + n;
        v4u o; o.x = (unsigned)f2bf(s[0]) | ((unsigned)f2bf(s[33]) << 16); o.y = (unsigned)f2bf(s[66]) | ((unsigned)f2bf(s[99]) << 16);
        o.z = (unsigned)f2bf(s[132]) | ((unsigned)f2bf(s[165]) << 16); o.w = (unsigned)f2bf(s[198]) | ((unsigned)f2bf(s[231]) << 16);
        if (n0 + n < N) { bf16* d = mp(n0 + n); if (d) *(v4u*)(d + k0 + 8 * c) = o; } }
    LDS_WAIT(); asm volatile("" ::: "memory");
}
template <class Map>
__device__ __forceinline__ bool conv_job(int& r, const float* W, int K, int N, const Map& mp, LAS float* scr, int lane) {
    const int items = (K / 64) * ((N + 31) / 32);
    if (r < items) { transpose_item(W, K, N, mp, scr, r, lane); return true; }
    r -= items; return false;
}

struct RmsIn { f32x4 v[DM / 256]; };
__device__ __forceinline__ void rms_load(RmsIn& r, const float* xrow, int lane) { const f32x4* xr = (const f32x4*)xrow + lane;
#pragma unroll
    for (int j = 0; j < DM / 256; ++j) r.v[j] = xr[64 * j]; }
__device__ __forceinline__ void rms_row(const P& p, const RmsIn& rin, const float* g, bf16* orow, int lane, bool route, int t, unsigned long long& c0, unsigned long long& c1) {
    const f32x4* gr = (const f32x4*)g + lane;
    f32x4 v[DM / 256]; float ss = 0.f;
#pragma unroll
    for (int j = 0; j < DM / 256; ++j) { v[j] = rin.v[j]; ss += (v[j].x * v[j].x + v[j].y * v[j].y) + (v[j].z * v[j].z + v[j].w * v[j].w); }
    const float rs = 1.f / sqrtf(wave_sum(ss, lane) * (1.f / DM) + RMS_EPS);
    v2u* o8 = (v2u*)orow + lane;
#pragma unroll
    for (int j = 0; j < DM / 256; ++j) { const f32x4 gg = gr[64 * j]; v[j].x *= rs * gg.x; v[j].y *= rs * gg.y; v[j].z *= rs * gg.z; v[j].w *= rs * gg.w;
        v2u w; w.x = cvt_pk_bf16(v[j].x, v[j].y); w.y = cvt_pk_bf16(v[j].z, v[j].w); o8[64 * j] = w; }
    if (route) {
        float lg[NEXP];
#pragma unroll
        for (int e = 0; e < NEXP; ++e) lg[e] = 0.f;
#pragma unroll
        for (int j = 0; j < DM / 256; ++j) { const float* rw = p.router_w + (size_t)(4 * (lane + 64 * j)) * NEXP;
#pragma unroll
            for (int e = 0; e < NEXP; ++e) lg[e] += v[j].x * rw[e] + v[j].y * rw[NEXP + e] + v[j].z * rw[2 * NEXP + e] + v[j].w * rw[3 * NEXP + e]; }
#pragma unroll
        for (int e = 0; e < NEXP; ++e) lg[e] = wave_sum(lg[e], lane) + p.router_b[e];
        int e0 = 0; float l0 = lg[0];
#pragma unroll
        for (int e = 1; e < NEXP; ++e) if (lg[e] > l0) { l0 = lg[e]; e0 = e; }
        int e1 = -1; float l1 = -3e38f;
#pragma unroll
        for (int e = 0; e < NEXP; ++e) if (e != e0 && lg[e] > l1) { l1 = lg[e]; e1 = e; }
        e0 = __builtin_amdgcn_readfirstlane(e0); e1 = __builtin_amdgcn_readfirstlane(e1);
        const int r0 = (int)((c0 >> (8 * e0)) & 255ull), r1 = (int)((c1 >> (8 * e1)) & 255ull);
        c0 += 1ull << (8 * e0); c1 += 1ull << (8 * e1);
        if (lane == 0) { const float w0 = 1.f / (1.f + expf(l1 - l0));
            WSP(int, AR_RTE)[t] = e0 | (e1 << 8) | (r0 << 16) | (r1 << 24); float* rw = WSP(float, AR_RTW) + (size_t)t * 2; rw[0] = w0; rw[1] = 1.f - w0; }
    }
}
__device__ __forceinline__ void copy_rows4(const bf16* s0, const bf16* s1, const bf16* s2, const bf16* s3, bf16* d0, bf16* d1, bf16* d2, bf16* d3, int lane) {
    v4u a[4][DM / 512];
#pragma unroll
    for (int j = 0; j < DM / 512; ++j) { a[0][j] = ((const v4u*)s0)[lane + 64 * j]; a[1][j] = ((const v4u*)s1)[lane + 64 * j]; a[2][j] = ((const v4u*)s2)[lane + 64 * j]; a[3][j] = ((const v4u*)s3)[lane + 64 * j]; }
#pragma unroll
    for (int j = 0; j < DM / 512; ++j) { ((v4u*)d0)[lane + 64 * j] = a[0][j]; ((v4u*)d1)[lane + 64 * j] = a[1][j]; ((v4u*)d2)[lane + 64 * j] = a[2][j]; ((v4u*)d3)[lane + 64 * j] = a[3][j]; }
}
__device__ __forceinline__ void copy_row_wave(const bf16* src, bf16* dst, int lane) {
#pragma unroll
    for (int j = 0; j < DM / 512; ++j) ((v4u*)dst)[lane + 64 * j] = ((const v4u*)src)[lane + 64 * j];
}
__device__ __forceinline__ int moe_seg_start(const unsigned* cnt, int e) { int s = 0;
#pragma unroll
    for (int k = 0; k < NEXP; ++k) s += (k < e) ? (int)((cnt[k] + 255u) & ~255u) : 0;
    return s; }

#ifndef PHMASK
#define PHMASK 0xFFFFFFFFu
#endif
#define PHM(k) (((PHMASK) >> (k)) & 1u)
#ifdef PROBE_LO
constexpr int PR_LO = PROBE_LO, PR_HI = PROBE_HI;
#else
constexpr int PR_LO = -1, PR_HI = -1;
#endif
constexpr int NPH = 16, NPHASES = 1 + 2 * NPH;
struct Args { const float* in[29]; float* out; unsigned char* ws; int ph_lo, ph_hi; };

__device__ __forceinline__ bool in_phase(int k, int lo, int hi) { asm volatile("" : "+s"(lo), "+s"(hi)); return lo <= k && k < hi; }
typedef const Args __attribute__((address_space(4)))* CArgsP;
__device__ __forceinline__ void fill_params_k(P& p, CArgsP a) {
    p.x = a->in[0]; p.mix_norm_g = a->in[1]; p.w_in_first = a->in[2]; p.w_in_rest = a->in[3]; p.mu_first = a->in[4]; p.mu_rest = a->in[5]; p.qk_g = a->in[6]; p.cmp_pos = a->in[7];
    p.cmp_w1 = a->in[8]; p.cmp_w2 = a->in[9]; p.nsa_w_o = a->in[10]; p.conv_w = a->in[11]; p.conv_vec = a->in[12]; p.conv_w_o = a->in[13]; p.rwkv_vec = a->in[14]; p.w_up = a->in[15];
    p.a_up = a->in[16]; p.g_up = a->in[17]; p.vres_up = a->in[18]; p.vres_b = a->in[19]; p.rwkv_w_o = a->in[20]; p.w_out = a->in[21]; p.ffn_norm_g = a->in[22]; p.dense_gu = a->in[23];
    p.dense_down = a->in[24]; p.router_w = a->in[25]; p.router_b = a->in[26]; p.moe_gu = a->in[27]; p.moe_down = a->in[28]; p.out = a->out; p.ws = a->ws;
}
__global__ void __launch_bounds__(NTHREADS, 2) mk_fwd(Args args) {
    extern __shared__ __attribute__((aligned(16))) unsigned char lds_raw[];
    LAS unsigned char* lds = (LAS unsigned char*)lds_raw;
    const int wave0 = __builtin_amdgcn_readfirstlane((int)threadIdx.x >> 6);
    const int tid = wave0 * 64 + lane_id_opaque();
    unsigned* ctl = (unsigned*)(args.ws + WS_CTL);
    for (int u = tid; u < (LDS_BYTES - LDSCTL_OFF) / 4; u += NTHREADS) ((LAS unsigned*)(lds + LDSCTL_OFF))[u] = 0u;
    __syncthreads();
    const int lo = args.ph_lo, hi = args.ph_hi;
    XcdBarrier bar; bar.bar = ctl + CW_BAR; bar.x = 0; bar.st = nullptr;
    if (hi - lo > 1) { bar.x = xb_xcc_id(); bar.st = (volatile LAS unsigned*)(lds + MISC_OFF) + 8; if (tid == 0) (void)xb_add(ctl + CW_BAR + XB_XCNT(bar.x), 1u); }
#define RMS_LOOP(X, GN, ROUTE, C0, C1) do { int m_ = gw; if (m_ < T) { RmsIn ra_, rb_; rms_load(ra_, (X) + (size_t)m_ * DM, lane); \
        for (; m_ < T; m_ += 2 * NGW) { const int m1_ = m_ + NGW, m2_ = m1_ + NGW; rms_load(rb_, (X) + (size_t)(m1_ < T ? m1_ : m_) * DM, lane); \
            rms_row(p, ra_, (GN), WSP(bf16, WS_H) + (size_t)m_ * DM, lane, (ROUTE), m_, C0, C1); \
            if (m1_ < T) { rms_load(ra_, (X) + (size_t)(m2_ < T ? m2_ : m1_) * DM, lane); rms_row(p, rb_, (GN), WSP(bf16, WS_H) + (size_t)m1_ * DM, lane, (ROUTE), m1_, C0, C1); } } } } while (0)
#define IN(k) (in_phase((k), lo, hi) && (PR_LO < 0 || (st == 0 ? (k) <= PR_HI : (st == 1 ? ((k) >= PR_LO && (k) <= PR_HI) : (k) > PR_HI))))
#define MKP unsigned long long cdum0 = 0ull, cdum1 = 0ull; (void)cdum0; (void)cdum1; CArgsP ap_ = (CArgsP)__builtin_amdgcn_kernarg_segment_ptr(); asm volatile("" : "+s"(ap_)); P p; fill_params_k(p, ap_); int w0_ = wave0; asm volatile("" : "+s"(w0_)); int tid = w0_ * 64 + lane_id_opaque(); asm volatile("" : "+v"(tid)); const int lane = tid & 63, wave = __builtin_amdgcn_readfirstlane(tid >> 6); int G = gridDim.x, bid = blockIdx.x; asm volatile("" : "+s"(G), "+s"(bid)); unsigned* ctl = WSP(unsigned, WS_CTL); const long gtid = (long)bid * NTHREADS + tid, NT = (long)G * NTHREADS; const int gw = bid * NWAVES + wave, NGW = G * NWAVES; LAS float* scrw = (LAS float*)(lds + wave * 16384); (void)gtid; (void)NT; (void)gw; (void)NGW; (void)scrw; (void)lane; (void)ctl
#define SEAM(k) do { if ((k) + 1 < hi) { int w_ = wave0; asm volatile("" : "+s"(w_)); xcd_barrier(bar, w_ * 64 + lane_id_opaque()); } } while (0)

    for (int st = 0; st < (PR_LO >= 0 ? 3 : 1); ++st) {
    if (PHM(16) && IN(0)) { MKP;
        constexpr int IT_WIN0 = (DM / 64) * ((N_IN_FIRST + 31) / 32), IT_WIN1 = (DM / 64) * ((N_IN_REST + 31) / 32), IT_WO = (512 / 64) * (DM / 32), IT_WOUT = (DM / 64) * (DM / 32);
        constexpr int total = IT_WIN0 + IT_WIN1 + 6 * IT_WO + 2 * IT_WOUT + (DM / 64) * (2 * DENSE_FF / 32) + (DENSE_FF / 64) * (DM / 32);
        bf16* wl0 = WSP(bf16, WS_W); bf16* wl1 = WSP(bf16, WS_W + SZ_LAYERW);
#define WOFF(b, o) ((bf16*)((unsigned char*)(b) + (o)))
        for (int it = gw; it < total; it += NGW) {
            int r = it;
            if (conv_job(r, p.w_in_first, DM, N_IN_FIRST, MapWin{(unsigned char*)wl0, 0}, scrw, lane)) continue;
            if (conv_job(r, p.w_in_rest, DM, N_IN_REST, MapWin{(unsigned char*)wl1, 1}, scrw, lane)) continue;
            if (conv_job(r, p.nsa_w_o, 512, DM, MapPlain{WOFF(wl0, OFF_WO3), 512}, scrw, lane)) continue;
            if (conv_job(r, p.rwkv_w_o, 512, DM, MapPlain{WOFF(wl0, OFF_WO3) + (size_t)DM * 512, 512}, scrw, lane)) continue;
            if (conv_job(r, p.conv_w_o, 512, DM, MapPlain{WOFF(wl0, OFF_WO3) + (size_t)2 * DM * 512, 512}, scrw, lane)) continue;
            if (conv_job(r, p.nsa_w_o + (size_t)512 * DM, 512, DM, MapPlain{WOFF(wl1, OFF_WO3), 512}, scrw, lane)) continue;
            if (conv_job(r, p.rwkv_w_o + (size_t)512 * DM, 512, DM, MapPlain{WOFF(wl1, OFF_WO3) + (size_t)DM * 512, 512}, scrw, lane)) continue;
            if (conv_job(r, p.conv_w_o + (size_t)512 * DM, 512, DM, MapPlain{WOFF(wl1, OFF_WO3) + (size_t)2 * DM * 512, 512}, scrw, lane)) continue;
            if (conv_job(r, p.w_out, DM, DM, MapPlain{WOFF(wl0, OFF_WOUT), DM}, scrw, lane)) continue;
            if (conv_job(r, p.w_out + (size_t)DM * DM, DM, DM, MapPlain{WOFF(wl1, OFF_WOUT), DM}, scrw, lane)) continue;
            if (conv_job(r, p.dense_gu, DM, 2 * DENSE_FF, MapGlu{WSP(bf16, WS_DGU), DM, DENSE_FF}, scrw, lane)) continue;
            conv_job(r, p.dense_down, DENSE_FF, DM, MapPlain{WSP(bf16, WS_DDN), DENSE_FF}, scrw, lane);
        }
        for (int l = 0; l < 2; ++l) {
            unsigned char* wlb = p.ws + WS_W + (size_t)l * SZ_LAYERW;
            bf16* win = (bf16*)(wlb + OFF_WIN);
            for (long i = gtid; i < 512L * DM; i += NT) { const int w = (int)(i / DM); const bool src = w < 288 || (w < 320 && l == 1) || (w >= 320 && w < 344); if (!src) win[(size_t)(3840 + w) * DM + i % DM] = 0; }
            bf16* lw = (bf16*)(wlb + OFF_LW);
            for (long i = gtid; i < 2048L * 384; i += NT) { const int n = (int)(i / 384), k = (int)(i % 384), blk = n >> 9, c = n & 511; float v = 0.f;
                if (blk == 0 && k < 64) v = p.w_up[((size_t)l * 64 + k) * RC + c]; else if (blk == 1 && k >= 64 && k < 128) v = p.a_up[((size_t)l * 64 + k - 64) * RC + c];
                else if (blk == 2 && k >= 128 && k < 288) v = p.g_up[((size_t)l * 160 + k - 128) * RC + c]; else if (blk == 3 && k >= 288 && k < 320 && l == 1) v = p.vres_up[(size_t)(k - 288) * RC + c];
                lw[i] = f2bf(v); }
            bf16* cw1 = (bf16*)(wlb + OFF_CW1);
            for (long i = gtid; i < 2L * 256 * 1024; i += NT) { const int k = (int)(i % 1024), n = (int)((i / 1024) % 256), which = (int)(i / (256 * 1024));
                cw1[i] = f2bf(p.cmp_w1[((size_t)(l * 2 + which) * 2048 + (n < 128 ? k : 1024 + k)) * 128 + (n & 127)]); }
        }
        for (int job = bid; job < 4; job += G) { const int l = job >> 1, which = job & 1;
            const float* pe = p.cmp_pos + (size_t)(l * 2 + which) * 2048; const float* w1 = p.cmp_w1 + (size_t)(l * 2 + which) * 2048 * 128 + 2 * lane;
            float s0 = 0.f, s1 = 0.f;
#pragma unroll 8
            for (int k = wave * 256; k < wave * 256 + 256; ++k) { const float2 wv = *(const float2*)(w1 + (size_t)k * 128); const float pk = pe[k]; s0 += pk * wv.x; s1 += pk * wv.y; }
            scrw[2 * lane] = s0; scrw[2 * lane + 1] = s1;
            __syncthreads();
            if (tid < 128) { float sum = 0.f;
#pragma unroll
                for (int w = 0; w < NWAVES; ++w) sum += ((const LAS float*)(lds + w * 16384))[tid];
                ((float*)(p.ws + WS_W + (size_t)l * SZ_LAYERW + OFF_PEC))[which * 128 + tid] = sum; }
            __syncthreads();
        }
    }

    for (int layer = 0; layer < 2; ++layer) {
        const int pb = 1 + layer * NPH;
        if (PHM(0) && IN(pb + 0)) { MKP;
            const float* xin = layer == 0 ? p.x : p.out;
            RMS_LOOP(xin, p.mix_norm_g + (size_t)layer * DM, false, cdum0, cdum1);
            SEAM(pb + 0);
        }
        if (PHM(1) && IN(pb + 1)) { MKP;
            Gemm g{WSP(bf16, WS_H), (const bf16*)(p.ws + WS_W + (size_t)layer * SZ_LAYERW + OFF_WIN), T, NPROJ, DM}; SOrder S; S.init(T, NPROJ, G, bid);
            EpiProj E{p.ws};
            pg8::gemm_phase<EpiProj, SOrder, true, true>(lds, g, S, E, tid);
            SEAM(pb + 1);
        }
        if (PHM(2) && IN(pb + 2)) { MKP;
            { Gemm g{WSP(bf16, AR_CKV), (const bf16*)(p.ws + WS_W + (size_t)layer * SZ_LAYERW + OFF_CW1), 2 * BATCH * NKV * 512, 512, 1024, 0}; StackOrder S{BATCH * NKV * 512 / 256, 1, 2, G, bid};
              EpiStore E{WSP(bf16, AR_HID), 256, 1};
              pg8::gemm_phase<EpiStore, StackOrder, true, true>(lds, g, S, E, tid); }
            ph_shift(p, layer, gtid, NT); ph_nsa_prep(p, layer, gtid, NT); ph_vtrans(p, gtid, NT);
            ph_convw(p, layer, gw, NGW, lane, tid, lds);
#ifdef APROBE_CONV
            ph_convw(p, layer, gw, NGW, lane, tid, lds);
#endif
#ifdef APROBE_VT
            ph_vtrans(p, gtid, NT);
#endif
            SEAM(pb + 2); }
        if (PHM(3) && IN(pb + 3)) { MKP;
#ifndef LORA_NAIVE
            { Gemm g{WSP(bf16, WS_LB), (const bf16*)(p.ws + WS_W + (size_t)layer * SZ_LAYERW + OFF_LW), T, 2048, 384, 0}; SOrder S; S.init(T, 2048, G, bid);
              EpiLora E{p.ws};
              pg8::gemm_phase<EpiLora, SOrder, false, true>(lds, g, S, E, tid); }
#else
            { bf16* RW = WSP(bf16, AR_RW); bf16* Wm = WSP(bf16, AR_W); bf16* Am = WSP(bf16, AR_A); bf16* Gm = WSP(bf16, AR_G); const bf16* VF = WSP(bf16, WS_VF);
              const float* vec = p.rwkv_vec + (size_t)layer * 7 * RC; const float* wup = p.w_up + (size_t)layer * 64 * RC; const float* aup = p.a_up + (size_t)layer * 64 * RC; const float* gup = p.g_up + (size_t)layer * 160 * RC;
              for (long it = gtid; it < (long)T * RC; it += NT) { const int t = (int)(it / RC), c = (int)(it % RC); bf16* row = RW + (size_t)t * LDRW; const bf16* L = row + LBLK;
                  float wl = vec[c], alin = vec[RC + c], g = 0.f;
                  for (int j = 0; j < 64; ++j) { wl += bf2f(L[j]) * bf2f(f2bf(wup[j * RC + c])); alin += bf2f(L[64 + j]) * bf2f(f2bf(aup[j * RC + c])); }
                  for (int j = 0; j < 160; ++j) g += bf2f(L[128 + j]) * bf2f(f2bf(gup[j * RC + c]));
                  const float nx = -wl, sp = fmaxf(nx, 0.f) + __logf(1.f + __expf(-fabsf(nx))), e = __expf(-sp - 0.5f);
                  Wm[it] = f2bf(1.f - __expf(-e)); Am[it] = f2bf(fsig(alin)); Gm[it] = f2bf(g);
                  if (layer == 1) { float vl = p.vres_b[c]; for (int j = 0; j < 32; ++j) vl += bf2f(L[288 + j]) * bf2f(f2bf(p.vres_up[j * RC + c]));
                      const float v = bf2f(row[1024 + c]), vf = bf2f(VF[it]); row[1024 + c] = f2bf(v + (vf - v) * fsig(vl)); } } }
#endif
            SEAM(pb + 3); }
        if (PHM(4) && IN(pb + 4)) { MKP; ph_rwkv_b2w(p, layer, gw, NGW, lane); ph_cmp2w(p, layer, gw, NGW, lane, (LAS float*)(lds + wave * 512)); SEAM(pb + 4); }
        if (PHM(5) && IN(pb + 5)) { MKP;
            { LAS unsigned char* wl = lds + wave * AW_BYTES; constexpr int NSC = BATCH * 8 * 16, NIT = BATCH * NKV * (SEQ / 16);
#ifndef SCAN_QUEUE
              if (wave < 4) {
                  if (G * 4 == NSC && (G & 7) == 0) scan_unit(p, (bid & 7) * (NSC / 8) + (bid >> 3) * 4 + wave, lane, wl);
                  else for (int u = bid * 4 + wave; u < NSC; u += G * 4) scan_unit(p, u, lane, wl); }
#endif
#ifdef APROBE_SPLIT
              xcd_barrier(bar, tid);
#endif
              const int xme = (int)(xb_xcc_id() & 7u);
              for (int qq = 0; qq < 8; ++qq) { const int qx = (xme + qq) & 7; unsigned* head = ctl + CW_ATT + ((layer * 3 + st) * 8 + qx) * 16;
                  for (;;) { int it = 0; if (lane == 0) it = (int)atomicAdd(head, 1u); it = __builtin_amdgcn_readfirstlane(it); if (it >= NIT / 8) break;
                      const int bg = 2 * qx + it / (SEQ / 16), t16 = (SEQ / 16 - 1) - it % (SEQ / 16);
                      nsa_attn_item(p, bg * (SEQ / 16) + t16, lane, wl); } } }
 SEAM(pb + 5); }
        if (PHM(6) && IN(pb + 6)) { MKP; ph_rwkv_postw(p, layer, gw, NGW, lane); SEAM(pb + 6); }
        if (PHM(7) && IN(pb + 7)) { MKP;
            Gemm g{WSP(bf16, AR_QB), (const bf16*)(p.ws + WS_W + (size_t)layer * SZ_LAYERW + OFF_WO3), 3 * T, 3 * DM, 512}; StackOrder S{T / 256, DM / 256, 3, G, bid};
            EpiStore E{WSP(bf16, AR_OBUF), DM, DM / 256};
            pg8::gemm_phase<EpiStore, StackOrder, true, true>(lds, g, S, E, tid);
            { MKP; const float* xin = layer == 0 ? p.x : p.out;
              RMS_LOOP(xin, p.mix_norm_g + (size_t)layer * DM, false, cdum0, cdum1); }
            SEAM(pb + 7);
        }
        if (PHM(8) && IN(pb + 8)) { MKP;
            Gemm g{WSP(bf16, WS_H), (const bf16*)(p.ws + WS_W + (size_t)layer * SZ_LAYERW + OFF_WG), T, 3 * DM, DM}; GateOrder S{T / 256, DM / 256, G, bid};
            EpiGate E{p.ws, DM / 256};
            pg8::gemm_phase<EpiGate, GateOrder, true, true>(lds, g, S, E, tid);
            SEAM(pb + 8);
        }
        if (PHM(9) && IN(pb + 9)) { MKP;
            Gemm g{WSP(bf16, AR_MIX), (const bf16*)(p.ws + WS_W + (size_t)layer * SZ_LAYERW + OFF_WOUT), T, DM, DM}; SOrder S; S.init(T, DM, G, bid);
            EpiResid E{layer == 0 ? p.x : p.out, p.out};
            pg8::gemm_phase<EpiResid, SOrder, true, true>(lds, g, S, E, tid);
            SEAM(pb + 9);
        }
        if (PHM(10) && IN(pb + 10)) { MKP;
            unsigned long long c0 = 0ull, c1 = 0ull;
            RMS_LOOP(p.out, p.ffn_norm_g + (size_t)layer * DM, layer == 1, c0, c1);
            if (layer == 1 && lane < 16) {
                const unsigned cn = (unsigned)(((lane < 8 ? c0 : c1) >> (8 * (lane & 7))) & 255ull);
                WSP(unsigned, AR_WBASE)[(size_t)gw * 16 + lane] = atomicAdd(ctl + CW_CNT + lane * 64, cn); }
            if (layer == 1) { int* rt = WSP(int, AR_RTOK); for (long i = gtid; i < 2L * MOE_ROWS; i += NT) rt[i] = -1; }
            SEAM(pb + 10);
        }
        if (layer == 0) {
            if (PHM(11) && IN(pb + 11)) { MKP;
                Gemm g{WSP(bf16, WS_H), WSP(bf16, WS_DGU), T, 2 * DENSE_FF, DM}; SOrder S; S.init(T, 2 * DENSE_FF, G, bid);
                EpiSwiglu E{WSP(bf16, AR_ACT), DENSE_FF, 2 * DENSE_FF / 256};
                pg8::gemm_phase<EpiSwiglu, SOrder, true, true>(lds, g, S, E, tid);
                SEAM(pb + 11);
            }
            if (PHM(12) && IN(pb + 12)) { MKP;
                Gemm g{WSP(bf16, AR_ACT), WSP(bf16, WS_DDN), T, DM, DENSE_FF}; SOrder S; S.init(T, DM, G, bid);
                EpiResid E{p.out, p.out};
                pg8::gemm_phase<EpiResid, SOrder, true, true>(lds, g, S, E, tid);
                SEAM(pb + 12);
            }
        } else {
            if (PHM(11) && IN(pb + 11)) { MKP;
                const int ig = (DM / 64) * (2 * EXPERT_FF / 32), id = (EXPERT_FF / 64) * (DM / 32);
                for (int it = gw; it < NEXP * (ig + id); it += NGW) { const int e = it / (ig + id); int r = it % (ig + id);
                    if (conv_job(r, p.moe_gu + (size_t)e * DM * 2 * EXPERT_FF, DM, 2 * EXPERT_FF, MapGlu{WSP(bf16, AR_MGU) + (size_t)e * 2 * EXPERT_FF * DM, DM, EXPERT_FF}, scrw, lane)) continue;
                    conv_job(r, p.moe_down + (size_t)e * EXPERT_FF * DM, EXPERT_FF, DM, MapPlain{WSP(bf16, AR_MDN) + (size_t)e * DM * EXPERT_FF, EXPERT_FF}, scrw, lane); }
                int* rtok = WSP(int, AR_RTOK); float* rww = WSP(float, AR_RW8); int* trow = WSP(int, AR_TROW);
                int segv = 0; { const int pc = lane < 16 ? (int)((ctl[CW_CNT + lane * 64] + 255u) & ~255u) : 0;
#pragma unroll
                    for (int k = 0; k < 8; ++k) { const int ck = bperm_i(pc, (lane & 8) + k); segv += (k < (lane & 7)) ? ck : 0; } }
                for (int hb = gw; hb < 2 * (T / 64); hb += NGW) {
                    const int tb = (hb >> 1) * 64, half = hb & 1, t = tb + lane; const int ee = WSP(int, AR_RTE)[t], e0 = ee & 255, e1 = (ee >> 8) & 255, r0 = (ee >> 16) & 255, r1 = (ee >> 24) & 255;
                    const float* w = WSP(float, AR_RTW) + (size_t)t * 2; const unsigned* wb = WSP(unsigned, AR_WBASE) + (size_t)(t % NGW) * 16;
                    const int row0 = bperm_i(segv, e0) + (int)wb[e0] + r0, row1 = bperm_i(segv, 8 + e1) + (int)wb[8 + e1] + r1;
                    if (half == 0) { rtok[row0] = t; rww[row0] = w[0]; rtok[MOE_ROWS + row1] = t; rww[MOE_ROWS + row1] = w[1]; trow[T + t] = row1; }
                    for (int l = 32 * half; l < 32 * half + 32; l += 4) { const bf16* hs = WSP(bf16, WS_H) + (size_t)(tb + l) * DM; bf16* xg = WSP(bf16, AR_XG);
                        copy_rows4(hs, hs + DM, hs + 2 * DM, hs + 3 * DM, xg + (size_t)__builtin_amdgcn_readlane(row0, l) * DM, xg + (size_t)__builtin_amdgcn_readlane(row0, l + 1) * DM, xg + (size_t)__builtin_amdgcn_readlane(row0, l + 2) * DM, xg + (size_t)__builtin_amdgcn_readlane(row0, l + 3) * DM, lane); }
                }
                SEAM(pb + 11);
            }
#pragma unroll
            for (int pass = 0; pass < 2; ++pass) {
                if (PHM(12) && IN(pb + 12 + 2 * pass)) { MKP;
                    Gemm g{WSP(bf16, AR_XG), WSP(bf16, AR_MGU), MOE_ROWS, NEXP * 2 * EXPERT_FF, DM}; MoeOrder S; S.init(ctl + CW_CNT + 8 * 64 * pass, 2 * EXPERT_FF / 256, G, bid);
                    EpiSwiglu E{WSP(bf16, AR_MACT), EXPERT_FF, 2 * EXPERT_FF / 256};
                    if (pass == 1) {
                        MoeOrder S0; S0.init(ctl + CW_CNT, DM / 256, G, bid); const int nwg = S0.s.nwg, mainw = (nwg / G) * G, ttiles = nwg - mainw;
                        if (bar.st != nullptr && (G & 31) == 0 && mainw > 0 && ttiles > 0 && ttiles <= 32) {
                            EpiMoeDown E0{p.out, WSP(int, AR_RTOK), WSP(float, AR_RW8), DM / 256, (PR_LO >= 0 && st == 0 && pb + 14 >= PR_LO && pb + 14 <= PR_HI) ? 0.f : 1.f};
                            for (int job = wave * G + bid; job < ttiles * 32; job += NWAVES * G) moe_tail_combine(E0, S0, WSP(float, WS_PART), mainw / (DM / 256), job, lane); } }
                    pg8::gemm_phase<EpiSwiglu, MoeOrder, true, true>(lds, g, S, E, tid);
                    SEAM(pb + 12 + 2 * pass);
                }
                if (PHM(13) && IN(pb + 13 + 2 * pass)) { MKP;
                    Gemm g{WSP(bf16, AR_MACT), WSP(bf16, AR_MDN), MOE_ROWS, NEXP * DM, EXPERT_FF}; MoeOrder S; S.init(ctl + CW_CNT + 8 * 64 * pass, DM / 256, G, bid);
                    EpiMoeDown E{p.out, WSP(int, AR_RTOK) + (size_t)pass * MOE_ROWS, WSP(float, AR_RW8) + (size_t)pass * MOE_ROWS, DM / 256, (PR_LO >= 0 && st == 0 && pb + 13 + 2 * pass >= PR_LO && pb + 13 + 2 * pass <= PR_HI) ? 0.f : 1.f};
                    if (pass == 0) { const int* trow = WSP(int, AR_TROW);
                        for (int t = gw * 4; t < T; t += NGW * 4) { const bf16* hs = WSP(bf16, WS_H) + (size_t)t * DM; bf16* xg = WSP(bf16, AR_XG);
                            copy_rows4(hs, hs + DM, hs + 2 * DM, hs + 3 * DM, xg + (size_t)trow[T + t] * DM, xg + (size_t)trow[T + t + 1] * DM, xg + (size_t)trow[T + t + 2] * DM, xg + (size_t)trow[T + t + 3] * DM, lane); } }
                    const int nwg = S.s.nwg, mainw = (nwg / G) * G, ttiles = nwg - mainw; const bool split = bar.st != nullptr && (G & 31) == 0 && mainw > 0 && ttiles > 0 && ttiles <= 32;
                    if (split) S.s.nwg = mainw;
                    pg8::gemm_phase<EpiMoeDown, MoeOrder, true, true>(lds, g, S, E, tid);
                    if (split) { Gemm g2{WSP(bf16, AR_MACT), WSP(bf16, AR_MDN), MOE_ROWS, NEXP * DM, MT_K, EXPERT_FF, EXPERT_FF}; MoeTailOrder S2; S2.init(S, mainw / (DM / 256), ttiles, G, bid);
                        EpiPart E2{WSP(float, WS_PART), mainw / (DM / 256), DM / 256};
                        pg8::gemm_phase<EpiPart, MoeTailOrder, true, true, true>(lds, g2, S2, E2, tid); }
                    if (pass == 1 && split) { { int w_ = wave0; asm volatile("" : "+s"(w_)); xcd_barrier(bar, w_ * 64 + lane_id_opaque()); }
                        for (int job = wave * G + bid; job < ttiles * 32; job += NWAVES * G) moe_tail_combine(E, S, WSP(float, WS_PART), mainw / (DM / 256), job, lane); }
                    SEAM(pb + 13 + 2 * pass);
                }
            }
        }
    }
    }
#undef IN
#undef SEAM
}

#ifndef MK_ONE_LAUNCH
#define MK_ONE_LAUNCH 1
#endif
extern "C" void kernel_launch(void* const* d_in, const int* in_sizes, int n_in, void* d_out, int out_size, void* d_ws, size_t ws_size, hipStream_t stream) {
    static int grid = 0;
    if (grid == 0) {
        if (n_in != 29 || in_sizes[0] != T * DM || out_size != T * DM || ws_size < WS_END) { fprintf(stderr, "kernel_launch: unexpected shapes / workspace (%d inputs, ws %zu, need %zu)\n", n_in, ws_size, (size_t)WS_END); grid = -1; return; }
        int dev = 0, cus = 0;
        if (hipGetDevice(&dev) != hipSuccess || hipDeviceGetAttribute(&cus, hipDeviceAttributeMultiprocessorCount, dev) != hipSuccess) { grid = -1; return; }
        if (hipFuncSetAttribute((const void*)mk_fwd, hipFuncAttributeMaxDynamicSharedMemorySize, LDS_BYTES) != hipSuccess) { fprintf(stderr, "kernel_launch: hipFuncSetAttribute failed\n"); grid = -1; return; }
        int per_cu = 0;
        if (hipOccupancyMaxActiveBlocksPerMultiprocessor(&per_cu, (const void*)mk_fwd, NTHREADS, LDS_BYTES) != hipSuccess || per_cu < 1) { fprintf(stderr, "kernel_launch: occupancy query says %d\n", per_cu); }
        (void)hipGetLastError();
        grid = cus;
    }
    if (grid < 0) return;
    if (hipMemsetAsync((char*)d_ws + WS_CTL, 0, CTL_BYTES, stream) != hipSuccess) return;
    Args a{};
    for (int i = 0; i < 29; ++i) a.in[i] = (const float*)d_in[i];
    a.out = (float*)d_out; a.ws = (unsigned char*)d_ws;
#if MK_ONE_LAUNCH
    a.ph_lo = 0; a.ph_hi = NPHASES;
    hipLaunchKernelGGL(mk_fwd, dim3(grid), dim3(NTHREADS), LDS_BYTES, stream, a);
#else
    for (int k = 0; k < NPHASES; ++k) {
        if (k >= 1 + 13 && k < 1 + NPH) continue;
        a.ph_lo = k; a.ph_hi = k + 1;
        hipLaunchKernelGGL(mk_fwd, dim3(grid), dim3(NTHREADS), LDS_BYTES, stream, a);
    }
#endif
}
```

```cpp
#include <hip/hip_runtime.h>
#include <cstdio>
#include <cstdint>
#include <cmath>
#include <cstring>
#ifdef HOST_EMU
#define HD
#define DEV_INLINE inline
#else
#define HD __host__ __device__
#define DEV_INLINE __device__ __forceinline__
#endif

typedef unsigned short bf16;
struct alignas(16) U4 { unsigned x, y, z, w; };

#ifdef SMALL_CFG
constexpr int BATCH = 1, SEQ = 1024, DM = 128, DENSE_FF = 256, EXPERT_FF = 256;
#else
constexpr int BATCH = 8, SEQ = 8192, DM = 1024, DENSE_FF = 2816, EXPERT_FF = 3584;
#endif
constexpr int T = BATCH * SEQ;
constexpr int NHEAD = 8, NKV = 2, HG = 4, DH = 64;
constexpr int NC = SEQ / 16 - 1, NS = SEQ / 64, NSEL = 8, WINDOW = 512;
constexpr int CONV_CH = 512, CONV_K = 31, RC = 512;
constexpr int NEXP = 8;
constexpr int NSA_IN = 1304, OFF_CONV = 1304, OFF_GATE = 2328, OFF_RWKV = OFF_GATE + 3 * DM;
constexpr int N_IN_FIRST = OFF_RWKV + 1824, N_IN_REST = OFF_RWKV + 1856;
constexpr int NPROJ = 4352;
constexpr int LDQ = 512, LDKV = 512, LDRW = 2048, LBLK = 1536;
constexpr int MOE_ROWS = T + NEXP * 256;
constexpr float RMS_EPS = 1e-6f, LN_EPS = 1e-5f, GN_EPS = 64e-5f;

constexpr size_t al(size_t x) { return (x + 255) & ~(size_t)255; }
constexpr size_t WS_CTL = 0, CTL_BYTES = 1u << 20;
constexpr size_t SZ_WIN = (size_t)NPROJ * DM * 2, SZ_WG = (size_t)3 * DM * DM * 2, SZ_WO3 = (size_t)3 * DM * 512 * 2, SZ_WOUT = (size_t)DM * DM * 2;
constexpr size_t SZ_LW = (size_t)2048 * 384 * 2, SZ_CW1 = (size_t)2 * 256 * 1024 * 2, SZ_PEC = 1024;
constexpr size_t SZ_LAYERW = SZ_WIN + SZ_WG + SZ_WO3 + SZ_WOUT + SZ_LW + SZ_CW1 + SZ_PEC;
constexpr size_t WS_W = CTL_BYTES;
constexpr size_t OFF_WIN = 0, OFF_WG = SZ_WIN, OFF_WO3 = OFF_WG + SZ_WG, OFF_WOUT = OFF_WO3 + SZ_WO3, OFF_LW = OFF_WOUT + SZ_WOUT, OFF_CW1 = OFF_LW + SZ_LW, OFF_PEC = OFF_CW1 + SZ_CW1;
constexpr size_t WS_DGU = WS_W + 2 * SZ_LAYERW, SZ_DGU = (size_t)2 * DENSE_FF * DM * 2;
constexpr size_t WS_DDN = WS_DGU + SZ_DGU, SZ_DDN = (size_t)DM * DENSE_FF * 2;
constexpr size_t WS_VF = al(WS_DDN + SZ_DDN), SZ_TC = (size_t)T * 512 * 2;
constexpr size_t WS_H = WS_VF + SZ_TC, SZ_H = (size_t)T * DM * 2;
constexpr size_t WS_PART = WS_VF;
static_assert((size_t)32 * 7 * 65536 * 4 <= SZ_TC, "WS_PART");
constexpr size_t WS_AR = al(WS_H + SZ_H);
constexpr size_t AR_QB = WS_AR, AR_A = AR_QB + SZ_TC, AR_CO = AR_A + SZ_TC;
constexpr size_t AR_KV = AR_CO + SZ_TC, SZ_KV = (size_t)T * LDKV * 2;
constexpr size_t AR_RW = AR_KV + SZ_KV, SZ_RW = (size_t)T * LDRW * 2;
constexpr size_t AR_W = AR_RW + SZ_RW, AR_G = AR_W + SZ_TC, AR_UB = AR_G + SZ_TC;
constexpr size_t AR_NG = AR_UB + SZ_TC, SZ_NG = (size_t)T * 24 * 4;
constexpr size_t AR_HALO = al(AR_NG + SZ_NG), SZ_HALO = (size_t)(T / 256) * LDRW * 2;
constexpr size_t AR_KC = al(AR_HALO + SZ_HALO), SZ_CMP = (size_t)BATCH * NKV * (SEQ / 16) * 64 * 2;
constexpr size_t AR_VC = AR_KC + SZ_CMP;
constexpr size_t AR_HID = al(AR_VC + SZ_CMP), SZ_HID = (size_t)BATCH * NKV * (SEQ / 16) * 2 * 128 * 4;
constexpr size_t AR_SEL = al(AR_HID + SZ_HID), SZ_SEL = (size_t)T * NKV * 8 * 4;
constexpr size_t AR_INVN = al(AR_SEL + SZ_SEL), SZ_INVN = (size_t)T * 8 * 4;
constexpr size_t AR_VCT = al(AR_INVN + SZ_INVN);
constexpr size_t AR_CKV = al(AR_VCT + SZ_CMP), SZ_CKV = (size_t)2 * T * 128;
constexpr size_t AR_END1 = al(AR_CKV + SZ_CKV * 2);
constexpr size_t WS_VST = WS_H, WS_VWT = WS_H + (size_t)T * 128 * 2, WS_LB = WS_VWT + (size_t)T * 128 * 2, WS_KS8 = WS_LB + (size_t)T * 384 * 2, WS_KW8 = WS_KS8 + (size_t)T * 128 * 2;
constexpr size_t AR_OBUF = AR_KV, SZ_OBUF = (size_t)3 * T * DM * 2;
constexpr size_t AR_MIX = AR_OBUF + SZ_OBUF, SZ_MIX = (size_t)T * DM * 2;
constexpr size_t AR_END2 = AR_MIX + SZ_MIX;
constexpr size_t AR_ACT = WS_AR;
constexpr size_t AR_MGU = WS_AR, SZ_MGU = (size_t)NEXP * 2 * EXPERT_FF * DM * 2;
constexpr size_t AR_MDN = AR_MGU + SZ_MGU, SZ_MDN = (size_t)NEXP * DM * EXPERT_FF * 2;
constexpr size_t AR_XG = al(AR_MDN + SZ_MDN), SZ_XG = (size_t)MOE_ROWS * DM * 2;
constexpr size_t AR_MACT = al(AR_XG + SZ_XG), SZ_MACT = (size_t)MOE_ROWS * EXPERT_FF * 2;
constexpr size_t AR_RTOK = al(AR_MACT + SZ_MACT), SZ_RTOK = (size_t)2 * MOE_ROWS * 4;
constexpr size_t AR_RW8 = al(AR_RTOK + SZ_RTOK);
constexpr size_t AR_TROW = al(AR_RW8 + SZ_RTOK), SZ_TROW = (size_t)2 * T * 4;
constexpr size_t AR_RTE = al(AR_TROW + SZ_TROW);
constexpr size_t AR_RTW = al(AR_RTE + (size_t)T * 4);
constexpr size_t AR_WBASE = al(AR_RTW + (size_t)T * 8);
constexpr size_t AR_END3 = al(AR_WBASE + (size_t)4096 * 16 * 4);
constexpr size_t WS_END = (AR_END1 > AR_END2 ? (AR_END1 > AR_END3 ? AR_END1 : AR_END3) : (AR_END2 > AR_END3 ? AR_END2 : AR_END3));
constexpr int CW_CNT = 1024;
constexpr int CW_ATT = 256;
constexpr int CW_BAR = 4096, CW_TK = 8192;

struct P {
    const float *x, *mix_norm_g, *w_in_first, *w_in_rest, *mu_first, *mu_rest, *qk_g, *cmp_pos, *cmp_w1, *cmp_w2, *nsa_w_o, *conv_w, *conv_vec, *conv_w_o,
        *rwkv_vec, *w_up, *a_up, *g_up, *vres_up, *vres_b, *rwkv_w_o, *w_out, *ffn_norm_g, *dense_gu, *dense_down, *router_w, *router_b, *moe_gu, *moe_down;
    float* out; unsigned char* ws;
};
HD inline void fill_params(P& p, const float* const* in, float* out, unsigned char* ws) {
    p.x = in[0]; p.mix_norm_g = in[1]; p.w_in_first = in[2]; p.w_in_rest = in[3]; p.mu_first = in[4]; p.mu_rest = in[5]; p.qk_g = in[6]; p.cmp_pos = in[7];
    p.cmp_w1 = in[8]; p.cmp_w2 = in[9]; p.nsa_w_o = in[10]; p.conv_w = in[11]; p.conv_vec = in[12]; p.conv_w_o = in[13]; p.rwkv_vec = in[14]; p.w_up = in[15];
    p.a_up = in[16]; p.g_up = in[17]; p.vres_up = in[18]; p.vres_b = in[19]; p.rwkv_w_o = in[20]; p.w_out = in[21]; p.ffn_norm_g = in[22]; p.dense_gu = in[23];
    p.dense_down = in[24]; p.router_w = in[25]; p.router_b = in[26]; p.moe_gu = in[27]; p.moe_down = in[28]; p.out = out; p.ws = ws;
}
#define WSP(type, off) ((type*)(p.ws + (off)))

#ifdef HOST_EMU
#define FENCE()
#else
#define FENCE() asm volatile("" ::: "memory")
#endif
HD inline float bf2f(bf16 v) { unsigned u = (unsigned)v << 16; float f; memcpy(&f, &u, 4); return f; }
HD inline bf16 f2bf(float f) { unsigned u; memcpy(&u, &f, 4); return (bf16)((u + 0x7fffu + ((u >> 16) & 1u)) >> 16); }
HD inline float blo(unsigned v) { unsigned u = v << 16; float f; memcpy(&f, &u, 4); return f; }
HD inline float bhi(unsigned v) { unsigned u = v & 0xffff0000u; float f; memcpy(&f, &u, 4); return f; }
#if !defined(SCAN_BF16) && !defined(RKV_BF16)
HD inline bf16 f2h(float f) { return __builtin_bit_cast(unsigned short, (_Float16)f); }
#else
HD inline bf16 f2bf(float f);
HD inline bf16 f2h(float f) { return f2bf(f); }
#endif
HD inline float h2f(bf16 v) { return (float)__builtin_bit_cast(_Float16, v); }
HD inline float sigmoidf_(float x) { return 1.f / (1.f + expf(-x)); }
HD inline float dot64(const float* q, const bf16* kp) {
    const U4* k4 = (const U4*)kp; float s0 = 0.f, s1 = 0.f;
#pragma unroll
    for (int i = 0; i < 8; ++i) { const U4 v = k4[i];
        s0 += q[8 * i + 0] * blo(v.x) + q[8 * i + 2] * blo(v.y) + q[8 * i + 4] * blo(v.z) + q[8 * i + 6] * blo(v.w);
        s1 += q[8 * i + 1] * bhi(v.x) + q[8 * i + 3] * bhi(v.y) + q[8 * i + 5] * bhi(v.z) + q[8 * i + 7] * bhi(v.w); }
    return s0 + s1;
}
HD inline float dot64p(const U4* q, const bf16* kp) {
    const U4* k4 = (const U4*)kp; float s0 = 0.f, s1 = 0.f;
#pragma unroll
    for (int i = 0; i < 8; ++i) { const U4 v = k4[i], w = q[i];
        s0 += blo(w.x) * blo(v.x) + blo(w.y) * blo(v.y) + blo(w.z) * blo(v.z) + blo(w.w) * blo(v.w);
        s1 += bhi(w.x) * bhi(v.x) + bhi(w.y) * bhi(v.y) + bhi(w.z) * bhi(v.z) + bhi(w.w) * bhi(v.w); }
    return s0 + s1;
}
HD inline void ld64(const bf16* kp, float* q) {
    const U4* k4 = (const U4*)kp;
#pragma unroll
    for (int i = 0; i < 8; ++i) { const U4 v = k4[i]; q[8 * i] = blo(v.x); q[8 * i + 1] = bhi(v.x); q[8 * i + 2] = blo(v.y); q[8 * i + 3] = bhi(v.y);
        q[8 * i + 4] = blo(v.z); q[8 * i + 5] = bhi(v.z); q[8 * i + 6] = blo(v.w); q[8 * i + 7] = bhi(v.w); }
}
HD inline void axpy64(float* o, float w, const bf16* vp) {
    const U4* k4 = (const U4*)vp;
#pragma unroll
    for (int i = 0; i < 8; ++i) { const U4 v = k4[i]; o[8 * i] += w * blo(v.x); o[8 * i + 1] += w * bhi(v.x); o[8 * i + 2] += w * blo(v.y); o[8 * i + 3] += w * bhi(v.y);
        o[8 * i + 4] += w * blo(v.z); o[8 * i + 5] += w * bhi(v.z); o[8 * i + 6] += w * blo(v.w); o[8 * i + 7] += w * bhi(v.w); }
}
HD inline void axpy64s(float* o, float w, const bf16* vp) {
    const U4* k4 = (const U4*)vp;
#pragma unroll
    for (int i = 0; i < 8; ++i) { const U4 v = k4[i]; o[8 * i] = w * o[8 * i] + blo(v.x); o[8 * i + 1] = w * o[8 * i + 1] + bhi(v.x); o[8 * i + 2] = w * o[8 * i + 2] + blo(v.y); o[8 * i + 3] = w * o[8 * i + 3] + bhi(v.y);
        o[8 * i + 4] = w * o[8 * i + 4] + blo(v.z); o[8 * i + 5] = w * o[8 * i + 5] + bhi(v.z); o[8 * i + 6] = w * o[8 * i + 6] + blo(v.w); o[8 * i + 7] = w * o[8 * i + 7] + bhi(v.w); }
}
HD inline void st64(bf16* op, const float* o) {
    U4* o4 = (U4*)op;
#pragma unroll
    for (int i = 0; i < 8; ++i) { U4 v; v.x = (unsigned)f2bf(o[8 * i]) | ((unsigned)f2bf(o[8 * i + 1]) << 16); v.y = (unsigned)f2bf(o[8 * i + 2]) | ((unsigned)f2bf(o[8 * i + 3]) << 16);
        v.z = (unsigned)f2bf(o[8 * i + 4]) | ((unsigned)f2bf(o[8 * i + 5]) << 16); v.w = (unsigned)f2bf(o[8 * i + 6]) | ((unsigned)f2bf(o[8 * i + 7]) << 16); o4[i] = v; }
}

HD inline void rope_cs(int pos, int i, float& cs, float& sn) {
    const float c = exp2f(-(float)i * 0.41524101186092f) * 0.15915494309189535f, pf = (float)pos;
    const float prod = pf * c, err = fmaf(pf, c, -prod), fr = (prod - rintf(prod)) + err;
#ifdef HOST_EMU
    cs = cosf(6.283185307179586f * fr); sn = sinf(6.283185307179586f * fr);
#else
    cs = __builtin_amdgcn_cosf(fr); sn = __builtin_amdgcn_sinf(fr);
#endif
}
HD inline int win_dest(int j, int layer, int& which) {
    which = 0;
    if (j < 1280) return j;
    if (j < 1304) return 3840 + 320 + (j - 1280);
    if (j < 1816) { const int cc = j - 1304; return 1280 + 256 * (cc / 128) + cc % 128; }
    if (j < 2328) { const int cc = j - 1816; return 1280 + 256 * (cc / 128) + 128 + cc % 128; }
    if (j < OFF_RWKV) { which = 1; const int gg = j - OFF_GATE, br = gg / DM; return (br == 0 ? 0 : (br == 1 ? 2 * DM : DM)) + gg % DM; }
    const int rr = j - OFF_RWKV;
    if (rr < 1536) return 2304 + rr;
    if (rr < 1824) return 3840 + (rr - 1536);
    if (rr < 1856 && layer == 1) return 3840 + 288 + (rr - 1824);
    return -1;
}
HD inline int glu_dest(int j, int ff) { return j < ff ? 256 * (j / 128) + j % 128 : 256 * ((j - ff) / 128) + 128 + (j - ff) % 128; }

DEV_INLINE void ph_shift(const P& p, int layer, long gtid, long NT) {
    bf16* RW = WSP(bf16, AR_RW); const bf16* HALO = WSP(bf16, AR_HALO); bf16* VF = WSP(bf16, WS_VF); bf16* LB = WSP(bf16, WS_LB);
    const float* mu = layer == 0 ? p.mu_first : p.mu_rest;
    constexpr int NCP = (LBLK + 384) / 2;
    const long n = (long)(T / 256) * NCP;
    for (long it = gtid; it < n; it += NT) {
        const int pm = (int)(it / NCP), c = 2 * (int)(it % NCP);
        int mi = -1, act = 0;
        if (c < LBLK) mi = c;
        else { const int w = c - LBLK; if (w < 288) { mi = 1536 + w; act = w < 64 ? 1 : (w >= 128 ? 2 : 0); } else if (w < 320 && layer == 1) mi = 1824 + (w - 288); }
        if (mi < 0) { for (int r = 0; r < 256; ++r) *(unsigned*)(LB + ((size_t)pm * 256 + r) * 384 + (c - LBLK)) = 0u; continue; }
        const float m0 = mu[mi], m1 = mu[mi + 1];
        float prev0 = 0.f, prev1 = 0.f;
        if ((pm * 256) % SEQ != 0) { const unsigned hv = *(const unsigned*)(HALO + (size_t)(pm - 1) * LDRW + c); prev0 = blo(hv); prev1 = bhi(hv); }
        bf16* col = RW + (size_t)pm * 256 * LDRW + c;
        for (int r0 = 0; r0 < 256; r0 += 16) {
            unsigned pv[16];
#pragma unroll
            for (int k = 0; k < 16; ++k) pv[k] = *(const unsigned*)(col + (size_t)(r0 + k) * LDRW);
#pragma unroll
            for (int k = 0; k < 16; ++k) { const int r = r0 + k; const float p0 = blo(pv[k]), p1 = bhi(pv[k]);
                float u0 = p0 + (prev0 - p0) * m0, u1 = p1 + (prev1 - p1) * m1; prev0 = p0; prev1 = p1;
                if (act == 1) { u0 = tanhf(u0); u1 = tanhf(u1); } else if (act == 2) { u0 = sigmoidf_(u0); u1 = sigmoidf_(u1); }
                if (c < LBLK) { const unsigned hv = (unsigned)f2h(u0) | ((unsigned)f2h(u1) << 16); *(unsigned*)(col + (size_t)r * LDRW) = hv;
                    if (layer == 0 && c >= 1024) *(unsigned*)(VF + ((size_t)pm * 256 + r) * RC + (c - 1024)) = hv; }
                else *(unsigned*)(LB + ((size_t)pm * 256 + r) * 384 + (c - LBLK)) = (unsigned)f2bf(u0) | ((unsigned)f2bf(u1) << 16); }
        }
    }
}

DEV_INLINE void ph_nsa_prep(const P& p, int layer, long gtid, long NT) {
    bf16* QB = WSP(bf16, AR_QB); bf16* KV = WSP(bf16, AR_KV);
    const long n = (long)T * 12;
    for (long it = gtid; it < n; it += NT) {
        const int t = (int)(it / 12), s = (int)(it % 12), pos = t % SEQ;
        bf16* ptr; const float* g;
        if (s < 8) { ptr = QB + (size_t)t * LDQ + s * 64; g = p.qk_g + (layer * 4 + 0) * 64; }
        else if (s < 10) { ptr = KV + (size_t)t * LDKV + (s - 8) * 64; g = p.qk_g + (layer * 4 + 2) * 64; }
        else { ptr = KV + (size_t)t * LDKV + 256 + (s - 10) * 64; g = p.qk_g + (layer * 4 + 3) * 64; }
        float v[64]; ld64(ptr, v);
        float ss = 0.f;
#pragma unroll
        for (int i = 0; i < 64; ++i) ss += v[i] * v[i];
        const float rs = 1.f / sqrtf(ss * (1.f / 64.f) + RMS_EPS);
#pragma unroll
        for (int i = 0; i < 64; ++i) v[i] = v[i] * rs * g[i];
#pragma unroll
        for (int i = 0; i < 32; ++i) {
            float cs, sn; rope_cs(pos, i, cs, sn);
            const float x1 = v[i], x2 = v[i + 32]; v[i] = x1 * cs - x2 * sn; v[i + 32] = x2 * cs + x1 * sn;
        }
        if (s < 8) {
#pragma unroll
            for (int i = 0; i < 64; ++i) v[i] *= 0.125f * 1.4426950408889634f; }
        if (s < 8) st64(ptr, v);
        else {
            const int gg = (s - 8) & 1, bq = t / SEQ; bf16* k8 = WSP(bf16, s < 10 ? WS_KS8 : WS_KW8) + (size_t)(bq * NKV + gg) * 8 * SEQ * 8;
#pragma unroll
            for (int dg = 0; dg < 8; ++dg) { U4 w; w.x = (unsigned)f2bf(v[8 * dg]) | ((unsigned)f2bf(v[8 * dg + 1]) << 16); w.y = (unsigned)f2bf(v[8 * dg + 2]) | ((unsigned)f2bf(v[8 * dg + 3]) << 16);
                w.z = (unsigned)f2bf(v[8 * dg + 4]) | ((unsigned)f2bf(v[8 * dg + 5]) << 16); w.w = (unsigned)f2bf(v[8 * dg + 6]) | ((unsigned)f2bf(v[8 * dg + 7]) << 16);
                *(U4*)(k8 + ((size_t)dg * SEQ + pos) * 8) = w; } }
    }
}

DEV_INLINE void ph_vtrans(const P& p, long gtid, long NT) {
    const bf16* KV = WSP(bf16, AR_KV); bf16* VsT = WSP(bf16, WS_VST); bf16* VwT = WSP(bf16, WS_VWT);
    const long n = (long)BATCH * NKV * (SEQ / 8) * 64;
    for (long it = gtid; it < n; it += NT) {
        const int d = (int)(it % 64); long r = it / 64; const int kg = (int)(r % (SEQ / 8)); const int bg = (int)(r / (SEQ / 8)), b = bg / NKV, g = bg % NKV;
        const int kbase = (kg >> 2) * 32 + 4 * (kg & 3);
        const bf16* src = KV + (size_t)(b * SEQ + kbase) * LDKV + g * 64 + d;
        U4 s, w; unsigned short sv[8], wv[8];
#pragma unroll
        for (int j = 0; j < 8; ++j) { const size_t ro = (size_t)((j & 3) + 16 * (j >> 2)) * LDKV; sv[j] = src[ro + 128]; wv[j] = src[ro + 384]; }
        s.x = sv[0] | ((unsigned)sv[1] << 16); s.y = sv[2] | ((unsigned)sv[3] << 16); s.z = sv[4] | ((unsigned)sv[5] << 16); s.w = sv[6] | ((unsigned)sv[7] << 16);
        w.x = wv[0] | ((unsigned)wv[1] << 16); w.y = wv[2] | ((unsigned)wv[3] << 16); w.z = wv[4] | ((unsigned)wv[5] << 16); w.w = wv[6] | ((unsigned)wv[7] << 16);
        *(U4*)(VsT + (((size_t)bg * (SEQ / 8) + kg) * 64 + d) * 8) = s; *(U4*)(VwT + (((size_t)bg * (SEQ / 8) + kg) * 64 + d) * 8) = w;
    }
}
namespace pg8 {
#define PG8_LAS __attribute__((address_space(3)))
typedef unsigned short bf16_t;
typedef short bf16x8 __attribute__((ext_vector_type(8)));
typedef float f32x4 __attribute__((ext_vector_type(4)));
typedef unsigned u32x4 __attribute__((ext_vector_type(4)));
constexpr int BM = 256, BK = 64, HALF = 128, HTB = HALF * BK * 2  , STAGE_BYTES = 8 * HTB, NXCD = 8, WGM = 8;

__host__ __device__ __forceinline__ int lds_byte(int r, int c) { const int st = (r >> 4) * 2 + (c >> 5), rr = r & 15, cc = c & 31, ob = rr * 64 + cc * 2; return st * 1024 + (ob ^ (((ob >> 9) & 1) << 5)); }
__host__ __device__ __forceinline__ void stage_rc(int b, int& R, int& C) { const int st = b / 1024, sb = b % 1024, swz = sb ^ (((sb >> 9) & 1) << 5); R = (st >> 1) * 16 + swz / 64; C = (st & 1) * 32 + (swz % 64) / 2; }
__host__ __device__ __forceinline__ int perm32(int rho) { const int n = rho >> 4, i = rho & 15; return 8 * (i >> 2) + 4 * n + (i & 3); }

struct Unit { int pm, pn; };
struct Gemm { const bf16_t* A; const bf16_t* Bt; int M, N, K; int lda; int ldb; };

struct StaticOrder {
    int nM, nN, nwg, G, c;
    __host__ __device__ void init(int M, int N, int G_, int c_) { nM = M / BM; nN = N / BM; nwg = nM * nN; G = G_; c = c_; }
    __host__ __device__ bool next(int i, Unit& u) const {
        const long L = (long)i * G + c; if (L >= nwg) return false;
        int wgid = (int)L; { const int q = nwg / NXCD, r = nwg % NXCD, xcd = wgid % NXCD, off = wgid / NXCD; wgid = (xcd < r ? xcd * (q + 1) : r * (q + 1) + (xcd - r) * q) + off; }
        const int nig = WGM * nN, gid = wgid / nig, fm = gid * WGM, gsz = (nM - fm) < WGM ? (nM - fm) : WGM;
        u.pm = fm + ((wgid % nig) % gsz); u.pn = (wgid % nig) / gsz; return true;
    }
    __device__ __forceinline__ void a_ready(const Unit&) const {}
    __device__ __forceinline__ void done(const Unit&) const {}
};

__device__ __forceinline__ unsigned cvt_pk_bf16(float lo, float hi) { unsigned r; asm volatile("v_cvt_pk_bf16_f32 %0, %1, %2" : "=v"(r) : "v"(lo), "v"(hi)); return r; }
typedef float f32x2 __attribute__((ext_vector_type(2)));
template <class Epi, class Sched, bool ALIGN_EPI = false, bool SP2 = false, bool KSPLIT = false>
__device__ __forceinline__ void gemm_phase(PG8_LAS unsigned char* lds, const Gemm g, const Sched& S, const Epi& E, int tid_in) {
    int tid_ = tid_in; asm volatile("" : "+v"(tid_));
    const int tid = tid_, wid = __builtin_amdgcn_readfirstlane(tid >> 6), lane = tid & 63, wr = wid >> 2, wc = wid & 3, fr = lane & 15, fq = lane >> 4;
    const int K = g.K, nt = K / BK, lda = g.lda ? g.lda : K, ldb = g.ldb ? g.ldb : K;
    unsigned voffA[2], voffB[2];
#pragma unroll
    for (int i = 0; i < 2; ++i) { int R, C; stage_rc(tid * 16 + i * 8192, R, C); const int Rb = Epi::PERM ? ((R & ~31) + perm32(R & 31)) : R;
        voffA[i] = (unsigned)(R * lda + C) * 2u; voffB[i] = (unsigned)(Rb * ldb + C) * 2u; }
    const size_t kstep = (size_t)(BK * 2);
    const size_t hstepA = (size_t)HALF * lda * 2, hstepB = (size_t)HALF * ldb * 2;
    const size_t hstep_unused = (size_t)HALF * K * 2;
    const size_t tstepA = 2 * hstepA, tstepB = 2 * hstepB;
    const unsigned ldsw = (unsigned)wid * 1024u;
    const int aoff = lds_byte(wr * 64 + fr, fq * 8), boff = lds_byte(wc * 32 + fr, fq * 8);
#define PG8_SA(b, h) (((b) * 2 + (h)) * HTB)
#define PG8_SB(b, h) ((4 + (b) * 2 + (h)) * HTB)
#define PG8_STAGE(bufoff, gbase, voff) do { _Pragma("unroll") for (int _i = 0; _i < 2; ++_i) \
        __builtin_amdgcn_global_load_lds((const unsigned*)((const char*)(gbase) + (voff)[_i]), (PG8_LAS unsigned*)(lds + (bufoff) + ldsw + _i * 8192), 16, 0, 0); } while (0)
#define PG8_LDA(dst, b, h) do { _Pragma("unroll") for (int m = 0; m < 4; ++m) _Pragma("unroll") for (int k = 0; k < 2; ++k) dst[m][k] = *(const PG8_LAS bf16x8*)(lds + PG8_SA(b, h) + aoff + m * 2048 + k * 1024); } while (0)
#define PG8_LDB(dst, b, h) do { _Pragma("unroll") for (int n = 0; n < 2; ++n) _Pragma("unroll") for (int k = 0; k < 2; ++k) dst[n][k] = *(const PG8_LAS bf16x8*)(lds + PG8_SB(b, h) + boff + n * 2048 + k * 1024); } while (0)
#define PG8_MMA(ai, bj, At, Bt) do { __builtin_amdgcn_s_setprio(1); _Pragma("unroll") for (int m = 0; m < 4; ++m) _Pragma("unroll") for (int n = 0; n < 2; ++n) _Pragma("unroll") for (int k = 0; k < 2; ++k) \
        acc[ai][bj][m][n] = __builtin_amdgcn_mfma_f32_16x16x32_bf16(Bt[n][k], At[m][k], acc[ai][bj][m][n], 0, 0, 0); __builtin_amdgcn_s_setprio(0); } while (0)
#define PG8_WAIT_V(n) asm volatile("s_waitcnt vmcnt(" #n ")" ::: "memory")
#define PG8_WAIT_L(n) asm volatile("s_waitcnt lgkmcnt(" #n ")" ::: "memory")
#define PG8_BAR __builtin_amdgcn_s_barrier()
#define PG8_SCHED __builtin_amdgcn_sched_barrier(0)
    Unit cur, nxt; int ui = 0;
    if (!S.next(0, cur)) return;
    f32x4 acc[2][2][4][2];
#pragma unroll
    for (int a = 0; a < 2; ++a)
#pragma unroll
        for (int b = 0; b < 2; ++b)
#pragma unroll
            for (int m = 0; m < 4; ++m)
#pragma unroll
                for (int n = 0; n < 2; ++n) acc[a][b][m][n] = (f32x4){0.f, 0.f, 0.f, 0.f};
    bf16x8 At[4][2], B0[2][2], B1[2][2];
    const char* cA = (const char*)g.A + (size_t)cur.pm * tstepA + (KSPLIT ? (size_t)(cur.pn >> 16) * K * 2 : 0); const char* cB = (const char*)g.Bt + (size_t)(KSPLIT ? (cur.pn & 0xffff) : cur.pn) * tstepB + (KSPLIT ? (size_t)(cur.pn >> 16) * K * 2 : 0);
    S.a_ready(cur);
    if constexpr (SP2) {
        PG8_STAGE(PG8_SB(0, 0), cB, voffB); PG8_STAGE(PG8_SB(0, 1), cB + hstepB, voffB); PG8_STAGE(PG8_SA(0, 0), cA, voffA); PG8_STAGE(PG8_SA(0, 1), cA + hstepA, voffA);
        if (wr == 1) PG8_BAR;
        PG8_WAIT_V(2); PG8_BAR;
        PG8_STAGE(PG8_SB(1, 0), cB + kstep, voffB); PG8_STAGE(PG8_SA(1, 0), cA + kstep, voffA); PG8_STAGE(PG8_SB(1, 1), cB + hstepB + kstep, voffB);
        PG8_WAIT_V(6); PG8_BAR;
    } else {
        PG8_STAGE(PG8_SB(0, 0), cB, voffB); PG8_STAGE(PG8_SA(0, 0), cA, voffA); PG8_STAGE(PG8_SB(0, 1), cB + hstepB, voffB); PG8_STAGE(PG8_SA(0, 1), cA + hstepA, voffA);
        if (wr == 1) PG8_BAR;
        PG8_WAIT_V(4); PG8_BAR;
        PG8_STAGE(PG8_SB(1, 0), cB + kstep, voffB); PG8_STAGE(PG8_SA(1, 0), cA + kstep, voffA); PG8_STAGE(PG8_SB(1, 1), cB + hstepB + kstep, voffB);
        PG8_WAIT_V(6); PG8_BAR;
    }
    for (;;) {
        const bool has_next = S.next(ui + 1, nxt);
        const char* nA = has_next ? (const char*)g.A + (size_t)nxt.pm * tstepA + (KSPLIT ? (size_t)(nxt.pn >> 16) * K * 2 : 0) : cA; const char* nB = has_next ? (const char*)g.Bt + (size_t)(KSPLIT ? (nxt.pn & 0xffff) : nxt.pn) * tstepB + (KSPLIT ? (size_t)(nxt.pn >> 16) * K * 2 : 0) : cB;
        for (int t = 0; t < nt; t += 2) {
            const bool last = (t == nt - 2);
            const char* a1 = cA + (size_t)(t + 1) * kstep;
            const char* a2 = last ? nA : cA + (size_t)(t + 2) * kstep; const char* b2 = last ? nB : cB + (size_t)(t + 2) * kstep;
            const char* a3 = a2 + kstep; const char* b3 = b2 + kstep;
            if (last && has_next) S.a_ready(nxt);
            if constexpr (SP2) {
            PG8_LDB(B0, 0, 0); PG8_LDB(B1, 0, 1); PG8_SCHED; PG8_LDA(At, 0, 0); PG8_STAGE(PG8_SA(1, 1), a1 + hstepA, voffA);
            PG8_WAIT_V(8); PG8_WAIT_L(0); PG8_BAR; PG8_MMA(0, 0, At, B0); PG8_MMA(0, 1, At, B1); PG8_BAR; PG8_SCHED;
            PG8_LDA(At, 0, 1); PG8_STAGE(PG8_SB(0, 0), b2, voffB); PG8_STAGE(PG8_SB(0, 1), b2 + hstepB, voffB); PG8_STAGE(PG8_SA(0, 0), a2, voffA);
            PG8_WAIT_V(8); PG8_WAIT_L(0); PG8_BAR; PG8_MMA(1, 0, At, B0); PG8_MMA(1, 1, At, B1); PG8_BAR; PG8_SCHED;
            PG8_LDB(B0, 1, 0); PG8_LDB(B1, 1, 1); PG8_SCHED; PG8_LDA(At, 1, 0); PG8_STAGE(PG8_SA(0, 1), a2 + hstepA, voffA);
            PG8_WAIT_V(8); PG8_WAIT_L(0); PG8_BAR; PG8_MMA(0, 0, At, B0); PG8_MMA(0, 1, At, B1); PG8_BAR; PG8_SCHED;
            PG8_LDA(At, 1, 1); PG8_STAGE(PG8_SB(1, 0), b3, voffB); PG8_STAGE(PG8_SB(1, 1), b3 + hstepB, voffB); PG8_STAGE(PG8_SA(1, 0), a3, voffA);
            PG8_WAIT_V(8); PG8_WAIT_L(0); PG8_BAR; PG8_MMA(1, 0, At, B0); PG8_MMA(1, 1, At, B1); PG8_BAR; PG8_SCHED;
            } else {
            PG8_LDB(B0, 0, 0); PG8_SCHED; PG8_LDA(At, 0, 0); PG8_STAGE(PG8_SA(1, 1), a1 + hstepA, voffA);
            PG8_WAIT_L(8); PG8_BAR; PG8_WAIT_L(0); PG8_MMA(0, 0, At, B0); PG8_BAR; PG8_SCHED;
            PG8_LDB(B1, 0, 1); PG8_STAGE(PG8_SB(0, 0), b2, voffB);
            PG8_BAR; PG8_WAIT_L(0); PG8_MMA(0, 1, At, B1); PG8_BAR;
            PG8_LDA(At, 0, 1); PG8_STAGE(PG8_SA(0, 0), a2, voffA);
            PG8_BAR; PG8_WAIT_L(0); PG8_MMA(1, 0, At, B0); PG8_BAR; PG8_SCHED;
            PG8_STAGE(PG8_SB(0, 1), b2 + hstepB, voffB);
            PG8_WAIT_V(6); PG8_BAR; PG8_MMA(1, 1, At, B1); PG8_BAR;
            PG8_LDB(B0, 1, 0); PG8_SCHED; PG8_LDA(At, 1, 0); PG8_STAGE(PG8_SA(0, 1), a2 + hstepA, voffA);
            PG8_WAIT_L(8); PG8_BAR; PG8_WAIT_L(0); PG8_MMA(0, 0, At, B0); PG8_BAR; PG8_SCHED;
            PG8_LDB(B1, 1, 1); PG8_STAGE(PG8_SB(1, 0), b3, voffB);
            PG8_BAR; PG8_WAIT_L(0); PG8_MMA(0, 1, At, B1); PG8_BAR;
            PG8_LDA(At, 1, 1); PG8_STAGE(PG8_SA(1, 0), a3, voffA);
            PG8_BAR; PG8_WAIT_L(0); PG8_MMA(1, 0, At, B0); PG8_BAR; PG8_SCHED;
            PG8_STAGE(PG8_SB(1, 1), b3 + hstepB, voffB);
            PG8_WAIT_V(6); PG8_BAR; PG8_MMA(1, 1, At, B1); PG8_BAR;
            }
        }
        if constexpr (ALIGN_EPI) { if (wr == 0) PG8_BAR; }
        if constexpr (!Epi::AFTER_DRAIN) { E(acc, cur, wr, wc, fr, fq); S.done(cur); }
        if (!has_next) break;
#pragma unroll
        for (int a = 0; a < 2; ++a)
#pragma unroll
            for (int b = 0; b < 2; ++b)
#pragma unroll
                for (int m = 0; m < 4; ++m)
#pragma unroll
                    for (int n = 0; n < 2; ++n) acc[a][b][m][n] = (f32x4){0.f, 0.f, 0.f, 0.f};
        cur = nxt; cA = nA; cB = nB; ++ui;
        if constexpr (ALIGN_EPI) { if (wr == 1) PG8_BAR; }
    }
    PG8_WAIT_V(0);
    if constexpr (!ALIGN_EPI) { if (wr == 0) PG8_BAR; }
    PG8_BAR;
    if constexpr (Epi::AFTER_DRAIN) { E.fused(acc, cur, wr, wc, fr, fq, lds, wid, lane); S.done(cur); }
#undef PG8_SA
#undef PG8_SB
#undef PG8_STAGE
#undef PG8_LDA
#undef PG8_LDB
#undef PG8_MMA
#undef PG8_WAIT_V
#undef PG8_WAIT_L
#undef PG8_BAR
#undef PG8_SCHED
}
}

#define LAS __attribute__((address_space(3)))
#define XB_TMO      128
#define XB_XCNT(j)  (256  + 64 * (j))
#define XB_XSUB(j)  (1280 + 64 * (j))
#define XB_XGEN(j)  (2304 + 64 * (j))
#define XB_TOP      3328
#define XB_TOPGEN   3392
#define XCD_BAR_WORDS 3456
#define XB_SPIN_CAP (1u << 22)

__device__ __forceinline__ unsigned xb_ld(unsigned* p)              { return __hip_atomic_load(p, __ATOMIC_RELAXED, __HIP_MEMORY_SCOPE_AGENT); }
__device__ __forceinline__ unsigned xb_add(unsigned* p, unsigned v) { return __hip_atomic_fetch_add(p, v, __ATOMIC_RELAXED, __HIP_MEMORY_SCOPE_AGENT); }
__device__ __forceinline__ unsigned xb_xcc_id() { return (unsigned)__builtin_amdgcn_s_getreg((3 << 11) | 20) & 0xFu; }
#define XB_SPIN(cond, bar) do { unsigned _sp = 0; while (cond) { __builtin_amdgcn_s_sleep(1); \
    if ((++_sp & 255u) == 0u) { if (xb_ld(&(bar)[XB_TMO])) break; if (_sp > XB_SPIN_CAP) { atomicAdd(&(bar)[XB_TMO], 1u); break; } } } } while (0)

struct XcdBarrier {
    unsigned* bar; unsigned x;
    volatile LAS unsigned* st;
};

__device__ __forceinline__ XcdBarrier xcd_barrier_post(unsigned* bar, volatile LAS unsigned* st) {
    XcdBarrier b; b.bar = bar; b.x = xb_xcc_id(); b.st = st;
    if (threadIdx.x == 0) (void)xb_add(&bar[XB_XCNT(b.x)], 1u);
    return b;
}
__device__ __forceinline__ void xcd_barrier_complete(unsigned* bar, unsigned x, unsigned& nloc, unsigned& nx) {
    const unsigned G = gridDim.x * gridDim.y * gridDim.z;
    unsigned sum, cnt, mine, sp = 0u;
    for (;;) {
        sum = 0u; cnt = 0u; mine = 0u;
#pragma unroll
        for (unsigned j = 0; j < 16; ++j) { const unsigned c = xb_ld(&bar[XB_XCNT(j)]); sum += c; cnt += (c > 0u) ? 1u : 0u; mine = (j == x) ? c : mine; }
        if (sum == G) break;
        __builtin_amdgcn_s_sleep(1);
        if ((++sp & 255u) == 0u) { if (xb_ld(&bar[XB_TMO])) break; if (sp > XB_SPIN_CAP) { atomicAdd(&bar[XB_TMO], 1u); break; } }
    }
    nloc = mine > 0u ? mine : 1u; nx = cnt > 0u ? cnt : 1u;
}

__device__ __forceinline__ void xcd_barrier(const XcdBarrier& b, int tid_x  ) {
    asm volatile("s_waitcnt vmcnt(0)" ::: "memory");
    __syncthreads();
    if (tid_x == 0) {
        unsigned* bar = b.bar; asm volatile("" : "+s"(bar));
        unsigned xx = b.x; asm volatile("" : "+s"(xx));
        __builtin_amdgcn_s_waitcnt(0);
        unsigned nloc = b.st[0], nx = b.st[1];
        if (nloc == 0u) { xcd_barrier_complete(bar, xx, nloc, nx); b.st[0] = nloc; b.st[1] = nx; }
        const unsigned old = xb_add(&bar[XB_XSUB(xx)], 1u);
        const unsigned gen = old / nloc;
        if (old + 1u == (gen + 1u) * nloc) {
            __builtin_amdgcn_fence(__ATOMIC_RELEASE, "agent");
            asm volatile("s_waitcnt vmcnt(0)" ::: "memory");
            const unsigned og = xb_add(&bar[XB_TOP], 1u);
            const unsigned tg = og / nx;
            if (og + 1u == (tg + 1u) * nx) xb_add(&bar[XB_TOPGEN], 1u);
            else XB_SPIN(xb_ld(&bar[XB_TOPGEN]) == tg, bar);
            __builtin_amdgcn_fence(__ATOMIC_ACQUIRE, "agent");
            xb_add(&bar[XB_XGEN(xx)], 1u);
            asm volatile("s_waitcnt vmcnt(0)" ::: "memory");
        } else {
            XB_SPIN(xb_ld(&bar[XB_XGEN(xx)]) == gen, bar);
            __builtin_amdgcn_fence(__ATOMIC_ACQUIRE, "agent");
            asm volatile("s_waitcnt vmcnt(0)" ::: "memory");
        }
    }
    __syncthreads();
}
#define GAS __attribute__((address_space(1)))
typedef unsigned v4u __attribute__((ext_vector_type(4)));
typedef unsigned v2u __attribute__((ext_vector_type(2)));
typedef GAS unsigned gu32;
#define RLX_AGENT __ATOMIC_RELAXED, __HIP_MEMORY_SCOPE_AGENT
#define LDS_WAIT() asm volatile("s_waitcnt lgkmcnt(0)" ::: "memory")
#define VM_WAIT() asm volatile("s_waitcnt vmcnt(0)" ::: "memory")
using pg8::f32x4; using pg8::Unit; using pg8::Gemm; using pg8::BM; using pg8::HALF; using pg8::cvt_pk_bf16; using pg8::u32x4;

constexpr int NWAVES = 8, NTHREADS = 512;
constexpr int RING_BYTES = 131072, LDSCTL_OFF = 147456 - 1024, MISC_OFF = LDSCTL_OFF + 320, LDS_BYTES = 147456;

__device__ __forceinline__ float wave_sum(float v, int lane) {
#pragma unroll
    for (int o = 1; o < 64; o <<= 1) v += __builtin_bit_cast(float, __builtin_amdgcn_ds_bpermute((lane ^ o) << 2, __builtin_bit_cast(int, v)));
    return v;
}
__device__ __forceinline__ float fsig(float x) { return __builtin_amdgcn_rcpf(1.f + __expf(-x)); }

__device__ __forceinline__ int lane_id_opaque() { int l; asm volatile("v_mbcnt_lo_u32_b32 %0, -1, 0\n\tv_mbcnt_hi_u32_b32 %0, -1, %0" : "=v"(l)); return l; }
__device__ __forceinline__ int rfl(int v) { return __builtin_amdgcn_readfirstlane(v); }
struct SOrder {
    pg8::StaticOrder s;
    __device__ void init(int M, int N, int G, int c) { s.init(M, N, G, c); }
    __device__ bool next(int i, Unit& u) const { Unit t; t.pm = 0; t.pn = 0; const bool ok = s.next(i, t); u.pm = rfl(t.pm); u.pn = rfl(t.pn); return ok; }
    __device__ __forceinline__ void a_ready(const Unit&) const {}
    __device__ __forceinline__ void done(const Unit&) const {}
};
struct StackOrder {
    pg8::StaticOrder s; int nM, nN;
    __device__ StackOrder(int nM_, int nN_, int nb, int G, int c) : nM(nM_), nN(nN_) { s.init(nb * nM_ * 256, nN_ * 256, G, c); }
    __device__ bool next(int i, Unit& u) const { Unit t; t.pm = 0; t.pn = 0; if (!s.next(i, t)) return false; u.pm = rfl(t.pm); u.pn = rfl((t.pm / nM) * nN + t.pn); return true; }
    __device__ __forceinline__ void a_ready(const Unit&) const {}
    __device__ __forceinline__ void done(const Unit&) const {}
};
struct GateOrder {
    pg8::StaticOrder s; int nN;
    __device__ GateOrder(int nM_, int nN_, int G, int c) : nN(nN_) { s.init(nM_ * 256, nN_ * 256, G, c); }
    __device__ bool next(int i, Unit& u) const { const int j = i / 3, br = i - 3 * j; Unit t; t.pm = 0; t.pn = 0; if (!s.next(j, t)) return false; u.pm = rfl(t.pm); u.pn = rfl(br * nN + t.pn); return true; }
    __device__ __forceinline__ void a_ready(const Unit&) const {}
    __device__ __forceinline__ void done(const Unit&) const {}
};
struct MoeOrder {
    pg8::StaticOrder s; int nN, e0, e1, e2, e3, e4, e5, e6, e7;
    __device__ void init(const unsigned* cnt  , int nN_, int G_, int c_) { nN = nN_;
        int t = 0; t += (cnt[0] + 255) >> 8; e0 = t; t += (cnt[64] + 255) >> 8; e1 = t; t += (cnt[128] + 255) >> 8; e2 = t; t += (cnt[192] + 255) >> 8; e3 = t;
        t += (cnt[256] + 255) >> 8; e4 = t; t += (cnt[320] + 255) >> 8; e5 = t; t += (cnt[384] + 255) >> 8; e6 = t; t += (cnt[448] + 255) >> 8; e7 = t;
        s.init(e7 * 256, nN_ * 256, G_, c_); }
    __device__ bool next(int i, Unit& u) const { Unit t; t.pm = 0; t.pn = 0; if (!s.next(i, t)) return false;
        const int pm = t.pm, e = (pm >= e0) + (pm >= e1) + (pm >= e2) + (pm >= e3) + (pm >= e4) + (pm >= e5) + (pm >= e6);
        u.pm = rfl(pm); u.pn = rfl(e * nN + t.pn); return true; }
    __device__ __forceinline__ void a_ready(const Unit&) const {}
    __device__ __forceinline__ void done(const Unit&) const {}
};

__device__ __forceinline__ u32x4 pack8(f32x4 v0, f32x4 v1) { u32x4 w; w.x = cvt_pk_bf16(v0[0], v0[1]); w.y = cvt_pk_bf16(v0[2], v0[3]); w.z = cvt_pk_bf16(v1[0], v1[1]); w.w = cvt_pk_bf16(v1[2], v1[3]); return w; }
__device__ __forceinline__ void unpack8(u32x4 w, f32x4& v0, f32x4& v1) {
    v0 = (f32x4){blo(w.x), bhi(w.x), blo(w.y), bhi(w.y)}; v1 = (f32x4){blo(w.z), bhi(w.z), blo(w.w), bhi(w.w)}; }

struct EpiProj {
    static constexpr bool PERM = true, AFTER_DRAIN = false;
    unsigned char* ws;
    __device__ __forceinline__ void operator()(const f32x4 (&acc)[2][2][4][2], const Unit& u, int wr, int wc, int fr, int fq) const {
        bf16* const QB = (bf16*)(ws + AR_QB); bf16* const KV = (bf16*)(ws + AR_KV); bf16* const UB = (bf16*)(ws + AR_UB); bf16* const RW = (bf16*)(ws + AR_RW); bf16* const HALO = (bf16*)(ws + AR_HALO); bf16* const CKV = (bf16*)(ws + AR_CKV);
        const int row0 = u.pm * BM + wr * 64 + fr, cl = wc * 32 + 8 * fq;
        if (u.pn >= 5 && u.pn < 9) {
#pragma unroll
            for (int ai = 0; ai < 2; ++ai)
#pragma unroll
                for (int m = 0; m < 4; ++m) { f32x4 a0 = acc[ai][0][m][0], a1 = acc[ai][0][m][1]; const f32x4 b0 = acc[ai][1][m][0], b1 = acc[ai][1][m][1];
#pragma unroll
                    for (int k = 0; k < 4; ++k) { a0[k] *= fsig(b0[k]); a1[k] *= fsig(b1[k]); }
                    *(u32x4*)(UB + (size_t)(row0 + ai * HALF + m * 16) * 512 + (u.pn - 5) * 128 + cl) = pack8(a0, a1); }
            return;
        }
        if (u.pn == 2) {
#pragma unroll
            for (int ai = 0; ai < 2; ++ai)
#pragma unroll
                for (int m = 0; m < 4; ++m) { const int row = row0 + ai * HALF + m * 16, b = row / SEQ, tt = row % SEQ;
#pragma unroll
                    for (int bj = 0; bj < 2; ++bj) *(u32x4*)(CKV + (((size_t)bj * (BATCH * NKV) + b * NKV + (cl >> 6)) * SEQ + tt) * 64 + (cl & 63)) = pack8(acc[ai][bj][m][0], acc[ai][bj][m][1]); }
            return;
        }
        bf16* base; int ld, c0;
        if (u.pn < 2) { base = QB; ld = LDQ; c0 = u.pn * 256; } else if (u.pn < 5) { base = KV; ld = LDKV; c0 = (u.pn - 3) * 256; } else { base = RW; ld = LDRW; c0 = (u.pn - 9) * 256; }
#pragma unroll
        for (int ai = 0; ai < 2; ++ai)
#pragma unroll
            for (int m = 0; m < 4; ++m)
#pragma unroll
                for (int bj = 0; bj < 2; ++bj) { const u32x4 w = pack8(acc[ai][bj][m][0], acc[ai][bj][m][1]);
                    *(u32x4*)(base + (size_t)(row0 + ai * HALF + m * 16) * ld + c0 + bj * HALF + cl) = w;
                    if (u.pn >= 9 && ai == 1 && m == 3 && wr == 1 && fr == 15) *(u32x4*)(HALO + (size_t)u.pm * LDRW + c0 + bj * HALF + cl) = w; }
    }
};
struct EpiStore {
    static constexpr bool PERM = true, AFTER_DRAIN = false;
    bf16* O; int ld, ntn;
    __device__ __forceinline__ void operator()(const f32x4 (&acc)[2][2][4][2], const Unit& u, int wr, int wc, int fr, int fq) const {
        const int row0 = u.pm * BM + wr * 64 + fr, c0 = (u.pn % ntn) * 256 + wc * 32 + 8 * fq;
#pragma unroll
        for (int ai = 0; ai < 2; ++ai)
#pragma unroll
            for (int m = 0; m < 4; ++m)
#pragma unroll
                for (int bj = 0; bj < 2; ++bj) *(u32x4*)(O + (size_t)(row0 + ai * HALF + m * 16) * ld + c0 + bj * HALF) = pack8(acc[ai][bj][m][0], acc[ai][bj][m][1]);
    }
};
struct EpiGate {
    static constexpr bool PERM = true, AFTER_DRAIN = false;
    unsigned char* ws; int ntn;
    __device__ __forceinline__ void operator()(const f32x4 (&acc)[2][2][4][2], const Unit& u, int wr, int wc, int fr, int fq) const {
        const bf16* const OB = (const bf16*)(ws + AR_OBUF); bf16* const MIX = (bf16*)(ws + AR_MIX);
        const int br = u.pn / ntn, row0 = u.pm * BM + wr * 64 + fr, c0 = (u.pn % ntn) * 256 + wc * 32 + 8 * fq;
        const bf16* ob = OB + (size_t)br * T * DM;
#pragma unroll
        for (int ai = 0; ai < 2; ++ai) {
            u32x4 o[4][2], mx[4][2];
#pragma unroll
            for (int m = 0; m < 4; ++m)
#pragma unroll
                for (int bj = 0; bj < 2; ++bj) { const size_t off = (size_t)(row0 + ai * HALF + m * 16) * DM + c0 + bj * HALF; o[m][bj] = *(const u32x4*)(ob + off); if (br != 0) mx[m][bj] = *(const u32x4*)(MIX + off); }
#pragma unroll
            for (int m = 0; m < 4; ++m)
#pragma unroll
                for (int bj = 0; bj < 2; ++bj) { const size_t off = (size_t)(row0 + ai * HALF + m * 16) * DM + c0 + bj * HALF;
                    f32x4 o0, o1; unpack8(o[m][bj], o0, o1);
                    f32x4 g0 = acc[ai][bj][m][0], g1 = acc[ai][bj][m][1];
#pragma unroll
                    for (int k = 0; k < 4; ++k) { g0[k] = fsig(g0[k]) * o0[k]; g1[k] = fsig(g1[k]) * o1[k]; }
                    if (br != 0) { f32x4 p0, p1; unpack8(mx[m][bj], p0, p1); g0 += p0; g1 += p1; }
                    *(u32x4*)(MIX + off) = pack8(g0, g1); }
        }
    }
};
struct EpiResid {
    static constexpr bool PERM = true, AFTER_DRAIN = false;
    const float* base; float* out;
    __device__ __forceinline__ void operator()(const f32x4 (&acc)[2][2][4][2], const Unit& u, int wr, int wc, int fr, int fq) const {
        const int row0 = u.pm * BM + wr * 64 + fr, c0 = u.pn * 256 + wc * 32 + 8 * fq;
#pragma unroll
        for (int ai = 0; ai < 2; ++ai)
#pragma unroll
            for (int mh = 0; mh < 2; ++mh) {
                f32x4 x[2][2][2];
#pragma unroll
                for (int mm = 0; mm < 2; ++mm)
#pragma unroll
                    for (int bj = 0; bj < 2; ++bj) { const size_t off = (size_t)(row0 + ai * HALF + (2 * mh + mm) * 16) * DM + c0 + bj * HALF; x[mm][bj][0] = *(const f32x4*)(base + off); x[mm][bj][1] = *(const f32x4*)(base + off + 4); }
#pragma unroll
                for (int mm = 0; mm < 2; ++mm)
#pragma unroll
                    for (int bj = 0; bj < 2; ++bj) { const int m = 2 * mh + mm; const size_t off = (size_t)(row0 + ai * HALF + m * 16) * DM + c0 + bj * HALF;
                        *(f32x4*)(out + off) = x[mm][bj][0] + acc[ai][bj][m][0]; *(f32x4*)(out + off + 4) = x[mm][bj][1] + acc[ai][bj][m][1]; }
            }
    }
};
struct EpiSwiglu {
    static constexpr bool PERM = true, AFTER_DRAIN = false;
    bf16* ACT; int ld, ntn;
    __device__ __forceinline__ void operator()(const f32x4 (&acc)[2][2][4][2], const Unit& u, int wr, int wc, int fr, int fq) const {
        const int row0 = u.pm * BM + wr * 64 + fr, c0 = (u.pn % ntn) * 128 + wc * 32 + 8 * fq;
#pragma unroll
        for (int ai = 0; ai < 2; ++ai)
#pragma unroll
            for (int m = 0; m < 4; ++m) { f32x4 g0 = acc[ai][0][m][0], g1 = acc[ai][0][m][1]; const f32x4 u0 = acc[ai][1][m][0], u1 = acc[ai][1][m][1];
#pragma unroll
                for (int k = 0; k < 4; ++k) { g0[k] = g0[k] * fsig(g0[k]) * u0[k]; g1[k] = g1[k] * fsig(g1[k]) * u1[k]; }
                *(u32x4*)(ACT + (size_t)(row0 + ai * HALF + m * 16) * ld + c0) = pack8(g0, g1); }
    }
};
struct EpiMoeDown {
    static constexpr bool PERM = true, AFTER_DRAIN = false;
    float* out; const int* rtok; const float* rw; int ntn; float sc;
    __device__ __forceinline__ void operator()(const f32x4 (&acc)[2][2][4][2], const Unit& u, int wr, int wc, int fr, int fq) const {
        const int row0 = u.pm * BM + wr * 64 + fr, c0 = (u.pn % ntn) * 256 + wc * 32 + 8 * fq;
#pragma unroll
        for (int ai = 0; ai < 2; ++ai)
#pragma unroll
            for (int mh = 0; mh < 2; ++mh) {
                int tok[2]; float w[2]; f32x4 x[2][2][2];
#pragma unroll
                for (int mm = 0; mm < 2; ++mm) { const int row = row0 + ai * HALF + (2 * mh + mm) * 16; tok[mm] = rtok[row]; w[mm] = rw[row] * sc; }
#pragma unroll
                for (int mm = 0; mm < 2; ++mm)
#pragma unroll
                    for (int bj = 0; bj < 2; ++bj) { const float* o = out + (size_t)(tok[mm] >= 0 ? tok[mm] : 0) * DM + c0 + bj * HALF; x[mm][bj][0] = *(const f32x4*)o; x[mm][bj][1] = *(const f32x4*)(o + 4); }
#pragma unroll
                for (int mm = 0; mm < 2; ++mm)
#pragma unroll
                    for (int bj = 0; bj < 2; ++bj) if (tok[mm] >= 0) { const int m = 2 * mh + mm; float* o = out + (size_t)tok[mm] * DM + c0 + bj * HALF;
                        *(f32x4*)o = x[mm][bj][0] + acc[ai][bj][m][0] * w[mm]; *(f32x4*)(o + 4) = x[mm][bj][1] + acc[ai][bj][m][1] * w[mm]; }
            }
    }
};

constexpr int MT_KS = 7, MT_K = EXPERT_FF / MT_KS;
struct MoeTailOrder {
    int nN, pm0, nsub, G, c, e0, e1, e2, e3, e4, e5, e6;
    __device__ void init(const MoeOrder& m, int pm0_, int ntiles, int G_, int c_) { nN = m.nN; pm0 = pm0_; nsub = ntiles * MT_KS; G = G_; c = c_; e0 = m.e0; e1 = m.e1; e2 = m.e2; e3 = m.e3; e4 = m.e4; e5 = m.e5; e6 = m.e6; }
    __device__ bool next(int i, Unit& u) const { const int L = i * G + c; if (L >= nsub) return false;
        const int j = L / MT_KS, ks = L - j * MT_KS, pm = pm0 + j / nN, pl = j % nN, e = (pm >= e0) + (pm >= e1) + (pm >= e2) + (pm >= e3) + (pm >= e4) + (pm >= e5) + (pm >= e6);
        u.pm = rfl(pm); u.pn = rfl((e * nN + pl) | (ks << 16)); return true; }
    __device__ __forceinline__ void a_ready(const Unit&) const {}
    __device__ __forceinline__ void done(const Unit&) const {}
};
struct EpiPart {
    static constexpr bool PERM = true, AFTER_DRAIN = false;
    float* part; int pm0, nN;
    __device__ __forceinline__ void operator()(const f32x4 (&acc)[2][2][4][2], const Unit& u, int wr, int wc, int fr, int fq) const {
        const int slot = ((u.pm - pm0) * nN + (u.pn & 0xffff) % nN) * MT_KS + (u.pn >> 16);
        float* b = part + (size_t)slot * 65536 + (size_t)(((wr * 4 + wc) * 64 + fq * 16 + fr) * 4);
#pragma unroll
        for (int ai = 0; ai < 2; ++ai)
#pragma unroll
            for (int bj = 0; bj < 2; ++bj)
#pragma unroll
                for (int m = 0; m < 4; ++m)
#pragma unroll
                    for (int n = 0; n < 2; ++n) *(f32x4*)(b + (((ai * 2 + bj) * 4 + m) * 2 + n) * 2048) = acc[ai][bj][m][n];
    }
};
__device__ __forceinline__ void moe_tail_combine(const EpiMoeDown& E, const MoeOrder& mo, const float* part, int pm0, int job, int lane_in) {
    int lane = lane_in; asm volatile("" : "+v"(lane));
    const int q = job & 3, role = (job >> 2) & 7, j = job >> 5, ai = q >> 1, mh = q & 1, pm = pm0 + j / mo.nN, pl = j % mo.nN, wr = role >> 2, wc = role & 3, fr = lane & 15, fq = lane >> 4;
    const float* b = part + (size_t)j * MT_KS * 65536 + (size_t)((role * 64 + lane) * 4);
    f32x4 a[2][2][2];
#pragma unroll
    for (int mm = 0; mm < 2; ++mm)
#pragma unroll
        for (int bj = 0; bj < 2; ++bj)
#pragma unroll
            for (int n = 0; n < 2; ++n) a[mm][bj][n] = *(const f32x4*)(b + (((ai * 2 + bj) * 4 + 2 * mh + mm) * 2 + n) * 2048);
#pragma unroll
    for (int ks = 1; ks < MT_KS; ++ks)
#pragma unroll
        for (int mm = 0; mm < 2; ++mm)
#pragma unroll
            for (int bj = 0; bj < 2; ++bj)
#pragma unroll
                for (int n = 0; n < 2; ++n) a[mm][bj][n] += *(const f32x4*)(b + (size_t)ks * 65536 + (((ai * 2 + bj) * 4 + 2 * mh + mm) * 2 + n) * 2048);
    const int row0 = pm * BM + wr * 64 + fr + ai * HALF + 2 * mh * 16, c0 = pl * 256 + wc * 32 + 8 * fq;
#pragma unroll
    for (int mm = 0; mm < 2; ++mm) { const int tok = E.rtok[row0 + mm * 16]; const float w = E.rw[row0 + mm * 16] * E.sc;
        if (tok >= 0) {
#pragma unroll
            for (int bj = 0; bj < 2; ++bj) { float* o = E.out + (size_t)tok * DM + c0 + bj * HALF; const f32x4 x0 = *(const f32x4*)o, x1 = *(const f32x4*)(o + 4);
                *(f32x4*)o = x0 + a[mm][bj][0] * w; *(f32x4*)(o + 4) = x1 + a[mm][bj][1] * w; } } }
}

typedef short bf16x8_t __attribute__((ext_vector_type(8)));
#define MFMA16(a, b, c) __builtin_amdgcn_mfma_f32_16x16x32_bf16((a), (b), (c), 0, 0, 0)
constexpr float ATT_C = 0.125f * 1.4426950408889634f;
constexpr int AW_IMP = 0, AW_SEL = 8448, AW_QS = 8960, AW_BYTES = 8960 + 8192;
__device__ __forceinline__ float bperm_f(float v, int srclane) { return __builtin_bit_cast(float, __builtin_amdgcn_ds_bpermute(srclane << 2, __builtin_bit_cast(int, v))); }
__device__ __forceinline__ int bperm_i(int v, int srclane) { return __builtin_amdgcn_ds_bpermute(srclane << 2, v); }
__device__ __forceinline__ bf16x8_t ldg8(const bf16* p) { return *(const bf16x8_t*)p; }
__device__ __forceinline__ bf16x8_t pack_p(const f32x4& a, const f32x4& b) {
    v4u w; w.x = cvt_pk_bf16(a[0], a[1]); w.y = cvt_pk_bf16(a[2], a[3]); w.z = cvt_pk_bf16(b[0], b[1]); w.w = cvt_pk_bf16(b[2], b[3]); return __builtin_bit_cast(bf16x8_t, w); }

__device__ __forceinline__ void nsa_attn_item(const P& p, int item, int lane, LAS unsigned char* wl) {
    const bf16* KV = WSP(bf16, AR_KV); const bf16* KC = WSP(bf16, AR_KC); const bf16* VcT = WSP(bf16, AR_VCT); const bf16* VsT = WSP(bf16, WS_VST); const bf16* VwT = WSP(bf16, WS_VWT);
    bf16* QB = WSP(bf16, AR_QB); const float* NG = WSP(float, AR_NG);
    const int bg = item / (SEQ / 16), t0 = (item % (SEQ / 16)) * 16, b = bg >> 1, g = bg & 1;
    const int col = lane & 15, fq = lane >> 4, tok = t0 + col;
    const size_t grow = (size_t)b * SEQ + tok;
    LAS float* IMP = (LAS float*)(wl + AW_IMP); LAS int* SEL = (LAS int*)(wl + AW_SEL); LAS bf16* OS = (LAS bf16*)(wl + AW_IMP);
    const int krowA = 8 * (col >> 2) + (col & 3);
    const float* gate = NG + grow * 24 + g * 12;
    LAS bf16x8_t* QS = (LAS bf16x8_t*)(wl + AW_QS) + lane;
#pragma unroll
    for (int hh = 0; hh < 4; ++hh)
#pragma unroll
        for (int ks = 0; ks < 2; ++ks) QS[(hh * 2 + ks) * 64] = ldg8(QB + grow * LDQ + (g * 4 + hh) * 64 + ks * 32 + fq * 8);
#define Qc(hh, ks) (QS[((hh) * 2 + (ks)) * 64])
    for (int i = lane; i < 16 * 132; i += 64) IMP[i] = 0.f;
    const f32x4 z4 = {0.f, 0.f, 0.f, 0.f};
    f32x4 O[4][4];
    int nvmax = (t0 + 15 >= 31) ? (((t0 + 15 - 31) >> 4) + 1) : 0; if (nvmax > NC) nvmax = NC;
    const int nch = (nvmax + 31) >> 5;
    const bf16* kcb = KC + (size_t)bg * 512 * 64; const bf16* vcb = VcT + (size_t)bg * 64 * 512;
    float linv[4] = {0.f, 0.f, 0.f, 0.f};
#pragma unroll
    for (int hh = 0; hh < 4; ++hh)
#pragma unroll
        for (int mt = 0; mt < 4; ++mt) O[hh][mt] = z4;
#pragma unroll 1
    for (int pass = 0; pass < 2; ++pass) {
#pragma unroll 1
        for (int ch = 0; ch < nch; ++ch) {
            asm volatile("" ::: "memory");
            const int k0 = 32 * ch; const bool cfull = 16 * (k0 + 31) + 31 <= t0;
            bf16x8_t ka[2][2];
#pragma unroll
            for (int tl = 0; tl < 2; ++tl)
#pragma unroll
                for (int ks = 0; ks < 2; ++ks) ka[tl][ks] = ldg8(kcb + ((size_t)(4 * ks + fq) * 512 + k0 + 16 * tl + col) * 8);
            bf16x8_t va[4];
            if (pass == 1) {
#pragma unroll
                for (int mt = 0; mt < 4; ++mt) va[mt] = ldg8(vcb + ((size_t)((k0 >> 3) + fq) * 64 + 16 * mt + col) * 8);
            }
            float ps[8] = {0.f, 0.f, 0.f, 0.f, 0.f, 0.f, 0.f, 0.f};
#pragma unroll
            for (int hh = 0; hh < 4; ++hh) {
                const bf16x8_t q0_ = Qc(hh, 0), q1_ = Qc(hh, 1);
                f32x4 sa = MFMA16(ka[0][0], q0_, z4); sa = MFMA16(ka[0][1], q1_, sa);
                f32x4 sb = MFMA16(ka[1][0], q0_, z4); sb = MFMA16(ka[1][1], q1_, sb);
#pragma unroll
                for (int i = 0; i < 4; ++i) { sa[i] = __builtin_amdgcn_exp2f(sa[i]); sb[i] = __builtin_amdgcn_exp2f(sb[i]); }
                if (!cfull) {
#pragma unroll
                    for (int i = 0; i < 4; ++i) { const int c = k0 + 4 * fq + i; sa[i] = (16 * c + 31 <= tok) ? sa[i] : 0.f; sb[i] = (16 * (c + 16) + 31 <= tok) ? sb[i] : 0.f; } }
                if (pass == 0) { linv[hh] += (sa[0] + sa[1]) + (sa[2] + sa[3]) + (sb[0] + sb[1]) + (sb[2] + sb[3]); }
                else {
#pragma unroll
                    for (int i = 0; i < 4; ++i) { ps[i] = __builtin_fmaf(sa[i], linv[hh], ps[i]); ps[4 + i] = __builtin_fmaf(sb[i], linv[hh], ps[4 + i]); }
                    const bf16x8_t pt = pack_p(sa, sb);
#pragma unroll
                    for (int mt = 0; mt < 4; ++mt) O[hh][mt] = MFMA16(va[mt], pt, O[hh][mt]);
                }
            }
            if (pass == 1) {
                const int Ga = 8 * ch + fq; LAS float* ir = IMP + col * 132 + Ga;
                __hip_atomic_fetch_add(ir, (ps[0] + ps[1]) + (ps[2] + ps[3]), __ATOMIC_RELAXED, __HIP_MEMORY_SCOPE_WORKGROUP);
                __hip_atomic_fetch_add(ir + 1, ps[3], __ATOMIC_RELAXED, __HIP_MEMORY_SCOPE_WORKGROUP);
                __hip_atomic_fetch_add(ir + 4, (ps[4] + ps[5]) + (ps[6] + ps[7]), __ATOMIC_RELAXED, __HIP_MEMORY_SCOPE_WORKGROUP);
                if (Ga + 5 < NS) __hip_atomic_fetch_add(ir + 5, ps[7], __ATOMIC_RELAXED, __HIP_MEMORY_SCOPE_WORKGROUP);
            }
        }
        if (pass == 0) {
#pragma unroll
            for (int hh = 0; hh < 4; ++hh) { float l = linv[hh]; l += bperm_f(l, lane ^ 16); l += bperm_f(l, lane ^ 32); linv[hh] = l > 0.f ? 1.f / l : 0.f; }
        }
    }
    LDS_WAIT(); asm volatile("" ::: "memory");
    {
        const int cur = tok >> 6; LAS float* sc = IMP + col * 132;
        for (int j = fq * 32; j < fq * 32 + 32; ++j) { const bool forced = (j == 0) || (j == cur) || (j == cur - 1); const float v = sc[j]; sc[j] = forced ? 1e4f : (j <= cur ? v : -1.f); }
        LDS_WAIT(); asm volatile("" ::: "memory");
#pragma unroll 1
        for (int r = 0; r < 8; ++r) {
            float bv = sc[fq * 32]; int bj = fq * 32;
            for (int j = fq * 32 + 1; j < fq * 32 + 32; ++j) { const float v = sc[j]; if (v > bv) { bv = v; bj = j; } }
#pragma unroll
            for (int o = 16; o <= 32; o <<= 1) { const float ov = bperm_f(bv, lane ^ o); const int oj = bperm_i(bj, lane ^ o); if (ov > bv || (ov == bv && oj < bj)) { bv = ov; bj = oj; } }
            if ((bj >> 5) == fq) sc[bj] = -3e38f;
            if (fq == 0) SEL[col * 8 + r] = bj;
            LDS_WAIT(); asm volatile("" ::: "memory");
        }
    }
#pragma unroll
    for (int hh = 0; hh < 4; ++hh) { const float g0 = gate[hh * 3 + 0] * linv[hh];
#pragma unroll
        for (int mt = 0; mt < 4; ++mt) { const f32x4 o = O[hh][mt] * g0; v2u w; w.x = cvt_pk_bf16(o[0], o[1]); w.y = cvt_pk_bf16(o[2], o[3]);
            *(LAS v2u*)(OS + (col * 4 + hh) * 64 + 16 * mt + 4 * fq) = w; } }
    LDS_WAIT(); asm volatile("" ::: "memory");
    const int cur = t0 >> 6;
    {
        const bf16* kwb = WSP(bf16, WS_KW8) + (size_t)bg * 8 * SEQ * 8; const bf16* vwb = VwT + (size_t)bg * 64 * SEQ;
        const bf16* ksb = WSP(bf16, WS_KS8) + (size_t)bg * 8 * SEQ * 8; const bf16* vsb = VsT + (size_t)bg * 64 * SEQ;
        int kst = t0 - (WINDOW - 1); if (kst < 0) kst = 0; kst &= ~31;
        const int nwin = ((t0 + 15 - kst) >> 5) + 1, nfb = cur >= 2 ? 3 : cur + 1;
#pragma unroll 1
        for (int part = 0; part < 2; ++part) {
            float lw[4] = {0.f, 0.f, 0.f, 0.f};
#pragma unroll
            for (int hh = 0; hh < 4; ++hh)
#pragma unroll
                for (int mt = 0; mt < 4; ++mt) O[hh][mt] = z4;
            const bf16* kb = part ? ksb : kwb; const bf16* vb = part ? vsb : vwb;
            const int nchk = part ? 2 * nfb : nwin;
#pragma unroll 1
            for (int ci = 0; ci < nchk; ++ci) {
                asm volatile("" ::: "memory");
                int k0;
                if (part == 0) k0 = kst + 32 * ci; else { const int fb = ci >> 1, j = fb == 0 ? 0 : (fb == 1 ? cur : cur - 1); k0 = 64 * j + 32 * (ci & 1); }
                bf16x8_t ka[2][2], va[4];
#pragma unroll
                for (int tl = 0; tl < 2; ++tl)
#pragma unroll
                    for (int ks = 0; ks < 2; ++ks) ka[tl][ks] = ldg8(kb + ((size_t)(4 * ks + fq) * SEQ + k0 + 16 * tl + col) * 8);
#pragma unroll
                for (int mt = 0; mt < 4; ++mt) va[mt] = ldg8(vb + ((size_t)((k0 >> 3) + fq) * 64 + 16 * mt + col) * 8);
                const int lowk = part ? -1 : tok - WINDOW; const bool dfull = (k0 + 31 <= t0) && (part || k0 > t0 + 15 - WINDOW);
#pragma unroll
                for (int hh = 0; hh < 4; ++hh) {
                    const bf16x8_t q0_ = Qc(hh, 0), q1_ = Qc(hh, 1);
                    f32x4 sa = MFMA16(ka[0][0], q0_, z4); sa = MFMA16(ka[0][1], q1_, sa);
                    f32x4 sb = MFMA16(ka[1][0], q0_, z4); sb = MFMA16(ka[1][1], q1_, sb);
#pragma unroll
                    for (int i = 0; i < 4; ++i) { sa[i] = __builtin_amdgcn_exp2f(sa[i]); sb[i] = __builtin_amdgcn_exp2f(sb[i]); }
                    if (!dfull) {
#pragma unroll
                        for (int i = 0; i < 4; ++i) { const int kt = k0 + 4 * fq + i; sa[i] = (kt <= tok && kt > lowk) ? sa[i] : 0.f; sb[i] = (kt + 16 <= tok && kt + 16 > lowk) ? sb[i] : 0.f; } }
                    lw[hh] += (sa[0] + sa[1]) + (sa[2] + sa[3]) + (sb[0] + sb[1]) + (sb[2] + sb[3]);
                    const bf16x8_t pt = pack_p(sa, sb);
#pragma unroll
                    for (int mt = 0; mt < 4; ++mt) O[hh][mt] = MFMA16(va[mt], pt, O[hh][mt]);
                }
            }
            LDS_WAIT(); asm volatile("" ::: "memory");
            if (part == 0) {
#pragma unroll
                for (int hh = 0; hh < 4; ++hh) { float l = lw[hh]; l += bperm_f(l, lane ^ 16); l += bperm_f(l, lane ^ 32); const float w = l > 0.f ? gate[hh * 3 + 2] / l : 0.f;
#pragma unroll
                    for (int mt = 0; mt < 4; ++mt) { LAS v2u* dp = (LAS v2u*)(OS + (col * 4 + hh) * 64 + 16 * mt + 4 * fq); const v2u old = *dp;
                        v2u w2; w2.x = cvt_pk_bf16(blo(old.x) + w * O[hh][mt][0], bhi(old.x) + w * O[hh][mt][1]); w2.y = cvt_pk_bf16(blo(old.y) + w * O[hh][mt][2], bhi(old.y) + w * O[hh][mt][3]); *dp = w2; } }
            } else {
                LAS bf16* OF = (LAS bf16*)(wl + AW_QS); LAS float* LF = (LAS float*)(wl + AW_IMP + 8192);
#pragma unroll
                for (int hh = 0; hh < 4; ++hh) { float l = lw[hh]; l += bperm_f(l, lane ^ 16); l += bperm_f(l, lane ^ 32); if (fq == 0) LF[col * 4 + hh] = l;
#pragma unroll
                    for (int mt = 0; mt < 4; ++mt) { v2u w2; w2.x = cvt_pk_bf16(O[hh][mt][0], O[hh][mt][1]); w2.y = cvt_pk_bf16(O[hh][mt][2], O[hh][mt][3]); *(LAS v2u*)(OF + (col * 4 + hh) * 64 + 16 * mt + 4 * fq) = w2; } }
            }
            LDS_WAIT(); asm volatile("" ::: "memory");
        }
    }
    {
        const bf16* ksb = WSP(bf16, WS_KS8) + (size_t)bg * 8 * SEQ * 8; const bf16* vsb = VsT + (size_t)bg * 64 * SEQ;
        const LAS bf16* OF = (const LAS bf16*)(wl + AW_QS); const LAS float* LF = (const LAS float*)(wl + AW_IMP + 8192);
#pragma unroll 1
        for (int tt = 0; tt < 16; ++tt) {
            const int tq = t0 + tt; const size_t qrow = (size_t)b * SEQ + tq;
            bf16x8_t Qh[2];
#pragma unroll
            for (int ks = 0; ks < 2; ++ks) { Qh[ks] = ldg8(QB + qrow * LDQ + (g * 4 + (col & 3)) * 64 + ks * 32 + fq * 8); if (col >= 4) Qh[ks] = (bf16x8_t){0, 0, 0, 0, 0, 0, 0, 0}; }
            f32x4 Os[4] = {z4, z4, z4, z4}; float ls = 0.f;
#ifdef APROBE_SEL
            for (int rp = 0; rp < 2; ++rp) { Os[0] = z4; Os[1] = z4; Os[2] = z4; Os[3] = z4; ls = 0.f; asm volatile("" ::: "memory");
#endif
#pragma unroll 1
            for (int r8 = 0; r8 < 8; ++r8) {
                const int j = __builtin_amdgcn_readfirstlane(SEL[tt * 8 + r8]);
                if (64 * j > tq || j == 0 || j == cur || j == cur - 1) continue;
                const int kb0 = 64 * j;
                bf16x8_t ka[2][2][2], va[2][4];
#pragma unroll
                for (int hf = 0; hf < 2; ++hf) {
#pragma unroll
                    for (int tl = 0; tl < 2; ++tl)
#pragma unroll
                        for (int ks = 0; ks < 2; ++ks) ka[hf][tl][ks] = ldg8(ksb + ((size_t)(4 * ks + fq) * SEQ + kb0 + 32 * hf + 16 * tl + col) * 8);
#pragma unroll
                    for (int mt = 0; mt < 4; ++mt) va[hf][mt] = ldg8(vsb + ((size_t)(((kb0 + 32 * hf) >> 3) + fq) * 64 + 16 * mt + col) * 8);
                }
#pragma unroll
                for (int hf = 0; hf < 2; ++hf) {
                    f32x4 sa = MFMA16(ka[hf][0][0], Qh[0], z4); sa = MFMA16(ka[hf][0][1], Qh[1], sa);
                    f32x4 sb = MFMA16(ka[hf][1][0], Qh[0], z4); sb = MFMA16(ka[hf][1][1], Qh[1], sb);
#pragma unroll
                    for (int i = 0; i < 4; ++i) { sa[i] = __builtin_amdgcn_exp2f(sa[i]); sb[i] = __builtin_amdgcn_exp2f(sb[i]); }
                    ls += (sa[0] + sa[1]) + (sa[2] + sa[3]) + (sb[0] + sb[1]) + (sb[2] + sb[3]);
                    const bf16x8_t pt = pack_p(sa, sb);
#pragma unroll
                    for (int mt = 0; mt < 4; ++mt) Os[mt] = MFMA16(va[hf][mt], pt, Os[mt]);
                }
            }
#ifdef APROBE_SEL
            }
#endif
            ls += bperm_f(ls, lane ^ 16); ls += bperm_f(ls, lane ^ 32);
            if (col < 4) {
                const float den = ls + LF[tt * 4 + col]; const float w = den > 0.f ? (NG + qrow * 24 + g * 12)[col * 3 + 1] / den : 0.f;
#pragma unroll
                for (int mt = 0; mt < 4; ++mt) { const int e = (tt * 4 + col) * 64 + 16 * mt + 4 * fq; const v2u old = *(const LAS v2u*)(OS + e), fo = *(const LAS v2u*)(OF + e);
                    v2u w2; w2.x = cvt_pk_bf16(blo(old.x) + w * (Os[mt][0] + blo(fo.x)), bhi(old.x) + w * (Os[mt][1] + bhi(fo.x))); w2.y = cvt_pk_bf16(blo(old.y) + w * (Os[mt][2] + blo(fo.y)), bhi(old.y) + w * (Os[mt][3] + bhi(fo.y)));
                    *(v2u*)(QB + qrow * LDQ + (g * 4 + col) * 64 + 16 * mt + 4 * fq) = w2; }
            }
        }
    }
    LDS_WAIT(); asm volatile("" ::: "memory");
#undef Qc
}

typedef _Float16 h16x2 __attribute__((ext_vector_type(2)));
__device__ __forceinline__ h16x2 as_h2(unsigned u) { h16x2 r; __builtin_memcpy(&r, &u, 4); return r; }
constexpr int SC_STEPS = 8, SC_BUF = 6 * 1024;
__device__ __forceinline__ float dpp_sum16(float v) {
    v += __builtin_bit_cast(float, __builtin_amdgcn_update_dpp(0, __builtin_bit_cast(int, v), 0xB1, 0xF, 0xF, true));
    v += __builtin_bit_cast(float, __builtin_amdgcn_update_dpp(0, __builtin_bit_cast(int, v), 0x4E, 0xF, 0xF, true));
    v += __builtin_bit_cast(float, __builtin_amdgcn_update_dpp(0, __builtin_bit_cast(int, v), 0x141, 0xF, 0xF, true));
    v += __builtin_bit_cast(float, __builtin_amdgcn_update_dpp(0, __builtin_bit_cast(int, v), 0x140, 0xF, 0xF, true));
    return v;
}
__device__ __forceinline__ void scan_fill(const bf16* RW, const bf16* Wm, const bf16* Am, size_t trow, int h, int lane, LAS unsigned char* buf) {
    const size_t t = trow + (lane >> 3); const int sub = (lane & 7) * 8;
    const bf16* row = RW + t * LDRW + h * 64 + sub;
    __builtin_amdgcn_global_load_lds((const unsigned*)(row + LBLK), (LAS unsigned*)(buf + 0 * 1024), 16, 0, 0);
    __builtin_amdgcn_global_load_lds((const unsigned*)(Am + t * RC + h * 64 + sub), (LAS unsigned*)(buf + 1 * 1024), 16, 0, 0);
    __builtin_amdgcn_global_load_lds((const unsigned*)(Wm + t * RC + h * 64 + sub), (LAS unsigned*)(buf + 2 * 1024), 16, 0, 0);
    __builtin_amdgcn_global_load_lds((const unsigned*)(row + 512), (LAS unsigned*)(buf + 3 * 1024), 16, 0, 0);
    __builtin_amdgcn_global_load_lds((const unsigned*)(row), (LAS unsigned*)(buf + 4 * 1024), 16, 0, 0);
    __builtin_amdgcn_global_load_lds((const unsigned*)(row + 1024), (LAS unsigned*)(buf + 5 * 1024), 16, 0, 0);
}
__device__ __forceinline__ void scan_unit(const P& p, int unit, int lane, LAS unsigned char* wl) {
    const bf16* RW = WSP(bf16, AR_RW); const bf16* Wm = WSP(bf16, AR_W); const bf16* Am = WSP(bf16, AR_A); bf16* Y = WSP(bf16, AR_UB);
    const int rg = unit & 15, h = (unit >> 4) & 7, b = unit >> 7, row = rg * 4 + (lane >> 4), kq = lane & 15;
    const size_t tb = (size_t)b * SEQ;
    float s0 = 0.f, s1 = 0.f, s2 = 0.f, s3 = 0.f;
    __builtin_amdgcn_s_setprio(3);
    scan_fill(RW, Wm, Am, tb, h, lane, wl);
#pragma unroll 1
    for (int c = 0; c < SEQ / SC_STEPS; ++c) {
        LAS unsigned char* buf = wl + (c & 1) * SC_BUF;
        asm volatile("s_waitcnt vmcnt(0) lgkmcnt(0)" ::: "memory");
        if (c + 1 < SEQ / SC_STEPS) scan_fill(RW, Wm, Am, tb + (size_t)(c + 1) * SC_STEPS, h, lane, wl + ((c + 1) & 1) * SC_BUF);
#ifndef SCAN_VARB
        float ys[SC_STEPS];
#pragma unroll
        for (int st = 0; st < SC_STEPS; ++st) {
            const LAS unsigned char* o = buf + st * 128 + kq * 8;
            const v2u kkw = *(const LAS v2u*)(o), bbw = *(const LAS v2u*)(o + 1024), eew = *(const LAS v2u*)(o + 2048), ktw = *(const LAS v2u*)(o + 3072), rrw = *(const LAS v2u*)(o + 4096);
#ifdef SCAN_BF16
            struct F2 { float x, y; }; const F2 kk0{blo(kkw.x), bhi(kkw.x)}, kk1{blo(kkw.y), bhi(kkw.y)}, bb0{blo(bbw.x), bhi(bbw.x)}, bb1{blo(bbw.y), bhi(bbw.y)}, ee0{blo(eew.x), bhi(eew.x)}, ee1{blo(eew.y), bhi(eew.y)}, kt0{blo(ktw.x), bhi(ktw.x)}, kt1{blo(ktw.y), bhi(ktw.y)}, rr0{blo(rrw.x), bhi(rrw.x)}, rr1{blo(rrw.y), bhi(rrw.y)};
            const float vv = bf2f(*(const LAS unsigned short*)(buf + 5 * 1024 + st * 128 + row * 2));
#else
            const h16x2 kk0 = as_h2(kkw.x), kk1 = as_h2(kkw.y), bb0 = as_h2(bbw.x), bb1 = as_h2(bbw.y);
            const h16x2 ee0 = as_h2(eew.x), ee1 = as_h2(eew.y);
#ifdef RKV_BF16
            struct F2 { float x, y; }; const F2 kt0{blo(ktw.x), bhi(ktw.x)}, kt1{blo(ktw.y), bhi(ktw.y)}, rr0{blo(rrw.x), bhi(rrw.x)}, rr1{blo(rrw.y), bhi(rrw.y)};
            const float vv = bf2f(*(const LAS unsigned short*)(buf + 5 * 1024 + st * 128 + row * 2));
#else
            const h16x2 kt0 = as_h2(ktw.x), kt1 = as_h2(ktw.y);
            const h16x2 rr0 = as_h2(rrw.x), rr1 = as_h2(rrw.y);
            const float vv = (float)__builtin_bit_cast(_Float16, *(const LAS unsigned short*)(buf + 5 * 1024 + st * 128 + row * 2));
#endif
#endif
            float d0 = __builtin_fmaf(s0, (float)kk0.x, 0.f); d0 = __builtin_fmaf(s1, (float)kk0.y, d0); float d1 = __builtin_fmaf(s2, (float)kk1.x, 0.f); d1 = __builtin_fmaf(s3, (float)kk1.y, d1);
            const float nskk = -dpp_sum16(d0 + d1);
            s0 = __builtin_fmaf(s0, -(float)ee0.x, s0); s1 = __builtin_fmaf(s1, -(float)ee0.y, s1); s2 = __builtin_fmaf(s2, -(float)ee1.x, s2); s3 = __builtin_fmaf(s3, -(float)ee1.y, s3);
            s0 = __builtin_fmaf(nskk, (float)bb0.x, s0); s1 = __builtin_fmaf(nskk, (float)bb0.y, s1); s2 = __builtin_fmaf(nskk, (float)bb1.x, s2); s3 = __builtin_fmaf(nskk, (float)bb1.y, s3);
            s0 = __builtin_fmaf(vv, (float)kt0.x, s0); s1 = __builtin_fmaf(vv, (float)kt0.y, s1); s2 = __builtin_fmaf(vv, (float)kt1.x, s2); s3 = __builtin_fmaf(vv, (float)kt1.y, s3);
            float y0 = __builtin_fmaf(s0, (float)rr0.x, 0.f); y0 = __builtin_fmaf(s1, (float)rr0.y, y0); float y1 = __builtin_fmaf(s2, (float)rr1.x, 0.f); y1 = __builtin_fmaf(s3, (float)rr1.y, y1);
            ys[st] = dpp_sum16(y0 + y1);
        }
        if (kq < SC_STEPS) { float yv = ys[0];
#pragma unroll
            for (int st = 1; st < SC_STEPS; ++st) yv = (kq == st) ? ys[st] : yv;
            Y[(tb + (size_t)c * SC_STEPS + kq) * RC + h * 64 + row] = f2bf(yv); }
    }
#else
#pragma unroll
        for (int st = 0; st < SC_STEPS; ++st) {
            const LAS unsigned char* o = buf + st * 128 + kq * 8;
            float kk[4], bb[4], ee[4], kt[4], rr[4];
            { const v2u w = *(const LAS v2u*)(o); const h16x2 a = as_h2(w.x), b2 = as_h2(w.y); kk[0] = (float)a.x; kk[1] = (float)a.y; kk[2] = (float)b2.x; kk[3] = (float)b2.y; }
            { const v2u w = *(const LAS v2u*)(o + 1024); const h16x2 a = as_h2(w.x), b2 = as_h2(w.y); bb[0] = (float)a.x; bb[1] = (float)a.y; bb[2] = (float)b2.x; bb[3] = (float)b2.y; }
            { const v2u w = *(const LAS v2u*)(o + 2048); const h16x2 a = as_h2(w.x), b2 = as_h2(w.y); ee[0] = (float)a.x; ee[1] = (float)a.y; ee[2] = (float)b2.x; ee[3] = (float)b2.y; }
            { const v2u w = *(const LAS v2u*)(o + 3072); const h16x2 a = as_h2(w.x), b2 = as_h2(w.y); kt[0] = (float)a.x; kt[1] = (float)a.y; kt[2] = (float)b2.x; kt[3] = (float)b2.y; }
            { const v2u w = *(const LAS v2u*)(o + 4096); const h16x2 a = as_h2(w.x), b2 = as_h2(w.y); rr[0] = (float)a.x; rr[1] = (float)a.y; rr[2] = (float)b2.x; rr[3] = (float)b2.y; }
            const float vv = (float)__builtin_bit_cast(_Float16, *(const LAS unsigned short*)(buf + 5 * 1024 + st * 128 + row * 2));
            const float skk = dpp_sum16((s0 * kk[0] + s1 * kk[1]) + (s2 * kk[2] + s3 * kk[3]));
            s0 = s0 - s0 * ee[0] - skk * bb[0] + vv * kt[0]; s1 = s1 - s1 * ee[1] - skk * bb[1] + vv * kt[1]; s2 = s2 - s2 * ee[2] - skk * bb[2] + vv * kt[2]; s3 = s3 - s3 * ee[3] - skk * bb[3] + vv * kt[3];
            const float y = dpp_sum16((s0 * rr[0] + s1 * rr[1]) + (s2 * rr[2] + s3 * rr[3]));
            if (kq == 0) Y[(tb + (size_t)c * SC_STEPS + st) * RC + h * 64 + row] = f2bf(y);
        }
    }
#endif
    asm volatile("s_waitcnt vmcnt(0) lgkmcnt(0)" ::: "memory");
    __builtin_amdgcn_s_setprio(0);
}
__device__ __forceinline__ float sum8(float v) {
    v += __builtin_bit_cast(float, __builtin_amdgcn_update_dpp(0, __builtin_bit_cast(int, v), 0xB1, 0xF, 0xF, true));
    v += __builtin_bit_cast(float, __builtin_amdgcn_update_dpp(0, __builtin_bit_cast(int, v), 0x4E, 0xF, 0xF, true));
    v += __builtin_bit_cast(float, __builtin_amdgcn_update_dpp(0, __builtin_bit_cast(int, v), 0x141, 0xF, 0xF, true));
    return v;
}
__device__ __forceinline__ void up8(v4u w, float* f) { f[0] = blo(w.x); f[1] = bhi(w.x); f[2] = blo(w.y); f[3] = bhi(w.y); f[4] = blo(w.z); f[5] = bhi(w.z); f[6] = blo(w.w); f[7] = bhi(w.w); }
#ifdef SCAN_BF16
#define uph8 up8
#define pkh8 pk8
#else
#define uph8 uph8_
#define pkh8 pkh8_
#endif
__device__ __forceinline__ void uph8_(v4u w, float* f) { const h16x2 a = as_h2(w.x), b = as_h2(w.y), c = as_h2(w.z), d = as_h2(w.w);
    f[0] = (float)a.x; f[1] = (float)a.y; f[2] = (float)b.x; f[3] = (float)b.y; f[4] = (float)c.x; f[5] = (float)c.y; f[6] = (float)d.x; f[7] = (float)d.y; }
__device__ __forceinline__ unsigned pkh2(float lo, float hi) { h16x2 v; v.x = (_Float16)lo; v.y = (_Float16)hi; return __builtin_bit_cast(unsigned, v); }
__device__ __forceinline__ v4u pkh8_(const float* f) { v4u w; w.x = pkh2(f[0], f[1]); w.y = pkh2(f[2], f[3]); w.z = pkh2(f[4], f[5]); w.w = pkh2(f[6], f[7]); return w; }
__device__ __forceinline__ v4u pk8(const float* f) { v4u w; w.x = cvt_pk_bf16(f[0], f[1]); w.y = cvt_pk_bf16(f[2], f[3]); w.z = cvt_pk_bf16(f[4], f[5]); w.w = cvt_pk_bf16(f[6], f[7]); return w; }
__device__ __forceinline__ void ldf8(const float* p, float* f) { const f32x4 a = *(const f32x4*)p, b = *(const f32x4*)(p + 4); f[0] = a[0]; f[1] = a[1]; f[2] = a[2]; f[3] = a[3]; f[4] = b[0]; f[5] = b[1]; f[6] = b[2]; f[7] = b[3]; }

struct EpiLora {
    static constexpr bool PERM = true, AFTER_DRAIN = false;
    unsigned char* ws;
    __device__ __forceinline__ void operator()(const f32x4 (&acc)[2][2][4][2], const Unit& u, int wr, int wc, int fr, int fq) const {
        const int which = u.pn >> 1, row0 = u.pm * BM + wr * 64 + fr, c0 = (u.pn & 1) * 256 + wc * 32 + 8 * fq;
        bf16* const O = (bf16*)(ws + (which == 0 ? AR_W : (which == 1 ? AR_A : (which == 2 ? AR_G : AR_UB))));
#pragma unroll
        for (int ai = 0; ai < 2; ++ai)
#pragma unroll
            for (int m = 0; m < 4; ++m)
#pragma unroll
                for (int bj = 0; bj < 2; ++bj) *(u32x4*)(O + (size_t)(row0 + ai * HALF + m * 16) * RC + c0 + bj * HALF) = pack8(acc[ai][bj][m][0], acc[ai][bj][m][1]);
    }
};
#ifdef RKV_BF16
#define UPR up8
#define PKR pk8
#else
#define UPR uph8
#define PKR pkh8
#endif
struct B2In { v4u k, a, w, vr, vv, vf; float gt; };
__device__ __forceinline__ void b2w_load(B2In& in, const P& p, int layer, int t, int lane) {
    const bf16* row = WSP(bf16, AR_RW) + (size_t)t * LDRW;
    in.k = *(const v4u*)(row + 512 + 8 * lane); in.a = *(const v4u*)(WSP(bf16, AR_A) + (size_t)t * RC + 8 * lane); in.w = *(const v4u*)(WSP(bf16, AR_W) + (size_t)t * RC + 8 * lane);
    in.gt = lane < 24 ? bf2f(row[LBLK + 320 + lane]) : 0.f;
    if (layer == 1) { in.vr = *(const v4u*)(WSP(bf16, AR_UB) + (size_t)t * RC + 8 * lane); in.vv = *(const v4u*)(row + 1024 + 8 * lane); in.vf = *(const v4u*)(WSP(bf16, WS_VF) + (size_t)t * RC + 8 * lane); }
}
__device__ __forceinline__ void b2w_compute(const B2In& in, const P& p, int layer, int t, int lane, const float* v0, const float* v1, const float* v2, const float* v3, const float* vb) {
    bf16* row = WSP(bf16, AR_RW) + (size_t)t * LDRW; bf16* Am = WSP(bf16, AR_A); bf16* Wm = WSP(bf16, AR_W); float* NG = WSP(float, AR_NG);
    float k[8], a[8], w[8]; uph8(in.k, k); up8(in.a, a); up8(in.w, w);
    const float ngv = fsig(in.gt);
    float kk[8], ss = 0.f;
#pragma unroll
    for (int i = 0; i < 8; ++i) {
        a[i] = fsig(a[i] + v1[i]);
        const float nx = -(w[i] + v0[i]), sp = fmaxf(nx, 0.f) + __logf(1.f + __expf(-fabsf(nx))), e = __expf(-sp - 0.5f); w[i] = 1.f - __expf(-e);
        kk[i] = k[i] * v2[i]; ss += kk[i] * kk[i]; }
    ss = sum8(ss); const float nrm = sqrtf(ss), inv = 1.f / (nrm > 1e-12f ? nrm : 1e-12f);
#pragma unroll
    for (int i = 0; i < 8; ++i) { kk[i] *= inv; k[i] = k[i] * (1.f + (a[i] - 1.f) * v3[i]); a[i] *= kk[i]; }
    asm volatile("" :: "v"(ngv));
    if (layer == 1) { float vr[8], vv[8], vf[8]; up8(in.vr, vr); uph8(in.vv, vv); uph8(in.vf, vf);
#pragma unroll
        for (int i = 0; i < 8; ++i) vv[i] = vv[i] + (vf[i] - vv[i]) * fsig(vr[i] + vb[i]);
        *(v4u*)(row + 1024 + 8 * lane) = pkh8(vv); }
    if (lane < 24) NG[(size_t)t * 24 + lane] = ngv;
    *(v4u*)(row + LBLK + 8 * lane) = pkh8(kk); *(v4u*)(row + 512 + 8 * lane) = pkh8(k);
    *(v4u*)(Am + (size_t)t * RC + 8 * lane) = pkh8(a); *(v4u*)(Wm + (size_t)t * RC + 8 * lane) = pkh8(w);
}
__device__ __forceinline__ void ph_rwkv_b2w(const P& p, int layer, int gw, int NGW, int lane) {
    const float* vec = p.rwkv_vec + (size_t)layer * 7 * RC; float v0[8], v1[8], v2[8], v3[8], vb[8];
    ldf8(vec + 8 * lane, v0); ldf8(vec + RC + 8 * lane, v1); ldf8(vec + 2 * RC + 8 * lane, v2); ldf8(vec + 3 * RC + 8 * lane, v3); ldf8(p.vres_b + 8 * lane, vb);
    int t = gw; if (t >= T) return;
    B2In A, B; b2w_load(A, p, layer, t, lane);
    for (; t < T; t += 2 * NGW) { const int t1 = t + NGW, t2 = t1 + NGW;
        b2w_load(B, p, layer, t1 < T ? t1 : t, lane); b2w_compute(A, p, layer, t, lane, v0, v1, v2, v3, vb);
        if (t1 < T) { b2w_load(A, p, layer, t2 < T ? t2 : t1, lane); b2w_compute(B, p, layer, t1, lane, v0, v1, v2, v3, vb); } }
}
struct PoIn { v4u y, r, k, v, g; };
__device__ __forceinline__ void post_load(PoIn& in, const P& p, int t, int lane) { const bf16* row = WSP(bf16, AR_RW) + (size_t)t * LDRW;
    in.y = *(const v4u*)(WSP(bf16, AR_UB) + (size_t)t * RC + 8 * lane); in.r = *(const v4u*)(row + 8 * lane); in.k = *(const v4u*)(row + 512 + 8 * lane); in.v = *(const v4u*)(row + 1024 + 8 * lane); in.g = *(const v4u*)(WSP(bf16, AR_G) + (size_t)t * RC + 8 * lane); }
__device__ __forceinline__ void post_compute(const PoIn& in, const P& p, int t, int lane, const float* v4_, const float* v5, const float* v6) {
    float y[8], r[8], k[8], v[8], g[8]; up8(in.y, y); uph8(in.r, r); uph8(in.k, k); uph8(in.v, v); up8(in.g, g);
    float s = 0.f, bon = 0.f;
#pragma unroll
    for (int i = 0; i < 8; ++i) { s += y[i]; bon += r[i] * k[i] * v4_[i]; }
    const float m = sum8(s) * (1.f / 64.f); bon = sum8(bon);
    float q = 0.f;
#pragma unroll
    for (int i = 0; i < 8; ++i) { y[i] -= m; q += y[i] * y[i]; }
    const float rstd = 1.f / sqrtf(sum8(q) * (1.f / 64.f) + GN_EPS);
#pragma unroll
    for (int i = 0; i < 8; ++i) y[i] = (y[i] * rstd * v5[i] + v6[i] + bon * v[i]) * g[i];
    *(v4u*)(WSP(bf16, AR_A) + (size_t)t * RC + 8 * lane) = pk8(y);
}
__device__ __forceinline__ void ph_rwkv_postw(const P& p, int layer, int gw, int NGW, int lane) {
    const float* vec = p.rwkv_vec + (size_t)layer * 7 * RC; float v4_[8], v5[8], v6[8]; ldf8(vec + 4 * RC + 8 * lane, v4_); ldf8(vec + 5 * RC + 8 * lane, v5); ldf8(vec + 6 * RC + 8 * lane, v6);
    int t = gw; if (t >= T) return;
    PoIn A, B; post_load(A, p, t, lane);
    for (; t < T; t += 2 * NGW) { const int t1 = t + NGW, t2 = t1 + NGW;
        post_load(B, p, t1 < T ? t1 : t, lane); post_compute(A, p, t, lane, v4_, v5, v6);
        if (t1 < T) { post_load(A, p, t2 < T ? t2 : t1, lane); post_compute(B, p, t1, lane, v4_, v5, v6); } }
}
typedef float f32x2 __attribute__((ext_vector_type(2)));
__device__ __forceinline__ f32x2 up2(unsigned w) { f32x2 r; r.x = __builtin_bit_cast(float, w << 16); r.y = __builtin_bit_cast(float, w & 0xffff0000u); return r; }
__device__ __forceinline__ void ph_convw(const P& p, int layer, int gw, int NGW, int lane, int tid, LAS unsigned char* lds) {
    const bf16* UB = WSP(bf16, AR_UB); bf16* CO = WSP(bf16, AR_CO);
    const float* cw = p.conv_w + (size_t)layer * CONV_K * CONV_CH; const float* cv = p.conv_vec + (size_t)layer * 3 * CONV_CH;
    LAS float* wl = (LAS float*)lds;
    for (int i = tid; i < CONV_K * CONV_CH; i += NTHREADS) wl[i] = cw[i];
    for (int i = tid; i < 3 * CONV_CH; i += NTHREADS) wl[CONV_K * CONV_CH + i] = cv[i];
    __syncthreads();
    const LAS float* wlane = wl + 8 * lane;
    for (int tb = gw * 8; tb < T; tb += NGW * 8) {
        const int pos0 = tb % SEQ, j0 = pos0 >= 30 ? 0 : 30 - pos0;
        const bf16* ub = UB + ((size_t)tb * CONV_CH + 8 * lane) - (size_t)30 * CONV_CH;
        f32x2 a[8][4], wt[8][4]; v4u cur[8];
        { const f32x4 c0 = *(const LAS f32x4*)(wlane + CONV_K * CONV_CH), c1 = *(const LAS f32x4*)(wlane + CONV_K * CONV_CH + 4);
#pragma unroll
          for (int q = 0; q < 8; ++q) { a[q][0] = (f32x2){c0.x, c0.y}; a[q][1] = (f32x2){c0.z, c0.w}; a[q][2] = (f32x2){c1.x, c1.y}; a[q][3] = (f32x2){c1.z, c1.w}; } }
#pragma unroll
        for (int jj = 0; jj < 8; ++jj) cur[jj] = jj >= j0 ? *(const v4u*)(ub + (size_t)jj * CONV_CH) : (v4u){0u, 0u, 0u, 0u};
#pragma unroll 1
        for (int g = 0; g < 5; ++g) {
#pragma unroll
            for (int jj = 0; jj < 8; ++jj) { const int j = 8 * g + jj;
                if (j < CONV_K) { const f32x4 w0 = *(const LAS f32x4*)(wlane + j * CONV_CH), w1 = *(const LAS f32x4*)(wlane + j * CONV_CH + 4);
                    wt[jj][0] = (f32x2){w0.x, w0.y}; wt[jj][1] = (f32x2){w0.z, w0.w}; wt[jj][2] = (f32x2){w1.x, w1.y}; wt[jj][3] = (f32x2){w1.z, w1.w}; }
                f32x2 u[4]; u[0] = up2(cur[jj].x); u[1] = up2(cur[jj].y); u[2] = up2(cur[jj].z); u[3] = up2(cur[jj].w);
                if (j + 8 < CONV_K + 7) cur[jj] = j + 8 >= j0 ? *(const v4u*)(ub + (size_t)(j + 8) * CONV_CH) : (v4u){0u, 0u, 0u, 0u};
#pragma unroll
                for (int q = 0; q < 8; ++q) { const int tap = j - q; if (tap >= 0 && tap < CONV_K) {
#pragma unroll
                    for (int i = 0; i < 4; ++i) a[q][i] = __builtin_elementwise_fma(u[i], wt[(jj - q) & 7][i], a[q][i]); } }
            }
        }
        const f32x4 g10 = *(const LAS f32x4*)(wlane + (CONV_K + 1) * CONV_CH), g11 = *(const LAS f32x4*)(wlane + (CONV_K + 1) * CONV_CH + 4);
        const f32x4 b20 = *(const LAS f32x4*)(wlane + (CONV_K + 2) * CONV_CH), b21 = *(const LAS f32x4*)(wlane + (CONV_K + 2) * CONV_CH + 4);
        const f32x2 g1[4] = {(f32x2){g10.x, g10.y}, (f32x2){g10.z, g10.w}, (f32x2){g11.x, g11.y}, (f32x2){g11.z, g11.w}}, b2[4] = {(f32x2){b20.x, b20.y}, (f32x2){b20.z, b20.w}, (f32x2){b21.x, b21.y}, (f32x2){b21.z, b21.w}};
#pragma unroll
        for (int q = 0; q < 8; ++q) {
            const f32x2 s2 = (a[q][0] + a[q][1]) + (a[q][2] + a[q][3]);
            const float mean = wave_sum(s2.x + s2.y, lane) * (1.f / CONV_CH); f32x2 q2 = (f32x2){0.f, 0.f};
#pragma unroll
            for (int i = 0; i < 4; ++i) { a[q][i] -= (f32x2){mean, mean}; q2 = __builtin_elementwise_fma(a[q][i], a[q][i], q2); }
            const float rstd = 1.f / sqrtf(wave_sum(q2.x + q2.y, lane) * (1.f / CONV_CH) + LN_EPS);
            float y[8];
#pragma unroll
            for (int i = 0; i < 4; ++i) { const f32x2 yy = __builtin_elementwise_fma(a[q][i] * (f32x2){rstd, rstd}, g1[i], b2[i]); y[2 * i] = yy.x * fsig(yy.x); y[2 * i + 1] = yy.y * fsig(yy.y); }
            *(v4u*)(CO + (size_t)(tb + q) * CONV_CH + 8 * lane) = pk8(y);
        }
    }
    __syncthreads();
}
__device__ __forceinline__ void ph_cmp2w(const P& p, int layer, int gw, int NGW, int lane, LAS float* hl  ) {
    const bf16* Z = WSP(bf16, AR_HID); const float* pec = (const float*)(p.ws + WS_W + (size_t)layer * SZ_LAYERW + OFF_PEC);
    for (int it = gw; it < 2 * BATCH * NKV * NC; it += NGW) {
        const int i = it % NC, r = it / NC, bg = r % (BATCH * NKV), which = r / (BATCH * NKV);
        const bf16* z1 = Z + ((size_t)which * (BATCH * NKV * 512) + (size_t)bg * 512 + i) * 256; const bf16* z2 = z1 + 256 + 128;
#pragma unroll
        for (int jj = 0; jj < 2; ++jj) { const int j = lane + 64 * jj; const float x = bf2f(z1[j]) + bf2f(z2[j]) + pec[which * 128 + j];
            const float e = __expf(fminf(2.f * 0.7978845608028654f * (x + 0.044715f * x * x * x), 30.f)); hl[j] = 0.5f * x * (1.f + (e - 1.f) / (e + 1.f)); }
        LDS_WAIT(); asm volatile("" ::: "memory");
        const float* w2 = p.cmp_w2 + (size_t)(layer * 2 + which) * 128 * 64 + lane; float o = 0.f;
#pragma unroll 8
        for (int j = 0; j < 128; ++j) o += hl[j] * w2[j * 64];
        if (which == 0) {
            const float rs = 1.f / sqrtf(wave_sum(o * o, lane) * (1.f / 64.f) + RMS_EPS); o = o * rs * p.qk_g[(layer * 4 + 1) * 64 + lane];
            const float other = bperm_f(o, lane ^ 32); float cs, sn; rope_cs(16 * i + 31, lane & 31, cs, sn);
            o = lane < 32 ? o * cs - other * sn : o * cs + other * sn;
            WSP(bf16, AR_KC)[(((size_t)bg * 8 + (lane >> 3)) * 512 + i) * 8 + (lane & 7)] = f2bf(o);
        } else { bf16* vt = WSP(bf16, AR_VCT) + (size_t)bg * 64 * 512 + lane * 8;
            vt[(size_t)((i >> 5) * 4 + ((i & 15) >> 2)) * 512 + (i & 3) + 4 * ((i >> 4) & 1)] = f2bf(o); if (i == 0) vt[(size_t)((NC >> 5) * 4 + ((NC & 15) >> 2)) * 512 + (NC & 3) + 4 * ((NC >> 4) & 1)] = 0; }
        LDS_WAIT(); asm volatile("" ::: "memory");
    }
}

struct MapPlain { bf16* base; int K; __device__ __forceinline__ bf16* operator()(int col) const { return base + (size_t)col * K; } };
struct MapGlu { bf16* base; int K, ff; __device__ __forceinline__ bf16* operator()(int col) const { return base + (size_t)glu_dest(col, ff) * K; } };
struct MapWin { unsigned char* wl; int layer; __device__ __forceinline__ bf16* operator()(int col) const { int which; const int r = win_dest(col, layer, which); const size_t off = (which ? OFF_WG : OFF_WIN) + (size_t)(r < 0 ? 0 : r) * DM * 2; return r < 0 ? nullptr : (bf16*)(wl + off); } };
template <class Map>
__device__ __forceinline__ void transpose_item(const float* W, int K, int N, const Map& mp, LAS float* scr, int item, int lane) {
    const int nblk = (N + 31) / 32, kb = item / nblk, nb = item % nblk, k0 = 64 * kb, n0 = 32 * nb;
    const int c4 = 4 * (lane & 7), col = n0 + c4;
    f32x4 v[8];
#pragma unroll
    for (int i = 0; i < 8; ++i) v[i] = col < N ? *(const f32x4*)(W + (size_t)(k0 + (lane >> 3) + 8 * i) * N + col) : (f32x4){0.f, 0.f, 0.f, 0.f};
#pragma unroll
    for (int i = 0; i < 8; ++i) { LAS float* d = scr + ((lane >> 3) + 8 * i) * 33 + c4; d[0] = v[i].x; d[1] = v[i].y; d[2] = v[i].z; d[3] = v[i].w; }
    LDS_WAIT(); asm volatile("" ::: "memory");
    const int c = lane & 7;
#pragma unroll
    for (int j = 0; j < 4; ++j) { const int n = (lane >> 3) + 8 * j; const LAS float* s = scr + (8 * c) * 33 + n;
        v4u o; o.x = (unsigned)f2bf(s[0]) | ((unsigned)f2bf(s[33]) << 16); o.y = (unsigned)f2bf(s[66]) | ((unsigned)f2bf(s[99]) << 16);
        o.z = (unsigned)f2bf(s[132]) | ((unsigned)f2bf(s[165]) << 16); o.w = (unsigned)f2bf(s[198]) | ((unsigned)f2bf(s[231]) << 16);
        if (n0 + n < N) { bf16* d = mp(n0 + n); if (d) *(v4u*)(d + k0 + 8 * c) = o; } }
    LDS_WAIT(); asm volatile("" ::: "memory");
}
template <class Map>
__device__ __forceinline__ bool conv_job(int& r, const float* W, int K, int N, const Map& mp, LAS float* scr, int lane) {
    const int items = (K / 64) * ((N + 31) / 32);
    if (r < items) { transpose_item(W, K, N, mp, scr, r, lane); return true; }
    r -= items; return false;
}

struct RmsIn { f32x4 v[DM / 256]; };
__device__ __forceinline__ void rms_load(RmsIn& r, const float* xrow, int lane) { const f32x4* xr = (const f32x4*)xrow + lane;
#pragma unroll
    for (int j = 0; j < DM / 256; ++j) r.v[j] = xr[64 * j]; }
__device__ __forceinline__ void rms_row(const P& p, const RmsIn& rin, const float* g, bf16* orow, int lane, bool route, int t, unsigned long long& c0, unsigned long long& c1) {
    const f32x4* gr = (const f32x4*)g + lane;
    f32x4 v[DM / 256]; float ss = 0.f;
#pragma unroll
    for (int j = 0; j < DM / 256; ++j) { v[j] = rin.v[j]; ss += (v[j].x * v[j].x + v[j].y * v[j].y) + (v[j].z * v[j].z + v[j].w * v[j].w); }
    const float rs = 1.f / sqrtf(wave_sum(ss, lane) * (1.f / DM) + RMS_EPS);
    v2u* o8 = (v2u*)orow + lane;
#pragma unroll
    for (int j = 0; j < DM / 256; ++j) { const f32x4 gg = gr[64 * j]; v[j].x *= rs * gg.x; v[j].y *= rs * gg.y; v[j].z *= rs * gg.z; v[j].w *= rs * gg.w;
        v2u w; w.x = cvt_pk_bf16(v[j].x, v[j].y); w.y = cvt_pk_bf16(v[j].z, v[j].w); o8[64 * j] = w; }
    if (route) {
        float lg[NEXP];
#pragma unroll
        for (int e = 0; e < NEXP; ++e) lg[e] = 0.f;
#pragma unroll
        for (int j = 0; j < DM / 256; ++j) { const float* rw = p.router_w + (size_t)(4 * (lane + 64 * j)) * NEXP;
#pragma unroll
            for (int e = 0; e < NEXP; ++e) lg[e] += v[j].x * rw[e] + v[j].y * rw[NEXP + e] + v[j].z * rw[2 * NEXP + e] + v[j].w * rw[3 * NEXP + e]; }
#pragma unroll
        for (int e = 0; e < NEXP; ++e) lg[e] = wave_sum(lg[e], lane) + p.router_b[e];
        int e0 = 0; float l0 = lg[0];
#pragma unroll
        for (int e = 1; e < NEXP; ++e) if (lg[e] > l0) { l0 = lg[e]; e0 = e; }
        int e1 = -1; float l1 = -3e38f;
#pragma unroll
        for (int e = 0; e < NEXP; ++e) if (e != e0 && lg[e] > l1) { l1 = lg[e]; e1 = e; }
        e0 = __builtin_amdgcn_readfirstlane(e0); e1 = __builtin_amdgcn_readfirstlane(e1);
        const int r0 = (int)((c0 >> (8 * e0)) & 255ull), r1 = (int)((c1 >> (8 * e1)) & 255ull);
        c0 += 1ull << (8 * e0); c1 += 1ull << (8 * e1);
        if (lane == 0) { const float w0 = 1.f / (1.f + expf(l1 - l0));
            WSP(int, AR_RTE)[t] = e0 | (e1 << 8) | (r0 << 16) | (r1 << 24); float* rw = WSP(float, AR_RTW) + (size_t)t * 2; rw[0] = w0; rw[1] = 1.f - w0; }
    }
}
__device__ __forceinline__ void copy_rows4(const bf16* s0, const bf16* s1, const bf16* s2, const bf16* s3, bf16* d0, bf16* d1, bf16* d2, bf16* d3, int lane) {
    v4u a[4][DM / 512];
#pragma unroll
    for (int j = 0; j < DM / 512; ++j) { a[0][j] = ((const v4u*)s0)[lane + 64 * j]; a[1][j] = ((const v4u*)s1)[lane + 64 * j]; a[2][j] = ((const v4u*)s2)[lane + 64 * j]; a[3][j] = ((const v4u*)s3)[lane + 64 * j]; }
#pragma unroll
    for (int j = 0; j < DM / 512; ++j) { ((v4u*)d0)[lane + 64 * j] = a[0][j]; ((v4u*)d1)[lane + 64 * j] = a[1][j]; ((v4u*)d2)[lane + 64 * j] = a[2][j]; ((v4u*)d3)[lane + 64 * j] = a[3][j]; }
}
__device__ __forceinline__ void copy_row_wave(const bf16* src, bf16* dst, int lane) {
#pragma unroll
    for (int j = 0; j < DM / 512; ++j) ((v4u*)dst)[lane + 64 * j] = ((const v4u*)src)[lane + 64 * j];
}
__device__ __forceinline__ int moe_seg_start(const unsigned* cnt, int e) { int s = 0;
#pragma unroll
    for (int k = 0; k < NEXP; ++k) s += (k < e) ? (int)((cnt[k] + 255u) & ~255u) : 0;
    return s; }

#ifndef PHMASK
#define PHMASK 0xFFFFFFFFu
#endif
#define PHM(k) (((PHMASK) >> (k)) & 1u)
#ifdef PROBE_LO
constexpr int PR_LO = PROBE_LO, PR_HI = PROBE_HI;
#else
constexpr int PR_LO = -1, PR_HI = -1;
#endif
constexpr int NPH = 16, NPHASES = 1 + 2 * NPH;
struct Args { const float* in[29]; float* out; unsigned char* ws; int ph_lo, ph_hi; };

__device__ __forceinline__ bool in_phase(int k, int lo, int hi) { asm volatile("" : "+s"(lo), "+s"(hi)); return lo <= k && k < hi; }
typedef const Args __attribute__((address_space(4)))* CArgsP;
__device__ __forceinline__ void fill_params_k(P& p, CArgsP a) {
    p.x = a->in[0]; p.mix_norm_g = a->in[1]; p.w_in_first = a->in[2]; p.w_in_rest = a->in[3]; p.mu_first = a->in[4]; p.mu_rest = a->in[5]; p.qk_g = a->in[6]; p.cmp_pos = a->in[7];
    p.cmp_w1 = a->in[8]; p.cmp_w2 = a->in[9]; p.nsa_w_o = a->in[10]; p.conv_w = a->in[11]; p.conv_vec = a->in[12]; p.conv_w_o = a->in[13]; p.rwkv_vec = a->in[14]; p.w_up = a->in[15];
    p.a_up = a->in[16]; p.g_up = a->in[17]; p.vres_up = a->in[18]; p.vres_b = a->in[19]; p.rwkv_w_o = a->in[20]; p.w_out = a->in[21]; p.ffn_norm_g = a->in[22]; p.dense_gu = a->in[23];
    p.dense_down = a->in[24]; p.router_w = a->in[25]; p.router_b = a->in[26]; p.moe_gu = a->in[27]; p.moe_down = a->in[28]; p.out = a->out; p.ws = a->ws;
}
__global__ void __launch_bounds__(NTHREADS, 2) mk_fwd(Args args) {
    extern __shared__ __attribute__((aligned(16))) unsigned char lds_raw[];
    LAS unsigned char* lds = (LAS unsigned char*)lds_raw;
    const int wave0 = __builtin_amdgcn_readfirstlane((int)threadIdx.x >> 6);
    const int tid = wave0 * 64 + lane_id_opaque();
    unsigned* ctl = (unsigned*)(args.ws + WS_CTL);
    for (int u = tid; u < (LDS_BYTES - LDSCTL_OFF) / 4; u += NTHREADS) ((LAS unsigned*)(lds + LDSCTL_OFF))[u] = 0u;
    __syncthreads();
    const int lo = args.ph_lo, hi = args.ph_hi;
    XcdBarrier bar; bar.bar = ctl + CW_BAR; bar.x = 0; bar.st = nullptr;
    if (hi - lo > 1) { bar.x = xb_xcc_id(); bar.st = (volatile LAS unsigned*)(lds + MISC_OFF) + 8; if (tid == 0) (void)xb_add(ctl + CW_BAR + XB_XCNT(bar.x), 1u); }
#define RMS_LOOP(X, GN, ROUTE, C0, C1) do { int m_ = gw; if (m_ < T) { RmsIn ra_, rb_; rms_load(ra_, (X) + (size_t)m_ * DM, lane); \
        for (; m_ < T; m_ += 2 * NGW) { const int m1_ = m_ + NGW, m2_ = m1_ + NGW; rms_load(rb_, (X) + (size_t)(m1_ < T ? m1_ : m_) * DM, lane); \
            rms_row(p, ra_, (GN), WSP(bf16, WS_H) + (size_t)m_ * DM, lane, (ROUTE), m_, C0, C1); \
            if (m1_ < T) { rms_load(ra_, (X) + (size_t)(m2_ < T ? m2_ : m1_) * DM, lane); rms_row(p, rb_, (GN), WSP(bf16, WS_H) + (size_t)m1_ * DM, lane, (ROUTE), m1_, C0, C1); } } } } while (0)
#define IN(k) (in_phase((k), lo, hi) && (PR_LO < 0 || (st == 0 ? (k) <= PR_HI : (st == 1 ? ((k) >= PR_LO && (k) <= PR_HI) : (k) > PR_HI))))
#define MKP unsigned long long cdum0 = 0ull, cdum1 = 0ull; (void)cdum0; (void)cdum1; CArgsP ap_ = (CArgsP)__builtin_amdgcn_kernarg_segment_ptr(); asm volatile("" : "+s"(ap_)); P p; fill_params_k(p, ap_); int w0_ = wave0; asm volatile("" : "+s"(w0_)); int tid = w0_ * 64 + lane_id_opaque(); asm volatile("" : "+v"(tid)); const int lane = tid & 63, wave = __builtin_amdgcn_readfirstlane(tid >> 6); int G = gridDim.x, bid = blockIdx.x; asm volatile("" : "+s"(G), "+s"(bid)); unsigned* ctl = WSP(unsigned, WS_CTL); const long gtid = (long)bid * NTHREADS + tid, NT = (long)G * NTHREADS; const int gw = bid * NWAVES + wave, NGW = G * NWAVES; LAS float* scrw = (LAS float*)(lds + wave * 16384); (void)gtid; (void)NT; (void)gw; (void)NGW; (void)scrw; (void)lane; (void)ctl
#ifdef PROBE_TK
#define TKW(i) do { if (blockIdx.x == PROBE_BLK && threadIdx.x == 0) ((unsigned long long*)(args.ws + WS_CTL + 4 * CW_TK))[(i)] = __builtin_amdgcn_s_memrealtime(); } while (0)
#define TKP(i) do { if (layer == PROBE_LAYER) TKW(i); } while (0)
#define SEAM(k) do { if ((k) + 1 < hi) { int w_ = wave0; asm volatile("" : "+s"(w_)); xcd_barrier(bar, w_ * 64 + lane_id_opaque()); } \
    if ((k) == PROBE_TK) TKW(1); if ((k) == PROBE_TK - 1) TKW(0); } while (0)
#else
#define TKP(i) do { } while (0)
#define SEAM(k) do { if ((k) + 1 < hi) { int w_ = wave0; asm volatile("" : "+s"(w_)); xcd_barrier(bar, w_ * 64 + lane_id_opaque()); } } while (0)
#endif

    for (int st = 0; st < (PR_LO >= 0 ? 3 : 1); ++st) {
    if (PHM(16) && IN(0)) { MKP;
        constexpr int IT_WIN0 = (DM / 64) * ((N_IN_FIRST + 31) / 32), IT_WIN1 = (DM / 64) * ((N_IN_REST + 31) / 32), IT_WO = (512 / 64) * (DM / 32), IT_WOUT = (DM / 64) * (DM / 32);
        constexpr int total = IT_WIN0 + IT_WIN1 + 6 * IT_WO + 2 * IT_WOUT + (DM / 64) * (2 * DENSE_FF / 32) + (DENSE_FF / 64) * (DM / 32);
        bf16* wl0 = WSP(bf16, WS_W); bf16* wl1 = WSP(bf16, WS_W + SZ_LAYERW);
#define WOFF(b, o) ((bf16*)((unsigned char*)(b) + (o)))
        for (int it = gw; it < total; it += NGW) {
            int r = it;
            if (conv_job(r, p.w_in_first, DM, N_IN_FIRST, MapWin{(unsigned char*)wl0, 0}, scrw, lane)) continue;
            if (conv_job(r, p.w_in_rest, DM, N_IN_REST, MapWin{(unsigned char*)wl1, 1}, scrw, lane)) continue;
            if (conv_job(r, p.nsa_w_o, 512, DM, MapPlain{WOFF(wl0, OFF_WO3), 512}, scrw, lane)) continue;
            if (conv_job(r, p.rwkv_w_o, 512, DM, MapPlain{WOFF(wl0, OFF_WO3) + (size_t)DM * 512, 512}, scrw, lane)) continue;
            if (conv_job(r, p.conv_w_o, 512, DM, MapPlain{WOFF(wl0, OFF_WO3) + (size_t)2 * DM * 512, 512}, scrw, lane)) continue;
            if (conv_job(r, p.nsa_w_o + (size_t)512 * DM, 512, DM, MapPlain{WOFF(wl1, OFF_WO3), 512}, scrw, lane)) continue;
            if (conv_job(r, p.rwkv_w_o + (size_t)512 * DM, 512, DM, MapPlain{WOFF(wl1, OFF_WO3) + (size_t)DM * 512, 512}, scrw, lane)) continue;
            if (conv_job(r, p.conv_w_o + (size_t)512 * DM, 512, DM, MapPlain{WOFF(wl1, OFF_WO3) + (size_t)2 * DM * 512, 512}, scrw, lane)) continue;
            if (conv_job(r, p.w_out, DM, DM, MapPlain{WOFF(wl0, OFF_WOUT), DM}, scrw, lane)) continue;
            if (conv_job(r, p.w_out + (size_t)DM * DM, DM, DM, MapPlain{WOFF(wl1, OFF_WOUT), DM}, scrw, lane)) continue;
            if (conv_job(r, p.dense_gu, DM, 2 * DENSE_FF, MapGlu{WSP(bf16, WS_DGU), DM, DENSE_FF}, scrw, lane)) continue;
            conv_job(r, p.dense_down, DENSE_FF, DM, MapPlain{WSP(bf16, WS_DDN), DENSE_FF}, scrw, lane);
        }
        for (int l = 0; l < 2; ++l) {
            unsigned char* wlb = p.ws + WS_W + (size_t)l * SZ_LAYERW;
            bf16* win = (bf16*)(wlb + OFF_WIN);
            for (long i = gtid; i < 512L * DM; i += NT) { const int w = (int)(i / DM); const bool src = w < 288 || (w < 320 && l == 1) || (w >= 320 && w < 344); if (!src) win[(size_t)(3840 + w) * DM + i % DM] = 0; }
            bf16* lw = (bf16*)(wlb + OFF_LW);
            for (long i = gtid; i < 2048L * 384; i += NT) { const int n = (int)(i / 384), k = (int)(i % 384), blk = n >> 9, c = n & 511; float v = 0.f;
                if (blk == 0 && k < 64) v = p.w_up[((size_t)l * 64 + k) * RC + c]; else if (blk == 1 && k >= 64 && k < 128) v = p.a_up[((size_t)l * 64 + k - 64) * RC + c];
                else if (blk == 2 && k >= 128 && k < 288) v = p.g_up[((size_t)l * 160 + k - 128) * RC + c]; else if (blk == 3 && k >= 288 && k < 320 && l == 1) v = p.vres_up[(size_t)(k - 288) * RC + c];
                lw[i] = f2bf(v); }
            bf16* cw1 = (bf16*)(wlb + OFF_CW1);
            for (long i = gtid; i < 2L * 256 * 1024; i += NT) { const int k = (int)(i % 1024), n = (int)((i / 1024) % 256), which = (int)(i / (256 * 1024));
                cw1[i] = f2bf(p.cmp_w1[((size_t)(l * 2 + which) * 2048 + (n < 128 ? k : 1024 + k)) * 128 + (n & 127)]); }
        }
        for (int job = bid; job < 4; job += G) { const int l = job >> 1, which = job & 1;
            const float* pe = p.cmp_pos + (size_t)(l * 2 + which) * 2048; const float* w1 = p.cmp_w1 + (size_t)(l * 2 + which) * 2048 * 128 + 2 * lane;
            float s0 = 0.f, s1 = 0.f;
#pragma unroll 8
            for (int k = wave * 256; k < wave * 256 + 256; ++k) { const float2 wv = *(const float2*)(w1 + (size_t)k * 128); const float pk = pe[k]; s0 += pk * wv.x; s1 += pk * wv.y; }
            scrw[2 * lane] = s0; scrw[2 * lane + 1] = s1;
            __syncthreads();
            if (tid < 128) { float sum = 0.f;
#pragma unroll
                for (int w = 0; w < NWAVES; ++w) sum += ((const LAS float*)(lds + w * 16384))[tid];
                ((float*)(p.ws + WS_W + (size_t)l * SZ_LAYERW + OFF_PEC))[which * 128 + tid] = sum; }
            __syncthreads();
        }
    }

    for (int layer = 0; layer < 2; ++layer) {
        const int pb = 1 + layer * NPH;
        if (PHM(0) && IN(pb + 0)) { MKP;
            const float* xin = layer == 0 ? p.x : p.out;
            RMS_LOOP(xin, p.mix_norm_g + (size_t)layer * DM, false, cdum0, cdum1);
            SEAM(pb + 0);
        }
        if (PHM(1) && IN(pb + 1)) { MKP;
            Gemm g{WSP(bf16, WS_H), (const bf16*)(p.ws + WS_W + (size_t)layer * SZ_LAYERW + OFF_WIN), T, NPROJ, DM}; SOrder S; S.init(T, NPROJ, G, bid);
            EpiProj E{p.ws};
            pg8::gemm_phase<EpiProj, SOrder, true, true>(lds, g, S, E, tid);
            SEAM(pb + 1);
        }
        if (PHM(2) && IN(pb + 2)) { MKP;
            { Gemm g{WSP(bf16, AR_CKV), (const bf16*)(p.ws + WS_W + (size_t)layer * SZ_LAYERW + OFF_CW1), 2 * BATCH * NKV * 512, 512, 1024, 0}; StackOrder S{BATCH * NKV * 512 / 256, 1, 2, G, bid};
              EpiStore E{WSP(bf16, AR_HID), 256, 1};
              pg8::gemm_phase<EpiStore, StackOrder, true, true>(lds, g, S, E, tid); }
            TKP(2); ph_shift(p, layer, gtid, NT); TKP(3); ph_nsa_prep(p, layer, gtid, NT); TKP(4); ph_vtrans(p, gtid, NT); TKP(5);
            ph_convw(p, layer, gw, NGW, lane, tid, lds); TKP(6);
#ifdef APROBE_CONV
            ph_convw(p, layer, gw, NGW, lane, tid, lds);
#endif
#ifdef APROBE_VT
            ph_vtrans(p, gtid, NT);
#endif
            SEAM(pb + 2); }
        if (PHM(3) && IN(pb + 3)) { MKP;
#ifndef LORA_NAIVE
            { Gemm g{WSP(bf16, WS_LB), (const bf16*)(p.ws + WS_W + (size_t)layer * SZ_LAYERW + OFF_LW), T, 2048, 384, 0}; SOrder S; S.init(T, 2048, G, bid);
              EpiLora E{p.ws};
              pg8::gemm_phase<EpiLora, SOrder, false, true>(lds, g, S, E, tid); }
#else
            { bf16* RW = WSP(bf16, AR_RW); bf16* Wm = WSP(bf16, AR_W); bf16* Am = WSP(bf16, AR_A); bf16* Gm = WSP(bf16, AR_G); const bf16* VF = WSP(bf16, WS_VF);
              const float* vec = p.rwkv_vec + (size_t)layer * 7 * RC; const float* wup = p.w_up + (size_t)layer * 64 * RC; const float* aup = p.a_up + (size_t)layer * 64 * RC; const float* gup = p.g_up + (size_t)layer * 160 * RC;
              for (long it = gtid; it < (long)T * RC; it += NT) { const int t = (int)(it / RC), c = (int)(it % RC); bf16* row = RW + (size_t)t * LDRW; const bf16* L = row + LBLK;
                  float wl = vec[c], alin = vec[RC + c], g = 0.f;
                  for (int j = 0; j < 64; ++j) { wl += bf2f(L[j]) * bf2f(f2bf(wup[j * RC + c])); alin += bf2f(L[64 + j]) * bf2f(f2bf(aup[j * RC + c])); }
                  for (int j = 0; j < 160; ++j) g += bf2f(L[128 + j]) * bf2f(f2bf(gup[j * RC + c]));
                  const float nx = -wl, sp = fmaxf(nx, 0.f) + __logf(1.f + __expf(-fabsf(nx))), e = __expf(-sp - 0.5f);
                  Wm[it] = f2bf(1.f - __expf(-e)); Am[it] = f2bf(fsig(alin)); Gm[it] = f2bf(g);
                  if (layer == 1) { float vl = p.vres_b[c]; for (int j = 0; j < 32; ++j) vl += bf2f(L[288 + j]) * bf2f(f2bf(p.vres_up[j * RC + c]));
                      const float v = bf2f(row[1024 + c]), vf = bf2f(VF[it]); row[1024 + c] = f2bf(v + (vf - v) * fsig(vl)); } } }
#endif
            SEAM(pb + 3); }
        if (PHM(4) && IN(pb + 4)) { MKP; ph_rwkv_b2w(p, layer, gw, NGW, lane); ph_cmp2w(p, layer, gw, NGW, lane, (LAS float*)(lds + wave * 512)); SEAM(pb + 4); }
        if (PHM(5) && IN(pb + 5)) { MKP;
            { LAS unsigned char* wl = lds + wave * AW_BYTES; constexpr int NSC = BATCH * 8 * 16, NIT = BATCH * NKV * (SEQ / 16);
#ifndef SCAN_QUEUE
              if (wave < 4) {
                  if (G * 4 == NSC && (G & 7) == 0) scan_unit(p, (bid & 7) * (NSC / 8) + (bid >> 3) * 4 + wave, lane, wl);
                  else for (int u = bid * 4 + wave; u < NSC; u += G * 4) scan_unit(p, u, lane, wl); }
#endif
#ifdef APROBE_SPLIT
              xcd_barrier(bar, tid);
#endif
              const int xme = (int)(xb_xcc_id() & 7u);
              for (int qq = 0; qq < 8; ++qq) { const int qx = (xme + qq) & 7; unsigned* head = ctl + CW_ATT + ((layer * 3 + st) * 8 + qx) * 16;
                  for (;;) { int it = 0; if (lane == 0) it = (int)atomicAdd(head, 1u); it = __builtin_amdgcn_readfirstlane(it); if (it >= NIT / 8) break;
                      const int bg = 2 * qx + it / (SEQ / 16), t16 = (SEQ / 16 - 1) - it % (SEQ / 16);
                      nsa_attn_item(p, bg * (SEQ / 16) + t16, lane, wl); } } }
 SEAM(pb + 5); }
        if (PHM(6) && IN(pb + 6)) { MKP; ph_rwkv_postw(p, layer, gw, NGW, lane); SEAM(pb + 6); }
        if (PHM(7) && IN(pb + 7)) { MKP;
            Gemm g{WSP(bf16, AR_QB), (const bf16*)(p.ws + WS_W + (size_t)layer * SZ_LAYERW + OFF_WO3), 3 * T, 3 * DM, 512}; StackOrder S{T / 256, DM / 256, 3, G, bid};
            EpiStore E{WSP(bf16, AR_OBUF), DM, DM / 256};
            pg8::gemm_phase<EpiStore, StackOrder, true, true>(lds, g, S, E, tid);
            { MKP; const float* xin = layer == 0 ? p.x : p.out;
              RMS_LOOP(xin, p.mix_norm_g + (size_t)layer * DM, false, cdum0, cdum1); }
            SEAM(pb + 7);
        }
        if (PHM(8) && IN(pb + 8)) { MKP;
            Gemm g{WSP(bf16, WS_H), (const bf16*)(p.ws + WS_W + (size_t)layer * SZ_LAYERW + OFF_WG), T, 3 * DM, DM}; GateOrder S{T / 256, DM / 256, G, bid};
            EpiGate E{p.ws, DM / 256};
            pg8::gemm_phase<EpiGate, GateOrder, true, true>(lds, g, S, E, tid);
            SEAM(pb + 8);
        }
        if (PHM(9) && IN(pb + 9)) { MKP;
            Gemm g{WSP(bf16, AR_MIX), (const bf16*)(p.ws + WS_W + (size_t)layer * SZ_LAYERW + OFF_WOUT), T, DM, DM}; SOrder S; S.init(T, DM, G, bid);
            EpiResid E{layer == 0 ? p.x : p.out, p.out};
            pg8::gemm_phase<EpiResid, SOrder, true, true>(lds, g, S, E, tid);
            SEAM(pb + 9);
        }
        if (PHM(10) && IN(pb + 10)) { MKP;
            unsigned long long c0 = 0ull, c1 = 0ull;
            RMS_LOOP(p.out, p.ffn_norm_g + (size_t)layer * DM, layer == 1, c0, c1);
            if (layer == 1 && lane < 16) {
                const unsigned cn = (unsigned)(((lane < 8 ? c0 : c1) >> (8 * (lane & 7))) & 255ull);
                WSP(unsigned, AR_WBASE)[(size_t)gw * 16 + lane] = atomicAdd(ctl + CW_CNT + lane * 64, cn); }
            if (layer == 1) { int* rt = WSP(int, AR_RTOK); for (long i = gtid; i < 2L * MOE_ROWS; i += NT) rt[i] = -1; }
            SEAM(pb + 10);
        }
        if (layer == 0) {
            if (PHM(11) && IN(pb + 11)) { MKP;
                Gemm g{WSP(bf16, WS_H), WSP(bf16, WS_DGU), T, 2 * DENSE_FF, DM}; SOrder S; S.init(T, 2 * DENSE_FF, G, bid);
                EpiSwiglu E{WSP(bf16, AR_ACT), DENSE_FF, 2 * DENSE_FF / 256};
                pg8::gemm_phase<EpiSwiglu, SOrder, true, true>(lds, g, S, E, tid);
                SEAM(pb + 11);
            }
            if (PHM(12) && IN(pb + 12)) { MKP;
                Gemm g{WSP(bf16, AR_ACT), WSP(bf16, WS_DDN), T, DM, DENSE_FF}; SOrder S; S.init(T, DM, G, bid);
                EpiResid E{p.out, p.out};
                pg8::gemm_phase<EpiResid, SOrder, true, true>(lds, g, S, E, tid);
                SEAM(pb + 12);
            }
        } else {
            if (PHM(11) && IN(pb + 11)) { MKP;
                const int ig = (DM / 64) * (2 * EXPERT_FF / 32), id = (EXPERT_FF / 64) * (DM / 32);
                for (int it = gw; it < NEXP * (ig + id); it += NGW) { const int e = it / (ig + id); int r = it % (ig + id);
                    if (conv_job(r, p.moe_gu + (size_t)e * DM * 2 * EXPERT_FF, DM, 2 * EXPERT_FF, MapGlu{WSP(bf16, AR_MGU) + (size_t)e * 2 * EXPERT_FF * DM, DM, EXPERT_FF}, scrw, lane)) continue;
                    conv_job(r, p.moe_down + (size_t)e * EXPERT_FF * DM, EXPERT_FF, DM, MapPlain{WSP(bf16, AR_MDN) + (size_t)e * DM * EXPERT_FF, EXPERT_FF}, scrw, lane); }
                int* rtok = WSP(int, AR_RTOK); float* rww = WSP(float, AR_RW8); int* trow = WSP(int, AR_TROW);
                int segv = 0; { const int pc = lane < 16 ? (int)((ctl[CW_CNT + lane * 64] + 255u) & ~255u) : 0;
#pragma unroll
                    for (int k = 0; k < 8; ++k) { const int ck = bperm_i(pc, (lane & 8) + k); segv += (k < (lane & 7)) ? ck : 0; } }
                for (int hb = gw; hb < 2 * (T / 64); hb += NGW) {
                    const int tb = (hb >> 1) * 64, half = hb & 1, t = tb + lane; const int ee = WSP(int, AR_RTE)[t], e0 = ee & 255, e1 = (ee >> 8) & 255, r0 = (ee >> 16) & 255, r1 = (ee >> 24) & 255;
                    const float* w = WSP(float, AR_RTW) + (size_t)t * 2; const unsigned* wb = WSP(unsigned, AR_WBASE) + (size_t)(t % NGW) * 16;
                    const int row0 = bperm_i(segv, e0) + (int)wb[e0] + r0, row1 = bperm_i(segv, 8 + e1) + (int)wb[8 + e1] + r1;
                    if (half == 0) { rtok[row0] = t; rww[row0] = w[0]; rtok[MOE_ROWS + row1] = t; rww[MOE_ROWS + row1] = w[1]; trow[T + t] = row1; }
                    for (int l = 32 * half; l < 32 * half + 32; l += 4) { const bf16* hs = WSP(bf16, WS_H) + (size_t)(tb + l) * DM; bf16* xg = WSP(bf16, AR_XG);
                        copy_rows4(hs, hs + DM, hs + 2 * DM, hs + 3 * DM, xg + (size_t)__builtin_amdgcn_readlane(row0, l) * DM, xg + (size_t)__builtin_amdgcn_readlane(row0, l + 1) * DM, xg + (size_t)__builtin_amdgcn_readlane(row0, l + 2) * DM, xg + (size_t)__builtin_amdgcn_readlane(row0, l + 3) * DM, lane); }
                }
                SEAM(pb + 11);
            }
#pragma unroll
            for (int pass = 0; pass < 2; ++pass) {
                if (PHM(12) && IN(pb + 12 + 2 * pass)) { MKP;
                    Gemm g{WSP(bf16, AR_XG), WSP(bf16, AR_MGU), MOE_ROWS, NEXP * 2 * EXPERT_FF, DM}; MoeOrder S; S.init(ctl + CW_CNT + 8 * 64 * pass, 2 * EXPERT_FF / 256, G, bid);
                    EpiSwiglu E{WSP(bf16, AR_MACT), EXPERT_FF, 2 * EXPERT_FF / 256};
                    if (pass == 1) {
                        MoeOrder S0; S0.init(ctl + CW_CNT, DM / 256, G, bid); const int nwg = S0.s.nwg, mainw = (nwg / G) * G, ttiles = nwg - mainw;
                        if (bar.st != nullptr && (G & 31) == 0 && mainw > 0 && ttiles > 0 && ttiles <= 32) {
                            EpiMoeDown E0{p.out, WSP(int, AR_RTOK), WSP(float, AR_RW8), DM / 256, (PR_LO >= 0 && st == 0 && pb + 14 >= PR_LO && pb + 14 <= PR_HI) ? 0.f : 1.f};
                            for (int job = wave * G + bid; job < ttiles * 32; job += NWAVES * G) moe_tail_combine(E0, S0, WSP(float, WS_PART), mainw / (DM / 256), job, lane); } }
                    pg8::gemm_phase<EpiSwiglu, MoeOrder, true, true>(lds, g, S, E, tid);
                    SEAM(pb + 12 + 2 * pass);
                }
                if (PHM(13) && IN(pb + 13 + 2 * pass)) { MKP;
                    Gemm g{WSP(bf16, AR_MACT), WSP(bf16, AR_MDN), MOE_ROWS, NEXP * DM, EXPERT_FF}; MoeOrder S; S.init(ctl + CW_CNT + 8 * 64 * pass, DM / 256, G, bid);
                    EpiMoeDown E{p.out, WSP(int, AR_RTOK) + (size_t)pass * MOE_ROWS, WSP(float, AR_RW8) + (size_t)pass * MOE_ROWS, DM / 256, (PR_LO >= 0 && st == 0 && pb + 13 + 2 * pass >= PR_LO && pb + 13 + 2 * pass <= PR_HI) ? 0.f : 1.f};
                    if (pass == 0) { const int* trow = WSP(int, AR_TROW);
                        for (int t = gw * 4; t < T; t += NGW * 4) { const bf16* hs = WSP(bf16, WS_H) + (size_t)t * DM; bf16* xg = WSP(bf16, AR_XG);
                            copy_rows4(hs, hs + DM, hs + 2 * DM, hs + 3 * DM, xg + (size_t)trow[T + t] * DM, xg + (size_t)trow[T + t + 1] * DM, xg + (size_t)trow[T + t + 2] * DM, xg + (size_t)trow[T + t + 3] * DM, lane); } }
                    const int nwg = S.s.nwg, mainw = (nwg / G) * G, ttiles = nwg - mainw; const bool split = bar.st != nullptr && (G & 31) == 0 && mainw > 0 && ttiles > 0 && ttiles <= 32;
                    if (split) S.s.nwg = mainw;
                    pg8::gemm_phase<EpiMoeDown, MoeOrder, true, true>(lds, g, S, E, tid);
                    if (split) { Gemm g2{WSP(bf16, AR_MACT), WSP(bf16, AR_MDN), MOE_ROWS, NEXP * DM, MT_K, EXPERT_FF, EXPERT_FF}; MoeTailOrder S2; S2.init(S, mainw / (DM / 256), ttiles, G, bid);
                        EpiPart E2{WSP(float, WS_PART), mainw / (DM / 256), DM / 256};
                        pg8::gemm_phase<EpiPart, MoeTailOrder, true, true, true>(lds, g2, S2, E2, tid); }
                    if (pass == 1 && split) { { int w_ = wave0; asm volatile("" : "+s"(w_)); xcd_barrier(bar, w_ * 64 + lane_id_opaque()); }
                        for (int job = wave * G + bid; job < ttiles * 32; job += NWAVES * G) moe_tail_combine(E, S, WSP(float, WS_PART), mainw / (DM / 256), job, lane); }
                    SEAM(pb + 13 + 2 * pass);
                }
            }
        }
    }
    }
#ifdef PROBE_TK
    { int w_ = wave0; asm volatile("" : "+s"(w_)); xcd_barrier(bar, w_ * 64 + lane_id_opaque()); }
    if (blockIdx.x == 0 && threadIdx.x == 0) { const unsigned long long* tk = (const unsigned long long*)(args.ws + WS_CTL + 4 * CW_TK); __builtin_amdgcn_fence(__ATOMIC_SEQ_CST, "agent");
        args.out[0] += floorf((float)(long long)(tk[PROBE_A1] - tk[PROBE_A0]) * 0.01f / (float)(PROBE_TU)); }
#endif
#undef IN
#undef SEAM
}

#ifndef MK_ONE_LAUNCH
#define MK_ONE_LAUNCH 1
#endif
extern "C" void kernel_launch(void* const* d_in, const int* in_sizes, int n_in, void* d_out, int out_size, void* d_ws, size_t ws_size, hipStream_t stream) {
    static int grid = 0;
    if (grid == 0) {
        if (n_in != 29 || in_sizes[0] != T * DM || out_size != T * DM || ws_size < WS_END) { fprintf(stderr, "kernel_launch: unexpected shapes / workspace (%d inputs, ws %zu, need %zu)\n", n_in, ws_size, (size_t)WS_END); grid = -1; return; }
        int dev = 0, cus = 0;
        if (hipGetDevice(&dev) != hipSuccess || hipDeviceGetAttribute(&cus, hipDeviceAttributeMultiprocessorCount, dev) != hipSuccess) { grid = -1; return; }
        if (hipFuncSetAttribute((const void*)mk_fwd, hipFuncAttributeMaxDynamicSharedMemorySize, LDS_BYTES) != hipSuccess) { fprintf(stderr, "kernel_launch: hipFuncSetAttribute failed\n"); grid = -1; return; }
        int per_cu = 0;
        if (hipOccupancyMaxActiveBlocksPerMultiprocessor(&per_cu, (const void*)mk_fwd, NTHREADS, LDS_BYTES) != hipSuccess || per_cu < 1) { fprintf(stderr, "kernel_launch: occupancy query says %d\n", per_cu); }
        (void)hipGetLastError();
        grid = cus;
    }
    if (grid < 0) return;
    if (hipMemsetAsync((char*)d_ws + WS_CTL, 0, CTL_BYTES, stream) != hipSuccess) return;
    Args a{};
    for (int i = 0; i < 29; ++i) a.in[i] = (const float*)d_in[i];
    a.out = (float*)d_out; a.ws = (unsigned char*)d_ws;
#if MK_ONE_LAUNCH
    a.ph_lo = 0; a.ph_hi = NPHASES;
    hipLaunchKernelGGL(mk_fwd, dim3(grid), dim3(NTHREADS), LDS_BYTES, stream, a);
#else
    for (int k = 0; k < NPHASES; ++k) {
        if (k >= 1 + 13 && k < 1 + NPH) continue;
        a.ph_lo = k; a.ph_hi = k + 1;
        hipLaunchKernelGGL(mk_fwd, dim3(grid), dim3(NTHREADS), LDS_BYTES, stream, a);
    }
#endif
}
```

```cpp
#include <hip/hip_runtime.h>
#include <cstdio>
#include <cstdint>
#include <cmath>
#include <cstring>
#ifdef HOST_EMU
#define HD
#define DEV_INLINE inline
#else
#define HD __host__ __device__
#define DEV_INLINE __device__ __forceinline__
#endif

typedef unsigned short bf16;
struct alignas(16) U4 { unsigned x, y, z, w; };

#ifdef SMALL_CFG
constexpr int BATCH = 1, SEQ = 1024, DM = 128, DENSE_FF = 256, EXPERT_FF = 256;
#else
constexpr int BATCH = 8, SEQ = 8192, DM = 1024, DENSE_FF = 2816, EXPERT_FF = 3584;
#endif
constexpr int T = BATCH * SEQ;
constexpr int NHEAD = 8, NKV = 2, HG = 4, DH = 64;
constexpr int NC = SEQ / 16 - 1, NS = SEQ / 64, NSEL = 8, WINDOW = 512;
constexpr int CONV_CH = 512, CONV_K = 31, RC = 512;
constexpr int NEXP = 8;
constexpr int NSA_IN = 1304, OFF_CONV = 1304, OFF_GATE = 2328, OFF_RWKV = OFF_GATE + 3 * DM;
constexpr int N_IN_FIRST = OFF_RWKV + 1824, N_IN_REST = OFF_RWKV + 1856;
constexpr int NPROJ = 4352;
constexpr int LDQ = 512, LDKV = 512, LDRW = 2048, LBLK = 1536;
constexpr int MOE_ROWS = T + NEXP * 256;
constexpr float RMS_EPS = 1e-6f, LN_EPS = 1e-5f, GN_EPS = 64e-5f;

constexpr size_t al(size_t x) { return (x + 255) & ~(size_t)255; }
constexpr size_t WS_CTL = 0, CTL_BYTES = 1u << 20;
constexpr size_t SZ_WIN = (size_t)NPROJ * DM * 2, SZ_WG = (size_t)3 * DM * DM * 2, SZ_WO3 = (size_t)3 * DM * 512 * 2, SZ_WOUT = (size_t)DM * DM * 2;
constexpr size_t SZ_LW = (size_t)2048 * 384 * 2, SZ_CW1 = (size_t)2 * 256 * 1024 * 2, SZ_PEC = 1024;
constexpr size_t SZ_LAYERW = SZ_WIN + SZ_WG + SZ_WO3 + SZ_WOUT + SZ_LW + SZ_CW1 + SZ_PEC;
constexpr size_t WS_W = CTL_BYTES;
constexpr size_t OFF_WIN = 0, OFF_WG = SZ_WIN, OFF_WO3 = OFF_WG + SZ_WG, OFF_WOUT = OFF_WO3 + SZ_WO3, OFF_LW = OFF_WOUT + SZ_WOUT, OFF_CW1 = OFF_LW + SZ_LW, OFF_PEC = OFF_CW1 + SZ_CW1;
constexpr size_t WS_DGU = WS_W + 2 * SZ_LAYERW, SZ_DGU = (size_t)2 * DENSE_FF * DM * 2;
constexpr size_t WS_DDN = WS_DGU + SZ_DGU, SZ_DDN = (size_t)DM * DENSE_FF * 2;
constexpr size_t WS_VF = al(WS_DDN + SZ_DDN), SZ_TC = (size_t)T * 512 * 2;
constexpr size_t WS_H = WS_VF + SZ_TC, SZ_H = (size_t)T * DM * 2;
constexpr size_t WS_PART = WS_VF;
static_assert((size_t)32 * 7 * 65536 * 4 <= SZ_TC, "WS_PART");
constexpr size_t WS_AR = al(WS_H + SZ_H);
constexpr size_t AR_QB = WS_AR, AR_A = AR_QB + SZ_TC, AR_CO = AR_A + SZ_TC;
constexpr size_t AR_KV = AR_CO + SZ_TC, SZ_KV = (size_t)T * LDKV * 2;
constexpr size_t AR_RW = AR_KV + SZ_KV, SZ_RW = (size_t)T * LDRW * 2;
constexpr size_t AR_W = AR_RW + SZ_RW, AR_G = AR_W + SZ_TC, AR_UB = AR_G + SZ_TC;
constexpr size_t AR_NG = AR_UB + SZ_TC, SZ_NG = (size_t)T * 24 * 4;
constexpr size_t AR_HALO = al(AR_NG + SZ_NG), SZ_HALO = (size_t)(T / 256) * LDRW * 2;
constexpr size_t AR_KC = al(AR_HALO + SZ_HALO), SZ_CMP = (size_t)BATCH * NKV * (SEQ / 16) * 64 * 2;
constexpr size_t AR_VC = AR_KC + SZ_CMP;
constexpr size_t AR_HID = al(AR_VC + SZ_CMP), SZ_HID = (size_t)BATCH * NKV * (SEQ / 16) * 2 * 128 * 4;
constexpr size_t AR_SEL = al(AR_HID + SZ_HID), SZ_SEL = (size_t)T * NKV * 8 * 4;
constexpr size_t AR_INVN = al(AR_SEL + SZ_SEL), SZ_INVN = (size_t)T * 8 * 4;
constexpr size_t AR_VCT = al(AR_INVN + SZ_INVN);
constexpr size_t AR_CKV = al(AR_VCT + SZ_CMP), SZ_CKV = (size_t)2 * T * 128;
constexpr size_t AR_END1 = al(AR_CKV + SZ_CKV * 2);
constexpr size_t WS_VST = WS_H, WS_VWT = WS_H + (size_t)T * 128 * 2, WS_LB = WS_VWT + (size_t)T * 128 * 2, WS_KS8 = WS_LB + (size_t)T * 384 * 2, WS_KW8 = WS_KS8 + (size_t)T * 128 * 2;
constexpr size_t AR_OBUF = AR_KV, SZ_OBUF = (size_t)3 * T * DM * 2;
constexpr size_t AR_MIX = AR_OBUF + SZ_OBUF, SZ_MIX = (size_t)T * DM * 2;
constexpr size_t AR_END2 = AR_MIX + SZ_MIX;
constexpr size_t AR_ACT = WS_AR;
constexpr size_t AR_MGU = WS_AR, SZ_MGU = (size_t)NEXP * 2 * EXPERT_FF * DM * 2;
constexpr size_t AR_MDN = AR_MGU + SZ_MGU, SZ_MDN = (size_t)NEXP * DM * EXPERT_FF * 2;
constexpr size_t AR_XG = al(AR_MDN + SZ_MDN), SZ_XG = (size_t)MOE_ROWS * DM * 2;
constexpr size_t AR_MACT = al(AR_XG + SZ_XG), SZ_MACT = (size_t)MOE_ROWS * EXPERT_FF * 2;
constexpr size_t AR_RTOK = al(AR_MACT + SZ_MACT), SZ_RTOK = (size_t)2 * MOE_ROWS * 4;
constexpr size_t AR_RW8 = al(AR_RTOK + SZ_RTOK);
constexpr size_t AR_TROW = al(AR_RW8 + SZ_RTOK), SZ_TROW = (size_t)2 * T * 4;
constexpr size_t AR_RTE = al(AR_TROW + SZ_TROW);
constexpr size_t AR_RTW = al(AR_RTE + (size_t)T * 4);
constexpr size_t AR_WBASE = al(AR_RTW + (size_t)T * 8);
constexpr size_t AR_END3 = al(AR_WBASE + (size_t)4096 * 16 * 4);
constexpr size_t WS_END = (AR_END1 > AR_END2 ? (AR_END1 > AR_END3 ? AR_END1 : AR_END3) : (AR_END2 > AR_END3 ? AR_END2 : AR_END3));
constexpr int CW_CNT = 1024;
constexpr int CW_ATT = 256;
constexpr int CW_BAR = 4096, CW_TK = 8192;

struct P {
    const float *x, *mix_norm_g, *w_in_first, *w_in_rest, *mu_first, *mu_rest, *qk_g, *cmp_pos, *cmp_w1, *cmp_w2, *nsa_w_o, *conv_w, *conv_vec, *conv_w_o,
        *rwkv_vec, *w_up, *a_up, *g_up, *vres_up, *vres_b, *rwkv_w_o, *w_out, *ffn_norm_g, *dense_gu, *dense_down, *router_w, *router_b, *moe_gu, *moe_down;
    float* out; unsigned char* ws;
};
HD inline void fill_params(P& p, const float* const* in, float* out, unsigned char* ws) {
    p.x = in[0]; p.mix_norm_g = in[1]; p.w_in_first = in[2]; p.w_in_rest = in[3]; p.mu_first = in[4]; p.mu_rest = in[5]; p.qk_g = in[6]; p.cmp_pos = in[7];
    p.cmp_w1 = in[8]; p.cmp_w2 = in[9]; p.nsa_w_o = in[10]; p.conv_w = in[11]; p.conv_vec = in[12]; p.conv_w_o = in[13]; p.rwkv_vec = in[14]; p.w_up = in[15];
    p.a_up = in[16]; p.g_up = in[17]; p.vres_up = in[18]; p.vres_b = in[19]; p.rwkv_w_o = in[20]; p.w_out = in[21]; p.ffn_norm_g = in[22]; p.dense_gu = in[23];
    p.dense_down = in[24]; p.router_w = in[25]; p.router_b = in[26]; p.moe_gu = in[27]; p.moe_down = in[28]; p.out = out; p.ws = ws;
}
#define WSP(type, off) ((type*)(p.ws + (off)))

#ifdef HOST_EMU
#define FENCE()
#else
#define FENCE() asm volatile("" ::: "memory")
#endif
HD inline float bf2f(bf16 v) { unsigned u = (unsigned)v << 16; float f; memcpy(&f, &u, 4); return f; }
HD inline bf16 f2bf(float f) { unsigned u; memcpy(&u, &f, 4); return (bf16)((u + 0x7fffu + ((u >> 16) & 1u)) >> 16); }
HD inline float blo(unsigned v) { unsigned u = v << 16; float f; memcpy(&f, &u, 4); return f; }
HD inline float bhi(unsigned v) { unsigned u = v & 0xffff0000u; float f; memcpy(&f, &u, 4); return f; }
#if !defined(SCAN_BF16) && !defined(RKV_BF16)
HD inline bf16 f2h(float f) { return __builtin_bit_cast(unsigned short, (_Float16)f); }
#else
HD inline bf16 f2bf(float f);
HD inline bf16 f2h(float f) { return f2bf(f); }
#endif
HD inline float h2f(bf16 v) { return (float)__builtin_bit_cast(_Float16, v); }
HD inline float sigmoidf_(float x) { return 1.f / (1.f + expf(-x)); }
HD inline float dot64(const float* q, const bf16* kp) {
    const U4* k4 = (const U4*)kp; float s0 = 0.f, s1 = 0.f;
#pragma unroll
    for (int i = 0; i < 8; ++i) { const U4 v = k4[i];
        s0 += q[8 * i + 0] * blo(v.x) + q[8 * i + 2] * blo(v.y) + q[8 * i + 4] * blo(v.z) + q[8 * i + 6] * blo(v.w);
        s1 += q[8 * i + 1] * bhi(v.x) + q[8 * i + 3] * bhi(v.y) + q[8 * i + 5] * bhi(v.z) + q[8 * i + 7] * bhi(v.w); }
    return s0 + s1;
}
HD inline float dot64p(const U4* q, const bf16* kp) {
    const U4* k4 = (const U4*)kp; float s0 = 0.f, s1 = 0.f;
#pragma unroll
    for (int i = 0; i < 8; ++i) { const U4 v = k4[i], w = q[i];
        s0 += blo(w.x) * blo(v.x) + blo(w.y) * blo(v.y) + blo(w.z) * blo(v.z) + blo(w.w) * blo(v.w);
        s1 += bhi(w.x) * bhi(v.x) + bhi(w.y) * bhi(v.y) + bhi(w.z) * bhi(v.z) + bhi(w.w) * bhi(v.w); }
    return s0 + s1;
}
HD inline void ld64(const bf16* kp, float* q) {
    const U4* k4 = (const U4*)kp;
#pragma unroll
    for (int i = 0; i < 8; ++i) { const U4 v = k4[i]; q[8 * i] = blo(v.x); q[8 * i + 1] = bhi(v.x); q[8 * i + 2] = blo(v.y); q[8 * i + 3] = bhi(v.y);
        q[8 * i + 4] = blo(v.z); q[8 * i + 5] = bhi(v.z); q[8 * i + 6] = blo(v.w); q[8 * i + 7] = bhi(v.w); }
}
HD inline void axpy64(float* o, float w, const bf16* vp) {
    const U4* k4 = (const U4*)vp;
#pragma unroll
    for (int i = 0; i < 8; ++i) { const U4 v = k4[i]; o[8 * i] += w * blo(v.x); o[8 * i + 1] += w * bhi(v.x); o[8 * i + 2] += w * blo(v.y); o[8 * i + 3] += w * bhi(v.y);
        o[8 * i + 4] += w * blo(v.z); o[8 * i + 5] += w * bhi(v.z); o[8 * i + 6] += w * blo(v.w); o[8 * i + 7] += w * bhi(v.w); }
}
HD inline void axpy64s(float* o, float w, const bf16* vp) {
    const U4* k4 = (const U4*)vp;
#pragma unroll
    for (int i = 0; i < 8; ++i) { const U4 v = k4[i]; o[8 * i] = w * o[8 * i] + blo(v.x); o[8 * i + 1] = w * o[8 * i + 1] + bhi(v.x); o[8 * i + 2] = w * o[8 * i + 2] + blo(v.y); o[8 * i + 3] = w * o[8 * i + 3] + bhi(v.y);
        o[8 * i + 4] = w * o[8 * i + 4] + blo(v.z); o[8 * i + 5] = w * o[8 * i + 5] + bhi(v.z); o[8 * i + 6] = w * o[8 * i + 6] + blo(v.w); o[8 * i + 7] = w * o[8 * i + 7] + bhi(v.w); }
}
HD inline void st64(bf16* op, const float* o) {
    U4* o4 = (U4*)op;
#pragma unroll
    for (int i = 0; i < 8; ++i) { U4 v; v.x = (unsigned)f2bf(o[8 * i]) | ((unsigned)f2bf(o[8 * i + 1]) << 16); v.y = (unsigned)f2bf(o[8 * i + 2]) | ((unsigned)f2bf(o[8 * i + 3]) << 16);
        v.z = (unsigned)f2bf(o[8 * i + 4]) | ((unsigned)f2bf(o[8 * i + 5]) << 16); v.w = (unsigned)f2bf(o[8 * i + 6]) | ((unsigned)f2bf(o[8 * i + 7]) << 16); o4[i] = v; }
}

HD inline void rope_cs(int pos, int i, float& cs, float& sn) {
    const float c = exp2f(-(float)i * 0.41524101186092f) * 0.15915494309189535f, pf = (float)pos;
    const float prod = pf * c, err = fmaf(pf, c, -prod), fr = (prod - rintf(prod)) + err;
#ifdef HOST_EMU
    cs = cosf(6.283185307179586f * fr); sn = sinf(6.283185307179586f * fr);
#else
    cs = __builtin_amdgcn_cosf(fr); sn = __builtin_amdgcn_sinf(fr);
#endif
}
HD inline int win_dest(int j, int layer, int& which) {
    which = 0;
    if (j < 1280) return j;
    if (j < 1304) return 3840 + 320 + (j - 1280);
    if (j < 1816) { const int cc = j - 1304; return 1280 + 256 * (cc / 128) + cc % 128; }
    if (j < 2328) { const int cc = j - 1816; return 1280 + 256 * (cc / 128) + 128 + cc % 128; }
    if (j < OFF_RWKV) { which = 1; const int gg = j - OFF_GATE, br = gg / DM; return (br == 0 ? 0 : (br == 1 ? 2 * DM : DM)) + gg % DM; }
    const int rr = j - OFF_RWKV;
    if (rr < 1536) return 2304 + rr;
    if (rr < 1824) return 3840 + (rr - 1536);
    if (rr < 1856 && layer == 1) return 3840 + 288 + (rr - 1824);
    return -1;
}
HD inline int glu_dest(int j, int ff) { return j < ff ? 256 * (j / 128) + j % 128 : 256 * ((j - ff) / 128) + 128 + (j - ff) % 128; }

DEV_INLINE void ph_shift(const P& p, int layer, long gtid, long NT) {
    bf16* RW = WSP(bf16, AR_RW); const bf16* HALO = WSP(bf16, AR_HALO); bf16* VF = WSP(bf16, WS_VF); bf16* LB = WSP(bf16, WS_LB);
    const float* mu = layer == 0 ? p.mu_first : p.mu_rest;
    constexpr int NCP = (LBLK + 384) / 2;
    const long n = (long)(T / 256) * NCP;
    for (long it = gtid; it < n; it += NT) {
        const int pm = (int)(it / NCP), c = 2 * (int)(it % NCP);
        int mi = -1, act = 0;
        if (c < LBLK) mi = c;
        else { const int w = c - LBLK; if (w < 288) { mi = 1536 + w; act = w < 64 ? 1 : (w >= 128 ? 2 : 0); } else if (w < 320 && layer == 1) mi = 1824 + (w - 288); }
        if (mi < 0) { for (int r = 0; r < 256; ++r) *(unsigned*)(LB + ((size_t)pm * 256 + r) * 384 + (c - LBLK)) = 0u; continue; }
        const float m0 = mu[mi], m1 = mu[mi + 1];
        float prev0 = 0.f, prev1 = 0.f;
        if ((pm * 256) % SEQ != 0) { const unsigned hv = *(const unsigned*)(HALO + (size_t)(pm - 1) * LDRW + c); prev0 = blo(hv); prev1 = bhi(hv); }
        bf16* col = RW + (size_t)pm * 256 * LDRW + c;
        for (int r0 = 0; r0 < 256; r0 += 16) {
            unsigned pv[16];
#pragma unroll
            for (int k = 0; k < 16; ++k) pv[k] = *(const unsigned*)(col + (size_t)(r0 + k) * LDRW);
#pragma unroll
            for (int k = 0; k < 16; ++k) { const int r = r0 + k; const float p0 = blo(pv[k]), p1 = bhi(pv[k]);
                float u0 = p0 + (prev0 - p0) * m0, u1 = p1 + (prev1 - p1) * m1; prev0 = p0; prev1 = p1;
                if (act == 1) { u0 = tanhf(u0); u1 = tanhf(u1); } else if (act == 2) { u0 = sigmoidf_(u0); u1 = sigmoidf_(u1); }
                if (c < LBLK) { const unsigned hv = (unsigned)f2h(u0) | ((unsigned)f2h(u1) << 16); *(unsigned*)(col + (size_t)r * LDRW) = hv;
                    if (layer == 0 && c >= 1024) *(unsigned*)(VF + ((size_t)pm * 256 + r) * RC + (c - 1024)) = hv; }
                else *(unsigned*)(LB + ((size_t)pm * 256 + r) * 384 + (c - LBLK)) = (unsigned)f2bf(u0) | ((unsigned)f2bf(u1) << 16); }
        }
    }
}

DEV_INLINE void ph_nsa_prep(const P& p, int layer, long gtid, long NT) {
    bf16* QB = WSP(bf16, AR_QB); bf16* KV = WSP(bf16, AR_KV);
    const long n = (long)T * 12;
    for (long it = gtid; it < n; it += NT) {
        const int t = (int)(it / 12), s = (int)(it % 12), pos = t % SEQ;
        bf16* ptr; const float* g;
        if (s < 8) { ptr = QB + (size_t)t * LDQ + s * 64; g = p.qk_g + (layer * 4 + 0) * 64; }
        else if (s < 10) { ptr = KV + (size_t)t * LDKV + (s - 8) * 64; g = p.qk_g + (layer * 4 + 2) * 64; }
        else { ptr = KV + (size_t)t * LDKV + 256 + (s - 10) * 64; g = p.qk_g + (layer * 4 + 3) * 64; }
        float v[64]; ld64(ptr, v);
        float ss = 0.f;
#pragma unroll
        for (int i = 0; i < 64; ++i) ss += v[i] * v[i];
        const float rs = 1.f / sqrtf(ss * (1.f / 64.f) + RMS_EPS);
#pragma unroll
        for (int i = 0; i < 64; ++i) v[i] = v[i] * rs * g[i];
#pragma unroll
        for (int i = 0; i < 32; ++i) {
            float cs, sn; rope_cs(pos, i, cs, sn);
            const float x1 = v[i], x2 = v[i + 32]; v[i] = x1 * cs - x2 * sn; v[i + 32] = x2 * cs + x1 * sn;
        }
        if (s < 8) {
#pragma unroll
            for (int i = 0; i < 64; ++i) v[i] *= 0.125f * 1.4426950408889634f; }
        if (s < 8) st64(ptr, v);
        else {
            const int gg = (s - 8) & 1, bq = t / SEQ; bf16* k8 = WSP(bf16, s < 10 ? WS_KS8 : WS_KW8) + (size_t)(bq * NKV + gg) * 8 * SEQ * 8;
#pragma unroll
            for (int dg = 0; dg < 8; ++dg) { U4 w; w.x = (unsigned)f2bf(v[8 * dg]) | ((unsigned)f2bf(v[8 * dg + 1]) << 16); w.y = (unsigned)f2bf(v[8 * dg + 2]) | ((unsigned)f2bf(v[8 * dg + 3]) << 16);
                w.z = (unsigned)f2bf(v[8 * dg + 4]) | ((unsigned)f2bf(v[8 * dg + 5]) << 16); w.w = (unsigned)f2bf(v[8 * dg + 6]) | ((unsigned)f2bf(v[8 * dg + 7]) << 16);
                *(U4*)(k8 + ((size_t)dg * SEQ + pos) * 8) = w; } }
    }
}

DEV_INLINE void ph_vtrans(const P& p, long gtid, long NT) {
    const bf16* KV = WSP(bf16, AR_KV); bf16* VsT = WSP(bf16, WS_VST); bf16* VwT = WSP(bf16, WS_VWT);
    const long n = (long)BATCH * NKV * (SEQ / 8) * 64;
    for (long it = gtid; it < n; it += NT) {
        const int d = (int)(it % 64); long r = it / 64; const int kg = (int)(r % (SEQ / 8)); const int bg = (int)(r / (SEQ / 8)), b = bg / NKV, g = bg % NKV;
        const int kbase = (kg >> 2) * 32 + 4 * (kg & 3);
        const bf16* src = KV + (size_t)(b * SEQ + kbase) * LDKV + g * 64 + d;
        U4 s, w; unsigned short sv[8], wv[8];
#pragma unroll
        for (int j = 0; j < 8; ++j) { const size_t ro = (size_t)((j & 3) + 16 * (j >> 2)) * LDKV; sv[j] = src[ro + 128]; wv[j] = src[ro + 384]; }
        s.x = sv[0] | ((unsigned)sv[1] << 16); s.y = sv[2] | ((unsigned)sv[3] << 16); s.z = sv[4] | ((unsigned)sv[5] << 16); s.w = sv[6] | ((unsigned)sv[7] << 16);
        w.x = wv[0] | ((unsigned)wv[1] << 16); w.y = wv[2] | ((unsigned)wv[3] << 16); w.z = wv[4] | ((unsigned)wv[5] << 16); w.w = wv[6] | ((unsigned)wv[7] << 16);
        *(U4*)(VsT + (((size_t)bg * (SEQ / 8) + kg) * 64 + d) * 8) = s; *(U4*)(VwT + (((size_t)bg * (SEQ / 8) + kg) * 64 + d) * 8) = w;
    }
}
namespace pg8 {
#define PG8_LAS __attribute__((address_space(3)))
typedef unsigned short bf16_t;
typedef short bf16x8 __attribute__((ext_vector_type(8)));
typedef float f32x4 __attribute__((ext_vector_type(4)));
typedef unsigned u32x4 __attribute__((ext_vector_type(4)));
constexpr int BM = 256, BK = 64, HALF = 128, HTB = HALF * BK * 2  , STAGE_BYTES = 8 * HTB, NXCD = 8, WGM = 8;

__host__ __device__ __forceinline__ int lds_byte(int r, int c) { const int st = (r >> 4) * 2 + (c >> 5), rr = r & 15, cc = c & 31, ob = rr * 64 + cc * 2; return st * 1024 + (ob ^ (((ob >> 9) & 1) << 5)); }
__host__ __device__ __forceinline__ void stage_rc(int b, int& R, int& C) { const int st = b / 1024, sb = b % 1024, swz = sb ^ (((sb >> 9) & 1) << 5); R = (st >> 1) * 16 + swz / 64; C = (st & 1) * 32 + (swz % 64) / 2; }
__host__ __device__ __forceinline__ int perm32(int rho) { const int n = rho >> 4, i = rho & 15; return 8 * (i >> 2) + 4 * n + (i & 3); }

struct Unit { int pm, pn; };
struct Gemm { const bf16_t* A; const bf16_t* Bt; int M, N, K; int lda; int ldb; };

struct StaticOrder {
    int nM, nN, nwg, G, c;
    __host__ __device__ void init(int M, int N, int G_, int c_) { nM = M / BM; nN = N / BM; nwg = nM * nN; G = G_; c = c_; }
    __host__ __device__ bool next(int i, Unit& u) const {
        const long L = (long)i * G + c; if (L >= nwg) return false;
        int wgid = (int)L; { const int q = nwg / NXCD, r = nwg % NXCD, xcd = wgid % NXCD, off = wgid / NXCD; wgid = (xcd < r ? xcd * (q + 1) : r * (q + 1) + (xcd - r) * q) + off; }
        const int nig = WGM * nN, gid = wgid / nig, fm = gid * WGM, gsz = (nM - fm) < WGM ? (nM - fm) : WGM;
        u.pm = fm + ((wgid % nig) % gsz); u.pn = (wgid % nig) / gsz; return true;
    }
    __device__ __forceinline__ void a_ready(const Unit&) const {}
    __device__ __forceinline__ void done(const Unit&) const {}
};

__device__ __forceinline__ unsigned cvt_pk_bf16(float lo, float hi) { unsigned r; asm volatile("v_cvt_pk_bf16_f32 %0, %1, %2" : "=v"(r) : "v"(lo), "v"(hi)); return r; }
typedef float f32x2 __attribute__((ext_vector_type(2)));
template <class Epi, class Sched, bool ALIGN_EPI = false, bool SP2 = false, bool KSPLIT = false>
__device__ __forceinline__ void gemm_phase(PG8_LAS unsigned char* lds, const Gemm g, const Sched& S, const Epi& E, int tid_in) {
    int tid_ = tid_in; asm volatile("" : "+v"(tid_));
    const int tid = tid_, wid = __builtin_amdgcn_readfirstlane(tid >> 6), lane = tid & 63, wr = wid >> 2, wc = wid & 3, fr = lane & 15, fq = lane >> 4;
    const int K = g.K, nt = K / BK, lda = g.lda ? g.lda : K, ldb = g.ldb ? g.ldb : K;
    unsigned voffA[2], voffB[2];
#pragma unroll
    for (int i = 0; i < 2; ++i) { int R, C; stage_rc(tid * 16 + i * 8192, R, C); const int Rb = Epi::PERM ? ((R & ~31) + perm32(R & 31)) : R;
        voffA[i] = (unsigned)(R * lda + C) * 2u; voffB[i] = (unsigned)(Rb * ldb + C) * 2u; }
    const size_t kstep = (size_t)(BK * 2);
    const size_t hstepA = (size_t)HALF * lda * 2, hstepB = (size_t)HALF * ldb * 2;
    const size_t hstep_unused = (size_t)HALF * K * 2;
    const size_t tstepA = 2 * hstepA, tstepB = 2 * hstepB;
    const unsigned ldsw = (unsigned)wid * 1024u;
    const int aoff = lds_byte(wr * 64 + fr, fq * 8), boff = lds_byte(wc * 32 + fr, fq * 8);
#define PG8_SA(b, h) (((b) * 2 + (h)) * HTB)
#define PG8_SB(b, h) ((4 + (b) * 2 + (h)) * HTB)
#define PG8_STAGE(bufoff, gbase, voff) do { _Pragma("unroll") for (int _i = 0; _i < 2; ++_i) \
        __builtin_amdgcn_global_load_lds((const unsigned*)((const char*)(gbase) + (voff)[_i]), (PG8_LAS unsigned*)(lds + (bufoff) + ldsw + _i * 8192), 16, 0, 0); } while (0)
#define PG8_LDA(dst, b, h) do { _Pragma("unroll") for (int m = 0; m < 4; ++m) _Pragma("unroll") for (int k = 0; k < 2; ++k) dst[m][k] = *(const PG8_LAS bf16x8*)(lds + PG8_SA(b, h) + aoff + m * 2048 + k * 1024); } while (0)
#define PG8_LDB(dst, b, h) do { _Pragma("unroll") for (int n = 0; n < 2; ++n) _Pragma("unroll") for (int k = 0; k < 2; ++k) dst[n][k] = *(const PG8_LAS bf16x8*)(lds + PG8_SB(b, h) + boff + n * 2048 + k * 1024); } while (0)
#define PG8_MMA(ai, bj, At, Bt) do { __builtin_amdgcn_s_setprio(1); _Pragma("unroll") for (int m = 0; m < 4; ++m) _Pragma("unroll") for (int n = 0; n < 2; ++n) _Pragma("unroll") for (int k = 0; k < 2; ++k) \
        acc[ai][bj][m][n] = __builtin_amdgcn_mfma_f32_16x16x32_bf16(Bt[n][k], At[m][k], acc[ai][bj][m][n], 0, 0, 0); __builtin_amdgcn_s_setprio(0); } while (0)
#define PG8_WAIT_V(n) asm volatile("s_waitcnt vmcnt(" #n ")" ::: "memory")
#define PG8_WAIT_L(n) asm volatile("s_waitcnt lgkmcnt(" #n ")" ::: "memory")
#define PG8_BAR __builtin_amdgcn_s_barrier()
#define PG8_SCHED __builtin_amdgcn_sched_barrier(0)
    Unit cur, nxt; int ui = 0;
    if (!S.next(0, cur)) return;
    f32x4 acc[2][2][4][2];
#pragma unroll
    for (int a = 0; a < 2; ++a)
#pragma unroll
        for (int b = 0; b < 2; ++b)
#pragma unroll
            for (int m = 0; m < 4; ++m)
#pragma unroll
                for (int n = 0; n < 2; ++n) acc[a][b][m][n] = (f32x4){0.f, 0.f, 0.f, 0.f};
    bf16x8 At[4][2], B0[2][2], B1[2][2];
    const char* cA = (const char*)g.A + (size_t)cur.pm * tstepA + (KSPLIT ? (size_t)(cur.pn >> 16) * K * 2 : 0); const char* cB = (const char*)g.Bt + (size_t)(KSPLIT ? (cur.pn & 0xffff) : cur.pn) * tstepB + (KSPLIT ? (size_t)(cur.pn >> 16) * K * 2 : 0);
    S.a_ready(cur);
    if constexpr (SP2) {
        PG8_STAGE(PG8_SB(0, 0), cB, voffB); PG8_STAGE(PG8_SB(0, 1), cB + hstepB, voffB); PG8_STAGE(PG8_SA(0, 0), cA, voffA); PG8_STAGE(PG8_SA(0, 1), cA + hstepA, voffA);
        if (wr == 1) PG8_BAR;
        PG8_WAIT_V(2); PG8_BAR;
        PG8_STAGE(PG8_SB(1, 0), cB + kstep, voffB); PG8_STAGE(PG8_SA(1, 0), cA + kstep, voffA); PG8_STAGE(PG8_SB(1, 1), cB + hstepB + kstep, voffB);
        PG8_WAIT_V(6); PG8_BAR;
    } else {
        PG8_STAGE(PG8_SB(0, 0), cB, voffB); PG8_STAGE(PG8_SA(0, 0), cA, voffA); PG8_STAGE(PG8_SB(0, 1), cB + hstepB, voffB); PG8_STAGE(PG8_SA(0, 1), cA + hstepA, voffA);
        if (wr == 1) PG8_BAR;
        PG8_WAIT_V(4); PG8_BAR;
        PG8_STAGE(PG8_SB(1, 0), cB + kstep, voffB); PG8_STAGE(PG8_SA(1, 0), cA + kstep, voffA); PG8_STAGE(PG8_SB(1, 1), cB + hstepB + kstep, voffB);
        PG8_WAIT_V(6); PG8_BAR;
    }
    for (;;) {
        const bool has_next = S.next(ui + 1, nxt);
        const char* nA = has_next ? (const char*)g.A + (size_t)nxt.pm * tstepA + (KSPLIT ? (size_t)(nxt.pn >> 16) * K * 2 : 0) : cA; const char* nB = has_next ? (const char*)g.Bt + (size_t)(KSPLIT ? (nxt.pn & 0xffff) : nxt.pn) * tstepB + (KSPLIT ? (size_t)(nxt.pn >> 16) * K * 2 : 0) : cB;
        for (int t = 0; t < nt; t += 2) {
            const bool last = (t == nt - 2);
            const char* a1 = cA + (size_t)(t + 1) * kstep;
            const char* a2 = last ? nA : cA + (size_t)(t + 2) * kstep; const char* b2 = last ? nB : cB + (size_t)(t + 2) * kstep;
            const char* a3 = a2 + kstep; const char* b3 = b2 + kstep;
            if (last && has_next) S.a_ready(nxt);
            if constexpr (SP2) {
            PG8_LDB(B0, 0, 0); PG8_LDB(B1, 0, 1); PG8_SCHED; PG8_LDA(At, 0, 0); PG8_STAGE(PG8_SA(1, 1), a1 + hstepA, voffA);
            PG8_WAIT_V(8); PG8_WAIT_L(0); PG8_BAR; PG8_MMA(0, 0, At, B0); PG8_MMA(0, 1, At, B1); PG8_BAR; PG8_SCHED;
            PG8_LDA(At, 0, 1); PG8_STAGE(PG8_SB(0, 0), b2, voffB); PG8_STAGE(PG8_SB(0, 1), b2 + hstepB, voffB); PG8_STAGE(PG8_SA(0, 0), a2, voffA);
            PG8_WAIT_V(8); PG8_WAIT_L(0); PG8_BAR; PG8_MMA(1, 0, At, B0); PG8_MMA(1, 1, At, B1); PG8_BAR; PG8_SCHED;
            PG8_LDB(B0, 1, 0); PG8_LDB(B1, 1, 1); PG8_SCHED; PG8_LDA(At, 1, 0); PG8_STAGE(PG8_SA(0, 1), a2 + hstepA, voffA);
            PG8_WAIT_V(8); PG8_WAIT_L(0); PG8_BAR; PG8_MMA(0, 0, At, B0); PG8_MMA(0, 1, At, B1); PG8_BAR; PG8_SCHED;
            PG8_LDA(At, 1, 1); PG8_STAGE(PG8_SB(1, 0), b3, voffB); PG8_STAGE(PG8_SB(1, 1), b3 + hstepB, voffB); PG8_STAGE(PG8_SA(1, 0), a3, voffA);
            PG8_WAIT_V(8); PG8_WAIT_L(0); PG8_BAR; PG8_MMA(1, 0, At, B0); PG8_MMA(1, 1, At, B1); PG8_BAR; PG8_SCHED;
            } else {
            PG8_LDB(B0, 0, 0); PG8_SCHED; PG8_LDA(At, 0, 0); PG8_STAGE(PG8_SA(1, 1), a1 + hstepA, voffA);
            PG8_WAIT_L(8); PG8_BAR; PG8_WAIT_L(0); PG8_MMA(0, 0, At, B0); PG8_BAR; PG8_SCHED;
            PG8_LDB(B1, 0, 1); PG8_STAGE(PG8_SB(0, 0), b2, voffB);
            PG8_BAR; PG8_WAIT_L(0); PG8_MMA(0, 1, At, B1); PG8_BAR;
            PG8_LDA(At, 0, 1); PG8_STAGE(PG8_SA(0, 0), a2, voffA);
            PG8_BAR; PG8_WAIT_L(0); PG8_MMA(1, 0, At, B0); PG8_BAR; PG8_SCHED;
            PG8_STAGE(PG8_SB(0, 1), b2 + hstepB, voffB);
            PG8_WAIT_V(6); PG8_BAR; PG8_MMA(1, 1, At, B1); PG8_BAR;
            PG8_LDB(B0, 1, 0); PG8_SCHED; PG8_LDA(At, 1, 0); PG8_STAGE(PG8_SA(0, 1), a2 + hstepA, voffA);
            PG8_WAIT_L(8); PG8_BAR; PG8_WAIT_L(0); PG8_MMA(0, 0, At, B0); PG8_BAR; PG8_SCHED;
            PG8_LDB(B1, 1, 1); PG8_STAGE(PG8_SB(1, 0), b3, voffB);
            PG8_BAR; PG8_WAIT_L(0); PG8_MMA(0, 1, At, B1); PG8_BAR;
            PG8_LDA(At, 1, 1); PG8_STAGE(PG8_SA(1, 0), a3, voffA);
            PG8_BAR; PG8_WAIT_L(0); PG8_MMA(1, 0, At, B0); PG8_BAR; PG8_SCHED;
            PG8_STAGE(PG8_SB(1, 1), b3 + hstepB, voffB);
            PG8_WAIT_V(6); PG8_BAR; PG8_MMA(1, 1, At, B1); PG8_BAR;
            }
        }
        if constexpr (ALIGN_EPI) { if (wr == 0) PG8_BAR; }
        if constexpr (!Epi::AFTER_DRAIN) { E(acc, cur, wr, wc, fr, fq); S.done(cur); }
        if (!has_next) break;
#pragma unroll
        for (int a = 0; a < 2; ++a)
#pragma unroll
            for (int b = 0; b < 2; ++b)
#pragma unroll
                for (int m = 0; m < 4; ++m)
#pragma unroll
                    for (int n = 0; n < 2; ++n) acc[a][b][m][n] = (f32x4){0.f, 0.f, 0.f, 0.f};
        cur = nxt; cA = nA; cB = nB; ++ui;
        if constexpr (ALIGN_EPI) { if (wr == 1) PG8_BAR; }
    }
    PG8_WAIT_V(0);
    if constexpr (!ALIGN_EPI) { if (wr == 0) PG8_BAR; }
    PG8_BAR;
    if constexpr (Epi::AFTER_DRAIN) { E.fused(acc, cur, wr, wc, fr, fq, lds, wid, lane); S.done(cur); }
#undef PG8_SA
#undef PG8_SB
#undef PG8_STAGE
#undef PG8_LDA
#undef PG8_LDB
#undef PG8_MMA
#undef PG8_WAIT_V
#undef PG8_WAIT_L
#undef PG8_BAR
#undef PG8_SCHED
}
}

#define LAS __attribute__((address_space(3)))
#define XB_TMO      128
#define XB_XCNT(j)  (256  + 64 * (j))
#define XB_XSUB(j)  (1280 + 64 * (j))
#define XB_XGEN(j)  (2304 + 64 * (j))
#define XB_TOP      3328
#define XB_TOPGEN   3392
#define XCD_BAR_WORDS 3456
#define XB_SPIN_CAP (1u << 22)

__device__ __forceinline__ unsigned xb_ld(unsigned* p)              { return __hip_atomic_load(p, __ATOMIC_RELAXED, __HIP_MEMORY_SCOPE_AGENT); }
__device__ __forceinline__ unsigned xb_add(unsigned* p, unsigned v) { return __hip_atomic_fetch_add(p, v, __ATOMIC_RELAXED, __HIP_MEMORY_SCOPE_AGENT); }
__device__ __forceinline__ unsigned xb_xcc_id() { return (unsigned)__builtin_amdgcn_s_getreg((3 << 11) | 20) & 0xFu; }
#define XB_SPIN(cond, bar) do { unsigned _sp = 0; while (cond) { __builtin_amdgcn_s_sleep(1); \
    if ((++_sp & 255u) == 0u) { if (xb_ld(&(bar)[XB_TMO])) break; if (_sp > XB_SPIN_CAP) { atomicAdd(&(bar)[XB_TMO], 1u); break; } } } } while (0)

struct XcdBarrier {
    unsigned* bar; unsigned x;
    volatile LAS unsigned* st;
};

__device__ __forceinline__ XcdBarrier xcd_barrier_post(unsigned* bar, volatile LAS unsigned* st) {
    XcdBarrier b; b.bar = bar; b.x = xb_xcc_id(); b.st = st;
    if (threadIdx.x == 0) (void)xb_add(&bar[XB_XCNT(b.x)], 1u);
    return b;
}
__device__ __forceinline__ void xcd_barrier_complete(unsigned* bar, unsigned x, unsigned& nloc, unsigned& nx) {
    const unsigned G = gridDim.x * gridDim.y * gridDim.z;
    unsigned sum, cnt, mine, sp = 0u;
    for (;;) {
        sum = 0u; cnt = 0u; mine = 0u;
#pragma unroll
        for (unsigned j = 0; j < 16; ++j) { const unsigned c = xb_ld(&bar[XB_XCNT(j)]); sum += c; cnt += (c > 0u) ? 1u : 0u; mine = (j == x) ? c : mine; }
        if (sum == G) break;
        __builtin_amdgcn_s_sleep(1);
        if ((++sp & 255u) == 0u) { if (xb_ld(&bar[XB_TMO])) break; if (sp > XB_SPIN_CAP) { atomicAdd(&bar[XB_TMO], 1u); break; } }
    }
    nloc = mine > 0u ? mine : 1u; nx = cnt > 0u ? cnt : 1u;
}

__device__ __forceinline__ void xcd_barrier(const XcdBarrier& b, int tid_x  ) {
    asm volatile("s_waitcnt vmcnt(0)" ::: "memory");
    __syncthreads();
    if (tid_x == 0) {
        unsigned* bar = b.bar; asm volatile("" : "+s"(bar));
        unsigned xx = b.x; asm volatile("" : "+s"(xx));
        __builtin_amdgcn_s_waitcnt(0);
        unsigned nloc = b.st[0], nx = b.st[1];
        if (nloc == 0u) { xcd_barrier_complete(bar, xx, nloc, nx); b.st[0] = nloc; b.st[1] = nx; }
        const unsigned old = xb_add(&bar[XB_XSUB(xx)], 1u);
        const unsigned gen = old / nloc;
        if (old + 1u == (gen + 1u) * nloc) {
            __builtin_amdgcn_fence(__ATOMIC_RELEASE, "agent");
            asm volatile("s_waitcnt vmcnt(0)" ::: "memory");
            const unsigned og = xb_add(&bar[XB_TOP], 1u);
            const unsigned tg = og / nx;
            if (og + 1u == (tg + 1u) * nx) xb_add(&bar[XB_TOPGEN], 1u);
            else XB_SPIN(xb_ld(&bar[XB_TOPGEN]) == tg, bar);
            __builtin_amdgcn_fence(__ATOMIC_ACQUIRE, "agent");
            xb_add(&bar[XB_XGEN(xx)], 1u);
            asm volatile("s_waitcnt vmcnt(0)" ::: "memory");
        } else {
            XB_SPIN(xb_ld(&bar[XB_XGEN(xx)]) == gen, bar);
            __builtin_amdgcn_fence(__ATOMIC_ACQUIRE, "agent");
            asm volatile("s_waitcnt vmcnt(0)" ::: "memory");
        }
    }
    __syncthreads();
}
#define GAS __attribute__((address_space(1)))
typedef unsigned v4u __attribute__((ext_vector_type(4)));
typedef unsigned v2u __attribute__((ext_vector_type(2)));
typedef GAS unsigned gu32;
#define RLX_AGENT __ATOMIC_RELAXED, __HIP_MEMORY_SCOPE_AGENT
#define LDS_WAIT() asm volatile("s_waitcnt lgkmcnt(0)" ::: "memory")
#define VM_WAIT() asm volatile("s_waitcnt vmcnt(0)" ::: "memory")
using pg8::f32x4; using pg8::Unit; using pg8::Gemm; using pg8::BM; using pg8::HALF; using pg8::cvt_pk_bf16; using pg8::u32x4;

constexpr int NWAVES = 8, NTHREADS = 512;
constexpr int RING_BYTES = 131072, LDSCTL_OFF = 147456 - 1024, MISC_OFF = LDSCTL_OFF + 320, LDS_BYTES = 147456;

__device__ __forceinline__ float wave_sum(float v, int lane) {
#pragma unroll
    for (int o = 1; o < 64; o <<= 1) v += __builtin_bit_cast(float, __builtin_amdgcn_ds_bpermute((lane ^ o) << 2, __builtin_bit_cast(int, v)));
    return v;
}
__device__ __forceinline__ float fsig(float x) { return __builtin_amdgcn_rcpf(1.f + __expf(-x)); }

__device__ __forceinline__ int lane_id_opaque() { int l; asm volatile("v_mbcnt_lo_u32_b32 %0, -1, 0\n\tv_mbcnt_hi_u32_b32 %0, -1, %0" : "=v"(l)); return l; }
__device__ __forceinline__ int rfl(int v) { return __builtin_amdgcn_readfirstlane(v); }
struct SOrder {
    pg8::StaticOrder s;
    __device__ void init(int M, int N, int G, int c) { s.init(M, N, G, c); }
    __device__ bool next(int i, Unit& u) const { Unit t; t.pm = 0; t.pn = 0; const bool ok = s.next(i, t); u.pm = rfl(t.pm); u.pn = rfl(t.pn); return ok; }
    __device__ __forceinline__ void a_ready(const Unit&) const {}
    __device__ __forceinline__ void done(const Unit&) const {}
};
struct StackOrder {
    pg8::StaticOrder s; int nM, nN;
    __device__ StackOrder(int nM_, int nN_, int nb, int G, int c) : nM(nM_), nN(nN_) { s.init(nb * nM_ * 256, nN_ * 256, G, c); }
    __device__ bool next(int i, Unit& u) const { Unit t; t.pm = 0; t.pn = 0; if (!s.next(i, t)) return false; u.pm = rfl(t.pm); u.pn = rfl((t.pm / nM) * nN + t.pn); return true; }
    __device__ __forceinline__ void a_ready(const Unit&) const {}
    __device__ __forceinline__ void done(const Unit&) const {}
};
struct GateOrder {
    pg8::StaticOrder s; int nN;
    __device__ GateOrder(int nM_, int nN_, int G, int c) : nN(nN_) { s.init(nM_ * 256, nN_ * 256, G, c); }
    __device__ bool next(int i, Unit& u) const { const int j = i / 3, br = i - 3 * j; Unit t; t.pm = 0; t.pn = 0; if (!s.next(j, t)) return false; u.pm = rfl(t.pm); u.pn = rfl(br * nN + t.pn); return true; }
    __device__ __forceinline__ void a_ready(const Unit&) const {}
    __device__ __forceinline__ void done(const Unit&) const {}
};
struct MoeOrder {
    pg8::StaticOrder s; int nN, e0, e1, e2, e3, e4, e5, e6, e7;
    __device__ void init(const unsigned* cnt  , int nN_, int G_, int c_) { nN = nN_;
        int t = 0; t += (cnt[0] + 255) >> 8; e0 = t; t += (cnt[64] + 255) >> 8; e1 = t; t += (cnt[128] + 255) >> 8; e2 = t; t += (cnt[192] + 255) >> 8; e3 = t;
        t += (cnt[256] + 255) >> 8; e4 = t; t += (cnt[320] + 255) >> 8; e5 = t; t += (cnt[384] + 255) >> 8; e6 = t; t += (cnt[448] + 255) >> 8; e7 = t;
        s.init(e7 * 256, nN_ * 256, G_, c_); }
    __device__ bool next(int i, Unit& u) const { Unit t; t.pm = 0; t.pn = 0; if (!s.next(i, t)) return false;
        const int pm = t.pm, e = (pm >= e0) + (pm >= e1) + (pm >= e2) + (pm >= e3) + (pm >= e4) + (pm >= e5) + (pm >= e6);
        u.pm = rfl(pm); u.pn = rfl(e * nN + t.pn); return true; }
    __device__ __forceinline__ void a_ready(const Unit&) const {}
    __device__ __forceinline__ void done(const Unit&) const {}
};

__device__ __forceinline__ u32x4 pack8(f32x4 v0, f32x4 v1) { u32x4 w; w.x = cvt_pk_bf16(v0[0], v0[1]); w.y = cvt_pk_bf16(v0[2], v0[3]); w.z = cvt_pk_bf16(v1[0], v1[1]); w.w = cvt_pk_bf16(v1[2], v1[3]); return w; }
__device__ __forceinline__ void unpack8(u32x4 w, f32x4& v0, f32x4& v1) {
    v0 = (f32x4){blo(w.x), bhi(w.x), blo(w.y), bhi(w.y)}; v1 = (f32x4){blo(w.z), bhi(w.z), blo(w.w), bhi(w.w)}; }

struct EpiProj {
    static constexpr bool PERM = true, AFTER_DRAIN = false;
    unsigned char* ws;
    __device__ __forceinline__ void operator()(const f32x4 (&acc)[2][2][4][2], const Unit& u, int wr, int wc, int fr, int fq) const {
        bf16* const QB = (bf16*)(ws + AR_QB); bf16* const KV = (bf16*)(ws + AR_KV); bf16* const UB = (bf16*)(ws + AR_UB); bf16* const RW = (bf16*)(ws + AR_RW); bf16* const HALO = (bf16*)(ws + AR_HALO); bf16* const CKV = (bf16*)(ws + AR_CKV);
        const int row0 = u.pm * BM + wr * 64 + fr, cl = wc * 32 + 8 * fq;
        if (u.pn >= 5 && u.pn < 9) {
#pragma unroll
            for (int ai = 0; ai < 2; ++ai)
#pragma unroll
                for (int m = 0; m < 4; ++m) { f32x4 a0 = acc[ai][0][m][0], a1 = acc[ai][0][m][1]; const f32x4 b0 = acc[ai][1][m][0], b1 = acc[ai][1][m][1];
#pragma unroll
                    for (int k = 0; k < 4; ++k) { a0[k] *= fsig(b0[k]); a1[k] *= fsig(b1[k]); }
                    *(u32x4*)(UB + (size_t)(row0 + ai * HALF + m * 16) * 512 + (u.pn - 5) * 128 + cl) = pack8(a0, a1); }
            return;
        }
        if (u.pn == 2) {
#pragma unroll
            for (int ai = 0; ai < 2; ++ai)
#pragma unroll
                for (int m = 0; m < 4; ++m) { const int row = row0 + ai * HALF + m * 16, b = row / SEQ, tt = row % SEQ;
#pragma unroll
                    for (int bj = 0; bj < 2; ++bj) *(u32x4*)(CKV + (((size_t)bj * (BATCH * NKV) + b * NKV + (cl >> 6)) * SEQ + tt) * 64 + (cl & 63)) = pack8(acc[ai][bj][m][0], acc[ai][bj][m][1]); }
            return;
        }
        bf16* base; int ld, c0;
        if (u.pn < 2) { base = QB; ld = LDQ; c0 = u.pn * 256; } else if (u.pn < 5) { base = KV; ld = LDKV; c0 = (u.pn - 3) * 256; } else { base = RW; ld = LDRW; c0 = (u.pn - 9) * 256; }
#pragma unroll
        for (int ai = 0; ai < 2; ++ai)
#pragma unroll
            for (int m = 0; m < 4; ++m)
#pragma unroll
                for (int bj = 0; bj < 2; ++bj) { const u32x4 w = pack8(acc[ai][bj][m][0], acc[ai][bj][m][1]);
                    *(u32x4*)(base + (size_t)(row0 + ai * HALF + m * 16) * ld + c0 + bj * HALF + cl) = w;
                    if (u.pn >= 9 && ai == 1 && m == 3 && wr == 1 && fr == 15) *(u32x4*)(HALO + (size_t)u.pm * LDRW + c0 + bj * HALF + cl) = w; }
    }
};
struct EpiStore {
    static constexpr bool PERM = true, AFTER_DRAIN = false;
    bf16* O; int ld, ntn;
    __device__ __forceinline__ void operator()(const f32x4 (&acc)[2][2][4][2], const Unit& u, int wr, int wc, int fr, int fq) const {
        const int row0 = u.pm * BM + wr * 64 + fr, c0 = (u.pn % ntn) * 256 + wc * 32 + 8 * fq;
#pragma unroll
        for (int ai = 0; ai < 2; ++ai)
#pragma unroll
            for (int m = 0; m < 4; ++m)
#pragma unroll
                for (int bj = 0; bj < 2; ++bj) *(u32x4*)(O + (size_t)(row0 + ai * HALF + m * 16) * ld + c0 + bj * HALF) = pack8(acc[ai][bj][m][0], acc[ai][bj][m][1]);
    }
};
struct EpiGate {
    static constexpr bool PERM = true, AFTER_DRAIN = false;
    unsigned char* ws; int ntn;
    __device__ __forceinline__ void operator()(const f32x4 (&acc)[2][2][4][2], const Unit& u, int wr, int wc, int fr, int fq) const {
        const bf16* const OB = (const bf16*)(ws + AR_OBUF); bf16* const MIX = (bf16*)(ws + AR_MIX);
        const int br = u.pn / ntn, row0 = u.pm * BM + wr * 64 + fr, c0 = (u.pn % ntn) * 256 + wc * 32 + 8 * fq;
        const bf16* ob = OB + (size_t)br * T * DM;
#pragma unroll
        for (int ai = 0; ai < 2; ++ai) {
            u32x4 o[4][2], mx[4][2];
#pragma unroll
            for (int m = 0; m < 4; ++m)
#pragma unroll
                for (int bj = 0; bj < 2; ++bj) { const size_t off = (size_t)(row0 + ai * HALF + m * 16) * DM + c0 + bj * HALF; o[m][bj] = *(const u32x4*)(ob + off); if (br != 0) mx[m][bj] = *(const u32x4*)(MIX + off); }
#pragma unroll
            for (int m = 0; m < 4; ++m)
#pragma unroll
                for (int bj = 0; bj < 2; ++bj) { const size_t off = (size_t)(row0 + ai * HALF + m * 16) * DM + c0 + bj * HALF;
                    f32x4 o0, o1; unpack8(o[m][bj], o0, o1);
                    f32x4 g0 = acc[ai][bj][m][0], g1 = acc[ai][bj][m][1];
#pragma unroll
                    for (int k = 0; k < 4; ++k) { g0[k] = fsig(g0[k]) * o0[k]; g1[k] = fsig(g1[k]) * o1[k]; }
                    if (br != 0) { f32x4 p0, p1; unpack8(mx[m][bj], p0, p1); g0 += p0; g1 += p1; }
                    *(u32x4*)(MIX + off) = pack8(g0, g1); }
        }
    }
};
struct EpiResid {
    static constexpr bool PERM = true, AFTER_DRAIN = false;
    const float* base; float* out;
    __device__ __forceinline__ void operator()(const f32x4 (&acc)[2][2][4][2], const Unit& u, int wr, int wc, int fr, int fq) const {
        const int row0 = u.pm * BM + wr * 64 + fr, c0 = u.pn * 256 + wc * 32 + 8 * fq;
#pragma unroll
        for (int ai = 0; ai < 2; ++ai)
#pragma unroll
            for (int mh = 0; mh < 2; ++mh) {
                f32x4 x[2][2][2];
#pragma unroll
                for (int mm = 0; mm < 2; ++mm)
#pragma unroll
                    for (int bj = 0; bj < 2; ++bj) { const size_t off = (size_t)(row0 + ai * HALF + (2 * mh + mm) * 16) * DM + c0 + bj * HALF; x[mm][bj][0] = *(const f32x4*)(base + off); x[mm][bj][1] = *(const f32x4*)(base + off + 4); }
#pragma unroll
                for (int mm = 0; mm < 2; ++mm)
#pragma unroll
                    for (int bj = 0; bj < 2; ++bj) { const int m = 2 * mh + mm; const size_t off = (size_t)(row0 + ai * HALF + m * 16) * DM + c0 + bj * HALF;
                        *(f32x4*)(out + off) = x[mm][bj][0] + acc[ai][bj][m][0]; *(f32x4*)(out + off + 4) = x[mm][bj][1] + acc[ai][bj][m][1]; }
            }
    }
};
struct EpiSwiglu {
    static constexpr bool PERM = true, AFTER_DRAIN = false;
    bf16* ACT; int ld, ntn;
    __device__ __forceinline__ void operator()(const f32x4 (&acc)[2][2][4][2], const Unit& u, int wr, int wc, int fr, int fq) const {
        const int row0 = u.pm * BM + wr * 64 + fr, c0 = (u.pn % ntn) * 128 + wc * 32 + 8 * fq;
#pragma unroll
        for (int ai = 0; ai < 2; ++ai)
#pragma unroll
            for (int m = 0; m < 4; ++m) { f32x4 g0 = acc[ai][0][m][0], g1 = acc[ai][0][m][1]; const f32x4 u0 = acc[ai][1][m][0], u1 = acc[ai][1][m][1];
#pragma unroll
                for (int k = 0; k < 4; ++k) { g0[k] = g0[k] * fsig(g0[k]) * u0[k]; g1[k] = g1[k] * fsig(g1[k]) * u1[k]; }
                *(u32x4*)(ACT + (size_t)(row0 + ai * HALF + m * 16) * ld + c0) = pack8(g0, g1); }
    }
};
struct EpiMoeDown {
    static constexpr bool PERM = true, AFTER_DRAIN = false;
    float* out; const int* rtok; const float* rw; int ntn; float sc;
    __device__ __forceinline__ void operator()(const f32x4 (&acc)[2][2][4][2], const Unit& u, int wr, int wc, int fr, int fq) const {
        const int row0 = u.pm * BM + wr * 64 + fr, c0 = (u.pn % ntn) * 256 + wc * 32 + 8 * fq;
#pragma unroll
        for (int ai = 0; ai < 2; ++ai)
#pragma unroll
            for (int mh = 0; mh < 2; ++mh) {
                int tok[2]; float w[2]; f32x4 x[2][2][2];
#pragma unroll
                for (int mm = 0; mm < 2; ++mm) { const int row = row0 + ai * HALF + (2 * mh + mm) * 16; tok[mm] = rtok[row]; w[mm] = rw[row] * sc; }
#pragma unroll
                for (int mm = 0; mm < 2; ++mm)
#pragma unroll
                    for (int bj = 0; bj < 2; ++bj) { const float* o = out + (size_t)(tok[mm] >= 0 ? tok[mm] : 0) * DM + c0 + bj * HALF; x[mm][bj][0] = *(const f32x4*)o; x[mm][bj][1] = *(const f32x4*)(o + 4); }
#pragma unroll
                for (int mm = 0; mm < 2; ++mm)
#pragma unroll
                    for (int bj = 0; bj < 2; ++bj) if (tok[mm] >= 0) { const int m = 2 * mh + mm; float* o = out + (size_t)tok[mm] * DM + c0 + bj * HALF;
                        *(f32x4*)o = x[mm][bj][0] + acc[ai][bj][m][0] * w[mm]; *(f32x4*)(o + 4) = x[mm][bj][1] + acc[ai][bj][m][1] * w[mm]; }
            }
    }
};

constexpr int MT_KS = 7, MT_K = EXPERT_FF / MT_KS;
struct MoeTailOrder {
    int nN, pm0, nsub, G, c, e0, e1, e2, e3, e4, e5, e6;
    __device__ void init(const MoeOrder& m, int pm0_, int ntiles, int G_, int c_) { nN = m.nN; pm0 = pm0_; nsub = ntiles * MT_KS; G = G_; c = c_; e0 = m.e0; e1 = m.e1; e2 = m.e2; e3 = m.e3; e4 = m.e4; e5 = m.e5; e6 = m.e6; }
    __device__ bool next(int i, Unit& u) const { const int L = i * G + c; if (L >= nsub) return false;
        const int j = L / MT_KS, ks = L - j * MT_KS, pm = pm0 + j / nN, pl = j % nN, e = (pm >= e0) + (pm >= e1) + (pm >= e2) + (pm >= e3) + (pm >= e4) + (pm >= e5) + (pm >= e6);
        u.pm = rfl(pm); u.pn = rfl((e * nN + pl) | (ks << 16)); return true; }
    __device__ __forceinline__ void a_ready(const Unit&) const {}
    __device__ __forceinline__ void done(const Unit&) const {}
};
struct EpiPart {
    static constexpr bool PERM = true, AFTER_DRAIN = false;
    float* part; int pm0, nN;
    __device__ __forceinline__ void operator()(const f32x4 (&acc)[2][2][4][2], const Unit& u, int wr, int wc, int fr, int fq) const {
        const int slot = ((u.pm - pm0) * nN + (u.pn & 0xffff) % nN) * MT_KS + (u.pn >> 16);
        float* b = part + (size_t)slot * 65536 + (size_t)(((wr * 4 + wc) * 64 + fq * 16 + fr) * 4);
#pragma unroll
        for (int ai = 0; ai < 2; ++ai)
#pragma unroll
            for (int bj = 0; bj < 2; ++bj)
#pragma unroll
                for (int m = 0; m < 4; ++m)
#pragma unroll
                    for (int n = 0; n < 2; ++n) *(f32x4*)(b + (((ai * 2 + bj) * 4 + m) * 2 + n) * 2048) = acc[ai][bj][m][n];
    }
};
__device__ __forceinline__ void moe_tail_combine(const EpiMoeDown& E, const MoeOrder& mo, const float* part, int pm0, int job, int lane_in) {
    int lane = lane_in; asm volatile("" : "+v"(lane));
    const int q = job & 3, role = (job >> 2) & 7, j = job >> 5, ai = q >> 1, mh = q & 1, pm = pm0 + j / mo.nN, pl = j % mo.nN, wr = role >> 2, wc = role & 3, fr = lane & 15, fq = lane >> 4;
    const float* b = part + (size_t)j * MT_KS * 65536 + (size_t)((role * 64 + lane) * 4);
    f32x4 a[2][2][2];
#pragma unroll
    for (int mm = 0; mm < 2; ++mm)
#pragma unroll
        for (int bj = 0; bj < 2; ++bj)
#pragma unroll
            for (int n = 0; n < 2; ++n) a[mm][bj][n] = *(const f32x4*)(b + (((ai * 2 + bj) * 4 + 2 * mh + mm) * 2 + n) * 2048);
#pragma unroll
    for (int ks = 1; ks < MT_KS; ++ks)
#pragma unroll
        for (int mm = 0; mm < 2; ++mm)
#pragma unroll
            for (int bj = 0; bj < 2; ++bj)
#pragma unroll
                for (int n = 0; n < 2; ++n) a[mm][bj][n] += *(const f32x4*)(b + (size_t)ks * 65536 + (((ai * 2 + bj) * 4 + 2 * mh + mm) * 2 + n) * 2048);
    const int row0 = pm * BM + wr * 64 + fr + ai * HALF + 2 * mh * 16, c0 = pl * 256 + wc * 32 + 8 * fq;
#pragma unroll
    for (int mm = 0; mm < 2; ++mm) { const int tok = E.rtok[row0 + mm * 16]; const float w = E.rw[row0 + mm * 16] * E.sc;
        if (tok >= 0) {
#pragma unroll
            for (int bj = 0; bj < 2; ++bj) { float* o = E.out + (size_t)tok * DM + c0 + bj * HALF; const f32x4 x0 = *(const f32x4*)o, x1 = *(const f32x4*)(o + 4);
                *(f32x4*)o = x0 + a[mm][bj][0] * w; *(f32x4*)(o + 4) = x1 + a[mm][bj][1] * w; } } }
}

typedef short bf16x8_t __attribute__((ext_vector_type(8)));
#define MFMA16(a, b, c) __builtin_amdgcn_mfma_f32_16x16x32_bf16((a), (b), (c), 0, 0, 0)
constexpr float ATT_C = 0.125f * 1.4426950408889634f;
constexpr int AW_IMP = 0, AW_SEL = 8448, AW_QS = 8960, AW_BYTES = 8960 + 8192;
__device__ __forceinline__ float bperm_f(float v, int srclane) { return __builtin_bit_cast(float, __builtin_amdgcn_ds_bpermute(srclane << 2, __builtin_bit_cast(int, v))); }
__device__ __forceinline__ int bperm_i(int v, int srclane) { return __builtin_amdgcn_ds_bpermute(srclane << 2, v); }
__device__ __forceinline__ bf16x8_t ldg8(const bf16* p) { return *(const bf16x8_t*)p; }
__device__ __forceinline__ bf16x8_t pack_p(const f32x4& a, const f32x4& b) {
    v4u w; w.x = cvt_pk_bf16(a[0], a[1]); w.y = cvt_pk_bf16(a[2], a[3]); w.z = cvt_pk_bf16(b[0], b[1]); w.w = cvt_pk_bf16(b[2], b[3]); return __builtin_bit_cast(bf16x8_t, w); }

__device__ __forceinline__ void nsa_attn_item(const P& p, int item, int lane, LAS unsigned char* wl) {
    const bf16* KV = WSP(bf16, AR_KV); const bf16* KC = WSP(bf16, AR_KC); const bf16* VcT = WSP(bf16, AR_VCT); const bf16* VsT = WSP(bf16, WS_VST); const bf16* VwT = WSP(bf16, WS_VWT);
    bf16* QB = WSP(bf16, AR_QB); const float* NG = WSP(float, AR_NG);
    const int bg = item / (SEQ / 16), t0 = (item % (SEQ / 16)) * 16, b = bg >> 1, g = bg & 1;
    const int col = lane & 15, fq = lane >> 4, tok = t0 + col;
    const size_t grow = (size_t)b * SEQ + tok;
    LAS float* IMP = (LAS float*)(wl + AW_IMP); LAS int* SEL = (LAS int*)(wl + AW_SEL); LAS bf16* OS = (LAS bf16*)(wl + AW_IMP);
    const int krowA = 8 * (col >> 2) + (col & 3);
    const float* gate = NG + grow * 24 + g * 12;
    LAS bf16x8_t* QS = (LAS bf16x8_t*)(wl + AW_QS) + lane;
#pragma unroll
    for (int hh = 0; hh < 4; ++hh)
#pragma unroll
        for (int ks = 0; ks < 2; ++ks) QS[(hh * 2 + ks) * 64] = ldg8(QB + grow * LDQ + (g * 4 + hh) * 64 + ks * 32 + fq * 8);
#define Qc(hh, ks) (QS[((hh) * 2 + (ks)) * 64])
    for (int i = lane; i < 16 * 132; i += 64) IMP[i] = 0.f;
    const f32x4 z4 = {0.f, 0.f, 0.f, 0.f};
    f32x4 O[4][4];
    int nvmax = (t0 + 15 >= 31) ? (((t0 + 15 - 31) >> 4) + 1) : 0; if (nvmax > NC) nvmax = NC;
    const int nch = (nvmax + 31) >> 5;
    const bf16* kcb = KC + (size_t)bg * 512 * 64; const bf16* vcb = VcT + (size_t)bg * 64 * 512;
    float linv[4] = {0.f, 0.f, 0.f, 0.f};
#pragma unroll
    for (int hh = 0; hh < 4; ++hh)
#pragma unroll
        for (int mt = 0; mt < 4; ++mt) O[hh][mt] = z4;
#pragma unroll 1
    for (int pass = 0; pass < 2; ++pass) {
#pragma unroll 1
        for (int ch = 0; ch < nch; ++ch) {
            asm volatile("" ::: "memory");
            const int k0 = 32 * ch; const bool cfull = 16 * (k0 + 31) + 31 <= t0;
            bf16x8_t ka[2][2];
#pragma unroll
            for (int tl = 0; tl < 2; ++tl)
#pragma unroll
                for (int ks = 0; ks < 2; ++ks) ka[tl][ks] = ldg8(kcb + ((size_t)(4 * ks + fq) * 512 + k0 + 16 * tl + col) * 8);
            bf16x8_t va[4];
            if (pass == 1) {
#pragma unroll
                for (int mt = 0; mt < 4; ++mt) va[mt] = ldg8(vcb + ((size_t)((k0 >> 3) + fq) * 64 + 16 * mt + col) * 8);
            }
            float ps[8] = {0.f, 0.f, 0.f, 0.f, 0.f, 0.f, 0.f, 0.f};
#pragma unroll
            for (int hh = 0; hh < 4; ++hh) {
                const bf16x8_t q0_ = Qc(hh, 0), q1_ = Qc(hh, 1);
                f32x4 sa = MFMA16(ka[0][0], q0_, z4); sa = MFMA16(ka[0][1], q1_, sa);
                f32x4 sb = MFMA16(ka[1][0], q0_, z4); sb = MFMA16(ka[1][1], q1_, sb);
#pragma unroll
                for (int i = 0; i < 4; ++i) { sa[i] = __builtin_amdgcn_exp2f(sa[i]); sb[i] = __builtin_amdgcn_exp2f(sb[i]); }
                if (!cfull) {
#pragma unroll
                    for (int i = 0; i < 4; ++i) { const int c = k0 + 4 * fq + i; sa[i] = (16 * c + 31 <= tok) ? sa[i] : 0.f; sb[i] = (16 * (c + 16) + 31 <= tok) ? sb[i] : 0.f; } }
                if (pass == 0) { linv[hh] += (sa[0] + sa[1]) + (sa[2] + sa[3]) + (sb[0] + sb[1]) + (sb[2] + sb[3]); }
                else {
#pragma unroll
                    for (int i = 0; i < 4; ++i) { ps[i] = __builtin_fmaf(sa[i], linv[hh], ps[i]); ps[4 + i] = __builtin_fmaf(sb[i], linv[hh], ps[4 + i]); }
                    const bf16x8_t pt = pack_p(sa, sb);
#pragma unroll
                    for (int mt = 0; mt < 4; ++mt) O[hh][mt] = MFMA16(va[mt], pt, O[hh][mt]);
                }
            }
            if (pass == 1) {
                const int Ga = 8 * ch + fq; LAS float* ir = IMP + col * 132 + Ga;
                __hip_atomic_fetch_add(ir, (ps[0] + ps[1]) + (ps[2] + ps[3]), __ATOMIC_RELAXED, __HIP_MEMORY_SCOPE_WORKGROUP);
                __hip_atomic_fetch_add(ir + 1, ps[3], __ATOMIC_RELAXED, __HIP_MEMORY_SCOPE_WORKGROUP);
                __hip_atomic_fetch_add(ir + 4, (ps[4] + ps[5]) + (ps[6] + ps[7]), __ATOMIC_RELAXED, __HIP_MEMORY_SCOPE_WORKGROUP);
                if (Ga + 5 < NS) __hip_atomic_fetch_add(ir + 5, ps[7], __ATOMIC_RELAXED, __HIP_MEMORY_SCOPE_WORKGROUP);
            }
        }
        if (pass == 0) {
#pragma unroll
            for (int hh = 0; hh < 4; ++hh) { float l = linv[hh]; l += bperm_f(l, lane ^ 16); l += bperm_f(l, lane ^ 32); linv[hh] = l > 0.f ? 1.f / l : 0.f; }
        }
    }
    LDS_WAIT(); asm volatile("" ::: "memory");
    {
        const int cur = tok >> 6; LAS float* sc = IMP + col * 132;
        for (int j = fq * 32; j < fq * 32 + 32; ++j) { const bool forced = (j == 0) || (j == cur) || (j == cur - 1); const float v = sc[j]; sc[j] = forced ? 1e4f : (j <= cur ? v : -1.f); }
        LDS_WAIT(); asm volatile("" ::: "memory");
#pragma unroll 1
        for (int r = 0; r < 8; ++r) {
            float bv = sc[fq * 32]; int bj = fq * 32;
            for (int j = fq * 32 + 1; j < fq * 32 + 32; ++j) { const float v = sc[j]; if (v > bv) { bv = v; bj = j; } }
#pragma unroll
            for (int o = 16; o <= 32; o <<= 1) { const float ov = bperm_f(bv, lane ^ o); const int oj = bperm_i(bj, lane ^ o); if (ov > bv || (ov == bv && oj < bj)) { bv = ov; bj = oj; } }
            if ((bj >> 5) == fq) sc[bj] = -3e38f;
            if (fq == 0) SEL[col * 8 + r] = bj;
            LDS_WAIT(); asm volatile("" ::: "memory");
        }
    }
#pragma unroll
    for (int hh = 0; hh < 4; ++hh) { const float g0 = gate[hh * 3 + 0] * linv[hh];
#pragma unroll
        for (int mt = 0; mt < 4; ++mt) { const f32x4 o = O[hh][mt] * g0; v2u w; w.x = cvt_pk_bf16(o[0], o[1]); w.y = cvt_pk_bf16(o[2], o[3]);
            *(LAS v2u*)(OS + (col * 4 + hh) * 64 + 16 * mt + 4 * fq) = w; } }
    LDS_WAIT(); asm volatile("" ::: "memory");
    const int cur = t0 >> 6;
    {
        const bf16* kwb = WSP(bf16, WS_KW8) + (size_t)bg * 8 * SEQ * 8; const bf16* vwb = VwT + (size_t)bg * 64 * SEQ;
        const bf16* ksb = WSP(bf16, WS_KS8) + (size_t)bg * 8 * SEQ * 8; const bf16* vsb = VsT + (size_t)bg * 64 * SEQ;
        int kst = t0 - (WINDOW - 1); if (kst < 0) kst = 0; kst &= ~31;
        const int nwin = ((t0 + 15 - kst) >> 5) + 1, nfb = cur >= 2 ? 3 : cur + 1;
#pragma unroll 1
        for (int part = 0; part < 2; ++part) {
            float lw[4] = {0.f, 0.f, 0.f, 0.f};
#pragma unroll
            for (int hh = 0; hh < 4; ++hh)
#pragma unroll
                for (int mt = 0; mt < 4; ++mt) O[hh][mt] = z4;
            const bf16* kb = part ? ksb : kwb; const bf16* vb = part ? vsb : vwb;
            const int nchk = part ? 2 * nfb : nwin;
#pragma unroll 1
            for (int ci = 0; ci < nchk; ++ci) {
                asm volatile("" ::: "memory");
                int k0;
                if (part == 0) k0 = kst + 32 * ci; else { const int fb = ci >> 1, j = fb == 0 ? 0 : (fb == 1 ? cur : cur - 1); k0 = 64 * j + 32 * (ci & 1); }
                bf16x8_t ka[2][2], va[4];
#pragma unroll
                for (int tl = 0; tl < 2; ++tl)
#pragma unroll
                    for (int ks = 0; ks < 2; ++ks) ka[tl][ks] = ldg8(kb + ((size_t)(4 * ks + fq) * SEQ + k0 + 16 * tl + col) * 8);
#pragma unroll
                for (int mt = 0; mt < 4; ++mt) va[mt] = ldg8(vb + ((size_t)((k0 >> 3) + fq) * 64 + 16 * mt + col) * 8);
                const int lowk = part ? -1 : tok - WINDOW; const bool dfull = (k0 + 31 <= t0) && (part || k0 > t0 + 15 - WINDOW);
#pragma unroll
                for (int hh = 0; hh < 4; ++hh) {
                    const bf16x8_t q0_ = Qc(hh, 0), q1_ = Qc(hh, 1);
                    f32x4 sa = MFMA16(ka[0][0], q0_, z4); sa = MFMA16(ka[0][1], q1_, sa);
                    f32x4 sb = MFMA16(ka[1][0], q0_, z4); sb = MFMA16(ka[1][1], q1_, sb);
#pragma unroll
                    for (int i = 0; i < 4; ++i) { sa[i] = __builtin_amdgcn_exp2f(sa[i]); sb[i] = __builtin_amdgcn_exp2f(sb[i]); }
                    if (!dfull) {
#pragma unroll
                        for (int i = 0; i < 4; ++i) { const int kt = k0 + 4 * fq + i; sa[i] = (kt <= tok && kt > lowk) ? sa[i] : 0.f; sb[i] = (kt + 16 <= tok && kt + 16 > lowk) ? sb[i] : 0.f; } }
                    lw[hh] += (sa[0] + sa[1]) + (sa[2] + sa[3]) + (sb[0] + sb[1]) + (sb[2] + sb[3]);
                    const bf16x8_t pt = pack_p(sa, sb);
#pragma unroll
                    for (int mt = 0; mt < 4; ++mt) O[hh][mt] = MFMA16(va[mt], pt, O[hh][mt]);
                }
            }
            LDS_WAIT(); asm volatile("" ::: "memory");
            if (part == 0) {
#pragma unroll
                for (int hh = 0; hh < 4; ++hh) { float l = lw[hh]; l += bperm_f(l, lane ^ 16); l += bperm_f(l, lane ^ 32); const float w = l > 0.f ? gate[hh * 3 + 2] / l : 0.f;
#pragma unroll
                    for (int mt = 0; mt < 4; ++mt) { LAS v2u* dp = (LAS v2u*)(OS + (col * 4 + hh) * 64 + 16 * mt + 4 * fq); const v2u old = *dp;
                        v2u w2; w2.x = cvt_pk_bf16(blo(old.x) + w * O[hh][mt][0], bhi(old.x) + w * O[hh][mt][1]); w2.y = cvt_pk_bf16(blo(old.y) + w * O[hh][mt][2], bhi(old.y) + w * O[hh][mt][3]); *dp = w2; } }
            } else {
                LAS bf16* OF = (LAS bf16*)(wl + AW_QS); LAS float* LF = (LAS float*)(wl + AW_IMP + 8192);
#pragma unroll
                for (int hh = 0; hh < 4; ++hh) { float l = lw[hh]; l += bperm_f(l, lane ^ 16); l += bperm_f(l, lane ^ 32); if (fq == 0) LF[col * 4 + hh] = l;
#pragma unroll
                    for (int mt = 0; mt < 4; ++mt) { v2u w2; w2.x = cvt_pk_bf16(O[hh][mt][0], O[hh][mt][1]); w2.y = cvt_pk_bf16(O[hh][mt][2], O[hh][mt][3]); *(LAS v2u*)(OF + (col * 4 + hh) * 64 + 16 * mt + 4 * fq) = w2; } }
            }
            LDS_WAIT(); asm volatile("" ::: "memory");
        }
    }
    {
        const bf16* ksb = WSP(bf16, WS_KS8) + (size_t)bg * 8 * SEQ * 8; const bf16* vsb = VsT + (size_t)bg * 64 * SEQ;
        const LAS bf16* OF = (const LAS bf16*)(wl + AW_QS); const LAS float* LF = (const LAS float*)(wl + AW_IMP + 8192);
#pragma unroll 1
        for (int tt = 0; tt < 16; ++tt) {
            const int tq = t0 + tt; const size_t qrow = (size_t)b * SEQ + tq;
            bf16x8_t Qh[2];
#pragma unroll
            for (int ks = 0; ks < 2; ++ks) { Qh[ks] = ldg8(QB + qrow * LDQ + (g * 4 + (col & 3)) * 64 + ks * 32 + fq * 8); if (col >= 4) Qh[ks] = (bf16x8_t){0, 0, 0, 0, 0, 0, 0, 0}; }
            f32x4 Os[4] = {z4, z4, z4, z4}; float ls = 0.f;
#ifdef APROBE_SEL
            for (int rp = 0; rp < 2; ++rp) { Os[0] = z4; Os[1] = z4; Os[2] = z4; Os[3] = z4; ls = 0.f; asm volatile("" ::: "memory");
#endif
#pragma unroll 1
            for (int r8 = 0; r8 < 8; ++r8) {
                const int j = __builtin_amdgcn_readfirstlane(SEL[tt * 8 + r8]);
                if (64 * j > tq || j == 0 || j == cur || j == cur - 1) continue;
                const int kb0 = 64 * j;
                bf16x8_t ka[2][2][2], va[2][4];
#pragma unroll
                for (int hf = 0; hf < 2; ++hf) {
#pragma unroll
                    for (int tl = 0; tl < 2; ++tl)
#pragma unroll
                        for (int ks = 0; ks < 2; ++ks) ka[hf][tl][ks] = ldg8(ksb + ((size_t)(4 * ks + fq) * SEQ + kb0 + 32 * hf + 16 * tl + col) * 8);
#pragma unroll
                    for (int mt = 0; mt < 4; ++mt) va[hf][mt] = ldg8(vsb + ((size_t)(((kb0 + 32 * hf) >> 3) + fq) * 64 + 16 * mt + col) * 8);
                }
#pragma unroll
                for (int hf = 0; hf < 2; ++hf) {
                    f32x4 sa = MFMA16(ka[hf][0][0], Qh[0], z4); sa = MFMA16(ka[hf][0][1], Qh[1], sa);
                    f32x4 sb = MFMA16(ka[hf][1][0], Qh[0], z4); sb = MFMA16(ka[hf][1][1], Qh[1], sb);
#pragma unroll
                    for (int i = 0; i < 4; ++i) { sa[i] = __builtin_amdgcn_exp2f(sa[i]); sb[i] = __builtin_amdgcn_exp2f(sb[i]); }
                    ls += (sa[0] + sa[1]) + (sa[2] + sa[3]) + (sb[0] + sb[1]) + (sb[2] + sb[3]);
                    const bf16x8_t pt = pack_p(sa, sb);
#pragma unroll
                    for (int mt = 0; mt < 4; ++mt) Os[mt] = MFMA16(va[hf][mt], pt, Os[mt]);
                }
            }
#ifdef APROBE_SEL
            }
#endif
            ls += bperm_f(ls, lane ^ 16); ls += bperm_f(ls, lane ^ 32);
            if (col < 4) {
                const float den = ls + LF[tt * 4 + col]; const float w = den > 0.f ? (NG + qrow * 24 + g * 12)[col * 3 + 1] / den : 0.f;
#pragma unroll
                for (int mt = 0; mt < 4; ++mt) { const int e = (tt * 4 + col) * 64 + 16 * mt + 4 * fq; const v2u old = *(const LAS v2u*)(OS + e), fo = *(const LAS v2u*)(OF + e);
                    v2u w2; w2.x = cvt_pk_bf16(blo(old.x) + w * (Os[mt][0] + blo(fo.x)), bhi(old.x) + w * (Os[mt][1] + bhi(fo.x))); w2.y = cvt_pk_bf16(blo(old.y) + w * (Os[mt][2] + blo(fo.y)), bhi(old.y) + w * (Os[mt][3] + bhi(fo.y)));
                    *(v2u*)(QB + qrow * LDQ + (g * 4 + col) * 64 + 16 * mt + 4 * fq) = w2; }
            }
        }
    }
    LDS_WAIT(); asm volatile("" ::: "memory");
#undef Qc
}

typedef _Float16 h16x2 __attribute__((ext_vector_type(2)));
__device__ __forceinline__ h16x2 as_h2(unsigned u) { h16x2 r; __builtin_memcpy(&r, &u, 4); return r; }
constexpr int SC_STEPS = 8, SC_BUF = 6 * 1024;
__device__ __forceinline__ float dpp_sum16(float v) {
    v += __builtin_bit_cast(float, __builtin_amdgcn_update_dpp(0, __builtin_bit_cast(int, v), 0xB1, 0xF, 0xF, true));
    v += __builtin_bit_cast(float, __builtin_amdgcn_update_dpp(0, __builtin_bit_cast(int, v), 0x4E, 0xF, 0xF, true));
    v += __builtin_bit_cast(float, __builtin_amdgcn_update_dpp(0, __builtin_bit_cast(int, v), 0x141, 0xF, 0xF, true));
    v += __builtin_bit_cast(float, __builtin_amdgcn_update_dpp(0, __builtin_bit_cast(int, v), 0x140, 0xF, 0xF, true));
    return v;
}
__device__ __forceinline__ void scan_fill(const bf16* RW, const bf16* Wm, const bf16* Am, size_t trow, int h, int lane, LAS unsigned char* buf) {
    const size_t t = trow + (lane >> 3); const int sub = (lane & 7) * 8;
    const bf16* row = RW + t * LDRW + h * 64 + sub;
    __builtin_amdgcn_global_load_lds((const unsigned*)(row + LBLK), (LAS unsigned*)(buf + 0 * 1024), 16, 0, 0);
    __builtin_amdgcn_global_load_lds((const unsigned*)(Am + t * RC + h * 64 + sub), (LAS unsigned*)(buf + 1 * 1024), 16, 0, 0);
    __builtin_amdgcn_global_load_lds((const unsigned*)(Wm + t * RC + h * 64 + sub), (LAS unsigned*)(buf + 2 * 1024), 16, 0, 0);
    __builtin_amdgcn_global_load_lds((const unsigned*)(row + 512), (LAS unsigned*)(buf + 3 * 1024), 16, 0, 0);
    __builtin_amdgcn_global_load_lds((const unsigned*)(row), (LAS unsigned*)(buf + 4 * 1024), 16, 0, 0);
    __builtin_amdgcn_global_load_lds((const unsigned*)(row + 1024), (LAS unsigned*)(buf + 5 * 1024), 16, 0, 0);
}
__device__ __forceinline__ void scan_unit(const P& p, int unit, int lane, LAS unsigned char* wl) {
    const bf16* RW = WSP(bf16, AR_RW); const bf16* Wm = WSP(bf16, AR_W); const bf16* Am = WSP(bf16, AR_A); bf16* Y = WSP(bf16, AR_UB);
    const int rg = unit & 15, h = (unit >> 4) & 7, b = unit >> 7, row = rg * 4 + (lane >> 4), kq = lane & 15;
    const size_t tb = (size_t)b * SEQ;
    float s0 = 0.f, s1 = 0.f, s2 = 0.f, s3 = 0.f;
    __builtin_amdgcn_s_setprio(3);
    scan_fill(RW, Wm, Am, tb, h, lane, wl);
#pragma unroll 1
    for (int c = 0; c < SEQ / SC_STEPS; ++c) {
        LAS unsigned char* buf = wl + (c & 1) * SC_BUF;
        asm volatile("s_waitcnt vmcnt(0) lgkmcnt(0)" ::: "memory");
        if (c + 1 < SEQ / SC_STEPS) scan_fill(RW, Wm, Am, tb + (size_t)(c + 1) * SC_STEPS, h, lane, wl + ((c + 1) & 1) * SC_BUF);
#ifndef SCAN_VARB
        float ys[SC_STEPS];
#pragma unroll
        for (int st = 0; st < SC_STEPS; ++st) {
            const LAS unsigned char* o = buf + st * 128 + kq * 8;
            const v2u kkw = *(const LAS v2u*)(o), bbw = *(const LAS v2u*)(o + 1024), eew = *(const LAS v2u*)(o + 2048), ktw = *(const LAS v2u*)(o + 3072), rrw = *(const LAS v2u*)(o + 4096);
#ifdef SCAN_BF16
            struct F2 { float x, y; }; const F2 kk0{blo(kkw.x), bhi(kkw.x)}, kk1{blo(kkw.y), bhi(kkw.y)}, bb0{blo(bbw.x), bhi(bbw.x)}, bb1{blo(bbw.y), bhi(bbw.y)}, ee0{blo(eew.x), bhi(eew.x)}, ee1{blo(eew.y), bhi(eew.y)}, kt0{blo(ktw.x), bhi(ktw.x)}, kt1{blo(ktw.y), bhi(ktw.y)}, rr0{blo(rrw.x), bhi(rrw.x)}, rr1{blo(rrw.y), bhi(rrw.y)};
            const float vv = bf2f(*(const LAS unsigned short*)(buf + 5 * 1024 + st * 128 + row * 2));
#else
            const h16x2 kk0 = as_h2(kkw.x), kk1 = as_h2(kkw.y), bb0 = as_h2(bbw.x), bb1 = as_h2(bbw.y);
            const h16x2 ee0 = as_h2(eew.x), ee1 = as_h2(eew.y);
#ifdef RKV_BF16
            struct F2 { float x, y; }; const F2 kt0{blo(ktw.x), bhi(ktw.x)}, kt1{blo(ktw.y), bhi(ktw.y)}, rr0{blo(rrw.x), bhi(rrw.x)}, rr1{blo(rrw.y), bhi(rrw.y)};
            const float vv = bf2f(*(const LAS unsigned short*)(buf + 5 * 1024 + st * 128 + row * 2));
#else
            const h16x2 kt0 = as_h2(ktw.x), kt1 = as_h2(ktw.y);
            const h16x2 rr0 = as_h2(rrw.x), rr1 = as_h2(rrw.y);
            const float vv = (float)__builtin_bit_cast(_Float16, *(const LAS unsigned short*)(buf + 5 * 1024 + st * 128 + row * 2));
#endif
#endif
            float d0 = __builtin_fmaf(s0, (float)kk0.x, 0.f); d0 = __builtin_fmaf(s1, (float)kk0.y, d0); float d1 = __builtin_fmaf(s2, (float)kk1.x, 0.f); d1 = __builtin_fmaf(s3, (float)kk1.y, d1);
            const float nskk = -dpp_sum16(d0 + d1);
            s0 = __builtin_fmaf(s0, -(float)ee0.x, s0); s1 = __builtin_fmaf(s1, -(float)ee0.y, s1); s2 = __builtin_fmaf(s2, -(float)ee1.x, s2); s3 = __builtin_fmaf(s3, -(float)ee1.y, s3);
            s0 = __builtin_fmaf(nskk, (float)bb0.x, s0); s1 = __builtin_fmaf(nskk, (float)bb0.y, s1); s2 = __builtin_fmaf(nskk, (float)bb1.x, s2); s3 = __builtin_fmaf(nskk, (float)bb1.y, s3);
            s0 = __builtin_fmaf(vv, (float)kt0.x, s0); s1 = __builtin_fmaf(vv, (float)kt0.y, s1); s2 = __builtin_fmaf(vv, (float)kt1.x, s2); s3 = __builtin_fmaf(vv, (float)kt1.y, s3);
            float y0 = __builtin_fmaf(s0, (float)rr0.x, 0.f); y0 = __builtin_fmaf(s1, (float)rr0.y, y0); float y1 = __builtin_fmaf(s2, (float)rr1.x, 0.f); y1 = __builtin_fmaf(s3, (float)rr1.y, y1);
            ys[st] = dpp_sum16(y0 + y1);
        }
        if (kq < SC_STEPS) { float yv = ys[0];
#pragma unroll
            for (int st = 1; st < SC_STEPS; ++st) yv = (kq == st) ? ys[st] : yv;
            Y[(tb + (size_t)c * SC_STEPS + kq) * RC + h * 64 + row] = f2bf(yv); }
    }
#else
#pragma unroll
        for (int st = 0; st < SC_STEPS; ++st) {
            const LAS unsigned char* o = buf + st * 128 + kq * 8;
            float kk[4], bb[4], ee[4], kt[4], rr[4];
            { const v2u w = *(const LAS v2u*)(o); const h16x2 a = as_h2(w.x), b2 = as_h2(w.y); kk[0] = (float)a.x; kk[1] = (float)a.y; kk[2] = (float)b2.x; kk[3] = (float)b2.y; }
            { const v2u w = *(const LAS v2u*)(o + 1024); const h16x2 a = as_h2(w.x), b2 = as_h2(w.y); bb[0] = (float)a.x; bb[1] = (float)a.y; bb[2] = (float)b2.x; bb[3] = (float)b2.y; }
            { const v2u w = *(const LAS v2u*)(o + 2048); const h16x2 a = as_h2(w.x), b2 = as_h2(w.y); ee[0] = (float)a.x; ee[1] = (float)a.y; ee[2] = (float)b2.x; ee[3] = (float)b2.y; }
            { const v2u w = *(const LAS v2u*)(o + 3072); const h16x2 a = as_h2(w.x), b2 = as_h2(w.y); kt[0] = (float)a.x; kt[1] = (float)a.y; kt[2] = (float)b2.x; kt[3] = (float)b2.y; }
            { const v2u w = *(const LAS v2u*)(o + 4096); const h16x2 a = as_h2(w.x), b2 = as_h2(w.y); rr[0] = (float)a.x; rr[1] = (float)a.y; rr[2] = (float)b2.x; rr[3] = (float)b2.y; }
            const float vv = (float)__builtin_bit_cast(_Float16, *(const LAS unsigned short*)(buf + 5 * 1024 + st * 128 + row * 2));
            const float skk = dpp_sum16((s0 * kk[0] + s1 * kk[1]) + (s2 * kk[2] + s3 * kk[3]));
            s0 = s0 - s0 * ee[0] - skk * bb[0] + vv * kt[0]; s1 = s1 - s1 * ee[1] - skk * bb[1] + vv * kt[1]; s2 = s2 - s2 * ee[2] - skk * bb[2] + vv * kt[2]; s3 = s3 - s3 * ee[3] - skk * bb[3] + vv * kt[3];
            const float y = dpp_sum16((s0 * rr[0] + s1 * rr[1]) + (s2 * rr[2] + s3 * rr[3]));
            if (kq == 0) Y[(tb + (size_t)c * SC_STEPS + st) * RC + h * 64 + row] = f2bf(y);
        }
    }
#endif
    asm volatile("s_waitcnt vmcnt(0) lgkmcnt(0)" ::: "memory");
    __builtin_amdgcn_s_setprio(0);
}
__device__ __forceinline__ float sum8(float v) {
    v += __builtin_bit_cast(float, __builtin_amdgcn_update_dpp(0, __builtin_bit_cast(int, v), 0xB1, 0xF, 0xF, true));
    v += __builtin_bit_cast(float, __builtin_amdgcn_update_dpp(0, __builtin_bit_cast(int, v), 0x4E, 0xF, 0xF, true));
    v += __builtin_bit_cast(float, __builtin_amdgcn_update_dpp(0, __builtin_bit_cast(int, v), 0x141, 0xF, 0xF, true));
    return v;
}
__device__ __forceinline__ void up8(v4u w, float* f) { f[0] = blo(w.x); f[1] = bhi(w.x); f[2] = blo(w.y); f[3] = bhi(w.y); f[4] = blo(w.z); f[5] = bhi(w.z); f[6] = blo(w.w); f[7] = bhi(w.w); }
#ifdef SCAN_BF16
#define uph8 up8
#define pkh8 pk8
#else
#define uph8 uph8_
#define pkh8 pkh8_
#endif
__device__ __forceinline__ void uph8_(v4u w, float* f) { const h16x2 a = as_h2(w.x), b = as_h2(w.y), c = as_h2(w.z), d = as_h2(w.w);
    f[0] = (float)a.x; f[1] = (float)a.y; f[2] = (float)b.x; f[3] = (float)b.y; f[4] = (float)c.x; f[5] = (float)c.y; f[6] = (float)d.x; f[7] = (float)d.y; }
__device__ __forceinline__ unsigned pkh2(float lo, float hi) { h16x2 v; v.x = (_Float16)lo; v.y = (_Float16)hi; return __builtin_bit_cast(unsigned, v); }
__device__ __forceinline__ v4u pkh8_(const float* f) { v4u w; w.x = pkh2(f[0], f[1]); w.y = pkh2(f[2], f[3]); w.z = pkh2(f[4], f[5]); w.w = pkh2(f[6], f[7]); return w; }
__device__ __forceinline__ v4u pk8(const float* f) { v4u w; w.x = cvt_pk_bf16(f[0], f[1]); w.y = cvt_pk_bf16(f[2], f[3]); w.z = cvt_pk_bf16(f[4], f[5]); w.w = cvt_pk_bf16(f[6], f[7]); return w; }
__device__ __forceinline__ void ldf8(const float* p, float* f) { const f32x4 a = *(const f32x4*)p, b = *(const f32x4*)(p + 4); f[0] = a[0]; f[1] = a[1]; f[2] = a[2]; f[3] = a[3]; f[4] = b[0]; f[5] = b[1]; f[6] = b[2]; f[7] = b[3]; }

struct EpiLora {
    static constexpr bool PERM = true, AFTER_DRAIN = false;
    unsigned char* ws;
    __device__ __forceinline__ void operator()(const f32x4 (&acc)[2][2][4][2], const Unit& u, int wr, int wc, int fr, int fq) const {
        const int which = u.pn >> 1, row0 = u.pm * BM + wr * 64 + fr, c0 = (u.pn & 1) * 256 + wc * 32 + 8 * fq;
        bf16* const O = (bf16*)(ws + (which == 0 ? AR_W : (which == 1 ? AR_A : (which == 2 ? AR_G : AR_UB))));
#pragma unroll
        for (int ai = 0; ai < 2; ++ai)
#pragma unroll
            for (int m = 0; m < 4; ++m)
#pragma unroll
                for (int bj = 0; bj < 2; ++bj) *(u32x4*)(O + (size_t)(row0 + ai * HALF + m * 16) * RC + c0 + bj * HALF) = pack8(acc[ai][bj][m][0], acc[ai][bj][m][1]);
    }
};
#ifdef RKV_BF16
#define UPR up8
#define PKR pk8
#else
#define UPR uph8
#define PKR pkh8
#endif
struct B2In { v4u k, a, w, vr, vv, vf; float gt; };
__device__ __forceinline__ void b2w_load(B2In& in, const P& p, int layer, int t, int lane) {
    const bf16* row = WSP(bf16, AR_RW) + (size_t)t * LDRW;
    in.k = *(const v4u*)(row + 512 + 8 * lane); in.a = *(const v4u*)(WSP(bf16, AR_A) + (size_t)t * RC + 8 * lane); in.w = *(const v4u*)(WSP(bf16, AR_W) + (size_t)t * RC + 8 * lane);
    in.gt = lane < 24 ? bf2f(row[LBLK + 320 + lane]) : 0.f;
    if (layer == 1) { in.vr = *(const v4u*)(WSP(bf16, AR_UB) + (size_t)t * RC + 8 * lane); in.vv = *(const v4u*)(row + 1024 + 8 * lane); in.vf = *(const v4u*)(WSP(bf16, WS_VF) + (size_t)t * RC + 8 * lane); }
}
__device__ __forceinline__ void b2w_compute(const B2In& in, const P& p, int layer, int t, int lane, const float* v0, const float* v1, const float* v2, const float* v3, const float* vb) {
    bf16* row = WSP(bf16, AR_RW) + (size_t)t * LDRW; bf16* Am = WSP(bf16, AR_A); bf16* Wm = WSP(bf16, AR_W); float* NG = WSP(float, AR_NG);
    float k[8], a[8], w[8]; uph8(in.k, k); up8(in.a, a); up8(in.w, w);
    const float ngv = fsig(in.gt);
    float kk[8], ss = 0.f;
#pragma unroll
    for (int i = 0; i < 8; ++i) {
        a[i] = fsig(a[i] + v1[i]);
        const float nx = -(w[i] + v0[i]), sp = fmaxf(nx, 0.f) + __logf(1.f + __expf(-fabsf(nx))), e = __expf(-sp - 0.5f); w[i] = 1.f - __expf(-e);
        kk[i] = k[i] * v2[i]; ss += kk[i] * kk[i]; }
    ss = sum8(ss); const float nrm = sqrtf(ss), inv = 1.f / (nrm > 1e-12f ? nrm : 1e-12f);
#pragma unroll
    for (int i = 0; i < 8; ++i) { kk[i] *= inv; k[i] = k[i] * (1.f + (a[i] - 1.f) * v3[i]); a[i] *= kk[i]; }
    asm volatile("" :: "v"(ngv));
    if (layer == 1) { float vr[8], vv[8], vf[8]; up8(in.vr, vr); uph8(in.vv, vv); uph8(in.vf, vf);
#pragma unroll
        for (int i = 0; i < 8; ++i) vv[i] = vv[i] + (vf[i] - vv[i]) * fsig(vr[i] + vb[i]);
        *(v4u*)(row + 1024 + 8 * lane) = pkh8(vv); }
    if (lane < 24) NG[(size_t)t * 24 + lane] = ngv;
    *(v4u*)(row + LBLK + 8 * lane) = pkh8(kk); *(v4u*)(row + 512 + 8 * lane) = pkh8(k);
    *(v4u*)(Am + (size_t)t * RC + 8 * lane) = pkh8(a); *(v4u*)(Wm + (size_t)t * RC + 8 * lane) = pkh8(w);
}
__device__ __forceinline__ void ph_rwkv_b2w(const P& p, int layer, int gw, int NGW, int lane) {
    const float* vec = p.rwkv_vec + (size_t)layer * 7 * RC; float v0[8], v1[8], v2[8], v3[8], vb[8];
    ldf8(vec + 8 * lane, v0); ldf8(vec + RC + 8 * lane, v1); ldf8(vec + 2 * RC + 8 * lane, v2); ldf8(vec + 3 * RC + 8 * lane, v3); ldf8(p.vres_b + 8 * lane, vb);
    int t = gw; if (t >= T) return;
    B2In A, B; b2w_load(A, p, layer, t, lane);
    for (; t < T; t += 2 * NGW) { const int t1 = t + NGW, t2 = t1 + NGW;
        b2w_load(B, p, layer, t1 < T ? t1 : t, lane); b2w_compute(A, p, layer, t, lane, v0, v1, v2, v3, vb);
        if (t1 < T) { b2w_load(A, p, layer, t2 < T ? t2 : t1, lane); b2w_compute(B, p, layer, t1, lane, v0, v1, v2, v3, vb); } }
}
struct PoIn { v4u y, r, k, v, g; };
__device__ __forceinline__ void post_load(PoIn& in, const P& p, int t, int lane) { const bf16* row = WSP(bf16, AR_RW) + (size_t)t * LDRW;
    in.y = *(const v4u*)(WSP(bf16, AR_UB) + (size_t)t * RC + 8 * lane); in.r = *(const v4u*)(row + 8 * lane); in.k = *(const v4u*)(row + 512 + 8 * lane); in.v = *(const v4u*)(row + 1024 + 8 * lane); in.g = *(const v4u*)(WSP(bf16, AR_G) + (size_t)t * RC + 8 * lane); }
__device__ __forceinline__ void post_compute(const PoIn& in, const P& p, int t, int lane, const float* v4_, const float* v5, const float* v6) {
    float y[8], r[8], k[8], v[8], g[8]; up8(in.y, y); uph8(in.r, r); uph8(in.k, k); uph8(in.v, v); up8(in.g, g);
    float s = 0.f, bon = 0.f;
#pragma unroll
    for (int i = 0; i < 8; ++i) { s += y[i]; bon += r[i] * k[i] * v4_[i]; }
    const float m = sum8(s) * (1.f / 64.f); bon = sum8(bon);
    float q = 0.f;
#pragma unroll
    for (int i = 0; i < 8; ++i) { y[i] -= m; q += y[i] * y[i]; }
    const float rstd = 1.f / sqrtf(sum8(q) * (1.f / 64.f) + GN_EPS);
#pragma unroll
    for (int i = 0; i < 8; ++i) y[i] = (y[i] * rstd * v5[i] + v6[i] + bon * v[i]) * g[i];
    *(v4u*)(WSP(bf16, AR_A) + (size_t)t * RC + 8 * lane) = pk8(y);
}
__device__ __forceinline__ void ph_rwkv_postw(const P& p, int layer, int gw, int NGW, int lane) {
    const float* vec = p.rwkv_vec + (size_t)layer * 7 * RC; float v4_[8], v5[8], v6[8]; ldf8(vec + 4 * RC + 8 * lane, v4_); ldf8(vec + 5 * RC + 8 * lane, v5); ldf8(vec + 6 * RC + 8 * lane, v6);
    int t = gw; if (t >= T) return;
    PoIn A, B; post_load(A, p, t, lane);
    for (; t < T; t += 2 * NGW) { const int t1 = t + NGW, t2 = t1 + NGW;
        post_load(B, p, t1 < T ? t1 : t, lane); post_compute(A, p, t, lane, v4_, v5, v6);
        if (t1 < T) { post_load(A, p, t2 < T ? t2 : t1, lane); post_compute(B, p, t1, lane, v4_, v5, v6); } }
}
typedef float f32x2 __attribute__((ext_vector_type(2)));
__device__ __forceinline__ f32x2 up2(unsigned w) { f32x2 r; r.x = __builtin_bit_cast(float, w << 16); r.y = __builtin_bit_cast(float, w & 0xffff0000u); return r; }
__device__ __forceinline__ void ph_convw(const P& p, int layer, int gw, int NGW, int lane, int tid, LAS unsigned char* lds) {
    const bf16* UB = WSP(bf16, AR_UB); bf16* CO = WSP(bf16, AR_CO);
    const float* cw = p.conv_w + (size_t)layer * CONV_K * CONV_CH; const float* cv = p.conv_vec + (size_t)layer * 3 * CONV_CH;
    LAS float* wl = (LAS float*)lds;
    for (int i = tid; i < CONV_K * CONV_CH; i += NTHREADS) wl[i] = cw[i];
    for (int i = tid; i < 3 * CONV_CH; i += NTHREADS) wl[CONV_K * CONV_CH + i] = cv[i];
    __syncthreads();
    const LAS float* wlane = wl + 8 * lane;
    for (int tb = gw * 8; tb < T; tb += NGW * 8) {
        const int pos0 = tb % SEQ, j0 = pos0 >= 30 ? 0 : 30 - pos0;
        const bf16* ub = UB + ((size_t)tb * CONV_CH + 8 * lane) - (size_t)30 * CONV_CH;
        f32x2 a[8][4], wt[8][4]; v4u cur[8];
        { const f32x4 c0 = *(const LAS f32x4*)(wlane + CONV_K * CONV_CH), c1 = *(const LAS f32x4*)(wlane + CONV_K * CONV_CH + 4);
#pragma unroll
          for (int q = 0; q < 8; ++q) { a[q][0] = (f32x2){c0.x, c0.y}; a[q][1] = (f32x2){c0.z, c0.w}; a[q][2] = (f32x2){c1.x, c1.y}; a[q][3] = (f32x2){c1.z, c1.w}; } }
#pragma unroll
        for (int jj = 0; jj < 8; ++jj) cur[jj] = jj >= j0 ? *(const v4u*)(ub + (size_t)jj * CONV_CH) : (v4u){0u, 0u, 0u, 0u};
#pragma unroll 1
        for (int g = 0; g < 5; ++g) {
#pragma unroll
            for (int jj = 0; jj < 8; ++jj) { const int j = 8 * g + jj;
                if (j < CONV_K) { const f32x4 w0 = *(const LAS f32x4*)(wlane + j * CONV_CH), w1 = *(const LAS f32x4*)(wlane + j * CONV_CH + 4);
                    wt[jj][0] = (f32x2){w0.x, w0.y}; wt[jj][1] = (f32x2){w0.z, w0.w}; wt[jj][2] = (f32x2){w1.x, w1.y}; wt[jj][3] = (f32x2){w1.z, w1.w}; }
                f32x2 u[4]; u[0] = up2(cur[jj].x); u[1] = up2(cur[jj].y); u[2] = up2(cur[jj].z); u[3] = up2(cur[jj].w);
                if (j + 8 < CONV_K + 7) cur[jj] = j + 8 >= j0 ? *(const v4u*)(ub + (size_t)(j + 8) * CONV_CH) : (v4u){0u, 0u, 0u, 0u};
#pragma unroll
                for (int q = 0; q < 8; ++q) { const int tap = j - q; if (tap >= 0 && tap < CONV_K) {
#pragma unroll
                    for (int i = 0; i < 4; ++i) a[q][i] = __builtin_elementwise_fma(u[i], wt[(jj - q) & 7][i], a[q][i]); } }
            }
        }
        const f32x4 g10 = *(const LAS f32x4*)(wlane + (CONV_K + 1) * CONV_CH), g11 = *(const LAS f32x4*)(wlane + (CONV_K + 1) * CONV_CH + 4);
        const f32x4 b20 = *(const LAS f32x4*)(wlane + (CONV_K + 2) * CONV_CH), b21 = *(const LAS f32x4*)(wlane + (CONV_K + 2) * CONV_CH + 4);
        const f32x2 g1[4] = {(f32x2){g10.x, g10.y}, (f32x2){g10.z, g10.w}, (f32x2){g11.x, g11.y}, (f32x2){g11.z, g11.w}}, b2[4] = {(f32x2){b20.x, b20.y}, (f32x2){b20.z, b20.w}, (f32x2){b21.x, b21.y}, (f32x2){b21.z, b21.w}};
#pragma unroll
        for (int q = 0; q < 8; ++q) {
            const f32x2 s2 = (a[q][0] + a[q][1]) + (a[q][2] + a[q][3]);
            const float mean = wave_sum(s2.x + s2.y, lane) * (1.f / CONV_CH); f32x2 q2 = (f32x2){0.f, 0.f};
#pragma unroll
            for (int i = 0; i < 4; ++i) { a[q][i] -= (f32x2){mean, mean}; q2 = __builtin_elementwise_fma(a[q][i], a[q][i], q2); }
            const float rstd = 1.f / sqrtf(wave_sum(q2.x + q2.y, lane) * (1.f / CONV_CH) + LN_EPS);
            float y[8];
#pragma unroll
            for (int i = 0; i < 4; ++i) { const f32x2 yy = __builtin_elementwise_fma(a[q][i] * (f32x2){rstd, rstd}, g1[i], b2[i]); y[2 * i] = yy.x * fsig(yy.x); y[2 * i + 1] = yy.y * fsig(yy.y); }
            *(v4u*)(CO + (size_t)(tb + q) * CONV_CH + 8 * lane) = pk8(y);
        }
    }
    __syncthreads();
}
__device__ __forceinline__ void ph_cmp2w(const P& p, int layer, int gw, int NGW, int lane, LAS float* hl  ) {
    const bf16* Z = WSP(bf16, AR_HID); const float* pec = (const float*)(p.ws + WS_W + (size_t)layer * SZ_LAYERW + OFF_PEC);
    for (int it = gw; it < 2 * BATCH * NKV * NC; it += NGW) {
        const int i = it % NC, r = it / NC, bg = r % (BATCH * NKV), which = r / (BATCH * NKV);
        const bf16* z1 = Z + ((size_t)which * (BATCH * NKV * 512) + (size_t)bg * 512 + i) * 256; const bf16* z2 = z1 + 256 + 128;
#pragma unroll
        for (int jj = 0; jj < 2; ++jj) { const int j = lane + 64 * jj; const float x = bf2f(z1[j]) + bf2f(z2[j]) + pec[which * 128 + j];
            const float e = __expf(fminf(2.f * 0.7978845608028654f * (x + 0.044715f * x * x * x), 30.f)); hl[j] = 0.5f * x * (1.f + (e - 1.f) / (e + 1.f)); }
        LDS_WAIT(); asm volatile("" ::: "memory");
        const float* w2 = p.cmp_w2 + (size_t)(layer * 2 + which) * 128 * 64 + lane; float o = 0.f;
#pragma unroll 8
        for (int j = 0; j < 128; ++j) o += hl[j] * w2[j * 64];
        if (which == 0) {
            const float rs = 1.f / sqrtf(wave_sum(o * o, lane) * (1.f / 64.f) + RMS_EPS); o = o * rs * p.qk_g[(layer * 4 + 1) * 64 + lane];
            const float other = bperm_f(o, lane ^ 32); float cs, sn; rope_cs(16 * i + 31, lane & 31, cs, sn);
            o = lane < 32 ? o * cs - other * sn : o * cs + other * sn;
            WSP(bf16, AR_KC)[(((size_t)bg * 8 + (lane >> 3)) * 512 + i) * 8 + (lane & 7)] = f2bf(o);
        } else { bf16* vt = WSP(bf16, AR_VCT) + (size_t)bg * 64 * 512 + lane * 8;
            vt[(size_t)((i >> 5) * 4 + ((i & 15) >> 2)) * 512 + (i & 3) + 4 * ((i >> 4) & 1)] = f2bf(o); if (i == 0) vt[(size_t)((NC >> 5) * 4 + ((NC & 15) >> 2)) * 512 + (NC & 3) + 4 * ((NC >> 4) & 1)] = 0; }
        LDS_WAIT(); asm volatile("" ::: "memory");
    }
}

struct MapPlain { bf16* base; int K; __device__ __forceinline__ bf16* operator()(int col) const { return base + (size_t)col * K; } };
struct MapGlu { bf16* base; int K, ff; __device__ __forceinline__ bf16* operator()(int col) const { return base + (size_t)glu_dest(col, ff) * K; } };
struct MapWin { unsigned char* wl; int layer; __device__ __forceinline__ bf16* operator()(int col) const { int which; const int r = win_dest(col, layer, which); const size_t off = (which ? OFF_WG : OFF_WIN) + (size_t)(r < 0 ? 0 : r) * DM * 2; return r < 0 ? nullptr : (bf16*)(wl + off); } };
template <class Map>
__device__ __forceinline__ void transpose_item(const float* W, int K, int N, const Map& mp, LAS float* scr, int item, int lane) {
    const int nblk = (N + 31) / 32, kb = item / nblk, nb = item % nblk, k0 = 64 * kb, n0 = 32 * nb;
    const int c4 = 4 * (lane & 7), col = n0 + c4;
    f32x4 v[8];
#pragma unroll
    for (int i = 0; i < 8; ++i) v[i] = col < N ? *(const f32x4*)(W + (size_t)(k0 + (lane >> 3) + 8 * i) * N + col) : (f32x4){0.f, 0.f, 0.f, 0.f};
#pragma unroll
    for (int i = 0; i < 8; ++i) { LAS float* d = scr + ((lane >> 3) + 8 * i) * 33 + c4; d[0] = v[i].x; d[1] = v[i].y; d[2] = v[i].z; d[3] = v[i].w; }
    LDS_WAIT(); asm volatile("" ::: "memory");
    const int c = lane & 7;
#pragma unroll
    for (int j = 0; j < 4; ++j) { const int n = (lane >> 3) + 8 * j; const LAS float* s = scr + (8 * c) * 33 + n;
        v4u o; o.x = (unsigned)f2bf(s[0]) | ((unsigned)f2bf(s[33]) << 16); o.y = (unsigned)f2bf(s[66]) | ((unsigned)f2bf(s[99]) << 16);
        o.z = (unsigned)f2bf(s[132]) | ((unsigned)f2bf(s[165]) << 16); o.w = (unsigned)f2bf(s[198]) | ((unsigned)f2bf(s[231]) << 16);
        if (n0 + n < N) { bf16* d = mp(n0 + n); if (d) *(v4u*)(d + k0 + 8 * c) = o; } }
    LDS_WAIT(); asm volatile("" ::: "memory");
}
template <class Map>
__device__ __forceinline__ bool conv_job(int& r, const float* W, int K, int N, const Map& mp, LAS float* scr, int lane) {
    const int items = (K / 64) * ((N + 31) / 32);
    if (r < items) { transpose_item(W, K, N, mp, scr, r, lane); return true; }
    r -= items; return false;
}

struct RmsIn { f32x4 v[DM / 256]; };
__device__ __forceinline__ void rms_load(RmsIn& r, const float* xrow, int lane) { const f32x4* xr = (const f32x4*)xrow + lane;
#pragma unroll
    for (int j = 0; j < DM / 256; ++j) r.v[j] = xr[64 * j]; }
__device__ __forceinline__ void rms_row(const P& p, const RmsIn& rin, const float* g, bf16* orow, int lane, bool route, int t, unsigned long long& c0, unsigned long long& c1) {
    const f32x4* gr = (const f32x4*)g + lane;
    f32x4 v[DM / 256]; float ss = 0.f;
#pragma unroll
    for (int j = 0; j < DM / 256; ++j) { v[j] = rin.v[j]; ss += (v[j].x * v[j].x + v[j].y * v[j].y) + (v[j].z * v[j].z + v[j].w * v[j].w); }
    const float rs = 1.f / sqrtf(wave_sum(ss, lane) * (1.f / DM) + RMS_EPS);
    v2u* o8 = (v2u*)orow + lane;
#pragma unroll
    for (int j = 0; j < DM / 256; ++j) { const f32x4 gg = gr[64 * j]; v[j].x *= rs * gg.x; v[j].y *= rs * gg.y; v[j].z *= rs * gg.z; v[j].w *= rs * gg.w;
        v2u w; w.x = cvt_pk_bf16(v[j].x, v[j].y); w.y = cvt_pk_bf16(v[j].z, v[j].w); o8[64 * j] = w; }
    if (route) {
        float lg[NEXP];
#pragma unroll
        for (int e = 0; e < NEXP; ++e) lg[e] = 0.f;
#pragma unroll
        for (int j = 0; j < DM / 256; ++j) { const float* rw = p.router_w + (size_t)(4 * (lane + 64 * j)) * NEXP;
#pragma unroll
            for (int e = 0; e < NEXP; ++e) lg[e] += v[j].x * rw[e] + v[j].y * rw[NEXP + e] + v[j].z * rw[2 * NEXP + e] + v[j].w * rw[3 * NEXP + e]; }
#pragma unroll
        for (int e = 0; e < NEXP; ++e) lg[e] = wave_sum(lg[e], lane) + p.router_b[e];
        int e0 = 0; float l0 = lg[0];
#pragma unroll
        for (int e = 1; e < NEXP; ++e) if (lg[e] > l0) { l0 = lg[e]; e0 = e; }
        int e1 = -1; float l1 = -3e38f;
#pragma unroll
        for (int e = 0; e < NEXP; ++e) if (e != e0 && lg[e] > l1) { l1 = lg[e]; e1 = e; }
        e0 = __builtin_amdgcn_readfirstlane(e0); e1 = __builtin_amdgcn_readfirstlane(e1);
        const int r0 = (int)((c0 >> (8 * e0)) & 255ull), r1 = (int)((c1 >> (8 * e1)) & 255ull);
        c0 += 1ull << (8 * e0); c1 += 1ull << (8 * e1);
        if (lane == 0) { const float w0 = 1.f / (1.f + expf(l1 - l0));
            WSP(int, AR_RTE)[t] = e0 | (e1 << 8) | (r0 << 16) | (r1 << 24); float* rw = WSP(float, AR_RTW) + (size_t)t * 2; rw[0] = w0; rw[1] = 1.f - w0; }
    }
}
__device__ __forceinline__ void rms_row_route(const P& p, const RmsIn& rin, const float* g, bf16* orow, int lane, int t, unsigned long long& c0, unsigned long long& c1, const float (&rwr)[128]) {
    const f32x4* gr = (const f32x4*)g + lane;
    f32x4 v[DM / 256]; float ss = 0.f;
#pragma unroll
    for (int j = 0; j < DM / 256; ++j) { v[j] = rin.v[j]; ss += (v[j].x * v[j].x + v[j].y * v[j].y) + (v[j].z * v[j].z + v[j].w * v[j].w); }
    const float rs = 1.f / sqrtf(wave_sum(ss, lane) * (1.f / DM) + RMS_EPS);
    v2u* o8 = (v2u*)orow + lane;
#pragma unroll
    for (int j = 0; j < DM / 256; ++j) { const f32x4 gg = gr[64 * j]; v[j].x *= rs * gg.x; v[j].y *= rs * gg.y; v[j].z *= rs * gg.z; v[j].w *= rs * gg.w;
        v2u w; w.x = cvt_pk_bf16(v[j].x, v[j].y); w.y = cvt_pk_bf16(v[j].z, v[j].w); o8[64 * j] = w; }
    float lg[NEXP];
#pragma unroll
    for (int e = 0; e < NEXP; ++e) lg[e] = 0.f;
#pragma unroll
    for (int j = 0; j < DM / 256; ++j)
#pragma unroll
        for (int e = 0; e < NEXP; ++e) lg[e] += v[j].x * rwr[(4 * j) * 8 + e] + v[j].y * rwr[(4 * j + 1) * 8 + e] + v[j].z * rwr[(4 * j + 2) * 8 + e] + v[j].w * rwr[(4 * j + 3) * 8 + e];
    float r4[4], r2[2], r1;
    { const bool hi = (lane & 32) != 0;
#pragma unroll
      for (int i = 0; i < 4; ++i) { const float mine = hi ? lg[4 + i] : lg[i], theirs = hi ? lg[i] : lg[4 + i]; r4[i] = mine + bperm_f(theirs, lane ^ 32); } }
    { const bool hi = (lane & 16) != 0;
#pragma unroll
      for (int i = 0; i < 2; ++i) { const float mine = hi ? r4[2 + i] : r4[i], theirs = hi ? r4[i] : r4[2 + i]; r2[i] = mine + bperm_f(theirs, lane ^ 16); } }
    { const bool hi = (lane & 8) != 0; const float mine = hi ? r2[1] : r2[0], theirs = hi ? r2[0] : r2[1]; r1 = mine + bperm_f(theirs, lane ^ 8); }
    r1 += bperm_f(r1, lane ^ 4); r1 += bperm_f(r1, lane ^ 2); r1 += bperm_f(r1, lane ^ 1);
#pragma unroll
    for (int e = 0; e < NEXP; ++e) lg[e] = __builtin_bit_cast(float, __builtin_amdgcn_readlane(__builtin_bit_cast(int, r1), 8 * e)) + p.router_b[e];
    int e0 = 0; float l0 = lg[0];
#pragma unroll
    for (int e = 1; e < NEXP; ++e) if (lg[e] > l0) { l0 = lg[e]; e0 = e; }
    int e1 = -1; float l1 = -3e38f;
#pragma unroll
    for (int e = 0; e < NEXP; ++e) if (e != e0 && lg[e] > l1) { l1 = lg[e]; e1 = e; }
    e0 = __builtin_amdgcn_readfirstlane(e0); e1 = __builtin_amdgcn_readfirstlane(e1);
    const int r0 = (int)((c0 >> (8 * e0)) & 255ull), r1i = (int)((c1 >> (8 * e1)) & 255ull);
    c0 += 1ull << (8 * e0); c1 += 1ull << (8 * e1);
    if (lane == 0) { const float w0 = 1.f / (1.f + expf(l1 - l0));
        WSP(int, AR_RTE)[t] = e0 | (e1 << 8) | (r0 << 16) | (r1i << 24); float* rw = WSP(float, AR_RTW) + (size_t)t * 2; rw[0] = w0; rw[1] = 1.f - w0; }
}
__device__ __forceinline__ void copy_rows4(const bf16* s0, const bf16* s1, const bf16* s2, const bf16* s3, bf16* d0, bf16* d1, bf16* d2, bf16* d3, int lane) {
    v4u a[4][DM / 512];
#pragma unroll
    for (int j = 0; j < DM / 512; ++j) { a[0][j] = ((const v4u*)s0)[lane + 64 * j]; a[1][j] = ((const v4u*)s1)[lane + 64 * j]; a[2][j] = ((const v4u*)s2)[lane + 64 * j]; a[3][j] = ((const v4u*)s3)[lane + 64 * j]; }
#pragma unroll
    for (int j = 0; j < DM / 512; ++j) { ((v4u*)d0)[lane + 64 * j] = a[0][j]; ((v4u*)d1)[lane + 64 * j] = a[1][j]; ((v4u*)d2)[lane + 64 * j] = a[2][j]; ((v4u*)d3)[lane + 64 * j] = a[3][j]; }
}
__device__ __forceinline__ void copy_row_wave(const bf16* src, bf16* dst, int lane) {
#pragma unroll
    for (int j = 0; j < DM / 512; ++j) ((v4u*)dst)[lane + 64 * j] = ((const v4u*)src)[lane + 64 * j];
}
__device__ __forceinline__ int moe_seg_start(const unsigned* cnt, int e) { int s = 0;
#pragma unroll
    for (int k = 0; k < NEXP; ++k) s += (k < e) ? (int)((cnt[k] + 255u) & ~255u) : 0;
    return s; }

#ifndef PHMASK
#define PHMASK 0xFFFFFFFFu
#endif
#define PHM(k) (((PHMASK) >> (k)) & 1u)
#ifdef PROBE_LO
constexpr int PR_LO = PROBE_LO, PR_HI = PROBE_HI;
#else
constexpr int PR_LO = -1, PR_HI = -1;
#endif
constexpr int NPH = 16, NPHASES = 1 + 2 * NPH;
struct Args { const float* in[29]; float* out; unsigned char* ws; int ph_lo, ph_hi; };

__device__ __forceinline__ bool in_phase(int k, int lo, int hi) { asm volatile("" : "+s"(lo), "+s"(hi)); return lo <= k && k < hi; }
typedef const Args __attribute__((address_space(4)))* CArgsP;
__device__ __forceinline__ void fill_params_k(P& p, CArgsP a) {
    p.x = a->in[0]; p.mix_norm_g = a->in[1]; p.w_in_first = a->in[2]; p.w_in_rest = a->in[3]; p.mu_first = a->in[4]; p.mu_rest = a->in[5]; p.qk_g = a->in[6]; p.cmp_pos = a->in[7];
    p.cmp_w1 = a->in[8]; p.cmp_w2 = a->in[9]; p.nsa_w_o = a->in[10]; p.conv_w = a->in[11]; p.conv_vec = a->in[12]; p.conv_w_o = a->in[13]; p.rwkv_vec = a->in[14]; p.w_up = a->in[15];
    p.a_up = a->in[16]; p.g_up = a->in[17]; p.vres_up = a->in[18]; p.vres_b = a->in[19]; p.rwkv_w_o = a->in[20]; p.w_out = a->in[21]; p.ffn_norm_g = a->in[22]; p.dense_gu = a->in[23];
    p.dense_down = a->in[24]; p.router_w = a->in[25]; p.router_b = a->in[26]; p.moe_gu = a->in[27]; p.moe_down = a->in[28]; p.out = a->out; p.ws = a->ws;
}
__global__ void __launch_bounds__(NTHREADS, 2) mk_fwd(Args args) {
    extern __shared__ __attribute__((aligned(16))) unsigned char lds_raw[];
    LAS unsigned char* lds = (LAS unsigned char*)lds_raw;
    const int wave0 = __builtin_amdgcn_readfirstlane((int)threadIdx.x >> 6);
    const int tid = wave0 * 64 + lane_id_opaque();
    unsigned* ctl = (unsigned*)(args.ws + WS_CTL);
    for (int u = tid; u < (LDS_BYTES - LDSCTL_OFF) / 4; u += NTHREADS) ((LAS unsigned*)(lds + LDSCTL_OFF))[u] = 0u;
    __syncthreads();
    const int lo = args.ph_lo, hi = args.ph_hi;
    XcdBarrier bar; bar.bar = ctl + CW_BAR; bar.x = 0; bar.st = nullptr;
    if (hi - lo > 1) { bar.x = xb_xcc_id(); bar.st = (volatile LAS unsigned*)(lds + MISC_OFF) + 8; if (tid == 0) (void)xb_add(ctl + CW_BAR + XB_XCNT(bar.x), 1u); }
#define RMS_LOOP(X, GN, ROUTE, C0, C1) do { int m_ = gw; if (m_ < T) { RmsIn ra_, rb_; rms_load(ra_, (X) + (size_t)m_ * DM, lane); \
        for (; m_ < T; m_ += 2 * NGW) { const int m1_ = m_ + NGW, m2_ = m1_ + NGW; rms_load(rb_, (X) + (size_t)(m1_ < T ? m1_ : m_) * DM, lane); \
            rms_row(p, ra_, (GN), WSP(bf16, WS_H) + (size_t)m_ * DM, lane, (ROUTE), m_, C0, C1); \
            if (m1_ < T) { rms_load(ra_, (X) + (size_t)(m2_ < T ? m2_ : m1_) * DM, lane); rms_row(p, rb_, (GN), WSP(bf16, WS_H) + (size_t)m1_ * DM, lane, (ROUTE), m1_, C0, C1); } } } } while (0)
#define RMS_LOOP_R(X, GN, C0, C1, RWR) do { int m_ = gw; if (m_ < T) { RmsIn ra_, rb_; rms_load(ra_, (X) + (size_t)m_ * DM, lane); \
        for (; m_ < T; m_ += 2 * NGW) { const int m1_ = m_ + NGW, m2_ = m1_ + NGW; rms_load(rb_, (X) + (size_t)(m1_ < T ? m1_ : m_) * DM, lane); \
            rms_row_route(p, ra_, (GN), WSP(bf16, WS_H) + (size_t)m_ * DM, lane, m_, C0, C1, RWR); \
            if (m1_ < T) { rms_load(ra_, (X) + (size_t)(m2_ < T ? m2_ : m1_) * DM, lane); rms_row_route(p, rb_, (GN), WSP(bf16, WS_H) + (size_t)m1_ * DM, lane, m1_, C0, C1, RWR); } } } } while (0)
#define IN(k) (in_phase((k), lo, hi) && (PR_LO < 0 || (st == 0 ? (k) <= PR_HI : (st == 1 ? ((k) >= PR_LO && (k) <= PR_HI) : (k) > PR_HI))))
#define MKP unsigned long long cdum0 = 0ull, cdum1 = 0ull; (void)cdum0; (void)cdum1; CArgsP ap_ = (CArgsP)__builtin_amdgcn_kernarg_segment_ptr(); asm volatile("" : "+s"(ap_)); P p; fill_params_k(p, ap_); int w0_ = wave0; asm volatile("" : "+s"(w0_)); int tid = w0_ * 64 + lane_id_opaque(); asm volatile("" : "+v"(tid)); const int lane = tid & 63, wave = __builtin_amdgcn_readfirstlane(tid >> 6); int G = gridDim.x, bid = blockIdx.x; asm volatile("" : "+s"(G), "+s"(bid)); unsigned* ctl = WSP(unsigned, WS_CTL); const long gtid = (long)bid * NTHREADS + tid, NT = (long)G * NTHREADS; const int gw = bid * NWAVES + wave, NGW = G * NWAVES; LAS float* scrw = (LAS float*)(lds + wave * 16384); (void)gtid; (void)NT; (void)gw; (void)NGW; (void)scrw; (void)lane; (void)ctl
#ifdef PROBE_TK
#define TKW(i) do { if (blockIdx.x == PROBE_BLK && threadIdx.x == 0) ((unsigned long long*)(args.ws + WS_CTL + 4 * CW_TK))[(i)] = __builtin_amdgcn_s_memrealtime(); } while (0)
#define TKP(i) do { if (layer == PROBE_LAYER) TKW(i); } while (0)
#define SEAM(k) do { if ((k) + 1 < hi) { int w_ = wave0; asm volatile("" : "+s"(w_)); xcd_barrier(bar, w_ * 64 + lane_id_opaque()); } \
    if ((k) == PROBE_TK) TKW(1); if ((k) == PROBE_TK - 1) TKW(0); } while (0)
#else
#define TKP(i) do { } while (0)
#define SEAM(k) do { if ((k) + 1 < hi) { int w_ = wave0; asm volatile("" : "+s"(w_)); xcd_barrier(bar, w_ * 64 + lane_id_opaque()); } } while (0)
#endif

    for (int st = 0; st < (PR_LO >= 0 ? 3 : 1); ++st) {
    if (PHM(16) && IN(0)) { MKP;
        constexpr int IT_WIN0 = (DM / 64) * ((N_IN_FIRST + 31) / 32), IT_WIN1 = (DM / 64) * ((N_IN_REST + 31) / 32), IT_WO = (512 / 64) * (DM / 32), IT_WOUT = (DM / 64) * (DM / 32);
        constexpr int total = IT_WIN0 + IT_WIN1 + 6 * IT_WO + 2 * IT_WOUT + (DM / 64) * (2 * DENSE_FF / 32) + (DENSE_FF / 64) * (DM / 32);
        bf16* wl0 = WSP(bf16, WS_W); bf16* wl1 = WSP(bf16, WS_W + SZ_LAYERW);
#define WOFF(b, o) ((bf16*)((unsigned char*)(b) + (o)))
        for (int it = gw; it < total; it += NGW) {
            int r = it;
            if (conv_job(r, p.w_in_first, DM, N_IN_FIRST, MapWin{(unsigned char*)wl0, 0}, scrw, lane)) continue;
            if (conv_job(r, p.w_in_rest, DM, N_IN_REST, MapWin{(unsigned char*)wl1, 1}, scrw, lane)) continue;
            if (conv_job(r, p.nsa_w_o, 512, DM, MapPlain{WOFF(wl0, OFF_WO3), 512}, scrw, lane)) continue;
            if (conv_job(r, p.rwkv_w_o, 512, DM, MapPlain{WOFF(wl0, OFF_WO3) + (size_t)DM * 512, 512}, scrw, lane)) continue;
            if (conv_job(r, p.conv_w_o, 512, DM, MapPlain{WOFF(wl0, OFF_WO3) + (size_t)2 * DM * 512, 512}, scrw, lane)) continue;
            if (conv_job(r, p.nsa_w_o + (size_t)512 * DM, 512, DM, MapPlain{WOFF(wl1, OFF_WO3), 512}, scrw, lane)) continue;
            if (conv_job(r, p.rwkv_w_o + (size_t)512 * DM, 512, DM, MapPlain{WOFF(wl1, OFF_WO3) + (size_t)DM * 512, 512}, scrw, lane)) continue;
            if (conv_job(r, p.conv_w_o + (size_t)512 * DM, 512, DM, MapPlain{WOFF(wl1, OFF_WO3) + (size_t)2 * DM * 512, 512}, scrw, lane)) continue;
            if (conv_job(r, p.w_out, DM, DM, MapPlain{WOFF(wl0, OFF_WOUT), DM}, scrw, lane)) continue;
            if (conv_job(r, p.w_out + (size_t)DM * DM, DM, DM, MapPlain{WOFF(wl1, OFF_WOUT), DM}, scrw, lane)) continue;
            if (conv_job(r, p.dense_gu, DM, 2 * DENSE_FF, MapGlu{WSP(bf16, WS_DGU), DM, DENSE_FF}, scrw, lane)) continue;
            conv_job(r, p.dense_down, DENSE_FF, DM, MapPlain{WSP(bf16, WS_DDN), DENSE_FF}, scrw, lane);
        }
        for (int l = 0; l < 2; ++l) {
            unsigned char* wlb = p.ws + WS_W + (size_t)l * SZ_LAYERW;
            bf16* win = (bf16*)(wlb + OFF_WIN);
            for (long i = gtid; i < 512L * DM; i += NT) { const int w = (int)(i / DM); const bool src = w < 288 || (w < 320 && l == 1) || (w >= 320 && w < 344); if (!src) win[(size_t)(3840 + w) * DM + i % DM] = 0; }
            bf16* lw = (bf16*)(wlb + OFF_LW);
            for (long i = gtid; i < 2048L * 384; i += NT) { const int n = (int)(i / 384), k = (int)(i % 384), blk = n >> 9, c = n & 511; float v = 0.f;
                if (blk == 0 && k < 64) v = p.w_up[((size_t)l * 64 + k) * RC + c]; else if (blk == 1 && k >= 64 && k < 128) v = p.a_up[((size_t)l * 64 + k - 64) * RC + c];
                else if (blk == 2 && k >= 128 && k < 288) v = p.g_up[((size_t)l * 160 + k - 128) * RC + c]; else if (blk == 3 && k >= 288 && k < 320 && l == 1) v = p.vres_up[(size_t)(k - 288) * RC + c];
                lw[i] = f2bf(v); }
            bf16* cw1 = (bf16*)(wlb + OFF_CW1);
            for (long i = gtid; i < 2L * 256 * 1024; i += NT) { const int k = (int)(i % 1024), n = (int)((i / 1024) % 256), which = (int)(i / (256 * 1024));
                cw1[i] = f2bf(p.cmp_w1[((size_t)(l * 2 + which) * 2048 + (n < 128 ? k : 1024 + k)) * 128 + (n & 127)]); }
        }
        for (int job = bid; job < 4; job += G) { const int l = job >> 1, which = job & 1;
            const float* pe = p.cmp_pos + (size_t)(l * 2 + which) * 2048; const float* w1 = p.cmp_w1 + (size_t)(l * 2 + which) * 2048 * 128 + 2 * lane;
            float s0 = 0.f, s1 = 0.f;
#pragma unroll 8
            for (int k = wave * 256; k < wave * 256 + 256; ++k) { const float2 wv = *(const float2*)(w1 + (size_t)k * 128); const float pk = pe[k]; s0 += pk * wv.x; s1 += pk * wv.y; }
            scrw[2 * lane] = s0; scrw[2 * lane + 1] = s1;
            __syncthreads();
            if (tid < 128) { float sum = 0.f;
#pragma unroll
                for (int w = 0; w < NWAVES; ++w) sum += ((const LAS float*)(lds + w * 16384))[tid];
                ((float*)(p.ws + WS_W + (size_t)l * SZ_LAYERW + OFF_PEC))[which * 128 + tid] = sum; }
            __syncthreads();
        }
    }

    for (int layer = 0; layer < 2; ++layer) {
        const int pb = 1 + layer * NPH;
        if (PHM(0) && IN(pb + 0)) { MKP;
            const float* xin = layer == 0 ? p.x : p.out;
            RMS_LOOP(xin, p.mix_norm_g + (size_t)layer * DM, false, cdum0, cdum1);
            SEAM(pb + 0);
        }
        if (PHM(1) && IN(pb + 1)) { MKP;
            Gemm g{WSP(bf16, WS_H), (const bf16*)(p.ws + WS_W + (size_t)layer * SZ_LAYERW + OFF_WIN), T, NPROJ, DM}; SOrder S; S.init(T, NPROJ, G, bid);
            EpiProj E{p.ws};
            pg8::gemm_phase<EpiProj, SOrder, true, true>(lds, g, S, E, tid);
            SEAM(pb + 1);
        }
        if (PHM(2) && IN(pb + 2)) { MKP;
            { Gemm g{WSP(bf16, AR_CKV), (const bf16*)(p.ws + WS_W + (size_t)layer * SZ_LAYERW + OFF_CW1), 2 * BATCH * NKV * 512, 512, 1024, 0}; StackOrder S{BATCH * NKV * 512 / 256, 1, 2, G, bid};
              EpiStore E{WSP(bf16, AR_HID), 256, 1};
              pg8::gemm_phase<EpiStore, StackOrder, true, true>(lds, g, S, E, tid); }
            TKP(2); ph_shift(p, layer, gtid, NT); TKP(3); ph_nsa_prep(p, layer, gtid, NT); TKP(4); ph_vtrans(p, gtid, NT); TKP(5);
            ph_convw(p, layer, gw, NGW, lane, tid, lds); TKP(6);
#ifdef APROBE_CONV
            ph_convw(p, layer, gw, NGW, lane, tid, lds);
#endif
#ifdef APROBE_VT
            ph_vtrans(p, gtid, NT);
#endif
            SEAM(pb + 2); }
        if (PHM(3) && IN(pb + 3)) { MKP;
#ifndef LORA_NAIVE
            { Gemm g{WSP(bf16, WS_LB), (const bf16*)(p.ws + WS_W + (size_t)layer * SZ_LAYERW + OFF_LW), T, 2048, 384, 0}; SOrder S; S.init(T, 2048, G, bid);
              EpiLora E{p.ws};
              pg8::gemm_phase<EpiLora, SOrder, false, true>(lds, g, S, E, tid); }
#else
            { bf16* RW = WSP(bf16, AR_RW); bf16* Wm = WSP(bf16, AR_W); bf16* Am = WSP(bf16, AR_A); bf16* Gm = WSP(bf16, AR_G); const bf16* VF = WSP(bf16, WS_VF);
              const float* vec = p.rwkv_vec + (size_t)layer * 7 * RC; const float* wup = p.w_up + (size_t)layer * 64 * RC; const float* aup = p.a_up + (size_t)layer * 64 * RC; const float* gup = p.g_up + (size_t)layer * 160 * RC;
              for (long it = gtid; it < (long)T * RC; it += NT) { const int t = (int)(it / RC), c = (int)(it % RC); bf16* row = RW + (size_t)t * LDRW; const bf16* L = row + LBLK;
                  float wl = vec[c], alin = vec[RC + c], g = 0.f;
                  for (int j = 0; j < 64; ++j) { wl += bf2f(L[j]) * bf2f(f2bf(wup[j * RC + c])); alin += bf2f(L[64 + j]) * bf2f(f2bf(aup[j * RC + c])); }
                  for (int j = 0; j < 160; ++j) g += bf2f(L[128 + j]) * bf2f(f2bf(gup[j * RC + c]));
                  const float nx = -wl, sp = fmaxf(nx, 0.f) + __logf(1.f + __expf(-fabsf(nx))), e = __expf(-sp - 0.5f);
                  Wm[it] = f2bf(1.f - __expf(-e)); Am[it] = f2bf(fsig(alin)); Gm[it] = f2bf(g);
                  if (layer == 1) { float vl = p.vres_b[c]; for (int j = 0; j < 32; ++j) vl += bf2f(L[288 + j]) * bf2f(f2bf(p.vres_up[j * RC + c]));
                      const float v = bf2f(row[1024 + c]), vf = bf2f(VF[it]); row[1024 + c] = f2bf(v + (vf - v) * fsig(vl)); } } }
#endif
            SEAM(pb + 3); }
        if (PHM(4) && IN(pb + 4)) { MKP; ph_rwkv_b2w(p, layer, gw, NGW, lane); ph_cmp2w(p, layer, gw, NGW, lane, (LAS float*)(lds + wave * 512)); SEAM(pb + 4); }
        if (PHM(5) && IN(pb + 5)) { MKP;
            { LAS unsigned char* wl = lds + wave * AW_BYTES; constexpr int NSC = BATCH * 8 * 16, NIT = BATCH * NKV * (SEQ / 16);
#ifndef SCAN_QUEUE
              if (wave < 4) {
                  if (G * 4 == NSC && (G & 7) == 0) scan_unit(p, (bid & 7) * (NSC / 8) + (bid >> 3) * 4 + wave, lane, wl);
                  else for (int u = bid * 4 + wave; u < NSC; u += G * 4) scan_unit(p, u, lane, wl); }
#endif
#ifdef APROBE_SPLIT
              xcd_barrier(bar, tid);
#endif
              const int xme = (int)(xb_xcc_id() & 7u);
              for (int qq = 0; qq < 8; ++qq) { const int qx = (xme + qq) & 7; unsigned* head = ctl + CW_ATT + ((layer * 3 + st) * 8 + qx) * 16;
                  for (;;) { int it = 0; if (lane == 0) it = (int)atomicAdd(head, 1u); it = __builtin_amdgcn_readfirstlane(it); if (it >= NIT / 8) break;
                      const int bg = 2 * qx + it / (SEQ / 16), t16 = (SEQ / 16 - 1) - it % (SEQ / 16);
                      nsa_attn_item(p, bg * (SEQ / 16) + t16, lane, wl); } } }
 SEAM(pb + 5); }
        if (PHM(6) && IN(pb + 6)) { MKP; ph_rwkv_postw(p, layer, gw, NGW, lane); SEAM(pb + 6); }
        if (PHM(7) && IN(pb + 7)) { MKP;
            Gemm g{WSP(bf16, AR_QB), (const bf16*)(p.ws + WS_W + (size_t)layer * SZ_LAYERW + OFF_WO3), 3 * T, 3 * DM, 512}; StackOrder S{T / 256, DM / 256, 3, G, bid};
            EpiStore E{WSP(bf16, AR_OBUF), DM, DM / 256};
            pg8::gemm_phase<EpiStore, StackOrder, true, true>(lds, g, S, E, tid);
            { MKP; const float* xin = layer == 0 ? p.x : p.out;
              RMS_LOOP(xin, p.mix_norm_g + (size_t)layer * DM, false, cdum0, cdum1); }
            SEAM(pb + 7);
        }
        if (PHM(8) && IN(pb + 8)) { MKP;
            Gemm g{WSP(bf16, WS_H), (const bf16*)(p.ws + WS_W + (size_t)layer * SZ_LAYERW + OFF_WG), T, 3 * DM, DM}; GateOrder S{T / 256, DM / 256, G, bid};
            EpiGate E{p.ws, DM / 256};
            pg8::gemm_phase<EpiGate, GateOrder, true, true>(lds, g, S, E, tid);
            SEAM(pb + 8);
        }
        if (PHM(9) && IN(pb + 9)) { MKP;
            Gemm g{WSP(bf16, AR_MIX), (const bf16*)(p.ws + WS_W + (size_t)layer * SZ_LAYERW + OFF_WOUT), T, DM, DM}; SOrder S; S.init(T, DM, G, bid);
            EpiResid E{layer == 0 ? p.x : p.out, p.out};
            pg8::gemm_phase<EpiResid, SOrder, true, true>(lds, g, S, E, tid);
            SEAM(pb + 9);
        }
        if (PHM(10) && IN(pb + 10)) { MKP;
            unsigned long long c0 = 0ull, c1 = 0ull;
            if (layer == 1) { float rwr[128];
#pragma unroll
                for (int j = 0; j < DM / 256; ++j)
#pragma unroll
                    for (int k = 0; k < 8; ++k) { const f32x4 w4 = *(const f32x4*)(p.router_w + (size_t)(4 * (lane + 64 * j)) * NEXP + 4 * k); rwr[j * 32 + 4 * k] = w4.x; rwr[j * 32 + 4 * k + 1] = w4.y; rwr[j * 32 + 4 * k + 2] = w4.z; rwr[j * 32 + 4 * k + 3] = w4.w; }
                RMS_LOOP_R(p.out, p.ffn_norm_g + (size_t)layer * DM, c0, c1, rwr);
            } else RMS_LOOP(p.out, p.ffn_norm_g + (size_t)layer * DM, false, c0, c1);
            if (layer == 1 && lane < 16) {
                const unsigned cn = (unsigned)(((lane < 8 ? c0 : c1) >> (8 * (lane & 7))) & 255ull);
                WSP(unsigned, AR_WBASE)[(size_t)gw * 16 + lane] = atomicAdd(ctl + CW_CNT + lane * 64, cn); }
            if (layer == 1) { int* rt = WSP(int, AR_RTOK); for (long i = gtid; i < 2L * MOE_ROWS; i += NT) rt[i] = -1; }
            SEAM(pb + 10);
        }
        if (layer == 0) {
            if (PHM(11) && IN(pb + 11)) { MKP;
                Gemm g{WSP(bf16, WS_H), WSP(bf16, WS_DGU), T, 2 * DENSE_FF, DM}; SOrder S; S.init(T, 2 * DENSE_FF, G, bid);
                EpiSwiglu E{WSP(bf16, AR_ACT), DENSE_FF, 2 * DENSE_FF / 256};
                pg8::gemm_phase<EpiSwiglu, SOrder, true, true>(lds, g, S, E, tid);
                SEAM(pb + 11);
            }
            if (PHM(12) && IN(pb + 12)) { MKP;
                Gemm g{WSP(bf16, AR_ACT), WSP(bf16, WS_DDN), T, DM, DENSE_FF}; SOrder S; S.init(T, DM, G, bid);
                EpiResid E{p.out, p.out};
                pg8::gemm_phase<EpiResid, SOrder, true, true>(lds, g, S, E, tid);
                SEAM(pb + 12);
            }
        } else {
            if (PHM(11) && IN(pb + 11)) { MKP;
                const int ig = (DM / 64) * (2 * EXPERT_FF / 32), id = (EXPERT_FF / 64) * (DM / 32);
                for (int it = gw; it < NEXP * (ig + id); it += NGW) { const int e = it / (ig + id); int r = it % (ig + id);
                    if (conv_job(r, p.moe_gu + (size_t)e * DM * 2 * EXPERT_FF, DM, 2 * EXPERT_FF, MapGlu{WSP(bf16, AR_MGU) + (size_t)e * 2 * EXPERT_FF * DM, DM, EXPERT_FF}, scrw, lane)) continue;
                    conv_job(r, p.moe_down + (size_t)e * EXPERT_FF * DM, EXPERT_FF, DM, MapPlain{WSP(bf16, AR_MDN) + (size_t)e * DM * EXPERT_FF, EXPERT_FF}, scrw, lane); }
                int* rtok = WSP(int, AR_RTOK); float* rww = WSP(float, AR_RW8); int* trow = WSP(int, AR_TROW);
                int segv = 0; { const int pc = lane < 16 ? (int)((ctl[CW_CNT + lane * 64] + 255u) & ~255u) : 0;
#pragma unroll
                    for (int k = 0; k < 8; ++k) { const int ck = bperm_i(pc, (lane & 8) + k); segv += (k < (lane & 7)) ? ck : 0; } }
                for (int hb = gw; hb < 2 * (T / 64); hb += NGW) {
                    const int tb = (hb >> 1) * 64, half = hb & 1, t = tb + lane; const int ee = WSP(int, AR_RTE)[t], e0 = ee & 255, e1 = (ee >> 8) & 255, r0 = (ee >> 16) & 255, r1 = (ee >> 24) & 255;
                    const float* w = WSP(float, AR_RTW) + (size_t)t * 2; const unsigned* wb = WSP(unsigned, AR_WBASE) + (size_t)(t % NGW) * 16;
                    const int row0 = bperm_i(segv, e0) + (int)wb[e0] + r0, row1 = bperm_i(segv, 8 + e1) + (int)wb[8 + e1] + r1;
                    if (half == 0) { rtok[row0] = t; rww[row0] = w[0]; rtok[MOE_ROWS + row1] = t; rww[MOE_ROWS + row1] = w[1]; trow[T + t] = row1; }
                    for (int l = 32 * half; l < 32 * half + 32; l += 4) { const bf16* hs = WSP(bf16, WS_H) + (size_t)(tb + l) * DM; bf16* xg = WSP(bf16, AR_XG);
                        copy_rows4(hs, hs + DM, hs + 2 * DM, hs + 3 * DM, xg + (size_t)__builtin_amdgcn_readlane(row0, l) * DM, xg + (size_t)__builtin_amdgcn_readlane(row0, l + 1) * DM, xg + (size_t)__builtin_amdgcn_readlane(row0, l + 2) * DM, xg + (size_t)__builtin_amdgcn_readlane(row0, l + 3) * DM, lane); }
                }
                SEAM(pb + 11);
            }
#pragma unroll
            for (int pass = 0; pass < 2; ++pass) {
                if (PHM(12) && IN(pb + 12 + 2 * pass)) { MKP;
                    Gemm g{WSP(bf16, AR_XG), WSP(bf16, AR_MGU), MOE_ROWS, NEXP * 2 * EXPERT_FF, DM}; MoeOrder S; S.init(ctl + CW_CNT + 8 * 64 * pass, 2 * EXPERT_FF / 256, G, bid);
                    EpiSwiglu E{WSP(bf16, AR_MACT), EXPERT_FF, 2 * EXPERT_FF / 256};
                    if (pass == 1) {
                        MoeOrder S0; S0.init(ctl + CW_CNT, DM / 256, G, bid); const int nwg = S0.s.nwg, mainw = (nwg / G) * G, ttiles = nwg - mainw;
                        if (bar.st != nullptr && (G & 31) == 0 && mainw > 0 && ttiles > 0 && ttiles <= 32) {
                            EpiMoeDown E0{p.out, WSP(int, AR_RTOK), WSP(float, AR_RW8), DM / 256, (PR_LO >= 0 && st == 0 && pb + 14 >= PR_LO && pb + 14 <= PR_HI) ? 0.f : 1.f};
                            for (int job = wave * G + bid; job < ttiles * 32; job += NWAVES * G) moe_tail_combine(E0, S0, WSP(float, WS_PART), mainw / (DM / 256), job, lane); } }
                    pg8::gemm_phase<EpiSwiglu, MoeOrder, true, true>(lds, g, S, E, tid);
                    SEAM(pb + 12 + 2 * pass);
                }
                if (PHM(13) && IN(pb + 13 + 2 * pass)) { MKP;
                    Gemm g{WSP(bf16, AR_MACT), WSP(bf16, AR_MDN), MOE_ROWS, NEXP * DM, EXPERT_FF}; MoeOrder S; S.init(ctl + CW_CNT + 8 * 64 * pass, DM / 256, G, bid);
                    EpiMoeDown E{p.out, WSP(int, AR_RTOK) + (size_t)pass * MOE_ROWS, WSP(float, AR_RW8) + (size_t)pass * MOE_ROWS, DM / 256, (PR_LO >= 0 && st == 0 && pb + 13 + 2 * pass >= PR_LO && pb + 13 + 2 * pass <= PR_HI) ? 0.f : 1.f};
                    if (pass == 0) { const int* trow = WSP(int, AR_TROW);
                        for (int t = gw * 4; t < T; t += NGW * 4) { const bf16* hs = WSP(bf16, WS_H) + (size_t)t * DM; bf16* xg = WSP(bf16, AR_XG);
                            copy_rows4(hs, hs + DM, hs + 2 * DM, hs + 3 * DM, xg + (size_t)trow[T + t] * DM, xg + (size_t)trow[T + t + 1] * DM, xg + (size_t)trow[T + t + 2] * DM, xg + (size_t)trow[T + t + 3] * DM, lane); } }
                    const int nwg = S.s.nwg, mainw = (nwg / G) * G, ttiles = nwg - mainw; const bool split = bar.st != nullptr && (G & 31) == 0 && mainw > 0 && ttiles > 0 && ttiles <= 32;
                    if (split) S.s.nwg = mainw;
                    pg8::gemm_phase<EpiMoeDown, MoeOrder, true, true>(lds, g, S, E, tid);
                    if (split) { Gemm g2{WSP(bf16, AR_MACT), WSP(bf16, AR_MDN), MOE_ROWS, NEXP * DM, MT_K, EXPERT_FF, EXPERT_FF}; MoeTailOrder S2; S2.init(S, mainw / (DM / 256), ttiles, G, bid);
                        EpiPart E2{WSP(float, WS_PART), mainw / (DM / 256), DM / 256};
                        pg8::gemm_phase<EpiPart, MoeTailOrder, true, true, true>(lds, g2, S2, E2, tid); }
                    if (pass == 1 && split) { { int w_ = wave0; asm volatile("" : "+s"(w_)); xcd_barrier(bar, w_ * 64 + lane_id_opaque()); }
                        for (int job = wave * G + bid; job < ttiles * 32; job += NWAVES * G) moe_tail_combine(E, S, WSP(float, WS_PART), mainw / (DM / 256), job, lane); }
                    SEAM(pb + 13 + 2 * pass);
                }
            }
        }
    }
    }
#ifdef PROBE_TK
    { int w_ = wave0; asm volatile("" : "+s"(w_)); xcd_barrier(bar, w_ * 64 + lane_id_opaque()); }
    if (blockIdx.x == 0 && threadIdx.x == 0) { const unsigned long long* tk = (const unsigned long long*)(args.ws + WS_CTL + 4 * CW_TK); __builtin_amdgcn_fence(__ATOMIC_SEQ_CST, "agent");
        args.out[0] += floorf((float)(long long)(tk[PROBE_A1] - tk[PROBE_A0]) * 0.01f / (float)(PROBE_TU)); }
#endif
#undef IN
#undef SEAM
}

#ifndef MK_ONE_LAUNCH
#define MK_ONE_LAUNCH 1
#endif
extern "C" void kernel_launch(void* const* d_in, const int* in_sizes, int n_in, void* d_out, int out_size, void* d_ws, size_t ws_size, hipStream_t stream) {
    static int grid = 0;
    if (grid == 0) {
        if (n_in != 29 || in_sizes[0] != T * DM || out_size != T * DM || ws_size < WS_END) { fprintf(stderr, "kernel_launch: unexpected shapes / workspace (%d inputs, ws %zu, need %zu)\n", n_in, ws_size, (size_t)WS_END); grid = -1; return; }
        int dev = 0, cus = 0;
        if (hipGetDevice(&dev) != hipSuccess || hipDeviceGetAttribute(&cus, hipDeviceAttributeMultiprocessorCount, dev) != hipSuccess) { grid = -1; return; }
        if (hipFuncSetAttribute((const void*)mk_fwd, hipFuncAttributeMaxDynamicSharedMemorySize, LDS_BYTES) != hipSuccess) { fprintf(stderr, "kernel_launch: hipFuncSetAttribute failed\n"); grid = -1; return; }
        int per_cu = 0;
        if (hipOccupancyMaxActiveBlocksPerMultiprocessor(&per_cu, (const void*)mk_fwd, NTHREADS, LDS_BYTES) != hipSuccess || per_cu < 1) { fprintf(stderr, "kernel_launch: occupancy query says %d\n", per_cu); }
        (void)hipGetLastError();
        grid = cus;
    }
    if (grid < 0) return;
    if (hipMemsetAsync((char*)d_ws + WS_CTL, 0, CTL_BYTES, stream) != hipSuccess) return;
    Args a{};
    for (int i = 0; i < 29; ++i) a.in[i] = (const float*)d_in[i];
    a.out = (float*)d_out; a.ws = (unsigned char*)d_ws;
#if MK_ONE_LAUNCH
    a.ph_lo = 0; a.ph_hi = NPHASES;
    hipLaunchKernelGGL(mk_fwd, dim3(grid), dim3(NTHREADS), LDS_BYTES, stream, a);
#else
    for (int k = 0; k < NPHASES; ++k) {
        if (k >= 1 + 13 && k < 1 + NPH) continue;
        a.ph_lo = k; a.ph_hi = k + 1;
        hipLaunchKernelGGL(mk_fwd, dim3(grid), dim3(NTHREADS), LDS_BYTES, stream, a);
    }
#endif
}
```

```cpp
#include <hip/hip_runtime.h>
#include <cstdio>
#include <cstdint>
#include <cmath>
#include <cstring>
#ifdef HOST_EMU
#define HD
#define DEV_INLINE inline
#else
#define HD __host__ __device__
#define DEV_INLINE __device__ __forceinline__
#endif

typedef unsigned short bf16;
struct alignas(16) U4 { unsigned x, y, z, w; };

#ifdef SMALL_CFG
constexpr int BATCH = 1, SEQ = 1024, DM = 128, DENSE_FF = 256, EXPERT_FF = 256;
#else
constexpr int BATCH = 8, SEQ = 8192, DM = 1024, DENSE_FF = 2816, EXPERT_FF = 3584;
#endif
constexpr int T = BATCH * SEQ;
constexpr int NHEAD = 8, NKV = 2, HG = 4, DH = 64;
constexpr int NC = SEQ / 16 - 1, NS = SEQ / 64, NSEL = 8, WINDOW = 512;
constexpr int CONV_CH = 512, CONV_K = 31, RC = 512;
constexpr int NEXP = 8;
constexpr int NSA_IN = 1304, OFF_CONV = 1304, OFF_GATE = 2328, OFF_RWKV = OFF_GATE + 3 * DM;
constexpr int N_IN_FIRST = OFF_RWKV + 1824, N_IN_REST = OFF_RWKV + 1856;
constexpr int NPROJ = 4352;
constexpr int LDQ = 512, LDKV = 512, LDRW = 2048, LBLK = 1536;
constexpr int MOE_ROWS = T + NEXP * 256;
constexpr float RMS_EPS = 1e-6f, LN_EPS = 1e-5f, GN_EPS = 64e-5f;

constexpr size_t al(size_t x) { return (x + 255) & ~(size_t)255; }
constexpr size_t WS_CTL = 0, CTL_BYTES = 1u << 20;
constexpr size_t SZ_WIN = (size_t)NPROJ * DM * 2, SZ_WG = (size_t)3 * DM * DM * 2, SZ_WO3 = (size_t)3 * DM * 512 * 2, SZ_WOUT = (size_t)DM * DM * 2;
constexpr size_t SZ_LW = (size_t)2048 * 384 * 2, SZ_CW1 = (size_t)2 * 256 * 1024 * 2, SZ_PEC = 1024;
constexpr size_t SZ_LAYERW = SZ_WIN + SZ_WG + SZ_WO3 + SZ_WOUT + SZ_LW + SZ_CW1 + SZ_PEC;
constexpr size_t WS_W = CTL_BYTES;
constexpr size_t OFF_WIN = 0, OFF_WG = SZ_WIN, OFF_WO3 = OFF_WG + SZ_WG, OFF_WOUT = OFF_WO3 + SZ_WO3, OFF_LW = OFF_WOUT + SZ_WOUT, OFF_CW1 = OFF_LW + SZ_LW, OFF_PEC = OFF_CW1 + SZ_CW1;
constexpr size_t WS_DGU = WS_W + 2 * SZ_LAYERW, SZ_DGU = (size_t)2 * DENSE_FF * DM * 2;
constexpr size_t WS_DDN = WS_DGU + SZ_DGU, SZ_DDN = (size_t)DM * DENSE_FF * 2;
constexpr size_t WS_VF = al(WS_DDN + SZ_DDN), SZ_TC = (size_t)T * 512 * 2;
constexpr size_t WS_H = WS_VF + SZ_TC, SZ_H = (size_t)T * DM * 2;
constexpr size_t WS_PART = WS_VF;
static_assert((size_t)32 * 7 * 65536 * 4 <= SZ_TC, "WS_PART");
constexpr size_t WS_AR = al(WS_H + SZ_H);
constexpr size_t AR_QB = WS_AR, AR_A = AR_QB + SZ_TC, AR_CO = AR_A + SZ_TC;
constexpr size_t AR_KV = AR_CO + SZ_TC, SZ_KV = (size_t)T * LDKV * 2;
constexpr size_t AR_RW = AR_KV + SZ_KV, SZ_RW = (size_t)T * LDRW * 2;
constexpr size_t AR_W = AR_RW + SZ_RW, AR_G = AR_W + SZ_TC, AR_UB = AR_G + SZ_TC;
constexpr size_t AR_NG = AR_UB + SZ_TC, SZ_NG = (size_t)T * 24 * 4;
constexpr size_t AR_HALO = al(AR_NG + SZ_NG), SZ_HALO = (size_t)(T / 256) * LDRW * 2;
constexpr size_t AR_KC = al(AR_HALO + SZ_HALO), SZ_CMP = (size_t)BATCH * NKV * (SEQ / 16) * 64 * 2;
constexpr size_t AR_VC = AR_KC + SZ_CMP;
constexpr size_t AR_HID = al(AR_VC + SZ_CMP), SZ_HID = (size_t)BATCH * NKV * (SEQ / 16) * 2 * 128 * 4;
constexpr size_t AR_SEL = al(AR_HID + SZ_HID), SZ_SEL = (size_t)T * NKV * 8 * 4;
constexpr size_t AR_INVN = al(AR_SEL + SZ_SEL), SZ_INVN = (size_t)T * 8 * 4;
constexpr size_t AR_VCT = al(AR_INVN + SZ_INVN);
constexpr size_t AR_CKV = al(AR_VCT + SZ_CMP), SZ_CKV = (size_t)2 * T * 128;
constexpr size_t AR_END1 = al(AR_CKV + SZ_CKV * 2);
constexpr size_t WS_VST = WS_H, WS_VWT = WS_H + (size_t)T * 128 * 2, WS_LB = WS_VWT + (size_t)T * 128 * 2, WS_KS8 = WS_LB + (size_t)T * 384 * 2, WS_KW8 = WS_KS8 + (size_t)T * 128 * 2;
constexpr size_t AR_OBUF = AR_KV, SZ_OBUF = (size_t)3 * T * DM * 2;
constexpr size_t AR_MIX = AR_OBUF + SZ_OBUF, SZ_MIX = (size_t)T * DM * 2;
constexpr size_t AR_END2 = AR_MIX + SZ_MIX;
constexpr size_t AR_ACT = WS_AR;
constexpr size_t AR_MGU = WS_AR, SZ_MGU = (size_t)NEXP * 2 * EXPERT_FF * DM * 2;
constexpr size_t AR_MDN = AR_MGU + SZ_MGU, SZ_MDN = (size_t)NEXP * DM * EXPERT_FF * 2;
constexpr size_t AR_XG = al(AR_MDN + SZ_MDN), SZ_XG = (size_t)MOE_ROWS * DM * 2;
constexpr size_t AR_MACT = al(AR_XG + SZ_XG), SZ_MACT = (size_t)MOE_ROWS * EXPERT_FF * 2;
constexpr size_t AR_RTOK = al(AR_MACT + SZ_MACT), SZ_RTOK = (size_t)2 * MOE_ROWS * 4;
constexpr size_t AR_RW8 = al(AR_RTOK + SZ_RTOK);
constexpr size_t AR_TROW = al(AR_RW8 + SZ_RTOK), SZ_TROW = (size_t)2 * T * 4;
constexpr size_t AR_RTE = al(AR_TROW + SZ_TROW);
constexpr size_t AR_RTW = al(AR_RTE + (size_t)T * 4);
constexpr size_t AR_WBASE = al(AR_RTW + (size_t)T * 8);
constexpr size_t AR_END3 = al(AR_WBASE + (size_t)4096 * 16 * 4);
constexpr size_t WS_END = (AR_END1 > AR_END2 ? (AR_END1 > AR_END3 ? AR_END1 : AR_END3) : (AR_END2 > AR_END3 ? AR_END2 : AR_END3));
constexpr int CW_CNT = 1024;
constexpr int CW_ATT = 256;
constexpr int CW_BAR = 4096, CW_TK = 8192, CW_CONV = 8256;

struct P {
    const float *x, *mix_norm_g, *w_in_first, *w_in_rest, *mu_first, *mu_rest, *qk_g, *cmp_pos, *cmp_w1, *cmp_w2, *nsa_w_o, *conv_w, *conv_vec, *conv_w_o,
        *rwkv_vec, *w_up, *a_up, *g_up, *vres_up, *vres_b, *rwkv_w_o, *w_out, *ffn_norm_g, *dense_gu, *dense_down, *router_w, *router_b, *moe_gu, *moe_down;
    float* out; unsigned char* ws;
};
HD inline void fill_params(P& p, const float* const* in, float* out, unsigned char* ws) {
    p.x = in[0]; p.mix_norm_g = in[1]; p.w_in_first = in[2]; p.w_in_rest = in[3]; p.mu_first = in[4]; p.mu_rest = in[5]; p.qk_g = in[6]; p.cmp_pos = in[7];
    p.cmp_w1 = in[8]; p.cmp_w2 = in[9]; p.nsa_w_o = in[10]; p.conv_w = in[11]; p.conv_vec = in[12]; p.conv_w_o = in[13]; p.rwkv_vec = in[14]; p.w_up = in[15];
    p.a_up = in[16]; p.g_up = in[17]; p.vres_up = in[18]; p.vres_b = in[19]; p.rwkv_w_o = in[20]; p.w_out = in[21]; p.ffn_norm_g = in[22]; p.dense_gu = in[23];
    p.dense_down = in[24]; p.router_w = in[25]; p.router_b = in[26]; p.moe_gu = in[27]; p.moe_down = in[28]; p.out = out; p.ws = ws;
}
#define WSP(type, off) ((type*)(p.ws + (off)))

#ifdef HOST_EMU
#define FENCE()
#else
#define FENCE() asm volatile("" ::: "memory")
#endif
HD inline float bf2f(bf16 v) { unsigned u = (unsigned)v << 16; float f; memcpy(&f, &u, 4); return f; }
HD inline bf16 f2bf(float f) { unsigned u; memcpy(&u, &f, 4); return (bf16)((u + 0x7fffu + ((u >> 16) & 1u)) >> 16); }
HD inline float blo(unsigned v) { unsigned u = v << 16; float f; memcpy(&f, &u, 4); return f; }
HD inline float bhi(unsigned v) { unsigned u = v & 0xffff0000u; float f; memcpy(&f, &u, 4); return f; }
#if !defined(SCAN_BF16) && !defined(RKV_BF16)
HD inline bf16 f2h(float f) { return __builtin_bit_cast(unsigned short, (_Float16)f); }
#else
HD inline bf16 f2bf(float f);
HD inline bf16 f2h(float f) { return f2bf(f); }
#endif
HD inline float h2f(bf16 v) { return (float)__builtin_bit_cast(_Float16, v); }
HD inline float sigmoidf_(float x) { return 1.f / (1.f + expf(-x)); }
HD inline float dot64(const float* q, const bf16* kp) {
    const U4* k4 = (const U4*)kp; float s0 = 0.f, s1 = 0.f;
#pragma unroll
    for (int i = 0; i < 8; ++i) { const U4 v = k4[i];
        s0 += q[8 * i + 0] * blo(v.x) + q[8 * i + 2] * blo(v.y) + q[8 * i + 4] * blo(v.z) + q[8 * i + 6] * blo(v.w);
        s1 += q[8 * i + 1] * bhi(v.x) + q[8 * i + 3] * bhi(v.y) + q[8 * i + 5] * bhi(v.z) + q[8 * i + 7] * bhi(v.w); }
    return s0 + s1;
}
HD inline float dot64p(const U4* q, const bf16* kp) {
    const U4* k4 = (const U4*)kp; float s0 = 0.f, s1 = 0.f;
#pragma unroll
    for (int i = 0; i < 8; ++i) { const U4 v = k4[i], w = q[i];
        s0 += blo(w.x) * blo(v.x) + blo(w.y) * blo(v.y) + blo(w.z) * blo(v.z) + blo(w.w) * blo(v.w);
        s1 += bhi(w.x) * bhi(v.x) + bhi(w.y) * bhi(v.y) + bhi(w.z) * bhi(v.z) + bhi(w.w) * bhi(v.w); }
    return s0 + s1;
}
HD inline void ld64(const bf16* kp, float* q) {
    const U4* k4 = (const U4*)kp;
#pragma unroll
    for (int i = 0; i < 8; ++i) { const U4 v = k4[i]; q[8 * i] = blo(v.x); q[8 * i + 1] = bhi(v.x); q[8 * i + 2] = blo(v.y); q[8 * i + 3] = bhi(v.y);
        q[8 * i + 4] = blo(v.z); q[8 * i + 5] = bhi(v.z); q[8 * i + 6] = blo(v.w); q[8 * i + 7] = bhi(v.w); }
}
HD inline void axpy64(float* o, float w, const bf16* vp) {
    const U4* k4 = (const U4*)vp;
#pragma unroll
    for (int i = 0; i < 8; ++i) { const U4 v = k4[i]; o[8 * i] += w * blo(v.x); o[8 * i + 1] += w * bhi(v.x); o[8 * i + 2] += w * blo(v.y); o[8 * i + 3] += w * bhi(v.y);
        o[8 * i + 4] += w * blo(v.z); o[8 * i + 5] += w * bhi(v.z); o[8 * i + 6] += w * blo(v.w); o[8 * i + 7] += w * bhi(v.w); }
}
HD inline void axpy64s(float* o, float w, const bf16* vp) {
    const U4* k4 = (const U4*)vp;
#pragma unroll
    for (int i = 0; i < 8; ++i) { const U4 v = k4[i]; o[8 * i] = w * o[8 * i] + blo(v.x); o[8 * i + 1] = w * o[8 * i + 1] + bhi(v.x); o[8 * i + 2] = w * o[8 * i + 2] + blo(v.y); o[8 * i + 3] = w * o[8 * i + 3] + bhi(v.y);
        o[8 * i + 4] = w * o[8 * i + 4] + blo(v.z); o[8 * i + 5] = w * o[8 * i + 5] + bhi(v.z); o[8 * i + 6] = w * o[8 * i + 6] + blo(v.w); o[8 * i + 7] = w * o[8 * i + 7] + bhi(v.w); }
}
HD inline void st64(bf16* op, const float* o) {
    U4* o4 = (U4*)op;
#pragma unroll
    for (int i = 0; i < 8; ++i) { U4 v; v.x = (unsigned)f2bf(o[8 * i]) | ((unsigned)f2bf(o[8 * i + 1]) << 16); v.y = (unsigned)f2bf(o[8 * i + 2]) | ((unsigned)f2bf(o[8 * i + 3]) << 16);
        v.z = (unsigned)f2bf(o[8 * i + 4]) | ((unsigned)f2bf(o[8 * i + 5]) << 16); v.w = (unsigned)f2bf(o[8 * i + 6]) | ((unsigned)f2bf(o[8 * i + 7]) << 16); o4[i] = v; }
}

HD inline void rope_cs(int pos, int i, float& cs, float& sn) {
    const float c = exp2f(-(float)i * 0.41524101186092f) * 0.15915494309189535f, pf = (float)pos;
    const float prod = pf * c, err = fmaf(pf, c, -prod), fr = (prod - rintf(prod)) + err;
#ifdef HOST_EMU
    cs = cosf(6.283185307179586f * fr); sn = sinf(6.283185307179586f * fr);
#else
    cs = __builtin_amdgcn_cosf(fr); sn = __builtin_amdgcn_sinf(fr);
#endif
}
HD inline int win_dest(int j, int layer, int& which) {
    which = 0;
    if (j < 1280) return j;
    if (j < 1304) return 3840 + 320 + (j - 1280);
    if (j < 1816) { const int cc = j - 1304; return 1280 + 256 * (cc / 128) + cc % 128; }
    if (j < 2328) { const int cc = j - 1816; return 1280 + 256 * (cc / 128) + 128 + cc % 128; }
    if (j < OFF_RWKV) { which = 1; const int gg = j - OFF_GATE, br = gg / DM; return (br == 0 ? 0 : (br == 1 ? 2 * DM : DM)) + gg % DM; }
    const int rr = j - OFF_RWKV;
    if (rr < 1536) return 2304 + rr;
    if (rr < 1824) return 3840 + (rr - 1536);
    if (rr < 1856 && layer == 1) return 3840 + 288 + (rr - 1824);
    return -1;
}
HD inline int glu_dest(int j, int ff) { return j < ff ? 256 * (j / 128) + j % 128 : 256 * ((j - ff) / 128) + 128 + (j - ff) % 128; }

DEV_INLINE void ph_shift(const P& p, int layer, long gtid, long NT) {
    bf16* RW = WSP(bf16, AR_RW); const bf16* HALO = WSP(bf16, AR_HALO); bf16* VF = WSP(bf16, WS_VF); bf16* LB = WSP(bf16, WS_LB);
    const float* mu = layer == 0 ? p.mu_first : p.mu_rest;
    constexpr int NCP = (LBLK + 384) / 2;
    const long n = (long)(T / 256) * NCP;
    for (long it = gtid; it < n; it += NT) {
        const int pm = (int)(it / NCP), c = 2 * (int)(it % NCP);
        int mi = -1, act = 0;
        if (c < LBLK) mi = c;
        else { const int w = c - LBLK; if (w < 288) { mi = 1536 + w; act = w < 64 ? 1 : (w >= 128 ? 2 : 0); } else if (w < 320 && layer == 1) mi = 1824 + (w - 288); }
        if (mi < 0) { for (int r = 0; r < 256; ++r) *(unsigned*)(LB + ((size_t)pm * 256 + r) * 384 + (c - LBLK)) = 0u; continue; }
        const float m0 = mu[mi], m1 = mu[mi + 1];
        float prev0 = 0.f, prev1 = 0.f;
        if ((pm * 256) % SEQ != 0) { const unsigned hv = *(const unsigned*)(HALO + (size_t)(pm - 1) * LDRW + c); prev0 = blo(hv); prev1 = bhi(hv); }
        bf16* col = RW + (size_t)pm * 256 * LDRW + c;
        for (int r0 = 0; r0 < 256; r0 += 16) {
            unsigned pv[16];
#pragma unroll
            for (int k = 0; k < 16; ++k) pv[k] = *(const unsigned*)(col + (size_t)(r0 + k) * LDRW);
#pragma unroll
            for (int k = 0; k < 16; ++k) { const int r = r0 + k; const float p0 = blo(pv[k]), p1 = bhi(pv[k]);
                float u0 = p0 + (prev0 - p0) * m0, u1 = p1 + (prev1 - p1) * m1; prev0 = p0; prev1 = p1;
                if (act == 1) { u0 = tanhf(u0); u1 = tanhf(u1); } else if (act == 2) { u0 = sigmoidf_(u0); u1 = sigmoidf_(u1); }
                if (c < LBLK) { const unsigned hv = (unsigned)f2h(u0) | ((unsigned)f2h(u1) << 16); *(unsigned*)(col + (size_t)r * LDRW) = hv;
                    if (layer == 0 && c >= 1024) *(unsigned*)(VF + ((size_t)pm * 256 + r) * RC + (c - 1024)) = hv; }
                else *(unsigned*)(LB + ((size_t)pm * 256 + r) * 384 + (c - LBLK)) = (unsigned)f2bf(u0) | ((unsigned)f2bf(u1) << 16); }
        }
    }
}

DEV_INLINE void ph_nsa_prep(const P& p, int layer, long gtid, long NT) {
    bf16* QB = WSP(bf16, AR_QB); bf16* KV = WSP(bf16, AR_KV);
    const long n = (long)T * 12;
    for (long it = gtid; it < n; it += NT) {
        const int t = (int)(it / 12), s = (int)(it % 12), pos = t % SEQ;
        bf16* ptr; const float* g;
        if (s < 8) { ptr = QB + (size_t)t * LDQ + s * 64; g = p.qk_g + (layer * 4 + 0) * 64; }
        else if (s < 10) { ptr = KV + (size_t)t * LDKV + (s - 8) * 64; g = p.qk_g + (layer * 4 + 2) * 64; }
        else { ptr = KV + (size_t)t * LDKV + 256 + (s - 10) * 64; g = p.qk_g + (layer * 4 + 3) * 64; }
        float v[64]; ld64(ptr, v);
        float ss = 0.f;
#pragma unroll
        for (int i = 0; i < 64; ++i) ss += v[i] * v[i];
        const float rs = 1.f / sqrtf(ss * (1.f / 64.f) + RMS_EPS);
#pragma unroll
        for (int i = 0; i < 64; ++i) v[i] = v[i] * rs * g[i];
#pragma unroll
        for (int i = 0; i < 32; ++i) {
            float cs, sn; rope_cs(pos, i, cs, sn);
            const float x1 = v[i], x2 = v[i + 32]; v[i] = x1 * cs - x2 * sn; v[i + 32] = x2 * cs + x1 * sn;
        }
        if (s < 8) {
#pragma unroll
            for (int i = 0; i < 64; ++i) v[i] *= 0.125f * 1.4426950408889634f; }
        if (s < 8) st64(ptr, v);
        else {
            const int gg = (s - 8) & 1, bq = t / SEQ; bf16* k8 = WSP(bf16, s < 10 ? WS_KS8 : WS_KW8) + (size_t)(bq * NKV + gg) * 8 * SEQ * 8;
#pragma unroll
            for (int dg = 0; dg < 8; ++dg) { U4 w; w.x = (unsigned)f2bf(v[8 * dg]) | ((unsigned)f2bf(v[8 * dg + 1]) << 16); w.y = (unsigned)f2bf(v[8 * dg + 2]) | ((unsigned)f2bf(v[8 * dg + 3]) << 16);
                w.z = (unsigned)f2bf(v[8 * dg + 4]) | ((unsigned)f2bf(v[8 * dg + 5]) << 16); w.w = (unsigned)f2bf(v[8 * dg + 6]) | ((unsigned)f2bf(v[8 * dg + 7]) << 16);
                *(U4*)(k8 + ((size_t)dg * SEQ + pos) * 8) = w; } }
    }
}

DEV_INLINE void ph_vtrans(const P& p, long gtid, long NT) {
    const bf16* KV = WSP(bf16, AR_KV); bf16* VsT = WSP(bf16, WS_VST); bf16* VwT = WSP(bf16, WS_VWT);
    const long n = (long)BATCH * NKV * (SEQ / 8) * 64;
    for (long it = gtid; it < n; it += NT) {
        const int d = (int)(it % 64); long r = it / 64; const int kg = (int)(r % (SEQ / 8)); const int bg = (int)(r / (SEQ / 8)), b = bg / NKV, g = bg % NKV;
        const int kbase = (kg >> 2) * 32 + 4 * (kg & 3);
        const bf16* src = KV + (size_t)(b * SEQ + kbase) * LDKV + g * 64 + d;
        U4 s, w; unsigned short sv[8], wv[8];
#pragma unroll
        for (int j = 0; j < 8; ++j) { const size_t ro = (size_t)((j & 3) + 16 * (j >> 2)) * LDKV; sv[j] = src[ro + 128]; wv[j] = src[ro + 384]; }
        s.x = sv[0] | ((unsigned)sv[1] << 16); s.y = sv[2] | ((unsigned)sv[3] << 16); s.z = sv[4] | ((unsigned)sv[5] << 16); s.w = sv[6] | ((unsigned)sv[7] << 16);
        w.x = wv[0] | ((unsigned)wv[1] << 16); w.y = wv[2] | ((unsigned)wv[3] << 16); w.z = wv[4] | ((unsigned)wv[5] << 16); w.w = wv[6] | ((unsigned)wv[7] << 16);
        *(U4*)(VsT + (((size_t)bg * (SEQ / 8) + kg) * 64 + d) * 8) = s; *(U4*)(VwT + (((size_t)bg * (SEQ / 8) + kg) * 64 + d) * 8) = w;
    }
}
namespace pg8 {
#define PG8_LAS __attribute__((address_space(3)))
typedef unsigned short bf16_t;
typedef short bf16x8 __attribute__((ext_vector_type(8)));
typedef float f32x4 __attribute__((ext_vector_type(4)));
typedef unsigned u32x4 __attribute__((ext_vector_type(4)));
constexpr int BM = 256, BK = 64, HALF = 128, HTB = HALF * BK * 2  , STAGE_BYTES = 8 * HTB, NXCD = 8, WGM = 8;

__host__ __device__ __forceinline__ int lds_byte(int r, int c) { const int st = (r >> 4) * 2 + (c >> 5), rr = r & 15, cc = c & 31, ob = rr * 64 + cc * 2; return st * 1024 + (ob ^ (((ob >> 9) & 1) << 5)); }
__host__ __device__ __forceinline__ void stage_rc(int b, int& R, int& C) { const int st = b / 1024, sb = b % 1024, swz = sb ^ (((sb >> 9) & 1) << 5); R = (st >> 1) * 16 + swz / 64; C = (st & 1) * 32 + (swz % 64) / 2; }
__host__ __device__ __forceinline__ int perm32(int rho) { const int n = rho >> 4, i = rho & 15; return 8 * (i >> 2) + 4 * n + (i & 3); }

struct Unit { int pm, pn; };
struct Gemm { const bf16_t* A; const bf16_t* Bt; int M, N, K; int lda; int ldb; };

struct StaticOrder {
    int nM, nN, nwg, G, c;
    __host__ __device__ void init(int M, int N, int G_, int c_) { nM = M / BM; nN = N / BM; nwg = nM * nN; G = G_; c = c_; }
    __host__ __device__ bool next(int i, Unit& u) const {
        const long L = (long)i * G + c; if (L >= nwg) return false;
        int wgid = (int)L; { const int q = nwg / NXCD, r = nwg % NXCD, xcd = wgid % NXCD, off = wgid / NXCD; wgid = (xcd < r ? xcd * (q + 1) : r * (q + 1) + (xcd - r) * q) + off; }
        const int nig = WGM * nN, gid = wgid / nig, fm = gid * WGM, gsz = (nM - fm) < WGM ? (nM - fm) : WGM;
        u.pm = fm + ((wgid % nig) % gsz); u.pn = (wgid % nig) / gsz; return true;
    }
    __device__ __forceinline__ void a_ready(const Unit&) const {}
    __device__ __forceinline__ void done(const Unit&) const {}
};

__device__ __forceinline__ unsigned cvt_pk_bf16(float lo, float hi) { unsigned r; asm volatile("v_cvt_pk_bf16_f32 %0, %1, %2" : "=v"(r) : "v"(lo), "v"(hi)); return r; }
typedef float f32x2 __attribute__((ext_vector_type(2)));
template <class Epi, class Sched, bool ALIGN_EPI = false, bool SP2 = false, bool KSPLIT = false>
__device__ __forceinline__ void gemm_phase(PG8_LAS unsigned char* lds, const Gemm g, const Sched& S, const Epi& E, int tid_in) {
    int tid_ = tid_in; asm volatile("" : "+v"(tid_));
    const int tid = tid_, wid = __builtin_amdgcn_readfirstlane(tid >> 6), lane = tid & 63, wr = wid >> 2, wc = wid & 3, fr = lane & 15, fq = lane >> 4;
    const int K = g.K, nt = K / BK, lda = g.lda ? g.lda : K, ldb = g.ldb ? g.ldb : K;
    unsigned voffA[2], voffB[2];
#pragma unroll
    for (int i = 0; i < 2; ++i) { int R, C; stage_rc(tid * 16 + i * 8192, R, C); const int Rb = Epi::PERM ? ((R & ~31) + perm32(R & 31)) : R;
        voffA[i] = (unsigned)(R * lda + C) * 2u; voffB[i] = (unsigned)(Rb * ldb + C) * 2u; }
    const size_t kstep = (size_t)(BK * 2);
    const size_t hstepA = (size_t)HALF * lda * 2, hstepB = (size_t)HALF * ldb * 2;
    const size_t hstep_unused = (size_t)HALF * K * 2;
    const size_t tstepA = 2 * hstepA, tstepB = 2 * hstepB;
    const unsigned ldsw = (unsigned)wid * 1024u;
    const int aoff = lds_byte(wr * 64 + fr, fq * 8), boff = lds_byte(wc * 32 + fr, fq * 8);
#define PG8_SA(b, h) (((b) * 2 + (h)) * HTB)
#define PG8_SB(b, h) ((4 + (b) * 2 + (h)) * HTB)
#define PG8_STAGE(bufoff, gbase, voff) do { _Pragma("unroll") for (int _i = 0; _i < 2; ++_i) \
        __builtin_amdgcn_global_load_lds((const unsigned*)((const char*)(gbase) + (voff)[_i]), (PG8_LAS unsigned*)(lds + (bufoff) + ldsw + _i * 8192), 16, 0, 0); } while (0)
#define PG8_LDA(dst, b, h) do { _Pragma("unroll") for (int m = 0; m < 4; ++m) _Pragma("unroll") for (int k = 0; k < 2; ++k) dst[m][k] = *(const PG8_LAS bf16x8*)(lds + PG8_SA(b, h) + aoff + m * 2048 + k * 1024); } while (0)
#define PG8_LDB(dst, b, h) do { _Pragma("unroll") for (int n = 0; n < 2; ++n) _Pragma("unroll") for (int k = 0; k < 2; ++k) dst[n][k] = *(const PG8_LAS bf16x8*)(lds + PG8_SB(b, h) + boff + n * 2048 + k * 1024); } while (0)
#define PG8_MMA(ai, bj, At, Bt) do { __builtin_amdgcn_s_setprio(1); _Pragma("unroll") for (int m = 0; m < 4; ++m) _Pragma("unroll") for (int n = 0; n < 2; ++n) _Pragma("unroll") for (int k = 0; k < 2; ++k) \
        acc[ai][bj][m][n] = __builtin_amdgcn_mfma_f32_16x16x32_bf16(Bt[n][k], At[m][k], acc[ai][bj][m][n], 0, 0, 0); __builtin_amdgcn_s_setprio(0); } while (0)
#define PG8_WAIT_V(n) asm volatile("s_waitcnt vmcnt(" #n ")" ::: "memory")
#define PG8_WAIT_L(n) asm volatile("s_waitcnt lgkmcnt(" #n ")" ::: "memory")
#define PG8_BAR __builtin_amdgcn_s_barrier()
#define PG8_SCHED __builtin_amdgcn_sched_barrier(0)
    Unit cur, nxt; int ui = 0;
    if (!S.next(0, cur)) return;
    f32x4 acc[2][2][4][2];
#pragma unroll
    for (int a = 0; a < 2; ++a)
#pragma unroll
        for (int b = 0; b < 2; ++b)
#pragma unroll
            for (int m = 0; m < 4; ++m)
#pragma unroll
                for (int n = 0; n < 2; ++n) acc[a][b][m][n] = (f32x4){0.f, 0.f, 0.f, 0.f};
    bf16x8 At[4][2], B0[2][2], B1[2][2];
    const char* cA = (const char*)g.A + (size_t)cur.pm * tstepA + (KSPLIT ? (size_t)(cur.pn >> 16) * K * 2 : 0); const char* cB = (const char*)g.Bt + (size_t)(KSPLIT ? (cur.pn & 0xffff) : cur.pn) * tstepB + (KSPLIT ? (size_t)(cur.pn >> 16) * K * 2 : 0);
    S.a_ready(cur);
    if constexpr (SP2) {
        PG8_STAGE(PG8_SB(0, 0), cB, voffB); PG8_STAGE(PG8_SB(0, 1), cB + hstepB, voffB); PG8_STAGE(PG8_SA(0, 0), cA, voffA); PG8_STAGE(PG8_SA(0, 1), cA + hstepA, voffA);
        if (wr == 1) PG8_BAR;
        PG8_WAIT_V(2); PG8_BAR;
        PG8_STAGE(PG8_SB(1, 0), cB + kstep, voffB); PG8_STAGE(PG8_SA(1, 0), cA + kstep, voffA); PG8_STAGE(PG8_SB(1, 1), cB + hstepB + kstep, voffB);
        PG8_WAIT_V(6); PG8_BAR;
    } else {
        PG8_STAGE(PG8_SB(0, 0), cB, voffB); PG8_STAGE(PG8_SA(0, 0), cA, voffA); PG8_STAGE(PG8_SB(0, 1), cB + hstepB, voffB); PG8_STAGE(PG8_SA(0, 1), cA + hstepA, voffA);
        if (wr == 1) PG8_BAR;
        PG8_WAIT_V(4); PG8_BAR;
        PG8_STAGE(PG8_SB(1, 0), cB + kstep, voffB); PG8_STAGE(PG8_SA(1, 0), cA + kstep, voffA); PG8_STAGE(PG8_SB(1, 1), cB + hstepB + kstep, voffB);
        PG8_WAIT_V(6); PG8_BAR;
    }
    for (;;) {
        const bool has_next = S.next(ui + 1, nxt);
        const char* nA = has_next ? (const char*)g.A + (size_t)nxt.pm * tstepA + (KSPLIT ? (size_t)(nxt.pn >> 16) * K * 2 : 0) : cA; const char* nB = has_next ? (const char*)g.Bt + (size_t)(KSPLIT ? (nxt.pn & 0xffff) : nxt.pn) * tstepB + (KSPLIT ? (size_t)(nxt.pn >> 16) * K * 2 : 0) : cB;
        for (int t = 0; t < nt; t += 2) {
            const bool last = (t == nt - 2);
            const char* a1 = cA + (size_t)(t + 1) * kstep;
            const char* a2 = last ? nA : cA + (size_t)(t + 2) * kstep; const char* b2 = last ? nB : cB + (size_t)(t + 2) * kstep;
            const char* a3 = a2 + kstep; const char* b3 = b2 + kstep;
            if (last && has_next) S.a_ready(nxt);
            if constexpr (SP2) {
            PG8_LDB(B0, 0, 0); PG8_LDB(B1, 0, 1); PG8_SCHED; PG8_LDA(At, 0, 0); PG8_STAGE(PG8_SA(1, 1), a1 + hstepA, voffA);
            PG8_WAIT_V(8); PG8_WAIT_L(0); PG8_BAR; PG8_MMA(0, 0, At, B0); PG8_MMA(0, 1, At, B1); PG8_BAR; PG8_SCHED;
            PG8_LDA(At, 0, 1); PG8_STAGE(PG8_SB(0, 0), b2, voffB); PG8_STAGE(PG8_SB(0, 1), b2 + hstepB, voffB); PG8_STAGE(PG8_SA(0, 0), a2, voffA);
            PG8_WAIT_V(8); PG8_WAIT_L(0); PG8_BAR; PG8_MMA(1, 0, At, B0); PG8_MMA(1, 1, At, B1); PG8_BAR; PG8_SCHED;
            PG8_LDB(B0, 1, 0); PG8_LDB(B1, 1, 1); PG8_SCHED; PG8_LDA(At, 1, 0); PG8_STAGE(PG8_SA(0, 1), a2 + hstepA, voffA);
            PG8_WAIT_V(8); PG8_WAIT_L(0); PG8_BAR; PG8_MMA(0, 0, At, B0); PG8_MMA(0, 1, At, B1); PG8_BAR; PG8_SCHED;
            PG8_LDA(At, 1, 1); PG8_STAGE(PG8_SB(1, 0), b3, voffB); PG8_STAGE(PG8_SB(1, 1), b3 + hstepB, voffB); PG8_STAGE(PG8_SA(1, 0), a3, voffA);
            PG8_WAIT_V(8); PG8_WAIT_L(0); PG8_BAR; PG8_MMA(1, 0, At, B0); PG8_MMA(1, 1, At, B1); PG8_BAR; PG8_SCHED;
            } else {
            PG8_LDB(B0, 0, 0); PG8_SCHED; PG8_LDA(At, 0, 0); PG8_STAGE(PG8_SA(1, 1), a1 + hstepA, voffA);
            PG8_WAIT_L(8); PG8_BAR; PG8_WAIT_L(0); PG8_MMA(0, 0, At, B0); PG8_BAR; PG8_SCHED;
            PG8_LDB(B1, 0, 1); PG8_STAGE(PG8_SB(0, 0), b2, voffB);
            PG8_BAR; PG8_WAIT_L(0); PG8_MMA(0, 1, At, B1); PG8_BAR;
            PG8_LDA(At, 0, 1); PG8_STAGE(PG8_SA(0, 0), a2, voffA);
            PG8_BAR; PG8_WAIT_L(0); PG8_MMA(1, 0, At, B0); PG8_BAR; PG8_SCHED;
            PG8_STAGE(PG8_SB(0, 1), b2 + hstepB, voffB);
            PG8_WAIT_V(6); PG8_BAR; PG8_MMA(1, 1, At, B1); PG8_BAR;
            PG8_LDB(B0, 1, 0); PG8_SCHED; PG8_LDA(At, 1, 0); PG8_STAGE(PG8_SA(0, 1), a2 + hstepA, voffA);
            PG8_WAIT_L(8); PG8_BAR; PG8_WAIT_L(0); PG8_MMA(0, 0, At, B0); PG8_BAR; PG8_SCHED;
            PG8_LDB(B1, 1, 1); PG8_STAGE(PG8_SB(1, 0), b3, voffB);
            PG8_BAR; PG8_WAIT_L(0); PG8_MMA(0, 1, At, B1); PG8_BAR;
            PG8_LDA(At, 1, 1); PG8_STAGE(PG8_SA(1, 0), a3, voffA);
            PG8_BAR; PG8_WAIT_L(0); PG8_MMA(1, 0, At, B0); PG8_BAR; PG8_SCHED;
            PG8_STAGE(PG8_SB(1, 1), b3 + hstepB, voffB);
            PG8_WAIT_V(6); PG8_BAR; PG8_MMA(1, 1, At, B1); PG8_BAR;
            }
        }
        if constexpr (ALIGN_EPI) { if (wr == 0) PG8_BAR; }
        if constexpr (!Epi::AFTER_DRAIN) { E(acc, cur, wr, wc, fr, fq); S.done(cur); }
        if (!has_next) break;
#pragma unroll
        for (int a = 0; a < 2; ++a)
#pragma unroll
            for (int b = 0; b < 2; ++b)
#pragma unroll
                for (int m = 0; m < 4; ++m)
#pragma unroll
                    for (int n = 0; n < 2; ++n) acc[a][b][m][n] = (f32x4){0.f, 0.f, 0.f, 0.f};
        cur = nxt; cA = nA; cB = nB; ++ui;
        if constexpr (ALIGN_EPI) { if (wr == 1) PG8_BAR; }
    }
    PG8_WAIT_V(0);
    if constexpr (!ALIGN_EPI) { if (wr == 0) PG8_BAR; }
    PG8_BAR;
    if constexpr (Epi::AFTER_DRAIN) { E.fused(acc, cur, wr, wc, fr, fq, lds, wid, lane); S.done(cur); }
#undef PG8_SA
#undef PG8_SB
#undef PG8_STAGE
#undef PG8_LDA
#undef PG8_LDB
#undef PG8_MMA
#undef PG8_WAIT_V
#undef PG8_WAIT_L
#undef PG8_BAR
#undef PG8_SCHED
}
}

#define LAS __attribute__((address_space(3)))
#define XB_TMO      128
#define XB_XCNT(j)  (256  + 64 * (j))
#define XB_XSUB(j)  (1280 + 64 * (j))
#define XB_XGEN(j)  (2304 + 64 * (j))
#define XB_TOP      3328
#define XB_TOPGEN   3392
#define XCD_BAR_WORDS 3456
#define XB_SPIN_CAP (1u << 22)

__device__ __forceinline__ unsigned xb_ld(unsigned* p)              { return __hip_atomic_load(p, __ATOMIC_RELAXED, __HIP_MEMORY_SCOPE_AGENT); }
__device__ __forceinline__ unsigned xb_add(unsigned* p, unsigned v) { return __hip_atomic_fetch_add(p, v, __ATOMIC_RELAXED, __HIP_MEMORY_SCOPE_AGENT); }
__device__ __forceinline__ unsigned xb_xcc_id() { return (unsigned)__builtin_amdgcn_s_getreg((3 << 11) | 20) & 0xFu; }
#define XB_SPIN(cond, bar) do { unsigned _sp = 0; while (cond) { __builtin_amdgcn_s_sleep(1); \
    if ((++_sp & 255u) == 0u) { if (xb_ld(&(bar)[XB_TMO])) break; if (_sp > XB_SPIN_CAP) { atomicAdd(&(bar)[XB_TMO], 1u); break; } } } } while (0)

struct XcdBarrier {
    unsigned* bar; unsigned x;
    volatile LAS unsigned* st;
};

__device__ __forceinline__ XcdBarrier xcd_barrier_post(unsigned* bar, volatile LAS unsigned* st) {
    XcdBarrier b; b.bar = bar; b.x = xb_xcc_id(); b.st = st;
    if (threadIdx.x == 0) (void)xb_add(&bar[XB_XCNT(b.x)], 1u);
    return b;
}
__device__ __forceinline__ void xcd_barrier_complete(unsigned* bar, unsigned x, unsigned& nloc, unsigned& nx) {
    const unsigned G = gridDim.x * gridDim.y * gridDim.z;
    unsigned sum, cnt, mine, sp = 0u;
    for (;;) {
        sum = 0u; cnt = 0u; mine = 0u;
#pragma unroll
        for (unsigned j = 0; j < 16; ++j) { const unsigned c = xb_ld(&bar[XB_XCNT(j)]); sum += c; cnt += (c > 0u) ? 1u : 0u; mine = (j == x) ? c : mine; }
        if (sum == G) break;
        __builtin_amdgcn_s_sleep(1);
        if ((++sp & 255u) == 0u) { if (xb_ld(&bar[XB_TMO])) break; if (sp > XB_SPIN_CAP) { atomicAdd(&bar[XB_TMO], 1u); break; } }
    }
    nloc = mine > 0u ? mine : 1u; nx = cnt > 0u ? cnt : 1u;
}

__device__ __forceinline__ void xcd_barrier(const XcdBarrier& b, int tid_x  ) {
    asm volatile("s_waitcnt vmcnt(0)" ::: "memory");
    __syncthreads();
    if (tid_x == 0) {
        unsigned* bar = b.bar; asm volatile("" : "+s"(bar));
        unsigned xx = b.x; asm volatile("" : "+s"(xx));
        __builtin_amdgcn_s_waitcnt(0);
        unsigned nloc = b.st[0], nx = b.st[1];
        if (nloc == 0u) { xcd_barrier_complete(bar, xx, nloc, nx); b.st[0] = nloc; b.st[1] = nx; }
        const unsigned old = xb_add(&bar[XB_XSUB(xx)], 1u);
        const unsigned gen = old / nloc;
        if (old + 1u == (gen + 1u) * nloc) {
            __builtin_amdgcn_fence(__ATOMIC_RELEASE, "agent");
            asm volatile("s_waitcnt vmcnt(0)" ::: "memory");
            const unsigned og = xb_add(&bar[XB_TOP], 1u);
            const unsigned tg = og / nx;
            if (og + 1u == (tg + 1u) * nx) xb_add(&bar[XB_TOPGEN], 1u);
            else XB_SPIN(xb_ld(&bar[XB_TOPGEN]) == tg, bar);
            __builtin_amdgcn_fence(__ATOMIC_ACQUIRE, "agent");
            xb_add(&bar[XB_XGEN(xx)], 1u);
            asm volatile("s_waitcnt vmcnt(0)" ::: "memory");
        } else {
            XB_SPIN(xb_ld(&bar[XB_XGEN(xx)]) == gen, bar);
            __builtin_amdgcn_fence(__ATOMIC_ACQUIRE, "agent");
            asm volatile("s_waitcnt vmcnt(0)" ::: "memory");
        }
    }
    __syncthreads();
}
#define GAS __attribute__((address_space(1)))
typedef unsigned v4u __attribute__((ext_vector_type(4)));
#ifdef PROBE_TK
#define TKQ(i) do { if (layer == PROBE_LAYER && blockIdx.x == PROBE_BLK && threadIdx.x == 0) ((unsigned long long*)(p.ws + WS_CTL + 4 * CW_TK))[(i)] = __builtin_amdgcn_s_memrealtime(); } while (0)
#else
#define TKQ(i) do { } while (0)
#endif
typedef unsigned v2u __attribute__((ext_vector_type(2)));
typedef GAS unsigned gu32;
#define RLX_AGENT __ATOMIC_RELAXED, __HIP_MEMORY_SCOPE_AGENT
#define LDS_WAIT() asm volatile("s_waitcnt lgkmcnt(0)" ::: "memory")
#define VM_WAIT() asm volatile("s_waitcnt vmcnt(0)" ::: "memory")
using pg8::f32x4; using pg8::Unit; using pg8::Gemm; using pg8::BM; using pg8::HALF; using pg8::cvt_pk_bf16; using pg8::u32x4;

constexpr int NWAVES = 8, NTHREADS = 512;
constexpr int RING_BYTES = 131072, LDSCTL_OFF = 147456 - 1024, MISC_OFF = LDSCTL_OFF + 320, LDS_BYTES = 147456;

__device__ __forceinline__ float wave_sum(float v, int lane) {
#pragma unroll
    for (int o = 1; o < 64; o <<= 1) v += __builtin_bit_cast(float, __builtin_amdgcn_ds_bpermute((lane ^ o) << 2, __builtin_bit_cast(int, v)));
    return v;
}
__device__ __forceinline__ float fsig(float x) { return __builtin_amdgcn_rcpf(1.f + __expf(-x)); }

__device__ __forceinline__ int lane_id_opaque() { int l; asm volatile("v_mbcnt_lo_u32_b32 %0, -1, 0\n\tv_mbcnt_hi_u32_b32 %0, -1, %0" : "=v"(l)); return l; }
__device__ __forceinline__ int rfl(int v) { return __builtin_amdgcn_readfirstlane(v); }
struct SOrder {
    pg8::StaticOrder s;
    __device__ void init(int M, int N, int G, int c) { s.init(M, N, G, c); }
    __device__ bool next(int i, Unit& u) const { Unit t; t.pm = 0; t.pn = 0; const bool ok = s.next(i, t); u.pm = rfl(t.pm); u.pn = rfl(t.pn); return ok; }
    __device__ __forceinline__ void a_ready(const Unit&) const {}
    __device__ __forceinline__ void done(const Unit&) const {}
};
struct StackOrder {
    pg8::StaticOrder s; int nM, nN;
    __device__ StackOrder(int nM_, int nN_, int nb, int G, int c) : nM(nM_), nN(nN_) { s.init(nb * nM_ * 256, nN_ * 256, G, c); }
    __device__ bool next(int i, Unit& u) const { Unit t; t.pm = 0; t.pn = 0; if (!s.next(i, t)) return false; u.pm = rfl(t.pm); u.pn = rfl((t.pm / nM) * nN + t.pn); return true; }
    __device__ __forceinline__ void a_ready(const Unit&) const {}
    __device__ __forceinline__ void done(const Unit&) const {}
};
struct GateOrder {
    pg8::StaticOrder s; int nN;
    __device__ GateOrder(int nM_, int nN_, int G, int c) : nN(nN_) { s.init(nM_ * 256, nN_ * 256, G, c); }
    __device__ bool next(int i, Unit& u) const { const int j = i / 3, br = i - 3 * j; Unit t; t.pm = 0; t.pn = 0; if (!s.next(j, t)) return false; u.pm = rfl(t.pm); u.pn = rfl(br * nN + t.pn); return true; }
    __device__ __forceinline__ void a_ready(const Unit&) const {}
    __device__ __forceinline__ void done(const Unit&) const {}
};
struct MoeOrder {
    pg8::StaticOrder s; int nN, e0, e1, e2, e3, e4, e5, e6, e7;
    __device__ void init(const unsigned* cnt  , int nN_, int G_, int c_) { nN = nN_;
        int t = 0; t += (cnt[0] + 255) >> 8; e0 = t; t += (cnt[64] + 255) >> 8; e1 = t; t += (cnt[128] + 255) >> 8; e2 = t; t += (cnt[192] + 255) >> 8; e3 = t;
        t += (cnt[256] + 255) >> 8; e4 = t; t += (cnt[320] + 255) >> 8; e5 = t; t += (cnt[384] + 255) >> 8; e6 = t; t += (cnt[448] + 255) >> 8; e7 = t;
        s.init(e7 * 256, nN_ * 256, G_, c_); }
    __device__ bool next(int i, Unit& u) const { Unit t; t.pm = 0; t.pn = 0; if (!s.next(i, t)) return false;
        const int pm = t.pm, e = (pm >= e0) + (pm >= e1) + (pm >= e2) + (pm >= e3) + (pm >= e4) + (pm >= e5) + (pm >= e6);
        u.pm = rfl(pm); u.pn = rfl(e * nN + t.pn); return true; }
    __device__ __forceinline__ void a_ready(const Unit&) const {}
    __device__ __forceinline__ void done(const Unit&) const {}
};

__device__ __forceinline__ u32x4 pack8(f32x4 v0, f32x4 v1) { u32x4 w; w.x = cvt_pk_bf16(v0[0], v0[1]); w.y = cvt_pk_bf16(v0[2], v0[3]); w.z = cvt_pk_bf16(v1[0], v1[1]); w.w = cvt_pk_bf16(v1[2], v1[3]); return w; }
__device__ __forceinline__ void unpack8(u32x4 w, f32x4& v0, f32x4& v1) {
    v0 = (f32x4){blo(w.x), bhi(w.x), blo(w.y), bhi(w.y)}; v1 = (f32x4){blo(w.z), bhi(w.z), blo(w.w), bhi(w.w)}; }

struct EpiProj {
    static constexpr bool PERM = true, AFTER_DRAIN = false;
    unsigned char* ws;
    __device__ __forceinline__ void operator()(const f32x4 (&acc)[2][2][4][2], const Unit& u, int wr, int wc, int fr, int fq) const {
        bf16* const QB = (bf16*)(ws + AR_QB); bf16* const KV = (bf16*)(ws + AR_KV); bf16* const UB = (bf16*)(ws + AR_UB); bf16* const RW = (bf16*)(ws + AR_RW); bf16* const HALO = (bf16*)(ws + AR_HALO); bf16* const CKV = (bf16*)(ws + AR_CKV);
        const int row0 = u.pm * BM + wr * 64 + fr, cl = wc * 32 + 8 * fq;
        if (u.pn >= 5 && u.pn < 9) {
#pragma unroll
            for (int ai = 0; ai < 2; ++ai)
#pragma unroll
                for (int m = 0; m < 4; ++m) { f32x4 a0 = acc[ai][0][m][0], a1 = acc[ai][0][m][1]; const f32x4 b0 = acc[ai][1][m][0], b1 = acc[ai][1][m][1];
#pragma unroll
                    for (int k = 0; k < 4; ++k) { a0[k] *= fsig(b0[k]); a1[k] *= fsig(b1[k]); }
                    *(u32x4*)(UB + (size_t)(row0 + ai * HALF + m * 16) * 512 + (u.pn - 5) * 128 + cl) = pack8(a0, a1); }
            return;
        }
        if (u.pn == 2) {
#pragma unroll
            for (int ai = 0; ai < 2; ++ai)
#pragma unroll
                for (int m = 0; m < 4; ++m) { const int row = row0 + ai * HALF + m * 16, b = row / SEQ, tt = row % SEQ;
#pragma unroll
                    for (int bj = 0; bj < 2; ++bj) *(u32x4*)(CKV + (((size_t)bj * (BATCH * NKV) + b * NKV + (cl >> 6)) * SEQ + tt) * 64 + (cl & 63)) = pack8(acc[ai][bj][m][0], acc[ai][bj][m][1]); }
            return;
        }
        bf16* base; int ld, c0;
        if (u.pn < 2) { base = QB; ld = LDQ; c0 = u.pn * 256; } else if (u.pn < 5) { base = KV; ld = LDKV; c0 = (u.pn - 3) * 256; } else { base = RW; ld = LDRW; c0 = (u.pn - 9) * 256; }
#pragma unroll
        for (int ai = 0; ai < 2; ++ai)
#pragma unroll
            for (int m = 0; m < 4; ++m)
#pragma unroll
                for (int bj = 0; bj < 2; ++bj) { const u32x4 w = pack8(acc[ai][bj][m][0], acc[ai][bj][m][1]);
                    *(u32x4*)(base + (size_t)(row0 + ai * HALF + m * 16) * ld + c0 + bj * HALF + cl) = w;
                    if (u.pn >= 9 && ai == 1 && m == 3 && wr == 1 && fr == 15) *(u32x4*)(HALO + (size_t)u.pm * LDRW + c0 + bj * HALF + cl) = w; }
    }
};
struct EpiStore {
    static constexpr bool PERM = true, AFTER_DRAIN = false;
    bf16* O; int ld, ntn;
    __device__ __forceinline__ void operator()(const f32x4 (&acc)[2][2][4][2], const Unit& u, int wr, int wc, int fr, int fq) const {
        const int row0 = u.pm * BM + wr * 64 + fr, c0 = (u.pn % ntn) * 256 + wc * 32 + 8 * fq;
#pragma unroll
        for (int ai = 0; ai < 2; ++ai)
#pragma unroll
            for (int m = 0; m < 4; ++m)
#pragma unroll
                for (int bj = 0; bj < 2; ++bj) *(u32x4*)(O + (size_t)(row0 + ai * HALF + m * 16) * ld + c0 + bj * HALF) = pack8(acc[ai][bj][m][0], acc[ai][bj][m][1]);
    }
};
struct EpiGate {
    static constexpr bool PERM = true, AFTER_DRAIN = false;
    unsigned char* ws; int ntn;
    __device__ __forceinline__ void operator()(const f32x4 (&acc)[2][2][4][2], const Unit& u, int wr, int wc, int fr, int fq) const {
        const bf16* const OB = (const bf16*)(ws + AR_OBUF); bf16* const MIX = (bf16*)(ws + AR_MIX);
        const int br = u.pn / ntn, row0 = u.pm * BM + wr * 64 + fr, c0 = (u.pn % ntn) * 256 + wc * 32 + 8 * fq;
        const bf16* ob = OB + (size_t)br * T * DM;
#pragma unroll
        for (int ai = 0; ai < 2; ++ai) {
            u32x4 o[4][2], mx[4][2];
#pragma unroll
            for (int m = 0; m < 4; ++m)
#pragma unroll
                for (int bj = 0; bj < 2; ++bj) { const size_t off = (size_t)(row0 + ai * HALF + m * 16) * DM + c0 + bj * HALF; o[m][bj] = *(const u32x4*)(ob + off); if (br != 0) mx[m][bj] = *(const u32x4*)(MIX + off); }
#pragma unroll
            for (int m = 0; m < 4; ++m)
#pragma unroll
                for (int bj = 0; bj < 2; ++bj) { const size_t off = (size_t)(row0 + ai * HALF + m * 16) * DM + c0 + bj * HALF;
                    f32x4 o0, o1; unpack8(o[m][bj], o0, o1);
                    f32x4 g0 = acc[ai][bj][m][0], g1 = acc[ai][bj][m][1];
#pragma unroll
                    for (int k = 0; k < 4; ++k) { g0[k] = fsig(g0[k]) * o0[k]; g1[k] = fsig(g1[k]) * o1[k]; }
                    if (br != 0) { f32x4 p0, p1; unpack8(mx[m][bj], p0, p1); g0 += p0; g1 += p1; }
                    *(u32x4*)(MIX + off) = pack8(g0, g1); }
        }
    }
};
struct EpiResid {
    static constexpr bool PERM = true, AFTER_DRAIN = false;
    const float* base; float* out;
    __device__ __forceinline__ void operator()(const f32x4 (&acc)[2][2][4][2], const Unit& u, int wr, int wc, int fr, int fq) const {
        const int row0 = u.pm * BM + wr * 64 + fr, c0 = u.pn * 256 + wc * 32 + 8 * fq;
#pragma unroll
        for (int ai = 0; ai < 2; ++ai)
#pragma unroll
            for (int mh = 0; mh < 2; ++mh) {
                f32x4 x[2][2][2];
#pragma unroll
                for (int mm = 0; mm < 2; ++mm)
#pragma unroll
                    for (int bj = 0; bj < 2; ++bj) { const size_t off = (size_t)(row0 + ai * HALF + (2 * mh + mm) * 16) * DM + c0 + bj * HALF; x[mm][bj][0] = *(const f32x4*)(base + off); x[mm][bj][1] = *(const f32x4*)(base + off + 4); }
#pragma unroll
                for (int mm = 0; mm < 2; ++mm)
#pragma unroll
                    for (int bj = 0; bj < 2; ++bj) { const int m = 2 * mh + mm; const size_t off = (size_t)(row0 + ai * HALF + m * 16) * DM + c0 + bj * HALF;
                        *(f32x4*)(out + off) = x[mm][bj][0] + acc[ai][bj][m][0]; *(f32x4*)(out + off + 4) = x[mm][bj][1] + acc[ai][bj][m][1]; }
            }
    }
};
struct EpiSwiglu {
    static constexpr bool PERM = true, AFTER_DRAIN = false;
    bf16* ACT; int ld, ntn;
    __device__ __forceinline__ void operator()(const f32x4 (&acc)[2][2][4][2], const Unit& u, int wr, int wc, int fr, int fq) const {
        const int row0 = u.pm * BM + wr * 64 + fr, c0 = (u.pn % ntn) * 128 + wc * 32 + 8 * fq;
#pragma unroll
        for (int ai = 0; ai < 2; ++ai)
#pragma unroll
            for (int m = 0; m < 4; ++m) { f32x4 g0 = acc[ai][0][m][0], g1 = acc[ai][0][m][1]; const f32x4 u0 = acc[ai][1][m][0], u1 = acc[ai][1][m][1];
#pragma unroll
                for (int k = 0; k < 4; ++k) { g0[k] = g0[k] * fsig(g0[k]) * u0[k]; g1[k] = g1[k] * fsig(g1[k]) * u1[k]; }
                *(u32x4*)(ACT + (size_t)(row0 + ai * HALF + m * 16) * ld + c0) = pack8(g0, g1); }
    }
};
struct EpiMoeDown {
    static constexpr bool PERM = true, AFTER_DRAIN = false;
    float* out; const int* rtok; const float* rw; int ntn; float sc;
    __device__ __forceinline__ void operator()(const f32x4 (&acc)[2][2][4][2], const Unit& u, int wr, int wc, int fr, int fq) const {
        const int row0 = u.pm * BM + wr * 64 + fr, c0 = (u.pn % ntn) * 256 + wc * 32 + 8 * fq;
#pragma unroll
        for (int ai = 0; ai < 2; ++ai)
#pragma unroll
            for (int mh = 0; mh < 2; ++mh) {
                int tok[2]; float w[2]; f32x4 x[2][2][2];
#pragma unroll
                for (int mm = 0; mm < 2; ++mm) { const int row = row0 + ai * HALF + (2 * mh + mm) * 16; tok[mm] = rtok[row]; w[mm] = rw[row] * sc; }
#pragma unroll
                for (int mm = 0; mm < 2; ++mm)
#pragma unroll
                    for (int bj = 0; bj < 2; ++bj) { const float* o = out + (size_t)(tok[mm] >= 0 ? tok[mm] : 0) * DM + c0 + bj * HALF; x[mm][bj][0] = *(const f32x4*)o; x[mm][bj][1] = *(const f32x4*)(o + 4); }
#pragma unroll
                for (int mm = 0; mm < 2; ++mm)
#pragma unroll
                    for (int bj = 0; bj < 2; ++bj) if (tok[mm] >= 0) { const int m = 2 * mh + mm; float* o = out + (size_t)tok[mm] * DM + c0 + bj * HALF;
                        *(f32x4*)o = x[mm][bj][0] + acc[ai][bj][m][0] * w[mm]; *(f32x4*)(o + 4) = x[mm][bj][1] + acc[ai][bj][m][1] * w[mm]; }
            }
    }
};

constexpr int MT_KS = 7, MT_K = EXPERT_FF / MT_KS;
struct MoeTailOrder {
    int nN, pm0, nsub, G, c, e0, e1, e2, e3, e4, e5, e6;
    __device__ void init(const MoeOrder& m, int pm0_, int ntiles, int G_, int c_) { nN = m.nN; pm0 = pm0_; nsub = ntiles * MT_KS; G = G_; c = c_; e0 = m.e0; e1 = m.e1; e2 = m.e2; e3 = m.e3; e4 = m.e4; e5 = m.e5; e6 = m.e6; }
    __device__ bool next(int i, Unit& u) const { const int L = i * G + c; if (L >= nsub) return false;
        const int j = L / MT_KS, ks = L - j * MT_KS, pm = pm0 + j / nN, pl = j % nN, e = (pm >= e0) + (pm >= e1) + (pm >= e2) + (pm >= e3) + (pm >= e4) + (pm >= e5) + (pm >= e6);
        u.pm = rfl(pm); u.pn = rfl((e * nN + pl) | (ks << 16)); return true; }
    __device__ __forceinline__ void a_ready(const Unit&) const {}
    __device__ __forceinline__ void done(const Unit&) const {}
};
struct EpiPart {
    static constexpr bool PERM = true, AFTER_DRAIN = false;
    float* part; int pm0, nN;
    __device__ __forceinline__ void operator()(const f32x4 (&acc)[2][2][4][2], const Unit& u, int wr, int wc, int fr, int fq) const {
        const int slot = ((u.pm - pm0) * nN + (u.pn & 0xffff) % nN) * MT_KS + (u.pn >> 16);
        float* b = part + (size_t)slot * 65536 + (size_t)(((wr * 4 + wc) * 64 + fq * 16 + fr) * 4);
#pragma unroll
        for (int ai = 0; ai < 2; ++ai)
#pragma unroll
            for (int bj = 0; bj < 2; ++bj)
#pragma unroll
                for (int m = 0; m < 4; ++m)
#pragma unroll
                    for (int n = 0; n < 2; ++n) *(f32x4*)(b + (((ai * 2 + bj) * 4 + m) * 2 + n) * 2048) = acc[ai][bj][m][n];
    }
};
__device__ __forceinline__ void moe_tail_combine(const EpiMoeDown& E, const MoeOrder& mo, const float* part, int pm0, int job, int lane_in) {
    int lane = lane_in; asm volatile("" : "+v"(lane));
    const int q = job & 3, role = (job >> 2) & 7, j = job >> 5, ai = q >> 1, mh = q & 1, pm = pm0 + j / mo.nN, pl = j % mo.nN, wr = role >> 2, wc = role & 3, fr = lane & 15, fq = lane >> 4;
    const float* b = part + (size_t)j * MT_KS * 65536 + (size_t)((role * 64 + lane) * 4);
    f32x4 a[2][2][2];
#pragma unroll
    for (int mm = 0; mm < 2; ++mm)
#pragma unroll
        for (int bj = 0; bj < 2; ++bj)
#pragma unroll
            for (int n = 0; n < 2; ++n) a[mm][bj][n] = *(const f32x4*)(b + (((ai * 2 + bj) * 4 + 2 * mh + mm) * 2 + n) * 2048);
#pragma unroll
    for (int ks = 1; ks < MT_KS; ++ks)
#pragma unroll
        for (int mm = 0; mm < 2; ++mm)
#pragma unroll
            for (int bj = 0; bj < 2; ++bj)
#pragma unroll
                for (int n = 0; n < 2; ++n) a[mm][bj][n] += *(const f32x4*)(b + (size_t)ks * 65536 + (((ai * 2 + bj) * 4 + 2 * mh + mm) * 2 + n) * 2048);
    const int row0 = pm * BM + wr * 64 + fr + ai * HALF + 2 * mh * 16, c0 = pl * 256 + wc * 32 + 8 * fq;
#pragma unroll
    for (int mm = 0; mm < 2; ++mm) { const int tok = E.rtok[row0 + mm * 16]; const float w = E.rw[row0 + mm * 16] * E.sc;
        if (tok >= 0) {
#pragma unroll
            for (int bj = 0; bj < 2; ++bj) { float* o = E.out + (size_t)tok * DM + c0 + bj * HALF; const f32x4 x0 = *(const f32x4*)o, x1 = *(const f32x4*)(o + 4);
                *(f32x4*)o = x0 + a[mm][bj][0] * w; *(f32x4*)(o + 4) = x1 + a[mm][bj][1] * w; } } }
}

typedef short bf16x8_t __attribute__((ext_vector_type(8)));
#define MFMA16(a, b, c) __builtin_amdgcn_mfma_f32_16x16x32_bf16((a), (b), (c), 0, 0, 0)
constexpr float ATT_C = 0.125f * 1.4426950408889634f;
constexpr int AW_IMP = 0, AW_SEL = 8448, AW_QS = 8960, AW_BYTES = 8960 + 8192;
__device__ __forceinline__ float bperm_f(float v, int srclane) { return __builtin_bit_cast(float, __builtin_amdgcn_ds_bpermute(srclane << 2, __builtin_bit_cast(int, v))); }
__device__ __forceinline__ int bperm_i(int v, int srclane) { return __builtin_amdgcn_ds_bpermute(srclane << 2, v); }
__device__ __forceinline__ bf16x8_t ldg8(const bf16* p) { return *(const bf16x8_t*)p; }
__device__ __forceinline__ bf16x8_t pack_p(const f32x4& a, const f32x4& b) {
    v4u w; w.x = cvt_pk_bf16(a[0], a[1]); w.y = cvt_pk_bf16(a[2], a[3]); w.z = cvt_pk_bf16(b[0], b[1]); w.w = cvt_pk_bf16(b[2], b[3]); return __builtin_bit_cast(bf16x8_t, w); }

__device__ __forceinline__ void nsa_attn_item(const P& p, int item, int lane, LAS unsigned char* wl) {
    const bf16* KV = WSP(bf16, AR_KV); const bf16* KC = WSP(bf16, AR_KC); const bf16* VcT = WSP(bf16, AR_VCT); const bf16* VsT = WSP(bf16, WS_VST); const bf16* VwT = WSP(bf16, WS_VWT);
    bf16* QB = WSP(bf16, AR_QB); const float* NG = WSP(float, AR_NG);
    const int bg = item / (SEQ / 16), t0 = (item % (SEQ / 16)) * 16, b = bg >> 1, g = bg & 1;
    const int col = lane & 15, fq = lane >> 4, tok = t0 + col;
    const size_t grow = (size_t)b * SEQ + tok;
    LAS float* IMP = (LAS float*)(wl + AW_IMP); LAS int* SEL = (LAS int*)(wl + AW_SEL); LAS bf16* OS = (LAS bf16*)(wl + AW_IMP);
    const int krowA = 8 * (col >> 2) + (col & 3);
    const float* gate = NG + grow * 24 + g * 12;
    LAS bf16x8_t* QS = (LAS bf16x8_t*)(wl + AW_QS) + lane;
#pragma unroll
    for (int hh = 0; hh < 4; ++hh)
#pragma unroll
        for (int ks = 0; ks < 2; ++ks) QS[(hh * 2 + ks) * 64] = ldg8(QB + grow * LDQ + (g * 4 + hh) * 64 + ks * 32 + fq * 8);
#define Qc(hh, ks) (QS[((hh) * 2 + (ks)) * 64])
    for (int i = lane; i < 16 * 132; i += 64) IMP[i] = 0.f;
    const f32x4 z4 = {0.f, 0.f, 0.f, 0.f};
    f32x4 O[4][4];
    int nvmax = (t0 + 15 >= 31) ? (((t0 + 15 - 31) >> 4) + 1) : 0; if (nvmax > NC) nvmax = NC;
    const int nch = (nvmax + 31) >> 5;
    const bf16* kcb = KC + (size_t)bg * 512 * 64; const bf16* vcb = VcT + (size_t)bg * 64 * 512;
    float linv[4] = {0.f, 0.f, 0.f, 0.f};
#pragma unroll
    for (int hh = 0; hh < 4; ++hh)
#pragma unroll
        for (int mt = 0; mt < 4; ++mt) O[hh][mt] = z4;
#pragma unroll 1
    for (int pass = 0; pass < 2; ++pass) {
#pragma unroll 1
        for (int ch = 0; ch < nch; ++ch) {
            asm volatile("" ::: "memory");
            const int k0 = 32 * ch; const bool cfull = 16 * (k0 + 31) + 31 <= t0;
            bf16x8_t ka[2][2];
#pragma unroll
            for (int tl = 0; tl < 2; ++tl)
#pragma unroll
                for (int ks = 0; ks < 2; ++ks) ka[tl][ks] = ldg8(kcb + ((size_t)(4 * ks + fq) * 512 + k0 + 16 * tl + col) * 8);
            bf16x8_t va[4];
            if (pass == 1) {
#pragma unroll
                for (int mt = 0; mt < 4; ++mt) va[mt] = ldg8(vcb + ((size_t)((k0 >> 3) + fq) * 64 + 16 * mt + col) * 8);
            }
            float ps[8] = {0.f, 0.f, 0.f, 0.f, 0.f, 0.f, 0.f, 0.f};
#pragma unroll
            for (int hh = 0; hh < 4; ++hh) {
                const bf16x8_t q0_ = Qc(hh, 0), q1_ = Qc(hh, 1);
                f32x4 sa = MFMA16(ka[0][0], q0_, z4); sa = MFMA16(ka[0][1], q1_, sa);
                f32x4 sb = MFMA16(ka[1][0], q0_, z4); sb = MFMA16(ka[1][1], q1_, sb);
#pragma unroll
                for (int i = 0; i < 4; ++i) { sa[i] = __builtin_amdgcn_exp2f(sa[i]); sb[i] = __builtin_amdgcn_exp2f(sb[i]); }
                if (!cfull) {
#pragma unroll
                    for (int i = 0; i < 4; ++i) { const int c = k0 + 4 * fq + i; sa[i] = (16 * c + 31 <= tok) ? sa[i] : 0.f; sb[i] = (16 * (c + 16) + 31 <= tok) ? sb[i] : 0.f; } }
                if (pass == 0) { linv[hh] += (sa[0] + sa[1]) + (sa[2] + sa[3]) + (sb[0] + sb[1]) + (sb[2] + sb[3]); }
                else {
#pragma unroll
                    for (int i = 0; i < 4; ++i) { ps[i] = __builtin_fmaf(sa[i], linv[hh], ps[i]); ps[4 + i] = __builtin_fmaf(sb[i], linv[hh], ps[4 + i]); }
                    const bf16x8_t pt = pack_p(sa, sb);
#pragma unroll
                    for (int mt = 0; mt < 4; ++mt) O[hh][mt] = MFMA16(va[mt], pt, O[hh][mt]);
                }
            }
            if (pass == 1) {
                const int Ga = 8 * ch + fq; LAS float* ir = IMP + col * 132 + Ga;
                __hip_atomic_fetch_add(ir, (ps[0] + ps[1]) + (ps[2] + ps[3]), __ATOMIC_RELAXED, __HIP_MEMORY_SCOPE_WORKGROUP);
                __hip_atomic_fetch_add(ir + 1, ps[3], __ATOMIC_RELAXED, __HIP_MEMORY_SCOPE_WORKGROUP);
                __hip_atomic_fetch_add(ir + 4, (ps[4] + ps[5]) + (ps[6] + ps[7]), __ATOMIC_RELAXED, __HIP_MEMORY_SCOPE_WORKGROUP);
                if (Ga + 5 < NS) __hip_atomic_fetch_add(ir + 5, ps[7], __ATOMIC_RELAXED, __HIP_MEMORY_SCOPE_WORKGROUP);
            }
        }
        if (pass == 0) {
#pragma unroll
            for (int hh = 0; hh < 4; ++hh) { float l = linv[hh]; l += bperm_f(l, lane ^ 16); l += bperm_f(l, lane ^ 32); linv[hh] = l > 0.f ? 1.f / l : 0.f; }
        }
    }
    LDS_WAIT(); asm volatile("" ::: "memory");
    {
        const int cur = tok >> 6; LAS float* sc = IMP + col * 132;
        for (int j = fq * 32; j < fq * 32 + 32; ++j) { const bool forced = (j == 0) || (j == cur) || (j == cur - 1); const float v = sc[j]; sc[j] = forced ? 1e4f : (j <= cur ? v : -1.f); }
        LDS_WAIT(); asm volatile("" ::: "memory");
#pragma unroll 1
        for (int r = 0; r < 8; ++r) {
            float bv = sc[fq * 32]; int bj = fq * 32;
            for (int j = fq * 32 + 1; j < fq * 32 + 32; ++j) { const float v = sc[j]; if (v > bv) { bv = v; bj = j; } }
#pragma unroll
            for (int o = 16; o <= 32; o <<= 1) { const float ov = bperm_f(bv, lane ^ o); const int oj = bperm_i(bj, lane ^ o); if (ov > bv || (ov == bv && oj < bj)) { bv = ov; bj = oj; } }
            if ((bj >> 5) == fq) sc[bj] = -3e38f;
            if (fq == 0) SEL[col * 8 + r] = bj;
            LDS_WAIT(); asm volatile("" ::: "memory");
        }
    }
#pragma unroll
    for (int hh = 0; hh < 4; ++hh) { const float g0 = gate[hh * 3 + 0] * linv[hh];
#pragma unroll
        for (int mt = 0; mt < 4; ++mt) { const f32x4 o = O[hh][mt] * g0; v2u w; w.x = cvt_pk_bf16(o[0], o[1]); w.y = cvt_pk_bf16(o[2], o[3]);
            *(LAS v2u*)(OS + (col * 4 + hh) * 64 + 16 * mt + 4 * fq) = w; } }
    LDS_WAIT(); asm volatile("" ::: "memory");
    const int cur = t0 >> 6;
    {
        const bf16* kwb = WSP(bf16, WS_KW8) + (size_t)bg * 8 * SEQ * 8; const bf16* vwb = VwT + (size_t)bg * 64 * SEQ;
        const bf16* ksb = WSP(bf16, WS_KS8) + (size_t)bg * 8 * SEQ * 8; const bf16* vsb = VsT + (size_t)bg * 64 * SEQ;
        int kst = t0 - (WINDOW - 1); if (kst < 0) kst = 0; kst &= ~31;
        const int nwin = ((t0 + 15 - kst) >> 5) + 1, nfb = cur >= 2 ? 3 : cur + 1;
#pragma unroll 1
        for (int part = 0; part < 2; ++part) {
            float lw[4] = {0.f, 0.f, 0.f, 0.f};
#pragma unroll
            for (int hh = 0; hh < 4; ++hh)
#pragma unroll
                for (int mt = 0; mt < 4; ++mt) O[hh][mt] = z4;
            const bf16* kb = part ? ksb : kwb; const bf16* vb = part ? vsb : vwb;
            const int nchk = part ? 2 * nfb : nwin;
#pragma unroll 1
            for (int ci = 0; ci < nchk; ++ci) {
                asm volatile("" ::: "memory");
                int k0;
                if (part == 0) k0 = kst + 32 * ci; else { const int fb = ci >> 1, j = fb == 0 ? 0 : (fb == 1 ? cur : cur - 1); k0 = 64 * j + 32 * (ci & 1); }
                bf16x8_t ka[2][2], va[4];
#pragma unroll
                for (int tl = 0; tl < 2; ++tl)
#pragma unroll
                    for (int ks = 0; ks < 2; ++ks) ka[tl][ks] = ldg8(kb + ((size_t)(4 * ks + fq) * SEQ + k0 + 16 * tl + col) * 8);
#pragma unroll
                for (int mt = 0; mt < 4; ++mt) va[mt] = ldg8(vb + ((size_t)((k0 >> 3) + fq) * 64 + 16 * mt + col) * 8);
                const int lowk = part ? -1 : tok - WINDOW; const bool dfull = (k0 + 31 <= t0) && (part || k0 > t0 + 15 - WINDOW);
#pragma unroll
                for (int hh = 0; hh < 4; ++hh) {
                    const bf16x8_t q0_ = Qc(hh, 0), q1_ = Qc(hh, 1);
                    f32x4 sa = MFMA16(ka[0][0], q0_, z4); sa = MFMA16(ka[0][1], q1_, sa);
                    f32x4 sb = MFMA16(ka[1][0], q0_, z4); sb = MFMA16(ka[1][1], q1_, sb);
#pragma unroll
                    for (int i = 0; i < 4; ++i) { sa[i] = __builtin_amdgcn_exp2f(sa[i]); sb[i] = __builtin_amdgcn_exp2f(sb[i]); }
                    if (!dfull) {
#pragma unroll
                        for (int i = 0; i < 4; ++i) { const int kt = k0 + 4 * fq + i; sa[i] = (kt <= tok && kt > lowk) ? sa[i] : 0.f; sb[i] = (kt + 16 <= tok && kt + 16 > lowk) ? sb[i] : 0.f; } }
                    lw[hh] += (sa[0] + sa[1]) + (sa[2] + sa[3]) + (sb[0] + sb[1]) + (sb[2] + sb[3]);
                    const bf16x8_t pt = pack_p(sa, sb);
#pragma unroll
                    for (int mt = 0; mt < 4; ++mt) O[hh][mt] = MFMA16(va[mt], pt, O[hh][mt]);
                }
            }
            LDS_WAIT(); asm volatile("" ::: "memory");
            if (part == 0) {
#pragma unroll
                for (int hh = 0; hh < 4; ++hh) { float l = lw[hh]; l += bperm_f(l, lane ^ 16); l += bperm_f(l, lane ^ 32); const float w = l > 0.f ? gate[hh * 3 + 2] / l : 0.f;
#pragma unroll
                    for (int mt = 0; mt < 4; ++mt) { LAS v2u* dp = (LAS v2u*)(OS + (col * 4 + hh) * 64 + 16 * mt + 4 * fq); const v2u old = *dp;
                        v2u w2; w2.x = cvt_pk_bf16(blo(old.x) + w * O[hh][mt][0], bhi(old.x) + w * O[hh][mt][1]); w2.y = cvt_pk_bf16(blo(old.y) + w * O[hh][mt][2], bhi(old.y) + w * O[hh][mt][3]); *dp = w2; } }
            } else {
                LAS bf16* OF = (LAS bf16*)(wl + AW_QS); LAS float* LF = (LAS float*)(wl + AW_IMP + 8192);
#pragma unroll
                for (int hh = 0; hh < 4; ++hh) { float l = lw[hh]; l += bperm_f(l, lane ^ 16); l += bperm_f(l, lane ^ 32); if (fq == 0) LF[col * 4 + hh] = l;
#pragma unroll
                    for (int mt = 0; mt < 4; ++mt) { v2u w2; w2.x = cvt_pk_bf16(O[hh][mt][0], O[hh][mt][1]); w2.y = cvt_pk_bf16(O[hh][mt][2], O[hh][mt][3]); *(LAS v2u*)(OF + (col * 4 + hh) * 64 + 16 * mt + 4 * fq) = w2; } }
            }
            LDS_WAIT(); asm volatile("" ::: "memory");
        }
    }
    {
        const bf16* ksb = WSP(bf16, WS_KS8) + (size_t)bg * 8 * SEQ * 8; const bf16* vsb = VsT + (size_t)bg * 64 * SEQ;
        const LAS bf16* OF = (const LAS bf16*)(wl + AW_QS); const LAS float* LF = (const LAS float*)(wl + AW_IMP + 8192);
#pragma unroll 1
        for (int tt = 0; tt < 16; ++tt) {
            const int tq = t0 + tt; const size_t qrow = (size_t)b * SEQ + tq;
            bf16x8_t Qh[2];
#pragma unroll
            for (int ks = 0; ks < 2; ++ks) { Qh[ks] = ldg8(QB + qrow * LDQ + (g * 4 + (col & 3)) * 64 + ks * 32 + fq * 8); if (col >= 4) Qh[ks] = (bf16x8_t){0, 0, 0, 0, 0, 0, 0, 0}; }
            f32x4 Os[4] = {z4, z4, z4, z4}; float ls = 0.f;
#ifdef APROBE_SEL
            for (int rp = 0; rp < 2; ++rp) { Os[0] = z4; Os[1] = z4; Os[2] = z4; Os[3] = z4; ls = 0.f; asm volatile("" ::: "memory");
#endif
#pragma unroll 1
            for (int r8 = 0; r8 < 8; ++r8) {
                const int j = __builtin_amdgcn_readfirstlane(SEL[tt * 8 + r8]);
                if (64 * j > tq || j == 0 || j == cur || j == cur - 1) continue;
                const int kb0 = 64 * j;
                bf16x8_t ka[2][2][2], va[2][4];
#pragma unroll
                for (int hf = 0; hf < 2; ++hf) {
#pragma unroll
                    for (int tl = 0; tl < 2; ++tl)
#pragma unroll
                        for (int ks = 0; ks < 2; ++ks) ka[hf][tl][ks] = ldg8(ksb + ((size_t)(4 * ks + fq) * SEQ + kb0 + 32 * hf + 16 * tl + col) * 8);
#pragma unroll
                    for (int mt = 0; mt < 4; ++mt) va[hf][mt] = ldg8(vsb + ((size_t)(((kb0 + 32 * hf) >> 3) + fq) * 64 + 16 * mt + col) * 8);
                }
#pragma unroll
                for (int hf = 0; hf < 2; ++hf) {
                    f32x4 sa = MFMA16(ka[hf][0][0], Qh[0], z4); sa = MFMA16(ka[hf][0][1], Qh[1], sa);
                    f32x4 sb = MFMA16(ka[hf][1][0], Qh[0], z4); sb = MFMA16(ka[hf][1][1], Qh[1], sb);
#pragma unroll
                    for (int i = 0; i < 4; ++i) { sa[i] = __builtin_amdgcn_exp2f(sa[i]); sb[i] = __builtin_amdgcn_exp2f(sb[i]); }
                    ls += (sa[0] + sa[1]) + (sa[2] + sa[3]) + (sb[0] + sb[1]) + (sb[2] + sb[3]);
                    const bf16x8_t pt = pack_p(sa, sb);
#pragma unroll
                    for (int mt = 0; mt < 4; ++mt) Os[mt] = MFMA16(va[hf][mt], pt, Os[mt]);
                }
            }
#ifdef APROBE_SEL
            }
#endif
            ls += bperm_f(ls, lane ^ 16); ls += bperm_f(ls, lane ^ 32);
            if (col < 4) {
                const float den = ls + LF[tt * 4 + col]; const float w = den > 0.f ? (NG + qrow * 24 + g * 12)[col * 3 + 1] / den : 0.f;
#pragma unroll
                for (int mt = 0; mt < 4; ++mt) { const int e = (tt * 4 + col) * 64 + 16 * mt + 4 * fq; const v2u old = *(const LAS v2u*)(OS + e), fo = *(const LAS v2u*)(OF + e);
                    v2u w2; w2.x = cvt_pk_bf16(blo(old.x) + w * (Os[mt][0] + blo(fo.x)), bhi(old.x) + w * (Os[mt][1] + bhi(fo.x))); w2.y = cvt_pk_bf16(blo(old.y) + w * (Os[mt][2] + blo(fo.y)), bhi(old.y) + w * (Os[mt][3] + bhi(fo.y)));
                    *(v2u*)(QB + qrow * LDQ + (g * 4 + col) * 64 + 16 * mt + 4 * fq) = w2; }
            }
        }
    }
    LDS_WAIT(); asm volatile("" ::: "memory");
#undef Qc
}

typedef _Float16 h16x2 __attribute__((ext_vector_type(2)));
__device__ __forceinline__ h16x2 as_h2(unsigned u) { h16x2 r; __builtin_memcpy(&r, &u, 4); return r; }
constexpr int SC_STEPS = 8, SC_BUF = 6 * 1024;
__device__ __forceinline__ float dpp_sum16(float v) {
    v += __builtin_bit_cast(float, __builtin_amdgcn_update_dpp(0, __builtin_bit_cast(int, v), 0xB1, 0xF, 0xF, true));
    v += __builtin_bit_cast(float, __builtin_amdgcn_update_dpp(0, __builtin_bit_cast(int, v), 0x4E, 0xF, 0xF, true));
    v += __builtin_bit_cast(float, __builtin_amdgcn_update_dpp(0, __builtin_bit_cast(int, v), 0x141, 0xF, 0xF, true));
    v += __builtin_bit_cast(float, __builtin_amdgcn_update_dpp(0, __builtin_bit_cast(int, v), 0x140, 0xF, 0xF, true));
    return v;
}
__device__ __forceinline__ void scan_fill(const bf16* RW, const bf16* Wm, const bf16* Am, size_t trow, int h, int lane, LAS unsigned char* buf) {
    const size_t t = trow + (lane >> 3); const int sub = (lane & 7) * 8;
    const bf16* row = RW + t * LDRW + h * 64 + sub;
    __builtin_amdgcn_global_load_lds((const unsigned*)(row + LBLK), (LAS unsigned*)(buf + 0 * 1024), 16, 0, 0);
    __builtin_amdgcn_global_load_lds((const unsigned*)(Am + t * RC + h * 64 + sub), (LAS unsigned*)(buf + 1 * 1024), 16, 0, 0);
    __builtin_amdgcn_global_load_lds((const unsigned*)(Wm + t * RC + h * 64 + sub), (LAS unsigned*)(buf + 2 * 1024), 16, 0, 0);
    __builtin_amdgcn_global_load_lds((const unsigned*)(row + 512), (LAS unsigned*)(buf + 3 * 1024), 16, 0, 0);
    __builtin_amdgcn_global_load_lds((const unsigned*)(row), (LAS unsigned*)(buf + 4 * 1024), 16, 0, 0);
    __builtin_amdgcn_global_load_lds((const unsigned*)(row + 1024), (LAS unsigned*)(buf + 5 * 1024), 16, 0, 0);
}
__device__ __forceinline__ void scan_unit(const P& p, int unit, int lane, LAS unsigned char* wl) {
    const bf16* RW = WSP(bf16, AR_RW); const bf16* Wm = WSP(bf16, AR_W); const bf16* Am = WSP(bf16, AR_A); bf16* Y = WSP(bf16, AR_UB);
    const int rg = unit & 15, h = (unit >> 4) & 7, b = unit >> 7, row = rg * 4 + (lane >> 4), kq = lane & 15;
    const size_t tb = (size_t)b * SEQ;
    float s0 = 0.f, s1 = 0.f, s2 = 0.f, s3 = 0.f;
    __builtin_amdgcn_s_setprio(3);
    scan_fill(RW, Wm, Am, tb, h, lane, wl);
#pragma unroll 1
    for (int c = 0; c < SEQ / SC_STEPS; ++c) {
        LAS unsigned char* buf = wl + (c & 1) * SC_BUF;
        asm volatile("s_waitcnt vmcnt(0) lgkmcnt(0)" ::: "memory");
        if (c + 1 < SEQ / SC_STEPS) scan_fill(RW, Wm, Am, tb + (size_t)(c + 1) * SC_STEPS, h, lane, wl + ((c + 1) & 1) * SC_BUF);
#ifndef SCAN_VARB
        float ys[SC_STEPS];
#pragma unroll
        for (int st = 0; st < SC_STEPS; ++st) {
            const LAS unsigned char* o = buf + st * 128 + kq * 8;
            const v2u kkw = *(const LAS v2u*)(o), bbw = *(const LAS v2u*)(o + 1024), eew = *(const LAS v2u*)(o + 2048), ktw = *(const LAS v2u*)(o + 3072), rrw = *(const LAS v2u*)(o + 4096);
#ifdef SCAN_BF16
            struct F2 { float x, y; }; const F2 kk0{blo(kkw.x), bhi(kkw.x)}, kk1{blo(kkw.y), bhi(kkw.y)}, bb0{blo(bbw.x), bhi(bbw.x)}, bb1{blo(bbw.y), bhi(bbw.y)}, ee0{blo(eew.x), bhi(eew.x)}, ee1{blo(eew.y), bhi(eew.y)}, kt0{blo(ktw.x), bhi(ktw.x)}, kt1{blo(ktw.y), bhi(ktw.y)}, rr0{blo(rrw.x), bhi(rrw.x)}, rr1{blo(rrw.y), bhi(rrw.y)};
            const float vv = bf2f(*(const LAS unsigned short*)(buf + 5 * 1024 + st * 128 + row * 2));
#else
            const h16x2 kk0 = as_h2(kkw.x), kk1 = as_h2(kkw.y), bb0 = as_h2(bbw.x), bb1 = as_h2(bbw.y);
            const h16x2 ee0 = as_h2(eew.x), ee1 = as_h2(eew.y);
#ifdef RKV_BF16
            struct F2 { float x, y; }; const F2 kt0{blo(ktw.x), bhi(ktw.x)}, kt1{blo(ktw.y), bhi(ktw.y)}, rr0{blo(rrw.x), bhi(rrw.x)}, rr1{blo(rrw.y), bhi(rrw.y)};
            const float vv = bf2f(*(const LAS unsigned short*)(buf + 5 * 1024 + st * 128 + row * 2));
#else
            const h16x2 kt0 = as_h2(ktw.x), kt1 = as_h2(ktw.y);
            const h16x2 rr0 = as_h2(rrw.x), rr1 = as_h2(rrw.y);
            const float vv = (float)__builtin_bit_cast(_Float16, *(const LAS unsigned short*)(buf + 5 * 1024 + st * 128 + row * 2));
#endif
#endif
            float d0 = __builtin_fmaf(s0, (float)kk0.x, 0.f); d0 = __builtin_fmaf(s1, (float)kk0.y, d0); float d1 = __builtin_fmaf(s2, (float)kk1.x, 0.f); d1 = __builtin_fmaf(s3, (float)kk1.y, d1);
            const float nskk = -dpp_sum16(d0 + d1);
            s0 = __builtin_fmaf(s0, -(float)ee0.x, s0); s1 = __builtin_fmaf(s1, -(float)ee0.y, s1); s2 = __builtin_fmaf(s2, -(float)ee1.x, s2); s3 = __builtin_fmaf(s3, -(float)ee1.y, s3);
            s0 = __builtin_fmaf(nskk, (float)bb0.x, s0); s1 = __builtin_fmaf(nskk, (float)bb0.y, s1); s2 = __builtin_fmaf(nskk, (float)bb1.x, s2); s3 = __builtin_fmaf(nskk, (float)bb1.y, s3);
            s0 = __builtin_fmaf(vv, (float)kt0.x, s0); s1 = __builtin_fmaf(vv, (float)kt0.y, s1); s2 = __builtin_fmaf(vv, (float)kt1.x, s2); s3 = __builtin_fmaf(vv, (float)kt1.y, s3);
            float y0 = __builtin_fmaf(s0, (float)rr0.x, 0.f); y0 = __builtin_fmaf(s1, (float)rr0.y, y0); float y1 = __builtin_fmaf(s2, (float)rr1.x, 0.f); y1 = __builtin_fmaf(s3, (float)rr1.y, y1);
            ys[st] = dpp_sum16(y0 + y1);
        }
        if (kq < SC_STEPS) { float yv = ys[0];
#pragma unroll
            for (int st = 1; st < SC_STEPS; ++st) yv = (kq == st) ? ys[st] : yv;
            Y[(tb + (size_t)c * SC_STEPS + kq) * RC + h * 64 + row] = f2bf(yv); }
    }
#else
#pragma unroll
        for (int st = 0; st < SC_STEPS; ++st) {
            const LAS unsigned char* o = buf + st * 128 + kq * 8;
            float kk[4], bb[4], ee[4], kt[4], rr[4];
            { const v2u w = *(const LAS v2u*)(o); const h16x2 a = as_h2(w.x), b2 = as_h2(w.y); kk[0] = (float)a.x; kk[1] = (float)a.y; kk[2] = (float)b2.x; kk[3] = (float)b2.y; }
            { const v2u w = *(const LAS v2u*)(o + 1024); const h16x2 a = as_h2(w.x), b2 = as_h2(w.y); bb[0] = (float)a.x; bb[1] = (float)a.y; bb[2] = (float)b2.x; bb[3] = (float)b2.y; }
            { const v2u w = *(const LAS v2u*)(o + 2048); const h16x2 a = as_h2(w.x), b2 = as_h2(w.y); ee[0] = (float)a.x; ee[1] = (float)a.y; ee[2] = (float)b2.x; ee[3] = (float)b2.y; }
            { const v2u w = *(const LAS v2u*)(o + 3072); const h16x2 a = as_h2(w.x), b2 = as_h2(w.y); kt[0] = (float)a.x; kt[1] = (float)a.y; kt[2] = (float)b2.x; kt[3] = (float)b2.y; }
            { const v2u w = *(const LAS v2u*)(o + 4096); const h16x2 a = as_h2(w.x), b2 = as_h2(w.y); rr[0] = (float)a.x; rr[1] = (float)a.y; rr[2] = (float)b2.x; rr[3] = (float)b2.y; }
            const float vv = (float)__builtin_bit_cast(_Float16, *(const LAS unsigned short*)(buf + 5 * 1024 + st * 128 + row * 2));
            const float skk = dpp_sum16((s0 * kk[0] + s1 * kk[1]) + (s2 * kk[2] + s3 * kk[3]));
            s0 = s0 - s0 * ee[0] - skk * bb[0] + vv * kt[0]; s1 = s1 - s1 * ee[1] - skk * bb[1] + vv * kt[1]; s2 = s2 - s2 * ee[2] - skk * bb[2] + vv * kt[2]; s3 = s3 - s3 * ee[3] - skk * bb[3] + vv * kt[3];
            const float y = dpp_sum16((s0 * rr[0] + s1 * rr[1]) + (s2 * rr[2] + s3 * rr[3]));
            if (kq == 0) Y[(tb + (size_t)c * SC_STEPS + st) * RC + h * 64 + row] = f2bf(y);
        }
    }
#endif
    asm volatile("s_waitcnt vmcnt(0) lgkmcnt(0)" ::: "memory");
    __builtin_amdgcn_s_setprio(0);
}
__device__ __forceinline__ float sum8(float v) {
    v += __builtin_bit_cast(float, __builtin_amdgcn_update_dpp(0, __builtin_bit_cast(int, v), 0xB1, 0xF, 0xF, true));
    v += __builtin_bit_cast(float, __builtin_amdgcn_update_dpp(0, __builtin_bit_cast(int, v), 0x4E, 0xF, 0xF, true));
    v += __builtin_bit_cast(float, __builtin_amdgcn_update_dpp(0, __builtin_bit_cast(int, v), 0x141, 0xF, 0xF, true));
    return v;
}
__device__ __forceinline__ void up8(v4u w, float* f) { f[0] = blo(w.x); f[1] = bhi(w.x); f[2] = blo(w.y); f[3] = bhi(w.y); f[4] = blo(w.z); f[5] = bhi(w.z); f[6] = blo(w.w); f[7] = bhi(w.w); }
#ifdef SCAN_BF16
#define uph8 up8
#define pkh8 pk8
#else
#define uph8 uph8_
#define pkh8 pkh8_
#endif
__device__ __forceinline__ void uph8_(v4u w, float* f) { const h16x2 a = as_h2(w.x), b = as_h2(w.y), c = as_h2(w.z), d = as_h2(w.w);
    f[0] = (float)a.x; f[1] = (float)a.y; f[2] = (float)b.x; f[3] = (float)b.y; f[4] = (float)c.x; f[5] = (float)c.y; f[6] = (float)d.x; f[7] = (float)d.y; }
__device__ __forceinline__ unsigned pkh2(float lo, float hi) { h16x2 v; v.x = (_Float16)lo; v.y = (_Float16)hi; return __builtin_bit_cast(unsigned, v); }
__device__ __forceinline__ v4u pkh8_(const float* f) { v4u w; w.x = pkh2(f[0], f[1]); w.y = pkh2(f[2], f[3]); w.z = pkh2(f[4], f[5]); w.w = pkh2(f[6], f[7]); return w; }
__device__ __forceinline__ v4u pk8(const float* f) { v4u w; w.x = cvt_pk_bf16(f[0], f[1]); w.y = cvt_pk_bf16(f[2], f[3]); w.z = cvt_pk_bf16(f[4], f[5]); w.w = cvt_pk_bf16(f[6], f[7]); return w; }
__device__ __forceinline__ void ldf8(const float* p, float* f) { const f32x4 a = *(const f32x4*)p, b = *(const f32x4*)(p + 4); f[0] = a[0]; f[1] = a[1]; f[2] = a[2]; f[3] = a[3]; f[4] = b[0]; f[5] = b[1]; f[6] = b[2]; f[7] = b[3]; }

struct EpiLora {
    static constexpr bool PERM = true, AFTER_DRAIN = false;
    unsigned char* ws;
    __device__ __forceinline__ void operator()(const f32x4 (&acc)[2][2][4][2], const Unit& u, int wr, int wc, int fr, int fq) const {
        const int which = u.pn >> 1, row0 = u.pm * BM + wr * 64 + fr, c0 = (u.pn & 1) * 256 + wc * 32 + 8 * fq;
        bf16* const O = (bf16*)(ws + (which == 0 ? AR_W : (which == 1 ? AR_A : (which == 2 ? AR_G : AR_UB))));
#pragma unroll
        for (int ai = 0; ai < 2; ++ai)
#pragma unroll
            for (int m = 0; m < 4; ++m)
#pragma unroll
                for (int bj = 0; bj < 2; ++bj) *(u32x4*)(O + (size_t)(row0 + ai * HALF + m * 16) * RC + c0 + bj * HALF) = pack8(acc[ai][bj][m][0], acc[ai][bj][m][1]);
    }
};
#ifdef RKV_BF16
#define UPR up8
#define PKR pk8
#else
#define UPR uph8
#define PKR pkh8
#endif
struct B2In { v4u k, a, w, vr, vv, vf; float gt; };
__device__ __forceinline__ void b2w_load(B2In& in, const P& p, int layer, int t, int lane) {
    const bf16* row = WSP(bf16, AR_RW) + (size_t)t * LDRW;
    in.k = *(const v4u*)(row + 512 + 8 * lane); in.a = *(const v4u*)(WSP(bf16, AR_A) + (size_t)t * RC + 8 * lane); in.w = *(const v4u*)(WSP(bf16, AR_W) + (size_t)t * RC + 8 * lane);
    in.gt = lane < 24 ? bf2f(row[LBLK + 320 + lane]) : 0.f;
    if (layer == 1) { in.vr = *(const v4u*)(WSP(bf16, AR_UB) + (size_t)t * RC + 8 * lane); in.vv = *(const v4u*)(row + 1024 + 8 * lane); in.vf = *(const v4u*)(WSP(bf16, WS_VF) + (size_t)t * RC + 8 * lane); }
}
__device__ __forceinline__ void b2w_compute(const B2In& in, const P& p, int layer, int t, int lane, const float* v0, const float* v1, const float* v2, const float* v3, const float* vb) {
    bf16* row = WSP(bf16, AR_RW) + (size_t)t * LDRW; bf16* Am = WSP(bf16, AR_A); bf16* Wm = WSP(bf16, AR_W); float* NG = WSP(float, AR_NG);
    float k[8], a[8], w[8]; uph8(in.k, k); up8(in.a, a); up8(in.w, w);
    const float ngv = fsig(in.gt);
    float kk[8], ss = 0.f;
#pragma unroll
    for (int i = 0; i < 8; ++i) {
        a[i] = fsig(a[i] + v1[i]);
        const float nx = -(w[i] + v0[i]), sp = fmaxf(nx, 0.f) + __logf(1.f + __expf(-fabsf(nx))), e = __expf(-sp - 0.5f); w[i] = 1.f - __expf(-e);
        kk[i] = k[i] * v2[i]; ss += kk[i] * kk[i]; }
    ss = sum8(ss); const float nrm = sqrtf(ss), inv = 1.f / (nrm > 1e-12f ? nrm : 1e-12f);
#pragma unroll
    for (int i = 0; i < 8; ++i) { kk[i] *= inv; k[i] = k[i] * (1.f + (a[i] - 1.f) * v3[i]); a[i] *= kk[i]; }
    asm volatile("" :: "v"(ngv));
    if (layer == 1) { float vr[8], vv[8], vf[8]; up8(in.vr, vr); uph8(in.vv, vv); uph8(in.vf, vf);
#pragma unroll
        for (int i = 0; i < 8; ++i) vv[i] = vv[i] + (vf[i] - vv[i]) * fsig(vr[i] + vb[i]);
        *(v4u*)(row + 1024 + 8 * lane) = pkh8(vv); }
    if (lane < 24) NG[(size_t)t * 24 + lane] = ngv;
    *(v4u*)(row + LBLK + 8 * lane) = pkh8(kk); *(v4u*)(row + 512 + 8 * lane) = pkh8(k);
    *(v4u*)(Am + (size_t)t * RC + 8 * lane) = pkh8(a); *(v4u*)(Wm + (size_t)t * RC + 8 * lane) = pkh8(w);
}
__device__ __forceinline__ void ph_rwkv_b2w(const P& p, int layer, int gw, int NGW, int lane) {
    const float* vec = p.rwkv_vec + (size_t)layer * 7 * RC; float v0[8], v1[8], v2[8], v3[8], vb[8];
    ldf8(vec + 8 * lane, v0); ldf8(vec + RC + 8 * lane, v1); ldf8(vec + 2 * RC + 8 * lane, v2); ldf8(vec + 3 * RC + 8 * lane, v3); ldf8(p.vres_b + 8 * lane, vb);
    int t = gw; if (t >= T) return;
    B2In A, B; b2w_load(A, p, layer, t, lane);
    for (; t < T; t += 2 * NGW) { const int t1 = t + NGW, t2 = t1 + NGW;
        b2w_load(B, p, layer, t1 < T ? t1 : t, lane); b2w_compute(A, p, layer, t, lane, v0, v1, v2, v3, vb);
        if (t1 < T) { b2w_load(A, p, layer, t2 < T ? t2 : t1, lane); b2w_compute(B, p, layer, t1, lane, v0, v1, v2, v3, vb); } }
}
struct PoIn { v4u y, r, k, v, g; };
__device__ __forceinline__ void post_load(PoIn& in, const P& p, int t, int lane) { const bf16* row = WSP(bf16, AR_RW) + (size_t)t * LDRW;
    in.y = *(const v4u*)(WSP(bf16, AR_UB) + (size_t)t * RC + 8 * lane); in.r = *(const v4u*)(row + 8 * lane); in.k = *(const v4u*)(row + 512 + 8 * lane); in.v = *(const v4u*)(row + 1024 + 8 * lane); in.g = *(const v4u*)(WSP(bf16, AR_G) + (size_t)t * RC + 8 * lane); }
__device__ __forceinline__ void post_compute(const PoIn& in, const P& p, int t, int lane, const float* v4_, const float* v5, const float* v6) {
    float y[8], r[8], k[8], v[8], g[8]; up8(in.y, y); uph8(in.r, r); uph8(in.k, k); uph8(in.v, v); up8(in.g, g);
    float s = 0.f, bon = 0.f;
#pragma unroll
    for (int i = 0; i < 8; ++i) { s += y[i]; bon += r[i] * k[i] * v4_[i]; }
    const float m = sum8(s) * (1.f / 64.f); bon = sum8(bon);
    float q = 0.f;
#pragma unroll
    for (int i = 0; i < 8; ++i) { y[i] -= m; q += y[i] * y[i]; }
    const float rstd = 1.f / sqrtf(sum8(q) * (1.f / 64.f) + GN_EPS);
#pragma unroll
    for (int i = 0; i < 8; ++i) y[i] = (y[i] * rstd * v5[i] + v6[i] + bon * v[i]) * g[i];
    *(v4u*)(WSP(bf16, AR_A) + (size_t)t * RC + 8 * lane) = pk8(y);
}
__device__ __forceinline__ void ph_rwkv_postw(const P& p, int layer, int gw, int NGW, int lane) {
    const float* vec = p.rwkv_vec + (size_t)layer * 7 * RC; float v4_[8], v5[8], v6[8]; ldf8(vec + 4 * RC + 8 * lane, v4_); ldf8(vec + 5 * RC + 8 * lane, v5); ldf8(vec + 6 * RC + 8 * lane, v6);
    int t = gw; if (t >= T) return;
    PoIn A, B; post_load(A, p, t, lane);
    for (; t < T; t += 2 * NGW) { const int t1 = t + NGW, t2 = t1 + NGW;
        post_load(B, p, t1 < T ? t1 : t, lane); post_compute(A, p, t, lane, v4_, v5, v6);
        if (t1 < T) { post_load(A, p, t2 < T ? t2 : t1, lane); post_compute(B, p, t1, lane, v4_, v5, v6); } }
}
__device__ __forceinline__ void tr8x8(v4u& w, unsigned selA, bool b1, bool b2) {
    unsigned r[4] = {w.x, w.y, w.z, w.w};
#pragma unroll
    for (int i = 0; i < 4; ++i) { const unsigned pv = (unsigned)__builtin_amdgcn_update_dpp(0, (int)r[i], 0xB1, 0xF, 0xF, true); r[i] = __builtin_amdgcn_perm(pv, r[i], selA); }
#pragma unroll
    for (int a = 0; a < 4; a += 2) { const unsigned send = b1 ? r[a] : r[a + 1]; const unsigned recv = (unsigned)__builtin_amdgcn_update_dpp(0, (int)send, 0x4E, 0xF, 0xF, true);
        r[a] = b1 ? recv : r[a]; r[a + 1] = b1 ? r[a + 1] : recv; }
#pragma unroll
    for (int a = 0; a < 2; ++a) { const unsigned send = b2 ? r[a] : r[a + 2];
        int recv = __builtin_amdgcn_update_dpp(0, (int)send, 0x104, 0xF, 0x5, false);
        recv = __builtin_amdgcn_update_dpp(recv, (int)send, 0x114, 0xF, 0xA, false);
        r[a] = b2 ? (unsigned)recv : r[a]; r[a + 2] = b2 ? r[a + 2] : (unsigned)recv; }
    w.x = r[0]; w.y = r[1]; w.z = r[2]; w.w = r[3];
}
__device__ __forceinline__ void ph_vtransw(const P& p, int gw, int NGW, int lane_in) {
    int lane = lane_in; asm volatile("" : "+v"(lane));
    const bf16* KV = WSP(bf16, AR_KV); bf16* VsT = WSP(bf16, WS_VST); bf16* VwT = WSP(bf16, WS_VWT);
    const int j = lane & 7, c = lane >> 3; const unsigned selA = (lane & 1) ? 0x03020706u : 0x05040100u; const bool b1 = (lane & 2) != 0, b2 = (lane & 4) != 0;
    constexpr int NU = BATCH * NKV * (SEQ / 8);
    for (int u0 = gw * 4; u0 < NU; u0 += NGW * 4) {
        v4u s[4], w[4];
#pragma unroll
        for (int i = 0; i < 4; ++i) { const int u = u0 + i, kg = u % (SEQ / 8), bg = u / (SEQ / 8), b = bg / NKV, g = bg % NKV, tok = (kg >> 2) * 32 + 4 * (kg & 3) + (j & 3) + 16 * (j >> 2);
            const bf16* src = KV + (size_t)(b * SEQ + tok) * LDKV + g * 64 + 8 * c; s[i] = *(const v4u*)(src + 128); w[i] = *(const v4u*)(src + 384); }
#pragma unroll
        for (int i = 0; i < 4; ++i) { tr8x8(s[i], selA, b1, b2); tr8x8(w[i], selA, b1, b2);
            *(v4u*)(VsT + ((size_t)(u0 + i) * 64 + lane) * 8) = s[i]; *(v4u*)(VwT + ((size_t)(u0 + i) * 64 + lane) * 8) = w[i]; }
    }
}
typedef float f32x2 __attribute__((ext_vector_type(2)));
__device__ __forceinline__ f32x2 up2(unsigned w) { f32x2 r; r.x = __builtin_bit_cast(float, w << 16); r.y = __builtin_bit_cast(float, w & 0xffff0000u); return r; }
template <int JJ>
__device__ __forceinline__ void conv_row(f32x2 (&a)[8][4], f32x2 (&wt)[8][4], v4u (&cur)[8], f32x4& wn0, f32x4& wn1, const LAS float* wlane, const bf16* ub, int g, int j0) {
    const int j = 8 * g + JJ;
    wt[JJ][0] = (f32x2){wn0.x, wn0.y}; wt[JJ][1] = (f32x2){wn0.z, wn0.w}; wt[JJ][2] = (f32x2){wn1.x, wn1.y}; wt[JJ][3] = (f32x2){wn1.z, wn1.w};
    { const int jl = j + 1 < CONV_K ? j + 1 : CONV_K - 1; wn0 = *(const LAS f32x4*)(wlane + jl * CONV_CH); wn1 = *(const LAS f32x4*)(wlane + jl * CONV_CH + 4); }
    const unsigned msk = j >= j0 ? 0xffffffffu : 0u;
    f32x2 u[4]; u[0] = up2(cur[JJ].x & msk); u[1] = up2(cur[JJ].y & msk); u[2] = up2(cur[JJ].z & msk); u[3] = up2(cur[JJ].w & msk);
    { int jn = j + 8; jn = jn < j0 ? j0 : jn; jn = jn > CONV_K + 6 ? CONV_K + 6 : jn; cur[JJ] = *(const v4u*)(ub + (size_t)jn * CONV_CH); }
#pragma unroll
    for (int q = 0; q < 8; ++q) { const int tap = j - q; if (tap >= 0 && tap < CONV_K) {
#pragma unroll
        for (int i = 0; i < 4; ++i) a[q][i] = __builtin_elementwise_fma(u[i], wt[(JJ - q) & 7][i], a[q][i]); } }
}
__device__ __forceinline__ void ph_convw(const P& p, int layer, int gw, int NGW, int lane, int tid, LAS unsigned char* lds) {
    const bf16* UB = WSP(bf16, AR_UB); bf16* CO = WSP(bf16, AR_CO);
    const float* cw = p.conv_w + (size_t)layer * CONV_K * CONV_CH; const float* cv = p.conv_vec + (size_t)layer * 3 * CONV_CH;
    LAS float* wl = (LAS float*)lds;
    { f32x4 tw[8];
#pragma unroll
      for (int k = 0; k < 8; ++k) { const int i4 = tid + k * NTHREADS; tw[k] = i4 < CONV_K * CONV_CH / 4 ? *(const f32x4*)(cw + 4 * i4) : *(const f32x4*)(cv + 4 * (i4 - CONV_K * CONV_CH / 4)); }
      f32x4 tl = (f32x4){0.f, 0.f, 0.f, 0.f}; if (tid < 256) tl = *(const f32x4*)(cv + 4 * (tid + 8 * NTHREADS - CONV_K * CONV_CH / 4));
#pragma unroll
      for (int k = 0; k < 8; ++k) *(LAS f32x4*)(wl + 4 * (tid + k * NTHREADS)) = tw[k];
      if (tid < 256) *(LAS f32x4*)(wl + 4 * (tid + 8 * NTHREADS)) = tl; }
    TKQ(7);
    __syncthreads();
    TKQ(8);
    const LAS float* wlane = wl + 8 * lane;
    for (int tb = gw * 8; tb < T; tb += NGW * 8) {
        const int pos0 = tb % SEQ, j0 = pos0 >= 30 ? 0 : 30 - pos0;
        const bf16* ub = UB + ((size_t)tb * CONV_CH + 8 * lane) - (size_t)30 * CONV_CH;
        f32x2 a[8][4], wt[8][4]; v4u cur[8];
        { const f32x4 c0 = *(const LAS f32x4*)(wlane + CONV_K * CONV_CH), c1 = *(const LAS f32x4*)(wlane + CONV_K * CONV_CH + 4);
#pragma unroll
          for (int q = 0; q < 8; ++q) { a[q][0] = (f32x2){c0.x, c0.y}; a[q][1] = (f32x2){c0.z, c0.w}; a[q][2] = (f32x2){c1.x, c1.y}; a[q][3] = (f32x2){c1.z, c1.w}; } }
#pragma unroll
        for (int jj = 0; jj < 8; ++jj) cur[jj] = *(const v4u*)(ub + (size_t)(jj < j0 ? j0 : jj) * CONV_CH);
        f32x4 wn0 = *(const LAS f32x4*)(wlane), wn1 = *(const LAS f32x4*)(wlane + 4);
#pragma unroll 1
        for (int g = 0; g < 5; ++g) {
            conv_row<0>(a, wt, cur, wn0, wn1, wlane, ub, g, j0); conv_row<1>(a, wt, cur, wn0, wn1, wlane, ub, g, j0); conv_row<2>(a, wt, cur, wn0, wn1, wlane, ub, g, j0); conv_row<3>(a, wt, cur, wn0, wn1, wlane, ub, g, j0);
            conv_row<4>(a, wt, cur, wn0, wn1, wlane, ub, g, j0); conv_row<5>(a, wt, cur, wn0, wn1, wlane, ub, g, j0); conv_row<6>(a, wt, cur, wn0, wn1, wlane, ub, g, j0); conv_row<7>(a, wt, cur, wn0, wn1, wlane, ub, g, j0);
        }
        const f32x4 g10 = *(const LAS f32x4*)(wlane + (CONV_K + 1) * CONV_CH), g11 = *(const LAS f32x4*)(wlane + (CONV_K + 1) * CONV_CH + 4);
        const f32x4 b20 = *(const LAS f32x4*)(wlane + (CONV_K + 2) * CONV_CH), b21 = *(const LAS f32x4*)(wlane + (CONV_K + 2) * CONV_CH + 4);
        const f32x2 g1[4] = {(f32x2){g10.x, g10.y}, (f32x2){g10.z, g10.w}, (f32x2){g11.x, g11.y}, (f32x2){g11.z, g11.w}}, b2[4] = {(f32x2){b20.x, b20.y}, (f32x2){b20.z, b20.w}, (f32x2){b21.x, b21.y}, (f32x2){b21.z, b21.w}};
#pragma unroll
        for (int q = 0; q < 8; ++q) {
            const f32x2 s2 = (a[q][0] + a[q][1]) + (a[q][2] + a[q][3]);
            const float mean = wave_sum(s2.x + s2.y, lane) * (1.f / CONV_CH); f32x2 q2 = (f32x2){0.f, 0.f};
#pragma unroll
            for (int i = 0; i < 4; ++i) { a[q][i] -= (f32x2){mean, mean}; q2 = __builtin_elementwise_fma(a[q][i], a[q][i], q2); }
            const float rstd = 1.f / sqrtf(wave_sum(q2.x + q2.y, lane) * (1.f / CONV_CH) + LN_EPS);
            float y[8];
#pragma unroll
            for (int i = 0; i < 4; ++i) { const f32x2 yy = __builtin_elementwise_fma(a[q][i] * (f32x2){rstd, rstd}, g1[i], b2[i]); y[2 * i] = yy.x * fsig(yy.x); y[2 * i + 1] = yy.y * fsig(yy.y); }
            *(v4u*)(CO + (size_t)(tb + q) * CONV_CH + 8 * lane) = pk8(y);
        }
    }
    TKQ(9);
    __syncthreads();
}
__device__ __forceinline__ void ph_cmp2w(const P& p, int layer, int gw, int NGW, int lane, LAS float* hl  ) {
    const bf16* Z = WSP(bf16, AR_HID); const float* pec = (const float*)(p.ws + WS_W + (size_t)layer * SZ_LAYERW + OFF_PEC);
    for (int it = gw; it < 2 * BATCH * NKV * NC; it += NGW) {
        const int i = it % NC, r = it / NC, bg = r % (BATCH * NKV), which = r / (BATCH * NKV);
        const bf16* z1 = Z + ((size_t)which * (BATCH * NKV * 512) + (size_t)bg * 512 + i) * 256; const bf16* z2 = z1 + 256 + 128;
#pragma unroll
        for (int jj = 0; jj < 2; ++jj) { const int j = lane + 64 * jj; const float x = bf2f(z1[j]) + bf2f(z2[j]) + pec[which * 128 + j];
            const float e = __expf(fminf(2.f * 0.7978845608028654f * (x + 0.044715f * x * x * x), 30.f)); hl[j] = 0.5f * x * (1.f + (e - 1.f) / (e + 1.f)); }
        LDS_WAIT(); asm volatile("" ::: "memory");
        const float* w2 = p.cmp_w2 + (size_t)(layer * 2 + which) * 128 * 64 + lane; float o = 0.f;
#pragma unroll 8
        for (int j = 0; j < 128; ++j) o += hl[j] * w2[j * 64];
        if (which == 0) {
            const float rs = 1.f / sqrtf(wave_sum(o * o, lane) * (1.f / 64.f) + RMS_EPS); o = o * rs * p.qk_g[(layer * 4 + 1) * 64 + lane];
            const float other = bperm_f(o, lane ^ 32); float cs, sn; rope_cs(16 * i + 31, lane & 31, cs, sn);
            o = lane < 32 ? o * cs - other * sn : o * cs + other * sn;
            WSP(bf16, AR_KC)[(((size_t)bg * 8 + (lane >> 3)) * 512 + i) * 8 + (lane & 7)] = f2bf(o);
        } else { bf16* vt = WSP(bf16, AR_VCT) + (size_t)bg * 64 * 512 + lane * 8;
            vt[(size_t)((i >> 5) * 4 + ((i & 15) >> 2)) * 512 + (i & 3) + 4 * ((i >> 4) & 1)] = f2bf(o); if (i == 0) vt[(size_t)((NC >> 5) * 4 + ((NC & 15) >> 2)) * 512 + (NC & 3) + 4 * ((NC >> 4) & 1)] = 0; }
        LDS_WAIT(); asm volatile("" ::: "memory");
    }
}

struct MapPlain { bf16* base; int K; __device__ __forceinline__ bf16* operator()(int col) const { return base + (size_t)col * K; } };
struct MapGlu { bf16* base; int K, ff; __device__ __forceinline__ bf16* operator()(int col) const { return base + (size_t)glu_dest(col, ff) * K; } };
struct MapWin { unsigned char* wl; int layer; __device__ __forceinline__ bf16* operator()(int col) const { int which; const int r = win_dest(col, layer, which); const size_t off = (which ? OFF_WG : OFF_WIN) + (size_t)(r < 0 ? 0 : r) * DM * 2; return r < 0 ? nullptr : (bf16*)(wl + off); } };
template <class Map>
__device__ __forceinline__ void transpose_item(const float* W, int K, int N, const Map& mp, LAS float* scr, int item, int lane) {
    const int nblk = (N + 31) / 32, kb = item / nblk, nb = item % nblk, k0 = 64 * kb, n0 = 32 * nb;
    const int c4 = 4 * (lane & 7), col = n0 + c4;
    f32x4 v[8];
#pragma unroll
    for (int i = 0; i < 8; ++i) v[i] = col < N ? *(const f32x4*)(W + (size_t)(k0 + (lane >> 3) + 8 * i) * N + col) : (f32x4){0.f, 0.f, 0.f, 0.f};
#pragma unroll
    for (int i = 0; i < 8; ++i) { LAS float* d = scr + ((lane >> 3) + 8 * i) * 33 + c4; d[0] = v[i].x; d[1] = v[i].y; d[2] = v[i].z; d[3] = v[i].w; }
    LDS_WAIT(); asm volatile("" ::: "memory");
    const int c = lane & 7;
#pragma unroll
    for (int j = 0; j < 4; ++j) { const int n = (lane >> 3) + 8 * j; const LAS float* s = scr + (8 * c) * 33 + n;
        v4u o; o.x = (unsigned)f2bf(s[0]) | ((unsigned)f2bf(s[33]) << 16); o.y = (unsigned)f2bf(s[66]) | ((unsigned)f2bf(s[99]) << 16);
        o.z = (unsigned)f2bf(s[132]) | ((unsigned)f2bf(s[165]) << 16); o.w = (unsigned)f2bf(s[198]) | ((unsigned)f2bf(s[231]) << 16);
        if (n0 + n < N) { bf16* d = mp(n0 + n); if (d) *(v4u*)(d + k0 + 8 * c) = o; } }
    LDS_WAIT(); asm volatile("" ::: "memory");
}
template <class Map>
__device__ __forceinline__ bool conv_job(int& r, const float* W, int K, int N, const Map& mp, LAS float* scr, int lane) {
    const int items = (K / 64) * ((N + 31) / 32);
    if (r < items) { transpose_item(W, K, N, mp, scr, r, lane); return true; }
    r -= items; return false;
}

struct RmsIn { f32x4 v[DM / 256]; };
__device__ __forceinline__ void rms_load(RmsIn& r, const float* xrow, int lane) { const f32x4* xr = (const f32x4*)xrow + lane;
#pragma unroll
    for (int j = 0; j < DM / 256; ++j) r.v[j] = xr[64 * j]; }
__device__ __forceinline__ void rms_row(const P& p, const RmsIn& rin, const float* g, bf16* orow, int lane, bool route, int t, unsigned long long& c0, unsigned long long& c1) {
    const f32x4* gr = (const f32x4*)g + lane;
    f32x4 v[DM / 256]; float ss = 0.f;
#pragma unroll
    for (int j = 0; j < DM / 256; ++j) { v[j] = rin.v[j]; ss += (v[j].x * v[j].x + v[j].y * v[j].y) + (v[j].z * v[j].z + v[j].w * v[j].w); }
    const float rs = 1.f / sqrtf(wave_sum(ss, lane) * (1.f / DM) + RMS_EPS);
    v2u* o8 = (v2u*)orow + lane;
#pragma unroll
    for (int j = 0; j < DM / 256; ++j) { const f32x4 gg = gr[64 * j]; v[j].x *= rs * gg.x; v[j].y *= rs * gg.y; v[j].z *= rs * gg.z; v[j].w *= rs * gg.w;
        v2u w; w.x = cvt_pk_bf16(v[j].x, v[j].y); w.y = cvt_pk_bf16(v[j].z, v[j].w); o8[64 * j] = w; }
    if (route) {
        float lg[NEXP];
#pragma unroll
        for (int e = 0; e < NEXP; ++e) lg[e] = 0.f;
#pragma unroll
        for (int j = 0; j < DM / 256; ++j) { const float* rw = p.router_w + (size_t)(4 * (lane + 64 * j)) * NEXP;
#pragma unroll
            for (int e = 0; e < NEXP; ++e) lg[e] += v[j].x * rw[e] + v[j].y * rw[NEXP + e] + v[j].z * rw[2 * NEXP + e] + v[j].w * rw[3 * NEXP + e]; }
#pragma unroll
        for (int e = 0; e < NEXP; ++e) lg[e] = wave_sum(lg[e], lane) + p.router_b[e];
        int e0 = 0; float l0 = lg[0];
#pragma unroll
        for (int e = 1; e < NEXP; ++e) if (lg[e] > l0) { l0 = lg[e]; e0 = e; }
        int e1 = -1; float l1 = -3e38f;
#pragma unroll
        for (int e = 0; e < NEXP; ++e) if (e != e0 && lg[e] > l1) { l1 = lg[e]; e1 = e; }
        e0 = __builtin_amdgcn_readfirstlane(e0); e1 = __builtin_amdgcn_readfirstlane(e1);
        const int r0 = (int)((c0 >> (8 * e0)) & 255ull), r1 = (int)((c1 >> (8 * e1)) & 255ull);
        c0 += 1ull << (8 * e0); c1 += 1ull << (8 * e1);
        if (lane == 0) { const float w0 = 1.f / (1.f + expf(l1 - l0));
            WSP(int, AR_RTE)[t] = e0 | (e1 << 8) | (r0 << 16) | (r1 << 24); float* rw = WSP(float, AR_RTW) + (size_t)t * 2; rw[0] = w0; rw[1] = 1.f - w0; }
    }
}
__device__ __forceinline__ void rms_row_route(const P& p, const RmsIn& rin, const float* g, bf16* orow, int lane, int t, unsigned long long& c0, unsigned long long& c1, const float (&rwr)[128]) {
    const f32x4* gr = (const f32x4*)g + lane;
    f32x4 v[DM / 256]; float ss = 0.f;
#pragma unroll
    for (int j = 0; j < DM / 256; ++j) { v[j] = rin.v[j]; ss += (v[j].x * v[j].x + v[j].y * v[j].y) + (v[j].z * v[j].z + v[j].w * v[j].w); }
    const float rs = 1.f / sqrtf(wave_sum(ss, lane) * (1.f / DM) + RMS_EPS);
    v2u* o8 = (v2u*)orow + lane;
#pragma unroll
    for (int j = 0; j < DM / 256; ++j) { const f32x4 gg = gr[64 * j]; v[j].x *= rs * gg.x; v[j].y *= rs * gg.y; v[j].z *= rs * gg.z; v[j].w *= rs * gg.w;
        v2u w; w.x = cvt_pk_bf16(v[j].x, v[j].y); w.y = cvt_pk_bf16(v[j].z, v[j].w); o8[64 * j] = w; }
    float lg[NEXP];
#pragma unroll
    for (int e = 0; e < NEXP; ++e) lg[e] = 0.f;
#pragma unroll
    for (int j = 0; j < DM / 256; ++j)
#pragma unroll
        for (int e = 0; e < NEXP; ++e) lg[e] += v[j].x * rwr[(4 * j) * 8 + e] + v[j].y * rwr[(4 * j + 1) * 8 + e] + v[j].z * rwr[(4 * j + 2) * 8 + e] + v[j].w * rwr[(4 * j + 3) * 8 + e];
    float r4[4], r2[2], r1;
    { const bool hi = (lane & 32) != 0;
#pragma unroll
      for (int i = 0; i < 4; ++i) { const float mine = hi ? lg[4 + i] : lg[i], theirs = hi ? lg[i] : lg[4 + i]; r4[i] = mine + bperm_f(theirs, lane ^ 32); } }
    { const bool hi = (lane & 16) != 0;
#pragma unroll
      for (int i = 0; i < 2; ++i) { const float mine = hi ? r4[2 + i] : r4[i], theirs = hi ? r4[i] : r4[2 + i]; r2[i] = mine + bperm_f(theirs, lane ^ 16); } }
    { const bool hi = (lane & 8) != 0; const float mine = hi ? r2[1] : r2[0], theirs = hi ? r2[0] : r2[1]; r1 = mine + bperm_f(theirs, lane ^ 8); }
    r1 += bperm_f(r1, lane ^ 4); r1 += bperm_f(r1, lane ^ 2); r1 += bperm_f(r1, lane ^ 1);
#pragma unroll
    for (int e = 0; e < NEXP; ++e) lg[e] = __builtin_bit_cast(float, __builtin_amdgcn_readlane(__builtin_bit_cast(int, r1), 8 * e)) + p.router_b[e];
    int e0 = 0; float l0 = lg[0];
#pragma unroll
    for (int e = 1; e < NEXP; ++e) if (lg[e] > l0) { l0 = lg[e]; e0 = e; }
    int e1 = -1; float l1 = -3e38f;
#pragma unroll
    for (int e = 0; e < NEXP; ++e) if (e != e0 && lg[e] > l1) { l1 = lg[e]; e1 = e; }
    e0 = __builtin_amdgcn_readfirstlane(e0); e1 = __builtin_amdgcn_readfirstlane(e1);
    const int r0 = (int)((c0 >> (8 * e0)) & 255ull), r1i = (int)((c1 >> (8 * e1)) & 255ull);
    c0 += 1ull << (8 * e0); c1 += 1ull << (8 * e1);
    if (lane == 0) { const float w0 = 1.f / (1.f + expf(l1 - l0));
        WSP(int, AR_RTE)[t] = e0 | (e1 << 8) | (r0 << 16) | (r1i << 24); float* rw = WSP(float, AR_RTW) + (size_t)t * 2; rw[0] = w0; rw[1] = 1.f - w0; }
}
__device__ __forceinline__ void copy_rows4(const bf16* s0, const bf16* s1, const bf16* s2, const bf16* s3, bf16* d0, bf16* d1, bf16* d2, bf16* d3, int lane) {
    v4u a[4][DM / 512];
#pragma unroll
    for (int j = 0; j < DM / 512; ++j) { a[0][j] = ((const v4u*)s0)[lane + 64 * j]; a[1][j] = ((const v4u*)s1)[lane + 64 * j]; a[2][j] = ((const v4u*)s2)[lane + 64 * j]; a[3][j] = ((const v4u*)s3)[lane + 64 * j]; }
#pragma unroll
    for (int j = 0; j < DM / 512; ++j) { ((v4u*)d0)[lane + 64 * j] = a[0][j]; ((v4u*)d1)[lane + 64 * j] = a[1][j]; ((v4u*)d2)[lane + 64 * j] = a[2][j]; ((v4u*)d3)[lane + 64 * j] = a[3][j]; }
}
__device__ __forceinline__ void copy_row_wave(const bf16* src, bf16* dst, int lane) {
#pragma unroll
    for (int j = 0; j < DM / 512; ++j) ((v4u*)dst)[lane + 64 * j] = ((const v4u*)src)[lane + 64 * j];
}
__device__ __forceinline__ int moe_seg_start(const unsigned* cnt, int e) { int s = 0;
#pragma unroll
    for (int k = 0; k < NEXP; ++k) s += (k < e) ? (int)((cnt[k] + 255u) & ~255u) : 0;
    return s; }

#ifndef STAG_GATE
#define STAG_GATE 700
#endif
__device__ __forceinline__ void stagger_start(int bid, int ticks) {
    const unsigned long long t0 = __builtin_amdgcn_s_memrealtime(), dl = (unsigned long long)(((bid >> 3) & 3) * ticks);
    while (__builtin_amdgcn_s_memrealtime() - t0 < dl) __builtin_amdgcn_s_sleep(16);
}
#ifndef PHMASK
#define PHMASK 0xFFFFFFFFu
#endif
#define PHM(k) (((PHMASK) >> (k)) & 1u)
#ifdef PROBE_LO
constexpr int PR_LO = PROBE_LO, PR_HI = PROBE_HI;
#else
constexpr int PR_LO = -1, PR_HI = -1;
#endif
constexpr int NPH = 16, NPHASES = 1 + 2 * NPH;
struct Args { const float* in[29]; float* out; unsigned char* ws; int ph_lo, ph_hi; };

__device__ __forceinline__ bool in_phase(int k, int lo, int hi) { asm volatile("" : "+s"(lo), "+s"(hi)); return lo <= k && k < hi; }
typedef const Args __attribute__((address_space(4)))* CArgsP;
__device__ __forceinline__ void fill_params_k(P& p, CArgsP a) {
    p.x = a->in[0]; p.mix_norm_g = a->in[1]; p.w_in_first = a->in[2]; p.w_in_rest = a->in[3]; p.mu_first = a->in[4]; p.mu_rest = a->in[5]; p.qk_g = a->in[6]; p.cmp_pos = a->in[7];
    p.cmp_w1 = a->in[8]; p.cmp_w2 = a->in[9]; p.nsa_w_o = a->in[10]; p.conv_w = a->in[11]; p.conv_vec = a->in[12]; p.conv_w_o = a->in[13]; p.rwkv_vec = a->in[14]; p.w_up = a->in[15];
    p.a_up = a->in[16]; p.g_up = a->in[17]; p.vres_up = a->in[18]; p.vres_b = a->in[19]; p.rwkv_w_o = a->in[20]; p.w_out = a->in[21]; p.ffn_norm_g = a->in[22]; p.dense_gu = a->in[23];
    p.dense_down = a->in[24]; p.router_w = a->in[25]; p.router_b = a->in[26]; p.moe_gu = a->in[27]; p.moe_down = a->in[28]; p.out = a->out; p.ws = a->ws;
}
__global__ void __launch_bounds__(NTHREADS, 2) mk_fwd(Args args) {
    extern __shared__ __attribute__((aligned(16))) unsigned char lds_raw[];
    LAS unsigned char* lds = (LAS unsigned char*)lds_raw;
    const int wave0 = __builtin_amdgcn_readfirstlane((int)threadIdx.x >> 6);
    const int tid = wave0 * 64 + lane_id_opaque();
    unsigned* ctl = (unsigned*)(args.ws + WS_CTL);
    for (int u = tid; u < (LDS_BYTES - LDSCTL_OFF) / 4; u += NTHREADS) ((LAS unsigned*)(lds + LDSCTL_OFF))[u] = 0u;
    __syncthreads();
    const int lo = args.ph_lo, hi = args.ph_hi;
    XcdBarrier bar; bar.bar = ctl + CW_BAR; bar.x = 0; bar.st = nullptr;
    if (hi - lo > 1) { bar.x = xb_xcc_id(); bar.st = (volatile LAS unsigned*)(lds + MISC_OFF) + 8; if (tid == 0) (void)xb_add(ctl + CW_BAR + XB_XCNT(bar.x), 1u); }
#define RMS_LOOP(X, GN, ROUTE, C0, C1) do { int m_ = gw; if (m_ < T) { RmsIn ra_, rb_; rms_load(ra_, (X) + (size_t)m_ * DM, lane); \
        for (; m_ < T; m_ += 2 * NGW) { const int m1_ = m_ + NGW, m2_ = m1_ + NGW; rms_load(rb_, (X) + (size_t)(m1_ < T ? m1_ : m_) * DM, lane); \
            rms_row(p, ra_, (GN), WSP(bf16, WS_H) + (size_t)m_ * DM, lane, (ROUTE), m_, C0, C1); \
            if (m1_ < T) { rms_load(ra_, (X) + (size_t)(m2_ < T ? m2_ : m1_) * DM, lane); rms_row(p, rb_, (GN), WSP(bf16, WS_H) + (size_t)m1_ * DM, lane, (ROUTE), m1_, C0, C1); } } } } while (0)
#define RMS_LOOP_R(X, GN, C0, C1, RWR) do { int m_ = gw; if (m_ < T) { RmsIn ra_, rb_; rms_load(ra_, (X) + (size_t)m_ * DM, lane); \
        for (; m_ < T; m_ += 2 * NGW) { const int m1_ = m_ + NGW, m2_ = m1_ + NGW; rms_load(rb_, (X) + (size_t)(m1_ < T ? m1_ : m_) * DM, lane); \
            rms_row_route(p, ra_, (GN), WSP(bf16, WS_H) + (size_t)m_ * DM, lane, m_, C0, C1, RWR); \
            if (m1_ < T) { rms_load(ra_, (X) + (size_t)(m2_ < T ? m2_ : m1_) * DM, lane); rms_row_route(p, rb_, (GN), WSP(bf16, WS_H) + (size_t)m1_ * DM, lane, m1_, C0, C1, RWR); } } } } while (0)
#define IN(k) (in_phase((k), lo, hi) && (PR_LO < 0 || (st == 0 ? (k) <= PR_HI : (st == 1 ? ((k) >= PR_LO && (k) <= PR_HI) : (k) > PR_HI))))
#define MKP unsigned long long cdum0 = 0ull, cdum1 = 0ull; (void)cdum0; (void)cdum1; CArgsP ap_ = (CArgsP)__builtin_amdgcn_kernarg_segment_ptr(); asm volatile("" : "+s"(ap_)); P p; fill_params_k(p, ap_); int w0_ = wave0; asm volatile("" : "+s"(w0_)); int tid = w0_ * 64 + lane_id_opaque(); asm volatile("" : "+v"(tid)); const int lane = tid & 63, wave = __builtin_amdgcn_readfirstlane(tid >> 6); int G = gridDim.x, bid = blockIdx.x; asm volatile("" : "+s"(G), "+s"(bid)); unsigned* ctl = WSP(unsigned, WS_CTL); const long gtid = (long)bid * NTHREADS + tid, NT = (long)G * NTHREADS; const int gw = bid * NWAVES + wave, NGW = G * NWAVES; LAS float* scrw = (LAS float*)(lds + wave * 16384); (void)gtid; (void)NT; (void)gw; (void)NGW; (void)scrw; (void)lane; (void)ctl
#ifdef PROBE_TK
#define TKW(i) do { if (blockIdx.x == PROBE_BLK && threadIdx.x == 0) ((unsigned long long*)(args.ws + WS_CTL + 4 * CW_TK))[(i)] = __builtin_amdgcn_s_memrealtime(); } while (0)
#define TKP(i) do { if (layer == PROBE_LAYER) TKW(i); } while (0)
#define TKB() do { if (layer == PROBE_LAYER && threadIdx.x == 0) ((unsigned long long*)(args.ws + WS_CTL + 4 * CW_TK))[32 + blockIdx.x] = __builtin_amdgcn_s_memrealtime(); } while (0)
#define SEAM(k) do { if ((k) + 1 < hi) { int w_ = wave0; asm volatile("" : "+s"(w_)); xcd_barrier(bar, w_ * 64 + lane_id_opaque()); } \
    if ((k) == PROBE_TK) TKW(1); if ((k) == PROBE_TK - 1) TKW(0); } while (0)
#else
#define TKP(i) do { } while (0)
#define TKB() do { } while (0)
#define SEAM(k) do { if ((k) + 1 < hi) { int w_ = wave0; asm volatile("" : "+s"(w_)); xcd_barrier(bar, w_ * 64 + lane_id_opaque()); } } while (0)
#endif

    for (int st = 0; st < (PR_LO >= 0 ? 3 : 1); ++st) {
    if (PHM(16) && IN(0)) { MKP;
        constexpr int IT_WIN0 = (DM / 64) * ((N_IN_FIRST + 31) / 32), IT_WIN1 = (DM / 64) * ((N_IN_REST + 31) / 32), IT_WO = (512 / 64) * (DM / 32), IT_WOUT = (DM / 64) * (DM / 32);
        constexpr int total = IT_WIN0 + IT_WIN1 + 6 * IT_WO + 2 * IT_WOUT + (DM / 64) * (2 * DENSE_FF / 32) + (DENSE_FF / 64) * (DM / 32);
        bf16* wl0 = WSP(bf16, WS_W); bf16* wl1 = WSP(bf16, WS_W + SZ_LAYERW);
#define WOFF(b, o) ((bf16*)((unsigned char*)(b) + (o)))
        for (int it = gw; it < total; it += NGW) {
            int r = it;
            if (conv_job(r, p.w_in_first, DM, N_IN_FIRST, MapWin{(unsigned char*)wl0, 0}, scrw, lane)) continue;
            if (conv_job(r, p.w_in_rest, DM, N_IN_REST, MapWin{(unsigned char*)wl1, 1}, scrw, lane)) continue;
            if (conv_job(r, p.nsa_w_o, 512, DM, MapPlain{WOFF(wl0, OFF_WO3), 512}, scrw, lane)) continue;
            if (conv_job(r, p.rwkv_w_o, 512, DM, MapPlain{WOFF(wl0, OFF_WO3) + (size_t)DM * 512, 512}, scrw, lane)) continue;
            if (conv_job(r, p.conv_w_o, 512, DM, MapPlain{WOFF(wl0, OFF_WO3) + (size_t)2 * DM * 512, 512}, scrw, lane)) continue;
            if (conv_job(r, p.nsa_w_o + (size_t)512 * DM, 512, DM, MapPlain{WOFF(wl1, OFF_WO3), 512}, scrw, lane)) continue;
            if (conv_job(r, p.rwkv_w_o + (size_t)512 * DM, 512, DM, MapPlain{WOFF(wl1, OFF_WO3) + (size_t)DM * 512, 512}, scrw, lane)) continue;
            if (conv_job(r, p.conv_w_o + (size_t)512 * DM, 512, DM, MapPlain{WOFF(wl1, OFF_WO3) + (size_t)2 * DM * 512, 512}, scrw, lane)) continue;
            if (conv_job(r, p.w_out, DM, DM, MapPlain{WOFF(wl0, OFF_WOUT), DM}, scrw, lane)) continue;
            if (conv_job(r, p.w_out + (size_t)DM * DM, DM, DM, MapPlain{WOFF(wl1, OFF_WOUT), DM}, scrw, lane)) continue;
            if (conv_job(r, p.dense_gu, DM, 2 * DENSE_FF, MapGlu{WSP(bf16, WS_DGU), DM, DENSE_FF}, scrw, lane)) continue;
            conv_job(r, p.dense_down, DENSE_FF, DM, MapPlain{WSP(bf16, WS_DDN), DENSE_FF}, scrw, lane);
        }
        for (int l = 0; l < 2; ++l) {
            unsigned char* wlb = p.ws + WS_W + (size_t)l * SZ_LAYERW;
            bf16* win = (bf16*)(wlb + OFF_WIN);
            for (long i = gtid; i < 512L * DM; i += NT) { const int w = (int)(i / DM); const bool src = w < 288 || (w < 320 && l == 1) || (w >= 320 && w < 344); if (!src) win[(size_t)(3840 + w) * DM + i % DM] = 0; }
            bf16* lw = (bf16*)(wlb + OFF_LW);
            for (long i = gtid; i < 2048L * 384; i += NT) { const int n = (int)(i / 384), k = (int)(i % 384), blk = n >> 9, c = n & 511; float v = 0.f;
                if (blk == 0 && k < 64) v = p.w_up[((size_t)l * 64 + k) * RC + c]; else if (blk == 1 && k >= 64 && k < 128) v = p.a_up[((size_t)l * 64 + k - 64) * RC + c];
                else if (blk == 2 && k >= 128 && k < 288) v = p.g_up[((size_t)l * 160 + k - 128) * RC + c]; else if (blk == 3 && k >= 288 && k < 320 && l == 1) v = p.vres_up[(size_t)(k - 288) * RC + c];
                lw[i] = f2bf(v); }
            bf16* cw1 = (bf16*)(wlb + OFF_CW1);
            for (long i = gtid; i < 2L * 256 * 1024; i += NT) { const int k = (int)(i % 1024), n = (int)((i / 1024) % 256), which = (int)(i / (256 * 1024));
                cw1[i] = f2bf(p.cmp_w1[((size_t)(l * 2 + which) * 2048 + (n < 128 ? k : 1024 + k)) * 128 + (n & 127)]); }
        }
        for (int job = bid; job < 4; job += G) { const int l = job >> 1, which = job & 1;
            const float* pe = p.cmp_pos + (size_t)(l * 2 + which) * 2048; const float* w1 = p.cmp_w1 + (size_t)(l * 2 + which) * 2048 * 128 + 2 * lane;
            float s0 = 0.f, s1 = 0.f;
#pragma unroll 8
            for (int k = wave * 256; k < wave * 256 + 256; ++k) { const float2 wv = *(const float2*)(w1 + (size_t)k * 128); const float pk = pe[k]; s0 += pk * wv.x; s1 += pk * wv.y; }
            scrw[2 * lane] = s0; scrw[2 * lane + 1] = s1;
            __syncthreads();
            if (tid < 128) { float sum = 0.f;
#pragma unroll
                for (int w = 0; w < NWAVES; ++w) sum += ((const LAS float*)(lds + w * 16384))[tid];
                ((float*)(p.ws + WS_W + (size_t)l * SZ_LAYERW + OFF_PEC))[which * 128 + tid] = sum; }
            __syncthreads();
        }
    }

    for (int layer = 0; layer < 2; ++layer) {
        const int pb = 1 + layer * NPH;
        if (PHM(0) && IN(pb + 0)) { MKP;
            const float* xin = layer == 0 ? p.x : p.out;
            RMS_LOOP(xin, p.mix_norm_g + (size_t)layer * DM, false, cdum0, cdum1);
            SEAM(pb + 0);
        }
        if (PHM(1) && IN(pb + 1)) { MKP;
            Gemm g{WSP(bf16, WS_H), (const bf16*)(p.ws + WS_W + (size_t)layer * SZ_LAYERW + OFF_WIN), T, NPROJ, DM}; SOrder S; S.init(T, NPROJ, G, bid);
            EpiProj E{p.ws};
            pg8::gemm_phase<EpiProj, SOrder, true, true>(lds, g, S, E, tid);
            SEAM(pb + 1);
        }
        if (PHM(2) && IN(pb + 2)) { MKP;
            { Gemm g{WSP(bf16, AR_CKV), (const bf16*)(p.ws + WS_W + (size_t)layer * SZ_LAYERW + OFF_CW1), 2 * BATCH * NKV * 512, 512, 1024, 0}; StackOrder S{BATCH * NKV * 512 / 256, 1, 2, G, bid};
              EpiStore E{WSP(bf16, AR_HID), 256, 1};
              pg8::gemm_phase<EpiStore, StackOrder, true, true>(lds, g, S, E, tid); }
            TKP(2); ph_shift(p, layer, gtid, NT); TKP(3); ph_nsa_prep(p, layer, gtid, NT); TKP(4); ph_vtransw(p, gw, NGW, lane); TKP(5);
            ph_convw(p, layer, gw, NGW, lane, tid, lds); TKP(6); TKB();
#ifdef APROBE_CONV
            ph_convw(p, layer, gw, NGW, lane, tid, lds);
#endif
#ifdef APROBE_VT
            ph_vtransw(p, gw, NGW, lane);
#endif
            SEAM(pb + 2); }
        if (PHM(3) && IN(pb + 3)) { MKP;
#ifndef LORA_NAIVE
            { Gemm g{WSP(bf16, WS_LB), (const bf16*)(p.ws + WS_W + (size_t)layer * SZ_LAYERW + OFF_LW), T, 2048, 384, 0}; SOrder S; S.init(T, 2048, G, bid);
              EpiLora E{p.ws};
              pg8::gemm_phase<EpiLora, SOrder, false, true>(lds, g, S, E, tid); }
#else
            { bf16* RW = WSP(bf16, AR_RW); bf16* Wm = WSP(bf16, AR_W); bf16* Am = WSP(bf16, AR_A); bf16* Gm = WSP(bf16, AR_G); const bf16* VF = WSP(bf16, WS_VF);
              const float* vec = p.rwkv_vec + (size_t)layer * 7 * RC; const float* wup = p.w_up + (size_t)layer * 64 * RC; const float* aup = p.a_up + (size_t)layer * 64 * RC; const float* gup = p.g_up + (size_t)layer * 160 * RC;
              for (long it = gtid; it < (long)T * RC; it += NT) { const int t = (int)(it / RC), c = (int)(it % RC); bf16* row = RW + (size_t)t * LDRW; const bf16* L = row + LBLK;
                  float wl = vec[c], alin = vec[RC + c], g = 0.f;
                  for (int j = 0; j < 64; ++j) { wl += bf2f(L[j]) * bf2f(f2bf(wup[j * RC + c])); alin += bf2f(L[64 + j]) * bf2f(f2bf(aup[j * RC + c])); }
                  for (int j = 0; j < 160; ++j) g += bf2f(L[128 + j]) * bf2f(f2bf(gup[j * RC + c]));
                  const float nx = -wl, sp = fmaxf(nx, 0.f) + __logf(1.f + __expf(-fabsf(nx))), e = __expf(-sp - 0.5f);
                  Wm[it] = f2bf(1.f - __expf(-e)); Am[it] = f2bf(fsig(alin)); Gm[it] = f2bf(g);
                  if (layer == 1) { float vl = p.vres_b[c]; for (int j = 0; j < 32; ++j) vl += bf2f(L[288 + j]) * bf2f(f2bf(p.vres_up[j * RC + c]));
                      const float v = bf2f(row[1024 + c]), vf = bf2f(VF[it]); row[1024 + c] = f2bf(v + (vf - v) * fsig(vl)); } } }
#endif
            SEAM(pb + 3); }
        if (PHM(4) && IN(pb + 4)) { MKP; ph_rwkv_b2w(p, layer, gw, NGW, lane); ph_cmp2w(p, layer, gw, NGW, lane, (LAS float*)(lds + wave * 512)); SEAM(pb + 4); }
        if (PHM(5) && IN(pb + 5)) { MKP;
            { LAS unsigned char* wl = lds + wave * AW_BYTES; constexpr int NSC = BATCH * 8 * 16, NIT = BATCH * NKV * (SEQ / 16);
#ifndef SCAN_QUEUE
              if (wave < 4) {
                  if (G * 4 == NSC && (G & 7) == 0) scan_unit(p, (bid & 7) * (NSC / 8) + (bid >> 3) * 4 + wave, lane, wl);
                  else for (int u = bid * 4 + wave; u < NSC; u += G * 4) scan_unit(p, u, lane, wl); }
#endif
#ifdef APROBE_SPLIT
              xcd_barrier(bar, tid);
#endif
              const int xme = (int)(xb_xcc_id() & 7u);
              for (int qq = 0; qq < 8; ++qq) { const int qx = (xme + qq) & 7; unsigned* head = ctl + CW_ATT + ((layer * 3 + st) * 8 + qx) * 16;
                  for (;;) { int it = 0; if (lane == 0) it = (int)atomicAdd(head, 1u); it = __builtin_amdgcn_readfirstlane(it); if (it >= NIT / 8) break;
                      const int bg = 2 * qx + it / (SEQ / 16), t16 = (SEQ / 16 - 1) - it % (SEQ / 16);
                      nsa_attn_item(p, bg * (SEQ / 16) + t16, lane, wl); } } }
 SEAM(pb + 5); }
        if (PHM(6) && IN(pb + 6)) { MKP; ph_rwkv_postw(p, layer, gw, NGW, lane); SEAM(pb + 6); }
        if (PHM(7) && IN(pb + 7)) { MKP;
            Gemm g{WSP(bf16, AR_QB), (const bf16*)(p.ws + WS_W + (size_t)layer * SZ_LAYERW + OFF_WO3), 3 * T, 3 * DM, 512}; StackOrder S{T / 256, DM / 256, 3, G, bid};
            EpiStore E{WSP(bf16, AR_OBUF), DM, DM / 256};
            pg8::gemm_phase<EpiStore, StackOrder, true, true>(lds, g, S, E, tid);
            { MKP; const float* xin = layer == 0 ? p.x : p.out;
              RMS_LOOP(xin, p.mix_norm_g + (size_t)layer * DM, false, cdum0, cdum1); }
            SEAM(pb + 7);
        }
        if (PHM(8) && IN(pb + 8)) { MKP;
            Gemm g{WSP(bf16, WS_H), (const bf16*)(p.ws + WS_W + (size_t)layer * SZ_LAYERW + OFF_WG), T, 3 * DM, DM}; GateOrder S{T / 256, DM / 256, G, bid};
            EpiGate E{p.ws, DM / 256};
            pg8::gemm_phase<EpiGate, GateOrder, true, true>(lds, g, S, E, tid);
            SEAM(pb + 8);
        }
        if (PHM(9) && IN(pb + 9)) { MKP;
            Gemm g{WSP(bf16, AR_MIX), (const bf16*)(p.ws + WS_W + (size_t)layer * SZ_LAYERW + OFF_WOUT), T, DM, DM}; SOrder S; S.init(T, DM, G, bid);
            EpiResid E{layer == 0 ? p.x : p.out, p.out};
            pg8::gemm_phase<EpiResid, SOrder, true, true>(lds, g, S, E, tid);
            SEAM(pb + 9);
        }
        if (PHM(10) && IN(pb + 10)) { MKP;
            unsigned long long c0 = 0ull, c1 = 0ull;
            if (layer == 1) { float rwr[128];
#pragma unroll
                for (int j = 0; j < DM / 256; ++j)
#pragma unroll
                    for (int k = 0; k < 8; ++k) { const f32x4 w4 = *(const f32x4*)(p.router_w + (size_t)(4 * (lane + 64 * j)) * NEXP + 4 * k); rwr[j * 32 + 4 * k] = w4.x; rwr[j * 32 + 4 * k + 1] = w4.y; rwr[j * 32 + 4 * k + 2] = w4.z; rwr[j * 32 + 4 * k + 3] = w4.w; }
                RMS_LOOP_R(p.out, p.ffn_norm_g + (size_t)layer * DM, c0, c1, rwr);
            } else RMS_LOOP(p.out, p.ffn_norm_g + (size_t)layer * DM, false, c0, c1);
            if (layer == 1 && lane < 16) {
                const unsigned cn = (unsigned)(((lane < 8 ? c0 : c1) >> (8 * (lane & 7))) & 255ull);
                WSP(unsigned, AR_WBASE)[(size_t)gw * 16 + lane] = atomicAdd(ctl + CW_CNT + lane * 64, cn); }
            if (layer == 1) { int* rt = WSP(int, AR_RTOK); for (long i = gtid; i < 2L * MOE_ROWS; i += NT) rt[i] = -1; }
            SEAM(pb + 10);
        }
        if (layer == 0) {
            if (PHM(11) && IN(pb + 11)) { MKP;
                Gemm g{WSP(bf16, WS_H), WSP(bf16, WS_DGU), T, 2 * DENSE_FF, DM}; SOrder S; S.init(T, 2 * DENSE_FF, G, bid);
                EpiSwiglu E{WSP(bf16, AR_ACT), DENSE_FF, 2 * DENSE_FF / 256};
                pg8::gemm_phase<EpiSwiglu, SOrder, true, true>(lds, g, S, E, tid);
                SEAM(pb + 11);
            }
            if (PHM(12) && IN(pb + 12)) { MKP;
                Gemm g{WSP(bf16, AR_ACT), WSP(bf16, WS_DDN), T, DM, DENSE_FF}; SOrder S; S.init(T, DM, G, bid);
                EpiResid E{p.out, p.out};
                pg8::gemm_phase<EpiResid, SOrder, true, true>(lds, g, S, E, tid);
                SEAM(pb + 12);
            }
        } else {
            if (PHM(11) && IN(pb + 11)) { MKP;
                const int ig = (DM / 64) * (2 * EXPERT_FF / 32), id = (EXPERT_FF / 64) * (DM / 32);
                for (int it = gw; it < NEXP * (ig + id); it += NGW) { const int e = it / (ig + id); int r = it % (ig + id);
                    if (conv_job(r, p.moe_gu + (size_t)e * DM * 2 * EXPERT_FF, DM, 2 * EXPERT_FF, MapGlu{WSP(bf16, AR_MGU) + (size_t)e * 2 * EXPERT_FF * DM, DM, EXPERT_FF}, scrw, lane)) continue;
                    conv_job(r, p.moe_down + (size_t)e * EXPERT_FF * DM, EXPERT_FF, DM, MapPlain{WSP(bf16, AR_MDN) + (size_t)e * DM * EXPERT_FF, EXPERT_FF}, scrw, lane); }
                int* rtok = WSP(int, AR_RTOK); float* rww = WSP(float, AR_RW8); int* trow = WSP(int, AR_TROW);
                int segv = 0; { const int pc = lane < 16 ? (int)((ctl[CW_CNT + lane * 64] + 255u) & ~255u) : 0;
#pragma unroll
                    for (int k = 0; k < 8; ++k) { const int ck = bperm_i(pc, (lane & 8) + k); segv += (k < (lane & 7)) ? ck : 0; } }
                for (int hb = gw; hb < 2 * (T / 64); hb += NGW) {
                    const int tb = (hb >> 1) * 64, half = hb & 1, t = tb + lane; const int ee = WSP(int, AR_RTE)[t], e0 = ee & 255, e1 = (ee >> 8) & 255, r0 = (ee >> 16) & 255, r1 = (ee >> 24) & 255;
                    const float* w = WSP(float, AR_RTW) + (size_t)t * 2; const unsigned* wb = WSP(unsigned, AR_WBASE) + (size_t)(t % NGW) * 16;
                    const int row0 = bperm_i(segv, e0) + (int)wb[e0] + r0, row1 = bperm_i(segv, 8 + e1) + (int)wb[8 + e1] + r1;
                    if (half == 0) { rtok[row0] = t; rww[row0] = w[0]; rtok[MOE_ROWS + row1] = t; rww[MOE_ROWS + row1] = w[1]; trow[T + t] = row1; }
                    for (int l = 32 * half; l < 32 * half + 32; l += 4) { const bf16* hs = WSP(bf16, WS_H) + (size_t)(tb + l) * DM; bf16* xg = WSP(bf16, AR_XG);
                        copy_rows4(hs, hs + DM, hs + 2 * DM, hs + 3 * DM, xg + (size_t)__builtin_amdgcn_readlane(row0, l) * DM, xg + (size_t)__builtin_amdgcn_readlane(row0, l + 1) * DM, xg + (size_t)__builtin_amdgcn_readlane(row0, l + 2) * DM, xg + (size_t)__builtin_amdgcn_readlane(row0, l + 3) * DM, lane); }
                }
                SEAM(pb + 11);
            }
#pragma unroll
            for (int pass = 0; pass < 2; ++pass) {
                if (PHM(12) && IN(pb + 12 + 2 * pass)) { MKP;
                    Gemm g{WSP(bf16, AR_XG), WSP(bf16, AR_MGU), MOE_ROWS, NEXP * 2 * EXPERT_FF, DM}; MoeOrder S; S.init(ctl + CW_CNT + 8 * 64 * pass, 2 * EXPERT_FF / 256, G, bid);
                    EpiSwiglu E{WSP(bf16, AR_MACT), EXPERT_FF, 2 * EXPERT_FF / 256};
                    if (pass == 1) {
                        MoeOrder S0; S0.init(ctl + CW_CNT, DM / 256, G, bid); const int nwg = S0.s.nwg, mainw = (nwg / G) * G, ttiles = nwg - mainw;
                        if (bar.st != nullptr && (G & 31) == 0 && mainw > 0 && ttiles > 0 && ttiles <= 32) {
                            EpiMoeDown E0{p.out, WSP(int, AR_RTOK), WSP(float, AR_RW8), DM / 256, (PR_LO >= 0 && st == 0 && pb + 14 >= PR_LO && pb + 14 <= PR_HI) ? 0.f : 1.f};
                            for (int job = wave * G + bid; job < ttiles * 32; job += NWAVES * G) moe_tail_combine(E0, S0, WSP(float, WS_PART), mainw / (DM / 256), job, lane); } }
                    pg8::gemm_phase<EpiSwiglu, MoeOrder, true, true>(lds, g, S, E, tid);
                    SEAM(pb + 12 + 2 * pass);
                }
                if (PHM(13) && IN(pb + 13 + 2 * pass)) { MKP;
                    Gemm g{WSP(bf16, AR_MACT), WSP(bf16, AR_MDN), MOE_ROWS, NEXP * DM, EXPERT_FF}; MoeOrder S; S.init(ctl + CW_CNT + 8 * 64 * pass, DM / 256, G, bid);
                    EpiMoeDown E{p.out, WSP(int, AR_RTOK) + (size_t)pass * MOE_ROWS, WSP(float, AR_RW8) + (size_t)pass * MOE_ROWS, DM / 256, (PR_LO >= 0 && st == 0 && pb + 13 + 2 * pass >= PR_LO && pb + 13 + 2 * pass <= PR_HI) ? 0.f : 1.f};
                    if (pass == 0) { const int* trow = WSP(int, AR_TROW);
                        for (int t = gw * 4; t < T; t += NGW * 4) { const bf16* hs = WSP(bf16, WS_H) + (size_t)t * DM; bf16* xg = WSP(bf16, AR_XG);
                            copy_rows4(hs, hs + DM, hs + 2 * DM, hs + 3 * DM, xg + (size_t)trow[T + t] * DM, xg + (size_t)trow[T + t + 1] * DM, xg + (size_t)trow[T + t + 2] * DM, xg + (size_t)trow[T + t + 3] * DM, lane); } }
                    const int nwg = S.s.nwg, mainw = (nwg / G) * G, ttiles = nwg - mainw; const bool split = bar.st != nullptr && (G & 31) == 0 && mainw > 0 && ttiles > 0 && ttiles <= 32;
                    if (split) S.s.nwg = mainw;
                    pg8::gemm_phase<EpiMoeDown, MoeOrder, true, true>(lds, g, S, E, tid);
                    if (split) { Gemm g2{WSP(bf16, AR_MACT), WSP(bf16, AR_MDN), MOE_ROWS, NEXP * DM, MT_K, EXPERT_FF, EXPERT_FF}; MoeTailOrder S2; S2.init(S, mainw / (DM / 256), ttiles, G, bid);
                        EpiPart E2{WSP(float, WS_PART), mainw / (DM / 256), DM / 256};
                        pg8::gemm_phase<EpiPart, MoeTailOrder, true, true, true>(lds, g2, S2, E2, tid); }
                    if (pass == 1 && split) { { int w_ = wave0; asm volatile("" : "+s"(w_)); xcd_barrier(bar, w_ * 64 + lane_id_opaque()); }
                        for (int job = wave * G + bid; job < ttiles * 32; job += NWAVES * G) moe_tail_combine(E, S, WSP(float, WS_PART), mainw / (DM / 256), job, lane); }
                    SEAM(pb + 13 + 2 * pass);
                }
            }
        }
    }
    }
#ifdef PROBE_TK
    { int w_ = wave0; asm volatile("" : "+s"(w_)); xcd_barrier(bar, w_ * 64 + lane_id_opaque()); }
    if (blockIdx.x == 0 && threadIdx.x == 0) { const unsigned long long* tk = (const unsigned long long*)(args.ws + WS_CTL + 4 * CW_TK); __builtin_amdgcn_fence(__ATOMIC_SEQ_CST, "agent");
#ifndef PROBE_STAT
        args.out[0] += floorf((float)(long long)(tk[PROBE_A1] - tk[PROBE_A0]) * 0.01f / (float)(PROBE_TU)); }
#else
        long long mx = 0, mn = 1ll << 60; for (int b = 0; b < (int)gridDim.x; ++b) { const long long d = (long long)(tk[32 + b] - tk[0]); mx = d > mx ? d : mx; mn = d < mn ? d : mn; }
        int cnt = 0; for (int b = 0; b < (int)gridDim.x; ++b) { const long long d = (long long)(tk[32 + b] - tk[0]); cnt += (mx - d) <= 100ll * PROBE_WIN ? 1 : 0; }
        args.out[0] += PROBE_STAT == 1 ? floorf((float)mx * 0.01f / (float)(PROBE_TU)) : (PROBE_STAT == 2 ? (float)cnt : floorf((float)mn * 0.01f / (float)(PROBE_TU))); }
#endif
#endif
#undef IN
#undef SEAM
}

#ifndef MK_ONE_LAUNCH
#define MK_ONE_LAUNCH 1
#endif
extern "C" void kernel_launch(void* const* d_in, const int* in_sizes, int n_in, void* d_out, int out_size, void* d_ws, size_t ws_size, hipStream_t stream) {
    static int grid = 0;
    if (grid == 0) {
        if (n_in != 29 || in_sizes[0] != T * DM || out_size != T * DM || ws_size < WS_END) { fprintf(stderr, "kernel_launch: unexpected shapes / workspace (%d inputs, ws %zu, need %zu)\n", n_in, ws_size, (size_t)WS_END); grid = -1; return; }
        int dev = 0, cus = 0;
        if (hipGetDevice(&dev) != hipSuccess || hipDeviceGetAttribute(&cus, hipDeviceAttributeMultiprocessorCount, dev) != hipSuccess) { grid = -1; return; }
        if (hipFuncSetAttribute((const void*)mk_fwd, hipFuncAttributeMaxDynamicSharedMemorySize, LDS_BYTES) != hipSuccess) { fprintf(stderr, "kernel_launch: hipFuncSetAttribute failed\n"); grid = -1; return; }
        int per_cu = 0;
        if (hipOccupancyMaxActiveBlocksPerMultiprocessor(&per_cu, (const void*)mk_fwd, NTHREADS, LDS_BYTES) != hipSuccess || per_cu < 1) { fprintf(stderr, "kernel_launch: occupancy query says %d\n", per_cu); }
        (void)hipGetLastError();
        grid = cus;
    }
    if (grid < 0) return;
    if (hipMemsetAsync((char*)d_ws + WS_CTL, 0, CTL_BYTES, stream) != hipSuccess) return;
    Args a{};
    for (int i = 0; i < 29; ++i) a.in[i] = (const float*)d_in[i];
    a.out = (float*)d_out; a.ws = (unsigned char*)d_ws;
#if MK_ONE_LAUNCH
    a.ph_lo = 0; a.ph_hi = NPHASES;
    hipLaunchKernelGGL(mk_fwd, dim3(grid), dim3(NTHREADS), LDS_BYTES, stream, a);
#else
    for (int k = 0; k < NPHASES; ++k) {
        if (k >= 1 + 13 && k < 1 + NPH) continue;
        a.ph_lo = k; a.ph_hi = k + 1;
        hipLaunchKernelGGL(mk_fwd, dim3(grid), dim3(NTHREADS), LDS_BYTES, stream, a);
    }
#endif
}
```

```cpp
#include <hip/hip_runtime.h>
#include <cstdio>
#include <cstdint>
#include <cmath>
#include <cstring>
#ifdef HOST_EMU
#define HD
#define DEV_INLINE inline
#else
#define HD __host__ __device__
#define DEV_INLINE __device__ __forceinline__
#endif

typedef unsigned short bf16;
struct alignas(16) U4 { unsigned x, y, z, w; };

#ifdef SMALL_CFG
constexpr int BATCH = 1, SEQ = 1024, DM = 128, DENSE_FF = 256, EXPERT_FF = 256;
#else
constexpr int BATCH = 8, SEQ = 8192, DM = 1024, DENSE_FF = 2816, EXPERT_FF = 3584;
#endif
constexpr int T = BATCH * SEQ;
constexpr int NHEAD = 8, NKV = 2, HG = 4, DH = 64;
constexpr int NC = SEQ / 16 - 1, NS = SEQ / 64, NSEL = 8, WINDOW = 512;
constexpr int CONV_CH = 512, CONV_K = 31, RC = 512;
constexpr int NEXP = 8;
constexpr int NSA_IN = 1304, OFF_CONV = 1304, OFF_GATE = 2328, OFF_RWKV = OFF_GATE + 3 * DM;
constexpr int N_IN_FIRST = OFF_RWKV + 1824, N_IN_REST = OFF_RWKV + 1856;
constexpr int NPROJ = 4352;
constexpr int LDQ = 512, LDKV = 512, LDRW = 2048, LBLK = 1536;
constexpr int MOE_ROWS = T + NEXP * 256;
constexpr float RMS_EPS = 1e-6f, LN_EPS = 1e-5f, GN_EPS = 64e-5f;

constexpr size_t al(size_t x) { return (x + 255) & ~(size_t)255; }
constexpr size_t WS_CTL = 0, CTL_BYTES = 1u << 20;
constexpr size_t SZ_WIN = (size_t)NPROJ * DM * 2, SZ_WG = (size_t)3 * DM * DM * 2, SZ_WO3 = (size_t)3 * DM * 512 * 2, SZ_WOUT = (size_t)DM * DM * 2;
constexpr size_t SZ_LW = (size_t)2048 * 384 * 2, SZ_CW1 = (size_t)2 * 256 * 1024 * 2, SZ_PEC = 1024;
constexpr size_t SZ_LAYERW = SZ_WIN + SZ_WG + SZ_WO3 + SZ_WOUT + SZ_LW + SZ_CW1 + SZ_PEC;
constexpr size_t WS_W = CTL_BYTES;
constexpr size_t OFF_WIN = 0, OFF_WG = SZ_WIN, OFF_WO3 = OFF_WG + SZ_WG, OFF_WOUT = OFF_WO3 + SZ_WO3, OFF_LW = OFF_WOUT + SZ_WOUT, OFF_CW1 = OFF_LW + SZ_LW, OFF_PEC = OFF_CW1 + SZ_CW1;
constexpr size_t WS_DGU = WS_W + 2 * SZ_LAYERW, SZ_DGU = (size_t)2 * DENSE_FF * DM * 2;
constexpr size_t WS_DDN = WS_DGU + SZ_DGU, SZ_DDN = (size_t)DM * DENSE_FF * 2;
constexpr size_t WS_VF = al(WS_DDN + SZ_DDN), SZ_TC = (size_t)T * 512 * 2;
constexpr size_t WS_H = WS_VF + SZ_TC, SZ_H = (size_t)T * DM * 2;
constexpr size_t WS_PART = WS_VF;
static_assert((size_t)32 * 7 * 65536 * 4 <= SZ_TC, "WS_PART");
constexpr size_t WS_AR = al(WS_H + SZ_H);
constexpr size_t AR_QB = WS_AR, AR_A = AR_QB + SZ_TC, AR_CO = AR_A + SZ_TC;
constexpr size_t AR_KV = AR_CO + SZ_TC, SZ_KV = (size_t)T * LDKV * 2;
constexpr size_t AR_RW = AR_KV + SZ_KV, SZ_RW = (size_t)T * LDRW * 2;
constexpr size_t AR_W = AR_RW + SZ_RW, AR_G = AR_W + SZ_TC, AR_UB = AR_G + SZ_TC;
constexpr size_t AR_NG = AR_UB + SZ_TC, SZ_NG = (size_t)T * 24 * 4;
constexpr size_t AR_HALO = al(AR_NG + SZ_NG), SZ_HALO = (size_t)(T / 256) * LDRW * 2;
constexpr size_t AR_KC = al(AR_HALO + SZ_HALO), SZ_CMP = (size_t)BATCH * NKV * (SEQ / 16) * 64 * 2;
constexpr size_t AR_VC = AR_KC + SZ_CMP;
constexpr size_t AR_HID = al(AR_VC + SZ_CMP), SZ_HID = (size_t)BATCH * NKV * (SEQ / 16) * 2 * 128 * 4;
constexpr size_t AR_SEL = al(AR_HID + SZ_HID), SZ_SEL = (size_t)T * NKV * 8 * 4;
constexpr size_t AR_INVN = al(AR_SEL + SZ_SEL), SZ_INVN = (size_t)T * 8 * 4;
constexpr size_t AR_VCT = al(AR_INVN + SZ_INVN);
constexpr size_t AR_CKV = al(AR_VCT + SZ_CMP), SZ_CKV = (size_t)2 * T * 128;
constexpr size_t AR_END1 = al(AR_CKV + SZ_CKV * 2);
constexpr size_t WS_VST = WS_H, WS_VWT = WS_H + (size_t)T * 128 * 2, WS_LB = WS_VWT + (size_t)T * 128 * 2, WS_KS8 = WS_LB + (size_t)T * 384 * 2, WS_KW8 = WS_KS8 + (size_t)T * 128 * 2;
constexpr size_t AR_OBUF = AR_KV, SZ_OBUF = (size_t)3 * T * DM * 2;
constexpr size_t AR_MIX = AR_OBUF + SZ_OBUF, SZ_MIX = (size_t)T * DM * 2;
constexpr size_t AR_END2 = AR_MIX + SZ_MIX;
constexpr size_t AR_ACT = WS_AR;
constexpr size_t AR_MGU = WS_AR, SZ_MGU = (size_t)NEXP * 2 * EXPERT_FF * DM * 2;
constexpr size_t AR_MDN = AR_MGU + SZ_MGU, SZ_MDN = (size_t)NEXP * DM * EXPERT_FF * 2;
constexpr size_t AR_XG = al(AR_MDN + SZ_MDN), SZ_XG = (size_t)MOE_ROWS * DM * 2;
constexpr size_t AR_MACT = al(AR_XG + SZ_XG), SZ_MACT = (size_t)MOE_ROWS * EXPERT_FF * 2;
constexpr size_t AR_RTOK = al(AR_MACT + SZ_MACT), SZ_RTOK = (size_t)2 * MOE_ROWS * 4;
constexpr size_t AR_RW8 = al(AR_RTOK + SZ_RTOK);
constexpr size_t AR_TROW = al(AR_RW8 + SZ_RTOK), SZ_TROW = (size_t)2 * T * 4;
constexpr size_t AR_RTE = al(AR_TROW + SZ_TROW);
constexpr size_t AR_RTW = al(AR_RTE + (size_t)T * 4);
constexpr size_t AR_WBASE = al(AR_RTW + (size_t)T * 8);
constexpr size_t AR_END3 = al(AR_WBASE + (size_t)4096 * 16 * 4);
constexpr size_t WS_END = (AR_END1 > AR_END2 ? (AR_END1 > AR_END3 ? AR_END1 : AR_END3) : (AR_END2 > AR_END3 ? AR_END2 : AR_END3));
constexpr int CW_CNT = 1024;
constexpr int CW_ATT = 256;
constexpr int CW_BAR = 4096, CW_TK = 8192, CW_CONV = 8256;

struct P {
    const float *x, *mix_norm_g, *w_in_first, *w_in_rest, *mu_first, *mu_rest, *qk_g, *cmp_pos, *cmp_w1, *cmp_w2, *nsa_w_o, *conv_w, *conv_vec, *conv_w_o,
        *rwkv_vec, *w_up, *a_up, *g_up, *vres_up, *vres_b, *rwkv_w_o, *w_out, *ffn_norm_g, *dense_gu, *dense_down, *router_w, *router_b, *moe_gu, *moe_down;
    float* out; unsigned char* ws;
};
HD inline void fill_params(P& p, const float* const* in, float* out, unsigned char* ws) {
    p.x = in[0]; p.mix_norm_g = in[1]; p.w_in_first = in[2]; p.w_in_rest = in[3]; p.mu_first = in[4]; p.mu_rest = in[5]; p.qk_g = in[6]; p.cmp_pos = in[7];
    p.cmp_w1 = in[8]; p.cmp_w2 = in[9]; p.nsa_w_o = in[10]; p.conv_w = in[11]; p.conv_vec = in[12]; p.conv_w_o = in[13]; p.rwkv_vec = in[14]; p.w_up = in[15];
    p.a_up = in[16]; p.g_up = in[17]; p.vres_up = in[18]; p.vres_b = in[19]; p.rwkv_w_o = in[20]; p.w_out = in[21]; p.ffn_norm_g = in[22]; p.dense_gu = in[23];
    p.dense_down = in[24]; p.router_w = in[25]; p.router_b = in[26]; p.moe_gu = in[27]; p.moe_down = in[28]; p.out = out; p.ws = ws;
}
#define WSP(type, off) ((type*)(p.ws + (off)))

#ifdef HOST_EMU
#define FENCE()
#else
#define FENCE() asm volatile("" ::: "memory")
#endif
HD inline float bf2f(bf16 v) { unsigned u = (unsigned)v << 16; float f; memcpy(&f, &u, 4); return f; }
HD inline bf16 f2bf(float f) { unsigned u; memcpy(&u, &f, 4); return (bf16)((u + 0x7fffu + ((u >> 16) & 1u)) >> 16); }
HD inline float blo(unsigned v) { unsigned u = v << 16; float f; memcpy(&f, &u, 4); return f; }
HD inline float bhi(unsigned v) { unsigned u = v & 0xffff0000u; float f; memcpy(&f, &u, 4); return f; }
#if !defined(SCAN_BF16) && !defined(RKV_BF16)
HD inline bf16 f2h(float f) { return __builtin_bit_cast(unsigned short, (_Float16)f); }
#else
HD inline bf16 f2bf(float f);
HD inline bf16 f2h(float f) { return f2bf(f); }
#endif
HD inline float h2f(bf16 v) { return (float)__builtin_bit_cast(_Float16, v); }
HD inline float sigmoidf_(float x) { return 1.f / (1.f + expf(-x)); }
HD inline float dot64(const float* q, const bf16* kp) {
    const U4* k4 = (const U4*)kp; float s0 = 0.f, s1 = 0.f;
#pragma unroll
    for (int i = 0; i < 8; ++i) { const U4 v = k4[i];
        s0 += q[8 * i + 0] * blo(v.x) + q[8 * i + 2] * blo(v.y) + q[8 * i + 4] * blo(v.z) + q[8 * i + 6] * blo(v.w);
        s1 += q[8 * i + 1] * bhi(v.x) + q[8 * i + 3] * bhi(v.y) + q[8 * i + 5] * bhi(v.z) + q[8 * i + 7] * bhi(v.w); }
    return s0 + s1;
}
HD inline float dot64p(const U4* q, const bf16* kp) {
    const U4* k4 = (const U4*)kp; float s0 = 0.f, s1 = 0.f;
#pragma unroll
    for (int i = 0; i < 8; ++i) { const U4 v = k4[i], w = q[i];
        s0 += blo(w.x) * blo(v.x) + blo(w.y) * blo(v.y) + blo(w.z) * blo(v.z) + blo(w.w) * blo(v.w);
        s1 += bhi(w.x) * bhi(v.x) + bhi(w.y) * bhi(v.y) + bhi(w.z) * bhi(v.z) + bhi(w.w) * bhi(v.w); }
    return s0 + s1;
}
HD inline void ld64(const bf16* kp, float* q) {
    const U4* k4 = (const U4*)kp;
#pragma unroll
    for (int i = 0; i < 8; ++i) { const U4 v = k4[i]; q[8 * i] = blo(v.x); q[8 * i + 1] = bhi(v.x); q[8 * i + 2] = blo(v.y); q[8 * i + 3] = bhi(v.y);
        q[8 * i + 4] = blo(v.z); q[8 * i + 5] = bhi(v.z); q[8 * i + 6] = blo(v.w); q[8 * i + 7] = bhi(v.w); }
}
HD inline void axpy64(float* o, float w, const bf16* vp) {
    const U4* k4 = (const U4*)vp;
#pragma unroll
    for (int i = 0; i < 8; ++i) { const U4 v = k4[i]; o[8 * i] += w * blo(v.x); o[8 * i + 1] += w * bhi(v.x); o[8 * i + 2] += w * blo(v.y); o[8 * i + 3] += w * bhi(v.y);
        o[8 * i + 4] += w * blo(v.z); o[8 * i + 5] += w * bhi(v.z); o[8 * i + 6] += w * blo(v.w); o[8 * i + 7] += w * bhi(v.w); }
}
HD inline void axpy64s(float* o, float w, const bf16* vp) {
    const U4* k4 = (const U4*)vp;
#pragma unroll
    for (int i = 0; i < 8; ++i) { const U4 v = k4[i]; o[8 * i] = w * o[8 * i] + blo(v.x); o[8 * i + 1] = w * o[8 * i + 1] + bhi(v.x); o[8 * i + 2] = w * o[8 * i + 2] + blo(v.y); o[8 * i + 3] = w * o[8 * i + 3] + bhi(v.y);
        o[8 * i + 4] = w * o[8 * i + 4] + blo(v.z); o[8 * i + 5] = w * o[8 * i + 5] + bhi(v.z); o[8 * i + 6] = w * o[8 * i + 6] + blo(v.w); o[8 * i + 7] = w * o[8 * i + 7] + bhi(v.w); }
}
HD inline void st64(bf16* op, const float* o) {
    U4* o4 = (U4*)op;
#pragma unroll
    for (int i = 0; i < 8; ++i) { U4 v; v.x = (unsigned)f2bf(o[8 * i]) | ((unsigned)f2bf(o[8 * i + 1]) << 16); v.y = (unsigned)f2bf(o[8 * i + 2]) | ((unsigned)f2bf(o[8 * i + 3]) << 16);
        v.z = (unsigned)f2bf(o[8 * i + 4]) | ((unsigned)f2bf(o[8 * i + 5]) << 16); v.w = (unsigned)f2bf(o[8 * i + 6]) | ((unsigned)f2bf(o[8 * i + 7]) << 16); o4[i] = v; }
}

HD inline void rope_cs(int pos, int i, float& cs, float& sn) {
    const float c = exp2f(-(float)i * 0.41524101186092f) * 0.15915494309189535f, pf = (float)pos;
    const float prod = pf * c, err = fmaf(pf, c, -prod), fr = (prod - rintf(prod)) + err;
#ifdef HOST_EMU
    cs = cosf(6.283185307179586f * fr); sn = sinf(6.283185307179586f * fr);
#else
    cs = __builtin_amdgcn_cosf(fr); sn = __builtin_amdgcn_sinf(fr);
#endif
}
HD inline int win_dest(int j, int layer, int& which) {
    which = 0;
    if (j < 1280) return j;
    if (j < 1304) return 3840 + 320 + (j - 1280);
    if (j < 1816) { const int cc = j - 1304; return 1280 + 256 * (cc / 128) + cc % 128; }
    if (j < 2328) { const int cc = j - 1816; return 1280 + 256 * (cc / 128) + 128 + cc % 128; }
    if (j < OFF_RWKV) { which = 1; const int gg = j - OFF_GATE, br = gg / DM; return (br == 0 ? 0 : (br == 1 ? 2 * DM : DM)) + gg % DM; }
    const int rr = j - OFF_RWKV;
    if (rr < 1536) return 2304 + rr;
    if (rr < 1824) return 3840 + (rr - 1536);
    if (rr < 1856 && layer == 1) return 3840 + 288 + (rr - 1824);
    return -1;
}
HD inline int glu_dest(int j, int ff) { return j < ff ? 256 * (j / 128) + j % 128 : 256 * ((j - ff) / 128) + 128 + (j - ff) % 128; }

DEV_INLINE void ph_shift(const P& p, int layer, long gtid, long NT) {
    bf16* RW = WSP(bf16, AR_RW); const bf16* HALO = WSP(bf16, AR_HALO); bf16* VF = WSP(bf16, WS_VF); bf16* LB = WSP(bf16, WS_LB);
    const float* mu = layer == 0 ? p.mu_first : p.mu_rest;
    constexpr int NCP = (LBLK + 384) / 2;
    const long n = (long)(T / 256) * NCP;
    for (long it = gtid; it < n; it += NT) {
        const int pm = (int)(it / NCP), c = 2 * (int)(it % NCP);
        int mi = -1, act = 0;
        if (c < LBLK) mi = c;
        else { const int w = c - LBLK; if (w < 288) { mi = 1536 + w; act = w < 64 ? 1 : (w >= 128 ? 2 : 0); } else if (w < 320 && layer == 1) mi = 1824 + (w - 288); }
        if (mi < 0) { for (int r = 0; r < 256; ++r) *(unsigned*)(LB + ((size_t)pm * 256 + r) * 384 + (c - LBLK)) = 0u; continue; }
        const float m0 = mu[mi], m1 = mu[mi + 1];
        float prev0 = 0.f, prev1 = 0.f;
        if ((pm * 256) % SEQ != 0) { const unsigned hv = *(const unsigned*)(HALO + (size_t)(pm - 1) * LDRW + c); prev0 = blo(hv); prev1 = bhi(hv); }
        bf16* col = RW + (size_t)pm * 256 * LDRW + c;
        for (int r0 = 0; r0 < 256; r0 += 16) {
            unsigned pv[16];
#pragma unroll
            for (int k = 0; k < 16; ++k) pv[k] = *(const unsigned*)(col + (size_t)(r0 + k) * LDRW);
#pragma unroll
            for (int k = 0; k < 16; ++k) { const int r = r0 + k; const float p0 = blo(pv[k]), p1 = bhi(pv[k]);
                float u0 = p0 + (prev0 - p0) * m0, u1 = p1 + (prev1 - p1) * m1; prev0 = p0; prev1 = p1;
                if (act == 1) { u0 = tanhf(u0); u1 = tanhf(u1); } else if (act == 2) { u0 = sigmoidf_(u0); u1 = sigmoidf_(u1); }
                if (c < LBLK) { const unsigned hv = (unsigned)f2h(u0) | ((unsigned)f2h(u1) << 16); *(unsigned*)(col + (size_t)r * LDRW) = hv;
                    if (layer == 0 && c >= 1024) *(unsigned*)(VF + ((size_t)pm * 256 + r) * RC + (c - 1024)) = hv; }
                else *(unsigned*)(LB + ((size_t)pm * 256 + r) * 384 + (c - LBLK)) = (unsigned)f2bf(u0) | ((unsigned)f2bf(u1) << 16); }
        }
    }
}

DEV_INLINE void ph_nsa_prep(const P& p, int layer, long gtid, long NT) {
    bf16* QB = WSP(bf16, AR_QB); bf16* KV = WSP(bf16, AR_KV);
    const long n = (long)T * 12;
    for (long it = gtid; it < n; it += NT) {
        const int t = (int)(it / 12), s = (int)(it % 12), pos = t % SEQ;
        bf16* ptr; const float* g;
        if (s < 8) { ptr = QB + (size_t)t * LDQ + s * 64; g = p.qk_g + (layer * 4 + 0) * 64; }
        else if (s < 10) { ptr = KV + (size_t)t * LDKV + (s - 8) * 64; g = p.qk_g + (layer * 4 + 2) * 64; }
        else { ptr = KV + (size_t)t * LDKV + 256 + (s - 10) * 64; g = p.qk_g + (layer * 4 + 3) * 64; }
        float v[64]; ld64(ptr, v);
        float ss = 0.f;
#pragma unroll
        for (int i = 0; i < 64; ++i) ss += v[i] * v[i];
        const float rs = 1.f / sqrtf(ss * (1.f / 64.f) + RMS_EPS);
#pragma unroll
        for (int i = 0; i < 64; ++i) v[i] = v[i] * rs * g[i];
#pragma unroll
        for (int i = 0; i < 32; ++i) {
            float cs, sn; rope_cs(pos, i, cs, sn);
            const float x1 = v[i], x2 = v[i + 32]; v[i] = x1 * cs - x2 * sn; v[i + 32] = x2 * cs + x1 * sn;
        }
        if (s < 8) {
#pragma unroll
            for (int i = 0; i < 64; ++i) v[i] *= 0.125f * 1.4426950408889634f; }
        if (s < 8) st64(ptr, v);
        else {
            const int gg = (s - 8) & 1, bq = t / SEQ; bf16* k8 = WSP(bf16, s < 10 ? WS_KS8 : WS_KW8) + (size_t)(bq * NKV + gg) * 8 * SEQ * 8;
#pragma unroll
            for (int dg = 0; dg < 8; ++dg) { U4 w; w.x = (unsigned)f2bf(v[8 * dg]) | ((unsigned)f2bf(v[8 * dg + 1]) << 16); w.y = (unsigned)f2bf(v[8 * dg + 2]) | ((unsigned)f2bf(v[8 * dg + 3]) << 16);
                w.z = (unsigned)f2bf(v[8 * dg + 4]) | ((unsigned)f2bf(v[8 * dg + 5]) << 16); w.w = (unsigned)f2bf(v[8 * dg + 6]) | ((unsigned)f2bf(v[8 * dg + 7]) << 16);
                *(U4*)(k8 + ((size_t)dg * SEQ + pos) * 8) = w; } }
    }
}

DEV_INLINE void ph_vtrans(const P& p, long gtid, long NT) {
    const bf16* KV = WSP(bf16, AR_KV); bf16* VsT = WSP(bf16, WS_VST); bf16* VwT = WSP(bf16, WS_VWT);
    const long n = (long)BATCH * NKV * (SEQ / 8) * 64;
    for (long it = gtid; it < n; it += NT) {
        const int d = (int)(it % 64); long r = it / 64; const int kg = (int)(r % (SEQ / 8)); const int bg = (int)(r / (SEQ / 8)), b = bg / NKV, g = bg % NKV;
        const int kbase = (kg >> 2) * 32 + 4 * (kg & 3);
        const bf16* src = KV + (size_t)(b * SEQ + kbase) * LDKV + g * 64 + d;
        U4 s, w; unsigned short sv[8], wv[8];
#pragma unroll
        for (int j = 0; j < 8; ++j) { const size_t ro = (size_t)((j & 3) + 16 * (j >> 2)) * LDKV; sv[j] = src[ro + 128]; wv[j] = src[ro + 384]; }
        s.x = sv[0] | ((unsigned)sv[1] << 16); s.y = sv[2] | ((unsigned)sv[3] << 16); s.z = sv[4] | ((unsigned)sv[5] << 16); s.w = sv[6] | ((unsigned)sv[7] << 16);
        w.x = wv[0] | ((unsigned)wv[1] << 16); w.y = wv[2] | ((unsigned)wv[3] << 16); w.z = wv[4] | ((unsigned)wv[5] << 16); w.w = wv[6] | ((unsigned)wv[7] << 16);
        *(U4*)(VsT + (((size_t)bg * (SEQ / 8) + kg) * 64 + d) * 8) = s; *(U4*)(VwT + (((size_t)bg * (SEQ / 8) + kg) * 64 + d) * 8) = w;
    }
}
namespace pg8 {
#define PG8_LAS __attribute__((address_space(3)))
typedef unsigned short bf16_t;
typedef short bf16x8 __attribute__((ext_vector_type(8)));
typedef float f32x4 __attribute__((ext_vector_type(4)));
typedef unsigned u32x4 __attribute__((ext_vector_type(4)));
constexpr int BM = 256, BK = 64, HALF = 128, HTB = HALF * BK * 2  , STAGE_BYTES = 8 * HTB, NXCD = 8, WGM = 8;

__host__ __device__ __forceinline__ int lds_byte(int r, int c) { const int st = (r >> 4) * 2 + (c >> 5), rr = r & 15, cc = c & 31, ob = rr * 64 + cc * 2; return st * 1024 + (ob ^ (((ob >> 9) & 1) << 5)); }
__host__ __device__ __forceinline__ void stage_rc(int b, int& R, int& C) { const int st = b / 1024, sb = b % 1024, swz = sb ^ (((sb >> 9) & 1) << 5); R = (st >> 1) * 16 + swz / 64; C = (st & 1) * 32 + (swz % 64) / 2; }
__host__ __device__ __forceinline__ int perm32(int rho) { const int n = rho >> 4, i = rho & 15; return 8 * (i >> 2) + 4 * n + (i & 3); }

struct Unit { int pm, pn; };
struct Gemm { const bf16_t* A; const bf16_t* Bt; int M, N, K; int lda; int ldb; };

struct StaticOrder {
    int nM, nN, nwg, G, c;
    __host__ __device__ void init(int M, int N, int G_, int c_) { nM = M / BM; nN = N / BM; nwg = nM * nN; G = G_; c = c_; }
    __host__ __device__ bool next(int i, Unit& u) const {
        const long L = (long)i * G + c; if (L >= nwg) return false;
        int wgid = (int)L; { const int q = nwg / NXCD, r = nwg % NXCD, xcd = wgid % NXCD, off = wgid / NXCD; wgid = (xcd < r ? xcd * (q + 1) : r * (q + 1) + (xcd - r) * q) + off; }
        const int nig = WGM * nN, gid = wgid / nig, fm = gid * WGM, gsz = (nM - fm) < WGM ? (nM - fm) : WGM;
        u.pm = fm + ((wgid % nig) % gsz); u.pn = (wgid % nig) / gsz; return true;
    }
    __device__ __forceinline__ void a_ready(const Unit&) const {}
    __device__ __forceinline__ void done(const Unit&) const {}
};

__device__ __forceinline__ unsigned cvt_pk_bf16(float lo, float hi) { unsigned r; asm volatile("v_cvt_pk_bf16_f32 %0, %1, %2" : "=v"(r) : "v"(lo), "v"(hi)); return r; }
typedef float f32x2 __attribute__((ext_vector_type(2)));
template <class Epi, class Sched, bool ALIGN_EPI = false, bool SP2 = false, bool KSPLIT = false>
__device__ __forceinline__ void gemm_phase(PG8_LAS unsigned char* lds, const Gemm g, const Sched& S, const Epi& E, int tid_in) {
    int tid_ = tid_in; asm volatile("" : "+v"(tid_));
    const int tid = tid_, wid = __builtin_amdgcn_readfirstlane(tid >> 6), lane = tid & 63, wr = wid >> 2, wc = wid & 3, fr = lane & 15, fq = lane >> 4;
    const int K = g.K, nt = K / BK, lda = g.lda ? g.lda : K, ldb = g.ldb ? g.ldb : K;
    unsigned voffA[2], voffB[2];
#pragma unroll
    for (int i = 0; i < 2; ++i) { int R, C; stage_rc(tid * 16 + i * 8192, R, C); const int Rb = Epi::PERM ? ((R & ~31) + perm32(R & 31)) : R;
        voffA[i] = (unsigned)(R * lda + C) * 2u; voffB[i] = (unsigned)(Rb * ldb + C) * 2u; }
    const size_t kstep = (size_t)(BK * 2);
    const size_t hstepA = (size_t)HALF * lda * 2, hstepB = (size_t)HALF * ldb * 2;
    const size_t hstep_unused = (size_t)HALF * K * 2;
    const size_t tstepA = 2 * hstepA, tstepB = 2 * hstepB;
    const unsigned ldsw = (unsigned)wid * 1024u;
    const int aoff = lds_byte(wr * 64 + fr, fq * 8), boff = lds_byte(wc * 32 + fr, fq * 8);
#define PG8_SA(b, h) (((b) * 2 + (h)) * HTB)
#define PG8_SB(b, h) ((4 + (b) * 2 + (h)) * HTB)
#define PG8_STAGE(bufoff, gbase, voff) do { _Pragma("unroll") for (int _i = 0; _i < 2; ++_i) \
        __builtin_amdgcn_global_load_lds((const unsigned*)((const char*)(gbase) + (voff)[_i]), (PG8_LAS unsigned*)(lds + (bufoff) + ldsw + _i * 8192), 16, 0, 0); } while (0)
#define PG8_LDA(dst, b, h) do { _Pragma("unroll") for (int m = 0; m < 4; ++m) _Pragma("unroll") for (int k = 0; k < 2; ++k) dst[m][k] = *(const PG8_LAS bf16x8*)(lds + PG8_SA(b, h) + aoff + m * 2048 + k * 1024); } while (0)
#define PG8_LDB(dst, b, h) do { _Pragma("unroll") for (int n = 0; n < 2; ++n) _Pragma("unroll") for (int k = 0; k < 2; ++k) dst[n][k] = *(const PG8_LAS bf16x8*)(lds + PG8_SB(b, h) + boff + n * 2048 + k * 1024); } while (0)
#define PG8_MMA(ai, bj, At, Bt) do { __builtin_amdgcn_s_setprio(1); _Pragma("unroll") for (int m = 0; m < 4; ++m) _Pragma("unroll") for (int n = 0; n < 2; ++n) _Pragma("unroll") for (int k = 0; k < 2; ++k) \
        acc[ai][bj][m][n] = __builtin_amdgcn_mfma_f32_16x16x32_bf16(Bt[n][k], At[m][k], acc[ai][bj][m][n], 0, 0, 0); __builtin_amdgcn_s_setprio(0); } while (0)
#define PG8_WAIT_V(n) asm volatile("s_waitcnt vmcnt(" #n ")" ::: "memory")
#define PG8_WAIT_L(n) asm volatile("s_waitcnt lgkmcnt(" #n ")" ::: "memory")
#define PG8_BAR __builtin_amdgcn_s_barrier()
#define PG8_SCHED __builtin_amdgcn_sched_barrier(0)
    Unit cur, nxt; int ui = 0;
    if (!S.next(0, cur)) return;
    f32x4 acc[2][2][4][2];
#pragma unroll
    for (int a = 0; a < 2; ++a)
#pragma unroll
        for (int b = 0; b < 2; ++b)
#pragma unroll
            for (int m = 0; m < 4; ++m)
#pragma unroll
                for (int n = 0; n < 2; ++n) acc[a][b][m][n] = (f32x4){0.f, 0.f, 0.f, 0.f};
    bf16x8 At[4][2], B0[2][2], B1[2][2];
    const char* cA = (const char*)g.A + (size_t)cur.pm * tstepA + (KSPLIT ? (size_t)(cur.pn >> 16) * K * 2 : 0); const char* cB = (const char*)g.Bt + (size_t)(KSPLIT ? (cur.pn & 0xffff) : cur.pn) * tstepB + (KSPLIT ? (size_t)(cur.pn >> 16) * K * 2 : 0);
    S.a_ready(cur);
    if constexpr (SP2) {
        PG8_STAGE(PG8_SB(0, 0), cB, voffB); PG8_STAGE(PG8_SB(0, 1), cB + hstepB, voffB); PG8_STAGE(PG8_SA(0, 0), cA, voffA); PG8_STAGE(PG8_SA(0, 1), cA + hstepA, voffA);
        if (wr == 1) PG8_BAR;
        PG8_WAIT_V(2); PG8_BAR;
        PG8_STAGE(PG8_SB(1, 0), cB + kstep, voffB); PG8_STAGE(PG8_SA(1, 0), cA + kstep, voffA); PG8_STAGE(PG8_SB(1, 1), cB + hstepB + kstep, voffB);
        PG8_WAIT_V(6); PG8_BAR;
    } else {
        PG8_STAGE(PG8_SB(0, 0), cB, voffB); PG8_STAGE(PG8_SA(0, 0), cA, voffA); PG8_STAGE(PG8_SB(0, 1), cB + hstepB, voffB); PG8_STAGE(PG8_SA(0, 1), cA + hstepA, voffA);
        if (wr == 1) PG8_BAR;
        PG8_WAIT_V(4); PG8_BAR;
        PG8_STAGE(PG8_SB(1, 0), cB + kstep, voffB); PG8_STAGE(PG8_SA(1, 0), cA + kstep, voffA); PG8_STAGE(PG8_SB(1, 1), cB + hstepB + kstep, voffB);
        PG8_WAIT_V(6); PG8_BAR;
    }
    for (;;) {
        const bool has_next = S.next(ui + 1, nxt);
        const char* nA = has_next ? (const char*)g.A + (size_t)nxt.pm * tstepA + (KSPLIT ? (size_t)(nxt.pn >> 16) * K * 2 : 0) : cA; const char* nB = has_next ? (const char*)g.Bt + (size_t)(KSPLIT ? (nxt.pn & 0xffff) : nxt.pn) * tstepB + (KSPLIT ? (size_t)(nxt.pn >> 16) * K * 2 : 0) : cB;
        for (int t = 0; t < nt; t += 2) {
            const bool last = (t == nt - 2);
            const char* a1 = cA + (size_t)(t + 1) * kstep;
            const char* a2 = last ? nA : cA + (size_t)(t + 2) * kstep; const char* b2 = last ? nB : cB + (size_t)(t + 2) * kstep;
            const char* a3 = a2 + kstep; const char* b3 = b2 + kstep;
            if (last && has_next) S.a_ready(nxt);
            if constexpr (SP2) {
            PG8_LDB(B0, 0, 0); PG8_LDB(B1, 0, 1); PG8_SCHED; PG8_LDA(At, 0, 0); PG8_STAGE(PG8_SA(1, 1), a1 + hstepA, voffA);
            PG8_WAIT_V(8); PG8_WAIT_L(0); PG8_BAR; PG8_MMA(0, 0, At, B0); PG8_MMA(0, 1, At, B1); PG8_BAR; PG8_SCHED;
            PG8_LDA(At, 0, 1); PG8_STAGE(PG8_SB(0, 0), b2, voffB); PG8_STAGE(PG8_SB(0, 1), b2 + hstepB, voffB); PG8_STAGE(PG8_SA(0, 0), a2, voffA);
            PG8_WAIT_V(8); PG8_WAIT_L(0); PG8_BAR; PG8_MMA(1, 0, At, B0); PG8_MMA(1, 1, At, B1); PG8_BAR; PG8_SCHED;
            PG8_LDB(B0, 1, 0); PG8_LDB(B1, 1, 1); PG8_SCHED; PG8_LDA(At, 1, 0); PG8_STAGE(PG8_SA(0, 1), a2 + hstepA, voffA);
            PG8_WAIT_V(8); PG8_WAIT_L(0); PG8_BAR; PG8_MMA(0, 0, At, B0); PG8_MMA(0, 1, At, B1); PG8_BAR; PG8_SCHED;
            PG8_LDA(At, 1, 1); PG8_STAGE(PG8_SB(1, 0), b3, voffB); PG8_STAGE(PG8_SB(1, 1), b3 + hstepB, voffB); PG8_STAGE(PG8_SA(1, 0), a3, voffA);
            PG8_WAIT_V(8); PG8_WAIT_L(0); PG8_BAR; PG8_MMA(1, 0, At, B0); PG8_MMA(1, 1, At, B1); PG8_BAR; PG8_SCHED;
            } else {
            PG8_LDB(B0, 0, 0); PG8_SCHED; PG8_LDA(At, 0, 0); PG8_STAGE(PG8_SA(1, 1), a1 + hstepA, voffA);
            PG8_WAIT_L(8); PG8_BAR; PG8_WAIT_L(0); PG8_MMA(0, 0, At, B0); PG8_BAR; PG8_SCHED;
            PG8_LDB(B1, 0, 1); PG8_STAGE(PG8_SB(0, 0), b2, voffB);
            PG8_BAR; PG8_WAIT_L(0); PG8_MMA(0, 1, At, B1); PG8_BAR;
            PG8_LDA(At, 0, 1); PG8_STAGE(PG8_SA(0, 0), a2, voffA);
            PG8_BAR; PG8_WAIT_L(0); PG8_MMA(1, 0, At, B0); PG8_BAR; PG8_SCHED;
            PG8_STAGE(PG8_SB(0, 1), b2 + hstepB, voffB);
            PG8_WAIT_V(6); PG8_BAR; PG8_MMA(1, 1, At, B1); PG8_BAR;
            PG8_LDB(B0, 1, 0); PG8_SCHED; PG8_LDA(At, 1, 0); PG8_STAGE(PG8_SA(0, 1), a2 + hstepA, voffA);
            PG8_WAIT_L(8); PG8_BAR; PG8_WAIT_L(0); PG8_MMA(0, 0, At, B0); PG8_BAR; PG8_SCHED;
            PG8_LDB(B1, 1, 1); PG8_STAGE(PG8_SB(1, 0), b3, voffB);
            PG8_BAR; PG8_WAIT_L(0); PG8_MMA(0, 1, At, B1); PG8_BAR;
            PG8_LDA(At, 1, 1); PG8_STAGE(PG8_SA(1, 0), a3, voffA);
            PG8_BAR; PG8_WAIT_L(0); PG8_MMA(1, 0, At, B0); PG8_BAR; PG8_SCHED;
            PG8_STAGE(PG8_SB(1, 1), b3 + hstepB, voffB);
            PG8_WAIT_V(6); PG8_BAR; PG8_MMA(1, 1, At, B1); PG8_BAR;
            }
        }
        if constexpr (ALIGN_EPI) { if (wr == 0) PG8_BAR; }
        if constexpr (!Epi::AFTER_DRAIN) { E(acc, cur, wr, wc, fr, fq); S.done(cur); }
        if (!has_next) break;
#pragma unroll
        for (int a = 0; a < 2; ++a)
#pragma unroll
            for (int b = 0; b < 2; ++b)
#pragma unroll
                for (int m = 0; m < 4; ++m)
#pragma unroll
                    for (int n = 0; n < 2; ++n) acc[a][b][m][n] = (f32x4){0.f, 0.f, 0.f, 0.f};
        cur = nxt; cA = nA; cB = nB; ++ui;
        if constexpr (ALIGN_EPI) { if (wr == 1) PG8_BAR; }
    }
    PG8_WAIT_V(0);
    if constexpr (!ALIGN_EPI) { if (wr == 0) PG8_BAR; }
    PG8_BAR;
    if constexpr (Epi::AFTER_DRAIN) { E.fused(acc, cur, wr, wc, fr, fq, lds, wid, lane); S.done(cur); }
#undef PG8_SA
#undef PG8_SB
#undef PG8_STAGE
#undef PG8_LDA
#undef PG8_LDB
#undef PG8_MMA
#undef PG8_WAIT_V
#undef PG8_WAIT_L
#undef PG8_BAR
#undef PG8_SCHED
}
}

#define LAS __attribute__((address_space(3)))
#define XB_TMO      128
#define XB_XCNT(j)  (256  + 64 * (j))
#define XB_XSUB(j)  (1280 + 64 * (j))
#define XB_XGEN(j)  (2304 + 64 * (j))
#define XB_TOP      3328
#define XB_TOPGEN   3392
#define XCD_BAR_WORDS 3456
#define XB_SPIN_CAP (1u << 22)

__device__ __forceinline__ unsigned xb_ld(unsigned* p)              { return __hip_atomic_load(p, __ATOMIC_RELAXED, __HIP_MEMORY_SCOPE_AGENT); }
__device__ __forceinline__ unsigned xb_add(unsigned* p, unsigned v) { return __hip_atomic_fetch_add(p, v, __ATOMIC_RELAXED, __HIP_MEMORY_SCOPE_AGENT); }
__device__ __forceinline__ unsigned xb_xcc_id() { return (unsigned)__builtin_amdgcn_s_getreg((3 << 11) | 20) & 0xFu; }
#define XB_SPIN(cond, bar) do { unsigned _sp = 0; while (cond) { __builtin_amdgcn_s_sleep(1); \
    if ((++_sp & 255u) == 0u) { if (xb_ld(&(bar)[XB_TMO])) break; if (_sp > XB_SPIN_CAP) { atomicAdd(&(bar)[XB_TMO], 1u); break; } } } } while (0)

struct XcdBarrier {
    unsigned* bar; unsigned x;
    volatile LAS unsigned* st;
};

__device__ __forceinline__ XcdBarrier xcd_barrier_post(unsigned* bar, volatile LAS unsigned* st) {
    XcdBarrier b; b.bar = bar; b.x = xb_xcc_id(); b.st = st;
    if (threadIdx.x == 0) (void)xb_add(&bar[XB_XCNT(b.x)], 1u);
    return b;
}
__device__ __forceinline__ void xcd_barrier_complete(unsigned* bar, unsigned x, unsigned& nloc, unsigned& nx) {
    const unsigned G = gridDim.x * gridDim.y * gridDim.z;
    unsigned sum, cnt, mine, sp = 0u;
    for (;;) {
        sum = 0u; cnt = 0u; mine = 0u;
#pragma unroll
        for (unsigned j = 0; j < 16; ++j) { const unsigned c = xb_ld(&bar[XB_XCNT(j)]); sum += c; cnt += (c > 0u) ? 1u : 0u; mine = (j == x) ? c : mine; }
        if (sum == G) break;
        __builtin_amdgcn_s_sleep(1);
        if ((++sp & 255u) == 0u) { if (xb_ld(&bar[XB_TMO])) break; if (sp > XB_SPIN_CAP) { atomicAdd(&bar[XB_TMO], 1u); break; } }
    }
    nloc = mine > 0u ? mine : 1u; nx = cnt > 0u ? cnt : 1u;
}

__device__ __forceinline__ void xcd_barrier(const XcdBarrier& b, int tid_x  ) {
    asm volatile("s_waitcnt vmcnt(0)" ::: "memory");
    __syncthreads();
    if (tid_x == 0) {
        unsigned* bar = b.bar; asm volatile("" : "+s"(bar));
        unsigned xx = b.x; asm volatile("" : "+s"(xx));
        __builtin_amdgcn_s_waitcnt(0);
        unsigned nloc = b.st[0], nx = b.st[1];
        if (nloc == 0u) { xcd_barrier_complete(bar, xx, nloc, nx); b.st[0] = nloc; b.st[1] = nx; }
        const unsigned old = xb_add(&bar[XB_XSUB(xx)], 1u);
        const unsigned gen = old / nloc;
        if (old + 1u == (gen + 1u) * nloc) {
            __builtin_amdgcn_fence(__ATOMIC_RELEASE, "agent");
            asm volatile("s_waitcnt vmcnt(0)" ::: "memory");
            const unsigned og = xb_add(&bar[XB_TOP], 1u);
            const unsigned tg = og / nx;
            if (og + 1u == (tg + 1u) * nx) xb_add(&bar[XB_TOPGEN], 1u);
            else XB_SPIN(xb_ld(&bar[XB_TOPGEN]) == tg, bar);
            __builtin_amdgcn_fence(__ATOMIC_ACQUIRE, "agent");
            xb_add(&bar[XB_XGEN(xx)], 1u);
            asm volatile("s_waitcnt vmcnt(0)" ::: "memory");
        } else {
            XB_SPIN(xb_ld(&bar[XB_XGEN(xx)]) == gen, bar);
            __builtin_amdgcn_fence(__ATOMIC_ACQUIRE, "agent");
            asm volatile("s_waitcnt vmcnt(0)" ::: "memory");
        }
    }
    __syncthreads();
}
#define GAS __attribute__((address_space(1)))
typedef unsigned v4u __attribute__((ext_vector_type(4)));
#ifdef PROBE_TK
#define TKQ(i) do { if (layer == PROBE_LAYER && blockIdx.x == PROBE_BLK && threadIdx.x == 0) ((unsigned long long*)(p.ws + WS_CTL + 4 * CW_TK))[(i)] = __builtin_amdgcn_s_memrealtime(); } while (0)
#else
#define TKQ(i) do { } while (0)
#endif
typedef unsigned v2u __attribute__((ext_vector_type(2)));
typedef GAS unsigned gu32;
#define RLX_AGENT __ATOMIC_RELAXED, __HIP_MEMORY_SCOPE_AGENT
#define LDS_WAIT() asm volatile("s_waitcnt lgkmcnt(0)" ::: "memory")
#define VM_WAIT() asm volatile("s_waitcnt vmcnt(0)" ::: "memory")
using pg8::f32x4; using pg8::Unit; using pg8::Gemm; using pg8::BM; using pg8::HALF; using pg8::cvt_pk_bf16; using pg8::u32x4;

constexpr int NWAVES = 8, NTHREADS = 512;
constexpr int RING_BYTES = 131072, LDSCTL_OFF = 147456 - 1024, MISC_OFF = LDSCTL_OFF + 320, LDS_BYTES = 147456;

__device__ __forceinline__ float wave_sum(float v, int lane) {
#pragma unroll
    for (int o = 1; o < 64; o <<= 1) v += __builtin_bit_cast(float, __builtin_amdgcn_ds_bpermute((lane ^ o) << 2, __builtin_bit_cast(int, v)));
    return v;
}
__device__ __forceinline__ float fsig(float x) { return __builtin_amdgcn_rcpf(1.f + __expf(-x)); }

__device__ __forceinline__ int lane_id_opaque() { int l; asm volatile("v_mbcnt_lo_u32_b32 %0, -1, 0\n\tv_mbcnt_hi_u32_b32 %0, -1, %0" : "=v"(l)); return l; }
__device__ __forceinline__ int rfl(int v) { return __builtin_amdgcn_readfirstlane(v); }
struct SOrder {
    pg8::StaticOrder s;
    __device__ void init(int M, int N, int G, int c) { s.init(M, N, G, c); }
    __device__ bool next(int i, Unit& u) const { Unit t; t.pm = 0; t.pn = 0; const bool ok = s.next(i, t); u.pm = rfl(t.pm); u.pn = rfl(t.pn); return ok; }
    __device__ __forceinline__ void a_ready(const Unit&) const {}
    __device__ __forceinline__ void done(const Unit&) const {}
};
struct StackOrder {
    pg8::StaticOrder s; int nM, nN;
    __device__ StackOrder(int nM_, int nN_, int nb, int G, int c) : nM(nM_), nN(nN_) { s.init(nb * nM_ * 256, nN_ * 256, G, c); }
    __device__ bool next(int i, Unit& u) const { Unit t; t.pm = 0; t.pn = 0; if (!s.next(i, t)) return false; u.pm = rfl(t.pm); u.pn = rfl((t.pm / nM) * nN + t.pn); return true; }
    __device__ __forceinline__ void a_ready(const Unit&) const {}
    __device__ __forceinline__ void done(const Unit&) const {}
};
struct GateOrder {
    pg8::StaticOrder s; int nN;
    __device__ GateOrder(int nM_, int nN_, int G, int c) : nN(nN_) { s.init(nM_ * 256, nN_ * 256, G, c); }
    __device__ bool next(int i, Unit& u) const { const int j = i / 3, br = i - 3 * j; Unit t; t.pm = 0; t.pn = 0; if (!s.next(j, t)) return false; u.pm = rfl(t.pm); u.pn = rfl(br * nN + t.pn); return true; }
    __device__ __forceinline__ void a_ready(const Unit&) const {}
    __device__ __forceinline__ void done(const Unit&) const {}
};
struct MoeOrder {
    pg8::StaticOrder s; int nN, e0, e1, e2, e3, e4, e5, e6, e7;
    __device__ void init(const unsigned* cnt  , int nN_, int G_, int c_) { nN = nN_;
        int t = 0; t += (cnt[0] + 255) >> 8; e0 = t; t += (cnt[64] + 255) >> 8; e1 = t; t += (cnt[128] + 255) >> 8; e2 = t; t += (cnt[192] + 255) >> 8; e3 = t;
        t += (cnt[256] + 255) >> 8; e4 = t; t += (cnt[320] + 255) >> 8; e5 = t; t += (cnt[384] + 255) >> 8; e6 = t; t += (cnt[448] + 255) >> 8; e7 = t;
        s.init(e7 * 256, nN_ * 256, G_, c_); }
    __device__ bool next(int i, Unit& u) const { Unit t; t.pm = 0; t.pn = 0; if (!s.next(i, t)) return false;
        const int pm = t.pm, e = (pm >= e0) + (pm >= e1) + (pm >= e2) + (pm >= e3) + (pm >= e4) + (pm >= e5) + (pm >= e6);
        u.pm = rfl(pm); u.pn = rfl(e * nN + t.pn); return true; }
    __device__ __forceinline__ void a_ready(const Unit&) const {}
    __device__ __forceinline__ void done(const Unit&) const {}
};

__device__ __forceinline__ u32x4 pack8(f32x4 v0, f32x4 v1) { u32x4 w; w.x = cvt_pk_bf16(v0[0], v0[1]); w.y = cvt_pk_bf16(v0[2], v0[3]); w.z = cvt_pk_bf16(v1[0], v1[1]); w.w = cvt_pk_bf16(v1[2], v1[3]); return w; }
__device__ __forceinline__ void unpack8(u32x4 w, f32x4& v0, f32x4& v1) {
    v0 = (f32x4){blo(w.x), bhi(w.x), blo(w.y), bhi(w.y)}; v1 = (f32x4){blo(w.z), bhi(w.z), blo(w.w), bhi(w.w)}; }

struct EpiProj {
    static constexpr bool PERM = true, AFTER_DRAIN = false;
    unsigned char* ws;
    __device__ __forceinline__ void operator()(const f32x4 (&acc)[2][2][4][2], const Unit& u, int wr, int wc, int fr, int fq) const {
        bf16* const QB = (bf16*)(ws + AR_QB); bf16* const KV = (bf16*)(ws + AR_KV); bf16* const UB = (bf16*)(ws + AR_UB); bf16* const RW = (bf16*)(ws + AR_RW); bf16* const HALO = (bf16*)(ws + AR_HALO); bf16* const CKV = (bf16*)(ws + AR_CKV);
        const int row0 = u.pm * BM + wr * 64 + fr, cl = wc * 32 + 8 * fq;
        if (u.pn >= 5 && u.pn < 9) {
#pragma unroll
            for (int ai = 0; ai < 2; ++ai)
#pragma unroll
                for (int m = 0; m < 4; ++m) { f32x4 a0 = acc[ai][0][m][0], a1 = acc[ai][0][m][1]; const f32x4 b0 = acc[ai][1][m][0], b1 = acc[ai][1][m][1];
#pragma unroll
                    for (int k = 0; k < 4; ++k) { a0[k] *= fsig(b0[k]); a1[k] *= fsig(b1[k]); }
                    *(u32x4*)(UB + (size_t)(row0 + ai * HALF + m * 16) * 512 + (u.pn - 5) * 128 + cl) = pack8(a0, a1); }
            return;
        }
        if (u.pn == 2) {
#pragma unroll
            for (int ai = 0; ai < 2; ++ai)
#pragma unroll
                for (int m = 0; m < 4; ++m) { const int row = row0 + ai * HALF + m * 16, b = row / SEQ, tt = row % SEQ;
#pragma unroll
                    for (int bj = 0; bj < 2; ++bj) *(u32x4*)(CKV + (((size_t)bj * (BATCH * NKV) + b * NKV + (cl >> 6)) * SEQ + tt) * 64 + (cl & 63)) = pack8(acc[ai][bj][m][0], acc[ai][bj][m][1]); }
            return;
        }
        bf16* base; int ld, c0;
        if (u.pn < 2) { base = QB; ld = LDQ; c0 = u.pn * 256; } else if (u.pn < 5) { base = KV; ld = LDKV; c0 = (u.pn - 3) * 256; } else { base = RW; ld = LDRW; c0 = (u.pn - 9) * 256; }
#pragma unroll
        for (int ai = 0; ai < 2; ++ai)
#pragma unroll
            for (int m = 0; m < 4; ++m)
#pragma unroll
                for (int bj = 0; bj < 2; ++bj) { const u32x4 w = pack8(acc[ai][bj][m][0], acc[ai][bj][m][1]);
                    *(u32x4*)(base + (size_t)(row0 + ai * HALF + m * 16) * ld + c0 + bj * HALF + cl) = w;
                    if (u.pn >= 9 && ai == 1 && m == 3 && wr == 1 && fr == 15) *(u32x4*)(HALO + (size_t)u.pm * LDRW + c0 + bj * HALF + cl) = w; }
    }
};
struct EpiStore {
    static constexpr bool PERM = true, AFTER_DRAIN = false;
    bf16* O; int ld, ntn;
    __device__ __forceinline__ void operator()(const f32x4 (&acc)[2][2][4][2], const Unit& u, int wr, int wc, int fr, int fq) const {
        const int row0 = u.pm * BM + wr * 64 + fr, c0 = (u.pn % ntn) * 256 + wc * 32 + 8 * fq;
#pragma unroll
        for (int ai = 0; ai < 2; ++ai)
#pragma unroll
            for (int m = 0; m < 4; ++m)
#pragma unroll
                for (int bj = 0; bj < 2; ++bj) *(u32x4*)(O + (size_t)(row0 + ai * HALF + m * 16) * ld + c0 + bj * HALF) = pack8(acc[ai][bj][m][0], acc[ai][bj][m][1]);
    }
};
struct EpiGate {
    static constexpr bool PERM = true, AFTER_DRAIN = false;
    unsigned char* ws; int ntn;
    __device__ __forceinline__ void operator()(const f32x4 (&acc)[2][2][4][2], const Unit& u, int wr, int wc, int fr, int fq) const {
        const bf16* const OB = (const bf16*)(ws + AR_OBUF); bf16* const MIX = (bf16*)(ws + AR_MIX);
        const int br = u.pn / ntn, row0 = u.pm * BM + wr * 64 + fr, c0 = (u.pn % ntn) * 256 + wc * 32 + 8 * fq;
        const bf16* ob = OB + (size_t)br * T * DM;
#pragma unroll
        for (int ai = 0; ai < 2; ++ai) {
            u32x4 o[4][2], mx[4][2];
#pragma unroll
            for (int m = 0; m < 4; ++m)
#pragma unroll
                for (int bj = 0; bj < 2; ++bj) { const size_t off = (size_t)(row0 + ai * HALF + m * 16) * DM + c0 + bj * HALF; o[m][bj] = *(const u32x4*)(ob + off); if (br != 0) mx[m][bj] = *(const u32x4*)(MIX + off); }
#pragma unroll
            for (int m = 0; m < 4; ++m)
#pragma unroll
                for (int bj = 0; bj < 2; ++bj) { const size_t off = (size_t)(row0 + ai * HALF + m * 16) * DM + c0 + bj * HALF;
                    f32x4 o0, o1; unpack8(o[m][bj], o0, o1);
                    f32x4 g0 = acc[ai][bj][m][0], g1 = acc[ai][bj][m][1];
#pragma unroll
                    for (int k = 0; k < 4; ++k) { g0[k] = fsig(g0[k]) * o0[k]; g1[k] = fsig(g1[k]) * o1[k]; }
                    if (br != 0) { f32x4 p0, p1; unpack8(mx[m][bj], p0, p1); g0 += p0; g1 += p1; }
                    *(u32x4*)(MIX + off) = pack8(g0, g1); }
        }
    }
};
struct EpiResid {
    static constexpr bool PERM = true, AFTER_DRAIN = false;
    const float* base; float* out;
    __device__ __forceinline__ void operator()(const f32x4 (&acc)[2][2][4][2], const Unit& u, int wr, int wc, int fr, int fq) const {
        const int row0 = u.pm * BM + wr * 64 + fr, c0 = u.pn * 256 + wc * 32 + 8 * fq;
#pragma unroll
        for (int ai = 0; ai < 2; ++ai)
#pragma unroll
            for (int mh = 0; mh < 2; ++mh) {
                f32x4 x[2][2][2];
#pragma unroll
                for (int mm = 0; mm < 2; ++mm)
#pragma unroll
                    for (int bj = 0; bj < 2; ++bj) { const size_t off = (size_t)(row0 + ai * HALF + (2 * mh + mm) * 16) * DM + c0 + bj * HALF; x[mm][bj][0] = *(const f32x4*)(base + off); x[mm][bj][1] = *(const f32x4*)(base + off + 4); }
#pragma unroll
                for (int mm = 0; mm < 2; ++mm)
#pragma unroll
                    for (int bj = 0; bj < 2; ++bj) { const int m = 2 * mh + mm; const size_t off = (size_t)(row0 + ai * HALF + m * 16) * DM + c0 + bj * HALF;
                        *(f32x4*)(out + off) = x[mm][bj][0] + acc[ai][bj][m][0]; *(f32x4*)(out + off + 4) = x[mm][bj][1] + acc[ai][bj][m][1]; }
            }
    }
};
struct EpiSwiglu {
    static constexpr bool PERM = true, AFTER_DRAIN = false;
    bf16* ACT; int ld, ntn;
    __device__ __forceinline__ void operator()(const f32x4 (&acc)[2][2][4][2], const Unit& u, int wr, int wc, int fr, int fq) const {
        const int row0 = u.pm * BM + wr * 64 + fr, c0 = (u.pn % ntn) * 128 + wc * 32 + 8 * fq;
#pragma unroll
        for (int ai = 0; ai < 2; ++ai)
#pragma unroll
            for (int m = 0; m < 4; ++m) { f32x4 g0 = acc[ai][0][m][0], g1 = acc[ai][0][m][1]; const f32x4 u0 = acc[ai][1][m][0], u1 = acc[ai][1][m][1];
#pragma unroll
                for (int k = 0; k < 4; ++k) { g0[k] = g0[k] * fsig(g0[k]) * u0[k]; g1[k] = g1[k] * fsig(g1[k]) * u1[k]; }
                *(u32x4*)(ACT + (size_t)(row0 + ai * HALF + m * 16) * ld + c0) = pack8(g0, g1); }
    }
};
struct EpiMoeDown {
    static constexpr bool PERM = true, AFTER_DRAIN = false;
    float* out; const int* rtok; const float* rw; int ntn; float sc;
    __device__ __forceinline__ void operator()(const f32x4 (&acc)[2][2][4][2], const Unit& u, int wr, int wc, int fr, int fq) const {
        const int row0 = u.pm * BM + wr * 64 + fr, c0 = (u.pn % ntn) * 256 + wc * 32 + 8 * fq;
#pragma unroll
        for (int ai = 0; ai < 2; ++ai)
#pragma unroll
            for (int mh = 0; mh < 2; ++mh) {
                int tok[2]; float w[2]; f32x4 x[2][2][2];
#pragma unroll
                for (int mm = 0; mm < 2; ++mm) { const int row = row0 + ai * HALF + (2 * mh + mm) * 16; tok[mm] = rtok[row]; w[mm] = rw[row] * sc; }
#pragma unroll
                for (int mm = 0; mm < 2; ++mm)
#pragma unroll
                    for (int bj = 0; bj < 2; ++bj) { const float* o = out + (size_t)(tok[mm] >= 0 ? tok[mm] : 0) * DM + c0 + bj * HALF; x[mm][bj][0] = *(const f32x4*)o; x[mm][bj][1] = *(const f32x4*)(o + 4); }
#pragma unroll
                for (int mm = 0; mm < 2; ++mm)
#pragma unroll
                    for (int bj = 0; bj < 2; ++bj) if (tok[mm] >= 0) { const int m = 2 * mh + mm; float* o = out + (size_t)tok[mm] * DM + c0 + bj * HALF;
                        *(f32x4*)o = x[mm][bj][0] + acc[ai][bj][m][0] * w[mm]; *(f32x4*)(o + 4) = x[mm][bj][1] + acc[ai][bj][m][1] * w[mm]; }
            }
    }
};

constexpr int MT_KS = 7, MT_K = EXPERT_FF / MT_KS;
struct MoeTailOrder {
    int nN, pm0, nsub, G, c, e0, e1, e2, e3, e4, e5, e6;
    __device__ void init(const MoeOrder& m, int pm0_, int ntiles, int G_, int c_) { nN = m.nN; pm0 = pm0_; nsub = ntiles * MT_KS; G = G_; c = c_; e0 = m.e0; e1 = m.e1; e2 = m.e2; e3 = m.e3; e4 = m.e4; e5 = m.e5; e6 = m.e6; }
    __device__ bool next(int i, Unit& u) const { const int L = i * G + c; if (L >= nsub) return false;
        const int j = L / MT_KS, ks = L - j * MT_KS, pm = pm0 + j / nN, pl = j % nN, e = (pm >= e0) + (pm >= e1) + (pm >= e2) + (pm >= e3) + (pm >= e4) + (pm >= e5) + (pm >= e6);
        u.pm = rfl(pm); u.pn = rfl((e * nN + pl) | (ks << 16)); return true; }
    __device__ __forceinline__ void a_ready(const Unit&) const {}
    __device__ __forceinline__ void done(const Unit&) const {}
};
struct EpiPart {
    static constexpr bool PERM = true, AFTER_DRAIN = false;
    float* part; int pm0, nN;
    __device__ __forceinline__ void operator()(const f32x4 (&acc)[2][2][4][2], const Unit& u, int wr, int wc, int fr, int fq) const {
        const int slot = ((u.pm - pm0) * nN + (u.pn & 0xffff) % nN) * MT_KS + (u.pn >> 16);
        float* b = part + (size_t)slot * 65536 + (size_t)(((wr * 4 + wc) * 64 + fq * 16 + fr) * 4);
#pragma unroll
        for (int ai = 0; ai < 2; ++ai)
#pragma unroll
            for (int bj = 0; bj < 2; ++bj)
#pragma unroll
                for (int m = 0; m < 4; ++m)
#pragma unroll
                    for (int n = 0; n < 2; ++n) *(f32x4*)(b + (((ai * 2 + bj) * 4 + m) * 2 + n) * 2048) = acc[ai][bj][m][n];
    }
};
__device__ __forceinline__ void moe_tail_combine(const EpiMoeDown& E, const MoeOrder& mo, const float* part, int pm0, int job, int lane_in) {
    int lane = lane_in; asm volatile("" : "+v"(lane));
    const int q = job & 3, role = (job >> 2) & 7, j = job >> 5, ai = q >> 1, mh = q & 1, pm = pm0 + j / mo.nN, pl = j % mo.nN, wr = role >> 2, wc = role & 3, fr = lane & 15, fq = lane >> 4;
    const float* b = part + (size_t)j * MT_KS * 65536 + (size_t)((role * 64 + lane) * 4);
    f32x4 a[2][2][2];
#pragma unroll
    for (int mm = 0; mm < 2; ++mm)
#pragma unroll
        for (int bj = 0; bj < 2; ++bj)
#pragma unroll
            for (int n = 0; n < 2; ++n) a[mm][bj][n] = *(const f32x4*)(b + (((ai * 2 + bj) * 4 + 2 * mh + mm) * 2 + n) * 2048);
#pragma unroll
    for (int ks = 1; ks < MT_KS; ++ks)
#pragma unroll
        for (int mm = 0; mm < 2; ++mm)
#pragma unroll
            for (int bj = 0; bj < 2; ++bj)
#pragma unroll
                for (int n = 0; n < 2; ++n) a[mm][bj][n] += *(const f32x4*)(b + (size_t)ks * 65536 + (((ai * 2 + bj) * 4 + 2 * mh + mm) * 2 + n) * 2048);
    const int row0 = pm * BM + wr * 64 + fr + ai * HALF + 2 * mh * 16, c0 = pl * 256 + wc * 32 + 8 * fq;
#pragma unroll
    for (int mm = 0; mm < 2; ++mm) { const int tok = E.rtok[row0 + mm * 16]; const float w = E.rw[row0 + mm * 16] * E.sc;
        if (tok >= 0) {
#pragma unroll
            for (int bj = 0; bj < 2; ++bj) { float* o = E.out + (size_t)tok * DM + c0 + bj * HALF; const f32x4 x0 = *(const f32x4*)o, x1 = *(const f32x4*)(o + 4);
                *(f32x4*)o = x0 + a[mm][bj][0] * w; *(f32x4*)(o + 4) = x1 + a[mm][bj][1] * w; } } }
}

typedef short bf16x8_t __attribute__((ext_vector_type(8)));
#define MFMA16(a, b, c) __builtin_amdgcn_mfma_f32_16x16x32_bf16((a), (b), (c), 0, 0, 0)
constexpr float ATT_C = 0.125f * 1.4426950408889634f;
constexpr int AW_IMP = 0, AW_SEL = 8448, AW_QS = 8960, AW_BYTES = 8960 + 8192;
__device__ __forceinline__ float bperm_f(float v, int srclane) { return __builtin_bit_cast(float, __builtin_amdgcn_ds_bpermute(srclane << 2, __builtin_bit_cast(int, v))); }
__device__ __forceinline__ int bperm_i(int v, int srclane) { return __builtin_amdgcn_ds_bpermute(srclane << 2, v); }
__device__ __forceinline__ bf16x8_t ldg8(const bf16* p) { return *(const bf16x8_t*)p; }
__device__ __forceinline__ bf16x8_t pack_p(const f32x4& a, const f32x4& b) {
    v4u w; w.x = cvt_pk_bf16(a[0], a[1]); w.y = cvt_pk_bf16(a[2], a[3]); w.z = cvt_pk_bf16(b[0], b[1]); w.w = cvt_pk_bf16(b[2], b[3]); return __builtin_bit_cast(bf16x8_t, w); }

__device__ __forceinline__ void nsa_attn_item(const P& p, int item, int lane, LAS unsigned char* wl) {
    const bf16* KV = WSP(bf16, AR_KV); const bf16* KC = WSP(bf16, AR_KC); const bf16* VcT = WSP(bf16, AR_VCT); const bf16* VsT = WSP(bf16, WS_VST); const bf16* VwT = WSP(bf16, WS_VWT);
    bf16* QB = WSP(bf16, AR_QB); const float* NG = WSP(float, AR_NG);
    const int bg = item / (SEQ / 16), t0 = (item % (SEQ / 16)) * 16, b = bg >> 1, g = bg & 1;
    const int col = lane & 15, fq = lane >> 4, tok = t0 + col;
    const size_t grow = (size_t)b * SEQ + tok;
    LAS float* IMP = (LAS float*)(wl + AW_IMP); LAS int* SEL = (LAS int*)(wl + AW_SEL); LAS bf16* OS = (LAS bf16*)(wl + AW_IMP);
    const int krowA = 8 * (col >> 2) + (col & 3);
    const float* gate = NG + grow * 24 + g * 12;
    LAS bf16x8_t* QS = (LAS bf16x8_t*)(wl + AW_QS) + lane;
#pragma unroll
    for (int hh = 0; hh < 4; ++hh)
#pragma unroll
        for (int ks = 0; ks < 2; ++ks) QS[(hh * 2 + ks) * 64] = ldg8(QB + grow * LDQ + (g * 4 + hh) * 64 + ks * 32 + fq * 8);
#define Qc(hh, ks) (QS[((hh) * 2 + (ks)) * 64])
    for (int i = lane; i < 16 * 132; i += 64) IMP[i] = 0.f;
    const f32x4 z4 = {0.f, 0.f, 0.f, 0.f};
    f32x4 O[4][4];
    int nvmax = (t0 + 15 >= 31) ? (((t0 + 15 - 31) >> 4) + 1) : 0; if (nvmax > NC) nvmax = NC;
    const int nch = (nvmax + 31) >> 5;
    const bf16* kcb = KC + (size_t)bg * 512 * 64; const bf16* vcb = VcT + (size_t)bg * 64 * 512;
    float linv[4] = {0.f, 0.f, 0.f, 0.f};
#pragma unroll
    for (int hh = 0; hh < 4; ++hh)
#pragma unroll
        for (int mt = 0; mt < 4; ++mt) O[hh][mt] = z4;
#pragma unroll 1
    for (int pass = 0; pass < 2; ++pass) {
#pragma unroll 1
        for (int ch = 0; ch < nch; ++ch) {
            asm volatile("" ::: "memory");
            const int k0 = 32 * ch; const bool cfull = 16 * (k0 + 31) + 31 <= t0;
            bf16x8_t ka[2][2];
#pragma unroll
            for (int tl = 0; tl < 2; ++tl)
#pragma unroll
                for (int ks = 0; ks < 2; ++ks) ka[tl][ks] = ldg8(kcb + ((size_t)(4 * ks + fq) * 512 + k0 + 16 * tl + col) * 8);
            bf16x8_t va[4];
            if (pass == 1) {
#pragma unroll
                for (int mt = 0; mt < 4; ++mt) va[mt] = ldg8(vcb + ((size_t)((k0 >> 3) + fq) * 64 + 16 * mt + col) * 8);
            }
            float ps[8] = {0.f, 0.f, 0.f, 0.f, 0.f, 0.f, 0.f, 0.f};
#pragma unroll
            for (int hh = 0; hh < 4; ++hh) {
                const bf16x8_t q0_ = Qc(hh, 0), q1_ = Qc(hh, 1);
                f32x4 sa = MFMA16(ka[0][0], q0_, z4); sa = MFMA16(ka[0][1], q1_, sa);
                f32x4 sb = MFMA16(ka[1][0], q0_, z4); sb = MFMA16(ka[1][1], q1_, sb);
#pragma unroll
                for (int i = 0; i < 4; ++i) { sa[i] = __builtin_amdgcn_exp2f(sa[i]); sb[i] = __builtin_amdgcn_exp2f(sb[i]); }
                if (!cfull) {
#pragma unroll
                    for (int i = 0; i < 4; ++i) { const int c = k0 + 4 * fq + i; sa[i] = (16 * c + 31 <= tok) ? sa[i] : 0.f; sb[i] = (16 * (c + 16) + 31 <= tok) ? sb[i] : 0.f; } }
                if (pass == 0) { linv[hh] += (sa[0] + sa[1]) + (sa[2] + sa[3]) + (sb[0] + sb[1]) + (sb[2] + sb[3]); }
                else {
#pragma unroll
                    for (int i = 0; i < 4; ++i) { ps[i] = __builtin_fmaf(sa[i], linv[hh], ps[i]); ps[4 + i] = __builtin_fmaf(sb[i], linv[hh], ps[4 + i]); }
                    const bf16x8_t pt = pack_p(sa, sb);
#pragma unroll
                    for (int mt = 0; mt < 4; ++mt) O[hh][mt] = MFMA16(va[mt], pt, O[hh][mt]);
                }
            }
            if (pass == 1) {
                const int Ga = 8 * ch + fq; LAS float* ir = IMP + col * 132 + Ga;
                __hip_atomic_fetch_add(ir, (ps[0] + ps[1]) + (ps[2] + ps[3]), __ATOMIC_RELAXED, __HIP_MEMORY_SCOPE_WORKGROUP);
                __hip_atomic_fetch_add(ir + 1, ps[3], __ATOMIC_RELAXED, __HIP_MEMORY_SCOPE_WORKGROUP);
                __hip_atomic_fetch_add(ir + 4, (ps[4] + ps[5]) + (ps[6] + ps[7]), __ATOMIC_RELAXED, __HIP_MEMORY_SCOPE_WORKGROUP);
                if (Ga + 5 < NS) __hip_atomic_fetch_add(ir + 5, ps[7], __ATOMIC_RELAXED, __HIP_MEMORY_SCOPE_WORKGROUP);
            }
        }
        if (pass == 0) {
#pragma unroll
            for (int hh = 0; hh < 4; ++hh) { float l = linv[hh]; l += bperm_f(l, lane ^ 16); l += bperm_f(l, lane ^ 32); linv[hh] = l > 0.f ? 1.f / l : 0.f; }
        }
    }
    LDS_WAIT(); asm volatile("" ::: "memory");
    {
        const int cur = tok >> 6; LAS float* sc = IMP + col * 132;
        for (int j = fq * 32; j < fq * 32 + 32; ++j) { const bool forced = (j == 0) || (j == cur) || (j == cur - 1); const float v = sc[j]; sc[j] = forced ? 1e4f : (j <= cur ? v : -1.f); }
        LDS_WAIT(); asm volatile("" ::: "memory");
#pragma unroll 1
        for (int r = 0; r < 8; ++r) {
            float bv = sc[fq * 32]; int bj = fq * 32;
            for (int j = fq * 32 + 1; j < fq * 32 + 32; ++j) { const float v = sc[j]; if (v > bv) { bv = v; bj = j; } }
#pragma unroll
            for (int o = 16; o <= 32; o <<= 1) { const float ov = bperm_f(bv, lane ^ o); const int oj = bperm_i(bj, lane ^ o); if (ov > bv || (ov == bv && oj < bj)) { bv = ov; bj = oj; } }
            if ((bj >> 5) == fq) sc[bj] = -3e38f;
            if (fq == 0) SEL[col * 8 + r] = bj;
            LDS_WAIT(); asm volatile("" ::: "memory");
        }
    }
#pragma unroll
    for (int hh = 0; hh < 4; ++hh) { const float g0 = gate[hh * 3 + 0] * linv[hh];
#pragma unroll
        for (int mt = 0; mt < 4; ++mt) { const f32x4 o = O[hh][mt] * g0; v2u w; w.x = cvt_pk_bf16(o[0], o[1]); w.y = cvt_pk_bf16(o[2], o[3]);
            *(LAS v2u*)(OS + (col * 4 + hh) * 64 + 16 * mt + 4 * fq) = w; } }
    LDS_WAIT(); asm volatile("" ::: "memory");
    const int cur = t0 >> 6;
    {
        const bf16* kwb = WSP(bf16, WS_KW8) + (size_t)bg * 8 * SEQ * 8; const bf16* vwb = VwT + (size_t)bg * 64 * SEQ;
        const bf16* ksb = WSP(bf16, WS_KS8) + (size_t)bg * 8 * SEQ * 8; const bf16* vsb = VsT + (size_t)bg * 64 * SEQ;
        int kst = t0 - (WINDOW - 1); if (kst < 0) kst = 0; kst &= ~31;
        const int nwin = ((t0 + 15 - kst) >> 5) + 1, nfb = cur >= 2 ? 3 : cur + 1;
#pragma unroll 1
        for (int part = 0; part < 2; ++part) {
            float lw[4] = {0.f, 0.f, 0.f, 0.f};
#pragma unroll
            for (int hh = 0; hh < 4; ++hh)
#pragma unroll
                for (int mt = 0; mt < 4; ++mt) O[hh][mt] = z4;
            const bf16* kb = part ? ksb : kwb; const bf16* vb = part ? vsb : vwb;
            const int nchk = part ? 2 * nfb : nwin;
#pragma unroll 1
            for (int ci = 0; ci < nchk; ++ci) {
                asm volatile("" ::: "memory");
                int k0;
                if (part == 0) k0 = kst + 32 * ci; else { const int fb = ci >> 1, j = fb == 0 ? 0 : (fb == 1 ? cur : cur - 1); k0 = 64 * j + 32 * (ci & 1); }
                bf16x8_t ka[2][2], va[4];
#pragma unroll
                for (int tl = 0; tl < 2; ++tl)
#pragma unroll
                    for (int ks = 0; ks < 2; ++ks) ka[tl][ks] = ldg8(kb + ((size_t)(4 * ks + fq) * SEQ + k0 + 16 * tl + col) * 8);
#pragma unroll
                for (int mt = 0; mt < 4; ++mt) va[mt] = ldg8(vb + ((size_t)((k0 >> 3) + fq) * 64 + 16 * mt + col) * 8);
                const int lowk = part ? -1 : tok - WINDOW; const bool dfull = (k0 + 31 <= t0) && (part || k0 > t0 + 15 - WINDOW);
#pragma unroll
                for (int hh = 0; hh < 4; ++hh) {
                    const bf16x8_t q0_ = Qc(hh, 0), q1_ = Qc(hh, 1);
                    f32x4 sa = MFMA16(ka[0][0], q0_, z4); sa = MFMA16(ka[0][1], q1_, sa);
                    f32x4 sb = MFMA16(ka[1][0], q0_, z4); sb = MFMA16(ka[1][1], q1_, sb);
#pragma unroll
                    for (int i = 0; i < 4; ++i) { sa[i] = __builtin_amdgcn_exp2f(sa[i]); sb[i] = __builtin_amdgcn_exp2f(sb[i]); }
                    if (!dfull) {
#pragma unroll
                        for (int i = 0; i < 4; ++i) { const int kt = k0 + 4 * fq + i; sa[i] = (kt <= tok && kt > lowk) ? sa[i] : 0.f; sb[i] = (kt + 16 <= tok && kt + 16 > lowk) ? sb[i] : 0.f; } }
                    lw[hh] += (sa[0] + sa[1]) + (sa[2] + sa[3]) + (sb[0] + sb[1]) + (sb[2] + sb[3]);
                    const bf16x8_t pt = pack_p(sa, sb);
#pragma unroll
                    for (int mt = 0; mt < 4; ++mt) O[hh][mt] = MFMA16(va[mt], pt, O[hh][mt]);
                }
            }
            LDS_WAIT(); asm volatile("" ::: "memory");
            if (part == 0) {
#pragma unroll
                for (int hh = 0; hh < 4; ++hh) { float l = lw[hh]; l += bperm_f(l, lane ^ 16); l += bperm_f(l, lane ^ 32); const float w = l > 0.f ? gate[hh * 3 + 2] / l : 0.f;
#pragma unroll
                    for (int mt = 0; mt < 4; ++mt) { LAS v2u* dp = (LAS v2u*)(OS + (col * 4 + hh) * 64 + 16 * mt + 4 * fq); const v2u old = *dp;
                        v2u w2; w2.x = cvt_pk_bf16(blo(old.x) + w * O[hh][mt][0], bhi(old.x) + w * O[hh][mt][1]); w2.y = cvt_pk_bf16(blo(old.y) + w * O[hh][mt][2], bhi(old.y) + w * O[hh][mt][3]); *dp = w2; } }
            } else {
                LAS bf16* OF = (LAS bf16*)(wl + AW_QS); LAS float* LF = (LAS float*)(wl + AW_IMP + 8192);
#pragma unroll
                for (int hh = 0; hh < 4; ++hh) { float l = lw[hh]; l += bperm_f(l, lane ^ 16); l += bperm_f(l, lane ^ 32); if (fq == 0) LF[col * 4 + hh] = l;
#pragma unroll
                    for (int mt = 0; mt < 4; ++mt) { v2u w2; w2.x = cvt_pk_bf16(O[hh][mt][0], O[hh][mt][1]); w2.y = cvt_pk_bf16(O[hh][mt][2], O[hh][mt][3]); *(LAS v2u*)(OF + (col * 4 + hh) * 64 + 16 * mt + 4 * fq) = w2; } }
            }
            LDS_WAIT(); asm volatile("" ::: "memory");
        }
    }
    {
        const bf16* ksb = WSP(bf16, WS_KS8) + (size_t)bg * 8 * SEQ * 8; const bf16* vsb = VsT + (size_t)bg * 64 * SEQ;
        const LAS bf16* OF = (const LAS bf16*)(wl + AW_QS); const LAS float* LF = (const LAS float*)(wl + AW_IMP + 8192);
#pragma unroll 1
        for (int tt = 0; tt < 16; ++tt) {
            const int tq = t0 + tt; const size_t qrow = (size_t)b * SEQ + tq;
            bf16x8_t Qh[2];
#pragma unroll
            for (int ks = 0; ks < 2; ++ks) { Qh[ks] = ldg8(QB + qrow * LDQ + (g * 4 + (col & 3)) * 64 + ks * 32 + fq * 8); if (col >= 4) Qh[ks] = (bf16x8_t){0, 0, 0, 0, 0, 0, 0, 0}; }
            f32x4 Os[4] = {z4, z4, z4, z4}; float ls = 0.f;
#ifdef APROBE_SEL
            for (int rp = 0; rp < 2; ++rp) { Os[0] = z4; Os[1] = z4; Os[2] = z4; Os[3] = z4; ls = 0.f; asm volatile("" ::: "memory");
#endif
#pragma unroll 1
            for (int r8 = 0; r8 < 8; ++r8) {
                const int j = __builtin_amdgcn_readfirstlane(SEL[tt * 8 + r8]);
                if (64 * j > tq || j == 0 || j == cur || j == cur - 1) continue;
                const int kb0 = 64 * j;
                bf16x8_t ka[2][2][2], va[2][4];
#pragma unroll
                for (int hf = 0; hf < 2; ++hf) {
#pragma unroll
                    for (int tl = 0; tl < 2; ++tl)
#pragma unroll
                        for (int ks = 0; ks < 2; ++ks) ka[hf][tl][ks] = ldg8(ksb + ((size_t)(4 * ks + fq) * SEQ + kb0 + 32 * hf + 16 * tl + col) * 8);
#pragma unroll
                    for (int mt = 0; mt < 4; ++mt) va[hf][mt] = ldg8(vsb + ((size_t)(((kb0 + 32 * hf) >> 3) + fq) * 64 + 16 * mt + col) * 8);
                }
#pragma unroll
                for (int hf = 0; hf < 2; ++hf) {
                    f32x4 sa = MFMA16(ka[hf][0][0], Qh[0], z4); sa = MFMA16(ka[hf][0][1], Qh[1], sa);
                    f32x4 sb = MFMA16(ka[hf][1][0], Qh[0], z4); sb = MFMA16(ka[hf][1][1], Qh[1], sb);
#pragma unroll
                    for (int i = 0; i < 4; ++i) { sa[i] = __builtin_amdgcn_exp2f(sa[i]); sb[i] = __builtin_amdgcn_exp2f(sb[i]); }
                    ls += (sa[0] + sa[1]) + (sa[2] + sa[3]) + (sb[0] + sb[1]) + (sb[2] + sb[3]);
                    const bf16x8_t pt = pack_p(sa, sb);
#pragma unroll
                    for (int mt = 0; mt < 4; ++mt) Os[mt] = MFMA16(va[hf][mt], pt, Os[mt]);
                }
            }
#ifdef APROBE_SEL
            }
#endif
            ls += bperm_f(ls, lane ^ 16); ls += bperm_f(ls, lane ^ 32);
            if (col < 4) {
                const float den = ls + LF[tt * 4 + col]; const float w = den > 0.f ? (NG + qrow * 24 + g * 12)[col * 3 + 1] / den : 0.f;
#pragma unroll
                for (int mt = 0; mt < 4; ++mt) { const int e = (tt * 4 + col) * 64 + 16 * mt + 4 * fq; const v2u old = *(const LAS v2u*)(OS + e), fo = *(const LAS v2u*)(OF + e);
                    v2u w2; w2.x = cvt_pk_bf16(blo(old.x) + w * (Os[mt][0] + blo(fo.x)), bhi(old.x) + w * (Os[mt][1] + bhi(fo.x))); w2.y = cvt_pk_bf16(blo(old.y) + w * (Os[mt][2] + blo(fo.y)), bhi(old.y) + w * (Os[mt][3] + bhi(fo.y)));
                    *(v2u*)(QB + qrow * LDQ + (g * 4 + col) * 64 + 16 * mt + 4 * fq) = w2; }
            }
        }
    }
    LDS_WAIT(); asm volatile("" ::: "memory");
#undef Qc
}

typedef _Float16 h16x2 __attribute__((ext_vector_type(2)));
__device__ __forceinline__ h16x2 as_h2(unsigned u) { h16x2 r; __builtin_memcpy(&r, &u, 4); return r; }
constexpr int SC_STEPS = 8, SC_BUF = 6 * 1024;
__device__ __forceinline__ float dpp_sum16(float v) {
    v += __builtin_bit_cast(float, __builtin_amdgcn_update_dpp(0, __builtin_bit_cast(int, v), 0xB1, 0xF, 0xF, true));
    v += __builtin_bit_cast(float, __builtin_amdgcn_update_dpp(0, __builtin_bit_cast(int, v), 0x4E, 0xF, 0xF, true));
    v += __builtin_bit_cast(float, __builtin_amdgcn_update_dpp(0, __builtin_bit_cast(int, v), 0x141, 0xF, 0xF, true));
    v += __builtin_bit_cast(float, __builtin_amdgcn_update_dpp(0, __builtin_bit_cast(int, v), 0x140, 0xF, 0xF, true));
    return v;
}
__device__ __forceinline__ void scan_fill(const bf16* RW, const bf16* Wm, const bf16* Am, size_t trow, int h, int lane, LAS unsigned char* buf) {
    const size_t t = trow + (lane >> 3); const int sub = (lane & 7) * 8;
    const bf16* row = RW + t * LDRW + h * 64 + sub;
    __builtin_amdgcn_global_load_lds((const unsigned*)(row + LBLK), (LAS unsigned*)(buf + 0 * 1024), 16, 0, 0);
    __builtin_amdgcn_global_load_lds((const unsigned*)(Am + t * RC + h * 64 + sub), (LAS unsigned*)(buf + 1 * 1024), 16, 0, 0);
    __builtin_amdgcn_global_load_lds((const unsigned*)(Wm + t * RC + h * 64 + sub), (LAS unsigned*)(buf + 2 * 1024), 16, 0, 0);
    __builtin_amdgcn_global_load_lds((const unsigned*)(row + 512), (LAS unsigned*)(buf + 3 * 1024), 16, 0, 0);
    __builtin_amdgcn_global_load_lds((const unsigned*)(row), (LAS unsigned*)(buf + 4 * 1024), 16, 0, 0);
    __builtin_amdgcn_global_load_lds((const unsigned*)(row + 1024), (LAS unsigned*)(buf + 5 * 1024), 16, 0, 0);
}
__device__ __forceinline__ void scan_unit(const P& p, int unit, int lane, LAS unsigned char* wl) {
    const bf16* RW = WSP(bf16, AR_RW); const bf16* Wm = WSP(bf16, AR_W); const bf16* Am = WSP(bf16, AR_A); bf16* Y = WSP(bf16, AR_UB);
    const int rg = unit & 15, h = (unit >> 4) & 7, b = unit >> 7, row = rg * 4 + (lane >> 4), kq = lane & 15;
    const size_t tb = (size_t)b * SEQ;
    float s0 = 0.f, s1 = 0.f, s2 = 0.f, s3 = 0.f;
    __builtin_amdgcn_s_setprio(3);
    scan_fill(RW, Wm, Am, tb, h, lane, wl);
#pragma unroll 1
    for (int c = 0; c < SEQ / SC_STEPS; ++c) {
        LAS unsigned char* buf = wl + (c & 1) * SC_BUF;
        asm volatile("s_waitcnt vmcnt(0) lgkmcnt(0)" ::: "memory");
        if (c + 1 < SEQ / SC_STEPS) scan_fill(RW, Wm, Am, tb + (size_t)(c + 1) * SC_STEPS, h, lane, wl + ((c + 1) & 1) * SC_BUF);
#ifndef SCAN_VARB
        float ys[SC_STEPS];
#pragma unroll
        for (int st = 0; st < SC_STEPS; ++st) {
            const LAS unsigned char* o = buf + st * 128 + kq * 8;
            const v2u kkw = *(const LAS v2u*)(o), bbw = *(const LAS v2u*)(o + 1024), eew = *(const LAS v2u*)(o + 2048), ktw = *(const LAS v2u*)(o + 3072), rrw = *(const LAS v2u*)(o + 4096);
#ifdef SCAN_BF16
            struct F2 { float x, y; }; const F2 kk0{blo(kkw.x), bhi(kkw.x)}, kk1{blo(kkw.y), bhi(kkw.y)}, bb0{blo(bbw.x), bhi(bbw.x)}, bb1{blo(bbw.y), bhi(bbw.y)}, ee0{blo(eew.x), bhi(eew.x)}, ee1{blo(eew.y), bhi(eew.y)}, kt0{blo(ktw.x), bhi(ktw.x)}, kt1{blo(ktw.y), bhi(ktw.y)}, rr0{blo(rrw.x), bhi(rrw.x)}, rr1{blo(rrw.y), bhi(rrw.y)};
            const float vv = bf2f(*(const LAS unsigned short*)(buf + 5 * 1024 + st * 128 + row * 2));
#else
            const h16x2 kk0 = as_h2(kkw.x), kk1 = as_h2(kkw.y), bb0 = as_h2(bbw.x), bb1 = as_h2(bbw.y);
            const h16x2 ee0 = as_h2(eew.x), ee1 = as_h2(eew.y);
#ifdef RKV_BF16
            struct F2 { float x, y; }; const F2 kt0{blo(ktw.x), bhi(ktw.x)}, kt1{blo(ktw.y), bhi(ktw.y)}, rr0{blo(rrw.x), bhi(rrw.x)}, rr1{blo(rrw.y), bhi(rrw.y)};
            const float vv = bf2f(*(const LAS unsigned short*)(buf + 5 * 1024 + st * 128 + row * 2));
#else
            const h16x2 kt0 = as_h2(ktw.x), kt1 = as_h2(ktw.y);
            const h16x2 rr0 = as_h2(rrw.x), rr1 = as_h2(rrw.y);
            const float vv = (float)__builtin_bit_cast(_Float16, *(const LAS unsigned short*)(buf + 5 * 1024 + st * 128 + row * 2));
#endif
#endif
            float d0 = __builtin_fmaf(s0, (float)kk0.x, 0.f); d0 = __builtin_fmaf(s1, (float)kk0.y, d0); float d1 = __builtin_fmaf(s2, (float)kk1.x, 0.f); d1 = __builtin_fmaf(s3, (float)kk1.y, d1);
            const float nskk = -dpp_sum16(d0 + d1);
            s0 = __builtin_fmaf(s0, -(float)ee0.x, s0); s1 = __builtin_fmaf(s1, -(float)ee0.y, s1); s2 = __builtin_fmaf(s2, -(float)ee1.x, s2); s3 = __builtin_fmaf(s3, -(float)ee1.y, s3);
            s0 = __builtin_fmaf(nskk, (float)bb0.x, s0); s1 = __builtin_fmaf(nskk, (float)bb0.y, s1); s2 = __builtin_fmaf(nskk, (float)bb1.x, s2); s3 = __builtin_fmaf(nskk, (float)bb1.y, s3);
            s0 = __builtin_fmaf(vv, (float)kt0.x, s0); s1 = __builtin_fmaf(vv, (float)kt0.y, s1); s2 = __builtin_fmaf(vv, (float)kt1.x, s2); s3 = __builtin_fmaf(vv, (float)kt1.y, s3);
            float y0 = __builtin_fmaf(s0, (float)rr0.x, 0.f); y0 = __builtin_fmaf(s1, (float)rr0.y, y0); float y1 = __builtin_fmaf(s2, (float)rr1.x, 0.f); y1 = __builtin_fmaf(s3, (float)rr1.y, y1);
            ys[st] = dpp_sum16(y0 + y1);
        }
        if (kq < SC_STEPS) { float yv = ys[0];
#pragma unroll
            for (int st = 1; st < SC_STEPS; ++st) yv = (kq == st) ? ys[st] : yv;
            Y[(tb + (size_t)c * SC_STEPS + kq) * RC + h * 64 + row] = f2bf(yv); }
    }
#else
#pragma unroll
        for (int st = 0; st < SC_STEPS; ++st) {
            const LAS unsigned char* o = buf + st * 128 + kq * 8;
            float kk[4], bb[4], ee[4], kt[4], rr[4];
            { const v2u w = *(const LAS v2u*)(o); const h16x2 a = as_h2(w.x), b2 = as_h2(w.y); kk[0] = (float)a.x; kk[1] = (float)a.y; kk[2] = (float)b2.x; kk[3] = (float)b2.y; }
            { const v2u w = *(const LAS v2u*)(o + 1024); const h16x2 a = as_h2(w.x), b2 = as_h2(w.y); bb[0] = (float)a.x; bb[1] = (float)a.y; bb[2] = (float)b2.x; bb[3] = (float)b2.y; }
            { const v2u w = *(const LAS v2u*)(o + 2048); const h16x2 a = as_h2(w.x), b2 = as_h2(w.y); ee[0] = (float)a.x; ee[1] = (float)a.y; ee[2] = (float)b2.x; ee[3] = (float)b2.y; }
            { const v2u w = *(const LAS v2u*)(o + 3072); const h16x2 a = as_h2(w.x), b2 = as_h2(w.y); kt[0] = (float)a.x; kt[1] = (float)a.y; kt[2] = (float)b2.x; kt[3] = (float)b2.y; }
            { const v2u w = *(const LAS v2u*)(o + 4096); const h16x2 a = as_h2(w.x), b2 = as_h2(w.y); rr[0] = (float)a.x; rr[1] = (float)a.y; rr[2] = (float)b2.x; rr[3] = (float)b2.y; }
            const float vv = (float)__builtin_bit_cast(_Float16, *(const LAS unsigned short*)(buf + 5 * 1024 + st * 128 + row * 2));
            const float skk = dpp_sum16((s0 * kk[0] + s1 * kk[1]) + (s2 * kk[2] + s3 * kk[3]));
            s0 = s0 - s0 * ee[0] - skk * bb[0] + vv * kt[0]; s1 = s1 - s1 * ee[1] - skk * bb[1] + vv * kt[1]; s2 = s2 - s2 * ee[2] - skk * bb[2] + vv * kt[2]; s3 = s3 - s3 * ee[3] - skk * bb[3] + vv * kt[3];
            const float y = dpp_sum16((s0 * rr[0] + s1 * rr[1]) + (s2 * rr[2] + s3 * rr[3]));
            if (kq == 0) Y[(tb + (size_t)c * SC_STEPS + st) * RC + h * 64 + row] = f2bf(y);
        }
    }
#endif
    asm volatile("s_waitcnt vmcnt(0) lgkmcnt(0)" ::: "memory");
    __builtin_amdgcn_s_setprio(0);
}
__device__ __forceinline__ float sum8(float v) {
    v += __builtin_bit_cast(float, __builtin_amdgcn_update_dpp(0, __builtin_bit_cast(int, v), 0xB1, 0xF, 0xF, true));
    v += __builtin_bit_cast(float, __builtin_amdgcn_update_dpp(0, __builtin_bit_cast(int, v), 0x4E, 0xF, 0xF, true));
    v += __builtin_bit_cast(float, __builtin_amdgcn_update_dpp(0, __builtin_bit_cast(int, v), 0x141, 0xF, 0xF, true));
    return v;
}
__device__ __forceinline__ void up8(v4u w, float* f) { f[0] = blo(w.x); f[1] = bhi(w.x); f[2] = blo(w.y); f[3] = bhi(w.y); f[4] = blo(w.z); f[5] = bhi(w.z); f[6] = blo(w.w); f[7] = bhi(w.w); }
#ifdef SCAN_BF16
#define uph8 up8
#define pkh8 pk8
#else
#define uph8 uph8_
#define pkh8 pkh8_
#endif
__device__ __forceinline__ void uph8_(v4u w, float* f) { const h16x2 a = as_h2(w.x), b = as_h2(w.y), c = as_h2(w.z), d = as_h2(w.w);
    f[0] = (float)a.x; f[1] = (float)a.y; f[2] = (float)b.x; f[3] = (float)b.y; f[4] = (float)c.x; f[5] = (float)c.y; f[6] = (float)d.x; f[7] = (float)d.y; }
__device__ __forceinline__ unsigned pkh2(float lo, float hi) { h16x2 v; v.x = (_Float16)lo; v.y = (_Float16)hi; return __builtin_bit_cast(unsigned, v); }
__device__ __forceinline__ v4u pkh8_(const float* f) { v4u w; w.x = pkh2(f[0], f[1]); w.y = pkh2(f[2], f[3]); w.z = pkh2(f[4], f[5]); w.w = pkh2(f[6], f[7]); return w; }
__device__ __forceinline__ v4u pk8(const float* f) { v4u w; w.x = cvt_pk_bf16(f[0], f[1]); w.y = cvt_pk_bf16(f[2], f[3]); w.z = cvt_pk_bf16(f[4], f[5]); w.w = cvt_pk_bf16(f[6], f[7]); return w; }
__device__ __forceinline__ void ldf8(const float* p, float* f) { const f32x4 a = *(const f32x4*)p, b = *(const f32x4*)(p + 4); f[0] = a[0]; f[1] = a[1]; f[2] = a[2]; f[3] = a[3]; f[4] = b[0]; f[5] = b[1]; f[6] = b[2]; f[7] = b[3]; }

struct EpiLora {
    static constexpr bool PERM = true, AFTER_DRAIN = false;
    unsigned char* ws; int pn0;
    __device__ __forceinline__ void operator()(const f32x4 (&acc)[2][2][4][2], const Unit& u, int wr, int wc, int fr, int fq) const {
        const int pn = u.pn + pn0, which = pn >> 1, row0 = u.pm * BM + wr * 64 + fr, c0 = (pn & 1) * 256 + wc * 32 + 8 * fq;
        bf16* const O = (bf16*)(ws + (which == 0 ? AR_W : (which == 1 ? AR_A : (which == 2 ? AR_G : AR_UB))));
#pragma unroll
        for (int ai = 0; ai < 2; ++ai)
#pragma unroll
            for (int m = 0; m < 4; ++m)
#pragma unroll
                for (int bj = 0; bj < 2; ++bj) *(u32x4*)(O + (size_t)(row0 + ai * HALF + m * 16) * RC + c0 + bj * HALF) = pack8(acc[ai][bj][m][0], acc[ai][bj][m][1]);
    }
};
#ifdef RKV_BF16
#define UPR up8
#define PKR pk8
#else
#define UPR uph8
#define PKR pkh8
#endif
struct B2In { v4u k, a, w, vr, vv, vf; float gt; };
__device__ __forceinline__ void b2w_load(B2In& in, const P& p, int layer, int t, int lane) {
    const bf16* row = WSP(bf16, AR_RW) + (size_t)t * LDRW;
    in.k = *(const v4u*)(row + 512 + 8 * lane); in.a = *(const v4u*)(WSP(bf16, AR_A) + (size_t)t * RC + 8 * lane); in.w = *(const v4u*)(WSP(bf16, AR_W) + (size_t)t * RC + 8 * lane);
    in.gt = lane < 24 ? bf2f(row[LBLK + 320 + lane]) : 0.f;
    if (layer == 1) { in.vr = *(const v4u*)(WSP(bf16, AR_UB) + (size_t)t * RC + 8 * lane); in.vv = *(const v4u*)(row + 1024 + 8 * lane); in.vf = *(const v4u*)(WSP(bf16, WS_VF) + (size_t)t * RC + 8 * lane); }
}
__device__ __forceinline__ void b2w_compute(const B2In& in, const P& p, int layer, int t, int lane, const float* v0, const float* v1, const float* v2, const float* v3, const float* vb) {
    bf16* row = WSP(bf16, AR_RW) + (size_t)t * LDRW; bf16* Am = WSP(bf16, AR_A); bf16* Wm = WSP(bf16, AR_W); float* NG = WSP(float, AR_NG);
    float k[8], a[8], w[8]; uph8(in.k, k); up8(in.a, a); up8(in.w, w);
    const float ngv = fsig(in.gt);
    float kk[8], ss = 0.f;
#pragma unroll
    for (int i = 0; i < 8; ++i) {
        a[i] = fsig(a[i] + v1[i]);
        const float nx = -(w[i] + v0[i]), sp = fmaxf(nx, 0.f) + __logf(1.f + __expf(-fabsf(nx))), e = __expf(-sp - 0.5f); w[i] = 1.f - __expf(-e);
        kk[i] = k[i] * v2[i]; ss += kk[i] * kk[i]; }
    ss = sum8(ss); const float nrm = sqrtf(ss), inv = 1.f / (nrm > 1e-12f ? nrm : 1e-12f);
#pragma unroll
    for (int i = 0; i < 8; ++i) { kk[i] *= inv; k[i] = k[i] * (1.f + (a[i] - 1.f) * v3[i]); a[i] *= kk[i]; }
    asm volatile("" :: "v"(ngv));
    if (layer == 1) { float vr[8], vv[8], vf[8]; up8(in.vr, vr); uph8(in.vv, vv); uph8(in.vf, vf);
#pragma unroll
        for (int i = 0; i < 8; ++i) vv[i] = vv[i] + (vf[i] - vv[i]) * fsig(vr[i] + vb[i]);
        *(v4u*)(row + 1024 + 8 * lane) = pkh8(vv); }
    if (lane < 24) NG[(size_t)t * 24 + lane] = ngv;
    *(v4u*)(row + LBLK + 8 * lane) = pkh8(kk); *(v4u*)(row + 512 + 8 * lane) = pkh8(k);
    *(v4u*)(Am + (size_t)t * RC + 8 * lane) = pkh8(a); *(v4u*)(Wm + (size_t)t * RC + 8 * lane) = pkh8(w);
}
__device__ __forceinline__ void ph_rwkv_b2w(const P& p, int layer, int gw, int NGW, int lane) {
    const float* vec = p.rwkv_vec + (size_t)layer * 7 * RC; float v0[8], v1[8], v2[8], v3[8], vb[8];
    ldf8(vec + 8 * lane, v0); ldf8(vec + RC + 8 * lane, v1); ldf8(vec + 2 * RC + 8 * lane, v2); ldf8(vec + 3 * RC + 8 * lane, v3); ldf8(p.vres_b + 8 * lane, vb);
    int t = gw; if (t >= T) return;
    B2In A, B; b2w_load(A, p, layer, t, lane);
    for (; t < T; t += 2 * NGW) { const int t1 = t + NGW, t2 = t1 + NGW;
        b2w_load(B, p, layer, t1 < T ? t1 : t, lane); b2w_compute(A, p, layer, t, lane, v0, v1, v2, v3, vb);
        if (t1 < T) { b2w_load(A, p, layer, t2 < T ? t2 : t1, lane); b2w_compute(B, p, layer, t1, lane, v0, v1, v2, v3, vb); } }
}
struct PoIn { v4u y, r, k, v, g; };
__device__ __forceinline__ void post_load(PoIn& in, const P& p, int t, int lane) { const bf16* row = WSP(bf16, AR_RW) + (size_t)t * LDRW;
    in.y = *(const v4u*)(WSP(bf16, AR_UB) + (size_t)t * RC + 8 * lane); in.r = *(const v4u*)(row + 8 * lane); in.k = *(const v4u*)(row + 512 + 8 * lane); in.v = *(const v4u*)(row + 1024 + 8 * lane); in.g = *(const v4u*)(WSP(bf16, AR_G) + (size_t)t * RC + 8 * lane); }
__device__ __forceinline__ void post_compute(const PoIn& in, const P& p, int t, int lane, const float* v4_, const float* v5, const float* v6) {
    float y[8], r[8], k[8], v[8], g[8]; up8(in.y, y); uph8(in.r, r); uph8(in.k, k); uph8(in.v, v); up8(in.g, g);
    float s = 0.f, bon = 0.f;
#pragma unroll
    for (int i = 0; i < 8; ++i) { s += y[i]; bon += r[i] * k[i] * v4_[i]; }
    const float m = sum8(s) * (1.f / 64.f); bon = sum8(bon);
    float q = 0.f;
#pragma unroll
    for (int i = 0; i < 8; ++i) { y[i] -= m; q += y[i] * y[i]; }
    const float rstd = 1.f / sqrtf(sum8(q) * (1.f / 64.f) + GN_EPS);
#pragma unroll
    for (int i = 0; i < 8; ++i) y[i] = (y[i] * rstd * v5[i] + v6[i] + bon * v[i]) * g[i];
    *(v4u*)(WSP(bf16, AR_A) + (size_t)t * RC + 8 * lane) = pk8(y);
}
__device__ __forceinline__ void ph_rwkv_postw(const P& p, int layer, int gw, int NGW, int lane) {
    const float* vec = p.rwkv_vec + (size_t)layer * 7 * RC; float v4_[8], v5[8], v6[8]; ldf8(vec + 4 * RC + 8 * lane, v4_); ldf8(vec + 5 * RC + 8 * lane, v5); ldf8(vec + 6 * RC + 8 * lane, v6);
    int t = gw; if (t >= T) return;
    PoIn A, B; post_load(A, p, t, lane);
    for (; t < T; t += 2 * NGW) { const int t1 = t + NGW, t2 = t1 + NGW;
        post_load(B, p, t1 < T ? t1 : t, lane); post_compute(A, p, t, lane, v4_, v5, v6);
        if (t1 < T) { post_load(A, p, t2 < T ? t2 : t1, lane); post_compute(B, p, t1, lane, v4_, v5, v6); } }
}
__device__ __forceinline__ void tr8x8(v4u& w, unsigned selA, bool b1, bool b2) {
    unsigned r[4] = {w.x, w.y, w.z, w.w};
#pragma unroll
    for (int i = 0; i < 4; ++i) { const unsigned pv = (unsigned)__builtin_amdgcn_update_dpp(0, (int)r[i], 0xB1, 0xF, 0xF, true); r[i] = __builtin_amdgcn_perm(pv, r[i], selA); }
#pragma unroll
    for (int a = 0; a < 4; a += 2) { const unsigned send = b1 ? r[a] : r[a + 1]; const unsigned recv = (unsigned)__builtin_amdgcn_update_dpp(0, (int)send, 0x4E, 0xF, 0xF, true);
        r[a] = b1 ? recv : r[a]; r[a + 1] = b1 ? r[a + 1] : recv; }
#pragma unroll
    for (int a = 0; a < 2; ++a) { const unsigned send = b2 ? r[a] : r[a + 2];
        int recv = __builtin_amdgcn_update_dpp(0, (int)send, 0x104, 0xF, 0x5, false);
        recv = __builtin_amdgcn_update_dpp(recv, (int)send, 0x114, 0xF, 0xA, false);
        r[a] = b2 ? (unsigned)recv : r[a]; r[a + 2] = b2 ? r[a + 2] : (unsigned)recv; }
    w.x = r[0]; w.y = r[1]; w.z = r[2]; w.w = r[3];
}
__device__ __forceinline__ void ph_vtransw(const P& p, int gw, int NGW, int lane_in) {
    int lane = lane_in; asm volatile("" : "+v"(lane));
    const bf16* KV = WSP(bf16, AR_KV); bf16* VsT = WSP(bf16, WS_VST); bf16* VwT = WSP(bf16, WS_VWT);
    const int j = lane & 7, c = lane >> 3; const unsigned selA = (lane & 1) ? 0x03020706u : 0x05040100u; const bool b1 = (lane & 2) != 0, b2 = (lane & 4) != 0;
    constexpr int NU = BATCH * NKV * (SEQ / 8);
    for (int u0 = gw * 4; u0 < NU; u0 += NGW * 4) {
        v4u s[4], w[4];
#pragma unroll
        for (int i = 0; i < 4; ++i) { const int u = u0 + i, kg = u % (SEQ / 8), bg = u / (SEQ / 8), b = bg / NKV, g = bg % NKV, tok = (kg >> 2) * 32 + 4 * (kg & 3) + (j & 3) + 16 * (j >> 2);
            const bf16* src = KV + (size_t)(b * SEQ + tok) * LDKV + g * 64 + 8 * c; s[i] = *(const v4u*)(src + 128); w[i] = *(const v4u*)(src + 384); }
#pragma unroll
        for (int i = 0; i < 4; ++i) { tr8x8(s[i], selA, b1, b2); tr8x8(w[i], selA, b1, b2);
            *(v4u*)(VsT + ((size_t)(u0 + i) * 64 + lane) * 8) = s[i]; *(v4u*)(VwT + ((size_t)(u0 + i) * 64 + lane) * 8) = w[i]; }
    }
}
typedef float f32x2 __attribute__((ext_vector_type(2)));
__device__ __forceinline__ f32x2 up2(unsigned w) { f32x2 r; r.x = __builtin_bit_cast(float, w << 16); r.y = __builtin_bit_cast(float, w & 0xffff0000u); return r; }
template <int JJ>
__device__ __forceinline__ void conv_row(f32x2 (&a)[8][4], f32x2 (&wt)[8][4], v4u (&cur)[8], f32x4& wn0, f32x4& wn1, const LAS float* wlane, const bf16* ub, int g, int j0) {
    const int j = 8 * g + JJ;
    wt[JJ][0] = (f32x2){wn0.x, wn0.y}; wt[JJ][1] = (f32x2){wn0.z, wn0.w}; wt[JJ][2] = (f32x2){wn1.x, wn1.y}; wt[JJ][3] = (f32x2){wn1.z, wn1.w};
    { const int jl = j + 1 < CONV_K ? j + 1 : CONV_K - 1; wn0 = *(const LAS f32x4*)(wlane + jl * CONV_CH); wn1 = *(const LAS f32x4*)(wlane + jl * CONV_CH + 4); }
    const unsigned msk = j >= j0 ? 0xffffffffu : 0u;
    f32x2 u[4]; u[0] = up2(cur[JJ].x & msk); u[1] = up2(cur[JJ].y & msk); u[2] = up2(cur[JJ].z & msk); u[3] = up2(cur[JJ].w & msk);
    { int jn = j + 8; jn = jn < j0 ? j0 : jn; jn = jn > CONV_K + 6 ? CONV_K + 6 : jn; cur[JJ] = *(const v4u*)(ub + (size_t)jn * CONV_CH); }
#pragma unroll
    for (int q = 0; q < 8; ++q) { const int tap = j - q; if (tap >= 0 && tap < CONV_K) {
#pragma unroll
        for (int i = 0; i < 4; ++i) a[q][i] = __builtin_elementwise_fma(u[i], wt[(JJ - q) & 7][i], a[q][i]); } }
}
__device__ __forceinline__ void ph_convw(const P& p, int layer, int gw, int NGW, int lane, int tid, LAS unsigned char* lds) {
    const bf16* UB = WSP(bf16, AR_UB); bf16* CO = WSP(bf16, AR_CO);
    const float* cw = p.conv_w + (size_t)layer * CONV_K * CONV_CH; const float* cv = p.conv_vec + (size_t)layer * 3 * CONV_CH;
    LAS float* wl = (LAS float*)lds;
    { f32x4 tw[8];
#pragma unroll
      for (int k = 0; k < 8; ++k) { const int i4 = tid + k * NTHREADS; tw[k] = i4 < CONV_K * CONV_CH / 4 ? *(const f32x4*)(cw + 4 * i4) : *(const f32x4*)(cv + 4 * (i4 - CONV_K * CONV_CH / 4)); }
      f32x4 tl = (f32x4){0.f, 0.f, 0.f, 0.f}; if (tid < 256) tl = *(const f32x4*)(cv + 4 * (tid + 8 * NTHREADS - CONV_K * CONV_CH / 4));
#pragma unroll
      for (int k = 0; k < 8; ++k) *(LAS f32x4*)(wl + 4 * (tid + k * NTHREADS)) = tw[k];
      if (tid < 256) *(LAS f32x4*)(wl + 4 * (tid + 8 * NTHREADS)) = tl; }
    TKQ(7);
    __syncthreads();
    TKQ(8);
    const LAS float* wlane = wl + 8 * lane;
    for (int tb = gw * 8; tb < T; tb += NGW * 8) {
        const int pos0 = tb % SEQ, j0 = pos0 >= 30 ? 0 : 30 - pos0;
        const bf16* ub = UB + ((size_t)tb * CONV_CH + 8 * lane) - (size_t)30 * CONV_CH;
        f32x2 a[8][4], wt[8][4]; v4u cur[8];
        { const f32x4 c0 = *(const LAS f32x4*)(wlane + CONV_K * CONV_CH), c1 = *(const LAS f32x4*)(wlane + CONV_K * CONV_CH + 4);
#pragma unroll
          for (int q = 0; q < 8; ++q) { a[q][0] = (f32x2){c0.x, c0.y}; a[q][1] = (f32x2){c0.z, c0.w}; a[q][2] = (f32x2){c1.x, c1.y}; a[q][3] = (f32x2){c1.z, c1.w}; } }
#pragma unroll
        for (int jj = 0; jj < 8; ++jj) cur[jj] = *(const v4u*)(ub + (size_t)(jj < j0 ? j0 : jj) * CONV_CH);
        f32x4 wn0 = *(const LAS f32x4*)(wlane), wn1 = *(const LAS f32x4*)(wlane + 4);
#pragma unroll 1
        for (int g = 0; g < 5; ++g) {
            conv_row<0>(a, wt, cur, wn0, wn1, wlane, ub, g, j0); conv_row<1>(a, wt, cur, wn0, wn1, wlane, ub, g, j0); conv_row<2>(a, wt, cur, wn0, wn1, wlane, ub, g, j0); conv_row<3>(a, wt, cur, wn0, wn1, wlane, ub, g, j0);
            conv_row<4>(a, wt, cur, wn0, wn1, wlane, ub, g, j0); conv_row<5>(a, wt, cur, wn0, wn1, wlane, ub, g, j0); conv_row<6>(a, wt, cur, wn0, wn1, wlane, ub, g, j0); conv_row<7>(a, wt, cur, wn0, wn1, wlane, ub, g, j0);
        }
        const f32x4 g10 = *(const LAS f32x4*)(wlane + (CONV_K + 1) * CONV_CH), g11 = *(const LAS f32x4*)(wlane + (CONV_K + 1) * CONV_CH + 4);
        const f32x4 b20 = *(const LAS f32x4*)(wlane + (CONV_K + 2) * CONV_CH), b21 = *(const LAS f32x4*)(wlane + (CONV_K + 2) * CONV_CH + 4);
        const f32x2 g1[4] = {(f32x2){g10.x, g10.y}, (f32x2){g10.z, g10.w}, (f32x2){g11.x, g11.y}, (f32x2){g11.z, g11.w}}, b2[4] = {(f32x2){b20.x, b20.y}, (f32x2){b20.z, b20.w}, (f32x2){b21.x, b21.y}, (f32x2){b21.z, b21.w}};
#pragma unroll
        for (int q = 0; q < 8; ++q) {
            const f32x2 s2 = (a[q][0] + a[q][1]) + (a[q][2] + a[q][3]);
            const float mean = wave_sum(s2.x + s2.y, lane) * (1.f / CONV_CH); f32x2 q2 = (f32x2){0.f, 0.f};
#pragma unroll
            for (int i = 0; i < 4; ++i) { a[q][i] -= (f32x2){mean, mean}; q2 = __builtin_elementwise_fma(a[q][i], a[q][i], q2); }
            const float rstd = 1.f / sqrtf(wave_sum(q2.x + q2.y, lane) * (1.f / CONV_CH) + LN_EPS);
            float y[8];
#pragma unroll
            for (int i = 0; i < 4; ++i) { const f32x2 yy = __builtin_elementwise_fma(a[q][i] * (f32x2){rstd, rstd}, g1[i], b2[i]); y[2 * i] = yy.x * fsig(yy.x); y[2 * i + 1] = yy.y * fsig(yy.y); }
            *(v4u*)(CO + (size_t)(tb + q) * CONV_CH + 8 * lane) = pk8(y);
        }
    }
    TKQ(9);
    __syncthreads();
}
__device__ __forceinline__ void ph_cmp2w(const P& p, int layer, int gw, int NGW, int lane, LAS float* hl  ) {
    const bf16* Z = WSP(bf16, AR_HID); const float* pec = (const float*)(p.ws + WS_W + (size_t)layer * SZ_LAYERW + OFF_PEC);
    for (int it = gw; it < 2 * BATCH * NKV * NC; it += NGW) {
        const int i = it % NC, r = it / NC, bg = r % (BATCH * NKV), which = r / (BATCH * NKV);
        const bf16* z1 = Z + ((size_t)which * (BATCH * NKV * 512) + (size_t)bg * 512 + i) * 256; const bf16* z2 = z1 + 256 + 128;
#pragma unroll
        for (int jj = 0; jj < 2; ++jj) { const int j = lane + 64 * jj; const float x = bf2f(z1[j]) + bf2f(z2[j]) + pec[which * 128 + j];
            const float e = __expf(fminf(2.f * 0.7978845608028654f * (x + 0.044715f * x * x * x), 30.f)); hl[j] = 0.5f * x * (1.f + (e - 1.f) / (e + 1.f)); }
        LDS_WAIT(); asm volatile("" ::: "memory");
        const float* w2 = p.cmp_w2 + (size_t)(layer * 2 + which) * 128 * 64 + lane; float o = 0.f;
#pragma unroll 8
        for (int j = 0; j < 128; ++j) o += hl[j] * w2[j * 64];
        if (which == 0) {
            const float rs = 1.f / sqrtf(wave_sum(o * o, lane) * (1.f / 64.f) + RMS_EPS); o = o * rs * p.qk_g[(layer * 4 + 1) * 64 + lane];
            const float other = bperm_f(o, lane ^ 32); float cs, sn; rope_cs(16 * i + 31, lane & 31, cs, sn);
            o = lane < 32 ? o * cs - other * sn : o * cs + other * sn;
            WSP(bf16, AR_KC)[(((size_t)bg * 8 + (lane >> 3)) * 512 + i) * 8 + (lane & 7)] = f2bf(o);
        } else { bf16* vt = WSP(bf16, AR_VCT) + (size_t)bg * 64 * 512 + lane * 8;
            vt[(size_t)((i >> 5) * 4 + ((i & 15) >> 2)) * 512 + (i & 3) + 4 * ((i >> 4) & 1)] = f2bf(o); if (i == 0) vt[(size_t)((NC >> 5) * 4 + ((NC & 15) >> 2)) * 512 + (NC & 3) + 4 * ((NC >> 4) & 1)] = 0; }
        LDS_WAIT(); asm volatile("" ::: "memory");
    }
}

struct MapPlain { bf16* base; int K; __device__ __forceinline__ bf16* operator()(int col) const { return base + (size_t)col * K; } };
struct MapGlu { bf16* base; int K, ff; __device__ __forceinline__ bf16* operator()(int col) const { return base + (size_t)glu_dest(col, ff) * K; } };
struct MapWin { unsigned char* wl; int layer; __device__ __forceinline__ bf16* operator()(int col) const { int which; const int r = win_dest(col, layer, which); const size_t off = (which ? OFF_WG : OFF_WIN) + (size_t)(r < 0 ? 0 : r) * DM * 2; return r < 0 ? nullptr : (bf16*)(wl + off); } };
template <class Map>
__device__ __forceinline__ void transpose_item(const float* W, int K, int N, const Map& mp, LAS float* scr, int item, int lane) {
    const int nblk = (N + 31) / 32, kb = item / nblk, nb = item % nblk, k0 = 64 * kb, n0 = 32 * nb;
    const int c4 = 4 * (lane & 7), col = n0 + c4;
    f32x4 v[8];
#pragma unroll
    for (int i = 0; i < 8; ++i) v[i] = col < N ? *(const f32x4*)(W + (size_t)(k0 + (lane >> 3) + 8 * i) * N + col) : (f32x4){0.f, 0.f, 0.f, 0.f};
#pragma unroll
    for (int i = 0; i < 8; ++i) { LAS float* d = scr + ((lane >> 3) + 8 * i) * 33 + c4; d[0] = v[i].x; d[1] = v[i].y; d[2] = v[i].z; d[3] = v[i].w; }
    LDS_WAIT(); asm volatile("" ::: "memory");
    const int c = lane & 7;
#pragma unroll
    for (int j = 0; j < 4; ++j) { const int n = (lane >> 3) + 8 * j; const LAS float* s = scr + (8 * c) * 33 + n;
        v4u o; o.x = (unsigned)f2bf(s[0]) | ((unsigned)f2bf(s[33]) << 16); o.y = (unsigned)f2bf(s[66]) | ((unsigned)f2bf(s[99]) << 16);
        o.z = (unsigned)f2bf(s[132]) | ((unsigned)f2bf(s[165]) << 16); o.w = (unsigned)f2bf(s[198]) | ((unsigned)f2bf(s[231]) << 16);
        if (n0 + n < N) { bf16* d = mp(n0 + n); if (d) *(v4u*)(d + k0 + 8 * c) = o; } }
    LDS_WAIT(); asm volatile("" ::: "memory");
}
template <class Map>
__device__ __forceinline__ bool conv_job(int& r, const float* W, int K, int N, const Map& mp, LAS float* scr, int lane) {
    const int items = (K / 64) * ((N + 31) / 32);
    if (r < items) { transpose_item(W, K, N, mp, scr, r, lane); return true; }
    r -= items; return false;
}

struct RmsIn { f32x4 v[DM / 256]; };
__device__ __forceinline__ void rms_load(RmsIn& r, const float* xrow, int lane) { const f32x4* xr = (const f32x4*)xrow + lane;
#pragma unroll
    for (int j = 0; j < DM / 256; ++j) r.v[j] = xr[64 * j]; }
__device__ __forceinline__ void rms_row(const P& p, const RmsIn& rin, const float* g, bf16* orow, int lane, bool route, int t, unsigned long long& c0, unsigned long long& c1) {
    const f32x4* gr = (const f32x4*)g + lane;
    f32x4 v[DM / 256]; float ss = 0.f;
#pragma unroll
    for (int j = 0; j < DM / 256; ++j) { v[j] = rin.v[j]; ss += (v[j].x * v[j].x + v[j].y * v[j].y) + (v[j].z * v[j].z + v[j].w * v[j].w); }
    const float rs = 1.f / sqrtf(wave_sum(ss, lane) * (1.f / DM) + RMS_EPS);
    v2u* o8 = (v2u*)orow + lane;
#pragma unroll
    for (int j = 0; j < DM / 256; ++j) { const f32x4 gg = gr[64 * j]; v[j].x *= rs * gg.x; v[j].y *= rs * gg.y; v[j].z *= rs * gg.z; v[j].w *= rs * gg.w;
        v2u w; w.x = cvt_pk_bf16(v[j].x, v[j].y); w.y = cvt_pk_bf16(v[j].z, v[j].w); o8[64 * j] = w; }
    if (route) {
        float lg[NEXP];
#pragma unroll
        for (int e = 0; e < NEXP; ++e) lg[e] = 0.f;
#pragma unroll
        for (int j = 0; j < DM / 256; ++j) { const float* rw = p.router_w + (size_t)(4 * (lane + 64 * j)) * NEXP;
#pragma unroll
            for (int e = 0; e < NEXP; ++e) lg[e] += v[j].x * rw[e] + v[j].y * rw[NEXP + e] + v[j].z * rw[2 * NEXP + e] + v[j].w * rw[3 * NEXP + e]; }
#pragma unroll
        for (int e = 0; e < NEXP; ++e) lg[e] = wave_sum(lg[e], lane) + p.router_b[e];
        int e0 = 0; float l0 = lg[0];
#pragma unroll
        for (int e = 1; e < NEXP; ++e) if (lg[e] > l0) { l0 = lg[e]; e0 = e; }
        int e1 = -1; float l1 = -3e38f;
#pragma unroll
        for (int e = 0; e < NEXP; ++e) if (e != e0 && lg[e] > l1) { l1 = lg[e]; e1 = e; }
        e0 = __builtin_amdgcn_readfirstlane(e0); e1 = __builtin_amdgcn_readfirstlane(e1);
        const int r0 = (int)((c0 >> (8 * e0)) & 255ull), r1 = (int)((c1 >> (8 * e1)) & 255ull);
        c0 += 1ull << (8 * e0); c1 += 1ull << (8 * e1);
        if (lane == 0) { const float w0 = 1.f / (1.f + expf(l1 - l0));
            WSP(int, AR_RTE)[t] = e0 | (e1 << 8) | (r0 << 16) | (r1 << 24); float* rw = WSP(float, AR_RTW) + (size_t)t * 2; rw[0] = w0; rw[1] = 1.f - w0; }
    }
}
__device__ __forceinline__ void rms_row_route(const P& p, const RmsIn& rin, const float* g, bf16* orow, int lane, int t, unsigned long long& c0, unsigned long long& c1, const float (&rwr)[128]) {
    const f32x4* gr = (const f32x4*)g + lane;
    f32x4 v[DM / 256]; float ss = 0.f;
#pragma unroll
    for (int j = 0; j < DM / 256; ++j) { v[j] = rin.v[j]; ss += (v[j].x * v[j].x + v[j].y * v[j].y) + (v[j].z * v[j].z + v[j].w * v[j].w); }
    const float rs = 1.f / sqrtf(wave_sum(ss, lane) * (1.f / DM) + RMS_EPS);
    v2u* o8 = (v2u*)orow + lane;
#pragma unroll
    for (int j = 0; j < DM / 256; ++j) { const f32x4 gg = gr[64 * j]; v[j].x *= rs * gg.x; v[j].y *= rs * gg.y; v[j].z *= rs * gg.z; v[j].w *= rs * gg.w;
        v2u w; w.x = cvt_pk_bf16(v[j].x, v[j].y); w.y = cvt_pk_bf16(v[j].z, v[j].w); o8[64 * j] = w; }
    float lg[NEXP];
#pragma unroll
    for (int e = 0; e < NEXP; ++e) lg[e] = 0.f;
#pragma unroll
    for (int j = 0; j < DM / 256; ++j)
#pragma unroll
        for (int e = 0; e < NEXP; ++e) lg[e] += v[j].x * rwr[(4 * j) * 8 + e] + v[j].y * rwr[(4 * j + 1) * 8 + e] + v[j].z * rwr[(4 * j + 2) * 8 + e] + v[j].w * rwr[(4 * j + 3) * 8 + e];
    float r4[4], r2[2], r1;
    { const bool hi = (lane & 32) != 0;
#pragma unroll
      for (int i = 0; i < 4; ++i) { const float mine = hi ? lg[4 + i] : lg[i], theirs = hi ? lg[i] : lg[4 + i]; r4[i] = mine + bperm_f(theirs, lane ^ 32); } }
    { const bool hi = (lane & 16) != 0;
#pragma unroll
      for (int i = 0; i < 2; ++i) { const float mine = hi ? r4[2 + i] : r4[i], theirs = hi ? r4[i] : r4[2 + i]; r2[i] = mine + bperm_f(theirs, lane ^ 16); } }
    { const bool hi = (lane & 8) != 0; const float mine = hi ? r2[1] : r2[0], theirs = hi ? r2[0] : r2[1]; r1 = mine + bperm_f(theirs, lane ^ 8); }
    r1 += bperm_f(r1, lane ^ 4); r1 += bperm_f(r1, lane ^ 2); r1 += bperm_f(r1, lane ^ 1);
#pragma unroll
    for (int e = 0; e < NEXP; ++e) lg[e] = __builtin_bit_cast(float, __builtin_amdgcn_readlane(__builtin_bit_cast(int, r1), 8 * e)) + p.router_b[e];
    int e0 = 0; float l0 = lg[0];
#pragma unroll
    for (int e = 1; e < NEXP; ++e) if (lg[e] > l0) { l0 = lg[e]; e0 = e; }
    int e1 = -1; float l1 = -3e38f;
#pragma unroll
    for (int e = 0; e < NEXP; ++e) if (e != e0 && lg[e] > l1) { l1 = lg[e]; e1 = e; }
    e0 = __builtin_amdgcn_readfirstlane(e0); e1 = __builtin_amdgcn_readfirstlane(e1);
    const int r0 = (int)((c0 >> (8 * e0)) & 255ull), r1i = (int)((c1 >> (8 * e1)) & 255ull);
    c0 += 1ull << (8 * e0); c1 += 1ull << (8 * e1);
    if (lane == 0) { const float w0 = 1.f / (1.f + expf(l1 - l0));
        WSP(int, AR_RTE)[t] = e0 | (e1 << 8) | (r0 << 16) | (r1i << 24); float* rw = WSP(float, AR_RTW) + (size_t)t * 2; rw[0] = w0; rw[1] = 1.f - w0; }
}
__device__ __forceinline__ void copy_rows4(const bf16* s0, const bf16* s1, const bf16* s2, const bf16* s3, bf16* d0, bf16* d1, bf16* d2, bf16* d3, int lane) {
    v4u a[4][DM / 512];
#pragma unroll
    for (int j = 0; j < DM / 512; ++j) { a[0][j] = ((const v4u*)s0)[lane + 64 * j]; a[1][j] = ((const v4u*)s1)[lane + 64 * j]; a[2][j] = ((const v4u*)s2)[lane + 64 * j]; a[3][j] = ((const v4u*)s3)[lane + 64 * j]; }
#pragma unroll
    for (int j = 0; j < DM / 512; ++j) { ((v4u*)d0)[lane + 64 * j] = a[0][j]; ((v4u*)d1)[lane + 64 * j] = a[1][j]; ((v4u*)d2)[lane + 64 * j] = a[2][j]; ((v4u*)d3)[lane + 64 * j] = a[3][j]; }
}
__device__ __forceinline__ void copy_row_wave(const bf16* src, bf16* dst, int lane) {
#pragma unroll
    for (int j = 0; j < DM / 512; ++j) ((v4u*)dst)[lane + 64 * j] = ((const v4u*)src)[lane + 64 * j];
}
__device__ __forceinline__ int moe_seg_start(const unsigned* cnt, int e) { int s = 0;
#pragma unroll
    for (int k = 0; k < NEXP; ++k) s += (k < e) ? (int)((cnt[k] + 255u) & ~255u) : 0;
    return s; }

#ifndef STAG_GATE
#define STAG_GATE 700
#endif
__device__ __forceinline__ void stagger_start(int bid, int ticks) {
    const unsigned long long t0 = __builtin_amdgcn_s_memrealtime(), dl = (unsigned long long)(((bid >> 3) & 3) * ticks);
    while (__builtin_amdgcn_s_memrealtime() - t0 < dl) __builtin_amdgcn_s_sleep(16);
}
#ifndef PHMASK
#define PHMASK 0xFFFFFFFFu
#endif
#define PHM(k) (((PHMASK) >> (k)) & 1u)
#ifdef PROBE_LO
constexpr int PR_LO = PROBE_LO, PR_HI = PROBE_HI;
#else
constexpr int PR_LO = -1, PR_HI = -1;
#endif
constexpr int NPH = 16, NPHASES = 1 + 2 * NPH;
struct Args { const float* in[29]; float* out; unsigned char* ws; int ph_lo, ph_hi; };

__device__ __forceinline__ bool in_phase(int k, int lo, int hi) { asm volatile("" : "+s"(lo), "+s"(hi)); return lo <= k && k < hi; }
typedef const Args __attribute__((address_space(4)))* CArgsP;
__device__ __forceinline__ void fill_params_k(P& p, CArgsP a) {
    p.x = a->in[0]; p.mix_norm_g = a->in[1]; p.w_in_first = a->in[2]; p.w_in_rest = a->in[3]; p.mu_first = a->in[4]; p.mu_rest = a->in[5]; p.qk_g = a->in[6]; p.cmp_pos = a->in[7];
    p.cmp_w1 = a->in[8]; p.cmp_w2 = a->in[9]; p.nsa_w_o = a->in[10]; p.conv_w = a->in[11]; p.conv_vec = a->in[12]; p.conv_w_o = a->in[13]; p.rwkv_vec = a->in[14]; p.w_up = a->in[15];
    p.a_up = a->in[16]; p.g_up = a->in[17]; p.vres_up = a->in[18]; p.vres_b = a->in[19]; p.rwkv_w_o = a->in[20]; p.w_out = a->in[21]; p.ffn_norm_g = a->in[22]; p.dense_gu = a->in[23];
    p.dense_down = a->in[24]; p.router_w = a->in[25]; p.router_b = a->in[26]; p.moe_gu = a->in[27]; p.moe_down = a->in[28]; p.out = a->out; p.ws = a->ws;
}
__global__ void __launch_bounds__(NTHREADS, 2) mk_fwd(Args args) {
    extern __shared__ __attribute__((aligned(16))) unsigned char lds_raw[];
    LAS unsigned char* lds = (LAS unsigned char*)lds_raw;
    const int wave0 = __builtin_amdgcn_readfirstlane((int)threadIdx.x >> 6);
    const int tid = wave0 * 64 + lane_id_opaque();
    unsigned* ctl = (unsigned*)(args.ws + WS_CTL);
    for (int u = tid; u < (LDS_BYTES - LDSCTL_OFF) / 4; u += NTHREADS) ((LAS unsigned*)(lds + LDSCTL_OFF))[u] = 0u;
    __syncthreads();
    const int lo = args.ph_lo, hi = args.ph_hi;
    XcdBarrier bar; bar.bar = ctl + CW_BAR; bar.x = 0; bar.st = nullptr;
    if (hi - lo > 1) { bar.x = xb_xcc_id(); bar.st = (volatile LAS unsigned*)(lds + MISC_OFF) + 8; if (tid == 0) (void)xb_add(ctl + CW_BAR + XB_XCNT(bar.x), 1u); }
#define RMS_LOOP(X, GN, ROUTE, C0, C1) do { int m_ = gw; if (m_ < T) { RmsIn ra_, rb_; rms_load(ra_, (X) + (size_t)m_ * DM, lane); \
        for (; m_ < T; m_ += 2 * NGW) { const int m1_ = m_ + NGW, m2_ = m1_ + NGW; rms_load(rb_, (X) + (size_t)(m1_ < T ? m1_ : m_) * DM, lane); \
            rms_row(p, ra_, (GN), WSP(bf16, WS_H) + (size_t)m_ * DM, lane, (ROUTE), m_, C0, C1); \
            if (m1_ < T) { rms_load(ra_, (X) + (size_t)(m2_ < T ? m2_ : m1_) * DM, lane); rms_row(p, rb_, (GN), WSP(bf16, WS_H) + (size_t)m1_ * DM, lane, (ROUTE), m1_, C0, C1); } } } } while (0)
#define RMS_LOOP_R(X, GN, C0, C1, RWR) do { int m_ = gw; if (m_ < T) { RmsIn ra_, rb_; rms_load(ra_, (X) + (size_t)m_ * DM, lane); \
        for (; m_ < T; m_ += 2 * NGW) { const int m1_ = m_ + NGW, m2_ = m1_ + NGW; rms_load(rb_, (X) + (size_t)(m1_ < T ? m1_ : m_) * DM, lane); \
            rms_row_route(p, ra_, (GN), WSP(bf16, WS_H) + (size_t)m_ * DM, lane, m_, C0, C1, RWR); \
            if (m1_ < T) { rms_load(ra_, (X) + (size_t)(m2_ < T ? m2_ : m1_) * DM, lane); rms_row_route(p, rb_, (GN), WSP(bf16, WS_H) + (size_t)m1_ * DM, lane, m1_, C0, C1, RWR); } } } } while (0)
#define IN(k) (in_phase((k), lo, hi) && (PR_LO < 0 || (st == 0 ? (k) <= PR_HI : (st == 1 ? ((k) >= PR_LO && (k) <= PR_HI) : (k) > PR_HI))))
#define MKP unsigned long long cdum0 = 0ull, cdum1 = 0ull; (void)cdum0; (void)cdum1; CArgsP ap_ = (CArgsP)__builtin_amdgcn_kernarg_segment_ptr(); asm volatile("" : "+s"(ap_)); P p; fill_params_k(p, ap_); int w0_ = wave0; asm volatile("" : "+s"(w0_)); int tid = w0_ * 64 + lane_id_opaque(); asm volatile("" : "+v"(tid)); const int lane = tid & 63, wave = __builtin_amdgcn_readfirstlane(tid >> 6); int G = gridDim.x, bid = blockIdx.x; asm volatile("" : "+s"(G), "+s"(bid)); unsigned* ctl = WSP(unsigned, WS_CTL); const long gtid = (long)bid * NTHREADS + tid, NT = (long)G * NTHREADS; const int gw = bid * NWAVES + wave, NGW = G * NWAVES; LAS float* scrw = (LAS float*)(lds + wave * 16384); (void)gtid; (void)NT; (void)gw; (void)NGW; (void)scrw; (void)lane; (void)ctl
#ifdef PROBE_TK
#define TKW(i) do { if (blockIdx.x == PROBE_BLK && threadIdx.x == 0) ((unsigned long long*)(args.ws + WS_CTL + 4 * CW_TK))[(i)] = __builtin_amdgcn_s_memrealtime(); } while (0)
#define TKP(i) do { if (layer == PROBE_LAYER) TKW(i); } while (0)
#define TKB() do { if (layer == PROBE_LAYER && threadIdx.x == 0) ((unsigned long long*)(args.ws + WS_CTL + 4 * CW_TK))[32 + blockIdx.x] = __builtin_amdgcn_s_memrealtime(); } while (0)
#define SEAM(k) do { if ((k) + 1 < hi) { int w_ = wave0; asm volatile("" : "+s"(w_)); xcd_barrier(bar, w_ * 64 + lane_id_opaque()); } \
    if ((k) == PROBE_TK) TKW(1); if ((k) == PROBE_TK - 1) TKW(0); } while (0)
#else
#define TKP(i) do { } while (0)
#define TKB() do { } while (0)
#define SEAM(k) do { if ((k) + 1 < hi) { int w_ = wave0; asm volatile("" : "+s"(w_)); xcd_barrier(bar, w_ * 64 + lane_id_opaque()); } } while (0)
#endif

    for (int st = 0; st < (PR_LO >= 0 ? 3 : 1); ++st) {
    if (PHM(16) && IN(0)) { MKP;
        constexpr int IT_WIN0 = (DM / 64) * ((N_IN_FIRST + 31) / 32), IT_WIN1 = (DM / 64) * ((N_IN_REST + 31) / 32), IT_WO = (512 / 64) * (DM / 32), IT_WOUT = (DM / 64) * (DM / 32);
        constexpr int total = IT_WIN0 + IT_WIN1 + 6 * IT_WO + 2 * IT_WOUT + (DM / 64) * (2 * DENSE_FF / 32) + (DENSE_FF / 64) * (DM / 32);
        bf16* wl0 = WSP(bf16, WS_W); bf16* wl1 = WSP(bf16, WS_W + SZ_LAYERW);
#define WOFF(b, o) ((bf16*)((unsigned char*)(b) + (o)))
        for (int it = gw; it < total; it += NGW) {
            int r = it;
            if (conv_job(r, p.w_in_first, DM, N_IN_FIRST, MapWin{(unsigned char*)wl0, 0}, scrw, lane)) continue;
            if (conv_job(r, p.w_in_rest, DM, N_IN_REST, MapWin{(unsigned char*)wl1, 1}, scrw, lane)) continue;
            if (conv_job(r, p.nsa_w_o, 512, DM, MapPlain{WOFF(wl0, OFF_WO3), 512}, scrw, lane)) continue;
            if (conv_job(r, p.rwkv_w_o, 512, DM, MapPlain{WOFF(wl0, OFF_WO3) + (size_t)DM * 512, 512}, scrw, lane)) continue;
            if (conv_job(r, p.conv_w_o, 512, DM, MapPlain{WOFF(wl0, OFF_WO3) + (size_t)2 * DM * 512, 512}, scrw, lane)) continue;
            if (conv_job(r, p.nsa_w_o + (size_t)512 * DM, 512, DM, MapPlain{WOFF(wl1, OFF_WO3), 512}, scrw, lane)) continue;
            if (conv_job(r, p.rwkv_w_o + (size_t)512 * DM, 512, DM, MapPlain{WOFF(wl1, OFF_WO3) + (size_t)DM * 512, 512}, scrw, lane)) continue;
            if (conv_job(r, p.conv_w_o + (size_t)512 * DM, 512, DM, MapPlain{WOFF(wl1, OFF_WO3) + (size_t)2 * DM * 512, 512}, scrw, lane)) continue;
            if (conv_job(r, p.w_out, DM, DM, MapPlain{WOFF(wl0, OFF_WOUT), DM}, scrw, lane)) continue;
            if (conv_job(r, p.w_out + (size_t)DM * DM, DM, DM, MapPlain{WOFF(wl1, OFF_WOUT), DM}, scrw, lane)) continue;
            if (conv_job(r, p.dense_gu, DM, 2 * DENSE_FF, MapGlu{WSP(bf16, WS_DGU), DM, DENSE_FF}, scrw, lane)) continue;
            conv_job(r, p.dense_down, DENSE_FF, DM, MapPlain{WSP(bf16, WS_DDN), DENSE_FF}, scrw, lane);
        }
        for (int l = 0; l < 2; ++l) {
            unsigned char* wlb = p.ws + WS_W + (size_t)l * SZ_LAYERW;
            bf16* win = (bf16*)(wlb + OFF_WIN);
            for (long i = gtid; i < 512L * DM; i += NT) { const int w = (int)(i / DM); const bool src = w < 288 || (w < 320 && l == 1) || (w >= 320 && w < 344); if (!src) win[(size_t)(3840 + w) * DM + i % DM] = 0; }
            bf16* lw = (bf16*)(wlb + OFF_LW);
            for (long i = gtid; i < 2048L * 384; i += NT) { const int n = (int)(i / 384), k = (int)(i % 384), blk = n >> 9, c = n & 511; float v = 0.f;
                if (blk == 0 && k < 64) v = p.w_up[((size_t)l * 64 + k) * RC + c]; else if (blk == 1 && k >= 64 && k < 128) v = p.a_up[((size_t)l * 64 + k - 64) * RC + c];
                else if (blk == 2 && k >= 128 && k < 288) v = p.g_up[((size_t)l * 160 + k - 128) * RC + c]; else if (blk == 3 && k >= 288 && k < 320 && l == 1) v = p.vres_up[(size_t)(k - 288) * RC + c];
                lw[i] = f2bf(v); }
            bf16* cw1 = (bf16*)(wlb + OFF_CW1);
            for (long i = gtid; i < 2L * 256 * 1024; i += NT) { const int k = (int)(i % 1024), n = (int)((i / 1024) % 256), which = (int)(i / (256 * 1024));
                cw1[i] = f2bf(p.cmp_w1[((size_t)(l * 2 + which) * 2048 + (n < 128 ? k : 1024 + k)) * 128 + (n & 127)]); }
        }
        for (int job = bid; job < 4; job += G) { const int l = job >> 1, which = job & 1;
            const float* pe = p.cmp_pos + (size_t)(l * 2 + which) * 2048; const float* w1 = p.cmp_w1 + (size_t)(l * 2 + which) * 2048 * 128 + 2 * lane;
            float s0 = 0.f, s1 = 0.f;
#pragma unroll 8
            for (int k = wave * 256; k < wave * 256 + 256; ++k) { const float2 wv = *(const float2*)(w1 + (size_t)k * 128); const float pk = pe[k]; s0 += pk * wv.x; s1 += pk * wv.y; }
            scrw[2 * lane] = s0; scrw[2 * lane + 1] = s1;
            __syncthreads();
            if (tid < 128) { float sum = 0.f;
#pragma unroll
                for (int w = 0; w < NWAVES; ++w) sum += ((const LAS float*)(lds + w * 16384))[tid];
                ((float*)(p.ws + WS_W + (size_t)l * SZ_LAYERW + OFF_PEC))[which * 128 + tid] = sum; }
            __syncthreads();
        }
    }

    for (int layer = 0; layer < 2; ++layer) {
        const int pb = 1 + layer * NPH;
        if (PHM(0) && IN(pb + 0)) { MKP;
            const float* xin = layer == 0 ? p.x : p.out;
            RMS_LOOP(xin, p.mix_norm_g + (size_t)layer * DM, false, cdum0, cdum1);
            SEAM(pb + 0);
        }
        if (PHM(1) && IN(pb + 1)) { MKP;
            Gemm g{WSP(bf16, WS_H), (const bf16*)(p.ws + WS_W + (size_t)layer * SZ_LAYERW + OFF_WIN), T, NPROJ, DM}; SOrder S; S.init(T, NPROJ, G, bid);
            EpiProj E{p.ws};
            pg8::gemm_phase<EpiProj, SOrder, true, true>(lds, g, S, E, tid);
            SEAM(pb + 1);
        }
        if (PHM(2) && IN(pb + 2)) { MKP;
            { Gemm g{WSP(bf16, AR_CKV), (const bf16*)(p.ws + WS_W + (size_t)layer * SZ_LAYERW + OFF_CW1), 2 * BATCH * NKV * 512, 512, 1024, 0}; StackOrder S{BATCH * NKV * 512 / 256, 1, 2, G, bid};
              EpiStore E{WSP(bf16, AR_HID), 256, 1};
              pg8::gemm_phase<EpiStore, StackOrder, true, true>(lds, g, S, E, tid); }
            TKP(2); ph_shift(p, layer, gtid, NT); TKP(3); ph_nsa_prep(p, layer, gtid, NT); TKP(4); ph_vtransw(p, gw, NGW, lane); TKP(5);
            ph_convw(p, layer, gw, NGW, lane, tid, lds); TKP(6); TKB();
#ifdef APROBE_CONV
            ph_convw(p, layer, gw, NGW, lane, tid, lds);
#endif
#ifdef APROBE_VT
            ph_vtransw(p, gw, NGW, lane);
#endif
            SEAM(pb + 2); }
        if (PHM(3) && IN(pb + 3)) { MKP;
#ifndef LORA_NAIVE
            { const bf16* LBp = WSP(bf16, WS_LB); const bf16* LWp = (const bf16*)(p.ws + WS_W + (size_t)layer * SZ_LAYERW + OFF_LW);
              { Gemm g{LBp, LWp, T, 1024, 128, 384, 384}; SOrder S; S.init(T, 1024, G, bid); EpiLora E{p.ws, 0}; pg8::gemm_phase<EpiLora, SOrder, false, true>(lds, g, S, E, tid); }
              { Gemm g{LBp + 128, LWp + (size_t)1024 * 384 + 128, T, 512, 256, 384, 384}; SOrder S; S.init(T, 512, G, bid); EpiLora E{p.ws, 4}; pg8::gemm_phase<EpiLora, SOrder, false, true>(lds, g, S, E, tid); }
              if (layer == 1) { Gemm g{LBp + 256, LWp + (size_t)1536 * 384 + 256, T, 512, 128, 384, 384}; SOrder S; S.init(T, 512, G, bid); EpiLora E{p.ws, 6}; pg8::gemm_phase<EpiLora, SOrder, false, true>(lds, g, S, E, tid); } }
#else
            { bf16* RW = WSP(bf16, AR_RW); bf16* Wm = WSP(bf16, AR_W); bf16* Am = WSP(bf16, AR_A); bf16* Gm = WSP(bf16, AR_G); const bf16* VF = WSP(bf16, WS_VF);
              const float* vec = p.rwkv_vec + (size_t)layer * 7 * RC; const float* wup = p.w_up + (size_t)layer * 64 * RC; const float* aup = p.a_up + (size_t)layer * 64 * RC; const float* gup = p.g_up + (size_t)layer * 160 * RC;
              for (long it = gtid; it < (long)T * RC; it += NT) { const int t = (int)(it / RC), c = (int)(it % RC); bf16* row = RW + (size_t)t * LDRW; const bf16* L = row + LBLK;
                  float wl = vec[c], alin = vec[RC + c], g = 0.f;
                  for (int j = 0; j < 64; ++j) { wl += bf2f(L[j]) * bf2f(f2bf(wup[j * RC + c])); alin += bf2f(L[64 + j]) * bf2f(f2bf(aup[j * RC + c])); }
                  for (int j = 0; j < 160; ++j) g += bf2f(L[128 + j]) * bf2f(f2bf(gup[j * RC + c]));
                  const float nx = -wl, sp = fmaxf(nx, 0.f) + __logf(1.f + __expf(-fabsf(nx))), e = __expf(-sp - 0.5f);
                  Wm[it] = f2bf(1.f - __expf(-e)); Am[it] = f2bf(fsig(alin)); Gm[it] = f2bf(g);
                  if (layer == 1) { float vl = p.vres_b[c]; for (int j = 0; j < 32; ++j) vl += bf2f(L[288 + j]) * bf2f(f2bf(p.vres_up[j * RC + c]));
                      const float v = bf2f(row[1024 + c]), vf = bf2f(VF[it]); row[1024 + c] = f2bf(v + (vf - v) * fsig(vl)); } } }
#endif
            SEAM(pb + 3); }
        if (PHM(4) && IN(pb + 4)) { MKP; ph_rwkv_b2w(p, layer, gw, NGW, lane); ph_cmp2w(p, layer, gw, NGW, lane, (LAS float*)(lds + wave * 512)); SEAM(pb + 4); }
        if (PHM(5) && IN(pb + 5)) { MKP;
            { LAS unsigned char* wl = lds + wave * AW_BYTES; constexpr int NSC = BATCH * 8 * 16, NIT = BATCH * NKV * (SEQ / 16);
#ifndef SCAN_QUEUE
              if (wave < 4) {
                  if (G * 4 == NSC && (G & 7) == 0) scan_unit(p, (bid & 7) * (NSC / 8) + (bid >> 3) * 4 + wave, lane, wl);
                  else for (int u = bid * 4 + wave; u < NSC; u += G * 4) scan_unit(p, u, lane, wl); }
#endif
#ifdef APROBE_SPLIT
              xcd_barrier(bar, tid);
#endif
              const int xme = (int)(xb_xcc_id() & 7u);
              for (int qq = 0; qq < 8; ++qq) { const int qx = (xme + qq) & 7; unsigned* head = ctl + CW_ATT + ((layer * 3 + st) * 8 + qx) * 16;
                  for (;;) { int it = 0; if (lane == 0) it = (int)atomicAdd(head, 1u); it = __builtin_amdgcn_readfirstlane(it); if (it >= NIT / 8) break;
                      const int bg = 2 * qx + it / (SEQ / 16), t16 = (SEQ / 16 - 1) - it % (SEQ / 16);
                      nsa_attn_item(p, bg * (SEQ / 16) + t16, lane, wl); } } }
 SEAM(pb + 5); }
        if (PHM(6) && IN(pb + 6)) { MKP; ph_rwkv_postw(p, layer, gw, NGW, lane); SEAM(pb + 6); }
        if (PHM(7) && IN(pb + 7)) { MKP;
            Gemm g{WSP(bf16, AR_QB), (const bf16*)(p.ws + WS_W + (size_t)layer * SZ_LAYERW + OFF_WO3), 3 * T, 3 * DM, 512}; StackOrder S{T / 256, DM / 256, 3, G, bid};
            EpiStore E{WSP(bf16, AR_OBUF), DM, DM / 256};
            pg8::gemm_phase<EpiStore, StackOrder, true, true>(lds, g, S, E, tid);
            { MKP; const float* xin = layer == 0 ? p.x : p.out;
              RMS_LOOP(xin, p.mix_norm_g + (size_t)layer * DM, false, cdum0, cdum1); }
            SEAM(pb + 7);
        }
        if (PHM(8) && IN(pb + 8)) { MKP;
            Gemm g{WSP(bf16, WS_H), (const bf16*)(p.ws + WS_W + (size_t)layer * SZ_LAYERW + OFF_WG), T, 3 * DM, DM}; GateOrder S{T / 256, DM / 256, G, bid};
            EpiGate E{p.ws, DM / 256};
            pg8::gemm_phase<EpiGate, GateOrder, true, true>(lds, g, S, E, tid);
            SEAM(pb + 8);
        }
        if (PHM(9) && IN(pb + 9)) { MKP;
            Gemm g{WSP(bf16, AR_MIX), (const bf16*)(p.ws + WS_W + (size_t)layer * SZ_LAYERW + OFF_WOUT), T, DM, DM}; SOrder S; S.init(T, DM, G, bid);
            EpiResid E{layer == 0 ? p.x : p.out, p.out};
            pg8::gemm_phase<EpiResid, SOrder, true, true>(lds, g, S, E, tid);
            SEAM(pb + 9);
        }
        if (PHM(10) && IN(pb + 10)) { MKP;
            unsigned long long c0 = 0ull, c1 = 0ull;
            if (layer == 1) { float rwr[128];
#pragma unroll
                for (int j = 0; j < DM / 256; ++j)
#pragma unroll
                    for (int k = 0; k < 8; ++k) { const f32x4 w4 = *(const f32x4*)(p.router_w + (size_t)(4 * (lane + 64 * j)) * NEXP + 4 * k); rwr[j * 32 + 4 * k] = w4.x; rwr[j * 32 + 4 * k + 1] = w4.y; rwr[j * 32 + 4 * k + 2] = w4.z; rwr[j * 32 + 4 * k + 3] = w4.w; }
                RMS_LOOP_R(p.out, p.ffn_norm_g + (size_t)layer * DM, c0, c1, rwr);
            } else RMS_LOOP(p.out, p.ffn_norm_g + (size_t)layer * DM, false, c0, c1);
            if (layer == 1 && lane < 16) {
                const unsigned cn = (unsigned)(((lane < 8 ? c0 : c1) >> (8 * (lane & 7))) & 255ull);
                WSP(unsigned, AR_WBASE)[(size_t)gw * 16 + lane] = atomicAdd(ctl + CW_CNT + lane * 64, cn); }
            if (layer == 1) { int* rt = WSP(int, AR_RTOK); for (long i = gtid; i < 2L * MOE_ROWS; i += NT) rt[i] = -1; }
            SEAM(pb + 10);
        }
        if (layer == 0) {
            if (PHM(11) && IN(pb + 11)) { MKP;
                Gemm g{WSP(bf16, WS_H), WSP(bf16, WS_DGU), T, 2 * DENSE_FF, DM}; SOrder S; S.init(T, 2 * DENSE_FF, G, bid);
                EpiSwiglu E{WSP(bf16, AR_ACT), DENSE_FF, 2 * DENSE_FF / 256};
                pg8::gemm_phase<EpiSwiglu, SOrder, true, true>(lds, g, S, E, tid);
                SEAM(pb + 11);
            }
            if (PHM(12) && IN(pb + 12)) { MKP;
                Gemm g{WSP(bf16, AR_ACT), WSP(bf16, WS_DDN), T, DM, DENSE_FF}; SOrder S; S.init(T, DM, G, bid);
                EpiResid E{p.out, p.out};
                pg8::gemm_phase<EpiResid, SOrder, true, true>(lds, g, S, E, tid);
                SEAM(pb + 12);
            }
        } else {
            if (PHM(11) && IN(pb + 11)) { MKP;
                const int ig = (DM / 64) * (2 * EXPERT_FF / 32), id = (EXPERT_FF / 64) * (DM / 32);
                for (int it = gw; it < NEXP * (ig + id); it += NGW) { const int e = it / (ig + id); int r = it % (ig + id);
                    if (conv_job(r, p.moe_gu + (size_t)e * DM * 2 * EXPERT_FF, DM, 2 * EXPERT_FF, MapGlu{WSP(bf16, AR_MGU) + (size_t)e * 2 * EXPERT_FF * DM, DM, EXPERT_FF}, scrw, lane)) continue;
                    conv_job(r, p.moe_down + (size_t)e * EXPERT_FF * DM, EXPERT_FF, DM, MapPlain{WSP(bf16, AR_MDN) + (size_t)e * DM * EXPERT_FF, EXPERT_FF}, scrw, lane); }
                int* rtok = WSP(int, AR_RTOK); float* rww = WSP(float, AR_RW8); int* trow = WSP(int, AR_TROW);
                int segv = 0; { const int pc = lane < 16 ? (int)((ctl[CW_CNT + lane * 64] + 255u) & ~255u) : 0;
#pragma unroll
                    for (int k = 0; k < 8; ++k) { const int ck = bperm_i(pc, (lane & 8) + k); segv += (k < (lane & 7)) ? ck : 0; } }
                for (int hb = gw; hb < 2 * (T / 64); hb += NGW) {
                    const int tb = (hb >> 1) * 64, half = hb & 1, t = tb + lane; const int ee = WSP(int, AR_RTE)[t], e0 = ee & 255, e1 = (ee >> 8) & 255, r0 = (ee >> 16) & 255, r1 = (ee >> 24) & 255;
                    const float* w = WSP(float, AR_RTW) + (size_t)t * 2; const unsigned* wb = WSP(unsigned, AR_WBASE) + (size_t)(t % NGW) * 16;
                    const int row0 = bperm_i(segv, e0) + (int)wb[e0] + r0, row1 = bperm_i(segv, 8 + e1) + (int)wb[8 + e1] + r1;
                    if (half == 0) { rtok[row0] = t; rww[row0] = w[0]; rtok[MOE_ROWS + row1] = t; rww[MOE_ROWS + row1] = w[1]; trow[T + t] = row1; }
                    for (int l = 32 * half; l < 32 * half + 32; l += 4) { const bf16* hs = WSP(bf16, WS_H) + (size_t)(tb + l) * DM; bf16* xg = WSP(bf16, AR_XG);
                        copy_rows4(hs, hs + DM, hs + 2 * DM, hs + 3 * DM, xg + (size_t)__builtin_amdgcn_readlane(row0, l) * DM, xg + (size_t)__builtin_amdgcn_readlane(row0, l + 1) * DM, xg + (size_t)__builtin_amdgcn_readlane(row0, l + 2) * DM, xg + (size_t)__builtin_amdgcn_readlane(row0, l + 3) * DM, lane); }
                }
                SEAM(pb + 11);
            }
#pragma unroll
            for (int pass = 0; pass < 2; ++pass) {
                if (PHM(12) && IN(pb + 12 + 2 * pass)) { MKP;
                    Gemm g{WSP(bf16, AR_XG), WSP(bf16, AR_MGU), MOE_ROWS, NEXP * 2 * EXPERT_FF, DM}; MoeOrder S; S.init(ctl + CW_CNT + 8 * 64 * pass, 2 * EXPERT_FF / 256, G, bid);
                    EpiSwiglu E{WSP(bf16, AR_MACT), EXPERT_FF, 2 * EXPERT_FF / 256};
                    if (pass == 1) {
                        MoeOrder S0; S0.init(ctl + CW_CNT, DM / 256, G, bid); const int nwg = S0.s.nwg, mainw = (nwg / G) * G, ttiles = nwg - mainw;
                        if (bar.st != nullptr && (G & 31) == 0 && mainw > 0 && ttiles > 0 && ttiles <= 32) {
                            EpiMoeDown E0{p.out, WSP(int, AR_RTOK), WSP(float, AR_RW8), DM / 256, (PR_LO >= 0 && st == 0 && pb + 14 >= PR_LO && pb + 14 <= PR_HI) ? 0.f : 1.f};
                            for (int job = wave * G + bid; job < ttiles * 32; job += NWAVES * G) moe_tail_combine(E0, S0, WSP(float, WS_PART), mainw / (DM / 256), job, lane); } }
                    pg8::gemm_phase<EpiSwiglu, MoeOrder, true, true>(lds, g, S, E, tid);
                    SEAM(pb + 12 + 2 * pass);
                }
                if (PHM(13) && IN(pb + 13 + 2 * pass)) { MKP;
                    Gemm g{WSP(bf16, AR_MACT), WSP(bf16, AR_MDN), MOE_ROWS, NEXP * DM, EXPERT_FF}; MoeOrder S; S.init(ctl + CW_CNT + 8 * 64 * pass, DM / 256, G, bid);
                    EpiMoeDown E{p.out, WSP(int, AR_RTOK) + (size_t)pass * MOE_ROWS, WSP(float, AR_RW8) + (size_t)pass * MOE_ROWS, DM / 256, (PR_LO >= 0 && st == 0 && pb + 13 + 2 * pass >= PR_LO && pb + 13 + 2 * pass <= PR_HI) ? 0.f : 1.f};
                    if (pass == 0) { const int* trow = WSP(int, AR_TROW);
                        for (int t = gw * 4; t < T; t += NGW * 4) { const bf16* hs = WSP(bf16, WS_H) + (size_t)t * DM; bf16* xg = WSP(bf16, AR_XG);
                            copy_rows4(hs, hs + DM, hs + 2 * DM, hs + 3 * DM, xg + (size_t)trow[T + t] * DM, xg + (size_t)trow[T + t + 1] * DM, xg + (size_t)trow[T + t + 2] * DM, xg + (size_t)trow[T + t + 3] * DM, lane); } }
                    const int nwg = S.s.nwg, mainw = (nwg / G) * G, ttiles = nwg - mainw; const bool split = bar.st != nullptr && (G & 31) == 0 && mainw > 0 && ttiles > 0 && ttiles <= 32;
                    if (split) S.s.nwg = mainw;
                    pg8::gemm_phase<EpiMoeDown, MoeOrder, true, true>(lds, g, S, E, tid);
                    if (split) { Gemm g2{WSP(bf16, AR_MACT), WSP(bf16, AR_MDN), MOE_ROWS, NEXP * DM, MT_K, EXPERT_FF, EXPERT_FF}; MoeTailOrder S2; S2.init(S, mainw / (DM / 256), ttiles, G, bid);
                        EpiPart E2{WSP(float, WS_PART), mainw / (DM / 256), DM / 256};
                        pg8::gemm_phase<EpiPart, MoeTailOrder, true, true, true>(lds, g2, S2, E2, tid); }
                    if (pass == 1 && split) { { int w_ = wave0; asm volatile("" : "+s"(w_)); xcd_barrier(bar, w_ * 64 + lane_id_opaque()); }
                        for (int job = wave * G + bid; job < ttiles * 32; job += NWAVES * G) moe_tail_combine(E, S, WSP(float, WS_PART), mainw / (DM / 256), job, lane); }
                    SEAM(pb + 13 + 2 * pass);
                }
            }
        }
    }
    }
#ifdef PROBE_TK
    { int w_ = wave0; asm volatile("" : "+s"(w_)); xcd_barrier(bar, w_ * 64 + lane_id_opaque()); }
    if (blockIdx.x == 0 && threadIdx.x == 0) { const unsigned long long* tk = (const unsigned long long*)(args.ws + WS_CTL + 4 * CW_TK); __builtin_amdgcn_fence(__ATOMIC_SEQ_CST, "agent");
#ifndef PROBE_STAT
        args.out[0] += floorf((float)(long long)(tk[PROBE_A1] - tk[PROBE_A0]) * 0.01f / (float)(PROBE_TU)); }
#else
        long long mx = 0, mn = 1ll << 60; for (int b = 0; b < (int)gridDim.x; ++b) { const long long d = (long long)(tk[32 + b] - tk[0]); mx = d > mx ? d : mx; mn = d < mn ? d : mn; }
        int cnt = 0; for (int b = 0; b < (int)gridDim.x; ++b) { const long long d = (long long)(tk[32 + b] - tk[0]); cnt += (mx - d) <= 100ll * PROBE_WIN ? 1 : 0; }
        args.out[0] += PROBE_STAT == 1 ? floorf((float)mx * 0.01f / (float)(PROBE_TU)) : (PROBE_STAT == 2 ? (float)cnt : floorf((float)mn * 0.01f / (float)(PROBE_TU))); }
#endif
#endif
#undef IN
#undef SEAM
}

#ifndef MK_ONE_LAUNCH
#define MK_ONE_LAUNCH 1
#endif
extern "C" void kernel_launch(void* const* d_in, const int* in_sizes, int n_in, void* d_out, int out_size, void* d_ws, size_t ws_size, hipStream_t stream) {
    static int grid = 0;
    if (grid == 0) {
        if (n_in != 29 || in_sizes[0] != T * DM || out_size != T * DM || ws_size < WS_END) { fprintf(stderr, "kernel_launch: unexpected shapes / workspace (%d inputs, ws %zu, need %zu)\n", n_in, ws_size, (size_t)WS_END); grid = -1; return; }
        int dev = 0, cus = 0;
        if (hipGetDevice(&dev) != hipSuccess || hipDeviceGetAttribute(&cus, hipDeviceAttributeMultiprocessorCount, dev) != hipSuccess) { grid = -1; return; }
        if (hipFuncSetAttribute((const void*)mk_fwd, hipFuncAttributeMaxDynamicSharedMemorySize, LDS_BYTES) != hipSuccess) { fprintf(stderr, "kernel_launch: hipFuncSetAttribute failed\n"); grid = -1; return; }
        int per_cu = 0;
        if (hipOccupancyMaxActiveBlocksPerMultiprocessor(&per_cu, (const void*)mk_fwd, NTHREADS, LDS_BYTES) != hipSuccess || per_cu < 1) { fprintf(stderr, "kernel_launch: occupancy query says %d\n", per_cu); }
        (void)hipGetLastError();
        grid = cus;
    }
    if (grid < 0) return;
    if (hipMemsetAsync((char*)d_ws + WS_CTL, 0, CTL_BYTES, stream) != hipSuccess) return;
    Args a{};
    for (int i = 0; i < 29; ++i) a.in[i] = (const float*)d_in[i];
    a.out = (float*)d_out; a.ws = (unsigned char*)d_ws;
#if MK_ONE_LAUNCH
    a.ph_lo = 0; a.ph_hi = NPHASES;
    hipLaunchKernelGGL(mk_fwd, dim3(grid), dim3(NTHREADS), LDS_BYTES, stream, a);
#else
    for (int k = 0; k < NPHASES; ++k) {
        if (k >= 1 + 13 && k < 1 + NPH) continue;
        a.ph_lo = k; a.ph_hi = k + 1;
        hipLaunchKernelGGL(mk_fwd, dim3(grid), dim3(NTHREADS), LDS_BYTES, stream, a);
    }
#endif
}
```

```cpp
#include <hip/hip_runtime.h>
#include <cstdio>
#include <cstdint>
#include <cmath>
#include <cstring>
#ifdef HOST_EMU
#define HD
#define DEV_INLINE inline
#else
#define HD __host__ __device__
#define DEV_INLINE __device__ __forceinline__
#endif

typedef unsigned short bf16;
struct alignas(16) U4 { unsigned x, y, z, w; };

#ifdef SMALL_CFG
constexpr int BATCH = 1, SEQ = 1024, DM = 128, DENSE_FF = 256, EXPERT_FF = 256;
#else
constexpr int BATCH = 8, SEQ = 8192, DM = 1024, DENSE_FF = 2816, EXPERT_FF = 3584;
#endif
constexpr int T = BATCH * SEQ;
constexpr int NHEAD = 8, NKV = 2, HG = 4, DH = 64;
constexpr int NC = SEQ / 16 - 1, NS = SEQ / 64, NSEL = 8, WINDOW = 512;
constexpr int CONV_CH = 512, CONV_K = 31, RC = 512;
constexpr int NEXP = 8;
constexpr int NSA_IN = 1304, OFF_CONV = 1304, OFF_GATE = 2328, OFF_RWKV = OFF_GATE + 3 * DM;
constexpr int N_IN_FIRST = OFF_RWKV + 1824, N_IN_REST = OFF_RWKV + 1856;
constexpr int NPROJ = 4352;
constexpr int LDQ = 512, LDKV = 512, LDRW = 2048, LBLK = 1536;
constexpr int MOE_ROWS = T + NEXP * 256;
constexpr float RMS_EPS = 1e-6f, LN_EPS = 1e-5f, GN_EPS = 64e-5f;

constexpr size_t al(size_t x) { return (x + 255) & ~(size_t)255; }
constexpr size_t WS_CTL = 0, CTL_BYTES = 1u << 20;
constexpr size_t SZ_WIN = (size_t)NPROJ * DM * 2, SZ_WG = (size_t)3 * DM * DM * 2, SZ_WO3 = (size_t)3 * DM * 512 * 2, SZ_WOUT = (size_t)DM * DM * 2;
constexpr size_t SZ_LW = (size_t)2048 * 384 * 2, SZ_CW1 = (size_t)2 * 256 * 1024 * 2, SZ_PEC = 1024;
constexpr size_t SZ_LAYERW = SZ_WIN + SZ_WG + SZ_WO3 + SZ_WOUT + SZ_LW + SZ_CW1 + SZ_PEC;
constexpr size_t WS_W = CTL_BYTES;
constexpr size_t OFF_WIN = 0, OFF_WG = SZ_WIN, OFF_WO3 = OFF_WG + SZ_WG, OFF_WOUT = OFF_WO3 + SZ_WO3, OFF_LW = OFF_WOUT + SZ_WOUT, OFF_CW1 = OFF_LW + SZ_LW, OFF_PEC = OFF_CW1 + SZ_CW1;
constexpr size_t WS_DGU = WS_W + 2 * SZ_LAYERW, SZ_DGU = (size_t)2 * DENSE_FF * DM * 2;
constexpr size_t WS_DDN = WS_DGU + SZ_DGU, SZ_DDN = (size_t)DM * DENSE_FF * 2;
constexpr size_t WS_VF = al(WS_DDN + SZ_DDN), SZ_TC = (size_t)T * 512 * 2;
constexpr size_t WS_H = WS_VF + SZ_TC, SZ_H = (size_t)T * DM * 2;
constexpr size_t WS_PART = WS_VF;
static_assert((size_t)32 * 7 * 65536 * 4 <= SZ_TC, "WS_PART");
constexpr size_t WS_AR = al(WS_H + SZ_H);
constexpr size_t AR_QB = WS_AR, AR_A = AR_QB + SZ_TC, AR_CO = AR_A + SZ_TC;
constexpr size_t AR_KV = AR_CO + SZ_TC, SZ_KV = (size_t)T * LDKV * 2;
constexpr size_t AR_RW = AR_KV + SZ_KV, SZ_RW = (size_t)T * LDRW * 2;
constexpr size_t AR_W = AR_RW + SZ_RW, AR_G = AR_W + SZ_TC, AR_UB = AR_G + SZ_TC;
constexpr size_t AR_NG = AR_UB + SZ_TC, SZ_NG = (size_t)T * 24 * 4;
constexpr size_t AR_HALO = al(AR_NG + SZ_NG), SZ_HALO = (size_t)(T / 256) * LDRW * 2;
constexpr size_t AR_KC = al(AR_HALO + SZ_HALO), SZ_CMP = (size_t)BATCH * NKV * (SEQ / 16) * 64 * 2;
constexpr size_t AR_VC = AR_KC + SZ_CMP;
constexpr size_t AR_HID = al(AR_VC + SZ_CMP), SZ_HID = (size_t)BATCH * NKV * (SEQ / 16) * 2 * 128 * 4;
constexpr size_t AR_SEL = al(AR_HID + SZ_HID), SZ_SEL = (size_t)T * NKV * 8 * 4;
constexpr size_t AR_INVN = al(AR_SEL + SZ_SEL), SZ_INVN = (size_t)T * 8 * 4;
constexpr size_t AR_VCT = al(AR_INVN + SZ_INVN);
constexpr size_t AR_CKV = al(AR_VCT + SZ_CMP), SZ_CKV = (size_t)2 * T * 128;
constexpr size_t AR_END1 = al(AR_CKV + SZ_CKV * 2);
constexpr size_t WS_VST = WS_H, WS_VWT = WS_H + (size_t)T * 128 * 2, WS_LB = WS_VWT + (size_t)T * 128 * 2, WS_KS8 = WS_LB + (size_t)T * 384 * 2, WS_KW8 = WS_KS8 + (size_t)T * 128 * 2;
constexpr size_t AR_OBUF = AR_KV, SZ_OBUF = (size_t)3 * T * DM * 2;
constexpr size_t AR_MIX = AR_OBUF + SZ_OBUF, SZ_MIX = (size_t)T * DM * 2;
constexpr size_t AR_END2 = AR_MIX + SZ_MIX;
constexpr size_t AR_ACT = WS_AR;
constexpr size_t AR_MGU = WS_AR, SZ_MGU = (size_t)NEXP * 2 * EXPERT_FF * DM * 2;
constexpr size_t AR_MDN = AR_MGU + SZ_MGU, SZ_MDN = (size_t)NEXP * DM * EXPERT_FF * 2;
constexpr size_t AR_XG = al(AR_MDN + SZ_MDN), SZ_XG = (size_t)MOE_ROWS * DM * 2;
constexpr size_t AR_MACT = al(AR_XG + SZ_XG), SZ_MACT = (size_t)MOE_ROWS * EXPERT_FF * 2;
constexpr size_t AR_RTOK = al(AR_MACT + SZ_MACT), SZ_RTOK = (size_t)2 * MOE_ROWS * 4;
constexpr size_t AR_RW8 = al(AR_RTOK + SZ_RTOK);
constexpr size_t AR_TROW = al(AR_RW8 + SZ_RTOK), SZ_TROW = (size_t)2 * T * 4;
constexpr size_t AR_RTE = al(AR_TROW + SZ_TROW);
constexpr size_t AR_RTW = al(AR_RTE + (size_t)T * 4);
constexpr size_t AR_WBASE = al(AR_RTW + (size_t)T * 8);
constexpr size_t AR_END3 = al(AR_WBASE + (size_t)4096 * 16 * 4);
constexpr size_t WS_END = (AR_END1 > AR_END2 ? (AR_END1 > AR_END3 ? AR_END1 : AR_END3) : (AR_END2 > AR_END3 ? AR_END2 : AR_END3));
constexpr int CW_CNT = 1024;
constexpr int CW_ATT = 256;
constexpr int CW_BAR = 4096, CW_TK = 8192, CW_CONV = 8256, CW_SINK = 16384;

struct P {
    const float *x, *mix_norm_g, *w_in_first, *w_in_rest, *mu_first, *mu_rest, *qk_g, *cmp_pos, *cmp_w1, *cmp_w2, *nsa_w_o, *conv_w, *conv_vec, *conv_w_o,
        *rwkv_vec, *w_up, *a_up, *g_up, *vres_up, *vres_b, *rwkv_w_o, *w_out, *ffn_norm_g, *dense_gu, *dense_down, *router_w, *router_b, *moe_gu, *moe_down;
    float* out; unsigned char* ws;
};
HD inline void fill_params(P& p, const float* const* in, float* out, unsigned char* ws) {
    p.x = in[0]; p.mix_norm_g = in[1]; p.w_in_first = in[2]; p.w_in_rest = in[3]; p.mu_first = in[4]; p.mu_rest = in[5]; p.qk_g = in[6]; p.cmp_pos = in[7];
    p.cmp_w1 = in[8]; p.cmp_w2 = in[9]; p.nsa_w_o = in[10]; p.conv_w = in[11]; p.conv_vec = in[12]; p.conv_w_o = in[13]; p.rwkv_vec = in[14]; p.w_up = in[15];
    p.a_up = in[16]; p.g_up = in[17]; p.vres_up = in[18]; p.vres_b = in[19]; p.rwkv_w_o = in[20]; p.w_out = in[21]; p.ffn_norm_g = in[22]; p.dense_gu = in[23];
    p.dense_down = in[24]; p.router_w = in[25]; p.router_b = in[26]; p.moe_gu = in[27]; p.moe_down = in[28]; p.out = out; p.ws = ws;
}
#define WSP(type, off) ((type*)(p.ws + (off)))

#ifdef HOST_EMU
#define FENCE()
#else
#define FENCE() asm volatile("" ::: "memory")
#endif
HD inline float bf2f(bf16 v) { unsigned u = (unsigned)v << 16; float f; memcpy(&f, &u, 4); return f; }
HD inline bf16 f2bf(float f) { unsigned u; memcpy(&u, &f, 4); return (bf16)((u + 0x7fffu + ((u >> 16) & 1u)) >> 16); }
HD inline float blo(unsigned v) { unsigned u = v << 16; float f; memcpy(&f, &u, 4); return f; }
HD inline float bhi(unsigned v) { unsigned u = v & 0xffff0000u; float f; memcpy(&f, &u, 4); return f; }
#if !defined(SCAN_BF16) && !defined(RKV_BF16)
HD inline bf16 f2h(float f) { return __builtin_bit_cast(unsigned short, (_Float16)f); }
#else
HD inline bf16 f2bf(float f);
HD inline bf16 f2h(float f) { return f2bf(f); }
#endif
HD inline float h2f(bf16 v) { return (float)__builtin_bit_cast(_Float16, v); }
HD inline float sigmoidf_(float x) { return 1.f / (1.f + expf(-x)); }
HD inline float dot64(const float* q, const bf16* kp) {
    const U4* k4 = (const U4*)kp; float s0 = 0.f, s1 = 0.f;
#pragma unroll
    for (int i = 0; i < 8; ++i) { const U4 v = k4[i];
        s0 += q[8 * i + 0] * blo(v.x) + q[8 * i + 2] * blo(v.y) + q[8 * i + 4] * blo(v.z) + q[8 * i + 6] * blo(v.w);
        s1 += q[8 * i + 1] * bhi(v.x) + q[8 * i + 3] * bhi(v.y) + q[8 * i + 5] * bhi(v.z) + q[8 * i + 7] * bhi(v.w); }
    return s0 + s1;
}
HD inline float dot64p(const U4* q, const bf16* kp) {
    const U4* k4 = (const U4*)kp; float s0 = 0.f, s1 = 0.f;
#pragma unroll
    for (int i = 0; i < 8; ++i) { const U4 v = k4[i], w = q[i];
        s0 += blo(w.x) * blo(v.x) + blo(w.y) * blo(v.y) + blo(w.z) * blo(v.z) + blo(w.w) * blo(v.w);
        s1 += bhi(w.x) * bhi(v.x) + bhi(w.y) * bhi(v.y) + bhi(w.z) * bhi(v.z) + bhi(w.w) * bhi(v.w); }
    return s0 + s1;
}
HD inline void ld64(const bf16* kp, float* q) {
    const U4* k4 = (const U4*)kp;
#pragma unroll
    for (int i = 0; i < 8; ++i) { const U4 v = k4[i]; q[8 * i] = blo(v.x); q[8 * i + 1] = bhi(v.x); q[8 * i + 2] = blo(v.y); q[8 * i + 3] = bhi(v.y);
        q[8 * i + 4] = blo(v.z); q[8 * i + 5] = bhi(v.z); q[8 * i + 6] = blo(v.w); q[8 * i + 7] = bhi(v.w); }
}
HD inline void axpy64(float* o, float w, const bf16* vp) {
    const U4* k4 = (const U4*)vp;
#pragma unroll
    for (int i = 0; i < 8; ++i) { const U4 v = k4[i]; o[8 * i] += w * blo(v.x); o[8 * i + 1] += w * bhi(v.x); o[8 * i + 2] += w * blo(v.y); o[8 * i + 3] += w * bhi(v.y);
        o[8 * i + 4] += w * blo(v.z); o[8 * i + 5] += w * bhi(v.z); o[8 * i + 6] += w * blo(v.w); o[8 * i + 7] += w * bhi(v.w); }
}
HD inline void axpy64s(float* o, float w, const bf16* vp) {
    const U4* k4 = (const U4*)vp;
#pragma unroll
    for (int i = 0; i < 8; ++i) { const U4 v = k4[i]; o[8 * i] = w * o[8 * i] + blo(v.x); o[8 * i + 1] = w * o[8 * i + 1] + bhi(v.x); o[8 * i + 2] = w * o[8 * i + 2] + blo(v.y); o[8 * i + 3] = w * o[8 * i + 3] + bhi(v.y);
        o[8 * i + 4] = w * o[8 * i + 4] + blo(v.z); o[8 * i + 5] = w * o[8 * i + 5] + bhi(v.z); o[8 * i + 6] = w * o[8 * i + 6] + blo(v.w); o[8 * i + 7] = w * o[8 * i + 7] + bhi(v.w); }
}
HD inline void st64(bf16* op, const float* o) {
    U4* o4 = (U4*)op;
#pragma unroll
    for (int i = 0; i < 8; ++i) { U4 v; v.x = (unsigned)f2bf(o[8 * i]) | ((unsigned)f2bf(o[8 * i + 1]) << 16); v.y = (unsigned)f2bf(o[8 * i + 2]) | ((unsigned)f2bf(o[8 * i + 3]) << 16);
        v.z = (unsigned)f2bf(o[8 * i + 4]) | ((unsigned)f2bf(o[8 * i + 5]) << 16); v.w = (unsigned)f2bf(o[8 * i + 6]) | ((unsigned)f2bf(o[8 * i + 7]) << 16); o4[i] = v; }
}

HD inline void rope_cs(int pos, int i, float& cs, float& sn) {
    const float c = exp2f(-(float)i * 0.41524101186092f) * 0.15915494309189535f, pf = (float)pos;
    const float prod = pf * c, err = fmaf(pf, c, -prod), fr = (prod - rintf(prod)) + err;
#ifdef HOST_EMU
    cs = cosf(6.283185307179586f * fr); sn = sinf(6.283185307179586f * fr);
#else
    cs = __builtin_amdgcn_cosf(fr); sn = __builtin_amdgcn_sinf(fr);
#endif
}
HD inline int win_dest(int j, int layer, int& which) {
    which = 0;
    if (j < 1280) return j;
    if (j < 1304) return 3840 + 320 + (j - 1280);
    if (j < 1816) { const int cc = j - 1304; return 1280 + 256 * (cc / 128) + cc % 128; }
    if (j < 2328) { const int cc = j - 1816; return 1280 + 256 * (cc / 128) + 128 + cc % 128; }
    if (j < OFF_RWKV) { which = 1; const int gg = j - OFF_GATE, br = gg / DM; return (br == 0 ? 0 : (br == 1 ? 2 * DM : DM)) + gg % DM; }
    const int rr = j - OFF_RWKV;
    if (rr < 1536) return 2304 + rr;
    if (rr < 1824) return 3840 + (rr - 1536);
    if (rr < 1856 && layer == 1) return 3840 + 288 + (rr - 1824);
    return -1;
}
HD inline int glu_dest(int j, int ff) { return j < ff ? 256 * (j / 128) + j % 128 : 256 * ((j - ff) / 128) + 128 + (j - ff) % 128; }

DEV_INLINE void ph_shift(const P& p, int layer, long gtid, long NT) {
    bf16* RW = WSP(bf16, AR_RW); const bf16* HALO = WSP(bf16, AR_HALO); bf16* VF = WSP(bf16, WS_VF); bf16* LB = WSP(bf16, WS_LB);
    const float* mu = layer == 0 ? p.mu_first : p.mu_rest;
    constexpr int NCP = (LBLK + 384) / 2;
    const long n = (long)(T / 256) * NCP;
    for (long it = gtid; it < n; it += NT) {
        const int pm = (int)(it / NCP), c = 2 * (int)(it % NCP);
        int mi = -1, act = 0;
        if (c < LBLK) mi = c;
        else { const int w = c - LBLK; if (w < 288) { mi = 1536 + w; act = w < 64 ? 1 : (w >= 128 ? 2 : 0); } else if (w < 320 && layer == 1) mi = 1824 + (w - 288); }
        if (mi < 0) { for (int r = 0; r < 256; ++r) *(unsigned*)(LB + ((size_t)pm * 256 + r) * 384 + (c - LBLK)) = 0u; continue; }
        const float m0 = mu[mi], m1 = mu[mi + 1];
        float prev0 = 0.f, prev1 = 0.f;
        if ((pm * 256) % SEQ != 0) { const unsigned hv = *(const unsigned*)(HALO + (size_t)(pm - 1) * LDRW + c); prev0 = blo(hv); prev1 = bhi(hv); }
        bf16* col = RW + (size_t)pm * 256 * LDRW + c;
        for (int r0 = 0; r0 < 256; r0 += 16) {
            unsigned pv[16];
#pragma unroll
            for (int k = 0; k < 16; ++k) pv[k] = *(const unsigned*)(col + (size_t)(r0 + k) * LDRW);
#pragma unroll
            for (int k = 0; k < 16; ++k) { const int r = r0 + k; const float p0 = blo(pv[k]), p1 = bhi(pv[k]);
                float u0 = p0 + (prev0 - p0) * m0, u1 = p1 + (prev1 - p1) * m1; prev0 = p0; prev1 = p1;
                if (act == 1) { u0 = tanhf(u0); u1 = tanhf(u1); } else if (act == 2) { u0 = sigmoidf_(u0); u1 = sigmoidf_(u1); }
                if (c < LBLK) { const unsigned hv = (unsigned)f2h(u0) | ((unsigned)f2h(u1) << 16); *(unsigned*)(col + (size_t)r * LDRW) = hv;
                    if (layer == 0 && c >= 1024) *(unsigned*)(VF + ((size_t)pm * 256 + r) * RC + (c - 1024)) = hv; }
                else *(unsigned*)(LB + ((size_t)pm * 256 + r) * 384 + (c - LBLK)) = (unsigned)f2bf(u0) | ((unsigned)f2bf(u1) << 16); }
        }
    }
}

DEV_INLINE void ph_nsa_prep(const P& p, int layer, long gtid, long NT) {
    bf16* QB = WSP(bf16, AR_QB); bf16* KV = WSP(bf16, AR_KV);
    const long n = (long)T * 12;
    for (long it = gtid; it < n; it += NT) {
        const int t = (int)(it / 12), s = (int)(it % 12), pos = t % SEQ;
        bf16* ptr; const float* g;
        if (s < 8) { ptr = QB + (size_t)t * LDQ + s * 64; g = p.qk_g + (layer * 4 + 0) * 64; }
        else if (s < 10) { ptr = KV + (size_t)t * LDKV + (s - 8) * 64; g = p.qk_g + (layer * 4 + 2) * 64; }
        else { ptr = KV + (size_t)t * LDKV + 256 + (s - 10) * 64; g = p.qk_g + (layer * 4 + 3) * 64; }
        float v[64]; ld64(ptr, v);
        float ss = 0.f;
#pragma unroll
        for (int i = 0; i < 64; ++i) ss += v[i] * v[i];
        const float rs = 1.f / sqrtf(ss * (1.f / 64.f) + RMS_EPS);
#pragma unroll
        for (int i = 0; i < 64; ++i) v[i] = v[i] * rs * g[i];
#pragma unroll
        for (int i = 0; i < 32; ++i) {
            float cs, sn; rope_cs(pos, i, cs, sn);
            const float x1 = v[i], x2 = v[i + 32]; v[i] = x1 * cs - x2 * sn; v[i + 32] = x2 * cs + x1 * sn;
        }
        if (s < 8) {
#pragma unroll
            for (int i = 0; i < 64; ++i) v[i] *= 0.125f * 1.4426950408889634f; }
        if (s < 8) st64(ptr, v);
        else {
            const int gg = (s - 8) & 1, bq = t / SEQ; bf16* k8 = WSP(bf16, s < 10 ? WS_KS8 : WS_KW8) + (size_t)(bq * NKV + gg) * 8 * SEQ * 8;
#pragma unroll
            for (int dg = 0; dg < 8; ++dg) { U4 w; w.x = (unsigned)f2bf(v[8 * dg]) | ((unsigned)f2bf(v[8 * dg + 1]) << 16); w.y = (unsigned)f2bf(v[8 * dg + 2]) | ((unsigned)f2bf(v[8 * dg + 3]) << 16);
                w.z = (unsigned)f2bf(v[8 * dg + 4]) | ((unsigned)f2bf(v[8 * dg + 5]) << 16); w.w = (unsigned)f2bf(v[8 * dg + 6]) | ((unsigned)f2bf(v[8 * dg + 7]) << 16);
                *(U4*)(k8 + ((size_t)dg * SEQ + pos) * 8) = w; } }
    }
}

DEV_INLINE void ph_vtrans(const P& p, long gtid, long NT) {
    const bf16* KV = WSP(bf16, AR_KV); bf16* VsT = WSP(bf16, WS_VST); bf16* VwT = WSP(bf16, WS_VWT);
    const long n = (long)BATCH * NKV * (SEQ / 8) * 64;
    for (long it = gtid; it < n; it += NT) {
        const int d = (int)(it % 64); long r = it / 64; const int kg = (int)(r % (SEQ / 8)); const int bg = (int)(r / (SEQ / 8)), b = bg / NKV, g = bg % NKV;
        const int kbase = (kg >> 2) * 32 + 4 * (kg & 3);
        const bf16* src = KV + (size_t)(b * SEQ + kbase) * LDKV + g * 64 + d;
        U4 s, w; unsigned short sv[8], wv[8];
#pragma unroll
        for (int j = 0; j < 8; ++j) { const size_t ro = (size_t)((j & 3) + 16 * (j >> 2)) * LDKV; sv[j] = src[ro + 128]; wv[j] = src[ro + 384]; }
        s.x = sv[0] | ((unsigned)sv[1] << 16); s.y = sv[2] | ((unsigned)sv[3] << 16); s.z = sv[4] | ((unsigned)sv[5] << 16); s.w = sv[6] | ((unsigned)sv[7] << 16);
        w.x = wv[0] | ((unsigned)wv[1] << 16); w.y = wv[2] | ((unsigned)wv[3] << 16); w.z = wv[4] | ((unsigned)wv[5] << 16); w.w = wv[6] | ((unsigned)wv[7] << 16);
        *(U4*)(VsT + (((size_t)bg * (SEQ / 8) + kg) * 64 + d) * 8) = s; *(U4*)(VwT + (((size_t)bg * (SEQ / 8) + kg) * 64 + d) * 8) = w;
    }
}
namespace pg8 {
#define PG8_LAS __attribute__((address_space(3)))
typedef unsigned short bf16_t;
typedef short bf16x8 __attribute__((ext_vector_type(8)));
typedef float f32x4 __attribute__((ext_vector_type(4)));
typedef unsigned u32x4 __attribute__((ext_vector_type(4)));
constexpr int BM = 256, BK = 64, HALF = 128, HTB = HALF * BK * 2  , STAGE_BYTES = 8 * HTB, NXCD = 8, WGM = 8;

__host__ __device__ __forceinline__ int lds_byte(int r, int c) { const int st = (r >> 4) * 2 + (c >> 5), rr = r & 15, cc = c & 31, ob = rr * 64 + cc * 2; return st * 1024 + (ob ^ (((ob >> 9) & 1) << 5)); }
__host__ __device__ __forceinline__ void stage_rc(int b, int& R, int& C) { const int st = b / 1024, sb = b % 1024, swz = sb ^ (((sb >> 9) & 1) << 5); R = (st >> 1) * 16 + swz / 64; C = (st & 1) * 32 + (swz % 64) / 2; }
__host__ __device__ __forceinline__ int perm32(int rho) { const int n = rho >> 4, i = rho & 15; return 8 * (i >> 2) + 4 * n + (i & 3); }

struct Unit { int pm, pn; };
struct Gemm { const bf16_t* A; const bf16_t* Bt; int M, N, K; int lda; int ldb; };

struct StaticOrder {
    int nM, nN, nwg, G, c;
    __host__ __device__ void init(int M, int N, int G_, int c_) { nM = M / BM; nN = N / BM; nwg = nM * nN; G = G_; c = c_; }
    __host__ __device__ bool next(int i, Unit& u) const {
        const long L = (long)i * G + c; if (L >= nwg) return false;
        int wgid = (int)L; { const int q = nwg / NXCD, r = nwg % NXCD, xcd = wgid % NXCD, off = wgid / NXCD; wgid = (xcd < r ? xcd * (q + 1) : r * (q + 1) + (xcd - r) * q) + off; }
        const int nig = WGM * nN, gid = wgid / nig, fm = gid * WGM, gsz = (nM - fm) < WGM ? (nM - fm) : WGM;
        u.pm = fm + ((wgid % nig) % gsz); u.pn = (wgid % nig) / gsz; return true;
    }
    __device__ __forceinline__ void a_ready(const Unit&) const {}
    __device__ __forceinline__ void done(const Unit&) const {}
};

__device__ __forceinline__ unsigned cvt_pk_bf16(float lo, float hi) { unsigned r; asm volatile("v_cvt_pk_bf16_f32 %0, %1, %2" : "=v"(r) : "v"(lo), "v"(hi)); return r; }
typedef float f32x2 __attribute__((ext_vector_type(2)));
template <class Epi, class Sched, bool ALIGN_EPI = false, bool SP2 = false, bool KSPLIT = false>
__device__ __forceinline__ void gemm_phase(PG8_LAS unsigned char* lds, const Gemm g, const Sched& S, const Epi& E, int tid_in) {
    int tid_ = tid_in; asm volatile("" : "+v"(tid_));
    const int tid = tid_, wid = __builtin_amdgcn_readfirstlane(tid >> 6), lane = tid & 63, wr = wid >> 2, wc = wid & 3, fr = lane & 15, fq = lane >> 4;
    const int K = g.K, nt = K / BK, lda = g.lda ? g.lda : K, ldb = g.ldb ? g.ldb : K;
    unsigned voffA[2], voffB[2];
#pragma unroll
    for (int i = 0; i < 2; ++i) { int R, C; stage_rc(tid * 16 + i * 8192, R, C); const int Rb = Epi::PERM ? ((R & ~31) + perm32(R & 31)) : R;
        voffA[i] = (unsigned)(R * lda + C) * 2u; voffB[i] = (unsigned)(Rb * ldb + C) * 2u; }
    const size_t kstep = (size_t)(BK * 2);
    const size_t hstepA = (size_t)HALF * lda * 2, hstepB = (size_t)HALF * ldb * 2;
    const size_t hstep_unused = (size_t)HALF * K * 2;
    const size_t tstepA = 2 * hstepA, tstepB = 2 * hstepB;
    const unsigned ldsw = (unsigned)wid * 1024u;
    const int aoff = lds_byte(wr * 64 + fr, fq * 8), boff = lds_byte(wc * 32 + fr, fq * 8);
#define PG8_SA(b, h) (((b) * 2 + (h)) * HTB)
#define PG8_SB(b, h) ((4 + (b) * 2 + (h)) * HTB)
#define PG8_STAGE(bufoff, gbase, voff) do { _Pragma("unroll") for (int _i = 0; _i < 2; ++_i) \
        __builtin_amdgcn_global_load_lds((const unsigned*)((const char*)(gbase) + (voff)[_i]), (PG8_LAS unsigned*)(lds + (bufoff) + ldsw + _i * 8192), 16, 0, 0); } while (0)
#define PG8_LDA(dst, b, h) do { _Pragma("unroll") for (int m = 0; m < 4; ++m) _Pragma("unroll") for (int k = 0; k < 2; ++k) dst[m][k] = *(const PG8_LAS bf16x8*)(lds + PG8_SA(b, h) + aoff + m * 2048 + k * 1024); } while (0)
#define PG8_LDB(dst, b, h) do { _Pragma("unroll") for (int n = 0; n < 2; ++n) _Pragma("unroll") for (int k = 0; k < 2; ++k) dst[n][k] = *(const PG8_LAS bf16x8*)(lds + PG8_SB(b, h) + boff + n * 2048 + k * 1024); } while (0)
#define PG8_MMA(ai, bj, At, Bt) do { __builtin_amdgcn_s_setprio(1); _Pragma("unroll") for (int m = 0; m < 4; ++m) _Pragma("unroll") for (int n = 0; n < 2; ++n) _Pragma("unroll") for (int k = 0; k < 2; ++k) \
        acc[ai][bj][m][n] = __builtin_amdgcn_mfma_f32_16x16x32_bf16(Bt[n][k], At[m][k], acc[ai][bj][m][n], 0, 0, 0); __builtin_amdgcn_s_setprio(0); } while (0)
#define PG8_WAIT_V(n) asm volatile("s_waitcnt vmcnt(" #n ")" ::: "memory")
#define PG8_WAIT_L(n) asm volatile("s_waitcnt lgkmcnt(" #n ")" ::: "memory")
#define PG8_BAR __builtin_amdgcn_s_barrier()
#define PG8_SCHED __builtin_amdgcn_sched_barrier(0)
    Unit cur, nxt; int ui = 0;
    if (!S.next(0, cur)) return;
    f32x4 acc[2][2][4][2];
#pragma unroll
    for (int a = 0; a < 2; ++a)
#pragma unroll
        for (int b = 0; b < 2; ++b)
#pragma unroll
            for (int m = 0; m < 4; ++m)
#pragma unroll
                for (int n = 0; n < 2; ++n) acc[a][b][m][n] = (f32x4){0.f, 0.f, 0.f, 0.f};
    bf16x8 At[4][2], B0[2][2], B1[2][2];
    const char* cA = (const char*)g.A + (size_t)cur.pm * tstepA + (KSPLIT ? (size_t)(cur.pn >> 16) * K * 2 : 0); const char* cB = (const char*)g.Bt + (size_t)(KSPLIT ? (cur.pn & 0xffff) : cur.pn) * tstepB + (KSPLIT ? (size_t)(cur.pn >> 16) * K * 2 : 0);
    S.a_ready(cur);
    if constexpr (SP2) {
        PG8_STAGE(PG8_SB(0, 0), cB, voffB); PG8_STAGE(PG8_SB(0, 1), cB + hstepB, voffB); PG8_STAGE(PG8_SA(0, 0), cA, voffA); PG8_STAGE(PG8_SA(0, 1), cA + hstepA, voffA);
        if (wr == 1) PG8_BAR;
        PG8_WAIT_V(2); PG8_BAR;
        PG8_STAGE(PG8_SB(1, 0), cB + kstep, voffB); PG8_STAGE(PG8_SA(1, 0), cA + kstep, voffA); PG8_STAGE(PG8_SB(1, 1), cB + hstepB + kstep, voffB);
        PG8_WAIT_V(6); PG8_BAR;
    } else {
        PG8_STAGE(PG8_SB(0, 0), cB, voffB); PG8_STAGE(PG8_SA(0, 0), cA, voffA); PG8_STAGE(PG8_SB(0, 1), cB + hstepB, voffB); PG8_STAGE(PG8_SA(0, 1), cA + hstepA, voffA);
        if (wr == 1) PG8_BAR;
        PG8_WAIT_V(4); PG8_BAR;
        PG8_STAGE(PG8_SB(1, 0), cB + kstep, voffB); PG8_STAGE(PG8_SA(1, 0), cA + kstep, voffA); PG8_STAGE(PG8_SB(1, 1), cB + hstepB + kstep, voffB);
        PG8_WAIT_V(6); PG8_BAR;
    }
    for (;;) {
        const bool has_next = S.next(ui + 1, nxt);
        const char* nA = has_next ? (const char*)g.A + (size_t)nxt.pm * tstepA + (KSPLIT ? (size_t)(nxt.pn >> 16) * K * 2 : 0) : cA; const char* nB = has_next ? (const char*)g.Bt + (size_t)(KSPLIT ? (nxt.pn & 0xffff) : nxt.pn) * tstepB + (KSPLIT ? (size_t)(nxt.pn >> 16) * K * 2 : 0) : cB;
        for (int t = 0; t < nt; t += 2) {
            const bool last = (t == nt - 2);
            const char* a1 = cA + (size_t)(t + 1) * kstep;
            const char* a2 = last ? nA : cA + (size_t)(t + 2) * kstep; const char* b2 = last ? nB : cB + (size_t)(t + 2) * kstep;
            const char* a3 = a2 + kstep; const char* b3 = b2 + kstep;
            if (last && has_next) S.a_ready(nxt);
            if constexpr (SP2) {
            PG8_LDB(B0, 0, 0); PG8_LDB(B1, 0, 1); PG8_SCHED; PG8_LDA(At, 0, 0); PG8_STAGE(PG8_SA(1, 1), a1 + hstepA, voffA);
            PG8_WAIT_V(8); PG8_WAIT_L(0); PG8_BAR; PG8_MMA(0, 0, At, B0); PG8_MMA(0, 1, At, B1); PG8_BAR; PG8_SCHED;
            PG8_LDA(At, 0, 1); PG8_STAGE(PG8_SB(0, 0), b2, voffB); PG8_STAGE(PG8_SB(0, 1), b2 + hstepB, voffB); PG8_STAGE(PG8_SA(0, 0), a2, voffA);
            PG8_WAIT_V(8); PG8_WAIT_L(0); PG8_BAR; PG8_MMA(1, 0, At, B0); PG8_MMA(1, 1, At, B1); PG8_BAR; PG8_SCHED;
            PG8_LDB(B0, 1, 0); PG8_LDB(B1, 1, 1); PG8_SCHED; PG8_LDA(At, 1, 0); PG8_STAGE(PG8_SA(0, 1), a2 + hstepA, voffA);
            PG8_WAIT_V(8); PG8_WAIT_L(0); PG8_BAR; PG8_MMA(0, 0, At, B0); PG8_MMA(0, 1, At, B1); PG8_BAR; PG8_SCHED;
            PG8_LDA(At, 1, 1); PG8_STAGE(PG8_SB(1, 0), b3, voffB); PG8_STAGE(PG8_SB(1, 1), b3 + hstepB, voffB); PG8_STAGE(PG8_SA(1, 0), a3, voffA);
            PG8_WAIT_V(8); PG8_WAIT_L(0); PG8_BAR; PG8_MMA(1, 0, At, B0); PG8_MMA(1, 1, At, B1); PG8_BAR; PG8_SCHED;
            } else {
            PG8_LDB(B0, 0, 0); PG8_SCHED; PG8_LDA(At, 0, 0); PG8_STAGE(PG8_SA(1, 1), a1 + hstepA, voffA);
            PG8_WAIT_L(8); PG8_BAR; PG8_WAIT_L(0); PG8_MMA(0, 0, At, B0); PG8_BAR; PG8_SCHED;
            PG8_LDB(B1, 0, 1); PG8_STAGE(PG8_SB(0, 0), b2, voffB);
            PG8_BAR; PG8_WAIT_L(0); PG8_MMA(0, 1, At, B1); PG8_BAR;
            PG8_LDA(At, 0, 1); PG8_STAGE(PG8_SA(0, 0), a2, voffA);
            PG8_BAR; PG8_WAIT_L(0); PG8_MMA(1, 0, At, B0); PG8_BAR; PG8_SCHED;
            PG8_STAGE(PG8_SB(0, 1), b2 + hstepB, voffB);
            PG8_WAIT_V(6); PG8_BAR; PG8_MMA(1, 1, At, B1); PG8_BAR;
            PG8_LDB(B0, 1, 0); PG8_SCHED; PG8_LDA(At, 1, 0); PG8_STAGE(PG8_SA(0, 1), a2 + hstepA, voffA);
            PG8_WAIT_L(8); PG8_BAR; PG8_WAIT_L(0); PG8_MMA(0, 0, At, B0); PG8_BAR; PG8_SCHED;
            PG8_LDB(B1, 1, 1); PG8_STAGE(PG8_SB(1, 0), b3, voffB);
            PG8_BAR; PG8_WAIT_L(0); PG8_MMA(0, 1, At, B1); PG8_BAR;
            PG8_LDA(At, 1, 1); PG8_STAGE(PG8_SA(1, 0), a3, voffA);
            PG8_BAR; PG8_WAIT_L(0); PG8_MMA(1, 0, At, B0); PG8_BAR; PG8_SCHED;
            PG8_STAGE(PG8_SB(1, 1), b3 + hstepB, voffB);
            PG8_WAIT_V(6); PG8_BAR; PG8_MMA(1, 1, At, B1); PG8_BAR;
            }
        }
        if constexpr (ALIGN_EPI) { if (wr == 0) PG8_BAR; }
        if constexpr (!Epi::AFTER_DRAIN) { E(acc, cur, wr, wc, fr, fq); S.done(cur); }
        if (!has_next) break;
#pragma unroll
        for (int a = 0; a < 2; ++a)
#pragma unroll
            for (int b = 0; b < 2; ++b)
#pragma unroll
                for (int m = 0; m < 4; ++m)
#pragma unroll
                    for (int n = 0; n < 2; ++n) acc[a][b][m][n] = (f32x4){0.f, 0.f, 0.f, 0.f};
        cur = nxt; cA = nA; cB = nB; ++ui;
        if constexpr (ALIGN_EPI) { if (wr == 1) PG8_BAR; }
    }
    PG8_WAIT_V(0);
    if constexpr (!ALIGN_EPI) { if (wr == 0) PG8_BAR; }
    PG8_BAR;
    if constexpr (Epi::AFTER_DRAIN) { E.fused(acc, cur, wr, wc, fr, fq, lds, wid, lane); S.done(cur); }
#undef PG8_SA
#undef PG8_SB
#undef PG8_STAGE
#undef PG8_LDA
#undef PG8_LDB
#undef PG8_MMA
#undef PG8_WAIT_V
#undef PG8_WAIT_L
#undef PG8_BAR
#undef PG8_SCHED
}
}

#define LAS __attribute__((address_space(3)))
#define XB_TMO      128
#define XB_XCNT(j)  (256  + 64 * (j))
#define XB_XSUB(j)  (1280 + 64 * (j))
#define XB_XGEN(j)  (2304 + 64 * (j))
#define XB_TOP      3328
#define XB_TOPGEN   3392
#define XCD_BAR_WORDS 3456
#define XB_SPIN_CAP (1u << 22)

__device__ __forceinline__ unsigned xb_ld(unsigned* p)              { return __hip_atomic_load(p, __ATOMIC_RELAXED, __HIP_MEMORY_SCOPE_AGENT); }
__device__ __forceinline__ unsigned xb_add(unsigned* p, unsigned v) { return __hip_atomic_fetch_add(p, v, __ATOMIC_RELAXED, __HIP_MEMORY_SCOPE_AGENT); }
__device__ __forceinline__ unsigned xb_xcc_id() { return (unsigned)__builtin_amdgcn_s_getreg((3 << 11) | 20) & 0xFu; }
#define XB_SPIN(cond, bar) do { unsigned _sp = 0; while (cond) { __builtin_amdgcn_s_sleep(1); \
    if ((++_sp & 255u) == 0u) { if (xb_ld(&(bar)[XB_TMO])) break; if (_sp > XB_SPIN_CAP) { atomicAdd(&(bar)[XB_TMO], 1u); break; } } } } while (0)

struct XcdBarrier {
    unsigned* bar; unsigned x;
    volatile LAS unsigned* st;
};

__device__ __forceinline__ XcdBarrier xcd_barrier_post(unsigned* bar, volatile LAS unsigned* st) {
    XcdBarrier b; b.bar = bar; b.x = xb_xcc_id(); b.st = st;
    if (threadIdx.x == 0) (void)xb_add(&bar[XB_XCNT(b.x)], 1u);
    return b;
}
__device__ __forceinline__ void xcd_barrier_complete(unsigned* bar, unsigned x, unsigned& nloc, unsigned& nx) {
    const unsigned G = gridDim.x * gridDim.y * gridDim.z;
    unsigned sum, cnt, mine, sp = 0u;
    for (;;) {
        sum = 0u; cnt = 0u; mine = 0u;
#pragma unroll
        for (unsigned j = 0; j < 16; ++j) { const unsigned c = xb_ld(&bar[XB_XCNT(j)]); sum += c; cnt += (c > 0u) ? 1u : 0u; mine = (j == x) ? c : mine; }
        if (sum == G) break;
        __builtin_amdgcn_s_sleep(1);
        if ((++sp & 255u) == 0u) { if (xb_ld(&bar[XB_TMO])) break; if (sp > XB_SPIN_CAP) { atomicAdd(&bar[XB_TMO], 1u); break; } }
    }
    nloc = mine > 0u ? mine : 1u; nx = cnt > 0u ? cnt : 1u;
}

__device__ __forceinline__ void xcd_barrier(const XcdBarrier& b, int tid_x  ) {
    asm volatile("s_waitcnt vmcnt(0)" ::: "memory");
    __syncthreads();
    if (tid_x == 0) {
        unsigned* bar = b.bar; asm volatile("" : "+s"(bar));
        unsigned xx = b.x; asm volatile("" : "+s"(xx));
        __builtin_amdgcn_s_waitcnt(0);
        unsigned nloc = b.st[0], nx = b.st[1];
        if (nloc == 0u) { xcd_barrier_complete(bar, xx, nloc, nx); b.st[0] = nloc; b.st[1] = nx; }
        const unsigned old = xb_add(&bar[XB_XSUB(xx)], 1u);
        const unsigned gen = old / nloc;
        if (old + 1u == (gen + 1u) * nloc) {
            __builtin_amdgcn_fence(__ATOMIC_RELEASE, "agent");
            asm volatile("s_waitcnt vmcnt(0)" ::: "memory");
            const unsigned og = xb_add(&bar[XB_TOP], 1u);
            const unsigned tg = og / nx;
            if (og + 1u == (tg + 1u) * nx) xb_add(&bar[XB_TOPGEN], 1u);
            else XB_SPIN(xb_ld(&bar[XB_TOPGEN]) == tg, bar);
            __builtin_amdgcn_fence(__ATOMIC_ACQUIRE, "agent");
            xb_add(&bar[XB_XGEN(xx)], 1u);
            asm volatile("s_waitcnt vmcnt(0)" ::: "memory");
        } else {
            XB_SPIN(xb_ld(&bar[XB_XGEN(xx)]) == gen, bar);
            __builtin_amdgcn_fence(__ATOMIC_ACQUIRE, "agent");
            asm volatile("s_waitcnt vmcnt(0)" ::: "memory");
        }
    }
    __syncthreads();
}
#define GAS __attribute__((address_space(1)))
typedef unsigned v4u __attribute__((ext_vector_type(4)));
#ifdef PROBE_TK
#define TKQ(i) do { if (layer == PROBE_LAYER && blockIdx.x == PROBE_BLK && threadIdx.x == 0) ((unsigned long long*)(p.ws + WS_CTL + 4 * CW_TK))[(i)] = __builtin_amdgcn_s_memrealtime(); } while (0)
#else
#define TKQ(i) do { } while (0)
#endif
typedef unsigned v2u __attribute__((ext_vector_type(2)));
typedef GAS unsigned gu32;
#define RLX_AGENT __ATOMIC_RELAXED, __HIP_MEMORY_SCOPE_AGENT
#define LDS_WAIT() asm volatile("s_waitcnt lgkmcnt(0)" ::: "memory")
#define VM_WAIT() asm volatile("s_waitcnt vmcnt(0)" ::: "memory")
using pg8::f32x4; using pg8::Unit; using pg8::Gemm; using pg8::BM; using pg8::HALF; using pg8::cvt_pk_bf16; using pg8::u32x4;

constexpr int NWAVES = 8, NTHREADS = 512;
constexpr int RING_BYTES = 131072, LDSCTL_OFF = 147456 - 1024, MISC_OFF = LDSCTL_OFF + 320, LDS_BYTES = 147456;

__device__ __forceinline__ float wave_sum(float v, int lane) {
#pragma unroll
    for (int o = 1; o < 64; o <<= 1) v += __builtin_bit_cast(float, __builtin_amdgcn_ds_bpermute((lane ^ o) << 2, __builtin_bit_cast(int, v)));
    return v;
}
__device__ __forceinline__ float fsig(float x) { return __builtin_amdgcn_rcpf(1.f + __expf(-x)); }

__device__ __forceinline__ int lane_id_opaque() { int l; asm volatile("v_mbcnt_lo_u32_b32 %0, -1, 0\n\tv_mbcnt_hi_u32_b32 %0, -1, %0" : "=v"(l)); return l; }
__device__ __forceinline__ int rfl(int v) { return __builtin_amdgcn_readfirstlane(v); }
struct SOrder {
    pg8::StaticOrder s;
    __device__ void init(int M, int N, int G, int c) { s.init(M, N, G, c); }
    __device__ bool next(int i, Unit& u) const { Unit t; t.pm = 0; t.pn = 0; const bool ok = s.next(i, t); u.pm = rfl(t.pm); u.pn = rfl(t.pn); return ok; }
    __device__ __forceinline__ void a_ready(const Unit&) const {}
    __device__ __forceinline__ void done(const Unit&) const {}
};
struct StackOrder {
    pg8::StaticOrder s; int nM, nN;
    __device__ StackOrder(int nM_, int nN_, int nb, int G, int c) : nM(nM_), nN(nN_) { s.init(nb * nM_ * 256, nN_ * 256, G, c); }
    __device__ bool next(int i, Unit& u) const { Unit t; t.pm = 0; t.pn = 0; if (!s.next(i, t)) return false; u.pm = rfl(t.pm); u.pn = rfl((t.pm / nM) * nN + t.pn); return true; }
    __device__ __forceinline__ void a_ready(const Unit&) const {}
    __device__ __forceinline__ void done(const Unit&) const {}
};
struct GateOrder {
    pg8::StaticOrder s; int nN;
    __device__ GateOrder(int nM_, int nN_, int G, int c) : nN(nN_) { s.init(nM_ * 256, nN_ * 256, G, c); }
    __device__ bool next(int i, Unit& u) const { const int j = i / 3, br = i - 3 * j; Unit t; t.pm = 0; t.pn = 0; if (!s.next(j, t)) return false; u.pm = rfl(t.pm); u.pn = rfl(br * nN + t.pn); return true; }
    __device__ __forceinline__ void a_ready(const Unit&) const {}
    __device__ __forceinline__ void done(const Unit&) const {}
};
struct MoeOrder {
    pg8::StaticOrder s; int nN, e0, e1, e2, e3, e4, e5, e6, e7;
    __device__ void init(const unsigned* cnt  , int nN_, int G_, int c_) { nN = nN_;
        int t = 0; t += (cnt[0] + 255) >> 8; e0 = t; t += (cnt[64] + 255) >> 8; e1 = t; t += (cnt[128] + 255) >> 8; e2 = t; t += (cnt[192] + 255) >> 8; e3 = t;
        t += (cnt[256] + 255) >> 8; e4 = t; t += (cnt[320] + 255) >> 8; e5 = t; t += (cnt[384] + 255) >> 8; e6 = t; t += (cnt[448] + 255) >> 8; e7 = t;
        s.init(e7 * 256, nN_ * 256, G_, c_); }
    __device__ bool next(int i, Unit& u) const { Unit t; t.pm = 0; t.pn = 0; if (!s.next(i, t)) return false;
        const int pm = t.pm, e = (pm >= e0) + (pm >= e1) + (pm >= e2) + (pm >= e3) + (pm >= e4) + (pm >= e5) + (pm >= e6);
        u.pm = rfl(pm); u.pn = rfl(e * nN + t.pn); return true; }
    __device__ __forceinline__ void a_ready(const Unit&) const {}
    __device__ __forceinline__ void done(const Unit&) const {}
};

__device__ __forceinline__ u32x4 pack8(f32x4 v0, f32x4 v1) { u32x4 w; w.x = cvt_pk_bf16(v0[0], v0[1]); w.y = cvt_pk_bf16(v0[2], v0[3]); w.z = cvt_pk_bf16(v1[0], v1[1]); w.w = cvt_pk_bf16(v1[2], v1[3]); return w; }
__device__ __forceinline__ void unpack8(u32x4 w, f32x4& v0, f32x4& v1) {
    v0 = (f32x4){blo(w.x), bhi(w.x), blo(w.y), bhi(w.y)}; v1 = (f32x4){blo(w.z), bhi(w.z), blo(w.w), bhi(w.w)}; }

struct EpiProj {
    static constexpr bool PERM = true, AFTER_DRAIN = false;
    unsigned char* ws;
    __device__ __forceinline__ void operator()(const f32x4 (&acc)[2][2][4][2], const Unit& u, int wr, int wc, int fr, int fq) const {
        bf16* const QB = (bf16*)(ws + AR_QB); bf16* const KV = (bf16*)(ws + AR_KV); bf16* const UB = (bf16*)(ws + AR_UB); bf16* const RW = (bf16*)(ws + AR_RW); bf16* const HALO = (bf16*)(ws + AR_HALO); bf16* const CKV = (bf16*)(ws + AR_CKV);
        const int row0 = u.pm * BM + wr * 64 + fr, cl = wc * 32 + 8 * fq;
        if (u.pn >= 5 && u.pn < 9) {
#pragma unroll
            for (int ai = 0; ai < 2; ++ai)
#pragma unroll
                for (int m = 0; m < 4; ++m) { f32x4 a0 = acc[ai][0][m][0], a1 = acc[ai][0][m][1]; const f32x4 b0 = acc[ai][1][m][0], b1 = acc[ai][1][m][1];
#pragma unroll
                    for (int k = 0; k < 4; ++k) { a0[k] *= fsig(b0[k]); a1[k] *= fsig(b1[k]); }
                    *(u32x4*)(UB + (size_t)(row0 + ai * HALF + m * 16) * 512 + (u.pn - 5) * 128 + cl) = pack8(a0, a1); }
            return;
        }
        if (u.pn == 2) {
#pragma unroll
            for (int ai = 0; ai < 2; ++ai)
#pragma unroll
                for (int m = 0; m < 4; ++m) { const int row = row0 + ai * HALF + m * 16, b = row / SEQ, tt = row % SEQ;
#pragma unroll
                    for (int bj = 0; bj < 2; ++bj) *(u32x4*)(CKV + (((size_t)bj * (BATCH * NKV) + b * NKV + (cl >> 6)) * SEQ + tt) * 64 + (cl & 63)) = pack8(acc[ai][bj][m][0], acc[ai][bj][m][1]); }
            return;
        }
        bf16* base; int ld, c0;
        if (u.pn < 2) { base = QB; ld = LDQ; c0 = u.pn * 256; } else if (u.pn < 5) { base = KV; ld = LDKV; c0 = (u.pn - 3) * 256; } else { base = RW; ld = LDRW; c0 = (u.pn - 9) * 256; }
#pragma unroll
        for (int ai = 0; ai < 2; ++ai)
#pragma unroll
            for (int m = 0; m < 4; ++m)
#pragma unroll
                for (int bj = 0; bj < 2; ++bj) { const u32x4 w = pack8(acc[ai][bj][m][0], acc[ai][bj][m][1]);
                    *(u32x4*)(base + (size_t)(row0 + ai * HALF + m * 16) * ld + c0 + bj * HALF + cl) = w;
                    if (u.pn >= 9 && ai == 1 && m == 3 && wr == 1 && fr == 15) *(u32x4*)(HALO + (size_t)u.pm * LDRW + c0 + bj * HALF + cl) = w; }
    }
};
struct EpiStore {
    static constexpr bool PERM = true, AFTER_DRAIN = false;
    bf16* O; int ld, ntn;
    __device__ __forceinline__ void operator()(const f32x4 (&acc)[2][2][4][2], const Unit& u, int wr, int wc, int fr, int fq) const {
        const int row0 = u.pm * BM + wr * 64 + fr, c0 = (u.pn % ntn) * 256 + wc * 32 + 8 * fq;
#pragma unroll
        for (int ai = 0; ai < 2; ++ai)
#pragma unroll
            for (int m = 0; m < 4; ++m)
#pragma unroll
                for (int bj = 0; bj < 2; ++bj) *(u32x4*)(O + (size_t)(row0 + ai * HALF + m * 16) * ld + c0 + bj * HALF) = pack8(acc[ai][bj][m][0], acc[ai][bj][m][1]);
    }
};
struct EpiGate {
    static constexpr bool PERM = true, AFTER_DRAIN = false;
    unsigned char* ws; int ntn;
    __device__ __forceinline__ void operator()(const f32x4 (&acc)[2][2][4][2], const Unit& u, int wr, int wc, int fr, int fq) const {
        const bf16* const OB = (const bf16*)(ws + AR_OBUF); bf16* const MIX = (bf16*)(ws + AR_MIX);
        const int br = u.pn / ntn, row0 = u.pm * BM + wr * 64 + fr, c0 = (u.pn % ntn) * 256 + wc * 32 + 8 * fq;
        const bf16* ob = OB + (size_t)br * T * DM;
#pragma unroll
        for (int ai = 0; ai < 2; ++ai) {
            u32x4 o[4][2], mx[4][2];
#pragma unroll
            for (int m = 0; m < 4; ++m)
#pragma unroll
                for (int bj = 0; bj < 2; ++bj) { const size_t off = (size_t)(row0 + ai * HALF + m * 16) * DM + c0 + bj * HALF; o[m][bj] = *(const u32x4*)(ob + off); if (br != 0) mx[m][bj] = *(const u32x4*)(MIX + off); }
#pragma unroll
            for (int m = 0; m < 4; ++m)
#pragma unroll
                for (int bj = 0; bj < 2; ++bj) { const size_t off = (size_t)(row0 + ai * HALF + m * 16) * DM + c0 + bj * HALF;
                    f32x4 o0, o1; unpack8(o[m][bj], o0, o1);
                    f32x4 g0 = acc[ai][bj][m][0], g1 = acc[ai][bj][m][1];
#pragma unroll
                    for (int k = 0; k < 4; ++k) { g0[k] = fsig(g0[k]) * o0[k]; g1[k] = fsig(g1[k]) * o1[k]; }
                    if (br != 0) { f32x4 p0, p1; unpack8(mx[m][bj], p0, p1); g0 += p0; g1 += p1; }
                    *(u32x4*)(MIX + off) = pack8(g0, g1); }
        }
    }
};
struct EpiResid {
    static constexpr bool PERM = true, AFTER_DRAIN = false;
    const float* base; float* out;
    __device__ __forceinline__ void operator()(const f32x4 (&acc)[2][2][4][2], const Unit& u, int wr, int wc, int fr, int fq) const {
        const int row0 = u.pm * BM + wr * 64 + fr, c0 = u.pn * 256 + wc * 32 + 8 * fq;
#pragma unroll
        for (int ai = 0; ai < 2; ++ai)
#pragma unroll
            for (int mh = 0; mh < 2; ++mh) {
                f32x4 x[2][2][2];
#pragma unroll
                for (int mm = 0; mm < 2; ++mm)
#pragma unroll
                    for (int bj = 0; bj < 2; ++bj) { const size_t off = (size_t)(row0 + ai * HALF + (2 * mh + mm) * 16) * DM + c0 + bj * HALF; x[mm][bj][0] = *(const f32x4*)(base + off); x[mm][bj][1] = *(const f32x4*)(base + off + 4); }
#pragma unroll
                for (int mm = 0; mm < 2; ++mm)
#pragma unroll
                    for (int bj = 0; bj < 2; ++bj) { const int m = 2 * mh + mm; const size_t off = (size_t)(row0 + ai * HALF + m * 16) * DM + c0 + bj * HALF;
                        *(f32x4*)(out + off) = x[mm][bj][0] + acc[ai][bj][m][0]; *(f32x4*)(out + off + 4) = x[mm][bj][1] + acc[ai][bj][m][1]; }
            }
    }
};
struct EpiSwiglu {
    static constexpr bool PERM = true, AFTER_DRAIN = false;
    bf16* ACT; int ld, ntn;
    __device__ __forceinline__ void operator()(const f32x4 (&acc)[2][2][4][2], const Unit& u, int wr, int wc, int fr, int fq) const {
        const int row0 = u.pm * BM + wr * 64 + fr, c0 = (u.pn % ntn) * 128 + wc * 32 + 8 * fq;
#pragma unroll
        for (int ai = 0; ai < 2; ++ai)
#pragma unroll
            for (int m = 0; m < 4; ++m) { f32x4 g0 = acc[ai][0][m][0], g1 = acc[ai][0][m][1]; const f32x4 u0 = acc[ai][1][m][0], u1 = acc[ai][1][m][1];
#pragma unroll
                for (int k = 0; k < 4; ++k) { g0[k] = g0[k] * fsig(g0[k]) * u0[k]; g1[k] = g1[k] * fsig(g1[k]) * u1[k]; }
                *(u32x4*)(ACT + (size_t)(row0 + ai * HALF + m * 16) * ld + c0) = pack8(g0, g1); }
    }
};
struct EpiMoeDown {
    static constexpr bool PERM = true, AFTER_DRAIN = false;
    float* out; const int* rtok; const float* rw; int ntn; float sc;
    __device__ __forceinline__ void operator()(const f32x4 (&acc)[2][2][4][2], const Unit& u, int wr, int wc, int fr, int fq) const {
        const int row0 = u.pm * BM + wr * 64 + fr, c0 = (u.pn % ntn) * 256 + wc * 32 + 8 * fq;
#pragma unroll
        for (int ai = 0; ai < 2; ++ai)
#pragma unroll
            for (int mh = 0; mh < 2; ++mh) {
                int tok[2]; float w[2]; f32x4 x[2][2][2];
#pragma unroll
                for (int mm = 0; mm < 2; ++mm) { const int row = row0 + ai * HALF + (2 * mh + mm) * 16; tok[mm] = rtok[row]; w[mm] = rw[row] * sc; }
#pragma unroll
                for (int mm = 0; mm < 2; ++mm)
#pragma unroll
                    for (int bj = 0; bj < 2; ++bj) { const float* o = out + (size_t)(tok[mm] >= 0 ? tok[mm] : 0) * DM + c0 + bj * HALF; x[mm][bj][0] = *(const f32x4*)o; x[mm][bj][1] = *(const f32x4*)(o + 4); }
#pragma unroll
                for (int mm = 0; mm < 2; ++mm)
#pragma unroll
                    for (int bj = 0; bj < 2; ++bj) if (tok[mm] >= 0) { const int m = 2 * mh + mm; float* o = out + (size_t)tok[mm] * DM + c0 + bj * HALF;
                        *(f32x4*)o = x[mm][bj][0] + acc[ai][bj][m][0] * w[mm]; *(f32x4*)(o + 4) = x[mm][bj][1] + acc[ai][bj][m][1] * w[mm]; }
            }
    }
};

constexpr int MT_KS = 7, MT_K = EXPERT_FF / MT_KS;
struct MoeTailOrder {
    int nN, pm0, nsub, G, c, e0, e1, e2, e3, e4, e5, e6;
    __device__ void init(const MoeOrder& m, int pm0_, int ntiles, int G_, int c_) { nN = m.nN; pm0 = pm0_; nsub = ntiles * MT_KS; G = G_; c = c_; e0 = m.e0; e1 = m.e1; e2 = m.e2; e3 = m.e3; e4 = m.e4; e5 = m.e5; e6 = m.e6; }
    __device__ bool next(int i, Unit& u) const { const int L = i * G + c; if (L >= nsub) return false;
        const int j = L / MT_KS, ks = L - j * MT_KS, pm = pm0 + j / nN, pl = j % nN, e = (pm >= e0) + (pm >= e1) + (pm >= e2) + (pm >= e3) + (pm >= e4) + (pm >= e5) + (pm >= e6);
        u.pm = rfl(pm); u.pn = rfl((e * nN + pl) | (ks << 16)); return true; }
    __device__ __forceinline__ void a_ready(const Unit&) const {}
    __device__ __forceinline__ void done(const Unit&) const {}
};
struct EpiPart {
    static constexpr bool PERM = true, AFTER_DRAIN = false;
    float* part; int pm0, nN;
    __device__ __forceinline__ void operator()(const f32x4 (&acc)[2][2][4][2], const Unit& u, int wr, int wc, int fr, int fq) const {
        const int slot = ((u.pm - pm0) * nN + (u.pn & 0xffff) % nN) * MT_KS + (u.pn >> 16);
        float* b = part + (size_t)slot * 65536 + (size_t)(((wr * 4 + wc) * 64 + fq * 16 + fr) * 4);
#pragma unroll
        for (int ai = 0; ai < 2; ++ai)
#pragma unroll
            for (int bj = 0; bj < 2; ++bj)
#pragma unroll
                for (int m = 0; m < 4; ++m)
#pragma unroll
                    for (int n = 0; n < 2; ++n) *(f32x4*)(b + (((ai * 2 + bj) * 4 + m) * 2 + n) * 2048) = acc[ai][bj][m][n];
    }
};
__device__ __forceinline__ void moe_tail_combine(const EpiMoeDown& E, const MoeOrder& mo, const float* part, int pm0, int job, int lane_in) {
    int lane = lane_in; asm volatile("" : "+v"(lane));
    const int q = job & 3, role = (job >> 2) & 7, j = job >> 5, ai = q >> 1, mh = q & 1, pm = pm0 + j / mo.nN, pl = j % mo.nN, wr = role >> 2, wc = role & 3, fr = lane & 15, fq = lane >> 4;
    const float* b = part + (size_t)j * MT_KS * 65536 + (size_t)((role * 64 + lane) * 4);
    f32x4 a[2][2][2];
#pragma unroll
    for (int mm = 0; mm < 2; ++mm)
#pragma unroll
        for (int bj = 0; bj < 2; ++bj)
#pragma unroll
            for (int n = 0; n < 2; ++n) a[mm][bj][n] = *(const f32x4*)(b + (((ai * 2 + bj) * 4 + 2 * mh + mm) * 2 + n) * 2048);
#pragma unroll
    for (int ks = 1; ks < MT_KS; ++ks)
#pragma unroll
        for (int mm = 0; mm < 2; ++mm)
#pragma unroll
            for (int bj = 0; bj < 2; ++bj)
#pragma unroll
                for (int n = 0; n < 2; ++n) a[mm][bj][n] += *(const f32x4*)(b + (size_t)ks * 65536 + (((ai * 2 + bj) * 4 + 2 * mh + mm) * 2 + n) * 2048);
    const int row0 = pm * BM + wr * 64 + fr + ai * HALF + 2 * mh * 16, c0 = pl * 256 + wc * 32 + 8 * fq;
#pragma unroll
    for (int mm = 0; mm < 2; ++mm) { const int tok = E.rtok[row0 + mm * 16]; const float w = E.rw[row0 + mm * 16] * E.sc;
        if (tok >= 0) {
#pragma unroll
            for (int bj = 0; bj < 2; ++bj) { float* o = E.out + (size_t)tok * DM + c0 + bj * HALF; const f32x4 x0 = *(const f32x4*)o, x1 = *(const f32x4*)(o + 4);
                *(f32x4*)o = x0 + a[mm][bj][0] * w; *(f32x4*)(o + 4) = x1 + a[mm][bj][1] * w; } } }
}

typedef short bf16x8_t __attribute__((ext_vector_type(8)));
#define MFMA16(a, b, c) __builtin_amdgcn_mfma_f32_16x16x32_bf16((a), (b), (c), 0, 0, 0)
constexpr float ATT_C = 0.125f * 1.4426950408889634f;
constexpr int AW_IMP = 0, AW_SEL = 8448, AW_QS = 8960, AW_BYTES = 8960 + 8192;
__device__ __forceinline__ float bperm_f(float v, int srclane) { return __builtin_bit_cast(float, __builtin_amdgcn_ds_bpermute(srclane << 2, __builtin_bit_cast(int, v))); }
__device__ __forceinline__ int bperm_i(int v, int srclane) { return __builtin_amdgcn_ds_bpermute(srclane << 2, v); }
__device__ __forceinline__ bf16x8_t ldg8(const bf16* p) { return *(const bf16x8_t*)p; }
__device__ __forceinline__ bf16x8_t pack_p(const f32x4& a, const f32x4& b) {
    v4u w; w.x = cvt_pk_bf16(a[0], a[1]); w.y = cvt_pk_bf16(a[2], a[3]); w.z = cvt_pk_bf16(b[0], b[1]); w.w = cvt_pk_bf16(b[2], b[3]); return __builtin_bit_cast(bf16x8_t, w); }

__device__ __forceinline__ void nsa_attn_item(const P& p, int item, int lane, LAS unsigned char* wl) {
    const bf16* KV = WSP(bf16, AR_KV); const bf16* KC = WSP(bf16, AR_KC); const bf16* VcT = WSP(bf16, AR_VCT); const bf16* VsT = WSP(bf16, WS_VST); const bf16* VwT = WSP(bf16, WS_VWT);
    bf16* QB = WSP(bf16, AR_QB); const float* NG = WSP(float, AR_NG);
    const int bg = item / (SEQ / 16), t0 = (item % (SEQ / 16)) * 16, b = bg >> 1, g = bg & 1;
    const int col = lane & 15, fq = lane >> 4, tok = t0 + col;
    const size_t grow = (size_t)b * SEQ + tok;
    LAS float* IMP = (LAS float*)(wl + AW_IMP); LAS int* SEL = (LAS int*)(wl + AW_SEL); LAS bf16* OS = (LAS bf16*)(wl + AW_IMP);
    const int krowA = 8 * (col >> 2) + (col & 3);
    const float* gate = NG + grow * 24 + g * 12;
    LAS bf16x8_t* QS = (LAS bf16x8_t*)(wl + AW_QS) + lane;
#pragma unroll
    for (int hh = 0; hh < 4; ++hh)
#pragma unroll
        for (int ks = 0; ks < 2; ++ks) QS[(hh * 2 + ks) * 64] = ldg8(QB + grow * LDQ + (g * 4 + hh) * 64 + ks * 32 + fq * 8);
#define Qc(hh, ks) (QS[((hh) * 2 + (ks)) * 64])
    for (int i = lane; i < 16 * 132; i += 64) IMP[i] = 0.f;
    const f32x4 z4 = {0.f, 0.f, 0.f, 0.f};
    f32x4 O[4][4];
    int nvmax = (t0 + 15 >= 31) ? (((t0 + 15 - 31) >> 4) + 1) : 0; if (nvmax > NC) nvmax = NC;
    const int nch = (nvmax + 31) >> 5;
    const bf16* kcb = KC + (size_t)bg * 512 * 64; const bf16* vcb = VcT + (size_t)bg * 64 * 512;
    float linv[4] = {0.f, 0.f, 0.f, 0.f};
#pragma unroll
    for (int hh = 0; hh < 4; ++hh)
#pragma unroll
        for (int mt = 0; mt < 4; ++mt) O[hh][mt] = z4;
#pragma unroll 1
    for (int pass = 0; pass < 2; ++pass) {
#pragma unroll 1
        for (int ch = 0; ch < nch; ++ch) {
            asm volatile("" ::: "memory");
            const int k0 = 32 * ch; const bool cfull = 16 * (k0 + 31) + 31 <= t0;
            bf16x8_t ka[2][2];
#pragma unroll
            for (int tl = 0; tl < 2; ++tl)
#pragma unroll
                for (int ks = 0; ks < 2; ++ks) ka[tl][ks] = ldg8(kcb + ((size_t)(4 * ks + fq) * 512 + k0 + 16 * tl + col) * 8);
            bf16x8_t va[4];
            if (pass == 1) {
#pragma unroll
                for (int mt = 0; mt < 4; ++mt) va[mt] = ldg8(vcb + ((size_t)((k0 >> 3) + fq) * 64 + 16 * mt + col) * 8);
            }
            float ps[8] = {0.f, 0.f, 0.f, 0.f, 0.f, 0.f, 0.f, 0.f};
#pragma unroll
            for (int hh = 0; hh < 4; ++hh) {
                const bf16x8_t q0_ = Qc(hh, 0), q1_ = Qc(hh, 1);
                f32x4 sa = MFMA16(ka[0][0], q0_, z4); sa = MFMA16(ka[0][1], q1_, sa);
                f32x4 sb = MFMA16(ka[1][0], q0_, z4); sb = MFMA16(ka[1][1], q1_, sb);
#pragma unroll
                for (int i = 0; i < 4; ++i) { sa[i] = __builtin_amdgcn_exp2f(sa[i]); sb[i] = __builtin_amdgcn_exp2f(sb[i]); }
                if (!cfull) {
#pragma unroll
                    for (int i = 0; i < 4; ++i) { const int c = k0 + 4 * fq + i; sa[i] = (16 * c + 31 <= tok) ? sa[i] : 0.f; sb[i] = (16 * (c + 16) + 31 <= tok) ? sb[i] : 0.f; } }
                if (pass == 0) { linv[hh] += (sa[0] + sa[1]) + (sa[2] + sa[3]) + (sb[0] + sb[1]) + (sb[2] + sb[3]); }
                else {
#pragma unroll
                    for (int i = 0; i < 4; ++i) { ps[i] = __builtin_fmaf(sa[i], linv[hh], ps[i]); ps[4 + i] = __builtin_fmaf(sb[i], linv[hh], ps[4 + i]); }
                    const bf16x8_t pt = pack_p(sa, sb);
#pragma unroll
                    for (int mt = 0; mt < 4; ++mt) O[hh][mt] = MFMA16(va[mt], pt, O[hh][mt]);
                }
            }
            if (pass == 1) {
                const int Ga = 8 * ch + fq; LAS float* ir = IMP + col * 132 + Ga;
                __hip_atomic_fetch_add(ir, (ps[0] + ps[1]) + (ps[2] + ps[3]), __ATOMIC_RELAXED, __HIP_MEMORY_SCOPE_WORKGROUP);
                __hip_atomic_fetch_add(ir + 1, ps[3], __ATOMIC_RELAXED, __HIP_MEMORY_SCOPE_WORKGROUP);
                __hip_atomic_fetch_add(ir + 4, (ps[4] + ps[5]) + (ps[6] + ps[7]), __ATOMIC_RELAXED, __HIP_MEMORY_SCOPE_WORKGROUP);
                if (Ga + 5 < NS) __hip_atomic_fetch_add(ir + 5, ps[7], __ATOMIC_RELAXED, __HIP_MEMORY_SCOPE_WORKGROUP);
            }
        }
        if (pass == 0) {
#pragma unroll
            for (int hh = 0; hh < 4; ++hh) { float l = linv[hh]; l += bperm_f(l, lane ^ 16); l += bperm_f(l, lane ^ 32); linv[hh] = l > 0.f ? 1.f / l : 0.f; }
        }
    }
    LDS_WAIT(); asm volatile("" ::: "memory");
    {
        const int cur = tok >> 6; LAS float* sc = IMP + col * 132;
        for (int j = fq * 32; j < fq * 32 + 32; ++j) { const bool forced = (j == 0) || (j == cur) || (j == cur - 1); const float v = sc[j]; sc[j] = forced ? 1e4f : (j <= cur ? v : -1.f); }
        LDS_WAIT(); asm volatile("" ::: "memory");
#pragma unroll 1
        for (int r = 0; r < 8; ++r) {
            float bv = sc[fq * 32]; int bj = fq * 32;
            for (int j = fq * 32 + 1; j < fq * 32 + 32; ++j) { const float v = sc[j]; if (v > bv) { bv = v; bj = j; } }
#pragma unroll
            for (int o = 16; o <= 32; o <<= 1) { const float ov = bperm_f(bv, lane ^ o); const int oj = bperm_i(bj, lane ^ o); if (ov > bv || (ov == bv && oj < bj)) { bv = ov; bj = oj; } }
            if ((bj >> 5) == fq) sc[bj] = -3e38f;
            if (fq == 0) SEL[col * 8 + r] = bj;
            LDS_WAIT(); asm volatile("" ::: "memory");
        }
    }
#pragma unroll
    for (int hh = 0; hh < 4; ++hh) { const float g0 = gate[hh * 3 + 0] * linv[hh];
#pragma unroll
        for (int mt = 0; mt < 4; ++mt) { const f32x4 o = O[hh][mt] * g0; v2u w; w.x = cvt_pk_bf16(o[0], o[1]); w.y = cvt_pk_bf16(o[2], o[3]);
            *(LAS v2u*)(OS + (col * 4 + hh) * 64 + 16 * mt + 4 * fq) = w; } }
    LDS_WAIT(); asm volatile("" ::: "memory");
    const int cur = t0 >> 6;
    {
        const bf16* kwb = WSP(bf16, WS_KW8) + (size_t)bg * 8 * SEQ * 8; const bf16* vwb = VwT + (size_t)bg * 64 * SEQ;
        const bf16* ksb = WSP(bf16, WS_KS8) + (size_t)bg * 8 * SEQ * 8; const bf16* vsb = VsT + (size_t)bg * 64 * SEQ;
        int kst = t0 - (WINDOW - 1); if (kst < 0) kst = 0; kst &= ~31;
        const int nwin = ((t0 + 15 - kst) >> 5) + 1, nfb = cur >= 2 ? 3 : cur + 1;
#pragma unroll 1
        for (int part = 0; part < 2; ++part) {
            float lw[4] = {0.f, 0.f, 0.f, 0.f};
#pragma unroll
            for (int hh = 0; hh < 4; ++hh)
#pragma unroll
                for (int mt = 0; mt < 4; ++mt) O[hh][mt] = z4;
            const bf16* kb = part ? ksb : kwb; const bf16* vb = part ? vsb : vwb;
            const int nchk = part ? 2 * nfb : nwin;
#pragma unroll 1
            for (int ci = 0; ci < nchk; ++ci) {
                asm volatile("" ::: "memory");
                int k0;
                if (part == 0) k0 = kst + 32 * ci; else { const int fb = ci >> 1, j = fb == 0 ? 0 : (fb == 1 ? cur : cur - 1); k0 = 64 * j + 32 * (ci & 1); }
                bf16x8_t ka[2][2], va[4];
#pragma unroll
                for (int tl = 0; tl < 2; ++tl)
#pragma unroll
                    for (int ks = 0; ks < 2; ++ks) ka[tl][ks] = ldg8(kb + ((size_t)(4 * ks + fq) * SEQ + k0 + 16 * tl + col) * 8);
#pragma unroll
                for (int mt = 0; mt < 4; ++mt) va[mt] = ldg8(vb + ((size_t)((k0 >> 3) + fq) * 64 + 16 * mt + col) * 8);
                const int lowk = part ? -1 : tok - WINDOW; const bool dfull = (k0 + 31 <= t0) && (part || k0 > t0 + 15 - WINDOW);
#pragma unroll
                for (int hh = 0; hh < 4; ++hh) {
                    const bf16x8_t q0_ = Qc(hh, 0), q1_ = Qc(hh, 1);
                    f32x4 sa = MFMA16(ka[0][0], q0_, z4); sa = MFMA16(ka[0][1], q1_, sa);
                    f32x4 sb = MFMA16(ka[1][0], q0_, z4); sb = MFMA16(ka[1][1], q1_, sb);
#pragma unroll
                    for (int i = 0; i < 4; ++i) { sa[i] = __builtin_amdgcn_exp2f(sa[i]); sb[i] = __builtin_amdgcn_exp2f(sb[i]); }
                    if (!dfull) {
#pragma unroll
                        for (int i = 0; i < 4; ++i) { const int kt = k0 + 4 * fq + i; sa[i] = (kt <= tok && kt > lowk) ? sa[i] : 0.f; sb[i] = (kt + 16 <= tok && kt + 16 > lowk) ? sb[i] : 0.f; } }
                    lw[hh] += (sa[0] + sa[1]) + (sa[2] + sa[3]) + (sb[0] + sb[1]) + (sb[2] + sb[3]);
                    const bf16x8_t pt = pack_p(sa, sb);
#pragma unroll
                    for (int mt = 0; mt < 4; ++mt) O[hh][mt] = MFMA16(va[mt], pt, O[hh][mt]);
                }
            }
            LDS_WAIT(); asm volatile("" ::: "memory");
            if (part == 0) {
#pragma unroll
                for (int hh = 0; hh < 4; ++hh) { float l = lw[hh]; l += bperm_f(l, lane ^ 16); l += bperm_f(l, lane ^ 32); const float w = l > 0.f ? gate[hh * 3 + 2] / l : 0.f;
#pragma unroll
                    for (int mt = 0; mt < 4; ++mt) { LAS v2u* dp = (LAS v2u*)(OS + (col * 4 + hh) * 64 + 16 * mt + 4 * fq); const v2u old = *dp;
                        v2u w2; w2.x = cvt_pk_bf16(blo(old.x) + w * O[hh][mt][0], bhi(old.x) + w * O[hh][mt][1]); w2.y = cvt_pk_bf16(blo(old.y) + w * O[hh][mt][2], bhi(old.y) + w * O[hh][mt][3]); *dp = w2; } }
            } else {
                LAS bf16* OF = (LAS bf16*)(wl + AW_QS); LAS float* LF = (LAS float*)(wl + AW_IMP + 8192);
#pragma unroll
                for (int hh = 0; hh < 4; ++hh) { float l = lw[hh]; l += bperm_f(l, lane ^ 16); l += bperm_f(l, lane ^ 32); if (fq == 0) LF[col * 4 + hh] = l;
#pragma unroll
                    for (int mt = 0; mt < 4; ++mt) { v2u w2; w2.x = cvt_pk_bf16(O[hh][mt][0], O[hh][mt][1]); w2.y = cvt_pk_bf16(O[hh][mt][2], O[hh][mt][3]); *(LAS v2u*)(OF + (col * 4 + hh) * 64 + 16 * mt + 4 * fq) = w2; } }
            }
            LDS_WAIT(); asm volatile("" ::: "memory");
        }
    }
    {
        const bf16* ksb = WSP(bf16, WS_KS8) + (size_t)bg * 8 * SEQ * 8; const bf16* vsb = VsT + (size_t)bg * 64 * SEQ;
        const LAS bf16* OF = (const LAS bf16*)(wl + AW_QS); const LAS float* LF = (const LAS float*)(wl + AW_IMP + 8192);
#pragma unroll 1
        for (int tt = 0; tt < 16; ++tt) {
            const int tq = t0 + tt; const size_t qrow = (size_t)b * SEQ + tq;
            bf16x8_t Qh[2];
#pragma unroll
            for (int ks = 0; ks < 2; ++ks) { Qh[ks] = ldg8(QB + qrow * LDQ + (g * 4 + (col & 3)) * 64 + ks * 32 + fq * 8); if (col >= 4) Qh[ks] = (bf16x8_t){0, 0, 0, 0, 0, 0, 0, 0}; }
            f32x4 Os[4] = {z4, z4, z4, z4}; float ls = 0.f;
#ifdef APROBE_SEL
            for (int rp = 0; rp < 2; ++rp) { Os[0] = z4; Os[1] = z4; Os[2] = z4; Os[3] = z4; ls = 0.f; asm volatile("" ::: "memory");
#endif
#pragma unroll 1
            for (int r8 = 0; r8 < 8; ++r8) {
                const int j = __builtin_amdgcn_readfirstlane(SEL[tt * 8 + r8]);
                if (64 * j > tq || j == 0 || j == cur || j == cur - 1) continue;
                const int kb0 = 64 * j;
                bf16x8_t ka[2][2][2], va[2][4];
#pragma unroll
                for (int hf = 0; hf < 2; ++hf) {
#pragma unroll
                    for (int tl = 0; tl < 2; ++tl)
#pragma unroll
                        for (int ks = 0; ks < 2; ++ks) ka[hf][tl][ks] = ldg8(ksb + ((size_t)(4 * ks + fq) * SEQ + kb0 + 32 * hf + 16 * tl + col) * 8);
#pragma unroll
                    for (int mt = 0; mt < 4; ++mt) va[hf][mt] = ldg8(vsb + ((size_t)(((kb0 + 32 * hf) >> 3) + fq) * 64 + 16 * mt + col) * 8);
                }
#pragma unroll
                for (int hf = 0; hf < 2; ++hf) {
                    f32x4 sa = MFMA16(ka[hf][0][0], Qh[0], z4); sa = MFMA16(ka[hf][0][1], Qh[1], sa);
                    f32x4 sb = MFMA16(ka[hf][1][0], Qh[0], z4); sb = MFMA16(ka[hf][1][1], Qh[1], sb);
#pragma unroll
                    for (int i = 0; i < 4; ++i) { sa[i] = __builtin_amdgcn_exp2f(sa[i]); sb[i] = __builtin_amdgcn_exp2f(sb[i]); }
                    ls += (sa[0] + sa[1]) + (sa[2] + sa[3]) + (sb[0] + sb[1]) + (sb[2] + sb[3]);
                    const bf16x8_t pt = pack_p(sa, sb);
#pragma unroll
                    for (int mt = 0; mt < 4; ++mt) Os[mt] = MFMA16(va[hf][mt], pt, Os[mt]);
                }
            }
#ifdef APROBE_SEL
            }
#endif
            ls += bperm_f(ls, lane ^ 16); ls += bperm_f(ls, lane ^ 32);
            if (col < 4) {
                const float den = ls + LF[tt * 4 + col]; const float w = den > 0.f ? (NG + qrow * 24 + g * 12)[col * 3 + 1] / den : 0.f;
#pragma unroll
                for (int mt = 0; mt < 4; ++mt) { const int e = (tt * 4 + col) * 64 + 16 * mt + 4 * fq; const v2u old = *(const LAS v2u*)(OS + e), fo = *(const LAS v2u*)(OF + e);
                    v2u w2; w2.x = cvt_pk_bf16(blo(old.x) + w * (Os[mt][0] + blo(fo.x)), bhi(old.x) + w * (Os[mt][1] + bhi(fo.x))); w2.y = cvt_pk_bf16(blo(old.y) + w * (Os[mt][2] + blo(fo.y)), bhi(old.y) + w * (Os[mt][3] + bhi(fo.y)));
                    *(v2u*)(QB + qrow * LDQ + (g * 4 + col) * 64 + 16 * mt + 4 * fq) = w2; }
            }
        }
    }
    LDS_WAIT(); asm volatile("" ::: "memory");
#undef Qc
}

typedef _Float16 h16x2 __attribute__((ext_vector_type(2)));
__device__ __forceinline__ h16x2 as_h2(unsigned u) { h16x2 r; __builtin_memcpy(&r, &u, 4); return r; }
constexpr int SC_STEPS = 8, SC_BUF = 6 * 1024;
__device__ __forceinline__ float dpp_sum16(float v) {
    v += __builtin_bit_cast(float, __builtin_amdgcn_update_dpp(0, __builtin_bit_cast(int, v), 0xB1, 0xF, 0xF, true));
    v += __builtin_bit_cast(float, __builtin_amdgcn_update_dpp(0, __builtin_bit_cast(int, v), 0x4E, 0xF, 0xF, true));
    v += __builtin_bit_cast(float, __builtin_amdgcn_update_dpp(0, __builtin_bit_cast(int, v), 0x141, 0xF, 0xF, true));
    v += __builtin_bit_cast(float, __builtin_amdgcn_update_dpp(0, __builtin_bit_cast(int, v), 0x140, 0xF, 0xF, true));
    return v;
}
__device__ __forceinline__ float fmix_lo(float a, unsigned b, float c) { float d; asm("v_fma_mix_f32 %0, %1, %2, %3 op_sel_hi:[0,1,0]" : "=v"(d) : "v"(a), "v"(b), "v"(c)); return d; }
__device__ __forceinline__ float fmix_hi(float a, unsigned b, float c) { float d; asm("v_fma_mix_f32 %0, %1, %2, %3 op_sel:[0,1,0] op_sel_hi:[0,1,0]" : "=v"(d) : "v"(a), "v"(b), "v"(c)); return d; }
__device__ __forceinline__ float fmix_lo0(float a, unsigned b) { float d; asm("v_fma_mix_f32 %0, %1, %2, 0 op_sel_hi:[0,1,0]" : "=v"(d) : "v"(a), "v"(b)); return d; }
__device__ __forceinline__ float fmix_nlo(float a, unsigned b, float c) { float d; asm("v_fma_mix_f32 %0, %1, -%2, %3 op_sel_hi:[0,1,0]" : "=v"(d) : "v"(a), "v"(b), "v"(c)); return d; }
__device__ __forceinline__ float fmix_nhi(float a, unsigned b, float c) { float d; asm("v_fma_mix_f32 %0, %1, -%2, %3 op_sel:[0,1,0] op_sel_hi:[0,1,0]" : "=v"(d) : "v"(a), "v"(b), "v"(c)); return d; }
__device__ __forceinline__ float fmix_hlo(unsigned a, unsigned b, float c) { float d; asm("v_fma_mix_f32 %0, %1, %2, %3 op_sel_hi:[1,1,0]" : "=v"(d) : "v"(a), "v"(b), "v"(c)); return d; }
__device__ __forceinline__ float fmix_hhi(unsigned a, unsigned b, float c) { float d; asm("v_fma_mix_f32 %0, %1, %2, %3 op_sel:[0,1,0] op_sel_hi:[1,1,0]" : "=v"(d) : "v"(a), "v"(b), "v"(c)); return d; }
__device__ __forceinline__ void scan_fill(const bf16* RW, const bf16* Wm, const bf16* Am, size_t trow, int h, int lane, LAS unsigned char* buf) {
    const size_t t = trow + (lane >> 3); const int sub = (lane & 7) * 8;
    const bf16* row = RW + t * LDRW + h * 64 + sub;
    __builtin_amdgcn_global_load_lds((const unsigned*)(row + LBLK), (LAS unsigned*)(buf + 0 * 1024), 16, 0, 0);
    __builtin_amdgcn_global_load_lds((const unsigned*)(Am + t * RC + h * 64 + sub), (LAS unsigned*)(buf + 1 * 1024), 16, 0, 0);
    __builtin_amdgcn_global_load_lds((const unsigned*)(Wm + t * RC + h * 64 + sub), (LAS unsigned*)(buf + 2 * 1024), 16, 0, 0);
    __builtin_amdgcn_global_load_lds((const unsigned*)(row + 512), (LAS unsigned*)(buf + 3 * 1024), 16, 0, 0);
    __builtin_amdgcn_global_load_lds((const unsigned*)(row), (LAS unsigned*)(buf + 4 * 1024), 16, 0, 0);
    __builtin_amdgcn_global_load_lds((const unsigned*)(row + 1024), (LAS unsigned*)(buf + 5 * 1024), 16, 0, 0);
}
constexpr int SC_BUF3 = 5 * 1024 + 128;
__device__ __forceinline__ unsigned scan_fill3(const bf16* RW, const bf16* Wm, const bf16* Am, size_t trow, int h, int row, int lane, LAS unsigned char* buf) {
    const size_t t = trow + (lane >> 3); const int sub = (lane & 7) * 8;
    const bf16* rp = RW + t * LDRW + h * 64 + sub;
    __builtin_amdgcn_global_load_lds((const unsigned*)(rp + LBLK), (LAS unsigned*)(buf + 0 * 1024), 16, 0, 0);
    __builtin_amdgcn_global_load_lds((const unsigned*)(Am + t * RC + h * 64 + sub), (LAS unsigned*)(buf + 1 * 1024), 16, 0, 0);
    __builtin_amdgcn_global_load_lds((const unsigned*)(Wm + t * RC + h * 64 + sub), (LAS unsigned*)(buf + 2 * 1024), 16, 0, 0);
    __builtin_amdgcn_global_load_lds((const unsigned*)(rp + 512), (LAS unsigned*)(buf + 3 * 1024), 16, 0, 0);
    __builtin_amdgcn_global_load_lds((const unsigned*)(rp), (LAS unsigned*)(buf + 4 * 1024), 16, 0, 0);
    if (lane < 8) __builtin_amdgcn_global_load_lds((const unsigned*)(RW + (trow + lane) * LDRW + 1024 + h * 64 + (row & ~7)), (LAS unsigned*)(buf + 5 * 1024), 16, 0, 0);
    return 0u;
}
__device__ __forceinline__ void scan_unit(const P& p, int unit, int lane, LAS unsigned char* wl) {
    const bf16* RW = WSP(bf16, AR_RW); const bf16* Wm = WSP(bf16, AR_W); const bf16* Am = WSP(bf16, AR_A); bf16* Y = WSP(bf16, AR_UB);
    const int rg = unit & 15, h = (unit >> 4) & 7, b = unit >> 7, row = rg * 4 + (lane >> 4), kq = lane & 15;
    const size_t tb = (size_t)b * SEQ;
    constexpr int NCH = SEQ / SC_STEPS;
    float s0 = 0.f, s1 = 0.f, s2 = 0.f, s3 = 0.f;
    __builtin_amdgcn_s_setprio(3);
#define SCAN_CHUNK(C_, BI_, B2_, VCUR_, VNEW_) do { \
        LAS unsigned char* buf = wl + (BI_) * SC_BUF3; const int c2 = (C_) + 2 < NCH ? (C_) + 2 : NCH - 1;                  \
        asm volatile("s_waitcnt lgkmcnt(0)" ::: "memory");                                                                  \
        VNEW_ = scan_fill3(RW, Wm, Am, tb + (size_t)c2 * SC_STEPS, h, row, lane, wl + (B2_) * SC_BUF3); \
        asm volatile("s_waitcnt vmcnt(12)" ::: "memory");                                                                   \
        float ys[SC_STEPS]; v2u kkw[SC_STEPS], bbw[SC_STEPS], eew[SC_STEPS], ktw[SC_STEPS], rrw[SC_STEPS]; unsigned vvw[SC_STEPS]; \
        _Pragma("unroll") for (int st = 0; st < 4; ++st) { const LAS unsigned char* o = buf + st * 128 + kq * 8; \
            kkw[st] = *(const LAS v2u*)(o); bbw[st] = *(const LAS v2u*)(o + 1024); eew[st] = *(const LAS v2u*)(o + 2048); ktw[st] = *(const LAS v2u*)(o + 3072); rrw[st] = *(const LAS v2u*)(o + 4096); \
            vvw[st] = (unsigned)*(const LAS unsigned short*)(buf + 5 * 1024 + st * 16 + (row & 7) * 2); } \
        asm volatile("" ::: "memory"); \
        _Pragma("unroll") for (int st = 4; st < SC_STEPS; ++st) { const LAS unsigned char* o = buf + st * 128 + kq * 8; \
            kkw[st] = *(const LAS v2u*)(o); bbw[st] = *(const LAS v2u*)(o + 1024); eew[st] = *(const LAS v2u*)(o + 2048); ktw[st] = *(const LAS v2u*)(o + 3072); rrw[st] = *(const LAS v2u*)(o + 4096); \
            vvw[st] = (unsigned)*(const LAS unsigned short*)(buf + 5 * 1024 + st * 16 + (row & 7) * 2); } \
        asm volatile("" ::: "memory"); \
        _Pragma("unroll") for (int st = 0; st < SC_STEPS; ++st) { const unsigned vvr = vvw[st]; \
            const float d0 = fmix_hi(s1, kkw[st].x, fmix_lo0(s0, kkw[st].x)), d1 = fmix_hi(s3, kkw[st].y, fmix_lo0(s2, kkw[st].y)); \
            const float nskk = -dpp_sum16(d0 + d1); \
            s0 = fmix_nlo(s0, eew[st].x, s0); s1 = fmix_nhi(s1, eew[st].x, s1); s2 = fmix_nlo(s2, eew[st].y, s2); s3 = fmix_nhi(s3, eew[st].y, s3); \
            s0 = fmix_lo(nskk, bbw[st].x, s0); s1 = fmix_hi(nskk, bbw[st].x, s1); s2 = fmix_lo(nskk, bbw[st].y, s2); s3 = fmix_hi(nskk, bbw[st].y, s3); \
            s0 = fmix_hlo(vvr, ktw[st].x, s0); s1 = fmix_hhi(vvr, ktw[st].x, s1); s2 = fmix_hlo(vvr, ktw[st].y, s2); s3 = fmix_hhi(vvr, ktw[st].y, s3); \
            const float y0 = fmix_hi(s1, rrw[st].x, fmix_lo0(s0, rrw[st].x)), y1 = fmix_hi(s3, rrw[st].y, fmix_lo0(s2, rrw[st].y)); \
            ys[st] = dpp_sum16(y0 + y1); } \
        if (kq < SC_STEPS) { float yv = ys[0];        \
            _Pragma("unroll") for (int st = 1; st < SC_STEPS; ++st) yv = (kq == st) ? ys[st] : yv; \
            bf16* yd = (C_) < NCH ? Y + (tb + (size_t)(C_) * SC_STEPS + kq) * RC + h * 64 + row : ysink;         \
            *yd = f2bf(yv); } } while (0)
    bf16* ysink = (bf16*)(p.ws + WS_CTL + 4 * CW_SINK) + lane;
    unsigned v0 = scan_fill3(RW, Wm, Am, tb, h, row, lane, wl), v1 = scan_fill3(RW, Wm, Am, tb + SC_STEPS, h, row, lane, wl + SC_BUF3), v2 = 0u;
#pragma unroll 1
    for (int c = 0; c < NCH + 2; c += 3) {
        SCAN_CHUNK(c, 0, 2, v0, v2);
        SCAN_CHUNK(c + 1, 1, 0, v1, v0);
        SCAN_CHUNK(c + 2, 2, 1, v2, v1);
    }
#undef SCAN_CHUNK
    asm volatile("s_waitcnt vmcnt(0) lgkmcnt(0)" ::: "memory");
    __builtin_amdgcn_s_setprio(0);
}
__device__ __forceinline__ float sum8(float v) {
    v += __builtin_bit_cast(float, __builtin_amdgcn_update_dpp(0, __builtin_bit_cast(int, v), 0xB1, 0xF, 0xF, true));
    v += __builtin_bit_cast(float, __builtin_amdgcn_update_dpp(0, __builtin_bit_cast(int, v), 0x4E, 0xF, 0xF, true));
    v += __builtin_bit_cast(float, __builtin_amdgcn_update_dpp(0, __builtin_bit_cast(int, v), 0x141, 0xF, 0xF, true));
    return v;
}
__device__ __forceinline__ void up8(v4u w, float* f) { f[0] = blo(w.x); f[1] = bhi(w.x); f[2] = blo(w.y); f[3] = bhi(w.y); f[4] = blo(w.z); f[5] = bhi(w.z); f[6] = blo(w.w); f[7] = bhi(w.w); }
#ifdef SCAN_BF16
#define uph8 up8
#define pkh8 pk8
#else
#define uph8 uph8_
#define pkh8 pkh8_
#endif
__device__ __forceinline__ void uph8_(v4u w, float* f) { const h16x2 a = as_h2(w.x), b = as_h2(w.y), c = as_h2(w.z), d = as_h2(w.w);
    f[0] = (float)a.x; f[1] = (float)a.y; f[2] = (float)b.x; f[3] = (float)b.y; f[4] = (float)c.x; f[5] = (float)c.y; f[6] = (float)d.x; f[7] = (float)d.y; }
__device__ __forceinline__ unsigned pkh2(float lo, float hi) { h16x2 v; v.x = (_Float16)lo; v.y = (_Float16)hi; return __builtin_bit_cast(unsigned, v); }
__device__ __forceinline__ v4u pkh8_(const float* f) { v4u w; w.x = pkh2(f[0], f[1]); w.y = pkh2(f[2], f[3]); w.z = pkh2(f[4], f[5]); w.w = pkh2(f[6], f[7]); return w; }
__device__ __forceinline__ v4u pk8(const float* f) { v4u w; w.x = cvt_pk_bf16(f[0], f[1]); w.y = cvt_pk_bf16(f[2], f[3]); w.z = cvt_pk_bf16(f[4], f[5]); w.w = cvt_pk_bf16(f[6], f[7]); return w; }
__device__ __forceinline__ void ldf8(const float* p, float* f) { const f32x4 a = *(const f32x4*)p, b = *(const f32x4*)(p + 4); f[0] = a[0]; f[1] = a[1]; f[2] = a[2]; f[3] = a[3]; f[4] = b[0]; f[5] = b[1]; f[6] = b[2]; f[7] = b[3]; }

struct EpiLora {
    static constexpr bool PERM = true, AFTER_DRAIN = false;
    unsigned char* ws; int pn0;
    __device__ __forceinline__ void operator()(const f32x4 (&acc)[2][2][4][2], const Unit& u, int wr, int wc, int fr, int fq) const {
        const int pn = u.pn + pn0, which = pn >> 1, row0 = u.pm * BM + wr * 64 + fr, c0 = (pn & 1) * 256 + wc * 32 + 8 * fq;
        bf16* const O = (bf16*)(ws + (which == 0 ? AR_W : (which == 1 ? AR_A : (which == 2 ? AR_G : AR_UB))));
#pragma unroll
        for (int ai = 0; ai < 2; ++ai)
#pragma unroll
            for (int m = 0; m < 4; ++m)
#pragma unroll
                for (int bj = 0; bj < 2; ++bj) *(u32x4*)(O + (size_t)(row0 + ai * HALF + m * 16) * RC + c0 + bj * HALF) = pack8(acc[ai][bj][m][0], acc[ai][bj][m][1]);
    }
};
#ifdef RKV_BF16
#define UPR up8
#define PKR pk8
#else
#define UPR uph8
#define PKR pkh8
#endif
struct B2In { v4u k, a, w, vr, vv, vf; float gt; };
__device__ __forceinline__ void b2w_load(B2In& in, const P& p, int layer, int t, int lane) {
    const bf16* row = WSP(bf16, AR_RW) + (size_t)t * LDRW;
    in.k = *(const v4u*)(row + 512 + 8 * lane); in.a = *(const v4u*)(WSP(bf16, AR_A) + (size_t)t * RC + 8 * lane); in.w = *(const v4u*)(WSP(bf16, AR_W) + (size_t)t * RC + 8 * lane);
    in.gt = lane < 24 ? bf2f(row[LBLK + 320 + lane]) : 0.f;
    if (layer == 1) { in.vr = *(const v4u*)(WSP(bf16, AR_UB) + (size_t)t * RC + 8 * lane); in.vv = *(const v4u*)(row + 1024 + 8 * lane); in.vf = *(const v4u*)(WSP(bf16, WS_VF) + (size_t)t * RC + 8 * lane); }
}
__device__ __forceinline__ void b2w_compute(const B2In& in, const P& p, int layer, int t, int lane, const float* v0, const float* v1, const float* v2, const float* v3, const float* vb) {
    bf16* row = WSP(bf16, AR_RW) + (size_t)t * LDRW; bf16* Am = WSP(bf16, AR_A); bf16* Wm = WSP(bf16, AR_W); float* NG = WSP(float, AR_NG);
    float k[8], a[8], w[8]; uph8(in.k, k); up8(in.a, a); up8(in.w, w);
    const float ngv = fsig(in.gt);
    float kk[8], ss = 0.f;
#pragma unroll
    for (int i = 0; i < 8; ++i) {
        a[i] = fsig(a[i] + v1[i]);
        const float nx = -(w[i] + v0[i]), sp = fmaxf(nx, 0.f) + __logf(1.f + __expf(-fabsf(nx))), e = __expf(-sp - 0.5f); w[i] = 1.f - __expf(-e);
        kk[i] = k[i] * v2[i]; ss += kk[i] * kk[i]; }
    ss = sum8(ss); const float nrm = sqrtf(ss), inv = 1.f / (nrm > 1e-12f ? nrm : 1e-12f);
#pragma unroll
    for (int i = 0; i < 8; ++i) { kk[i] *= inv; k[i] = k[i] * (1.f + (a[i] - 1.f) * v3[i]); a[i] *= kk[i]; }
    asm volatile("" :: "v"(ngv));
    if (layer == 1) { float vr[8], vv[8], vf[8]; up8(in.vr, vr); uph8(in.vv, vv); uph8(in.vf, vf);
#pragma unroll
        for (int i = 0; i < 8; ++i) vv[i] = vv[i] + (vf[i] - vv[i]) * fsig(vr[i] + vb[i]);
        *(v4u*)(row + 1024 + 8 * lane) = pkh8(vv); }
    if (lane < 24) NG[(size_t)t * 24 + lane] = ngv;
    *(v4u*)(row + LBLK + 8 * lane) = pkh8(kk); *(v4u*)(row + 512 + 8 * lane) = pkh8(k);
    *(v4u*)(Am + (size_t)t * RC + 8 * lane) = pkh8(a); *(v4u*)(Wm + (size_t)t * RC + 8 * lane) = pkh8(w);
}
__device__ __forceinline__ void ph_rwkv_b2w(const P& p, int layer, int gw, int NGW, int lane) {
    const float* vec = p.rwkv_vec + (size_t)layer * 7 * RC; float v0[8], v1[8], v2[8], v3[8], vb[8];
    ldf8(vec + 8 * lane, v0); ldf8(vec + RC + 8 * lane, v1); ldf8(vec + 2 * RC + 8 * lane, v2); ldf8(vec + 3 * RC + 8 * lane, v3); ldf8(p.vres_b + 8 * lane, vb);
    int t = gw; if (t >= T) return;
    B2In A, B; b2w_load(A, p, layer, t, lane);
    for (; t < T; t += 2 * NGW) { const int t1 = t + NGW, t2 = t1 + NGW;
        b2w_load(B, p, layer, t1 < T ? t1 : t, lane); b2w_compute(A, p, layer, t, lane, v0, v1, v2, v3, vb);
        if (t1 < T) { b2w_load(A, p, layer, t2 < T ? t2 : t1, lane); b2w_compute(B, p, layer, t1, lane, v0, v1, v2, v3, vb); } }
}
struct PoIn { v4u y, r, k, v, g; };
__device__ __forceinline__ void post_load(PoIn& in, const P& p, int t, int lane) { const bf16* row = WSP(bf16, AR_RW) + (size_t)t * LDRW;
    in.y = *(const v4u*)(WSP(bf16, AR_UB) + (size_t)t * RC + 8 * lane); in.r = *(const v4u*)(row + 8 * lane); in.k = *(const v4u*)(row + 512 + 8 * lane); in.v = *(const v4u*)(row + 1024 + 8 * lane); in.g = *(const v4u*)(WSP(bf16, AR_G) + (size_t)t * RC + 8 * lane); }
__device__ __forceinline__ void post_compute(const PoIn& in, const P& p, int t, int lane, const float* v4_, const float* v5, const float* v6) {
    float y[8], r[8], k[8], v[8], g[8]; up8(in.y, y); uph8(in.r, r); uph8(in.k, k); uph8(in.v, v); up8(in.g, g);
    float s = 0.f, bon = 0.f;
#pragma unroll
    for (int i = 0; i < 8; ++i) { s += y[i]; bon += r[i] * k[i] * v4_[i]; }
    const float m = sum8(s) * (1.f / 64.f); bon = sum8(bon);
    float q = 0.f;
#pragma unroll
    for (int i = 0; i < 8; ++i) { y[i] -= m; q += y[i] * y[i]; }
    const float rstd = 1.f / sqrtf(sum8(q) * (1.f / 64.f) + GN_EPS);
#pragma unroll
    for (int i = 0; i < 8; ++i) y[i] = (y[i] * rstd * v5[i] + v6[i] + bon * v[i]) * g[i];
    *(v4u*)(WSP(bf16, AR_A) + (size_t)t * RC + 8 * lane) = pk8(y);
}
__device__ __forceinline__ void ph_rwkv_postw(const P& p, int layer, int gw, int NGW, int lane) {
    const float* vec = p.rwkv_vec + (size_t)layer * 7 * RC; float v4_[8], v5[8], v6[8]; ldf8(vec + 4 * RC + 8 * lane, v4_); ldf8(vec + 5 * RC + 8 * lane, v5); ldf8(vec + 6 * RC + 8 * lane, v6);
    int t = gw; if (t >= T) return;
    PoIn A, B; post_load(A, p, t, lane);
    for (; t < T; t += 2 * NGW) { const int t1 = t + NGW, t2 = t1 + NGW;
        post_load(B, p, t1 < T ? t1 : t, lane); post_compute(A, p, t, lane, v4_, v5, v6);
        if (t1 < T) { post_load(A, p, t2 < T ? t2 : t1, lane); post_compute(B, p, t1, lane, v4_, v5, v6); } }
}
__device__ __forceinline__ void tr8x8(v4u& w, unsigned selA, bool b1, bool b2) {
    unsigned r[4] = {w.x, w.y, w.z, w.w};
#pragma unroll
    for (int i = 0; i < 4; ++i) { const unsigned pv = (unsigned)__builtin_amdgcn_update_dpp(0, (int)r[i], 0xB1, 0xF, 0xF, true); r[i] = __builtin_amdgcn_perm(pv, r[i], selA); }
#pragma unroll
    for (int a = 0; a < 4; a += 2) { const unsigned send = b1 ? r[a] : r[a + 1]; const unsigned recv = (unsigned)__builtin_amdgcn_update_dpp(0, (int)send, 0x4E, 0xF, 0xF, true);
        r[a] = b1 ? recv : r[a]; r[a + 1] = b1 ? r[a + 1] : recv; }
#pragma unroll
    for (int a = 0; a < 2; ++a) { const unsigned send = b2 ? r[a] : r[a + 2];
        int recv = __builtin_amdgcn_update_dpp(0, (int)send, 0x104, 0xF, 0x5, false);
        recv = __builtin_amdgcn_update_dpp(recv, (int)send, 0x114, 0xF, 0xA, false);
        r[a] = b2 ? (unsigned)recv : r[a]; r[a + 2] = b2 ? r[a + 2] : (unsigned)recv; }
    w.x = r[0]; w.y = r[1]; w.z = r[2]; w.w = r[3];
}
__device__ __forceinline__ void ph_vtransw(const P& p, int gw, int NGW, int lane_in) {
    int lane = lane_in; asm volatile("" : "+v"(lane));
    const bf16* KV = WSP(bf16, AR_KV); bf16* VsT = WSP(bf16, WS_VST); bf16* VwT = WSP(bf16, WS_VWT);
    const int j = lane & 7, c = lane >> 3; const unsigned selA = (lane & 1) ? 0x03020706u : 0x05040100u; const bool b1 = (lane & 2) != 0, b2 = (lane & 4) != 0;
    constexpr int NU = BATCH * NKV * (SEQ / 8);
    for (int u0 = gw * 4; u0 < NU; u0 += NGW * 4) {
        v4u s[4], w[4];
#pragma unroll
        for (int i = 0; i < 4; ++i) { const int u = u0 + i, kg = u % (SEQ / 8), bg = u / (SEQ / 8), b = bg / NKV, g = bg % NKV, tok = (kg >> 2) * 32 + 4 * (kg & 3) + (j & 3) + 16 * (j >> 2);
            const bf16* src = KV + (size_t)(b * SEQ + tok) * LDKV + g * 64 + 8 * c; s[i] = *(const v4u*)(src + 128); w[i] = *(const v4u*)(src + 384); }
#pragma unroll
        for (int i = 0; i < 4; ++i) { tr8x8(s[i], selA, b1, b2); tr8x8(w[i], selA, b1, b2);
            *(v4u*)(VsT + ((size_t)(u0 + i) * 64 + lane) * 8) = s[i]; *(v4u*)(VwT + ((size_t)(u0 + i) * 64 + lane) * 8) = w[i]; }
    }
}
typedef float f32x2 __attribute__((ext_vector_type(2)));
__device__ __forceinline__ f32x2 up2(unsigned w) { f32x2 r; r.x = __builtin_bit_cast(float, w << 16); r.y = __builtin_bit_cast(float, w & 0xffff0000u); return r; }
template <int JJ>
__device__ __forceinline__ void conv_row(f32x2 (&a)[8][4], f32x2 (&wt)[8][4], v4u (&cur)[8], f32x4& wn0, f32x4& wn1, const LAS float* wlane, const bf16* ub, int g, int j0) {
    const int j = 8 * g + JJ;
    wt[JJ][0] = (f32x2){wn0.x, wn0.y}; wt[JJ][1] = (f32x2){wn0.z, wn0.w}; wt[JJ][2] = (f32x2){wn1.x, wn1.y}; wt[JJ][3] = (f32x2){wn1.z, wn1.w};
    { const int jl = j + 1 < CONV_K ? j + 1 : CONV_K - 1; wn0 = *(const LAS f32x4*)(wlane + jl * CONV_CH); wn1 = *(const LAS f32x4*)(wlane + jl * CONV_CH + 4); }
    const unsigned msk = j >= j0 ? 0xffffffffu : 0u;
    f32x2 u[4]; u[0] = up2(cur[JJ].x & msk); u[1] = up2(cur[JJ].y & msk); u[2] = up2(cur[JJ].z & msk); u[3] = up2(cur[JJ].w & msk);
    { int jn = j + 8; jn = jn < j0 ? j0 : jn; jn = jn > CONV_K + 6 ? CONV_K + 6 : jn; cur[JJ] = *(const v4u*)(ub + (size_t)jn * CONV_CH); }
#pragma unroll
    for (int q = 0; q < 8; ++q) { const int tap = j - q; if (tap >= 0 && tap < CONV_K) {
#pragma unroll
        for (int i = 0; i < 4; ++i) a[q][i] = __builtin_elementwise_fma(u[i], wt[(JJ - q) & 7][i], a[q][i]); } }
}
__device__ __forceinline__ void ph_convw(const P& p, int layer, int gw, int NGW, int lane, int tid, LAS unsigned char* lds) {
    const bf16* UB = WSP(bf16, AR_UB); bf16* CO = WSP(bf16, AR_CO);
    const float* cw = p.conv_w + (size_t)layer * CONV_K * CONV_CH; const float* cv = p.conv_vec + (size_t)layer * 3 * CONV_CH;
    LAS float* wl = (LAS float*)lds;
    { f32x4 tw[8];
#pragma unroll
      for (int k = 0; k < 8; ++k) { const int i4 = tid + k * NTHREADS; tw[k] = i4 < CONV_K * CONV_CH / 4 ? *(const f32x4*)(cw + 4 * i4) : *(const f32x4*)(cv + 4 * (i4 - CONV_K * CONV_CH / 4)); }
      f32x4 tl = (f32x4){0.f, 0.f, 0.f, 0.f}; if (tid < 256) tl = *(const f32x4*)(cv + 4 * (tid + 8 * NTHREADS - CONV_K * CONV_CH / 4));
#pragma unroll
      for (int k = 0; k < 8; ++k) *(LAS f32x4*)(wl + 4 * (tid + k * NTHREADS)) = tw[k];
      if (tid < 256) *(LAS f32x4*)(wl + 4 * (tid + 8 * NTHREADS)) = tl; }
    TKQ(7);
    __syncthreads();
    TKQ(8);
    const LAS float* wlane = wl + 8 * lane;
    for (int tb = gw * 8; tb < T; tb += NGW * 8) {
        const int pos0 = tb % SEQ, j0 = pos0 >= 30 ? 0 : 30 - pos0;
        const bf16* ub = UB + ((size_t)tb * CONV_CH + 8 * lane) - (size_t)30 * CONV_CH;
        f32x2 a[8][4], wt[8][4]; v4u cur[8];
        { const f32x4 c0 = *(const LAS f32x4*)(wlane + CONV_K * CONV_CH), c1 = *(const LAS f32x4*)(wlane + CONV_K * CONV_CH + 4);
#pragma unroll
          for (int q = 0; q < 8; ++q) { a[q][0] = (f32x2){c0.x, c0.y}; a[q][1] = (f32x2){c0.z, c0.w}; a[q][2] = (f32x2){c1.x, c1.y}; a[q][3] = (f32x2){c1.z, c1.w}; } }
#pragma unroll
        for (int jj = 0; jj < 8; ++jj) cur[jj] = *(const v4u*)(ub + (size_t)(jj < j0 ? j0 : jj) * CONV_CH);
        f32x4 wn0 = *(const LAS f32x4*)(wlane), wn1 = *(const LAS f32x4*)(wlane + 4);
#pragma unroll 1
        for (int g = 0; g < 5; ++g) {
            conv_row<0>(a, wt, cur, wn0, wn1, wlane, ub, g, j0); conv_row<1>(a, wt, cur, wn0, wn1, wlane, ub, g, j0); conv_row<2>(a, wt, cur, wn0, wn1, wlane, ub, g, j0); conv_row<3>(a, wt, cur, wn0, wn1, wlane, ub, g, j0);
            conv_row<4>(a, wt, cur, wn0, wn1, wlane, ub, g, j0); conv_row<5>(a, wt, cur, wn0, wn1, wlane, ub, g, j0); conv_row<6>(a, wt, cur, wn0, wn1, wlane, ub, g, j0); conv_row<7>(a, wt, cur, wn0, wn1, wlane, ub, g, j0);
        }
        const f32x4 g10 = *(const LAS f32x4*)(wlane + (CONV_K + 1) * CONV_CH), g11 = *(const LAS f32x4*)(wlane + (CONV_K + 1) * CONV_CH + 4);
        const f32x4 b20 = *(const LAS f32x4*)(wlane + (CONV_K + 2) * CONV_CH), b21 = *(const LAS f32x4*)(wlane + (CONV_K + 2) * CONV_CH + 4);
        const f32x2 g1[4] = {(f32x2){g10.x, g10.y}, (f32x2){g10.z, g10.w}, (f32x2){g11.x, g11.y}, (f32x2){g11.z, g11.w}}, b2[4] = {(f32x2){b20.x, b20.y}, (f32x2){b20.z, b20.w}, (f32x2){b21.x, b21.y}, (f32x2){b21.z, b21.w}};
#pragma unroll
        for (int q = 0; q < 8; ++q) {
            const f32x2 s2 = (a[q][0] + a[q][1]) + (a[q][2] + a[q][3]);
            const float mean = wave_sum(s2.x + s2.y, lane) * (1.f / CONV_CH); f32x2 q2 = (f32x2){0.f, 0.f};
#pragma unroll
            for (int i = 0; i < 4; ++i) { a[q][i] -= (f32x2){mean, mean}; q2 = __builtin_elementwise_fma(a[q][i], a[q][i], q2); }
            const float rstd = 1.f / sqrtf(wave_sum(q2.x + q2.y, lane) * (1.f / CONV_CH) + LN_EPS);
            float y[8];
#pragma unroll
            for (int i = 0; i < 4; ++i) { const f32x2 yy = __builtin_elementwise_fma(a[q][i] * (f32x2){rstd, rstd}, g1[i], b2[i]); y[2 * i] = yy.x * fsig(yy.x); y[2 * i + 1] = yy.y * fsig(yy.y); }
            *(v4u*)(CO + (size_t)(tb + q) * CONV_CH + 8 * lane) = pk8(y);
        }
    }
    TKQ(9);
    __syncthreads();
}
__device__ __forceinline__ void ph_cmp2w(const P& p, int layer, int gw, int NGW, int lane, LAS float* hl  ) {
    const bf16* Z = WSP(bf16, AR_HID); const float* pec = (const float*)(p.ws + WS_W + (size_t)layer * SZ_LAYERW + OFF_PEC);
    for (int it = gw; it < 2 * BATCH * NKV * NC; it += NGW) {
        const int i = it % NC, r = it / NC, bg = r % (BATCH * NKV), which = r / (BATCH * NKV);
        const bf16* z1 = Z + ((size_t)which * (BATCH * NKV * 512) + (size_t)bg * 512 + i) * 256; const bf16* z2 = z1 + 256 + 128;
#pragma unroll
        for (int jj = 0; jj < 2; ++jj) { const int j = lane + 64 * jj; const float x = bf2f(z1[j]) + bf2f(z2[j]) + pec[which * 128 + j];
            const float e = __expf(fminf(2.f * 0.7978845608028654f * (x + 0.044715f * x * x * x), 30.f)); hl[j] = 0.5f * x * (1.f + (e - 1.f) / (e + 1.f)); }
        LDS_WAIT(); asm volatile("" ::: "memory");
        const float* w2 = p.cmp_w2 + (size_t)(layer * 2 + which) * 128 * 64 + lane; float o = 0.f;
#pragma unroll 8
        for (int j = 0; j < 128; ++j) o += hl[j] * w2[j * 64];
        if (which == 0) {
            const float rs = 1.f / sqrtf(wave_sum(o * o, lane) * (1.f / 64.f) + RMS_EPS); o = o * rs * p.qk_g[(layer * 4 + 1) * 64 + lane];
            const float other = bperm_f(o, lane ^ 32); float cs, sn; rope_cs(16 * i + 31, lane & 31, cs, sn);
            o = lane < 32 ? o * cs - other * sn : o * cs + other * sn;
            WSP(bf16, AR_KC)[(((size_t)bg * 8 + (lane >> 3)) * 512 + i) * 8 + (lane & 7)] = f2bf(o);
        } else { bf16* vt = WSP(bf16, AR_VCT) + (size_t)bg * 64 * 512 + lane * 8;
            vt[(size_t)((i >> 5) * 4 + ((i & 15) >> 2)) * 512 + (i & 3) + 4 * ((i >> 4) & 1)] = f2bf(o); if (i == 0) vt[(size_t)((NC >> 5) * 4 + ((NC & 15) >> 2)) * 512 + (NC & 3) + 4 * ((NC >> 4) & 1)] = 0; }
        LDS_WAIT(); asm volatile("" ::: "memory");
    }
}

struct MapPlain { bf16* base; int K; __device__ __forceinline__ bf16* operator()(int col) const { return base + (size_t)col * K; } };
struct MapGlu { bf16* base; int K, ff; __device__ __forceinline__ bf16* operator()(int col) const { return base + (size_t)glu_dest(col, ff) * K; } };
struct MapWin { unsigned char* wl; int layer; __device__ __forceinline__ bf16* operator()(int col) const { int which; const int r = win_dest(col, layer, which); const size_t off = (which ? OFF_WG : OFF_WIN) + (size_t)(r < 0 ? 0 : r) * DM * 2; return r < 0 ? nullptr : (bf16*)(wl + off); } };
template <class Map>
__device__ __forceinline__ void transpose_item(const float* W, int K, int N, const Map& mp, LAS float* scr, int item, int lane) {
    const int nblk = (N + 31) / 32, kb = item / nblk, nb = item % nblk, k0 = 64 * kb, n0 = 32 * nb;
    const int c4 = 4 * (lane & 7), col = n0 + c4;
    f32x4 v[8];
#pragma unroll
    for (int i = 0; i < 8; ++i) v[i] = col < N ? *(const f32x4*)(W + (size_t)(k0 + (lane >> 3) + 8 * i) * N + col) : (f32x4){0.f, 0.f, 0.f, 0.f};
#pragma unroll
    for (int i = 0; i < 8; ++i) { LAS float* d = scr + ((lane >> 3) + 8 * i) * 33 + c4; d[0] = v[i].x; d[1] = v[i].y; d[2] = v[i].z; d[3] = v[i].w; }
    LDS_WAIT(); asm volatile("" ::: "memory");
    const int c = lane & 7;
#pragma unroll
    for (int j = 0; j < 4; ++j) { const int n = (lane >> 3) + 8 * j; const LAS float* s = scr + (8 * c) * 33 + n;
        v4u o; o.x = (unsigned)f2bf(s[0]) | ((unsigned)f2bf(s[33]) << 16); o.y = (unsigned)f2bf(s[66]) | ((unsigned)f2bf(s[99]) << 16);
        o.z = (unsigned)f2bf(s[132]) | ((unsigned)f2bf(s[165]) << 16); o.w = (unsigned)f2bf(s[198]) | ((unsigned)f2bf(s[231]) << 16);
        if (n0 + n < N) { bf16* d = mp(n0 + n); if (d) *(v4u*)(d + k0 + 8 * c) = o; } }
    LDS_WAIT(); asm volatile("" ::: "memory");
}
template <class Map>
__device__ __forceinline__ bool conv_job(int& r, const float* W, int K, int N, const Map& mp, LAS float* scr, int lane) {
    const int items = (K / 64) * ((N + 31) / 32);
    if (r < items) { transpose_item(W, K, N, mp, scr, r, lane); return true; }
    r -= items; return false;
}

struct RmsIn { f32x4 v[DM / 256]; };
__device__ __forceinline__ void rms_load(RmsIn& r, const float* xrow, int lane) { const f32x4* xr = (const f32x4*)xrow + lane;
#pragma unroll
    for (int j = 0; j < DM / 256; ++j) r.v[j] = xr[64 * j]; }
__device__ __forceinline__ void rms_row(const P& p, const RmsIn& rin, const float* g, bf16* orow, int lane, bool route, int t, unsigned long long& c0, unsigned long long& c1) {
    const f32x4* gr = (const f32x4*)g + lane;
    f32x4 v[DM / 256]; float ss = 0.f;
#pragma unroll
    for (int j = 0; j < DM / 256; ++j) { v[j] = rin.v[j]; ss += (v[j].x * v[j].x + v[j].y * v[j].y) + (v[j].z * v[j].z + v[j].w * v[j].w); }
    const float rs = 1.f / sqrtf(wave_sum(ss, lane) * (1.f / DM) + RMS_EPS);
    v2u* o8 = (v2u*)orow + lane;
#pragma unroll
    for (int j = 0; j < DM / 256; ++j) { const f32x4 gg = gr[64 * j]; v[j].x *= rs * gg.x; v[j].y *= rs * gg.y; v[j].z *= rs * gg.z; v[j].w *= rs * gg.w;
        v2u w; w.x = cvt_pk_bf16(v[j].x, v[j].y); w.y = cvt_pk_bf16(v[j].z, v[j].w); o8[64 * j] = w; }
    if (route) {
        float lg[NEXP];
#pragma unroll
        for (int e = 0; e < NEXP; ++e) lg[e] = 0.f;
#pragma unroll
        for (int j = 0; j < DM / 256; ++j) { const float* rw = p.router_w + (size_t)(4 * (lane + 64 * j)) * NEXP;
#pragma unroll
            for (int e = 0; e < NEXP; ++e) lg[e] += v[j].x * rw[e] + v[j].y * rw[NEXP + e] + v[j].z * rw[2 * NEXP + e] + v[j].w * rw[3 * NEXP + e]; }
#pragma unroll
        for (int e = 0; e < NEXP; ++e) lg[e] = wave_sum(lg[e], lane) + p.router_b[e];
        int e0 = 0; float l0 = lg[0];
#pragma unroll
        for (int e = 1; e < NEXP; ++e) if (lg[e] > l0) { l0 = lg[e]; e0 = e; }
        int e1 = -1; float l1 = -3e38f;
#pragma unroll
        for (int e = 0; e < NEXP; ++e) if (e != e0 && lg[e] > l1) { l1 = lg[e]; e1 = e; }
        e0 = __builtin_amdgcn_readfirstlane(e0); e1 = __builtin_amdgcn_readfirstlane(e1);
        const int r0 = (int)((c0 >> (8 * e0)) & 255ull), r1 = (int)((c1 >> (8 * e1)) & 255ull);
        c0 += 1ull << (8 * e0); c1 += 1ull << (8 * e1);
        if (lane == 0) { const float w0 = 1.f / (1.f + expf(l1 - l0));
            WSP(int, AR_RTE)[t] = e0 | (e1 << 8) | (r0 << 16) | (r1 << 24); float* rw = WSP(float, AR_RTW) + (size_t)t * 2; rw[0] = w0; rw[1] = 1.f - w0; }
    }
}
__device__ __forceinline__ void rms_row_route(const P& p, const RmsIn& rin, const float* g, bf16* orow, int lane, int t, unsigned long long& c0, unsigned long long& c1, const float (&rwr)[128]) {
    const f32x4* gr = (const f32x4*)g + lane;
    f32x4 v[DM / 256]; float ss = 0.f;
#pragma unroll
    for (int j = 0; j < DM / 256; ++j) { v[j] = rin.v[j]; ss += (v[j].x * v[j].x + v[j].y * v[j].y) + (v[j].z * v[j].z + v[j].w * v[j].w); }
    const float rs = 1.f / sqrtf(wave_sum(ss, lane) * (1.f / DM) + RMS_EPS);
    v2u* o8 = (v2u*)orow + lane;
#pragma unroll
    for (int j = 0; j < DM / 256; ++j) { const f32x4 gg = gr[64 * j]; v[j].x *= rs * gg.x; v[j].y *= rs * gg.y; v[j].z *= rs * gg.z; v[j].w *= rs * gg.w;
        v2u w; w.x = cvt_pk_bf16(v[j].x, v[j].y); w.y = cvt_pk_bf16(v[j].z, v[j].w); o8[64 * j] = w; }
    float lg[NEXP];
#pragma unroll
    for (int e = 0; e < NEXP; ++e) lg[e] = 0.f;
#pragma unroll
    for (int j = 0; j < DM / 256; ++j)
#pragma unroll
        for (int e = 0; e < NEXP; ++e) lg[e] += v[j].x * rwr[(4 * j) * 8 + e] + v[j].y * rwr[(4 * j + 1) * 8 + e] + v[j].z * rwr[(4 * j + 2) * 8 + e] + v[j].w * rwr[(4 * j + 3) * 8 + e];
    float r4[4], r2[2], r1;
    { const bool hi = (lane & 32) != 0;
#pragma unroll
      for (int i = 0; i < 4; ++i) { const float mine = hi ? lg[4 + i] : lg[i], theirs = hi ? lg[i] : lg[4 + i]; r4[i] = mine + bperm_f(theirs, lane ^ 32); } }
    { const bool hi = (lane & 16) != 0;
#pragma unroll
      for (int i = 0; i < 2; ++i) { const float mine = hi ? r4[2 + i] : r4[i], theirs = hi ? r4[i] : r4[2 + i]; r2[i] = mine + bperm_f(theirs, lane ^ 16); } }
    { const bool hi = (lane & 8) != 0; const float mine = hi ? r2[1] : r2[0], theirs = hi ? r2[0] : r2[1]; r1 = mine + bperm_f(theirs, lane ^ 8); }
    r1 += bperm_f(r1, lane ^ 4); r1 += bperm_f(r1, lane ^ 2); r1 += bperm_f(r1, lane ^ 1);
#pragma unroll
    for (int e = 0; e < NEXP; ++e) lg[e] = __builtin_bit_cast(float, __builtin_amdgcn_readlane(__builtin_bit_cast(int, r1), 8 * e)) + p.router_b[e];
    int e0 = 0; float l0 = lg[0];
#pragma unroll
    for (int e = 1; e < NEXP; ++e) if (lg[e] > l0) { l0 = lg[e]; e0 = e; }
    int e1 = -1; float l1 = -3e38f;
#pragma unroll
    for (int e = 0; e < NEXP; ++e) if (e != e0 && lg[e] > l1) { l1 = lg[e]; e1 = e; }
    e0 = __builtin_amdgcn_readfirstlane(e0); e1 = __builtin_amdgcn_readfirstlane(e1);
    const int r0 = (int)((c0 >> (8 * e0)) & 255ull), r1i = (int)((c1 >> (8 * e1)) & 255ull);
    c0 += 1ull << (8 * e0); c1 += 1ull << (8 * e1);
    if (lane == 0) { const float w0 = 1.f / (1.f + expf(l1 - l0));
        WSP(int, AR_RTE)[t] = e0 | (e1 << 8) | (r0 << 16) | (r1i << 24); float* rw = WSP(float, AR_RTW) + (size_t)t * 2; rw[0] = w0; rw[1] = 1.f - w0; }
}
__device__ __forceinline__ void copy_rows4(const bf16* s0, const bf16* s1, const bf16* s2, const bf16* s3, bf16* d0, bf16* d1, bf16* d2, bf16* d3, int lane) {
    v4u a[4][DM / 512];
#pragma unroll
    for (int j = 0; j < DM / 512; ++j) { a[0][j] = ((const v4u*)s0)[lane + 64 * j]; a[1][j] = ((const v4u*)s1)[lane + 64 * j]; a[2][j] = ((const v4u*)s2)[lane + 64 * j]; a[3][j] = ((const v4u*)s3)[lane + 64 * j]; }
#pragma unroll
    for (int j = 0; j < DM / 512; ++j) { ((v4u*)d0)[lane + 64 * j] = a[0][j]; ((v4u*)d1)[lane + 64 * j] = a[1][j]; ((v4u*)d2)[lane + 64 * j] = a[2][j]; ((v4u*)d3)[lane + 64 * j] = a[3][j]; }
}
__device__ __forceinline__ void copy_row_wave(const bf16* src, bf16* dst, int lane) {
#pragma unroll
    for (int j = 0; j < DM / 512; ++j) ((v4u*)dst)[lane + 64 * j] = ((const v4u*)src)[lane + 64 * j];
}
__device__ __forceinline__ int moe_seg_start(const unsigned* cnt, int e) { int s = 0;
#pragma unroll
    for (int k = 0; k < NEXP; ++k) s += (k < e) ? (int)((cnt[k] + 255u) & ~255u) : 0;
    return s; }

#ifndef STAG_GATE
#define STAG_GATE 700
#endif
__device__ __forceinline__ void stagger_start(int bid, int ticks) {
    const unsigned long long t0 = __builtin_amdgcn_s_memrealtime(), dl = (unsigned long long)(((bid >> 3) & 3) * ticks);
    while (__builtin_amdgcn_s_memrealtime() - t0 < dl) __builtin_amdgcn_s_sleep(16);
}
#ifndef PHMASK
#define PHMASK 0xFFFFFFFFu
#endif
#define PHM(k) (((PHMASK) >> (k)) & 1u)
#ifdef PROBE_LO
constexpr int PR_LO = PROBE_LO, PR_HI = PROBE_HI;
#else
constexpr int PR_LO = -1, PR_HI = -1;
#endif
constexpr int NPH = 16, NPHASES = 1 + 2 * NPH;
struct Args { const float* in[29]; float* out; unsigned char* ws; int ph_lo, ph_hi; };

__device__ __forceinline__ bool in_phase(int k, int lo, int hi) { asm volatile("" : "+s"(lo), "+s"(hi)); return lo <= k && k < hi; }
typedef const Args __attribute__((address_space(4)))* CArgsP;
__device__ __forceinline__ void fill_params_k(P& p, CArgsP a) {
    p.x = a->in[0]; p.mix_norm_g = a->in[1]; p.w_in_first = a->in[2]; p.w_in_rest = a->in[3]; p.mu_first = a->in[4]; p.mu_rest = a->in[5]; p.qk_g = a->in[6]; p.cmp_pos = a->in[7];
    p.cmp_w1 = a->in[8]; p.cmp_w2 = a->in[9]; p.nsa_w_o = a->in[10]; p.conv_w = a->in[11]; p.conv_vec = a->in[12]; p.conv_w_o = a->in[13]; p.rwkv_vec = a->in[14]; p.w_up = a->in[15];
    p.a_up = a->in[16]; p.g_up = a->in[17]; p.vres_up = a->in[18]; p.vres_b = a->in[19]; p.rwkv_w_o = a->in[20]; p.w_out = a->in[21]; p.ffn_norm_g = a->in[22]; p.dense_gu = a->in[23];
    p.dense_down = a->in[24]; p.router_w = a->in[25]; p.router_b = a->in[26]; p.moe_gu = a->in[27]; p.moe_down = a->in[28]; p.out = a->out; p.ws = a->ws;
}
__global__ void __launch_bounds__(NTHREADS, 2) mk_fwd(Args args) {
    extern __shared__ __attribute__((aligned(16))) unsigned char lds_raw[];
    LAS unsigned char* lds = (LAS unsigned char*)lds_raw;
    const int wave0 = __builtin_amdgcn_readfirstlane((int)threadIdx.x >> 6);
    const int tid = wave0 * 64 + lane_id_opaque();
    unsigned* ctl = (unsigned*)(args.ws + WS_CTL);
    for (int u = tid; u < (LDS_BYTES - LDSCTL_OFF) / 4; u += NTHREADS) ((LAS unsigned*)(lds + LDSCTL_OFF))[u] = 0u;
    __syncthreads();
    const int lo = args.ph_lo, hi = args.ph_hi;
    XcdBarrier bar; bar.bar = ctl + CW_BAR; bar.x = 0; bar.st = nullptr;
    if (hi - lo > 1) { bar.x = xb_xcc_id(); bar.st = (volatile LAS unsigned*)(lds + MISC_OFF) + 8; if (tid == 0) (void)xb_add(ctl + CW_BAR + XB_XCNT(bar.x), 1u); }
#define RMS_LOOP(X, GN, ROUTE, C0, C1) do { int m_ = gw; if (m_ < T) { RmsIn ra_, rb_; rms_load(ra_, (X) + (size_t)m_ * DM, lane); \
        for (; m_ < T; m_ += 2 * NGW) { const int m1_ = m_ + NGW, m2_ = m1_ + NGW; rms_load(rb_, (X) + (size_t)(m1_ < T ? m1_ : m_) * DM, lane); \
            rms_row(p, ra_, (GN), WSP(bf16, WS_H) + (size_t)m_ * DM, lane, (ROUTE), m_, C0, C1); \
            if (m1_ < T) { rms_load(ra_, (X) + (size_t)(m2_ < T ? m2_ : m1_) * DM, lane); rms_row(p, rb_, (GN), WSP(bf16, WS_H) + (size_t)m1_ * DM, lane, (ROUTE), m1_, C0, C1); } } } } while (0)
#define RMS_LOOP_R(X, GN, C0, C1, RWR) do { int m_ = gw; if (m_ < T) { RmsIn ra_, rb_; rms_load(ra_, (X) + (size_t)m_ * DM, lane); \
        for (; m_ < T; m_ += 2 * NGW) { const int m1_ = m_ + NGW, m2_ = m1_ + NGW; rms_load(rb_, (X) + (size_t)(m1_ < T ? m1_ : m_) * DM, lane); \
            rms_row_route(p, ra_, (GN), WSP(bf16, WS_H) + (size_t)m_ * DM, lane, m_, C0, C1, RWR); \
            if (m1_ < T) { rms_load(ra_, (X) + (size_t)(m2_ < T ? m2_ : m1_) * DM, lane); rms_row_route(p, rb_, (GN), WSP(bf16, WS_H) + (size_t)m1_ * DM, lane, m1_, C0, C1, RWR); } } } } while (0)
#define IN(k) (in_phase((k), lo, hi) && (PR_LO < 0 || (st == 0 ? (k) <= PR_HI : (st == 1 ? ((k) >= PR_LO && (k) <= PR_HI) : (k) > PR_HI))))
#define MKP unsigned long long cdum0 = 0ull, cdum1 = 0ull; (void)cdum0; (void)cdum1; CArgsP ap_ = (CArgsP)__builtin_amdgcn_kernarg_segment_ptr(); asm volatile("" : "+s"(ap_)); P p; fill_params_k(p, ap_); int w0_ = wave0; asm volatile("" : "+s"(w0_)); int tid = w0_ * 64 + lane_id_opaque(); asm volatile("" : "+v"(tid)); const int lane = tid & 63, wave = __builtin_amdgcn_readfirstlane(tid >> 6); int G = gridDim.x, bid = blockIdx.x; asm volatile("" : "+s"(G), "+s"(bid)); unsigned* ctl = WSP(unsigned, WS_CTL); const long gtid = (long)bid * NTHREADS + tid, NT = (long)G * NTHREADS; const int gw = bid * NWAVES + wave, NGW = G * NWAVES; LAS float* scrw = (LAS float*)(lds + wave * 16384); (void)gtid; (void)NT; (void)gw; (void)NGW; (void)scrw; (void)lane; (void)ctl
#ifdef PROBE_TK
#define TKW(i) do { if (blockIdx.x == PROBE_BLK && threadIdx.x == 0) ((unsigned long long*)(args.ws + WS_CTL + 4 * CW_TK))[(i)] = __builtin_amdgcn_s_memrealtime(); } while (0)
#define TKP(i) do { if (layer == PROBE_LAYER) TKW(i); } while (0)
#define TKB() do { if (layer == PROBE_LAYER && threadIdx.x == 0) ((unsigned long long*)(args.ws + WS_CTL + 4 * CW_TK))[32 + blockIdx.x] = __builtin_amdgcn_s_memrealtime(); } while (0)
#define SEAM(k) do { if ((k) + 1 < hi) { int w_ = wave0; asm volatile("" : "+s"(w_)); xcd_barrier(bar, w_ * 64 + lane_id_opaque()); } \
    if ((k) == PROBE_TK) TKW(1); if ((k) == PROBE_TK - 1) TKW(0); } while (0)
#else
#define TKP(i) do { } while (0)
#define TKB() do { } while (0)
#define SEAM(k) do { if ((k) + 1 < hi) { int w_ = wave0; asm volatile("" : "+s"(w_)); xcd_barrier(bar, w_ * 64 + lane_id_opaque()); } } while (0)
#endif

    for (int st = 0; st < (PR_LO >= 0 ? 3 : 1); ++st) {
    if (PHM(16) && IN(0)) { MKP;
        constexpr int IT_WIN0 = (DM / 64) * ((N_IN_FIRST + 31) / 32), IT_WIN1 = (DM / 64) * ((N_IN_REST + 31) / 32), IT_WO = (512 / 64) * (DM / 32), IT_WOUT = (DM / 64) * (DM / 32);
        constexpr int total = IT_WIN0 + IT_WIN1 + 6 * IT_WO + 2 * IT_WOUT + (DM / 64) * (2 * DENSE_FF / 32) + (DENSE_FF / 64) * (DM / 32);
        bf16* wl0 = WSP(bf16, WS_W); bf16* wl1 = WSP(bf16, WS_W + SZ_LAYERW);
#define WOFF(b, o) ((bf16*)((unsigned char*)(b) + (o)))
        for (int it = gw; it < total; it += NGW) {
            int r = it;
            if (conv_job(r, p.w_in_first, DM, N_IN_FIRST, MapWin{(unsigned char*)wl0, 0}, scrw, lane)) continue;
            if (conv_job(r, p.w_in_rest, DM, N_IN_REST, MapWin{(unsigned char*)wl1, 1}, scrw, lane)) continue;
            if (conv_job(r, p.nsa_w_o, 512, DM, MapPlain{WOFF(wl0, OFF_WO3), 512}, scrw, lane)) continue;
            if (conv_job(r, p.rwkv_w_o, 512, DM, MapPlain{WOFF(wl0, OFF_WO3) + (size_t)DM * 512, 512}, scrw, lane)) continue;
            if (conv_job(r, p.conv_w_o, 512, DM, MapPlain{WOFF(wl0, OFF_WO3) + (size_t)2 * DM * 512, 512}, scrw, lane)) continue;
            if (conv_job(r, p.nsa_w_o + (size_t)512 * DM, 512, DM, MapPlain{WOFF(wl1, OFF_WO3), 512}, scrw, lane)) continue;
            if (conv_job(r, p.rwkv_w_o + (size_t)512 * DM, 512, DM, MapPlain{WOFF(wl1, OFF_WO3) + (size_t)DM * 512, 512}, scrw, lane)) continue;
            if (conv_job(r, p.conv_w_o + (size_t)512 * DM, 512, DM, MapPlain{WOFF(wl1, OFF_WO3) + (size_t)2 * DM * 512, 512}, scrw, lane)) continue;
            if (conv_job(r, p.w_out, DM, DM, MapPlain{WOFF(wl0, OFF_WOUT), DM}, scrw, lane)) continue;
            if (conv_job(r, p.w_out + (size_t)DM * DM, DM, DM, MapPlain{WOFF(wl1, OFF_WOUT), DM}, scrw, lane)) continue;
            if (conv_job(r, p.dense_gu, DM, 2 * DENSE_FF, MapGlu{WSP(bf16, WS_DGU), DM, DENSE_FF}, scrw, lane)) continue;
            conv_job(r, p.dense_down, DENSE_FF, DM, MapPlain{WSP(bf16, WS_DDN), DENSE_FF}, scrw, lane);
        }
        for (int l = 0; l < 2; ++l) {
            unsigned char* wlb = p.ws + WS_W + (size_t)l * SZ_LAYERW;
            bf16* win = (bf16*)(wlb + OFF_WIN);
            for (long i = gtid; i < 512L * DM; i += NT) { const int w = (int)(i / DM); const bool src = w < 288 || (w < 320 && l == 1) || (w >= 320 && w < 344); if (!src) win[(size_t)(3840 + w) * DM + i % DM] = 0; }
            bf16* lw = (bf16*)(wlb + OFF_LW);
            for (long i = gtid; i < 2048L * 384; i += NT) { const int n = (int)(i / 384), k = (int)(i % 384), blk = n >> 9, c = n & 511; float v = 0.f;
                if (blk == 0 && k < 64) v = p.w_up[((size_t)l * 64 + k) * RC + c]; else if (blk == 1 && k >= 64 && k < 128) v = p.a_up[((size_t)l * 64 + k - 64) * RC + c];
                else if (blk == 2 && k >= 128 && k < 288) v = p.g_up[((size_t)l * 160 + k - 128) * RC + c]; else if (blk == 3 && k >= 288 && k < 320 && l == 1) v = p.vres_up[(size_t)(k - 288) * RC + c];
                lw[i] = f2bf(v); }
            bf16* cw1 = (bf16*)(wlb + OFF_CW1);
            for (long i = gtid; i < 2L * 256 * 1024; i += NT) { const int k = (int)(i % 1024), n = (int)((i / 1024) % 256), which = (int)(i / (256 * 1024));
                cw1[i] = f2bf(p.cmp_w1[((size_t)(l * 2 + which) * 2048 + (n < 128 ? k : 1024 + k)) * 128 + (n & 127)]); }
        }
        for (int job = bid; job < 4; job += G) { const int l = job >> 1, which = job & 1;
            const float* pe = p.cmp_pos + (size_t)(l * 2 + which) * 2048; const float* w1 = p.cmp_w1 + (size_t)(l * 2 + which) * 2048 * 128 + 2 * lane;
            float s0 = 0.f, s1 = 0.f;
#pragma unroll 8
            for (int k = wave * 256; k < wave * 256 + 256; ++k) { const float2 wv = *(const float2*)(w1 + (size_t)k * 128); const float pk = pe[k]; s0 += pk * wv.x; s1 += pk * wv.y; }
            scrw[2 * lane] = s0; scrw[2 * lane + 1] = s1;
            __syncthreads();
            if (tid < 128) { float sum = 0.f;
#pragma unroll
                for (int w = 0; w < NWAVES; ++w) sum += ((const LAS float*)(lds + w * 16384))[tid];
                ((float*)(p.ws + WS_W + (size_t)l * SZ_LAYERW + OFF_PEC))[which * 128 + tid] = sum; }
            __syncthreads();
        }
    }

    for (int layer = 0; layer < 2; ++layer) {
        const int pb = 1 + layer * NPH;
        if (PHM(0) && IN(pb + 0)) { MKP;
            const float* xin = layer == 0 ? p.x : p.out;
            RMS_LOOP(xin, p.mix_norm_g + (size_t)layer * DM, false, cdum0, cdum1);
            SEAM(pb + 0);
        }
        if (PHM(1) && IN(pb + 1)) { MKP;
            Gemm g{WSP(bf16, WS_H), (const bf16*)(p.ws + WS_W + (size_t)layer * SZ_LAYERW + OFF_WIN), T, NPROJ, DM}; SOrder S; S.init(T, NPROJ, G, bid);
            EpiProj E{p.ws};
            pg8::gemm_phase<EpiProj, SOrder, true, true>(lds, g, S, E, tid);
            SEAM(pb + 1);
        }
        if (PHM(2) && IN(pb + 2)) { MKP;
            { Gemm g{WSP(bf16, AR_CKV), (const bf16*)(p.ws + WS_W + (size_t)layer * SZ_LAYERW + OFF_CW1), 2 * BATCH * NKV * 512, 512, 1024, 0}; StackOrder S{BATCH * NKV * 512 / 256, 1, 2, G, bid};
              EpiStore E{WSP(bf16, AR_HID), 256, 1};
              pg8::gemm_phase<EpiStore, StackOrder, true, true>(lds, g, S, E, tid); }
            TKP(2); ph_shift(p, layer, gtid, NT); TKP(3); ph_nsa_prep(p, layer, gtid, NT); TKP(4); ph_vtransw(p, gw, NGW, lane); TKP(5);
            ph_convw(p, layer, gw, NGW, lane, tid, lds); TKP(6); TKB();
#ifdef APROBE_CONV
            ph_convw(p, layer, gw, NGW, lane, tid, lds);
#endif
#ifdef APROBE_VT
            ph_vtransw(p, gw, NGW, lane);
#endif
            SEAM(pb + 2); }
        if (PHM(3) && IN(pb + 3)) { MKP;
#ifndef LORA_NAIVE
            { const bf16* LBp = WSP(bf16, WS_LB); const bf16* LWp = (const bf16*)(p.ws + WS_W + (size_t)layer * SZ_LAYERW + OFF_LW);
              { Gemm g{LBp, LWp, T, 1024, 128, 384, 384}; SOrder S; S.init(T, 1024, G, bid); EpiLora E{p.ws, 0}; pg8::gemm_phase<EpiLora, SOrder, false, true>(lds, g, S, E, tid); }
              { Gemm g{LBp + 128, LWp + (size_t)1024 * 384 + 128, T, 512, 256, 384, 384}; SOrder S; S.init(T, 512, G, bid); EpiLora E{p.ws, 4}; pg8::gemm_phase<EpiLora, SOrder, false, true>(lds, g, S, E, tid); }
              if (layer == 1) { Gemm g{LBp + 256, LWp + (size_t)1536 * 384 + 256, T, 512, 128, 384, 384}; SOrder S; S.init(T, 512, G, bid); EpiLora E{p.ws, 6}; pg8::gemm_phase<EpiLora, SOrder, false, true>(lds, g, S, E, tid); } }
#else
            { bf16* RW = WSP(bf16, AR_RW); bf16* Wm = WSP(bf16, AR_W); bf16* Am = WSP(bf16, AR_A); bf16* Gm = WSP(bf16, AR_G); const bf16* VF = WSP(bf16, WS_VF);
              const float* vec = p.rwkv_vec + (size_t)layer * 7 * RC; const float* wup = p.w_up + (size_t)layer * 64 * RC; const float* aup = p.a_up + (size_t)layer * 64 * RC; const float* gup = p.g_up + (size_t)layer * 160 * RC;
              for (long it = gtid; it < (long)T * RC; it += NT) { const int t = (int)(it / RC), c = (int)(it % RC); bf16* row = RW + (size_t)t * LDRW; const bf16* L = row + LBLK;
                  float wl = vec[c], alin = vec[RC + c], g = 0.f;
                  for (int j = 0; j < 64; ++j) { wl += bf2f(L[j]) * bf2f(f2bf(wup[j * RC + c])); alin += bf2f(L[64 + j]) * bf2f(f2bf(aup[j * RC + c])); }
                  for (int j = 0; j < 160; ++j) g += bf2f(L[128 + j]) * bf2f(f2bf(gup[j * RC + c]));
                  const float nx = -wl, sp = fmaxf(nx, 0.f) + __logf(1.f + __expf(-fabsf(nx))), e = __expf(-sp - 0.5f);
                  Wm[it] = f2bf(1.f - __expf(-e)); Am[it] = f2bf(fsig(alin)); Gm[it] = f2bf(g);
                  if (layer == 1) { float vl = p.vres_b[c]; for (int j = 0; j < 32; ++j) vl += bf2f(L[288 + j]) * bf2f(f2bf(p.vres_up[j * RC + c]));
                      const float v = bf2f(row[1024 + c]), vf = bf2f(VF[it]); row[1024 + c] = f2bf(v + (vf - v) * fsig(vl)); } } }
#endif
            SEAM(pb + 3); }
        if (PHM(4) && IN(pb + 4)) { MKP; ph_rwkv_b2w(p, layer, gw, NGW, lane); ph_cmp2w(p, layer, gw, NGW, lane, (LAS float*)(lds + wave * 512)); SEAM(pb + 4); }
        if (PHM(5) && IN(pb + 5)) { MKP;
            { LAS unsigned char* wl = lds + wave * AW_BYTES; constexpr int NSC = BATCH * 8 * 16, NIT = BATCH * NKV * (SEQ / 16);
#ifndef SCAN_QUEUE
              if (wave < 4) {
                  if (G * 4 == NSC && (G & 7) == 0) scan_unit(p, (bid & 7) * (NSC / 8) + (bid >> 3) * 4 + wave, lane, wl);
                  else for (int u = bid * 4 + wave; u < NSC; u += G * 4) scan_unit(p, u, lane, wl); }
#endif
#ifdef APROBE_SPLIT
              xcd_barrier(bar, tid);
#endif
              const int xme = (int)(xb_xcc_id() & 7u);
              for (int qq = 0; qq < 8; ++qq) { const int qx = (xme + qq) & 7; unsigned* head = ctl + CW_ATT + ((layer * 3 + st) * 8 + qx) * 16;
                  for (;;) { int it = 0; if (lane == 0) it = (int)atomicAdd(head, 1u); it = __builtin_amdgcn_readfirstlane(it); if (it >= NIT / 8) break;
                      const int bg = 2 * qx + it / (SEQ / 16), t16 = (SEQ / 16 - 1) - it % (SEQ / 16);
                      nsa_attn_item(p, bg * (SEQ / 16) + t16, lane, wl); } } }
 SEAM(pb + 5); }
        if (PHM(6) && IN(pb + 6)) { MKP; ph_rwkv_postw(p, layer, gw, NGW, lane); SEAM(pb + 6); }
        if (PHM(7) && IN(pb + 7)) { MKP;
            Gemm g{WSP(bf16, AR_QB), (const bf16*)(p.ws + WS_W + (size_t)layer * SZ_LAYERW + OFF_WO3), 3 * T, 3 * DM, 512}; StackOrder S{T / 256, DM / 256, 3, G, bid};
            EpiStore E{WSP(bf16, AR_OBUF), DM, DM / 256};
            pg8::gemm_phase<EpiStore, StackOrder, true, true>(lds, g, S, E, tid);
            { MKP; const float* xin = layer == 0 ? p.x : p.out;
              RMS_LOOP(xin, p.mix_norm_g + (size_t)layer * DM, false, cdum0, cdum1); }
            SEAM(pb + 7);
        }
        if (PHM(8) && IN(pb + 8)) { MKP;
            Gemm g{WSP(bf16, WS_H), (const bf16*)(p.ws + WS_W + (size_t)layer * SZ_LAYERW + OFF_WG), T, 3 * DM, DM}; GateOrder S{T / 256, DM / 256, G, bid};
            EpiGate E{p.ws, DM / 256};
            pg8::gemm_phase<EpiGate, GateOrder, true, true>(lds, g, S, E, tid);
            SEAM(pb + 8);
        }
        if (PHM(9) && IN(pb + 9)) { MKP;
            Gemm g{WSP(bf16, AR_MIX), (const bf16*)(p.ws + WS_W + (size_t)layer * SZ_LAYERW + OFF_WOUT), T, DM, DM}; SOrder S; S.init(T, DM, G, bid);
            EpiResid E{layer == 0 ? p.x : p.out, p.out};
            pg8::gemm_phase<EpiResid, SOrder, true, true>(lds, g, S, E, tid);
            SEAM(pb + 9);
        }
        if (PHM(10) && IN(pb + 10)) { MKP;
            unsigned long long c0 = 0ull, c1 = 0ull;
            if (layer == 1) { float rwr[128];
#pragma unroll
                for (int j = 0; j < DM / 256; ++j)
#pragma unroll
                    for (int k = 0; k < 8; ++k) { const f32x4 w4 = *(const f32x4*)(p.router_w + (size_t)(4 * (lane + 64 * j)) * NEXP + 4 * k); rwr[j * 32 + 4 * k] = w4.x; rwr[j * 32 + 4 * k + 1] = w4.y; rwr[j * 32 + 4 * k + 2] = w4.z; rwr[j * 32 + 4 * k + 3] = w4.w; }
                RMS_LOOP_R(p.out, p.ffn_norm_g + (size_t)layer * DM, c0, c1, rwr);
            } else RMS_LOOP(p.out, p.ffn_norm_g + (size_t)layer * DM, false, c0, c1);
            if (layer == 1 && lane < 16) {
                const unsigned cn = (unsigned)(((lane < 8 ? c0 : c1) >> (8 * (lane & 7))) & 255ull);
                WSP(unsigned, AR_WBASE)[(size_t)gw * 16 + lane] = atomicAdd(ctl + CW_CNT + lane * 64, cn); }
            if (layer == 1) { int* rt = WSP(int, AR_RTOK); for (long i = gtid; i < 2L * MOE_ROWS; i += NT) rt[i] = -1; }
            SEAM(pb + 10);
        }
        if (layer == 0) {
            if (PHM(11) && IN(pb + 11)) { MKP;
                Gemm g{WSP(bf16, WS_H), WSP(bf16, WS_DGU), T, 2 * DENSE_FF, DM}; SOrder S; S.init(T, 2 * DENSE_FF, G, bid);
                EpiSwiglu E{WSP(bf16, AR_ACT), DENSE_FF, 2 * DENSE_FF / 256};
                pg8::gemm_phase<EpiSwiglu, SOrder, true, true>(lds, g, S, E, tid);
                SEAM(pb + 11);
            }
            if (PHM(12) && IN(pb + 12)) { MKP;
                Gemm g{WSP(bf16, AR_ACT), WSP(bf16, WS_DDN), T, DM, DENSE_FF}; SOrder S; S.init(T, DM, G, bid);
                EpiResid E{p.out, p.out};
                pg8::gemm_phase<EpiResid, SOrder, true, true>(lds, g, S, E, tid);
                SEAM(pb + 12);
            }
        } else {
            if (PHM(11) && IN(pb + 11)) { MKP;
                const int ig = (DM / 64) * (2 * EXPERT_FF / 32), id = (EXPERT_FF / 64) * (DM / 32);
                for (int it = gw; it < NEXP * (ig + id); it += NGW) { const int e = it / (ig + id); int r = it % (ig + id);
                    if (conv_job(r, p.moe_gu + (size_t)e * DM * 2 * EXPERT_FF, DM, 2 * EXPERT_FF, MapGlu{WSP(bf16, AR_MGU) + (size_t)e * 2 * EXPERT_FF * DM, DM, EXPERT_FF}, scrw, lane)) continue;
                    conv_job(r, p.moe_down + (size_t)e * EXPERT_FF * DM, EXPERT_FF, DM, MapPlain{WSP(bf16, AR_MDN) + (size_t)e * DM * EXPERT_FF, EXPERT_FF}, scrw, lane); }
                int* rtok = WSP(int, AR_RTOK); float* rww = WSP(float, AR_RW8); int* trow = WSP(int, AR_TROW);
                int segv = 0; { const int pc = lane < 16 ? (int)((ctl[CW_CNT + lane * 64] + 255u) & ~255u) : 0;
#pragma unroll
                    for (int k = 0; k < 8; ++k) { const int ck = bperm_i(pc, (lane & 8) + k); segv += (k < (lane & 7)) ? ck : 0; } }
                for (int hb = gw; hb < 2 * (T / 64); hb += NGW) {
                    const int tb = (hb >> 1) * 64, half = hb & 1, t = tb + lane; const int ee = WSP(int, AR_RTE)[t], e0 = ee & 255, e1 = (ee >> 8) & 255, r0 = (ee >> 16) & 255, r1 = (ee >> 24) & 255;
                    const float* w = WSP(float, AR_RTW) + (size_t)t * 2; const unsigned* wb = WSP(unsigned, AR_WBASE) + (size_t)(t % NGW) * 16;
                    const int row0 = bperm_i(segv, e0) + (int)wb[e0] + r0, row1 = bperm_i(segv, 8 + e1) + (int)wb[8 + e1] + r1;
                    if (half == 0) { rtok[row0] = t; rww[row0] = w[0]; rtok[MOE_ROWS + row1] = t; rww[MOE_ROWS + row1] = w[1]; trow[T + t] = row1; }
                    for (int l = 32 * half; l < 32 * half + 32; l += 4) { const bf16* hs = WSP(bf16, WS_H) + (size_t)(tb + l) * DM; bf16* xg = WSP(bf16, AR_XG);
                        copy_rows4(hs, hs + DM, hs + 2 * DM, hs + 3 * DM, xg + (size_t)__builtin_amdgcn_readlane(row0, l) * DM, xg + (size_t)__builtin_amdgcn_readlane(row0, l + 1) * DM, xg + (size_t)__builtin_amdgcn_readlane(row0, l + 2) * DM, xg + (size_t)__builtin_amdgcn_readlane(row0, l + 3) * DM, lane); }
                }
                SEAM(pb + 11);
            }
#pragma unroll
            for (int pass = 0; pass < 2; ++pass) {
                if (PHM(12) && IN(pb + 12 + 2 * pass)) { MKP;
                    Gemm g{WSP(bf16, AR_XG), WSP(bf16, AR_MGU), MOE_ROWS, NEXP * 2 * EXPERT_FF, DM}; MoeOrder S; S.init(ctl + CW_CNT + 8 * 64 * pass, 2 * EXPERT_FF / 256, G, bid);
                    EpiSwiglu E{WSP(bf16, AR_MACT), EXPERT_FF, 2 * EXPERT_FF / 256};
                    if (pass == 1) {
                        MoeOrder S0; S0.init(ctl + CW_CNT, DM / 256, G, bid); const int nwg = S0.s.nwg, mainw = (nwg / G) * G, ttiles = nwg - mainw;
                        if (bar.st != nullptr && (G & 31) == 0 && mainw > 0 && ttiles > 0 && ttiles <= 32) {
                            EpiMoeDown E0{p.out, WSP(int, AR_RTOK), WSP(float, AR_RW8), DM / 256, (PR_LO >= 0 && st == 0 && pb + 14 >= PR_LO && pb + 14 <= PR_HI) ? 0.f : 1.f};
                            for (int job = wave * G + bid; job < ttiles * 32; job += NWAVES * G) moe_tail_combine(E0, S0, WSP(float, WS_PART), mainw / (DM / 256), job, lane); } }
                    pg8::gemm_phase<EpiSwiglu, MoeOrder, true, true>(lds, g, S, E, tid);
                    SEAM(pb + 12 + 2 * pass);
                }
                if (PHM(13) && IN(pb + 13 + 2 * pass)) { MKP;
                    Gemm g{WSP(bf16, AR_MACT), WSP(bf16, AR_MDN), MOE_ROWS, NEXP * DM, EXPERT_FF}; MoeOrder S; S.init(ctl + CW_CNT + 8 * 64 * pass, DM / 256, G, bid);
                    EpiMoeDown E{p.out, WSP(int, AR_RTOK) + (size_t)pass * MOE_ROWS, WSP(float, AR_RW8) + (size_t)pass * MOE_ROWS, DM / 256, (PR_LO >= 0 && st == 0 && pb + 13 + 2 * pass >= PR_LO && pb + 13 + 2 * pass <= PR_HI) ? 0.f : 1.f};
                    if (pass == 0) { const int* trow = WSP(int, AR_TROW);
                        for (int t = gw * 4; t < T; t += NGW * 4) { const bf16* hs = WSP(bf16, WS_H) + (size_t)t * DM; bf16* xg = WSP(bf16, AR_XG);
                            copy_rows4(hs, hs + DM, hs + 2 * DM, hs + 3 * DM, xg + (size_t)trow[T + t] * DM, xg + (size_t)trow[T + t + 1] * DM, xg + (size_t)trow[T + t + 2] * DM, xg + (size_t)trow[T + t + 3] * DM, lane); } }
                    const int nwg = S.s.nwg, mainw = (nwg / G) * G, ttiles = nwg - mainw; const bool split = bar.st != nullptr && (G & 31) == 0 && mainw > 0 && ttiles > 0 && ttiles <= 32;
                    if (split) S.s.nwg = mainw;
                    pg8::gemm_phase<EpiMoeDown, MoeOrder, true, true>(lds, g, S, E, tid);
                    if (split) { Gemm g2{WSP(bf16, AR_MACT), WSP(bf16, AR_MDN), MOE_ROWS, NEXP * DM, MT_K, EXPERT_FF, EXPERT_FF}; MoeTailOrder S2; S2.init(S, mainw / (DM / 256), ttiles, G, bid);
                        EpiPart E2{WSP(float, WS_PART), mainw / (DM / 256), DM / 256};
                        pg8::gemm_phase<EpiPart, MoeTailOrder, true, true, true>(lds, g2, S2, E2, tid); }
                    if (pass == 1 && split) { { int w_ = wave0; asm volatile("" : "+s"(w_)); xcd_barrier(bar, w_ * 64 + lane_id_opaque()); }
                        for (int job = wave * G + bid; job < ttiles * 32; job += NWAVES * G) moe_tail_combine(E, S, WSP(float, WS_PART), mainw / (DM / 256), job, lane); }
                    SEAM(pb + 13 + 2 * pass);
                }
            }
        }
    }
    }
#ifdef PROBE_TK
    { int w_ = wave0; asm volatile("" : "+s"(w_)); xcd_barrier(bar, w_ * 64 + lane_id_opaque()); }
    if (blockIdx.x == 0 && threadIdx.x == 0) { const unsigned long long* tk = (const unsigned long long*)(args.ws + WS_CTL + 4 * CW_TK); __builtin_amdgcn_fence(__ATOMIC_SEQ_CST, "agent");
#ifndef PROBE_STAT
        args.out[0] += floorf((float)(long long)(tk[PROBE_A1] - tk[PROBE_A0]) * 0.01f / (float)(PROBE_TU)); }
#else
        long long mx = 0, mn = 1ll << 60; for (int b = 0; b < (int)gridDim.x; ++b) { const long long d = (long long)(tk[32 + b] - tk[0]); mx = d > mx ? d : mx; mn = d < mn ? d : mn; }
        int cnt = 0; for (int b = 0; b < (int)gridDim.x; ++b) { const long long d = (long long)(tk[32 + b] - tk[0]); cnt += (mx - d) <= 100ll * PROBE_WIN ? 1 : 0; }
        args.out[0] += PROBE_STAT == 1 ? floorf((float)mx * 0.01f / (float)(PROBE_TU)) : (PROBE_STAT == 2 ? (float)cnt : floorf((float)mn * 0.01f / (float)(PROBE_TU))); }
#endif
#endif
#undef IN
#undef SEAM
}

#ifndef MK_ONE_LAUNCH
#define MK_ONE_LAUNCH 1
#endif
extern "C" void kernel_launch(void* const* d_in, const int* in_sizes, int n_in, void* d_out, int out_size, void* d_ws, size_t ws_size, hipStream_t stream) {
    static int grid = 0;
    if (grid == 0) {
        if (n_in != 29 || in_sizes[0] != T * DM || out_size != T * DM || ws_size < WS_END) { fprintf(stderr, "kernel_launch: unexpected shapes / workspace (%d inputs, ws %zu, need %zu)\n", n_in, ws_size, (size_t)WS_END); grid = -1; return; }
        int dev = 0, cus = 0;
        if (hipGetDevice(&dev) != hipSuccess || hipDeviceGetAttribute(&cus, hipDeviceAttributeMultiprocessorCount, dev) != hipSuccess) { grid = -1; return; }
        if (hipFuncSetAttribute((const void*)mk_fwd, hipFuncAttributeMaxDynamicSharedMemorySize, LDS_BYTES) != hipSuccess) { fprintf(stderr, "kernel_launch: hipFuncSetAttribute failed\n"); grid = -1; return; }
        int per_cu = 0;
        if (hipOccupancyMaxActiveBlocksPerMultiprocessor(&per_cu, (const void*)mk_fwd, NTHREADS, LDS_BYTES) != hipSuccess || per_cu < 1) { fprintf(stderr, "kernel_launch: occupancy query says %d\n", per_cu); }
        (void)hipGetLastError();
        grid = cus;
    }
    if (grid < 0) return;
    if (hipMemsetAsync((char*)d_ws + WS_CTL, 0, CTL_BYTES, stream) != hipSuccess) return;
    Args a{};
    for (int i = 0; i < 29; ++i) a.in[i] = (const float*)d_in[i];
    a.out = (float*)d_out; a.ws = (unsigned char*)d_ws;
#if MK_ONE_LAUNCH
    a.ph_lo = 0; a.ph_hi = NPHASES;
    hipLaunchKernelGGL(mk_fwd, dim3(grid), dim3(NTHREADS), LDS_BYTES, stream, a);
#else
    for (int k = 0; k < NPHASES; ++k) {
        if (k >= 1 + 13 && k < 1 + NPH) continue;
        a.ph_lo = k; a.ph_hi = k + 1;
        hipLaunchKernelGGL(mk_fwd, dim3(grid), dim3(NTHREADS), LDS_BYTES, stream, a);
    }
#endif
}
```

```cpp
#include <hip/hip_runtime.h>
#include <cstdio>
#include <cstdint>
#include <cmath>
#include <cstring>
#ifdef HOST_EMU
#define HD
#define DEV_INLINE inline
#else
#define HD __host__ __device__
#define DEV_INLINE __device__ __forceinline__
#endif

typedef unsigned short bf16;
struct alignas(16) U4 { unsigned x, y, z, w; };

#ifdef SMALL_CFG
constexpr int BATCH = 1, SEQ = 1024, DM = 128, DENSE_FF = 256, EXPERT_FF = 256;
#else
constexpr int BATCH = 8, SEQ = 8192, DM = 1024, DENSE_FF = 2816, EXPERT_FF = 3584;
#endif
constexpr int T = BATCH * SEQ;
constexpr int NHEAD = 8, NKV = 2, HG = 4, DH = 64;
constexpr int NC = SEQ / 16 - 1, NS = SEQ / 64, NSEL = 8, WINDOW = 512;
constexpr int CONV_CH = 512, CONV_K = 31, RC = 512;
constexpr int NEXP = 8;
constexpr int NSA_IN = 1304, OFF_CONV = 1304, OFF_GATE = 2328, OFF_RWKV = OFF_GATE + 3 * DM;
constexpr int N_IN_FIRST = OFF_RWKV + 1824, N_IN_REST = OFF_RWKV + 1856;
constexpr int NPROJ = 4352;
constexpr int LDQ = 512, LDKV = 512, LDRW = 2048, LBLK = 1536;
constexpr int MOE_ROWS = T + NEXP * 256;
constexpr float RMS_EPS = 1e-6f, LN_EPS = 1e-5f, GN_EPS = 64e-5f;

constexpr size_t al(size_t x) { return (x + 255) & ~(size_t)255; }
constexpr size_t WS_CTL = 0, CTL_BYTES = 1u << 20;
constexpr size_t SZ_WIN = (size_t)NPROJ * DM * 2, SZ_WG = (size_t)3 * DM * DM * 2, SZ_WO3 = (size_t)3 * DM * 512 * 2, SZ_WOUT = (size_t)DM * DM * 2;
constexpr size_t SZ_LW = (size_t)2048 * 384 * 2, SZ_CW1 = (size_t)2 * 256 * 1024 * 2, SZ_PEC = 1024;
constexpr size_t SZ_LAYERW = SZ_WIN + SZ_WG + SZ_WO3 + SZ_WOUT + SZ_LW + SZ_CW1 + SZ_PEC;
constexpr size_t WS_W = CTL_BYTES;
constexpr size_t OFF_WIN = 0, OFF_WG = SZ_WIN, OFF_WO3 = OFF_WG + SZ_WG, OFF_WOUT = OFF_WO3 + SZ_WO3, OFF_LW = OFF_WOUT + SZ_WOUT, OFF_CW1 = OFF_LW + SZ_LW, OFF_PEC = OFF_CW1 + SZ_CW1;
constexpr size_t WS_DGU = WS_W + 2 * SZ_LAYERW, SZ_DGU = (size_t)2 * DENSE_FF * DM * 2;
constexpr size_t WS_DDN = WS_DGU + SZ_DGU, SZ_DDN = (size_t)DM * DENSE_FF * 2;
constexpr size_t WS_VF = al(WS_DDN + SZ_DDN), SZ_TC = (size_t)T * 512 * 2;
constexpr size_t WS_H = WS_VF + SZ_TC, SZ_H = (size_t)T * DM * 2;
constexpr size_t WS_PART = WS_VF;
static_assert((size_t)32 * 7 * 65536 * 4 <= SZ_TC, "WS_PART");
constexpr size_t WS_AR = al(WS_H + SZ_H);
constexpr size_t AR_QB = WS_AR, AR_A = AR_QB + SZ_TC, AR_CO = AR_A + SZ_TC;
constexpr size_t AR_KV = AR_CO + SZ_TC, SZ_KV = (size_t)T * LDKV * 2;
constexpr size_t AR_RW = AR_KV + SZ_KV, SZ_RW = (size_t)T * LDRW * 2;
constexpr size_t AR_W = AR_RW + SZ_RW, AR_G = AR_W + SZ_TC, AR_UB = AR_G + SZ_TC;
constexpr size_t AR_NG = AR_UB + SZ_TC, SZ_NG = (size_t)T * 24 * 4;
constexpr size_t AR_HALO = al(AR_NG + SZ_NG), SZ_HALO = (size_t)(T / 256) * LDRW * 2;
constexpr size_t AR_KC = al(AR_HALO + SZ_HALO), SZ_CMP = (size_t)BATCH * NKV * (SEQ / 16) * 64 * 2;
constexpr size_t AR_VC = AR_KC + SZ_CMP;
constexpr size_t AR_HID = al(AR_VC + SZ_CMP), SZ_HID = (size_t)BATCH * NKV * (SEQ / 16) * 2 * 128 * 4;
constexpr size_t AR_SEL = al(AR_HID + SZ_HID), SZ_SEL = (size_t)T * NKV * 8 * 4;
constexpr size_t AR_INVN = al(AR_SEL + SZ_SEL), SZ_INVN = (size_t)T * 8 * 4;
constexpr size_t AR_VCT = al(AR_INVN + SZ_INVN);
constexpr size_t AR_CKV = al(AR_VCT + SZ_CMP), SZ_CKV = (size_t)2 * T * 128;
constexpr size_t AR_END1 = al(AR_CKV + SZ_CKV * 2);
constexpr size_t WS_VST = WS_H, WS_VWT = WS_H + (size_t)T * 128 * 2, WS_LB = WS_VWT + (size_t)T * 128 * 2, WS_KS8 = WS_LB + (size_t)T * 384 * 2, WS_KW8 = WS_KS8 + (size_t)T * 128 * 2;
constexpr size_t AR_OBUF = AR_KV, SZ_OBUF = (size_t)3 * T * DM * 2;
constexpr size_t AR_MIX = AR_OBUF + SZ_OBUF, SZ_MIX = (size_t)T * DM * 2;
constexpr size_t AR_END2 = AR_MIX + SZ_MIX;
constexpr size_t AR_ACT = WS_AR;
constexpr size_t AR_MGU = WS_AR, SZ_MGU = (size_t)NEXP * 2 * EXPERT_FF * DM * 2;
constexpr size_t AR_MDN = AR_MGU + SZ_MGU, SZ_MDN = (size_t)NEXP * DM * EXPERT_FF * 2;
constexpr size_t AR_XG = al(AR_MDN + SZ_MDN), SZ_XG = (size_t)MOE_ROWS * DM * 2;
constexpr size_t AR_MACT = al(AR_XG + SZ_XG), SZ_MACT = (size_t)MOE_ROWS * EXPERT_FF * 2;
constexpr size_t AR_RTOK = al(AR_MACT + SZ_MACT), SZ_RTOK = (size_t)2 * MOE_ROWS * 4;
constexpr size_t AR_RW8 = al(AR_RTOK + SZ_RTOK);
constexpr size_t AR_TROW = al(AR_RW8 + SZ_RTOK), SZ_TROW = (size_t)2 * T * 4;
constexpr size_t AR_RTE = al(AR_TROW + SZ_TROW);
constexpr size_t AR_RTW = al(AR_RTE + (size_t)T * 4);
constexpr size_t AR_WBASE = al(AR_RTW + (size_t)T * 8);
constexpr size_t AR_END3 = al(AR_WBASE + (size_t)4096 * 16 * 4);
constexpr size_t WS_END = (AR_END1 > AR_END2 ? (AR_END1 > AR_END3 ? AR_END1 : AR_END3) : (AR_END2 > AR_END3 ? AR_END2 : AR_END3));
constexpr int CW_CNT = 1024;
constexpr int CW_ATT = 256;
constexpr int CW_BAR = 4096, CW_TK = 8192, CW_CONV = 8256, CW_SINK = 16384;

struct P {
    const float *x, *mix_norm_g, *w_in_first, *w_in_rest, *mu_first, *mu_rest, *qk_g, *cmp_pos, *cmp_w1, *cmp_w2, *nsa_w_o, *conv_w, *conv_vec, *conv_w_o,
        *rwkv_vec, *w_up, *a_up, *g_up, *vres_up, *vres_b, *rwkv_w_o, *w_out, *ffn_norm_g, *dense_gu, *dense_down, *router_w, *router_b, *moe_gu, *moe_down;
    float* out; unsigned char* ws;
};
HD inline void fill_params(P& p, const float* const* in, float* out, unsigned char* ws) {
    p.x = in[0]; p.mix_norm_g = in[1]; p.w_in_first = in[2]; p.w_in_rest = in[3]; p.mu_first = in[4]; p.mu_rest = in[5]; p.qk_g = in[6]; p.cmp_pos = in[7];
    p.cmp_w1 = in[8]; p.cmp_w2 = in[9]; p.nsa_w_o = in[10]; p.conv_w = in[11]; p.conv_vec = in[12]; p.conv_w_o = in[13]; p.rwkv_vec = in[14]; p.w_up = in[15];
    p.a_up = in[16]; p.g_up = in[17]; p.vres_up = in[18]; p.vres_b = in[19]; p.rwkv_w_o = in[20]; p.w_out = in[21]; p.ffn_norm_g = in[22]; p.dense_gu = in[23];
    p.dense_down = in[24]; p.router_w = in[25]; p.router_b = in[26]; p.moe_gu = in[27]; p.moe_down = in[28]; p.out = out; p.ws = ws;
}
#define WSP(type, off) ((type*)(p.ws + (off)))

#ifdef HOST_EMU
#define FENCE()
#else
#define FENCE() asm volatile("" ::: "memory")
#endif
HD inline float bf2f(bf16 v) { unsigned u = (unsigned)v << 16; float f; memcpy(&f, &u, 4); return f; }
HD inline bf16 f2bf(float f) { unsigned u; memcpy(&u, &f, 4); return (bf16)((u + 0x7fffu + ((u >> 16) & 1u)) >> 16); }
HD inline float blo(unsigned v) { unsigned u = v << 16; float f; memcpy(&f, &u, 4); return f; }
HD inline float bhi(unsigned v) { unsigned u = v & 0xffff0000u; float f; memcpy(&f, &u, 4); return f; }
#if !defined(SCAN_BF16) && !defined(RKV_BF16)
HD inline bf16 f2h(float f) { return __builtin_bit_cast(unsigned short, (_Float16)f); }
#else
HD inline bf16 f2bf(float f);
HD inline bf16 f2h(float f) { return f2bf(f); }
#endif
HD inline float h2f(bf16 v) { return (float)__builtin_bit_cast(_Float16, v); }
HD inline float sigmoidf_(float x) { return 1.f / (1.f + expf(-x)); }
HD inline float dot64(const float* q, const bf16* kp) {
    const U4* k4 = (const U4*)kp; float s0 = 0.f, s1 = 0.f;
#pragma unroll
    for (int i = 0; i < 8; ++i) { const U4 v = k4[i];
        s0 += q[8 * i + 0] * blo(v.x) + q[8 * i + 2] * blo(v.y) + q[8 * i + 4] * blo(v.z) + q[8 * i + 6] * blo(v.w);
        s1 += q[8 * i + 1] * bhi(v.x) + q[8 * i + 3] * bhi(v.y) + q[8 * i + 5] * bhi(v.z) + q[8 * i + 7] * bhi(v.w); }
    return s0 + s1;
}
HD inline float dot64p(const U4* q, const bf16* kp) {
    const U4* k4 = (const U4*)kp; float s0 = 0.f, s1 = 0.f;
#pragma unroll
    for (int i = 0; i < 8; ++i) { const U4 v = k4[i], w = q[i];
        s0 += blo(w.x) * blo(v.x) + blo(w.y) * blo(v.y) + blo(w.z) * blo(v.z) + blo(w.w) * blo(v.w);
        s1 += bhi(w.x) * bhi(v.x) + bhi(w.y) * bhi(v.y) + bhi(w.z) * bhi(v.z) + bhi(w.w) * bhi(v.w); }
    return s0 + s1;
}
HD inline void ld64(const bf16* kp, float* q) {
    const U4* k4 = (const U4*)kp;
#pragma unroll
    for (int i = 0; i < 8; ++i) { const U4 v = k4[i]; q[8 * i] = blo(v.x); q[8 * i + 1] = bhi(v.x); q[8 * i + 2] = blo(v.y); q[8 * i + 3] = bhi(v.y);
        q[8 * i + 4] = blo(v.z); q[8 * i + 5] = bhi(v.z); q[8 * i + 6] = blo(v.w); q[8 * i + 7] = bhi(v.w); }
}
HD inline void axpy64(float* o, float w, const bf16* vp) {
    const U4* k4 = (const U4*)vp;
#pragma unroll
    for (int i = 0; i < 8; ++i) { const U4 v = k4[i]; o[8 * i] += w * blo(v.x); o[8 * i + 1] += w * bhi(v.x); o[8 * i + 2] += w * blo(v.y); o[8 * i + 3] += w * bhi(v.y);
        o[8 * i + 4] += w * blo(v.z); o[8 * i + 5] += w * bhi(v.z); o[8 * i + 6] += w * blo(v.w); o[8 * i + 7] += w * bhi(v.w); }
}
HD inline void axpy64s(float* o, float w, const bf16* vp) {
    const U4* k4 = (const U4*)vp;
#pragma unroll
    for (int i = 0; i < 8; ++i) { const U4 v = k4[i]; o[8 * i] = w * o[8 * i] + blo(v.x); o[8 * i + 1] = w * o[8 * i + 1] + bhi(v.x); o[8 * i + 2] = w * o[8 * i + 2] + blo(v.y); o[8 * i + 3] = w * o[8 * i + 3] + bhi(v.y);
        o[8 * i + 4] = w * o[8 * i + 4] + blo(v.z); o[8 * i + 5] = w * o[8 * i + 5] + bhi(v.z); o[8 * i + 6] = w * o[8 * i + 6] + blo(v.w); o[8 * i + 7] = w * o[8 * i + 7] + bhi(v.w); }
}
HD inline void st64(bf16* op, const float* o) {
    U4* o4 = (U4*)op;
#pragma unroll
    for (int i = 0; i < 8; ++i) { U4 v; v.x = (unsigned)f2bf(o[8 * i]) | ((unsigned)f2bf(o[8 * i + 1]) << 16); v.y = (unsigned)f2bf(o[8 * i + 2]) | ((unsigned)f2bf(o[8 * i + 3]) << 16);
        v.z = (unsigned)f2bf(o[8 * i + 4]) | ((unsigned)f2bf(o[8 * i + 5]) << 16); v.w = (unsigned)f2bf(o[8 * i + 6]) | ((unsigned)f2bf(o[8 * i + 7]) << 16); o4[i] = v; }
}

HD inline void rope_cs(int pos, int i, float& cs, float& sn) {
    const float c = exp2f(-(float)i * 0.41524101186092f) * 0.15915494309189535f, pf = (float)pos;
    const float prod = pf * c, err = fmaf(pf, c, -prod), fr = (prod - rintf(prod)) + err;
#ifdef HOST_EMU
    cs = cosf(6.283185307179586f * fr); sn = sinf(6.283185307179586f * fr);
#else
    cs = __builtin_amdgcn_cosf(fr); sn = __builtin_amdgcn_sinf(fr);
#endif
}
HD inline int win_dest(int j, int layer, int& which) {
    which = 0;
    if (j < 1280) return j;
    if (j < 1304) return 3840 + 320 + (j - 1280);
    if (j < 1816) { const int cc = j - 1304; return 1280 + 256 * (cc / 128) + cc % 128; }
    if (j < 2328) { const int cc = j - 1816; return 1280 + 256 * (cc / 128) + 128 + cc % 128; }
    if (j < OFF_RWKV) { which = 1; const int gg = j - OFF_GATE, br = gg / DM; return (br == 0 ? 0 : (br == 1 ? 2 * DM : DM)) + gg % DM; }
    const int rr = j - OFF_RWKV;
    if (rr < 1536) return 2304 + rr;
    if (rr < 1824) return 3840 + (rr - 1536);
    if (rr < 1856 && layer == 1) return 3840 + 288 + (rr - 1824);
    return -1;
}
HD inline int glu_dest(int j, int ff) { return j < ff ? 256 * (j / 128) + j % 128 : 256 * ((j - ff) / 128) + 128 + (j - ff) % 128; }

DEV_INLINE void ph_shift(const P& p, int layer, long gtid, long NT) {
    bf16* RW = WSP(bf16, AR_RW); const bf16* HALO = WSP(bf16, AR_HALO); bf16* VF = WSP(bf16, WS_VF); bf16* LB = WSP(bf16, WS_LB);
    const float* mu = layer == 0 ? p.mu_first : p.mu_rest;
    constexpr int NCP = (LBLK + 384) / 2;
    const long n = (long)(T / 256) * NCP;
    for (long it = gtid; it < n; it += NT) {
        const int pm = (int)(it / NCP), c = 2 * (int)(it % NCP);
        int mi = -1, act = 0;
        if (c < LBLK) mi = c;
        else { const int w = c - LBLK; if (w < 288) { mi = 1536 + w; act = w < 64 ? 1 : (w >= 128 ? 2 : 0); } else if (w < 320 && layer == 1) mi = 1824 + (w - 288); }
        if (mi < 0) { for (int r = 0; r < 256; ++r) *(unsigned*)(LB + ((size_t)pm * 256 + r) * 384 + (c - LBLK)) = 0u; continue; }
        const float m0 = mu[mi], m1 = mu[mi + 1];
        float prev0 = 0.f, prev1 = 0.f;
        if ((pm * 256) % SEQ != 0) { const unsigned hv = *(const unsigned*)(HALO + (size_t)(pm - 1) * LDRW + c); prev0 = blo(hv); prev1 = bhi(hv); }
        bf16* col = RW + (size_t)pm * 256 * LDRW + c;
        for (int r0 = 0; r0 < 256; r0 += 16) {
            unsigned pv[16];
#pragma unroll
            for (int k = 0; k < 16; ++k) pv[k] = *(const unsigned*)(col + (size_t)(r0 + k) * LDRW);
#pragma unroll
            for (int k = 0; k < 16; ++k) { const int r = r0 + k; const float p0 = blo(pv[k]), p1 = bhi(pv[k]);
                float u0 = p0 + (prev0 - p0) * m0, u1 = p1 + (prev1 - p1) * m1; prev0 = p0; prev1 = p1;
                if (act == 1) { u0 = tanhf(u0); u1 = tanhf(u1); } else if (act == 2) { u0 = sigmoidf_(u0); u1 = sigmoidf_(u1); }
                if (c < LBLK) { const unsigned hv = (unsigned)f2h(u0) | ((unsigned)f2h(u1) << 16); *(unsigned*)(col + (size_t)r * LDRW) = hv;
                    if (layer == 0 && c >= 1024) *(unsigned*)(VF + ((size_t)pm * 256 + r) * RC + (c - 1024)) = hv; }
                else *(unsigned*)(LB + ((size_t)pm * 256 + r) * 384 + (c - LBLK)) = (unsigned)f2bf(u0) | ((unsigned)f2bf(u1) << 16); }
        }
    }
}

DEV_INLINE void ph_nsa_prep(const P& p, int layer, long gtid, long NT) {
    bf16* QB = WSP(bf16, AR_QB); bf16* KV = WSP(bf16, AR_KV);
    const long n = (long)T * 12;
    for (long it = gtid; it < n; it += NT) {
        const int t = (int)(it / 12), s = (int)(it % 12), pos = t % SEQ;
        bf16* ptr; const float* g;
        if (s < 8) { ptr = QB + (size_t)t * LDQ + s * 64; g = p.qk_g + (layer * 4 + 0) * 64; }
        else if (s < 10) { ptr = KV + (size_t)t * LDKV + (s - 8) * 64; g = p.qk_g + (layer * 4 + 2) * 64; }
        else { ptr = KV + (size_t)t * LDKV + 256 + (s - 10) * 64; g = p.qk_g + (layer * 4 + 3) * 64; }
        float v[64]; ld64(ptr, v);
        float ss = 0.f;
#pragma unroll
        for (int i = 0; i < 64; ++i) ss += v[i] * v[i];
        const float rs = 1.f / sqrtf(ss * (1.f / 64.f) + RMS_EPS);
#pragma unroll
        for (int i = 0; i < 64; ++i) v[i] = v[i] * rs * g[i];
#pragma unroll
        for (int i = 0; i < 32; ++i) {
            float cs, sn; rope_cs(pos, i, cs, sn);
            const float x1 = v[i], x2 = v[i + 32]; v[i] = x1 * cs - x2 * sn; v[i + 32] = x2 * cs + x1 * sn;
        }
        if (s < 8) {
#pragma unroll
            for (int i = 0; i < 64; ++i) v[i] *= 0.125f * 1.4426950408889634f; }
        if (s < 8) st64(ptr, v);
        else {
            const int gg = (s - 8) & 1, bq = t / SEQ; bf16* k8 = WSP(bf16, s < 10 ? WS_KS8 : WS_KW8) + (size_t)(bq * NKV + gg) * 8 * SEQ * 8;
#pragma unroll
            for (int dg = 0; dg < 8; ++dg) { U4 w; w.x = (unsigned)f2bf(v[8 * dg]) | ((unsigned)f2bf(v[8 * dg + 1]) << 16); w.y = (unsigned)f2bf(v[8 * dg + 2]) | ((unsigned)f2bf(v[8 * dg + 3]) << 16);
                w.z = (unsigned)f2bf(v[8 * dg + 4]) | ((unsigned)f2bf(v[8 * dg + 5]) << 16); w.w = (unsigned)f2bf(v[8 * dg + 6]) | ((unsigned)f2bf(v[8 * dg + 7]) << 16);
                *(U4*)(k8 + ((size_t)dg * SEQ + pos) * 8) = w; } }
    }
}

DEV_INLINE void ph_vtrans(const P& p, long gtid, long NT) {
    const bf16* KV = WSP(bf16, AR_KV); bf16* VsT = WSP(bf16, WS_VST); bf16* VwT = WSP(bf16, WS_VWT);
    const long n = (long)BATCH * NKV * (SEQ / 8) * 64;
    for (long it = gtid; it < n; it += NT) {
        const int d = (int)(it % 64); long r = it / 64; const int kg = (int)(r % (SEQ / 8)); const int bg = (int)(r / (SEQ / 8)), b = bg / NKV, g = bg % NKV;
        const int kbase = (kg >> 2) * 32 + 4 * (kg & 3);
        const bf16* src = KV + (size_t)(b * SEQ + kbase) * LDKV + g * 64 + d;
        U4 s, w; unsigned short sv[8], wv[8];
#pragma unroll
        for (int j = 0; j < 8; ++j) { const size_t ro = (size_t)((j & 3) + 16 * (j >> 2)) * LDKV; sv[j] = src[ro + 128]; wv[j] = src[ro + 384]; }
        s.x = sv[0] | ((unsigned)sv[1] << 16); s.y = sv[2] | ((unsigned)sv[3] << 16); s.z = sv[4] | ((unsigned)sv[5] << 16); s.w = sv[6] | ((unsigned)sv[7] << 16);
        w.x = wv[0] | ((unsigned)wv[1] << 16); w.y = wv[2] | ((unsigned)wv[3] << 16); w.z = wv[4] | ((unsigned)wv[5] << 16); w.w = wv[6] | ((unsigned)wv[7] << 16);
        *(U4*)(VsT + (((size_t)bg * (SEQ / 8) + kg) * 64 + d) * 8) = s; *(U4*)(VwT + (((size_t)bg * (SEQ / 8) + kg) * 64 + d) * 8) = w;
    }
}
namespace pg8 {
#define PG8_LAS __attribute__((address_space(3)))
typedef unsigned short bf16_t;
typedef short bf16x8 __attribute__((ext_vector_type(8)));
typedef float f32x4 __attribute__((ext_vector_type(4)));
typedef unsigned u32x4 __attribute__((ext_vector_type(4)));
constexpr int BM = 256, BK = 64, HALF = 128, HTB = HALF * BK * 2  , STAGE_BYTES = 8 * HTB, NXCD = 8, WGM = 8;

__host__ __device__ __forceinline__ int lds_byte(int r, int c) { const int st = (r >> 4) * 2 + (c >> 5), rr = r & 15, cc = c & 31, ob = rr * 64 + cc * 2; return st * 1024 + (ob ^ (((ob >> 9) & 1) << 5)); }
__host__ __device__ __forceinline__ void stage_rc(int b, int& R, int& C) { const int st = b / 1024, sb = b % 1024, swz = sb ^ (((sb >> 9) & 1) << 5); R = (st >> 1) * 16 + swz / 64; C = (st & 1) * 32 + (swz % 64) / 2; }
__host__ __device__ __forceinline__ int perm32(int rho) { const int n = rho >> 4, i = rho & 15; return 8 * (i >> 2) + 4 * n + (i & 3); }

struct Unit { int pm, pn; };
struct Gemm { const bf16_t* A; const bf16_t* Bt; int M, N, K; int lda; int ldb; };

struct StaticOrder {
    int nM, nN, nwg, G, c;
    __host__ __device__ void init(int M, int N, int G_, int c_) { nM = M / BM; nN = N / BM; nwg = nM * nN; G = G_; c = c_; }
    __host__ __device__ bool next(int i, Unit& u) const {
        const long L = (long)i * G + c; if (L >= nwg) return false;
        int wgid = (int)L; { const int q = nwg / NXCD, r = nwg % NXCD, xcd = wgid % NXCD, off = wgid / NXCD; wgid = (xcd < r ? xcd * (q + 1) : r * (q + 1) + (xcd - r) * q) + off; }
        const int nig = WGM * nN, gid = wgid / nig, fm = gid * WGM, gsz = (nM - fm) < WGM ? (nM - fm) : WGM;
        u.pm = fm + ((wgid % nig) % gsz); u.pn = (wgid % nig) / gsz; return true;
    }
    __device__ __forceinline__ void a_ready(const Unit&) const {}
    __device__ __forceinline__ void done(const Unit&) const {}
};

__device__ __forceinline__ unsigned cvt_pk_bf16(float lo, float hi) { unsigned r; asm volatile("v_cvt_pk_bf16_f32 %0, %1, %2" : "=v"(r) : "v"(lo), "v"(hi)); return r; }
typedef float f32x2 __attribute__((ext_vector_type(2)));
template <class Epi, class Sched, bool ALIGN_EPI = false, bool SP2 = false, bool KSPLIT = false>
__device__ __forceinline__ void gemm_phase(PG8_LAS unsigned char* lds, const Gemm g, const Sched& S, const Epi& E, int tid_in) {
    int tid_ = tid_in; asm volatile("" : "+v"(tid_));
    const int tid = tid_, wid = __builtin_amdgcn_readfirstlane(tid >> 6), lane = tid & 63, wr = wid >> 2, wc = wid & 3, fr = lane & 15, fq = lane >> 4;
    const int K = g.K, nt = K / BK, lda = g.lda ? g.lda : K, ldb = g.ldb ? g.ldb : K;
    unsigned voffA[2], voffB[2];
#pragma unroll
    for (int i = 0; i < 2; ++i) { int R, C; stage_rc(tid * 16 + i * 8192, R, C); const int Rb = Epi::PERM ? ((R & ~31) + perm32(R & 31)) : R;
        voffA[i] = (unsigned)(R * lda + C) * 2u; voffB[i] = (unsigned)(Rb * ldb + C) * 2u; }
    const size_t kstep = (size_t)(BK * 2);
    const size_t hstepA = (size_t)HALF * lda * 2, hstepB = (size_t)HALF * ldb * 2;
    const size_t hstep_unused = (size_t)HALF * K * 2;
    const size_t tstepA = 2 * hstepA, tstepB = 2 * hstepB;
    const unsigned ldsw = (unsigned)wid * 1024u;
    const int aoff = lds_byte(wr * 64 + fr, fq * 8), boff = lds_byte(wc * 32 + fr, fq * 8);
#define PG8_SA(b, h) (((b) * 2 + (h)) * HTB)
#define PG8_SB(b, h) ((4 + (b) * 2 + (h)) * HTB)
#define PG8_STAGE(bufoff, gbase, voff) do { _Pragma("unroll") for (int _i = 0; _i < 2; ++_i) \
        __builtin_amdgcn_global_load_lds((const unsigned*)((const char*)(gbase) + (voff)[_i]), (PG8_LAS unsigned*)(lds + (bufoff) + ldsw + _i * 8192), 16, 0, 0); } while (0)
#define PG8_LDA(dst, b, h) do { _Pragma("unroll") for (int m = 0; m < 4; ++m) _Pragma("unroll") for (int k = 0; k < 2; ++k) dst[m][k] = *(const PG8_LAS bf16x8*)(lds + PG8_SA(b, h) + aoff + m * 2048 + k * 1024); } while (0)
#define PG8_LDB(dst, b, h) do { _Pragma("unroll") for (int n = 0; n < 2; ++n) _Pragma("unroll") for (int k = 0; k < 2; ++k) dst[n][k] = *(const PG8_LAS bf16x8*)(lds + PG8_SB(b, h) + boff + n * 2048 + k * 1024); } while (0)
#define PG8_MMA(ai, bj, At, Bt) do { __builtin_amdgcn_s_setprio(1); _Pragma("unroll") for (int m = 0; m < 4; ++m) _Pragma("unroll") for (int n = 0; n < 2; ++n) _Pragma("unroll") for (int k = 0; k < 2; ++k) \
        acc[ai][bj][m][n] = __builtin_amdgcn_mfma_f32_16x16x32_bf16(Bt[n][k], At[m][k], acc[ai][bj][m][n], 0, 0, 0); __builtin_amdgcn_s_setprio(0); } while (0)
#define PG8_WAIT_V(n) asm volatile("s_waitcnt vmcnt(" #n ")" ::: "memory")
#define PG8_WAIT_L(n) asm volatile("s_waitcnt lgkmcnt(" #n ")" ::: "memory")
#define PG8_BAR __builtin_amdgcn_s_barrier()
#define PG8_SCHED __builtin_amdgcn_sched_barrier(0)
    Unit cur, nxt; int ui = 0;
    if (!S.next(0, cur)) return;
    f32x4 acc[2][2][4][2];
#pragma unroll
    for (int a = 0; a < 2; ++a)
#pragma unroll
        for (int b = 0; b < 2; ++b)
#pragma unroll
            for (int m = 0; m < 4; ++m)
#pragma unroll
                for (int n = 0; n < 2; ++n) acc[a][b][m][n] = (f32x4){0.f, 0.f, 0.f, 0.f};
    bf16x8 At[4][2], B0[2][2], B1[2][2];
    const char* cA = (const char*)g.A + (size_t)cur.pm * tstepA + (KSPLIT ? (size_t)(cur.pn >> 16) * K * 2 : 0); const char* cB = (const char*)g.Bt + (size_t)(KSPLIT ? (cur.pn & 0xffff) : cur.pn) * tstepB + (KSPLIT ? (size_t)(cur.pn >> 16) * K * 2 : 0);
    S.a_ready(cur);
    if constexpr (SP2) {
        PG8_STAGE(PG8_SB(0, 0), cB, voffB); PG8_STAGE(PG8_SB(0, 1), cB + hstepB, voffB); PG8_STAGE(PG8_SA(0, 0), cA, voffA); PG8_STAGE(PG8_SA(0, 1), cA + hstepA, voffA);
        if (wr == 1) PG8_BAR;
        PG8_WAIT_V(2); PG8_BAR;
        PG8_STAGE(PG8_SB(1, 0), cB + kstep, voffB); PG8_STAGE(PG8_SA(1, 0), cA + kstep, voffA); PG8_STAGE(PG8_SB(1, 1), cB + hstepB + kstep, voffB);
        PG8_WAIT_V(6); PG8_BAR;
    } else {
        PG8_STAGE(PG8_SB(0, 0), cB, voffB); PG8_STAGE(PG8_SA(0, 0), cA, voffA); PG8_STAGE(PG8_SB(0, 1), cB + hstepB, voffB); PG8_STAGE(PG8_SA(0, 1), cA + hstepA, voffA);
        if (wr == 1) PG8_BAR;
        PG8_WAIT_V(4); PG8_BAR;
        PG8_STAGE(PG8_SB(1, 0), cB + kstep, voffB); PG8_STAGE(PG8_SA(1, 0), cA + kstep, voffA); PG8_STAGE(PG8_SB(1, 1), cB + hstepB + kstep, voffB);
        PG8_WAIT_V(6); PG8_BAR;
    }
    for (;;) {
        const bool has_next = S.next(ui + 1, nxt);
        const char* nA = has_next ? (const char*)g.A + (size_t)nxt.pm * tstepA + (KSPLIT ? (size_t)(nxt.pn >> 16) * K * 2 : 0) : cA; const char* nB = has_next ? (const char*)g.Bt + (size_t)(KSPLIT ? (nxt.pn & 0xffff) : nxt.pn) * tstepB + (KSPLIT ? (size_t)(nxt.pn >> 16) * K * 2 : 0) : cB;
        for (int t = 0; t < nt; t += 2) {
            const bool last = (t == nt - 2);
            const char* a1 = cA + (size_t)(t + 1) * kstep;
            const char* a2 = last ? nA : cA + (size_t)(t + 2) * kstep; const char* b2 = last ? nB : cB + (size_t)(t + 2) * kstep;
            const char* a3 = a2 + kstep; const char* b3 = b2 + kstep;
            if (last && has_next) S.a_ready(nxt);
            if constexpr (SP2) {
            PG8_LDB(B0, 0, 0); PG8_LDB(B1, 0, 1); PG8_SCHED; PG8_LDA(At, 0, 0); PG8_STAGE(PG8_SA(1, 1), a1 + hstepA, voffA);
            PG8_WAIT_V(8); PG8_WAIT_L(0); PG8_BAR; PG8_MMA(0, 0, At, B0); PG8_MMA(0, 1, At, B1); PG8_BAR; PG8_SCHED;
            PG8_LDA(At, 0, 1); PG8_STAGE(PG8_SB(0, 0), b2, voffB); PG8_STAGE(PG8_SB(0, 1), b2 + hstepB, voffB); PG8_STAGE(PG8_SA(0, 0), a2, voffA);
            PG8_WAIT_V(8); PG8_WAIT_L(0); PG8_BAR; PG8_MMA(1, 0, At, B0); PG8_MMA(1, 1, At, B1); PG8_BAR; PG8_SCHED;
            PG8_LDB(B0, 1, 0); PG8_LDB(B1, 1, 1); PG8_SCHED; PG8_LDA(At, 1, 0); PG8_STAGE(PG8_SA(0, 1), a2 + hstepA, voffA);
            PG8_WAIT_V(8); PG8_WAIT_L(0); PG8_BAR; PG8_MMA(0, 0, At, B0); PG8_MMA(0, 1, At, B1); PG8_BAR; PG8_SCHED;
            PG8_LDA(At, 1, 1); PG8_STAGE(PG8_SB(1, 0), b3, voffB); PG8_STAGE(PG8_SB(1, 1), b3 + hstepB, voffB); PG8_STAGE(PG8_SA(1, 0), a3, voffA);
            PG8_WAIT_V(8); PG8_WAIT_L(0); PG8_BAR; PG8_MMA(1, 0, At, B0); PG8_MMA(1, 1, At, B1); PG8_BAR; PG8_SCHED;
            } else {
            PG8_LDB(B0, 0, 0); PG8_SCHED; PG8_LDA(At, 0, 0); PG8_STAGE(PG8_SA(1, 1), a1 + hstepA, voffA);
            PG8_WAIT_L(8); PG8_BAR; PG8_WAIT_L(0); PG8_MMA(0, 0, At, B0); PG8_BAR; PG8_SCHED;
            PG8_LDB(B1, 0, 1); PG8_STAGE(PG8_SB(0, 0), b2, voffB);
            PG8_BAR; PG8_WAIT_L(0); PG8_MMA(0, 1, At, B1); PG8_BAR;
            PG8_LDA(At, 0, 1); PG8_STAGE(PG8_SA(0, 0), a2, voffA);
            PG8_BAR; PG8_WAIT_L(0); PG8_MMA(1, 0, At, B0); PG8_BAR; PG8_SCHED;
            PG8_STAGE(PG8_SB(0, 1), b2 + hstepB, voffB);
            PG8_WAIT_V(6); PG8_BAR; PG8_MMA(1, 1, At, B1); PG8_BAR;
            PG8_LDB(B0, 1, 0); PG8_SCHED; PG8_LDA(At, 1, 0); PG8_STAGE(PG8_SA(0, 1), a2 + hstepA, voffA);
            PG8_WAIT_L(8); PG8_BAR; PG8_WAIT_L(0); PG8_MMA(0, 0, At, B0); PG8_BAR; PG8_SCHED;
            PG8_LDB(B1, 1, 1); PG8_STAGE(PG8_SB(1, 0), b3, voffB);
            PG8_BAR; PG8_WAIT_L(0); PG8_MMA(0, 1, At, B1); PG8_BAR;
            PG8_LDA(At, 1, 1); PG8_STAGE(PG8_SA(1, 0), a3, voffA);
            PG8_BAR; PG8_WAIT_L(0); PG8_MMA(1, 0, At, B0); PG8_BAR; PG8_SCHED;
            PG8_STAGE(PG8_SB(1, 1), b3 + hstepB, voffB);
            PG8_WAIT_V(6); PG8_BAR; PG8_MMA(1, 1, At, B1); PG8_BAR;
            }
        }
        if constexpr (ALIGN_EPI) { if (wr == 0) PG8_BAR; }
        if constexpr (!Epi::AFTER_DRAIN) { E(acc, cur, wr, wc, fr, fq); S.done(cur); }
        if (!has_next) break;
#pragma unroll
        for (int a = 0; a < 2; ++a)
#pragma unroll
            for (int b = 0; b < 2; ++b)
#pragma unroll
                for (int m = 0; m < 4; ++m)
#pragma unroll
                    for (int n = 0; n < 2; ++n) acc[a][b][m][n] = (f32x4){0.f, 0.f, 0.f, 0.f};
        cur = nxt; cA = nA; cB = nB; ++ui;
        if constexpr (ALIGN_EPI) { if (wr == 1) PG8_BAR; }
    }
    PG8_WAIT_V(0);
    if constexpr (!ALIGN_EPI) { if (wr == 0) PG8_BAR; }
    PG8_BAR;
    if constexpr (Epi::AFTER_DRAIN) { E.fused(acc, cur, wr, wc, fr, fq, lds, wid, lane); S.done(cur); }
#undef PG8_SA
#undef PG8_SB
#undef PG8_STAGE
#undef PG8_LDA
#undef PG8_LDB
#undef PG8_MMA
#undef PG8_WAIT_V
#undef PG8_WAIT_L
#undef PG8_BAR
#undef PG8_SCHED
}
}

#define LAS __attribute__((address_space(3)))
#define XB_TMO      128
#define XB_XCNT(j)  (256  + 64 * (j))
#define XB_XSUB(j)  (1280 + 64 * (j))
#define XB_XGEN(j)  (2304 + 64 * (j))
#define XB_TOP      3328
#define XB_TOPGEN   3392
#define XCD_BAR_WORDS 3456
#define XB_SPIN_CAP (1u << 22)

__device__ __forceinline__ unsigned xb_ld(unsigned* p)              { return __hip_atomic_load(p, __ATOMIC_RELAXED, __HIP_MEMORY_SCOPE_AGENT); }
__device__ __forceinline__ unsigned xb_add(unsigned* p, unsigned v) { return __hip_atomic_fetch_add(p, v, __ATOMIC_RELAXED, __HIP_MEMORY_SCOPE_AGENT); }
__device__ __forceinline__ unsigned xb_xcc_id() { return (unsigned)__builtin_amdgcn_s_getreg((3 << 11) | 20) & 0xFu; }
#define XB_SPIN(cond, bar) do { unsigned _sp = 0; while (cond) { __builtin_amdgcn_s_sleep(1); \
    if ((++_sp & 255u) == 0u) { if (xb_ld(&(bar)[XB_TMO])) break; if (_sp > XB_SPIN_CAP) { atomicAdd(&(bar)[XB_TMO], 1u); break; } } } } while (0)

struct XcdBarrier {
    unsigned* bar; unsigned x;
    volatile LAS unsigned* st;
};

__device__ __forceinline__ XcdBarrier xcd_barrier_post(unsigned* bar, volatile LAS unsigned* st) {
    XcdBarrier b; b.bar = bar; b.x = xb_xcc_id(); b.st = st;
    if (threadIdx.x == 0) (void)xb_add(&bar[XB_XCNT(b.x)], 1u);
    return b;
}
__device__ __forceinline__ void xcd_barrier_complete(unsigned* bar, unsigned x, unsigned& nloc, unsigned& nx) {
    const unsigned G = gridDim.x * gridDim.y * gridDim.z;
    unsigned sum, cnt, mine, sp = 0u;
    for (;;) {
        sum = 0u; cnt = 0u; mine = 0u;
#pragma unroll
        for (unsigned j = 0; j < 16; ++j) { const unsigned c = xb_ld(&bar[XB_XCNT(j)]); sum += c; cnt += (c > 0u) ? 1u : 0u; mine = (j == x) ? c : mine; }
        if (sum == G) break;
        __builtin_amdgcn_s_sleep(1);
        if ((++sp & 255u) == 0u) { if (xb_ld(&bar[XB_TMO])) break; if (sp > XB_SPIN_CAP) { atomicAdd(&bar[XB_TMO], 1u); break; } }
    }
    nloc = mine > 0u ? mine : 1u; nx = cnt > 0u ? cnt : 1u;
}

__device__ __forceinline__ void xcd_barrier(const XcdBarrier& b, int tid_x  ) {
    asm volatile("s_waitcnt vmcnt(0)" ::: "memory");
    __syncthreads();
    if (tid_x == 0) {
        unsigned* bar = b.bar; asm volatile("" : "+s"(bar));
        unsigned xx = b.x; asm volatile("" : "+s"(xx));
        __builtin_amdgcn_s_waitcnt(0);
        unsigned nloc = b.st[0], nx = b.st[1];
        if (nloc == 0u) { xcd_barrier_complete(bar, xx, nloc, nx); b.st[0] = nloc; b.st[1] = nx; }
        const unsigned old = xb_add(&bar[XB_XSUB(xx)], 1u);
        const unsigned gen = old / nloc;
        if (old + 1u == (gen + 1u) * nloc) {
            __builtin_amdgcn_fence(__ATOMIC_RELEASE, "agent");
            asm volatile("s_waitcnt vmcnt(0)" ::: "memory");
            const unsigned og = xb_add(&bar[XB_TOP], 1u);
            const unsigned tg = og / nx;
            if (og + 1u == (tg + 1u) * nx) xb_add(&bar[XB_TOPGEN], 1u);
            else XB_SPIN(xb_ld(&bar[XB_TOPGEN]) == tg, bar);
            __builtin_amdgcn_fence(__ATOMIC_ACQUIRE, "agent");
            xb_add(&bar[XB_XGEN(xx)], 1u);
            asm volatile("s_waitcnt vmcnt(0)" ::: "memory");
        } else {
            XB_SPIN(xb_ld(&bar[XB_XGEN(xx)]) == gen, bar);
            __builtin_amdgcn_fence(__ATOMIC_ACQUIRE, "agent");
            asm volatile("s_waitcnt vmcnt(0)" ::: "memory");
        }
    }
    __syncthreads();
}
#define GAS __attribute__((address_space(1)))
typedef unsigned v4u __attribute__((ext_vector_type(4)));
#ifdef PROBE_TK
#define TKQ(i) do { if (layer == PROBE_LAYER && blockIdx.x == PROBE_BLK && threadIdx.x == 0) ((unsigned long long*)(p.ws + WS_CTL + 4 * CW_TK))[(i)] = __builtin_amdgcn_s_memrealtime(); } while (0)
#else
#define TKQ(i) do { } while (0)
#endif
typedef unsigned v2u __attribute__((ext_vector_type(2)));
typedef GAS unsigned gu32;
#define RLX_AGENT __ATOMIC_RELAXED, __HIP_MEMORY_SCOPE_AGENT
#define LDS_WAIT() asm volatile("s_waitcnt lgkmcnt(0)" ::: "memory")
#define VM_WAIT() asm volatile("s_waitcnt vmcnt(0)" ::: "memory")
using pg8::f32x4; using pg8::Unit; using pg8::Gemm; using pg8::BM; using pg8::HALF; using pg8::cvt_pk_bf16; using pg8::u32x4;

constexpr int NWAVES = 8, NTHREADS = 512;
constexpr int RING_BYTES = 131072, LDSCTL_OFF = 147456 - 1024, MISC_OFF = LDSCTL_OFF + 320, LDS_BYTES = 147456;

__device__ __forceinline__ float wave_sum(float v, int lane) {
#pragma unroll
    for (int o = 1; o < 64; o <<= 1) v += __builtin_bit_cast(float, __builtin_amdgcn_ds_bpermute((lane ^ o) << 2, __builtin_bit_cast(int, v)));
    return v;
}
__device__ __forceinline__ float fsig(float x) { return __builtin_amdgcn_rcpf(1.f + __expf(-x)); }

__device__ __forceinline__ int lane_id_opaque() { int l; asm volatile("v_mbcnt_lo_u32_b32 %0, -1, 0\n\tv_mbcnt_hi_u32_b32 %0, -1, %0" : "=v"(l)); return l; }
__device__ __forceinline__ int rfl(int v) { return __builtin_amdgcn_readfirstlane(v); }
struct SOrder {
    pg8::StaticOrder s;
    __device__ void init(int M, int N, int G, int c) { s.init(M, N, G, c); }
    __device__ bool next(int i, Unit& u) const { Unit t; t.pm = 0; t.pn = 0; const bool ok = s.next(i, t); u.pm = rfl(t.pm); u.pn = rfl(t.pn); return ok; }
    __device__ __forceinline__ void a_ready(const Unit&) const {}
    __device__ __forceinline__ void done(const Unit&) const {}
};
struct StackOrder {
    pg8::StaticOrder s; int nM, nN;
    __device__ StackOrder(int nM_, int nN_, int nb, int G, int c) : nM(nM_), nN(nN_) { s.init(nb * nM_ * 256, nN_ * 256, G, c); }
    __device__ bool next(int i, Unit& u) const { Unit t; t.pm = 0; t.pn = 0; if (!s.next(i, t)) return false; u.pm = rfl(t.pm); u.pn = rfl((t.pm / nM) * nN + t.pn); return true; }
    __device__ __forceinline__ void a_ready(const Unit&) const {}
    __device__ __forceinline__ void done(const Unit&) const {}
};
struct GateOrder {
    pg8::StaticOrder s; int nN;
    __device__ GateOrder(int nM_, int nN_, int G, int c) : nN(nN_) { s.init(nM_ * 256, nN_ * 256, G, c); }
    __device__ bool next(int i, Unit& u) const { const int j = i / 3, br = i - 3 * j; Unit t; t.pm = 0; t.pn = 0; if (!s.next(j, t)) return false; u.pm = rfl(t.pm); u.pn = rfl(br * nN + t.pn); return true; }
    __device__ __forceinline__ void a_ready(const Unit&) const {}
    __device__ __forceinline__ void done(const Unit&) const {}
};
struct MoeOrder {
    pg8::StaticOrder s; int nN, e0, e1, e2, e3, e4, e5, e6, e7;
    __device__ void init(const unsigned* cnt  , int nN_, int G_, int c_) { nN = nN_;
        int t = 0; t += (cnt[0] + 255) >> 8; e0 = t; t += (cnt[64] + 255) >> 8; e1 = t; t += (cnt[128] + 255) >> 8; e2 = t; t += (cnt[192] + 255) >> 8; e3 = t;
        t += (cnt[256] + 255) >> 8; e4 = t; t += (cnt[320] + 255) >> 8; e5 = t; t += (cnt[384] + 255) >> 8; e6 = t; t += (cnt[448] + 255) >> 8; e7 = t;
        s.init(e7 * 256, nN_ * 256, G_, c_); }
    __device__ bool next(int i, Unit& u) const { Unit t; t.pm = 0; t.pn = 0; if (!s.next(i, t)) return false;
        const int pm = t.pm, e = (pm >= e0) + (pm >= e1) + (pm >= e2) + (pm >= e3) + (pm >= e4) + (pm >= e5) + (pm >= e6);
        u.pm = rfl(pm); u.pn = rfl(e * nN + t.pn); return true; }
    __device__ __forceinline__ void a_ready(const Unit&) const {}
    __device__ __forceinline__ void done(const Unit&) const {}
};

__device__ __forceinline__ u32x4 pack8(f32x4 v0, f32x4 v1) { u32x4 w; w.x = cvt_pk_bf16(v0[0], v0[1]); w.y = cvt_pk_bf16(v0[2], v0[3]); w.z = cvt_pk_bf16(v1[0], v1[1]); w.w = cvt_pk_bf16(v1[2], v1[3]); return w; }
__device__ __forceinline__ void unpack8(u32x4 w, f32x4& v0, f32x4& v1) {
    v0 = (f32x4){blo(w.x), bhi(w.x), blo(w.y), bhi(w.y)}; v1 = (f32x4){blo(w.z), bhi(w.z), blo(w.w), bhi(w.w)}; }

struct EpiProj {
    static constexpr bool PERM = true, AFTER_DRAIN = false;
    unsigned char* ws;
    __device__ __forceinline__ void operator()(const f32x4 (&acc)[2][2][4][2], const Unit& u, int wr, int wc, int fr, int fq) const {
        bf16* const QB = (bf16*)(ws + AR_QB); bf16* const KV = (bf16*)(ws + AR_KV); bf16* const UB = (bf16*)(ws + AR_UB); bf16* const RW = (bf16*)(ws + AR_RW); bf16* const HALO = (bf16*)(ws + AR_HALO); bf16* const CKV = (bf16*)(ws + AR_CKV);
        const int row0 = u.pm * BM + wr * 64 + fr, cl = wc * 32 + 8 * fq;
        if (u.pn >= 5 && u.pn < 9) {
#pragma unroll
            for (int ai = 0; ai < 2; ++ai)
#pragma unroll
                for (int m = 0; m < 4; ++m) { f32x4 a0 = acc[ai][0][m][0], a1 = acc[ai][0][m][1]; const f32x4 b0 = acc[ai][1][m][0], b1 = acc[ai][1][m][1];
#pragma unroll
                    for (int k = 0; k < 4; ++k) { a0[k] *= fsig(b0[k]); a1[k] *= fsig(b1[k]); }
                    *(u32x4*)(UB + (size_t)(row0 + ai * HALF + m * 16) * 512 + (u.pn - 5) * 128 + cl) = pack8(a0, a1); }
            return;
        }
        if (u.pn == 2) {
#pragma unroll
            for (int ai = 0; ai < 2; ++ai)
#pragma unroll
                for (int m = 0; m < 4; ++m) { const int row = row0 + ai * HALF + m * 16, b = row / SEQ, tt = row % SEQ;
#pragma unroll
                    for (int bj = 0; bj < 2; ++bj) *(u32x4*)(CKV + (((size_t)bj * (BATCH * NKV) + b * NKV + (cl >> 6)) * SEQ + tt) * 64 + (cl & 63)) = pack8(acc[ai][bj][m][0], acc[ai][bj][m][1]); }
            return;
        }
        bf16* base; int ld, c0;
        if (u.pn < 2) { base = QB; ld = LDQ; c0 = u.pn * 256; } else if (u.pn < 5) { base = KV; ld = LDKV; c0 = (u.pn - 3) * 256; } else { base = RW; ld = LDRW; c0 = (u.pn - 9) * 256; }
#pragma unroll
        for (int ai = 0; ai < 2; ++ai)
#pragma unroll
            for (int m = 0; m < 4; ++m)
#pragma unroll
                for (int bj = 0; bj < 2; ++bj) { const u32x4 w = pack8(acc[ai][bj][m][0], acc[ai][bj][m][1]);
                    *(u32x4*)(base + (size_t)(row0 + ai * HALF + m * 16) * ld + c0 + bj * HALF + cl) = w;
                    if (u.pn >= 9 && ai == 1 && m == 3 && wr == 1 && fr == 15) *(u32x4*)(HALO + (size_t)u.pm * LDRW + c0 + bj * HALF + cl) = w; }
    }
};
struct EpiStore {
    static constexpr bool PERM = true, AFTER_DRAIN = false;
    bf16* O; int ld, ntn;
    __device__ __forceinline__ void operator()(const f32x4 (&acc)[2][2][4][2], const Unit& u, int wr, int wc, int fr, int fq) const {
        const int row0 = u.pm * BM + wr * 64 + fr, c0 = (u.pn % ntn) * 256 + wc * 32 + 8 * fq;
#pragma unroll
        for (int ai = 0; ai < 2; ++ai)
#pragma unroll
            for (int m = 0; m < 4; ++m)
#pragma unroll
                for (int bj = 0; bj < 2; ++bj) *(u32x4*)(O + (size_t)(row0 + ai * HALF + m * 16) * ld + c0 + bj * HALF) = pack8(acc[ai][bj][m][0], acc[ai][bj][m][1]);
    }
};
struct EpiGate {
    static constexpr bool PERM = true, AFTER_DRAIN = false;
    unsigned char* ws; int ntn;
    __device__ __forceinline__ void operator()(const f32x4 (&acc)[2][2][4][2], const Unit& u, int wr, int wc, int fr, int fq) const {
        const bf16* const OB = (const bf16*)(ws + AR_OBUF); bf16* const MIX = (bf16*)(ws + AR_MIX);
        const int br = u.pn / ntn, row0 = u.pm * BM + wr * 64 + fr, c0 = (u.pn % ntn) * 256 + wc * 32 + 8 * fq;
        const bf16* ob = OB + (size_t)br * T * DM;
#pragma unroll
        for (int ai = 0; ai < 2; ++ai) {
            u32x4 o[4][2], mx[4][2];
#pragma unroll
            for (int m = 0; m < 4; ++m)
#pragma unroll
                for (int bj = 0; bj < 2; ++bj) { const size_t off = (size_t)(row0 + ai * HALF + m * 16) * DM + c0 + bj * HALF; o[m][bj] = *(const u32x4*)(ob + off); if (br != 0) mx[m][bj] = *(const u32x4*)(MIX + off); }
#pragma unroll
            for (int m = 0; m < 4; ++m)
#pragma unroll
                for (int bj = 0; bj < 2; ++bj) { const size_t off = (size_t)(row0 + ai * HALF + m * 16) * DM + c0 + bj * HALF;
                    f32x4 o0, o1; unpack8(o[m][bj], o0, o1);
                    f32x4 g0 = acc[ai][bj][m][0], g1 = acc[ai][bj][m][1];
#pragma unroll
                    for (int k = 0; k < 4; ++k) { g0[k] = fsig(g0[k]) * o0[k]; g1[k] = fsig(g1[k]) * o1[k]; }
                    if (br != 0) { f32x4 p0, p1; unpack8(mx[m][bj], p0, p1); g0 += p0; g1 += p1; }
                    *(u32x4*)(MIX + off) = pack8(g0, g1); }
        }
    }
};
struct EpiResid {
    static constexpr bool PERM = true, AFTER_DRAIN = false;
    const float* base; float* out;
    __device__ __forceinline__ void operator()(const f32x4 (&acc)[2][2][4][2], const Unit& u, int wr, int wc, int fr, int fq) const {
        const int row0 = u.pm * BM + wr * 64 + fr, c0 = u.pn * 256 + wc * 32 + 8 * fq;
#pragma unroll
        for (int ai = 0; ai < 2; ++ai)
#pragma unroll
            for (int mh = 0; mh < 2; ++mh) {
                f32x4 x[2][2][2];
#pragma unroll
                for (int mm = 0; mm < 2; ++mm)
#pragma unroll
                    for (int bj = 0; bj < 2; ++bj) { const size_t off = (size_t)(row0 + ai * HALF + (2 * mh + mm) * 16) * DM + c0 + bj * HALF; x[mm][bj][0] = *(const f32x4*)(base + off); x[mm][bj][1] = *(const f32x4*)(base + off + 4); }
#pragma unroll
                for (int mm = 0; mm < 2; ++mm)
#pragma unroll
                    for (int bj = 0; bj < 2; ++bj) { const int m = 2 * mh + mm; const size_t off = (size_t)(row0 + ai * HALF + m * 16) * DM + c0 + bj * HALF;
                        *(f32x4*)(out + off) = x[mm][bj][0] + acc[ai][bj][m][0]; *(f32x4*)(out + off + 4) = x[mm][bj][1] + acc[ai][bj][m][1]; }
            }
    }
};
struct EpiSwiglu {
    static constexpr bool PERM = true, AFTER_DRAIN = false;
    bf16* ACT; int ld, ntn;
    __device__ __forceinline__ void operator()(const f32x4 (&acc)[2][2][4][2], const Unit& u, int wr, int wc, int fr, int fq) const {
        const int row0 = u.pm * BM + wr * 64 + fr, c0 = (u.pn % ntn) * 128 + wc * 32 + 8 * fq;
#pragma unroll
        for (int ai = 0; ai < 2; ++ai)
#pragma unroll
            for (int m = 0; m < 4; ++m) { f32x4 g0 = acc[ai][0][m][0], g1 = acc[ai][0][m][1]; const f32x4 u0 = acc[ai][1][m][0], u1 = acc[ai][1][m][1];
#pragma unroll
                for (int k = 0; k < 4; ++k) { g0[k] = g0[k] * fsig(g0[k]) * u0[k]; g1[k] = g1[k] * fsig(g1[k]) * u1[k]; }
                *(u32x4*)(ACT + (size_t)(row0 + ai * HALF + m * 16) * ld + c0) = pack8(g0, g1); }
    }
};
struct EpiMoeDown {
    static constexpr bool PERM = true, AFTER_DRAIN = false;
    float* out; const int* rtok; const float* rw; int ntn; float sc;
    __device__ __forceinline__ void operator()(const f32x4 (&acc)[2][2][4][2], const Unit& u, int wr, int wc, int fr, int fq) const {
        const int row0 = u.pm * BM + wr * 64 + fr, c0 = (u.pn % ntn) * 256 + wc * 32 + 8 * fq;
#pragma unroll
        for (int ai = 0; ai < 2; ++ai)
#pragma unroll
            for (int mh = 0; mh < 2; ++mh) {
                int tok[2]; float w[2]; f32x4 x[2][2][2];
#pragma unroll
                for (int mm = 0; mm < 2; ++mm) { const int row = row0 + ai * HALF + (2 * mh + mm) * 16; tok[mm] = rtok[row]; w[mm] = rw[row] * sc; }
#pragma unroll
                for (int mm = 0; mm < 2; ++mm)
#pragma unroll
                    for (int bj = 0; bj < 2; ++bj) { const float* o = out + (size_t)(tok[mm] >= 0 ? tok[mm] : 0) * DM + c0 + bj * HALF; x[mm][bj][0] = *(const f32x4*)o; x[mm][bj][1] = *(const f32x4*)(o + 4); }
#pragma unroll
                for (int mm = 0; mm < 2; ++mm)
#pragma unroll
                    for (int bj = 0; bj < 2; ++bj) if (tok[mm] >= 0) { const int m = 2 * mh + mm; float* o = out + (size_t)tok[mm] * DM + c0 + bj * HALF;
                        *(f32x4*)o = x[mm][bj][0] + acc[ai][bj][m][0] * w[mm]; *(f32x4*)(o + 4) = x[mm][bj][1] + acc[ai][bj][m][1] * w[mm]; }
            }
    }
};

constexpr int MT_KS = 7, MT_K = EXPERT_FF / MT_KS;
struct MoeTailOrder {
    int nN, pm0, nsub, G, c, e0, e1, e2, e3, e4, e5, e6;
    __device__ void init(const MoeOrder& m, int pm0_, int ntiles, int G_, int c_) { nN = m.nN; pm0 = pm0_; nsub = ntiles * MT_KS; G = G_; c = c_; e0 = m.e0; e1 = m.e1; e2 = m.e2; e3 = m.e3; e4 = m.e4; e5 = m.e5; e6 = m.e6; }
    __device__ bool next(int i, Unit& u) const { const int L = i * G + c; if (L >= nsub) return false;
        const int j = L / MT_KS, ks = L - j * MT_KS, pm = pm0 + j / nN, pl = j % nN, e = (pm >= e0) + (pm >= e1) + (pm >= e2) + (pm >= e3) + (pm >= e4) + (pm >= e5) + (pm >= e6);
        u.pm = rfl(pm); u.pn = rfl((e * nN + pl) | (ks << 16)); return true; }
    __device__ __forceinline__ void a_ready(const Unit&) const {}
    __device__ __forceinline__ void done(const Unit&) const {}
};
struct EpiPart {
    static constexpr bool PERM = true, AFTER_DRAIN = false;
    float* part; int pm0, nN;
    __device__ __forceinline__ void operator()(const f32x4 (&acc)[2][2][4][2], const Unit& u, int wr, int wc, int fr, int fq) const {
        const int slot = ((u.pm - pm0) * nN + (u.pn & 0xffff) % nN) * MT_KS + (u.pn >> 16);
        float* b = part + (size_t)slot * 65536 + (size_t)(((wr * 4 + wc) * 64 + fq * 16 + fr) * 4);
#pragma unroll
        for (int ai = 0; ai < 2; ++ai)
#pragma unroll
            for (int bj = 0; bj < 2; ++bj)
#pragma unroll
                for (int m = 0; m < 4; ++m)
#pragma unroll
                    for (int n = 0; n < 2; ++n) *(f32x4*)(b + (((ai * 2 + bj) * 4 + m) * 2 + n) * 2048) = acc[ai][bj][m][n];
    }
};
__device__ __forceinline__ void moe_tail_combine(const EpiMoeDown& E, const MoeOrder& mo, const float* part, int pm0, int job, int lane_in) {
    int lane = lane_in; asm volatile("" : "+v"(lane));
    const int q = job & 3, role = (job >> 2) & 7, j = job >> 5, ai = q >> 1, mh = q & 1, pm = pm0 + j / mo.nN, pl = j % mo.nN, wr = role >> 2, wc = role & 3, fr = lane & 15, fq = lane >> 4;
    const float* b = part + (size_t)j * MT_KS * 65536 + (size_t)((role * 64 + lane) * 4);
    f32x4 a[2][2][2];
#pragma unroll
    for (int mm = 0; mm < 2; ++mm)
#pragma unroll
        for (int bj = 0; bj < 2; ++bj)
#pragma unroll
            for (int n = 0; n < 2; ++n) a[mm][bj][n] = *(const f32x4*)(b + (((ai * 2 + bj) * 4 + 2 * mh + mm) * 2 + n) * 2048);
#pragma unroll
    for (int ks = 1; ks < MT_KS; ++ks)
#pragma unroll
        for (int mm = 0; mm < 2; ++mm)
#pragma unroll
            for (int bj = 0; bj < 2; ++bj)
#pragma unroll
                for (int n = 0; n < 2; ++n) a[mm][bj][n] += *(const f32x4*)(b + (size_t)ks * 65536 + (((ai * 2 + bj) * 4 + 2 * mh + mm) * 2 + n) * 2048);
    const int row0 = pm * BM + wr * 64 + fr + ai * HALF + 2 * mh * 16, c0 = pl * 256 + wc * 32 + 8 * fq;
#pragma unroll
    for (int mm = 0; mm < 2; ++mm) { const int tok = E.rtok[row0 + mm * 16]; const float w = E.rw[row0 + mm * 16] * E.sc;
        if (tok >= 0) {
#pragma unroll
            for (int bj = 0; bj < 2; ++bj) { float* o = E.out + (size_t)tok * DM + c0 + bj * HALF; const f32x4 x0 = *(const f32x4*)o, x1 = *(const f32x4*)(o + 4);
                *(f32x4*)o = x0 + a[mm][bj][0] * w; *(f32x4*)(o + 4) = x1 + a[mm][bj][1] * w; } } }
}

typedef short bf16x8_t __attribute__((ext_vector_type(8)));
#define MFMA16(a, b, c) __builtin_amdgcn_mfma_f32_16x16x32_bf16((a), (b), (c), 0, 0, 0)
constexpr float ATT_C = 0.125f * 1.4426950408889634f;
constexpr int AW_IMP = 0, AW_SEL = 8448, AW_QS = 8960, AW_BYTES = 8960 + 8192;
__device__ __forceinline__ float bperm_f(float v, int srclane) { return __builtin_bit_cast(float, __builtin_amdgcn_ds_bpermute(srclane << 2, __builtin_bit_cast(int, v))); }
__device__ __forceinline__ int bperm_i(int v, int srclane) { return __builtin_amdgcn_ds_bpermute(srclane << 2, v); }
__device__ __forceinline__ bf16x8_t ldg8(const bf16* p) { return *(const bf16x8_t*)p; }
__device__ __forceinline__ bf16x8_t pack_p(const f32x4& a, const f32x4& b) {
    v4u w; w.x = cvt_pk_bf16(a[0], a[1]); w.y = cvt_pk_bf16(a[2], a[3]); w.z = cvt_pk_bf16(b[0], b[1]); w.w = cvt_pk_bf16(b[2], b[3]); return __builtin_bit_cast(bf16x8_t, w); }

__device__ __forceinline__ void nsa_attn_item(const P& p, int item, int lane, LAS unsigned char* wl) {
    const bf16* KV = WSP(bf16, AR_KV); const bf16* KC = WSP(bf16, AR_KC); const bf16* VcT = WSP(bf16, AR_VCT); const bf16* VsT = WSP(bf16, WS_VST); const bf16* VwT = WSP(bf16, WS_VWT);
    bf16* QB = WSP(bf16, AR_QB); const float* NG = WSP(float, AR_NG);
    const int bg = item / (SEQ / 16), t0 = (item % (SEQ / 16)) * 16, b = bg >> 1, g = bg & 1;
    const int col = lane & 15, fq = lane >> 4, tok = t0 + col;
    const size_t grow = (size_t)b * SEQ + tok;
    LAS float* IMP = (LAS float*)(wl + AW_IMP); LAS int* SEL = (LAS int*)(wl + AW_SEL); LAS bf16* OS = (LAS bf16*)(wl + AW_IMP);
    const int krowA = 8 * (col >> 2) + (col & 3);
    const float* gate = NG + grow * 24 + g * 12;
    LAS bf16x8_t* QS = (LAS bf16x8_t*)(wl + AW_QS) + lane;
#pragma unroll
    for (int hh = 0; hh < 4; ++hh)
#pragma unroll
        for (int ks = 0; ks < 2; ++ks) QS[(hh * 2 + ks) * 64] = ldg8(QB + grow * LDQ + (g * 4 + hh) * 64 + ks * 32 + fq * 8);
#define Qc(hh, ks) (QS[((hh) * 2 + (ks)) * 64])
    for (int i = lane; i < 16 * 132; i += 64) IMP[i] = 0.f;
    const f32x4 z4 = {0.f, 0.f, 0.f, 0.f};
    f32x4 O[4][4];
    int nvmax = (t0 + 15 >= 31) ? (((t0 + 15 - 31) >> 4) + 1) : 0; if (nvmax > NC) nvmax = NC;
    const int nch = (nvmax + 31) >> 5;
    const bf16* kcb = KC + (size_t)bg * 512 * 64; const bf16* vcb = VcT + (size_t)bg * 64 * 512;
    float linv[4] = {0.f, 0.f, 0.f, 0.f};
#pragma unroll
    for (int hh = 0; hh < 4; ++hh)
#pragma unroll
        for (int mt = 0; mt < 4; ++mt) O[hh][mt] = z4;
#pragma unroll 1
    for (int pass = 0; pass < 2; ++pass) {
#pragma unroll 1
        for (int ch = 0; ch < nch; ++ch) {
            asm volatile("" ::: "memory");
            const int k0 = 32 * ch; const bool cfull = 16 * (k0 + 31) + 31 <= t0;
            bf16x8_t ka[2][2];
#pragma unroll
            for (int tl = 0; tl < 2; ++tl)
#pragma unroll
                for (int ks = 0; ks < 2; ++ks) ka[tl][ks] = ldg8(kcb + ((size_t)(4 * ks + fq) * 512 + k0 + 16 * tl + col) * 8);
            bf16x8_t va[4];
            if (pass == 1) {
#pragma unroll
                for (int mt = 0; mt < 4; ++mt) va[mt] = ldg8(vcb + ((size_t)((k0 >> 3) + fq) * 64 + 16 * mt + col) * 8);
            }
            float ps[8] = {0.f, 0.f, 0.f, 0.f, 0.f, 0.f, 0.f, 0.f};
#pragma unroll
            for (int hh = 0; hh < 4; ++hh) {
                const bf16x8_t q0_ = Qc(hh, 0), q1_ = Qc(hh, 1);
                f32x4 sa = MFMA16(ka[0][0], q0_, z4); sa = MFMA16(ka[0][1], q1_, sa);
                f32x4 sb = MFMA16(ka[1][0], q0_, z4); sb = MFMA16(ka[1][1], q1_, sb);
#pragma unroll
                for (int i = 0; i < 4; ++i) { sa[i] = __builtin_amdgcn_exp2f(sa[i]); sb[i] = __builtin_amdgcn_exp2f(sb[i]); }
                if (!cfull) {
#pragma unroll
                    for (int i = 0; i < 4; ++i) { const int c = k0 + 4 * fq + i; sa[i] = (16 * c + 31 <= tok) ? sa[i] : 0.f; sb[i] = (16 * (c + 16) + 31 <= tok) ? sb[i] : 0.f; } }
                if (pass == 0) { linv[hh] += (sa[0] + sa[1]) + (sa[2] + sa[3]) + (sb[0] + sb[1]) + (sb[2] + sb[3]); }
                else {
#pragma unroll
                    for (int i = 0; i < 4; ++i) { ps[i] = __builtin_fmaf(sa[i], linv[hh], ps[i]); ps[4 + i] = __builtin_fmaf(sb[i], linv[hh], ps[4 + i]); }
                    const bf16x8_t pt = pack_p(sa, sb);
#pragma unroll
                    for (int mt = 0; mt < 4; ++mt) O[hh][mt] = MFMA16(va[mt], pt, O[hh][mt]);
                }
            }
            if (pass == 1) {
                const int Ga = 8 * ch + fq; LAS float* ir = IMP + col * 132 + Ga;
                __hip_atomic_fetch_add(ir, (ps[0] + ps[1]) + (ps[2] + ps[3]), __ATOMIC_RELAXED, __HIP_MEMORY_SCOPE_WORKGROUP);
                __hip_atomic_fetch_add(ir + 1, ps[3], __ATOMIC_RELAXED, __HIP_MEMORY_SCOPE_WORKGROUP);
                __hip_atomic_fetch_add(ir + 4, (ps[4] + ps[5]) + (ps[6] + ps[7]), __ATOMIC_RELAXED, __HIP_MEMORY_SCOPE_WORKGROUP);
                if (Ga + 5 < NS) __hip_atomic_fetch_add(ir + 5, ps[7], __ATOMIC_RELAXED, __HIP_MEMORY_SCOPE_WORKGROUP);
            }
        }
        if (pass == 0) {
#pragma unroll
            for (int hh = 0; hh < 4; ++hh) { float l = linv[hh]; l += bperm_f(l, lane ^ 16); l += bperm_f(l, lane ^ 32); linv[hh] = l > 0.f ? 1.f / l : 0.f; }
        }
    }
    LDS_WAIT(); asm volatile("" ::: "memory");
    {
        const int cur = tok >> 6; LAS float* sc = IMP + col * 132;
        for (int j = fq * 32; j < fq * 32 + 32; ++j) { const bool forced = (j == 0) || (j == cur) || (j == cur - 1); const float v = sc[j]; sc[j] = forced ? 1e4f : (j <= cur ? v : -1.f); }
        LDS_WAIT(); asm volatile("" ::: "memory");
#pragma unroll 1
        for (int r = 0; r < 8; ++r) {
            float bv = sc[fq * 32]; int bj = fq * 32;
            for (int j = fq * 32 + 1; j < fq * 32 + 32; ++j) { const float v = sc[j]; if (v > bv) { bv = v; bj = j; } }
#pragma unroll
            for (int o = 16; o <= 32; o <<= 1) { const float ov = bperm_f(bv, lane ^ o); const int oj = bperm_i(bj, lane ^ o); if (ov > bv || (ov == bv && oj < bj)) { bv = ov; bj = oj; } }
            if ((bj >> 5) == fq) sc[bj] = -3e38f;
            if (fq == 0) SEL[col * 8 + r] = bj;
            LDS_WAIT(); asm volatile("" ::: "memory");
        }
    }
#pragma unroll
    for (int hh = 0; hh < 4; ++hh) { const float g0 = gate[hh * 3 + 0] * linv[hh];
#pragma unroll
        for (int mt = 0; mt < 4; ++mt) { const f32x4 o = O[hh][mt] * g0; v2u w; w.x = cvt_pk_bf16(o[0], o[1]); w.y = cvt_pk_bf16(o[2], o[3]);
            *(LAS v2u*)(OS + (col * 4 + hh) * 64 + 16 * mt + 4 * fq) = w; } }
    LDS_WAIT(); asm volatile("" ::: "memory");
    const int cur = t0 >> 6;
    {
        const bf16* kwb = WSP(bf16, WS_KW8) + (size_t)bg * 8 * SEQ * 8; const bf16* vwb = VwT + (size_t)bg * 64 * SEQ;
        const bf16* ksb = WSP(bf16, WS_KS8) + (size_t)bg * 8 * SEQ * 8; const bf16* vsb = VsT + (size_t)bg * 64 * SEQ;
        int kst = t0 - (WINDOW - 1); if (kst < 0) kst = 0; kst &= ~31;
        const int nwin = ((t0 + 15 - kst) >> 5) + 1, nfb = cur >= 2 ? 3 : cur + 1;
#pragma unroll 1
        for (int part = 0; part < 2; ++part) {
            float lw[4] = {0.f, 0.f, 0.f, 0.f};
#pragma unroll
            for (int hh = 0; hh < 4; ++hh)
#pragma unroll
                for (int mt = 0; mt < 4; ++mt) O[hh][mt] = z4;
            const bf16* kb = part ? ksb : kwb; const bf16* vb = part ? vsb : vwb;
            const int nchk = part ? 2 * nfb : nwin;
#pragma unroll 1
            for (int ci = 0; ci < nchk; ++ci) {
                asm volatile("" ::: "memory");
                int k0;
                if (part == 0) k0 = kst + 32 * ci; else { const int fb = ci >> 1, j = fb == 0 ? 0 : (fb == 1 ? cur : cur - 1); k0 = 64 * j + 32 * (ci & 1); }
                bf16x8_t ka[2][2], va[4];
#pragma unroll
                for (int tl = 0; tl < 2; ++tl)
#pragma unroll
                    for (int ks = 0; ks < 2; ++ks) ka[tl][ks] = ldg8(kb + ((size_t)(4 * ks + fq) * SEQ + k0 + 16 * tl + col) * 8);
#pragma unroll
                for (int mt = 0; mt < 4; ++mt) va[mt] = ldg8(vb + ((size_t)((k0 >> 3) + fq) * 64 + 16 * mt + col) * 8);
                const int lowk = part ? -1 : tok - WINDOW; const bool dfull = (k0 + 31 <= t0) && (part || k0 > t0 + 15 - WINDOW);
#pragma unroll
                for (int hh = 0; hh < 4; ++hh) {
                    const bf16x8_t q0_ = Qc(hh, 0), q1_ = Qc(hh, 1);
                    f32x4 sa = MFMA16(ka[0][0], q0_, z4); sa = MFMA16(ka[0][1], q1_, sa);
                    f32x4 sb = MFMA16(ka[1][0], q0_, z4); sb = MFMA16(ka[1][1], q1_, sb);
#pragma unroll
                    for (int i = 0; i < 4; ++i) { sa[i] = __builtin_amdgcn_exp2f(sa[i]); sb[i] = __builtin_amdgcn_exp2f(sb[i]); }
                    if (!dfull) {
#pragma unroll
                        for (int i = 0; i < 4; ++i) { const int kt = k0 + 4 * fq + i; sa[i] = (kt <= tok && kt > lowk) ? sa[i] : 0.f; sb[i] = (kt + 16 <= tok && kt + 16 > lowk) ? sb[i] : 0.f; } }
                    lw[hh] += (sa[0] + sa[1]) + (sa[2] + sa[3]) + (sb[0] + sb[1]) + (sb[2] + sb[3]);
                    const bf16x8_t pt = pack_p(sa, sb);
#pragma unroll
                    for (int mt = 0; mt < 4; ++mt) O[hh][mt] = MFMA16(va[mt], pt, O[hh][mt]);
                }
            }
            LDS_WAIT(); asm volatile("" ::: "memory");
            if (part == 0) {
#pragma unroll
                for (int hh = 0; hh < 4; ++hh) { float l = lw[hh]; l += bperm_f(l, lane ^ 16); l += bperm_f(l, lane ^ 32); const float w = l > 0.f ? gate[hh * 3 + 2] / l : 0.f;
#pragma unroll
                    for (int mt = 0; mt < 4; ++mt) { LAS v2u* dp = (LAS v2u*)(OS + (col * 4 + hh) * 64 + 16 * mt + 4 * fq); const v2u old = *dp;
                        v2u w2; w2.x = cvt_pk_bf16(blo(old.x) + w * O[hh][mt][0], bhi(old.x) + w * O[hh][mt][1]); w2.y = cvt_pk_bf16(blo(old.y) + w * O[hh][mt][2], bhi(old.y) + w * O[hh][mt][3]); *dp = w2; } }
            } else {
                LAS bf16* OF = (LAS bf16*)(wl + AW_QS); LAS float* LF = (LAS float*)(wl + AW_IMP + 8192);
#pragma unroll
                for (int hh = 0; hh < 4; ++hh) { float l = lw[hh]; l += bperm_f(l, lane ^ 16); l += bperm_f(l, lane ^ 32); if (fq == 0) LF[col * 4 + hh] = l;
#pragma unroll
                    for (int mt = 0; mt < 4; ++mt) { v2u w2; w2.x = cvt_pk_bf16(O[hh][mt][0], O[hh][mt][1]); w2.y = cvt_pk_bf16(O[hh][mt][2], O[hh][mt][3]); *(LAS v2u*)(OF + (col * 4 + hh) * 64 + 16 * mt + 4 * fq) = w2; } }
            }
            LDS_WAIT(); asm volatile("" ::: "memory");
        }
    }
    {
        const bf16* ksb = WSP(bf16, WS_KS8) + (size_t)bg * 8 * SEQ * 8; const bf16* vsb = VsT + (size_t)bg * 64 * SEQ;
        const LAS bf16* OF = (const LAS bf16*)(wl + AW_QS); const LAS float* LF = (const LAS float*)(wl + AW_IMP + 8192);
#pragma unroll 1
        for (int tt = 0; tt < 16; ++tt) {
            const int tq = t0 + tt; const size_t qrow = (size_t)b * SEQ + tq;
            bf16x8_t Qh[2];
#pragma unroll
            for (int ks = 0; ks < 2; ++ks) { Qh[ks] = ldg8(QB + qrow * LDQ + (g * 4 + (col & 3)) * 64 + ks * 32 + fq * 8); if (col >= 4) Qh[ks] = (bf16x8_t){0, 0, 0, 0, 0, 0, 0, 0}; }
            f32x4 Os[4] = {z4, z4, z4, z4}; float ls = 0.f;
#ifdef APROBE_SEL
            for (int rp = 0; rp < 2; ++rp) { Os[0] = z4; Os[1] = z4; Os[2] = z4; Os[3] = z4; ls = 0.f; asm volatile("" ::: "memory");
#endif
#pragma unroll 1
            for (int r8 = 0; r8 < 8; ++r8) {
                const int j = __builtin_amdgcn_readfirstlane(SEL[tt * 8 + r8]);
                if (64 * j > tq || j == 0 || j == cur || j == cur - 1) continue;
                const int kb0 = 64 * j;
                bf16x8_t ka[2][2][2], va[2][4];
#pragma unroll
                for (int hf = 0; hf < 2; ++hf) {
#pragma unroll
                    for (int tl = 0; tl < 2; ++tl)
#pragma unroll
                        for (int ks = 0; ks < 2; ++ks) ka[hf][tl][ks] = ldg8(ksb + ((size_t)(4 * ks + fq) * SEQ + kb0 + 32 * hf + 16 * tl + col) * 8);
#pragma unroll
                    for (int mt = 0; mt < 4; ++mt) va[hf][mt] = ldg8(vsb + ((size_t)(((kb0 + 32 * hf) >> 3) + fq) * 64 + 16 * mt + col) * 8);
                }
#pragma unroll
                for (int hf = 0; hf < 2; ++hf) {
                    f32x4 sa = MFMA16(ka[hf][0][0], Qh[0], z4); sa = MFMA16(ka[hf][0][1], Qh[1], sa);
                    f32x4 sb = MFMA16(ka[hf][1][0], Qh[0], z4); sb = MFMA16(ka[hf][1][1], Qh[1], sb);
#pragma unroll
                    for (int i = 0; i < 4; ++i) { sa[i] = __builtin_amdgcn_exp2f(sa[i]); sb[i] = __builtin_amdgcn_exp2f(sb[i]); }
                    ls += (sa[0] + sa[1]) + (sa[2] + sa[3]) + (sb[0] + sb[1]) + (sb[2] + sb[3]);
                    const bf16x8_t pt = pack_p(sa, sb);
#pragma unroll
                    for (int mt = 0; mt < 4; ++mt) Os[mt] = MFMA16(va[hf][mt], pt, Os[mt]);
                }
            }
#ifdef APROBE_SEL
            }
#endif
            ls += bperm_f(ls, lane ^ 16); ls += bperm_f(ls, lane ^ 32);
            if (col < 4) {
                const float den = ls + LF[tt * 4 + col]; const float w = den > 0.f ? (NG + qrow * 24 + g * 12)[col * 3 + 1] / den : 0.f;
#pragma unroll
                for (int mt = 0; mt < 4; ++mt) { const int e = (tt * 4 + col) * 64 + 16 * mt + 4 * fq; const v2u old = *(const LAS v2u*)(OS + e), fo = *(const LAS v2u*)(OF + e);
                    v2u w2; w2.x = cvt_pk_bf16(blo(old.x) + w * (Os[mt][0] + blo(fo.x)), bhi(old.x) + w * (Os[mt][1] + bhi(fo.x))); w2.y = cvt_pk_bf16(blo(old.y) + w * (Os[mt][2] + blo(fo.y)), bhi(old.y) + w * (Os[mt][3] + bhi(fo.y)));
                    *(LAS v2u*)(OS + e) = w2; }
            }
        }
        LDS_WAIT(); asm volatile("" ::: "memory");
        bf16* orow = QB + ((size_t)b * SEQ + t0) * LDQ + g * 256;
#pragma unroll
        for (int i = 0; i < 8; ++i) { const int pc = i * 64 + lane; *(v4u*)(orow + (size_t)(pc >> 5) * LDQ + (pc & 31) * 8) = *(const LAS v4u*)(OS + pc * 8); }
    }
    LDS_WAIT(); asm volatile("" ::: "memory");
#undef Qc
}

typedef _Float16 h16x2 __attribute__((ext_vector_type(2)));
__device__ __forceinline__ h16x2 as_h2(unsigned u) { h16x2 r; __builtin_memcpy(&r, &u, 4); return r; }
constexpr int SC_STEPS = 8, SC_BUF = 6 * 1024;
__device__ __forceinline__ float dpp_sum16(float v) {
    v += __builtin_bit_cast(float, __builtin_amdgcn_update_dpp(0, __builtin_bit_cast(int, v), 0xB1, 0xF, 0xF, true));
    v += __builtin_bit_cast(float, __builtin_amdgcn_update_dpp(0, __builtin_bit_cast(int, v), 0x4E, 0xF, 0xF, true));
    v += __builtin_bit_cast(float, __builtin_amdgcn_update_dpp(0, __builtin_bit_cast(int, v), 0x141, 0xF, 0xF, true));
    v += __builtin_bit_cast(float, __builtin_amdgcn_update_dpp(0, __builtin_bit_cast(int, v), 0x140, 0xF, 0xF, true));
    return v;
}
__device__ __forceinline__ float fmix_lo(float a, unsigned b, float c) { float d; asm("v_fma_mix_f32 %0, %1, %2, %3 op_sel_hi:[0,1,0]" : "=v"(d) : "v"(a), "v"(b), "v"(c)); return d; }
__device__ __forceinline__ float fmix_hi(float a, unsigned b, float c) { float d; asm("v_fma_mix_f32 %0, %1, %2, %3 op_sel:[0,1,0] op_sel_hi:[0,1,0]" : "=v"(d) : "v"(a), "v"(b), "v"(c)); return d; }
__device__ __forceinline__ float fmix_lo0(float a, unsigned b) { float d; asm("v_fma_mix_f32 %0, %1, %2, 0 op_sel_hi:[0,1,0]" : "=v"(d) : "v"(a), "v"(b)); return d; }
__device__ __forceinline__ float fmix_nlo(float a, unsigned b, float c) { float d; asm("v_fma_mix_f32 %0, %1, -%2, %3 op_sel_hi:[0,1,0]" : "=v"(d) : "v"(a), "v"(b), "v"(c)); return d; }
__device__ __forceinline__ float fmix_nhi(float a, unsigned b, float c) { float d; asm("v_fma_mix_f32 %0, %1, -%2, %3 op_sel:[0,1,0] op_sel_hi:[0,1,0]" : "=v"(d) : "v"(a), "v"(b), "v"(c)); return d; }
__device__ __forceinline__ float fmix_hlo(unsigned a, unsigned b, float c) { float d; asm("v_fma_mix_f32 %0, %1, %2, %3 op_sel_hi:[1,1,0]" : "=v"(d) : "v"(a), "v"(b), "v"(c)); return d; }
__device__ __forceinline__ float fmix_hhi(unsigned a, unsigned b, float c) { float d; asm("v_fma_mix_f32 %0, %1, %2, %3 op_sel:[0,1,0] op_sel_hi:[1,1,0]" : "=v"(d) : "v"(a), "v"(b), "v"(c)); return d; }
__device__ __forceinline__ void scan_fill(const bf16* RW, const bf16* Wm, const bf16* Am, size_t trow, int h, int lane, LAS unsigned char* buf) {
    const size_t t = trow + (lane >> 3); const int sub = (lane & 7) * 8;
    const bf16* row = RW + t * LDRW + h * 64 + sub;
    __builtin_amdgcn_global_load_lds((const unsigned*)(row + LBLK), (LAS unsigned*)(buf + 0 * 1024), 16, 0, 0);
    __builtin_amdgcn_global_load_lds((const unsigned*)(Am + t * RC + h * 64 + sub), (LAS unsigned*)(buf + 1 * 1024), 16, 0, 0);
    __builtin_amdgcn_global_load_lds((const unsigned*)(Wm + t * RC + h * 64 + sub), (LAS unsigned*)(buf + 2 * 1024), 16, 0, 0);
    __builtin_amdgcn_global_load_lds((const unsigned*)(row + 512), (LAS unsigned*)(buf + 3 * 1024), 16, 0, 0);
    __builtin_amdgcn_global_load_lds((const unsigned*)(row), (LAS unsigned*)(buf + 4 * 1024), 16, 0, 0);
    __builtin_amdgcn_global_load_lds((const unsigned*)(row + 1024), (LAS unsigned*)(buf + 5 * 1024), 16, 0, 0);
}
constexpr int SC_BUF3 = 5 * 1024 + 128;
__device__ __forceinline__ unsigned scan_fill3(const bf16* RW, const bf16* Wm, const bf16* Am, size_t trow, int h, int row, int lane, LAS unsigned char* buf) {
    const size_t t = trow + (lane >> 3); const int sub = (lane & 7) * 8;
    const bf16* rp = RW + t * LDRW + h * 64 + sub;
    __builtin_amdgcn_global_load_lds((const unsigned*)(rp + LBLK), (LAS unsigned*)(buf + 0 * 1024), 16, 0, 0);
    __builtin_amdgcn_global_load_lds((const unsigned*)(Am + t * RC + h * 64 + sub), (LAS unsigned*)(buf + 1 * 1024), 16, 0, 0);
    __builtin_amdgcn_global_load_lds((const unsigned*)(Wm + t * RC + h * 64 + sub), (LAS unsigned*)(buf + 2 * 1024), 16, 0, 0);
    __builtin_amdgcn_global_load_lds((const unsigned*)(rp + 512), (LAS unsigned*)(buf + 3 * 1024), 16, 0, 0);
    __builtin_amdgcn_global_load_lds((const unsigned*)(rp), (LAS unsigned*)(buf + 4 * 1024), 16, 0, 0);
    if (lane < 8) __builtin_amdgcn_global_load_lds((const unsigned*)(RW + (trow + lane) * LDRW + 1024 + h * 64 + (row & ~7)), (LAS unsigned*)(buf + 5 * 1024), 16, 0, 0);
    return 0u;
}
__device__ __forceinline__ void scan_unit(const P& p, int unit, int lane, LAS unsigned char* wl) {
    const bf16* RW = WSP(bf16, AR_RW); const bf16* Wm = WSP(bf16, AR_W); const bf16* Am = WSP(bf16, AR_A); bf16* Y = WSP(bf16, AR_UB);
    const int rg = unit & 15, h = (unit >> 4) & 7, b = unit >> 7, row = rg * 4 + (lane >> 4), kq = lane & 15;
    const size_t tb = (size_t)b * SEQ;
    constexpr int NCH = SEQ / SC_STEPS;
    float s0 = 0.f, s1 = 0.f, s2 = 0.f, s3 = 0.f;
    __builtin_amdgcn_s_setprio(3);
#define SCAN_CHUNK(C_, BI_, B2_, VCUR_, VNEW_) do { \
        LAS unsigned char* buf = wl + (BI_) * SC_BUF3; const int c2 = (C_) + 2 < NCH ? (C_) + 2 : NCH - 1;                  \
        asm volatile("s_waitcnt lgkmcnt(0)" ::: "memory");                                                                  \
        VNEW_ = scan_fill3(RW, Wm, Am, tb + (size_t)c2 * SC_STEPS, h, row, lane, wl + (B2_) * SC_BUF3); \
        asm volatile("s_waitcnt vmcnt(12)" ::: "memory");                                                                   \
        float ys[SC_STEPS]; v2u kkw[SC_STEPS], bbw[SC_STEPS], eew[SC_STEPS], ktw[SC_STEPS], rrw[SC_STEPS]; unsigned vvw[SC_STEPS]; \
        _Pragma("unroll") for (int st = 0; st < 4; ++st) { const LAS unsigned char* o = buf + st * 128 + kq * 8; \
            kkw[st] = *(const LAS v2u*)(o); bbw[st] = *(const LAS v2u*)(o + 1024); eew[st] = *(const LAS v2u*)(o + 2048); ktw[st] = *(const LAS v2u*)(o + 3072); rrw[st] = *(const LAS v2u*)(o + 4096); \
            vvw[st] = (unsigned)*(const LAS unsigned short*)(buf + 5 * 1024 + st * 16 + (row & 7) * 2); } \
        asm volatile("" ::: "memory"); \
        _Pragma("unroll") for (int st = 4; st < SC_STEPS; ++st) { const LAS unsigned char* o = buf + st * 128 + kq * 8; \
            kkw[st] = *(const LAS v2u*)(o); bbw[st] = *(const LAS v2u*)(o + 1024); eew[st] = *(const LAS v2u*)(o + 2048); ktw[st] = *(const LAS v2u*)(o + 3072); rrw[st] = *(const LAS v2u*)(o + 4096); \
            vvw[st] = (unsigned)*(const LAS unsigned short*)(buf + 5 * 1024 + st * 16 + (row & 7) * 2); } \
        asm volatile("" ::: "memory"); \
        _Pragma("unroll") for (int st = 0; st < SC_STEPS; ++st) { const unsigned vvr = vvw[st]; \
            const float d0 = fmix_hi(s1, kkw[st].x, fmix_lo0(s0, kkw[st].x)), d1 = fmix_hi(s3, kkw[st].y, fmix_lo0(s2, kkw[st].y)); \
            const float nskk = -dpp_sum16(d0 + d1); \
            s0 = fmix_nlo(s0, eew[st].x, s0); s1 = fmix_nhi(s1, eew[st].x, s1); s2 = fmix_nlo(s2, eew[st].y, s2); s3 = fmix_nhi(s3, eew[st].y, s3); \
            s0 = fmix_lo(nskk, bbw[st].x, s0); s1 = fmix_hi(nskk, bbw[st].x, s1); s2 = fmix_lo(nskk, bbw[st].y, s2); s3 = fmix_hi(nskk, bbw[st].y, s3); \
            s0 = fmix_hlo(vvr, ktw[st].x, s0); s1 = fmix_hhi(vvr, ktw[st].x, s1); s2 = fmix_hlo(vvr, ktw[st].y, s2); s3 = fmix_hhi(vvr, ktw[st].y, s3); \
            const float y0 = fmix_hi(s1, rrw[st].x, fmix_lo0(s0, rrw[st].x)), y1 = fmix_hi(s3, rrw[st].y, fmix_lo0(s2, rrw[st].y)); \
            ys[st] = dpp_sum16(y0 + y1); } \
        if (kq < SC_STEPS) { float yv = ys[0];        \
            _Pragma("unroll") for (int st = 1; st < SC_STEPS; ++st) yv = (kq == st) ? ys[st] : yv; \
            bf16* yd = (C_) < NCH ? Y + (tb + (size_t)(C_) * SC_STEPS + kq) * RC + h * 64 + row : ysink;         \
            *yd = f2bf(yv); } } while (0)
    bf16* ysink = (bf16*)(p.ws + WS_CTL + 4 * CW_SINK) + lane;
    unsigned v0 = scan_fill3(RW, Wm, Am, tb, h, row, lane, wl), v1 = scan_fill3(RW, Wm, Am, tb + SC_STEPS, h, row, lane, wl + SC_BUF3), v2 = 0u;
#pragma unroll 1
    for (int c = 0; c < NCH + 2; c += 3) {
        SCAN_CHUNK(c, 0, 2, v0, v2);
        SCAN_CHUNK(c + 1, 1, 0, v1, v0);
        SCAN_CHUNK(c + 2, 2, 1, v2, v1);
    }
#undef SCAN_CHUNK
    asm volatile("s_waitcnt vmcnt(0) lgkmcnt(0)" ::: "memory");
    __builtin_amdgcn_s_setprio(0);
}
__device__ __forceinline__ float sum8(float v) {
    v += __builtin_bit_cast(float, __builtin_amdgcn_update_dpp(0, __builtin_bit_cast(int, v), 0xB1, 0xF, 0xF, true));
    v += __builtin_bit_cast(float, __builtin_amdgcn_update_dpp(0, __builtin_bit_cast(int, v), 0x4E, 0xF, 0xF, true));
    v += __builtin_bit_cast(float, __builtin_amdgcn_update_dpp(0, __builtin_bit_cast(int, v), 0x141, 0xF, 0xF, true));
    return v;
}
__device__ __forceinline__ void up8(v4u w, float* f) { f[0] = blo(w.x); f[1] = bhi(w.x); f[2] = blo(w.y); f[3] = bhi(w.y); f[4] = blo(w.z); f[5] = bhi(w.z); f[6] = blo(w.w); f[7] = bhi(w.w); }
#ifdef SCAN_BF16
#define uph8 up8
#define pkh8 pk8
#else
#define uph8 uph8_
#define pkh8 pkh8_
#endif
__device__ __forceinline__ void uph8_(v4u w, float* f) { const h16x2 a = as_h2(w.x), b = as_h2(w.y), c = as_h2(w.z), d = as_h2(w.w);
    f[0] = (float)a.x; f[1] = (float)a.y; f[2] = (float)b.x; f[3] = (float)b.y; f[4] = (float)c.x; f[5] = (float)c.y; f[6] = (float)d.x; f[7] = (float)d.y; }
__device__ __forceinline__ unsigned pkh2(float lo, float hi) { h16x2 v; v.x = (_Float16)lo; v.y = (_Float16)hi; return __builtin_bit_cast(unsigned, v); }
__device__ __forceinline__ v4u pkh8_(const float* f) { v4u w; w.x = pkh2(f[0], f[1]); w.y = pkh2(f[2], f[3]); w.z = pkh2(f[4], f[5]); w.w = pkh2(f[6], f[7]); return w; }
__device__ __forceinline__ v4u pk8(const float* f) { v4u w; w.x = cvt_pk_bf16(f[0], f[1]); w.y = cvt_pk_bf16(f[2], f[3]); w.z = cvt_pk_bf16(f[4], f[5]); w.w = cvt_pk_bf16(f[6], f[7]); return w; }
__device__ __forceinline__ void ldf8(const float* p, float* f) { const f32x4 a = *(const f32x4*)p, b = *(const f32x4*)(p + 4); f[0] = a[0]; f[1] = a[1]; f[2] = a[2]; f[3] = a[3]; f[4] = b[0]; f[5] = b[1]; f[6] = b[2]; f[7] = b[3]; }

struct EpiLora {
    static constexpr bool PERM = true, AFTER_DRAIN = false;
    unsigned char* ws; int pn0;
    __device__ __forceinline__ void operator()(const f32x4 (&acc)[2][2][4][2], const Unit& u, int wr, int wc, int fr, int fq) const {
        const int pn = u.pn + pn0, which = pn >> 1, row0 = u.pm * BM + wr * 64 + fr, c0 = (pn & 1) * 256 + wc * 32 + 8 * fq;
        bf16* const O = (bf16*)(ws + (which == 0 ? AR_W : (which == 1 ? AR_A : (which == 2 ? AR_G : AR_UB))));
#pragma unroll
        for (int ai = 0; ai < 2; ++ai)
#pragma unroll
            for (int m = 0; m < 4; ++m)
#pragma unroll
                for (int bj = 0; bj < 2; ++bj) *(u32x4*)(O + (size_t)(row0 + ai * HALF + m * 16) * RC + c0 + bj * HALF) = pack8(acc[ai][bj][m][0], acc[ai][bj][m][1]);
    }
};
#ifdef RKV_BF16
#define UPR up8
#define PKR pk8
#else
#define UPR uph8
#define PKR pkh8
#endif
struct B2In { v4u k, a, w, vr, vv, vf; float gt; };
__device__ __forceinline__ void b2w_load(B2In& in, const P& p, int layer, int t, int lane) {
    const bf16* row = WSP(bf16, AR_RW) + (size_t)t * LDRW;
    in.k = *(const v4u*)(row + 512 + 8 * lane); in.a = *(const v4u*)(WSP(bf16, AR_A) + (size_t)t * RC + 8 * lane); in.w = *(const v4u*)(WSP(bf16, AR_W) + (size_t)t * RC + 8 * lane);
    in.gt = lane < 24 ? bf2f(row[LBLK + 320 + lane]) : 0.f;
    if (layer == 1) { in.vr = *(const v4u*)(WSP(bf16, AR_UB) + (size_t)t * RC + 8 * lane); in.vv = *(const v4u*)(row + 1024 + 8 * lane); in.vf = *(const v4u*)(WSP(bf16, WS_VF) + (size_t)t * RC + 8 * lane); }
}
__device__ __forceinline__ void b2w_compute(const B2In& in, const P& p, int layer, int t, int lane, const float* v0, const float* v1, const float* v2, const float* v3, const float* vb) {
    bf16* row = WSP(bf16, AR_RW) + (size_t)t * LDRW; bf16* Am = WSP(bf16, AR_A); bf16* Wm = WSP(bf16, AR_W); float* NG = WSP(float, AR_NG);
    float k[8], a[8], w[8]; uph8(in.k, k); up8(in.a, a); up8(in.w, w);
    const float ngv = fsig(in.gt);
    float kk[8], ss = 0.f;
#pragma unroll
    for (int i = 0; i < 8; ++i) {
        a[i] = fsig(a[i] + v1[i]);
        const float nx = -(w[i] + v0[i]), sp = fmaxf(nx, 0.f) + __logf(1.f + __expf(-fabsf(nx))), e = __expf(-sp - 0.5f); w[i] = 1.f - __expf(-e);
        kk[i] = k[i] * v2[i]; ss += kk[i] * kk[i]; }
    ss = sum8(ss); const float nrm = sqrtf(ss), inv = 1.f / (nrm > 1e-12f ? nrm : 1e-12f);
#pragma unroll
    for (int i = 0; i < 8; ++i) { kk[i] *= inv; k[i] = k[i] * (1.f + (a[i] - 1.f) * v3[i]); a[i] *= kk[i]; }
    asm volatile("" :: "v"(ngv));
    if (layer == 1) { float vr[8], vv[8], vf[8]; up8(in.vr, vr); uph8(in.vv, vv); uph8(in.vf, vf);
#pragma unroll
        for (int i = 0; i < 8; ++i) vv[i] = vv[i] + (vf[i] - vv[i]) * fsig(vr[i] + vb[i]);
        *(v4u*)(row + 1024 + 8 * lane) = pkh8(vv); }
    if (lane < 24) NG[(size_t)t * 24 + lane] = ngv;
    *(v4u*)(row + LBLK + 8 * lane) = pkh8(kk); *(v4u*)(row + 512 + 8 * lane) = pkh8(k);
    *(v4u*)(Am + (size_t)t * RC + 8 * lane) = pkh8(a); *(v4u*)(Wm + (size_t)t * RC + 8 * lane) = pkh8(w);
}
__device__ __forceinline__ void ph_rwkv_b2w(const P& p, int layer, int gw, int NGW, int lane) {
    const float* vec = p.rwkv_vec + (size_t)layer * 7 * RC; float v0[8], v1[8], v2[8], v3[8], vb[8];
    ldf8(vec + 8 * lane, v0); ldf8(vec + RC + 8 * lane, v1); ldf8(vec + 2 * RC + 8 * lane, v2); ldf8(vec + 3 * RC + 8 * lane, v3); ldf8(p.vres_b + 8 * lane, vb);
    int t = gw; if (t >= T) return;
    B2In A, B; b2w_load(A, p, layer, t, lane);
    for (; t < T; t += 2 * NGW) { const int t1 = t + NGW, t2 = t1 + NGW;
        b2w_load(B, p, layer, t1 < T ? t1 : t, lane); b2w_compute(A, p, layer, t, lane, v0, v1, v2, v3, vb);
        if (t1 < T) { b2w_load(A, p, layer, t2 < T ? t2 : t1, lane); b2w_compute(B, p, layer, t1, lane, v0, v1, v2, v3, vb); } }
}
struct PoIn { v4u y, r, k, v, g; };
__device__ __forceinline__ void post_load(PoIn& in, const P& p, int t, int lane) { const bf16* row = WSP(bf16, AR_RW) + (size_t)t * LDRW;
    in.y = *(const v4u*)(WSP(bf16, AR_UB) + (size_t)t * RC + 8 * lane); in.r = *(const v4u*)(row + 8 * lane); in.k = *(const v4u*)(row + 512 + 8 * lane); in.v = *(const v4u*)(row + 1024 + 8 * lane); in.g = *(const v4u*)(WSP(bf16, AR_G) + (size_t)t * RC + 8 * lane); }
__device__ __forceinline__ void post_compute(const PoIn& in, const P& p, int t, int lane, const float* v4_, const float* v5, const float* v6) {
    float y[8], r[8], k[8], v[8], g[8]; up8(in.y, y); uph8(in.r, r); uph8(in.k, k); uph8(in.v, v); up8(in.g, g);
    float s = 0.f, bon = 0.f;
#pragma unroll
    for (int i = 0; i < 8; ++i) { s += y[i]; bon += r[i] * k[i] * v4_[i]; }
    const float m = sum8(s) * (1.f / 64.f); bon = sum8(bon);
    float q = 0.f;
#pragma unroll
    for (int i = 0; i < 8; ++i) { y[i] -= m; q += y[i] * y[i]; }
    const float rstd = 1.f / sqrtf(sum8(q) * (1.f / 64.f) + GN_EPS);
#pragma unroll
    for (int i = 0; i < 8; ++i) y[i] = (y[i] * rstd * v5[i] + v6[i] + bon * v[i]) * g[i];
    *(v4u*)(WSP(bf16, AR_A) + (size_t)t * RC + 8 * lane) = pk8(y);
}
__device__ __forceinline__ void ph_rwkv_postw(const P& p, int layer, int gw, int NGW, int lane) {
    const float* vec = p.rwkv_vec + (size_t)layer * 7 * RC; float v4_[8], v5[8], v6[8]; ldf8(vec + 4 * RC + 8 * lane, v4_); ldf8(vec + 5 * RC + 8 * lane, v5); ldf8(vec + 6 * RC + 8 * lane, v6);
    int t = gw; if (t >= T) return;
    PoIn A, B; post_load(A, p, t, lane);
    for (; t < T; t += 2 * NGW) { const int t1 = t + NGW, t2 = t1 + NGW;
        post_load(B, p, t1 < T ? t1 : t, lane); post_compute(A, p, t, lane, v4_, v5, v6);
        if (t1 < T) { post_load(A, p, t2 < T ? t2 : t1, lane); post_compute(B, p, t1, lane, v4_, v5, v6); } }
}
__device__ __forceinline__ void tr8x8(v4u& w, unsigned selA, bool b1, bool b2) {
    unsigned r[4] = {w.x, w.y, w.z, w.w};
#pragma unroll
    for (int i = 0; i < 4; ++i) { const unsigned pv = (unsigned)__builtin_amdgcn_update_dpp(0, (int)r[i], 0xB1, 0xF, 0xF, true); r[i] = __builtin_amdgcn_perm(pv, r[i], selA); }
#pragma unroll
    for (int a = 0; a < 4; a += 2) { const unsigned send = b1 ? r[a] : r[a + 1]; const unsigned recv = (unsigned)__builtin_amdgcn_update_dpp(0, (int)send, 0x4E, 0xF, 0xF, true);
        r[a] = b1 ? recv : r[a]; r[a + 1] = b1 ? r[a + 1] : recv; }
#pragma unroll
    for (int a = 0; a < 2; ++a) { const unsigned send = b2 ? r[a] : r[a + 2];
        int recv = __builtin_amdgcn_update_dpp(0, (int)send, 0x104, 0xF, 0x5, false);
        recv = __builtin_amdgcn_update_dpp(recv, (int)send, 0x114, 0xF, 0xA, false);
        r[a] = b2 ? (unsigned)recv : r[a]; r[a + 2] = b2 ? r[a + 2] : (unsigned)recv; }
    w.x = r[0]; w.y = r[1]; w.z = r[2]; w.w = r[3];
}
__device__ __forceinline__ void ph_vtransw(const P& p, int gw, int NGW, int lane_in) {
    int lane = lane_in; asm volatile("" : "+v"(lane));
    const bf16* KV = WSP(bf16, AR_KV); bf16* VsT = WSP(bf16, WS_VST); bf16* VwT = WSP(bf16, WS_VWT);
    const int j = lane & 7, c = lane >> 3; const unsigned selA = (lane & 1) ? 0x03020706u : 0x05040100u; const bool b1 = (lane & 2) != 0, b2 = (lane & 4) != 0;
    constexpr int NU = BATCH * NKV * (SEQ / 8);
    for (int u0 = gw * 4; u0 < NU; u0 += NGW * 4) {
        v4u s[4], w[4];
#pragma unroll
        for (int i = 0; i < 4; ++i) { const int u = u0 + i, kg = u % (SEQ / 8), bg = u / (SEQ / 8), b = bg / NKV, g = bg % NKV, tok = (kg >> 2) * 32 + 4 * (kg & 3) + (j & 3) + 16 * (j >> 2);
            const bf16* src = KV + (size_t)(b * SEQ + tok) * LDKV + g * 64 + 8 * c; s[i] = *(const v4u*)(src + 128); w[i] = *(const v4u*)(src + 384); }
#pragma unroll
        for (int i = 0; i < 4; ++i) { tr8x8(s[i], selA, b1, b2); tr8x8(w[i], selA, b1, b2);
            *(v4u*)(VsT + ((size_t)(u0 + i) * 64 + lane) * 8) = s[i]; *(v4u*)(VwT + ((size_t)(u0 + i) * 64 + lane) * 8) = w[i]; }
    }
}
typedef float f32x2 __attribute__((ext_vector_type(2)));
__device__ __forceinline__ f32x2 up2(unsigned w) { f32x2 r; r.x = __builtin_bit_cast(float, w << 16); r.y = __builtin_bit_cast(float, w & 0xffff0000u); return r; }
template <int JJ>
__device__ __forceinline__ void conv_row(f32x2 (&a)[8][4], f32x2 (&wt)[8][4], v4u (&cur)[8], f32x4& wn0, f32x4& wn1, const LAS float* wlane, const bf16* ub, int g, int j0) {
    const int j = 8 * g + JJ;
    wt[JJ][0] = (f32x2){wn0.x, wn0.y}; wt[JJ][1] = (f32x2){wn0.z, wn0.w}; wt[JJ][2] = (f32x2){wn1.x, wn1.y}; wt[JJ][3] = (f32x2){wn1.z, wn1.w};
    { const int jl = j + 1 < CONV_K ? j + 1 : CONV_K - 1; wn0 = *(const LAS f32x4*)(wlane + jl * CONV_CH); wn1 = *(const LAS f32x4*)(wlane + jl * CONV_CH + 4); }
    const unsigned msk = j >= j0 ? 0xffffffffu : 0u;
    f32x2 u[4]; u[0] = up2(cur[JJ].x & msk); u[1] = up2(cur[JJ].y & msk); u[2] = up2(cur[JJ].z & msk); u[3] = up2(cur[JJ].w & msk);
    { int jn = j + 8; jn = jn < j0 ? j0 : jn; jn = jn > CONV_K + 6 ? CONV_K + 6 : jn; cur[JJ] = *(const v4u*)(ub + (size_t)jn * CONV_CH); }
#pragma unroll
    for (int q = 0; q < 8; ++q) { const int tap = j - q; if (tap >= 0 && tap < CONV_K) {
#pragma unroll
        for (int i = 0; i < 4; ++i) a[q][i] = __builtin_elementwise_fma(u[i], wt[(JJ - q) & 7][i], a[q][i]); } }
}
__device__ __forceinline__ void ph_convw(const P& p, int layer, int gw, int NGW, int lane, int tid, LAS unsigned char* lds) {
    const bf16* UB = WSP(bf16, AR_UB); bf16* CO = WSP(bf16, AR_CO);
    const float* cw = p.conv_w + (size_t)layer * CONV_K * CONV_CH; const float* cv = p.conv_vec + (size_t)layer * 3 * CONV_CH;
    LAS float* wl = (LAS float*)lds;
    { f32x4 tw[8];
#pragma unroll
      for (int k = 0; k < 8; ++k) { const int i4 = tid + k * NTHREADS; tw[k] = i4 < CONV_K * CONV_CH / 4 ? *(const f32x4*)(cw + 4 * i4) : *(const f32x4*)(cv + 4 * (i4 - CONV_K * CONV_CH / 4)); }
      f32x4 tl = (f32x4){0.f, 0.f, 0.f, 0.f}; if (tid < 256) tl = *(const f32x4*)(cv + 4 * (tid + 8 * NTHREADS - CONV_K * CONV_CH / 4));
#pragma unroll
      for (int k = 0; k < 8; ++k) *(LAS f32x4*)(wl + 4 * (tid + k * NTHREADS)) = tw[k];
      if (tid < 256) *(LAS f32x4*)(wl + 4 * (tid + 8 * NTHREADS)) = tl; }
    TKQ(7);
    __syncthreads();
    TKQ(8);
    const LAS float* wlane = wl + 8 * lane;
    for (int tb = gw * 8; tb < T; tb += NGW * 8) {
        const int pos0 = tb % SEQ, j0 = pos0 >= 30 ? 0 : 30 - pos0;
        const bf16* ub = UB + ((size_t)tb * CONV_CH + 8 * lane) - (size_t)30 * CONV_CH;
        f32x2 a[8][4], wt[8][4]; v4u cur[8];
        { const f32x4 c0 = *(const LAS f32x4*)(wlane + CONV_K * CONV_CH), c1 = *(const LAS f32x4*)(wlane + CONV_K * CONV_CH + 4);
#pragma unroll
          for (int q = 0; q < 8; ++q) { a[q][0] = (f32x2){c0.x, c0.y}; a[q][1] = (f32x2){c0.z, c0.w}; a[q][2] = (f32x2){c1.x, c1.y}; a[q][3] = (f32x2){c1.z, c1.w}; } }
#pragma unroll
        for (int jj = 0; jj < 8; ++jj) cur[jj] = *(const v4u*)(ub + (size_t)(jj < j0 ? j0 : jj) * CONV_CH);
        f32x4 wn0 = *(const LAS f32x4*)(wlane), wn1 = *(const LAS f32x4*)(wlane + 4);
#pragma unroll 1
        for (int g = 0; g < 5; ++g) {
            conv_row<0>(a, wt, cur, wn0, wn1, wlane, ub, g, j0); conv_row<1>(a, wt, cur, wn0, wn1, wlane, ub, g, j0); conv_row<2>(a, wt, cur, wn0, wn1, wlane, ub, g, j0); conv_row<3>(a, wt, cur, wn0, wn1, wlane, ub, g, j0);
            conv_row<4>(a, wt, cur, wn0, wn1, wlane, ub, g, j0); conv_row<5>(a, wt, cur, wn0, wn1, wlane, ub, g, j0); conv_row<6>(a, wt, cur, wn0, wn1, wlane, ub, g, j0); conv_row<7>(a, wt, cur, wn0, wn1, wlane, ub, g, j0);
        }
        const f32x4 g10 = *(const LAS f32x4*)(wlane + (CONV_K + 1) * CONV_CH), g11 = *(const LAS f32x4*)(wlane + (CONV_K + 1) * CONV_CH + 4);
        const f32x4 b20 = *(const LAS f32x4*)(wlane + (CONV_K + 2) * CONV_CH), b21 = *(const LAS f32x4*)(wlane + (CONV_K + 2) * CONV_CH + 4);
        const f32x2 g1[4] = {(f32x2){g10.x, g10.y}, (f32x2){g10.z, g10.w}, (f32x2){g11.x, g11.y}, (f32x2){g11.z, g11.w}}, b2[4] = {(f32x2){b20.x, b20.y}, (f32x2){b20.z, b20.w}, (f32x2){b21.x, b21.y}, (f32x2){b21.z, b21.w}};
#pragma unroll
        for (int q = 0; q < 8; ++q) {
            const f32x2 s2 = (a[q][0] + a[q][1]) + (a[q][2] + a[q][3]);
            const float mean = wave_sum(s2.x + s2.y, lane) * (1.f / CONV_CH); f32x2 q2 = (f32x2){0.f, 0.f};
#pragma unroll
            for (int i = 0; i < 4; ++i) { a[q][i] -= (f32x2){mean, mean}; q2 = __builtin_elementwise_fma(a[q][i], a[q][i], q2); }
            const float rstd = 1.f / sqrtf(wave_sum(q2.x + q2.y, lane) * (1.f / CONV_CH) + LN_EPS);
            float y[8];
#pragma unroll
            for (int i = 0; i < 4; ++i) { const f32x2 yy = __builtin_elementwise_fma(a[q][i] * (f32x2){rstd, rstd}, g1[i], b2[i]); y[2 * i] = yy.x * fsig(yy.x); y[2 * i + 1] = yy.y * fsig(yy.y); }
            *(v4u*)(CO + (size_t)(tb + q) * CONV_CH + 8 * lane) = pk8(y);
        }
    }
    TKQ(9);
    __syncthreads();
}
__device__ __forceinline__ void ph_cmp2w(const P& p, int layer, int gw, int NGW, int lane, LAS float* hl  ) {
    const bf16* Z = WSP(bf16, AR_HID); const float* pec = (const float*)(p.ws + WS_W + (size_t)layer * SZ_LAYERW + OFF_PEC);
    for (int it = gw; it < 2 * BATCH * NKV * NC; it += NGW) {
        const int i = it % NC, r = it / NC, bg = r % (BATCH * NKV), which = r / (BATCH * NKV);
        const bf16* z1 = Z + ((size_t)which * (BATCH * NKV * 512) + (size_t)bg * 512 + i) * 256; const bf16* z2 = z1 + 256 + 128;
#pragma unroll
        for (int jj = 0; jj < 2; ++jj) { const int j = lane + 64 * jj; const float x = bf2f(z1[j]) + bf2f(z2[j]) + pec[which * 128 + j];
            const float e = __expf(fminf(2.f * 0.7978845608028654f * (x + 0.044715f * x * x * x), 30.f)); hl[j] = 0.5f * x * (1.f + (e - 1.f) / (e + 1.f)); }
        LDS_WAIT(); asm volatile("" ::: "memory");
        const float* w2 = p.cmp_w2 + (size_t)(layer * 2 + which) * 128 * 64 + lane; float o = 0.f;
#pragma unroll 8
        for (int j = 0; j < 128; ++j) o += hl[j] * w2[j * 64];
        if (which == 0) {
            const float rs = 1.f / sqrtf(wave_sum(o * o, lane) * (1.f / 64.f) + RMS_EPS); o = o * rs * p.qk_g[(layer * 4 + 1) * 64 + lane];
            const float other = bperm_f(o, lane ^ 32); float cs, sn; rope_cs(16 * i + 31, lane & 31, cs, sn);
            o = lane < 32 ? o * cs - other * sn : o * cs + other * sn;
            WSP(bf16, AR_KC)[(((size_t)bg * 8 + (lane >> 3)) * 512 + i) * 8 + (lane & 7)] = f2bf(o);
        } else { bf16* vt = WSP(bf16, AR_VCT) + (size_t)bg * 64 * 512 + lane * 8;
            vt[(size_t)((i >> 5) * 4 + ((i & 15) >> 2)) * 512 + (i & 3) + 4 * ((i >> 4) & 1)] = f2bf(o); if (i == 0) vt[(size_t)((NC >> 5) * 4 + ((NC & 15) >> 2)) * 512 + (NC & 3) + 4 * ((NC >> 4) & 1)] = 0; }
        LDS_WAIT(); asm volatile("" ::: "memory");
    }
}

struct MapPlain { bf16* base; int K; __device__ __forceinline__ bf16* operator()(int col) const { return base + (size_t)col * K; } };
struct MapGlu { bf16* base; int K, ff; __device__ __forceinline__ bf16* operator()(int col) const { return base + (size_t)glu_dest(col, ff) * K; } };
struct MapWin { unsigned char* wl; int layer; __device__ __forceinline__ bf16* operator()(int col) const { int which; const int r = win_dest(col, layer, which); const size_t off = (which ? OFF_WG : OFF_WIN) + (size_t)(r < 0 ? 0 : r) * DM * 2; return r < 0 ? nullptr : (bf16*)(wl + off); } };
template <class Map>
__device__ __forceinline__ void transpose_item(const float* W, int K, int N, const Map& mp, LAS float* scr, int item, int lane) {
    const int nblk = (N + 31) / 32, kb = item / nblk, nb = item % nblk, k0 = 64 * kb, n0 = 32 * nb;
    const int c4 = 4 * (lane & 7), col = n0 + c4;
    f32x4 v[8];
#pragma unroll
    for (int i = 0; i < 8; ++i) v[i] = col < N ? *(const f32x4*)(W + (size_t)(k0 + (lane >> 3) + 8 * i) * N + col) : (f32x4){0.f, 0.f, 0.f, 0.f};
#pragma unroll
    for (int i = 0; i < 8; ++i) { LAS float* d = scr + ((lane >> 3) + 8 * i) * 33 + c4; d[0] = v[i].x; d[1] = v[i].y; d[2] = v[i].z; d[3] = v[i].w; }
    LDS_WAIT(); asm volatile("" ::: "memory");
    const int c = lane & 7;
#pragma unroll
    for (int j = 0; j < 4; ++j) { const int n = (lane >> 3) + 8 * j; const LAS float* s = scr + (8 * c) * 33 + n;
        v4u o; o.x = (unsigned)f2bf(s[0]) | ((unsigned)f2bf(s[33]) << 16); o.y = (unsigned)f2bf(s[66]) | ((unsigned)f2bf(s[99]) << 16);
        o.z = (unsigned)f2bf(s[132]) | ((unsigned)f2bf(s[165]) << 16); o.w = (unsigned)f2bf(s[198]) | ((unsigned)f2bf(s[231]) << 16);
        if (n0 + n < N) { bf16* d = mp(n0 + n); if (d) *(v4u*)(d + k0 + 8 * c) = o; } }
    LDS_WAIT(); asm volatile("" ::: "memory");
}
template <class Map>
__device__ __forceinline__ bool conv_job(int& r, const float* W, int K, int N, const Map& mp, LAS float* scr, int lane) {
    const int items = (K / 64) * ((N + 31) / 32);
    if (r < items) { transpose_item(W, K, N, mp, scr, r, lane); return true; }
    r -= items; return false;
}

struct RmsIn { f32x4 v[DM / 256]; };
__device__ __forceinline__ void rms_load(RmsIn& r, const float* xrow, int lane) { const f32x4* xr = (const f32x4*)xrow + lane;
#pragma unroll
    for (int j = 0; j < DM / 256; ++j) r.v[j] = xr[64 * j]; }
__device__ __forceinline__ void rms_row(const P& p, const RmsIn& rin, const float* g, bf16* orow, int lane, bool route, int t, unsigned long long& c0, unsigned long long& c1) {
    const f32x4* gr = (const f32x4*)g + lane;
    f32x4 v[DM / 256]; float ss = 0.f;
#pragma unroll
    for (int j = 0; j < DM / 256; ++j) { v[j] = rin.v[j]; ss += (v[j].x * v[j].x + v[j].y * v[j].y) + (v[j].z * v[j].z + v[j].w * v[j].w); }
    const float rs = 1.f / sqrtf(wave_sum(ss, lane) * (1.f / DM) + RMS_EPS);
    v2u* o8 = (v2u*)orow + lane;
#pragma unroll
    for (int j = 0; j < DM / 256; ++j) { const f32x4 gg = gr[64 * j]; v[j].x *= rs * gg.x; v[j].y *= rs * gg.y; v[j].z *= rs * gg.z; v[j].w *= rs * gg.w;
        v2u w; w.x = cvt_pk_bf16(v[j].x, v[j].y); w.y = cvt_pk_bf16(v[j].z, v[j].w); o8[64 * j] = w; }
    if (route) {
        float lg[NEXP];
#pragma unroll
        for (int e = 0; e < NEXP; ++e) lg[e] = 0.f;
#pragma unroll
        for (int j = 0; j < DM / 256; ++j) { const float* rw = p.router_w + (size_t)(4 * (lane + 64 * j)) * NEXP;
#pragma unroll
            for (int e = 0; e < NEXP; ++e) lg[e] += v[j].x * rw[e] + v[j].y * rw[NEXP + e] + v[j].z * rw[2 * NEXP + e] + v[j].w * rw[3 * NEXP + e]; }
#pragma unroll
        for (int e = 0; e < NEXP; ++e) lg[e] = wave_sum(lg[e], lane) + p.router_b[e];
        int e0 = 0; float l0 = lg[0];
#pragma unroll
        for (int e = 1; e < NEXP; ++e) if (lg[e] > l0) { l0 = lg[e]; e0 = e; }
        int e1 = -1; float l1 = -3e38f;
#pragma unroll
        for (int e = 0; e < NEXP; ++e) if (e != e0 && lg[e] > l1) { l1 = lg[e]; e1 = e; }
        e0 = __builtin_amdgcn_readfirstlane(e0); e1 = __builtin_amdgcn_readfirstlane(e1);
        const int r0 = (int)((c0 >> (8 * e0)) & 255ull), r1 = (int)((c1 >> (8 * e1)) & 255ull);
        c0 += 1ull << (8 * e0); c1 += 1ull << (8 * e1);
        if (lane == 0) { const float w0 = 1.f / (1.f + expf(l1 - l0));
            WSP(int, AR_RTE)[t] = e0 | (e1 << 8) | (r0 << 16) | (r1 << 24); float* rw = WSP(float, AR_RTW) + (size_t)t * 2; rw[0] = w0; rw[1] = 1.f - w0; }
    }
}
__device__ __forceinline__ void rms_row_route(const P& p, const RmsIn& rin, const float* g, bf16* orow, int lane, int t, unsigned long long& c0, unsigned long long& c1, const float (&rwr)[128]) {
    const f32x4* gr = (const f32x4*)g + lane;
    f32x4 v[DM / 256]; float ss = 0.f;
#pragma unroll
    for (int j = 0; j < DM / 256; ++j) { v[j] = rin.v[j]; ss += (v[j].x * v[j].x + v[j].y * v[j].y) + (v[j].z * v[j].z + v[j].w * v[j].w); }
    const float rs = 1.f / sqrtf(wave_sum(ss, lane) * (1.f / DM) + RMS_EPS);
    v2u* o8 = (v2u*)orow + lane;
#pragma unroll
    for (int j = 0; j < DM / 256; ++j) { const f32x4 gg = gr[64 * j]; v[j].x *= rs * gg.x; v[j].y *= rs * gg.y; v[j].z *= rs * gg.z; v[j].w *= rs * gg.w;
        v2u w; w.x = cvt_pk_bf16(v[j].x, v[j].y); w.y = cvt_pk_bf16(v[j].z, v[j].w); o8[64 * j] = w; }
    float lg[NEXP];
#pragma unroll
    for (int e = 0; e < NEXP; ++e) lg[e] = 0.f;
#pragma unroll
    for (int j = 0; j < DM / 256; ++j)
#pragma unroll
        for (int e = 0; e < NEXP; ++e) lg[e] += v[j].x * rwr[(4 * j) * 8 + e] + v[j].y * rwr[(4 * j + 1) * 8 + e] + v[j].z * rwr[(4 * j + 2) * 8 + e] + v[j].w * rwr[(4 * j + 3) * 8 + e];
    float r4[4], r2[2], r1;
    { const bool hi = (lane & 32) != 0;
#pragma unroll
      for (int i = 0; i < 4; ++i) { const float mine = hi ? lg[4 + i] : lg[i], theirs = hi ? lg[i] : lg[4 + i]; r4[i] = mine + bperm_f(theirs, lane ^ 32); } }
    { const bool hi = (lane & 16) != 0;
#pragma unroll
      for (int i = 0; i < 2; ++i) { const float mine = hi ? r4[2 + i] : r4[i], theirs = hi ? r4[i] : r4[2 + i]; r2[i] = mine + bperm_f(theirs, lane ^ 16); } }
    { const bool hi = (lane & 8) != 0; const float mine = hi ? r2[1] : r2[0], theirs = hi ? r2[0] : r2[1]; r1 = mine + bperm_f(theirs, lane ^ 8); }
    r1 += bperm_f(r1, lane ^ 4); r1 += bperm_f(r1, lane ^ 2); r1 += bperm_f(r1, lane ^ 1);
#pragma unroll
    for (int e = 0; e < NEXP; ++e) lg[e] = __builtin_bit_cast(float, __builtin_amdgcn_readlane(__builtin_bit_cast(int, r1), 8 * e)) + p.router_b[e];
    int e0 = 0; float l0 = lg[0];
#pragma unroll
    for (int e = 1; e < NEXP; ++e) if (lg[e] > l0) { l0 = lg[e]; e0 = e; }
    int e1 = -1; float l1 = -3e38f;
#pragma unroll
    for (int e = 0; e < NEXP; ++e) if (e != e0 && lg[e] > l1) { l1 = lg[e]; e1 = e; }
    e0 = __builtin_amdgcn_readfirstlane(e0); e1 = __builtin_amdgcn_readfirstlane(e1);
    const int r0 = (int)((c0 >> (8 * e0)) & 255ull), r1i = (int)((c1 >> (8 * e1)) & 255ull);
    c0 += 1ull << (8 * e0); c1 += 1ull << (8 * e1);
    if (lane == 0) { const float w0 = 1.f / (1.f + expf(l1 - l0));
        WSP(int, AR_RTE)[t] = e0 | (e1 << 8) | (r0 << 16) | (r1i << 24); float* rw = WSP(float, AR_RTW) + (size_t)t * 2; rw[0] = w0; rw[1] = 1.f - w0; }
}
__device__ __forceinline__ void copy_rows4(const bf16* s0, const bf16* s1, const bf16* s2, const bf16* s3, bf16* d0, bf16* d1, bf16* d2, bf16* d3, int lane) {
    v4u a[4][DM / 512];
#pragma unroll
    for (int j = 0; j < DM / 512; ++j) { a[0][j] = ((const v4u*)s0)[lane + 64 * j]; a[1][j] = ((const v4u*)s1)[lane + 64 * j]; a[2][j] = ((const v4u*)s2)[lane + 64 * j]; a[3][j] = ((const v4u*)s3)[lane + 64 * j]; }
#pragma unroll
    for (int j = 0; j < DM / 512; ++j) { ((v4u*)d0)[lane + 64 * j] = a[0][j]; ((v4u*)d1)[lane + 64 * j] = a[1][j]; ((v4u*)d2)[lane + 64 * j] = a[2][j]; ((v4u*)d3)[lane + 64 * j] = a[3][j]; }
}
__device__ __forceinline__ void copy_row_wave(const bf16* src, bf16* dst, int lane) {
#pragma unroll
    for (int j = 0; j < DM / 512; ++j) ((v4u*)dst)[lane + 64 * j] = ((const v4u*)src)[lane + 64 * j];
}
__device__ __forceinline__ int moe_seg_start(const unsigned* cnt, int e) { int s = 0;
#pragma unroll
    for (int k = 0; k < NEXP; ++k) s += (k < e) ? (int)((cnt[k] + 255u) & ~255u) : 0;
    return s; }

#ifndef STAG_GATE
#define STAG_GATE 700
#endif
__device__ __forceinline__ void stagger_start(int bid, int ticks) {
    const unsigned long long t0 = __builtin_amdgcn_s_memrealtime(), dl = (unsigned long long)(((bid >> 3) & 3) * ticks);
    while (__builtin_amdgcn_s_memrealtime() - t0 < dl) __builtin_amdgcn_s_sleep(16);
}
#ifndef PHMASK
#define PHMASK 0xFFFFFFFFu
#endif
#define PHM(k) (((PHMASK) >> (k)) & 1u)
#ifdef PROBE_LO
constexpr int PR_LO = PROBE_LO, PR_HI = PROBE_HI;
#else
constexpr int PR_LO = -1, PR_HI = -1;
#endif
constexpr int NPH = 16, NPHASES = 1 + 2 * NPH;
struct Args { const float* in[29]; float* out; unsigned char* ws; int ph_lo, ph_hi; };

__device__ __forceinline__ bool in_phase(int k, int lo, int hi) { asm volatile("" : "+s"(lo), "+s"(hi)); return lo <= k && k < hi; }
typedef const Args __attribute__((address_space(4)))* CArgsP;
__device__ __forceinline__ void fill_params_k(P& p, CArgsP a) {
    p.x = a->in[0]; p.mix_norm_g = a->in[1]; p.w_in_first = a->in[2]; p.w_in_rest = a->in[3]; p.mu_first = a->in[4]; p.mu_rest = a->in[5]; p.qk_g = a->in[6]; p.cmp_pos = a->in[7];
    p.cmp_w1 = a->in[8]; p.cmp_w2 = a->in[9]; p.nsa_w_o = a->in[10]; p.conv_w = a->in[11]; p.conv_vec = a->in[12]; p.conv_w_o = a->in[13]; p.rwkv_vec = a->in[14]; p.w_up = a->in[15];
    p.a_up = a->in[16]; p.g_up = a->in[17]; p.vres_up = a->in[18]; p.vres_b = a->in[19]; p.rwkv_w_o = a->in[20]; p.w_out = a->in[21]; p.ffn_norm_g = a->in[22]; p.dense_gu = a->in[23];
    p.dense_down = a->in[24]; p.router_w = a->in[25]; p.router_b = a->in[26]; p.moe_gu = a->in[27]; p.moe_down = a->in[28]; p.out = a->out; p.ws = a->ws;
}
__global__ void __launch_bounds__(NTHREADS, 2) mk_fwd(Args args) {
    extern __shared__ __attribute__((aligned(16))) unsigned char lds_raw[];
    LAS unsigned char* lds = (LAS unsigned char*)lds_raw;
    const int wave0 = __builtin_amdgcn_readfirstlane((int)threadIdx.x >> 6);
    const int tid = wave0 * 64 + lane_id_opaque();
    unsigned* ctl = (unsigned*)(args.ws + WS_CTL);
    for (int u = tid; u < (LDS_BYTES - LDSCTL_OFF) / 4; u += NTHREADS) ((LAS unsigned*)(lds + LDSCTL_OFF))[u] = 0u;
    __syncthreads();
    const int lo = args.ph_lo, hi = args.ph_hi;
    XcdBarrier bar; bar.bar = ctl + CW_BAR; bar.x = 0; bar.st = nullptr;
    if (hi - lo > 1) { bar.x = xb_xcc_id(); bar.st = (volatile LAS unsigned*)(lds + MISC_OFF) + 8; if (tid == 0) (void)xb_add(ctl + CW_BAR + XB_XCNT(bar.x), 1u); }
#define RMS_LOOP(X, GN, ROUTE, C0, C1) do { int m_ = gw; if (m_ < T) { RmsIn ra_, rb_; rms_load(ra_, (X) + (size_t)m_ * DM, lane); \
        for (; m_ < T; m_ += 2 * NGW) { const int m1_ = m_ + NGW, m2_ = m1_ + NGW; rms_load(rb_, (X) + (size_t)(m1_ < T ? m1_ : m_) * DM, lane); \
            rms_row(p, ra_, (GN), WSP(bf16, WS_H) + (size_t)m_ * DM, lane, (ROUTE), m_, C0, C1); \
            if (m1_ < T) { rms_load(ra_, (X) + (size_t)(m2_ < T ? m2_ : m1_) * DM, lane); rms_row(p, rb_, (GN), WSP(bf16, WS_H) + (size_t)m1_ * DM, lane, (ROUTE), m1_, C0, C1); } } } } while (0)
#define RMS_LOOP_R(X, GN, C0, C1, RWR) do { int m_ = gw; if (m_ < T) { RmsIn ra_, rb_; rms_load(ra_, (X) + (size_t)m_ * DM, lane); \
        for (; m_ < T; m_ += 2 * NGW) { const int m1_ = m_ + NGW, m2_ = m1_ + NGW; rms_load(rb_, (X) + (size_t)(m1_ < T ? m1_ : m_) * DM, lane); \
            rms_row_route(p, ra_, (GN), WSP(bf16, WS_H) + (size_t)m_ * DM, lane, m_, C0, C1, RWR); \
            if (m1_ < T) { rms_load(ra_, (X) + (size_t)(m2_ < T ? m2_ : m1_) * DM, lane); rms_row_route(p, rb_, (GN), WSP(bf16, WS_H) + (size_t)m1_ * DM, lane, m1_, C0, C1, RWR); } } } } while (0)
#define IN(k) (in_phase((k), lo, hi) && (PR_LO < 0 || (st == 0 ? (k) <= PR_HI : (st == 1 ? ((k) >= PR_LO && (k) <= PR_HI) : (k) > PR_HI))))
#define MKP unsigned long long cdum0 = 0ull, cdum1 = 0ull; (void)cdum0; (void)cdum1; CArgsP ap_ = (CArgsP)__builtin_amdgcn_kernarg_segment_ptr(); asm volatile("" : "+s"(ap_)); P p; fill_params_k(p, ap_); int w0_ = wave0; asm volatile("" : "+s"(w0_)); int tid = w0_ * 64 + lane_id_opaque(); asm volatile("" : "+v"(tid)); const int lane = tid & 63, wave = __builtin_amdgcn_readfirstlane(tid >> 6); int G = gridDim.x, bid = blockIdx.x; asm volatile("" : "+s"(G), "+s"(bid)); unsigned* ctl = WSP(unsigned, WS_CTL); const long gtid = (long)bid * NTHREADS + tid, NT = (long)G * NTHREADS; const int gw = bid * NWAVES + wave, NGW = G * NWAVES; LAS float* scrw = (LAS float*)(lds + wave * 16384); (void)gtid; (void)NT; (void)gw; (void)NGW; (void)scrw; (void)lane; (void)ctl
#ifdef PROBE_TK
#define TKW(i) do { if (blockIdx.x == PROBE_BLK && threadIdx.x == 0) ((unsigned long long*)(args.ws + WS_CTL + 4 * CW_TK))[(i)] = __builtin_amdgcn_s_memrealtime(); } while (0)
#define TKP(i) do { if (layer == PROBE_LAYER) TKW(i); } while (0)
#define TKB() do { if (layer == PROBE_LAYER && threadIdx.x == 0) ((unsigned long long*)(args.ws + WS_CTL + 4 * CW_TK))[32 + blockIdx.x] = __builtin_amdgcn_s_memrealtime(); } while (0)
#define SEAM(k) do { if ((k) + 1 < hi) { int w_ = wave0; asm volatile("" : "+s"(w_)); xcd_barrier(bar, w_ * 64 + lane_id_opaque()); } \
    if ((k) == PROBE_TK) TKW(1); if ((k) == PROBE_TK - 1) TKW(0); } while (0)
#else
#define TKP(i) do { } while (0)
#define TKB() do { } while (0)
#define SEAM(k) do { if ((k) + 1 < hi) { int w_ = wave0; asm volatile("" : "+s"(w_)); xcd_barrier(bar, w_ * 64 + lane_id_opaque()); } } while (0)
#endif

    for (int st = 0; st < (PR_LO >= 0 ? 3 : 1); ++st) {
    if (PHM(16) && IN(0)) { MKP;
        constexpr int IT_WIN0 = (DM / 64) * ((N_IN_FIRST + 31) / 32), IT_WIN1 = (DM / 64) * ((N_IN_REST + 31) / 32), IT_WO = (512 / 64) * (DM / 32), IT_WOUT = (DM / 64) * (DM / 32);
        constexpr int total = IT_WIN0 + IT_WIN1 + 6 * IT_WO + 2 * IT_WOUT + (DM / 64) * (2 * DENSE_FF / 32) + (DENSE_FF / 64) * (DM / 32);
        bf16* wl0 = WSP(bf16, WS_W); bf16* wl1 = WSP(bf16, WS_W + SZ_LAYERW);
#define WOFF(b, o) ((bf16*)((unsigned char*)(b) + (o)))
        for (int it = gw; it < total; it += NGW) {
            int r = it;
            if (conv_job(r, p.w_in_first, DM, N_IN_FIRST, MapWin{(unsigned char*)wl0, 0}, scrw, lane)) continue;
            if (conv_job(r, p.w_in_rest, DM, N_IN_REST, MapWin{(unsigned char*)wl1, 1}, scrw, lane)) continue;
            if (conv_job(r, p.nsa_w_o, 512, DM, MapPlain{WOFF(wl0, OFF_WO3), 512}, scrw, lane)) continue;
            if (conv_job(r, p.rwkv_w_o, 512, DM, MapPlain{WOFF(wl0, OFF_WO3) + (size_t)DM * 512, 512}, scrw, lane)) continue;
            if (conv_job(r, p.conv_w_o, 512, DM, MapPlain{WOFF(wl0, OFF_WO3) + (size_t)2 * DM * 512, 512}, scrw, lane)) continue;
            if (conv_job(r, p.nsa_w_o + (size_t)512 * DM, 512, DM, MapPlain{WOFF(wl1, OFF_WO3), 512}, scrw, lane)) continue;
            if (conv_job(r, p.rwkv_w_o + (size_t)512 * DM, 512, DM, MapPlain{WOFF(wl1, OFF_WO3) + (size_t)DM * 512, 512}, scrw, lane)) continue;
            if (conv_job(r, p.conv_w_o + (size_t)512 * DM, 512, DM, MapPlain{WOFF(wl1, OFF_WO3) + (size_t)2 * DM * 512, 512}, scrw, lane)) continue;
            if (conv_job(r, p.w_out, DM, DM, MapPlain{WOFF(wl0, OFF_WOUT), DM}, scrw, lane)) continue;
            if (conv_job(r, p.w_out + (size_t)DM * DM, DM, DM, MapPlain{WOFF(wl1, OFF_WOUT), DM}, scrw, lane)) continue;
            if (conv_job(r, p.dense_gu, DM, 2 * DENSE_FF, MapGlu{WSP(bf16, WS_DGU), DM, DENSE_FF}, scrw, lane)) continue;
            conv_job(r, p.dense_down, DENSE_FF, DM, MapPlain{WSP(bf16, WS_DDN), DENSE_FF}, scrw, lane);
        }
        for (int l = 0; l < 2; ++l) {
            unsigned char* wlb = p.ws + WS_W + (size_t)l * SZ_LAYERW;
            bf16* win = (bf16*)(wlb + OFF_WIN);
            for (long i = gtid; i < 512L * DM; i += NT) { const int w = (int)(i / DM); const bool src = w < 288 || (w < 320 && l == 1) || (w >= 320 && w < 344); if (!src) win[(size_t)(3840 + w) * DM + i % DM] = 0; }
            bf16* lw = (bf16*)(wlb + OFF_LW);
            for (long i = gtid; i < 2048L * 384; i += NT) { const int n = (int)(i / 384), k = (int)(i % 384), blk = n >> 9, c = n & 511; float v = 0.f;
                if (blk == 0 && k < 64) v = p.w_up[((size_t)l * 64 + k) * RC + c]; else if (blk == 1 && k >= 64 && k < 128) v = p.a_up[((size_t)l * 64 + k - 64) * RC + c];
                else if (blk == 2 && k >= 128 && k < 288) v = p.g_up[((size_t)l * 160 + k - 128) * RC + c]; else if (blk == 3 && k >= 288 && k < 320 && l == 1) v = p.vres_up[(size_t)(k - 288) * RC + c];
                lw[i] = f2bf(v); }
            bf16* cw1 = (bf16*)(wlb + OFF_CW1);
            for (long i = gtid; i < 2L * 256 * 1024; i += NT) { const int k = (int)(i % 1024), n = (int)((i / 1024) % 256), which = (int)(i / (256 * 1024));
                cw1[i] = f2bf(p.cmp_w1[((size_t)(l * 2 + which) * 2048 + (n < 128 ? k : 1024 + k)) * 128 + (n & 127)]); }
        }
        for (int job = bid; job < 4; job += G) { const int l = job >> 1, which = job & 1;
            const float* pe = p.cmp_pos + (size_t)(l * 2 + which) * 2048; const float* w1 = p.cmp_w1 + (size_t)(l * 2 + which) * 2048 * 128 + 2 * lane;
            float s0 = 0.f, s1 = 0.f;
#pragma unroll 8
            for (int k = wave * 256; k < wave * 256 + 256; ++k) { const float2 wv = *(const float2*)(w1 + (size_t)k * 128); const float pk = pe[k]; s0 += pk * wv.x; s1 += pk * wv.y; }
            scrw[2 * lane] = s0; scrw[2 * lane + 1] = s1;
            __syncthreads();
            if (tid < 128) { float sum = 0.f;
#pragma unroll
                for (int w = 0; w < NWAVES; ++w) sum += ((const LAS float*)(lds + w * 16384))[tid];
                ((float*)(p.ws + WS_W + (size_t)l * SZ_LAYERW + OFF_PEC))[which * 128 + tid] = sum; }
            __syncthreads();
        }
    }

    for (int layer = 0; layer < 2; ++layer) {
        const int pb = 1 + layer * NPH;
        if (PHM(0) && IN(pb + 0)) { MKP;
            const float* xin = layer == 0 ? p.x : p.out;
            RMS_LOOP(xin, p.mix_norm_g + (size_t)layer * DM, false, cdum0, cdum1);
            SEAM(pb + 0);
        }
        if (PHM(1) && IN(pb + 1)) { MKP;
            Gemm g{WSP(bf16, WS_H), (const bf16*)(p.ws + WS_W + (size_t)layer * SZ_LAYERW + OFF_WIN), T, NPROJ, DM}; SOrder S; S.init(T, NPROJ, G, bid);
            EpiProj E{p.ws};
            pg8::gemm_phase<EpiProj, SOrder, true, true>(lds, g, S, E, tid);
            SEAM(pb + 1);
        }
        if (PHM(2) && IN(pb + 2)) { MKP;
            { Gemm g{WSP(bf16, AR_CKV), (const bf16*)(p.ws + WS_W + (size_t)layer * SZ_LAYERW + OFF_CW1), 2 * BATCH * NKV * 512, 512, 1024, 0}; StackOrder S{BATCH * NKV * 512 / 256, 1, 2, G, bid};
              EpiStore E{WSP(bf16, AR_HID), 256, 1};
              pg8::gemm_phase<EpiStore, StackOrder, true, true>(lds, g, S, E, tid); }
            TKP(2); ph_shift(p, layer, gtid, NT); TKP(3); ph_nsa_prep(p, layer, gtid, NT); TKP(4); ph_vtransw(p, gw, NGW, lane); TKP(5);
            ph_convw(p, layer, gw, NGW, lane, tid, lds); TKP(6); TKB();
#ifdef APROBE_CONV
            ph_convw(p, layer, gw, NGW, lane, tid, lds);
#endif
#ifdef APROBE_VT
            ph_vtransw(p, gw, NGW, lane);
#endif
            SEAM(pb + 2); }
        if (PHM(3) && IN(pb + 3)) { MKP;
#ifndef LORA_NAIVE
            { const bf16* LBp = WSP(bf16, WS_LB); const bf16* LWp = (const bf16*)(p.ws + WS_W + (size_t)layer * SZ_LAYERW + OFF_LW);
              { Gemm g{LBp, LWp, T, 1024, 128, 384, 384}; SOrder S; S.init(T, 1024, G, bid); EpiLora E{p.ws, 0}; pg8::gemm_phase<EpiLora, SOrder, false, true>(lds, g, S, E, tid); }
              { Gemm g{LBp + 128, LWp + (size_t)1024 * 384 + 128, T, 512, 256, 384, 384}; SOrder S; S.init(T, 512, G, bid); EpiLora E{p.ws, 4}; pg8::gemm_phase<EpiLora, SOrder, false, true>(lds, g, S, E, tid); }
              if (layer == 1) { Gemm g{LBp + 256, LWp + (size_t)1536 * 384 + 256, T, 512, 128, 384, 384}; SOrder S; S.init(T, 512, G, bid); EpiLora E{p.ws, 6}; pg8::gemm_phase<EpiLora, SOrder, false, true>(lds, g, S, E, tid); } }
#else
            { bf16* RW = WSP(bf16, AR_RW); bf16* Wm = WSP(bf16, AR_W); bf16* Am = WSP(bf16, AR_A); bf16* Gm = WSP(bf16, AR_G); const bf16* VF = WSP(bf16, WS_VF);
              const float* vec = p.rwkv_vec + (size_t)layer * 7 * RC; const float* wup = p.w_up + (size_t)layer * 64 * RC; const float* aup = p.a_up + (size_t)layer * 64 * RC; const float* gup = p.g_up + (size_t)layer * 160 * RC;
              for (long it = gtid; it < (long)T * RC; it += NT) { const int t = (int)(it / RC), c = (int)(it % RC); bf16* row = RW + (size_t)t * LDRW; const bf16* L = row + LBLK;
                  float wl = vec[c], alin = vec[RC + c], g = 0.f;
                  for (int j = 0; j < 64; ++j) { wl += bf2f(L[j]) * bf2f(f2bf(wup[j * RC + c])); alin += bf2f(L[64 + j]) * bf2f(f2bf(aup[j * RC + c])); }
                  for (int j = 0; j < 160; ++j) g += bf2f(L[128 + j]) * bf2f(f2bf(gup[j * RC + c]));
                  const float nx = -wl, sp = fmaxf(nx, 0.f) + __logf(1.f + __expf(-fabsf(nx))), e = __expf(-sp - 0.5f);
                  Wm[it] = f2bf(1.f - __expf(-e)); Am[it] = f2bf(fsig(alin)); Gm[it] = f2bf(g);
                  if (layer == 1) { float vl = p.vres_b[c]; for (int j = 0; j < 32; ++j) vl += bf2f(L[288 + j]) * bf2f(f2bf(p.vres_up[j * RC + c]));
                      const float v = bf2f(row[1024 + c]), vf = bf2f(VF[it]); row[1024 + c] = f2bf(v + (vf - v) * fsig(vl)); } } }
#endif
            SEAM(pb + 3); }
        if (PHM(4) && IN(pb + 4)) { MKP; ph_rwkv_b2w(p, layer, gw, NGW, lane); ph_cmp2w(p, layer, gw, NGW, lane, (LAS float*)(lds + wave * 512)); SEAM(pb + 4); }
        if (PHM(5) && IN(pb + 5)) { MKP;
            { LAS unsigned char* wl = lds + wave * AW_BYTES; constexpr int NSC = BATCH * 8 * 16, NIT = BATCH * NKV * (SEQ / 16);
#ifndef SCAN_QUEUE
              if (wave < 4) {
                  if (G * 4 == NSC && (G & 7) == 0) scan_unit(p, (bid & 7) * (NSC / 8) + (bid >> 3) * 4 + wave, lane, wl);
                  else for (int u = bid * 4 + wave; u < NSC; u += G * 4) scan_unit(p, u, lane, wl); }
#endif
#ifdef APROBE_SPLIT
              xcd_barrier(bar, tid);
#endif
              const int xme = (int)(xb_xcc_id() & 7u);
              for (int qq = 0; qq < 8; ++qq) { const int qx = (xme + qq) & 7; unsigned* head = ctl + CW_ATT + ((layer * 3 + st) * 8 + qx) * 16;
                  for (;;) { int it = 0; if (lane == 0) it = (int)atomicAdd(head, 1u); it = __builtin_amdgcn_readfirstlane(it); if (it >= NIT / 8) break;
                      const int bg = 2 * qx + it / (SEQ / 16), t16 = (SEQ / 16 - 1) - it % (SEQ / 16);
                      nsa_attn_item(p, bg * (SEQ / 16) + t16, lane, wl); } } }
 SEAM(pb + 5); }
        if (PHM(6) && IN(pb + 6)) { MKP; ph_rwkv_postw(p, layer, gw, NGW, lane); SEAM(pb + 6); }
        if (PHM(7) && IN(pb + 7)) { MKP;
            Gemm g{WSP(bf16, AR_QB), (const bf16*)(p.ws + WS_W + (size_t)layer * SZ_LAYERW + OFF_WO3), 3 * T, 3 * DM, 512}; StackOrder S{T / 256, DM / 256, 3, G, bid};
            EpiStore E{WSP(bf16, AR_OBUF), DM, DM / 256};
            pg8::gemm_phase<EpiStore, StackOrder, true, true>(lds, g, S, E, tid);
            { MKP; const float* xin = layer == 0 ? p.x : p.out;
              RMS_LOOP(xin, p.mix_norm_g + (size_t)layer * DM, false, cdum0, cdum1); }
            SEAM(pb + 7);
        }
        if (PHM(8) && IN(pb + 8)) { MKP;
            Gemm g{WSP(bf16, WS_H), (const bf16*)(p.ws + WS_W + (size_t)layer * SZ_LAYERW + OFF_WG), T, 3 * DM, DM}; GateOrder S{T / 256, DM / 256, G, bid};
            EpiGate E{p.ws, DM / 256};
            pg8::gemm_phase<EpiGate, GateOrder, true, true>(lds, g, S, E, tid);
            SEAM(pb + 8);
        }
        if (PHM(9) && IN(pb + 9)) { MKP;
            Gemm g{WSP(bf16, AR_MIX), (const bf16*)(p.ws + WS_W + (size_t)layer * SZ_LAYERW + OFF_WOUT), T, DM, DM}; SOrder S; S.init(T, DM, G, bid);
            EpiResid E{layer == 0 ? p.x : p.out, p.out};
            pg8::gemm_phase<EpiResid, SOrder, true, true>(lds, g, S, E, tid);
            SEAM(pb + 9);
        }
        if (PHM(10) && IN(pb + 10)) { MKP;
            unsigned long long c0 = 0ull, c1 = 0ull;
            if (layer == 1) { float rwr[128];
#pragma unroll
                for (int j = 0; j < DM / 256; ++j)
#pragma unroll
                    for (int k = 0; k < 8; ++k) { const f32x4 w4 = *(const f32x4*)(p.router_w + (size_t)(4 * (lane + 64 * j)) * NEXP + 4 * k); rwr[j * 32 + 4 * k] = w4.x; rwr[j * 32 + 4 * k + 1] = w4.y; rwr[j * 32 + 4 * k + 2] = w4.z; rwr[j * 32 + 4 * k + 3] = w4.w; }
                RMS_LOOP_R(p.out, p.ffn_norm_g + (size_t)layer * DM, c0, c1, rwr);
            } else RMS_LOOP(p.out, p.ffn_norm_g + (size_t)layer * DM, false, c0, c1);
            if (layer == 1 && lane < 16) {
                const unsigned cn = (unsigned)(((lane < 8 ? c0 : c1) >> (8 * (lane & 7))) & 255ull);
                WSP(unsigned, AR_WBASE)[(size_t)gw * 16 + lane] = atomicAdd(ctl + CW_CNT + lane * 64, cn); }
            if (layer == 1) { int* rt = WSP(int, AR_RTOK); for (long i = gtid; i < 2L * MOE_ROWS; i += NT) rt[i] = -1; }
            SEAM(pb + 10);
        }
        if (layer == 0) {
            if (PHM(11) && IN(pb + 11)) { MKP;
                Gemm g{WSP(bf16, WS_H), WSP(bf16, WS_DGU), T, 2 * DENSE_FF, DM}; SOrder S; S.init(T, 2 * DENSE_FF, G, bid);
                EpiSwiglu E{WSP(bf16, AR_ACT), DENSE_FF, 2 * DENSE_FF / 256};
                pg8::gemm_phase<EpiSwiglu, SOrder, true, true>(lds, g, S, E, tid);
                SEAM(pb + 11);
            }
            if (PHM(12) && IN(pb + 12)) { MKP;
                Gemm g{WSP(bf16, AR_ACT), WSP(bf16, WS_DDN), T, DM, DENSE_FF}; SOrder S; S.init(T, DM, G, bid);
                EpiResid E{p.out, p.out};
                pg8::gemm_phase<EpiResid, SOrder, true, true>(lds, g, S, E, tid);
                SEAM(pb + 12);
            }
        } else {
            if (PHM(11) && IN(pb + 11)) { MKP;
                const int ig = (DM / 64) * (2 * EXPERT_FF / 32), id = (EXPERT_FF / 64) * (DM / 32);
                for (int it = gw; it < NEXP * (ig + id); it += NGW) { const int e = it / (ig + id); int r = it % (ig + id);
                    if (conv_job(r, p.moe_gu + (size_t)e * DM * 2 * EXPERT_FF, DM, 2 * EXPERT_FF, MapGlu{WSP(bf16, AR_MGU) + (size_t)e * 2 * EXPERT_FF * DM, DM, EXPERT_FF}, scrw, lane)) continue;
                    conv_job(r, p.moe_down + (size_t)e * EXPERT_FF * DM, EXPERT_FF, DM, MapPlain{WSP(bf16, AR_MDN) + (size_t)e * DM * EXPERT_FF, EXPERT_FF}, scrw, lane); }
                int* rtok = WSP(int, AR_RTOK); float* rww = WSP(float, AR_RW8); int* trow = WSP(int, AR_TROW);
                int segv = 0; { const int pc = lane < 16 ? (int)((ctl[CW_CNT + lane * 64] + 255u) & ~255u) : 0;
#pragma unroll
                    for (int k = 0; k < 8; ++k) { const int ck = bperm_i(pc, (lane & 8) + k); segv += (k < (lane & 7)) ? ck : 0; } }
                for (int hb = gw; hb < 2 * (T / 64); hb += NGW) {
                    const int tb = (hb >> 1) * 64, half = hb & 1, t = tb + lane; const int ee = WSP(int, AR_RTE)[t], e0 = ee & 255, e1 = (ee >> 8) & 255, r0 = (ee >> 16) & 255, r1 = (ee >> 24) & 255;
                    const float* w = WSP(float, AR_RTW) + (size_t)t * 2; const unsigned* wb = WSP(unsigned, AR_WBASE) + (size_t)(t % NGW) * 16;
                    const int row0 = bperm_i(segv, e0) + (int)wb[e0] + r0, row1 = bperm_i(segv, 8 + e1) + (int)wb[8 + e1] + r1;
                    if (half == 0) { rtok[row0] = t; rww[row0] = w[0]; rtok[MOE_ROWS + row1] = t; rww[MOE_ROWS + row1] = w[1]; trow[T + t] = row1; }
                    for (int l = 32 * half; l < 32 * half + 32; l += 4) { const bf16* hs = WSP(bf16, WS_H) + (size_t)(tb + l) * DM; bf16* xg = WSP(bf16, AR_XG);
                        copy_rows4(hs, hs + DM, hs + 2 * DM, hs + 3 * DM, xg + (size_t)__builtin_amdgcn_readlane(row0, l) * DM, xg + (size_t)__builtin_amdgcn_readlane(row0, l + 1) * DM, xg + (size_t)__builtin_amdgcn_readlane(row0, l + 2) * DM, xg + (size_t)__builtin_amdgcn_readlane(row0, l + 3) * DM, lane); }
                }
                SEAM(pb + 11);
            }
#pragma unroll
            for (int pass = 0; pass < 2; ++pass) {
                if (PHM(12) && IN(pb + 12 + 2 * pass)) { MKP;
                    Gemm g{WSP(bf16, AR_XG), WSP(bf16, AR_MGU), MOE_ROWS, NEXP * 2 * EXPERT_FF, DM}; MoeOrder S; S.init(ctl + CW_CNT + 8 * 64 * pass, 2 * EXPERT_FF / 256, G, bid);
                    EpiSwiglu E{WSP(bf16, AR_MACT), EXPERT_FF, 2 * EXPERT_FF / 256};
                    if (pass == 1) {
                        MoeOrder S0; S0.init(ctl + CW_CNT, DM / 256, G, bid); const int nwg = S0.s.nwg, mainw = (nwg / G) * G, ttiles = nwg - mainw;
                        if (bar.st != nullptr && (G & 31) == 0 && mainw > 0 && ttiles > 0 && ttiles <= 32) {
                            EpiMoeDown E0{p.out, WSP(int, AR_RTOK), WSP(float, AR_RW8), DM / 256, (PR_LO >= 0 && st == 0 && pb + 14 >= PR_LO && pb + 14 <= PR_HI) ? 0.f : 1.f};
                            for (int job = wave * G + bid; job < ttiles * 32; job += NWAVES * G) moe_tail_combine(E0, S0, WSP(float, WS_PART), mainw / (DM / 256), job, lane); } }
                    pg8::gemm_phase<EpiSwiglu, MoeOrder, true, true>(lds, g, S, E, tid);
                    SEAM(pb + 12 + 2 * pass);
                }
                if (PHM(13) && IN(pb + 13 + 2 * pass)) { MKP;
                    Gemm g{WSP(bf16, AR_MACT), WSP(bf16, AR_MDN), MOE_ROWS, NEXP * DM, EXPERT_FF}; MoeOrder S; S.init(ctl + CW_CNT + 8 * 64 * pass, DM / 256, G, bid);
                    EpiMoeDown E{p.out, WSP(int, AR_RTOK) + (size_t)pass * MOE_ROWS, WSP(float, AR_RW8) + (size_t)pass * MOE_ROWS, DM / 256, (PR_LO >= 0 && st == 0 && pb + 13 + 2 * pass >= PR_LO && pb + 13 + 2 * pass <= PR_HI) ? 0.f : 1.f};
                    if (pass == 0) { const int* trow = WSP(int, AR_TROW);
                        for (int t = gw * 4; t < T; t += NGW * 4) { const bf16* hs = WSP(bf16, WS_H) + (size_t)t * DM; bf16* xg = WSP(bf16, AR_XG);
                            copy_rows4(hs, hs + DM, hs + 2 * DM, hs + 3 * DM, xg + (size_t)trow[T + t] * DM, xg + (size_t)trow[T + t + 1] * DM, xg + (size_t)trow[T + t + 2] * DM, xg + (size_t)trow[T + t + 3] * DM, lane); } }
                    const int nwg = S.s.nwg, mainw = (nwg / G) * G, ttiles = nwg - mainw; const bool split = bar.st != nullptr && (G & 31) == 0 && mainw > 0 && ttiles > 0 && ttiles <= 32;
                    if (split) S.s.nwg = mainw;
                    pg8::gemm_phase<EpiMoeDown, MoeOrder, true, true>(lds, g, S, E, tid);
                    if (split) { Gemm g2{WSP(bf16, AR_MACT), WSP(bf16, AR_MDN), MOE_ROWS, NEXP * DM, MT_K, EXPERT_FF, EXPERT_FF}; MoeTailOrder S2; S2.init(S, mainw / (DM / 256), ttiles, G, bid);
                        EpiPart E2{WSP(float, WS_PART), mainw / (DM / 256), DM / 256};
                        pg8::gemm_phase<EpiPart, MoeTailOrder, true, true, true>(lds, g2, S2, E2, tid); }
                    if (pass == 1 && split) { { int w_ = wave0; asm volatile("" : "+s"(w_)); xcd_barrier(bar, w_ * 64 + lane_id_opaque()); }
                        for (int job = wave * G + bid; job < ttiles * 32; job += NWAVES * G) moe_tail_combine(E, S, WSP(float, WS_PART), mainw / (DM / 256), job, lane); }
                    SEAM(pb + 13 + 2 * pass);
                }
            }
        }
    }
    }
#ifdef PROBE_TK
    { int w_ = wave0; asm volatile("" : "+s"(w_)); xcd_barrier(bar, w_ * 64 + lane_id_opaque()); }
    if (blockIdx.x == 0 && threadIdx.x == 0) { const unsigned long long* tk = (const unsigned long long*)(args.ws + WS_CTL + 4 * CW_TK); __builtin_amdgcn_fence(__ATOMIC_SEQ_CST, "agent");
#ifndef PROBE_STAT
        args.out[0] += floorf((float)(long long)(tk[PROBE_A1] - tk[PROBE_A0]) * 0.01f / (float)(PROBE_TU)); }
#else
        long long mx = 0, mn = 1ll << 60; for (int b = 0; b < (int)gridDim.x; ++b) { const long long d = (long long)(tk[32 + b] - tk[0]); mx = d > mx ? d : mx; mn = d < mn ? d : mn; }
        int cnt = 0; for (int b = 0; b < (int)gridDim.x; ++b) { const long long d = (long long)(tk[32 + b] - tk[0]); cnt += (mx - d) <= 100ll * PROBE_WIN ? 1 : 0; }
        args.out[0] += PROBE_STAT == 1 ? floorf((float)mx * 0.01f / (float)(PROBE_TU)) : (PROBE_STAT == 2 ? (float)cnt : floorf((float)mn * 0.01f / (float)(PROBE_TU))); }
#endif
#endif
#undef IN
#undef SEAM
}

#ifndef MK_ONE_LAUNCH
#define MK_ONE_LAUNCH 1
#endif
extern "C" void kernel_launch(void* const* d_in, const int* in_sizes, int n_in, void* d_out, int out_size, void* d_ws, size_t ws_size, hipStream_t stream) {
    static int grid = 0;
    if (grid == 0) {
        if (n_in != 29 || in_sizes[0] != T * DM || out_size != T * DM || ws_size < WS_END) { fprintf(stderr, "kernel_launch: unexpected shapes / workspace (%d inputs, ws %zu, need %zu)\n", n_in, ws_size, (size_t)WS_END); grid = -1; return; }
        int dev = 0, cus = 0;
        if (hipGetDevice(&dev) != hipSuccess || hipDeviceGetAttribute(&cus, hipDeviceAttributeMultiprocessorCount, dev) != hipSuccess) { grid = -1; return; }
        if (hipFuncSetAttribute((const void*)mk_fwd, hipFuncAttributeMaxDynamicSharedMemorySize, LDS_BYTES) != hipSuccess) { fprintf(stderr, "kernel_launch: hipFuncSetAttribute failed\n"); grid = -1; return; }
        int per_cu = 0;
        if (hipOccupancyMaxActiveBlocksPerMultiprocessor(&per_cu, (const void*)mk_fwd, NTHREADS, LDS_BYTES) != hipSuccess || per_cu < 1) { fprintf(stderr, "kernel_launch: occupancy query says %d\n", per_cu); }
        (void)hipGetLastError();
        grid = cus;
    }
    if (grid < 0) return;
    if (hipMemsetAsync((char*)d_ws + WS_CTL, 0, CTL_BYTES, stream) != hipSuccess) return;
    Args a{};
    for (int i = 0; i < 29; ++i) a.in[i] = (const float*)d_in[i];
    a.out = (float*)d_out; a.ws = (unsigned char*)d_ws;
#if MK_ONE_LAUNCH
    a.ph_lo = 0; a.ph_hi = NPHASES;
    hipLaunchKernelGGL(mk_fwd, dim3(grid), dim3(NTHREADS), LDS_BYTES, stream, a);
#else
    for (int k = 0; k < NPHASES; ++k) {
        if (k >= 1 + 13 && k < 1 + NPH) continue;
        a.ph_lo = k; a.ph_hi = k + 1;
        hipLaunchKernelGGL(mk_fwd, dim3(grid), dim3(NTHREADS), LDS_BYTES, stream, a);
    }
#endif
}
```

```cpp
#include <hip/hip_runtime.h>
#include <cstdio>
#include <cstdint>
#include <cmath>
#include <cstring>
#ifdef HOST_EMU
#define HD
#define DEV_INLINE inline
#else
#define HD __host__ __device__
#define DEV_INLINE __device__ __forceinline__
#endif

typedef unsigned short bf16;
struct alignas(16) U4 { unsigned x, y, z, w; };

#ifdef SMALL_CFG
constexpr int BATCH = 1, SEQ = 1024, DM = 128, DENSE_FF = 256, EXPERT_FF = 256;
#else
constexpr int BATCH = 8, SEQ = 8192, DM = 1024, DENSE_FF = 2816, EXPERT_FF = 3584;
#endif
constexpr int T = BATCH * SEQ;
constexpr int NHEAD = 8, NKV = 2, HG = 4, DH = 64;
constexpr int NC = SEQ / 16 - 1, NS = SEQ / 64, NSEL = 8, WINDOW = 512;
constexpr int CONV_CH = 512, CONV_K = 31, RC = 512;
constexpr int NEXP = 8;
constexpr int NSA_IN = 1304, OFF_CONV = 1304, OFF_GATE = 2328, OFF_RWKV = OFF_GATE + 3 * DM;
constexpr int N_IN_FIRST = OFF_RWKV + 1824, N_IN_REST = OFF_RWKV + 1856;
constexpr int NPROJ = 4352;
constexpr int LDQ = 512, LDKV = 512, LDRW = 2048, LBLK = 1536;
constexpr int MOE_ROWS = T + NEXP * 256;
constexpr float RMS_EPS = 1e-6f, LN_EPS = 1e-5f, GN_EPS = 64e-5f;

constexpr size_t al(size_t x) { return (x + 255) & ~(size_t)255; }
constexpr size_t WS_CTL = 0, CTL_BYTES = 1u << 20;
constexpr size_t SZ_WIN = (size_t)NPROJ * DM * 2, SZ_WG = (size_t)3 * DM * DM * 2, SZ_WO3 = (size_t)3 * DM * 512 * 2, SZ_WOUT = (size_t)DM * DM * 2;
constexpr size_t SZ_LW = (size_t)2048 * 384 * 2, SZ_CW1 = (size_t)2 * 256 * 1024 * 2, SZ_PEC = 1024;
constexpr size_t SZ_LAYERW = SZ_WIN + SZ_WG + SZ_WO3 + SZ_WOUT + SZ_LW + SZ_CW1 + SZ_PEC;
constexpr size_t WS_W = CTL_BYTES;
constexpr size_t OFF_WIN = 0, OFF_WG = SZ_WIN, OFF_WO3 = OFF_WG + SZ_WG, OFF_WOUT = OFF_WO3 + SZ_WO3, OFF_LW = OFF_WOUT + SZ_WOUT, OFF_CW1 = OFF_LW + SZ_LW, OFF_PEC = OFF_CW1 + SZ_CW1;
constexpr size_t WS_DGU = WS_W + 2 * SZ_LAYERW, SZ_DGU = (size_t)2 * DENSE_FF * DM * 2;
constexpr size_t WS_DDN = WS_DGU + SZ_DGU, SZ_DDN = (size_t)DM * DENSE_FF * 2;
constexpr size_t WS_VF = al(WS_DDN + SZ_DDN), SZ_TC = (size_t)T * 512 * 2;
constexpr size_t WS_H = WS_VF + SZ_TC, SZ_H = (size_t)T * DM * 2;
constexpr size_t WS_PART = WS_VF;
static_assert((size_t)32 * 7 * 65536 * 4 <= SZ_TC, "WS_PART");
constexpr size_t WS_AR = al(WS_H + SZ_H);
constexpr size_t AR_QB = WS_AR, AR_A = AR_QB + SZ_TC, AR_CO = AR_A + SZ_TC;
constexpr size_t AR_KV = AR_CO + SZ_TC, SZ_KV = (size_t)T * LDKV * 2;
constexpr size_t AR_RW = AR_KV + SZ_KV, SZ_RW = (size_t)T * LDRW * 2;
constexpr size_t AR_W = AR_RW + SZ_RW, AR_G = AR_W + SZ_TC, AR_UB = AR_G + SZ_TC;
constexpr size_t AR_NG = AR_UB + SZ_TC, SZ_NG = (size_t)T * 24 * 4;
constexpr size_t AR_HALO = al(AR_NG + SZ_NG), SZ_HALO = (size_t)(T / 256) * LDRW * 2;
constexpr size_t AR_KC = al(AR_HALO + SZ_HALO), SZ_CMP = (size_t)BATCH * NKV * (SEQ / 16) * 64 * 2;
constexpr size_t AR_VC = AR_KC + SZ_CMP;
constexpr size_t AR_HID = al(AR_VC + SZ_CMP), SZ_HID = (size_t)BATCH * NKV * (SEQ / 16) * 2 * 128 * 4;
constexpr size_t AR_SEL = al(AR_HID + SZ_HID), SZ_SEL = (size_t)T * NKV * 8 * 4;
constexpr size_t AR_INVN = al(AR_SEL + SZ_SEL), SZ_INVN = (size_t)T * 8 * 4;
constexpr size_t AR_VCT = al(AR_INVN + SZ_INVN);
constexpr size_t AR_CKV = al(AR_VCT + SZ_CMP), SZ_CKV = (size_t)2 * T * 128;
constexpr size_t AR_END1 = al(AR_CKV + SZ_CKV * 2);
constexpr size_t WS_VST = WS_H, WS_VWT = WS_H + (size_t)T * 128 * 2, WS_LB = WS_VWT + (size_t)T * 128 * 2, WS_KS8 = WS_LB + (size_t)T * 384 * 2, WS_KW8 = WS_KS8 + (size_t)T * 128 * 2;
constexpr size_t AR_OBUF = AR_KV, SZ_OBUF = (size_t)3 * T * DM * 2;
constexpr size_t AR_MIX = AR_OBUF + SZ_OBUF, SZ_MIX = (size_t)T * DM * 2;
constexpr size_t AR_END2 = AR_MIX + SZ_MIX;
constexpr size_t AR_ACT = WS_AR;
constexpr size_t AR_MGU = WS_AR, SZ_MGU = (size_t)NEXP * 2 * EXPERT_FF * DM * 2;
constexpr size_t AR_MDN = AR_MGU + SZ_MGU, SZ_MDN = (size_t)NEXP * DM * EXPERT_FF * 2;
constexpr size_t AR_XG = al(AR_MDN + SZ_MDN), SZ_XG = (size_t)MOE_ROWS * DM * 2;
constexpr size_t AR_MACT = al(AR_XG + SZ_XG), SZ_MACT = (size_t)MOE_ROWS * EXPERT_FF * 2;
constexpr size_t AR_RTOK = al(AR_MACT + SZ_MACT), SZ_RTOK = (size_t)2 * MOE_ROWS * 4;
constexpr size_t AR_RW8 = al(AR_RTOK + SZ_RTOK);
constexpr size_t AR_TROW = al(AR_RW8 + SZ_RTOK), SZ_TROW = (size_t)2 * T * 4;
constexpr size_t AR_RTE = al(AR_TROW + SZ_TROW);
constexpr size_t AR_RTW = al(AR_RTE + (size_t)T * 4);
constexpr size_t AR_WBASE = al(AR_RTW + (size_t)T * 8);
constexpr size_t AR_END3 = al(AR_WBASE + (size_t)4096 * 16 * 4);
constexpr size_t WS_END = (AR_END1 > AR_END2 ? (AR_END1 > AR_END3 ? AR_END1 : AR_END3) : (AR_END2 > AR_END3 ? AR_END2 : AR_END3));
constexpr int CW_CNT = 1024;
constexpr int CW_ATT = 256;
constexpr int CW_BAR = 4096, CW_TK = 8192, CW_CONV = 8256, CW_SINK = 16384;

struct P {
    const float *x, *mix_norm_g, *w_in_first, *w_in_rest, *mu_first, *mu_rest, *qk_g, *cmp_pos, *cmp_w1, *cmp_w2, *nsa_w_o, *conv_w, *conv_vec, *conv_w_o,
        *rwkv_vec, *w_up, *a_up, *g_up, *vres_up, *vres_b, *rwkv_w_o, *w_out, *ffn_norm_g, *dense_gu, *dense_down, *router_w, *router_b, *moe_gu, *moe_down;
    float* out; unsigned char* ws;
};
HD inline void fill_params(P& p, const float* const* in, float* out, unsigned char* ws) {
    p.x = in[0]; p.mix_norm_g = in[1]; p.w_in_first = in[2]; p.w_in_rest = in[3]; p.mu_first = in[4]; p.mu_rest = in[5]; p.qk_g = in[6]; p.cmp_pos = in[7];
    p.cmp_w1 = in[8]; p.cmp_w2 = in[9]; p.nsa_w_o = in[10]; p.conv_w = in[11]; p.conv_vec = in[12]; p.conv_w_o = in[13]; p.rwkv_vec = in[14]; p.w_up = in[15];
    p.a_up = in[16]; p.g_up = in[17]; p.vres_up = in[18]; p.vres_b = in[19]; p.rwkv_w_o = in[20]; p.w_out = in[21]; p.ffn_norm_g = in[22]; p.dense_gu = in[23];
    p.dense_down = in[24]; p.router_w = in[25]; p.router_b = in[26]; p.moe_gu = in[27]; p.moe_down = in[28]; p.out = out; p.ws = ws;
}
#define WSP(type, off) ((type*)(p.ws + (off)))

#ifdef HOST_EMU
#define FENCE()
#else
#define FENCE() asm volatile("" ::: "memory")
#endif
HD inline float bf2f(bf16 v) { unsigned u = (unsigned)v << 16; float f; memcpy(&f, &u, 4); return f; }
HD inline bf16 f2bf(float f) { unsigned u; memcpy(&u, &f, 4); return (bf16)((u + 0x7fffu + ((u >> 16) & 1u)) >> 16); }
HD inline float blo(unsigned v) { unsigned u = v << 16; float f; memcpy(&f, &u, 4); return f; }
HD inline float bhi(unsigned v) { unsigned u = v & 0xffff0000u; float f; memcpy(&f, &u, 4); return f; }
#if !defined(SCAN_BF16) && !defined(RKV_BF16)
HD inline bf16 f2h(float f) { return __builtin_bit_cast(unsigned short, (_Float16)f); }
#else
HD inline bf16 f2bf(float f);
HD inline bf16 f2h(float f) { return f2bf(f); }
#endif
HD inline float h2f(bf16 v) { return (float)__builtin_bit_cast(_Float16, v); }
HD inline float sigmoidf_(float x) { return 1.f / (1.f + expf(-x)); }
HD inline float dot64(const float* q, const bf16* kp) {
    const U4* k4 = (const U4*)kp; float s0 = 0.f, s1 = 0.f;
#pragma unroll
    for (int i = 0; i < 8; ++i) { const U4 v = k4[i];
        s0 += q[8 * i + 0] * blo(v.x) + q[8 * i + 2] * blo(v.y) + q[8 * i + 4] * blo(v.z) + q[8 * i + 6] * blo(v.w);
        s1 += q[8 * i + 1] * bhi(v.x) + q[8 * i + 3] * bhi(v.y) + q[8 * i + 5] * bhi(v.z) + q[8 * i + 7] * bhi(v.w); }
    return s0 + s1;
}
HD inline float dot64p(const U4* q, const bf16* kp) {
    const U4* k4 = (const U4*)kp; float s0 = 0.f, s1 = 0.f;
#pragma unroll
    for (int i = 0; i < 8; ++i) { const U4 v = k4[i], w = q[i];
        s0 += blo(w.x) * blo(v.x) + blo(w.y) * blo(v.y) + blo(w.z) * blo(v.z) + blo(w.w) * blo(v.w);
        s1 += bhi(w.x) * bhi(v.x) + bhi(w.y) * bhi(v.y) + bhi(w.z) * bhi(v.z) + bhi(w.w) * bhi(v.w); }
    return s0 + s1;
}
HD inline void ld64(const bf16* kp, float* q) {
    const U4* k4 = (const U4*)kp;
#pragma unroll
    for (int i = 0; i < 8; ++i) { const U4 v = k4[i]; q[8 * i] = blo(v.x); q[8 * i + 1] = bhi(v.x); q[8 * i + 2] = blo(v.y); q[8 * i + 3] = bhi(v.y);
        q[8 * i + 4] = blo(v.z); q[8 * i + 5] = bhi(v.z); q[8 * i + 6] = blo(v.w); q[8 * i + 7] = bhi(v.w); }
}
HD inline void axpy64(float* o, float w, const bf16* vp) {
    const U4* k4 = (const U4*)vp;
#pragma unroll
    for (int i = 0; i < 8; ++i) { const U4 v = k4[i]; o[8 * i] += w * blo(v.x); o[8 * i + 1] += w * bhi(v.x); o[8 * i + 2] += w * blo(v.y); o[8 * i + 3] += w * bhi(v.y);
        o[8 * i + 4] += w * blo(v.z); o[8 * i + 5] += w * bhi(v.z); o[8 * i + 6] += w * blo(v.w); o[8 * i + 7] += w * bhi(v.w); }
}
HD inline void axpy64s(float* o, float w, const bf16* vp) {
    const U4* k4 = (const U4*)vp;
#pragma unroll
    for (int i = 0; i < 8; ++i) { const U4 v = k4[i]; o[8 * i] = w * o[8 * i] + blo(v.x); o[8 * i + 1] = w * o[8 * i + 1] + bhi(v.x); o[8 * i + 2] = w * o[8 * i + 2] + blo(v.y); o[8 * i + 3] = w * o[8 * i + 3] + bhi(v.y);
        o[8 * i + 4] = w * o[8 * i + 4] + blo(v.z); o[8 * i + 5] = w * o[8 * i + 5] + bhi(v.z); o[8 * i + 6] = w * o[8 * i + 6] + blo(v.w); o[8 * i + 7] = w * o[8 * i + 7] + bhi(v.w); }
}
HD inline void st64(bf16* op, const float* o) {
    U4* o4 = (U4*)op;
#pragma unroll
    for (int i = 0; i < 8; ++i) { U4 v; v.x = (unsigned)f2bf(o[8 * i]) | ((unsigned)f2bf(o[8 * i + 1]) << 16); v.y = (unsigned)f2bf(o[8 * i + 2]) | ((unsigned)f2bf(o[8 * i + 3]) << 16);
        v.z = (unsigned)f2bf(o[8 * i + 4]) | ((unsigned)f2bf(o[8 * i + 5]) << 16); v.w = (unsigned)f2bf(o[8 * i + 6]) | ((unsigned)f2bf(o[8 * i + 7]) << 16); o4[i] = v; }
}

HD inline void rope_cs(int pos, int i, float& cs, float& sn) {
    const float c = exp2f(-(float)i * 0.41524101186092f) * 0.15915494309189535f, pf = (float)pos;
    const float prod = pf * c, err = fmaf(pf, c, -prod), fr = (prod - rintf(prod)) + err;
#ifdef HOST_EMU
    cs = cosf(6.283185307179586f * fr); sn = sinf(6.283185307179586f * fr);
#else
    cs = __builtin_amdgcn_cosf(fr); sn = __builtin_amdgcn_sinf(fr);
#endif
}
HD inline int win_dest(int j, int layer, int& which) {
    which = 0;
    if (j < 1280) return j;
    if (j < 1304) return 3840 + 320 + (j - 1280);
    if (j < 1816) { const int cc = j - 1304; return 1280 + 256 * (cc / 128) + cc % 128; }
    if (j < 2328) { const int cc = j - 1816; return 1280 + 256 * (cc / 128) + 128 + cc % 128; }
    if (j < OFF_RWKV) { which = 1; const int gg = j - OFF_GATE, br = gg / DM; return (br == 0 ? 0 : (br == 1 ? 2 * DM : DM)) + gg % DM; }
    const int rr = j - OFF_RWKV;
    if (rr < 1536) return 2304 + rr;
    if (rr < 1824) return 3840 + (rr - 1536);
    if (rr < 1856 && layer == 1) return 3840 + 288 + (rr - 1824);
    return -1;
}
HD inline int glu_dest(int j, int ff) { return j < ff ? 256 * (j / 128) + j % 128 : 256 * ((j - ff) / 128) + 128 + (j - ff) % 128; }

DEV_INLINE void ph_shift(const P& p, int layer, long gtid, long NT) {
    bf16* RW = WSP(bf16, AR_RW); const bf16* HALO = WSP(bf16, AR_HALO); bf16* VF = WSP(bf16, WS_VF); bf16* LB = WSP(bf16, WS_LB);
    const float* mu = layer == 0 ? p.mu_first : p.mu_rest;
    constexpr int NCP = (LBLK + 384) / 2;
    const long n = (long)(T / 256) * NCP;
    for (long it = gtid; it < n; it += NT) {
        const int pm = (int)(it / NCP), c = 2 * (int)(it % NCP);
        int mi = -1, act = 0;
        if (c < LBLK) mi = c;
        else { const int w = c - LBLK; if (w < 288) { mi = 1536 + w; act = w < 64 ? 1 : (w >= 128 ? 2 : 0); } else if (w < 320 && layer == 1) mi = 1824 + (w - 288); }
        if (mi < 0) { for (int r = 0; r < 256; ++r) *(unsigned*)(LB + ((size_t)pm * 256 + r) * 384 + (c - LBLK)) = 0u; continue; }
        const float m0 = mu[mi], m1 = mu[mi + 1];
        float prev0 = 0.f, prev1 = 0.f;
        if ((pm * 256) % SEQ != 0) { const unsigned hv = *(const unsigned*)(HALO + (size_t)(pm - 1) * LDRW + c); prev0 = blo(hv); prev1 = bhi(hv); }
        bf16* col = RW + (size_t)pm * 256 * LDRW + c;
        for (int r0 = 0; r0 < 256; r0 += 16) {
            unsigned pv[16];
#pragma unroll
            for (int k = 0; k < 16; ++k) pv[k] = *(const unsigned*)(col + (size_t)(r0 + k) * LDRW);
#pragma unroll
            for (int k = 0; k < 16; ++k) { const int r = r0 + k; const float p0 = blo(pv[k]), p1 = bhi(pv[k]);
                float u0 = p0 + (prev0 - p0) * m0, u1 = p1 + (prev1 - p1) * m1; prev0 = p0; prev1 = p1;
                if (act == 1) { u0 = tanhf(u0); u1 = tanhf(u1); } else if (act == 2) { u0 = sigmoidf_(u0); u1 = sigmoidf_(u1); }
                if (c < LBLK) { const unsigned hv = (unsigned)f2h(u0) | ((unsigned)f2h(u1) << 16); *(unsigned*)(col + (size_t)r * LDRW) = hv;
                    if (layer == 0 && c >= 1024) *(unsigned*)(VF + ((size_t)pm * 256 + r) * RC + (c - 1024)) = hv; }
                else *(unsigned*)(LB + ((size_t)pm * 256 + r) * 384 + (c - LBLK)) = (unsigned)f2bf(u0) | ((unsigned)f2bf(u1) << 16); }
        }
    }
}

DEV_INLINE void ph_nsa_prep(const P& p, int layer, long gtid, long NT) {
    bf16* QB = WSP(bf16, AR_QB); bf16* KV = WSP(bf16, AR_KV);
    const long n = (long)T * 12;
    for (long it = gtid; it < n; it += NT) {
        const int t = (int)(it / 12), s = (int)(it % 12), pos = t % SEQ;
        bf16* ptr; const float* g;
        if (s < 8) { ptr = QB + (size_t)t * LDQ + s * 64; g = p.qk_g + (layer * 4 + 0) * 64; }
        else if (s < 10) { ptr = KV + (size_t)t * LDKV + (s - 8) * 64; g = p.qk_g + (layer * 4 + 2) * 64; }
        else { ptr = KV + (size_t)t * LDKV + 256 + (s - 10) * 64; g = p.qk_g + (layer * 4 + 3) * 64; }
        float v[64]; ld64(ptr, v);
        float ss = 0.f;
#pragma unroll
        for (int i = 0; i < 64; ++i) ss += v[i] * v[i];
        const float rs = 1.f / sqrtf(ss * (1.f / 64.f) + RMS_EPS);
#pragma unroll
        for (int i = 0; i < 64; ++i) v[i] = v[i] * rs * g[i];
#pragma unroll
        for (int i = 0; i < 32; ++i) {
            float cs, sn; rope_cs(pos, i, cs, sn);
            const float x1 = v[i], x2 = v[i + 32]; v[i] = x1 * cs - x2 * sn; v[i + 32] = x2 * cs + x1 * sn;
        }
        if (s < 8) {
#pragma unroll
            for (int i = 0; i < 64; ++i) v[i] *= 0.125f * 1.4426950408889634f; }
        if (s < 8) st64(ptr, v);
        else {
            const int gg = (s - 8) & 1, bq = t / SEQ; bf16* k8 = WSP(bf16, s < 10 ? WS_KS8 : WS_KW8) + (size_t)(bq * NKV + gg) * 8 * SEQ * 8;
#pragma unroll
            for (int dg = 0; dg < 8; ++dg) { U4 w; w.x = (unsigned)f2bf(v[8 * dg]) | ((unsigned)f2bf(v[8 * dg + 1]) << 16); w.y = (unsigned)f2bf(v[8 * dg + 2]) | ((unsigned)f2bf(v[8 * dg + 3]) << 16);
                w.z = (unsigned)f2bf(v[8 * dg + 4]) | ((unsigned)f2bf(v[8 * dg + 5]) << 16); w.w = (unsigned)f2bf(v[8 * dg + 6]) | ((unsigned)f2bf(v[8 * dg + 7]) << 16);
                *(U4*)(k8 + ((size_t)dg * SEQ + pos) * 8) = w; } }
    }
}

DEV_INLINE void ph_vtrans(const P& p, long gtid, long NT) {
    const bf16* KV = WSP(bf16, AR_KV); bf16* VsT = WSP(bf16, WS_VST); bf16* VwT = WSP(bf16, WS_VWT);
    const long n = (long)BATCH * NKV * (SEQ / 8) * 64;
    for (long it = gtid; it < n; it += NT) {
        const int d = (int)(it % 64); long r = it / 64; const int kg = (int)(r % (SEQ / 8)); const int bg = (int)(r / (SEQ / 8)), b = bg / NKV, g = bg % NKV;
        const int kbase = (kg >> 2) * 32 + 4 * (kg & 3);
        const bf16* src = KV + (size_t)(b * SEQ + kbase) * LDKV + g * 64 + d;
        U4 s, w; unsigned short sv[8], wv[8];
#pragma unroll
        for (int j = 0; j < 8; ++j) { const size_t ro = (size_t)((j & 3) + 16 * (j >> 2)) * LDKV; sv[j] = src[ro + 128]; wv[j] = src[ro + 384]; }
        s.x = sv[0] | ((unsigned)sv[1] << 16); s.y = sv[2] | ((unsigned)sv[3] << 16); s.z = sv[4] | ((unsigned)sv[5] << 16); s.w = sv[6] | ((unsigned)sv[7] << 16);
        w.x = wv[0] | ((unsigned)wv[1] << 16); w.y = wv[2] | ((unsigned)wv[3] << 16); w.z = wv[4] | ((unsigned)wv[5] << 16); w.w = wv[6] | ((unsigned)wv[7] << 16);
        *(U4*)(VsT + (((size_t)bg * (SEQ / 8) + kg) * 64 + d) * 8) = s; *(U4*)(VwT + (((size_t)bg * (SEQ / 8) + kg) * 64 + d) * 8) = w;
    }
}
namespace pg8 {
#define PG8_LAS __attribute__((address_space(3)))
typedef unsigned short bf16_t;
typedef short bf16x8 __attribute__((ext_vector_type(8)));
typedef float f32x4 __attribute__((ext_vector_type(4)));
typedef unsigned u32x4 __attribute__((ext_vector_type(4)));
constexpr int BM = 256, BK = 64, HALF = 128, HTB = HALF * BK * 2  , STAGE_BYTES = 8 * HTB, NXCD = 8, WGM = 8;

__host__ __device__ __forceinline__ int lds_byte(int r, int c) { const int st = (r >> 4) * 2 + (c >> 5), rr = r & 15, cc = c & 31, ob = rr * 64 + cc * 2; return st * 1024 + (ob ^ (((ob >> 9) & 1) << 5)); }
__host__ __device__ __forceinline__ void stage_rc(int b, int& R, int& C) { const int st = b / 1024, sb = b % 1024, swz = sb ^ (((sb >> 9) & 1) << 5); R = (st >> 1) * 16 + swz / 64; C = (st & 1) * 32 + (swz % 64) / 2; }
__host__ __device__ __forceinline__ int perm32(int rho) { const int n = rho >> 4, i = rho & 15; return 8 * (i >> 2) + 4 * n + (i & 3); }

struct Unit { int pm, pn; };
struct Gemm { const bf16_t* A; const bf16_t* Bt; int M, N, K; int lda; int ldb; };

struct StaticOrder {
    int nM, nN, nwg, G, c;
    __host__ __device__ void init(int M, int N, int G_, int c_) { nM = M / BM; nN = N / BM; nwg = nM * nN; G = G_; c = c_; }
    __host__ __device__ bool next(int i, Unit& u) const {
        const long L = (long)i * G + c; if (L >= nwg) return false;
        int wgid = (int)L; { const int q = nwg / NXCD, r = nwg % NXCD, xcd = wgid % NXCD, off = wgid / NXCD; wgid = (xcd < r ? xcd * (q + 1) : r * (q + 1) + (xcd - r) * q) + off; }
        const int nig = WGM * nN, gid = wgid / nig, fm = gid * WGM, gsz = (nM - fm) < WGM ? (nM - fm) : WGM;
        u.pm = fm + ((wgid % nig) % gsz); u.pn = (wgid % nig) / gsz; return true;
    }
    __device__ __forceinline__ void a_ready(const Unit&) const {}
    __device__ __forceinline__ void done(const Unit&) const {}
};

__device__ __forceinline__ unsigned cvt_pk_bf16(float lo, float hi) { unsigned r; asm volatile("v_cvt_pk_bf16_f32 %0, %1, %2" : "=v"(r) : "v"(lo), "v"(hi)); return r; }
typedef float f32x2 __attribute__((ext_vector_type(2)));
template <class Epi, class Sched, bool ALIGN_EPI = false, bool SP2 = false, bool KSPLIT = false>
__device__ __forceinline__ void gemm_phase(PG8_LAS unsigned char* lds, const Gemm g, const Sched& S, const Epi& E, int tid_in) {
    int tid_ = tid_in; asm volatile("" : "+v"(tid_));
    const int tid = tid_, wid = __builtin_amdgcn_readfirstlane(tid >> 6), lane = tid & 63, wr = wid >> 2, wc = wid & 3, fr = lane & 15, fq = lane >> 4;
    const int K = g.K, nt = K / BK, lda = g.lda ? g.lda : K, ldb = g.ldb ? g.ldb : K;
    unsigned voffA[2], voffB[2];
#pragma unroll
    for (int i = 0; i < 2; ++i) { int R, C; stage_rc(tid * 16 + i * 8192, R, C); const int Rb = Epi::PERM ? ((R & ~31) + perm32(R & 31)) : R;
        voffA[i] = (unsigned)(R * lda + C) * 2u; voffB[i] = (unsigned)(Rb * ldb + C) * 2u; }
    const size_t kstep = (size_t)(BK * 2);
    const size_t hstepA = (size_t)HALF * lda * 2, hstepB = (size_t)HALF * ldb * 2;
    const size_t hstep_unused = (size_t)HALF * K * 2;
    const size_t tstepA = 2 * hstepA, tstepB = 2 * hstepB;
    const unsigned ldsw = (unsigned)wid * 1024u;
    const int aoff = lds_byte(wr * 64 + fr, fq * 8), boff = lds_byte(wc * 32 + fr, fq * 8);
#define PG8_SA(b, h) (((b) * 2 + (h)) * HTB)
#define PG8_SB(b, h) ((4 + (b) * 2 + (h)) * HTB)
#define PG8_STAGE(bufoff, gbase, voff) do { _Pragma("unroll") for (int _i = 0; _i < 2; ++_i) \
        __builtin_amdgcn_global_load_lds((const unsigned*)((const char*)(gbase) + (voff)[_i]), (PG8_LAS unsigned*)(lds + (bufoff) + ldsw + _i * 8192), 16, 0, 0); } while (0)
#define PG8_LDA(dst, b, h) do { _Pragma("unroll") for (int m = 0; m < 4; ++m) _Pragma("unroll") for (int k = 0; k < 2; ++k) dst[m][k] = *(const PG8_LAS bf16x8*)(lds + PG8_SA(b, h) + aoff + m * 2048 + k * 1024); } while (0)
#define PG8_LDB(dst, b, h) do { _Pragma("unroll") for (int n = 0; n < 2; ++n) _Pragma("unroll") for (int k = 0; k < 2; ++k) dst[n][k] = *(const PG8_LAS bf16x8*)(lds + PG8_SB(b, h) + boff + n * 2048 + k * 1024); } while (0)
#define PG8_MMA(ai, bj, At, Bt) do { __builtin_amdgcn_s_setprio(1); _Pragma("unroll") for (int m = 0; m < 4; ++m) _Pragma("unroll") for (int n = 0; n < 2; ++n) _Pragma("unroll") for (int k = 0; k < 2; ++k) \
        acc[ai][bj][m][n] = __builtin_amdgcn_mfma_f32_16x16x32_bf16(Bt[n][k], At[m][k], acc[ai][bj][m][n], 0, 0, 0); __builtin_amdgcn_s_setprio(0); } while (0)
#define PG8_WAIT_V(n) asm volatile("s_waitcnt vmcnt(" #n ")" ::: "memory")
#define PG8_WAIT_L(n) asm volatile("s_waitcnt lgkmcnt(" #n ")" ::: "memory")
#define PG8_BAR __builtin_amdgcn_s_barrier()
#define PG8_SCHED __builtin_amdgcn_sched_barrier(0)
    Unit cur, nxt; int ui = 0;
    if (!S.next(0, cur)) return;
    f32x4 acc[2][2][4][2];
#pragma unroll
    for (int a = 0; a < 2; ++a)
#pragma unroll
        for (int b = 0; b < 2; ++b)
#pragma unroll
            for (int m = 0; m < 4; ++m)
#pragma unroll
                for (int n = 0; n < 2; ++n) acc[a][b][m][n] = (f32x4){0.f, 0.f, 0.f, 0.f};
    bf16x8 At[4][2], B0[2][2], B1[2][2];
    const char* cA = (const char*)g.A + (size_t)cur.pm * tstepA + (KSPLIT ? (size_t)(cur.pn >> 16) * K * 2 : 0); const char* cB = (const char*)g.Bt + (size_t)(KSPLIT ? (cur.pn & 0xffff) : cur.pn) * tstepB + (KSPLIT ? (size_t)(cur.pn >> 16) * K * 2 : 0);
    S.a_ready(cur);
    if constexpr (SP2) {
        PG8_STAGE(PG8_SB(0, 0), cB, voffB); PG8_STAGE(PG8_SB(0, 1), cB + hstepB, voffB); PG8_STAGE(PG8_SA(0, 0), cA, voffA); PG8_STAGE(PG8_SA(0, 1), cA + hstepA, voffA);
        if (wr == 1) PG8_BAR;
        PG8_WAIT_V(2); PG8_BAR;
        PG8_STAGE(PG8_SB(1, 0), cB + kstep, voffB); PG8_STAGE(PG8_SA(1, 0), cA + kstep, voffA); PG8_STAGE(PG8_SB(1, 1), cB + hstepB + kstep, voffB);
        PG8_WAIT_V(6); PG8_BAR;
    } else {
        PG8_STAGE(PG8_SB(0, 0), cB, voffB); PG8_STAGE(PG8_SA(0, 0), cA, voffA); PG8_STAGE(PG8_SB(0, 1), cB + hstepB, voffB); PG8_STAGE(PG8_SA(0, 1), cA + hstepA, voffA);
        if (wr == 1) PG8_BAR;
        PG8_WAIT_V(4); PG8_BAR;
        PG8_STAGE(PG8_SB(1, 0), cB + kstep, voffB); PG8_STAGE(PG8_SA(1, 0), cA + kstep, voffA); PG8_STAGE(PG8_SB(1, 1), cB + hstepB + kstep, voffB);
        PG8_WAIT_V(6); PG8_BAR;
    }
    for (;;) {
        const bool has_next = S.next(ui + 1, nxt);
        const char* nA = has_next ? (const char*)g.A + (size_t)nxt.pm * tstepA + (KSPLIT ? (size_t)(nxt.pn >> 16) * K * 2 : 0) : cA; const char* nB = has_next ? (const char*)g.Bt + (size_t)(KSPLIT ? (nxt.pn & 0xffff) : nxt.pn) * tstepB + (KSPLIT ? (size_t)(nxt.pn >> 16) * K * 2 : 0) : cB;
        for (int t = 0; t < nt; t += 2) {
            const bool last = (t == nt - 2);
            const char* a1 = cA + (size_t)(t + 1) * kstep;
            const char* a2 = last ? nA : cA + (size_t)(t + 2) * kstep; const char* b2 = last ? nB : cB + (size_t)(t + 2) * kstep;
            const char* a3 = a2 + kstep; const char* b3 = b2 + kstep;
            if (last && has_next) S.a_ready(nxt);
            if constexpr (SP2) {
            PG8_LDB(B0, 0, 0); PG8_LDB(B1, 0, 1); PG8_SCHED; PG8_LDA(At, 0, 0); PG8_STAGE(PG8_SA(1, 1), a1 + hstepA, voffA);
            PG8_WAIT_V(8); PG8_WAIT_L(0); PG8_BAR; PG8_MMA(0, 0, At, B0); PG8_MMA(0, 1, At, B1); PG8_BAR; PG8_SCHED;
            PG8_LDA(At, 0, 1); PG8_STAGE(PG8_SB(0, 0), b2, voffB); PG8_STAGE(PG8_SB(0, 1), b2 + hstepB, voffB); PG8_STAGE(PG8_SA(0, 0), a2, voffA);
            PG8_WAIT_V(8); PG8_WAIT_L(0); PG8_BAR; PG8_MMA(1, 0, At, B0); PG8_MMA(1, 1, At, B1); PG8_BAR; PG8_SCHED;
            PG8_LDB(B0, 1, 0); PG8_LDB(B1, 1, 1); PG8_SCHED; PG8_LDA(At, 1, 0); PG8_STAGE(PG8_SA(0, 1), a2 + hstepA, voffA);
            PG8_WAIT_V(8); PG8_WAIT_L(0); PG8_BAR; PG8_MMA(0, 0, At, B0); PG8_MMA(0, 1, At, B1); PG8_BAR; PG8_SCHED;
            PG8_LDA(At, 1, 1); PG8_STAGE(PG8_SB(1, 0), b3, voffB); PG8_STAGE(PG8_SB(1, 1), b3 + hstepB, voffB); PG8_STAGE(PG8_SA(1, 0), a3, voffA);
            PG8_WAIT_V(8); PG8_WAIT_L(0); PG8_BAR; PG8_MMA(1, 0, At, B0); PG8_MMA(1, 1, At, B1); PG8_BAR; PG8_SCHED;
            } else {
            PG8_LDB(B0, 0, 0); PG8_SCHED; PG8_LDA(At, 0, 0); PG8_STAGE(PG8_SA(1, 1), a1 + hstepA, voffA);
            PG8_WAIT_L(8); PG8_BAR; PG8_WAIT_L(0); PG8_MMA(0, 0, At, B0); PG8_BAR; PG8_SCHED;
            PG8_LDB(B1, 0, 1); PG8_STAGE(PG8_SB(0, 0), b2, voffB);
            PG8_BAR; PG8_WAIT_L(0); PG8_MMA(0, 1, At, B1); PG8_BAR;
            PG8_LDA(At, 0, 1); PG8_STAGE(PG8_SA(0, 0), a2, voffA);
            PG8_BAR; PG8_WAIT_L(0); PG8_MMA(1, 0, At, B0); PG8_BAR; PG8_SCHED;
            PG8_STAGE(PG8_SB(0, 1), b2 + hstepB, voffB);
            PG8_WAIT_V(6); PG8_BAR; PG8_MMA(1, 1, At, B1); PG8_BAR;
            PG8_LDB(B0, 1, 0); PG8_SCHED; PG8_LDA(At, 1, 0); PG8_STAGE(PG8_SA(0, 1), a2 + hstepA, voffA);
            PG8_WAIT_L(8); PG8_BAR; PG8_WAIT_L(0); PG8_MMA(0, 0, At, B0); PG8_BAR; PG8_SCHED;
            PG8_LDB(B1, 1, 1); PG8_STAGE(PG8_SB(1, 0), b3, voffB);
            PG8_BAR; PG8_WAIT_L(0); PG8_MMA(0, 1, At, B1); PG8_BAR;
            PG8_LDA(At, 1, 1); PG8_STAGE(PG8_SA(1, 0), a3, voffA);
            PG8_BAR; PG8_WAIT_L(0); PG8_MMA(1, 0, At, B0); PG8_BAR; PG8_SCHED;
            PG8_STAGE(PG8_SB(1, 1), b3 + hstepB, voffB);
            PG8_WAIT_V(6); PG8_BAR; PG8_MMA(1, 1, At, B1); PG8_BAR;
            }
        }
        if constexpr (ALIGN_EPI) { if (wr == 0) PG8_BAR; }
        if constexpr (!Epi::AFTER_DRAIN) { E(acc, cur, wr, wc, fr, fq); S.done(cur); }
        if (!has_next) break;
#pragma unroll
        for (int a = 0; a < 2; ++a)
#pragma unroll
            for (int b = 0; b < 2; ++b)
#pragma unroll
                for (int m = 0; m < 4; ++m)
#pragma unroll
                    for (int n = 0; n < 2; ++n) acc[a][b][m][n] = (f32x4){0.f, 0.f, 0.f, 0.f};
        cur = nxt; cA = nA; cB = nB; ++ui;
        if constexpr (ALIGN_EPI) { if (wr == 1) PG8_BAR; }
    }
    PG8_WAIT_V(0);
    if constexpr (!ALIGN_EPI) { if (wr == 0) PG8_BAR; }
    PG8_BAR;
    if constexpr (Epi::AFTER_DRAIN) { E.fused(acc, cur, wr, wc, fr, fq, lds, wid, lane); S.done(cur); }
#undef PG8_SA
#undef PG8_SB
#undef PG8_STAGE
#undef PG8_LDA
#undef PG8_LDB
#undef PG8_MMA
#undef PG8_WAIT_V
#undef PG8_WAIT_L
#undef PG8_BAR
#undef PG8_SCHED
}
}

#define LAS __attribute__((address_space(3)))
#define XB_TMO      128
#define XB_XCNT(j)  (256  + 64 * (j))
#define XB_XSUB(j)  (1280 + 64 * (j))
#define XB_XGEN(j)  (2304 + 64 * (j))
#define XB_TOP      3328
#define XB_TOPGEN   3392
#define XCD_BAR_WORDS 3456
#define XB_SPIN_CAP (1u << 22)

__device__ __forceinline__ unsigned xb_ld(unsigned* p)              { return __hip_atomic_load(p, __ATOMIC_RELAXED, __HIP_MEMORY_SCOPE_AGENT); }
__device__ __forceinline__ unsigned xb_add(unsigned* p, unsigned v) { return __hip_atomic_fetch_add(p, v, __ATOMIC_RELAXED, __HIP_MEMORY_SCOPE_AGENT); }
__device__ __forceinline__ unsigned xb_xcc_id() { return (unsigned)__builtin_amdgcn_s_getreg((3 << 11) | 20) & 0xFu; }
#define XB_SPIN(cond, bar) do { unsigned _sp = 0; while (cond) { __builtin_amdgcn_s_sleep(1); \
    if ((++_sp & 255u) == 0u) { if (xb_ld(&(bar)[XB_TMO])) break; if (_sp > XB_SPIN_CAP) { atomicAdd(&(bar)[XB_TMO], 1u); break; } } } } while (0)

struct XcdBarrier {
    unsigned* bar; unsigned x;
    volatile LAS unsigned* st;
};

__device__ __forceinline__ XcdBarrier xcd_barrier_post(unsigned* bar, volatile LAS unsigned* st) {
    XcdBarrier b; b.bar = bar; b.x = xb_xcc_id(); b.st = st;
    if (threadIdx.x == 0) (void)xb_add(&bar[XB_XCNT(b.x)], 1u);
    return b;
}
__device__ __forceinline__ void xcd_barrier_complete(unsigned* bar, unsigned x, unsigned& nloc, unsigned& nx) {
    const unsigned G = gridDim.x * gridDim.y * gridDim.z;
    unsigned sum, cnt, mine, sp = 0u;
    for (;;) {
        sum = 0u; cnt = 0u; mine = 0u;
#pragma unroll
        for (unsigned j = 0; j < 16; ++j) { const unsigned c = xb_ld(&bar[XB_XCNT(j)]); sum += c; cnt += (c > 0u) ? 1u : 0u; mine = (j == x) ? c : mine; }
        if (sum == G) break;
        __builtin_amdgcn_s_sleep(1);
        if ((++sp & 255u) == 0u) { if (xb_ld(&bar[XB_TMO])) break; if (sp > XB_SPIN_CAP) { atomicAdd(&bar[XB_TMO], 1u); break; } }
    }
    nloc = mine > 0u ? mine : 1u; nx = cnt > 0u ? cnt : 1u;
}

__device__ __forceinline__ void xcd_barrier(const XcdBarrier& b, int tid_x  ) {
    asm volatile("s_waitcnt vmcnt(0)" ::: "memory");
    __syncthreads();
    if (tid_x == 0) {
        unsigned* bar = b.bar; asm volatile("" : "+s"(bar));
        unsigned xx = b.x; asm volatile("" : "+s"(xx));
        __builtin_amdgcn_s_waitcnt(0);
        unsigned nloc = b.st[0], nx = b.st[1];
        if (nloc == 0u) { xcd_barrier_complete(bar, xx, nloc, nx); b.st[0] = nloc; b.st[1] = nx; }
        const unsigned old = xb_add(&bar[XB_XSUB(xx)], 1u);
        const unsigned gen = old / nloc;
        if (old + 1u == (gen + 1u) * nloc) {
            __builtin_amdgcn_fence(__ATOMIC_RELEASE, "agent");
            asm volatile("s_waitcnt vmcnt(0)" ::: "memory");
            const unsigned og = xb_add(&bar[XB_TOP], 1u);
            const unsigned tg = og / nx;
            if (og + 1u == (tg + 1u) * nx) xb_add(&bar[XB_TOPGEN], 1u);
            else XB_SPIN(xb_ld(&bar[XB_TOPGEN]) == tg, bar);
            __builtin_amdgcn_fence(__ATOMIC_ACQUIRE, "agent");
            xb_add(&bar[XB_XGEN(xx)], 1u);
            asm volatile("s_waitcnt vmcnt(0)" ::: "memory");
        } else {
            XB_SPIN(xb_ld(&bar[XB_XGEN(xx)]) == gen, bar);
            __builtin_amdgcn_fence(__ATOMIC_ACQUIRE, "agent");
            asm volatile("s_waitcnt vmcnt(0)" ::: "memory");
        }
    }
    __syncthreads();
}
#define GAS __attribute__((address_space(1)))
typedef unsigned v4u __attribute__((ext_vector_type(4)));
#ifdef PROBE_TK
#define TKQ(i) do { if (layer == PROBE_LAYER && blockIdx.x == PROBE_BLK && threadIdx.x == 0) ((unsigned long long*)(p.ws + WS_CTL + 4 * CW_TK))[(i)] = __builtin_amdgcn_s_memrealtime(); } while (0)
#else
#define TKQ(i) do { } while (0)
#endif
typedef unsigned v2u __attribute__((ext_vector_type(2)));
typedef GAS unsigned gu32;
#define RLX_AGENT __ATOMIC_RELAXED, __HIP_MEMORY_SCOPE_AGENT
#define LDS_WAIT() asm volatile("s_waitcnt lgkmcnt(0)" ::: "memory")
#define VM_WAIT() asm volatile("s_waitcnt vmcnt(0)" ::: "memory")
using pg8::f32x4; using pg8::Unit; using pg8::Gemm; using pg8::BM; using pg8::HALF; using pg8::cvt_pk_bf16; using pg8::u32x4;

constexpr int NWAVES = 8, NTHREADS = 512;
constexpr int RING_BYTES = 131072, LDSCTL_OFF = 147456 - 1024, MISC_OFF = LDSCTL_OFF + 320, LDS_BYTES = 147456;

__device__ __forceinline__ float wave_sum(float v, int lane) {
#pragma unroll
    for (int o = 1; o < 64; o <<= 1) v += __builtin_bit_cast(float, __builtin_amdgcn_ds_bpermute((lane ^ o) << 2, __builtin_bit_cast(int, v)));
    return v;
}
__device__ __forceinline__ float fsig(float x) { return __builtin_amdgcn_rcpf(1.f + __expf(-x)); }

__device__ __forceinline__ int lane_id_opaque() { int l; asm volatile("v_mbcnt_lo_u32_b32 %0, -1, 0\n\tv_mbcnt_hi_u32_b32 %0, -1, %0" : "=v"(l)); return l; }
__device__ __forceinline__ int rfl(int v) { return __builtin_amdgcn_readfirstlane(v); }
struct SOrder {
    pg8::StaticOrder s;
    __device__ void init(int M, int N, int G, int c) { s.init(M, N, G, c); }
    __device__ bool next(int i, Unit& u) const { Unit t; t.pm = 0; t.pn = 0; const bool ok = s.next(i, t); u.pm = rfl(t.pm); u.pn = rfl(t.pn); return ok; }
    __device__ __forceinline__ void a_ready(const Unit&) const {}
    __device__ __forceinline__ void done(const Unit&) const {}
};
struct StackOrder {
    pg8::StaticOrder s; int nM, nN;
    __device__ StackOrder(int nM_, int nN_, int nb, int G, int c) : nM(nM_), nN(nN_) { s.init(nb * nM_ * 256, nN_ * 256, G, c); }
    __device__ bool next(int i, Unit& u) const { Unit t; t.pm = 0; t.pn = 0; if (!s.next(i, t)) return false; u.pm = rfl(t.pm); u.pn = rfl((t.pm / nM) * nN + t.pn); return true; }
    __device__ __forceinline__ void a_ready(const Unit&) const {}
    __device__ __forceinline__ void done(const Unit&) const {}
};
struct GateOrder {
    pg8::StaticOrder s; int nN;
    __device__ GateOrder(int nM_, int nN_, int G, int c) : nN(nN_) { s.init(nM_ * 256, nN_ * 256, G, c); }
    __device__ bool next(int i, Unit& u) const { const int j = i / 3, br = i - 3 * j; Unit t; t.pm = 0; t.pn = 0; if (!s.next(j, t)) return false; u.pm = rfl(t.pm); u.pn = rfl(br * nN + t.pn); return true; }
    __device__ __forceinline__ void a_ready(const Unit&) const {}
    __device__ __forceinline__ void done(const Unit&) const {}
};
struct MoeOrder {
    pg8::StaticOrder s; int nN, e0, e1, e2, e3, e4, e5, e6, e7;
    __device__ void init(const unsigned* cnt  , int nN_, int G_, int c_) { nN = nN_;
        int t = 0; t += (cnt[0] + 255) >> 8; e0 = t; t += (cnt[64] + 255) >> 8; e1 = t; t += (cnt[128] + 255) >> 8; e2 = t; t += (cnt[192] + 255) >> 8; e3 = t;
        t += (cnt[256] + 255) >> 8; e4 = t; t += (cnt[320] + 255) >> 8; e5 = t; t += (cnt[384] + 255) >> 8; e6 = t; t += (cnt[448] + 255) >> 8; e7 = t;
        s.init(e7 * 256, nN_ * 256, G_, c_); }
    __device__ bool next(int i, Unit& u) const { Unit t; t.pm = 0; t.pn = 0; if (!s.next(i, t)) return false;
        const int pm = t.pm, e = (pm >= e0) + (pm >= e1) + (pm >= e2) + (pm >= e3) + (pm >= e4) + (pm >= e5) + (pm >= e6);
        u.pm = rfl(pm); u.pn = rfl(e * nN + t.pn); return true; }
    __device__ __forceinline__ void a_ready(const Unit&) const {}
    __device__ __forceinline__ void done(const Unit&) const {}
};

__device__ __forceinline__ u32x4 pack8(f32x4 v0, f32x4 v1) { u32x4 w; w.x = cvt_pk_bf16(v0[0], v0[1]); w.y = cvt_pk_bf16(v0[2], v0[3]); w.z = cvt_pk_bf16(v1[0], v1[1]); w.w = cvt_pk_bf16(v1[2], v1[3]); return w; }
__device__ __forceinline__ void unpack8(u32x4 w, f32x4& v0, f32x4& v1) {
    v0 = (f32x4){blo(w.x), bhi(w.x), blo(w.y), bhi(w.y)}; v1 = (f32x4){blo(w.z), bhi(w.z), blo(w.w), bhi(w.w)}; }

struct EpiProj {
    static constexpr bool PERM = true, AFTER_DRAIN = false;
    unsigned char* ws;
    __device__ __forceinline__ void operator()(const f32x4 (&acc)[2][2][4][2], const Unit& u, int wr, int wc, int fr, int fq) const {
        bf16* const QB = (bf16*)(ws + AR_QB); bf16* const KV = (bf16*)(ws + AR_KV); bf16* const UB = (bf16*)(ws + AR_UB); bf16* const RW = (bf16*)(ws + AR_RW); bf16* const HALO = (bf16*)(ws + AR_HALO); bf16* const CKV = (bf16*)(ws + AR_CKV);
        const int row0 = u.pm * BM + wr * 64 + fr, cl = wc * 32 + 8 * fq;
        if (u.pn >= 5 && u.pn < 9) {
#pragma unroll
            for (int ai = 0; ai < 2; ++ai)
#pragma unroll
                for (int m = 0; m < 4; ++m) { f32x4 a0 = acc[ai][0][m][0], a1 = acc[ai][0][m][1]; const f32x4 b0 = acc[ai][1][m][0], b1 = acc[ai][1][m][1];
#pragma unroll
                    for (int k = 0; k < 4; ++k) { a0[k] *= fsig(b0[k]); a1[k] *= fsig(b1[k]); }
                    *(u32x4*)(UB + (size_t)(row0 + ai * HALF + m * 16) * 512 + (u.pn - 5) * 128 + cl) = pack8(a0, a1); }
            return;
        }
        if (u.pn == 2) {
#pragma unroll
            for (int ai = 0; ai < 2; ++ai)
#pragma unroll
                for (int m = 0; m < 4; ++m) { const int row = row0 + ai * HALF + m * 16, b = row / SEQ, tt = row % SEQ;
#pragma unroll
                    for (int bj = 0; bj < 2; ++bj) *(u32x4*)(CKV + (((size_t)bj * (BATCH * NKV) + b * NKV + (cl >> 6)) * SEQ + tt) * 64 + (cl & 63)) = pack8(acc[ai][bj][m][0], acc[ai][bj][m][1]); }
            return;
        }
        bf16* base; int ld, c0;
        if (u.pn < 2) { base = QB; ld = LDQ; c0 = u.pn * 256; } else if (u.pn < 5) { base = KV; ld = LDKV; c0 = (u.pn - 3) * 256; } else { base = RW; ld = LDRW; c0 = (u.pn - 9) * 256; }
#pragma unroll
        for (int ai = 0; ai < 2; ++ai)
#pragma unroll
            for (int m = 0; m < 4; ++m)
#pragma unroll
                for (int bj = 0; bj < 2; ++bj) { const u32x4 w = pack8(acc[ai][bj][m][0], acc[ai][bj][m][1]);
                    *(u32x4*)(base + (size_t)(row0 + ai * HALF + m * 16) * ld + c0 + bj * HALF + cl) = w;
                    if (u.pn >= 9 && ai == 1 && m == 3 && wr == 1 && fr == 15) *(u32x4*)(HALO + (size_t)u.pm * LDRW + c0 + bj * HALF + cl) = w; }
    }
};
struct EpiStore {
    static constexpr bool PERM = true, AFTER_DRAIN = false;
    bf16* O; int ld, ntn;
    __device__ __forceinline__ void operator()(const f32x4 (&acc)[2][2][4][2], const Unit& u, int wr, int wc, int fr, int fq) const {
        const int row0 = u.pm * BM + wr * 64 + fr, c0 = (u.pn % ntn) * 256 + wc * 32 + 8 * fq;
#pragma unroll
        for (int ai = 0; ai < 2; ++ai)
#pragma unroll
            for (int m = 0; m < 4; ++m)
#pragma unroll
                for (int bj = 0; bj < 2; ++bj) *(u32x4*)(O + (size_t)(row0 + ai * HALF + m * 16) * ld + c0 + bj * HALF) = pack8(acc[ai][bj][m][0], acc[ai][bj][m][1]);
    }
};
struct EpiGate {
    static constexpr bool PERM = true, AFTER_DRAIN = false;
    unsigned char* ws; int ntn;
    __device__ __forceinline__ void operator()(const f32x4 (&acc)[2][2][4][2], const Unit& u, int wr, int wc, int fr, int fq) const {
        const bf16* const OB = (const bf16*)(ws + AR_OBUF); bf16* const MIX = (bf16*)(ws + AR_MIX);
        const int br = u.pn / ntn, row0 = u.pm * BM + wr * 64 + fr, c0 = (u.pn % ntn) * 256 + wc * 32 + 8 * fq;
        const bf16* ob = OB + (size_t)br * T * DM;
#pragma unroll
        for (int ai = 0; ai < 2; ++ai) {
            u32x4 o[4][2], mx[4][2];
#pragma unroll
            for (int m = 0; m < 4; ++m)
#pragma unroll
                for (int bj = 0; bj < 2; ++bj) { const size_t off = (size_t)(row0 + ai * HALF + m * 16) * DM + c0 + bj * HALF; o[m][bj] = *(const u32x4*)(ob + off); if (br != 0) mx[m][bj] = *(const u32x4*)(MIX + off); }
#pragma unroll
            for (int m = 0; m < 4; ++m)
#pragma unroll
                for (int bj = 0; bj < 2; ++bj) { const size_t off = (size_t)(row0 + ai * HALF + m * 16) * DM + c0 + bj * HALF;
                    f32x4 o0, o1; unpack8(o[m][bj], o0, o1);
                    f32x4 g0 = acc[ai][bj][m][0], g1 = acc[ai][bj][m][1];
#pragma unroll
                    for (int k = 0; k < 4; ++k) { g0[k] = fsig(g0[k]) * o0[k]; g1[k] = fsig(g1[k]) * o1[k]; }
                    if (br != 0) { f32x4 p0, p1; unpack8(mx[m][bj], p0, p1); g0 += p0; g1 += p1; }
                    *(u32x4*)(MIX + off) = pack8(g0, g1); }
        }
    }
};
struct EpiResid {
    static constexpr bool PERM = true, AFTER_DRAIN = false;
    const float* base; float* out;
    __device__ __forceinline__ void operator()(const f32x4 (&acc)[2][2][4][2], const Unit& u, int wr, int wc, int fr, int fq) const {
        const int row0 = u.pm * BM + wr * 64 + fr, c0 = u.pn * 256 + wc * 32 + 8 * fq;
#pragma unroll
        for (int ai = 0; ai < 2; ++ai)
#pragma unroll
            for (int mh = 0; mh < 2; ++mh) {
                f32x4 x[2][2][2];
#pragma unroll
                for (int mm = 0; mm < 2; ++mm)
#pragma unroll
                    for (int bj = 0; bj < 2; ++bj) { const size_t off = (size_t)(row0 + ai * HALF + (2 * mh + mm) * 16) * DM + c0 + bj * HALF; x[mm][bj][0] = *(const f32x4*)(base + off); x[mm][bj][1] = *(const f32x4*)(base + off + 4); }
#pragma unroll
                for (int mm = 0; mm < 2; ++mm)
#pragma unroll
                    for (int bj = 0; bj < 2; ++bj) { const int m = 2 * mh + mm; const size_t off = (size_t)(row0 + ai * HALF + m * 16) * DM + c0 + bj * HALF;
                        *(f32x4*)(out + off) = x[mm][bj][0] + acc[ai][bj][m][0]; *(f32x4*)(out + off + 4) = x[mm][bj][1] + acc[ai][bj][m][1]; }
            }
    }
};
struct EpiSwiglu {
    static constexpr bool PERM = true, AFTER_DRAIN = false;
    bf16* ACT; int ld, ntn;
    __device__ __forceinline__ void operator()(const f32x4 (&acc)[2][2][4][2], const Unit& u, int wr, int wc, int fr, int fq) const {
        const int row0 = u.pm * BM + wr * 64 + fr, c0 = (u.pn % ntn) * 128 + wc * 32 + 8 * fq;
#pragma unroll
        for (int ai = 0; ai < 2; ++ai)
#pragma unroll
            for (int m = 0; m < 4; ++m) { f32x4 g0 = acc[ai][0][m][0], g1 = acc[ai][0][m][1]; const f32x4 u0 = acc[ai][1][m][0], u1 = acc[ai][1][m][1];
#pragma unroll
                for (int k = 0; k < 4; ++k) { g0[k] = g0[k] * fsig(g0[k]) * u0[k]; g1[k] = g1[k] * fsig(g1[k]) * u1[k]; }
                *(u32x4*)(ACT + (size_t)(row0 + ai * HALF + m * 16) * ld + c0) = pack8(g0, g1); }
    }
};
struct EpiMoeDown {
    static constexpr bool PERM = true, AFTER_DRAIN = false;
    float* out; const int* rtok; const float* rw; int ntn; float sc;
    __device__ __forceinline__ void operator()(const f32x4 (&acc)[2][2][4][2], const Unit& u, int wr, int wc, int fr, int fq) const {
        const int row0 = u.pm * BM + wr * 64 + fr, c0 = (u.pn % ntn) * 256 + wc * 32 + 8 * fq;
#pragma unroll
        for (int ai = 0; ai < 2; ++ai)
#pragma unroll
            for (int mh = 0; mh < 2; ++mh) {
                int tok[2]; float w[2]; f32x4 x[2][2][2];
#pragma unroll
                for (int mm = 0; mm < 2; ++mm) { const int row = row0 + ai * HALF + (2 * mh + mm) * 16; tok[mm] = rtok[row]; w[mm] = rw[row] * sc; }
#pragma unroll
                for (int mm = 0; mm < 2; ++mm)
#pragma unroll
                    for (int bj = 0; bj < 2; ++bj) { const float* o = out + (size_t)(tok[mm] >= 0 ? tok[mm] : 0) * DM + c0 + bj * HALF; x[mm][bj][0] = *(const f32x4*)o; x[mm][bj][1] = *(const f32x4*)(o + 4); }
#pragma unroll
                for (int mm = 0; mm < 2; ++mm)
#pragma unroll
                    for (int bj = 0; bj < 2; ++bj) if (tok[mm] >= 0) { const int m = 2 * mh + mm; float* o = out + (size_t)tok[mm] * DM + c0 + bj * HALF;
                        *(f32x4*)o = x[mm][bj][0] + acc[ai][bj][m][0] * w[mm]; *(f32x4*)(o + 4) = x[mm][bj][1] + acc[ai][bj][m][1] * w[mm]; }
            }
    }
};

constexpr int MT_KS = 7, MT_K = EXPERT_FF / MT_KS;
struct MoeTailOrder {
    int nN, pm0, nsub, G, c, e0, e1, e2, e3, e4, e5, e6;
    __device__ void init(const MoeOrder& m, int pm0_, int ntiles, int G_, int c_) { nN = m.nN; pm0 = pm0_; nsub = ntiles * MT_KS; G = G_; c = c_; e0 = m.e0; e1 = m.e1; e2 = m.e2; e3 = m.e3; e4 = m.e4; e5 = m.e5; e6 = m.e6; }
    __device__ bool next(int i, Unit& u) const { const int L = i * G + c; if (L >= nsub) return false;
        const int j = L / MT_KS, ks = L - j * MT_KS, pm = pm0 + j / nN, pl = j % nN, e = (pm >= e0) + (pm >= e1) + (pm >= e2) + (pm >= e3) + (pm >= e4) + (pm >= e5) + (pm >= e6);
        u.pm = rfl(pm); u.pn = rfl((e * nN + pl) | (ks << 16)); return true; }
    __device__ __forceinline__ void a_ready(const Unit&) const {}
    __device__ __forceinline__ void done(const Unit&) const {}
};
struct EpiPart {
    static constexpr bool PERM = true, AFTER_DRAIN = false;
    float* part; int pm0, nN;
    __device__ __forceinline__ void operator()(const f32x4 (&acc)[2][2][4][2], const Unit& u, int wr, int wc, int fr, int fq) const {
        const int slot = ((u.pm - pm0) * nN + (u.pn & 0xffff) % nN) * MT_KS + (u.pn >> 16);
        float* b = part + (size_t)slot * 65536 + (size_t)(((wr * 4 + wc) * 64 + fq * 16 + fr) * 4);
#pragma unroll
        for (int ai = 0; ai < 2; ++ai)
#pragma unroll
            for (int bj = 0; bj < 2; ++bj)
#pragma unroll
                for (int m = 0; m < 4; ++m)
#pragma unroll
                    for (int n = 0; n < 2; ++n) *(f32x4*)(b + (((ai * 2 + bj) * 4 + m) * 2 + n) * 2048) = acc[ai][bj][m][n];
    }
};
__device__ __forceinline__ void moe_tail_combine(const EpiMoeDown& E, const MoeOrder& mo, const float* part, int pm0, int job, int lane_in) {
    int lane = lane_in; asm volatile("" : "+v"(lane));
    const int q = job & 3, role = (job >> 2) & 7, j = job >> 5, ai = q >> 1, mh = q & 1, pm = pm0 + j / mo.nN, pl = j % mo.nN, wr = role >> 2, wc = role & 3, fr = lane & 15, fq = lane >> 4;
    const float* b = part + (size_t)j * MT_KS * 65536 + (size_t)((role * 64 + lane) * 4);
    f32x4 a[2][2][2];
#pragma unroll
    for (int mm = 0; mm < 2; ++mm)
#pragma unroll
        for (int bj = 0; bj < 2; ++bj)
#pragma unroll
            for (int n = 0; n < 2; ++n) a[mm][bj][n] = *(const f32x4*)(b + (((ai * 2 + bj) * 4 + 2 * mh + mm) * 2 + n) * 2048);
#pragma unroll
    for (int ks = 1; ks < MT_KS; ++ks)
#pragma unroll
        for (int mm = 0; mm < 2; ++mm)
#pragma unroll
            for (int bj = 0; bj < 2; ++bj)
#pragma unroll
                for (int n = 0; n < 2; ++n) a[mm][bj][n] += *(const f32x4*)(b + (size_t)ks * 65536 + (((ai * 2 + bj) * 4 + 2 * mh + mm) * 2 + n) * 2048);
    const int row0 = pm * BM + wr * 64 + fr + ai * HALF + 2 * mh * 16, c0 = pl * 256 + wc * 32 + 8 * fq;
#pragma unroll
    for (int mm = 0; mm < 2; ++mm) { const int tok = E.rtok[row0 + mm * 16]; const float w = E.rw[row0 + mm * 16] * E.sc;
        if (tok >= 0) {
#pragma unroll
            for (int bj = 0; bj < 2; ++bj) { float* o = E.out + (size_t)tok * DM + c0 + bj * HALF; const f32x4 x0 = *(const f32x4*)o, x1 = *(const f32x4*)(o + 4);
                *(f32x4*)o = x0 + a[mm][bj][0] * w; *(f32x4*)(o + 4) = x1 + a[mm][bj][1] * w; } } }
}

typedef short bf16x8_t __attribute__((ext_vector_type(8)));
#define MFMA16(a, b, c) __builtin_amdgcn_mfma_f32_16x16x32_bf16((a), (b), (c), 0, 0, 0)
constexpr float ATT_C = 0.125f * 1.4426950408889634f;
constexpr int AW_IMP = 0, AW_SEL = 8448, AW_QS = 8960, AW_ENT = 8960 + 8192, AW_BYTES = 8960 + 8192 + 320;
__device__ __forceinline__ float bperm_f(float v, int srclane) { return __builtin_bit_cast(float, __builtin_amdgcn_ds_bpermute(srclane << 2, __builtin_bit_cast(int, v))); }
__device__ __forceinline__ int bperm_i(int v, int srclane) { return __builtin_amdgcn_ds_bpermute(srclane << 2, v); }
__device__ __forceinline__ bf16x8_t ldg8(const bf16* p) { return *(const bf16x8_t*)p; }
__device__ __forceinline__ bf16x8_t pack_p(const f32x4& a, const f32x4& b) {
    v4u w; w.x = cvt_pk_bf16(a[0], a[1]); w.y = cvt_pk_bf16(a[2], a[3]); w.z = cvt_pk_bf16(b[0], b[1]); w.w = cvt_pk_bf16(b[2], b[3]); return __builtin_bit_cast(bf16x8_t, w); }

__device__ __forceinline__ void nsa_attn_item(const P& p, int item, int lane, LAS unsigned char* wl) {
    const bf16* KV = WSP(bf16, AR_KV); const bf16* KC = WSP(bf16, AR_KC); const bf16* VcT = WSP(bf16, AR_VCT); const bf16* VsT = WSP(bf16, WS_VST); const bf16* VwT = WSP(bf16, WS_VWT);
    bf16* QB = WSP(bf16, AR_QB); const float* NG = WSP(float, AR_NG);
    const int bg = item / (SEQ / 16), t0 = (item % (SEQ / 16)) * 16, b = bg >> 1, g = bg & 1;
    const int col = lane & 15, fq = lane >> 4, tok = t0 + col;
    const size_t grow = (size_t)b * SEQ + tok;
    LAS float* IMP = (LAS float*)(wl + AW_IMP); LAS int* SEL = (LAS int*)(wl + AW_SEL); LAS bf16* OS = (LAS bf16*)(wl + AW_IMP);
    const int krowA = 8 * (col >> 2) + (col & 3);
    const float* gate = NG + grow * 24 + g * 12;
    LAS bf16x8_t* QS = (LAS bf16x8_t*)(wl + AW_QS) + lane;
#pragma unroll
    for (int hh = 0; hh < 4; ++hh)
#pragma unroll
        for (int ks = 0; ks < 2; ++ks) QS[(hh * 2 + ks) * 64] = ldg8(QB + grow * LDQ + (g * 4 + hh) * 64 + ks * 32 + fq * 8);
#define Qc(hh, ks) (QS[((hh) * 2 + (ks)) * 64])
    for (int i = lane; i < 16 * 132; i += 64) IMP[i] = 0.f;
    const f32x4 z4 = {0.f, 0.f, 0.f, 0.f};
    f32x4 O[4][4];
    int nvmax = (t0 + 15 >= 31) ? (((t0 + 15 - 31) >> 4) + 1) : 0; if (nvmax > NC) nvmax = NC;
    const int nch = (nvmax + 31) >> 5;
    const bf16* kcb = KC + (size_t)bg * 512 * 64; const bf16* vcb = VcT + (size_t)bg * 64 * 512;
    float linv[4] = {0.f, 0.f, 0.f, 0.f};
#pragma unroll
    for (int hh = 0; hh < 4; ++hh)
#pragma unroll
        for (int mt = 0; mt < 4; ++mt) O[hh][mt] = z4;
#pragma unroll 1
    for (int pass = 0; pass < 2; ++pass) {
#pragma unroll 1
        for (int ch = 0; ch < nch; ++ch) {
            asm volatile("" ::: "memory");
            const int k0 = 32 * ch; const bool cfull = 16 * (k0 + 31) + 31 <= t0;
            bf16x8_t ka[2][2];
#pragma unroll
            for (int tl = 0; tl < 2; ++tl)
#pragma unroll
                for (int ks = 0; ks < 2; ++ks) ka[tl][ks] = ldg8(kcb + ((size_t)(4 * ks + fq) * 512 + k0 + 16 * tl + col) * 8);
            bf16x8_t va[4];
            if (pass == 1) {
#pragma unroll
                for (int mt = 0; mt < 4; ++mt) va[mt] = ldg8(vcb + ((size_t)((k0 >> 3) + fq) * 64 + 16 * mt + col) * 8);
            }
            float ps[8] = {0.f, 0.f, 0.f, 0.f, 0.f, 0.f, 0.f, 0.f};
#pragma unroll
            for (int hh = 0; hh < 4; ++hh) {
                const bf16x8_t q0_ = Qc(hh, 0), q1_ = Qc(hh, 1);
                f32x4 sa = MFMA16(ka[0][0], q0_, z4); sa = MFMA16(ka[0][1], q1_, sa);
                f32x4 sb = MFMA16(ka[1][0], q0_, z4); sb = MFMA16(ka[1][1], q1_, sb);
#pragma unroll
                for (int i = 0; i < 4; ++i) { sa[i] = __builtin_amdgcn_exp2f(sa[i]); sb[i] = __builtin_amdgcn_exp2f(sb[i]); }
                if (!cfull) {
#pragma unroll
                    for (int i = 0; i < 4; ++i) { const int c = k0 + 4 * fq + i; sa[i] = (16 * c + 31 <= tok) ? sa[i] : 0.f; sb[i] = (16 * (c + 16) + 31 <= tok) ? sb[i] : 0.f; } }
                if (pass == 0) { linv[hh] += (sa[0] + sa[1]) + (sa[2] + sa[3]) + (sb[0] + sb[1]) + (sb[2] + sb[3]); }
                else {
#pragma unroll
                    for (int i = 0; i < 4; ++i) { ps[i] = __builtin_fmaf(sa[i], linv[hh], ps[i]); ps[4 + i] = __builtin_fmaf(sb[i], linv[hh], ps[4 + i]); }
                    const bf16x8_t pt = pack_p(sa, sb);
#pragma unroll
                    for (int mt = 0; mt < 4; ++mt) O[hh][mt] = MFMA16(va[mt], pt, O[hh][mt]);
                }
            }
            if (pass == 1) {
                const int Ga = 8 * ch + fq; LAS float* ir = IMP + col * 132 + Ga;
                __hip_atomic_fetch_add(ir, (ps[0] + ps[1]) + (ps[2] + ps[3]), __ATOMIC_RELAXED, __HIP_MEMORY_SCOPE_WORKGROUP);
                __hip_atomic_fetch_add(ir + 1, ps[3], __ATOMIC_RELAXED, __HIP_MEMORY_SCOPE_WORKGROUP);
                __hip_atomic_fetch_add(ir + 4, (ps[4] + ps[5]) + (ps[6] + ps[7]), __ATOMIC_RELAXED, __HIP_MEMORY_SCOPE_WORKGROUP);
                if (Ga + 5 < NS) __hip_atomic_fetch_add(ir + 5, ps[7], __ATOMIC_RELAXED, __HIP_MEMORY_SCOPE_WORKGROUP);
            }
        }
        if (pass == 0) {
#pragma unroll
            for (int hh = 0; hh < 4; ++hh) { float l = linv[hh]; l += bperm_f(l, lane ^ 16); l += bperm_f(l, lane ^ 32); linv[hh] = l > 0.f ? 1.f / l : 0.f; }
        }
    }
    LDS_WAIT(); asm volatile("" ::: "memory");
    {
        const int cur = tok >> 6; LAS float* sc = IMP + col * 132;
        for (int j = fq * 32; j < fq * 32 + 32; ++j) { const bool forced = (j == 0) || (j == cur) || (j == cur - 1); const float v = sc[j]; sc[j] = forced ? 1e4f : (j <= cur ? v : -1.f); }
        LDS_WAIT(); asm volatile("" ::: "memory");
#pragma unroll 1
        for (int r = 0; r < 8; ++r) {
            float bv = sc[fq * 32]; int bj = fq * 32;
            for (int j = fq * 32 + 1; j < fq * 32 + 32; ++j) { const float v = sc[j]; if (v > bv) { bv = v; bj = j; } }
#pragma unroll
            for (int o = 16; o <= 32; o <<= 1) { const float ov = bperm_f(bv, lane ^ o); const int oj = bperm_i(bj, lane ^ o); if (ov > bv || (ov == bv && oj < bj)) { bv = ov; bj = oj; } }
            if ((bj >> 5) == fq) sc[bj] = -3e38f;
            if (fq == 0) SEL[col * 8 + r] = bj;
            LDS_WAIT(); asm volatile("" ::: "memory");
        }
    }
#pragma unroll
    for (int hh = 0; hh < 4; ++hh) { const float g0 = gate[hh * 3 + 0] * linv[hh];
#pragma unroll
        for (int mt = 0; mt < 4; ++mt) { const f32x4 o = O[hh][mt] * g0; v2u w; w.x = cvt_pk_bf16(o[0], o[1]); w.y = cvt_pk_bf16(o[2], o[3]);
            *(LAS v2u*)(OS + (col * 4 + hh) * 64 + 16 * mt + 4 * fq) = w; } }
    LDS_WAIT(); asm volatile("" ::: "memory");
    const int cur = t0 >> 6;
    {
        const bf16* kwb = WSP(bf16, WS_KW8) + (size_t)bg * 8 * SEQ * 8; const bf16* vwb = VwT + (size_t)bg * 64 * SEQ;
        const bf16* ksb = WSP(bf16, WS_KS8) + (size_t)bg * 8 * SEQ * 8; const bf16* vsb = VsT + (size_t)bg * 64 * SEQ;
        int kst = t0 - (WINDOW - 1); if (kst < 0) kst = 0; kst &= ~31;
        const int nwin = ((t0 + 15 - kst) >> 5) + 1, nfb = cur >= 2 ? 3 : cur + 1;
#pragma unroll 1
        for (int part = 0; part < 2; ++part) {
            float lw[4] = {0.f, 0.f, 0.f, 0.f};
#pragma unroll
            for (int hh = 0; hh < 4; ++hh)
#pragma unroll
                for (int mt = 0; mt < 4; ++mt) O[hh][mt] = z4;
            const bf16* kb = part ? ksb : kwb; const bf16* vb = part ? vsb : vwb;
            const int nchk = part ? 2 * nfb : nwin;
#pragma unroll 1
            for (int ci = 0; ci < nchk; ++ci) {
                asm volatile("" ::: "memory");
                int k0;
                if (part == 0) k0 = kst + 32 * ci; else { const int fb = ci >> 1, j = fb == 0 ? 0 : (fb == 1 ? cur : cur - 1); k0 = 64 * j + 32 * (ci & 1); }
                bf16x8_t ka[2][2], va[4];
#pragma unroll
                for (int tl = 0; tl < 2; ++tl)
#pragma unroll
                    for (int ks = 0; ks < 2; ++ks) ka[tl][ks] = ldg8(kb + ((size_t)(4 * ks + fq) * SEQ + k0 + 16 * tl + col) * 8);
#pragma unroll
                for (int mt = 0; mt < 4; ++mt) va[mt] = ldg8(vb + ((size_t)((k0 >> 3) + fq) * 64 + 16 * mt + col) * 8);
                const int lowk = part ? -1 : tok - WINDOW; const bool dfull = (k0 + 31 <= t0) && (part || k0 > t0 + 15 - WINDOW);
#pragma unroll
                for (int hh = 0; hh < 4; ++hh) {
                    const bf16x8_t q0_ = Qc(hh, 0), q1_ = Qc(hh, 1);
                    f32x4 sa = MFMA16(ka[0][0], q0_, z4); sa = MFMA16(ka[0][1], q1_, sa);
                    f32x4 sb = MFMA16(ka[1][0], q0_, z4); sb = MFMA16(ka[1][1], q1_, sb);
#pragma unroll
                    for (int i = 0; i < 4; ++i) { sa[i] = __builtin_amdgcn_exp2f(sa[i]); sb[i] = __builtin_amdgcn_exp2f(sb[i]); }
                    if (!dfull) {
#pragma unroll
                        for (int i = 0; i < 4; ++i) { const int kt = k0 + 4 * fq + i; sa[i] = (kt <= tok && kt > lowk) ? sa[i] : 0.f; sb[i] = (kt + 16 <= tok && kt + 16 > lowk) ? sb[i] : 0.f; } }
                    lw[hh] += (sa[0] + sa[1]) + (sa[2] + sa[3]) + (sb[0] + sb[1]) + (sb[2] + sb[3]);
                    const bf16x8_t pt = pack_p(sa, sb);
#pragma unroll
                    for (int mt = 0; mt < 4; ++mt) O[hh][mt] = MFMA16(va[mt], pt, O[hh][mt]);
                }
            }
            LDS_WAIT(); asm volatile("" ::: "memory");
            if (part == 0) {
#pragma unroll
                for (int hh = 0; hh < 4; ++hh) { float l = lw[hh]; l += bperm_f(l, lane ^ 16); l += bperm_f(l, lane ^ 32); const float w = l > 0.f ? gate[hh * 3 + 2] / l : 0.f;
#pragma unroll
                    for (int mt = 0; mt < 4; ++mt) { LAS v2u* dp = (LAS v2u*)(OS + (col * 4 + hh) * 64 + 16 * mt + 4 * fq); const v2u old = *dp;
                        v2u w2; w2.x = cvt_pk_bf16(blo(old.x) + w * O[hh][mt][0], bhi(old.x) + w * O[hh][mt][1]); w2.y = cvt_pk_bf16(blo(old.y) + w * O[hh][mt][2], bhi(old.y) + w * O[hh][mt][3]); *dp = w2; } }
            } else {
                LAS bf16* OF = (LAS bf16*)(wl + AW_QS); LAS float* LF = (LAS float*)(wl + AW_IMP + 8192);
#pragma unroll
                for (int hh = 0; hh < 4; ++hh) { float l = lw[hh]; l += bperm_f(l, lane ^ 16); l += bperm_f(l, lane ^ 32); if (fq == 0) LF[col * 4 + hh] = l;
#pragma unroll
                    for (int mt = 0; mt < 4; ++mt) { v2u w2; w2.x = cvt_pk_bf16(O[hh][mt][0], O[hh][mt][1]); w2.y = cvt_pk_bf16(O[hh][mt][2], O[hh][mt][3]); *(LAS v2u*)(OF + (col * 4 + hh) * 64 + 16 * mt + 4 * fq) = w2; } }
            }
            LDS_WAIT(); asm volatile("" ::: "memory");
        }
    }
    {
        const bf16* ksb = WSP(bf16, WS_KS8) + (size_t)bg * 8 * SEQ * 8; const bf16* vsb = VsT + (size_t)bg * 64 * SEQ;
        const LAS bf16* OF = (const LAS bf16*)(wl + AW_QS); const LAS float* LF = (const LAS float*)(wl + AW_IMP + 8192);
        int ento_ = AW_ENT; asm volatile("" : "+s"(ento_)); LAS unsigned short* ENT = (LAS unsigned short*)(wl + ento_);
        int n;
        { const int ja = SEL[lane], jb = SEL[lane + 64], tqa = t0 + (lane >> 3), tqb = t0 + 8 + (lane >> 3);
          const bool va_ = !(64 * ja > tqa || ja == 0 || ja == cur || ja == cur - 1), vb_ = !(64 * jb > tqb || jb == 0 || jb == cur || jb == cur - 1);
          unsigned long long ba = __builtin_amdgcn_ballot_w64(va_), bb = __builtin_amdgcn_ballot_w64(vb_); const unsigned long long lt = (1ull << lane) - 1ull;
          const bool da_ = ((ba >> (lane & 56)) & 0xffull) == 0ull && (lane & 7) == 0, db_ = ((bb >> (lane & 56)) & 0xffull) == 0ull && (lane & 7) == 0;
          ba = __builtin_amdgcn_ballot_w64(va_ || da_); bb = __builtin_amdgcn_ballot_w64(vb_ || db_);
          const int na = __builtin_popcountll(ba); n = na + __builtin_popcountll(bb);
          if (va_ || da_) ENT[__builtin_popcountll(ba & lt)] = (unsigned short)(((lane >> 3) << 8) | (va_ ? ja : 0x8000));
          if (vb_ || db_) ENT[na + __builtin_popcountll(bb & lt)] = (unsigned short)(((8 + (lane >> 3)) << 8) | (vb_ ? jb : 0x8000));
          if (lane < 3) ENT[n + lane] = (unsigned short)(0x8000 | (15 << 8));
          LDS_WAIT(); asm volatile("" ::: "memory"); }
        const float gate_l = (NG + ((size_t)b * SEQ + t0 + (lane >> 2)) * 24 + g * 12)[(lane & 3) * 3 + 1];
        const bf16* qsrc = QB + ((size_t)b * SEQ + t0) * LDQ + (g * 4 + (col & 3)) * 64 + fq * 8;
        bf16x8_t Qh[2], Qn[2]; f32x4 Os[4] = {z4, z4, z4, z4}; float ls = 0.f; int cur_tt = -1;
        Qn[0] = ldg8(qsrc); Qn[1] = ldg8(qsrc + 32);
        bf16x8_t kX[2][2], vX[4], kY[2][2], vY[4], kZ[2][2], vZ[4];
#define SEL_ISSUE(K_, V_, ENT_, HF_) do { const int kb0_ = 64 * ((ENT_) & 255) + 32 * (HF_); \
            _Pragma("unroll") for (int tl = 0; tl < 2; ++tl) _Pragma("unroll") for (int ks = 0; ks < 2; ++ks) K_[tl][ks] = ldg8(ksb + ((size_t)(4 * ks + fq) * SEQ + kb0_ + 16 * tl + col) * 8); \
            _Pragma("unroll") for (int mt = 0; mt < 4; ++mt) V_[mt] = ldg8(vsb + ((size_t)((kb0_ >> 3) + fq) * 64 + 16 * mt + col) * 8); } while (0)
#define SEL_COMPUTE(K_, V_, ENT_) do { if (!((ENT_) & 0x8000)) { \
            f32x4 sa = MFMA16(K_[0][0], Qh[0], z4); sa = MFMA16(K_[0][1], Qh[1], sa); f32x4 sb = MFMA16(K_[1][0], Qh[0], z4); sb = MFMA16(K_[1][1], Qh[1], sb); \
            _Pragma("unroll") for (int i = 0; i < 4; ++i) { sa[i] = __builtin_amdgcn_exp2f(sa[i]); sb[i] = __builtin_amdgcn_exp2f(sb[i]); } \
            ls += (sa[0] + sa[1]) + (sa[2] + sa[3]) + (sb[0] + sb[1]) + (sb[2] + sb[3]); const bf16x8_t pt = pack_p(sa, sb); \
            _Pragma("unroll") for (int mt = 0; mt < 4; ++mt) Os[mt] = MFMA16(V_[mt], pt, Os[mt]); } } while (0)
#define SEL_FINAL(tz) do { float l_ = ls; l_ += bperm_f(l_, lane ^ 16); l_ += bperm_f(l_, lane ^ 32); const float gt_ = bperm_f(gate_l, (tz) * 4 + (col & 3)); \
            if (col < 4) { const float den = l_ + LF[(tz) * 4 + col]; const float w = den > 0.f ? gt_ / den : 0.f; \
                _Pragma("unroll") for (int mt = 0; mt < 4; ++mt) { const int e_ = ((tz) * 4 + col) * 64 + 16 * mt + 4 * fq; const v2u old = *(const LAS v2u*)(OS + e_), fo = *(const LAS v2u*)(OF + e_); \
                    v2u w2; w2.x = cvt_pk_bf16(blo(old.x) + w * (Os[mt][0] + blo(fo.x)), bhi(old.x) + w * (Os[mt][1] + bhi(fo.x))); w2.y = cvt_pk_bf16(blo(old.y) + w * (Os[mt][2] + blo(fo.y)), bhi(old.y) + w * (Os[mt][3] + bhi(fo.y))); \
                    *(LAS v2u*)(OS + e_) = w2; } } \
            Os[0] = z4; Os[1] = z4; Os[2] = z4; Os[3] = z4; ls = 0.f; } while (0)
#define SEL_ADVANCE(ENT_) do { const int tt_ = ((ENT_) >> 8) & 15; if (tt_ != cur_tt) { if (cur_tt >= 0) SEL_FINAL(cur_tt); cur_tt = tt_; Qh[0] = Qn[0]; Qh[1] = Qn[1]; \
                if (col >= 4) { Qh[0] = (bf16x8_t){0, 0, 0, 0, 0, 0, 0, 0}; Qh[1] = (bf16x8_t){0, 0, 0, 0, 0, 0, 0, 0}; } } \
            const int tn_ = tt_ + 1 < 16 ? tt_ + 1 : 15; Qn[0] = ldg8(qsrc + (size_t)tn_ * LDQ); Qn[1] = ldg8(qsrc + (size_t)tn_ * LDQ + 32); } while (0)
#define ENTRD(i_) __builtin_amdgcn_readfirstlane((int)ENT[(i_)])
        int e0 = ENTRD(0);
        SEL_ISSUE(kX, vX, e0, 0); SEL_ISSUE(kY, vY, e0, 1);
        const int np = ((n + 2) / 3) * 3;
#pragma unroll 1
        for (int e = 0; e < np; e += 3) {
            const int e1 = ENTRD(e + 1), e2 = ENTRD(e + 2), e3 = ENTRD(e + 3);
            SEL_ADVANCE(e0);
            SEL_ISSUE(kZ, vZ, e1, 0); SEL_COMPUTE(kX, vX, e0);
            SEL_ISSUE(kX, vX, e1, 1); SEL_COMPUTE(kY, vY, e0);
            SEL_ADVANCE(e1);
            SEL_ISSUE(kY, vY, e2, 0); SEL_COMPUTE(kZ, vZ, e1);
            SEL_ISSUE(kZ, vZ, e2, 1); SEL_COMPUTE(kX, vX, e1);
            SEL_ADVANCE(e2);
            SEL_ISSUE(kX, vX, e3, 0); SEL_COMPUTE(kY, vY, e2);
            SEL_ISSUE(kY, vY, e3, 1); SEL_COMPUTE(kZ, vZ, e2);
            e0 = e3;
        }
        SEL_FINAL(15);
#undef ENTRD
#undef SEL_ISSUE
#undef SEL_COMPUTE
#undef SEL_FINAL
#undef SEL_ADVANCE
        LDS_WAIT(); asm volatile("" ::: "memory");
        { int l2 = lane; asm volatile("" : "+v"(l2)); bf16* orow = QB + ((size_t)b * SEQ + t0) * LDQ + g * 256;
#pragma unroll 2
          for (int i = 0; i < 8; ++i) { const int pc = i * 64 + l2; *(v4u*)(orow + (size_t)(pc >> 5) * LDQ + (pc & 31) * 8) = *(const LAS v4u*)(OS + pc * 8); } }
    }
    LDS_WAIT(); asm volatile("" ::: "memory");
#undef Qc
}

typedef _Float16 h16x2 __attribute__((ext_vector_type(2)));
__device__ __forceinline__ h16x2 as_h2(unsigned u) { h16x2 r; __builtin_memcpy(&r, &u, 4); return r; }
constexpr int SC_STEPS = 8, SC_BUF = 6 * 1024;
__device__ __forceinline__ float dpp_sum16(float v) {
    v += __builtin_bit_cast(float, __builtin_amdgcn_update_dpp(0, __builtin_bit_cast(int, v), 0xB1, 0xF, 0xF, true));
    v += __builtin_bit_cast(float, __builtin_amdgcn_update_dpp(0, __builtin_bit_cast(int, v), 0x4E, 0xF, 0xF, true));
    v += __builtin_bit_cast(float, __builtin_amdgcn_update_dpp(0, __builtin_bit_cast(int, v), 0x141, 0xF, 0xF, true));
    v += __builtin_bit_cast(float, __builtin_amdgcn_update_dpp(0, __builtin_bit_cast(int, v), 0x140, 0xF, 0xF, true));
    return v;
}
__device__ __forceinline__ float fmix_lo(float a, unsigned b, float c) { float d; asm("v_fma_mix_f32 %0, %1, %2, %3 op_sel_hi:[0,1,0]" : "=v"(d) : "v"(a), "v"(b), "v"(c)); return d; }
__device__ __forceinline__ float fmix_hi(float a, unsigned b, float c) { float d; asm("v_fma_mix_f32 %0, %1, %2, %3 op_sel:[0,1,0] op_sel_hi:[0,1,0]" : "=v"(d) : "v"(a), "v"(b), "v"(c)); return d; }
__device__ __forceinline__ float fmix_lo0(float a, unsigned b) { float d; asm("v_fma_mix_f32 %0, %1, %2, 0 op_sel_hi:[0,1,0]" : "=v"(d) : "v"(a), "v"(b)); return d; }
__device__ __forceinline__ float fmix_nlo(float a, unsigned b, float c) { float d; asm("v_fma_mix_f32 %0, %1, -%2, %3 op_sel_hi:[0,1,0]" : "=v"(d) : "v"(a), "v"(b), "v"(c)); return d; }
__device__ __forceinline__ float fmix_nhi(float a, unsigned b, float c) { float d; asm("v_fma_mix_f32 %0, %1, -%2, %3 op_sel:[0,1,0] op_sel_hi:[0,1,0]" : "=v"(d) : "v"(a), "v"(b), "v"(c)); return d; }
__device__ __forceinline__ float fmix_hlo(unsigned a, unsigned b, float c) { float d; asm("v_fma_mix_f32 %0, %1, %2, %3 op_sel_hi:[1,1,0]" : "=v"(d) : "v"(a), "v"(b), "v"(c)); return d; }
__device__ __forceinline__ float fmix_hhi(unsigned a, unsigned b, float c) { float d; asm("v_fma_mix_f32 %0, %1, %2, %3 op_sel:[0,1,0] op_sel_hi:[1,1,0]" : "=v"(d) : "v"(a), "v"(b), "v"(c)); return d; }
__device__ __forceinline__ void scan_fill(const bf16* RW, const bf16* Wm, const bf16* Am, size_t trow, int h, int lane, LAS unsigned char* buf) {
    const size_t t = trow + (lane >> 3); const int sub = (lane & 7) * 8;
    const bf16* row = RW + t * LDRW + h * 64 + sub;
    __builtin_amdgcn_global_load_lds((const unsigned*)(row + LBLK), (LAS unsigned*)(buf + 0 * 1024), 16, 0, 0);
    __builtin_amdgcn_global_load_lds((const unsigned*)(Am + t * RC + h * 64 + sub), (LAS unsigned*)(buf + 1 * 1024), 16, 0, 0);
    __builtin_amdgcn_global_load_lds((const unsigned*)(Wm + t * RC + h * 64 + sub), (LAS unsigned*)(buf + 2 * 1024), 16, 0, 0);
    __builtin_amdgcn_global_load_lds((const unsigned*)(row + 512), (LAS unsigned*)(buf + 3 * 1024), 16, 0, 0);
    __builtin_amdgcn_global_load_lds((const unsigned*)(row), (LAS unsigned*)(buf + 4 * 1024), 16, 0, 0);
    __builtin_amdgcn_global_load_lds((const unsigned*)(row + 1024), (LAS unsigned*)(buf + 5 * 1024), 16, 0, 0);
}
constexpr int SC_BUF3 = 5 * 1024 + 128;
__device__ __forceinline__ unsigned scan_fill3(const bf16* RW, const bf16* Wm, const bf16* Am, size_t trow, int h, int row, int lane, LAS unsigned char* buf) {
    const size_t t = trow + (lane >> 3); const int sub = (lane & 7) * 8;
    const bf16* rp = RW + t * LDRW + h * 64 + sub;
    __builtin_amdgcn_global_load_lds((const unsigned*)(rp + LBLK), (LAS unsigned*)(buf + 0 * 1024), 16, 0, 0);
    __builtin_amdgcn_global_load_lds((const unsigned*)(Am + t * RC + h * 64 + sub), (LAS unsigned*)(buf + 1 * 1024), 16, 0, 0);
    __builtin_amdgcn_global_load_lds((const unsigned*)(Wm + t * RC + h * 64 + sub), (LAS unsigned*)(buf + 2 * 1024), 16, 0, 0);
    __builtin_amdgcn_global_load_lds((const unsigned*)(rp + 512), (LAS unsigned*)(buf + 3 * 1024), 16, 0, 0);
    __builtin_amdgcn_global_load_lds((const unsigned*)(rp), (LAS unsigned*)(buf + 4 * 1024), 16, 0, 0);
    if (lane < 8) __builtin_amdgcn_global_load_lds((const unsigned*)(RW + (trow + lane) * LDRW + 1024 + h * 64 + (row & ~7)), (LAS unsigned*)(buf + 5 * 1024), 16, 0, 0);
    return 0u;
}
__device__ __forceinline__ void scan_unit(const P& p, int unit, int lane, LAS unsigned char* wl) {
    const bf16* RW = WSP(bf16, AR_RW); const bf16* Wm = WSP(bf16, AR_W); const bf16* Am = WSP(bf16, AR_A); bf16* Y = WSP(bf16, AR_UB);
    const int rg = unit & 15, h = (unit >> 4) & 7, b = unit >> 7, row = rg * 4 + (lane >> 4), kq = lane & 15;
    const size_t tb = (size_t)b * SEQ;
    constexpr int NCH = SEQ / SC_STEPS;
    float s0 = 0.f, s1 = 0.f, s2 = 0.f, s3 = 0.f;
    __builtin_amdgcn_s_setprio(3);
#define SCAN_CHUNK(C_, BI_, B2_, VCUR_, VNEW_) do { \
        LAS unsigned char* buf = wl + (BI_) * SC_BUF3; const int c2 = (C_) + 2 < NCH ? (C_) + 2 : NCH - 1;                  \
        asm volatile("s_waitcnt lgkmcnt(0)" ::: "memory");                                                                  \
        VNEW_ = scan_fill3(RW, Wm, Am, tb + (size_t)c2 * SC_STEPS, h, row, lane, wl + (B2_) * SC_BUF3); \
        asm volatile("s_waitcnt vmcnt(12)" ::: "memory");                                                                   \
        float ys[SC_STEPS]; v2u kkw[SC_STEPS], bbw[SC_STEPS], eew[SC_STEPS], ktw[SC_STEPS], rrw[SC_STEPS]; unsigned vvw[SC_STEPS]; \
        _Pragma("unroll") for (int st = 0; st < 4; ++st) { const LAS unsigned char* o = buf + st * 128 + kq * 8; \
            kkw[st] = *(const LAS v2u*)(o); bbw[st] = *(const LAS v2u*)(o + 1024); eew[st] = *(const LAS v2u*)(o + 2048); ktw[st] = *(const LAS v2u*)(o + 3072); rrw[st] = *(const LAS v2u*)(o + 4096); \
            vvw[st] = (unsigned)*(const LAS unsigned short*)(buf + 5 * 1024 + st * 16 + (row & 7) * 2); } \
        asm volatile("" ::: "memory"); \
        _Pragma("unroll") for (int st = 4; st < SC_STEPS; ++st) { const LAS unsigned char* o = buf + st * 128 + kq * 8; \
            kkw[st] = *(const LAS v2u*)(o); bbw[st] = *(const LAS v2u*)(o + 1024); eew[st] = *(const LAS v2u*)(o + 2048); ktw[st] = *(const LAS v2u*)(o + 3072); rrw[st] = *(const LAS v2u*)(o + 4096); \
            vvw[st] = (unsigned)*(const LAS unsigned short*)(buf + 5 * 1024 + st * 16 + (row & 7) * 2); } \
        asm volatile("" ::: "memory"); \
        _Pragma("unroll") for (int st = 0; st < SC_STEPS; ++st) { const unsigned vvr = vvw[st]; \
            const float d0 = fmix_hi(s1, kkw[st].x, fmix_lo0(s0, kkw[st].x)), d1 = fmix_hi(s3, kkw[st].y, fmix_lo0(s2, kkw[st].y)); \
            const float nskk = -dpp_sum16(d0 + d1); \
            s0 = fmix_nlo(s0, eew[st].x, s0); s1 = fmix_nhi(s1, eew[st].x, s1); s2 = fmix_nlo(s2, eew[st].y, s2); s3 = fmix_nhi(s3, eew[st].y, s3); \
            s0 = fmix_lo(nskk, bbw[st].x, s0); s1 = fmix_hi(nskk, bbw[st].x, s1); s2 = fmix_lo(nskk, bbw[st].y, s2); s3 = fmix_hi(nskk, bbw[st].y, s3); \
            s0 = fmix_hlo(vvr, ktw[st].x, s0); s1 = fmix_hhi(vvr, ktw[st].x, s1); s2 = fmix_hlo(vvr, ktw[st].y, s2); s3 = fmix_hhi(vvr, ktw[st].y, s3); \
            const float y0 = fmix_hi(s1, rrw[st].x, fmix_lo0(s0, rrw[st].x)), y1 = fmix_hi(s3, rrw[st].y, fmix_lo0(s2, rrw[st].y)); \
            ys[st] = dpp_sum16(y0 + y1); } \
        if (kq < SC_STEPS) { float yv = ys[0];        \
            _Pragma("unroll") for (int st = 1; st < SC_STEPS; ++st) yv = (kq == st) ? ys[st] : yv; \
            bf16* yd = (C_) < NCH ? Y + (tb + (size_t)(C_) * SC_STEPS + kq) * RC + h * 64 + row : ysink;         \
            *yd = f2bf(yv); } } while (0)
    bf16* ysink = (bf16*)(p.ws + WS_CTL + 4 * CW_SINK) + lane;
    unsigned v0 = scan_fill3(RW, Wm, Am, tb, h, row, lane, wl), v1 = scan_fill3(RW, Wm, Am, tb + SC_STEPS, h, row, lane, wl + SC_BUF3), v2 = 0u;
#pragma unroll 1
    for (int c = 0; c < NCH + 2; c += 3) {
        SCAN_CHUNK(c, 0, 2, v0, v2);
        SCAN_CHUNK(c + 1, 1, 0, v1, v0);
        SCAN_CHUNK(c + 2, 2, 1, v2, v1);
    }
#undef SCAN_CHUNK
    asm volatile("s_waitcnt vmcnt(0) lgkmcnt(0)" ::: "memory");
    __builtin_amdgcn_s_setprio(0);
}
__device__ __forceinline__ float sum8(float v) {
    v += __builtin_bit_cast(float, __builtin_amdgcn_update_dpp(0, __builtin_bit_cast(int, v), 0xB1, 0xF, 0xF, true));
    v += __builtin_bit_cast(float, __builtin_amdgcn_update_dpp(0, __builtin_bit_cast(int, v), 0x4E, 0xF, 0xF, true));
    v += __builtin_bit_cast(float, __builtin_amdgcn_update_dpp(0, __builtin_bit_cast(int, v), 0x141, 0xF, 0xF, true));
    return v;
}
__device__ __forceinline__ void up8(v4u w, float* f) { f[0] = blo(w.x); f[1] = bhi(w.x); f[2] = blo(w.y); f[3] = bhi(w.y); f[4] = blo(w.z); f[5] = bhi(w.z); f[6] = blo(w.w); f[7] = bhi(w.w); }
#ifdef SCAN_BF16
#define uph8 up8
#define pkh8 pk8
#else
#define uph8 uph8_
#define pkh8 pkh8_
#endif
__device__ __forceinline__ void uph8_(v4u w, float* f) { const h16x2 a = as_h2(w.x), b = as_h2(w.y), c = as_h2(w.z), d = as_h2(w.w);
    f[0] = (float)a.x; f[1] = (float)a.y; f[2] = (float)b.x; f[3] = (float)b.y; f[4] = (float)c.x; f[5] = (float)c.y; f[6] = (float)d.x; f[7] = (float)d.y; }
__device__ __forceinline__ unsigned pkh2(float lo, float hi) { h16x2 v; v.x = (_Float16)lo; v.y = (_Float16)hi; return __builtin_bit_cast(unsigned, v); }
__device__ __forceinline__ v4u pkh8_(const float* f) { v4u w; w.x = pkh2(f[0], f[1]); w.y = pkh2(f[2], f[3]); w.z = pkh2(f[4], f[5]); w.w = pkh2(f[6], f[7]); return w; }
__device__ __forceinline__ v4u pk8(const float* f) { v4u w; w.x = cvt_pk_bf16(f[0], f[1]); w.y = cvt_pk_bf16(f[2], f[3]); w.z = cvt_pk_bf16(f[4], f[5]); w.w = cvt_pk_bf16(f[6], f[7]); return w; }
__device__ __forceinline__ void ldf8(const float* p, float* f) { const f32x4 a = *(const f32x4*)p, b = *(const f32x4*)(p + 4); f[0] = a[0]; f[1] = a[1]; f[2] = a[2]; f[3] = a[3]; f[4] = b[0]; f[5] = b[1]; f[6] = b[2]; f[7] = b[3]; }

struct EpiLora {
    static constexpr bool PERM = true, AFTER_DRAIN = false;
    unsigned char* ws; int pn0;
    __device__ __forceinline__ void operator()(const f32x4 (&acc)[2][2][4][2], const Unit& u, int wr, int wc, int fr, int fq) const {
        const int pn = u.pn + pn0, which = pn >> 1, row0 = u.pm * BM + wr * 64 + fr, c0 = (pn & 1) * 256 + wc * 32 + 8 * fq;
        bf16* const O = (bf16*)(ws + (which == 0 ? AR_W : (which == 1 ? AR_A : (which == 2 ? AR_G : AR_UB))));
#pragma unroll
        for (int ai = 0; ai < 2; ++ai)
#pragma unroll
            for (int m = 0; m < 4; ++m)
#pragma unroll
                for (int bj = 0; bj < 2; ++bj) *(u32x4*)(O + (size_t)(row0 + ai * HALF + m * 16) * RC + c0 + bj * HALF) = pack8(acc[ai][bj][m][0], acc[ai][bj][m][1]);
    }
};
#ifdef RKV_BF16
#define UPR up8
#define PKR pk8
#else
#define UPR uph8
#define PKR pkh8
#endif
struct B2In { v4u k, a, w, vr, vv, vf; float gt; };
__device__ __forceinline__ void b2w_load(B2In& in, const P& p, int layer, int t, int lane) {
    const bf16* row = WSP(bf16, AR_RW) + (size_t)t * LDRW;
    in.k = *(const v4u*)(row + 512 + 8 * lane); in.a = *(const v4u*)(WSP(bf16, AR_A) + (size_t)t * RC + 8 * lane); in.w = *(const v4u*)(WSP(bf16, AR_W) + (size_t)t * RC + 8 * lane);
    in.gt = lane < 24 ? bf2f(row[LBLK + 320 + lane]) : 0.f;
    if (layer == 1) { in.vr = *(const v4u*)(WSP(bf16, AR_UB) + (size_t)t * RC + 8 * lane); in.vv = *(const v4u*)(row + 1024 + 8 * lane); in.vf = *(const v4u*)(WSP(bf16, WS_VF) + (size_t)t * RC + 8 * lane); }
}
__device__ __forceinline__ void b2w_compute(const B2In& in, const P& p, int layer, int t, int lane, const float* v0, const float* v1, const float* v2, const float* v3, const float* vb) {
    bf16* row = WSP(bf16, AR_RW) + (size_t)t * LDRW; bf16* Am = WSP(bf16, AR_A); bf16* Wm = WSP(bf16, AR_W); float* NG = WSP(float, AR_NG);
    float k[8], a[8], w[8]; uph8(in.k, k); up8(in.a, a); up8(in.w, w);
    const float ngv = fsig(in.gt);
    float kk[8], ss = 0.f;
#pragma unroll
    for (int i = 0; i < 8; ++i) {
        a[i] = fsig(a[i] + v1[i]);
        const float nx = -(w[i] + v0[i]), sp = fmaxf(nx, 0.f) + __logf(1.f + __expf(-fabsf(nx))), e = __expf(-sp - 0.5f); w[i] = 1.f - __expf(-e);
        kk[i] = k[i] * v2[i]; ss += kk[i] * kk[i]; }
    ss = sum8(ss); const float nrm = sqrtf(ss), inv = 1.f / (nrm > 1e-12f ? nrm : 1e-12f);
#pragma unroll
    for (int i = 0; i < 8; ++i) { kk[i] *= inv; k[i] = k[i] * (1.f + (a[i] - 1.f) * v3[i]); a[i] *= kk[i]; }
    asm volatile("" :: "v"(ngv));
    if (layer == 1) { float vr[8], vv[8], vf[8]; up8(in.vr, vr); uph8(in.vv, vv); uph8(in.vf, vf);
#pragma unroll
        for (int i = 0; i < 8; ++i) vv[i] = vv[i] + (vf[i] - vv[i]) * fsig(vr[i] + vb[i]);
        *(v4u*)(row + 1024 + 8 * lane) = pkh8(vv); }
    if (lane < 24) NG[(size_t)t * 24 + lane] = ngv;
    *(v4u*)(row + LBLK + 8 * lane) = pkh8(kk); *(v4u*)(row + 512 + 8 * lane) = pkh8(k);
    *(v4u*)(Am + (size_t)t * RC + 8 * lane) = pkh8(a); *(v4u*)(Wm + (size_t)t * RC + 8 * lane) = pkh8(w);
}
__device__ __forceinline__ void ph_rwkv_b2w(const P& p, int layer, int gw, int NGW, int lane) {
    const float* vec = p.rwkv_vec + (size_t)layer * 7 * RC; float v0[8], v1[8], v2[8], v3[8], vb[8];
    ldf8(vec + 8 * lane, v0); ldf8(vec + RC + 8 * lane, v1); ldf8(vec + 2 * RC + 8 * lane, v2); ldf8(vec + 3 * RC + 8 * lane, v3); ldf8(p.vres_b + 8 * lane, vb);
    int t = gw; if (t >= T) return;
    B2In A, B; b2w_load(A, p, layer, t, lane);
    for (; t < T; t += 2 * NGW) { const int t1 = t + NGW, t2 = t1 + NGW;
        b2w_load(B, p, layer, t1 < T ? t1 : t, lane); b2w_compute(A, p, layer, t, lane, v0, v1, v2, v3, vb);
        if (t1 < T) { b2w_load(A, p, layer, t2 < T ? t2 : t1, lane); b2w_compute(B, p, layer, t1, lane, v0, v1, v2, v3, vb); } }
}
struct PoIn { v4u y, r, k, v, g; };
__device__ __forceinline__ void post_load(PoIn& in, const P& p, int t, int lane) { const bf16* row = WSP(bf16, AR_RW) + (size_t)t * LDRW;
    in.y = *(const v4u*)(WSP(bf16, AR_UB) + (size_t)t * RC + 8 * lane); in.r = *(const v4u*)(row + 8 * lane); in.k = *(const v4u*)(row + 512 + 8 * lane); in.v = *(const v4u*)(row + 1024 + 8 * lane); in.g = *(const v4u*)(WSP(bf16, AR_G) + (size_t)t * RC + 8 * lane); }
__device__ __forceinline__ void post_compute(const PoIn& in, const P& p, int t, int lane, const float* v4_, const float* v5, const float* v6) {
    float y[8], r[8], k[8], v[8], g[8]; up8(in.y, y); uph8(in.r, r); uph8(in.k, k); uph8(in.v, v); up8(in.g, g);
    float s = 0.f, bon = 0.f;
#pragma unroll
    for (int i = 0; i < 8; ++i) { s += y[i]; bon += r[i] * k[i] * v4_[i]; }
    const float m = sum8(s) * (1.f / 64.f); bon = sum8(bon);
    float q = 0.f;
#pragma unroll
    for (int i = 0; i < 8; ++i) { y[i] -= m; q += y[i] * y[i]; }
    const float rstd = 1.f / sqrtf(sum8(q) * (1.f / 64.f) + GN_EPS);
#pragma unroll
    for (int i = 0; i < 8; ++i) y[i] = (y[i] * rstd * v5[i] + v6[i] + bon * v[i]) * g[i];
    *(v4u*)(WSP(bf16, AR_A) + (size_t)t * RC + 8 * lane) = pk8(y);
}
__device__ __forceinline__ void ph_rwkv_postw(const P& p, int layer, int gw, int NGW, int lane) {
    const float* vec = p.rwkv_vec + (size_t)layer * 7 * RC; float v4_[8], v5[8], v6[8]; ldf8(vec + 4 * RC + 8 * lane, v4_); ldf8(vec + 5 * RC + 8 * lane, v5); ldf8(vec + 6 * RC + 8 * lane, v6);
    int t = gw; if (t >= T) return;
    PoIn A, B; post_load(A, p, t, lane);
    for (; t < T; t += 2 * NGW) { const int t1 = t + NGW, t2 = t1 + NGW;
        post_load(B, p, t1 < T ? t1 : t, lane); post_compute(A, p, t, lane, v4_, v5, v6);
        if (t1 < T) { post_load(A, p, t2 < T ? t2 : t1, lane); post_compute(B, p, t1, lane, v4_, v5, v6); } }
}
__device__ __forceinline__ void tr8x8(v4u& w, unsigned selA, bool b1, bool b2) {
    unsigned r[4] = {w.x, w.y, w.z, w.w};
#pragma unroll
    for (int i = 0; i < 4; ++i) { const unsigned pv = (unsigned)__builtin_amdgcn_update_dpp(0, (int)r[i], 0xB1, 0xF, 0xF, true); r[i] = __builtin_amdgcn_perm(pv, r[i], selA); }
#pragma unroll
    for (int a = 0; a < 4; a += 2) { const unsigned send = b1 ? r[a] : r[a + 1]; const unsigned recv = (unsigned)__builtin_amdgcn_update_dpp(0, (int)send, 0x4E, 0xF, 0xF, true);
        r[a] = b1 ? recv : r[a]; r[a + 1] = b1 ? r[a + 1] : recv; }
#pragma unroll
    for (int a = 0; a < 2; ++a) { const unsigned send = b2 ? r[a] : r[a + 2];
        int recv = __builtin_amdgcn_update_dpp(0, (int)send, 0x104, 0xF, 0x5, false);
        recv = __builtin_amdgcn_update_dpp(recv, (int)send, 0x114, 0xF, 0xA, false);
        r[a] = b2 ? (unsigned)recv : r[a]; r[a + 2] = b2 ? r[a + 2] : (unsigned)recv; }
    w.x = r[0]; w.y = r[1]; w.z = r[2]; w.w = r[3];
}
__device__ __forceinline__ void ph_vtransw(const P& p, int gw, int NGW, int lane_in) {
    int lane = lane_in; asm volatile("" : "+v"(lane));
    const bf16* KV = WSP(bf16, AR_KV); bf16* VsT = WSP(bf16, WS_VST); bf16* VwT = WSP(bf16, WS_VWT);
    const int j = lane & 7, c = lane >> 3; const unsigned selA = (lane & 1) ? 0x03020706u : 0x05040100u; const bool b1 = (lane & 2) != 0, b2 = (lane & 4) != 0;
    constexpr int NU = BATCH * NKV * (SEQ / 8);
    for (int u0 = gw * 4; u0 < NU; u0 += NGW * 4) {
        v4u s[4], w[4];
#pragma unroll
        for (int i = 0; i < 4; ++i) { const int u = u0 + i, kg = u % (SEQ / 8), bg = u / (SEQ / 8), b = bg / NKV, g = bg % NKV, tok = (kg >> 2) * 32 + 4 * (kg & 3) + (j & 3) + 16 * (j >> 2);
            const bf16* src = KV + (size_t)(b * SEQ + tok) * LDKV + g * 64 + 8 * c; s[i] = *(const v4u*)(src + 128); w[i] = *(const v4u*)(src + 384); }
#pragma unroll
        for (int i = 0; i < 4; ++i) { tr8x8(s[i], selA, b1, b2); tr8x8(w[i], selA, b1, b2);
            *(v4u*)(VsT + ((size_t)(u0 + i) * 64 + lane) * 8) = s[i]; *(v4u*)(VwT + ((size_t)(u0 + i) * 64 + lane) * 8) = w[i]; }
    }
}
typedef float f32x2 __attribute__((ext_vector_type(2)));
__device__ __forceinline__ f32x2 up2(unsigned w) { f32x2 r; r.x = __builtin_bit_cast(float, w << 16); r.y = __builtin_bit_cast(float, w & 0xffff0000u); return r; }
template <int JJ>
__device__ __forceinline__ void conv_row(f32x2 (&a)[8][4], f32x2 (&wt)[8][4], v4u (&cur)[8], f32x4& wn0, f32x4& wn1, const LAS float* wlane, const bf16* ub, int g, int j0) {
    const int j = 8 * g + JJ;
    wt[JJ][0] = (f32x2){wn0.x, wn0.y}; wt[JJ][1] = (f32x2){wn0.z, wn0.w}; wt[JJ][2] = (f32x2){wn1.x, wn1.y}; wt[JJ][3] = (f32x2){wn1.z, wn1.w};
    { const int jl = j + 1 < CONV_K ? j + 1 : CONV_K - 1; wn0 = *(const LAS f32x4*)(wlane + jl * CONV_CH); wn1 = *(const LAS f32x4*)(wlane + jl * CONV_CH + 4); }
    const unsigned msk = j >= j0 ? 0xffffffffu : 0u;
    f32x2 u[4]; u[0] = up2(cur[JJ].x & msk); u[1] = up2(cur[JJ].y & msk); u[2] = up2(cur[JJ].z & msk); u[3] = up2(cur[JJ].w & msk);
    { int jn = j + 8; jn = jn < j0 ? j0 : jn; jn = jn > CONV_K + 6 ? CONV_K + 6 : jn; cur[JJ] = *(const v4u*)(ub + (size_t)jn * CONV_CH); }
#pragma unroll
    for (int q = 0; q < 8; ++q) { const int tap = j - q; if (tap >= 0 && tap < CONV_K) {
#pragma unroll
        for (int i = 0; i < 4; ++i) a[q][i] = __builtin_elementwise_fma(u[i], wt[(JJ - q) & 7][i], a[q][i]); } }
}
__device__ __forceinline__ void ph_convw(const P& p, int layer, int gw, int NGW, int lane, int tid, LAS unsigned char* lds) {
    const bf16* UB = WSP(bf16, AR_UB); bf16* CO = WSP(bf16, AR_CO);
    const float* cw = p.conv_w + (size_t)layer * CONV_K * CONV_CH; const float* cv = p.conv_vec + (size_t)layer * 3 * CONV_CH;
    LAS float* wl = (LAS float*)lds;
    { f32x4 tw[8];
#pragma unroll
      for (int k = 0; k < 8; ++k) { const int i4 = tid + k * NTHREADS; tw[k] = i4 < CONV_K * CONV_CH / 4 ? *(const f32x4*)(cw + 4 * i4) : *(const f32x4*)(cv + 4 * (i4 - CONV_K * CONV_CH / 4)); }
      f32x4 tl = (f32x4){0.f, 0.f, 0.f, 0.f}; if (tid < 256) tl = *(const f32x4*)(cv + 4 * (tid + 8 * NTHREADS - CONV_K * CONV_CH / 4));
#pragma unroll
      for (int k = 0; k < 8; ++k) *(LAS f32x4*)(wl + 4 * (tid + k * NTHREADS)) = tw[k];
      if (tid < 256) *(LAS f32x4*)(wl + 4 * (tid + 8 * NTHREADS)) = tl; }
    TKQ(7);
    __syncthreads();
    TKQ(8);
    const LAS float* wlane = wl + 8 * lane;
    for (int tb = gw * 8; tb < T; tb += NGW * 8) {
        const int pos0 = tb % SEQ, j0 = pos0 >= 30 ? 0 : 30 - pos0;
        const bf16* ub = UB + ((size_t)tb * CONV_CH + 8 * lane) - (size_t)30 * CONV_CH;
        f32x2 a[8][4], wt[8][4]; v4u cur[8];
        { const f32x4 c0 = *(const LAS f32x4*)(wlane + CONV_K * CONV_CH), c1 = *(const LAS f32x4*)(wlane + CONV_K * CONV_CH + 4);
#pragma unroll
          for (int q = 0; q < 8; ++q) { a[q][0] = (f32x2){c0.x, c0.y}; a[q][1] = (f32x2){c0.z, c0.w}; a[q][2] = (f32x2){c1.x, c1.y}; a[q][3] = (f32x2){c1.z, c1.w}; } }
#pragma unroll
        for (int jj = 0; jj < 8; ++jj) cur[jj] = *(const v4u*)(ub + (size_t)(jj < j0 ? j0 : jj) * CONV_CH);
        f32x4 wn0 = *(const LAS f32x4*)(wlane), wn1 = *(const LAS f32x4*)(wlane + 4);
#pragma unroll 1
        for (int g = 0; g < 5; ++g) {
            conv_row<0>(a, wt, cur, wn0, wn1, wlane, ub, g, j0); conv_row<1>(a, wt, cur, wn0, wn1, wlane, ub, g, j0); conv_row<2>(a, wt, cur, wn0, wn1, wlane, ub, g, j0); conv_row<3>(a, wt, cur, wn0, wn1, wlane, ub, g, j0);
            conv_row<4>(a, wt, cur, wn0, wn1, wlane, ub, g, j0); conv_row<5>(a, wt, cur, wn0, wn1, wlane, ub, g, j0); conv_row<6>(a, wt, cur, wn0, wn1, wlane, ub, g, j0); conv_row<7>(a, wt, cur, wn0, wn1, wlane, ub, g, j0);
        }
        const f32x4 g10 = *(const LAS f32x4*)(wlane + (CONV_K + 1) * CONV_CH), g11 = *(const LAS f32x4*)(wlane + (CONV_K + 1) * CONV_CH + 4);
        const f32x4 b20 = *(const LAS f32x4*)(wlane + (CONV_K + 2) * CONV_CH), b21 = *(const LAS f32x4*)(wlane + (CONV_K + 2) * CONV_CH + 4);
        const f32x2 g1[4] = {(f32x2){g10.x, g10.y}, (f32x2){g10.z, g10.w}, (f32x2){g11.x, g11.y}, (f32x2){g11.z, g11.w}}, b2[4] = {(f32x2){b20.x, b20.y}, (f32x2){b20.z, b20.w}, (f32x2){b21.x, b21.y}, (f32x2){b21.z, b21.w}};
#pragma unroll
        for (int q = 0; q < 8; ++q) {
            const f32x2 s2 = (a[q][0] + a[q][1]) + (a[q][2] + a[q][3]);
            const float mean = wave_sum(s2.x + s2.y, lane) * (1.f / CONV_CH); f32x2 q2 = (f32x2){0.f, 0.f};
#pragma unroll
            for (int i = 0; i < 4; ++i) { a[q][i] -= (f32x2){mean, mean}; q2 = __builtin_elementwise_fma(a[q][i], a[q][i], q2); }
            const float rstd = 1.f / sqrtf(wave_sum(q2.x + q2.y, lane) * (1.f / CONV_CH) + LN_EPS);
            float y[8];
#pragma unroll
            for (int i = 0; i < 4; ++i) { const f32x2 yy = __builtin_elementwise_fma(a[q][i] * (f32x2){rstd, rstd}, g1[i], b2[i]); y[2 * i] = yy.x * fsig(yy.x); y[2 * i + 1] = yy.y * fsig(yy.y); }
            *(v4u*)(CO + (size_t)(tb + q) * CONV_CH + 8 * lane) = pk8(y);
        }
    }
    TKQ(9);
    __syncthreads();
}
__device__ __forceinline__ void ph_cmp2w(const P& p, int layer, int gw, int NGW, int lane, LAS float* hl  ) {
    const bf16* Z = WSP(bf16, AR_HID); const float* pec = (const float*)(p.ws + WS_W + (size_t)layer * SZ_LAYERW + OFF_PEC);
    for (int it = gw; it < 2 * BATCH * NKV * NC; it += NGW) {
        const int i = it % NC, r = it / NC, bg = r % (BATCH * NKV), which = r / (BATCH * NKV);
        const bf16* z1 = Z + ((size_t)which * (BATCH * NKV * 512) + (size_t)bg * 512 + i) * 256; const bf16* z2 = z1 + 256 + 128;
#pragma unroll
        for (int jj = 0; jj < 2; ++jj) { const int j = lane + 64 * jj; const float x = bf2f(z1[j]) + bf2f(z2[j]) + pec[which * 128 + j];
            const float e = __expf(fminf(2.f * 0.7978845608028654f * (x + 0.044715f * x * x * x), 30.f)); hl[j] = 0.5f * x * (1.f + (e - 1.f) / (e + 1.f)); }
        LDS_WAIT(); asm volatile("" ::: "memory");
        const float* w2 = p.cmp_w2 + (size_t)(layer * 2 + which) * 128 * 64 + lane; float o = 0.f;
#pragma unroll 8
        for (int j = 0; j < 128; ++j) o += hl[j] * w2[j * 64];
        if (which == 0) {
            const float rs = 1.f / sqrtf(wave_sum(o * o, lane) * (1.f / 64.f) + RMS_EPS); o = o * rs * p.qk_g[(layer * 4 + 1) * 64 + lane];
            const float other = bperm_f(o, lane ^ 32); float cs, sn; rope_cs(16 * i + 31, lane & 31, cs, sn);
            o = lane < 32 ? o * cs - other * sn : o * cs + other * sn;
            WSP(bf16, AR_KC)[(((size_t)bg * 8 + (lane >> 3)) * 512 + i) * 8 + (lane & 7)] = f2bf(o);
        } else { bf16* vt = WSP(bf16, AR_VCT) + (size_t)bg * 64 * 512 + lane * 8;
            vt[(size_t)((i >> 5) * 4 + ((i & 15) >> 2)) * 512 + (i & 3) + 4 * ((i >> 4) & 1)] = f2bf(o); if (i == 0) vt[(size_t)((NC >> 5) * 4 + ((NC & 15) >> 2)) * 512 + (NC & 3) + 4 * ((NC >> 4) & 1)] = 0; }
        LDS_WAIT(); asm volatile("" ::: "memory");
    }
}

struct MapPlain { bf16* base; int K; __device__ __forceinline__ bf16* operator()(int col) const { return base + (size_t)col * K; } };
struct MapGlu { bf16* base; int K, ff; __device__ __forceinline__ bf16* operator()(int col) const { return base + (size_t)glu_dest(col, ff) * K; } };
struct MapWin { unsigned char* wl; int layer; __device__ __forceinline__ bf16* operator()(int col) const { int which; const int r = win_dest(col, layer, which); const size_t off = (which ? OFF_WG : OFF_WIN) + (size_t)(r < 0 ? 0 : r) * DM * 2; return r < 0 ? nullptr : (bf16*)(wl + off); } };
template <class Map>
__device__ __forceinline__ void transpose_item(const float* W, int K, int N, const Map& mp, LAS float* scr, int item, int lane) {
    const int nblk = (N + 31) / 32, kb = item / nblk, nb = item % nblk, k0 = 64 * kb, n0 = 32 * nb;
    const int c4 = 4 * (lane & 7), col = n0 + c4;
    f32x4 v[8];
#pragma unroll
    for (int i = 0; i < 8; ++i) v[i] = col < N ? *(const f32x4*)(W + (size_t)(k0 + (lane >> 3) + 8 * i) * N + col) : (f32x4){0.f, 0.f, 0.f, 0.f};
#pragma unroll
    for (int i = 0; i < 8; ++i) { LAS float* d = scr + ((lane >> 3) + 8 * i) * 33 + c4; d[0] = v[i].x; d[1] = v[i].y; d[2] = v[i].z; d[3] = v[i].w; }
    LDS_WAIT(); asm volatile("" ::: "memory");
    const int c = lane & 7;
#pragma unroll
    for (int j = 0; j < 4; ++j) { const int n = (lane >> 3) + 8 * j; const LAS float* s = scr + (8 * c) * 33 + n;
        v4u o; o.x = (unsigned)f2bf(s[0]) | ((unsigned)f2bf(s[33]) << 16); o.y = (unsigned)f2bf(s[66]) | ((unsigned)f2bf(s[99]) << 16);
        o.z = (unsigned)f2bf(s[132]) | ((unsigned)f2bf(s[165]) << 16); o.w = (unsigned)f2bf(s[198]) | ((unsigned)f2bf(s[231]) << 16);
        if (n0 + n < N) { bf16* d = mp(n0 + n); if (d) *(v4u*)(d + k0 + 8 * c) = o; } }
    LDS_WAIT(); asm volatile("" ::: "memory");
}
template <class Map>
__device__ __forceinline__ bool conv_job(int& r, const float* W, int K, int N, const Map& mp, LAS float* scr, int lane) {
    const int items = (K / 64) * ((N + 31) / 32);
    if (r < items) { transpose_item(W, K, N, mp, scr, r, lane); return true; }
    r -= items; return false;
}

struct RmsIn { f32x4 v[DM / 256]; };
__device__ __forceinline__ void rms_load(RmsIn& r, const float* xrow, int lane) { const f32x4* xr = (const f32x4*)xrow + lane;
#pragma unroll
    for (int j = 0; j < DM / 256; ++j) r.v[j] = xr[64 * j]; }
__device__ __forceinline__ void rms_row(const P& p, const RmsIn& rin, const float* g, bf16* orow, int lane, bool route, int t, unsigned long long& c0, unsigned long long& c1) {
    const f32x4* gr = (const f32x4*)g + lane;
    f32x4 v[DM / 256]; float ss = 0.f;
#pragma unroll
    for (int j = 0; j < DM / 256; ++j) { v[j] = rin.v[j]; ss += (v[j].x * v[j].x + v[j].y * v[j].y) + (v[j].z * v[j].z + v[j].w * v[j].w); }
    const float rs = 1.f / sqrtf(wave_sum(ss, lane) * (1.f / DM) + RMS_EPS);
    v2u* o8 = (v2u*)orow + lane;
#pragma unroll
    for (int j = 0; j < DM / 256; ++j) { const f32x4 gg = gr[64 * j]; v[j].x *= rs * gg.x; v[j].y *= rs * gg.y; v[j].z *= rs * gg.z; v[j].w *= rs * gg.w;
        v2u w; w.x = cvt_pk_bf16(v[j].x, v[j].y); w.y = cvt_pk_bf16(v[j].z, v[j].w); o8[64 * j] = w; }
    if (route) {
        float lg[NEXP];
#pragma unroll
        for (int e = 0; e < NEXP; ++e) lg[e] = 0.f;
#pragma unroll
        for (int j = 0; j < DM / 256; ++j) { const float* rw = p.router_w + (size_t)(4 * (lane + 64 * j)) * NEXP;
#pragma unroll
            for (int e = 0; e < NEXP; ++e) lg[e] += v[j].x * rw[e] + v[j].y * rw[NEXP + e] + v[j].z * rw[2 * NEXP + e] + v[j].w * rw[3 * NEXP + e]; }
#pragma unroll
        for (int e = 0; e < NEXP; ++e) lg[e] = wave_sum(lg[e], lane) + p.router_b[e];
        int e0 = 0; float l0 = lg[0];
#pragma unroll
        for (int e = 1; e < NEXP; ++e) if (lg[e] > l0) { l0 = lg[e]; e0 = e; }
        int e1 = -1; float l1 = -3e38f;
#pragma unroll
        for (int e = 0; e < NEXP; ++e) if (e != e0 && lg[e] > l1) { l1 = lg[e]; e1 = e; }
        e0 = __builtin_amdgcn_readfirstlane(e0); e1 = __builtin_amdgcn_readfirstlane(e1);
        const int r0 = (int)((c0 >> (8 * e0)) & 255ull), r1 = (int)((c1 >> (8 * e1)) & 255ull);
        c0 += 1ull << (8 * e0); c1 += 1ull << (8 * e1);
        if (lane == 0) { const float w0 = 1.f / (1.f + expf(l1 - l0));
            WSP(int, AR_RTE)[t] = e0 | (e1 << 8) | (r0 << 16) | (r1 << 24); float* rw = WSP(float, AR_RTW) + (size_t)t * 2; rw[0] = w0; rw[1] = 1.f - w0; }
    }
}
__device__ __forceinline__ void rms_row_route(const P& p, const RmsIn& rin, const float* g, bf16* orow, int lane, int t, unsigned long long& c0, unsigned long long& c1, const float (&rwr)[128]) {
    const f32x4* gr = (const f32x4*)g + lane;
    f32x4 v[DM / 256]; float ss = 0.f;
#pragma unroll
    for (int j = 0; j < DM / 256; ++j) { v[j] = rin.v[j]; ss += (v[j].x * v[j].x + v[j].y * v[j].y) + (v[j].z * v[j].z + v[j].w * v[j].w); }
    const float rs = 1.f / sqrtf(wave_sum(ss, lane) * (1.f / DM) + RMS_EPS);
    v2u* o8 = (v2u*)orow + lane;
#pragma unroll
    for (int j = 0; j < DM / 256; ++j) { const f32x4 gg = gr[64 * j]; v[j].x *= rs * gg.x; v[j].y *= rs * gg.y; v[j].z *= rs * gg.z; v[j].w *= rs * gg.w;
        v2u w; w.x = cvt_pk_bf16(v[j].x, v[j].y); w.y = cvt_pk_bf16(v[j].z, v[j].w); o8[64 * j] = w; }
    float lg[NEXP];
#pragma unroll
    for (int e = 0; e < NEXP; ++e) lg[e] = 0.f;
#pragma unroll
    for (int j = 0; j < DM / 256; ++j)
#pragma unroll
        for (int e = 0; e < NEXP; ++e) lg[e] += v[j].x * rwr[(4 * j) * 8 + e] + v[j].y * rwr[(4 * j + 1) * 8 + e] + v[j].z * rwr[(4 * j + 2) * 8 + e] + v[j].w * rwr[(4 * j + 3) * 8 + e];
    float r4[4], r2[2], r1;
    { const bool hi = (lane & 32) != 0;
#pragma unroll
      for (int i = 0; i < 4; ++i) { const float mine = hi ? lg[4 + i] : lg[i], theirs = hi ? lg[i] : lg[4 + i]; r4[i] = mine + bperm_f(theirs, lane ^ 32); } }
    { const bool hi = (lane & 16) != 0;
#pragma unroll
      for (int i = 0; i < 2; ++i) { const float mine = hi ? r4[2 + i] : r4[i], theirs = hi ? r4[i] : r4[2 + i]; r2[i] = mine + bperm_f(theirs, lane ^ 16); } }
    { const bool hi = (lane & 8) != 0; const float mine = hi ? r2[1] : r2[0], theirs = hi ? r2[0] : r2[1]; r1 = mine + bperm_f(theirs, lane ^ 8); }
    r1 += bperm_f(r1, lane ^ 4); r1 += bperm_f(r1, lane ^ 2); r1 += bperm_f(r1, lane ^ 1);
#pragma unroll
    for (int e = 0; e < NEXP; ++e) lg[e] = __builtin_bit_cast(float, __builtin_amdgcn_readlane(__builtin_bit_cast(int, r1), 8 * e)) + p.router_b[e];
    int e0 = 0; float l0 = lg[0];
#pragma unroll
    for (int e = 1; e < NEXP; ++e) if (lg[e] > l0) { l0 = lg[e]; e0 = e; }
    int e1 = -1; float l1 = -3e38f;
#pragma unroll
    for (int e = 0; e < NEXP; ++e) if (e != e0 && lg[e] > l1) { l1 = lg[e]; e1 = e; }
    e0 = __builtin_amdgcn_readfirstlane(e0); e1 = __builtin_amdgcn_readfirstlane(e1);
    const int r0 = (int)((c0 >> (8 * e0)) & 255ull), r1i = (int)((c1 >> (8 * e1)) & 255ull);
    c0 += 1ull << (8 * e0); c1 += 1ull << (8 * e1);
    if (lane == 0) { const float w0 = 1.f / (1.f + expf(l1 - l0));
        WSP(int, AR_RTE)[t] = e0 | (e1 << 8) | (r0 << 16) | (r1i << 24); float* rw = WSP(float, AR_RTW) + (size_t)t * 2; rw[0] = w0; rw[1] = 1.f - w0; }
}
__device__ __forceinline__ void copy_rows4(const bf16* s0, const bf16* s1, const bf16* s2, const bf16* s3, bf16* d0, bf16* d1, bf16* d2, bf16* d3, int lane) {
    v4u a[4][DM / 512];
#pragma unroll
    for (int j = 0; j < DM / 512; ++j) { a[0][j] = ((const v4u*)s0)[lane + 64 * j]; a[1][j] = ((const v4u*)s1)[lane + 64 * j]; a[2][j] = ((const v4u*)s2)[lane + 64 * j]; a[3][j] = ((const v4u*)s3)[lane + 64 * j]; }
#pragma unroll
    for (int j = 0; j < DM / 512; ++j) { ((v4u*)d0)[lane + 64 * j] = a[0][j]; ((v4u*)d1)[lane + 64 * j] = a[1][j]; ((v4u*)d2)[lane + 64 * j] = a[2][j]; ((v4u*)d3)[lane + 64 * j] = a[3][j]; }
}
__device__ __forceinline__ void copy_row_wave(const bf16* src, bf16* dst, int lane) {
#pragma unroll
    for (int j = 0; j < DM / 512; ++j) ((v4u*)dst)[lane + 64 * j] = ((const v4u*)src)[lane + 64 * j];
}
__device__ __forceinline__ int moe_seg_start(const unsigned* cnt, int e) { int s = 0;
#pragma unroll
    for (int k = 0; k < NEXP; ++k) s += (k < e) ? (int)((cnt[k] + 255u) & ~255u) : 0;
    return s; }

#ifndef STAG_GATE
#define STAG_GATE 700
#endif
__device__ __forceinline__ void stagger_start(int bid, int ticks) {
    const unsigned long long t0 = __builtin_amdgcn_s_memrealtime(), dl = (unsigned long long)(((bid >> 3) & 3) * ticks);
    while (__builtin_amdgcn_s_memrealtime() - t0 < dl) __builtin_amdgcn_s_sleep(16);
}
#ifndef PHMASK
#define PHMASK 0xFFFFFFFFu
#endif
#define PHM(k) (((PHMASK) >> (k)) & 1u)
#ifdef PROBE_LO
constexpr int PR_LO = PROBE_LO, PR_HI = PROBE_HI;
#else
constexpr int PR_LO = -1, PR_HI = -1;
#endif
constexpr int NPH = 16, NPHASES = 1 + 2 * NPH;
struct Args { const float* in[29]; float* out; unsigned char* ws; int ph_lo, ph_hi; };

__device__ __forceinline__ bool in_phase(int k, int lo, int hi) { asm volatile("" : "+s"(lo), "+s"(hi)); return lo <= k && k < hi; }
typedef const Args __attribute__((address_space(4)))* CArgsP;
__device__ __forceinline__ void fill_params_k(P& p, CArgsP a) {
    p.x = a->in[0]; p.mix_norm_g = a->in[1]; p.w_in_first = a->in[2]; p.w_in_rest = a->in[3]; p.mu_first = a->in[4]; p.mu_rest = a->in[5]; p.qk_g = a->in[6]; p.cmp_pos = a->in[7];
    p.cmp_w1 = a->in[8]; p.cmp_w2 = a->in[9]; p.nsa_w_o = a->in[10]; p.conv_w = a->in[11]; p.conv_vec = a->in[12]; p.conv_w_o = a->in[13]; p.rwkv_vec = a->in[14]; p.w_up = a->in[15];
    p.a_up = a->in[16]; p.g_up = a->in[17]; p.vres_up = a->in[18]; p.vres_b = a->in[19]; p.rwkv_w_o = a->in[20]; p.w_out = a->in[21]; p.ffn_norm_g = a->in[22]; p.dense_gu = a->in[23];
    p.dense_down = a->in[24]; p.router_w = a->in[25]; p.router_b = a->in[26]; p.moe_gu = a->in[27]; p.moe_down = a->in[28]; p.out = a->out; p.ws = a->ws;
}
__global__ void __launch_bounds__(NTHREADS, 2) mk_fwd(Args args) {
    extern __shared__ __attribute__((aligned(16))) unsigned char lds_raw[];
    LAS unsigned char* lds = (LAS unsigned char*)lds_raw;
    const int wave0 = __builtin_amdgcn_readfirstlane((int)threadIdx.x >> 6);
    const int tid = wave0 * 64 + lane_id_opaque();
    unsigned* ctl = (unsigned*)(args.ws + WS_CTL);
    for (int u = tid; u < (LDS_BYTES - LDSCTL_OFF) / 4; u += NTHREADS) ((LAS unsigned*)(lds + LDSCTL_OFF))[u] = 0u;
    __syncthreads();
    const int lo = args.ph_lo, hi = args.ph_hi;
    XcdBarrier bar; bar.bar = ctl + CW_BAR; bar.x = 0; bar.st = nullptr;
    if (hi - lo > 1) { bar.x = xb_xcc_id(); bar.st = (volatile LAS unsigned*)(lds + MISC_OFF) + 8; if (tid == 0) (void)xb_add(ctl + CW_BAR + XB_XCNT(bar.x), 1u); }
#define RMS_LOOP(X, GN, ROUTE, C0, C1) do { int m_ = gw; if (m_ < T) { RmsIn ra_, rb_; rms_load(ra_, (X) + (size_t)m_ * DM, lane); \
        for (; m_ < T; m_ += 2 * NGW) { const int m1_ = m_ + NGW, m2_ = m1_ + NGW; rms_load(rb_, (X) + (size_t)(m1_ < T ? m1_ : m_) * DM, lane); \
            rms_row(p, ra_, (GN), WSP(bf16, WS_H) + (size_t)m_ * DM, lane, (ROUTE), m_, C0, C1); \
            if (m1_ < T) { rms_load(ra_, (X) + (size_t)(m2_ < T ? m2_ : m1_) * DM, lane); rms_row(p, rb_, (GN), WSP(bf16, WS_H) + (size_t)m1_ * DM, lane, (ROUTE), m1_, C0, C1); } } } } while (0)
#define RMS_LOOP_R(X, GN, C0, C1, RWR) do { int m_ = gw; if (m_ < T) { RmsIn ra_, rb_; rms_load(ra_, (X) + (size_t)m_ * DM, lane); \
        for (; m_ < T; m_ += 2 * NGW) { const int m1_ = m_ + NGW, m2_ = m1_ + NGW; rms_load(rb_, (X) + (size_t)(m1_ < T ? m1_ : m_) * DM, lane); \
            rms_row_route(p, ra_, (GN), WSP(bf16, WS_H) + (size_t)m_ * DM, lane, m_, C0, C1, RWR); \
            if (m1_ < T) { rms_load(ra_, (X) + (size_t)(m2_ < T ? m2_ : m1_) * DM, lane); rms_row_route(p, rb_, (GN), WSP(bf16, WS_H) + (size_t)m1_ * DM, lane, m1_, C0, C1, RWR); } } } } while (0)
#define IN(k) (in_phase((k), lo, hi) && (PR_LO < 0 || (st == 0 ? (k) <= PR_HI : (st == 1 ? ((k) >= PR_LO && (k) <= PR_HI) : (k) > PR_HI))))
#define MKP unsigned long long cdum0 = 0ull, cdum1 = 0ull; (void)cdum0; (void)cdum1; CArgsP ap_ = (CArgsP)__builtin_amdgcn_kernarg_segment_ptr(); asm volatile("" : "+s"(ap_)); P p; fill_params_k(p, ap_); int w0_ = wave0; asm volatile("" : "+s"(w0_)); int tid = w0_ * 64 + lane_id_opaque(); asm volatile("" : "+v"(tid)); const int lane = tid & 63, wave = __builtin_amdgcn_readfirstlane(tid >> 6); int G = gridDim.x, bid = blockIdx.x; asm volatile("" : "+s"(G), "+s"(bid)); unsigned* ctl = WSP(unsigned, WS_CTL); const long gtid = (long)bid * NTHREADS + tid, NT = (long)G * NTHREADS; const int gw = bid * NWAVES + wave, NGW = G * NWAVES; LAS float* scrw = (LAS float*)(lds + wave * 16384); (void)gtid; (void)NT; (void)gw; (void)NGW; (void)scrw; (void)lane; (void)ctl
#ifdef PROBE_TK
#define TKW(i) do { if (blockIdx.x == PROBE_BLK && threadIdx.x == 0) ((unsigned long long*)(args.ws + WS_CTL + 4 * CW_TK))[(i)] = __builtin_amdgcn_s_memrealtime(); } while (0)
#define TKP(i) do { if (layer == PROBE_LAYER) TKW(i); } while (0)
#define TKB() do { if (layer == PROBE_LAYER && threadIdx.x == 0) ((unsigned long long*)(args.ws + WS_CTL + 4 * CW_TK))[32 + blockIdx.x] = __builtin_amdgcn_s_memrealtime(); } while (0)
#define SEAM(k) do { if ((k) + 1 < hi) { int w_ = wave0; asm volatile("" : "+s"(w_)); xcd_barrier(bar, w_ * 64 + lane_id_opaque()); } \
    if ((k) == PROBE_TK) TKW(1); if ((k) == PROBE_TK - 1) TKW(0); } while (0)
#else
#define TKP(i) do { } while (0)
#define TKB() do { } while (0)
#define SEAM(k) do { if ((k) + 1 < hi) { int w_ = wave0; asm volatile("" : "+s"(w_)); xcd_barrier(bar, w_ * 64 + lane_id_opaque()); } } while (0)
#endif

    for (int st = 0; st < (PR_LO >= 0 ? 3 : 1); ++st) {
    if (PHM(16) && IN(0)) { MKP;
        constexpr int IT_WIN0 = (DM / 64) * ((N_IN_FIRST + 31) / 32), IT_WIN1 = (DM / 64) * ((N_IN_REST + 31) / 32), IT_WO = (512 / 64) * (DM / 32), IT_WOUT = (DM / 64) * (DM / 32);
        constexpr int total = IT_WIN0 + IT_WIN1 + 6 * IT_WO + 2 * IT_WOUT + (DM / 64) * (2 * DENSE_FF / 32) + (DENSE_FF / 64) * (DM / 32);
        bf16* wl0 = WSP(bf16, WS_W); bf16* wl1 = WSP(bf16, WS_W + SZ_LAYERW);
#define WOFF(b, o) ((bf16*)((unsigned char*)(b) + (o)))
        for (int it = gw; it < total; it += NGW) {
            int r = it;
            if (conv_job(r, p.w_in_first, DM, N_IN_FIRST, MapWin{(unsigned char*)wl0, 0}, scrw, lane)) continue;
            if (conv_job(r, p.w_in_rest, DM, N_IN_REST, MapWin{(unsigned char*)wl1, 1}, scrw, lane)) continue;
            if (conv_job(r, p.nsa_w_o, 512, DM, MapPlain{WOFF(wl0, OFF_WO3), 512}, scrw, lane)) continue;
            if (conv_job(r, p.rwkv_w_o, 512, DM, MapPlain{WOFF(wl0, OFF_WO3) + (size_t)DM * 512, 512}, scrw, lane)) continue;
            if (conv_job(r, p.conv_w_o, 512, DM, MapPlain{WOFF(wl0, OFF_WO3) + (size_t)2 * DM * 512, 512}, scrw, lane)) continue;
            if (conv_job(r, p.nsa_w_o + (size_t)512 * DM, 512, DM, MapPlain{WOFF(wl1, OFF_WO3), 512}, scrw, lane)) continue;
            if (conv_job(r, p.rwkv_w_o + (size_t)512 * DM, 512, DM, MapPlain{WOFF(wl1, OFF_WO3) + (size_t)DM * 512, 512}, scrw, lane)) continue;
            if (conv_job(r, p.conv_w_o + (size_t)512 * DM, 512, DM, MapPlain{WOFF(wl1, OFF_WO3) + (size_t)2 * DM * 512, 512}, scrw, lane)) continue;
            if (conv_job(r, p.w_out, DM, DM, MapPlain{WOFF(wl0, OFF_WOUT), DM}, scrw, lane)) continue;
            if (conv_job(r, p.w_out + (size_t)DM * DM, DM, DM, MapPlain{WOFF(wl1, OFF_WOUT), DM}, scrw, lane)) continue;
            if (conv_job(r, p.dense_gu, DM, 2 * DENSE_FF, MapGlu{WSP(bf16, WS_DGU), DM, DENSE_FF}, scrw, lane)) continue;
            conv_job(r, p.dense_down, DENSE_FF, DM, MapPlain{WSP(bf16, WS_DDN), DENSE_FF}, scrw, lane);
        }
        for (int l = 0; l < 2; ++l) {
            unsigned char* wlb = p.ws + WS_W + (size_t)l * SZ_LAYERW;
            bf16* win = (bf16*)(wlb + OFF_WIN);
            for (long i = gtid; i < 512L * DM; i += NT) { const int w = (int)(i / DM); const bool src = w < 288 || (w < 320 && l == 1) || (w >= 320 && w < 344); if (!src) win[(size_t)(3840 + w) * DM + i % DM] = 0; }
            bf16* lw = (bf16*)(wlb + OFF_LW);
            for (long i = gtid; i < 2048L * 384; i += NT) { const int n = (int)(i / 384), k = (int)(i % 384), blk = n >> 9, c = n & 511; float v = 0.f;
                if (blk == 0 && k < 64) v = p.w_up[((size_t)l * 64 + k) * RC + c]; else if (blk == 1 && k >= 64 && k < 128) v = p.a_up[((size_t)l * 64 + k - 64) * RC + c];
                else if (blk == 2 && k >= 128 && k < 288) v = p.g_up[((size_t)l * 160 + k - 128) * RC + c]; else if (blk == 3 && k >= 288 && k < 320 && l == 1) v = p.vres_up[(size_t)(k - 288) * RC + c];
                lw[i] = f2bf(v); }
            bf16* cw1 = (bf16*)(wlb + OFF_CW1);
            for (long i = gtid; i < 2L * 256 * 1024; i += NT) { const int k = (int)(i % 1024), n = (int)((i / 1024) % 256), which = (int)(i / (256 * 1024));
                cw1[i] = f2bf(p.cmp_w1[((size_t)(l * 2 + which) * 2048 + (n < 128 ? k : 1024 + k)) * 128 + (n & 127)]); }
        }
        for (int job = bid; job < 4; job += G) { const int l = job >> 1, which = job & 1;
            const float* pe = p.cmp_pos + (size_t)(l * 2 + which) * 2048; const float* w1 = p.cmp_w1 + (size_t)(l * 2 + which) * 2048 * 128 + 2 * lane;
            float s0 = 0.f, s1 = 0.f;
#pragma unroll 8
            for (int k = wave * 256; k < wave * 256 + 256; ++k) { const float2 wv = *(const float2*)(w1 + (size_t)k * 128); const float pk = pe[k]; s0 += pk * wv.x; s1 += pk * wv.y; }
            scrw[2 * lane] = s0; scrw[2 * lane + 1] = s1;
            __syncthreads();
            if (tid < 128) { float sum = 0.f;
#pragma unroll
                for (int w = 0; w < NWAVES; ++w) sum += ((const LAS float*)(lds + w * 16384))[tid];
                ((float*)(p.ws + WS_W + (size_t)l * SZ_LAYERW + OFF_PEC))[which * 128 + tid] = sum; }
            __syncthreads();
        }
    }

    for (int layer = 0; layer < 2; ++layer) {
        const int pb = 1 + layer * NPH;
        if (PHM(0) && IN(pb + 0)) { MKP;
            const float* xin = layer == 0 ? p.x : p.out;
            RMS_LOOP(xin, p.mix_norm_g + (size_t)layer * DM, false, cdum0, cdum1);
            SEAM(pb + 0);
        }
        if (PHM(1) && IN(pb + 1)) { MKP;
            Gemm g{WSP(bf16, WS_H), (const bf16*)(p.ws + WS_W + (size_t)layer * SZ_LAYERW + OFF_WIN), T, NPROJ, DM}; SOrder S; S.init(T, NPROJ, G, bid);
            EpiProj E{p.ws};
            pg8::gemm_phase<EpiProj, SOrder, true, true>(lds, g, S, E, tid);
            SEAM(pb + 1);
        }
        if (PHM(2) && IN(pb + 2)) { MKP;
            { Gemm g{WSP(bf16, AR_CKV), (const bf16*)(p.ws + WS_W + (size_t)layer * SZ_LAYERW + OFF_CW1), 2 * BATCH * NKV * 512, 512, 1024, 0}; StackOrder S{BATCH * NKV * 512 / 256, 1, 2, G, bid};
              EpiStore E{WSP(bf16, AR_HID), 256, 1};
              pg8::gemm_phase<EpiStore, StackOrder, true, true>(lds, g, S, E, tid); }
            TKP(2); ph_shift(p, layer, gtid, NT); TKP(3); ph_nsa_prep(p, layer, gtid, NT); TKP(4); ph_vtransw(p, gw, NGW, lane); TKP(5);
            ph_convw(p, layer, gw, NGW, lane, tid, lds); TKP(6); TKB();
#ifdef APROBE_CONV
            ph_convw(p, layer, gw, NGW, lane, tid, lds);
#endif
#ifdef APROBE_VT
            ph_vtransw(p, gw, NGW, lane);
#endif
            SEAM(pb + 2); }
        if (PHM(3) && IN(pb + 3)) { MKP;
#ifndef LORA_NAIVE
            { const bf16* LBp = WSP(bf16, WS_LB); const bf16* LWp = (const bf16*)(p.ws + WS_W + (size_t)layer * SZ_LAYERW + OFF_LW);
              { Gemm g{LBp, LWp, T, 1024, 128, 384, 384}; SOrder S; S.init(T, 1024, G, bid); EpiLora E{p.ws, 0}; pg8::gemm_phase<EpiLora, SOrder, false, true>(lds, g, S, E, tid); }
              { Gemm g{LBp + 128, LWp + (size_t)1024 * 384 + 128, T, 512, 256, 384, 384}; SOrder S; S.init(T, 512, G, bid); EpiLora E{p.ws, 4}; pg8::gemm_phase<EpiLora, SOrder, false, true>(lds, g, S, E, tid); }
              if (layer == 1) { Gemm g{LBp + 256, LWp + (size_t)1536 * 384 + 256, T, 512, 128, 384, 384}; SOrder S; S.init(T, 512, G, bid); EpiLora E{p.ws, 6}; pg8::gemm_phase<EpiLora, SOrder, false, true>(lds, g, S, E, tid); } }
#else
            { bf16* RW = WSP(bf16, AR_RW); bf16* Wm = WSP(bf16, AR_W); bf16* Am = WSP(bf16, AR_A); bf16* Gm = WSP(bf16, AR_G); const bf16* VF = WSP(bf16, WS_VF);
              const float* vec = p.rwkv_vec + (size_t)layer * 7 * RC; const float* wup = p.w_up + (size_t)layer * 64 * RC; const float* aup = p.a_up + (size_t)layer * 64 * RC; const float* gup = p.g_up + (size_t)layer * 160 * RC;
              for (long it = gtid; it < (long)T * RC; it += NT) { const int t = (int)(it / RC), c = (int)(it % RC); bf16* row = RW + (size_t)t * LDRW; const bf16* L = row + LBLK;
                  float wl = vec[c], alin = vec[RC + c], g = 0.f;
                  for (int j = 0; j < 64; ++j) { wl += bf2f(L[j]) * bf2f(f2bf(wup[j * RC + c])); alin += bf2f(L[64 + j]) * bf2f(f2bf(aup[j * RC + c])); }
                  for (int j = 0; j < 160; ++j) g += bf2f(L[128 + j]) * bf2f(f2bf(gup[j * RC + c]));
                  const float nx = -wl, sp = fmaxf(nx, 0.f) + __logf(1.f + __expf(-fabsf(nx))), e = __expf(-sp - 0.5f);
                  Wm[it] = f2bf(1.f - __expf(-e)); Am[it] = f2bf(fsig(alin)); Gm[it] = f2bf(g);
                  if (layer == 1) { float vl = p.vres_b[c]; for (int j = 0; j < 32; ++j) vl += bf2f(L[288 + j]) * bf2f(f2bf(p.vres_up[j * RC + c]));
                      const float v = bf2f(row[1024 + c]), vf = bf2f(VF[it]); row[1024 + c] = f2bf(v + (vf - v) * fsig(vl)); } } }
#endif
            SEAM(pb + 3); }
        if (PHM(4) && IN(pb + 4)) { MKP; ph_rwkv_b2w(p, layer, gw, NGW, lane); ph_cmp2w(p, layer, gw, NGW, lane, (LAS float*)(lds + wave * 512)); SEAM(pb + 4); }
        if (PHM(5) && IN(pb + 5)) { MKP;
            { LAS unsigned char* wl = lds + wave * AW_BYTES; constexpr int NSC = BATCH * 8 * 16, NIT = BATCH * NKV * (SEQ / 16);
#ifndef SCAN_QUEUE
              if (wave < 4) {
                  if (G * 4 == NSC && (G & 7) == 0) scan_unit(p, (bid & 7) * (NSC / 8) + (bid >> 3) * 4 + wave, lane, wl);
                  else for (int u = bid * 4 + wave; u < NSC; u += G * 4) scan_unit(p, u, lane, wl); }
#endif
#ifdef APROBE_SPLIT
              xcd_barrier(bar, tid);
#endif
              const int xme = (int)(xb_xcc_id() & 7u);
              for (int qq = 0; qq < 8; ++qq) { const int qx = (xme + qq) & 7; unsigned* head = ctl + CW_ATT + ((layer * 3 + st) * 8 + qx) * 16;
                  for (;;) { int it = 0; if (lane == 0) it = (int)atomicAdd(head, 1u); it = __builtin_amdgcn_readfirstlane(it); if (it >= NIT / 8) break;
                      const int bg = 2 * qx + it / (SEQ / 16), t16 = (SEQ / 16 - 1) - it % (SEQ / 16);
                      nsa_attn_item(p, bg * (SEQ / 16) + t16, lane, wl); } } }
 SEAM(pb + 5); }
        if (PHM(6) && IN(pb + 6)) { MKP; ph_rwkv_postw(p, layer, gw, NGW, lane); SEAM(pb + 6); }
        if (PHM(7) && IN(pb + 7)) { MKP;
            Gemm g{WSP(bf16, AR_QB), (const bf16*)(p.ws + WS_W + (size_t)layer * SZ_LAYERW + OFF_WO3), 3 * T, 3 * DM, 512}; StackOrder S{T / 256, DM / 256, 3, G, bid};
            EpiStore E{WSP(bf16, AR_OBUF), DM, DM / 256};
            pg8::gemm_phase<EpiStore, StackOrder, true, true>(lds, g, S, E, tid);
            { MKP; const float* xin = layer == 0 ? p.x : p.out;
              RMS_LOOP(xin, p.mix_norm_g + (size_t)layer * DM, false, cdum0, cdum1); }
            SEAM(pb + 7);
        }
        if (PHM(8) && IN(pb + 8)) { MKP;
            Gemm g{WSP(bf16, WS_H), (const bf16*)(p.ws + WS_W + (size_t)layer * SZ_LAYERW + OFF_WG), T, 3 * DM, DM}; GateOrder S{T / 256, DM / 256, G, bid};
            EpiGate E{p.ws, DM / 256};
            pg8::gemm_phase<EpiGate, GateOrder, true, true>(lds, g, S, E, tid);
            SEAM(pb + 8);
        }
        if (PHM(9) && IN(pb + 9)) { MKP;
            Gemm g{WSP(bf16, AR_MIX), (const bf16*)(p.ws + WS_W + (size_t)layer * SZ_LAYERW + OFF_WOUT), T, DM, DM}; SOrder S; S.init(T, DM, G, bid);
            EpiResid E{layer == 0 ? p.x : p.out, p.out};
            pg8::gemm_phase<EpiResid, SOrder, true, true>(lds, g, S, E, tid);
            SEAM(pb + 9);
        }
        if (PHM(10) && IN(pb + 10)) { MKP;
            unsigned long long c0 = 0ull, c1 = 0ull;
            if (layer == 1) { float rwr[128];
#pragma unroll
                for (int j = 0; j < DM / 256; ++j)
#pragma unroll
                    for (int k = 0; k < 8; ++k) { const f32x4 w4 = *(const f32x4*)(p.router_w + (size_t)(4 * (lane + 64 * j)) * NEXP + 4 * k); rwr[j * 32 + 4 * k] = w4.x; rwr[j * 32 + 4 * k + 1] = w4.y; rwr[j * 32 + 4 * k + 2] = w4.z; rwr[j * 32 + 4 * k + 3] = w4.w; }
                RMS_LOOP_R(p.out, p.ffn_norm_g + (size_t)layer * DM, c0, c1, rwr);
            } else RMS_LOOP(p.out, p.ffn_norm_g + (size_t)layer * DM, false, c0, c1);
            if (layer == 1 && lane < 16) {
                const unsigned cn = (unsigned)(((lane < 8 ? c0 : c1) >> (8 * (lane & 7))) & 255ull);
                WSP(unsigned, AR_WBASE)[(size_t)gw * 16 + lane] = atomicAdd(ctl + CW_CNT + lane * 64, cn); }
            if (layer == 1) { int* rt = WSP(int, AR_RTOK); for (long i = gtid; i < 2L * MOE_ROWS; i += NT) rt[i] = -1; }
            SEAM(pb + 10);
        }
        if (layer == 0) {
            if (PHM(11) && IN(pb + 11)) { MKP;
                Gemm g{WSP(bf16, WS_H), WSP(bf16, WS_DGU), T, 2 * DENSE_FF, DM}; SOrder S; S.init(T, 2 * DENSE_FF, G, bid);
                EpiSwiglu E{WSP(bf16, AR_ACT), DENSE_FF, 2 * DENSE_FF / 256};
                pg8::gemm_phase<EpiSwiglu, SOrder, true, true>(lds, g, S, E, tid);
                SEAM(pb + 11);
            }
            if (PHM(12) && IN(pb + 12)) { MKP;
                Gemm g{WSP(bf16, AR_ACT), WSP(bf16, WS_DDN), T, DM, DENSE_FF}; SOrder S; S.init(T, DM, G, bid);
                EpiResid E{p.out, p.out};
                pg8::gemm_phase<EpiResid, SOrder, true, true>(lds, g, S, E, tid);
                SEAM(pb + 12);
            }
        } else {
            if (PHM(11) && IN(pb + 11)) { MKP;
                const int ig = (DM / 64) * (2 * EXPERT_FF / 32), id = (EXPERT_FF / 64) * (DM / 32);
                for (int it = gw; it < NEXP * (ig + id); it += NGW) { const int e = it / (ig + id); int r = it % (ig + id);
                    if (conv_job(r, p.moe_gu + (size_t)e * DM * 2 * EXPERT_FF, DM, 2 * EXPERT_FF, MapGlu{WSP(bf16, AR_MGU) + (size_t)e * 2 * EXPERT_FF * DM, DM, EXPERT_FF}, scrw, lane)) continue;
                    conv_job(r, p.moe_down + (size_t)e * EXPERT_FF * DM, EXPERT_FF, DM, MapPlain{WSP(bf16, AR_MDN) + (size_t)e * DM * EXPERT_FF, EXPERT_FF}, scrw, lane); }
                int* rtok = WSP(int, AR_RTOK); float* rww = WSP(float, AR_RW8); int* trow = WSP(int, AR_TROW);
                int segv = 0; { const int pc = lane < 16 ? (int)((ctl[CW_CNT + lane * 64] + 255u) & ~255u) : 0;
#pragma unroll
                    for (int k = 0; k < 8; ++k) { const int ck = bperm_i(pc, (lane & 8) + k); segv += (k < (lane & 7)) ? ck : 0; } }
                for (int hb = gw; hb < 2 * (T / 64); hb += NGW) {
                    const int tb = (hb >> 1) * 64, half = hb & 1, t = tb + lane; const int ee = WSP(int, AR_RTE)[t], e0 = ee & 255, e1 = (ee >> 8) & 255, r0 = (ee >> 16) & 255, r1 = (ee >> 24) & 255;
                    const float* w = WSP(float, AR_RTW) + (size_t)t * 2; const unsigned* wb = WSP(unsigned, AR_WBASE) + (size_t)(t % NGW) * 16;
                    const int row0 = bperm_i(segv, e0) + (int)wb[e0] + r0, row1 = bperm_i(segv, 8 + e1) + (int)wb[8 + e1] + r1;
                    if (half == 0) { rtok[row0] = t; rww[row0] = w[0]; rtok[MOE_ROWS + row1] = t; rww[MOE_ROWS + row1] = w[1]; trow[T + t] = row1; }
                    for (int l = 32 * half; l < 32 * half + 32; l += 4) { const bf16* hs = WSP(bf16, WS_H) + (size_t)(tb + l) * DM; bf16* xg = WSP(bf16, AR_XG);
                        copy_rows4(hs, hs + DM, hs + 2 * DM, hs + 3 * DM, xg + (size_t)__builtin_amdgcn_readlane(row0, l) * DM, xg + (size_t)__builtin_amdgcn_readlane(row0, l + 1) * DM, xg + (size_t)__builtin_amdgcn_readlane(row0, l + 2) * DM, xg + (size_t)__builtin_amdgcn_readlane(row0, l + 3) * DM, lane); }
                }
                SEAM(pb + 11);
            }
#pragma unroll
            for (int pass = 0; pass < 2; ++pass) {
                if (PHM(12) && IN(pb + 12 + 2 * pass)) { MKP;
                    Gemm g{WSP(bf16, AR_XG), WSP(bf16, AR_MGU), MOE_ROWS, NEXP * 2 * EXPERT_FF, DM}; MoeOrder S; S.init(ctl + CW_CNT + 8 * 64 * pass, 2 * EXPERT_FF / 256, G, bid);
                    EpiSwiglu E{WSP(bf16, AR_MACT), EXPERT_FF, 2 * EXPERT_FF / 256};
                    if (pass == 1) {
                        MoeOrder S0; S0.init(ctl + CW_CNT, DM / 256, G, bid); const int nwg = S0.s.nwg, mainw = (nwg / G) * G, ttiles = nwg - mainw;
                        if (bar.st != nullptr && (G & 31) == 0 && mainw > 0 && ttiles > 0 && ttiles <= 32) {
                            EpiMoeDown E0{p.out, WSP(int, AR_RTOK), WSP(float, AR_RW8), DM / 256, (PR_LO >= 0 && st == 0 && pb + 14 >= PR_LO && pb + 14 <= PR_HI) ? 0.f : 1.f};
                            for (int job = wave * G + bid; job < ttiles * 32; job += NWAVES * G) moe_tail_combine(E0, S0, WSP(float, WS_PART), mainw / (DM / 256), job, lane); } }
                    pg8::gemm_phase<EpiSwiglu, MoeOrder, true, true>(lds, g, S, E, tid);
                    SEAM(pb + 12 + 2 * pass);
                }
                if (PHM(13) && IN(pb + 13 + 2 * pass)) { MKP;
                    Gemm g{WSP(bf16, AR_MACT), WSP(bf16, AR_MDN), MOE_ROWS, NEXP * DM, EXPERT_FF}; MoeOrder S; S.init(ctl + CW_CNT + 8 * 64 * pass, DM / 256, G, bid);
                    EpiMoeDown E{p.out, WSP(int, AR_RTOK) + (size_t)pass * MOE_ROWS, WSP(float, AR_RW8) + (size_t)pass * MOE_ROWS, DM / 256, (PR_LO >= 0 && st == 0 && pb + 13 + 2 * pass >= PR_LO && pb + 13 + 2 * pass <= PR_HI) ? 0.f : 1.f};
                    if (pass == 0) { const int* trow = WSP(int, AR_TROW);
                        for (int t = gw * 4; t < T; t += NGW * 4) { const bf16* hs = WSP(bf16, WS_H) + (size_t)t * DM; bf16* xg = WSP(bf16, AR_XG);
                            copy_rows4(hs, hs + DM, hs + 2 * DM, hs + 3 * DM, xg + (size_t)trow[T + t] * DM, xg + (size_t)trow[T + t + 1] * DM, xg + (size_t)trow[T + t + 2] * DM, xg + (size_t)trow[T + t + 3] * DM, lane); } }
                    const int nwg = S.s.nwg, mainw = (nwg / G) * G, ttiles = nwg - mainw; const bool split = bar.st != nullptr && (G & 31) == 0 && mainw > 0 && ttiles > 0 && ttiles <= 32;
                    if (split) S.s.nwg = mainw;
                    pg8::gemm_phase<EpiMoeDown, MoeOrder, true, true>(lds, g, S, E, tid);
                    if (split) { Gemm g2{WSP(bf16, AR_MACT), WSP(bf16, AR_MDN), MOE_ROWS, NEXP * DM, MT_K, EXPERT_FF, EXPERT_FF}; MoeTailOrder S2; S2.init(S, mainw / (DM / 256), ttiles, G, bid);
                        EpiPart E2{WSP(float, WS_PART), mainw / (DM / 256), DM / 256};
                        pg8::gemm_phase<EpiPart, MoeTailOrder, true, true, true>(lds, g2, S2, E2, tid); }
                    if (pass == 1 && split) { { int w_ = wave0; asm volatile("" : "+s"(w_)); xcd_barrier(bar, w_ * 64 + lane_id_opaque()); }
                        for (int job = wave * G + bid; job < ttiles * 32; job += NWAVES * G) moe_tail_combine(E, S, WSP(float, WS_PART), mainw / (DM / 256), job, lane); }
                    SEAM(pb + 13 + 2 * pass);
                }
            }
        }
    }
    }
#ifdef PROBE_TK
    { int w_ = wave0; asm volatile("" : "+s"(w_)); xcd_barrier(bar, w_ * 64 + lane_id_opaque()); }
    if (blockIdx.x == 0 && threadIdx.x == 0) { const unsigned long long* tk = (const unsigned long long*)(args.ws + WS_CTL + 4 * CW_TK); __builtin_amdgcn_fence(__ATOMIC_SEQ_CST, "agent");
#ifndef PROBE_STAT
        args.out[0] += floorf((float)(long long)(tk[PROBE_A1] - tk[PROBE_A0]) * 0.01f / (float)(PROBE_TU)); }
#else
        long long mx = 0, mn = 1ll << 60; for (int b = 0; b < (int)gridDim.x; ++b) { const long long d = (long long)(tk[32 + b] - tk[0]); mx = d > mx ? d : mx; mn = d < mn ? d : mn; }
        int cnt = 0; for (int b = 0; b < (int)gridDim.x; ++b) { const long long d = (long long)(tk[32 + b] - tk[0]); cnt += (mx - d) <= 100ll * PROBE_WIN ? 1 : 0; }
        args.out[0] += PROBE_STAT == 1 ? floorf((float)mx * 0.01f / (float)(PROBE_TU)) : (PROBE_STAT == 2 ? (float)cnt : floorf((float)mn * 0.01f / (float)(PROBE_TU))); }
#endif
#endif
#undef IN
#undef SEAM
}

#ifndef MK_ONE_LAUNCH
#define MK_ONE_LAUNCH 1
#endif
extern "C" void kernel_launch(void* const* d_in, const int* in_sizes, int n_in, void* d_out, int out_size, void* d_ws, size_t ws_size, hipStream_t stream) {
    static int grid = 0;
    if (grid == 0) {
        if (n_in != 29 || in_sizes[0] != T * DM || out_size != T * DM || ws_size < WS_END) { fprintf(stderr, "kernel_launch: unexpected shapes / workspace (%d inputs, ws %zu, need %zu)\n", n_in, ws_size, (size_t)WS_END); grid = -1; return; }
        int dev = 0, cus = 0;
        if (hipGetDevice(&dev) != hipSuccess || hipDeviceGetAttribute(&cus, hipDeviceAttributeMultiprocessorCount, dev) != hipSuccess) { grid = -1; return; }
        if (hipFuncSetAttribute((const void*)mk_fwd, hipFuncAttributeMaxDynamicSharedMemorySize, LDS_BYTES) != hipSuccess) { fprintf(stderr, "kernel_launch: hipFuncSetAttribute failed\n"); grid = -1; return; }
        int per_cu = 0;
        if (hipOccupancyMaxActiveBlocksPerMultiprocessor(&per_cu, (const void*)mk_fwd, NTHREADS, LDS_BYTES) != hipSuccess || per_cu < 1) { fprintf(stderr, "kernel_launch: occupancy query says %d\n", per_cu); }
        (void)hipGetLastError();
        grid = cus;
    }
    if (grid < 0) return;
    if (hipMemsetAsync((char*)d_ws + WS_CTL, 0, CTL_BYTES, stream) != hipSuccess) return;
    Args a{};
    for (int i = 0; i < 29; ++i) a.in[i] = (const float*)d_in[i];
    a.out = (float*)d_out; a.ws = (unsigned char*)d_ws;
#if MK_ONE_LAUNCH
    a.ph_lo = 0; a.ph_hi = NPHASES;
    hipLaunchKernelGGL(mk_fwd, dim3(grid), dim3(NTHREADS), LDS_BYTES, stream, a);
#else
    for (int k = 0; k < NPHASES; ++k) {
        if (k >= 1 + 13 && k < 1 + NPH) continue;
        a.ph_lo = k; a.ph_hi = k + 1;
        hipLaunchKernelGGL(mk_fwd, dim3(grid), dim3(NTHREADS), LDS_BYTES, stream, a);
    }
#endif
}
```

```cpp
#include <hip/hip_runtime.h>
#include <cstdio>
#include <cstdint>
#include <cmath>
#include <cstring>
#include <type_traits>
#ifdef HOST_EMU
#define HD
#define DEV_INLINE inline
#else
#define HD __host__ __device__
#define DEV_INLINE __device__ __forceinline__
#endif

typedef unsigned short bf16;
struct alignas(16) U4 { unsigned x, y, z, w; };

#ifdef SMALL_CFG
constexpr int BATCH = 1, SEQ = 1024, DM = 128, DENSE_FF = 256, EXPERT_FF = 256;
#else
constexpr int BATCH = 8, SEQ = 8192, DM = 1024, DENSE_FF = 2816, EXPERT_FF = 3584;
#endif
constexpr int T = BATCH * SEQ;
constexpr int NHEAD = 8, NKV = 2, HG = 4, DH = 64;
constexpr int NC = SEQ / 16 - 1, NS = SEQ / 64, NSEL = 8, WINDOW = 512;
constexpr int CONV_CH = 512, CONV_K = 31, RC = 512;
constexpr int NEXP = 8;
constexpr int NSA_IN = 1304, OFF_CONV = 1304, OFF_GATE = 2328, OFF_RWKV = OFF_GATE + 3 * DM;
constexpr int N_IN_FIRST = OFF_RWKV + 1824, N_IN_REST = OFF_RWKV + 1856;
constexpr int NPROJ = 4352;
constexpr int LDQ = 512, LDKV = 512, LDRW = 2048, LBLK = 1536;
constexpr int MOE_ROWS = T + NEXP * 256;
constexpr float RMS_EPS = 1e-6f, LN_EPS = 1e-5f, GN_EPS = 64e-5f;

constexpr size_t al(size_t x) { return (x + 255) & ~(size_t)255; }
constexpr size_t WS_CTL = 0, CTL_BYTES = 1u << 20;
constexpr size_t SZ_WIN = (size_t)NPROJ * DM * 2, SZ_WG = (size_t)3 * DM * DM * 2, SZ_WO3 = (size_t)3 * DM * 512 * 2, SZ_WOUT = (size_t)DM * DM * 2;
constexpr size_t SZ_LW = (size_t)2048 * 384 * 2, SZ_CW1 = (size_t)2 * 256 * 1024 * 2, SZ_PEC = 1024;
constexpr size_t SZ_LAYERW = SZ_WIN + SZ_WG + SZ_WO3 + SZ_WOUT + SZ_LW + SZ_CW1 + SZ_PEC;
constexpr size_t WS_W = CTL_BYTES;
constexpr size_t OFF_WIN = 0, OFF_WG = SZ_WIN, OFF_WO3 = OFF_WG + SZ_WG, OFF_WOUT = OFF_WO3 + SZ_WO3, OFF_LW = OFF_WOUT + SZ_WOUT, OFF_CW1 = OFF_LW + SZ_LW, OFF_PEC = OFF_CW1 + SZ_CW1;
constexpr size_t WS_DGU = WS_W + 2 * SZ_LAYERW, SZ_DGU = (size_t)2 * DENSE_FF * DM * 2;
constexpr size_t WS_DDN = WS_DGU + SZ_DGU, SZ_DDN = (size_t)DM * DENSE_FF * 2;
constexpr size_t WS_VF = al(WS_DDN + SZ_DDN), SZ_TC = (size_t)T * 512 * 2;
constexpr size_t WS_H = WS_VF + SZ_TC, SZ_H = (size_t)T * DM * 2;
constexpr size_t WS_PART = WS_VF;
static_assert((size_t)32 * 7 * 65536 * 4 <= SZ_TC, "WS_PART");
constexpr size_t WS_AR = al(WS_H + SZ_H);
constexpr size_t AR_QB = WS_AR, AR_A = AR_QB + SZ_TC, AR_CO = AR_A + SZ_TC;
constexpr size_t AR_KV = AR_CO + SZ_TC, SZ_KV = (size_t)T * LDKV * 2;
constexpr size_t AR_RW = AR_KV + SZ_KV, SZ_RW = (size_t)T * LDRW * 2;
constexpr size_t AR_W = AR_RW + SZ_RW, AR_G = AR_W + SZ_TC, AR_UB = AR_G + SZ_TC;
constexpr size_t AR_NG = AR_UB + SZ_TC, SZ_NG = (size_t)T * 24 * 4;
constexpr size_t AR_HALO = al(AR_NG + SZ_NG), SZ_HALO = (size_t)(T / 256) * LDRW * 2;
constexpr size_t AR_KC = al(AR_HALO + SZ_HALO), SZ_CMP = (size_t)BATCH * NKV * (SEQ / 16) * 64 * 2;
constexpr size_t AR_VC = AR_KC + SZ_CMP;
constexpr size_t AR_HID = al(AR_VC + SZ_CMP), SZ_HID = (size_t)BATCH * NKV * (SEQ / 16) * 2 * 128 * 4;
constexpr size_t AR_SEL = al(AR_HID + SZ_HID), SZ_SEL = (size_t)T * NKV * 8 * 4;
constexpr size_t AR_INVN = al(AR_SEL + SZ_SEL), SZ_INVN = (size_t)T * 8 * 4;
constexpr size_t AR_VCT = al(AR_INVN + SZ_INVN);
constexpr size_t AR_CKV = al(AR_VCT + SZ_CMP), SZ_CKV = (size_t)2 * T * 128;
constexpr size_t AR_END1 = al(AR_CKV + SZ_CKV * 2);
constexpr size_t WS_VST = WS_H, WS_VWT = WS_H + (size_t)T * 128 * 2, WS_LB = WS_VWT + (size_t)T * 128 * 2, WS_KS8 = WS_LB + (size_t)T * 384 * 2, WS_KW8 = WS_KS8 + (size_t)T * 128 * 2;
constexpr size_t AR_OBUF = AR_KV, SZ_OBUF = (size_t)3 * T * DM * 2;
constexpr size_t AR_MIX = AR_OBUF + SZ_OBUF, SZ_MIX = (size_t)T * DM * 2;
constexpr size_t AR_END2 = AR_MIX + SZ_MIX;
constexpr size_t AR_ACT = WS_AR;
constexpr size_t AR_MGU = WS_AR, SZ_MGU = (size_t)NEXP * 2 * EXPERT_FF * DM * 2;
constexpr size_t AR_MDN = AR_MGU + SZ_MGU, SZ_MDN = (size_t)NEXP * DM * EXPERT_FF * 2;
constexpr size_t AR_XG = al(AR_MDN + SZ_MDN), SZ_XG = (size_t)MOE_ROWS * DM * 2;
constexpr size_t AR_MACT = al(AR_XG + SZ_XG), SZ_MACT = (size_t)MOE_ROWS * EXPERT_FF * 2;
constexpr size_t AR_RTOK = al(AR_MACT + SZ_MACT), SZ_RTOK = (size_t)2 * MOE_ROWS * 4;
constexpr size_t AR_RW8 = al(AR_RTOK + SZ_RTOK);
constexpr size_t AR_TROW = al(AR_RW8 + SZ_RTOK), SZ_TROW = (size_t)2 * T * 4;
constexpr size_t AR_RTE = al(AR_TROW + SZ_TROW);
constexpr size_t AR_RTW = al(AR_RTE + (size_t)T * 4);
constexpr size_t AR_WBASE = al(AR_RTW + (size_t)T * 8);
constexpr size_t AR_END3 = al(AR_WBASE + (size_t)4096 * 16 * 4);
constexpr size_t WS_END = (AR_END1 > AR_END2 ? (AR_END1 > AR_END3 ? AR_END1 : AR_END3) : (AR_END2 > AR_END3 ? AR_END2 : AR_END3));
constexpr int CW_CNT = 1024;
constexpr int CW_ATT = 256;
constexpr int CW_BAR = 4096, CW_TK = 8192, CW_CONV = 8256, CW_SINK = 16384;

struct P {
    const float *x, *mix_norm_g, *w_in_first, *w_in_rest, *mu_first, *mu_rest, *qk_g, *cmp_pos, *cmp_w1, *cmp_w2, *nsa_w_o, *conv_w, *conv_vec, *conv_w_o,
        *rwkv_vec, *w_up, *a_up, *g_up, *vres_up, *vres_b, *rwkv_w_o, *w_out, *ffn_norm_g, *dense_gu, *dense_down, *router_w, *router_b, *moe_gu, *moe_down;
    float* out; unsigned char* ws;
    unsigned char* hb;
};
HD inline void fill_params(P& p, const float* const* in, float* out, unsigned char* ws) {
    p.x = in[0]; p.mix_norm_g = in[1]; p.w_in_first = in[2]; p.w_in_rest = in[3]; p.mu_first = in[4]; p.mu_rest = in[5]; p.qk_g = in[6]; p.cmp_pos = in[7];
    p.cmp_w1 = in[8]; p.cmp_w2 = in[9]; p.nsa_w_o = in[10]; p.conv_w = in[11]; p.conv_vec = in[12]; p.conv_w_o = in[13]; p.rwkv_vec = in[14]; p.w_up = in[15];
    p.a_up = in[16]; p.g_up = in[17]; p.vres_up = in[18]; p.vres_b = in[19]; p.rwkv_w_o = in[20]; p.w_out = in[21]; p.ffn_norm_g = in[22]; p.dense_gu = in[23];
    p.dense_down = in[24]; p.router_w = in[25]; p.router_b = in[26]; p.moe_gu = in[27]; p.moe_down = in[28]; p.out = out; p.ws = ws; p.hb = ws + WS_H;
}
#define WSP(type, off) ((type*)(p.ws + (off)))
#define WSH(type, off) ((type*)(p.hb + ((off) - WS_H)))

#ifdef HOST_EMU
#define FENCE()
#else
#define FENCE() asm volatile("" ::: "memory")
#endif
HD inline float bf2f(bf16 v) { unsigned u = (unsigned)v << 16; float f; memcpy(&f, &u, 4); return f; }
HD inline bf16 f2bf(float f) { unsigned u; memcpy(&u, &f, 4); return (bf16)((u + 0x7fffu + ((u >> 16) & 1u)) >> 16); }
HD inline float blo(unsigned v) { unsigned u = v << 16; float f; memcpy(&f, &u, 4); return f; }
HD inline float bhi(unsigned v) { unsigned u = v & 0xffff0000u; float f; memcpy(&f, &u, 4); return f; }
#if !defined(SCAN_BF16) && !defined(RKV_BF16)
HD inline bf16 f2h(float f) { return __builtin_bit_cast(unsigned short, (_Float16)f); }
#else
HD inline bf16 f2bf(float f);
HD inline bf16 f2h(float f) { return f2bf(f); }
#endif
HD inline float h2f(bf16 v) { return (float)__builtin_bit_cast(_Float16, v); }
HD inline float sigmoidf_(float x) { return 1.f / (1.f + expf(-x)); }
HD inline float dot64(const float* q, const bf16* kp) {
    const U4* k4 = (const U4*)kp; float s0 = 0.f, s1 = 0.f;
#pragma unroll
    for (int i = 0; i < 8; ++i) { const U4 v = k4[i];
        s0 += q[8 * i + 0] * blo(v.x) + q[8 * i + 2] * blo(v.y) + q[8 * i + 4] * blo(v.z) + q[8 * i + 6] * blo(v.w);
        s1 += q[8 * i + 1] * bhi(v.x) + q[8 * i + 3] * bhi(v.y) + q[8 * i + 5] * bhi(v.z) + q[8 * i + 7] * bhi(v.w); }
    return s0 + s1;
}
HD inline float dot64p(const U4* q, const bf16* kp) {
    const U4* k4 = (const U4*)kp; float s0 = 0.f, s1 = 0.f;
#pragma unroll
    for (int i = 0; i < 8; ++i) { const U4 v = k4[i], w = q[i];
        s0 += blo(w.x) * blo(v.x) + blo(w.y) * blo(v.y) + blo(w.z) * blo(v.z) + blo(w.w) * blo(v.w);
        s1 += bhi(w.x) * bhi(v.x) + bhi(w.y) * bhi(v.y) + bhi(w.z) * bhi(v.z) + bhi(w.w) * bhi(v.w); }
    return s0 + s1;
}
HD inline void ld64(const bf16* kp, float* q) {
    const U4* k4 = (const U4*)kp;
#pragma unroll
    for (int i = 0; i < 8; ++i) { const U4 v = k4[i]; q[8 * i] = blo(v.x); q[8 * i + 1] = bhi(v.x); q[8 * i + 2] = blo(v.y); q[8 * i + 3] = bhi(v.y);
        q[8 * i + 4] = blo(v.z); q[8 * i + 5] = bhi(v.z); q[8 * i + 6] = blo(v.w); q[8 * i + 7] = bhi(v.w); }
}
HD inline void axpy64(float* o, float w, const bf16* vp) {
    const U4* k4 = (const U4*)vp;
#pragma unroll
    for (int i = 0; i < 8; ++i) { const U4 v = k4[i]; o[8 * i] += w * blo(v.x); o[8 * i + 1] += w * bhi(v.x); o[8 * i + 2] += w * blo(v.y); o[8 * i + 3] += w * bhi(v.y);
        o[8 * i + 4] += w * blo(v.z); o[8 * i + 5] += w * bhi(v.z); o[8 * i + 6] += w * blo(v.w); o[8 * i + 7] += w * bhi(v.w); }
}
HD inline void axpy64s(float* o, float w, const bf16* vp) {
    const U4* k4 = (const U4*)vp;
#pragma unroll
    for (int i = 0; i < 8; ++i) { const U4 v = k4[i]; o[8 * i] = w * o[8 * i] + blo(v.x); o[8 * i + 1] = w * o[8 * i + 1] + bhi(v.x); o[8 * i + 2] = w * o[8 * i + 2] + blo(v.y); o[8 * i + 3] = w * o[8 * i + 3] + bhi(v.y);
        o[8 * i + 4] = w * o[8 * i + 4] + blo(v.z); o[8 * i + 5] = w * o[8 * i + 5] + bhi(v.z); o[8 * i + 6] = w * o[8 * i + 6] + blo(v.w); o[8 * i + 7] = w * o[8 * i + 7] + bhi(v.w); }
}
HD inline void st64(bf16* op, const float* o) {
    U4* o4 = (U4*)op;
#pragma unroll
    for (int i = 0; i < 8; ++i) { U4 v; v.x = (unsigned)f2bf(o[8 * i]) | ((unsigned)f2bf(o[8 * i + 1]) << 16); v.y = (unsigned)f2bf(o[8 * i + 2]) | ((unsigned)f2bf(o[8 * i + 3]) << 16);
        v.z = (unsigned)f2bf(o[8 * i + 4]) | ((unsigned)f2bf(o[8 * i + 5]) << 16); v.w = (unsigned)f2bf(o[8 * i + 6]) | ((unsigned)f2bf(o[8 * i + 7]) << 16); o4[i] = v; }
}

HD inline void rope_cs(int pos, int i, float& cs, float& sn) {
    const float c = exp2f(-(float)i * 0.41524101186092f) * 0.15915494309189535f, pf = (float)pos;
    const float prod = pf * c, err = fmaf(pf, c, -prod), fr = (prod - rintf(prod)) + err;
#ifdef HOST_EMU
    cs = cosf(6.283185307179586f * fr); sn = sinf(6.283185307179586f * fr);
#else
    cs = __builtin_amdgcn_cosf(fr); sn = __builtin_amdgcn_sinf(fr);
#endif
}
HD inline int win_dest(int j, int layer, int& which) {
    which = 0;
    if (j < 1280) return j;
    if (j < 1304) return 3840 + 320 + (j - 1280);
    if (j < 1816) { const int cc = j - 1304; return 1280 + 256 * (cc / 128) + cc % 128; }
    if (j < 2328) { const int cc = j - 1816; return 1280 + 256 * (cc / 128) + 128 + cc % 128; }
    if (j < OFF_RWKV) { which = 1; const int gg = j - OFF_GATE, br = gg / DM; return (br == 0 ? 0 : (br == 1 ? 2 * DM : DM)) + gg % DM; }
    const int rr = j - OFF_RWKV;
    if (rr < 1536) return 2304 + rr;
    if (rr < 1824) return 3840 + (rr - 1536);
    if (rr < 1856 && layer == 1) return 3840 + 288 + (rr - 1824);
    return -1;
}
HD inline int glu_dest(int j, int ff) { return j < ff ? 256 * (j / 128) + j % 128 : 256 * ((j - ff) / 128) + 128 + (j - ff) % 128; }

DEV_INLINE void ph_shift(const P& p, int layer, long gtid, long NT) {
    bf16* RW = WSP(bf16, AR_RW); const bf16* HALO = WSP(bf16, AR_HALO); bf16* VF = WSP(bf16, WS_VF); bf16* LB = WSH(bf16, WS_LB);
    const float* mu = layer == 0 ? p.mu_first : p.mu_rest;
    constexpr int NCP = (LBLK + 384) / 2;
    const long n = (long)(T / 256) * NCP;
    for (long it = gtid; it < n; it += NT) {
        const int pm = (int)(it / NCP), c = 2 * (int)(it % NCP);
        int mi = -1, act = 0;
        if (c < LBLK) mi = c;
        else { const int w = c - LBLK; if (w < 288) { mi = 1536 + w; act = w < 64 ? 1 : (w >= 128 ? 2 : 0); } else if (w < 320 && layer == 1) mi = 1824 + (w - 288); }
        if (mi < 0) { for (int r = 0; r < 256; ++r) *(unsigned*)(LB + ((size_t)pm * 256 + r) * 384 + (c - LBLK)) = 0u; continue; }
        const float m0 = mu[mi], m1 = mu[mi + 1];
        float prev0 = 0.f, prev1 = 0.f;
        if ((pm * 256) % SEQ != 0) { const unsigned hv = *(const unsigned*)(HALO + (size_t)(pm - 1) * LDRW + c); prev0 = blo(hv); prev1 = bhi(hv); }
        bf16* col = RW + (size_t)pm * 256 * LDRW + c;
        for (int r0 = 0; r0 < 256; r0 += 32) {
            unsigned pv[32];
#pragma unroll
            for (int k = 0; k < 32; ++k) pv[k] = *(const unsigned*)(col + (size_t)(r0 + k) * LDRW);
#pragma unroll
            for (int k = 0; k < 32; ++k) { const int r = r0 + k; const float p0 = blo(pv[k]), p1 = bhi(pv[k]);
                float u0 = p0 + (prev0 - p0) * m0, u1 = p1 + (prev1 - p1) * m1; prev0 = p0; prev1 = p1;
                if (act == 1) { u0 = tanhf(u0); u1 = tanhf(u1); } else if (act == 2) { u0 = sigmoidf_(u0); u1 = sigmoidf_(u1); }
                if (c < LBLK) { const unsigned hv = (unsigned)f2h(u0) | ((unsigned)f2h(u1) << 16); *(unsigned*)(col + (size_t)r * LDRW) = hv;
                    if (layer == 0 && c >= 1024) *(unsigned*)(VF + ((size_t)pm * 256 + r) * RC + (c - 1024)) = hv; }
                else *(unsigned*)(LB + ((size_t)pm * 256 + r) * 384 + (c - LBLK)) = (unsigned)f2bf(u0) | ((unsigned)f2bf(u1) << 16); }
        }
    }
}

DEV_INLINE void ph_nsa_prep(const P& p, int layer, long gtid, long NT) {
    bf16* QB = WSP(bf16, AR_QB); bf16* KV = WSP(bf16, AR_KV);
    const long n = (long)T * 12;
    for (long it = gtid; it < n; it += NT) {
        const int t = (int)(it / 12), s = (int)(it % 12), pos = t % SEQ;
        bf16* ptr; const float* g;
        if (s < 8) { ptr = QB + (size_t)t * LDQ + s * 64; g = p.qk_g + (layer * 4 + 0) * 64; }
        else if (s < 10) { ptr = KV + (size_t)t * LDKV + (s - 8) * 64; g = p.qk_g + (layer * 4 + 2) * 64; }
        else { ptr = KV + (size_t)t * LDKV + 256 + (s - 10) * 64; g = p.qk_g + (layer * 4 + 3) * 64; }
        float v[64]; ld64(ptr, v);
        float ss = 0.f;
#pragma unroll
        for (int i = 0; i < 64; ++i) ss += v[i] * v[i];
        const float rs = 1.f / sqrtf(ss * (1.f / 64.f) + RMS_EPS);
#pragma unroll
        for (int i = 0; i < 64; ++i) v[i] = v[i] * rs * g[i];
#pragma unroll
        for (int i = 0; i < 32; ++i) {
            float cs, sn; rope_cs(pos, i, cs, sn);
            const float x1 = v[i], x2 = v[i + 32]; v[i] = x1 * cs - x2 * sn; v[i + 32] = x2 * cs + x1 * sn;
        }
        if (s < 8) {
#pragma unroll
            for (int i = 0; i < 64; ++i) v[i] *= 0.125f * 1.4426950408889634f; }
        if (s < 8) st64(ptr, v);
        else {
            const int gg = (s - 8) & 1, bq = t / SEQ; bf16* k8 = WSH(bf16, s < 10 ? WS_KS8 : WS_KW8) + (size_t)(bq * NKV + gg) * 8 * SEQ * 8;
#pragma unroll
            for (int dg = 0; dg < 8; ++dg) { U4 w; w.x = (unsigned)f2bf(v[8 * dg]) | ((unsigned)f2bf(v[8 * dg + 1]) << 16); w.y = (unsigned)f2bf(v[8 * dg + 2]) | ((unsigned)f2bf(v[8 * dg + 3]) << 16);
                w.z = (unsigned)f2bf(v[8 * dg + 4]) | ((unsigned)f2bf(v[8 * dg + 5]) << 16); w.w = (unsigned)f2bf(v[8 * dg + 6]) | ((unsigned)f2bf(v[8 * dg + 7]) << 16);
                *(U4*)(k8 + ((size_t)dg * SEQ + pos) * 8) = w; } }
    }
}

DEV_INLINE void ph_vtrans(const P& p, long gtid, long NT) {
    const bf16* KV = WSP(bf16, AR_KV); bf16* VsT = WSH(bf16, WS_VST); bf16* VwT = WSH(bf16, WS_VWT);
    const long n = (long)BATCH * NKV * (SEQ / 8) * 64;
    for (long it = gtid; it < n; it += NT) {
        const int d = (int)(it % 64); long r = it / 64; const int kg = (int)(r % (SEQ / 8)); const int bg = (int)(r / (SEQ / 8)), b = bg / NKV, g = bg % NKV;
        const int kbase = (kg >> 2) * 32 + 4 * (kg & 3);
        const bf16* src = KV + (size_t)(b * SEQ + kbase) * LDKV + g * 64 + d;
        U4 s, w; unsigned short sv[8], wv[8];
#pragma unroll
        for (int j = 0; j < 8; ++j) { const size_t ro = (size_t)((j & 3) + 16 * (j >> 2)) * LDKV; sv[j] = src[ro + 128]; wv[j] = src[ro + 384]; }
        s.x = sv[0] | ((unsigned)sv[1] << 16); s.y = sv[2] | ((unsigned)sv[3] << 16); s.z = sv[4] | ((unsigned)sv[5] << 16); s.w = sv[6] | ((unsigned)sv[7] << 16);
        w.x = wv[0] | ((unsigned)wv[1] << 16); w.y = wv[2] | ((unsigned)wv[3] << 16); w.z = wv[4] | ((unsigned)wv[5] << 16); w.w = wv[6] | ((unsigned)wv[7] << 16);
        *(U4*)(VsT + (((size_t)bg * (SEQ / 8) + kg) * 64 + d) * 8) = s; *(U4*)(VwT + (((size_t)bg * (SEQ / 8) + kg) * 64 + d) * 8) = w;
    }
}
namespace pg8 {
#define PG8_LAS __attribute__((address_space(3)))
typedef unsigned short bf16_t;
typedef short bf16x8 __attribute__((ext_vector_type(8)));
typedef float f32x4 __attribute__((ext_vector_type(4)));
typedef unsigned u32x4 __attribute__((ext_vector_type(4)));
constexpr int BM = 256, BK = 64, HALF = 128, HTB = HALF * BK * 2  , STAGE_BYTES = 8 * HTB, NXCD = 8, WGM = 8;

__host__ __device__ __forceinline__ int lds_byte(int r, int c) { const int st = (r >> 4) * 2 + (c >> 5), rr = r & 15, cc = c & 31, ob = rr * 64 + cc * 2; return st * 1024 + (ob ^ (((ob >> 9) & 1) << 5)); }
__host__ __device__ __forceinline__ void stage_rc(int b, int& R, int& C) { const int st = b / 1024, sb = b % 1024, swz = sb ^ (((sb >> 9) & 1) << 5); R = (st >> 1) * 16 + swz / 64; C = (st & 1) * 32 + (swz % 64) / 2; }
__host__ __device__ __forceinline__ int perm32(int rho) { const int n = rho >> 4, i = rho & 15; return 8 * (i >> 2) + 4 * n + (i & 3); }

struct Unit { int pm, pn; };
struct Gemm { const bf16_t* A; const bf16_t* Bt; int M, N, K; int lda; int ldb; };

struct StaticOrder {
    int nM, nN, nwg, G, c;
    __host__ __device__ void init(int M, int N, int G_, int c_) { nM = M / BM; nN = N / BM; nwg = nM * nN; G = G_; c = c_; }
    __host__ __device__ bool next(int i, Unit& u) const {
        const long L = (long)i * G + c; if (L >= nwg) return false;
        int wgid = (int)L; { const int q = nwg / NXCD, r = nwg % NXCD, xcd = wgid % NXCD, off = wgid / NXCD; wgid = (xcd < r ? xcd * (q + 1) : r * (q + 1) + (xcd - r) * q) + off; }
        const int nig = WGM * nN, gid = wgid / nig, fm = gid * WGM, gsz = (nM - fm) < WGM ? (nM - fm) : WGM;
        u.pm = fm + ((wgid % nig) % gsz); u.pn = (wgid % nig) / gsz; return true;
    }
    __device__ __forceinline__ void a_ready(const Unit&) const {}
    __device__ __forceinline__ void done(const Unit&) const {}
};

__device__ __forceinline__ unsigned cvt_pk_bf16(float lo, float hi) { unsigned r; asm volatile("v_cvt_pk_bf16_f32 %0, %1, %2" : "=v"(r) : "v"(lo), "v"(hi)); return r; }
typedef float f32x2 __attribute__((ext_vector_type(2)));
template <class Epi, class Sched, bool ALIGN_EPI = false, bool SP2 = false, bool KSPLIT = false>
__device__ __forceinline__ void gemm_phase(PG8_LAS unsigned char* lds, const Gemm g, const Sched& S, const Epi& E, int tid_in) {
    int tid_ = tid_in; asm volatile("" : "+v"(tid_));
    const int tid = tid_, wid = __builtin_amdgcn_readfirstlane(tid >> 6), lane = tid & 63, wr = wid >> 2, wc = wid & 3, fr = lane & 15, fq = lane >> 4;
    const int K = g.K, nt = K / BK, lda = g.lda ? g.lda : K, ldb = g.ldb ? g.ldb : K;
    unsigned voffA[2], voffB[2];
#pragma unroll
    for (int i = 0; i < 2; ++i) { int R, C; stage_rc(tid * 16 + i * 8192, R, C); const int Rb = Epi::PERM ? ((R & ~31) + perm32(R & 31)) : R;
        voffA[i] = (unsigned)(R * lda + C) * 2u; voffB[i] = (unsigned)(Rb * ldb + C) * 2u; }
    const size_t kstep = (size_t)(BK * 2);
    const size_t hstepA = (size_t)HALF * lda * 2, hstepB = (size_t)HALF * ldb * 2;
    const size_t hstep_unused = (size_t)HALF * K * 2;
    const size_t tstepA = 2 * hstepA, tstepB = 2 * hstepB;
    const unsigned ldsw = (unsigned)wid * 1024u;
    const int aoff = lds_byte(wr * 64 + fr, fq * 8), boff = lds_byte(wc * 32 + fr, fq * 8);
#define PG8_SA(b, h) (((b) * 2 + (h)) * HTB)
#define PG8_SB(b, h) ((4 + (b) * 2 + (h)) * HTB)
#define PG8_STAGE(bufoff, gbase, voff) do { _Pragma("unroll") for (int _i = 0; _i < 2; ++_i) \
        __builtin_amdgcn_global_load_lds((const unsigned*)((const char*)(gbase) + (voff)[_i]), (PG8_LAS unsigned*)(lds + (bufoff) + ldsw + _i * 8192), 16, 0, 0); } while (0)
#define PG8_LDA(dst, b, h) do { _Pragma("unroll") for (int m = 0; m < 4; ++m) _Pragma("unroll") for (int k = 0; k < 2; ++k) dst[m][k] = *(const PG8_LAS bf16x8*)(lds + PG8_SA(b, h) + aoff + m * 2048 + k * 1024); } while (0)
#define PG8_LDB(dst, b, h) do { _Pragma("unroll") for (int n = 0; n < 2; ++n) _Pragma("unroll") for (int k = 0; k < 2; ++k) dst[n][k] = *(const PG8_LAS bf16x8*)(lds + PG8_SB(b, h) + boff + n * 2048 + k * 1024); } while (0)
#define PG8_MMA(ai, bj, At, Bt) do { __builtin_amdgcn_s_setprio(1); _Pragma("unroll") for (int m = 0; m < 4; ++m) _Pragma("unroll") for (int n = 0; n < 2; ++n) _Pragma("unroll") for (int k = 0; k < 2; ++k) \
        acc[ai][bj][m][n] = __builtin_amdgcn_mfma_f32_16x16x32_bf16(Bt[n][k], At[m][k], acc[ai][bj][m][n], 0, 0, 0); __builtin_amdgcn_s_setprio(0); } while (0)
#define PG8_WAIT_V(n) asm volatile("s_waitcnt vmcnt(" #n ")" ::: "memory")
#define PG8_WAIT_L(n) asm volatile("s_waitcnt lgkmcnt(" #n ")" ::: "memory")
#define PG8_BAR __builtin_amdgcn_s_barrier()
#define PG8_SCHED __builtin_amdgcn_sched_barrier(0)
    Unit cur, nxt; int ui = 0;
    if (!S.next(0, cur)) return;
    f32x4 acc[2][2][4][2];
#pragma unroll
    for (int a = 0; a < 2; ++a)
#pragma unroll
        for (int b = 0; b < 2; ++b)
#pragma unroll
            for (int m = 0; m < 4; ++m)
#pragma unroll
                for (int n = 0; n < 2; ++n) acc[a][b][m][n] = (f32x4){0.f, 0.f, 0.f, 0.f};
    bf16x8 At[4][2], B0[2][2], B1[2][2];
    const char* cA = (const char*)g.A + (size_t)cur.pm * tstepA + (KSPLIT ? (size_t)(cur.pn >> 16) * K * 2 : 0); const char* cB = (const char*)g.Bt + (size_t)(KSPLIT ? (cur.pn & 0xffff) : cur.pn) * tstepB + (KSPLIT ? (size_t)(cur.pn >> 16) * K * 2 : 0);
    S.a_ready(cur);
    if constexpr (SP2) {
        PG8_STAGE(PG8_SB(0, 0), cB, voffB); PG8_STAGE(PG8_SB(0, 1), cB + hstepB, voffB); PG8_STAGE(PG8_SA(0, 0), cA, voffA); PG8_STAGE(PG8_SA(0, 1), cA + hstepA, voffA);
        if (wr == 1) PG8_BAR;
        PG8_WAIT_V(2); PG8_BAR;
        PG8_STAGE(PG8_SB(1, 0), cB + kstep, voffB); PG8_STAGE(PG8_SA(1, 0), cA + kstep, voffA); PG8_STAGE(PG8_SB(1, 1), cB + hstepB + kstep, voffB);
        PG8_WAIT_V(6); PG8_BAR;
    } else {
        PG8_STAGE(PG8_SB(0, 0), cB, voffB); PG8_STAGE(PG8_SA(0, 0), cA, voffA); PG8_STAGE(PG8_SB(0, 1), cB + hstepB, voffB); PG8_STAGE(PG8_SA(0, 1), cA + hstepA, voffA);
        if (wr == 1) PG8_BAR;
        PG8_WAIT_V(4); PG8_BAR;
        PG8_STAGE(PG8_SB(1, 0), cB + kstep, voffB); PG8_STAGE(PG8_SA(1, 0), cA + kstep, voffA); PG8_STAGE(PG8_SB(1, 1), cB + hstepB + kstep, voffB);
        PG8_WAIT_V(6); PG8_BAR;
    }
    for (;;) {
        const bool has_next = S.next(ui + 1, nxt);
        const char* nA = has_next ? (const char*)g.A + (size_t)nxt.pm * tstepA + (KSPLIT ? (size_t)(nxt.pn >> 16) * K * 2 : 0) : cA; const char* nB = has_next ? (const char*)g.Bt + (size_t)(KSPLIT ? (nxt.pn & 0xffff) : nxt.pn) * tstepB + (KSPLIT ? (size_t)(nxt.pn >> 16) * K * 2 : 0) : cB;
        for (int t = 0; t < nt; t += 2) {
            const bool last = (t == nt - 2);
            const char* a1 = cA + (size_t)(t + 1) * kstep;
            const char* a2 = last ? nA : cA + (size_t)(t + 2) * kstep; const char* b2 = last ? nB : cB + (size_t)(t + 2) * kstep;
            const char* a3 = a2 + kstep; const char* b3 = b2 + kstep;
            if (last && has_next) S.a_ready(nxt);
            if constexpr (SP2) {
            PG8_LDB(B0, 0, 0); PG8_LDB(B1, 0, 1); PG8_SCHED; PG8_LDA(At, 0, 0); PG8_STAGE(PG8_SA(1, 1), a1 + hstepA, voffA);
            PG8_WAIT_V(8); PG8_WAIT_L(0); PG8_BAR; PG8_MMA(0, 0, At, B0); PG8_MMA(0, 1, At, B1); PG8_BAR; PG8_SCHED;
            PG8_LDA(At, 0, 1); PG8_STAGE(PG8_SB(0, 0), b2, voffB); PG8_STAGE(PG8_SB(0, 1), b2 + hstepB, voffB); PG8_STAGE(PG8_SA(0, 0), a2, voffA);
            PG8_WAIT_V(8); PG8_WAIT_L(0); PG8_BAR; PG8_MMA(1, 0, At, B0); PG8_MMA(1, 1, At, B1); PG8_BAR; PG8_SCHED;
            PG8_LDB(B0, 1, 0); PG8_LDB(B1, 1, 1); PG8_SCHED; PG8_LDA(At, 1, 0); PG8_STAGE(PG8_SA(0, 1), a2 + hstepA, voffA);
            PG8_WAIT_V(8); PG8_WAIT_L(0); PG8_BAR; PG8_MMA(0, 0, At, B0); PG8_MMA(0, 1, At, B1); PG8_BAR; PG8_SCHED;
            PG8_LDA(At, 1, 1); PG8_STAGE(PG8_SB(1, 0), b3, voffB); PG8_STAGE(PG8_SB(1, 1), b3 + hstepB, voffB); PG8_STAGE(PG8_SA(1, 0), a3, voffA);
            PG8_WAIT_V(8); PG8_WAIT_L(0); PG8_BAR; PG8_MMA(1, 0, At, B0); PG8_MMA(1, 1, At, B1); PG8_BAR; PG8_SCHED;
            } else {
            PG8_LDB(B0, 0, 0); PG8_SCHED; PG8_LDA(At, 0, 0); PG8_STAGE(PG8_SA(1, 1), a1 + hstepA, voffA);
            PG8_WAIT_L(8); PG8_BAR; PG8_WAIT_L(0); PG8_MMA(0, 0, At, B0); PG8_BAR; PG8_SCHED;
            PG8_LDB(B1, 0, 1); PG8_STAGE(PG8_SB(0, 0), b2, voffB);
            PG8_BAR; PG8_WAIT_L(0); PG8_MMA(0, 1, At, B1); PG8_BAR;
            PG8_LDA(At, 0, 1); PG8_STAGE(PG8_SA(0, 0), a2, voffA);
            PG8_BAR; PG8_WAIT_L(0); PG8_MMA(1, 0, At, B0); PG8_BAR; PG8_SCHED;
            PG8_STAGE(PG8_SB(0, 1), b2 + hstepB, voffB);
            PG8_WAIT_V(6); PG8_BAR; PG8_MMA(1, 1, At, B1); PG8_BAR;
            PG8_LDB(B0, 1, 0); PG8_SCHED; PG8_LDA(At, 1, 0); PG8_STAGE(PG8_SA(0, 1), a2 + hstepA, voffA);
            PG8_WAIT_L(8); PG8_BAR; PG8_WAIT_L(0); PG8_MMA(0, 0, At, B0); PG8_BAR; PG8_SCHED;
            PG8_LDB(B1, 1, 1); PG8_STAGE(PG8_SB(1, 0), b3, voffB);
            PG8_BAR; PG8_WAIT_L(0); PG8_MMA(0, 1, At, B1); PG8_BAR;
            PG8_LDA(At, 1, 1); PG8_STAGE(PG8_SA(1, 0), a3, voffA);
            PG8_BAR; PG8_WAIT_L(0); PG8_MMA(1, 0, At, B0); PG8_BAR; PG8_SCHED;
            PG8_STAGE(PG8_SB(1, 1), b3 + hstepB, voffB);
            PG8_WAIT_V(6); PG8_BAR; PG8_MMA(1, 1, At, B1); PG8_BAR;
            }
        }
        if constexpr (ALIGN_EPI) { if (wr == 0) PG8_BAR; }
        if constexpr (!Epi::AFTER_DRAIN) { E(acc, cur, wr, wc, fr, fq); S.done(cur); }
        if (!has_next) break;
#pragma unroll
        for (int a = 0; a < 2; ++a)
#pragma unroll
            for (int b = 0; b < 2; ++b)
#pragma unroll
                for (int m = 0; m < 4; ++m)
#pragma unroll
                    for (int n = 0; n < 2; ++n) acc[a][b][m][n] = (f32x4){0.f, 0.f, 0.f, 0.f};
        cur = nxt; cA = nA; cB = nB; ++ui;
        if constexpr (ALIGN_EPI) { if (wr == 1) PG8_BAR; }
    }
    PG8_WAIT_V(0);
    if constexpr (!ALIGN_EPI) { if (wr == 0) PG8_BAR; }
    PG8_BAR;
    if constexpr (Epi::AFTER_DRAIN) { E.fused(acc, cur, wr, wc, fr, fq, lds, wid, lane); S.done(cur); }
#undef PG8_SA
#undef PG8_SB
#undef PG8_STAGE
#undef PG8_LDA
#undef PG8_LDB
#undef PG8_MMA
#undef PG8_WAIT_V
#undef PG8_WAIT_L
#undef PG8_BAR
#undef PG8_SCHED
}
}

#define LAS __attribute__((address_space(3)))
#define XB_TMO      128
#define XB_XCNT(j)  (256  + 64 * (j))
#define XB_XSUB(j)  (1280 + 64 * (j))
#define XB_XGEN(j)  (2304 + 64 * (j))
#define XB_TOP      3328
#define XB_TOPGEN   3392
#define XCD_BAR_WORDS 3456
#define XB_SPIN_CAP (1u << 22)

__device__ __forceinline__ unsigned xb_ld(unsigned* p)              { return __hip_atomic_load(p, __ATOMIC_RELAXED, __HIP_MEMORY_SCOPE_AGENT); }
__device__ __forceinline__ unsigned xb_add(unsigned* p, unsigned v) { return __hip_atomic_fetch_add(p, v, __ATOMIC_RELAXED, __HIP_MEMORY_SCOPE_AGENT); }
__device__ __forceinline__ unsigned xb_xcc_id() { return (unsigned)__builtin_amdgcn_s_getreg((3 << 11) | 20) & 0xFu; }
#define XB_SPIN(cond, bar) do { unsigned _sp = 0; while (cond) { __builtin_amdgcn_s_sleep(1); \
    if ((++_sp & 255u) == 0u) { if (xb_ld(&(bar)[XB_TMO])) break; if (_sp > XB_SPIN_CAP) { atomicAdd(&(bar)[XB_TMO], 1u); break; } } } } while (0)

struct XcdBarrier {
    unsigned* bar; unsigned x;
    volatile LAS unsigned* st;
};

__device__ __forceinline__ XcdBarrier xcd_barrier_post(unsigned* bar, volatile LAS unsigned* st) {
    XcdBarrier b; b.bar = bar; b.x = xb_xcc_id(); b.st = st;
    if (threadIdx.x == 0) (void)xb_add(&bar[XB_XCNT(b.x)], 1u);
    return b;
}
__device__ __forceinline__ void xcd_barrier_complete(unsigned* bar, unsigned x, unsigned& nloc, unsigned& nx) {
    const unsigned G = gridDim.x * gridDim.y * gridDim.z;
    unsigned sum, cnt, mine, sp = 0u;
    for (;;) {
        sum = 0u; cnt = 0u; mine = 0u;
#pragma unroll
        for (unsigned j = 0; j < 16; ++j) { const unsigned c = xb_ld(&bar[XB_XCNT(j)]); sum += c; cnt += (c > 0u) ? 1u : 0u; mine = (j == x) ? c : mine; }
        if (sum == G) break;
        __builtin_amdgcn_s_sleep(1);
        if ((++sp & 255u) == 0u) { if (xb_ld(&bar[XB_TMO])) break; if (sp > XB_SPIN_CAP) { atomicAdd(&bar[XB_TMO], 1u); break; } }
    }
    nloc = mine > 0u ? mine : 1u; nx = cnt > 0u ? cnt : 1u;
}

__device__ __forceinline__ void xcd_barrier(const XcdBarrier& b, int tid_x  ) {
    asm volatile("s_waitcnt vmcnt(0)" ::: "memory");
    __syncthreads();
    if (tid_x == 0) {
        unsigned* bar = b.bar; asm volatile("" : "+s"(bar));
        unsigned xx = b.x; asm volatile("" : "+s"(xx));
        __builtin_amdgcn_s_waitcnt(0);
        unsigned nloc = b.st[0], nx = b.st[1];
        if (nloc == 0u) { xcd_barrier_complete(bar, xx, nloc, nx); b.st[0] = nloc; b.st[1] = nx; }
        const unsigned old = xb_add(&bar[XB_XSUB(xx)], 1u);
        const unsigned gen = old / nloc;
        if (old + 1u == (gen + 1u) * nloc) {
            __builtin_amdgcn_fence(__ATOMIC_RELEASE, "agent");
            asm volatile("s_waitcnt vmcnt(0)" ::: "memory");
            const unsigned og = xb_add(&bar[XB_TOP], 1u);
            const unsigned tg = og / nx;
            if (og + 1u == (tg + 1u) * nx) xb_add(&bar[XB_TOPGEN], 1u);
            else XB_SPIN(xb_ld(&bar[XB_TOPGEN]) == tg, bar);
            __builtin_amdgcn_fence(__ATOMIC_ACQUIRE, "agent");
            xb_add(&bar[XB_XGEN(xx)], 1u);
            asm volatile("s_waitcnt vmcnt(0)" ::: "memory");
        } else {
            XB_SPIN(xb_ld(&bar[XB_XGEN(xx)]) == gen, bar);
            __builtin_amdgcn_fence(__ATOMIC_ACQUIRE, "agent");
            asm volatile("s_waitcnt vmcnt(0)" ::: "memory");
        }
    }
    __syncthreads();
}
#define GAS __attribute__((address_space(1)))
typedef unsigned v4u __attribute__((ext_vector_type(4)));
#ifdef PROBE_TK
#define TKQ(i) do { if (layer == PROBE_LAYER && blockIdx.x == PROBE_BLK && threadIdx.x == 0) ((unsigned long long*)(p.ws + WS_CTL + 4 * CW_TK))[(i)] = __builtin_amdgcn_s_memrealtime(); } while (0)
#else
#define TKQ(i) do { } while (0)
#endif
typedef unsigned v2u __attribute__((ext_vector_type(2)));
typedef GAS unsigned gu32;
#define RLX_AGENT __ATOMIC_RELAXED, __HIP_MEMORY_SCOPE_AGENT
#define LDS_WAIT() asm volatile("s_waitcnt lgkmcnt(0)" ::: "memory")
#define VM_WAIT() asm volatile("s_waitcnt vmcnt(0)" ::: "memory")
using pg8::f32x4; using pg8::Unit; using pg8::Gemm; using pg8::BM; using pg8::HALF; using pg8::cvt_pk_bf16; using pg8::u32x4;

constexpr int NWAVES = 8, NTHREADS = 512;
constexpr int RING_BYTES = 131072, LDSCTL_OFF = 147456 - 1024, MISC_OFF = LDSCTL_OFF + 320, LDS_BYTES = 147456;

__device__ __forceinline__ float wave_sum(float v, int lane) {
#pragma unroll
    for (int o = 1; o < 64; o <<= 1) v += __builtin_bit_cast(float, __builtin_amdgcn_ds_bpermute((lane ^ o) << 2, __builtin_bit_cast(int, v)));
    return v;
}
__device__ __forceinline__ float fsig(float x) { return __builtin_amdgcn_rcpf(1.f + __expf(-x)); }

__device__ __forceinline__ int lane_id_opaque() { int l; asm volatile("v_mbcnt_lo_u32_b32 %0, -1, 0\n\tv_mbcnt_hi_u32_b32 %0, -1, %0" : "=v"(l)); return l; }
__device__ __forceinline__ int rfl(int v) { return __builtin_amdgcn_readfirstlane(v); }
struct SOrder {
    pg8::StaticOrder s;
    __device__ void init(int M, int N, int G, int c) { s.init(M, N, G, c); }
    __device__ bool next(int i, Unit& u) const { Unit t; t.pm = 0; t.pn = 0; const bool ok = s.next(i, t); u.pm = rfl(t.pm); u.pn = rfl(t.pn); return ok; }
    __device__ __forceinline__ void a_ready(const Unit&) const {}
    __device__ __forceinline__ void done(const Unit&) const {}
};
struct StackOrder {
    pg8::StaticOrder s; int nM, nN;
    __device__ StackOrder(int nM_, int nN_, int nb, int G, int c) : nM(nM_), nN(nN_) { s.init(nb * nM_ * 256, nN_ * 256, G, c); }
    __device__ bool next(int i, Unit& u) const { Unit t; t.pm = 0; t.pn = 0; if (!s.next(i, t)) return false; u.pm = rfl(t.pm); u.pn = rfl((t.pm / nM) * nN + t.pn); return true; }
    __device__ __forceinline__ void a_ready(const Unit&) const {}
    __device__ __forceinline__ void done(const Unit&) const {}
};
struct GateOrder {
    pg8::StaticOrder s; int nN;
    __device__ GateOrder(int nM_, int nN_, int G, int c) : nN(nN_) { s.init(nM_ * 256, nN_ * 256, G, c); }
    __device__ bool next(int i, Unit& u) const { const int j = i / 3, br = i - 3 * j; Unit t; t.pm = 0; t.pn = 0; if (!s.next(j, t)) return false; u.pm = rfl(t.pm); u.pn = rfl(br * nN + t.pn); return true; }
    __device__ __forceinline__ void a_ready(const Unit&) const {}
    __device__ __forceinline__ void done(const Unit&) const {}
};
struct MoeOrder {
    pg8::StaticOrder s; int nN, e0, e1, e2, e3, e4, e5, e6, e7;
    __device__ void init(const unsigned* cnt  , int nN_, int G_, int c_) { nN = nN_;
        int t = 0; t += (cnt[0] + 255) >> 8; e0 = t; t += (cnt[64] + 255) >> 8; e1 = t; t += (cnt[128] + 255) >> 8; e2 = t; t += (cnt[192] + 255) >> 8; e3 = t;
        t += (cnt[256] + 255) >> 8; e4 = t; t += (cnt[320] + 255) >> 8; e5 = t; t += (cnt[384] + 255) >> 8; e6 = t; t += (cnt[448] + 255) >> 8; e7 = t;
        s.init(e7 * 256, nN_ * 256, G_, c_); }
    __device__ bool next(int i, Unit& u) const { Unit t; t.pm = 0; t.pn = 0; if (!s.next(i, t)) return false;
        const int pm = t.pm, e = (pm >= e0) + (pm >= e1) + (pm >= e2) + (pm >= e3) + (pm >= e4) + (pm >= e5) + (pm >= e6);
        u.pm = rfl(pm); u.pn = rfl(e * nN + t.pn); return true; }
    __device__ __forceinline__ void a_ready(const Unit&) const {}
    __device__ __forceinline__ void done(const Unit&) const {}
};

__device__ __forceinline__ u32x4 pack8(f32x4 v0, f32x4 v1) { u32x4 w; w.x = cvt_pk_bf16(v0[0], v0[1]); w.y = cvt_pk_bf16(v0[2], v0[3]); w.z = cvt_pk_bf16(v1[0], v1[1]); w.w = cvt_pk_bf16(v1[2], v1[3]); return w; }
__device__ __forceinline__ void unpack8(u32x4 w, f32x4& v0, f32x4& v1) {
    v0 = (f32x4){blo(w.x), bhi(w.x), blo(w.y), bhi(w.y)}; v1 = (f32x4){blo(w.z), bhi(w.z), blo(w.w), bhi(w.w)}; }

struct EpiProj {
    static constexpr bool PERM = true, AFTER_DRAIN = false;
    unsigned char* ws;
    __device__ __forceinline__ void operator()(const f32x4 (&acc)[2][2][4][2], const Unit& u, int wr, int wc, int fr, int fq) const {
        bf16* const QB = (bf16*)(ws + AR_QB); bf16* const KV = (bf16*)(ws + AR_KV); bf16* const UB = (bf16*)(ws + AR_UB); bf16* const RW = (bf16*)(ws + AR_RW); bf16* const HALO = (bf16*)(ws + AR_HALO); bf16* const CKV = (bf16*)(ws + AR_CKV);
        const int row0 = u.pm * BM + wr * 64 + fr, cl = wc * 32 + 8 * fq;
        if (u.pn >= 5 && u.pn < 9) {
#pragma unroll
            for (int ai = 0; ai < 2; ++ai)
#pragma unroll
                for (int m = 0; m < 4; ++m) { f32x4 a0 = acc[ai][0][m][0], a1 = acc[ai][0][m][1]; const f32x4 b0 = acc[ai][1][m][0], b1 = acc[ai][1][m][1];
#pragma unroll
                    for (int k = 0; k < 4; ++k) { a0[k] *= fsig(b0[k]); a1[k] *= fsig(b1[k]); }
                    *(u32x4*)(UB + (size_t)(row0 + ai * HALF + m * 16) * 512 + (u.pn - 5) * 128 + cl) = pack8(a0, a1); }
            return;
        }
        if (u.pn == 2) {
#pragma unroll
            for (int ai = 0; ai < 2; ++ai)
#pragma unroll
                for (int m = 0; m < 4; ++m) { const int row = row0 + ai * HALF + m * 16, b = row / SEQ, tt = row % SEQ;
#pragma unroll
                    for (int bj = 0; bj < 2; ++bj) *(u32x4*)(CKV + (((size_t)bj * (BATCH * NKV) + b * NKV + (cl >> 6)) * SEQ + tt) * 64 + (cl & 63)) = pack8(acc[ai][bj][m][0], acc[ai][bj][m][1]); }
            return;
        }
        bf16* base; int ld, c0;
        if (u.pn < 2) { base = QB; ld = LDQ; c0 = u.pn * 256; } else if (u.pn < 5) { base = KV; ld = LDKV; c0 = (u.pn - 3) * 256; } else { base = RW; ld = LDRW; c0 = (u.pn - 9) * 256; }
#pragma unroll
        for (int ai = 0; ai < 2; ++ai)
#pragma unroll
            for (int m = 0; m < 4; ++m)
#pragma unroll
                for (int bj = 0; bj < 2; ++bj) { const u32x4 w = pack8(acc[ai][bj][m][0], acc[ai][bj][m][1]);
                    *(u32x4*)(base + (size_t)(row0 + ai * HALF + m * 16) * ld + c0 + bj * HALF + cl) = w;
                    if (u.pn >= 9 && ai == 1 && m == 3 && wr == 1 && fr == 15) *(u32x4*)(HALO + (size_t)u.pm * LDRW + c0 + bj * HALF + cl) = w; }
    }
};
struct EpiStore {
    static constexpr bool PERM = true, AFTER_DRAIN = false;
    bf16* O; int ld, ntn;
    __device__ __forceinline__ void operator()(const f32x4 (&acc)[2][2][4][2], const Unit& u, int wr, int wc, int fr, int fq) const {
        const int row0 = u.pm * BM + wr * 64 + fr, c0 = (u.pn % ntn) * 256 + wc * 32 + 8 * fq;
#pragma unroll
        for (int ai = 0; ai < 2; ++ai)
#pragma unroll
            for (int m = 0; m < 4; ++m)
#pragma unroll
                for (int bj = 0; bj < 2; ++bj) *(u32x4*)(O + (size_t)(row0 + ai * HALF + m * 16) * ld + c0 + bj * HALF) = pack8(acc[ai][bj][m][0], acc[ai][bj][m][1]);
    }
};
struct EpiGate {
    static constexpr bool PERM = true, AFTER_DRAIN = false;
    unsigned char* ws; int ntn;
    template <bool ACC>
    __device__ __forceinline__ void body(const f32x4 (&acc)[2][2][4][2], const bf16* ob, bf16* MIX, int row0, int c0) const {
#pragma unroll
        for (int ai = 0; ai < 2; ++ai) {
            u32x4 o[4][2], mx[4][2];
#pragma unroll
            for (int m = 0; m < 4; ++m)
#pragma unroll
                for (int bj = 0; bj < 2; ++bj) { const size_t off = (size_t)(row0 + ai * HALF + m * 16) * DM + c0 + bj * HALF; o[m][bj] = *(const u32x4*)(ob + off); if (ACC) mx[m][bj] = *(const u32x4*)(MIX + off); }
#pragma unroll
            for (int m = 0; m < 4; ++m)
#pragma unroll
                for (int bj = 0; bj < 2; ++bj) { const size_t off = (size_t)(row0 + ai * HALF + m * 16) * DM + c0 + bj * HALF;
                    f32x4 o0, o1; unpack8(o[m][bj], o0, o1);
                    f32x4 g0 = acc[ai][bj][m][0], g1 = acc[ai][bj][m][1];
#pragma unroll
                    for (int k = 0; k < 4; ++k) { g0[k] = fsig(g0[k]) * o0[k]; g1[k] = fsig(g1[k]) * o1[k]; }
                    if (ACC) { f32x4 p0, p1; unpack8(mx[m][bj], p0, p1); g0 += p0; g1 += p1; }
                    *(u32x4*)(MIX + off) = pack8(g0, g1); }
        }
    }
    __device__ __forceinline__ void operator()(const f32x4 (&acc)[2][2][4][2], const Unit& u, int wr, int wc, int fr, int fq) const {
        const bf16* const OB = (const bf16*)(ws + AR_OBUF); bf16* const MIX = (bf16*)(ws + AR_MIX);
        const int br = u.pn / ntn, row0 = u.pm * BM + wr * 64 + fr, c0 = (u.pn % ntn) * 256 + wc * 32 + 8 * fq;
        const bf16* ob = OB + (size_t)br * T * DM;
        if (br == 0) body<false>(acc, ob, MIX, row0, c0); else body<true>(acc, ob, MIX, row0, c0);
    }
};
struct EpiResid {
    static constexpr bool PERM = true, AFTER_DRAIN = false;
    const float* base; float* out;
    __device__ __forceinline__ void operator()(const f32x4 (&acc)[2][2][4][2], const Unit& u, int wr, int wc, int fr, int fq) const {
        const int row0 = u.pm * BM + wr * 64 + fr, c0 = u.pn * 256 + wc * 32 + 8 * fq;
#pragma unroll
        for (int ai = 0; ai < 2; ++ai)
#pragma unroll
            for (int mh = 0; mh < 2; ++mh) {
                f32x4 x[2][2][2];
#pragma unroll
                for (int mm = 0; mm < 2; ++mm)
#pragma unroll
                    for (int bj = 0; bj < 2; ++bj) { const size_t off = (size_t)(row0 + ai * HALF + (2 * mh + mm) * 16) * DM + c0 + bj * HALF; x[mm][bj][0] = *(const f32x4*)(base + off); x[mm][bj][1] = *(const f32x4*)(base + off + 4); }
#pragma unroll
                for (int mm = 0; mm < 2; ++mm)
#pragma unroll
                    for (int bj = 0; bj < 2; ++bj) { const int m = 2 * mh + mm; const size_t off = (size_t)(row0 + ai * HALF + m * 16) * DM + c0 + bj * HALF;
                        *(f32x4*)(out + off) = x[mm][bj][0] + acc[ai][bj][m][0]; *(f32x4*)(out + off + 4) = x[mm][bj][1] + acc[ai][bj][m][1]; }
            }
    }
};
struct EpiSwiglu {
    static constexpr bool PERM = true, AFTER_DRAIN = false;
    bf16* ACT; int ld, ntn;
    __device__ __forceinline__ void operator()(const f32x4 (&acc)[2][2][4][2], const Unit& u, int wr, int wc, int fr, int fq) const {
        const int row0 = u.pm * BM + wr * 64 + fr, c0 = (u.pn % ntn) * 128 + wc * 32 + 8 * fq;
#pragma unroll
        for (int ai = 0; ai < 2; ++ai)
#pragma unroll
            for (int m = 0; m < 4; ++m) { f32x4 g0 = acc[ai][0][m][0], g1 = acc[ai][0][m][1]; const f32x4 u0 = acc[ai][1][m][0], u1 = acc[ai][1][m][1];
#pragma unroll
                for (int k = 0; k < 4; ++k) { g0[k] = g0[k] * fsig(g0[k]) * u0[k]; g1[k] = g1[k] * fsig(g1[k]) * u1[k]; }
                *(u32x4*)(ACT + (size_t)(row0 + ai * HALF + m * 16) * ld + c0) = pack8(g0, g1); }
    }
};
struct EpiMoeDown {
    static constexpr bool PERM = true, AFTER_DRAIN = false;
    float* out; const int* rtok; const float* rw; int ntn; float sc;
    __device__ __forceinline__ void operator()(const f32x4 (&acc)[2][2][4][2], const Unit& u, int wr, int wc, int fr, int fq) const {
        const int row0 = u.pm * BM + wr * 64 + fr, c0 = (u.pn % ntn) * 256 + wc * 32 + 8 * fq;
#pragma unroll
        for (int ai = 0; ai < 2; ++ai)
#pragma unroll
            for (int mh = 0; mh < 2; ++mh) {
                int tok[2]; float w[2]; f32x4 x[2][2][2];
#pragma unroll
                for (int mm = 0; mm < 2; ++mm) { const int row = row0 + ai * HALF + (2 * mh + mm) * 16; tok[mm] = rtok[row]; w[mm] = rw[row] * sc; }
#pragma unroll
                for (int mm = 0; mm < 2; ++mm)
#pragma unroll
                    for (int bj = 0; bj < 2; ++bj) { const float* o = out + (size_t)(tok[mm] >= 0 ? tok[mm] : 0) * DM + c0 + bj * HALF; x[mm][bj][0] = *(const f32x4*)o; x[mm][bj][1] = *(const f32x4*)(o + 4); }
#pragma unroll
                for (int mm = 0; mm < 2; ++mm)
#pragma unroll
                    for (int bj = 0; bj < 2; ++bj) if (tok[mm] >= 0) { const int m = 2 * mh + mm; float* o = out + (size_t)tok[mm] * DM + c0 + bj * HALF;
                        *(f32x4*)o = x[mm][bj][0] + acc[ai][bj][m][0] * w[mm]; *(f32x4*)(o + 4) = x[mm][bj][1] + acc[ai][bj][m][1] * w[mm]; }
            }
    }
};

constexpr int MT_KS = 7, MT_K = EXPERT_FF / MT_KS;
struct MoeTailOrder {
    int nN, pm0, nsub, G, c, e0, e1, e2, e3, e4, e5, e6;
    __device__ void init(const MoeOrder& m, int pm0_, int ntiles, int G_, int c_) { nN = m.nN; pm0 = pm0_; nsub = ntiles * MT_KS; G = G_; c = c_; e0 = m.e0; e1 = m.e1; e2 = m.e2; e3 = m.e3; e4 = m.e4; e5 = m.e5; e6 = m.e6; }
    __device__ bool next(int i, Unit& u) const { const int L = i * G + c; if (L >= nsub) return false;
        const int j = L / MT_KS, ks = L - j * MT_KS, pm = pm0 + j / nN, pl = j % nN, e = (pm >= e0) + (pm >= e1) + (pm >= e2) + (pm >= e3) + (pm >= e4) + (pm >= e5) + (pm >= e6);
        u.pm = rfl(pm); u.pn = rfl((e * nN + pl) | (ks << 16)); return true; }
    __device__ __forceinline__ void a_ready(const Unit&) const {}
    __device__ __forceinline__ void done(const Unit&) const {}
};
struct EpiPart {
    static constexpr bool PERM = true, AFTER_DRAIN = false;
    float* part; int pm0, nN;
    __device__ __forceinline__ void operator()(const f32x4 (&acc)[2][2][4][2], const Unit& u, int wr, int wc, int fr, int fq) const {
        const int slot = ((u.pm - pm0) * nN + (u.pn & 0xffff) % nN) * MT_KS + (u.pn >> 16);
        float* b = part + (size_t)slot * 65536 + (size_t)(((wr * 4 + wc) * 64 + fq * 16 + fr) * 4);
#pragma unroll
        for (int ai = 0; ai < 2; ++ai)
#pragma unroll
            for (int bj = 0; bj < 2; ++bj)
#pragma unroll
                for (int m = 0; m < 4; ++m)
#pragma unroll
                    for (int n = 0; n < 2; ++n) *(f32x4*)(b + (((ai * 2 + bj) * 4 + m) * 2 + n) * 2048) = acc[ai][bj][m][n];
    }
};
__device__ __forceinline__ void moe_tail_combine(const EpiMoeDown& E, const MoeOrder& mo, const float* part, int pm0, int job, int lane_in) {
    int lane = lane_in; asm volatile("" : "+v"(lane));
    const int q = job & 3, role = (job >> 2) & 7, j = job >> 5, ai = q >> 1, mh = q & 1, pm = pm0 + j / mo.nN, pl = j % mo.nN, wr = role >> 2, wc = role & 3, fr = lane & 15, fq = lane >> 4;
    const float* b = part + (size_t)j * MT_KS * 65536 + (size_t)((role * 64 + lane) * 4);
    f32x4 a[2][2][2];
#pragma unroll
    for (int mm = 0; mm < 2; ++mm)
#pragma unroll
        for (int bj = 0; bj < 2; ++bj)
#pragma unroll
            for (int n = 0; n < 2; ++n) a[mm][bj][n] = *(const f32x4*)(b + (((ai * 2 + bj) * 4 + 2 * mh + mm) * 2 + n) * 2048);
#pragma unroll
    for (int ks = 1; ks < MT_KS; ++ks)
#pragma unroll
        for (int mm = 0; mm < 2; ++mm)
#pragma unroll
            for (int bj = 0; bj < 2; ++bj)
#pragma unroll
                for (int n = 0; n < 2; ++n) a[mm][bj][n] += *(const f32x4*)(b + (size_t)ks * 65536 + (((ai * 2 + bj) * 4 + 2 * mh + mm) * 2 + n) * 2048);
    const int row0 = pm * BM + wr * 64 + fr + ai * HALF + 2 * mh * 16, c0 = pl * 256 + wc * 32 + 8 * fq;
#pragma unroll
    for (int mm = 0; mm < 2; ++mm) { const int tok = E.rtok[row0 + mm * 16]; const float w = E.rw[row0 + mm * 16] * E.sc;
        if (tok >= 0) {
#pragma unroll
            for (int bj = 0; bj < 2; ++bj) { float* o = E.out + (size_t)tok * DM + c0 + bj * HALF; const f32x4 x0 = *(const f32x4*)o, x1 = *(const f32x4*)(o + 4);
                *(f32x4*)o = x0 + a[mm][bj][0] * w; *(f32x4*)(o + 4) = x1 + a[mm][bj][1] * w; } } }
}

typedef short bf16x8_t __attribute__((ext_vector_type(8)));
#define MFMA16(a, b, c) __builtin_amdgcn_mfma_f32_16x16x32_bf16((a), (b), (c), 0, 0, 0)
constexpr float ATT_C = 0.125f * 1.4426950408889634f;
constexpr int AW_IMP = 0, AW_SEL = 8448, AW_QS = 8960, AW_ENT = 8960 + 8192, AW_BYTES = 8960 + 8192 + 320;
__device__ __forceinline__ float bperm_f(float v, int srclane) { return __builtin_bit_cast(float, __builtin_amdgcn_ds_bpermute(srclane << 2, __builtin_bit_cast(int, v))); }
__device__ __forceinline__ int bperm_i(int v, int srclane) { return __builtin_amdgcn_ds_bpermute(srclane << 2, v); }
__device__ __forceinline__ bf16x8_t ldg8(const bf16* p) { return *(const bf16x8_t*)p; }
__device__ __forceinline__ bf16x8_t pack_p(const f32x4& a, const f32x4& b) {
    v4u w; w.x = cvt_pk_bf16(a[0], a[1]); w.y = cvt_pk_bf16(a[2], a[3]); w.z = cvt_pk_bf16(b[0], b[1]); w.w = cvt_pk_bf16(b[2], b[3]); return __builtin_bit_cast(bf16x8_t, w); }

__device__ __forceinline__ void nsa_attn_item(const P& p, int item, int lane, LAS unsigned char* wl) {
    const bf16* KV = WSP(bf16, AR_KV); const bf16* KC = WSP(bf16, AR_KC); const bf16* VcT = WSP(bf16, AR_VCT); const bf16* VsT = WSH(bf16, WS_VST); const bf16* VwT = WSH(bf16, WS_VWT);
    bf16* QB = WSP(bf16, AR_QB); const float* NG = WSP(float, AR_NG);
    const int bg = item / (SEQ / 16), t0 = (item % (SEQ / 16)) * 16, b = bg >> 1, g = bg & 1;
    const int col = lane & 15, fq = lane >> 4, tok = t0 + col;
    const size_t grow = (size_t)b * SEQ + tok;
    LAS float* IMP = (LAS float*)(wl + AW_IMP); LAS int* SEL = (LAS int*)(wl + AW_SEL); LAS bf16* OS = (LAS bf16*)(wl + AW_IMP);
    const int krowA = 8 * (col >> 2) + (col & 3);
    const float* gate = NG + grow * 24 + g * 12;
    LAS bf16x8_t* QS = (LAS bf16x8_t*)(wl + AW_QS) + lane;
#pragma unroll
    for (int hh = 0; hh < 4; ++hh)
#pragma unroll
        for (int ks = 0; ks < 2; ++ks) QS[(hh * 2 + ks) * 64] = ldg8(QB + grow * LDQ + (g * 4 + hh) * 64 + ks * 32 + fq * 8);
#define Qc(hh, ks) (QS[((hh) * 2 + (ks)) * 64])
    for (int i = lane; i < 16 * 132; i += 64) IMP[i] = 0.f;
    const f32x4 z4 = {0.f, 0.f, 0.f, 0.f};
    f32x4 O[4][4];
    int nvmax = (t0 + 15 >= 31) ? (((t0 + 15 - 31) >> 4) + 1) : 0; if (nvmax > NC) nvmax = NC;
    const int nch = (nvmax + 31) >> 5;
    const bf16* kcb = KC + (size_t)bg * 512 * 64; const bf16* vcb = VcT + (size_t)bg * 64 * 512;
    float linv[4] = {0.f, 0.f, 0.f, 0.f};
#pragma unroll
    for (int hh = 0; hh < 4; ++hh)
#pragma unroll
        for (int mt = 0; mt < 4; ++mt) O[hh][mt] = z4;
#pragma unroll
    for (int pass = 0; pass < 2; ++pass) {
#pragma unroll 1
        for (int ch = 0; ch < nch; ++ch) {
            asm volatile("" ::: "memory");
            const int k0 = 32 * ch; const bool cfull = 16 * (k0 + 31) + 31 <= t0;
            bf16x8_t ka[2][2];
#pragma unroll
            for (int tl = 0; tl < 2; ++tl)
#pragma unroll
                for (int ks = 0; ks < 2; ++ks) ka[tl][ks] = ldg8(kcb + ((size_t)(4 * ks + fq) * 512 + k0 + 16 * tl + col) * 8);
            bf16x8_t va[4];
            if (pass == 1) {
#pragma unroll
                for (int mt = 0; mt < 4; ++mt) va[mt] = ldg8(vcb + ((size_t)((k0 >> 3) + fq) * 64 + 16 * mt + col) * 8);
            }
            float ps[8] = {0.f, 0.f, 0.f, 0.f, 0.f, 0.f, 0.f, 0.f};
#pragma unroll
            for (int hh = 0; hh < 4; ++hh) {
                const bf16x8_t q0_ = Qc(hh, 0), q1_ = Qc(hh, 1);
                f32x4 sa = MFMA16(ka[0][0], q0_, z4); sa = MFMA16(ka[0][1], q1_, sa);
                f32x4 sb = MFMA16(ka[1][0], q0_, z4); sb = MFMA16(ka[1][1], q1_, sb);
#pragma unroll
                for (int i = 0; i < 4; ++i) { sa[i] = __builtin_amdgcn_exp2f(sa[i]); sb[i] = __builtin_amdgcn_exp2f(sb[i]); }
                if (!cfull) {
#pragma unroll
                    for (int i = 0; i < 4; ++i) { const int c = k0 + 4 * fq + i; sa[i] = (16 * c + 31 <= tok) ? sa[i] : 0.f; sb[i] = (16 * (c + 16) + 31 <= tok) ? sb[i] : 0.f; } }
                if (pass == 0) { linv[hh] += (sa[0] + sa[1]) + (sa[2] + sa[3]) + (sb[0] + sb[1]) + (sb[2] + sb[3]); }
                else {
#pragma unroll
                    for (int i = 0; i < 4; ++i) { ps[i] = __builtin_fmaf(sa[i], linv[hh], ps[i]); ps[4 + i] = __builtin_fmaf(sb[i], linv[hh], ps[4 + i]); }
                    const bf16x8_t pt = pack_p(sa, sb);
#pragma unroll
                    for (int mt = 0; mt < 4; ++mt) O[hh][mt] = MFMA16(va[mt], pt, O[hh][mt]);
                }
            }
            if (pass == 1) {
                const int Ga = 8 * ch + fq; LAS float* ir = IMP + col * 132 + Ga;
                __hip_atomic_fetch_add(ir, (ps[0] + ps[1]) + (ps[2] + ps[3]), __ATOMIC_RELAXED, __HIP_MEMORY_SCOPE_WORKGROUP);
                __hip_atomic_fetch_add(ir + 1, ps[3], __ATOMIC_RELAXED, __HIP_MEMORY_SCOPE_WORKGROUP);
                __hip_atomic_fetch_add(ir + 4, (ps[4] + ps[5]) + (ps[6] + ps[7]), __ATOMIC_RELAXED, __HIP_MEMORY_SCOPE_WORKGROUP);
                if (Ga + 5 < NS) __hip_atomic_fetch_add(ir + 5, ps[7], __ATOMIC_RELAXED, __HIP_MEMORY_SCOPE_WORKGROUP);
            }
        }
        if (pass == 0) {
#pragma unroll
            for (int hh = 0; hh < 4; ++hh) { float l = linv[hh]; l += bperm_f(l, lane ^ 16); l += bperm_f(l, lane ^ 32); linv[hh] = l > 0.f ? 1.f / l : 0.f; }
        }
    }
    LDS_WAIT(); asm volatile("" ::: "memory");
    {
        const int cur = tok >> 6; const LAS float* sc = IMP + col * 132 + fq * 32;
        float cv[32];
#pragma unroll
        for (int q = 0; q < 8; ++q) { const f32x4 t4 = *(const LAS f32x4*)(sc + 4 * q); cv[4 * q] = t4.x; cv[4 * q + 1] = t4.y; cv[4 * q + 2] = t4.z; cv[4 * q + 3] = t4.w; }
#pragma unroll
        for (int i = 0; i < 32; ++i) { const int j = fq * 32 + i; const bool forced = (j == 0) || (j == cur) || (j == cur - 1); cv[i] = forced ? 1e4f : (j <= cur ? cv[i] : -1.f); }
#pragma unroll 1
        for (int r = 0; r < 8; ++r) {
            float bv = cv[0]; int bj = 0;
#pragma unroll
            for (int i = 1; i < 32; ++i) { const bool gt = cv[i] > bv; bv = gt ? cv[i] : bv; bj = gt ? i : bj; }
            bj += fq * 32;
#pragma unroll
            for (int o = 16; o <= 32; o <<= 1) { const float ov = bperm_f(bv, lane ^ o); const int oj = bperm_i(bj, lane ^ o); if (ov > bv || (ov == bv && oj < bj)) { bv = ov; bj = oj; } }
            const int mine = bj - fq * 32;
#pragma unroll
            for (int i = 0; i < 32; ++i) cv[i] = (i == mine) ? -3e38f : cv[i];
            if (fq == 0) SEL[col * 8 + r] = bj;
        }
        LDS_WAIT(); asm volatile("" ::: "memory");
    }
#pragma unroll
    for (int hh = 0; hh < 4; ++hh) { const float g0 = gate[hh * 3 + 0] * linv[hh];
#pragma unroll
        for (int mt = 0; mt < 4; ++mt) { const f32x4 o = O[hh][mt] * g0; v2u w; w.x = cvt_pk_bf16(o[0], o[1]); w.y = cvt_pk_bf16(o[2], o[3]);
            *(LAS v2u*)(OS + (col * 4 + hh) * 64 + 16 * mt + 4 * fq) = w; } }
    LDS_WAIT(); asm volatile("" ::: "memory");
    const int cur = t0 >> 6;
    {
        const bf16* kwb = WSH(bf16, WS_KW8) + (size_t)bg * 8 * SEQ * 8; const bf16* vwb = VwT + (size_t)bg * 64 * SEQ;
        const bf16* ksb = WSH(bf16, WS_KS8) + (size_t)bg * 8 * SEQ * 8; const bf16* vsb = VsT + (size_t)bg * 64 * SEQ;
        int kst = t0 - (WINDOW - 1); if (kst < 0) kst = 0; kst &= ~31;
        const int nwin = ((t0 + 15 - kst) >> 5) + 1, nfb = cur >= 2 ? 3 : cur + 1;
#pragma unroll
        for (int part = 0; part < 2; ++part) {
            float lw[4] = {0.f, 0.f, 0.f, 0.f};
#pragma unroll
            for (int hh = 0; hh < 4; ++hh)
#pragma unroll
                for (int mt = 0; mt < 4; ++mt) O[hh][mt] = z4;
            const bf16* kb = part ? ksb : kwb; const bf16* vb = part ? vsb : vwb;
            const int nchk = part ? 2 * nfb : nwin;
#pragma unroll 1
            for (int ci = 0; ci < nchk; ++ci) {
                asm volatile("" ::: "memory");
                int k0;
                if (part == 0) k0 = kst + 32 * ci; else { const int fb = ci >> 1, j = fb == 0 ? 0 : (fb == 1 ? cur : cur - 1); k0 = 64 * j + 32 * (ci & 1); }
                bf16x8_t ka[2][2], va[4];
#pragma unroll
                for (int tl = 0; tl < 2; ++tl)
#pragma unroll
                    for (int ks = 0; ks < 2; ++ks) ka[tl][ks] = ldg8(kb + ((size_t)(4 * ks + fq) * SEQ + k0 + 16 * tl + col) * 8);
#pragma unroll
                for (int mt = 0; mt < 4; ++mt) va[mt] = ldg8(vb + ((size_t)((k0 >> 3) + fq) * 64 + 16 * mt + col) * 8);
                bf16x8_t qf[4][2];
#pragma unroll
                for (int hh = 0; hh < 4; ++hh) { qf[hh][0] = Qc(hh, 0); qf[hh][1] = Qc(hh, 1); }
                const int lowk = part ? -1 : tok - WINDOW; const bool dfull = (k0 + 31 <= t0) && (part || k0 > t0 + 15 - WINDOW);
#pragma unroll
                for (int hh = 0; hh < 4; ++hh) {
                    const bf16x8_t q0_ = qf[hh][0], q1_ = qf[hh][1];
                    f32x4 sa = MFMA16(ka[0][0], q0_, z4); sa = MFMA16(ka[0][1], q1_, sa);
                    f32x4 sb = MFMA16(ka[1][0], q0_, z4); sb = MFMA16(ka[1][1], q1_, sb);
#pragma unroll
                    for (int i = 0; i < 4; ++i) { sa[i] = __builtin_amdgcn_exp2f(sa[i]); sb[i] = __builtin_amdgcn_exp2f(sb[i]); }
                    if (!dfull) {
#pragma unroll
                        for (int i = 0; i < 4; ++i) { const int kt = k0 + 4 * fq + i; sa[i] = (kt <= tok && kt > lowk) ? sa[i] : 0.f; sb[i] = (kt + 16 <= tok && kt + 16 > lowk) ? sb[i] : 0.f; } }
                    lw[hh] += (sa[0] + sa[1]) + (sa[2] + sa[3]) + (sb[0] + sb[1]) + (sb[2] + sb[3]);
                    const bf16x8_t pt = pack_p(sa, sb);
#pragma unroll
                    for (int mt = 0; mt < 4; ++mt) O[hh][mt] = MFMA16(va[mt], pt, O[hh][mt]);
                }
            }
            LDS_WAIT(); asm volatile("" ::: "memory");
            if (part == 0) {
#pragma unroll
                for (int hh = 0; hh < 4; ++hh) { float l = lw[hh]; l += bperm_f(l, lane ^ 16); l += bperm_f(l, lane ^ 32); const float w = l > 0.f ? gate[hh * 3 + 2] / l : 0.f;
#pragma unroll
                    for (int mt = 0; mt < 4; ++mt) { LAS v2u* dp = (LAS v2u*)(OS + (col * 4 + hh) * 64 + 16 * mt + 4 * fq); const v2u old = *dp;
                        v2u w2; w2.x = cvt_pk_bf16(blo(old.x) + w * O[hh][mt][0], bhi(old.x) + w * O[hh][mt][1]); w2.y = cvt_pk_bf16(blo(old.y) + w * O[hh][mt][2], bhi(old.y) + w * O[hh][mt][3]); *dp = w2; } }
            } else {
                LAS bf16* OF = (LAS bf16*)(wl + AW_QS); LAS float* LF = (LAS float*)(wl + AW_IMP + 8192);
#pragma unroll
                for (int hh = 0; hh < 4; ++hh) { float l = lw[hh]; l += bperm_f(l, lane ^ 16); l += bperm_f(l, lane ^ 32); if (fq == 0) LF[col * 4 + hh] = l;
#pragma unroll
                    for (int mt = 0; mt < 4; ++mt) { v2u w2; w2.x = cvt_pk_bf16(O[hh][mt][0], O[hh][mt][1]); w2.y = cvt_pk_bf16(O[hh][mt][2], O[hh][mt][3]); *(LAS v2u*)(OF + (col * 4 + hh) * 64 + 16 * mt + 4 * fq) = w2; } }
            }
            LDS_WAIT(); asm volatile("" ::: "memory");
        }
    }
    {
        const bf16* ksb = WSH(bf16, WS_KS8) + (size_t)bg * 8 * SEQ * 8; const bf16* vsb = VsT + (size_t)bg * 64 * SEQ;
        const LAS bf16* OF = (const LAS bf16*)(wl + AW_QS); const LAS float* LF = (const LAS float*)(wl + AW_IMP + 8192);
        int ento_ = AW_ENT; asm volatile("" : "+s"(ento_)); LAS unsigned short* ENT = (LAS unsigned short*)(wl + ento_);
        int n;
        { const int ja = SEL[lane], jb = SEL[lane + 64], tqa = t0 + (lane >> 3), tqb = t0 + 8 + (lane >> 3);
          const bool va_ = !(64 * ja > tqa || ja == 0 || ja == cur || ja == cur - 1), vb_ = !(64 * jb > tqb || jb == 0 || jb == cur || jb == cur - 1);
          unsigned long long ba = __builtin_amdgcn_ballot_w64(va_), bb = __builtin_amdgcn_ballot_w64(vb_); const unsigned long long lt = (1ull << lane) - 1ull;
          const bool da_ = ((ba >> (lane & 56)) & 0xffull) == 0ull && (lane & 7) == 0, db_ = ((bb >> (lane & 56)) & 0xffull) == 0ull && (lane & 7) == 0;
          ba = __builtin_amdgcn_ballot_w64(va_ || da_); bb = __builtin_amdgcn_ballot_w64(vb_ || db_);
          const int na = __builtin_popcountll(ba); n = na + __builtin_popcountll(bb);
          if (va_ || da_) ENT[__builtin_popcountll(ba & lt)] = (unsigned short)(((lane >> 3) << 8) | (va_ ? ja : 0x8000));
          if (vb_ || db_) ENT[na + __builtin_popcountll(bb & lt)] = (unsigned short)(((8 + (lane >> 3)) << 8) | (vb_ ? jb : 0x8000));
          if (lane < 3) ENT[n + lane] = (unsigned short)(0x8000 | (15 << 8));
          LDS_WAIT(); asm volatile("" ::: "memory"); }
        const float gate_l = (NG + ((size_t)b * SEQ + t0 + (lane >> 2)) * 24 + g * 12)[(lane & 3) * 3 + 1];
        const bf16* qsrc = QB + ((size_t)b * SEQ + t0) * LDQ + (g * 4 + (col & 3)) * 64 + fq * 8;
        bf16x8_t Qh[2], Qn[2]; f32x4 Os[4] = {z4, z4, z4, z4}; float ls = 0.f; int cur_tt = -1;
        Qn[0] = ldg8(qsrc); Qn[1] = ldg8(qsrc + 32);
        bf16x8_t kX[2][2], vX[4], kY[2][2], vY[4], kZ[2][2], vZ[4];
#define SEL_ISSUE(K_, V_, ENT_, HF_) do { const int kb0_ = 64 * ((ENT_) & 255) + 32 * (HF_); \
            _Pragma("unroll") for (int tl = 0; tl < 2; ++tl) _Pragma("unroll") for (int ks = 0; ks < 2; ++ks) K_[tl][ks] = ldg8(ksb + ((size_t)(4 * ks + fq) * SEQ + kb0_ + 16 * tl + col) * 8); \
            _Pragma("unroll") for (int mt = 0; mt < 4; ++mt) V_[mt] = ldg8(vsb + ((size_t)((kb0_ >> 3) + fq) * 64 + 16 * mt + col) * 8); } while (0)
#define SEL_COMPUTE(K_, V_, ENT_) do { if (!((ENT_) & 0x8000)) { \
            f32x4 sa = MFMA16(K_[0][0], Qh[0], z4); sa = MFMA16(K_[0][1], Qh[1], sa); f32x4 sb = MFMA16(K_[1][0], Qh[0], z4); sb = MFMA16(K_[1][1], Qh[1], sb); \
            _Pragma("unroll") for (int i = 0; i < 4; ++i) { sa[i] = __builtin_amdgcn_exp2f(sa[i]); sb[i] = __builtin_amdgcn_exp2f(sb[i]); } \
            ls += (sa[0] + sa[1]) + (sa[2] + sa[3]) + (sb[0] + sb[1]) + (sb[2] + sb[3]); const bf16x8_t pt = pack_p(sa, sb); \
            _Pragma("unroll") for (int mt = 0; mt < 4; ++mt) Os[mt] = MFMA16(V_[mt], pt, Os[mt]); } } while (0)
#define SEL_FINAL(tz) do { float l_ = ls; l_ += bperm_f(l_, lane ^ 16); l_ += bperm_f(l_, lane ^ 32); const float gt_ = bperm_f(gate_l, (tz) * 4 + (col & 3)); \
            if (col < 4) { const float den = l_ + LF[(tz) * 4 + col]; const float w = den > 0.f ? gt_ / den : 0.f; \
                _Pragma("unroll") for (int mt = 0; mt < 4; ++mt) { const int e_ = ((tz) * 4 + col) * 64 + 16 * mt + 4 * fq; const v2u old = *(const LAS v2u*)(OS + e_), fo = *(const LAS v2u*)(OF + e_); \
                    v2u w2; w2.x = cvt_pk_bf16(blo(old.x) + w * (Os[mt][0] + blo(fo.x)), bhi(old.x) + w * (Os[mt][1] + bhi(fo.x))); w2.y = cvt_pk_bf16(blo(old.y) + w * (Os[mt][2] + blo(fo.y)), bhi(old.y) + w * (Os[mt][3] + bhi(fo.y))); \
                    *(LAS v2u*)(OS + e_) = w2; } } \
            Os[0] = z4; Os[1] = z4; Os[2] = z4; Os[3] = z4; ls = 0.f; } while (0)
#define SEL_ADVANCE(ENT_) do { const int tt_ = ((ENT_) >> 8) & 15; if (tt_ != cur_tt) { if (cur_tt >= 0) SEL_FINAL(cur_tt); cur_tt = tt_; Qh[0] = Qn[0]; Qh[1] = Qn[1]; \
                if (col >= 4) { Qh[0] = (bf16x8_t){0, 0, 0, 0, 0, 0, 0, 0}; Qh[1] = (bf16x8_t){0, 0, 0, 0, 0, 0, 0, 0}; } } \
            const int tn_ = tt_ + 1 < 16 ? tt_ + 1 : 15; Qn[0] = ldg8(qsrc + (size_t)tn_ * LDQ); Qn[1] = ldg8(qsrc + (size_t)tn_ * LDQ + 32); } while (0)
#define ENTRD(i_) __builtin_amdgcn_readfirstlane((int)ENT[(i_)])
        int e0 = ENTRD(0);
        SEL_ISSUE(kX, vX, e0, 0); SEL_ISSUE(kY, vY, e0, 1);
        const int np = ((n + 2) / 3) * 3;
#pragma unroll 1
        for (int e = 0; e < np; e += 3) {
            const int e1 = ENTRD(e + 1), e2 = ENTRD(e + 2), e3 = ENTRD(e + 3);
            SEL_ADVANCE(e0);
            SEL_ISSUE(kZ, vZ, e1, 0); SEL_COMPUTE(kX, vX, e0);
            SEL_ISSUE(kX, vX, e1, 1); SEL_COMPUTE(kY, vY, e0);
            SEL_ADVANCE(e1);
            SEL_ISSUE(kY, vY, e2, 0); SEL_COMPUTE(kZ, vZ, e1);
            SEL_ISSUE(kZ, vZ, e2, 1); SEL_COMPUTE(kX, vX, e1);
            SEL_ADVANCE(e2);
            SEL_ISSUE(kX, vX, e3, 0); SEL_COMPUTE(kY, vY, e2);
            SEL_ISSUE(kY, vY, e3, 1); SEL_COMPUTE(kZ, vZ, e2);
            e0 = e3;
        }
        SEL_FINAL(15);
#undef ENTRD
#undef SEL_ISSUE
#undef SEL_COMPUTE
#undef SEL_FINAL
#undef SEL_ADVANCE
        LDS_WAIT(); asm volatile("" ::: "memory");
        { int l2 = lane; asm volatile("" : "+v"(l2)); bf16* orow = QB + ((size_t)b * SEQ + t0) * LDQ + g * 256;
#pragma unroll 2
          for (int i = 0; i < 8; ++i) { const int pc = i * 64 + l2; *(v4u*)(orow + (size_t)(pc >> 5) * LDQ + (pc & 31) * 8) = *(const LAS v4u*)(OS + pc * 8); } }
    }
    LDS_WAIT(); asm volatile("" ::: "memory");
#undef Qc
}

typedef _Float16 h16x2 __attribute__((ext_vector_type(2)));
__device__ __forceinline__ h16x2 as_h2(unsigned u) { h16x2 r; __builtin_memcpy(&r, &u, 4); return r; }
constexpr int SC_STEPS = 8, SC_BUF = 6 * 1024;
__device__ __forceinline__ float dpp_sum16(float v) {
    v += __builtin_bit_cast(float, __builtin_amdgcn_update_dpp(0, __builtin_bit_cast(int, v), 0xB1, 0xF, 0xF, true));
    v += __builtin_bit_cast(float, __builtin_amdgcn_update_dpp(0, __builtin_bit_cast(int, v), 0x4E, 0xF, 0xF, true));
    v += __builtin_bit_cast(float, __builtin_amdgcn_update_dpp(0, __builtin_bit_cast(int, v), 0x141, 0xF, 0xF, true));
    v += __builtin_bit_cast(float, __builtin_amdgcn_update_dpp(0, __builtin_bit_cast(int, v), 0x140, 0xF, 0xF, true));
    return v;
}
#ifdef SCAN_ASM_FMIX
__device__ __forceinline__ float fmix_lo(float a, unsigned b, float c) { float d; asm("v_fma_mix_f32 %0, %1, %2, %3 op_sel_hi:[0,1,0]" : "=v"(d) : "v"(a), "v"(b), "v"(c)); return d; }
__device__ __forceinline__ float fmix_hi(float a, unsigned b, float c) { float d; asm("v_fma_mix_f32 %0, %1, %2, %3 op_sel:[0,1,0] op_sel_hi:[0,1,0]" : "=v"(d) : "v"(a), "v"(b), "v"(c)); return d; }
__device__ __forceinline__ float fmix_lo0(float a, unsigned b) { float d; asm("v_fma_mix_f32 %0, %1, %2, 0 op_sel_hi:[0,1,0]" : "=v"(d) : "v"(a), "v"(b)); return d; }
__device__ __forceinline__ float fmix_nlo(float a, unsigned b, float c) { float d; asm("v_fma_mix_f32 %0, %1, -%2, %3 op_sel_hi:[0,1,0]" : "=v"(d) : "v"(a), "v"(b), "v"(c)); return d; }
__device__ __forceinline__ float fmix_nhi(float a, unsigned b, float c) { float d; asm("v_fma_mix_f32 %0, %1, -%2, %3 op_sel:[0,1,0] op_sel_hi:[0,1,0]" : "=v"(d) : "v"(a), "v"(b), "v"(c)); return d; }
__device__ __forceinline__ float fmix_hlo(unsigned a, unsigned b, float c) { float d; asm("v_fma_mix_f32 %0, %1, %2, %3 op_sel_hi:[1,1,0]" : "=v"(d) : "v"(a), "v"(b), "v"(c)); return d; }
__device__ __forceinline__ float fmix_hhi(unsigned a, unsigned b, float c) { float d; asm("v_fma_mix_f32 %0, %1, %2, %3 op_sel:[0,1,0] op_sel_hi:[1,1,0]" : "=v"(d) : "v"(a), "v"(b), "v"(c)); return d; }
#else
__device__ __forceinline__ float fmix_lo(float a, unsigned b, float c) { return __builtin_fmaf(a, (float)as_h2(b).x, c); }
__device__ __forceinline__ float fmix_hi(float a, unsigned b, float c) { return __builtin_fmaf(a, (float)as_h2(b).y, c); }
__device__ __forceinline__ float fmix_lo0(float a, unsigned b) { return __builtin_fmaf(a, (float)as_h2(b).x, 0.f); }
__device__ __forceinline__ float fmix_nlo(float a, unsigned b, float c) { return __builtin_fmaf(a, -(float)as_h2(b).x, c); }
__device__ __forceinline__ float fmix_nhi(float a, unsigned b, float c) { return __builtin_fmaf(a, -(float)as_h2(b).y, c); }
__device__ __forceinline__ float fmix_hlo(unsigned a, unsigned b, float c) { return __builtin_fmaf((float)as_h2(a).x, (float)as_h2(b).x, c); }
__device__ __forceinline__ float fmix_hhi(unsigned a, unsigned b, float c) { return __builtin_fmaf((float)as_h2(a).x, (float)as_h2(b).y, c); }
#endif
__device__ __forceinline__ void dpp_sum16x2(float& a, float& b) {
#define DPPA_(v, c) v += __builtin_bit_cast(float, __builtin_amdgcn_update_dpp(0, __builtin_bit_cast(int, v), c, 0xF, 0xF, true))
    DPPA_(a, 0xB1); DPPA_(b, 0xB1); DPPA_(a, 0x4E); DPPA_(b, 0x4E); DPPA_(a, 0x141); DPPA_(b, 0x141); DPPA_(a, 0x140); DPPA_(b, 0x140);
#undef DPPA_
}
__device__ __forceinline__ void scan_fill(const bf16* RW, const bf16* Wm, const bf16* Am, size_t trow, int h, int lane, LAS unsigned char* buf) {
    const size_t t = trow + (lane >> 3); const int sub = (lane & 7) * 8;
    const bf16* row = RW + t * LDRW + h * 64 + sub;
    __builtin_amdgcn_global_load_lds((const unsigned*)(row + LBLK), (LAS unsigned*)(buf + 0 * 1024), 16, 0, 0);
    __builtin_amdgcn_global_load_lds((const unsigned*)(Am + t * RC + h * 64 + sub), (LAS unsigned*)(buf + 1 * 1024), 16, 0, 0);
    __builtin_amdgcn_global_load_lds((const unsigned*)(Wm + t * RC + h * 64 + sub), (LAS unsigned*)(buf + 2 * 1024), 16, 0, 0);
    __builtin_amdgcn_global_load_lds((const unsigned*)(row + 512), (LAS unsigned*)(buf + 3 * 1024), 16, 0, 0);
    __builtin_amdgcn_global_load_lds((const unsigned*)(row), (LAS unsigned*)(buf + 4 * 1024), 16, 0, 0);
    __builtin_amdgcn_global_load_lds((const unsigned*)(row + 1024), (LAS unsigned*)(buf + 5 * 1024), 16, 0, 0);
}
constexpr int SC_BUF3 = 5 * 1024 + 128;
__device__ __forceinline__ unsigned scan_fill3(const bf16* RW, const bf16* Wm, const bf16* Am, size_t trow, int h, int row, int lane, LAS unsigned char* buf) {
    const size_t t = trow + (lane >> 3); const int sub = (lane & 7) * 8;
    const bf16* rp = RW + t * LDRW + h * 64 + sub;
    __builtin_amdgcn_global_load_lds((const unsigned*)(rp + LBLK), (LAS unsigned*)(buf + 0 * 1024), 16, 0, 0);
    __builtin_amdgcn_global_load_lds((const unsigned*)(Am + t * RC + h * 64 + sub), (LAS unsigned*)(buf + 1 * 1024), 16, 0, 0);
    __builtin_amdgcn_global_load_lds((const unsigned*)(Wm + t * RC + h * 64 + sub), (LAS unsigned*)(buf + 2 * 1024), 16, 0, 0);
    __builtin_amdgcn_global_load_lds((const unsigned*)(rp + 512), (LAS unsigned*)(buf + 3 * 1024), 16, 0, 0);
    __builtin_amdgcn_global_load_lds((const unsigned*)(rp), (LAS unsigned*)(buf + 4 * 1024), 16, 0, 0);
    if (lane < 8) __builtin_amdgcn_global_load_lds((const unsigned*)(RW + (trow + lane) * LDRW + 1024 + h * 64 + (row & ~7)), (LAS unsigned*)(buf + 5 * 1024), 16, 0, 0);
    return 0u;
}
__device__ __forceinline__ void scan_unit(const P& p, int unit, int lane, LAS unsigned char* wl) {
    const bf16* RW = WSP(bf16, AR_RW); const bf16* Wm = WSP(bf16, AR_W); const bf16* Am = WSP(bf16, AR_A); bf16* Y = WSP(bf16, AR_UB);
    const int rg = unit & 15, h = (unit >> 4) & 7, b = unit >> 7, row = rg * 4 + (lane >> 4), kq = lane & 15;
    const size_t tb = (size_t)b * SEQ;
    constexpr int NCH = SEQ / SC_STEPS;
    float s0 = 0.f, s1 = 0.f, s2 = 0.f, s3 = 0.f;
    __builtin_amdgcn_s_setprio(3);
#define SCAN_RD4(K_, B_, E_, T_, R_, V_, BUF_, ST0_) do { _Pragma("unroll") for (int q_ = 0; q_ < 4; ++q_) { const LAS unsigned char* o = (BUF_) + ((ST0_) + q_) * 128 + kq * 8; \
            K_[q_] = *(const LAS v2u*)(o); B_[q_] = *(const LAS v2u*)(o + 1024); E_[q_] = *(const LAS v2u*)(o + 2048); T_[q_] = *(const LAS v2u*)(o + 3072); R_[q_] = *(const LAS v2u*)(o + 4096); \
            V_[q_] = (unsigned)*(const LAS unsigned short*)((BUF_) + 5 * 1024 + ((ST0_) + q_) * 16 + (row & 7) * 2); } } while (0)
#define SCAN_STEP(B_, E_, T_, R_, V_, I_, KN_, YI_) do { const unsigned vvr = V_[I_]; \
            s0 = fmix_nlo(s0, E_[I_].x, s0); s1 = fmix_nhi(s1, E_[I_].x, s1); s2 = fmix_nlo(s2, E_[I_].y, s2); s3 = fmix_nhi(s3, E_[I_].y, s3); \
            s0 = fmix_lo(nskk, B_[I_].x, s0); s1 = fmix_hi(nskk, B_[I_].x, s1); s2 = fmix_lo(nskk, B_[I_].y, s2); s3 = fmix_hi(nskk, B_[I_].y, s3); \
            s0 = fmix_hlo(vvr, T_[I_].x, s0); s1 = fmix_hhi(vvr, T_[I_].x, s1); s2 = fmix_hlo(vvr, T_[I_].y, s2); s3 = fmix_hhi(vvr, T_[I_].y, s3); \
            float yy = fmix_hi(s1, R_[I_].x, fmix_lo0(s0, R_[I_].x)) + fmix_hi(s3, R_[I_].y, fmix_lo0(s2, R_[I_].y)); \
            float dd = fmix_hi(s1, (KN_).x, fmix_lo0(s0, (KN_).x)) + fmix_hi(s3, (KN_).y, fmix_lo0(s2, (KN_).y)); \
            dpp_sum16x2(yy, dd); nskk = -dd; ys[YI_] = yy; } while (0)
#define SCAN_PIN() asm volatile("" : "+v"(s0), "+v"(s1), "+v"(s2), "+v"(s3) :: "memory")
#define SCAN_CHUNK(C_, BI_, B1_, B2_) do { \
        LAS unsigned char* buf = wl + (BI_) * SC_BUF3; const int c3 = (C_) + 3 < NCH ? (C_) + 3 : NCH - 1;                  \
        float ys[SC_STEPS]; v2u kkB[4], bbB[4], eeB[4], ktB[4], rrB[4]; unsigned vvB[4]; \
        SCAN_STEP(bbA, eeA, ktA, rrA, vvA, 0, kkA[1], 0); \
        SCAN_PIN(); SCAN_RD4(kkB, bbB, eeB, ktB, rrB, vvB, buf, 4); asm volatile("" ::: "memory");                          \
        SCAN_STEP(bbA, eeA, ktA, rrA, vvA, 1, kkA[2], 1); SCAN_STEP(bbA, eeA, ktA, rrA, vvA, 2, kkA[3], 2); SCAN_STEP(bbA, eeA, ktA, rrA, vvA, 3, kkB[0], 3); \
        SCAN_STEP(bbB, eeB, ktB, rrB, vvB, 0, kkB[1], 4); \
          \
        asm volatile("s_waitcnt lgkmcnt(0)" : "+v"(s0), "+v"(s1), "+v"(s2), "+v"(s3) :: "memory"); \
        (void)scan_fill3(RW, Wm, Am, tb + (size_t)c3 * SC_STEPS, h, row, lane, buf); \
        asm volatile("s_waitcnt vmcnt(12)" ::: "memory");                                                                   \
        SCAN_RD4(kkA, bbA, eeA, ktA, rrA, vvA, wl + (B1_) * SC_BUF3, 0); asm volatile("" ::: "memory"); \
        SCAN_STEP(bbB, eeB, ktB, rrB, vvB, 1, kkB[2], 5); SCAN_STEP(bbB, eeB, ktB, rrB, vvB, 2, kkB[3], 6); SCAN_STEP(bbB, eeB, ktB, rrB, vvB, 3, kkA[0], 7); \
        if (kq < SC_STEPS) { float yv = ys[0];        \
            _Pragma("unroll") for (int st = 1; st < SC_STEPS; ++st) yv = (kq == st) ? ys[st] : yv; \
            bf16* yd = (C_) < NCH ? Y + (tb + (size_t)(C_) * SC_STEPS + kq) * RC + h * 64 + row : ysink;         \
            *yd = f2bf(yv); } } while (0)
    bf16* ysink = (bf16*)(p.ws + WS_CTL + 4 * CW_SINK) + lane;
    (void)scan_fill3(RW, Wm, Am, tb, h, row, lane, wl); (void)scan_fill3(RW, Wm, Am, tb + SC_STEPS, h, row, lane, wl + SC_BUF3); (void)scan_fill3(RW, Wm, Am, tb + 2 * SC_STEPS, h, row, lane, wl + 2 * SC_BUF3);
    v2u kkA[4], bbA[4], eeA[4], ktA[4], rrA[4]; unsigned vvA[4]; float nskk = 0.f;
    asm volatile("s_waitcnt vmcnt(12)" ::: "memory");
    SCAN_RD4(kkA, bbA, eeA, ktA, rrA, vvA, wl, 0);
#pragma unroll 1
    for (int c = 0; c < NCH + 2; c += 3) {
        SCAN_CHUNK(c, 0, 1, 2);
        SCAN_CHUNK(c + 1, 1, 2, 0);
        SCAN_CHUNK(c + 2, 2, 0, 1);
    }
#undef SCAN_RD4
#undef SCAN_STEP
#undef SCAN_PIN
#undef SCAN_CHUNK
    asm volatile("s_waitcnt vmcnt(0) lgkmcnt(0)" ::: "memory");
    __builtin_amdgcn_s_setprio(0);
}
__device__ __forceinline__ float sum8(float v) {
    v += __builtin_bit_cast(float, __builtin_amdgcn_update_dpp(0, __builtin_bit_cast(int, v), 0xB1, 0xF, 0xF, true));
    v += __builtin_bit_cast(float, __builtin_amdgcn_update_dpp(0, __builtin_bit_cast(int, v), 0x4E, 0xF, 0xF, true));
    v += __builtin_bit_cast(float, __builtin_amdgcn_update_dpp(0, __builtin_bit_cast(int, v), 0x141, 0xF, 0xF, true));
    return v;
}
__device__ __forceinline__ void up8(v4u w, float* f) { f[0] = blo(w.x); f[1] = bhi(w.x); f[2] = blo(w.y); f[3] = bhi(w.y); f[4] = blo(w.z); f[5] = bhi(w.z); f[6] = blo(w.w); f[7] = bhi(w.w); }
#ifdef SCAN_BF16
#define uph8 up8
#define pkh8 pk8
#else
#define uph8 uph8_
#define pkh8 pkh8_
#endif
__device__ __forceinline__ void uph8_(v4u w, float* f) { const h16x2 a = as_h2(w.x), b = as_h2(w.y), c = as_h2(w.z), d = as_h2(w.w);
    f[0] = (float)a.x; f[1] = (float)a.y; f[2] = (float)b.x; f[3] = (float)b.y; f[4] = (float)c.x; f[5] = (float)c.y; f[6] = (float)d.x; f[7] = (float)d.y; }
__device__ __forceinline__ unsigned pkh2(float lo, float hi) { h16x2 v; v.x = (_Float16)lo; v.y = (_Float16)hi; return __builtin_bit_cast(unsigned, v); }
__device__ __forceinline__ v4u pkh8_(const float* f) { v4u w; w.x = pkh2(f[0], f[1]); w.y = pkh2(f[2], f[3]); w.z = pkh2(f[4], f[5]); w.w = pkh2(f[6], f[7]); return w; }
__device__ __forceinline__ v4u pk8(const float* f) { v4u w; w.x = cvt_pk_bf16(f[0], f[1]); w.y = cvt_pk_bf16(f[2], f[3]); w.z = cvt_pk_bf16(f[4], f[5]); w.w = cvt_pk_bf16(f[6], f[7]); return w; }
__device__ __forceinline__ void ldf8(const float* p, float* f) { const f32x4 a = *(const f32x4*)p, b = *(const f32x4*)(p + 4); f[0] = a[0]; f[1] = a[1]; f[2] = a[2]; f[3] = a[3]; f[4] = b[0]; f[5] = b[1]; f[6] = b[2]; f[7] = b[3]; }

struct EpiLora {
    static constexpr bool PERM = true, AFTER_DRAIN = false;
    unsigned char* ws; int pn0;
    __device__ __forceinline__ void operator()(const f32x4 (&acc)[2][2][4][2], const Unit& u, int wr, int wc, int fr, int fq) const {
        const int pn = u.pn + pn0, which = pn >> 1, row0 = u.pm * BM + wr * 64 + fr, c0 = (pn & 1) * 256 + wc * 32 + 8 * fq;
        bf16* const O = (bf16*)(ws + (which == 0 ? AR_W : (which == 1 ? AR_A : (which == 2 ? AR_G : AR_UB))));
#pragma unroll
        for (int ai = 0; ai < 2; ++ai)
#pragma unroll
            for (int m = 0; m < 4; ++m)
#pragma unroll
                for (int bj = 0; bj < 2; ++bj) *(u32x4*)(O + (size_t)(row0 + ai * HALF + m * 16) * RC + c0 + bj * HALF) = pack8(acc[ai][bj][m][0], acc[ai][bj][m][1]);
    }
};
#ifdef RKV_BF16
#define UPR up8
#define PKR pk8
#else
#define UPR uph8
#define PKR pkh8
#endif
struct B2In { v4u k, a, w, vr, vv, vf; float gt; };
__device__ __forceinline__ void b2w_load(B2In& in, const P& p, int layer, int t, int lane) {
    const bf16* row = WSP(bf16, AR_RW) + (size_t)t * LDRW;
    in.k = *(const v4u*)(row + 512 + 8 * lane); in.a = *(const v4u*)(WSP(bf16, AR_A) + (size_t)t * RC + 8 * lane); in.w = *(const v4u*)(WSP(bf16, AR_W) + (size_t)t * RC + 8 * lane);
    in.gt = lane < 24 ? bf2f(row[LBLK + 320 + lane]) : 0.f;
    if (layer == 1) { in.vr = *(const v4u*)(WSP(bf16, AR_UB) + (size_t)t * RC + 8 * lane); in.vv = *(const v4u*)(row + 1024 + 8 * lane); in.vf = *(const v4u*)(WSP(bf16, WS_VF) + (size_t)t * RC + 8 * lane); }
}
__device__ __forceinline__ void b2w_compute(const B2In& in, const P& p, int layer, int t, int lane, const float* v0, const float* v1, const float* v2, const float* v3, const float* vb) {
    bf16* row = WSP(bf16, AR_RW) + (size_t)t * LDRW; bf16* Am = WSP(bf16, AR_A); bf16* Wm = WSP(bf16, AR_W); float* NG = WSP(float, AR_NG);
    float k[8], a[8], w[8]; uph8(in.k, k); up8(in.a, a); up8(in.w, w);
    const float ngv = fsig(in.gt);
    float kk[8], ss = 0.f;
#pragma unroll
    for (int i = 0; i < 8; ++i) {
        a[i] = fsig(a[i] + v1[i]);
        const float nx = -(w[i] + v0[i]), sp = fmaxf(nx, 0.f) + __logf(1.f + __expf(-fabsf(nx))), e = __expf(-sp - 0.5f); w[i] = 1.f - __expf(-e);
        kk[i] = k[i] * v2[i]; ss += kk[i] * kk[i]; }
    ss = sum8(ss); const float nrm = sqrtf(ss), inv = 1.f / (nrm > 1e-12f ? nrm : 1e-12f);
#pragma unroll
    for (int i = 0; i < 8; ++i) { kk[i] *= inv; k[i] = k[i] * (1.f + (a[i] - 1.f) * v3[i]); a[i] *= kk[i]; }
    asm volatile("" :: "v"(ngv));
    if (layer == 1) { float vr[8], vv[8], vf[8]; up8(in.vr, vr); uph8(in.vv, vv); uph8(in.vf, vf);
#pragma unroll
        for (int i = 0; i < 8; ++i) vv[i] = vv[i] + (vf[i] - vv[i]) * fsig(vr[i] + vb[i]);
        *(v4u*)(row + 1024 + 8 * lane) = pkh8(vv); }
    if (lane < 24) NG[(size_t)t * 24 + lane] = ngv;
    *(v4u*)(row + LBLK + 8 * lane) = pkh8(kk); *(v4u*)(row + 512 + 8 * lane) = pkh8(k);
    *(v4u*)(Am + (size_t)t * RC + 8 * lane) = pkh8(a); *(v4u*)(Wm + (size_t)t * RC + 8 * lane) = pkh8(w);
}
__device__ __forceinline__ void ph_rwkv_b2w(const P& p, int layer, int gw, int NGW, int lane) {
    const float* vec = p.rwkv_vec + (size_t)layer * 7 * RC; float v0[8], v1[8], v2[8], v3[8], vb[8];
    ldf8(vec + 8 * lane, v0); ldf8(vec + RC + 8 * lane, v1); ldf8(vec + 2 * RC + 8 * lane, v2); ldf8(vec + 3 * RC + 8 * lane, v3); ldf8(p.vres_b + 8 * lane, vb);
    int t = gw; if (t >= T) return;
    B2In A, B; b2w_load(A, p, layer, t, lane);
    for (; t < T; t += 2 * NGW) { const int t1 = t + NGW, t2 = t1 + NGW;
        b2w_load(B, p, layer, t1 < T ? t1 : t, lane); b2w_compute(A, p, layer, t, lane, v0, v1, v2, v3, vb);
        if (t1 < T) { b2w_load(A, p, layer, t2 < T ? t2 : t1, lane); b2w_compute(B, p, layer, t1, lane, v0, v1, v2, v3, vb); } }
}
struct PoIn { v4u y, r, k, v, g; };
__device__ __forceinline__ void post_load(PoIn& in, const P& p, int t, int lane) { const bf16* row = WSP(bf16, AR_RW) + (size_t)t * LDRW;
    in.y = *(const v4u*)(WSP(bf16, AR_UB) + (size_t)t * RC + 8 * lane); in.r = *(const v4u*)(row + 8 * lane); in.k = *(const v4u*)(row + 512 + 8 * lane); in.v = *(const v4u*)(row + 1024 + 8 * lane); in.g = *(const v4u*)(WSP(bf16, AR_G) + (size_t)t * RC + 8 * lane); }
__device__ __forceinline__ void post_compute(const PoIn& in, const P& p, int t, int lane, const float* v4_, const float* v5, const float* v6) {
    float y[8], r[8], k[8], v[8], g[8]; up8(in.y, y); uph8(in.r, r); uph8(in.k, k); uph8(in.v, v); up8(in.g, g);
    float s = 0.f, bon = 0.f;
#pragma unroll
    for (int i = 0; i < 8; ++i) { s += y[i]; bon += r[i] * k[i] * v4_[i]; }
    const float m = sum8(s) * (1.f / 64.f); bon = sum8(bon);
    float q = 0.f;
#pragma unroll
    for (int i = 0; i < 8; ++i) { y[i] -= m; q += y[i] * y[i]; }
    const float rstd = 1.f / sqrtf(sum8(q) * (1.f / 64.f) + GN_EPS);
#pragma unroll
    for (int i = 0; i < 8; ++i) y[i] = (y[i] * rstd * v5[i] + v6[i] + bon * v[i]) * g[i];
    *(v4u*)(WSP(bf16, AR_A) + (size_t)t * RC + 8 * lane) = pk8(y);
}
__device__ __forceinline__ void ph_rwkv_postw(const P& p, int layer, int gw, int NGW, int lane) {
    const float* vec = p.rwkv_vec + (size_t)layer * 7 * RC; float v4_[8], v5[8], v6[8]; ldf8(vec + 4 * RC + 8 * lane, v4_); ldf8(vec + 5 * RC + 8 * lane, v5); ldf8(vec + 6 * RC + 8 * lane, v6);
    int t = gw; if (t >= T) return;
    PoIn A, B; post_load(A, p, t, lane);
    for (; t < T; t += 2 * NGW) { const int t1 = t + NGW, t2 = t1 + NGW;
        post_load(B, p, t1 < T ? t1 : t, lane); post_compute(A, p, t, lane, v4_, v5, v6);
        if (t1 < T) { post_load(A, p, t2 < T ? t2 : t1, lane); post_compute(B, p, t1, lane, v4_, v5, v6); } }
}
__device__ __forceinline__ void tr8x8(v4u& w, unsigned selA, bool b1, bool b2) {
    unsigned r[4] = {w.x, w.y, w.z, w.w};
#pragma unroll
    for (int i = 0; i < 4; ++i) { const unsigned pv = (unsigned)__builtin_amdgcn_update_dpp(0, (int)r[i], 0xB1, 0xF, 0xF, true); r[i] = __builtin_amdgcn_perm(pv, r[i], selA); }
#pragma unroll
    for (int a = 0; a < 4; a += 2) { const unsigned send = b1 ? r[a] : r[a + 1]; const unsigned recv = (unsigned)__builtin_amdgcn_update_dpp(0, (int)send, 0x4E, 0xF, 0xF, true);
        r[a] = b1 ? recv : r[a]; r[a + 1] = b1 ? r[a + 1] : recv; }
#pragma unroll
    for (int a = 0; a < 2; ++a) { const unsigned send = b2 ? r[a] : r[a + 2];
        int recv = __builtin_amdgcn_update_dpp(0, (int)send, 0x104, 0xF, 0x5, false);
        recv = __builtin_amdgcn_update_dpp(recv, (int)send, 0x114, 0xF, 0xA, false);
        r[a] = b2 ? (unsigned)recv : r[a]; r[a + 2] = b2 ? r[a + 2] : (unsigned)recv; }
    w.x = r[0]; w.y = r[1]; w.z = r[2]; w.w = r[3];
}
__device__ __forceinline__ void ph_vtransw(const P& p, int gw, int NGW, int lane_in) {
    int lane = lane_in; asm volatile("" : "+v"(lane));
    const bf16* KV = WSP(bf16, AR_KV); bf16* VsT = WSH(bf16, WS_VST); bf16* VwT = WSH(bf16, WS_VWT);
    const int j = lane & 7, c = lane >> 3; const unsigned selA = (lane & 1) ? 0x03020706u : 0x05040100u; const bool b1 = (lane & 2) != 0, b2 = (lane & 4) != 0;
    constexpr int NU = BATCH * NKV * (SEQ / 8);
    for (int u0 = gw * 4; u0 < NU; u0 += NGW * 4) {
        v4u s[4], w[4];
#pragma unroll
        for (int i = 0; i < 4; ++i) { const int u = u0 + i, kg = u % (SEQ / 8), bg = u / (SEQ / 8), b = bg / NKV, g = bg % NKV, tok = (kg >> 2) * 32 + 4 * (kg & 3) + (j & 3) + 16 * (j >> 2);
            const bf16* src = KV + (size_t)(b * SEQ + tok) * LDKV + g * 64 + 8 * c; s[i] = *(const v4u*)(src + 128); w[i] = *(const v4u*)(src + 384); }
#pragma unroll
        for (int i = 0; i < 4; ++i) { tr8x8(s[i], selA, b1, b2); tr8x8(w[i], selA, b1, b2);
            *(v4u*)(VsT + ((size_t)(u0 + i) * 64 + lane) * 8) = s[i]; *(v4u*)(VwT + ((size_t)(u0 + i) * 64 + lane) * 8) = w[i]; }
    }
}
typedef float f32x2 __attribute__((ext_vector_type(2)));
__device__ __forceinline__ f32x2 up2(unsigned w) { f32x2 r; r.x = __builtin_bit_cast(float, w << 16); r.y = __builtin_bit_cast(float, w & 0xffff0000u); return r; }
template <int JJ>
__device__ __forceinline__ void conv_row(f32x2 (&a)[8][4], f32x2 (&wt)[8][4], v4u (&cur)[8], f32x4& wn0, f32x4& wn1, const LAS float* wlane, const bf16* ub, int g, int j0) {
    const int j = 8 * g + JJ;
    wt[JJ][0] = (f32x2){wn0.x, wn0.y}; wt[JJ][1] = (f32x2){wn0.z, wn0.w}; wt[JJ][2] = (f32x2){wn1.x, wn1.y}; wt[JJ][3] = (f32x2){wn1.z, wn1.w};
    { const int jl = j + 1 < CONV_K ? j + 1 : CONV_K - 1; wn0 = *(const LAS f32x4*)(wlane + jl * CONV_CH); wn1 = *(const LAS f32x4*)(wlane + jl * CONV_CH + 4); }
    const unsigned msk = j >= j0 ? 0xffffffffu : 0u;
    f32x2 u[4]; u[0] = up2(cur[JJ].x & msk); u[1] = up2(cur[JJ].y & msk); u[2] = up2(cur[JJ].z & msk); u[3] = up2(cur[JJ].w & msk);
    { int jn = j + 8; jn = jn < j0 ? j0 : jn; jn = jn > CONV_K + 6 ? CONV_K + 6 : jn; cur[JJ] = *(const v4u*)(ub + (size_t)jn * CONV_CH); }
#pragma unroll
    for (int q = 0; q < 8; ++q) { const int tap = j - q; if (tap >= 0 && tap < CONV_K) {
#pragma unroll
        for (int i = 0; i < 4; ++i) a[q][i] = __builtin_elementwise_fma(u[i], wt[(JJ - q) & 7][i], a[q][i]); } }
}
__device__ __forceinline__ void ph_convw(const P& p, int layer, int gw, int NGW, int lane, int tid, LAS unsigned char* lds) {
    const bf16* UB = WSP(bf16, AR_UB); bf16* CO = WSP(bf16, AR_CO);
    const float* cw = p.conv_w + (size_t)layer * CONV_K * CONV_CH; const float* cv = p.conv_vec + (size_t)layer * 3 * CONV_CH;
    LAS float* wl = (LAS float*)lds;
    { f32x4 tw[8];
#pragma unroll
      for (int k = 0; k < 8; ++k) { const int i4 = tid + k * NTHREADS; tw[k] = i4 < CONV_K * CONV_CH / 4 ? *(const f32x4*)(cw + 4 * i4) : *(const f32x4*)(cv + 4 * (i4 - CONV_K * CONV_CH / 4)); }
      f32x4 tl = (f32x4){0.f, 0.f, 0.f, 0.f}; if (tid < 256) tl = *(const f32x4*)(cv + 4 * (tid + 8 * NTHREADS - CONV_K * CONV_CH / 4));
#pragma unroll
      for (int k = 0; k < 8; ++k) *(LAS f32x4*)(wl + 4 * (tid + k * NTHREADS)) = tw[k];
      if (tid < 256) *(LAS f32x4*)(wl + 4 * (tid + 8 * NTHREADS)) = tl; }
    TKQ(7);
    __syncthreads();
    TKQ(8);
    const LAS float* wlane = wl + 8 * lane;
    for (int tb = gw * 8; tb < T; tb += NGW * 8) {
        const int pos0 = tb % SEQ, j0 = pos0 >= 30 ? 0 : 30 - pos0;
        const bf16* ub = UB + ((size_t)tb * CONV_CH + 8 * lane) - (size_t)30 * CONV_CH;
        f32x2 a[8][4], wt[8][4]; v4u cur[8];
        { const f32x4 c0 = *(const LAS f32x4*)(wlane + CONV_K * CONV_CH), c1 = *(const LAS f32x4*)(wlane + CONV_K * CONV_CH + 4);
#pragma unroll
          for (int q = 0; q < 8; ++q) { a[q][0] = (f32x2){c0.x, c0.y}; a[q][1] = (f32x2){c0.z, c0.w}; a[q][2] = (f32x2){c1.x, c1.y}; a[q][3] = (f32x2){c1.z, c1.w}; } }
#pragma unroll
        for (int jj = 0; jj < 8; ++jj) cur[jj] = *(const v4u*)(ub + (size_t)(jj < j0 ? j0 : jj) * CONV_CH);
        f32x4 wn0 = *(const LAS f32x4*)(wlane), wn1 = *(const LAS f32x4*)(wlane + 4);
#pragma unroll 1
        for (int g = 0; g < 5; ++g) {
            conv_row<0>(a, wt, cur, wn0, wn1, wlane, ub, g, j0); conv_row<1>(a, wt, cur, wn0, wn1, wlane, ub, g, j0); conv_row<2>(a, wt, cur, wn0, wn1, wlane, ub, g, j0); conv_row<3>(a, wt, cur, wn0, wn1, wlane, ub, g, j0);
            conv_row<4>(a, wt, cur, wn0, wn1, wlane, ub, g, j0); conv_row<5>(a, wt, cur, wn0, wn1, wlane, ub, g, j0); conv_row<6>(a, wt, cur, wn0, wn1, wlane, ub, g, j0); conv_row<7>(a, wt, cur, wn0, wn1, wlane, ub, g, j0);
        }
        const f32x4 g10 = *(const LAS f32x4*)(wlane + (CONV_K + 1) * CONV_CH), g11 = *(const LAS f32x4*)(wlane + (CONV_K + 1) * CONV_CH + 4);
        const f32x4 b20 = *(const LAS f32x4*)(wlane + (CONV_K + 2) * CONV_CH), b21 = *(const LAS f32x4*)(wlane + (CONV_K + 2) * CONV_CH + 4);
        const f32x2 g1[4] = {(f32x2){g10.x, g10.y}, (f32x2){g10.z, g10.w}, (f32x2){g11.x, g11.y}, (f32x2){g11.z, g11.w}}, b2[4] = {(f32x2){b20.x, b20.y}, (f32x2){b20.z, b20.w}, (f32x2){b21.x, b21.y}, (f32x2){b21.z, b21.w}};
#pragma unroll
        for (int q = 0; q < 8; ++q) {
            const f32x2 s2 = (a[q][0] + a[q][1]) + (a[q][2] + a[q][3]);
            const float mean = wave_sum(s2.x + s2.y, lane) * (1.f / CONV_CH); f32x2 q2 = (f32x2){0.f, 0.f};
#pragma unroll
            for (int i = 0; i < 4; ++i) { a[q][i] -= (f32x2){mean, mean}; q2 = __builtin_elementwise_fma(a[q][i], a[q][i], q2); }
            const float rstd = 1.f / sqrtf(wave_sum(q2.x + q2.y, lane) * (1.f / CONV_CH) + LN_EPS);
            float y[8];
#pragma unroll
            for (int i = 0; i < 4; ++i) { const f32x2 yy = __builtin_elementwise_fma(a[q][i] * (f32x2){rstd, rstd}, g1[i], b2[i]); y[2 * i] = yy.x * fsig(yy.x); y[2 * i + 1] = yy.y * fsig(yy.y); }
            *(v4u*)(CO + (size_t)(tb + q) * CONV_CH + 8 * lane) = pk8(y);
        }
    }
    TKQ(9);
    __syncthreads();
}
__device__ __forceinline__ void ph_cmp2w(const P& p, int layer, int gw, int NGW, int lane, LAS float* hl  ) {
    const bf16* Z = WSP(bf16, AR_HID); const float* pec = (const float*)(p.ws + WS_W + (size_t)layer * SZ_LAYERW + OFF_PEC);
#pragma unroll 1
    for (int which = 0; which < 2; ++which) {
    float wreg[128];
    { const float* w2c = p.cmp_w2 + (size_t)(layer * 2 + which) * 128 * 64 + lane;
#pragma unroll
      for (int j = 0; j < 128; ++j) wreg[j] = w2c[j * 64]; }
    for (int it = which * (BATCH * NKV * NC) + gw; it < (which + 1) * (BATCH * NKV * NC); it += NGW) {
        const int i = it % NC, r = it / NC, bg = r % (BATCH * NKV);
        const bf16* z1 = Z + ((size_t)which * (BATCH * NKV * 512) + (size_t)bg * 512 + i) * 256; const bf16* z2 = z1 + 256 + 128;
#pragma unroll
        for (int jj = 0; jj < 2; ++jj) { const int j = lane + 64 * jj; const float x = bf2f(z1[j]) + bf2f(z2[j]) + pec[which * 128 + j];
            const float e = __expf(fminf(2.f * 0.7978845608028654f * (x + 0.044715f * x * x * x), 30.f)); hl[j] = 0.5f * x * (1.f + (e - 1.f) / (e + 1.f)); }
        LDS_WAIT(); asm volatile("" ::: "memory");
        float o = 0.f;
#pragma unroll
        for (int j4 = 0; j4 < 128; j4 += 4) { const f32x4 h4 = *(const LAS f32x4*)(hl + j4); o += h4.x * wreg[j4] + h4.y * wreg[j4 + 1] + h4.z * wreg[j4 + 2] + h4.w * wreg[j4 + 3]; }
        if (which == 0) {
            const float rs = 1.f / sqrtf(wave_sum(o * o, lane) * (1.f / 64.f) + RMS_EPS); o = o * rs * p.qk_g[(layer * 4 + 1) * 64 + lane];
            const float other = bperm_f(o, lane ^ 32); float cs, sn; rope_cs(16 * i + 31, lane & 31, cs, sn);
            o = lane < 32 ? o * cs - other * sn : o * cs + other * sn;
            WSP(bf16, AR_KC)[(((size_t)bg * 8 + (lane >> 3)) * 512 + i) * 8 + (lane & 7)] = f2bf(o);
        } else { bf16* vt = WSP(bf16, AR_VCT) + (size_t)bg * 64 * 512 + lane * 8;
            vt[(size_t)((i >> 5) * 4 + ((i & 15) >> 2)) * 512 + (i & 3) + 4 * ((i >> 4) & 1)] = f2bf(o); if (i == 0) vt[(size_t)((NC >> 5) * 4 + ((NC & 15) >> 2)) * 512 + (NC & 3) + 4 * ((NC >> 4) & 1)] = 0; }
        LDS_WAIT(); asm volatile("" ::: "memory");
    }
    }
}

struct MapPlain { bf16* base; int K; __device__ __forceinline__ bf16* operator()(int col) const { return base + (size_t)col * K; } };
struct MapGlu { bf16* base; int K, ff; __device__ __forceinline__ bf16* operator()(int col) const { return base + (size_t)glu_dest(col, ff) * K; } };
struct MapWin { unsigned char* wl; int layer; __device__ __forceinline__ bf16* operator()(int col) const { int which; const int r = win_dest(col, layer, which); const size_t off = (which ? OFF_WG : OFF_WIN) + (size_t)(r < 0 ? 0 : r) * DM * 2; return r < 0 ? nullptr : (bf16*)(wl + off); } };
template <class Map>
__device__ __forceinline__ void transpose_item(const float* W, int K, int N, const Map& mp, LAS float* scr, int item, int lane) {
    const int nblk = (N + 31) / 32, kb = item / nblk, nb = item % nblk, k0 = 64 * kb, n0 = 32 * nb;
    const int c4 = 4 * (lane & 7), col = n0 + c4;
    f32x4 v[8];
#pragma unroll
    for (int i = 0; i < 8; ++i) v[i] = col < N ? *(const f32x4*)(W + (size_t)(k0 + (lane >> 3) + 8 * i) * N + col) : (f32x4){0.f, 0.f, 0.f, 0.f};
#pragma unroll
    for (int i = 0; i < 8; ++i) { LAS float* d = scr + ((lane >> 3) + 8 * i) * 33 + c4; d[0] = v[i].x; d[1] = v[i].y; d[2] = v[i].z; d[3] = v[i].w; }
    LDS_WAIT(); asm volatile("" ::: "memory");
    const int c = lane & 7;
#pragma unroll
    for (int j = 0; j < 4; ++j) { const int n = (lane >> 3) + 8 * j; const LAS float* s = scr + (8 * c) * 33 + n;
        v4u o; o.x = (unsigned)f2bf(s[0]) | ((unsigned)f2bf(s[33]) << 16); o.y = (unsigned)f2bf(s[66]) | ((unsigned)f2bf(s[99]) << 16);
        o.z = (unsigned)f2bf(s[132]) | ((unsigned)f2bf(s[165]) << 16); o.w = (unsigned)f2bf(s[198]) | ((unsigned)f2bf(s[231]) << 16);
        if (n0 + n < N) { bf16* d = mp(n0 + n); if (d) *(v4u*)(d + k0 + 8 * c) = o; } }
    LDS_WAIT(); asm volatile("" ::: "memory");
}
template <class Map>
__device__ __forceinline__ bool conv_job(int& r, const float* W, int K, int N, const Map& mp, LAS float* scr, int lane) {
    const int items = (K / 64) * ((N + 31) / 32);
    if (r < items) { transpose_item(W, K, N, mp, scr, r, lane); return true; }
    r -= items; return false;
}

struct RmsIn { f32x4 v[DM / 256]; };
__device__ __forceinline__ void rms_load(RmsIn& r, const float* xrow, int lane) { const f32x4* xr = (const f32x4*)xrow + lane;
#pragma unroll
    for (int j = 0; j < DM / 256; ++j) r.v[j] = xr[64 * j]; }
__device__ __forceinline__ void rms_row(const P& p, const RmsIn& rin, const float* g, bf16* orow, int lane, bool route, int t, unsigned long long& c0, unsigned long long& c1) {
    const f32x4* gr = (const f32x4*)g + lane;
    f32x4 v[DM / 256]; float ss = 0.f;
#pragma unroll
    for (int j = 0; j < DM / 256; ++j) { v[j] = rin.v[j]; ss += (v[j].x * v[j].x + v[j].y * v[j].y) + (v[j].z * v[j].z + v[j].w * v[j].w); }
    const float rs = 1.f / sqrtf(wave_sum(ss, lane) * (1.f / DM) + RMS_EPS);
    v2u* o8 = (v2u*)orow + lane;
#pragma unroll
    for (int j = 0; j < DM / 256; ++j) { const f32x4 gg = gr[64 * j]; v[j].x *= rs * gg.x; v[j].y *= rs * gg.y; v[j].z *= rs * gg.z; v[j].w *= rs * gg.w;
        v2u w; w.x = cvt_pk_bf16(v[j].x, v[j].y); w.y = cvt_pk_bf16(v[j].z, v[j].w); o8[64 * j] = w; }
    if (route) {
        float lg[NEXP];
#pragma unroll
        for (int e = 0; e < NEXP; ++e) lg[e] = 0.f;
#pragma unroll
        for (int j = 0; j < DM / 256; ++j) { const float* rw = p.router_w + (size_t)(4 * (lane + 64 * j)) * NEXP;
#pragma unroll
            for (int e = 0; e < NEXP; ++e) lg[e] += v[j].x * rw[e] + v[j].y * rw[NEXP + e] + v[j].z * rw[2 * NEXP + e] + v[j].w * rw[3 * NEXP + e]; }
#pragma unroll
        for (int e = 0; e < NEXP; ++e) lg[e] = wave_sum(lg[e], lane) + p.router_b[e];
        int e0 = 0; float l0 = lg[0];
#pragma unroll
        for (int e = 1; e < NEXP; ++e) if (lg[e] > l0) { l0 = lg[e]; e0 = e; }
        int e1 = -1; float l1 = -3e38f;
#pragma unroll
        for (int e = 0; e < NEXP; ++e) if (e != e0 && lg[e] > l1) { l1 = lg[e]; e1 = e; }
        e0 = __builtin_amdgcn_readfirstlane(e0); e1 = __builtin_amdgcn_readfirstlane(e1);
        const int r0 = (int)((c0 >> (8 * e0)) & 255ull), r1 = (int)((c1 >> (8 * e1)) & 255ull);
        c0 += 1ull << (8 * e0); c1 += 1ull << (8 * e1);
        if (lane == 0) { const float w0 = 1.f / (1.f + expf(l1 - l0));
            WSP(int, AR_RTE)[t] = e0 | (e1 << 8) | (r0 << 16) | (r1 << 24); float* rw = WSP(float, AR_RTW) + (size_t)t * 2; rw[0] = w0; rw[1] = 1.f - w0; }
    }
}
__device__ __forceinline__ void rms_row_route(const P& p, const RmsIn& rin, const float* g, bf16* orow, int lane, int t, unsigned long long& c0, unsigned long long& c1, const float (&rwr)[128]) {
    const f32x4* gr = (const f32x4*)g + lane;
    f32x4 v[DM / 256]; float ss = 0.f;
#pragma unroll
    for (int j = 0; j < DM / 256; ++j) { v[j] = rin.v[j]; ss += (v[j].x * v[j].x + v[j].y * v[j].y) + (v[j].z * v[j].z + v[j].w * v[j].w); }
    const float rs = 1.f / sqrtf(wave_sum(ss, lane) * (1.f / DM) + RMS_EPS);
    v2u* o8 = (v2u*)orow + lane;
#pragma unroll
    for (int j = 0; j < DM / 256; ++j) { const f32x4 gg = gr[64 * j]; v[j].x *= rs * gg.x; v[j].y *= rs * gg.y; v[j].z *= rs * gg.z; v[j].w *= rs * gg.w;
        v2u w; w.x = cvt_pk_bf16(v[j].x, v[j].y); w.y = cvt_pk_bf16(v[j].z, v[j].w); o8[64 * j] = w; }
    float lg[NEXP];
#pragma unroll
    for (int e = 0; e < NEXP; ++e) lg[e] = 0.f;
#pragma unroll
    for (int j = 0; j < DM / 256; ++j)
#pragma unroll
        for (int e = 0; e < NEXP; ++e) lg[e] += v[j].x * rwr[(4 * j) * 8 + e] + v[j].y * rwr[(4 * j + 1) * 8 + e] + v[j].z * rwr[(4 * j + 2) * 8 + e] + v[j].w * rwr[(4 * j + 3) * 8 + e];
    float r4[4], r2[2], r1;
    { const bool hi = (lane & 32) != 0;
#pragma unroll
      for (int i = 0; i < 4; ++i) { const float mine = hi ? lg[4 + i] : lg[i], theirs = hi ? lg[i] : lg[4 + i]; r4[i] = mine + bperm_f(theirs, lane ^ 32); } }
    { const bool hi = (lane & 16) != 0;
#pragma unroll
      for (int i = 0; i < 2; ++i) { const float mine = hi ? r4[2 + i] : r4[i], theirs = hi ? r4[i] : r4[2 + i]; r2[i] = mine + bperm_f(theirs, lane ^ 16); } }
    { const bool hi = (lane & 8) != 0; const float mine = hi ? r2[1] : r2[0], theirs = hi ? r2[0] : r2[1]; r1 = mine + bperm_f(theirs, lane ^ 8); }
    r1 += bperm_f(r1, lane ^ 4); r1 += bperm_f(r1, lane ^ 2); r1 += bperm_f(r1, lane ^ 1);
#pragma unroll
    for (int e = 0; e < NEXP; ++e) lg[e] = __builtin_bit_cast(float, __builtin_amdgcn_readlane(__builtin_bit_cast(int, r1), 8 * e)) + p.router_b[e];
    int e0 = 0; float l0 = lg[0];
#pragma unroll
    for (int e = 1; e < NEXP; ++e) if (lg[e] > l0) { l0 = lg[e]; e0 = e; }
    int e1 = -1; float l1 = -3e38f;
#pragma unroll
    for (int e = 0; e < NEXP; ++e) if (e != e0 && lg[e] > l1) { l1 = lg[e]; e1 = e; }
    e0 = __builtin_amdgcn_readfirstlane(e0); e1 = __builtin_amdgcn_readfirstlane(e1);
    const int r0 = (int)((c0 >> (8 * e0)) & 255ull), r1i = (int)((c1 >> (8 * e1)) & 255ull);
    c0 += 1ull << (8 * e0); c1 += 1ull << (8 * e1);
    if (lane == 0) { const float w0 = 1.f / (1.f + expf(l1 - l0));
        WSP(int, AR_RTE)[t] = e0 | (e1 << 8) | (r0 << 16) | (r1i << 24); float* rw = WSP(float, AR_RTW) + (size_t)t * 2; rw[0] = w0; rw[1] = 1.f - w0; }
}
__device__ __forceinline__ void copy_rows4(const bf16* s0, const bf16* s1, const bf16* s2, const bf16* s3, bf16* d0, bf16* d1, bf16* d2, bf16* d3, int lane) {
    v4u a[4][DM / 512];
#pragma unroll
    for (int j = 0; j < DM / 512; ++j) { a[0][j] = ((const v4u*)s0)[lane + 64 * j]; a[1][j] = ((const v4u*)s1)[lane + 64 * j]; a[2][j] = ((const v4u*)s2)[lane + 64 * j]; a[3][j] = ((const v4u*)s3)[lane + 64 * j]; }
#pragma unroll
    for (int j = 0; j < DM / 512; ++j) { ((v4u*)d0)[lane + 64 * j] = a[0][j]; ((v4u*)d1)[lane + 64 * j] = a[1][j]; ((v4u*)d2)[lane + 64 * j] = a[2][j]; ((v4u*)d3)[lane + 64 * j] = a[3][j]; }
}
__device__ __forceinline__ void copy_rows8(const bf16* s0, const int* drow, bf16* dbase, int lane) {
    v4u a[8][DM / 512];
#pragma unroll
    for (int r = 0; r < 8; ++r)
#pragma unroll
        for (int j = 0; j < DM / 512; ++j) a[r][j] = ((const v4u*)(s0 + (size_t)r * DM))[lane + 64 * j];
#pragma unroll
    for (int r = 0; r < 8; ++r) { v4u* dd = (v4u*)(dbase + (size_t)drow[r] * DM);
#pragma unroll
        for (int j = 0; j < DM / 512; ++j) dd[lane + 64 * j] = a[r][j]; }
}
__device__ __forceinline__ void copy_row_wave(const bf16* src, bf16* dst, int lane) {
#pragma unroll
    for (int j = 0; j < DM / 512; ++j) ((v4u*)dst)[lane + 64 * j] = ((const v4u*)src)[lane + 64 * j];
}
__device__ __forceinline__ int moe_seg_start(const unsigned* cnt, int e) { int s = 0;
#pragma unroll
    for (int k = 0; k < NEXP; ++k) s += (k < e) ? (int)((cnt[k] + 255u) & ~255u) : 0;
    return s; }

#ifndef STAG_GATE
#define STAG_GATE 700
#endif
__device__ __forceinline__ void stagger_start(int bid, int ticks) {
    const unsigned long long t0 = __builtin_amdgcn_s_memrealtime(), dl = (unsigned long long)(((bid >> 3) & 3) * ticks);
    while (__builtin_amdgcn_s_memrealtime() - t0 < dl) __builtin_amdgcn_s_sleep(16);
}
#ifndef PHMASK
#define PHMASK 0xFFFFFFFFu
#endif
#define PHM(k) (((PHMASK) >> (k)) & 1u)
#ifdef PROBE_LO
constexpr int PR_LO = PROBE_LO, PR_HI = PROBE_HI;
#else
constexpr int PR_LO = -1, PR_HI = -1;
#endif
constexpr int NPH = 16, NPHASES = 1 + 2 * NPH;
struct Args { const float* in[29]; float* out; unsigned char* ws; int ph_lo, ph_hi; };

__device__ __forceinline__ bool in_phase(int k, int lo, int hi) { asm volatile("" : "+s"(lo), "+s"(hi)); return lo <= k && k < hi; }
typedef const Args __attribute__((address_space(4)))* CArgsP;
__device__ __forceinline__ void fill_params_k(P& p, CArgsP a) {
    p.x = a->in[0]; p.mix_norm_g = a->in[1]; p.w_in_first = a->in[2]; p.w_in_rest = a->in[3]; p.mu_first = a->in[4]; p.mu_rest = a->in[5]; p.qk_g = a->in[6]; p.cmp_pos = a->in[7];
    p.cmp_w1 = a->in[8]; p.cmp_w2 = a->in[9]; p.nsa_w_o = a->in[10]; p.conv_w = a->in[11]; p.conv_vec = a->in[12]; p.conv_w_o = a->in[13]; p.rwkv_vec = a->in[14]; p.w_up = a->in[15];
    p.a_up = a->in[16]; p.g_up = a->in[17]; p.vres_up = a->in[18]; p.vres_b = a->in[19]; p.rwkv_w_o = a->in[20]; p.w_out = a->in[21]; p.ffn_norm_g = a->in[22]; p.dense_gu = a->in[23];
    p.dense_down = a->in[24]; p.router_w = a->in[25]; p.router_b = a->in[26]; p.moe_gu = a->in[27]; p.moe_down = a->in[28]; p.out = a->out; p.ws = a->ws; p.hb = a->ws + WS_H;
}
template <int GC>
__global__ void __launch_bounds__(NTHREADS, 2) mk_fwd_t(Args args) {
    extern __shared__ __attribute__((aligned(16))) unsigned char lds_raw[];
    LAS unsigned char* lds = (LAS unsigned char*)lds_raw;
    const int wave0 = __builtin_amdgcn_readfirstlane((int)threadIdx.x >> 6);
    const int tid = wave0 * 64 + lane_id_opaque();
    unsigned* ctl = (unsigned*)(args.ws + WS_CTL);
    for (int u = tid; u < (LDS_BYTES - LDSCTL_OFF) / 4; u += NTHREADS) ((LAS unsigned*)(lds + LDSCTL_OFF))[u] = 0u;
    __syncthreads();
    const int lo = args.ph_lo, hi = args.ph_hi;
    XcdBarrier bar; bar.bar = ctl + CW_BAR; bar.x = 0; bar.st = nullptr;
    if (hi - lo > 1) { bar.x = xb_xcc_id(); bar.st = (volatile LAS unsigned*)(lds + MISC_OFF) + 8; if (tid == 0) (void)xb_add(ctl + CW_BAR + XB_XCNT(bar.x), 1u); }
#define RMS_LOOP(X, GN, ROUTE, C0, C1) do { int m_ = gw; if (m_ < T) { RmsIn ra_, rb_; rms_load(ra_, (X) + (size_t)m_ * DM, lane); \
        for (; m_ < T; m_ += 2 * NGW) { const int m1_ = m_ + NGW, m2_ = m1_ + NGW; rms_load(rb_, (X) + (size_t)(m1_ < T ? m1_ : m_) * DM, lane); \
            rms_row(p, ra_, (GN), WSP(bf16, WS_H) + (size_t)m_ * DM, lane, (ROUTE), m_, C0, C1); \
            if (m1_ < T) { rms_load(ra_, (X) + (size_t)(m2_ < T ? m2_ : m1_) * DM, lane); rms_row(p, rb_, (GN), WSP(bf16, WS_H) + (size_t)m1_ * DM, lane, (ROUTE), m1_, C0, C1); } } } } while (0)
#define RMS_LOOP_R(X, GN, C0, C1, RWR) do { int m_ = gw; if (m_ < T) { RmsIn ra_, rb_; rms_load(ra_, (X) + (size_t)m_ * DM, lane); \
        for (; m_ < T; m_ += 2 * NGW) { const int m1_ = m_ + NGW, m2_ = m1_ + NGW; rms_load(rb_, (X) + (size_t)(m1_ < T ? m1_ : m_) * DM, lane); \
            rms_row_route(p, ra_, (GN), WSP(bf16, WS_H) + (size_t)m_ * DM, lane, m_, C0, C1, RWR); \
            if (m1_ < T) { rms_load(ra_, (X) + (size_t)(m2_ < T ? m2_ : m1_) * DM, lane); rms_row_route(p, rb_, (GN), WSP(bf16, WS_H) + (size_t)m1_ * DM, lane, m1_, C0, C1, RWR); } } } } while (0)
#define IN(k) (in_phase((k), lo, hi) && (PR_LO < 0 || (st == 0 ? (k) <= PR_HI : (st == 1 ? ((k) >= PR_LO && (k) <= PR_HI) : (k) > PR_HI))))
#define MKP unsigned long long cdum0 = 0ull, cdum1 = 0ull; (void)cdum0; (void)cdum1; CArgsP ap_ = (CArgsP)__builtin_amdgcn_kernarg_segment_ptr(); asm volatile("" : "+s"(ap_)); P p; fill_params_k(p, ap_); int w0_ = wave0; asm volatile("" : "+s"(w0_)); int tid = w0_ * 64 + lane_id_opaque(); asm volatile("" : "+v"(tid)); const int lane = tid & 63, wave = __builtin_amdgcn_readfirstlane(tid >> 6); int G = GC ? GC : (int)gridDim.x, bid = blockIdx.x; if (GC == 0) asm volatile("" : "+s"(G)); asm volatile("" : "+s"(bid)); unsigned* ctl = WSP(unsigned, WS_CTL); const long gtid = (long)bid * NTHREADS + tid, NT = (long)G * NTHREADS; const int gw = bid * NWAVES + wave, NGW = G * NWAVES; LAS float* scrw = (LAS float*)(lds + wave * 16384); (void)gtid; (void)NT; (void)gw; (void)NGW; (void)scrw; (void)lane; (void)ctl
#ifdef PROBE_TK
#define TKW(i) do { if (blockIdx.x == PROBE_BLK && threadIdx.x == 0) ((unsigned long long*)(args.ws + WS_CTL + 4 * CW_TK))[(i)] = __builtin_amdgcn_s_memrealtime(); } while (0)
#define TKP(i) do { if (layer == PROBE_LAYER) TKW(i); } while (0)
#define TKB() do { if (layer == PROBE_LAYER && threadIdx.x == 0) ((unsigned long long*)(args.ws + WS_CTL + 4 * CW_TK))[32 + blockIdx.x] = __builtin_amdgcn_s_memrealtime(); } while (0)
#define SEAM(k) do { if ((k) + 1 < hi) { int w_ = wave0; asm volatile("" : "+s"(w_)); xcd_barrier(bar, w_ * 64 + lane_id_opaque()); } \
    if ((k) == PROBE_TK) TKW(1); if ((k) == PROBE_TK - 1) TKW(0); } while (0)
#else
#define TKP(i) do { } while (0)
#define TKB() do { } while (0)
#define SEAM(k) do { if ((k) + 1 < hi) { int w_ = wave0; asm volatile("" : "+s"(w_)); xcd_barrier(bar, w_ * 64 + lane_id_opaque()); } } while (0)
#endif

    for (int st = 0; st < (PR_LO >= 0 ? 3 : 1); ++st) {
    if (PHM(16) && IN(0)) { MKP;
        constexpr int IT_WIN0 = (DM / 64) * ((N_IN_FIRST + 31) / 32), IT_WIN1 = (DM / 64) * ((N_IN_REST + 31) / 32), IT_WO = (512 / 64) * (DM / 32), IT_WOUT = (DM / 64) * (DM / 32);
        constexpr int total = IT_WIN0 + IT_WIN1 + 6 * IT_WO + 2 * IT_WOUT + (DM / 64) * (2 * DENSE_FF / 32) + (DENSE_FF / 64) * (DM / 32);
        bf16* wl0 = WSP(bf16, WS_W); bf16* wl1 = WSP(bf16, WS_W + SZ_LAYERW);
#define WOFF(b, o) ((bf16*)((unsigned char*)(b) + (o)))
        for (int it = gw; it < total; it += NGW) {
            int r = it;
            if (conv_job(r, p.w_in_first, DM, N_IN_FIRST, MapWin{(unsigned char*)wl0, 0}, scrw, lane)) continue;
            if (conv_job(r, p.w_in_rest, DM, N_IN_REST, MapWin{(unsigned char*)wl1, 1}, scrw, lane)) continue;
            if (conv_job(r, p.nsa_w_o, 512, DM, MapPlain{WOFF(wl0, OFF_WO3), 512}, scrw, lane)) continue;
            if (conv_job(r, p.rwkv_w_o, 512, DM, MapPlain{WOFF(wl0, OFF_WO3) + (size_t)DM * 512, 512}, scrw, lane)) continue;
            if (conv_job(r, p.conv_w_o, 512, DM, MapPlain{WOFF(wl0, OFF_WO3) + (size_t)2 * DM * 512, 512}, scrw, lane)) continue;
            if (conv_job(r, p.nsa_w_o + (size_t)512 * DM, 512, DM, MapPlain{WOFF(wl1, OFF_WO3), 512}, scrw, lane)) continue;
            if (conv_job(r, p.rwkv_w_o + (size_t)512 * DM, 512, DM, MapPlain{WOFF(wl1, OFF_WO3) + (size_t)DM * 512, 512}, scrw, lane)) continue;
            if (conv_job(r, p.conv_w_o + (size_t)512 * DM, 512, DM, MapPlain{WOFF(wl1, OFF_WO3) + (size_t)2 * DM * 512, 512}, scrw, lane)) continue;
            if (conv_job(r, p.w_out, DM, DM, MapPlain{WOFF(wl0, OFF_WOUT), DM}, scrw, lane)) continue;
            if (conv_job(r, p.w_out + (size_t)DM * DM, DM, DM, MapPlain{WOFF(wl1, OFF_WOUT), DM}, scrw, lane)) continue;
            if (conv_job(r, p.dense_gu, DM, 2 * DENSE_FF, MapGlu{WSP(bf16, WS_DGU), DM, DENSE_FF}, scrw, lane)) continue;
            conv_job(r, p.dense_down, DENSE_FF, DM, MapPlain{WSP(bf16, WS_DDN), DENSE_FF}, scrw, lane);
        }
        for (int l = 0; l < 2; ++l) {
            unsigned char* wlb = p.ws + WS_W + (size_t)l * SZ_LAYERW;
            bf16* win = (bf16*)(wlb + OFF_WIN);
            for (long i = gtid; i < 512L * DM; i += NT) { const int w = (int)(i / DM); const bool src = w < 288 || (w < 320 && l == 1) || (w >= 320 && w < 344); if (!src) win[(size_t)(3840 + w) * DM + i % DM] = 0; }
            bf16* lw = (bf16*)(wlb + OFF_LW);
            for (long i = gtid; i < 2048L * 384; i += NT) { const int n = (int)(i / 384), k = (int)(i % 384), blk = n >> 9, c = n & 511; float v = 0.f;
                if (blk == 0 && k < 64) v = p.w_up[((size_t)l * 64 + k) * RC + c]; else if (blk == 1 && k >= 64 && k < 128) v = p.a_up[((size_t)l * 64 + k - 64) * RC + c];
                else if (blk == 2 && k >= 128 && k < 288) v = p.g_up[((size_t)l * 160 + k - 128) * RC + c]; else if (blk == 3 && k >= 288 && k < 320 && l == 1) v = p.vres_up[(size_t)(k - 288) * RC + c];
                lw[i] = f2bf(v); }
            bf16* cw1 = (bf16*)(wlb + OFF_CW1);
            for (long i = gtid; i < 2L * 256 * 1024; i += NT) { const int k = (int)(i % 1024), n = (int)((i / 1024) % 256), which = (int)(i / (256 * 1024));
                cw1[i] = f2bf(p.cmp_w1[((size_t)(l * 2 + which) * 2048 + (n < 128 ? k : 1024 + k)) * 128 + (n & 127)]); }
        }
        for (int job = bid; job < 4; job += G) { const int l = job >> 1, which = job & 1;
            const float* pe = p.cmp_pos + (size_t)(l * 2 + which) * 2048; const float* w1 = p.cmp_w1 + (size_t)(l * 2 + which) * 2048 * 128 + 2 * lane;
            float s0 = 0.f, s1 = 0.f;
#pragma unroll 8
            for (int k = wave * 256; k < wave * 256 + 256; ++k) { const float2 wv = *(const float2*)(w1 + (size_t)k * 128); const float pk = pe[k]; s0 += pk * wv.x; s1 += pk * wv.y; }
            scrw[2 * lane] = s0; scrw[2 * lane + 1] = s1;
            __syncthreads();
            if (tid < 128) { float sum = 0.f;
#pragma unroll
                for (int w = 0; w < NWAVES; ++w) sum += ((const LAS float*)(lds + w * 16384))[tid];
                ((float*)(p.ws + WS_W + (size_t)l * SZ_LAYERW + OFF_PEC))[which * 128 + tid] = sum; }
            __syncthreads();
        }
    }

    auto run_layer = [&](auto LT_) __attribute__((always_inline)) { constexpr int layer = decltype(LT_)::value; const int pb = 1 + layer * NPH;
        if (PHM(0) && IN(pb + 0)) { MKP;
            const float* xin = layer == 0 ? p.x : p.out;
            RMS_LOOP(xin, p.mix_norm_g + (size_t)layer * DM, false, cdum0, cdum1);
            SEAM(pb + 0);
        }
        if (PHM(1) && IN(pb + 1)) { MKP;
            Gemm g{WSP(bf16, WS_H), (const bf16*)(p.ws + WS_W + (size_t)layer * SZ_LAYERW + OFF_WIN), T, NPROJ, DM}; SOrder S; S.init(T, NPROJ, G, bid);
            EpiProj E{p.ws};
            pg8::gemm_phase<EpiProj, SOrder, true, true>(lds, g, S, E, tid);
            SEAM(pb + 1);
        }
        if (PHM(2) && IN(pb + 2)) { MKP; if (layer == 0) p.hb = (unsigned char*)p.out;
            { Gemm g{WSP(bf16, AR_CKV), (const bf16*)(p.ws + WS_W + (size_t)layer * SZ_LAYERW + OFF_CW1), 2 * BATCH * NKV * 512, 512, 1024, 0}; StackOrder S{BATCH * NKV * 512 / 256, 1, 2, G, bid};
              EpiStore E{WSP(bf16, AR_HID), 256, 1};
              pg8::gemm_phase<EpiStore, StackOrder, true, true>(lds, g, S, E, tid); }
            TKP(2); ph_shift(p, layer, gtid, NT); TKP(3); ph_nsa_prep(p, layer, gtid, NT); TKP(4); ph_vtransw(p, gw, NGW, lane); TKP(5);
            ph_convw(p, layer, gw, NGW, lane, tid, lds); TKP(6); TKB();
#ifdef APROBE_CONV
            ph_convw(p, layer, gw, NGW, lane, tid, lds);
#endif
#ifdef APROBE_VT
            ph_vtransw(p, gw, NGW, lane);
#endif
            SEAM(pb + 2); }
        if (PHM(3) && IN(pb + 3)) { MKP; if (layer == 0) p.hb = (unsigned char*)p.out;
#ifndef LORA_NAIVE
            { const bf16* LBp = WSH(bf16, WS_LB); const bf16* LWp = (const bf16*)(p.ws + WS_W + (size_t)layer * SZ_LAYERW + OFF_LW);
              { Gemm g{LBp, LWp, T, 1024, 128, 384, 384}; SOrder S; S.init(T, 1024, G, bid); EpiLora E{p.ws, 0}; pg8::gemm_phase<EpiLora, SOrder, false, true>(lds, g, S, E, tid); }
              { Gemm g{LBp + 128, LWp + (size_t)1024 * 384 + 128, T, 512, 256, 384, 384}; SOrder S; S.init(T, 512, G, bid); EpiLora E{p.ws, 4}; pg8::gemm_phase<EpiLora, SOrder, false, true>(lds, g, S, E, tid); }
              if (layer == 1) { Gemm g{LBp + 256, LWp + (size_t)1536 * 384 + 256, T, 512, 128, 384, 384}; SOrder S; S.init(T, 512, G, bid); EpiLora E{p.ws, 6}; pg8::gemm_phase<EpiLora, SOrder, false, true>(lds, g, S, E, tid); } }
#else
            { bf16* RW = WSP(bf16, AR_RW); bf16* Wm = WSP(bf16, AR_W); bf16* Am = WSP(bf16, AR_A); bf16* Gm = WSP(bf16, AR_G); const bf16* VF = WSP(bf16, WS_VF);
              const float* vec = p.rwkv_vec + (size_t)layer * 7 * RC; const float* wup = p.w_up + (size_t)layer * 64 * RC; const float* aup = p.a_up + (size_t)layer * 64 * RC; const float* gup = p.g_up + (size_t)layer * 160 * RC;
              for (long it = gtid; it < (long)T * RC; it += NT) { const int t = (int)(it / RC), c = (int)(it % RC); bf16* row = RW + (size_t)t * LDRW; const bf16* L = row + LBLK;
                  float wl = vec[c], alin = vec[RC + c], g = 0.f;
                  for (int j = 0; j < 64; ++j) { wl += bf2f(L[j]) * bf2f(f2bf(wup[j * RC + c])); alin += bf2f(L[64 + j]) * bf2f(f2bf(aup[j * RC + c])); }
                  for (int j = 0; j < 160; ++j) g += bf2f(L[128 + j]) * bf2f(f2bf(gup[j * RC + c]));
                  const float nx = -wl, sp = fmaxf(nx, 0.f) + __logf(1.f + __expf(-fabsf(nx))), e = __expf(-sp - 0.5f);
                  Wm[it] = f2bf(1.f - __expf(-e)); Am[it] = f2bf(fsig(alin)); Gm[it] = f2bf(g);
                  if (layer == 1) { float vl = p.vres_b[c]; for (int j = 0; j < 32; ++j) vl += bf2f(L[288 + j]) * bf2f(f2bf(p.vres_up[j * RC + c]));
                      const float v = bf2f(row[1024 + c]), vf = bf2f(VF[it]); row[1024 + c] = f2bf(v + (vf - v) * fsig(vl)); } } }
#endif
            SEAM(pb + 3); }
        if (PHM(4) && IN(pb + 4)) { MKP; ph_rwkv_b2w(p, layer, gw, NGW, lane); ph_cmp2w(p, layer, gw, NGW, lane, (LAS float*)(lds + wave * 512)); SEAM(pb + 4); }
        if (PHM(5) && IN(pb + 5)) { MKP;  if (layer == 0) p.hb = (unsigned char*)p.out;
            { LAS unsigned char* wl = lds + wave * AW_BYTES; constexpr int NSC = BATCH * 8 * 16, NIT = BATCH * NKV * (SEQ / 16);
#ifndef SCAN_QUEUE
              if (wave < 4) {
                  if (G * 4 == NSC && (G & 7) == 0) scan_unit(p, (bid & 7) * (NSC / 8) + (bid >> 3) * 4 + wave, lane, wl);
                  else for (int u = bid * 4 + wave; u < NSC; u += G * 4) scan_unit(p, u, lane, wl); }
#endif
#ifdef APROBE_SPLIT
              xcd_barrier(bar, tid);
#endif
              const int xme = (int)(xb_xcc_id() & 7u);
              for (int qq = 0; qq < 8; ++qq) { const int qx = (xme + qq) & 7; unsigned* head = ctl + CW_ATT + ((layer * 3 + st) * 8 + qx) * 16;
                  for (;;) { int it = 0; if (lane == 0) it = (int)atomicAdd(head, 1u); it = __builtin_amdgcn_readfirstlane(it); if (it >= NIT / 8) break;
                      const int bg = 2 * qx + it / (SEQ / 16), t16 = (SEQ / 16 - 1) - it % (SEQ / 16);
                      nsa_attn_item(p, bg * (SEQ / 16) + t16, lane, wl); } } }
 SEAM(pb + 5); }
        if (PHM(6) && IN(pb + 6)) { MKP; ph_rwkv_postw(p, layer, gw, NGW, lane); SEAM(pb + 6); }
        if (PHM(7) && IN(pb + 7)) { MKP;
            Gemm g{WSP(bf16, AR_QB), (const bf16*)(p.ws + WS_W + (size_t)layer * SZ_LAYERW + OFF_WO3), 3 * T, 3 * DM, 512}; StackOrder S{T / 256, DM / 256, 3, G, bid};
            EpiStore E{WSP(bf16, AR_OBUF), DM, DM / 256};
            pg8::gemm_phase<EpiStore, StackOrder, true, true>(lds, g, S, E, tid);
            if (layer != 0) { MKP; const float* xin = p.out;
              RMS_LOOP(xin, p.mix_norm_g + (size_t)layer * DM, false, cdum0, cdum1); }
            SEAM(pb + 7);
        }
        if (PHM(8) && IN(pb + 8)) { MKP;
            Gemm g{WSP(bf16, WS_H), (const bf16*)(p.ws + WS_W + (size_t)layer * SZ_LAYERW + OFF_WG), T, 3 * DM, DM}; GateOrder S{T / 256, DM / 256, G, bid};
            EpiGate E{p.ws, DM / 256};
            pg8::gemm_phase<EpiGate, GateOrder, true, true>(lds, g, S, E, tid);
            SEAM(pb + 8);
        }
        if (PHM(9) && IN(pb + 9)) { MKP;
            Gemm g{WSP(bf16, AR_MIX), (const bf16*)(p.ws + WS_W + (size_t)layer * SZ_LAYERW + OFF_WOUT), T, DM, DM}; SOrder S; S.init(T, DM, G, bid);
            EpiResid E{layer == 0 ? p.x : p.out, p.out};
            pg8::gemm_phase<EpiResid, SOrder, true, true>(lds, g, S, E, tid);
            SEAM(pb + 9);
        }
        if (PHM(10) && IN(pb + 10)) { MKP;
            unsigned long long c0 = 0ull, c1 = 0ull;
            if (layer == 1) { float rwr[128];
#pragma unroll
                for (int j = 0; j < DM / 256; ++j)
#pragma unroll
                    for (int k = 0; k < 8; ++k) { const f32x4 w4 = *(const f32x4*)(p.router_w + (size_t)(4 * (lane + 64 * j)) * NEXP + 4 * k); rwr[j * 32 + 4 * k] = w4.x; rwr[j * 32 + 4 * k + 1] = w4.y; rwr[j * 32 + 4 * k + 2] = w4.z; rwr[j * 32 + 4 * k + 3] = w4.w; }
                RMS_LOOP_R(p.out, p.ffn_norm_g + (size_t)layer * DM, c0, c1, rwr);
            } else RMS_LOOP(p.out, p.ffn_norm_g + (size_t)layer * DM, false, c0, c1);
            if (layer == 1 && lane < 16) {
                const unsigned cn = (unsigned)(((lane < 8 ? c0 : c1) >> (8 * (lane & 7))) & 255ull);
                WSP(unsigned, AR_WBASE)[(size_t)gw * 16 + lane] = atomicAdd(ctl + CW_CNT + lane * 64, cn); }
            if (layer == 1) { int* rt = WSP(int, AR_RTOK); for (long i = gtid; i < 2L * MOE_ROWS; i += NT) rt[i] = -1; }
            SEAM(pb + 10);
        }
        if (layer == 0) {
            if (PHM(11) && IN(pb + 11)) { MKP;
                Gemm g{WSP(bf16, WS_H), WSP(bf16, WS_DGU), T, 2 * DENSE_FF, DM}; SOrder S; S.init(T, 2 * DENSE_FF, G, bid);
                EpiSwiglu E{WSP(bf16, AR_ACT), DENSE_FF, 2 * DENSE_FF / 256};
                pg8::gemm_phase<EpiSwiglu, SOrder, true, true>(lds, g, S, E, tid);
                SEAM(pb + 11);
            }
            if (PHM(12) && IN(pb + 12)) { MKP;
                Gemm g{WSP(bf16, AR_ACT), WSP(bf16, WS_DDN), T, DM, DENSE_FF}; SOrder S; S.init(T, DM, G, bid);
                EpiResid E{p.out, p.out};
                pg8::gemm_phase<EpiResid, SOrder, true, true>(lds, g, S, E, tid);
                SEAM(pb + 12);
            }
        } else {
            if (PHM(11) && IN(pb + 11)) { MKP;
                const int ig = (DM / 64) * (2 * EXPERT_FF / 32), id = (EXPERT_FF / 64) * (DM / 32);
                for (int it = gw; it < NEXP * (ig + id); it += NGW) { const int e = it / (ig + id); int r = it % (ig + id);
                    if (conv_job(r, p.moe_gu + (size_t)e * DM * 2 * EXPERT_FF, DM, 2 * EXPERT_FF, MapGlu{WSP(bf16, AR_MGU) + (size_t)e * 2 * EXPERT_FF * DM, DM, EXPERT_FF}, scrw, lane)) continue;
                    conv_job(r, p.moe_down + (size_t)e * EXPERT_FF * DM, EXPERT_FF, DM, MapPlain{WSP(bf16, AR_MDN) + (size_t)e * DM * EXPERT_FF, EXPERT_FF}, scrw, lane); }
                int* rtok = WSP(int, AR_RTOK); float* rww = WSP(float, AR_RW8); int* trow = WSP(int, AR_TROW);
                int segv = 0; { const int pc = lane < 16 ? (int)((ctl[CW_CNT + lane * 64] + 255u) & ~255u) : 0;
#pragma unroll
                    for (int k = 0; k < 8; ++k) { const int ck = bperm_i(pc, (lane & 8) + k); segv += (k < (lane & 7)) ? ck : 0; } }
                for (int hb = gw; hb < 2 * (T / 64); hb += NGW) {
                    const int tb = (hb >> 1) * 64, half = hb & 1, t = tb + lane; const int ee = WSP(int, AR_RTE)[t], e0 = ee & 255, e1 = (ee >> 8) & 255, r0 = (ee >> 16) & 255, r1 = (ee >> 24) & 255;
                    const float* w = WSP(float, AR_RTW) + (size_t)t * 2; const unsigned* wb = WSP(unsigned, AR_WBASE) + (size_t)(t % NGW) * 16;
                    const int row0 = bperm_i(segv, e0) + (int)wb[e0] + r0, row1 = bperm_i(segv, 8 + e1) + (int)wb[8 + e1] + r1;
                    if (half == 0) { rtok[row0] = t; rww[row0] = w[0]; rtok[MOE_ROWS + row1] = t; rww[MOE_ROWS + row1] = w[1]; trow[T + t] = row1; }
                    for (int l = 32 * half; l < 32 * half + 32; l += 8) { const bf16* hs = WSP(bf16, WS_H) + (size_t)(tb + l) * DM; int dr[8];
#pragma unroll
                        for (int q = 0; q < 8; ++q) dr[q] = __builtin_amdgcn_readlane(row0, l + q);
                        copy_rows8(hs, dr, WSP(bf16, AR_XG), lane); }
                }
                SEAM(pb + 11);
            }
#pragma unroll
            for (int pass = 0; pass < 2; ++pass) {
                if (PHM(12) && IN(pb + 12 + 2 * pass)) { MKP;
                    Gemm g{WSP(bf16, AR_XG), WSP(bf16, AR_MGU), MOE_ROWS, NEXP * 2 * EXPERT_FF, DM}; MoeOrder S; S.init(ctl + CW_CNT + 8 * 64 * pass, 2 * EXPERT_FF / 256, G, bid);
                    EpiSwiglu E{WSP(bf16, AR_MACT), EXPERT_FF, 2 * EXPERT_FF / 256};
                    if (pass == 1) {
                        MoeOrder S0; S0.init(ctl + CW_CNT, DM / 256, G, bid); const int nwg = S0.s.nwg, mainw = (nwg / G) * G, ttiles = nwg - mainw;
                        if (bar.st != nullptr && (G & 31) == 0 && mainw > 0 && ttiles > 0 && ttiles <= 32) {
                            EpiMoeDown E0{p.out, WSP(int, AR_RTOK), WSP(float, AR_RW8), DM / 256, (PR_LO >= 0 && st == 0 && pb + 14 >= PR_LO && pb + 14 <= PR_HI) ? 0.f : 1.f};
                            for (int job = wave * G + bid; job < ttiles * 32; job += NWAVES * G) moe_tail_combine(E0, S0, WSP(float, WS_PART), mainw / (DM / 256), job, lane); } }
                    pg8::gemm_phase<EpiSwiglu, MoeOrder, true, true>(lds, g, S, E, tid);
                    SEAM(pb + 12 + 2 * pass);
                }
                if (PHM(13) && IN(pb + 13 + 2 * pass)) { MKP;
                    Gemm g{WSP(bf16, AR_MACT), WSP(bf16, AR_MDN), MOE_ROWS, NEXP * DM, EXPERT_FF}; MoeOrder S; S.init(ctl + CW_CNT + 8 * 64 * pass, DM / 256, G, bid);
                    EpiMoeDown E{p.out, WSP(int, AR_RTOK) + (size_t)pass * MOE_ROWS, WSP(float, AR_RW8) + (size_t)pass * MOE_ROWS, DM / 256, (PR_LO >= 0 && st == 0 && pb + 13 + 2 * pass >= PR_LO && pb + 13 + 2 * pass <= PR_HI) ? 0.f : 1.f};
                    if (pass == 0) { const int* trow = WSP(int, AR_TROW);
                        for (int t = gw * 8; t < T; t += NGW * 8) { const bf16* hs = WSP(bf16, WS_H) + (size_t)t * DM; int dr[8];
#pragma unroll
                            for (int q = 0; q < 8; ++q) dr[q] = trow[T + t + q];
                            copy_rows8(hs, dr, WSP(bf16, AR_XG), lane); } }
                    const int nwg = S.s.nwg, mainw = (nwg / G) * G, ttiles = nwg - mainw; const bool split = bar.st != nullptr && (G & 31) == 0 && mainw > 0 && ttiles > 0 && ttiles <= 32;
                    if (split) S.s.nwg = mainw;
                    pg8::gemm_phase<EpiMoeDown, MoeOrder, true, true>(lds, g, S, E, tid);
                    if (split) { Gemm g2{WSP(bf16, AR_MACT), WSP(bf16, AR_MDN), MOE_ROWS, NEXP * DM, MT_K, EXPERT_FF, EXPERT_FF}; MoeTailOrder S2; S2.init(S, mainw / (DM / 256), ttiles, G, bid);
                        EpiPart E2{WSP(float, WS_PART), mainw / (DM / 256), DM / 256};
                        pg8::gemm_phase<EpiPart, MoeTailOrder, true, true, true>(lds, g2, S2, E2, tid); }
                    if (pass == 1 && split) { { int w_ = wave0; asm volatile("" : "+s"(w_)); xcd_barrier(bar, w_ * 64 + lane_id_opaque()); }
                        for (int job = wave * G + bid; job < ttiles * 32; job += NWAVES * G) moe_tail_combine(E, S, WSP(float, WS_PART), mainw / (DM / 256), job, lane); }
                    SEAM(pb + 13 + 2 * pass);
                }
            }
        }
    };
    run_layer(std::integral_constant<int, 0>{}); run_layer(std::integral_constant<int, 1>{});
    }
#ifdef PROBE_TK
    { int w_ = wave0; asm volatile("" : "+s"(w_)); xcd_barrier(bar, w_ * 64 + lane_id_opaque()); }
    if (blockIdx.x == 0 && threadIdx.x == 0) { const unsigned long long* tk = (const unsigned long long*)(args.ws + WS_CTL + 4 * CW_TK); __builtin_amdgcn_fence(__ATOMIC_SEQ_CST, "agent");
#ifndef PROBE_STAT
        args.out[0] += floorf((float)(long long)(tk[PROBE_A1] - tk[PROBE_A0]) * 0.01f / (float)(PROBE_TU)); }
#else
        long long mx = 0, mn = 1ll << 60; for (int b = 0; b < (int)gridDim.x; ++b) { const long long d = (long long)(tk[32 + b] - tk[0]); mx = d > mx ? d : mx; mn = d < mn ? d : mn; }
        int cnt = 0; for (int b = 0; b < (int)gridDim.x; ++b) { const long long d = (long long)(tk[32 + b] - tk[0]); cnt += (mx - d) <= 100ll * PROBE_WIN ? 1 : 0; }
        args.out[0] += PROBE_STAT == 1 ? floorf((float)mx * 0.01f / (float)(PROBE_TU)) : (PROBE_STAT == 2 ? (float)cnt : floorf((float)mn * 0.01f / (float)(PROBE_TU))); }
#endif
#endif
#undef IN
#undef SEAM
}

#ifndef MK_ONE_LAUNCH
#define MK_ONE_LAUNCH 1
#endif
extern "C" void kernel_launch(void* const* d_in, const int* in_sizes, int n_in, void* d_out, int out_size, void* d_ws, size_t ws_size, hipStream_t stream) {
    static int grid = 0;
    if (grid == 0) {
        if (n_in != 29 || in_sizes[0] != T * DM || out_size != T * DM || ws_size < WS_END) { fprintf(stderr, "kernel_launch: unexpected shapes / workspace (%d inputs, ws %zu, need %zu)\n", n_in, ws_size, (size_t)WS_END); grid = -1; return; }
        int dev = 0, cus = 0;
        if (hipGetDevice(&dev) != hipSuccess || hipDeviceGetAttribute(&cus, hipDeviceAttributeMultiprocessorCount, dev) != hipSuccess) { grid = -1; return; }
        const void* kfn = cus == 256 ? (const void*)mk_fwd_t<256> : (const void*)mk_fwd_t<0>;
        if (hipFuncSetAttribute(kfn, hipFuncAttributeMaxDynamicSharedMemorySize, LDS_BYTES) != hipSuccess) { fprintf(stderr, "kernel_launch: hipFuncSetAttribute failed\n"); grid = -1; return; }
        int per_cu = 0;
        if (hipOccupancyMaxActiveBlocksPerMultiprocessor(&per_cu, kfn, NTHREADS, LDS_BYTES) != hipSuccess || per_cu < 1) { fprintf(stderr, "kernel_launch: occupancy query says %d\n", per_cu); }
        (void)hipGetLastError();
        grid = cus;
    }
    if (grid < 0) return;
    if (hipMemsetAsync((char*)d_ws + WS_CTL, 0, CTL_BYTES, stream) != hipSuccess) return;
    Args a{};
    for (int i = 0; i < 29; ++i) a.in[i] = (const float*)d_in[i];
    a.out = (float*)d_out; a.ws = (unsigned char*)d_ws;
#if MK_ONE_LAUNCH
    a.ph_lo = 0; a.ph_hi = NPHASES;
    if (grid == 256) hipLaunchKernelGGL(mk_fwd_t<256>, dim3(grid), dim3(NTHREADS), LDS_BYTES, stream, a);
    else hipLaunchKernelGGL(mk_fwd_t<0>, dim3(grid), dim3(NTHREADS), LDS_BYTES, stream, a);
#else
    for (int k = 0; k < NPHASES; ++k) {
        if (k >= 1 + 13 && k < 1 + NPH) continue;
        a.ph_lo = k; a.ph_hi = k + 1;
        hipLaunchKernelGGL(mk_fwd_t<0>, dim3(grid), dim3(NTHREADS), LDS_BYTES, stream, a);
    }
#endif
}
```
